# Optimizing an MI355X kernel written in HIP

```python
import math
import jax
import jax.numpy as jnp
from jax import lax
import numpy as np

D_MODEL = 1024
BATCH = 2
SEQ = 8192
DEPTH = 2

GRID_W = 64
CTX_LEN = 256

N_MIXERS = 2
N_SSM_LAYERS = (DEPTH + 1) // 2
N_ATT_LAYERS = DEPTH // 2
N_MOD = 6

S5_GROUP = 16
S5_GROUPS = D_MODEL // S5_GROUP
S5_STATE = 64
S5_DT_MIN = 1e-3
S5_DT_MAX = 1e-1

MLA_HEADS = 8
MLA_NOPE = 128
MLA_ROPE = 64
MLA_V = 128
MLA_Q_LORA = 384
MLA_KV_LORA = 256
ROPE_BASE = 10000.0
Q_BLOCK = 128

PEER_HEADS = 8
PEER_NKEYS = 128
PEER_EXPERTS = PEER_NKEYS * PEER_NKEYS
PEER_DK = 128
PEER_TOPK = 16
PEER_TOKEN_BLOCK = 128

ALPHA = (2 * DEPTH) ** 0.25
BETA = (8 * DEPTH) ** -0.25
LN_EPS = 1e-5
RMS_EPS = 1e-6

kernel_name = 'hybrid_s5_mla_peer_diffusion_block'


def layer_norm(x, g, b):
    xf = x.astype(jnp.float32)
    mu = jnp.mean(xf, axis=-1, keepdims=True)
    var = jnp.mean(jnp.square(xf - mu), axis=-1, keepdims=True)
    return (xf - mu) * lax.rsqrt(var + LN_EPS) * g + b


def rms_norm(x, g):
    xf = x.astype(jnp.float32)
    return xf * lax.rsqrt(jnp.mean(jnp.square(xf), axis=-1, keepdims=True) + RMS_EPS) * g


def axial_rope_angles(n_tokens):
    rows = n_tokens // GRID_W
    r, col = jnp.meshgrid(jnp.arange(rows, dtype=jnp.float32),
                          jnp.arange(GRID_W, dtype=jnp.float32), indexing='ij')
    n_freq = MLA_ROPE // 4
    inv = ROPE_BASE ** (-jnp.arange(n_freq, dtype=jnp.float32) / n_freq)
    ang = jnp.concatenate([r.reshape(-1, 1) * inv, col.reshape(-1, 1) * inv], axis=-1)
    return jnp.cos(ang), jnp.sin(ang)


def apply_rope(x, cos, sin):
    half = x.shape[-1] // 2
    x1, x2 = x[..., :half], x[..., half:]
    return jnp.concatenate([x1 * cos - x2 * sin, x2 * cos + x1 * sin], axis=-1)


def s5_discretize(a_re, a_im, log_dt):
    a_re = a_re.astype(jnp.float32)
    a_im = a_im.astype(jnp.float32)
    dt = jnp.exp(log_dt.astype(jnp.float32))[:, None]
    mag = jnp.exp(a_re * dt)
    ab_re = mag * jnp.cos(a_im * dt)
    ab_im = mag * jnp.sin(a_im * dt)
    nr, ni = ab_re - 1.0, ab_im
    den = a_re * a_re + a_im * a_im
    f_re = (nr * a_re + ni * a_im) / den
    f_im = (ni * a_re - nr * a_im) / den
    return ab_re, ab_im, f_re, f_im


def _complex_affine_combine(e1, e2):
    a1r, a1i, b1r, b1i = e1
    a2r, a2i, b2r, b2i = e2
    return (a2r * a1r - a2i * a1i,
            a2r * a1i + a2i * a1r,
            a2r * b1r - a2i * b1i + b2r,
            a2r * b1i + a2i * b1r + b2i)


def complex_linear_scan(ab_re, ab_im, bu_re, bu_im, h0, reverse):
    if h0 is not None:
        first = -1 if reverse else 0
        h0_re, h0_im = h0
        bu_re = bu_re.at[first].add(ab_re * h0_re - ab_im * h0_im)
        bu_im = bu_im.at[first].add(ab_re * h0_im + ab_im * h0_re)
    n = bu_re.shape[0]
    a_re = jnp.broadcast_to(ab_re, (n, 1) + ab_re.shape)
    a_im = jnp.broadcast_to(ab_im, (n, 1) + ab_im.shape)
    _, _, h_re, h_im = lax.associative_scan(_complex_affine_combine, (a_re, a_im, bu_re, bu_im),
                                            reverse=reverse, axis=0)
    return h_re, h_im


def s5_direction(u_lat, u_ctx, a_re, a_im, log_dt, b_re, b_im, c_re, c_im, reverse, need_ctx_out):
    ab_re, ab_im, f_re, f_im = s5_discretize(a_re, a_im, log_dt)
    b_re = b_re.astype(jnp.float32)
    b_im = b_im.astype(jnp.float32)
    c_re = c_re.astype(jnp.float32)
    c_im = c_im.astype(jnp.float32)

    def drive(u):
        bu_re = jnp.einsum('lbgc,gpc->lbgp', u, b_re)
        bu_im = jnp.einsum('lbgc,gpc->lbgp', u, b_im)
        return f_re * bu_re - f_im * bu_im, f_re * bu_im + f_im * bu_re

    def readout(h_re, h_im):
        return (jnp.einsum('lbgp,gcp->lbgc', h_re, c_re)
                - jnp.einsum('lbgp,gcp->lbgc', h_im, c_im))

    hc_re, hc_im = complex_linear_scan(ab_re, ab_im, *drive(u_ctx), None, reverse)
    last = 0 if reverse else -1
    hl_re, hl_im = complex_linear_scan(ab_re, ab_im, *drive(u_lat),
                                       (hc_re[last], hc_im[last]), reverse)
    y_ctx = readout(hc_re, hc_im) if need_ctx_out else None
    return readout(hl_re, hl_im), y_ctx


def s5_output(y, w_glu, w_o):
    y = jax.nn.gelu(y, approximate=False)
    return (y * jax.nn.sigmoid(y @ w_glu)) @ w_o


def s5_mixer(h_lat, h_ctx, a_re, a_im, log_dt, b_re, b_im, c_re, c_im, d, w_glu, w_o, need_ctx_out):
    def to_groups(h):
        bsz, n, _ = h.shape
        return h.astype(jnp.float32).transpose(1, 0, 2).reshape(n, bsz, S5_GROUPS, S5_GROUP)

    def from_groups(y):
        n, bsz = y.shape[:2]
        return y.reshape(n, bsz, D_MODEL).transpose(1, 0, 2)

    u_lat, u_ctx = to_groups(h_lat), to_groups(h_ctx)
    yf_l, yf_c = s5_direction(u_lat, u_ctx, a_re[0], a_im[0], log_dt[0], b_re[0], b_im[0],
                              c_re[0], c_im[0], False, need_ctx_out)
    yb_l, yb_c = s5_direction(u_lat, u_ctx, a_re[1], a_im[1], log_dt[1], b_re[1], b_im[1],
                              c_re[1], c_im[1], True, need_ctx_out)
    o_lat = s5_output(from_groups(yf_l + yb_l) + d * h_lat, w_glu, w_o)
    o_ctx = None
    if need_ctx_out:
        o_ctx = s5_output(from_groups(yf_c + yb_c) + d * h_ctx, w_glu, w_o)
    return o_lat, o_ctx


def mla_queries(h, w_dq, q_norm, w_uq, rope):
    bsz, n, _ = h.shape
    q = (rms_norm(h @ w_dq, q_norm) @ w_uq).reshape(bsz, n, MLA_HEADS, MLA_NOPE + MLA_ROPE)
    q_nope, q_rope = q[..., :MLA_NOPE], q[..., MLA_NOPE:]
    if rope is not None:
        cos, sin = rope
        q_rope = apply_rope(q_rope, cos[None, :, None, :], sin[None, :, None, :])
    return q_nope, q_rope


def mla_keys_values(h, w_dkv, kv_norm, w_ukv, rope):
    bsz, n, _ = h.shape
    kv = h @ w_dkv
    c_kv = rms_norm(kv[..., :MLA_KV_LORA], kv_norm)
    k_rope = kv[..., MLA_KV_LORA:]
    if rope is not None:
        cos, sin = rope
        k_rope = apply_rope(k_rope, cos[None], sin[None])
    kvu = (c_kv @ w_ukv).reshape(bsz, n, MLA_HEADS, MLA_NOPE + MLA_V)
    return kvu[..., :MLA_NOPE], k_rope, kvu[..., MLA_NOPE:]


def mla_attend(q_nope, q_rope, k_nope, k_rope, v):
    scale = (MLA_NOPE + MLA_ROPE) ** -0.5
    s = (jnp.einsum('bqhd,bkhd->bhqk', q_nope, k_nope)
         + jnp.einsum('bqhr,bkr->bhqk', q_rope, k_rope))
    p = jax.nn.softmax(s.astype(jnp.float32) * scale, axis=-1).astype(v.dtype)
    return jnp.einsum('bhqk,bkhd->bqhd', p, v)


def mla_attend_blocked(q_nope, q_rope, k_nope, k_rope, v):
    bsz, n = q_nope.shape[:2]
    nb = n // Q_BLOCK
    qn = q_nope.reshape(bsz, nb, Q_BLOCK, MLA_HEADS, MLA_NOPE).transpose(1, 0, 2, 3, 4)
    qr = q_rope.reshape(bsz, nb, Q_BLOCK, MLA_HEADS, MLA_ROPE).transpose(1, 0, 2, 3, 4)
    out = lax.map(lambda qs: mla_attend(qs[0], qs[1], k_nope, k_rope, v), (qn, qr))
    return out.transpose(1, 0, 2, 3, 4).reshape(bsz, n, MLA_HEADS, MLA_V)


def mla_mixer(h_lat, h_ctx, w_dq, q_norm, w_uq, w_dkv, kv_norm, w_ukv, w_o, need_ctx_out):
    bsz, n_lat, _ = h_lat.shape
    rope = axial_rope_angles(n_lat)
    kn_c, kr_c, v_c = mla_keys_values(h_ctx, w_dkv, kv_norm, w_ukv, None)
    kn_l, kr_l, v_l = mla_keys_values(h_lat, w_dkv, kv_norm, w_ukv, rope)
    qn_l, qr_l = mla_queries(h_lat, w_dq, q_norm, w_uq, rope)
    k_nope = jnp.concatenate([kn_l, kn_c], axis=1)
    k_rope = jnp.concatenate([kr_l, kr_c], axis=1)
    v = jnp.concatenate([v_l, v_c], axis=1)
    o_lat = mla_attend_blocked(qn_l, qr_l, k_nope, k_rope, v).reshape(bsz, n_lat, MLA_HEADS * MLA_V) @ w_o
    o_ctx = None
    if need_ctx_out:
        qn_c, qr_c = mla_queries(h_ctx, w_dq, q_norm, w_uq, None)
        o_ctx = mla_attend(qn_c, qr_c, kn_c, kr_c, v_c).reshape(bsz, h_ctx.shape[1], MLA_HEADS * MLA_V) @ w_o
    return o_lat, o_ctx


def peer_route(t, w_q, keys):
    n_tok = t.shape[0]
    q = (t @ w_q).reshape(n_tok, PEER_HEADS, 2, PEER_DK // 2)
    s = jnp.einsum('thsd,hsnd->thsn', q, keys).astype(jnp.float32)
    sv, si = lax.top_k(s, PEER_TOPK)
    cand = sv[:, :, 0, :, None] + sv[:, :, 1, None, :]
    cv, ci = lax.top_k(cand.reshape(n_tok, PEER_HEADS, PEER_TOPK * PEER_TOPK), PEER_TOPK)
    i1 = jnp.take_along_axis(si[:, :, 0], ci // PEER_TOPK, axis=-1)
    i2 = jnp.take_along_axis(si[:, :, 1], ci % PEER_TOPK, axis=-1)
    e = i1 * PEER_NKEYS + i2
    g = jax.nn.softmax(cv, axis=-1)
    return e.reshape(n_tok, -1), g.reshape(n_tok, -1)


def peer_channel(h, w_q, keys, u_tab, v_tab):
    bsz, n, d = h.shape
    t = h.reshape(bsz * n, d)
    idx, gate = peer_route(t, w_q, keys)
    nb = t.shape[0] // PEER_TOKEN_BLOCK

    def block(args):
        hb, ib, gb = args
        act = jax.nn.gelu(jnp.einsum('td,tkd->tk', hb, u_tab[ib]), approximate=False) * gb
        return jnp.einsum('tk,tkd->td', act, v_tab[ib])

    out = lax.map(block, (t.reshape(nb, PEER_TOKEN_BLOCK, d),
                          idx.reshape(nb, PEER_TOKEN_BLOCK, -1),
                          gate.reshape(nb, PEER_TOKEN_BLOCK, -1)))
    return out.reshape(bsz, n, d)


def setup_inputs(seed: int = 0) -> dict:
    key = jax.random.key(seed)
    ks = jax.random.split(key, 32)
    f32 = jnp.float32

    def nrm(k, shape, std):
        return jax.random.normal(k, shape, f32) * std

    D = D_MODEL
    NS, NA = N_SSM_LAYERS, N_ATT_LAYERS
    G, P, GC = S5_GROUPS, S5_STATE, S5_GROUP
    n_idx = jnp.arange(P, dtype=f32)
    return {
        'x': nrm(ks[0], (BATCH, SEQ, D), 1.0),
        'c': nrm(ks[1], (BATCH, D), 1.0),
        'ctx': nrm(ks[2], (BATCH, CTX_LEN, D), 1.0),
        'c_ctx': nrm(ks[3], (D,), 1.0),
        'ada_w': nrm(ks[4], (DEPTH, D, N_MOD * D), 0.5 * D ** -0.5),
        'ada_b': nrm(ks[5], (DEPTH, N_MOD * D), 0.02),
        'ln_g': 1.0 + nrm(ks[6], (DEPTH, 2, D), 0.02),
        'ln_b': nrm(ks[7], (DEPTH, 2, D), 0.02),
        's5_a_re': -0.5 + nrm(ks[8], (NS, 2, G, P), 0.01),
        's5_a_im': math.pi * n_idx + nrm(ks[9], (NS, 2, G, P), 0.01),
        's5_log_dt': jax.random.uniform(ks[10], (NS, 2, G), f32, math.log(S5_DT_MIN), math.log(S5_DT_MAX)),
        's5_b_re': nrm(ks[11], (NS, 2, G, P, GC), (2 * GC) ** -0.5),
        's5_b_im': nrm(ks[12], (NS, 2, G, P, GC), (2 * GC) ** -0.5),
        's5_c_re': nrm(ks[13], (NS, 2, G, GC, P), P ** -0.5),
        's5_c_im': nrm(ks[14], (NS, 2, G, GC, P), P ** -0.5),
        's5_d': nrm(ks[15], (NS, D), 1.0),
        's5_w_glu': nrm(ks[16], (NS, D, D), D ** -0.5),
        's5_w_o': nrm(ks[17], (NS, D, D), BETA * D ** -0.5),
        'mla_w_dq': nrm(ks[18], (NA, D, MLA_Q_LORA), D ** -0.5),
        'mla_q_norm': 1.0 + nrm(ks[19], (NA, MLA_Q_LORA), 0.02),
        'mla_w_uq': nrm(ks[20], (NA, MLA_Q_LORA, MLA_HEADS * (MLA_NOPE + MLA_ROPE)), MLA_Q_LORA ** -0.5),
        'mla_w_dkv': nrm(ks[21], (NA, D, MLA_KV_LORA + MLA_ROPE), D ** -0.5),
        'mla_kv_norm': 1.0 + nrm(ks[22], (NA, MLA_KV_LORA), 0.02),
        'mla_w_ukv': nrm(ks[23], (NA, MLA_KV_LORA, MLA_HEADS * (MLA_NOPE + MLA_V)), MLA_KV_LORA ** -0.5),
        'mla_w_o': nrm(ks[24], (NA, MLA_HEADS * MLA_V, D), BETA * (MLA_HEADS * MLA_V) ** -0.5),
        'peer_w_q': nrm(ks[25], (DEPTH, D, PEER_HEADS * PEER_DK), D ** -0.5),
        'peer_keys': nrm(ks[26], (DEPTH, PEER_HEADS, 2, PEER_NKEYS, PEER_DK // 2), (PEER_DK // 2) ** -0.5),
        'peer_u': nrm(ks[27], (DEPTH, PEER_EXPERTS, D), D ** -0.5),
        'peer_v': nrm(ks[28], (DEPTH, PEER_EXPERTS, D), BETA),
    }


def reference(x, c, ctx, c_ctx, ada_w, ada_b, ln_g, ln_b,
              s5_a_re, s5_a_im, s5_log_dt, s5_b_re, s5_b_im, s5_c_re, s5_c_im, s5_d, s5_w_glu, s5_w_o,
              mla_w_dq, mla_q_norm, mla_w_uq, mla_w_dkv, mla_kv_norm, mla_w_ukv, mla_w_o,
              peer_w_q, peer_keys, peer_u, peer_v):
    bsz, n_lat, d = x.shape
    h_lat, h_ctx = x, ctx
    sc = jax.nn.silu(c)
    scc = jax.nn.silu(c_ctx)
    for i in range(DEPTH):
        last = i == DEPTH - 1
        mod_l = (sc @ ada_w[i] + ada_b[i]).reshape(bsz, N_MOD, d).transpose(1, 0, 2)[:, :, None, :]
        mod_c = (scc @ ada_w[i] + ada_b[i]).reshape(N_MOD, 1, 1, d)
        m_l = h_lat * (1.0 + mod_l[1]) + mod_l[0]
        m_c = h_ctx * (1.0 + mod_c[1]) + mod_c[0]
        j = i // N_MIXERS
        if i % N_MIXERS == 0:
            o_l, o_c = s5_mixer(m_l, m_c, s5_a_re[j], s5_a_im[j], s5_log_dt[j], s5_b_re[j], s5_b_im[j],
                                s5_c_re[j], s5_c_im[j], s5_d[j], s5_w_glu[j], s5_w_o[j], not last)
        else:
            o_l, o_c = mla_mixer(m_l, m_c, mla_w_dq[j], mla_q_norm[j], mla_w_uq[j], mla_w_dkv[j],
                                 mla_kv_norm[j], mla_w_ukv[j], mla_w_o[j], not last)
        h_lat = layer_norm(ALPHA * h_lat + mod_l[2] * o_l, ln_g[i, 0], ln_b[i, 0])
        f_l = peer_channel(h_lat * (1.0 + mod_l[4]) + mod_l[3], peer_w_q[i], peer_keys[i], peer_u[i], peer_v[i])
        h_lat = layer_norm(ALPHA * h_lat + mod_l[5] * f_l, ln_g[i, 1], ln_b[i, 1])
        if not last:
            h_ctx = layer_norm(ALPHA * h_ctx + mod_c[2] * o_c, ln_g[i, 0], ln_b[i, 0])
            f_c = peer_channel(h_ctx * (1.0 + mod_c[4]) + mod_c[3], peer_w_q[i], peer_keys[i], peer_u[i], peer_v[i])
            h_ctx = layer_norm(ALPHA * h_ctx + mod_c[5] * f_c, ln_g[i, 1], ln_b[i, 1])
    return h_lat.astype(x.dtype)
```

```cpp
#include <hip/hip_runtime.h>
#include <math.h>
#include <cstdio>

constexpr int D = 1024, NB = 2, SEQ = 8192, CTX = 256;
constexpr int NL = NB * SEQ, NC = NB * CTX, NT = NL + NC;
constexpr float ALPHA = 1.4142135623730951f;
constexpr float LN_EPS = 1e-5f, RMS_EPS = 1e-6f;

__device__ __forceinline__ float wave_sum(float v) {
#pragma unroll
  for (int o = 32; o >= 1; o >>= 1) v += __shfl_xor(v, o);
  return v;
}
__device__ __forceinline__ int row_vec(int row) { return row < NL ? (row >> 13) : 2; }
__device__ __forceinline__ float gelu_exact(float x) { return 0.5f * x * (1.f + erff(x * 0.70710678118654752f)); }

__global__ __launch_bounds__(256) void k_mod(const float* __restrict__ c, const float* __restrict__ c_ctx,
                                             const float* __restrict__ ada_w, const float* __restrict__ ada_b, float* __restrict__ MOD) {
  __shared__ float sc[3][1024];
  const int l = blockIdx.y, n = blockIdx.x * 256 + threadIdx.x;
  for (int i = threadIdx.x; i < 3072; i += 256) {
    int v = i >> 10, k = i & 1023;
    float x = v < 2 ? c[v * 1024 + k] : c_ctx[k];
    sc[v][k] = x / (1.f + expf(-x));
  }
  __syncthreads();
  float a0 = 0, a1 = 0, a2 = 0;
  const float* W = ada_w + (size_t)l * 1024 * 6144 + n;
#pragma unroll 8
  for (int k = 0; k < 1024; ++k) {
    float w = W[(size_t)k * 6144];
    a0 += sc[0][k] * w; a1 += sc[1][k] * w; a2 += sc[2][k] * w;
  }
  float bias = ada_b[l * 6144 + n];
  MOD[(l * 3 + 0) * 6144 + n] = a0 + bias;
  MOD[(l * 3 + 1) * 6144 + n] = a1 + bias;
  MOD[(l * 3 + 2) * 6144 + n] = a2 + bias;
}

__global__ __launch_bounds__(256) void k_modulate(const float* __restrict__ Hl, const float* __restrict__ Hc, const float* __restrict__ mod,
                                                  int shift_i, int scale_i, float* __restrict__ U, int nrows) {
  size_t i = (size_t)blockIdx.x * 256 + threadIdx.x;
  if (i >= (size_t)nrows * 256) return;
  int row = (int)(i >> 8), d = (int)(i & 255) * 4;
  const float* src = row < NL ? Hl + (size_t)row * D : Hc + (size_t)(row - NL) * D;
  float4 h = *(const float4*)(src + d);
  const float* m = mod + row_vec(row) * 6144;
  float4 sh = *(const float4*)(m + shift_i * 1024 + d), scv = *(const float4*)(m + scale_i * 1024 + d);
  float4 o; o.x = h.x * (1.f + scv.x) + sh.x; o.y = h.y * (1.f + scv.y) + sh.y; o.z = h.z * (1.f + scv.z) + sh.z; o.w = h.w * (1.f + scv.w) + sh.w;
  *(float4*)(U + (size_t)row * D + d) = o;
}

__global__ __launch_bounds__(64) void k_s5_scan(const float* __restrict__ U, const float* __restrict__ a_re, const float* __restrict__ a_im,
                                                const float* __restrict__ log_dt, const float* __restrict__ b_re, const float* __restrict__ b_im,
                                                const float* __restrict__ c_re, const float* __restrict__ c_im,
                                                float* __restrict__ YF, float* __restrict__ YB) {
  __shared__ __attribute__((aligned(16))) float hs[2][64];
  const int id = blockIdx.x, dir = id & 1, g = (id >> 1) & 63, b = id >> 7, lane = threadIdx.x;
  const int gp = (dir * 64 + g) * 64 + lane;
  const float are = a_re[gp], aim = a_im[gp], dt = expf(log_dt[dir * 64 + g]);
  const float mag = expf(are * dt);
  const float abr = mag * cosf(aim * dt), abi = mag * sinf(aim * dt);
  const float nr = abr - 1.f, ni = abi, den = are * are + aim * aim;
  const float fr = (nr * are + ni * aim) / den, fi = (ni * are - nr * aim) / den;
  float bpr[16], bpi[16];
#pragma unroll
  for (int ci = 0; ci < 16; ++ci) {
    float br = b_re[gp * 16 + ci], bi = b_im[gp * 16 + ci];
    bpr[ci] = fr * br - fi * bi; bpi[ci] = fr * bi + fi * br;
  }
  const int co = lane & 15, q = lane >> 4;
  float crr[16], cii[16];
#pragma unroll
  for (int k = 0; k < 16; ++k) {
    int idx = ((dir * 64 + g) * 16 + co) * 64 + q * 16 + k;
    crr[k] = c_re[idx]; cii[k] = c_im[idx];
  }
  float hr = 0.f, hi = 0.f;
  float* Y = dir ? YB : YF;
  auto rowof = [&](int s) -> int {
    if (dir == 0) return s < CTX ? NL + b * CTX + s : b * SEQ + (s - CTX);
    return s < CTX ? NL + b * CTX + (CTX - 1 - s) : b * SEQ + (SEQ - 1 - (s - CTX));
  };
  int row = rowof(0);
  const float4* up = (const float4*)(U + (size_t)row * D + g * 16);
  float4 n0 = up[0], n1 = up[1], n2 = up[2], n3 = up[3];
  for (int s = 0; s < CTX + SEQ; ++s) {
    float u[16] = {n0.x, n0.y, n0.z, n0.w, n1.x, n1.y, n1.z, n1.w, n2.x, n2.y, n2.z, n2.w, n3.x, n3.y, n3.z, n3.w};
    const int currow = row;
    if (s + 1 < CTX + SEQ) {
      row = rowof(s + 1);
      up = (const float4*)(U + (size_t)row * D + g * 16);
      n0 = up[0]; n1 = up[1]; n2 = up[2]; n3 = up[3];
    }
    float bur = 0.f, bui = 0.f;
#pragma unroll
    for (int ci = 0; ci < 16; ++ci) { bur += bpr[ci] * u[ci]; bui += bpi[ci] * u[ci]; }
    float nhr = abr * hr - abi * hi + bur, nhi = abr * hi + abi * hr + bui;
    hr = nhr; hi = nhi;
    hs[0][lane] = hr; hs[1][lane] = hi;
    __syncthreads();
    float acc = 0.f;
#pragma unroll
    for (int k4 = 0; k4 < 4; ++k4) {
      float4 a = *(const float4*)&hs[0][q * 16 + k4 * 4], bq = *(const float4*)&hs[1][q * 16 + k4 * 4];
      acc += crr[k4 * 4 + 0] * a.x - cii[k4 * 4 + 0] * bq.x;
      acc += crr[k4 * 4 + 1] * a.y - cii[k4 * 4 + 1] * bq.y;
      acc += crr[k4 * 4 + 2] * a.z - cii[k4 * 4 + 2] * bq.z;
      acc += crr[k4 * 4 + 3] * a.w - cii[k4 * 4 + 3] * bq.w;
    }
    acc += __shfl_xor(acc, 16); acc += __shfl_xor(acc, 32);
    if (lane < 16) Y[(size_t)currow * D + g * 16 + lane] = acc;
    __syncthreads();
  }
}

__global__ __launch_bounds__(256) void k_s5_gelu(float* __restrict__ YF, const float* __restrict__ YB, const float* __restrict__ U,
                                                 const float* __restrict__ dvec) {
  size_t i = (size_t)blockIdx.x * 256 + threadIdx.x;
  if (i >= (size_t)NT * 256) return;
  int d = (int)(i & 255) * 4;
  float4 a = ((const float4*)YF)[i], b = ((const float4*)YB)[i], u = ((const float4*)U)[i], dd = *(const float4*)(dvec + d);
  float4 o; o.x = gelu_exact(a.x + b.x + dd.x * u.x); o.y = gelu_exact(a.y + b.y + dd.y * u.y);
  o.z = gelu_exact(a.z + b.z + dd.z * u.z); o.w = gelu_exact(a.w + b.w + dd.w * u.w);
  ((float4*)YF)[i] = o;
}

struct EpiStore { float* C; int ldc; __device__ void operator()(int m, int n, float v) const { C[(size_t)m * ldc + n] = v; } };
struct EpiGlu { const float* G; float* V; __device__ void operator()(int m, int n, float z) const {
  float g = G[(size_t)m * D + n]; V[(size_t)m * D + n] = g / (1.f + expf(-z)); } };

template <class Epi>
__global__ __launch_bounds__(256) void k_gemm(const float* __restrict__ A, int lda, const float* __restrict__ W, int N, int K, Epi epi) {
  __shared__ __attribute__((aligned(16))) float As[16][68];
  __shared__ __attribute__((aligned(16))) float Bs[16][64];
  const int tid = threadIdx.x, ty = tid >> 4, tx = tid & 15;
  const int m0 = blockIdx.y * 64, n0 = blockIdx.x * 64;
  float acc[4][4] = {};
  const int am = tid >> 2, ak = (tid & 3) * 4;
  const int bk = tid >> 4, bn = (tid & 15) * 4;
  for (int k0 = 0; k0 < K; k0 += 16) {
    float4 av = *(const float4*)(A + (size_t)(m0 + am) * lda + k0 + ak);
    float4 bv = *(const float4*)(W + (size_t)(k0 + bk) * N + n0 + bn);
    __syncthreads();
    As[ak + 0][am] = av.x; As[ak + 1][am] = av.y; As[ak + 2][am] = av.z; As[ak + 3][am] = av.w;
    *(float4*)&Bs[bk][bn] = bv;
    __syncthreads();
#pragma unroll
    for (int kk = 0; kk < 16; ++kk) {
      float4 a = *(const float4*)&As[kk][ty * 4], b = *(const float4*)&Bs[kk][tx * 4];
      float ar[4] = {a.x, a.y, a.z, a.w}, br[4] = {b.x, b.y, b.z, b.w};
#pragma unroll
      for (int i = 0; i < 4; ++i)
#pragma unroll
        for (int j = 0; j < 4; ++j) acc[i][j] += ar[i] * br[j];
    }
  }
#pragma unroll
  for (int i = 0; i < 4; ++i)
#pragma unroll
    for (int j = 0; j < 4; ++j) epi(m0 + ty * 4 + i, n0 + tx * 4 + j, acc[i][j]);
}

__global__ __launch_bounds__(256) void k_ln_resid(const float* Hl, const float* Hc, const float* F,
                                                  const float* __restrict__ mod, int gate_i, const float* __restrict__ lng, const float* __restrict__ lnb,
                                                  float* Hout, float* T, const float* __restrict__ modT, int shift_i, int scale_i, int nrows) {
  const int row = blockIdx.x * 4 + (threadIdx.x >> 6), lane = threadIdx.x & 63;
  if (row >= nrows) return;
  const float* hin = row < NL ? Hl + (size_t)row * D : Hc + (size_t)(row - NL) * D;
  const float* f = F + (size_t)row * D;
  const int v = row_vec(row);
  const float* gm = mod + v * 6144 + gate_i * 1024;
  float r[16]; float s = 0.f;
#pragma unroll
  for (int i = 0; i < 4; ++i) {
    int d = i * 256 + lane * 4;
    float4 h4 = *(const float4*)(hin + d), f4 = *(const float4*)(f + d), g4 = *(const float4*)(gm + d);
    r[i * 4 + 0] = ALPHA * h4.x + g4.x * f4.x; r[i * 4 + 1] = ALPHA * h4.y + g4.y * f4.y;
    r[i * 4 + 2] = ALPHA * h4.z + g4.z * f4.z; r[i * 4 + 3] = ALPHA * h4.w + g4.w * f4.w;
    s += r[i * 4 + 0] + r[i * 4 + 1] + r[i * 4 + 2] + r[i * 4 + 3];
  }
  const float mu = wave_sum(s) * (1.f / D);
  float vs = 0.f;
#pragma unroll
  for (int i = 0; i < 16; ++i) { float dlt = r[i] - mu; vs += dlt * dlt; }
  const float rstd = rsqrtf(wave_sum(vs) * (1.f / D) + LN_EPS);
#pragma unroll
  for (int i = 0; i < 4; ++i) {
    int d = i * 256 + lane * 4;
    float4 g4 = *(const float4*)(lng + d), b4 = *(const float4*)(lnb + d);
    float4 o;
    o.x = (r[i * 4 + 0] - mu) * rstd * g4.x + b4.x; o.y = (r[i * 4 + 1] - mu) * rstd * g4.y + b4.y;
    o.z = (r[i * 4 + 2] - mu) * rstd * g4.z + b4.z; o.w = (r[i * 4 + 3] - mu) * rstd * g4.w + b4.w;
    *(float4*)(Hout + (size_t)row * D + d) = o;
    if (T) {
      const float* mt = modT + v * 6144;
      float4 sh = *(const float4*)(mt + shift_i * 1024 + d), sc = *(const float4*)(mt + scale_i * 1024 + d);
      float4 t; t.x = o.x * (1.f + sc.x) + sh.x; t.y = o.y * (1.f + sc.y) + sh.y; t.z = o.z * (1.f + sc.z) + sh.z; t.w = o.w * (1.f + sc.w) + sh.w;
      *(float4*)(T + (size_t)row * D + d) = t;
    }
  }
}

__global__ __launch_bounds__(256) void k_route(const float* __restrict__ Q, const float* __restrict__ keys, int* __restrict__ IDX, float* __restrict__ GATE) {
  __shared__ __attribute__((aligned(16))) float qs[4][1024];
  __shared__ float svs[4][2][16];
  __shared__ int sis[4][2][16];
  const int w = threadIdx.x >> 6, lane = threadIdx.x & 63, row = blockIdx.x * 4 + w;
  for (int i = lane; i < 256; i += 64) *(float4*)&qs[w][i * 4] = *(const float4*)(Q + (size_t)row * D + i * 4);
  __syncthreads();
  for (int h = 0; h < 8; ++h) {
    for (int s = 0; s < 2; ++s) {
      const float* kp = keys + (size_t)((h * 2 + s) * 128) * 64;
      const float* qp = &qs[w][(h * 2 + s) * 64];
      float v0 = 0.f, v1 = 0.f;
#pragma unroll
      for (int d = 0; d < 64; d += 4) {
        float4 k0 = *(const float4*)(kp + lane * 64 + d), k1 = *(const float4*)(kp + (lane + 64) * 64 + d), q4 = *(const float4*)(qp + d);
        v0 += q4.x * k0.x; v0 += q4.y * k0.y; v0 += q4.z * k0.z; v0 += q4.w * k0.w;
        v1 += q4.x * k1.x; v1 += q4.y * k1.y; v1 += q4.z * k1.z; v1 += q4.w * k1.w;
      }
      for (int r = 0; r < 16; ++r) {
        float bv; int bi;
        if (v0 >= v1) { bv = v0; bi = lane; } else { bv = v1; bi = lane + 64; }
#pragma unroll
        for (int off = 32; off >= 1; off >>= 1) {
          float ov = __shfl_xor(bv, off); int oi = __shfl_xor(bi, off);
          if (ov > bv || (ov == bv && oi < bi)) { bv = ov; bi = oi; }
        }
        if (lane == 0) { svs[w][s][r] = bv; sis[w][s][r] = bi; }
        if (bi == lane) v0 = -INFINITY;
        if (bi == lane + 64) v1 = -INFINITY;
      }
    }
    __syncthreads();
    float c0, c1, c2, c3;
    {
      float a = svs[w][0][lane >> 2];
      const int j0 = (lane & 3) * 4;
      c0 = a + svs[w][1][j0 + 0]; c1 = a + svs[w][1][j0 + 1]; c2 = a + svs[w][1][j0 + 2]; c3 = a + svs[w][1][j0 + 3];
    }
    float selv = 0.f; int seli = 0;
    for (int r = 0; r < 16; ++r) {
      float bv = c0; int bi = lane * 4;
      if (c1 > bv) { bv = c1; bi = lane * 4 + 1; }
      if (c2 > bv) { bv = c2; bi = lane * 4 + 2; }
      if (c3 > bv) { bv = c3; bi = lane * 4 + 3; }
#pragma unroll
      for (int off = 32; off >= 1; off >>= 1) {
        float ov = __shfl_xor(bv, off); int oi = __shfl_xor(bi, off);
        if (ov > bv || (ov == bv && oi < bi)) { bv = ov; bi = oi; }
      }
      if (lane == r) { selv = bv; seli = bi; }
      if ((bi >> 2) == lane) {
        int k = bi & 3;
        if (k == 0) c0 = -INFINITY; else if (k == 1) c1 = -INFINITY; else if (k == 2) c2 = -INFINITY; else c3 = -INFINITY;
      }
    }
    const float mx = __shfl(selv, 0);
    const float e = lane < 16 ? expf(selv - mx) : 0.f;
    const float sum = wave_sum(e);
    if (lane < 16) {
      int i1 = sis[w][0][seli >> 4], i2 = sis[w][1][seli & 15];
      IDX[(size_t)row * 128 + h * 16 + lane] = i1 * 128 + i2;
      GATE[(size_t)row * 128 + h * 16 + lane] = e / sum;
    }
    __syncthreads();
  }
}

__global__ __launch_bounds__(256) void k_peer(const float* __restrict__ T, const int* __restrict__ IDX, const float* __restrict__ GATE,
                                              const float* __restrict__ utab, const float* __restrict__ vtab, float* __restrict__ F) {
  const int row = blockIdx.x * 4 + (threadIdx.x >> 6), lane = threadIdx.x & 63;
  float4 t[4], f[4];
#pragma unroll
  for (int i = 0; i < 4; ++i) { t[i] = *(const float4*)(T + (size_t)row * D + i * 256 + lane * 4); f[i] = make_float4(0.f, 0.f, 0.f, 0.f); }
  for (int k = 0; k < 128; ++k) {
    const int e = IDX[(size_t)row * 128 + k];
    const float g = GATE[(size_t)row * 128 + k];
    const float* up = utab + (size_t)e * D + lane * 4;
    const float* vp = vtab + (size_t)e * D + lane * 4;
    float dot = 0.f;
#pragma unroll
    for (int i = 0; i < 4; ++i) { float4 u4 = *(const float4*)(up + i * 256); dot += t[i].x * u4.x + t[i].y * u4.y + t[i].z * u4.z + t[i].w * u4.w; }
    dot = wave_sum(dot);
    const float a = gelu_exact(dot) * g;
#pragma unroll
    for (int i = 0; i < 4; ++i) { float4 v4 = *(const float4*)(vp + i * 256); f[i].x += a * v4.x; f[i].y += a * v4.y; f[i].z += a * v4.z; f[i].w += a * v4.w; }
  }
#pragma unroll
  for (int i = 0; i < 4; ++i) *(float4*)(F + (size_t)row * D + i * 256 + lane * 4) = f[i];
}

__global__ __launch_bounds__(256) void k_rmsnorm(float* __restrict__ X, int ld, int ncols, const float* __restrict__ g, int nrows) {
  const int row = blockIdx.x * 4 + (threadIdx.x >> 6), lane = threadIdx.x & 63;
  if (row >= nrows) return;
  float* x = X + (size_t)row * ld;
  float s = 0.f;
  for (int i = lane; i < ncols; i += 64) { float v = x[i]; s += v * v; }
  const float r = rsqrtf(wave_sum(s) / (float)ncols + RMS_EPS);
  for (int i = lane; i < ncols; i += 64) x[i] = x[i] * r * g[i];
}
__global__ __launch_bounds__(256) void k_rope(float* __restrict__ X, int ld, int off, int hstride, int nheads, int nrows) {
  const int idx = blockIdx.x * 256 + threadIdx.x;
  const int i = idx & 31; const int rh = idx >> 5; const int head = rh % nheads; const int row = rh / nheads;
  if (row >= nrows) return;
  const int n = row & (SEQ - 1), r = n >> 6, col = n & 63;
  const float inv = powf(10000.f, -(float)(i & 15) / 16.f);
  const float ang = (i < 16 ? (float)r : (float)col) * inv;
  const float cs = cosf(ang), sn = sinf(ang);
  float* p = X + (size_t)row * ld + off + head * hstride;
  const float x1 = p[i], x2 = p[i + 32];
  p[i] = x1 * cs - x2 * sn; p[i + 32] = x2 * cs + x1 * sn;
}

__global__ __launch_bounds__(256) void k_attn(const float* __restrict__ QF, const float* __restrict__ KVU, const float* __restrict__ KV, float* __restrict__ AO) {
  __shared__ __attribute__((aligned(16))) float Qs[64][196];
  __shared__ __attribute__((aligned(16))) float Ks[32][196];
  __shared__ __attribute__((aligned(16))) float Vs[32][128];
  __shared__ float Ps[64][33];
  const int qt = blockIdx.x, h = blockIdx.y, b = blockIdx.z;
  const int tid = threadIdx.x, ty = tid >> 4, tx = tid & 15;
  for (int i = tid; i < 64 * 48; i += 256) {
    int r = i / 48, c4 = i % 48;
    *(float4*)&Qs[r][c4 * 4] = *(const float4*)(QF + (size_t)(b * SEQ + qt * 64 + r) * 1536 + h * 192 + c4 * 4);
  }
  float m[4], l[4], o[4][8];
#pragma unroll
  for (int i = 0; i < 4; ++i) { m[i] = -1e30f; l[i] = 0.f;
#pragma unroll
    for (int c = 0; c < 8; ++c) o[i][c] = 0.f; }
  const float scale = 0.07216878364870322f;
  for (int kt = 0; kt < (SEQ + CTX) / 32; ++kt) {
    __syncthreads();
    for (int i = tid; i < 32 * 48; i += 256) {
      int r = i / 48, c4 = i % 48, j = kt * 32 + r;
      int krow = j < SEQ ? b * SEQ + j : NL + b * CTX + (j - SEQ);
      float4 v = c4 < 32 ? *(const float4*)(KVU + (size_t)krow * 2048 + h * 256 + c4 * 4)
                         : *(const float4*)(KV + (size_t)krow * 320 + 256 + (c4 - 32) * 4);
      *(float4*)&Ks[r][c4 * 4] = v;
    }
    for (int i = tid; i < 32 * 32; i += 256) {
      int r = i >> 5, c4 = i & 31, j = kt * 32 + r;
      int krow = j < SEQ ? b * SEQ + j : NL + b * CTX + (j - SEQ);
      *(float4*)&Vs[r][c4 * 4] = *(const float4*)(KVU + (size_t)krow * 2048 + h * 256 + 128 + c4 * 4);
    }
    __syncthreads();
    float s[4][2] = {};
    for (int d4 = 0; d4 < 48; ++d4) {
      float4 k0 = *(const float4*)&Ks[tx * 2][d4 * 4], k1 = *(const float4*)&Ks[tx * 2 + 1][d4 * 4];
#pragma unroll
      for (int i = 0; i < 4; ++i) {
        float4 q = *(const float4*)&Qs[ty * 4 + i][d4 * 4];
        s[i][0] += q.x * k0.x + q.y * k0.y + q.z * k0.z + q.w * k0.w;
        s[i][1] += q.x * k1.x + q.y * k1.y + q.z * k1.z + q.w * k1.w;
      }
    }
#pragma unroll
    for (int i = 0; i < 4; ++i) {
      float s0 = s[i][0] * scale, s1 = s[i][1] * scale;
      float mx = fmaxf(s0, s1);
#pragma unroll
      for (int off = 8; off >= 1; off >>= 1) mx = fmaxf(mx, __shfl_xor(mx, off));
      const float mnew = fmaxf(m[i], mx);
      const float alpha = expf(m[i] - mnew);
      const float p0 = expf(s0 - mnew), p1 = expf(s1 - mnew);
      float rs = p0 + p1;
#pragma unroll
      for (int off = 8; off >= 1; off >>= 1) rs += __shfl_xor(rs, off);
      l[i] = l[i] * alpha + rs; m[i] = mnew;
#pragma unroll
      for (int c = 0; c < 8; ++c) o[i][c] *= alpha;
      Ps[ty * 4 + i][tx * 2] = p0; Ps[ty * 4 + i][tx * 2 + 1] = p1;
    }
    __syncthreads();
    for (int k = 0; k < 32; ++k) {
      float4 va = *(const float4*)&Vs[k][tx * 8], vb = *(const float4*)&Vs[k][tx * 8 + 4];
#pragma unroll
      for (int i = 0; i < 4; ++i) {
        float p = Ps[ty * 4 + i][k];
        o[i][0] += p * va.x; o[i][1] += p * va.y; o[i][2] += p * va.z; o[i][3] += p * va.w;
        o[i][4] += p * vb.x; o[i][5] += p * vb.y; o[i][6] += p * vb.z; o[i][7] += p * vb.w;
      }
    }
  }
#pragma unroll
  for (int i = 0; i < 4; ++i) {
    const float il = 1.f / l[i];
    float* dst = AO + (size_t)(b * SEQ + qt * 64 + ty * 4 + i) * D + h * 128 + tx * 8;
    *(float4*)dst = make_float4(o[i][0] * il, o[i][1] * il, o[i][2] * il, o[i][3] * il);
    *(float4*)(dst + 4) = make_float4(o[i][4] * il, o[i][5] * il, o[i][6] * il, o[i][7] * il);
  }
}

extern "C" void kernel_launch(void* const* d_in, const int* in_sizes, int n_in, void* d_out, int out_size, void* d_ws, size_t ws_size, hipStream_t stream) {
  const float* x = (const float*)d_in[0];       const float* c = (const float*)d_in[1];
  const float* ctx = (const float*)d_in[2];     const float* c_ctx = (const float*)d_in[3];
  const float* ada_w = (const float*)d_in[4];   const float* ada_b = (const float*)d_in[5];
  const float* ln_g = (const float*)d_in[6];    const float* ln_b = (const float*)d_in[7];
  const float* s5_a_re = (const float*)d_in[8]; const float* s5_a_im = (const float*)d_in[9];
  const float* s5_log_dt = (const float*)d_in[10];
  const float* s5_b_re = (const float*)d_in[11]; const float* s5_b_im = (const float*)d_in[12];
  const float* s5_c_re = (const float*)d_in[13]; const float* s5_c_im = (const float*)d_in[14];
  const float* s5_d = (const float*)d_in[15];   const float* s5_w_glu = (const float*)d_in[16];
  const float* s5_w_o = (const float*)d_in[17]; const float* mla_w_dq = (const float*)d_in[18];
  const float* mla_q_norm = (const float*)d_in[19]; const float* mla_w_uq = (const float*)d_in[20];
  const float* mla_w_dkv = (const float*)d_in[21];  const float* mla_kv_norm = (const float*)d_in[22];
  const float* mla_w_ukv = (const float*)d_in[23];  const float* mla_w_o = (const float*)d_in[24];
  const float* peer_w_q = (const float*)d_in[25];   const float* peer_keys = (const float*)d_in[26];
  const float* peer_u = (const float*)d_in[27];     const float* peer_v = (const float*)d_in[28];
  float* out = (float*)d_out;

  float* ws = (float*)d_ws;
  size_t off = 0;
  auto carve = [&](size_t n) { float* p = ws + off; off += (n + 63) / 64 * 64; return p; };
  float* MOD = carve(2 * 3 * 6144);
  float* BA = carve((size_t)NT * D);
  float* BB = carve((size_t)NT * D);
  float* BC = carve((size_t)NT * D);
  float* QF = carve((size_t)NL * 1536);
  float* KVU = carve((size_t)NT * 2048);
  float* DQ = carve((size_t)NL * 384);
  float* KV = carve((size_t)NT * 320);
  int* IDX = (int*)carve((size_t)NT * 128);
  float* GATE = carve((size_t)NT * 128);
  if (off * 4 > ws_size) { fprintf(stderr, "kernel_launch: workspace too small: need %zu have %zu\n", off * 4, ws_size); return; }

  const float* mod0 = MOD; const float* mod1 = MOD + 3 * 6144;
  const size_t TD = (size_t)1024 * 16384;

  k_mod<<<dim3(24, 2), 256, 0, stream>>>(c, c_ctx, ada_w, ada_b, MOD);
  k_modulate<<<NT, 256, 0, stream>>>(x, ctx, mod0, 0, 1, BA, NT);
  k_s5_scan<<<256, 64, 0, stream>>>(BA, s5_a_re, s5_a_im, s5_log_dt, s5_b_re, s5_b_im, s5_c_re, s5_c_im, BB, BC);
  k_s5_gelu<<<NT, 256, 0, stream>>>(BB, BC, BA, s5_d);
  k_gemm<EpiGlu><<<dim3(16, NT / 64), 256, 0, stream>>>(BB, D, s5_w_glu, D, D, EpiGlu{BB, BC});
  k_gemm<EpiStore><<<dim3(16, NT / 64), 256, 0, stream>>>(BC, D, s5_w_o, D, D, EpiStore{BA, D});
  k_ln_resid<<<NT / 4, 256, 0, stream>>>(x, ctx, BA, mod0, 2, ln_g, ln_b, BB, BC, mod0, 3, 4, NT);
  k_gemm<EpiStore><<<dim3(16, NT / 64), 256, 0, stream>>>(BC, D, peer_w_q, D, D, EpiStore{BA, D});
  k_route<<<NT / 4, 256, 0, stream>>>(BA, peer_keys, IDX, GATE);
  k_peer<<<NT / 4, 256, 0, stream>>>(BC, IDX, GATE, peer_u, peer_v, BA);
  k_ln_resid<<<NT / 4, 256, 0, stream>>>(BB, BB + (size_t)NL * D, BA, mod0, 5, ln_g + D, ln_b + D, BC, BB, mod1, 0, 1, NT);
  k_gemm<EpiStore><<<dim3(6, NL / 64), 256, 0, stream>>>(BB, D, mla_w_dq, 384, D, EpiStore{DQ, 384});
  k_rmsnorm<<<NL / 4, 256, 0, stream>>>(DQ, 384, 384, mla_q_norm, NL);
  k_gemm<EpiStore><<<dim3(24, NL / 64), 256, 0, stream>>>(DQ, 384, mla_w_uq, 1536, 384, EpiStore{QF, 1536});
  k_rope<<<NL * 8 * 32 / 256, 256, 0, stream>>>(QF, 1536, 128, 192, 8, NL);
  k_gemm<EpiStore><<<dim3(5, NT / 64), 256, 0, stream>>>(BB, D, mla_w_dkv, 320, D, EpiStore{KV, 320});
  k_rmsnorm<<<NT / 4, 256, 0, stream>>>(KV, 320, 256, mla_kv_norm, NT);
  k_rope<<<NL * 32 / 256, 256, 0, stream>>>(KV, 320, 256, 0, 1, NL);
  k_gemm<EpiStore><<<dim3(32, NT / 64), 256, 0, stream>>>(KV, 320, mla_w_ukv, 2048, 256, EpiStore{KVU, 2048});
  k_attn<<<dim3(SEQ / 64, 8, NB), 256, 0, stream>>>(QF, KVU, KV, BA);
  k_gemm<EpiStore><<<dim3(16, NL / 64), 256, 0, stream>>>(BA, D, mla_w_o, D, D, EpiStore{BB, D});
  k_ln_resid<<<NL / 4, 256, 0, stream>>>(BC, BC + (size_t)NL * D, BB, mod1, 2, ln_g + 2 * D, ln_b + 2 * D, BA, BB, mod1, 3, 4, NL);
  k_gemm<EpiStore><<<dim3(16, NL / 64), 256, 0, stream>>>(BB, D, peer_w_q + (size_t)D * D, D, D, EpiStore{BC, D});
  k_route<<<NL / 4, 256, 0, stream>>>(BC, peer_keys + 8 * 2 * 128 * 64, IDX, GATE);
  k_peer<<<NL / 4, 256, 0, stream>>>(BB, IDX, GATE, peer_u + TD, peer_v + TD, BC);
  k_ln_resid<<<NL / 4, 256, 0, stream>>>(BA, BA + (size_t)NL * D, BC, mod1, 5, ln_g + 3 * D, ln_b + 3 * D, out, nullptr, mod1, 0, 0, NL);
}
```

```cpp
#include <hip/hip_runtime.h>
#include <math.h>
#include <cstdio>

constexpr int D = 1024, NB = 2, SEQ = 8192, CTX = 256;
constexpr int NL = NB * SEQ, NC = NB * CTX, NT = NL + NC;
constexpr float ALPHA = 1.4142135623730951f;
constexpr float LN_EPS = 1e-5f, RMS_EPS = 1e-6f;

__device__ __forceinline__ float wave_sum(float v) {
#pragma unroll
  for (int o = 32; o >= 1; o >>= 1) v += __shfl_xor(v, o);
  return v;
}
__device__ __forceinline__ int row_vec(int row) { return row < NL ? (row >> 13) : 2; }
__device__ __forceinline__ float gelu_exact(float x) { return 0.5f * x * (1.f + erff(x * 0.70710678118654752f)); }


typedef unsigned short bf16_t;
using bf16x8 = __attribute__((ext_vector_type(8))) short;
using f32x4 = __attribute__((ext_vector_type(4))) float;
__device__ __forceinline__ bf16_t f2bf(float f) { unsigned u = __float_as_uint(f); u += 0x7FFFu + ((u >> 16) & 1u); return (bf16_t)(u >> 16); }
__device__ __forceinline__ float bf2f(bf16_t h) { return __uint_as_float(((unsigned)h) << 16); }
__device__ __forceinline__ unsigned pack2bf(float lo, float hi) { return (unsigned)f2bf(lo) | ((unsigned)f2bf(hi) << 16); }
__device__ __forceinline__ float bflo(unsigned w) { return __uint_as_float(w << 16); }
__device__ __forceinline__ float bfhi(unsigned w) { return __uint_as_float(w & 0xFFFF0000u); }

__global__ __launch_bounds__(256) void k_cvt(const float* __restrict__ a, bf16_t* __restrict__ o, size_t n8) {
  for (size_t i = (size_t)blockIdx.x * 256 + threadIdx.x; i < n8; i += (size_t)gridDim.x * 256) {
    float4 x = ((const float4*)a)[i * 2], y = ((const float4*)a)[i * 2 + 1];
    uint4 w; w.x = pack2bf(x.x, x.y); w.y = pack2bf(x.z, x.w); w.z = pack2bf(y.x, y.y); w.w = pack2bf(y.z, y.w);
    ((uint4*)o)[i] = w;
  }
}
__global__ __launch_bounds__(256) void k_cvt_t(const float* __restrict__ W, bf16_t* __restrict__ Wt, int K, int N) {
  const size_t total = (size_t)N * (K / 8);
  for (size_t i = (size_t)blockIdx.x * 256 + threadIdx.x; i < total; i += (size_t)gridDim.x * 256) {
    const int n = (int)(i % N), k8 = (int)(i / N);
    float v[8];
#pragma unroll
    for (int j = 0; j < 8; ++j) v[j] = W[(size_t)(k8 * 8 + j) * N + n];
    uint4 w; w.x = pack2bf(v[0], v[1]); w.y = pack2bf(v[2], v[3]); w.z = pack2bf(v[4], v[5]); w.w = pack2bf(v[6], v[7]);
    *(uint4*)(Wt + (size_t)n * K + k8 * 8) = w;
  }
}


__global__ __launch_bounds__(256) void k_cvt_lo(const float* __restrict__ a, bf16_t* __restrict__ o, size_t n8) {
  for (size_t i = (size_t)blockIdx.x * 256 + threadIdx.x; i < n8; i += (size_t)gridDim.x * 256) {
    float v[8];
    *(float4*)&v[0] = ((const float4*)a)[i * 2]; *(float4*)&v[4] = ((const float4*)a)[i * 2 + 1];
#pragma unroll
    for (int j = 0; j < 8; ++j) v[j] = v[j] - bf2f(f2bf(v[j]));
    uint4 w; w.x = pack2bf(v[0], v[1]); w.y = pack2bf(v[2], v[3]); w.z = pack2bf(v[4], v[5]); w.w = pack2bf(v[6], v[7]);
    ((uint4*)o)[i] = w;
  }
}
__global__ __launch_bounds__(256) void k_cvt_t_lo(const float* __restrict__ W, bf16_t* __restrict__ Wt, int K, int N) {
  const size_t total = (size_t)N * (K / 8);
  for (size_t i = (size_t)blockIdx.x * 256 + threadIdx.x; i < total; i += (size_t)gridDim.x * 256) {
    const int n = (int)(i % N), k8 = (int)(i / N);
    float v[8];
#pragma unroll
    for (int j = 0; j < 8; ++j) { const float w = W[(size_t)(k8 * 8 + j) * N + n]; v[j] = w - bf2f(f2bf(w)); }
    uint4 w; w.x = pack2bf(v[0], v[1]); w.y = pack2bf(v[2], v[3]); w.z = pack2bf(v[4], v[5]); w.w = pack2bf(v[6], v[7]);
    *(uint4*)(Wt + (size_t)n * K + k8 * 8) = w;
  }
}
constexpr int LDA_B = 1024 * 2 + 16;
template <int RT>
__device__ __forceinline__ void gemm_unit(const char* const (&ap)[RT], const bf16_t* __restrict__ w0, const bf16_t* __restrict__ w1, int kmul, int K, f32x4 (&acc)[RT][2]) {
#pragma unroll
  for (int t = 0; t < RT; ++t) { acc[t][0] = f32x4{0.f, 0.f, 0.f, 0.f}; acc[t][1] = f32x4{0.f, 0.f, 0.f, 0.f}; }
  bf16x8 bc[4][2], bn[4][2];
#pragma unroll
  for (int s2 = 0; s2 < 4; ++s2) { bc[s2][0] = *(const bf16x8*)(w0 + (s2 * 32) * kmul); bc[s2][1] = *(const bf16x8*)(w1 + (s2 * 32) * kmul); bn[s2][0] = bc[s2][0]; bn[s2][1] = bc[s2][1]; }
#pragma unroll 1
  for (int kb = 0; kb < K; kb += 128) {
    if (kb + 128 < K) {
#pragma unroll
      for (int s2 = 0; s2 < 4; ++s2) { bn[s2][0] = *(const bf16x8*)(w0 + (kb + 128 + s2 * 32) * kmul); bn[s2][1] = *(const bf16x8*)(w1 + (kb + 128 + s2 * 32) * kmul); }
    }
#pragma unroll
    for (int s2 = 0; s2 < 4; ++s2) {
#pragma unroll
      for (int t = 0; t < RT; ++t) {
        const bf16x8 a = *(const bf16x8*)(ap[t] + (kb + s2 * 32) * 2);
        acc[t][0] = __builtin_amdgcn_mfma_f32_16x16x32_bf16(a, bc[s2][0], acc[t][0], 0, 0, 0);
        acc[t][1] = __builtin_amdgcn_mfma_f32_16x16x32_bf16(a, bc[s2][1], acc[t][1], 0, 0, 0);
      }
    }
#pragma unroll
    for (int s2 = 0; s2 < 4; ++s2) { bc[s2][0] = bn[s2][0]; bc[s2][1] = bn[s2][1]; }
  }
}
template <int RT, class Epi>
__device__ __forceinline__ void gemm_ldsA(const char* As, int lda_b, int nrows, const bf16_t* __restrict__ Wt, int K, int N, Epi epi) {
  const int wave = threadIdx.x >> 6, lane = threadIdx.x & 63, l15 = lane & 15, q = lane >> 4;
  const char* ap[RT];
#pragma unroll
  for (int t = 0; t < RT; ++t) { int r = t * 16 + l15; r = r < nrows ? r : nrows - 1; ap[t] = As + r * lda_b + q * 16; }
#pragma unroll 1
  for (int unit = wave; unit < (N >> 5); unit += 8) {
    const int n0 = unit * 32;
    const bf16_t* w0 = Wt + (size_t)(n0 + l15) * K + q * 8;
    f32x4 acc[RT][2];
    gemm_unit<RT>(ap, w0, w0 + (size_t)16 * K, 1, K, acc);
#pragma unroll
    for (int t = 0; t < RT; ++t)
#pragma unroll
      for (int j = 0; j < 2; ++j)
#pragma unroll
        for (int r = 0; r < 4; ++r) {
          const int row = t * 16 + q * 4 + r, col = n0 + j * 16 + l15;
          if (row < nrows) epi(row, col, acc[t][j][r]);
        }
  }
}
struct EpiF32 { float* C; int ldc; __device__ __forceinline__ void operator()(int row, int col, float v) const { C[(size_t)row * ldc + col] = v; } };
struct EpiAddF32 { float* C; int ldc; __device__ __forceinline__ void operator()(int row, int col, float v) const { C[(size_t)row * ldc + col] += v; } };
struct EpiGluL { const char* As; bf16_t* V; __device__ __forceinline__ void operator()(int row, int col, float z) const {
  const float g = bf2f(*(const bf16_t*)(As + row * LDA_B + col * 2)); V[(size_t)row * D + col] = f2bf(g / (1.f + expf(-z))); } };

__device__ __forceinline__ void load_rows_lds(char* As, const bf16_t* __restrict__ src, int nrows) {
  for (int i = threadIdx.x; i < nrows * 128; i += 512) {
    const int r = i >> 7, c = i & 127;
    *(uint4*)(As + r * LDA_B + c * 16) = *(const uint4*)(src + (size_t)r * D + c * 8);
  }
}
__device__ __forceinline__ void ln_rows(char* As, int g0, int nrows, const float* Hl, const float* Hc, const float* __restrict__ O,
                                        const float* __restrict__ mod, int gate_i, const float* __restrict__ lng, const float* __restrict__ lnb,
                                        float* Hout, bf16_t* __restrict__ Tbf, int shift_i, int scale_i, bf16_t* __restrict__ Tlo) {
  const int wave = threadIdx.x >> 6, lane = threadIdx.x & 63;
  for (int rr = wave; rr < nrows; rr += 8) {
    const int row = g0 + rr;
    const float* hin = row < NL ? Hl + (size_t)row * D : Hc + (size_t)(row - NL) * D;
    const float* f = O + (size_t)row * D;
    const float* m = mod + row_vec(row) * 6144;
    const float* gm = m + gate_i * 1024;
    float r[16]; float s = 0.f;
#pragma unroll
    for (int i = 0; i < 4; ++i) {
      const int d = i * 256 + lane * 4;
      float4 h4 = *(const float4*)(hin + d), f4 = *(const float4*)(f + d), g4 = *(const float4*)(gm + d);
      r[i * 4 + 0] = ALPHA * h4.x + g4.x * f4.x; r[i * 4 + 1] = ALPHA * h4.y + g4.y * f4.y;
      r[i * 4 + 2] = ALPHA * h4.z + g4.z * f4.z; r[i * 4 + 3] = ALPHA * h4.w + g4.w * f4.w;
      s += r[i * 4 + 0] + r[i * 4 + 1] + r[i * 4 + 2] + r[i * 4 + 3];
    }
    const float mu = wave_sum(s) * (1.f / D);
    float vs = 0.f;
#pragma unroll
    for (int i = 0; i < 16; ++i) { float dlt = r[i] - mu; vs += dlt * dlt; }
    const float rstd = rsqrtf(wave_sum(vs) * (1.f / D) + LN_EPS);
#pragma unroll
    for (int i = 0; i < 4; ++i) {
      const int d = i * 256 + lane * 4;
      float4 g4 = *(const float4*)(lng + d), b4 = *(const float4*)(lnb + d);
      float4 o;
      o.x = (r[i * 4 + 0] - mu) * rstd * g4.x + b4.x; o.y = (r[i * 4 + 1] - mu) * rstd * g4.y + b4.y;
      o.z = (r[i * 4 + 2] - mu) * rstd * g4.z + b4.z; o.w = (r[i * 4 + 3] - mu) * rstd * g4.w + b4.w;
      *(float4*)(Hout + (size_t)row * D + d) = o;
      float4 sh = *(const float4*)(m + shift_i * 1024 + d), sc = *(const float4*)(m + scale_i * 1024 + d);
      const float t0 = o.x * (1.f + sc.x) + sh.x, t1 = o.y * (1.f + sc.y) + sh.y, t2 = o.z * (1.f + sc.z) + sh.z, t3 = o.w * (1.f + sc.w) + sh.w;
      uint2 w; w.x = pack2bf(t0, t1); w.y = pack2bf(t2, t3);
      *(uint2*)(As + rr * LDA_B + d * 2) = w;
      *(uint2*)(Tbf + (size_t)row * D + d) = w;
      uint2 wl; wl.x = pack2bf(t0 - bflo(w.x), t1 - bfhi(w.x)); wl.y = pack2bf(t2 - bflo(w.y), t3 - bfhi(w.y));
      *(uint2*)(Tlo + (size_t)row * D + d) = wl;
    }
  }
}


constexpr int S5T = 64, NCHUNK = (CTX + SEQ) / S5T  , NCC = NB * NCHUNK  ;
__device__ __forceinline__ int s5_token(int cc, int s) {
  const int b = cc / NCHUNK, ch = cc - b * NCHUNK;
  return ch < 4 ? NL + b * CTX + ch * S5T + s : b * SEQ + (ch - 4) * S5T + s;
}
__global__ __launch_bounds__(512) void k_s5_prep(const float* __restrict__ a_re, const float* __restrict__ a_im, const float* __restrict__ log_dt,
                                                 const float* __restrict__ b_re, const float* __restrict__ b_im, const float* __restrict__ c_re, const float* __restrict__ c_im,
                                                 bf16_t* __restrict__ Ktab, bf16_t* __restrict__ Bst_t, bf16_t* __restrict__ Cin_t) {
  __shared__ float2 pw[2][65][64];
  __shared__ float2 Bp[2][64][16];
  __shared__ float2 Cc[2][16][64];
  const int g = blockIdx.x, tid = threadIdx.x;
  if (tid < 128) {
    const int dir = tid >> 6, p = tid & 63, gp = (dir * 64 + g) * 64 + p;
    const float are = a_re[gp], aim = a_im[gp], dt = expf(log_dt[dir * 64 + g]);
    const float mag = expf(are * dt);
    const float abr = mag * cosf(aim * dt), abi = mag * sinf(aim * dt);
    const float nr = abr - 1.f, ni = abi, den = are * are + aim * aim;
    const float fr = (nr * are + ni * aim) / den, fi = (ni * are - nr * aim) / den;
    float pr = 1.f, pi = 0.f;
    for (int e = 0; e <= 64; ++e) { pw[dir][e][p] = make_float2(pr, pi); const float nr2 = pr * abr - pi * abi, ni2 = pr * abi + pi * abr; pr = nr2; pi = ni2; }
    for (int ci = 0; ci < 16; ++ci) { const float br = b_re[gp * 16 + ci], bi = b_im[gp * 16 + ci]; Bp[dir][p][ci] = make_float2(fr * br - fi * bi, fr * bi + fi * br); }
    for (int co = 0; co < 16; ++co) { const int idx = ((dir * 64 + g) * 16 + co) * 64 + p; Cc[dir][co][p] = make_float2(c_re[idx], c_im[idx]); }
  }
  __syncthreads();
  for (int i = tid; i < 127 * 256; i += 512) {
    const int ti = i >> 8, co = (i >> 4) & 15, ci = i & 15, tau = ti - 63;
    float acc = 0.f;
    if (tau >= 0) { for (int p = 0; p < 64; ++p) { const float2 c = Cc[0][co][p], w = pw[0][tau][p], b = Bp[0][p][ci];
        const float xr = c.x * w.x - c.y * w.y, xi = c.x * w.y + c.y * w.x; acc += xr * b.x - xi * b.y; } }
    if (tau <= 0) { for (int p = 0; p < 64; ++p) { const float2 c = Cc[1][co][p], w = pw[1][-tau][p], b = Bp[1][p][ci];
        const float xr = c.x * w.x - c.y * w.y, xi = c.x * w.y + c.y * w.x; acc += xr * b.x - xi * b.y; } }
    Ktab[(size_t)g * 127 * 256 + i] = f2bf(acc);
  }
  for (int i = tid; i < 256 * 128; i += 512) {
    const int n = i >> 7, k8 = i & 127, dir = n >> 7, c = (n >> 6) & 1, p = n & 63, sidx = k8 >> 1, ci0 = (k8 & 1) * 8;
    const float2 w = pw[dir][dir == 0 ? 63 - sidx : sidx][p];
    float v[8];
#pragma unroll
    for (int j = 0; j < 8; ++j) { const float2 b = Bp[dir][p][ci0 + j]; v[j] = c == 0 ? (w.x * b.x - w.y * b.y) : (w.x * b.y + w.y * b.x); }
    uint4 o; o.x = pack2bf(v[0], v[1]); o.y = pack2bf(v[2], v[3]); o.z = pack2bf(v[4], v[5]); o.w = pack2bf(v[6], v[7]);
    *(uint4*)(Bst_t + ((size_t)g * 256 + n) * 1024 + k8 * 8) = o;
  }
  for (int i = tid; i < 1024 * 32; i += 512) {
    const int n = i >> 5, k8 = i & 31, t = n >> 4, co = n & 15, dir = k8 >> 4, c = (k8 >> 3) & 1, p0 = (k8 & 7) * 8;
    const int e = dir == 0 ? t + 1 : 64 - t;
    float v[8];
#pragma unroll
    for (int j = 0; j < 8; ++j) { const float2 cc = Cc[dir][co][p0 + j], w = pw[dir][e][p0 + j];
      v[j] = c == 0 ? (cc.x * w.x - cc.y * w.y) : -(cc.x * w.y + cc.y * w.x); }
    uint4 o; o.x = pack2bf(v[0], v[1]); o.y = pack2bf(v[2], v[3]); o.z = pack2bf(v[4], v[5]); o.w = pack2bf(v[6], v[7]);
    *(uint4*)(Cin_t + ((size_t)g * 1024 + n) * 256 + k8 * 8) = o;
  }
}
__global__ __launch_bounds__(512) void k_s5_p1(const float* __restrict__ x, const float* __restrict__ ctx, const float* __restrict__ mod,
                                               const bf16_t* __restrict__ Ktab, const bf16_t* __restrict__ Bst_t, float* __restrict__ Ypart, float* __restrict__ S) {
  __shared__ __attribute__((aligned(16))) char As[66 * LDA_B];
  const int g = blockIdx.x >> 2, cc0 = (blockIdx.x & 3) * 66, tid = threadIdx.x;
  const int wave = tid >> 6, lane = tid & 63, l15 = lane & 15, q = lane >> 4;
  for (int i = tid; i < 66 * 64 * 2; i += 512) {
    const int half = i & 1, sidx = (i >> 1) & 63, r = i >> 7;
    const int tok = s5_token(cc0 + r, sidx), ch = g * 16 + half * 8;
    const float* src = (tok < NL ? x + (size_t)tok * D : ctx + (size_t)(tok - NL) * D) + ch;
    const float* m = mod + row_vec(tok) * 6144;
    const float4 a = *(const float4*)src, b = *(const float4*)(src + 4);
    const float4 sh0 = *(const float4*)(m + ch), sh1 = *(const float4*)(m + ch + 4), sc0 = *(const float4*)(m + 1024 + ch), sc1 = *(const float4*)(m + 1024 + ch + 4);
    uint4 o;
    o.x = pack2bf(a.x * (1.f + sc0.x) + sh0.x, a.y * (1.f + sc0.y) + sh0.y); o.y = pack2bf(a.z * (1.f + sc0.z) + sh0.z, a.w * (1.f + sc0.w) + sh0.w);
    o.z = pack2bf(b.x * (1.f + sc1.x) + sh1.x, b.y * (1.f + sc1.y) + sh1.y); o.w = pack2bf(b.z * (1.f + sc1.z) + sh1.z, b.w * (1.f + sc1.w) + sh1.w);
    *(uint4*)(As + r * LDA_B + sidx * 32 + half * 16) = o;
  }
  __syncthreads();
  const char* ap[5];
#pragma unroll
  for (int t = 0; t < 5; ++t) { int r = t * 16 + l15; r = r < 66 ? r : 65; ap[t] = As + r * LDA_B + q * 16; }
  const bf16_t* Kg = Ktab + (size_t)g * 127 * 256;
#pragma unroll 1
  for (int unit = wave; unit < 40; unit += 8) {
    f32x4 acc[5][2];
    if (unit < 32) {
      const int t0 = unit * 2;
      const bf16_t* w0 = Kg + (t0 + 63 - (q >> 1)) * 256 + l15 * 16 + (q & 1) * 8;
      gemm_unit<5>(ap, w0, w0 + 256, -16, 1024, acc);
#pragma unroll
      for (int t = 0; t < 5; ++t)
#pragma unroll
        for (int j = 0; j < 2; ++j)
#pragma unroll
          for (int r = 0; r < 4; ++r) {
            const int row = t * 16 + q * 4 + r;
            if (row < 66) Ypart[(size_t)s5_token(cc0 + row, t0 + j) * D + g * 16 + l15] = acc[t][j][r];
          }
    } else {
      const int n0 = (unit - 32) * 32;
      const bf16_t* w0 = Bst_t + ((size_t)g * 256 + n0 + l15) * 1024 + q * 8;
      gemm_unit<5>(ap, w0, w0 + 16 * 1024, 1, 1024, acc);
#pragma unroll
      for (int t = 0; t < 5; ++t)
#pragma unroll
        for (int j = 0; j < 2; ++j)
#pragma unroll
          for (int r = 0; r < 4; ++r) {
            const int row = t * 16 + q * 4 + r;
            if (row < 66) S[((size_t)(cc0 + row) * 64 + g) * 256 + n0 + j * 16 + l15] = acc[t][j][r];
          }
    }
  }
}
__global__ __launch_bounds__(64) void k_s5_carry(const float* __restrict__ S, const float* __restrict__ a_re, const float* __restrict__ a_im,
                                                 const float* __restrict__ log_dt, bf16_t* __restrict__ HP) {
  const int id = blockIdx.x, dir = id & 1, g = (id >> 1) & 63, b = id >> 7, p = threadIdx.x;
  const int gp = (dir * 64 + g) * 64 + p;
  const float are = a_re[gp], aim = a_im[gp], dt = expf(log_dt[dir * 64 + g]);
  const float mag = expf(are * dt);
  float tr = mag * cosf(aim * dt), ti = mag * sinf(aim * dt);
#pragma unroll
  for (int i = 0; i < 6; ++i) { const float nr = tr * tr - ti * ti, ni = 2.f * tr * ti; tr = nr; ti = ni; }
  float hr = 0.f, hi = 0.f;
#pragma unroll 4
  for (int step = 0; step < NCHUNK; ++step) {
    const int c = dir == 0 ? step : (step < 4 ? 3 - step : NCHUNK - 1 - (step - 4));
    const size_t base = ((size_t)(b * NCHUNK + c) * 64 + g) * 256 + dir * 128 + p;
    HP[base] = f2bf(hr); HP[base + 64] = f2bf(hi);
    const float sr = S[base], si = S[base + 64];
    const float nr = tr * hr - ti * hi + sr, ni = tr * hi + ti * hr + si;
    hr = nr; hi = ni;
  }
}
struct EpiS5 { const float* x; const float* ctx; const float* mod; const float* dvec; const float* Ypart; bf16_t* Gbf; int cc0; int g;
  __device__ __forceinline__ void operator()(int row, int col, float v) const {
    const int tok = s5_token(cc0 + row, col >> 4), ch = g * 16 + (col & 15);
    const float* m = mod + row_vec(tok) * 6144;
    const float xin = tok < NL ? x[(size_t)tok * D + ch] : ctx[(size_t)(tok - NL) * D + ch];
    const float mm = xin * (1.f + m[1024 + ch]) + m[ch];
    const float y = v + Ypart[(size_t)tok * D + ch] + dvec[ch] * mm;
    Gbf[(size_t)tok * D + ch] = f2bf(gelu_exact(y));
  } };
__global__ __launch_bounds__(512) void k_s5_p3(const float* __restrict__ x, const float* __restrict__ ctx, const float* __restrict__ mod, const float* __restrict__ dvec,
                                               const bf16_t* __restrict__ HP, const bf16_t* __restrict__ Cin_t, const float* __restrict__ Ypart, bf16_t* __restrict__ Gbf) {
  __shared__ __attribute__((aligned(16))) char As[66 * 528];
  const int g = blockIdx.x >> 2, cc0 = (blockIdx.x & 3) * 66, tid = threadIdx.x;
  for (int i = tid; i < 66 * 32; i += 512) {
    const int r = i >> 5, c = i & 31;
    *(uint4*)(As + r * 528 + c * 16) = *(const uint4*)(HP + ((size_t)(cc0 + r) * 64 + g) * 256 + c * 8);
  }
  __syncthreads();
  gemm_ldsA<5>(As, 528, 66, Cin_t + (size_t)g * 1024 * 256, 256, 1024, EpiS5{x, ctx, mod, dvec, Ypart, Gbf, cc0, g});
}

struct ChainP {
  const bf16_t* Ain;
  const bf16_t* Wglu_t; const bf16_t* Wo_t; const bf16_t* Wq_t;
  bf16_t* Vbf; float* O; const float* Hl; const float* Hc; const float* mod; const float* lng; const float* lnb;
  float* Hout; bf16_t* Tbf; float* Q; const bf16_t* Wq_lo; bf16_t* Tlo;
};
template <bool L0>
__global__ __launch_bounds__(512) void k_chainA(ChainP p) {
  __shared__ __attribute__((aligned(16))) char As[66 * LDA_B];
  constexpr int NR = L0 ? 66 : 64;
  constexpr int RT = L0 ? 5 : 4;
  const int g0 = blockIdx.x * NR;
  load_rows_lds(As, p.Ain + (size_t)g0 * D, NR);
  __syncthreads();
  if (L0) {
    gemm_ldsA<RT>(As, LDA_B, NR, p.Wglu_t, D, D, EpiGluL{As, p.Vbf + (size_t)g0 * D});
    __syncthreads();
    load_rows_lds(As, p.Vbf + (size_t)g0 * D, NR);
    __syncthreads();
  }
  gemm_ldsA<RT>(As, LDA_B, NR, p.Wo_t, D, D, EpiF32{p.O + (size_t)g0 * D, D});
  __syncthreads();
  ln_rows(As, g0, NR, p.Hl, p.Hc, p.O, p.mod, 2, p.lng, p.lnb, p.Hout, p.Tbf, 3, 4, p.Tlo);
  __syncthreads();
  gemm_ldsA<RT>(As, LDA_B, NR, p.Wq_t, D, D, EpiF32{p.Q + (size_t)g0 * D, D});
  gemm_ldsA<RT>(As, LDA_B, NR, p.Wq_lo, D, D, EpiAddF32{p.Q + (size_t)g0 * D, D});
  __syncthreads();
  load_rows_lds(As, p.Tlo + (size_t)g0 * D, NR);
  __syncthreads();
  gemm_ldsA<RT>(As, LDA_B, NR, p.Wq_t, D, D, EpiAddF32{p.Q + (size_t)g0 * D, D});
}


constexpr int KEYS = SEQ + CTX;
struct EpiKV { bf16_t* Ka; bf16_t* Va; int g0; int pad; __device__ __forceinline__ void operator()(int row, int col, float v) const {
  const int g = g0 + row; int b, key;
  if (g < NL) { b = g >> 13; key = g & (SEQ - 1); } else { const int cidx = g - NL; b = cidx >> 8; key = SEQ + (cidx & (CTX - 1)); }
  const int head = col >> 8, j = col & 255;
  if (j < 128) Ka[((size_t)(b * 8 + head) * KEYS + key) * 192 + j] = f2bf(v);
  else Va[((size_t)(b * 8 + head) * KEYS + key) * 128 + (j - 128)] = f2bf(v);
} };
struct ProjP { const bf16_t* M1; const bf16_t* Wcat_t; const bf16_t* Wuq_t; const bf16_t* Wukv_t; const float* q_norm; const float* kv_norm;
               float* PR; float* Qraw; bf16_t* Qa; bf16_t* Ka; bf16_t* Va; };
__global__ __launch_bounds__(512) void k_mla_proj(ProjP p) {
  __shared__ __attribute__((aligned(16))) char As[66 * LDA_B];
  const int g0 = blockIdx.x * 66, wave = threadIdx.x >> 6, lane = threadIdx.x & 63;
  load_rows_lds(As, p.M1 + (size_t)g0 * D, 66);
  __syncthreads();
  gemm_ldsA<5>(As, LDA_B, 66, p.Wcat_t, D, 704, EpiF32{p.PR + (size_t)g0 * 704, 704});
  __syncthreads();
  char* A1 = As; char* A2 = As + 66 * 784;
  for (int rr = wave; rr < 66; rr += 8) {
    const int g = g0 + rr;
    const float* pr = p.PR + (size_t)g * 704;
    float v[6]; float ss = 0.f;
#pragma unroll
    for (int i = 0; i < 6; ++i) { v[i] = pr[i * 64 + lane]; ss += v[i] * v[i]; }
    float rn = rsqrtf(wave_sum(ss) * (1.f / 384.f) + RMS_EPS);
#pragma unroll
    for (int i = 0; i < 6; ++i) *(bf16_t*)(A1 + rr * 784 + (i * 64 + lane) * 2) = f2bf(v[i] * rn * p.q_norm[i * 64 + lane]);
    float w[4]; ss = 0.f;
#pragma unroll
    for (int i = 0; i < 4; ++i) { w[i] = pr[384 + i * 64 + lane]; ss += w[i] * w[i]; }
    rn = rsqrtf(wave_sum(ss) * (1.f / 256.f) + RMS_EPS);
#pragma unroll
    for (int i = 0; i < 4; ++i) *(bf16_t*)(A2 + rr * 528 + (i * 64 + lane) * 2) = f2bf(w[i] * rn * p.kv_norm[i * 64 + lane]);
    if (lane < 32) {
      float x1 = pr[640 + lane], x2 = pr[672 + lane];
      int b, key;
      if (g < NL) {
        b = g >> 13; key = g & (SEQ - 1);
        const int n = key, rr2 = n >> 6, cc = n & 63;
        const float inv = powf(10000.f, -(float)(lane & 15) / 16.f);
        const float ang = (lane < 16 ? (float)rr2 : (float)cc) * inv;
        const float cs = cosf(ang), sn = sinf(ang);
        const float y1 = x1 * cs - x2 * sn, y2 = x2 * cs + x1 * sn; x1 = y1; x2 = y2;
      } else { const int cidx = g - NL; b = cidx >> 8; key = SEQ + (cidx & (CTX - 1)); }
      const bf16_t h1 = f2bf(x1), h2 = f2bf(x2);
#pragma unroll
      for (int h = 0; h < 8; ++h) {
        bf16_t* kp = p.Ka + ((size_t)(b * 8 + h) * KEYS + key) * 192 + 128;
        kp[lane] = h1; kp[32 + lane] = h2;
      }
    }
  }
  __syncthreads();
  int nq = NL - g0; nq = nq > 66 ? 66 : nq;
  if (nq > 0) gemm_ldsA<5>(A1, 784, nq, p.Wuq_t, 384, 1536, EpiF32{p.Qraw + (size_t)g0 * 1536, 1536});
  gemm_ldsA<5>(A2, 528, 66, p.Wukv_t, 256, 2048, EpiKV{p.Ka, p.Va, g0, 0});
  __syncthreads();
  for (int rr = wave; rr < nq; rr += 8) {
    const int g = g0 + rr, b = g >> 13, n = g & (SEQ - 1);
    const float* qr = p.Qraw + (size_t)g * 1536;
    float cs = 1.f, sn = 0.f;
    if (lane < 32) {
      const float inv = powf(10000.f, -(float)(lane & 15) / 16.f);
      const float ang = (lane < 16 ? (float)(n >> 6) : (float)(n & 63)) * inv;
      cs = cosf(ang); sn = sinf(ang);
    }
#pragma unroll
    for (int h = 0; h < 8; ++h) {
      bf16_t* qo = p.Qa + ((size_t)(b * 8 + h) * SEQ + n) * 192;
      const float2 a = *(const float2*)(qr + h * 192 + lane * 2);
      *(unsigned*)(qo + lane * 2) = pack2bf(a.x, a.y);
      if (lane < 32) {
        const float x1 = qr[h * 192 + 128 + lane], x2 = qr[h * 192 + 160 + lane];
        qo[128 + lane] = f2bf(x1 * cs - x2 * sn); qo[160 + lane] = f2bf(x2 * cs + x1 * sn);
      }
    }
  }
}

namespace att {
using s16x4 = __attribute__((ext_vector_type(4))) short;
using f32x16 = __attribute__((ext_vector_type(16))) float;
using u32x4 = __attribute__((ext_vector_type(4))) unsigned;
constexpr int KVBLK = 64, KROW = 400;
constexpr float SCALE = 0.07216878364870322f;
constexpr float THR = 8.f;
constexpr int SHM_V = KVBLK * 128 * 2, SHM_K = KVBLK * KROW, QRROW = 144, SHM_QR = 256 * QRROW, SHM_ATTN = 2 * SHM_V + 2 * SHM_K + 8 * 64 * 4 + SHM_QR;
#define SBAR() __builtin_amdgcn_sched_barrier(0)
__device__ __forceinline__ int crow(int r, int hi) { return (r & 3) + 8 * (r >> 2) + 4 * hi; }
__device__ __forceinline__ unsigned cvtpk(float lo, float hi) { unsigned r; asm volatile("v_cvt_pk_bf16_f32 %0, %1, %2" : "=v"(r) : "v"(lo), "v"(hi)); return r; }
__device__ __forceinline__ void partialSM(f32x16& p0, f32x16& p1, float& m_reg, float& mn, float& alpha) {
  constexpr float C = SCALE * 1.4426950408889634f;
  float pmax = p0[0];
#pragma unroll
  for (int r = 1; r < 16; ++r) pmax = fmaxf(pmax, p0[r]);
#pragma unroll
  for (int r = 0; r < 16; ++r) pmax = fmaxf(pmax, p1[r]);
  { auto rr = __builtin_amdgcn_permlane32_swap(__float_as_uint(pmax), __float_as_uint(pmax), false, false);
    pmax = fmaxf(__uint_as_float(rr[0]), __uint_as_float(rr[1])); }
  if (__builtin_expect(__all(pmax - m_reg <= THR / SCALE), 1)) { mn = m_reg; alpha = 1.f; }
  else { mn = fmaxf(m_reg, pmax); alpha = __builtin_amdgcn_exp2f((m_reg - mn) * C); m_reg = mn; }
  const float mnC = -mn * C;
#pragma unroll
  for (int r = 0; r < 16; ++r) p0[r] = fmaf(p0[r], C, mnC);
#pragma unroll
  for (int r = 0; r < 16; ++r) p1[r] = fmaf(p1[r], C, mnC);
#pragma unroll
  for (int r = 0; r < 16; ++r) p0[r] = __builtin_amdgcn_exp2f(p0[r]);
}
__device__ __forceinline__ void finishSM(f32x16& p0, f32x16& p1, float alpha, float& l_reg, bf16x8& pa0, bf16x8& pa1, bf16x8& pa2, bf16x8& pa3) {
#pragma unroll
  for (int r = 0; r < 16; ++r) p1[r] = __builtin_amdgcn_exp2f(p1[r]);
  float ps = 0;
#pragma unroll
  for (int r = 0; r < 16; ++r) ps += p0[r];
#pragma unroll
  for (int r = 0; r < 16; ++r) ps += p1[r];
  { auto rr = __builtin_amdgcn_permlane32_swap(__float_as_uint(ps), __float_as_uint(ps), false, false);
    ps = __uint_as_float(rr[0]) + __uint_as_float(rr[1]); }
  l_reg = l_reg * alpha + ps;
#define PK4(P, BASE, OUT) do { unsigned a0 = cvtpk(P[BASE + 0], P[BASE + 1]), a1 = cvtpk(P[BASE + 2], P[BASE + 3]);   \
    unsigned b0 = cvtpk(P[BASE + 4], P[BASE + 5]), b1 = cvtpk(P[BASE + 6], P[BASE + 7]);                              \
    auto r0 = __builtin_amdgcn_permlane32_swap(a0, b0, false, false); auto r1 = __builtin_amdgcn_permlane32_swap(a1, b1, false, false); \
    u32x4 w = {r0[0], r1[0], r0[1], r1[1]}; OUT = *reinterpret_cast<bf16x8*>(&w); } while (0)
  PK4(p0, 0, pa0); PK4(p0, 8, pa1); PK4(p1, 0, pa2); PK4(p1, 8, pa3);
#undef PK4
}
__device__ __forceinline__ void qkt(f32x16& p0, f32x16& p1, const char* Ks, const bf16x8* qr, const char* qrl, int r32, int hi) {
  p0 = f32x16{}; p1 = f32x16{};
#pragma unroll
  for (int d0 = 0; d0 < 12; ++d0) { const int cb = (d0 * 16 + hi * 8) * 2;
    bf16x8 b0 = *reinterpret_cast<const bf16x8*>(Ks + r32 * KROW + cb);
    bf16x8 b1 = *reinterpret_cast<const bf16x8*>(Ks + (32 + r32) * KROW + cb);
    const bf16x8 qv = d0 < 8 ? qr[d0 < 8 ? d0 : 0] : *reinterpret_cast<const bf16x8*>(qrl + (d0 - 8) * 32);
    p0 = __builtin_amdgcn_mfma_f32_32x32x16_bf16(b0, qv, p0, 0, 0, 0);
    p1 = __builtin_amdgcn_mfma_f32_32x32x16_bf16(b1, qv, p1, 0, 0, 0); }
}
__device__ __forceinline__ int v_st(int k, int c) { const int kk = (k & ~0xC) | ((k & 4) << 1) | ((k & 8) >> 1); return ((kk >> 3) * 4 + (c >> 5)) * 512 + ((kk & 7) * 32 + (c & 31)) * 2; }
__device__ __forceinline__ int v_rd_base(int lane) { return ((lane & 3) << 3) | (((lane >> 2) & 3) << 6) | (((lane >> 4) & 1) << 5) | (((lane >> 5) & 1) << 8); }
constexpr int v_rd_off(int d0, int ks, int half) { return d0 * 512 + ks * 4096 + half * 2048; }
template <int OFF> __device__ __forceinline__ s16x4 tr_read(int vb) {
  s16x4 r; asm volatile("ds_read_b64_tr_b16 %0, %1 offset:%2" : "=&v"(r) : "v"(vb), "i"(OFF) : "memory"); return r;
}
template <int D0> __device__ __forceinline__ void pv_one(f32x16& od, int vb, bf16x8 pa0, bf16x8 pa1, bf16x8 pa2, bf16x8 pa3) {
  const s16x4 l0 = tr_read<v_rd_off(D0, 0, 0)>(vb), h0 = tr_read<v_rd_off(D0, 0, 1)>(vb), l1 = tr_read<v_rd_off(D0, 1, 0)>(vb), h1 = tr_read<v_rd_off(D0, 1, 1)>(vb);
  const s16x4 l2 = tr_read<v_rd_off(D0, 2, 0)>(vb), h2 = tr_read<v_rd_off(D0, 2, 1)>(vb), l3 = tr_read<v_rd_off(D0, 3, 0)>(vb), h3 = tr_read<v_rd_off(D0, 3, 1)>(vb);
  asm volatile("s_waitcnt lgkmcnt(0)" ::: "memory"); SBAR();
#define PK(L, H) (bf16x8){L[0], L[1], L[2], L[3], H[0], H[1], H[2], H[3]}
  od = __builtin_amdgcn_mfma_f32_32x32x16_bf16(pa0, PK(l0, h0), od, 0, 0, 0);
  od = __builtin_amdgcn_mfma_f32_32x32x16_bf16(pa1, PK(l1, h1), od, 0, 0, 0);
  od = __builtin_amdgcn_mfma_f32_32x32x16_bf16(pa2, PK(l2, h2), od, 0, 0, 0);
  od = __builtin_amdgcn_mfma_f32_32x32x16_bf16(pa3, PK(l3, h3), od, 0, 0, 0);
#undef PK
}
__device__ __forceinline__ void pv_d0(f32x16* o, int vb, bf16x8 pa0, bf16x8 pa1, bf16x8 pa2, bf16x8 pa3) {
  pv_one<0>(o[0], vb, pa0, pa1, pa2, pa3); pv_one<1>(o[1], vb, pa0, pa1, pa2, pa3); pv_one<2>(o[2], vb, pa0, pa1, pa2, pa3); pv_one<3>(o[3], vb, pa0, pa1, pa2, pa3);
}
__device__ __forceinline__ void attn_body(const bf16_t* __restrict__ Qb, const bf16_t* __restrict__ Kh, const bf16_t* __restrict__ Vh,
                                          bf16_t* __restrict__ Ob, int nkeys, char* lds) {
  const int tid = threadIdx.x, wid = tid >> 6, lane = tid & 63, r32 = lane & 31, hi = lane >> 5;
  char* V_lds = lds; char* K_lds = lds + 2 * SHM_V;
  float* ws = (float*)(lds + 2 * SHM_V + 2 * SHM_K) + wid * 64; float* li_l = ws; float* al_l = ws + 32;
  float m_reg = -1e30f, l_reg = 0; f32x16 o[4] = {}; bf16x8 qr[8];
  const bf16_t* Qw = Qb + (size_t)(wid * 32 + r32) * 192 + hi * 8;
  char* qrl = lds + 2 * SHM_V + 2 * SHM_K + 8 * 64 * 4 + (wid * 32 + r32) * QRROW + hi * 16;
#pragma unroll
  for (int d0 = 0; d0 < 8; ++d0) qr[d0] = *reinterpret_cast<const bf16x8*>(Qw + d0 * 16);
#pragma unroll
  for (int d0 = 8; d0 < 12; ++d0) *reinterpret_cast<bf16x8*>(qrl + (d0 - 8) * 32) = *reinterpret_cast<const bf16x8*>(Qw + d0 * 16);
  const int sr = tid >> 4, sc = (tid & 15) * 8, vst0 = v_st(sr, sc), vst1 = v_st(32 + sr, sc);
  const int krw = tid >> 3, kch = tid & 7;
  const int vb0 = (int)(uintptr_t)V_lds + v_rd_base(lane);
  bf16x8 vs0, vs1, ks0, ks1, ks2;
#define SLOAD(k0) do { vs0 = *reinterpret_cast<const bf16x8*>(&Vh[(size_t)((k0) + sr) * 128 + sc]); vs1 = *reinterpret_cast<const bf16x8*>(&Vh[(size_t)((k0) + 32 + sr) * 128 + sc]); \
    const bf16_t* kp_ = &Kh[(size_t)((k0) + krw) * 192 + kch * 8]; \
    ks0 = *reinterpret_cast<const bf16x8*>(kp_); ks1 = *reinterpret_cast<const bf16x8*>(kp_ + 64); ks2 = *reinterpret_cast<const bf16x8*>(kp_ + 128); } while (0)
#define SWRITE(b) do { *(bf16x8*)(V_lds + (b) * SHM_V + vst0) = vs0; *(bf16x8*)(V_lds + (b) * SHM_V + vst1) = vs1; \
    char* kl_ = K_lds + (b) * SHM_K + krw * KROW + kch * 16; \
    *(bf16x8*)(kl_) = ks0; *(bf16x8*)(kl_ + 128) = ks1; *(bf16x8*)(kl_ + 256) = ks2; } while (0)
#define SWAIT() asm volatile("s_waitcnt vmcnt(0)" ::: "memory")
#define RESC(a) do { if (__any((a) < 1.f)) { if (hi == 0) al_l[r32] = (a); asm volatile("s_waitcnt lgkmcnt(0)" ::: "memory"); \
    for (int d = 0; d < 4; ++d) for (int r = 0; r < 16; ++r) o[d][r] *= al_l[crow(r, hi)]; } } while (0)
  f32x16 pA0, pA1, pB0, pB1; float mnA, mnB, alA, alB; bf16x8 pa0, pa1, pa2, pa3; const int NTL = nkeys / KVBLK;
  SLOAD(0); SWAIT(); SWRITE(0); __syncthreads();
  qkt(pA0, pA1, K_lds, qr, qrl, r32, hi); partialSM(pA0, pA1, m_reg, mnA, alA);
  SLOAD(KVBLK);
  SWAIT(); SWRITE(1); __syncthreads();
  for (int j = 1; j + 1 < NTL; j += 2) {
    SBAR(); qkt(pB0, pB1, K_lds + SHM_K, qr, qrl, r32, hi);
    finishSM(pA0, pA1, alA, l_reg, pa0, pa1, pa2, pa3); SBAR();
    SLOAD((j + 1) * KVBLK); SBAR();
    pv_d0(o, vb0, pa0, pa1, pa2, pa3); partialSM(pB0, pB1, m_reg, mnB, alB);
    __syncthreads(); SWAIT(); SWRITE(0);
    RESC(alB); __syncthreads();
    SBAR(); qkt(pA0, pA1, K_lds, qr, qrl, r32, hi);
    finishSM(pB0, pB1, alB, l_reg, pa0, pa1, pa2, pa3); SBAR();
    SLOAD((j + 2) * KVBLK); SBAR();
    pv_d0(o, vb0 + SHM_V, pa0, pa1, pa2, pa3); partialSM(pA0, pA1, m_reg, mnA, alA);
    __syncthreads(); SWAIT(); SWRITE(1);
    RESC(alA); __syncthreads();
  }
  SBAR(); qkt(pB0, pB1, K_lds + SHM_K, qr, qrl, r32, hi);
  finishSM(pA0, pA1, alA, l_reg, pa0, pa1, pa2, pa3); SBAR();
  pv_d0(o, vb0, pa0, pa1, pa2, pa3); partialSM(pB0, pB1, m_reg, mnB, alB);
  __syncthreads(); RESC(alB);
  finishSM(pB0, pB1, alB, l_reg, pa0, pa1, pa2, pa3); SBAR();
  pv_d0(o, vb0 + SHM_V, pa0, pa1, pa2, pa3);
  if (hi == 0) li_l[r32] = l_reg; asm volatile("s_waitcnt lgkmcnt(0)" ::: "memory");
  float rli[16];
#pragma unroll
  for (int r = 0; r < 16; ++r) rli[r] = __builtin_amdgcn_rcpf(li_l[crow(r, hi)]);
  bf16_t* Ow = Ob + (size_t)(wid * 32) * D;
#pragma unroll
  for (int r = 0; r < 16; ++r) { const int orow = crow(r, hi);
#pragma unroll
    for (int d0 = 0; d0 < 4; ++d0) Ow[(size_t)orow * D + d0 * 32 + r32] = f2bf(o[d0][r] * rli[r]); }
  __syncthreads();
#undef SLOAD
#undef SWRITE
#undef SWAIT
#undef RESC
}
}

__global__ __launch_bounds__(512) void k_attn_mfma(const bf16_t* __restrict__ Qa, const bf16_t* __restrict__ Ka, const bf16_t* __restrict__ Va, bf16_t* __restrict__ AO) {
  __shared__ __attribute__((aligned(16))) char lds[att::SHM_ATTN];
  for (int item = blockIdx.x; item < 512; item += gridDim.x) {
    const int b = item >> 8, h = item & 7, qb = (item >> 3) & 31;
    att::attn_body(Qa + ((size_t)(b * 8 + h) * SEQ + qb * 256) * 192, Ka + (size_t)(b * 8 + h) * KEYS * 192, Va + (size_t)(b * 8 + h) * KEYS * 128,
                   AO + (size_t)(b * SEQ + qb * 256) * D + h * 128, KEYS, lds);
  }
}


namespace rt {
using f32x16 = __attribute__((ext_vector_type(16))) float;
__device__ __forceinline__ int sortable(float f) { const int b = __float_as_int(f); return b ^ ((b >> 31) & 0x7FFFFFFF); }
__device__ __forceinline__ float unsortable(int k) { return __int_as_float(k ^ ((k >> 31) & 0x7FFFFFFF)); }
__device__ __forceinline__ int imax(int a, int b) { return a > b ? a : b; }
__device__ __forceinline__ int imin(int a, int b) { return a < b ? a : b; }
template <int N> __device__ __forceinline__ void sort_desc(int (&v)[N]) {
#pragma unroll
  for (int k = 2; k <= N; k <<= 1) {
#pragma unroll
    for (int j = k >> 1; j > 0; j >>= 1) {
#pragma unroll
      for (int i = 0; i < N; ++i) {
        const int l = i ^ j;
        if (l > i) {
          const bool desc = ((i & k) == 0);
          const int a = v[i], b = v[l];
          v[i] = desc ? imax(a, b) : imin(a, b);
          v[l] = desc ? imin(a, b) : imax(a, b);
        }
      }
    }
  }
}
template <int N> __device__ __forceinline__ void merge_desc(int (&v)[N]) {
#pragma unroll
  for (int j = N >> 1; j > 0; j >>= 1) {
#pragma unroll
    for (int i = 0; i < N; ++i) {
      const int l = i ^ j;
      if (l > i) { const int a = v[i], b = v[l]; v[i] = imax(a, b); v[l] = imin(a, b); }
    }
  }
}
__device__ __forceinline__ void absorb16(int (&L)[16], int (&B)[16]) {
  sort_desc<16>(B);
#pragma unroll
  for (int i = 0; i < 16; ++i) L[i] = imax(L[i], B[15 - i]);
  merge_desc<16>(L);
}
__device__ __forceinline__ constexpr int npairs_row(int i) { return 16 / (i + 1); }
}

struct RouteP { const float* Q; const bf16_t* Khi; const bf16_t* Klo; int* IDX; float* GATE; int rows_per_block; int pad; };
__global__ __launch_bounds__(512) void k_route_fast(RouteP p) {
  using namespace rt;
  __shared__ int svl[8][64][33];
  const int wave = threadIdx.x >> 6, lane = threadIdx.x & 63, r32 = lane & 31, hi = lane >> 5, hi4 = hi * 4;
  const int nrows = p.rows_per_block, g0 = blockIdx.x * nrows;
  const int h = wave;
  for (int tg = 0; tg * 32 < nrows; ++tg) {
    int trow = tg * 32 + r32; const bool valid = trow < nrows; trow = valid ? trow : nrows - 1;
    const float* qrow = p.Q + (size_t)(g0 + trow) * D;
    int sv[2][16];
#pragma unroll
    for (int s = 0; s < 2; ++s) {
      const int hs = h * 2 + s;
      f32x16 acc[4];
#pragma unroll
      for (int m = 0; m < 4; ++m) acc[m] = f32x16{};
#pragma unroll
      for (int ks = 0; ks < 4; ++ks) {
        const float4 qa = *(const float4*)(qrow + hs * 64 + ks * 16 + hi * 8), qb = *(const float4*)(qrow + hs * 64 + ks * 16 + hi * 8 + 4);
        uint4 qh, ql;
        qh.x = pack2bf(qa.x, qa.y); qh.y = pack2bf(qa.z, qa.w); qh.z = pack2bf(qb.x, qb.y); qh.w = pack2bf(qb.z, qb.w);
        ql.x = pack2bf(qa.x - bflo(qh.x), qa.y - bfhi(qh.x)); ql.y = pack2bf(qa.z - bflo(qh.y), qa.w - bfhi(qh.y));
        ql.z = pack2bf(qb.x - bflo(qh.z), qb.y - bfhi(qh.z)); ql.w = pack2bf(qb.z - bflo(qh.w), qb.w - bfhi(qh.w));
        const bf16x8 bqh = *reinterpret_cast<const bf16x8*>(&qh), bql = *reinterpret_cast<const bf16x8*>(&ql);
#pragma unroll
        for (int m = 0; m < 4; ++m) {
          const size_t ko = ((size_t)(hs * 128 + m * 32 + r32)) * 64 + ks * 16 + hi * 8;
          const bf16x8 kh = *(const bf16x8*)(p.Khi + ko), kl = *(const bf16x8*)(p.Klo + ko);
          acc[m] = __builtin_amdgcn_mfma_f32_32x32x16_bf16(kh, bqh, acc[m], 0, 0, 0);
          acc[m] = __builtin_amdgcn_mfma_f32_32x32x16_bf16(kh, bql, acc[m], 0, 0, 0);
          acc[m] = __builtin_amdgcn_mfma_f32_32x32x16_bf16(kl, bqh, acc[m], 0, 0, 0);
        }
      }
      int L[16];
#pragma unroll
      for (int m = 0; m < 4; ++m) {
        int B[16];
#pragma unroll
        for (int r = 0; r < 16; ++r) B[r] = (sortable(acc[m][r]) & ~0x7F) | (m * 32 + (r & 3) + 8 * (r >> 2)) | hi4;
        if (m == 0) { sort_desc<16>(B);
#pragma unroll
          for (int i = 0; i < 16; ++i) L[i] = B[i]; }
        else absorb16(L, B);
      }
      int Lo[16], Hi[16];
#pragma unroll
      for (int i = 0; i < 16; ++i) { auto rr = __builtin_amdgcn_permlane32_swap((unsigned)L[i], (unsigned)L[i], false, false); Lo[i] = (int)rr[0]; Hi[i] = (int)rr[1]; }
#pragma unroll
      for (int i = 0; i < 16; ++i) L[i] = imax(Lo[i], Hi[15 - i]);
      merge_desc<16>(L);
#pragma unroll
      for (int i = 0; i < 16; ++i) { sv[s][i] = L[i]; svl[wave][lane][s * 16 + i] = L[i]; }
    }
    float f0[16], f1[16];
#pragma unroll
    for (int i = 0; i < 16; ++i) { f0[i] = unsortable(sv[0][i] & ~0x7F); f1[i] = unsortable(sv[1][i] & ~0x7F); }
    int Lc[16];
    {
      int C[64];
      int n = 0;
#pragma unroll
      for (int i = 0; i < 16; ++i)
#pragma unroll
        for (int j = 0; j < 16; ++j)
          if ((i + 1) * (j + 1) <= 16) { C[n] = (sortable(f0[i] + f1[j]) & ~0xFF) | (i * 16 + j); ++n; }
#pragma unroll
      for (int k = 50; k < 64; ++k) C[k] = (int)0x80000000;
#pragma unroll
      for (int m = 0; m < 4; ++m) {
        int B[16];
#pragma unroll
        for (int r = 0; r < 16; ++r) B[r] = C[m * 16 + r];
        if (m == 0) { sort_desc<16>(B);
#pragma unroll
          for (int i = 0; i < 16; ++i) Lc[i] = B[i]; }
        else absorb16(Lc, B);
      }
    }
    float e[16]; float esum = 0.f;
    const float vmax = unsortable(Lc[0] & ~0xFF);
#pragma unroll
    for (int r = 0; r < 16; ++r) { e[r] = expf(unsortable(Lc[r] & ~0xFF) - vmax); esum += e[r]; }
    const float inv = 1.f / esum;
    int eid[16];
#pragma unroll
    for (int r = 0; r < 16; ++r) {
      const int pr = Lc[r] & 0xFF;
      const int k0 = svl[wave][lane][pr >> 4] & 0x7F, k1 = svl[wave][lane][16 + (pr & 15)] & 0x7F;
      eid[r] = k0 * 128 + k1;
    }
    if (valid && hi == 0) {
      int* ip = p.IDX + (size_t)(g0 + trow) * 128 + h * 16; float* gp = p.GATE + (size_t)(g0 + trow) * 128 + h * 16;
#pragma unroll
      for (int r = 0; r < 16; r += 4) {
        *(int4*)(ip + r) = make_int4(eid[r], eid[r + 1], eid[r + 2], eid[r + 3]);
        *(float4*)(gp + r) = make_float4(e[r] * inv, e[r + 1] * inv, e[r + 2] * inv, e[r + 3] * inv);
      }
    }
  }
}

__global__ __launch_bounds__(512) void k_gather(const bf16_t* __restrict__ Tbf, const int* __restrict__ IDX, const float* __restrict__ GATE,
                                                const bf16_t* __restrict__ utab, const bf16_t* __restrict__ vtab, float* __restrict__ F, int rows_per_block) {
  const int wave = threadIdx.x >> 6, lane = threadIdx.x & 63;
  for (int rr = wave; rr < rows_per_block; rr += 8) {
    const int row = blockIdx.x * rows_per_block + rr;
    float tf[16];
    {
      const uint4 t0 = *(const uint4*)(Tbf + (size_t)row * D + lane * 8), t1 = *(const uint4*)(Tbf + (size_t)row * D + 512 + lane * 8);
      tf[0] = bflo(t0.x); tf[1] = bfhi(t0.x); tf[2] = bflo(t0.y); tf[3] = bfhi(t0.y); tf[4] = bflo(t0.z); tf[5] = bfhi(t0.z); tf[6] = bflo(t0.w); tf[7] = bfhi(t0.w);
      tf[8] = bflo(t1.x); tf[9] = bfhi(t1.x); tf[10] = bflo(t1.y); tf[11] = bfhi(t1.y); tf[12] = bflo(t1.z); tf[13] = bfhi(t1.z); tf[14] = bflo(t1.w); tf[15] = bfhi(t1.w);
    }
    const int id_lo = IDX[(size_t)row * 128 + lane], id_hi = IDX[(size_t)row * 128 + 64 + lane];
    const float ga_lo = GATE[(size_t)row * 128 + lane], ga_hi = GATE[(size_t)row * 128 + 64 + lane];
    float f[16];
#pragma unroll
    for (int i = 0; i < 16; ++i) f[i] = 0.f;
    uint4 ub[3][2], vb[3][2];
#define ROWLOAD(slot, kk) do { const int e_ = __builtin_amdgcn_readlane((kk) < 64 ? id_lo : id_hi, (kk) & 63); \
      const bf16_t* up_ = utab + (size_t)e_ * D + lane * 8; const bf16_t* vp_ = vtab + (size_t)e_ * D + lane * 8; \
      ub[slot][0] = *(const uint4*)up_; ub[slot][1] = *(const uint4*)(up_ + 512); vb[slot][0] = *(const uint4*)vp_; vb[slot][1] = *(const uint4*)(vp_ + 512); } while (0)
#define ROWPROC(slot, kk) do { \
      float dot_ = 0.f; \
      { const uint4 a_ = ub[slot][0], b_ = ub[slot][1]; \
        dot_ += tf[0] * bflo(a_.x) + tf[1] * bfhi(a_.x) + tf[2] * bflo(a_.y) + tf[3] * bfhi(a_.y) + tf[4] * bflo(a_.z) + tf[5] * bfhi(a_.z) + tf[6] * bflo(a_.w) + tf[7] * bfhi(a_.w); \
        dot_ += tf[8] * bflo(b_.x) + tf[9] * bfhi(b_.x) + tf[10] * bflo(b_.y) + tf[11] * bfhi(b_.y) + tf[12] * bflo(b_.z) + tf[13] * bfhi(b_.z) + tf[14] * bflo(b_.w) + tf[15] * bfhi(b_.w); } \
      dot_ = wave_sum(dot_); \
      const float g_ = __uint_as_float(__builtin_amdgcn_readlane(__float_as_uint((kk) < 64 ? ga_lo : ga_hi), (kk) & 63)); \
      const float a_ = gelu_exact(dot_) * g_; \
      { const uint4 c_ = vb[slot][0], d_ = vb[slot][1]; \
        f[0] += a_ * bflo(c_.x); f[1] += a_ * bfhi(c_.x); f[2] += a_ * bflo(c_.y); f[3] += a_ * bfhi(c_.y); f[4] += a_ * bflo(c_.z); f[5] += a_ * bfhi(c_.z); f[6] += a_ * bflo(c_.w); f[7] += a_ * bfhi(c_.w); \
        f[8] += a_ * bflo(d_.x); f[9] += a_ * bfhi(d_.x); f[10] += a_ * bflo(d_.y); f[11] += a_ * bfhi(d_.y); f[12] += a_ * bflo(d_.z); f[13] += a_ * bfhi(d_.z); f[14] += a_ * bflo(d_.w); f[15] += a_ * bfhi(d_.w); } } while (0)
    ROWLOAD(0, 0); ROWLOAD(1, 1); ROWLOAD(2, 2);
    for (int k = 0; k < 126; k += 3) {
      ROWPROC(0, k); ROWLOAD(0, k + 3);
      ROWPROC(1, k + 1); if (k + 4 < 128) ROWLOAD(1, k + 4);
      ROWPROC(2, k + 2); if (k + 5 < 128) ROWLOAD(2, k + 5);
    }
    ROWPROC(0, 126); ROWPROC(1, 127);
#undef ROWLOAD
#undef ROWPROC
    float* fo = F + (size_t)row * D + lane * 8;
    *(float4*)fo = make_float4(f[0], f[1], f[2], f[3]); *(float4*)(fo + 4) = make_float4(f[4], f[5], f[6], f[7]);
    *(float4*)(fo + 512) = make_float4(f[8], f[9], f[10], f[11]); *(float4*)(fo + 516) = make_float4(f[12], f[13], f[14], f[15]);
  }
}
__global__ __launch_bounds__(256) void k_mod(const float* __restrict__ c, const float* __restrict__ c_ctx,
                                             const float* __restrict__ ada_w, const float* __restrict__ ada_b, float* __restrict__ MOD) {
  __shared__ float sc[3][1024];
  const int l = blockIdx.y, n = blockIdx.x * 256 + threadIdx.x;
  for (int i = threadIdx.x; i < 3072; i += 256) {
    int v = i >> 10, k = i & 1023;
    float x = v < 2 ? c[v * 1024 + k] : c_ctx[k];
    sc[v][k] = x / (1.f + expf(-x));
  }
  __syncthreads();
  float a0 = 0, a1 = 0, a2 = 0;
  const float* W = ada_w + (size_t)l * 1024 * 6144 + n;
#pragma unroll 8
  for (int k = 0; k < 1024; ++k) {
    float w = W[(size_t)k * 6144];
    a0 += sc[0][k] * w; a1 += sc[1][k] * w; a2 += sc[2][k] * w;
  }
  float bias = ada_b[l * 6144 + n];
  MOD[(l * 3 + 0) * 6144 + n] = a0 + bias;
  MOD[(l * 3 + 1) * 6144 + n] = a1 + bias;
  MOD[(l * 3 + 2) * 6144 + n] = a2 + bias;
}

__global__ __launch_bounds__(256) void k_modulate(const float* __restrict__ Hl, const float* __restrict__ Hc, const float* __restrict__ mod,
                                                  int shift_i, int scale_i, float* __restrict__ U, int nrows) {
  size_t i = (size_t)blockIdx.x * 256 + threadIdx.x;
  if (i >= (size_t)nrows * 256) return;
  int row = (int)(i >> 8), d = (int)(i & 255) * 4;
  const float* src = row < NL ? Hl + (size_t)row * D : Hc + (size_t)(row - NL) * D;
  float4 h = *(const float4*)(src + d);
  const float* m = mod + row_vec(row) * 6144;
  float4 sh = *(const float4*)(m + shift_i * 1024 + d), scv = *(const float4*)(m + scale_i * 1024 + d);
  float4 o; o.x = h.x * (1.f + scv.x) + sh.x; o.y = h.y * (1.f + scv.y) + sh.y; o.z = h.z * (1.f + scv.z) + sh.z; o.w = h.w * (1.f + scv.w) + sh.w;
  *(float4*)(U + (size_t)row * D + d) = o;
}

__global__ __launch_bounds__(64) void k_s5_scan(const float* __restrict__ U, const float* __restrict__ a_re, const float* __restrict__ a_im,
                                                const float* __restrict__ log_dt, const float* __restrict__ b_re, const float* __restrict__ b_im,
                                                const float* __restrict__ c_re, const float* __restrict__ c_im,
                                                float* __restrict__ YF, float* __restrict__ YB) {
  __shared__ __attribute__((aligned(16))) float hs[2][64];
  const int id = blockIdx.x, dir = id & 1, g = (id >> 1) & 63, b = id >> 7, lane = threadIdx.x;
  const int gp = (dir * 64 + g) * 64 + lane;
  const float are = a_re[gp], aim = a_im[gp], dt = expf(log_dt[dir * 64 + g]);
  const float mag = expf(are * dt);
  const float abr = mag * cosf(aim * dt), abi = mag * sinf(aim * dt);
  const float nr = abr - 1.f, ni = abi, den = are * are + aim * aim;
  const float fr = (nr * are + ni * aim) / den, fi = (ni * are - nr * aim) / den;
  float bpr[16], bpi[16];
#pragma unroll
  for (int ci = 0; ci < 16; ++ci) {
    float br = b_re[gp * 16 + ci], bi = b_im[gp * 16 + ci];
    bpr[ci] = fr * br - fi * bi; bpi[ci] = fr * bi + fi * br;
  }
  const int co = lane & 15, q = lane >> 4;
  float crr[16], cii[16];
#pragma unroll
  for (int k = 0; k < 16; ++k) {
    int idx = ((dir * 64 + g) * 16 + co) * 64 + q * 16 + k;
    crr[k] = c_re[idx]; cii[k] = c_im[idx];
  }
  float hr = 0.f, hi = 0.f;
  float* Y = dir ? YB : YF;
  auto rowof = [&](int s) -> int {
    if (dir == 0) return s < CTX ? NL + b * CTX + s : b * SEQ + (s - CTX);
    return s < CTX ? NL + b * CTX + (CTX - 1 - s) : b * SEQ + (SEQ - 1 - (s - CTX));
  };
  int row = rowof(0);
  const float4* up = (const float4*)(U + (size_t)row * D + g * 16);
  float4 n0 = up[0], n1 = up[1], n2 = up[2], n3 = up[3];
  for (int s = 0; s < CTX + SEQ; ++s) {
    float u[16] = {n0.x, n0.y, n0.z, n0.w, n1.x, n1.y, n1.z, n1.w, n2.x, n2.y, n2.z, n2.w, n3.x, n3.y, n3.z, n3.w};
    const int currow = row;
    if (s + 1 < CTX + SEQ) {
      row = rowof(s + 1);
      up = (const float4*)(U + (size_t)row * D + g * 16);
      n0 = up[0]; n1 = up[1]; n2 = up[2]; n3 = up[3];
    }
    float bur = 0.f, bui = 0.f;
#pragma unroll
    for (int ci = 0; ci < 16; ++ci) { bur += bpr[ci] * u[ci]; bui += bpi[ci] * u[ci]; }
    float nhr = abr * hr - abi * hi + bur, nhi = abr * hi + abi * hr + bui;
    hr = nhr; hi = nhi;
    hs[0][lane] = hr; hs[1][lane] = hi;
    __syncthreads();
    float acc = 0.f;
#pragma unroll
    for (int k4 = 0; k4 < 4; ++k4) {
      float4 a = *(const float4*)&hs[0][q * 16 + k4 * 4], bq = *(const float4*)&hs[1][q * 16 + k4 * 4];
      acc += crr[k4 * 4 + 0] * a.x - cii[k4 * 4 + 0] * bq.x;
      acc += crr[k4 * 4 + 1] * a.y - cii[k4 * 4 + 1] * bq.y;
      acc += crr[k4 * 4 + 2] * a.z - cii[k4 * 4 + 2] * bq.z;
      acc += crr[k4 * 4 + 3] * a.w - cii[k4 * 4 + 3] * bq.w;
    }
    acc += __shfl_xor(acc, 16); acc += __shfl_xor(acc, 32);
    if (lane < 16) Y[(size_t)currow * D + g * 16 + lane] = acc;
    __syncthreads();
  }
}

__global__ __launch_bounds__(256) void k_s5_gelu(float* __restrict__ YF, const float* __restrict__ YB, const float* __restrict__ U,
                                                 const float* __restrict__ dvec, bf16_t* __restrict__ Gbf) {
  size_t i = (size_t)blockIdx.x * 256 + threadIdx.x;
  if (i >= (size_t)NT * 256) return;
  int d = (int)(i & 255) * 4;
  float4 a = ((const float4*)YF)[i], b = ((const float4*)YB)[i], u = ((const float4*)U)[i], dd = *(const float4*)(dvec + d);
  float4 o; o.x = gelu_exact(a.x + b.x + dd.x * u.x); o.y = gelu_exact(a.y + b.y + dd.y * u.y);
  o.z = gelu_exact(a.z + b.z + dd.z * u.z); o.w = gelu_exact(a.w + b.w + dd.w * u.w);
  ((float4*)YF)[i] = o;
  uint2 w; w.x = pack2bf(o.x, o.y); w.y = pack2bf(o.z, o.w); ((uint2*)Gbf)[i] = w;
}

struct EpiStore { float* C; int ldc; int pad; __device__ void operator()(int m, int n, float v) const { C[(size_t)m * ldc + n] = v; } };
struct EpiGlu { const float* G; float* V; __device__ void operator()(int m, int n, float z) const {
  float g = G[(size_t)m * D + n]; V[(size_t)m * D + n] = g / (1.f + expf(-z)); } };

template <class Epi>
__global__ __launch_bounds__(256) void k_gemm(const float* __restrict__ A, int lda, const float* __restrict__ W, int N, int K, Epi epi) {
  __shared__ __attribute__((aligned(16))) float As[16][68];
  __shared__ __attribute__((aligned(16))) float Bs[16][64];
  const int tid = threadIdx.x, ty = tid >> 4, tx = tid & 15;
  const int m0 = blockIdx.y * 64, n0 = blockIdx.x * 64;
  float acc[4][4] = {};
  const int am = tid >> 2, ak = (tid & 3) * 4;
  const int bk = tid >> 4, bn = (tid & 15) * 4;
  for (int k0 = 0; k0 < K; k0 += 16) {
    float4 av = *(const float4*)(A + (size_t)(m0 + am) * lda + k0 + ak);
    float4 bv = *(const float4*)(W + (size_t)(k0 + bk) * N + n0 + bn);
    __syncthreads();
    As[ak + 0][am] = av.x; As[ak + 1][am] = av.y; As[ak + 2][am] = av.z; As[ak + 3][am] = av.w;
    *(float4*)&Bs[bk][bn] = bv;
    __syncthreads();
#pragma unroll
    for (int kk = 0; kk < 16; ++kk) {
      float4 a = *(const float4*)&As[kk][ty * 4], b = *(const float4*)&Bs[kk][tx * 4];
      float ar[4] = {a.x, a.y, a.z, a.w}, br[4] = {b.x, b.y, b.z, b.w};
#pragma unroll
      for (int i = 0; i < 4; ++i)
#pragma unroll
        for (int j = 0; j < 4; ++j) acc[i][j] += ar[i] * br[j];
    }
  }
#pragma unroll
  for (int i = 0; i < 4; ++i)
#pragma unroll
    for (int j = 0; j < 4; ++j) epi(m0 + ty * 4 + i, n0 + tx * 4 + j, acc[i][j]);
}

__global__ __launch_bounds__(256) void k_ln_resid(const float* Hl, const float* Hc, const float* F,
                                                  const float* __restrict__ mod, int gate_i, const float* __restrict__ lng, const float* __restrict__ lnb,
                                                  float* Hout, float* T, const float* __restrict__ modT, int shift_i, int scale_i, int nrows) {
  const int row = blockIdx.x * 4 + (threadIdx.x >> 6), lane = threadIdx.x & 63;
  if (row >= nrows) return;
  const float* hin = row < NL ? Hl + (size_t)row * D : Hc + (size_t)(row - NL) * D;
  const float* f = F + (size_t)row * D;
  const int v = row_vec(row);
  const float* gm = mod + v * 6144 + gate_i * 1024;
  float r[16]; float s = 0.f;
#pragma unroll
  for (int i = 0; i < 4; ++i) {
    int d = i * 256 + lane * 4;
    float4 h4 = *(const float4*)(hin + d), f4 = *(const float4*)(f + d), g4 = *(const float4*)(gm + d);
    r[i * 4 + 0] = ALPHA * h4.x + g4.x * f4.x; r[i * 4 + 1] = ALPHA * h4.y + g4.y * f4.y;
    r[i * 4 + 2] = ALPHA * h4.z + g4.z * f4.z; r[i * 4 + 3] = ALPHA * h4.w + g4.w * f4.w;
    s += r[i * 4 + 0] + r[i * 4 + 1] + r[i * 4 + 2] + r[i * 4 + 3];
  }
  const float mu = wave_sum(s) * (1.f / D);
  float vs = 0.f;
#pragma unroll
  for (int i = 0; i < 16; ++i) { float dlt = r[i] - mu; vs += dlt * dlt; }
  const float rstd = rsqrtf(wave_sum(vs) * (1.f / D) + LN_EPS);
#pragma unroll
  for (int i = 0; i < 4; ++i) {
    int d = i * 256 + lane * 4;
    float4 g4 = *(const float4*)(lng + d), b4 = *(const float4*)(lnb + d);
    float4 o;
    o.x = (r[i * 4 + 0] - mu) * rstd * g4.x + b4.x; o.y = (r[i * 4 + 1] - mu) * rstd * g4.y + b4.y;
    o.z = (r[i * 4 + 2] - mu) * rstd * g4.z + b4.z; o.w = (r[i * 4 + 3] - mu) * rstd * g4.w + b4.w;
    *(float4*)(Hout + (size_t)row * D + d) = o;
    if (T) {
      const float* mt = modT + v * 6144;
      float4 sh = *(const float4*)(mt + shift_i * 1024 + d), sc = *(const float4*)(mt + scale_i * 1024 + d);
      float4 t; t.x = o.x * (1.f + sc.x) + sh.x; t.y = o.y * (1.f + sc.y) + sh.y; t.z = o.z * (1.f + sc.z) + sh.z; t.w = o.w * (1.f + sc.w) + sh.w;
      *(float4*)(T + (size_t)row * D + d) = t;
    }
  }
}

__global__ __launch_bounds__(256) void k_route(const float* __restrict__ Q, const float* __restrict__ keys, int* __restrict__ IDX, float* __restrict__ GATE) {
  __shared__ __attribute__((aligned(16))) float qs[4][1024];
  __shared__ float svs[4][2][16];
  __shared__ int sis[4][2][16];
  const int w = threadIdx.x >> 6, lane = threadIdx.x & 63, row = blockIdx.x * 4 + w;
  for (int i = lane; i < 256; i += 64) *(float4*)&qs[w][i * 4] = *(const float4*)(Q + (size_t)row * D + i * 4);
  __syncthreads();
  for (int h = 0; h < 8; ++h) {
    for (int s = 0; s < 2; ++s) {
      const float* kp = keys + (size_t)((h * 2 + s) * 128) * 64;
      const float* qp = &qs[w][(h * 2 + s) * 64];
      float v0 = 0.f, v1 = 0.f;
#pragma unroll
      for (int d = 0; d < 64; d += 4) {
        float4 k0 = *(const float4*)(kp + lane * 64 + d), k1 = *(const float4*)(kp + (lane + 64) * 64 + d), q4 = *(const float4*)(qp + d);
        v0 += q4.x * k0.x; v0 += q4.y * k0.y; v0 += q4.z * k0.z; v0 += q4.w * k0.w;
        v1 += q4.x * k1.x; v1 += q4.y * k1.y; v1 += q4.z * k1.z; v1 += q4.w * k1.w;
      }
      for (int r = 0; r < 16; ++r) {
        float bv; int bi;
        if (v0 >= v1) { bv = v0; bi = lane; } else { bv = v1; bi = lane + 64; }
#pragma unroll
        for (int off = 32; off >= 1; off >>= 1) {
          float ov = __shfl_xor(bv, off); int oi = __shfl_xor(bi, off);
          if (ov > bv || (ov == bv && oi < bi)) { bv = ov; bi = oi; }
        }
        if (lane == 0) { svs[w][s][r] = bv; sis[w][s][r] = bi; }
        if (bi == lane) v0 = -INFINITY;
        if (bi == lane + 64) v1 = -INFINITY;
      }
    }
    __syncthreads();
    float c0, c1, c2, c3;
    {
      float a = svs[w][0][lane >> 2];
      const int j0 = (lane & 3) * 4;
      c0 = a + svs[w][1][j0 + 0]; c1 = a + svs[w][1][j0 + 1]; c2 = a + svs[w][1][j0 + 2]; c3 = a + svs[w][1][j0 + 3];
    }
    float selv = 0.f; int seli = 0;
    for (int r = 0; r < 16; ++r) {
      float bv = c0; int bi = lane * 4;
      if (c1 > bv) { bv = c1; bi = lane * 4 + 1; }
      if (c2 > bv) { bv = c2; bi = lane * 4 + 2; }
      if (c3 > bv) { bv = c3; bi = lane * 4 + 3; }
#pragma unroll
      for (int off = 32; off >= 1; off >>= 1) {
        float ov = __shfl_xor(bv, off); int oi = __shfl_xor(bi, off);
        if (ov > bv || (ov == bv && oi < bi)) { bv = ov; bi = oi; }
      }
      if (lane == r) { selv = bv; seli = bi; }
      if ((bi >> 2) == lane) {
        int k = bi & 3;
        if (k == 0) c0 = -INFINITY; else if (k == 1) c1 = -INFINITY; else if (k == 2) c2 = -INFINITY; else c3 = -INFINITY;
      }
    }
    const float mx = __shfl(selv, 0);
    const float e = lane < 16 ? expf(selv - mx) : 0.f;
    const float sum = wave_sum(e);
    if (lane < 16) {
      int i1 = sis[w][0][seli >> 4], i2 = sis[w][1][seli & 15];
      IDX[(size_t)row * 128 + h * 16 + lane] = i1 * 128 + i2;
      GATE[(size_t)row * 128 + h * 16 + lane] = e / sum;
    }
    __syncthreads();
  }
}

__global__ __launch_bounds__(256) void k_peer(const float* __restrict__ T, const int* __restrict__ IDX, const float* __restrict__ GATE,
                                              const float* __restrict__ utab, const float* __restrict__ vtab, float* __restrict__ F) {
  const int row = blockIdx.x * 4 + (threadIdx.x >> 6), lane = threadIdx.x & 63;
  float4 t[4], f[4];
#pragma unroll
  for (int i = 0; i < 4; ++i) { t[i] = *(const float4*)(T + (size_t)row * D + i * 256 + lane * 4); f[i] = make_float4(0.f, 0.f, 0.f, 0.f); }
  for (int k = 0; k < 128; ++k) {
    const int e = IDX[(size_t)row * 128 + k];
    const float g = GATE[(size_t)row * 128 + k];
    const float* up = utab + (size_t)e * D + lane * 4;
    const float* vp = vtab + (size_t)e * D + lane * 4;
    float dot = 0.f;
#pragma unroll
    for (int i = 0; i < 4; ++i) { float4 u4 = *(const float4*)(up + i * 256); dot += t[i].x * u4.x + t[i].y * u4.y + t[i].z * u4.z + t[i].w * u4.w; }
    dot = wave_sum(dot);
    const float a = gelu_exact(dot) * g;
#pragma unroll
    for (int i = 0; i < 4; ++i) { float4 v4 = *(const float4*)(vp + i * 256); f[i].x += a * v4.x; f[i].y += a * v4.y; f[i].z += a * v4.z; f[i].w += a * v4.w; }
  }
#pragma unroll
  for (int i = 0; i < 4; ++i) *(float4*)(F + (size_t)row * D + i * 256 + lane * 4) = f[i];
}

__global__ __launch_bounds__(256) void k_rmsnorm(float* __restrict__ X, int ld, int ncols, const float* __restrict__ g, int nrows) {
  const int row = blockIdx.x * 4 + (threadIdx.x >> 6), lane = threadIdx.x & 63;
  if (row >= nrows) return;
  float* x = X + (size_t)row * ld;
  float s = 0.f;
  for (int i = lane; i < ncols; i += 64) { float v = x[i]; s += v * v; }
  const float r = rsqrtf(wave_sum(s) / (float)ncols + RMS_EPS);
  for (int i = lane; i < ncols; i += 64) x[i] = x[i] * r * g[i];
}
__global__ __launch_bounds__(256) void k_rope(float* __restrict__ X, int ld, int off, int hstride, int nheads, int nrows) {
  const int idx = blockIdx.x * 256 + threadIdx.x;
  const int i = idx & 31; const int rh = idx >> 5; const int head = rh % nheads; const int row = rh / nheads;
  if (row >= nrows) return;
  const int n = row & (SEQ - 1), r = n >> 6, col = n & 63;
  const float inv = powf(10000.f, -(float)(i & 15) / 16.f);
  const float ang = (i < 16 ? (float)r : (float)col) * inv;
  const float cs = cosf(ang), sn = sinf(ang);
  float* p = X + (size_t)row * ld + off + head * hstride;
  const float x1 = p[i], x2 = p[i + 32];
  p[i] = x1 * cs - x2 * sn; p[i + 32] = x2 * cs + x1 * sn;
}

__global__ __launch_bounds__(256) void k_attn(const float* __restrict__ QF, const float* __restrict__ KVU, const float* __restrict__ KV, float* __restrict__ AO) {
  __shared__ __attribute__((aligned(16))) float Qs[64][196];
  __shared__ __attribute__((aligned(16))) float Ks[32][196];
  __shared__ __attribute__((aligned(16))) float Vs[32][128];
  __shared__ float Ps[64][33];
  const int qt = blockIdx.x, h = blockIdx.y, b = blockIdx.z;
  const int tid = threadIdx.x, ty = tid >> 4, tx = tid & 15;
  for (int i = tid; i < 64 * 48; i += 256) {
    int r = i / 48, c4 = i % 48;
    *(float4*)&Qs[r][c4 * 4] = *(const float4*)(QF + (size_t)(b * SEQ + qt * 64 + r) * 1536 + h * 192 + c4 * 4);
  }
  float m[4], l[4], o[4][8];
#pragma unroll
  for (int i = 0; i < 4; ++i) { m[i] = -1e30f; l[i] = 0.f;
#pragma unroll
    for (int c = 0; c < 8; ++c) o[i][c] = 0.f; }
  const float scale = 0.07216878364870322f;
  for (int kt = 0; kt < (SEQ + CTX) / 32; ++kt) {
    __syncthreads();
    for (int i = tid; i < 32 * 48; i += 256) {
      int r = i / 48, c4 = i % 48, j = kt * 32 + r;
      int krow = j < SEQ ? b * SEQ + j : NL + b * CTX + (j - SEQ);
      float4 v = c4 < 32 ? *(const float4*)(KVU + (size_t)krow * 2048 + h * 256 + c4 * 4)
                         : *(const float4*)(KV + (size_t)krow * 320 + 256 + (c4 - 32) * 4);
      *(float4*)&Ks[r][c4 * 4] = v;
    }
    for (int i = tid; i < 32 * 32; i += 256) {
      int r = i >> 5, c4 = i & 31, j = kt * 32 + r;
      int krow = j < SEQ ? b * SEQ + j : NL + b * CTX + (j - SEQ);
      *(float4*)&Vs[r][c4 * 4] = *(const float4*)(KVU + (size_t)krow * 2048 + h * 256 + 128 + c4 * 4);
    }
    __syncthreads();
    float s[4][2] = {};
    for (int d4 = 0; d4 < 48; ++d4) {
      float4 k0 = *(const float4*)&Ks[tx * 2][d4 * 4], k1 = *(const float4*)&Ks[tx * 2 + 1][d4 * 4];
#pragma unroll
      for (int i = 0; i < 4; ++i) {
        float4 q = *(const float4*)&Qs[ty * 4 + i][d4 * 4];
        s[i][0] += q.x * k0.x + q.y * k0.y + q.z * k0.z + q.w * k0.w;
        s[i][1] += q.x * k1.x + q.y * k1.y + q.z * k1.z + q.w * k1.w;
      }
    }
#pragma unroll
    for (int i = 0; i < 4; ++i) {
      float s0 = s[i][0] * scale, s1 = s[i][1] * scale;
      float mx = fmaxf(s0, s1);
#pragma unroll
      for (int off = 8; off >= 1; off >>= 1) mx = fmaxf(mx, __shfl_xor(mx, off));
      const float mnew = fmaxf(m[i], mx);
      const float alpha = expf(m[i] - mnew);
      const float p0 = expf(s0 - mnew), p1 = expf(s1 - mnew);
      float rs = p0 + p1;
#pragma unroll
      for (int off = 8; off >= 1; off >>= 1) rs += __shfl_xor(rs, off);
      l[i] = l[i] * alpha + rs; m[i] = mnew;
#pragma unroll
      for (int c = 0; c < 8; ++c) o[i][c] *= alpha;
      Ps[ty * 4 + i][tx * 2] = p0; Ps[ty * 4 + i][tx * 2 + 1] = p1;
    }
    __syncthreads();
    for (int k = 0; k < 32; ++k) {
      float4 va = *(const float4*)&Vs[k][tx * 8], vb = *(const float4*)&Vs[k][tx * 8 + 4];
#pragma unroll
      for (int i = 0; i < 4; ++i) {
        float p = Ps[ty * 4 + i][k];
        o[i][0] += p * va.x; o[i][1] += p * va.y; o[i][2] += p * va.z; o[i][3] += p * va.w;
        o[i][4] += p * vb.x; o[i][5] += p * vb.y; o[i][6] += p * vb.z; o[i][7] += p * vb.w;
      }
    }
  }
#pragma unroll
  for (int i = 0; i < 4; ++i) {
    const float il = 1.f / l[i];
    float* dst = AO + (size_t)(b * SEQ + qt * 64 + ty * 4 + i) * D + h * 128 + tx * 8;
    *(float4*)dst = make_float4(o[i][0] * il, o[i][1] * il, o[i][2] * il, o[i][3] * il);
    *(float4*)(dst + 4) = make_float4(o[i][4] * il, o[i][5] * il, o[i][6] * il, o[i][7] * il);
  }
}

extern "C" void kernel_launch(void* const* d_in, const int* in_sizes, int n_in, void* d_out, int out_size, void* d_ws, size_t ws_size, hipStream_t stream) {
  const float* x = (const float*)d_in[0];       const float* c = (const float*)d_in[1];
  const float* ctx = (const float*)d_in[2];     const float* c_ctx = (const float*)d_in[3];
  const float* ada_w = (const float*)d_in[4];   const float* ada_b = (const float*)d_in[5];
  const float* ln_g = (const float*)d_in[6];    const float* ln_b = (const float*)d_in[7];
  const float* s5_a_re = (const float*)d_in[8]; const float* s5_a_im = (const float*)d_in[9];
  const float* s5_log_dt = (const float*)d_in[10];
  const float* s5_b_re = (const float*)d_in[11]; const float* s5_b_im = (const float*)d_in[12];
  const float* s5_c_re = (const float*)d_in[13]; const float* s5_c_im = (const float*)d_in[14];
  const float* s5_d = (const float*)d_in[15];   const float* s5_w_glu = (const float*)d_in[16];
  const float* s5_w_o = (const float*)d_in[17]; const float* mla_w_dq = (const float*)d_in[18];
  const float* mla_q_norm = (const float*)d_in[19]; const float* mla_w_uq = (const float*)d_in[20];
  const float* mla_w_dkv = (const float*)d_in[21];  const float* mla_kv_norm = (const float*)d_in[22];
  const float* mla_w_ukv = (const float*)d_in[23];  const float* mla_w_o = (const float*)d_in[24];
  const float* peer_w_q = (const float*)d_in[25];   const float* peer_keys = (const float*)d_in[26];
  const float* peer_u = (const float*)d_in[27];     const float* peer_v = (const float*)d_in[28];
  float* out = (float*)d_out;

  float* ws = (float*)d_ws;
  size_t off = 0;
  auto carve = [&](size_t n) { float* p = ws + off; off += (n + 63) / 64 * 64; return p; };
  float* MOD = carve(2 * 3 * 6144);
  float* BA = carve((size_t)NT * D);
  float* BB = carve((size_t)NT * D);
  float* BC = carve((size_t)NT * D);
  float* QF = carve((size_t)NL * 1536);
  float* KVU = carve((size_t)NT * 2048);
  float* DQ = carve((size_t)NL * 384);
  float* KV = carve((size_t)NT * 320);
  int* IDX = (int*)carve((size_t)NT * 128);
  float* GATE = carve((size_t)NT * 128);
  bf16_t* Wt_glu = (bf16_t*)carve((size_t)D * D / 2);
  bf16_t* Wt_o0 = (bf16_t*)carve((size_t)D * D / 2);
  bf16_t* Wt_q0 = (bf16_t*)carve((size_t)D * D / 2);
  bf16_t* Wt_o1 = (bf16_t*)carve((size_t)D * D / 2);
  bf16_t* Wt_q1 = (bf16_t*)carve((size_t)D * D / 2);
  bf16_t* Wt_q0lo = (bf16_t*)carve((size_t)D * D / 2);
  bf16_t* Wt_q1lo = (bf16_t*)carve((size_t)D * D / 2);
  bf16_t* Khi = (bf16_t*)carve((size_t)2 * 131072 / 2);
  bf16_t* Klo = (bf16_t*)carve((size_t)2 * 131072 / 2);
  bf16_t* Wt_cat = (bf16_t*)carve((size_t)704 * D / 2);
  bf16_t* Wt_uq = (bf16_t*)carve((size_t)1536 * 384 / 2);
  bf16_t* Wt_ukv = (bf16_t*)carve((size_t)2048 * 256 / 2);
  if (off * 4 > ws_size) { fprintf(stderr, "kernel_launch: workspace too small: need %zu have %zu\n", off * 4, ws_size); return; }
  const size_t TD = (size_t)1024 * 16384;
  bf16_t* U0 = (bf16_t*)QF;  bf16_t* V0 = U0 + TD;
  bf16_t* U1 = (bf16_t*)KVU; bf16_t* V1 = U1 + TD;

  const float* mod0 = MOD; const float* mod1 = MOD + 3 * 6144;

  k_mod<<<dim3(24, 2), 256, 0, stream>>>(c, c_ctx, ada_w, ada_b, MOD);
  k_cvt_t<<<512, 256, 0, stream>>>(s5_w_glu, Wt_glu, D, D);
  k_cvt_t<<<512, 256, 0, stream>>>(s5_w_o, Wt_o0, D, D);
  k_cvt_t<<<512, 256, 0, stream>>>(peer_w_q, Wt_q0, D, D);
  k_cvt_t<<<512, 256, 0, stream>>>(mla_w_o, Wt_o1, D, D);
  k_cvt_t<<<512, 256, 0, stream>>>(peer_w_q + (size_t)D * D, Wt_q1, D, D);
  k_cvt_t_lo<<<512, 256, 0, stream>>>(peer_w_q, Wt_q0lo, D, D);
  k_cvt_t_lo<<<512, 256, 0, stream>>>(peer_w_q + (size_t)D * D, Wt_q1lo, D, D);
  k_cvt<<<64, 256, 0, stream>>>(peer_keys, Khi, (size_t)2 * 131072 / 8);
  k_cvt_lo<<<64, 256, 0, stream>>>(peer_keys, Klo, (size_t)2 * 131072 / 8);
  k_cvt_t<<<512, 256, 0, stream>>>(mla_w_dq, Wt_cat, D, 384);
  k_cvt_t<<<512, 256, 0, stream>>>(mla_w_dkv, Wt_cat + (size_t)384 * D, D, 320);
  k_cvt_t<<<512, 256, 0, stream>>>(mla_w_uq, Wt_uq, 384, 1536);
  k_cvt_t<<<512, 256, 0, stream>>>(mla_w_ukv, Wt_ukv, 256, 2048);
  k_cvt<<<2048, 256, 0, stream>>>(peer_u, U0, TD / 8);
  k_cvt<<<2048, 256, 0, stream>>>(peer_v, V0, TD / 8);
  bf16_t* Ktab = (bf16_t*)KVU;
  bf16_t* Bst_t = Ktab + (size_t)64 * 127 * 256;
  bf16_t* Cin_t = Bst_t + (size_t)64 * 256 * 1024;
  float* Ssta = BC;
  bf16_t* HP = (bf16_t*)(BC + (size_t)NCC * 64 * 256);
  bf16_t* Gbf = (bf16_t*)DQ;
  k_s5_prep<<<64, 512, 0, stream>>>(s5_a_re, s5_a_im, s5_log_dt, s5_b_re, s5_b_im, s5_c_re, s5_c_im, Ktab, Bst_t, Cin_t);
  k_s5_p1<<<256, 512, 0, stream>>>(x, ctx, mod0, Ktab, Bst_t, BB  , Ssta);
  k_s5_carry<<<256, 64, 0, stream>>>(Ssta, s5_a_re, s5_a_im, s5_log_dt, HP);
  k_s5_p3<<<256, 512, 0, stream>>>(x, ctx, mod0, s5_d, HP, Cin_t, BB, Gbf);
  bf16_t* Vbf = (bf16_t*)BC;
  bf16_t* Tbf = Vbf + (size_t)NT * D;
  {
    ChainP p{Gbf, Wt_glu, Wt_o0, Wt_q0, Vbf, BA  , x, ctx, mod0, ln_g, ln_b, BB  , Tbf, BA  , Wt_q0lo, (bf16_t*)(KVU + (size_t)20 * 1024 * 1024)  };
    k_chainA<true><<<256, 512, 0, stream>>>(p);
  }
  k_route_fast<<<256, 512, 0, stream>>>(RouteP{BA, Khi, Klo, IDX, GATE, 66, 0});
  k_gather<<<256, 512, 0, stream>>>(Tbf, IDX, GATE, U0, V0, BA, 66);
  k_ln_resid<<<NT / 4, 256, 0, stream>>>(BB, BB + (size_t)NL * D, BA, mod0, 5, ln_g + D, ln_b + D, BC, BB, mod1, 0, 1, NT);
  bf16_t* M1bf = (bf16_t*)BA;
  k_cvt<<<2048, 256, 0, stream>>>(BB, M1bf, (size_t)NT * D / 8);
  float* PR = DQ;
  bf16_t* Qa = (bf16_t*)BB;
  bf16_t* Ka = (bf16_t*)KVU; bf16_t* Va = Ka + (size_t)NB * 8 * KEYS * 192;
  {
    ProjP p{M1bf, Wt_cat, Wt_uq, Wt_ukv, mla_q_norm, mla_kv_norm, PR, QF  , Qa, Ka, Va};
    k_mla_proj<<<256, 512, 0, stream>>>(p);
  }
  bf16_t* AObf = (bf16_t*)QF;
  k_attn_mfma<<<256, 512, 0, stream>>>(Qa, Ka, Va, AObf);
  k_cvt<<<2048, 256, 0, stream>>>(peer_u + TD, U1, TD / 8);
  k_cvt<<<2048, 256, 0, stream>>>(peer_v + TD, V1, TD / 8);
  bf16_t* Tbf1 = (bf16_t*)DQ;
  {
    ChainP p{AObf, nullptr, Wt_o1, Wt_q1, nullptr, BB  , BC  , BC + (size_t)NL * D, mod1, ln_g + 2 * D, ln_b + 2 * D, BA  , Tbf1, BB  , Wt_q1lo, (bf16_t*)(KVU + (size_t)20 * 1024 * 1024)  };
    k_chainA<false><<<256, 512, 0, stream>>>(p);
  }
  k_route_fast<<<256, 512, 0, stream>>>(RouteP{BB, Khi + 131072, Klo + 131072, IDX, GATE, 64, 0});
  k_gather<<<256, 512, 0, stream>>>(Tbf1, IDX, GATE, U1, V1, BC, 64);
  k_ln_resid<<<NL / 4, 256, 0, stream>>>(BA, BA + (size_t)NL * D, BC, mod1, 5, ln_g + 3 * D, ln_b + 3 * D, out, nullptr, mod1, 0, 0, NL);
}
```

```cpp
#include <hip/hip_runtime.h>
#include <math.h>
#include <hip/hip_cooperative_groups.h>
#include <cstdio>
namespace cg = cooperative_groups;
__device__ __forceinline__ int otid() { int t = (int)__builtin_amdgcn_workitem_id_x(); asm volatile("" : "+v"(t)); return t; }

constexpr int D = 1024, NB = 2, SEQ = 8192, CTX = 256;
constexpr int NL = NB * SEQ, NC = NB * CTX, NT = NL + NC;
constexpr float ALPHA = 1.4142135623730951f;
constexpr float LN_EPS = 1e-5f, RMS_EPS = 1e-6f;

__device__ __forceinline__ float wave_sum(float v) {
#pragma unroll
  for (int o = 32; o >= 1; o >>= 1) v += __shfl_xor(v, o);
  return v;
}
__device__ __forceinline__ int row_vec(int row) { return row < NL ? (row >> 13) : 2; }
__device__ __forceinline__ float gelu_exact(float x) { return 0.5f * x * (1.f + erff(x * 0.70710678118654752f)); }


typedef unsigned short bf16_t;
using bf16x8 = __attribute__((ext_vector_type(8))) short;
using f32x4 = __attribute__((ext_vector_type(4))) float;
__device__ __forceinline__ bf16_t f2bf(float f) { unsigned u = __float_as_uint(f); u += 0x7FFFu + ((u >> 16) & 1u); return (bf16_t)(u >> 16); }
__device__ __forceinline__ float bf2f(bf16_t h) { return __uint_as_float(((unsigned)h) << 16); }
__device__ __forceinline__ unsigned pack2bf(float lo, float hi) { return (unsigned)f2bf(lo) | ((unsigned)f2bf(hi) << 16); }
__device__ __forceinline__ float bflo(unsigned w) { return __uint_as_float(w << 16); }
__device__ __forceinline__ float bfhi(unsigned w) { return __uint_as_float(w & 0xFFFF0000u); }


constexpr int LDA_B = 1024 * 2 + 16;
template <int RT>
__device__ __forceinline__ void gemm_unit(const char* const (&ap)[RT], const bf16_t* __restrict__ w0, const bf16_t* __restrict__ w1, int kmul, int K, f32x4 (&acc)[RT][2]) {
#pragma unroll
  for (int t = 0; t < RT; ++t) { acc[t][0] = f32x4{0.f, 0.f, 0.f, 0.f}; acc[t][1] = f32x4{0.f, 0.f, 0.f, 0.f}; }
  bf16x8 bc[4][2], bn[4][2];
#pragma unroll
  for (int s2 = 0; s2 < 4; ++s2) { bc[s2][0] = *(const bf16x8*)(w0 + (s2 * 32) * kmul); bc[s2][1] = *(const bf16x8*)(w1 + (s2 * 32) * kmul); bn[s2][0] = bc[s2][0]; bn[s2][1] = bc[s2][1]; }
#pragma unroll 1
  for (int kb = 0; kb < K; kb += 128) {
    if (kb + 128 < K) {
#pragma unroll
      for (int s2 = 0; s2 < 4; ++s2) { bn[s2][0] = *(const bf16x8*)(w0 + (kb + 128 + s2 * 32) * kmul); bn[s2][1] = *(const bf16x8*)(w1 + (kb + 128 + s2 * 32) * kmul); }
    }
#pragma unroll
    for (int s2 = 0; s2 < 4; ++s2) {
#pragma unroll
      for (int t = 0; t < RT; ++t) {
        const bf16x8 a = *(const bf16x8*)(ap[t] + (kb + s2 * 32) * 2);
        acc[t][0] = __builtin_amdgcn_mfma_f32_16x16x32_bf16(a, bc[s2][0], acc[t][0], 0, 0, 0);
        acc[t][1] = __builtin_amdgcn_mfma_f32_16x16x32_bf16(a, bc[s2][1], acc[t][1], 0, 0, 0);
      }
    }
#pragma unroll
    for (int s2 = 0; s2 < 4; ++s2) { bc[s2][0] = bn[s2][0]; bc[s2][1] = bn[s2][1]; }
  }
}
template <int RT, class Epi>
__device__ __forceinline__ void gemm_ldsA(const char* As, int lda_b, int nrows, const bf16_t* __restrict__ Wt, int K, int N, Epi epi) {
  const int wave = otid() >> 6, lane = otid() & 63, l15 = lane & 15, q = lane >> 4;
  const char* ap[RT];
#pragma unroll
  for (int t = 0; t < RT; ++t) { int r = t * 16 + l15; r = r < nrows ? r : nrows - 1; ap[t] = As + r * lda_b + q * 16; }
#pragma unroll 1
  for (int unit = wave; unit < (N >> 5); unit += 8) {
    const int n0 = unit * 32;
    const bf16_t* w0 = Wt + (size_t)(n0 + l15) * K + q * 8;
    f32x4 acc[RT][2];
    gemm_unit<RT>(ap, w0, w0 + (size_t)16 * K, 1, K, acc);
#pragma unroll
    for (int t = 0; t < RT; ++t)
#pragma unroll
      for (int j = 0; j < 2; ++j)
#pragma unroll
        for (int r = 0; r < 4; ++r) {
          const int row = t * 16 + q * 4 + r, col = n0 + j * 16 + l15;
          if (row < nrows) epi(row, col, acc[t][j][r]);
        }
  }
}
struct EpiF32 { float* C; int ldc; __device__ __forceinline__ void operator()(int row, int col, float v) const { C[(size_t)row * ldc + col] = v; } };
struct EpiAddF32 { float* C; int ldc; __device__ __forceinline__ void operator()(int row, int col, float v) const { C[(size_t)row * ldc + col] += v; } };
struct EpiGluL { const char* As; bf16_t* V; __device__ __forceinline__ void operator()(int row, int col, float z) const {
  const float g = bf2f(*(const bf16_t*)(As + row * LDA_B + col * 2)); V[(size_t)row * D + col] = f2bf(g / (1.f + expf(-z))); } };

__device__ __forceinline__ void load_rows_lds(char* As, const bf16_t* __restrict__ src, int nrows) {
  for (int i = otid(); i < nrows * 128; i += 512) {
    const int r = i >> 7, c = i & 127;
    *(uint4*)(As + r * LDA_B + c * 16) = *(const uint4*)(src + (size_t)r * D + c * 8);
  }
}
__device__ __forceinline__ void ln_rows(char* As, int g0, int nrows, const float* Hl, const float* Hc, const float* __restrict__ O,
                                        const float* __restrict__ mod, int gate_i, const float* __restrict__ lng, const float* __restrict__ lnb,
                                        float* Hout, bf16_t* __restrict__ Tbf, int shift_i, int scale_i, bf16_t* __restrict__ Tlo) {
  const int wave = otid() >> 6, lane = otid() & 63;
  for (int rr = wave; rr < nrows; rr += 8) {
    const int row = g0 + rr;
    const float* hin = row < NL ? Hl + (size_t)row * D : Hc + (size_t)(row - NL) * D;
    const float* f = O + (size_t)row * D;
    const float* m = mod + row_vec(row) * 6144;
    const float* gm = m + gate_i * 1024;
    float r[16]; float s = 0.f;
#pragma unroll
    for (int i = 0; i < 4; ++i) {
      const int d = i * 256 + lane * 4;
      float4 h4 = *(const float4*)(hin + d), f4 = *(const float4*)(f + d), g4 = *(const float4*)(gm + d);
      r[i * 4 + 0] = ALPHA * h4.x + g4.x * f4.x; r[i * 4 + 1] = ALPHA * h4.y + g4.y * f4.y;
      r[i * 4 + 2] = ALPHA * h4.z + g4.z * f4.z; r[i * 4 + 3] = ALPHA * h4.w + g4.w * f4.w;
      s += r[i * 4 + 0] + r[i * 4 + 1] + r[i * 4 + 2] + r[i * 4 + 3];
    }
    const float mu = wave_sum(s) * (1.f / D);
    float vs = 0.f;
#pragma unroll
    for (int i = 0; i < 16; ++i) { float dlt = r[i] - mu; vs += dlt * dlt; }
    const float rstd = rsqrtf(wave_sum(vs) * (1.f / D) + LN_EPS);
#pragma unroll
    for (int i = 0; i < 4; ++i) {
      const int d = i * 256 + lane * 4;
      float4 g4 = *(const float4*)(lng + d), b4 = *(const float4*)(lnb + d);
      float4 o;
      o.x = (r[i * 4 + 0] - mu) * rstd * g4.x + b4.x; o.y = (r[i * 4 + 1] - mu) * rstd * g4.y + b4.y;
      o.z = (r[i * 4 + 2] - mu) * rstd * g4.z + b4.z; o.w = (r[i * 4 + 3] - mu) * rstd * g4.w + b4.w;
      *(float4*)(Hout + (size_t)row * D + d) = o;
      float4 sh = *(const float4*)(m + shift_i * 1024 + d), sc = *(const float4*)(m + scale_i * 1024 + d);
      const float t0 = o.x * (1.f + sc.x) + sh.x, t1 = o.y * (1.f + sc.y) + sh.y, t2 = o.z * (1.f + sc.z) + sh.z, t3 = o.w * (1.f + sc.w) + sh.w;
      uint2 w; w.x = pack2bf(t0, t1); w.y = pack2bf(t2, t3);
      *(uint2*)(As + rr * LDA_B + d * 2) = w;
      *(uint2*)(Tbf + (size_t)row * D + d) = w;
      uint2 wl; wl.x = pack2bf(t0 - bflo(w.x), t1 - bfhi(w.x)); wl.y = pack2bf(t2 - bflo(w.y), t3 - bfhi(w.y));
      *(uint2*)(Tlo + (size_t)row * D + d) = wl;
    }
  }
}


constexpr int S5T = 64, NCHUNK = (CTX + SEQ) / S5T  , NCC = NB * NCHUNK  ;
__device__ __forceinline__ int s5_token(int cc, int s) {
  const int b = cc / NCHUNK, ch = cc - b * NCHUNK;
  return ch < 4 ? NL + b * CTX + ch * S5T + s : b * SEQ + (ch - 4) * S5T + s;
}
__device__ __forceinline__ void ph_s5_prep(const float* __restrict__ a_re, const float* __restrict__ a_im, const float* __restrict__ log_dt,
                                                 const float* __restrict__ b_re, const float* __restrict__ b_im, const float* __restrict__ c_re, const float* __restrict__ c_im,
                                                 bf16_t* __restrict__ Ktab, bf16_t* __restrict__ Bst_t, bf16_t* __restrict__ Cin_t, int g, char* lds) {
  float2 (*pw)[65][64] = reinterpret_cast<float2 (*)[65][64]>(lds);
  float2 (*Bp)[64][16] = reinterpret_cast<float2 (*)[64][16]>(lds + 2 * 65 * 64 * 8);
  float2 (*Cc)[16][64] = reinterpret_cast<float2 (*)[16][64]>(lds + 2 * 65 * 64 * 8 + 2 * 64 * 16 * 8);
  const int tid = otid();
  if (tid < 128) {
    const int dir = tid >> 6, p = tid & 63, gp = (dir * 64 + g) * 64 + p;
    const float are = a_re[gp], aim = a_im[gp], dt = expf(log_dt[dir * 64 + g]);
    const float mag = expf(are * dt);
    const float abr = mag * cosf(aim * dt), abi = mag * sinf(aim * dt);
    const float nr = abr - 1.f, ni = abi, den = are * are + aim * aim;
    const float fr = (nr * are + ni * aim) / den, fi = (ni * are - nr * aim) / den;
    float pr = 1.f, pi = 0.f;
    for (int e = 0; e <= 64; ++e) { pw[dir][e][p] = make_float2(pr, pi); const float nr2 = pr * abr - pi * abi, ni2 = pr * abi + pi * abr; pr = nr2; pi = ni2; }
    for (int ci = 0; ci < 16; ++ci) { const float br = b_re[gp * 16 + ci], bi = b_im[gp * 16 + ci]; Bp[dir][p][ci] = make_float2(fr * br - fi * bi, fr * bi + fi * br); }
    for (int co = 0; co < 16; ++co) { const int idx = ((dir * 64 + g) * 16 + co) * 64 + p; Cc[dir][co][p] = make_float2(c_re[idx], c_im[idx]); }
  }
  __syncthreads();
  for (int i = tid; i < 127 * 256; i += 512) {
    const int ti = i >> 8, co = (i >> 4) & 15, ci = i & 15, tau = ti - 63;
    float acc = 0.f;
    if (tau >= 0) { for (int p = 0; p < 64; ++p) { const float2 c = Cc[0][co][p], w = pw[0][tau][p], b = Bp[0][p][ci];
        const float xr = c.x * w.x - c.y * w.y, xi = c.x * w.y + c.y * w.x; acc += xr * b.x - xi * b.y; } }
    if (tau <= 0) { for (int p = 0; p < 64; ++p) { const float2 c = Cc[1][co][p], w = pw[1][-tau][p], b = Bp[1][p][ci];
        const float xr = c.x * w.x - c.y * w.y, xi = c.x * w.y + c.y * w.x; acc += xr * b.x - xi * b.y; } }
    Ktab[(size_t)g * 127 * 256 + i] = f2bf(acc);
  }
  for (int i = tid; i < 256 * 128; i += 512) {
    const int n = i >> 7, k8 = i & 127, dir = n >> 7, c = (n >> 6) & 1, p = n & 63, sidx = k8 >> 1, ci0 = (k8 & 1) * 8;
    const float2 w = pw[dir][dir == 0 ? 63 - sidx : sidx][p];
    float v[8];
#pragma unroll
    for (int j = 0; j < 8; ++j) { const float2 b = Bp[dir][p][ci0 + j]; v[j] = c == 0 ? (w.x * b.x - w.y * b.y) : (w.x * b.y + w.y * b.x); }
    uint4 o; o.x = pack2bf(v[0], v[1]); o.y = pack2bf(v[2], v[3]); o.z = pack2bf(v[4], v[5]); o.w = pack2bf(v[6], v[7]);
    *(uint4*)(Bst_t + ((size_t)g * 256 + n) * 1024 + k8 * 8) = o;
  }
  for (int i = tid; i < 1024 * 32; i += 512) {
    const int n = i >> 5, k8 = i & 31, t = n >> 4, co = n & 15, dir = k8 >> 4, c = (k8 >> 3) & 1, p0 = (k8 & 7) * 8;
    const int e = dir == 0 ? t + 1 : 64 - t;
    float v[8];
#pragma unroll
    for (int j = 0; j < 8; ++j) { const float2 cc = Cc[dir][co][p0 + j], w = pw[dir][e][p0 + j];
      v[j] = c == 0 ? (cc.x * w.x - cc.y * w.y) : -(cc.x * w.y + cc.y * w.x); }
    uint4 o; o.x = pack2bf(v[0], v[1]); o.y = pack2bf(v[2], v[3]); o.z = pack2bf(v[4], v[5]); o.w = pack2bf(v[6], v[7]);
    *(uint4*)(Cin_t + ((size_t)g * 1024 + n) * 256 + k8 * 8) = o;
  }
}
__device__ __forceinline__ void ph_s5_p1(const float* __restrict__ x, const float* __restrict__ ctx, const float* __restrict__ mod,
                                               const bf16_t* __restrict__ Ktab, const bf16_t* __restrict__ Bst_t, float* __restrict__ Ypart, float* __restrict__ S, int bid, char* As) {
  const int g = bid >> 2, cc0 = (bid & 3) * 66, tid = otid();
  const int wave = tid >> 6, lane = tid & 63, l15 = lane & 15, q = lane >> 4;
  for (int i = tid; i < 66 * 64 * 2; i += 512) {
    const int half = i & 1, sidx = (i >> 1) & 63, r = i >> 7;
    const int tok = s5_token(cc0 + r, sidx), ch = g * 16 + half * 8;
    const float* src = (tok < NL ? x + (size_t)tok * D : ctx + (size_t)(tok - NL) * D) + ch;
    const float* m = mod + row_vec(tok) * 6144;
    const float4 a = *(const float4*)src, b = *(const float4*)(src + 4);
    const float4 sh0 = *(const float4*)(m + ch), sh1 = *(const float4*)(m + ch + 4), sc0 = *(const float4*)(m + 1024 + ch), sc1 = *(const float4*)(m + 1024 + ch + 4);
    uint4 o;
    o.x = pack2bf(a.x * (1.f + sc0.x) + sh0.x, a.y * (1.f + sc0.y) + sh0.y); o.y = pack2bf(a.z * (1.f + sc0.z) + sh0.z, a.w * (1.f + sc0.w) + sh0.w);
    o.z = pack2bf(b.x * (1.f + sc1.x) + sh1.x, b.y * (1.f + sc1.y) + sh1.y); o.w = pack2bf(b.z * (1.f + sc1.z) + sh1.z, b.w * (1.f + sc1.w) + sh1.w);
    *(uint4*)(As + r * LDA_B + sidx * 32 + half * 16) = o;
  }
  __syncthreads();
  const char* ap[5];
#pragma unroll
  for (int t = 0; t < 5; ++t) { int r = t * 16 + l15; r = r < 66 ? r : 65; ap[t] = As + r * LDA_B + q * 16; }
  const bf16_t* Kg = Ktab + (size_t)g * 127 * 256;
#pragma unroll 1
  for (int unit = wave; unit < 40; unit += 8) {
    f32x4 acc[5][2];
    if (unit < 32) {
      const int t0 = unit * 2;
      const bf16_t* w0 = Kg + (t0 + 63 - (q >> 1)) * 256 + l15 * 16 + (q & 1) * 8;
      gemm_unit<5>(ap, w0, w0 + 256, -16, 1024, acc);
#pragma unroll
      for (int t = 0; t < 5; ++t)
#pragma unroll
        for (int j = 0; j < 2; ++j)
#pragma unroll
          for (int r = 0; r < 4; ++r) {
            const int row = t * 16 + q * 4 + r;
            if (row < 66) Ypart[(size_t)s5_token(cc0 + row, t0 + j) * D + g * 16 + l15] = acc[t][j][r];
          }
    } else {
      const int n0 = (unit - 32) * 32;
      const bf16_t* w0 = Bst_t + ((size_t)g * 256 + n0 + l15) * 1024 + q * 8;
      gemm_unit<5>(ap, w0, w0 + 16 * 1024, 1, 1024, acc);
#pragma unroll
      for (int t = 0; t < 5; ++t)
#pragma unroll
        for (int j = 0; j < 2; ++j)
#pragma unroll
          for (int r = 0; r < 4; ++r) {
            const int row = t * 16 + q * 4 + r;
            if (row < 66) S[((size_t)(cc0 + row) * 64 + g) * 256 + n0 + j * 16 + l15] = acc[t][j][r];
          }
    }
  }
}
__device__ __forceinline__ void ph_s5_carry(const float* __restrict__ S, const float* __restrict__ a_re, const float* __restrict__ a_im,
                                                 const float* __restrict__ log_dt, bf16_t* __restrict__ HP, int id, int p) {
  const int dir = id & 1, g = (id >> 1) & 63, b = id >> 7;
  const int gp = (dir * 64 + g) * 64 + p;
  const float are = a_re[gp], aim = a_im[gp], dt = expf(log_dt[dir * 64 + g]);
  const float mag = expf(are * dt);
  float tr = mag * cosf(aim * dt), ti = mag * sinf(aim * dt);
#pragma unroll
  for (int i = 0; i < 6; ++i) { const float nr = tr * tr - ti * ti, ni = 2.f * tr * ti; tr = nr; ti = ni; }
  float hr = 0.f, hi = 0.f;
#pragma unroll 4
  for (int step = 0; step < NCHUNK; ++step) {
    const int c = dir == 0 ? step : (step < 4 ? 3 - step : NCHUNK - 1 - (step - 4));
    const size_t base = ((size_t)(b * NCHUNK + c) * 64 + g) * 256 + dir * 128 + p;
    HP[base] = f2bf(hr); HP[base + 64] = f2bf(hi);
    const float sr = S[base], si = S[base + 64];
    const float nr = tr * hr - ti * hi + sr, ni = tr * hi + ti * hr + si;
    hr = nr; hi = ni;
  }
}
struct EpiS5 { const float* x; const float* ctx; const float* mod; const float* dvec; const float* Ypart; bf16_t* Gbf; int cc0; int g;
  __device__ __forceinline__ void operator()(int row, int col, float v) const {
    const int tok = s5_token(cc0 + row, col >> 4), ch = g * 16 + (col & 15);
    const float* m = mod + row_vec(tok) * 6144;
    const float xin = tok < NL ? x[(size_t)tok * D + ch] : ctx[(size_t)(tok - NL) * D + ch];
    const float mm = xin * (1.f + m[1024 + ch]) + m[ch];
    const float y = v + Ypart[(size_t)tok * D + ch] + dvec[ch] * mm;
    Gbf[(size_t)tok * D + ch] = f2bf(gelu_exact(y));
  } };
__device__ __forceinline__ void ph_s5_p3(const float* __restrict__ x, const float* __restrict__ ctx, const float* __restrict__ mod, const float* __restrict__ dvec,
                                               const bf16_t* __restrict__ HP, const bf16_t* __restrict__ Cin_t, const float* __restrict__ Ypart, bf16_t* __restrict__ Gbf, int bid, char* As) {
  const int g = bid >> 2, cc0 = (bid & 3) * 66, tid = otid();
  for (int i = tid; i < 66 * 32; i += 512) {
    const int r = i >> 5, c = i & 31;
    *(uint4*)(As + r * 528 + c * 16) = *(const uint4*)(HP + ((size_t)(cc0 + r) * 64 + g) * 256 + c * 8);
  }
  __syncthreads();
  gemm_ldsA<5>(As, 528, 66, Cin_t + (size_t)g * 1024 * 256, 256, 1024, EpiS5{x, ctx, mod, dvec, Ypart, Gbf, cc0, g});
}


struct ChainP {
  const bf16_t* Ain;
  const bf16_t* Wglu_t; const bf16_t* Wo_t; const bf16_t* Wq_t;
  bf16_t* Vbf; float* O; const float* Hl; const float* Hc; const float* mod; const float* lng; const float* lnb;
  float* Hout; bf16_t* Tbf; float* Q; const bf16_t* Wq_lo; bf16_t* Tlo;
};
template <bool L0>
__device__ __forceinline__ void ph_chainA(const ChainP& p, int bid, char* As) {
  constexpr int NR = L0 ? 66 : 64;
  constexpr int RT = L0 ? 5 : 4;
  const int g0 = bid * NR;
  load_rows_lds(As, p.Ain + (size_t)g0 * D, NR);
  __syncthreads();
  if (L0) {
    gemm_ldsA<RT>(As, LDA_B, NR, p.Wglu_t, D, D, EpiGluL{As, p.Vbf + (size_t)g0 * D});
    __syncthreads();
    load_rows_lds(As, p.Vbf + (size_t)g0 * D, NR);
    __syncthreads();
  }
  gemm_ldsA<RT>(As, LDA_B, NR, p.Wo_t, D, D, EpiF32{p.O + (size_t)g0 * D, D});
  __syncthreads();
  ln_rows(As, g0, NR, p.Hl, p.Hc, p.O, p.mod, 2, p.lng, p.lnb, p.Hout, p.Tbf, 3, 4, p.Tlo);
  __syncthreads();
  gemm_ldsA<RT>(As, LDA_B, NR, p.Wq_t, D, D, EpiF32{p.Q + (size_t)g0 * D, D});
  gemm_ldsA<RT>(As, LDA_B, NR, p.Wq_lo, D, D, EpiAddF32{p.Q + (size_t)g0 * D, D});
  __syncthreads();
  load_rows_lds(As, p.Tlo + (size_t)g0 * D, NR);
  __syncthreads();
  gemm_ldsA<RT>(As, LDA_B, NR, p.Wq_t, D, D, EpiAddF32{p.Q + (size_t)g0 * D, D});
}


constexpr int KEYS = SEQ + CTX;
struct EpiKV { bf16_t* Kn; bf16_t* Va; int g0; int pad; __device__ __forceinline__ void operator()(int row, int col, float v) const {
  const int g = g0 + row; int b, key;
  if (g < NL) { b = g >> 13; key = g & (SEQ - 1); } else { const int cidx = g - NL; b = cidx >> 8; key = SEQ + (cidx & (CTX - 1)); }
  const int head = col >> 8, j = col & 255;
  if (j < 128) Kn[((size_t)(b * 8 + head) * KEYS + key) * 128 + j] = f2bf(v);
  else Va[((size_t)(b * 8 + head) * KEYS + key) * 128 + (j - 128)] = f2bf(v);
} };
struct EpiQ { bf16_t* Qa; int g0; int pad; __device__ __forceinline__ void operator()(int row, int col, float v) const {
  const int g = g0 + row, b = g >> 13, n = g & (SEQ - 1);
  const int head = col / 192, j = col - head * 192;
  Qa[((size_t)(b * 8 + head) * SEQ + n) * 192 + j] = f2bf(v);
} };
struct ProjP { const bf16_t* Wcat_t; const bf16_t* Wuq_t; const bf16_t* Wukv_t; const float* q_norm; const float* kv_norm;
               float* PR; bf16_t* Qa; bf16_t* Kn; bf16_t* Kr; bf16_t* Va; };
__device__ __forceinline__ void ph_mla_proj(const ProjP& p, int bid, char* As) {
  const int g0 = bid * 66, wave = otid() >> 6, lane = otid() & 63;
  gemm_ldsA<5>(As, LDA_B, 66, p.Wcat_t, D, 704, EpiF32{p.PR + (size_t)g0 * D, D});
  __syncthreads();
  char* A1 = As; char* A2 = As + 66 * 784;
  for (int rr = wave; rr < 66; rr += 8) {
    const int g = g0 + rr;
    const float* pr = p.PR + (size_t)g * D;
    float v[6]; float ss = 0.f;
#pragma unroll
    for (int i = 0; i < 6; ++i) { v[i] = pr[i * 64 + lane]; ss += v[i] * v[i]; }
    float rn = rsqrtf(wave_sum(ss) * (1.f / 384.f) + RMS_EPS);
#pragma unroll
    for (int i = 0; i < 6; ++i) *(bf16_t*)(A1 + rr * 784 + (i * 64 + lane) * 2) = f2bf(v[i] * rn * p.q_norm[i * 64 + lane]);
    float w[4]; ss = 0.f;
#pragma unroll
    for (int i = 0; i < 4; ++i) { w[i] = pr[384 + i * 64 + lane]; ss += w[i] * w[i]; }
    rn = rsqrtf(wave_sum(ss) * (1.f / 256.f) + RMS_EPS);
#pragma unroll
    for (int i = 0; i < 4; ++i) *(bf16_t*)(A2 + rr * 528 + (i * 64 + lane) * 2) = f2bf(w[i] * rn * p.kv_norm[i * 64 + lane]);
    if (lane < 32) {
      float x1 = pr[640 + lane], x2 = pr[672 + lane];
      int b, key;
      if (g < NL) {
        b = g >> 13; key = g & (SEQ - 1);
        const int n = key, rr2 = n >> 6, cc = n & 63;
        const float inv = powf(10000.f, -(float)(lane & 15) / 16.f);
        const float ang = (lane < 16 ? (float)rr2 : (float)cc) * inv;
        const float cs = cosf(ang), sn = sinf(ang);
        const float y1 = x1 * cs - x2 * sn, y2 = x2 * cs + x1 * sn; x1 = y1; x2 = y2;
      } else { const int cidx = g - NL; b = cidx >> 8; key = SEQ + (cidx & (CTX - 1)); }
      bf16_t* kp = p.Kr + ((size_t)b * KEYS + key) * 64;
      kp[lane] = f2bf(x1); kp[32 + lane] = f2bf(x2);
    }
  }
  __syncthreads();
  int nq = NL - g0; nq = nq > 66 ? 66 : nq;
  if (nq > 0) gemm_ldsA<5>(A1, 784, nq, p.Wuq_t, 384, 1536, EpiQ{p.Qa, g0, 0});
  gemm_ldsA<5>(A2, 528, 66, p.Wukv_t, 256, 2048, EpiKV{p.Kn, p.Va, g0, 0});
  __syncthreads();
  for (int rr = wave; rr < nq; rr += 8) {
    const int g = g0 + rr, b = g >> 13, n = g & (SEQ - 1);
    if (lane < 32) {
      const float inv = powf(10000.f, -(float)(lane & 15) / 16.f);
      const float ang = (lane < 16 ? (float)(n >> 6) : (float)(n & 63)) * inv;
      const float cs = cosf(ang), sn = sinf(ang);
#pragma unroll
      for (int h = 0; h < 8; ++h) {
        bf16_t* qo = p.Qa + ((size_t)(b * 8 + h) * SEQ + n) * 192;
        const float x1 = bf2f(qo[128 + lane]), x2 = bf2f(qo[160 + lane]);
        qo[128 + lane] = f2bf(x1 * cs - x2 * sn); qo[160 + lane] = f2bf(x2 * cs + x1 * sn);
      }
    }
  }
}

namespace att {
using s16x4 = __attribute__((ext_vector_type(4))) short;
using f32x16 = __attribute__((ext_vector_type(16))) float;
using u32x4 = __attribute__((ext_vector_type(4))) unsigned;
constexpr int KVBLK = 64, KROW = 400;
constexpr float SCALE = 0.07216878364870322f;
constexpr float THR = 8.f;
constexpr int SHM_V = KVBLK * 128 * 2, SHM_K = KVBLK * KROW, QRROW = 208, SHM_QR = 256 * QRROW, SHM_ATTN = 2 * SHM_V + 2 * SHM_K + 8 * 64 * 4 + SHM_QR;
#define SBAR() __builtin_amdgcn_sched_barrier(0)
__device__ __forceinline__ int crow(int r, int hi) { return (r & 3) + 8 * (r >> 2) + 4 * hi; }
__device__ __forceinline__ unsigned cvtpk(float lo, float hi) { unsigned r; asm volatile("v_cvt_pk_bf16_f32 %0, %1, %2" : "=v"(r) : "v"(lo), "v"(hi)); return r; }
__device__ __forceinline__ void partialSM(f32x16& p0, f32x16& p1, float& m_reg, float& mn, float& alpha) {
  constexpr float C = SCALE * 1.4426950408889634f;
  float pmax = p0[0];
#pragma unroll
  for (int r = 1; r < 16; ++r) pmax = fmaxf(pmax, p0[r]);
#pragma unroll
  for (int r = 0; r < 16; ++r) pmax = fmaxf(pmax, p1[r]);
  { auto rr = __builtin_amdgcn_permlane32_swap(__float_as_uint(pmax), __float_as_uint(pmax), false, false);
    pmax = fmaxf(__uint_as_float(rr[0]), __uint_as_float(rr[1])); }
  if (__builtin_expect(__all(pmax - m_reg <= THR / SCALE), 1)) { mn = m_reg; alpha = 1.f; }
  else { mn = fmaxf(m_reg, pmax); alpha = __builtin_amdgcn_exp2f((m_reg - mn) * C); m_reg = mn; }
  const float mnC = -mn * C;
#pragma unroll
  for (int r = 0; r < 16; ++r) p0[r] = fmaf(p0[r], C, mnC);
#pragma unroll
  for (int r = 0; r < 16; ++r) p1[r] = fmaf(p1[r], C, mnC);
#pragma unroll
  for (int r = 0; r < 16; ++r) p0[r] = __builtin_amdgcn_exp2f(p0[r]);
}
__device__ __forceinline__ void finishSM(f32x16& p0, f32x16& p1, float alpha, float& l_reg, bf16x8& pa0, bf16x8& pa1, bf16x8& pa2, bf16x8& pa3) {
#pragma unroll
  for (int r = 0; r < 16; ++r) p1[r] = __builtin_amdgcn_exp2f(p1[r]);
  float ps = 0;
#pragma unroll
  for (int r = 0; r < 16; ++r) ps += p0[r];
#pragma unroll
  for (int r = 0; r < 16; ++r) ps += p1[r];
  { auto rr = __builtin_amdgcn_permlane32_swap(__float_as_uint(ps), __float_as_uint(ps), false, false);
    ps = __uint_as_float(rr[0]) + __uint_as_float(rr[1]); }
  l_reg = l_reg * alpha + ps;
#define PK4(P, BASE, OUT) do { unsigned a0 = cvtpk(P[BASE + 0], P[BASE + 1]), a1 = cvtpk(P[BASE + 2], P[BASE + 3]);   \
    unsigned b0 = cvtpk(P[BASE + 4], P[BASE + 5]), b1 = cvtpk(P[BASE + 6], P[BASE + 7]);                              \
    auto r0 = __builtin_amdgcn_permlane32_swap(a0, b0, false, false); auto r1 = __builtin_amdgcn_permlane32_swap(a1, b1, false, false); \
    u32x4 w = {r0[0], r1[0], r0[1], r1[1]}; OUT = *reinterpret_cast<bf16x8*>(&w); } while (0)
  PK4(p0, 0, pa0); PK4(p0, 8, pa1); PK4(p1, 0, pa2); PK4(p1, 8, pa3);
#undef PK4
}
__device__ __forceinline__ void qkt(f32x16& p0, f32x16& p1, const char* Ks, const bf16x8* qr, const char* qrl, int r32, int hi) {
  p0 = f32x16{}; p1 = f32x16{};
#pragma unroll
  for (int d0 = 0; d0 < 12; ++d0) { const int cb = (d0 * 16 + hi * 8) * 2;
    bf16x8 b0 = *reinterpret_cast<const bf16x8*>(Ks + r32 * KROW + cb);
    bf16x8 b1 = *reinterpret_cast<const bf16x8*>(Ks + (32 + r32) * KROW + cb);
    const bf16x8 qv = d0 < 6 ? qr[d0 < 6 ? d0 : 0] : *reinterpret_cast<const bf16x8*>(qrl + (d0 - 6) * 32);
    p0 = __builtin_amdgcn_mfma_f32_32x32x16_bf16(b0, qv, p0, 0, 0, 0);
    p1 = __builtin_amdgcn_mfma_f32_32x32x16_bf16(b1, qv, p1, 0, 0, 0); }
}
__device__ __forceinline__ int v_st(int k, int c) { const int kk = (k & ~0xC) | ((k & 4) << 1) | ((k & 8) >> 1); return ((kk >> 3) * 4 + (c >> 5)) * 512 + ((kk & 7) * 32 + (c & 31)) * 2; }
__device__ __forceinline__ int v_rd_base(int lane) { return ((lane & 3) << 3) | (((lane >> 2) & 3) << 6) | (((lane >> 4) & 1) << 5) | (((lane >> 5) & 1) << 8); }
constexpr int v_rd_off(int d0, int ks, int half) { return d0 * 512 + ks * 4096 + half * 2048; }
template <int OFF> __device__ __forceinline__ s16x4 tr_read(int vb) {
  s16x4 r; asm volatile("ds_read_b64_tr_b16 %0, %1 offset:%2" : "=&v"(r) : "v"(vb), "i"(OFF) : "memory"); return r;
}
template <int D0> __device__ __forceinline__ void pv_one(f32x16& od, int vb, bf16x8 pa0, bf16x8 pa1, bf16x8 pa2, bf16x8 pa3) {
  const s16x4 l0 = tr_read<v_rd_off(D0, 0, 0)>(vb), h0 = tr_read<v_rd_off(D0, 0, 1)>(vb), l1 = tr_read<v_rd_off(D0, 1, 0)>(vb), h1 = tr_read<v_rd_off(D0, 1, 1)>(vb);
  const s16x4 l2 = tr_read<v_rd_off(D0, 2, 0)>(vb), h2 = tr_read<v_rd_off(D0, 2, 1)>(vb), l3 = tr_read<v_rd_off(D0, 3, 0)>(vb), h3 = tr_read<v_rd_off(D0, 3, 1)>(vb);
  asm volatile("s_waitcnt lgkmcnt(0)" ::: "memory"); SBAR();
#define PK(L, H) (bf16x8){L[0], L[1], L[2], L[3], H[0], H[1], H[2], H[3]}
  od = __builtin_amdgcn_mfma_f32_32x32x16_bf16(pa0, PK(l0, h0), od, 0, 0, 0);
  od = __builtin_amdgcn_mfma_f32_32x32x16_bf16(pa1, PK(l1, h1), od, 0, 0, 0);
  od = __builtin_amdgcn_mfma_f32_32x32x16_bf16(pa2, PK(l2, h2), od, 0, 0, 0);
  od = __builtin_amdgcn_mfma_f32_32x32x16_bf16(pa3, PK(l3, h3), od, 0, 0, 0);
#undef PK
}
__device__ __forceinline__ void pv_d0(f32x16* o, int vb, bf16x8 pa0, bf16x8 pa1, bf16x8 pa2, bf16x8 pa3) {
  pv_one<0>(o[0], vb, pa0, pa1, pa2, pa3); pv_one<1>(o[1], vb, pa0, pa1, pa2, pa3); pv_one<2>(o[2], vb, pa0, pa1, pa2, pa3); pv_one<3>(o[3], vb, pa0, pa1, pa2, pa3);
}
__device__ __forceinline__ void attn_body(const bf16_t* __restrict__ Qb, const bf16_t* __restrict__ Kh, const bf16_t* __restrict__ Krb, const bf16_t* __restrict__ Vh,
                                          bf16_t* __restrict__ Ob, int nkeys, char* lds) {
  const int tid = otid(), wid = tid >> 6, lane = tid & 63, r32 = lane & 31, hi = lane >> 5;
  char* V_lds = lds; char* K_lds = lds + 2 * SHM_V;
  float* ws = (float*)(lds + 2 * SHM_V + 2 * SHM_K) + wid * 64; float* li_l = ws; float* al_l = ws + 32;
  float m_reg = -1e30f, l_reg = 0; f32x16 o[4] = {}; bf16x8 qr[6];
  const bf16_t* Qw = Qb + (size_t)(wid * 32 + r32) * 192 + hi * 8;
  char* qrl = lds + 2 * SHM_V + 2 * SHM_K + 8 * 64 * 4 + (wid * 32 + r32) * QRROW + hi * 16;
#pragma unroll
  for (int d0 = 0; d0 < 6; ++d0) qr[d0] = *reinterpret_cast<const bf16x8*>(Qw + d0 * 16);
#pragma unroll
  for (int d0 = 6; d0 < 12; ++d0) *reinterpret_cast<bf16x8*>(qrl + (d0 - 6) * 32) = *reinterpret_cast<const bf16x8*>(Qw + d0 * 16);
  const int sr = tid >> 4, sc = (tid & 15) * 8, vst0 = v_st(sr, sc), vst1 = v_st(32 + sr, sc);
  const int krw = tid >> 3, kch = tid & 7;
  const int vb0 = (int)(uintptr_t)V_lds + v_rd_base(lane);
  bf16x8 vs0, vs1, ks0, ks1, ks2;
#define SLOAD(k0) do { vs0 = *reinterpret_cast<const bf16x8*>(&Vh[(size_t)((k0) + sr) * 128 + sc]); vs1 = *reinterpret_cast<const bf16x8*>(&Vh[(size_t)((k0) + 32 + sr) * 128 + sc]); \
    const bf16_t* kp_ = &Kh[(size_t)((k0) + krw) * 128 + kch * 8]; \
    ks0 = *reinterpret_cast<const bf16x8*>(kp_); ks1 = *reinterpret_cast<const bf16x8*>(kp_ + 64); \
    ks2 = *reinterpret_cast<const bf16x8*>(&Krb[(size_t)((k0) + krw) * 64 + kch * 8]); } while (0)
#define SWRITE(b) do { *(bf16x8*)(V_lds + (b) * SHM_V + vst0) = vs0; *(bf16x8*)(V_lds + (b) * SHM_V + vst1) = vs1; \
    char* kl_ = K_lds + (b) * SHM_K + krw * KROW + kch * 16; \
    *(bf16x8*)(kl_) = ks0; *(bf16x8*)(kl_ + 128) = ks1; *(bf16x8*)(kl_ + 256) = ks2; } while (0)
#define SWAIT() asm volatile("s_waitcnt vmcnt(0)" ::: "memory")
#define RESC(a) do { if (__any((a) < 1.f)) { if (hi == 0) al_l[r32] = (a); asm volatile("s_waitcnt lgkmcnt(0)" ::: "memory"); \
    for (int d = 0; d < 4; ++d) for (int r = 0; r < 16; ++r) o[d][r] *= al_l[crow(r, hi)]; } } while (0)
  f32x16 pA0, pA1, pB0, pB1; float mnA, mnB, alA, alB; bf16x8 pa0, pa1, pa2, pa3; const int NTL = nkeys / KVBLK;
  SLOAD(0); SWAIT(); SWRITE(0); __syncthreads();
  qkt(pA0, pA1, K_lds, qr, qrl, r32, hi); partialSM(pA0, pA1, m_reg, mnA, alA);
  SLOAD(KVBLK);
  SWAIT(); SWRITE(1); __syncthreads();
  for (int j = 1; j + 1 < NTL; j += 2) {
    SBAR(); qkt(pB0, pB1, K_lds + SHM_K, qr, qrl, r32, hi);
    finishSM(pA0, pA1, alA, l_reg, pa0, pa1, pa2, pa3); SBAR();
    SLOAD((j + 1) * KVBLK); SBAR();
    pv_d0(o, vb0, pa0, pa1, pa2, pa3); partialSM(pB0, pB1, m_reg, mnB, alB);
    __syncthreads(); SWAIT(); SWRITE(0);
    RESC(alB); __syncthreads();
    SBAR(); qkt(pA0, pA1, K_lds, qr, qrl, r32, hi);
    finishSM(pB0, pB1, alB, l_reg, pa0, pa1, pa2, pa3); SBAR();
    SLOAD((j + 2) * KVBLK); SBAR();
    pv_d0(o, vb0 + SHM_V, pa0, pa1, pa2, pa3); partialSM(pA0, pA1, m_reg, mnA, alA);
    __syncthreads(); SWAIT(); SWRITE(1);
    RESC(alA); __syncthreads();
  }
  SBAR(); qkt(pB0, pB1, K_lds + SHM_K, qr, qrl, r32, hi);
  finishSM(pA0, pA1, alA, l_reg, pa0, pa1, pa2, pa3); SBAR();
  pv_d0(o, vb0, pa0, pa1, pa2, pa3); partialSM(pB0, pB1, m_reg, mnB, alB);
  __syncthreads(); RESC(alB);
  finishSM(pB0, pB1, alB, l_reg, pa0, pa1, pa2, pa3); SBAR();
  pv_d0(o, vb0 + SHM_V, pa0, pa1, pa2, pa3);
  if (hi == 0) li_l[r32] = l_reg; asm volatile("s_waitcnt lgkmcnt(0)" ::: "memory");
  float rli[16];
#pragma unroll
  for (int r = 0; r < 16; ++r) rli[r] = __builtin_amdgcn_rcpf(li_l[crow(r, hi)]);
  bf16_t* Ow = Ob + (size_t)(wid * 32) * D;
#pragma unroll
  for (int r = 0; r < 16; ++r) { const int orow = crow(r, hi);
#pragma unroll
    for (int d0 = 0; d0 < 4; ++d0) Ow[(size_t)orow * D + d0 * 32 + r32] = f2bf(o[d0][r] * rli[r]); }
  __syncthreads();
#undef SLOAD
#undef SWRITE
#undef SWAIT
#undef RESC
}
}

__device__ __forceinline__ void ph_attn(const bf16_t* __restrict__ Qa, const bf16_t* __restrict__ Kn, const bf16_t* __restrict__ Kr, const bf16_t* __restrict__ Va,
                                        bf16_t* __restrict__ AO, int bid, int nblk, char* lds) {
  for (int item = bid; item < 512; item += nblk) {
    const int b = item >> 8, h = item & 7, qb = (item >> 3) & 31;
    att::attn_body(Qa + ((size_t)(b * 8 + h) * SEQ + qb * 256) * 192, Kn + (size_t)(b * 8 + h) * KEYS * 128, Kr + (size_t)b * KEYS * 64,
                   Va + (size_t)(b * 8 + h) * KEYS * 128, AO + (size_t)(b * SEQ + qb * 256) * D + h * 128, KEYS, lds);
  }
}

namespace rt {
using f32x16 = __attribute__((ext_vector_type(16))) float;
__device__ __forceinline__ int sortable(float f) { const int b = __float_as_int(f); return b ^ ((b >> 31) & 0x7FFFFFFF); }
__device__ __forceinline__ float unsortable(int k) { return __int_as_float(k ^ ((k >> 31) & 0x7FFFFFFF)); }
__device__ __forceinline__ int imax(int a, int b) { return a > b ? a : b; }
__device__ __forceinline__ int imin(int a, int b) { return a < b ? a : b; }
template <int N> __device__ __forceinline__ void sort_desc(int (&v)[N]) {
#pragma unroll
  for (int k = 2; k <= N; k <<= 1) {
#pragma unroll
    for (int j = k >> 1; j > 0; j >>= 1) {
#pragma unroll
      for (int i = 0; i < N; ++i) {
        const int l = i ^ j;
        if (l > i) {
          const bool desc = ((i & k) == 0);
          const int a = v[i], b = v[l];
          v[i] = desc ? imax(a, b) : imin(a, b);
          v[l] = desc ? imin(a, b) : imax(a, b);
        }
      }
    }
  }
}
template <int N> __device__ __forceinline__ void merge_desc(int (&v)[N]) {
#pragma unroll
  for (int j = N >> 1; j > 0; j >>= 1) {
#pragma unroll
    for (int i = 0; i < N; ++i) {
      const int l = i ^ j;
      if (l > i) { const int a = v[i], b = v[l]; v[i] = imax(a, b); v[l] = imin(a, b); }
    }
  }
}
__device__ __forceinline__ void absorb16(int (&L)[16], int (&B)[16]) {
  sort_desc<16>(B);
#pragma unroll
  for (int i = 0; i < 16; ++i) L[i] = imax(L[i], B[15 - i]);
  merge_desc<16>(L);
}
__device__ __forceinline__ constexpr int npairs_row(int i) { return 16 / (i + 1); }
}

struct RouteP { const float* Q; const bf16_t* Khi; const bf16_t* Klo; int* IDX; float* GATE; int rows_per_block; int pad; };
__device__ __forceinline__ void ph_route(const RouteP& p, int bid, char* lds) {
  using namespace rt;
  int (*svl)[64][33] = reinterpret_cast<int (*)[64][33]>(lds);
  const int wave = otid() >> 6, lane = otid() & 63, r32 = lane & 31, hi = lane >> 5, hi4 = hi * 4;
  int nrows = p.rows_per_block; asm volatile("" : "+s"(nrows));
  const int g0 = bid * nrows;
  const int h = wave;
#pragma unroll 1
  for (int tg = 0; tg * 32 < nrows; ++tg) {
    int trow = tg * 32 + r32; const bool valid = trow < nrows; trow = valid ? trow : nrows - 1;
    const float* qrow = p.Q + (size_t)(g0 + trow) * D;
    int sv[2][16];
#pragma unroll
    for (int s = 0; s < 2; ++s) {
      const int hs = h * 2 + s;
      f32x16 acc[4];
#pragma unroll
      for (int m = 0; m < 4; ++m) acc[m] = f32x16{};
#pragma unroll
      for (int ks = 0; ks < 4; ++ks) {
        const float4 qa = *(const float4*)(qrow + hs * 64 + ks * 16 + hi * 8), qb = *(const float4*)(qrow + hs * 64 + ks * 16 + hi * 8 + 4);
        uint4 qh, ql;
        qh.x = pack2bf(qa.x, qa.y); qh.y = pack2bf(qa.z, qa.w); qh.z = pack2bf(qb.x, qb.y); qh.w = pack2bf(qb.z, qb.w);
        ql.x = pack2bf(qa.x - bflo(qh.x), qa.y - bfhi(qh.x)); ql.y = pack2bf(qa.z - bflo(qh.y), qa.w - bfhi(qh.y));
        ql.z = pack2bf(qb.x - bflo(qh.z), qb.y - bfhi(qh.z)); ql.w = pack2bf(qb.z - bflo(qh.w), qb.w - bfhi(qh.w));
        const bf16x8 bqh = *reinterpret_cast<const bf16x8*>(&qh), bql = *reinterpret_cast<const bf16x8*>(&ql);
#pragma unroll
        for (int m = 0; m < 4; ++m) {
          const size_t ko = ((size_t)(hs * 128 + m * 32 + r32)) * 64 + ks * 16 + hi * 8;
          const bf16x8 kh = *(const bf16x8*)(p.Khi + ko), kl = *(const bf16x8*)(p.Klo + ko);
          acc[m] = __builtin_amdgcn_mfma_f32_32x32x16_bf16(kh, bqh, acc[m], 0, 0, 0);
          acc[m] = __builtin_amdgcn_mfma_f32_32x32x16_bf16(kh, bql, acc[m], 0, 0, 0);
          acc[m] = __builtin_amdgcn_mfma_f32_32x32x16_bf16(kl, bqh, acc[m], 0, 0, 0);
        }
      }
      int L[16];
#pragma unroll
      for (int m = 0; m < 4; ++m) {
        int B[16];
#pragma unroll
        for (int r = 0; r < 16; ++r) B[r] = (sortable(acc[m][r]) & ~0x7F) | (m * 32 + (r & 3) + 8 * (r >> 2)) | hi4;
        if (m == 0) { sort_desc<16>(B);
#pragma unroll
          for (int i = 0; i < 16; ++i) L[i] = B[i]; }
        else absorb16(L, B);
      }
      int Lo[16], Hi[16];
#pragma unroll
      for (int i = 0; i < 16; ++i) { auto rr = __builtin_amdgcn_permlane32_swap((unsigned)L[i], (unsigned)L[i], false, false); Lo[i] = (int)rr[0]; Hi[i] = (int)rr[1]; }
#pragma unroll
      for (int i = 0; i < 16; ++i) L[i] = imax(Lo[i], Hi[15 - i]);
      merge_desc<16>(L);
#pragma unroll
      for (int i = 0; i < 16; ++i) { sv[s][i] = L[i]; svl[wave][lane][s * 16 + i] = L[i]; }
    }
    float f0[16], f1[16];
#pragma unroll
    for (int i = 0; i < 16; ++i) { f0[i] = unsortable(sv[0][i] & ~0x7F); f1[i] = unsortable(sv[1][i] & ~0x7F); }
    int Lc[16];
    {
      int C[64];
      int n = 0;
#pragma unroll
      for (int i = 0; i < 16; ++i)
#pragma unroll
        for (int j = 0; j < 16; ++j)
          if ((i + 1) * (j + 1) <= 16) { C[n] = (sortable(f0[i] + f1[j]) & ~0xFF) | (i * 16 + j); ++n; }
#pragma unroll
      for (int k = 50; k < 64; ++k) C[k] = (int)0x80000000;
#pragma unroll
      for (int m = 0; m < 4; ++m) {
        int B[16];
#pragma unroll
        for (int r = 0; r < 16; ++r) B[r] = C[m * 16 + r];
        if (m == 0) { sort_desc<16>(B);
#pragma unroll
          for (int i = 0; i < 16; ++i) Lc[i] = B[i]; }
        else absorb16(Lc, B);
      }
    }
    float e[16]; float esum = 0.f;
    const float vmax = unsortable(Lc[0] & ~0xFF);
#pragma unroll
    for (int r = 0; r < 16; ++r) { e[r] = expf(unsortable(Lc[r] & ~0xFF) - vmax); esum += e[r]; }
    const float inv = 1.f / esum;
    int eid[16];
#pragma unroll
    for (int r = 0; r < 16; ++r) {
      const int pr = Lc[r] & 0xFF;
      const int k0 = svl[wave][lane][pr >> 4] & 0x7F, k1 = svl[wave][lane][16 + (pr & 15)] & 0x7F;
      eid[r] = k0 * 128 + k1;
    }
    if (valid && hi == 0) {
      int* ip = p.IDX + (size_t)(g0 + trow) * 128 + h * 16; float* gp = p.GATE + (size_t)(g0 + trow) * 128 + h * 16;
#pragma unroll
      for (int r = 0; r < 16; r += 4) {
        *(int4*)(ip + r) = make_int4(eid[r], eid[r + 1], eid[r + 2], eid[r + 3]);
        *(float4*)(gp + r) = make_float4(e[r] * inv, e[r + 1] * inv, e[r + 2] * inv, e[r + 3] * inv);
      }
    }
  }
}

struct GatherP { const bf16_t* Tbf; const int* IDX; const float* GATE; const bf16_t* utab; const bf16_t* vtab; const float* Hin; const float* mod; const float* lng; const float* lnb;
                 float* Hout; const float* modT; };
template <bool FINAL>
__device__ __forceinline__ void ph_gather_ln(const GatherP& p, int g0, int nrows, char* As) {
  const int wave = otid() >> 6, lane = otid() & 63;
  for (int rr = wave; rr < nrows; rr += 8) {
    const int row = g0 + rr;
    float tf[16];
    {
      const uint4 t0 = *(const uint4*)(p.Tbf + (size_t)row * D + lane * 8), t1 = *(const uint4*)(p.Tbf + (size_t)row * D + 512 + lane * 8);
      tf[0] = bflo(t0.x); tf[1] = bfhi(t0.x); tf[2] = bflo(t0.y); tf[3] = bfhi(t0.y); tf[4] = bflo(t0.z); tf[5] = bfhi(t0.z); tf[6] = bflo(t0.w); tf[7] = bfhi(t0.w);
      tf[8] = bflo(t1.x); tf[9] = bfhi(t1.x); tf[10] = bflo(t1.y); tf[11] = bfhi(t1.y); tf[12] = bflo(t1.z); tf[13] = bfhi(t1.z); tf[14] = bflo(t1.w); tf[15] = bfhi(t1.w);
    }
    const int id_lo = p.IDX[(size_t)row * 128 + lane], id_hi = p.IDX[(size_t)row * 128 + 64 + lane];
    const float ga_lo = p.GATE[(size_t)row * 128 + lane], ga_hi = p.GATE[(size_t)row * 128 + 64 + lane];
    float f[16];
#pragma unroll
    for (int i = 0; i < 16; ++i) f[i] = 0.f;
    uint4 ub[3][2], vb[3][2];
#define ROWLOAD(slot, kk) do { const int e_ = __builtin_amdgcn_readlane((kk) < 64 ? id_lo : id_hi, (kk) & 63); \
      const bf16_t* up_ = p.utab + (size_t)e_ * D + lane * 8; const bf16_t* vp_ = p.vtab + (size_t)e_ * D + lane * 8; \
      ub[slot][0] = *(const uint4*)up_; ub[slot][1] = *(const uint4*)(up_ + 512); vb[slot][0] = *(const uint4*)vp_; vb[slot][1] = *(const uint4*)(vp_ + 512); } while (0)
#define ROWPROC(slot, kk) do { \
      float dot_ = 0.f; \
      { const uint4 a_ = ub[slot][0], b_ = ub[slot][1]; \
        dot_ += tf[0] * bflo(a_.x) + tf[1] * bfhi(a_.x) + tf[2] * bflo(a_.y) + tf[3] * bfhi(a_.y) + tf[4] * bflo(a_.z) + tf[5] * bfhi(a_.z) + tf[6] * bflo(a_.w) + tf[7] * bfhi(a_.w); \
        dot_ += tf[8] * bflo(b_.x) + tf[9] * bfhi(b_.x) + tf[10] * bflo(b_.y) + tf[11] * bfhi(b_.y) + tf[12] * bflo(b_.z) + tf[13] * bfhi(b_.z) + tf[14] * bflo(b_.w) + tf[15] * bfhi(b_.w); } \
      dot_ = wave_sum(dot_); \
      const float g_ = __uint_as_float(__builtin_amdgcn_readlane(__float_as_uint((kk) < 64 ? ga_lo : ga_hi), (kk) & 63)); \
      const float a_ = gelu_exact(dot_) * g_; \
      { const uint4 c_ = vb[slot][0], d_ = vb[slot][1]; \
        f[0] += a_ * bflo(c_.x); f[1] += a_ * bfhi(c_.x); f[2] += a_ * bflo(c_.y); f[3] += a_ * bfhi(c_.y); f[4] += a_ * bflo(c_.z); f[5] += a_ * bfhi(c_.z); f[6] += a_ * bflo(c_.w); f[7] += a_ * bfhi(c_.w); \
        f[8] += a_ * bflo(d_.x); f[9] += a_ * bfhi(d_.x); f[10] += a_ * bflo(d_.y); f[11] += a_ * bfhi(d_.y); f[12] += a_ * bflo(d_.z); f[13] += a_ * bfhi(d_.z); f[14] += a_ * bflo(d_.w); f[15] += a_ * bfhi(d_.w); } } while (0)
    ROWLOAD(0, 0); ROWLOAD(1, 1); ROWLOAD(2, 2);
    for (int k = 0; k < 126; k += 3) {
      ROWPROC(0, k); ROWLOAD(0, k + 3);
      ROWPROC(1, k + 1); if (k + 4 < 128) ROWLOAD(1, k + 4);
      ROWPROC(2, k + 2); if (k + 5 < 128) ROWLOAD(2, k + 5);
    }
    ROWPROC(0, 126); ROWPROC(1, 127);
#undef ROWLOAD
#undef ROWPROC
    const int v = row_vec(row);
    const float* hin = p.Hin + (size_t)row * D;
    const float* gm = p.mod + v * 6144 + 5 * 1024;
    float r[16]; float ssum = 0.f;
#pragma unroll
    for (int i = 0; i < 4; ++i) {
      const int d = (i >> 1) * 512 + lane * 8 + (i & 1) * 4;
      const float4 h4 = *(const float4*)(hin + d), g4 = *(const float4*)(gm + d);
      r[i * 4 + 0] = ALPHA * h4.x + g4.x * f[i * 4 + 0]; r[i * 4 + 1] = ALPHA * h4.y + g4.y * f[i * 4 + 1];
      r[i * 4 + 2] = ALPHA * h4.z + g4.z * f[i * 4 + 2]; r[i * 4 + 3] = ALPHA * h4.w + g4.w * f[i * 4 + 3];
      ssum += r[i * 4 + 0] + r[i * 4 + 1] + r[i * 4 + 2] + r[i * 4 + 3];
    }
    const float mu = wave_sum(ssum) * (1.f / D);
    float vs = 0.f;
#pragma unroll
    for (int i = 0; i < 16; ++i) { const float dlt = r[i] - mu; vs += dlt * dlt; }
    const float rstd = rsqrtf(wave_sum(vs) * (1.f / D) + LN_EPS);
    float o[16];
#pragma unroll
    for (int i = 0; i < 4; ++i) {
      const int d = (i >> 1) * 512 + lane * 8 + (i & 1) * 4;
      const float4 g4 = *(const float4*)(p.lng + d), b4 = *(const float4*)(p.lnb + d);
      o[i * 4 + 0] = (r[i * 4 + 0] - mu) * rstd * g4.x + b4.x; o[i * 4 + 1] = (r[i * 4 + 1] - mu) * rstd * g4.y + b4.y;
      o[i * 4 + 2] = (r[i * 4 + 2] - mu) * rstd * g4.z + b4.z; o[i * 4 + 3] = (r[i * 4 + 3] - mu) * rstd * g4.w + b4.w;
      *(float4*)(p.Hout + (size_t)row * D + d) = make_float4(o[i * 4 + 0], o[i * 4 + 1], o[i * 4 + 2], o[i * 4 + 3]);
    }
    if (!FINAL) {
      const float* mt = p.modT + v * 6144;
#pragma unroll
      for (int hh = 0; hh < 2; ++hh) {
        const int d = hh * 512 + lane * 8;
        const float4 sh0 = *(const float4*)(mt + d), sh1 = *(const float4*)(mt + d + 4), sc0 = *(const float4*)(mt + 1024 + d), sc1 = *(const float4*)(mt + 1024 + d + 4);
        uint4 w;
        w.x = pack2bf(o[hh * 8 + 0] * (1.f + sc0.x) + sh0.x, o[hh * 8 + 1] * (1.f + sc0.y) + sh0.y); w.y = pack2bf(o[hh * 8 + 2] * (1.f + sc0.z) + sh0.z, o[hh * 8 + 3] * (1.f + sc0.w) + sh0.w);
        w.z = pack2bf(o[hh * 8 + 4] * (1.f + sc1.x) + sh1.x, o[hh * 8 + 5] * (1.f + sc1.y) + sh1.y); w.w = pack2bf(o[hh * 8 + 6] * (1.f + sc1.z) + sh1.z, o[hh * 8 + 7] * (1.f + sc1.w) + sh1.w);
        *(uint4*)(As + rr * LDA_B + d * 2) = w;
      }
    }
  }
}

__device__ __forceinline__ void cvt_plain(const float* __restrict__ a, bf16_t* __restrict__ o, size_t n8, bool lo, size_t gtid, size_t gsz) {
  for (size_t i = gtid; i < n8; i += gsz) {
    float v[8];
    *(float4*)&v[0] = ((const float4*)a)[i * 2]; *(float4*)&v[4] = ((const float4*)a)[i * 2 + 1];
    if (lo) {
#pragma unroll
      for (int j = 0; j < 8; ++j) v[j] = v[j] - bf2f(f2bf(v[j]));
    }
    uint4 w; w.x = pack2bf(v[0], v[1]); w.y = pack2bf(v[2], v[3]); w.z = pack2bf(v[4], v[5]); w.w = pack2bf(v[6], v[7]);
    ((uint4*)o)[i] = w;
  }
}
__device__ __forceinline__ void cvt_t(const float* __restrict__ W, bf16_t* __restrict__ Wt, int K, int N, bool lo, size_t gtid, size_t gsz) {
  const size_t total = (size_t)N * (K / 8);
  for (size_t i = gtid; i < total; i += gsz) {
    const int n = (int)(i % N), k8 = (int)(i / N);
    float v[8];
#pragma unroll
    for (int j = 0; j < 8; ++j) { const float w = W[(size_t)(k8 * 8 + j) * N + n]; v[j] = lo ? w - bf2f(f2bf(w)) : w; }
    uint4 w; w.x = pack2bf(v[0], v[1]); w.y = pack2bf(v[2], v[3]); w.z = pack2bf(v[4], v[5]); w.w = pack2bf(v[6], v[7]);
    *(uint4*)(Wt + (size_t)n * K + k8 * 8) = w;
  }
}
__device__ __forceinline__ void mod_item(const float* __restrict__ c, const float* __restrict__ c_ctx, const float* __restrict__ ada_w, const float* __restrict__ ada_b,
                                         float* __restrict__ MOD, int item, char* lds) {
  float* sc = (float*)lds;
  float* part = sc + 3072;
  const int tid = otid(), wave = tid >> 6, lane = tid & 63, l = item / 96, cg = item % 96;
  for (int i = tid; i < 3072; i += 512) { const int v = i >> 10, k = i & 1023; const float xv = v < 2 ? c[v * 1024 + k] : c_ctx[k]; sc[i] = xv / (1.f + expf(-xv)); }
  __syncthreads();
  float a0 = 0.f, a1 = 0.f, a2 = 0.f;
  const float* W = ada_w + (size_t)l * 1024 * 6144 + cg * 64 + lane;
#pragma unroll 16
  for (int k = wave * 128; k < wave * 128 + 128; ++k) { const float w = W[(size_t)k * 6144]; a0 += sc[k] * w; a1 += sc[1024 + k] * w; a2 += sc[2048 + k] * w; }
  part[(wave * 3 + 0) * 64 + lane] = a0; part[(wave * 3 + 1) * 64 + lane] = a1; part[(wave * 3 + 2) * 64 + lane] = a2;
  __syncthreads();
  if (tid < 192) {
    const int v = tid >> 6, ln = tid & 63; float sum = 0.f;
#pragma unroll
    for (int w = 0; w < 8; ++w) sum += part[(w * 3 + v) * 64 + ln];
    MOD[(l * 3 + v) * 6144 + cg * 64 + ln] = sum + ada_b[l * 6144 + cg * 64 + ln];
  }
  __syncthreads();
}

struct MP {
  const float *x, *c, *ctx, *c_ctx, *ada_w, *ada_b, *ln_g, *ln_b, *s5_a_re, *s5_a_im, *s5_log_dt, *s5_b_re, *s5_b_im, *s5_c_re, *s5_c_im, *s5_d, *s5_w_glu, *s5_w_o;
  const float *mla_w_dq, *mla_q_norm, *mla_w_uq, *mla_w_dkv, *mla_kv_norm, *mla_w_ukv, *mla_w_o, *peer_w_q, *peer_keys, *peer_u, *peer_v;
  float* out;
  float* MOD; bf16_t *Wt_glu, *Wt_o0, *Wt_q0, *Wt_q0lo, *Wt_o1, *Wt_q1, *Wt_q1lo, *Wt_cat, *Wt_uq, *Wt_ukv, *Khi, *Klo, *Khi1, *Klo1;
  bf16_t *U0, *V0, *U1, *V1, *Ktab, *Bst_t, *Cin_t;
  float *Ypart, *Ssta; bf16_t *HP, *Gbf, *Vbf, *Tbf, *Tlo; float *OQ, *H1, *H2; int* IDX; float* GATE;
  bf16_t *Qa, *Kn, *Kr, *Va, *AObf; float* H3; bf16_t *Tbf1, *Tlo1;
};
constexpr int LDS_BYTES = att::SHM_ATTN > 66 * LDA_B ? att::SHM_ATTN : 66 * LDA_B;
__global__ __launch_bounds__(512) void mega(MP p) {
  __shared__ __attribute__((aligned(16))) char lds[LDS_BYTES];
  cg::grid_group grid = cg::this_grid();
  const int nblk = gridDim.x;
  int bid = blockIdx.x;
  const size_t gtid = (size_t)bid * 512 + otid(), gsz = (size_t)nblk * 512;
  const size_t TD = (size_t)1024 * 16384;
  const float* mod0 = p.MOD; const float* mod1 = p.MOD + 3 * 6144;
  cvt_t(p.s5_w_glu, p.Wt_glu, D, D, false, gtid, gsz);
  cvt_t(p.s5_w_o, p.Wt_o0, D, D, false, gtid, gsz);
  cvt_t(p.peer_w_q, p.Wt_q0, D, D, false, gtid, gsz);
  cvt_t(p.peer_w_q, p.Wt_q0lo, D, D, true, gtid, gsz);
  cvt_t(p.mla_w_o, p.Wt_o1, D, D, false, gtid, gsz);
  cvt_t(p.peer_w_q + (size_t)D * D, p.Wt_q1, D, D, false, gtid, gsz);
  cvt_t(p.peer_w_q + (size_t)D * D, p.Wt_q1lo, D, D, true, gtid, gsz);
  cvt_t(p.mla_w_dq, p.Wt_cat, D, 384, false, gtid, gsz);
  cvt_t(p.mla_w_dkv, p.Wt_cat + (size_t)384 * D, D, 320, false, gtid, gsz);
  cvt_t(p.mla_w_uq, p.Wt_uq, 384, 1536, false, gtid, gsz);
  cvt_t(p.mla_w_ukv, p.Wt_ukv, 256, 2048, false, gtid, gsz);
  cvt_plain(p.peer_keys, p.Khi, (size_t)2 * 131072 / 8, false, gtid, gsz);
  cvt_plain(p.peer_keys, p.Klo, (size_t)2 * 131072 / 8, true, gtid, gsz);
  cvt_plain(p.peer_u, p.U0, TD / 8, false, gtid, gsz);
  cvt_plain(p.peer_v, p.V0, TD / 8, false, gtid, gsz);
  if (bid < 64) ph_s5_prep(p.s5_a_re, p.s5_a_im, p.s5_log_dt, p.s5_b_re, p.s5_b_im, p.s5_c_re, p.s5_c_im, p.Ktab, p.Bst_t, p.Cin_t, bid, lds);
  else mod_item(p.c, p.c_ctx, p.ada_w, p.ada_b, p.MOD, bid - 64, lds);
  grid.sync();
  asm volatile("" : "+s"(bid));
  ph_s5_p1(p.x, p.ctx, mod0, p.Ktab, p.Bst_t, p.Ypart, p.Ssta, bid, lds);
  grid.sync();
  asm volatile("" : "+s"(bid));
  if (otid() < 64) ph_s5_carry(p.Ssta, p.s5_a_re, p.s5_a_im, p.s5_log_dt, p.HP, bid, otid());
  grid.sync();
  asm volatile("" : "+s"(bid));
  ph_s5_p3(p.x, p.ctx, mod0, p.s5_d, p.HP, p.Cin_t, p.Ypart, p.Gbf, bid, lds);
  grid.sync();
  asm volatile("" : "+s"(bid));
  {
    ChainP cp{p.Gbf, p.Wt_glu, p.Wt_o0, p.Wt_q0, p.Vbf, p.OQ, p.x, p.ctx, mod0, p.ln_g, p.ln_b, p.H1, p.Tbf, p.OQ, p.Wt_q0lo, p.Tlo};
    ph_chainA<true>(cp, bid, lds);
    __syncthreads();
    ph_route(RouteP{p.OQ, p.Khi, p.Klo, p.IDX, p.GATE, 66, 0}, bid, lds);
    __syncthreads();
    GatherP gp{p.Tbf, p.IDX, p.GATE, p.U0, p.V0, p.H1, mod0, p.ln_g + D, p.ln_b + D, p.H2, mod1};
    ph_gather_ln<false>(gp, bid * 66, 66, lds);
    __syncthreads();
    ProjP pp{p.Wt_cat, p.Wt_uq, p.Wt_ukv, p.mla_q_norm, p.mla_kv_norm, p.OQ  , p.Qa, p.Kn, p.Kr, p.Va};
    ph_mla_proj(pp, bid, lds);
  }
  grid.sync();
  asm volatile("" : "+s"(bid));
  {
    const size_t gtid5 = (size_t)bid * 512 + otid(), gsz5 = (size_t)gridDim.x * 512;
    cvt_plain(p.peer_u + TD, p.U1, TD / 8, false, gtid5, gsz5);
    cvt_plain(p.peer_v + TD, p.V1, TD / 8, false, gtid5, gsz5);
  }
  ph_attn(p.Qa, p.Kn, p.Kr, p.Va, p.AObf, bid, nblk, lds);
  grid.sync();
  asm volatile("" : "+s"(bid));
  {
    ChainP cp{p.AObf, nullptr, p.Wt_o1, p.Wt_q1, nullptr, p.OQ, p.H2, p.H2 + (size_t)NL * D, mod1, p.ln_g + 2 * D, p.ln_b + 2 * D, p.H3, p.Tbf1, p.OQ, p.Wt_q1lo, p.Tlo1};
    ph_chainA<false>(cp, bid, lds);
    __syncthreads();
    ph_route(RouteP{p.OQ, p.Khi1, p.Klo1, p.IDX, p.GATE, 64, 0}, bid, lds);
    __syncthreads();
    GatherP gp{p.Tbf1, p.IDX, p.GATE, p.U1, p.V1, p.H3, mod1, p.ln_g + 3 * D, p.ln_b + 3 * D, p.out, mod1};
    ph_gather_ln<true>(gp, bid * 64, 64, lds);
  }
}

extern "C" void kernel_launch(void* const* d_in, const int* in_sizes, int n_in, void* d_out, int out_size, void* d_ws, size_t ws_size, hipStream_t stream) {
  MP p{};
  const float** in = (const float**)&p;
  for (int i = 0; i < 29; ++i) in[i] = (const float*)d_in[i];
  p.out = (float*)d_out;
  char* ws = (char*)d_ws; size_t off = 0;
  auto carve = [&](size_t bytes) { char* q = ws + off; off += (bytes + 255) / 256 * 256; return q; };
  const size_t TDB = (size_t)1024 * 16384 * 2, BIG = (size_t)NT * D * 4, HALF = (size_t)NT * D * 2;
  p.MOD = (float*)carve(2 * 3 * 6144 * 4);
  p.Wt_glu = (bf16_t*)carve((size_t)D * D * 2); p.Wt_o0 = (bf16_t*)carve((size_t)D * D * 2); p.Wt_q0 = (bf16_t*)carve((size_t)D * D * 2); p.Wt_q0lo = (bf16_t*)carve((size_t)D * D * 2);
  p.Wt_o1 = (bf16_t*)carve((size_t)D * D * 2); p.Wt_q1 = (bf16_t*)carve((size_t)D * D * 2); p.Wt_q1lo = (bf16_t*)carve((size_t)D * D * 2);
  p.Wt_cat = (bf16_t*)carve((size_t)704 * D * 2); p.Wt_uq = (bf16_t*)carve((size_t)1536 * 384 * 2); p.Wt_ukv = (bf16_t*)carve((size_t)2048 * 256 * 2);
  p.Khi = (bf16_t*)carve((size_t)2 * 131072 * 2); p.Klo = (bf16_t*)carve((size_t)2 * 131072 * 2); p.Khi1 = p.Khi + 131072; p.Klo1 = p.Klo + 131072;
  char* T0 = carve(2 * TDB); p.U0 = (bf16_t*)T0; p.V0 = (bf16_t*)(T0 + TDB); p.AObf = (bf16_t*)T0;
  const size_t KTAB_B = (size_t)64 * 127 * 256 * 2, BST_B = (size_t)64 * 256 * 1024 * 2, KN_B = (size_t)NB * 8 * KEYS * 128 * 2, KR_B = (size_t)NB * KEYS * 64 * 2;
  size_t x1 = KTAB_B + 2 * BST_B; if (x1 < 2 * KN_B + KR_B) x1 = 2 * KN_B + KR_B;
  char* X1 = carve(x1);
  p.Ktab = (bf16_t*)X1; p.Bst_t = (bf16_t*)(X1 + KTAB_B); p.Cin_t = (bf16_t*)(X1 + KTAB_B + BST_B);
  p.Kn = (bf16_t*)X1; p.Va = (bf16_t*)(X1 + KN_B); p.Kr = (bf16_t*)(X1 + 2 * KN_B); p.H3 = (float*)X1;
  char* X2 = carve(BIG); p.Ypart = (float*)X2; p.OQ = (float*)X2;
  char* X3 = carve(HALF); p.Ssta = (float*)X3; p.HP = (bf16_t*)(X3 + (size_t)NCC * 64 * 256 * 4); p.Vbf = (bf16_t*)X3; p.Tlo = (bf16_t*)X3; p.Tlo1 = (bf16_t*)X3;
  char* X4 = carve(HALF); p.Gbf = (bf16_t*)X4; p.Tbf = (bf16_t*)X4; p.Tbf1 = (bf16_t*)X4;
  char* X5 = carve(BIG); p.H1 = (float*)X5; p.U1 = (bf16_t*)X5; p.V1 = (bf16_t*)(X5 + TDB);
  p.H2 = (float*)carve(BIG);
  p.IDX = (int*)carve((size_t)NT * 128 * 4); p.GATE = (float*)carve((size_t)NT * 128 * 4);
  p.Qa = (bf16_t*)carve((size_t)NB * 8 * SEQ * 192 * 2);
  if (off > ws_size || n_in != 29) { fprintf(stderr, "kernel_launch: workspace too small (need %zu, have %zu) or n_in %d != 29\n", off, ws_size, n_in); return; }
  static int grid_blocks = 0;
  if (!grid_blocks) {
    int dev = 0, cus = 0, per_cu = 0;
    hipGetDevice(&dev);
    hipDeviceGetAttribute(&cus, hipDeviceAttributeMultiprocessorCount, dev);
    hipOccupancyMaxActiveBlocksPerMultiprocessor(&per_cu, mega, 512, 0);
    if (per_cu < 1 || cus < 256) { fprintf(stderr, "kernel_launch: need 256 resident workgroups (cus %d, per_cu %d)\n", cus, per_cu); return; }
    grid_blocks = 256;
  }
  void* args[] = {&p};
  hipError_t e = hipLaunchCooperativeKernel((void*)mega, dim3(grid_blocks), dim3(512), args, 0, stream);
  if (e != hipSuccess) fprintf(stderr, "cooperative launch failed: %s\n", hipGetErrorString(e));
}
```

```cpp
#include <hip/hip_runtime.h>
#include <math.h>
#include <hip/hip_cooperative_groups.h>
#include <cstdio>
namespace cg = cooperative_groups;
__device__ __forceinline__ int otid() { int t = (int)__builtin_amdgcn_workitem_id_x(); asm volatile("" : "+v"(t)); return t; }

constexpr int D = 1024, NB = 2, SEQ = 8192, CTX = 256;
constexpr int NL = NB * SEQ, NC = NB * CTX, NT = NL + NC;
constexpr float ALPHA = 1.4142135623730951f;
constexpr float LN_EPS = 1e-5f, RMS_EPS = 1e-6f;

__device__ __forceinline__ float wave_sum(float v) {
#pragma unroll
  for (int o = 32; o >= 1; o >>= 1) v += __shfl_xor(v, o);
  return v;
}
__device__ __forceinline__ int row_vec(int row) { return row < NL ? (row >> 13) : 2; }
__device__ __forceinline__ float gelu_exact(float x) { return 0.5f * x * (1.f + erff(x * 0.70710678118654752f)); }


typedef unsigned short bf16_t;
using bf16x8 = __attribute__((ext_vector_type(8))) short;
using f32x4 = __attribute__((ext_vector_type(4))) float;
__device__ __forceinline__ bf16_t f2bf(float f) { unsigned u = __float_as_uint(f); u += 0x7FFFu + ((u >> 16) & 1u); return (bf16_t)(u >> 16); }
__device__ __forceinline__ float bf2f(bf16_t h) { return __uint_as_float(((unsigned)h) << 16); }
__device__ __forceinline__ unsigned pack2bf(float lo, float hi) { return (unsigned)f2bf(lo) | ((unsigned)f2bf(hi) << 16); }
__device__ __forceinline__ float bflo(unsigned w) { return __uint_as_float(w << 16); }
__device__ __forceinline__ float bfhi(unsigned w) { return __uint_as_float(w & 0xFFFF0000u); }


constexpr int LDA_B = 1024 * 2 + 16;
template <int RT, int K>
__device__ __forceinline__ void gemm_unit(const char* const (&ap)[RT], const bf16_t* __restrict__ w0, const bf16_t* __restrict__ w1, int kmul, f32x4 (&acc)[RT][2]) {
  constexpr int KI = K / 128, NS = 3;
#pragma unroll
  for (int t = 0; t < RT; ++t) { acc[t][0] = f32x4{0.f, 0.f, 0.f, 0.f}; acc[t][1] = f32x4{0.f, 0.f, 0.f, 0.f}; }
  bf16x8 b[NS][4][2];
#pragma unroll
  for (int st = 0; st < NS - 1; ++st) {
    if (st < KI) {
#pragma unroll
      for (int s2 = 0; s2 < 4; ++s2) { b[st][s2][0] = *(const bf16x8*)(w0 + (st * 128 + s2 * 32) * kmul); b[st][s2][1] = *(const bf16x8*)(w1 + (st * 128 + s2 * 32) * kmul); }
    }
  }
  asm volatile("" ::: "memory");
#pragma unroll
  for (int it = 0; it < KI; ++it) {
    if (it + NS - 1 < KI) {
      constexpr int dummy = 0; (void)dummy;
#pragma unroll
      for (int s2 = 0; s2 < 4; ++s2) {
        b[(it + NS - 1) % NS][s2][0] = *(const bf16x8*)(w0 + ((it + NS - 1) * 128 + s2 * 32) * kmul);
        b[(it + NS - 1) % NS][s2][1] = *(const bf16x8*)(w1 + ((it + NS - 1) * 128 + s2 * 32) * kmul);
      }
    }
    asm volatile("" ::: "memory");
#pragma unroll
    for (int s2 = 0; s2 < 4; ++s2) {
#pragma unroll
      for (int t = 0; t < RT; ++t) {
        const bf16x8 a = *(const bf16x8*)(ap[t] + (it * 128 + s2 * 32) * 2);
        acc[t][0] = __builtin_amdgcn_mfma_f32_16x16x32_bf16(a, b[it % NS][s2][0], acc[t][0], 0, 0, 0);
        acc[t][1] = __builtin_amdgcn_mfma_f32_16x16x32_bf16(a, b[it % NS][s2][1], acc[t][1], 0, 0, 0);
      }
    }
  }
}
template <int RT, int K, class Epi>
__device__ __forceinline__ void gemm_ldsA(const char* As, int lda_b, int nrows, const bf16_t* __restrict__ Wt, int N, Epi epi) {
  const int wave = otid() >> 6, lane = otid() & 63, l15 = lane & 15, q = lane >> 4;
  const char* ap[RT];
#pragma unroll
  for (int t = 0; t < RT; ++t) { int r = t * 16 + l15; r = r < nrows ? r : nrows - 1; ap[t] = As + r * lda_b + q * 16; }
#pragma unroll 1
  for (int unit = wave; unit < (N >> 5); unit += 8) {
    const int n0 = unit * 32;
    const bf16_t* w0 = Wt + (size_t)(n0 >> 4) * K * 16 + lane * 8;
    f32x4 acc[RT][2];
    gemm_unit<RT, K>(ap, w0, w0 + (size_t)K * 16, 16, acc);
#pragma unroll
    for (int t = 0; t < RT; ++t)
#pragma unroll
      for (int j = 0; j < 2; ++j)
#pragma unroll
        for (int r = 0; r < 4; ++r) {
          const int row = t * 16 + q * 4 + r, col = n0 + j * 16 + l15;
          if (row < nrows) epi(row, col, acc[t][j][r]);
        }
  }
}
struct EpiF32 { float* C; int ldc; __device__ __forceinline__ void operator()(int row, int col, float v) const { C[(size_t)row * ldc + col] = v; } };
struct EpiAddF32 { float* C; int ldc; __device__ __forceinline__ void operator()(int row, int col, float v) const { C[(size_t)row * ldc + col] += v; } };
struct EpiGluL { const char* As; bf16_t* V; __device__ __forceinline__ void operator()(int row, int col, float z) const {
  const float g = bf2f(*(const bf16_t*)(As + row * LDA_B + col * 2)); V[(size_t)row * D + col] = f2bf(g / (1.f + expf(-z))); } };

__device__ __forceinline__ void load_rows_lds(char* As, const bf16_t* __restrict__ src, int nrows) {
  for (int i = otid(); i < nrows * 128; i += 512) {
    const int r = i >> 7, c = i & 127;
    *(uint4*)(As + r * LDA_B + c * 16) = *(const uint4*)(src + (size_t)r * D + c * 8);
  }
}
__device__ __forceinline__ void ln_rows(char* As, int g0, int nrows, const float* Hl, const float* Hc, const float* __restrict__ O,
                                        const float* __restrict__ mod, int gate_i, const float* __restrict__ lng, const float* __restrict__ lnb,
                                        float* Hout, bf16_t* __restrict__ Tbf, int shift_i, int scale_i, bf16_t* __restrict__ Tlo) {
  const int wave = otid() >> 6, lane = otid() & 63;
  for (int rr = wave; rr < nrows; rr += 8) {
    const int row = g0 + rr;
    const float* hin = row < NL ? Hl + (size_t)row * D : Hc + (size_t)(row - NL) * D;
    const float* f = O + (size_t)row * D;
    const float* m = mod + row_vec(row) * 6144;
    const float* gm = m + gate_i * 1024;
    float r[16]; float s = 0.f;
#pragma unroll
    for (int i = 0; i < 4; ++i) {
      const int d = i * 256 + lane * 4;
      float4 h4 = *(const float4*)(hin + d), f4 = *(const float4*)(f + d), g4 = *(const float4*)(gm + d);
      r[i * 4 + 0] = ALPHA * h4.x + g4.x * f4.x; r[i * 4 + 1] = ALPHA * h4.y + g4.y * f4.y;
      r[i * 4 + 2] = ALPHA * h4.z + g4.z * f4.z; r[i * 4 + 3] = ALPHA * h4.w + g4.w * f4.w;
      s += r[i * 4 + 0] + r[i * 4 + 1] + r[i * 4 + 2] + r[i * 4 + 3];
    }
    const float mu = wave_sum(s) * (1.f / D);
    float vs = 0.f;
#pragma unroll
    for (int i = 0; i < 16; ++i) { float dlt = r[i] - mu; vs += dlt * dlt; }
    const float rstd = rsqrtf(wave_sum(vs) * (1.f / D) + LN_EPS);
#pragma unroll
    for (int i = 0; i < 4; ++i) {
      const int d = i * 256 + lane * 4;
      float4 g4 = *(const float4*)(lng + d), b4 = *(const float4*)(lnb + d);
      float4 o;
      o.x = (r[i * 4 + 0] - mu) * rstd * g4.x + b4.x; o.y = (r[i * 4 + 1] - mu) * rstd * g4.y + b4.y;
      o.z = (r[i * 4 + 2] - mu) * rstd * g4.z + b4.z; o.w = (r[i * 4 + 3] - mu) * rstd * g4.w + b4.w;
      *(float4*)(Hout + (size_t)row * D + d) = o;
      float4 sh = *(const float4*)(m + shift_i * 1024 + d), sc = *(const float4*)(m + scale_i * 1024 + d);
      const float t0 = o.x * (1.f + sc.x) + sh.x, t1 = o.y * (1.f + sc.y) + sh.y, t2 = o.z * (1.f + sc.z) + sh.z, t3 = o.w * (1.f + sc.w) + sh.w;
      uint2 w; w.x = pack2bf(t0, t1); w.y = pack2bf(t2, t3);
      *(uint2*)(As + rr * LDA_B + d * 2) = w;
      *(uint2*)(Tbf + (size_t)row * D + d) = w;
      uint2 wl; wl.x = pack2bf(t0 - bflo(w.x), t1 - bfhi(w.x)); wl.y = pack2bf(t2 - bflo(w.y), t3 - bfhi(w.y));
      *(uint2*)(Tlo + (size_t)row * D + d) = wl;
    }
  }
}


constexpr int S5T = 64, NCHUNK = (CTX + SEQ) / S5T  , NCC = NB * NCHUNK  ;
__device__ __forceinline__ int s5_token(int cc, int s) {
  const int b = cc / NCHUNK, ch = cc - b * NCHUNK;
  return ch < 4 ? NL + b * CTX + ch * S5T + s : b * SEQ + (ch - 4) * S5T + s;
}
__device__ __forceinline__ void ph_s5_prep(const float* __restrict__ a_re, const float* __restrict__ a_im, const float* __restrict__ log_dt,
                                                 const float* __restrict__ b_re, const float* __restrict__ b_im, const float* __restrict__ c_re, const float* __restrict__ c_im,
                                                 bf16_t* __restrict__ Ktab, bf16_t* __restrict__ Bst_t, bf16_t* __restrict__ Cin_t, int g, char* lds) {
  float2 (*pw)[65][64] = reinterpret_cast<float2 (*)[65][64]>(lds);
  float2 (*Bp)[64][16] = reinterpret_cast<float2 (*)[64][16]>(lds + 2 * 65 * 64 * 8);
  float2 (*Cc)[16][64] = reinterpret_cast<float2 (*)[16][64]>(lds + 2 * 65 * 64 * 8 + 2 * 64 * 16 * 8);
  const int tid = otid();
  if (tid < 128) {
    const int dir = tid >> 6, p = tid & 63, gp = (dir * 64 + g) * 64 + p;
    const float are = a_re[gp], aim = a_im[gp], dt = expf(log_dt[dir * 64 + g]);
    const float mag = expf(are * dt);
    const float abr = mag * cosf(aim * dt), abi = mag * sinf(aim * dt);
    const float nr = abr - 1.f, ni = abi, den = are * are + aim * aim;
    const float fr = (nr * are + ni * aim) / den, fi = (ni * are - nr * aim) / den;
    float pr = 1.f, pi = 0.f;
    for (int e = 0; e <= 64; ++e) { pw[dir][e][p] = make_float2(pr, pi); const float nr2 = pr * abr - pi * abi, ni2 = pr * abi + pi * abr; pr = nr2; pi = ni2; }
    for (int ci = 0; ci < 16; ++ci) { const float br = b_re[gp * 16 + ci], bi = b_im[gp * 16 + ci]; Bp[dir][p][ci] = make_float2(fr * br - fi * bi, fr * bi + fi * br); }
    for (int co = 0; co < 16; ++co) { const int idx = ((dir * 64 + g) * 16 + co) * 64 + p; Cc[dir][co][p] = make_float2(c_re[idx], c_im[idx]); }
  }
  __syncthreads();
  for (int i = tid; i < 127 * 256; i += 512) {
    const int ti = i >> 8, co = (i >> 4) & 15, ci = i & 15, tau = ti - 63;
    float acc = 0.f;
    if (tau >= 0) { for (int p = 0; p < 64; ++p) { const float2 c = Cc[0][co][p], w = pw[0][tau][p], b = Bp[0][p][ci];
        const float xr = c.x * w.x - c.y * w.y, xi = c.x * w.y + c.y * w.x; acc += xr * b.x - xi * b.y; } }
    if (tau <= 0) { for (int p = 0; p < 64; ++p) { const float2 c = Cc[1][co][p], w = pw[1][-tau][p], b = Bp[1][p][ci];
        const float xr = c.x * w.x - c.y * w.y, xi = c.x * w.y + c.y * w.x; acc += xr * b.x - xi * b.y; } }
    Ktab[(size_t)g * 127 * 256 + i] = f2bf(acc);
  }
  for (int i = tid; i < 256 * 128; i += 512) {
    const int n = i >> 7, k8 = i & 127, dir = n >> 7, c = (n >> 6) & 1, p = n & 63, sidx = k8 >> 1, ci0 = (k8 & 1) * 8;
    const float2 w = pw[dir][dir == 0 ? 63 - sidx : sidx][p];
    float v[8];
#pragma unroll
    for (int j = 0; j < 8; ++j) { const float2 b = Bp[dir][p][ci0 + j]; v[j] = c == 0 ? (w.x * b.x - w.y * b.y) : (w.x * b.y + w.y * b.x); }
    uint4 o; o.x = pack2bf(v[0], v[1]); o.y = pack2bf(v[2], v[3]); o.z = pack2bf(v[4], v[5]); o.w = pack2bf(v[6], v[7]);
    *(uint4*)(Bst_t + (size_t)g * 256 * 1024 + ((size_t)((n >> 4) * 32 + (k8 >> 2)) * 64 + (k8 & 3) * 16 + (n & 15)) * 8) = o;
  }
  for (int i = tid; i < 1024 * 32; i += 512) {
    const int n = i >> 5, k8 = i & 31, t = n >> 4, co = n & 15, dir = k8 >> 4, c = (k8 >> 3) & 1, p0 = (k8 & 7) * 8;
    const int e = dir == 0 ? t + 1 : 64 - t;
    float v[8];
#pragma unroll
    for (int j = 0; j < 8; ++j) { const float2 cc = Cc[dir][co][p0 + j], w = pw[dir][e][p0 + j];
      v[j] = c == 0 ? (cc.x * w.x - cc.y * w.y) : -(cc.x * w.y + cc.y * w.x); }
    uint4 o; o.x = pack2bf(v[0], v[1]); o.y = pack2bf(v[2], v[3]); o.z = pack2bf(v[4], v[5]); o.w = pack2bf(v[6], v[7]);
    *(uint4*)(Cin_t + (size_t)g * 1024 * 256 + ((size_t)((n >> 4) * 8 + (k8 >> 2)) * 64 + (k8 & 3) * 16 + (n & 15)) * 8) = o;
  }
}
__device__ __forceinline__ void ph_s5_p1(const float* __restrict__ x, const float* __restrict__ ctx, const float* __restrict__ mod,
                                               const bf16_t* __restrict__ Ktab, const bf16_t* __restrict__ Bst_t, float* __restrict__ Ypart, float* __restrict__ S, int bid, char* As) {
  const int g = bid >> 2, cc0 = (bid & 3) * 66, tid = otid();
  const int wave = tid >> 6, lane = tid & 63, l15 = lane & 15, q = lane >> 4;
  for (int i = tid; i < 66 * 64 * 2; i += 512) {
    const int half = i & 1, sidx = (i >> 1) & 63, r = i >> 7;
    const int tok = s5_token(cc0 + r, sidx), ch = g * 16 + half * 8;
    const float* src = (tok < NL ? x + (size_t)tok * D : ctx + (size_t)(tok - NL) * D) + ch;
    const float* m = mod + row_vec(tok) * 6144;
    const float4 a = *(const float4*)src, b = *(const float4*)(src + 4);
    const float4 sh0 = *(const float4*)(m + ch), sh1 = *(const float4*)(m + ch + 4), sc0 = *(const float4*)(m + 1024 + ch), sc1 = *(const float4*)(m + 1024 + ch + 4);
    uint4 o;
    o.x = pack2bf(a.x * (1.f + sc0.x) + sh0.x, a.y * (1.f + sc0.y) + sh0.y); o.y = pack2bf(a.z * (1.f + sc0.z) + sh0.z, a.w * (1.f + sc0.w) + sh0.w);
    o.z = pack2bf(b.x * (1.f + sc1.x) + sh1.x, b.y * (1.f + sc1.y) + sh1.y); o.w = pack2bf(b.z * (1.f + sc1.z) + sh1.z, b.w * (1.f + sc1.w) + sh1.w);
    *(uint4*)(As + r * LDA_B + sidx * 32 + half * 16) = o;
  }
  __syncthreads();
  const char* ap[5];
#pragma unroll
  for (int t = 0; t < 5; ++t) { int r = t * 16 + l15; r = r < 66 ? r : 65; ap[t] = As + r * LDA_B + q * 16; }
  const bf16_t* Kg = Ktab + (size_t)g * 127 * 256;
#pragma unroll 1
  for (int unit = wave; unit < 40; unit += 8) {
    f32x4 acc[5][2];
    if (unit < 32) {
      const int t0 = unit * 2;
      const bf16_t* w0 = Kg + (t0 + 63 - (q >> 1)) * 256 + l15 * 16 + (q & 1) * 8;
      gemm_unit<5, 1024>(ap, w0, w0 + 256, -16, acc);
#pragma unroll
      for (int t = 0; t < 5; ++t)
#pragma unroll
        for (int j = 0; j < 2; ++j)
#pragma unroll
          for (int r = 0; r < 4; ++r) {
            const int row = t * 16 + q * 4 + r;
            if (row < 66) Ypart[(size_t)s5_token(cc0 + row, t0 + j) * D + g * 16 + l15] = acc[t][j][r];
          }
    } else {
      const int n0 = (unit - 32) * 32;
      const bf16_t* w0 = Bst_t + (size_t)g * 256 * 1024 + (size_t)(n0 >> 4) * 1024 * 16 + lane * 8;
      gemm_unit<5, 1024>(ap, w0, w0 + 1024 * 16, 16, acc);
#pragma unroll
      for (int t = 0; t < 5; ++t)
#pragma unroll
        for (int j = 0; j < 2; ++j)
#pragma unroll
          for (int r = 0; r < 4; ++r) {
            const int row = t * 16 + q * 4 + r;
            if (row < 66) S[((size_t)(cc0 + row) * 64 + g) * 256 + n0 + j * 16 + l15] = acc[t][j][r];
          }
    }
  }
}
__device__ __forceinline__ void ph_s5_carry(const float* __restrict__ S, const float* __restrict__ a_re, const float* __restrict__ a_im,
                                                 const float* __restrict__ log_dt, bf16_t* __restrict__ HP, int id, int p) {
  const int dir = id & 1, g = (id >> 1) & 63, b = id >> 7;
  const int gp = (dir * 64 + g) * 64 + p;
  const float are = a_re[gp], aim = a_im[gp], dt = expf(log_dt[dir * 64 + g]);
  const float mag = expf(are * dt);
  float tr = mag * cosf(aim * dt), ti = mag * sinf(aim * dt);
#pragma unroll
  for (int i = 0; i < 6; ++i) { const float nr = tr * tr - ti * ti, ni = 2.f * tr * ti; tr = nr; ti = ni; }
  float hr = 0.f, hi = 0.f;
#pragma unroll 4
  for (int step = 0; step < NCHUNK; ++step) {
    const int c = dir == 0 ? step : (step < 4 ? 3 - step : NCHUNK - 1 - (step - 4));
    const size_t base = ((size_t)(b * NCHUNK + c) * 64 + g) * 256 + dir * 128 + p;
    HP[base] = f2bf(hr); HP[base + 64] = f2bf(hi);
    const float sr = S[base], si = S[base + 64];
    const float nr = tr * hr - ti * hi + sr, ni = tr * hi + ti * hr + si;
    hr = nr; hi = ni;
  }
}
struct EpiS5 { const float* x; const float* ctx; const float* mod; const float* dvec; const float* Ypart; bf16_t* Gbf; int cc0; int g;
  __device__ __forceinline__ void operator()(int row, int col, float v) const {
    const int tok = s5_token(cc0 + row, col >> 4), ch = g * 16 + (col & 15);
    const float* m = mod + row_vec(tok) * 6144;
    const float xin = tok < NL ? x[(size_t)tok * D + ch] : ctx[(size_t)(tok - NL) * D + ch];
    const float mm = xin * (1.f + m[1024 + ch]) + m[ch];
    const float y = v + Ypart[(size_t)tok * D + ch] + dvec[ch] * mm;
    Gbf[(size_t)tok * D + ch] = f2bf(gelu_exact(y));
  } };
__device__ __forceinline__ void ph_s5_p3(const float* __restrict__ x, const float* __restrict__ ctx, const float* __restrict__ mod, const float* __restrict__ dvec,
                                               const bf16_t* __restrict__ HP, const bf16_t* __restrict__ Cin_t, const float* __restrict__ Ypart, bf16_t* __restrict__ Gbf, int bid, char* As) {
  const int g = bid >> 2, cc0 = (bid & 3) * 66, tid = otid();
  for (int i = tid; i < 66 * 32; i += 512) {
    const int r = i >> 5, c = i & 31;
    *(uint4*)(As + r * 528 + c * 16) = *(const uint4*)(HP + ((size_t)(cc0 + r) * 64 + g) * 256 + c * 8);
  }
  __syncthreads();
  gemm_ldsA<5, 256>(As, 528, 66, Cin_t + (size_t)g * 1024 * 256, 1024, EpiS5{x, ctx, mod, dvec, Ypart, Gbf, cc0, g});
}


struct ChainP {
  const bf16_t* Ain;
  const bf16_t* Wglu_t; const bf16_t* Wo_t; const bf16_t* Wq_t;
  bf16_t* Vbf; float* O; const float* Hl; const float* Hc; const float* mod; const float* lng; const float* lnb;
  float* Hout; bf16_t* Tbf; float* Q; const bf16_t* Wq_lo; bf16_t* Tlo;
};
template <bool L0>
__device__ __forceinline__ void ph_chainA(const ChainP& p, int bid, char* As) {
  constexpr int NR = L0 ? 66 : 64;
  constexpr int RT = L0 ? 5 : 4;
  const int g0 = bid * NR;
  load_rows_lds(As, p.Ain + (size_t)g0 * D, NR);
  __syncthreads();
  if (L0) {
    gemm_ldsA<RT, 1024>(As, LDA_B, NR, p.Wglu_t, D, EpiGluL{As, p.Vbf + (size_t)g0 * D});
    __syncthreads();
    load_rows_lds(As, p.Vbf + (size_t)g0 * D, NR);
    __syncthreads();
  }
  gemm_ldsA<RT, 1024>(As, LDA_B, NR, p.Wo_t, D, EpiF32{p.O + (size_t)g0 * D, D});
  __syncthreads();
  ln_rows(As, g0, NR, p.Hl, p.Hc, p.O, p.mod, 2, p.lng, p.lnb, p.Hout, p.Tbf, 3, 4, p.Tlo);
  __syncthreads();
  gemm_ldsA<RT, 1024>(As, LDA_B, NR, p.Wq_t, D, EpiF32{p.Q + (size_t)g0 * D, D});
  gemm_ldsA<RT, 1024>(As, LDA_B, NR, p.Wq_lo, D, EpiAddF32{p.Q + (size_t)g0 * D, D});
  __syncthreads();
  load_rows_lds(As, p.Tlo + (size_t)g0 * D, NR);
  __syncthreads();
  gemm_ldsA<RT, 1024>(As, LDA_B, NR, p.Wq_t, D, EpiAddF32{p.Q + (size_t)g0 * D, D});
}


constexpr int KEYS = SEQ + CTX;
struct EpiKV { bf16_t* Kn; bf16_t* Va; int g0; int pad; __device__ __forceinline__ void operator()(int row, int col, float v) const {
  const int g = g0 + row; int b, key;
  if (g < NL) { b = g >> 13; key = g & (SEQ - 1); } else { const int cidx = g - NL; b = cidx >> 8; key = SEQ + (cidx & (CTX - 1)); }
  const int head = col >> 8, j = col & 255;
  if (j < 128) Kn[((size_t)(b * 8 + head) * KEYS + key) * 128 + j] = f2bf(v);
  else Va[((size_t)(b * 8 + head) * KEYS + key) * 128 + (j - 128)] = f2bf(v);
} };
struct EpiQ { bf16_t* Qa; int g0; int pad; __device__ __forceinline__ void operator()(int row, int col, float v) const {
  const int g = g0 + row, b = g >> 13, n = g & (SEQ - 1);
  const int head = col / 192, j = col - head * 192;
  Qa[((size_t)(b * 8 + head) * SEQ + n) * 192 + j] = f2bf(v);
} };
struct ProjP { const bf16_t* Wcat_t; const bf16_t* Wuq_t; const bf16_t* Wukv_t; const float* q_norm; const float* kv_norm;
               float* PR; bf16_t* Qa; bf16_t* Kn; bf16_t* Kr; bf16_t* Va; };
__device__ __forceinline__ void ph_mla_proj(const ProjP& p, int bid, char* As) {
  const int g0 = bid * 66, wave = otid() >> 6, lane = otid() & 63;
  gemm_ldsA<5, 1024>(As, LDA_B, 66, p.Wcat_t, 704, EpiF32{p.PR + (size_t)g0 * D, D});
  __syncthreads();
  char* A1 = As; char* A2 = As + 66 * 784;
  for (int rr = wave; rr < 66; rr += 8) {
    const int g = g0 + rr;
    const float* pr = p.PR + (size_t)g * D;
    float v[6]; float ss = 0.f;
#pragma unroll
    for (int i = 0; i < 6; ++i) { v[i] = pr[i * 64 + lane]; ss += v[i] * v[i]; }
    float rn = rsqrtf(wave_sum(ss) * (1.f / 384.f) + RMS_EPS);
#pragma unroll
    for (int i = 0; i < 6; ++i) *(bf16_t*)(A1 + rr * 784 + (i * 64 + lane) * 2) = f2bf(v[i] * rn * p.q_norm[i * 64 + lane]);
    float w[4]; ss = 0.f;
#pragma unroll
    for (int i = 0; i < 4; ++i) { w[i] = pr[384 + i * 64 + lane]; ss += w[i] * w[i]; }
    rn = rsqrtf(wave_sum(ss) * (1.f / 256.f) + RMS_EPS);
#pragma unroll
    for (int i = 0; i < 4; ++i) *(bf16_t*)(A2 + rr * 528 + (i * 64 + lane) * 2) = f2bf(w[i] * rn * p.kv_norm[i * 64 + lane]);
    if (lane < 32) {
      float x1 = pr[640 + lane], x2 = pr[672 + lane];
      int b, key;
      if (g < NL) {
        b = g >> 13; key = g & (SEQ - 1);
        const int n = key, rr2 = n >> 6, cc = n & 63;
        const float inv = powf(10000.f, -(float)(lane & 15) / 16.f);
        const float ang = (lane < 16 ? (float)rr2 : (float)cc) * inv;
        const float cs = cosf(ang), sn = sinf(ang);
        const float y1 = x1 * cs - x2 * sn, y2 = x2 * cs + x1 * sn; x1 = y1; x2 = y2;
      } else { const int cidx = g - NL; b = cidx >> 8; key = SEQ + (cidx & (CTX - 1)); }
      bf16_t* kp = p.Kr + ((size_t)b * KEYS + key) * 64;
      kp[lane] = f2bf(x1); kp[32 + lane] = f2bf(x2);
    }
  }
  __syncthreads();
  int nq = NL - g0; nq = nq > 66 ? 66 : nq;
  if (nq > 0) gemm_ldsA<5, 384>(A1, 784, nq, p.Wuq_t, 1536, EpiQ{p.Qa, g0, 0});
  gemm_ldsA<5, 256>(A2, 528, 66, p.Wukv_t, 2048, EpiKV{p.Kn, p.Va, g0, 0});
  __syncthreads();
  for (int rr = wave; rr < nq; rr += 8) {
    const int g = g0 + rr, b = g >> 13, n = g & (SEQ - 1);
    if (lane < 32) {
      const float inv = powf(10000.f, -(float)(lane & 15) / 16.f);
      const float ang = (lane < 16 ? (float)(n >> 6) : (float)(n & 63)) * inv;
      const float cs = cosf(ang), sn = sinf(ang);
#pragma unroll
      for (int h = 0; h < 8; ++h) {
        bf16_t* qo = p.Qa + ((size_t)(b * 8 + h) * SEQ + n) * 192;
        const float x1 = bf2f(qo[128 + lane]), x2 = bf2f(qo[160 + lane]);
        qo[128 + lane] = f2bf(x1 * cs - x2 * sn); qo[160 + lane] = f2bf(x2 * cs + x1 * sn);
      }
    }
  }
}

namespace att {
using s16x4 = __attribute__((ext_vector_type(4))) short;
using f32x16 = __attribute__((ext_vector_type(16))) float;
using u32x4 = __attribute__((ext_vector_type(4))) unsigned;
constexpr int KVBLK = 64, KROW = 400;
constexpr float SCALE = 0.07216878364870322f;
constexpr float THR = 8.f;
constexpr int SHM_V = KVBLK * 128 * 2, SHM_K = KVBLK * KROW, QRROW = 208, SHM_QR = 256 * QRROW, SHM_ATTN = 2 * SHM_V + 2 * SHM_K + 8 * 64 * 4 + SHM_QR;
#define SBAR() __builtin_amdgcn_sched_barrier(0)
__device__ __forceinline__ int crow(int r, int hi) { return (r & 3) + 8 * (r >> 2) + 4 * hi; }
__device__ __forceinline__ unsigned cvtpk(float lo, float hi) { unsigned r; asm volatile("v_cvt_pk_bf16_f32 %0, %1, %2" : "=v"(r) : "v"(lo), "v"(hi)); return r; }
__device__ __forceinline__ void partialSM(f32x16& p0, f32x16& p1, float& m_reg, float& mn, float& alpha) {
  constexpr float C = SCALE * 1.4426950408889634f;
  float pmax = p0[0];
#pragma unroll
  for (int r = 1; r < 16; ++r) pmax = fmaxf(pmax, p0[r]);
#pragma unroll
  for (int r = 0; r < 16; ++r) pmax = fmaxf(pmax, p1[r]);
  { auto rr = __builtin_amdgcn_permlane32_swap(__float_as_uint(pmax), __float_as_uint(pmax), false, false);
    pmax = fmaxf(__uint_as_float(rr[0]), __uint_as_float(rr[1])); }
  if (__builtin_expect(__all(pmax - m_reg <= THR / SCALE), 1)) { mn = m_reg; alpha = 1.f; }
  else { mn = fmaxf(m_reg, pmax); alpha = __builtin_amdgcn_exp2f((m_reg - mn) * C); m_reg = mn; }
  const float mnC = -mn * C;
#pragma unroll
  for (int r = 0; r < 16; ++r) p0[r] = fmaf(p0[r], C, mnC);
#pragma unroll
  for (int r = 0; r < 16; ++r) p1[r] = fmaf(p1[r], C, mnC);
#pragma unroll
  for (int r = 0; r < 16; ++r) p0[r] = __builtin_amdgcn_exp2f(p0[r]);
}
__device__ __forceinline__ void finishSM(f32x16& p0, f32x16& p1, float alpha, float& l_reg, bf16x8& pa0, bf16x8& pa1, bf16x8& pa2, bf16x8& pa3) {
#pragma unroll
  for (int r = 0; r < 16; ++r) p1[r] = __builtin_amdgcn_exp2f(p1[r]);
  float ps = 0;
#pragma unroll
  for (int r = 0; r < 16; ++r) ps += p0[r];
#pragma unroll
  for (int r = 0; r < 16; ++r) ps += p1[r];
  { auto rr = __builtin_amdgcn_permlane32_swap(__float_as_uint(ps), __float_as_uint(ps), false, false);
    ps = __uint_as_float(rr[0]) + __uint_as_float(rr[1]); }
  l_reg = l_reg * alpha + ps;
#define PK4(P, BASE, OUT) do { unsigned a0 = cvtpk(P[BASE + 0], P[BASE + 1]), a1 = cvtpk(P[BASE + 2], P[BASE + 3]);   \
    unsigned b0 = cvtpk(P[BASE + 4], P[BASE + 5]), b1 = cvtpk(P[BASE + 6], P[BASE + 7]);                              \
    auto r0 = __builtin_amdgcn_permlane32_swap(a0, b0, false, false); auto r1 = __builtin_amdgcn_permlane32_swap(a1, b1, false, false); \
    u32x4 w = {r0[0], r1[0], r0[1], r1[1]}; OUT = *reinterpret_cast<bf16x8*>(&w); } while (0)
  PK4(p0, 0, pa0); PK4(p0, 8, pa1); PK4(p1, 0, pa2); PK4(p1, 8, pa3);
#undef PK4
}
__device__ __forceinline__ void qkt(f32x16& p0, f32x16& p1, const char* Ks, const bf16x8* qr, const char* qrl, int r32, int hi) {
  p0 = f32x16{}; p1 = f32x16{};
#pragma unroll
  for (int d0 = 0; d0 < 12; ++d0) { const int cb = (d0 * 16 + hi * 8) * 2;
    bf16x8 b0 = *reinterpret_cast<const bf16x8*>(Ks + r32 * KROW + cb);
    bf16x8 b1 = *reinterpret_cast<const bf16x8*>(Ks + (32 + r32) * KROW + cb);
    const bf16x8 qv = d0 < 6 ? qr[d0 < 6 ? d0 : 0] : *reinterpret_cast<const bf16x8*>(qrl + (d0 - 6) * 32);
    p0 = __builtin_amdgcn_mfma_f32_32x32x16_bf16(b0, qv, p0, 0, 0, 0);
    p1 = __builtin_amdgcn_mfma_f32_32x32x16_bf16(b1, qv, p1, 0, 0, 0); }
}
__device__ __forceinline__ int v_st(int k, int c) { const int kk = (k & ~0xC) | ((k & 4) << 1) | ((k & 8) >> 1); return ((kk >> 3) * 4 + (c >> 5)) * 512 + ((kk & 7) * 32 + (c & 31)) * 2; }
__device__ __forceinline__ int v_rd_base(int lane) { return ((lane & 3) << 3) | (((lane >> 2) & 3) << 6) | (((lane >> 4) & 1) << 5) | (((lane >> 5) & 1) << 8); }
constexpr int v_rd_off(int d0, int ks, int half) { return d0 * 512 + ks * 4096 + half * 2048; }
template <int OFF> __device__ __forceinline__ s16x4 tr_read(int vb) {
  s16x4 r; asm volatile("ds_read_b64_tr_b16 %0, %1 offset:%2" : "=&v"(r) : "v"(vb), "i"(OFF) : "memory"); return r;
}
template <int D0> __device__ __forceinline__ void pv_one(f32x16& od, int vb, bf16x8 pa0, bf16x8 pa1, bf16x8 pa2, bf16x8 pa3) {
  const s16x4 l0 = tr_read<v_rd_off(D0, 0, 0)>(vb), h0 = tr_read<v_rd_off(D0, 0, 1)>(vb), l1 = tr_read<v_rd_off(D0, 1, 0)>(vb), h1 = tr_read<v_rd_off(D0, 1, 1)>(vb);
  const s16x4 l2 = tr_read<v_rd_off(D0, 2, 0)>(vb), h2 = tr_read<v_rd_off(D0, 2, 1)>(vb), l3 = tr_read<v_rd_off(D0, 3, 0)>(vb), h3 = tr_read<v_rd_off(D0, 3, 1)>(vb);
  asm volatile("s_waitcnt lgkmcnt(0)" ::: "memory"); SBAR();
#define PK(L, H) (bf16x8){L[0], L[1], L[2], L[3], H[0], H[1], H[2], H[3]}
  od = __builtin_amdgcn_mfma_f32_32x32x16_bf16(pa0, PK(l0, h0), od, 0, 0, 0);
  od = __builtin_amdgcn_mfma_f32_32x32x16_bf16(pa1, PK(l1, h1), od, 0, 0, 0);
  od = __builtin_amdgcn_mfma_f32_32x32x16_bf16(pa2, PK(l2, h2), od, 0, 0, 0);
  od = __builtin_amdgcn_mfma_f32_32x32x16_bf16(pa3, PK(l3, h3), od, 0, 0, 0);
#undef PK
}
__device__ __forceinline__ void pv_d0(f32x16* o, int vb, bf16x8 pa0, bf16x8 pa1, bf16x8 pa2, bf16x8 pa3) {
  pv_one<0>(o[0], vb, pa0, pa1, pa2, pa3); pv_one<1>(o[1], vb, pa0, pa1, pa2, pa3); pv_one<2>(o[2], vb, pa0, pa1, pa2, pa3); pv_one<3>(o[3], vb, pa0, pa1, pa2, pa3);
}
__device__ __forceinline__ void attn_body(const bf16_t* __restrict__ Qb, const bf16_t* __restrict__ Kh, const bf16_t* __restrict__ Krb, const bf16_t* __restrict__ Vh,
                                          bf16_t* __restrict__ Ob, int nkeys, char* lds) {
  const int tid = otid(), wid = tid >> 6, lane = tid & 63, r32 = lane & 31, hi = lane >> 5;
  char* V_lds = lds; char* K_lds = lds + 2 * SHM_V;
  float* ws = (float*)(lds + 2 * SHM_V + 2 * SHM_K) + wid * 64; float* li_l = ws; float* al_l = ws + 32;
  float m_reg = -1e30f, l_reg = 0; f32x16 o[4] = {}; bf16x8 qr[6];
  const bf16_t* Qw = Qb + (size_t)(wid * 32 + r32) * 192 + hi * 8;
  char* qrl = lds + 2 * SHM_V + 2 * SHM_K + 8 * 64 * 4 + (wid * 32 + r32) * QRROW + hi * 16;
#pragma unroll
  for (int d0 = 0; d0 < 6; ++d0) qr[d0] = *reinterpret_cast<const bf16x8*>(Qw + d0 * 16);
#pragma unroll
  for (int d0 = 6; d0 < 12; ++d0) *reinterpret_cast<bf16x8*>(qrl + (d0 - 6) * 32) = *reinterpret_cast<const bf16x8*>(Qw + d0 * 16);
  const int sr = tid >> 4, sc = (tid & 15) * 8, vst0 = v_st(sr, sc), vst1 = v_st(32 + sr, sc);
  const int krw = tid >> 3, kch = tid & 7;
  const int vb0 = (int)(uintptr_t)V_lds + v_rd_base(lane);
  bf16x8 vs0, vs1, ks0, ks1, ks2;
#define SLOAD(k0) do { vs0 = *reinterpret_cast<const bf16x8*>(&Vh[(size_t)((k0) + sr) * 128 + sc]); vs1 = *reinterpret_cast<const bf16x8*>(&Vh[(size_t)((k0) + 32 + sr) * 128 + sc]); \
    const bf16_t* kp_ = &Kh[(size_t)((k0) + krw) * 128 + kch * 8]; \
    ks0 = *reinterpret_cast<const bf16x8*>(kp_); ks1 = *reinterpret_cast<const bf16x8*>(kp_ + 64); \
    ks2 = *reinterpret_cast<const bf16x8*>(&Krb[(size_t)((k0) + krw) * 64 + kch * 8]); } while (0)
#define SWRITE(b) do { *(bf16x8*)(V_lds + (b) * SHM_V + vst0) = vs0; *(bf16x8*)(V_lds + (b) * SHM_V + vst1) = vs1; \
    char* kl_ = K_lds + (b) * SHM_K + krw * KROW + kch * 16; \
    *(bf16x8*)(kl_) = ks0; *(bf16x8*)(kl_ + 128) = ks1; *(bf16x8*)(kl_ + 256) = ks2; } while (0)
#define SWAIT() asm volatile("s_waitcnt vmcnt(0)" ::: "memory")
#define RESC(a) do { if (__any((a) < 1.f)) { if (hi == 0) al_l[r32] = (a); asm volatile("s_waitcnt lgkmcnt(0)" ::: "memory"); \
    for (int d = 0; d < 4; ++d) for (int r = 0; r < 16; ++r) o[d][r] *= al_l[crow(r, hi)]; } } while (0)
  f32x16 pA0, pA1, pB0, pB1; float mnA, mnB, alA, alB; bf16x8 pa0, pa1, pa2, pa3; const int NTL = nkeys / KVBLK;
  SLOAD(0); SWAIT(); SWRITE(0); __syncthreads();
  qkt(pA0, pA1, K_lds, qr, qrl, r32, hi); partialSM(pA0, pA1, m_reg, mnA, alA);
  SLOAD(KVBLK);
  SWAIT(); SWRITE(1); __syncthreads();
  for (int j = 1; j + 1 < NTL; j += 2) {
    SBAR(); qkt(pB0, pB1, K_lds + SHM_K, qr, qrl, r32, hi);
    finishSM(pA0, pA1, alA, l_reg, pa0, pa1, pa2, pa3); SBAR();
    SLOAD((j + 1) * KVBLK); SBAR();
    pv_d0(o, vb0, pa0, pa1, pa2, pa3); partialSM(pB0, pB1, m_reg, mnB, alB);
    __syncthreads(); SWAIT(); SWRITE(0);
    RESC(alB); __syncthreads();
    SBAR(); qkt(pA0, pA1, K_lds, qr, qrl, r32, hi);
    finishSM(pB0, pB1, alB, l_reg, pa0, pa1, pa2, pa3); SBAR();
    SLOAD((j + 2) * KVBLK); SBAR();
    pv_d0(o, vb0 + SHM_V, pa0, pa1, pa2, pa3); partialSM(pA0, pA1, m_reg, mnA, alA);
    __syncthreads(); SWAIT(); SWRITE(1);
    RESC(alA); __syncthreads();
  }
  SBAR(); qkt(pB0, pB1, K_lds + SHM_K, qr, qrl, r32, hi);
  finishSM(pA0, pA1, alA, l_reg, pa0, pa1, pa2, pa3); SBAR();
  pv_d0(o, vb0, pa0, pa1, pa2, pa3); partialSM(pB0, pB1, m_reg, mnB, alB);
  __syncthreads(); RESC(alB);
  finishSM(pB0, pB1, alB, l_reg, pa0, pa1, pa2, pa3); SBAR();
  pv_d0(o, vb0 + SHM_V, pa0, pa1, pa2, pa3);
  if (hi == 0) li_l[r32] = l_reg; asm volatile("s_waitcnt lgkmcnt(0)" ::: "memory");
  float rli[16];
#pragma unroll
  for (int r = 0; r < 16; ++r) rli[r] = __builtin_amdgcn_rcpf(li_l[crow(r, hi)]);
  bf16_t* Ow = Ob + (size_t)(wid * 32) * D;
#pragma unroll
  for (int r = 0; r < 16; ++r) { const int orow = crow(r, hi);
#pragma unroll
    for (int d0 = 0; d0 < 4; ++d0) Ow[(size_t)orow * D + d0 * 32 + r32] = f2bf(o[d0][r] * rli[r]); }
  __syncthreads();
#undef SLOAD
#undef SWRITE
#undef SWAIT
#undef RESC
}
}

__device__ __forceinline__ void ph_attn(const bf16_t* __restrict__ Qa, const bf16_t* __restrict__ Kn, const bf16_t* __restrict__ Kr, const bf16_t* __restrict__ Va,
                                        bf16_t* __restrict__ AO, int bid, int nblk, char* lds) {
  for (int item = bid; item < 512; item += nblk) {
    const int b = item >> 8, h = item & 7, qb = (item >> 3) & 31;
    att::attn_body(Qa + ((size_t)(b * 8 + h) * SEQ + qb * 256) * 192, Kn + (size_t)(b * 8 + h) * KEYS * 128, Kr + (size_t)b * KEYS * 64,
                   Va + (size_t)(b * 8 + h) * KEYS * 128, AO + (size_t)(b * SEQ + qb * 256) * D + h * 128, KEYS, lds);
  }
}

namespace rt {
using f32x16 = __attribute__((ext_vector_type(16))) float;
__device__ __forceinline__ int sortable(float f) { const int b = __float_as_int(f); return b ^ ((b >> 31) & 0x7FFFFFFF); }
__device__ __forceinline__ float unsortable(int k) { return __int_as_float(k ^ ((k >> 31) & 0x7FFFFFFF)); }
__device__ __forceinline__ int imax(int a, int b) { return a > b ? a : b; }
__device__ __forceinline__ int imin(int a, int b) { return a < b ? a : b; }
template <int N> __device__ __forceinline__ void sort_desc(int (&v)[N]) {
#pragma unroll
  for (int k = 2; k <= N; k <<= 1) {
#pragma unroll
    for (int j = k >> 1; j > 0; j >>= 1) {
#pragma unroll
      for (int i = 0; i < N; ++i) {
        const int l = i ^ j;
        if (l > i) {
          const bool desc = ((i & k) == 0);
          const int a = v[i], b = v[l];
          v[i] = desc ? imax(a, b) : imin(a, b);
          v[l] = desc ? imin(a, b) : imax(a, b);
        }
      }
    }
  }
}
template <int N> __device__ __forceinline__ void merge_desc(int (&v)[N]) {
#pragma unroll
  for (int j = N >> 1; j > 0; j >>= 1) {
#pragma unroll
    for (int i = 0; i < N; ++i) {
      const int l = i ^ j;
      if (l > i) { const int a = v[i], b = v[l]; v[i] = imax(a, b); v[l] = imin(a, b); }
    }
  }
}
__device__ __forceinline__ void absorb16(int (&L)[16], int (&B)[16]) {
  sort_desc<16>(B);
#pragma unroll
  for (int i = 0; i < 16; ++i) L[i] = imax(L[i], B[15 - i]);
  merge_desc<16>(L);
}
__device__ __forceinline__ constexpr int npairs_row(int i) { return 16 / (i + 1); }
}

struct RouteP { const float* Q; const bf16_t* Khi; const bf16_t* Klo; int* IDX; float* GATE; int rows_per_block; int pad; };
__device__ __forceinline__ void ph_route(const RouteP& p, int bid, char* lds) {
  using namespace rt;
  int (*svl)[64][33] = reinterpret_cast<int (*)[64][33]>(lds);
  const int wave = otid() >> 6, lane = otid() & 63, r32 = lane & 31, hi = lane >> 5, hi4 = hi * 4;
  int nrows = p.rows_per_block; asm volatile("" : "+s"(nrows));
  const int g0 = bid * nrows;
  const int h = wave;
#pragma unroll 1
  for (int tg = 0; tg * 32 < nrows; ++tg) {
    int trow = tg * 32 + r32; const bool valid = trow < nrows; trow = valid ? trow : nrows - 1;
    const float* qrow = p.Q + (size_t)(g0 + trow) * D;
    int sv[2][16];
#pragma unroll
    for (int s = 0; s < 2; ++s) {
      const int hs = h * 2 + s;
      f32x16 acc[4];
#pragma unroll
      for (int m = 0; m < 4; ++m) acc[m] = f32x16{};
#pragma unroll
      for (int ks = 0; ks < 4; ++ks) {
        const float4 qa = *(const float4*)(qrow + hs * 64 + ks * 16 + hi * 8), qb = *(const float4*)(qrow + hs * 64 + ks * 16 + hi * 8 + 4);
        uint4 qh, ql;
        qh.x = pack2bf(qa.x, qa.y); qh.y = pack2bf(qa.z, qa.w); qh.z = pack2bf(qb.x, qb.y); qh.w = pack2bf(qb.z, qb.w);
        ql.x = pack2bf(qa.x - bflo(qh.x), qa.y - bfhi(qh.x)); ql.y = pack2bf(qa.z - bflo(qh.y), qa.w - bfhi(qh.y));
        ql.z = pack2bf(qb.x - bflo(qh.z), qb.y - bfhi(qh.z)); ql.w = pack2bf(qb.z - bflo(qh.w), qb.w - bfhi(qh.w));
        const bf16x8 bqh = *reinterpret_cast<const bf16x8*>(&qh), bql = *reinterpret_cast<const bf16x8*>(&ql);
#pragma unroll
        for (int m = 0; m < 4; ++m) {
          const size_t ko = ((size_t)(hs * 128 + m * 32 + r32)) * 64 + ks * 16 + hi * 8;
          const bf16x8 kh = *(const bf16x8*)(p.Khi + ko), kl = *(const bf16x8*)(p.Klo + ko);
          acc[m] = __builtin_amdgcn_mfma_f32_32x32x16_bf16(kh, bqh, acc[m], 0, 0, 0);
          acc[m] = __builtin_amdgcn_mfma_f32_32x32x16_bf16(kh, bql, acc[m], 0, 0, 0);
          acc[m] = __builtin_amdgcn_mfma_f32_32x32x16_bf16(kl, bqh, acc[m], 0, 0, 0);
        }
      }
      int L[16];
#pragma unroll
      for (int m = 0; m < 4; ++m) {
        int B[16];
#pragma unroll
        for (int r = 0; r < 16; ++r) B[r] = (sortable(acc[m][r]) & ~0x7F) | (m * 32 + (r & 3) + 8 * (r >> 2)) | hi4;
        if (m == 0) { sort_desc<16>(B);
#pragma unroll
          for (int i = 0; i < 16; ++i) L[i] = B[i]; }
        else absorb16(L, B);
      }
      int Lo[16], Hi[16];
#pragma unroll
      for (int i = 0; i < 16; ++i) { auto rr = __builtin_amdgcn_permlane32_swap((unsigned)L[i], (unsigned)L[i], false, false); Lo[i] = (int)rr[0]; Hi[i] = (int)rr[1]; }
#pragma unroll
      for (int i = 0; i < 16; ++i) L[i] = imax(Lo[i], Hi[15 - i]);
      merge_desc<16>(L);
#pragma unroll
      for (int i = 0; i < 16; ++i) { sv[s][i] = L[i]; svl[wave][lane][s * 16 + i] = L[i]; }
    }
    float f0[16], f1[16];
#pragma unroll
    for (int i = 0; i < 16; ++i) { f0[i] = unsortable(sv[0][i] & ~0x7F); f1[i] = unsortable(sv[1][i] & ~0x7F); }
    int Lc[16];
    {
      int C[64];
      int n = 0;
#pragma unroll
      for (int i = 0; i < 16; ++i)
#pragma unroll
        for (int j = 0; j < 16; ++j)
          if ((i + 1) * (j + 1) <= 16) { C[n] = (sortable(f0[i] + f1[j]) & ~0xFF) | (i * 16 + j); ++n; }
#pragma unroll
      for (int k = 50; k < 64; ++k) C[k] = (int)0x80000000;
#pragma unroll
      for (int m = 0; m < 4; ++m) {
        int B[16];
#pragma unroll
        for (int r = 0; r < 16; ++r) B[r] = C[m * 16 + r];
        if (m == 0) { sort_desc<16>(B);
#pragma unroll
          for (int i = 0; i < 16; ++i) Lc[i] = B[i]; }
        else absorb16(Lc, B);
      }
    }
    float e[16]; float esum = 0.f;
    const float vmax = unsortable(Lc[0] & ~0xFF);
#pragma unroll
    for (int r = 0; r < 16; ++r) { e[r] = expf(unsortable(Lc[r] & ~0xFF) - vmax); esum += e[r]; }
    const float inv = 1.f / esum;
    int eid[16];
#pragma unroll
    for (int r = 0; r < 16; ++r) {
      const int pr = Lc[r] & 0xFF;
      const int k0 = svl[wave][lane][pr >> 4] & 0x7F, k1 = svl[wave][lane][16 + (pr & 15)] & 0x7F;
      eid[r] = k0 * 128 + k1;
    }
    if (valid && hi == 0) {
      int* ip = p.IDX + (size_t)(g0 + trow) * 128 + h * 16; float* gp = p.GATE + (size_t)(g0 + trow) * 128 + h * 16;
#pragma unroll
      for (int r = 0; r < 16; r += 4) {
        *(int4*)(ip + r) = make_int4(eid[r], eid[r + 1], eid[r + 2], eid[r + 3]);
        *(float4*)(gp + r) = make_float4(e[r] * inv, e[r + 1] * inv, e[r + 2] * inv, e[r + 3] * inv);
      }
    }
  }
}

__device__ __forceinline__ float wave_sum_dpp(float v) {
  v += __uint_as_float(__builtin_amdgcn_update_dpp(0u, __float_as_uint(v), 0xB1, 0xF, 0xF, true));
  v += __uint_as_float(__builtin_amdgcn_update_dpp(0u, __float_as_uint(v), 0x4E, 0xF, 0xF, true));
  v += __uint_as_float(__builtin_amdgcn_update_dpp(0u, __float_as_uint(v), 0x141, 0xF, 0xF, true));
  v += __uint_as_float(__builtin_amdgcn_update_dpp(0u, __float_as_uint(v), 0x140, 0xF, 0xF, true));
  v += __uint_as_float(__builtin_amdgcn_update_dpp(0u, __float_as_uint(v), 0x142, 0xA, 0xF, true));
  v += __uint_as_float(__builtin_amdgcn_update_dpp(0u, __float_as_uint(v), 0x143, 0xC, 0xF, true));
  return __uint_as_float((unsigned)__builtin_amdgcn_readlane((int)__float_as_uint(v), 63));
}
__device__ __forceinline__ float gelu_fast(float x) {
  const float z = fabsf(x) * 0.70710678118654752f;
  const float t = __builtin_amdgcn_rcpf(fmaf(0.3275911f, z, 1.f));
  float pl = fmaf(1.061405429f, t, -1.453152027f); pl = fmaf(pl, t, 1.421413741f); pl = fmaf(pl, t, -0.284496736f); pl = fmaf(pl, t, 0.254829592f);
  const float e = __builtin_amdgcn_exp2f(-z * z * 1.4426950408889634f);
  const float erfa = 1.f - pl * t * e;
  const float hx = 0.5f * x;
  return hx + fabsf(hx) * erfa;
}
__device__ __forceinline__ void cvt_rows_i8(const float* __restrict__ src, unsigned char* __restrict__ dst, float* __restrict__ scl, int nrows, int wgid, int nw) {
  const int lane = otid() & 63;
  for (int r = wgid; r < nrows; r += nw) {
    float v[16];
    const float4* sp = (const float4*)(src + (size_t)r * D + lane * 16);
    *(float4*)&v[0] = sp[0]; *(float4*)&v[4] = sp[1]; *(float4*)&v[8] = sp[2]; *(float4*)&v[12] = sp[3];
    float am = 0.f;
#pragma unroll
    for (int j = 0; j < 16; ++j) am = fmaxf(am, fabsf(v[j]));
#pragma unroll
    for (int o = 32; o >= 1; o >>= 1) am = fmaxf(am, __shfl_xor(am, o));
    const float sc = am > 0.f ? am * (1.f / 127.f) : 1.f, inv = 1.f / sc;
    unsigned w[4];
#pragma unroll
    for (int q4 = 0; q4 < 4; ++q4) {
      unsigned ww = 0u;
#pragma unroll
      for (int j = 0; j < 4; ++j) { int qi = (int)rintf(v[q4 * 4 + j] * inv) + 128; qi = qi < 1 ? 1 : (qi > 255 ? 255 : qi); ww |= (unsigned)qi << (8 * j); }
      w[q4] = ww;
    }
    *(uint4*)(dst + (size_t)r * D + lane * 16) = make_uint4(w[0], w[1], w[2], w[3]);
    if (lane == 0) scl[r] = sc;
  }
}

struct GatherP { const bf16_t* Tbf; const int* IDX; const float* GATE; const unsigned char* utab; const unsigned char* vtab; const float* su; const float* sv;
                 const float* Hin; const float* mod; const float* lng; const float* lnb; float* Hout; const float* modT; };
constexpr int BSHIFT = 9, NBUCK = 16384 >> BSHIFT;
constexpr int ECHUNK = 32, ECAP = 512;
#define UB0(w) ((float)((w) & 0xFFu))
#define UB1(w) ((float)(((w) >> 8) & 0xFFu))
#define UB2(w) ((float)(((w) >> 16) & 0xFFu))
#define UB3(w) ((float)((w) >> 24))
template <int RS, int NROUND, bool FINAL>
__device__ __forceinline__ void ph_gather_i8(const GatherP& p, int g0, int nrows, char* As, unsigned* __restrict__ ENTb, float* __restrict__ GATb) {
  const int tid = otid(), wave = tid >> 6, lane = tid & 63;
  load_rows_lds(As, p.Tbf + (size_t)g0 * D, nrows);
  unsigned* ent = ENTb + wave * ECAP; float* gat = GATb + wave * ECAP;
  const unsigned long long ltm = (1ull << lane) - 1ull;
  __syncthreads();
#pragma unroll 1
  for (int round = 0; round < NROUND; ++round) {
    const int s0 = round * RS;
    int cnt = 0;
#pragma unroll 1
    for (int i = 0; i < RS; ++i) {
      const int rr = wave + 8 * (s0 + i);
      if (rr < nrows) {
        const size_t ro = (size_t)(g0 + rr) * 128;
        const int a = p.IDX[ro + lane] >> BSHIFT, b = p.IDX[ro + 64 + lane] >> BSHIFT;
#pragma unroll 4
        for (int v = 0; v < NBUCK; ++v) { const int c = __popcll(__ballot(a == v)) + __popcll(__ballot(b == v)); if (lane == v) cnt += c; }
      }
    }
    int incl = cnt;
#pragma unroll
    for (int o = 1; o < 64; o <<= 1) { const int t = __shfl_up(incl, o); if (lane >= o) incl += t; }
    int base = incl - cnt;
    const int total = __builtin_amdgcn_readlane(incl, 63);
    float tsum[RS];
#pragma unroll
    for (int i = 0; i < RS; ++i) tsum[i] = 0.f;
#pragma unroll 1
    for (int i = 0; i < RS; ++i) {
      const int rr = wave + 8 * (s0 + i);
      if (rr < nrows) {
        const size_t ro = (size_t)(g0 + rr) * 128;
        const int ea = p.IDX[ro + lane], eb = p.IDX[ro + 64 + lane];
        const float ga = p.GATE[ro + lane], gb = p.GATE[ro + 64 + lane];
        const int a = ea >> BSHIFT, b = eb >> BSHIFT;
        int pa = 0, pb = 0;
#pragma unroll 4
        for (int v = 0; v < NBUCK; ++v) {
          const unsigned long long m0 = __ballot(a == v), m1 = __ballot(b == v);
          const int bv = __shfl(base, v), c0 = __popcll(m0);
          if (a == v) pa = bv + __popcll(m0 & ltm);
          if (b == v) pb = bv + c0 + __popcll(m1 & ltm);
          if (lane == v) base += c0 + __popcll(m1);
        }
        ent[pa] = (unsigned)ea | ((unsigned)i << 16); gat[pa] = ga;
        ent[pb] = (unsigned)eb | ((unsigned)i << 16); gat[pb] = gb;
        const char* tp = As + rr * LDA_B + lane * 32;
        const uint4 t0 = *(const uint4*)tp, t1 = *(const uint4*)(tp + 16);
        float ts = bflo(t0.x) + bfhi(t0.x) + bflo(t0.y) + bfhi(t0.y) + bflo(t0.z) + bfhi(t0.z) + bflo(t0.w) + bfhi(t0.w)
                 + bflo(t1.x) + bfhi(t1.x) + bflo(t1.y) + bfhi(t1.y) + bflo(t1.z) + bfhi(t1.z) + bflo(t1.w) + bfhi(t1.w);
        ts = wave_sum_dpp(ts);
#pragma unroll
        for (int k = 0; k < RS; ++k) if (k == i) tsum[k] = ts;
      }
    }
    int nvalid0 = 0;
#pragma unroll
    for (int i = 0; i < RS; ++i) nvalid0 += (8 * (s0 + i) < nrows) ? 1 : 0;
    const int nchunks = (128 * nvalid0 + ECHUNK - 1) / ECHUNK;
    for (int k = total + lane; k < (nchunks + 2) * ECHUNK; k += 64) { ent[k] = 0u; gat[k] = 0.f; }
    asm volatile("s_waitcnt vmcnt(0)" ::: "memory");
    float f[RS][16], asum[RS];
#pragma unroll
    for (int i = 0; i < RS; ++i) { asum[i] = 0.f;
#pragma unroll
      for (int j = 0; j < 16; ++j) f[i][j] = 0.f; }
    uint4 ub[8], vb[8]; float sub[8], svb[8];
    unsigned ecur = ent[lane & 31], enxt = ent[ECHUNK + (lane & 31)];
    float gcur = gat[lane & 31], gnxt = gat[ECHUNK + (lane & 31)];
#define ROWLOAD3(slot, ep) do { const unsigned e_ = (ep) & 0xFFFFu; \
        ub[slot] = *(const uint4*)(p.utab + (size_t)e_ * D + lane * 16); vb[slot] = *(const uint4*)(p.vtab + (size_t)e_ * D + lane * 16); \
        sub[slot] = p.su[e_]; svb[slot] = p.sv[e_]; } while (0)
#define ROWPROC3(slot, ep, gv) do { \
        const int ts_ = (int)((ep) >> 16); \
        const char* tp_ = As + (wave + 8 * (s0 + ts_)) * LDA_B + lane * 32; \
        const uint4 t0_ = *(const uint4*)tp_, t1_ = *(const uint4*)(tp_ + 16); \
        const uint4 a_ = ub[slot]; \
        float dot_ = bflo(t0_.x) * UB0(a_.x); dot_ = fmaf(bfhi(t0_.x), UB1(a_.x), dot_); dot_ = fmaf(bflo(t0_.y), UB2(a_.x), dot_); dot_ = fmaf(bfhi(t0_.y), UB3(a_.x), dot_); \
        dot_ = fmaf(bflo(t0_.z), UB0(a_.y), dot_); dot_ = fmaf(bfhi(t0_.z), UB1(a_.y), dot_); dot_ = fmaf(bflo(t0_.w), UB2(a_.y), dot_); dot_ = fmaf(bfhi(t0_.w), UB3(a_.y), dot_); \
        dot_ = fmaf(bflo(t1_.x), UB0(a_.z), dot_); dot_ = fmaf(bfhi(t1_.x), UB1(a_.z), dot_); dot_ = fmaf(bflo(t1_.y), UB2(a_.z), dot_); dot_ = fmaf(bfhi(t1_.y), UB3(a_.z), dot_); \
        dot_ = fmaf(bflo(t1_.z), UB0(a_.w), dot_); dot_ = fmaf(bfhi(t1_.z), UB1(a_.w), dot_); dot_ = fmaf(bflo(t1_.w), UB2(a_.w), dot_); dot_ = fmaf(bfhi(t1_.w), UB3(a_.w), dot_); \
        dot_ = wave_sum_dpp(dot_); \
        float tsv_ = tsum[0]; \
        _Pragma("unroll") for (int i_ = 1; i_ < RS; ++i_) tsv_ = (ts_ == i_) ? tsum[i_] : tsv_; \
        const float act_ = gelu_fast(sub[slot] * (dot_ - 128.f * tsv_)) * (gv) * svb[slot]; \
        const uint4 c_ = vb[slot]; \
        float x_[16] = {UB0(c_.x), UB1(c_.x), UB2(c_.x), UB3(c_.x), UB0(c_.y), UB1(c_.y), UB2(c_.y), UB3(c_.y), UB0(c_.z), UB1(c_.z), UB2(c_.z), UB3(c_.z), UB0(c_.w), UB1(c_.w), UB2(c_.w), UB3(c_.w)}; \
        _Pragma("unroll") for (int i_ = 0; i_ < RS; ++i_) { const float m_ = (ts_ == i_) ? act_ : 0.f;        \
          asum[i_] += m_; \
          _Pragma("unroll") for (int j_ = 0; j_ < 16; ++j_) f[i_][j_] = fmaf(m_, x_[j_], f[i_][j_]); } } while (0)
#define RL(v, j) ((unsigned)__builtin_amdgcn_readlane((int)(v), (j)))
#define RLF(v, j) __uint_as_float((unsigned)__builtin_amdgcn_readlane((int)__float_as_uint(v), (j)))
    ROWLOAD3(0, RL(ecur, 0)); ROWLOAD3(1, RL(ecur, 1)); ROWLOAD3(2, RL(ecur, 2)); ROWLOAD3(3, RL(ecur, 3)); ROWLOAD3(4, RL(ecur, 4)); ROWLOAD3(5, RL(ecur, 5)); ROWLOAD3(6, RL(ecur, 6)); ROWLOAD3(7, RL(ecur, 7));
#pragma unroll 1
    for (int c = 0; c < nchunks; ++c) {
      __syncthreads();
#pragma unroll 1
      for (int j = 0; j < ECHUNK - 8; j += 8) {
        ROWPROC3(0, RL(ecur, j + 0), RLF(gcur, j + 0)); ROWLOAD3(0, RL(ecur, j + 8));
        ROWPROC3(1, RL(ecur, j + 1), RLF(gcur, j + 1)); ROWLOAD3(1, RL(ecur, j + 9));
        ROWPROC3(2, RL(ecur, j + 2), RLF(gcur, j + 2)); ROWLOAD3(2, RL(ecur, j + 10));
        ROWPROC3(3, RL(ecur, j + 3), RLF(gcur, j + 3)); ROWLOAD3(3, RL(ecur, j + 11));
        ROWPROC3(4, RL(ecur, j + 4), RLF(gcur, j + 4)); ROWLOAD3(4, RL(ecur, j + 12));
        ROWPROC3(5, RL(ecur, j + 5), RLF(gcur, j + 5)); ROWLOAD3(5, RL(ecur, j + 13));
        ROWPROC3(6, RL(ecur, j + 6), RLF(gcur, j + 6)); ROWLOAD3(6, RL(ecur, j + 14));
        ROWPROC3(7, RL(ecur, j + 7), RLF(gcur, j + 7)); ROWLOAD3(7, RL(ecur, j + 15));
      }
      ROWPROC3(0, RL(ecur, ECHUNK - 8), RLF(gcur, ECHUNK - 8)); ROWLOAD3(0, RL(enxt, 0));
      ROWPROC3(1, RL(ecur, ECHUNK - 7), RLF(gcur, ECHUNK - 7)); ROWLOAD3(1, RL(enxt, 1));
      ROWPROC3(2, RL(ecur, ECHUNK - 6), RLF(gcur, ECHUNK - 6)); ROWLOAD3(2, RL(enxt, 2));
      ROWPROC3(3, RL(ecur, ECHUNK - 5), RLF(gcur, ECHUNK - 5)); ROWLOAD3(3, RL(enxt, 3));
      ROWPROC3(4, RL(ecur, ECHUNK - 4), RLF(gcur, ECHUNK - 4)); ROWLOAD3(4, RL(enxt, 4));
      ROWPROC3(5, RL(ecur, ECHUNK - 3), RLF(gcur, ECHUNK - 3)); ROWLOAD3(5, RL(enxt, 5));
      ROWPROC3(6, RL(ecur, ECHUNK - 2), RLF(gcur, ECHUNK - 2)); ROWLOAD3(6, RL(enxt, 6));
      ROWPROC3(7, RL(ecur, ECHUNK - 1), RLF(gcur, ECHUNK - 1)); ROWLOAD3(7, RL(enxt, 7));
      ecur = enxt; gcur = gnxt;
      enxt = ent[(c + 2) * ECHUNK + (lane & 31)]; gnxt = gat[(c + 2) * ECHUNK + (lane & 31)];
    }
#undef ROWLOAD3
#undef ROWPROC3
#undef RL
#undef RLF
#pragma unroll
    for (int i = 0; i < RS; ++i) {
      int rr = wave + 8 * (s0 + i); asm volatile("" : "+v"(rr));
      if (rr < nrows) {
        const int row = g0 + rr, v = row_vec(row);
        const float* hin = p.Hin + (size_t)row * D + lane * 16;
        const float* gm = p.mod + v * 6144 + 5 * 1024 + lane * 16;
        const float off = 128.f * asum[i];
        float r[16]; float ssum = 0.f;
#pragma unroll
        for (int q4 = 0; q4 < 4; ++q4) {
          const float4 h4 = *(const float4*)(hin + q4 * 4), g4 = *(const float4*)(gm + q4 * 4);
          r[q4 * 4 + 0] = ALPHA * h4.x + g4.x * (f[i][q4 * 4 + 0] - off); r[q4 * 4 + 1] = ALPHA * h4.y + g4.y * (f[i][q4 * 4 + 1] - off);
          r[q4 * 4 + 2] = ALPHA * h4.z + g4.z * (f[i][q4 * 4 + 2] - off); r[q4 * 4 + 3] = ALPHA * h4.w + g4.w * (f[i][q4 * 4 + 3] - off);
          ssum += r[q4 * 4 + 0] + r[q4 * 4 + 1] + r[q4 * 4 + 2] + r[q4 * 4 + 3];
        }
        const float mu = wave_sum(ssum) * (1.f / D);
        float vs = 0.f;
#pragma unroll
        for (int j = 0; j < 16; ++j) { const float dlt = r[j] - mu; vs += dlt * dlt; }
        const float rstd = rsqrtf(wave_sum(vs) * (1.f / D) + LN_EPS);
        float o[16];
#pragma unroll
        for (int q4 = 0; q4 < 4; ++q4) {
          const float4 g4 = *(const float4*)(p.lng + lane * 16 + q4 * 4), b4 = *(const float4*)(p.lnb + lane * 16 + q4 * 4);
          o[q4 * 4 + 0] = (r[q4 * 4 + 0] - mu) * rstd * g4.x + b4.x; o[q4 * 4 + 1] = (r[q4 * 4 + 1] - mu) * rstd * g4.y + b4.y;
          o[q4 * 4 + 2] = (r[q4 * 4 + 2] - mu) * rstd * g4.z + b4.z; o[q4 * 4 + 3] = (r[q4 * 4 + 3] - mu) * rstd * g4.w + b4.w;
          *(float4*)(p.Hout + (size_t)row * D + lane * 16 + q4 * 4) = make_float4(o[q4 * 4 + 0], o[q4 * 4 + 1], o[q4 * 4 + 2], o[q4 * 4 + 3]);
        }
        if (!FINAL) {
          const float* mt = p.modT + v * 6144 + lane * 16;
          unsigned w[8];
#pragma unroll
          for (int q2 = 0; q2 < 8; ++q2) {
            const float2 sh = *(const float2*)(mt + q2 * 2), sc = *(const float2*)(mt + 1024 + q2 * 2);
            w[q2] = pack2bf(o[q2 * 2] * (1.f + sc.x) + sh.x, o[q2 * 2 + 1] * (1.f + sc.y) + sh.y);
          }
          *(uint4*)(As + rr * LDA_B + lane * 32) = make_uint4(w[0], w[1], w[2], w[3]);
          *(uint4*)(As + rr * LDA_B + lane * 32 + 16) = make_uint4(w[4], w[5], w[6], w[7]);
        }
      }
    }
  }
}


template <bool FINAL>
__device__ __forceinline__ void ph_gather_tm(const GatherP& p, int g0, int nrows, char* As) {
  const int tid = otid(), wave = tid >> 6, lane = tid & 63;
#pragma unroll 1
  for (int rr = wave; rr < nrows; rr += 8) {
    const int row = g0 + rr;
    float tf[16];
    {
      const uint4 t0 = *(const uint4*)(p.Tbf + (size_t)row * D + lane * 16), t1 = *(const uint4*)(p.Tbf + (size_t)row * D + lane * 16 + 8);
      tf[0] = bflo(t0.x); tf[1] = bfhi(t0.x); tf[2] = bflo(t0.y); tf[3] = bfhi(t0.y); tf[4] = bflo(t0.z); tf[5] = bfhi(t0.z); tf[6] = bflo(t0.w); tf[7] = bfhi(t0.w);
      tf[8] = bflo(t1.x); tf[9] = bfhi(t1.x); tf[10] = bflo(t1.y); tf[11] = bfhi(t1.y); tf[12] = bflo(t1.z); tf[13] = bfhi(t1.z); tf[14] = bflo(t1.w); tf[15] = bfhi(t1.w);
    }
    float tsum = 0.f;
#pragma unroll
    for (int j = 0; j < 16; ++j) tsum += tf[j];
    tsum = wave_sum_dpp(tsum) * 128.f;
    const int id_lo = p.IDX[(size_t)row * 128 + lane], id_hi = p.IDX[(size_t)row * 128 + 64 + lane];
    const float ga_lo = p.GATE[(size_t)row * 128 + lane], ga_hi = p.GATE[(size_t)row * 128 + 64 + lane];
    float f[16], asum = 0.f;
#pragma unroll
    for (int j = 0; j < 16; ++j) f[j] = 0.f;
    uint4 ub[8], vb[8]; float sub[8], svb[8];
#define TLOAD(slot, kk) do { const int e_ = __builtin_amdgcn_readlane((kk) < 64 ? id_lo : id_hi, (kk) & 63); \
      ub[slot] = *(const uint4*)(p.utab + (size_t)e_ * D + lane * 16); vb[slot] = *(const uint4*)(p.vtab + (size_t)e_ * D + lane * 16); \
      sub[slot] = p.su[e_]; svb[slot] = p.sv[e_]; } while (0)
#define TPROC(slot, kk) do { \
      const uint4 a_ = ub[slot]; \
      float dot_ = tf[0] * UB0(a_.x); dot_ = fmaf(tf[1], UB1(a_.x), dot_); dot_ = fmaf(tf[2], UB2(a_.x), dot_); dot_ = fmaf(tf[3], UB3(a_.x), dot_); \
      dot_ = fmaf(tf[4], UB0(a_.y), dot_); dot_ = fmaf(tf[5], UB1(a_.y), dot_); dot_ = fmaf(tf[6], UB2(a_.y), dot_); dot_ = fmaf(tf[7], UB3(a_.y), dot_); \
      dot_ = fmaf(tf[8], UB0(a_.z), dot_); dot_ = fmaf(tf[9], UB1(a_.z), dot_); dot_ = fmaf(tf[10], UB2(a_.z), dot_); dot_ = fmaf(tf[11], UB3(a_.z), dot_); \
      dot_ = fmaf(tf[12], UB0(a_.w), dot_); dot_ = fmaf(tf[13], UB1(a_.w), dot_); dot_ = fmaf(tf[14], UB2(a_.w), dot_); dot_ = fmaf(tf[15], UB3(a_.w), dot_); \
      dot_ = wave_sum_dpp(dot_); \
      const float g_ = __uint_as_float((unsigned)__builtin_amdgcn_readlane((int)__float_as_uint((kk) < 64 ? ga_lo : ga_hi), (kk) & 63)); \
      const float act_ = gelu_fast(sub[slot] * (dot_ - tsum)) * g_ * svb[slot]; \
      asum += act_; \
      const uint4 c_ = vb[slot]; \
      f[0] = fmaf(act_, UB0(c_.x), f[0]); f[1] = fmaf(act_, UB1(c_.x), f[1]); f[2] = fmaf(act_, UB2(c_.x), f[2]); f[3] = fmaf(act_, UB3(c_.x), f[3]); \
      f[4] = fmaf(act_, UB0(c_.y), f[4]); f[5] = fmaf(act_, UB1(c_.y), f[5]); f[6] = fmaf(act_, UB2(c_.y), f[6]); f[7] = fmaf(act_, UB3(c_.y), f[7]); \
      f[8] = fmaf(act_, UB0(c_.z), f[8]); f[9] = fmaf(act_, UB1(c_.z), f[9]); f[10] = fmaf(act_, UB2(c_.z), f[10]); f[11] = fmaf(act_, UB3(c_.z), f[11]); \
      f[12] = fmaf(act_, UB0(c_.w), f[12]); f[13] = fmaf(act_, UB1(c_.w), f[13]); f[14] = fmaf(act_, UB2(c_.w), f[14]); f[15] = fmaf(act_, UB3(c_.w), f[15]); } while (0)
    TLOAD(0, 0); TLOAD(1, 1); TLOAD(2, 2); TLOAD(3, 3); TLOAD(4, 4); TLOAD(5, 5); TLOAD(6, 6); TLOAD(7, 7);
#pragma unroll 1
    for (int k = 0; k < 120; k += 8) {
      TPROC(0, k); TLOAD(0, k + 8); TPROC(1, k + 1); TLOAD(1, k + 9); TPROC(2, k + 2); TLOAD(2, k + 10); TPROC(3, k + 3); TLOAD(3, k + 11);
      TPROC(4, k + 4); TLOAD(4, k + 12); TPROC(5, k + 5); TLOAD(5, k + 13); TPROC(6, k + 6); TLOAD(6, k + 14); TPROC(7, k + 7); TLOAD(7, k + 15);
    }
    TPROC(0, 120); TPROC(1, 121); TPROC(2, 122); TPROC(3, 123); TPROC(4, 124); TPROC(5, 125); TPROC(6, 126); TPROC(7, 127);
#undef TLOAD
#undef TPROC
    const int v = row_vec(row);
    const float* hin = p.Hin + (size_t)row * D + lane * 16;
    const float* gm = p.mod + v * 6144 + 5 * 1024 + lane * 16;
    const float off = 128.f * asum;
    float r[16]; float ssum = 0.f;
#pragma unroll
    for (int q4 = 0; q4 < 4; ++q4) {
      const float4 h4 = *(const float4*)(hin + q4 * 4), g4 = *(const float4*)(gm + q4 * 4);
      r[q4 * 4 + 0] = ALPHA * h4.x + g4.x * (f[q4 * 4 + 0] - off); r[q4 * 4 + 1] = ALPHA * h4.y + g4.y * (f[q4 * 4 + 1] - off);
      r[q4 * 4 + 2] = ALPHA * h4.z + g4.z * (f[q4 * 4 + 2] - off); r[q4 * 4 + 3] = ALPHA * h4.w + g4.w * (f[q4 * 4 + 3] - off);
      ssum += r[q4 * 4 + 0] + r[q4 * 4 + 1] + r[q4 * 4 + 2] + r[q4 * 4 + 3];
    }
    const float mu = wave_sum(ssum) * (1.f / D);
    float vs = 0.f;
#pragma unroll
    for (int j = 0; j < 16; ++j) { const float dlt = r[j] - mu; vs += dlt * dlt; }
    const float rstd = rsqrtf(wave_sum(vs) * (1.f / D) + LN_EPS);
    float o[16];
#pragma unroll
    for (int q4 = 0; q4 < 4; ++q4) {
      const float4 g4 = *(const float4*)(p.lng + lane * 16 + q4 * 4), b4 = *(const float4*)(p.lnb + lane * 16 + q4 * 4);
      o[q4 * 4 + 0] = (r[q4 * 4 + 0] - mu) * rstd * g4.x + b4.x; o[q4 * 4 + 1] = (r[q4 * 4 + 1] - mu) * rstd * g4.y + b4.y;
      o[q4 * 4 + 2] = (r[q4 * 4 + 2] - mu) * rstd * g4.z + b4.z; o[q4 * 4 + 3] = (r[q4 * 4 + 3] - mu) * rstd * g4.w + b4.w;
      *(float4*)(p.Hout + (size_t)row * D + lane * 16 + q4 * 4) = make_float4(o[q4 * 4 + 0], o[q4 * 4 + 1], o[q4 * 4 + 2], o[q4 * 4 + 3]);
    }
    if (!FINAL) {
      const float* mt = p.modT + v * 6144 + lane * 16;
      unsigned w[8];
#pragma unroll
      for (int q2 = 0; q2 < 8; ++q2) {
        const float2 sh = *(const float2*)(mt + q2 * 2), sc = *(const float2*)(mt + 1024 + q2 * 2);
        w[q2] = pack2bf(o[q2 * 2] * (1.f + sc.x) + sh.x, o[q2 * 2 + 1] * (1.f + sc.y) + sh.y);
      }
      *(uint4*)(As + rr * LDA_B + lane * 32) = make_uint4(w[0], w[1], w[2], w[3]);
      *(uint4*)(As + rr * LDA_B + lane * 32 + 16) = make_uint4(w[4], w[5], w[6], w[7]);
    }
  }
}

__device__ __forceinline__ void cvt_plain(const float* __restrict__ a, bf16_t* __restrict__ o, size_t n8, bool lo, size_t gtid, size_t gsz) {
  for (size_t i = gtid; i < n8; i += gsz) {
    float v[8];
    *(float4*)&v[0] = ((const float4*)a)[i * 2]; *(float4*)&v[4] = ((const float4*)a)[i * 2 + 1];
    if (lo) {
#pragma unroll
      for (int j = 0; j < 8; ++j) v[j] = v[j] - bf2f(f2bf(v[j]));
    }
    uint4 w; w.x = pack2bf(v[0], v[1]); w.y = pack2bf(v[2], v[3]); w.z = pack2bf(v[4], v[5]); w.w = pack2bf(v[6], v[7]);
    ((uint4*)o)[i] = w;
  }
}
__device__ __forceinline__ void cvt_t(const float* __restrict__ W, bf16_t* __restrict__ Wt, int K, int N, bool lo, size_t gtid, size_t gsz) {
  const size_t total = (size_t)N * (K / 8);
  for (size_t i = gtid; i < total; i += gsz) {
    const int n = (int)(i % N), k8 = (int)(i / N);
    float v[8];
#pragma unroll
    for (int j = 0; j < 8; ++j) { const float w = W[(size_t)(k8 * 8 + j) * N + n]; v[j] = lo ? w - bf2f(f2bf(w)) : w; }
    uint4 w; w.x = pack2bf(v[0], v[1]); w.y = pack2bf(v[2], v[3]); w.z = pack2bf(v[4], v[5]); w.w = pack2bf(v[6], v[7]);
    *(uint4*)(Wt + ((size_t)((n >> 4) * (K >> 5) + (k8 >> 2)) * 64 + (k8 & 3) * 16 + (n & 15)) * 8) = w;
  }
}
__device__ __forceinline__ void mod_item(const float* __restrict__ c, const float* __restrict__ c_ctx, const float* __restrict__ ada_w, const float* __restrict__ ada_b,
                                         float* __restrict__ MOD, int item, char* lds) {
  float* sc = (float*)lds;
  float* part = sc + 3072;
  const int tid = otid(), wave = tid >> 6, lane = tid & 63, l = item / 96, cg = item % 96;
  for (int i = tid; i < 3072; i += 512) { const int v = i >> 10, k = i & 1023; const float xv = v < 2 ? c[v * 1024 + k] : c_ctx[k]; sc[i] = xv / (1.f + expf(-xv)); }
  __syncthreads();
  float a0 = 0.f, a1 = 0.f, a2 = 0.f;
  const float* W = ada_w + (size_t)l * 1024 * 6144 + cg * 64 + lane;
#pragma unroll 16
  for (int k = wave * 128; k < wave * 128 + 128; ++k) { const float w = W[(size_t)k * 6144]; a0 += sc[k] * w; a1 += sc[1024 + k] * w; a2 += sc[2048 + k] * w; }
  part[(wave * 3 + 0) * 64 + lane] = a0; part[(wave * 3 + 1) * 64 + lane] = a1; part[(wave * 3 + 2) * 64 + lane] = a2;
  __syncthreads();
  if (tid < 192) {
    const int v = tid >> 6, ln = tid & 63; float sum = 0.f;
#pragma unroll
    for (int w = 0; w < 8; ++w) sum += part[(w * 3 + v) * 64 + ln];
    MOD[(l * 3 + v) * 6144 + cg * 64 + ln] = sum + ada_b[l * 6144 + cg * 64 + ln];
  }
  __syncthreads();
}

struct MP {
  const float *x, *c, *ctx, *c_ctx, *ada_w, *ada_b, *ln_g, *ln_b, *s5_a_re, *s5_a_im, *s5_log_dt, *s5_b_re, *s5_b_im, *s5_c_re, *s5_c_im, *s5_d, *s5_w_glu, *s5_w_o;
  const float *mla_w_dq, *mla_q_norm, *mla_w_uq, *mla_w_dkv, *mla_kv_norm, *mla_w_ukv, *mla_w_o, *peer_w_q, *peer_keys, *peer_u, *peer_v;
  float* out;
  float* MOD; bf16_t *Wt_glu, *Wt_o0, *Wt_q0, *Wt_q0lo, *Wt_o1, *Wt_q1, *Wt_q1lo, *Wt_cat, *Wt_uq, *Wt_ukv, *Khi, *Klo, *Khi1, *Klo1;
  unsigned char *U0, *V0, *U1, *V1; float *SU0, *SV0, *SU1, *SV1; bf16_t *Ktab, *Bst_t, *Cin_t;
  float *Ypart, *Ssta; bf16_t *HP, *Gbf, *Vbf, *Tbf, *Tlo; float *OQ, *H1, *H2; int* IDX; float* GATE;
  bf16_t *Qa, *Kn, *Kr, *Va, *AObf; float* H3; bf16_t *Tbf1, *Tlo1; unsigned* ENT; float* GATF;
};
constexpr int LDS_BYTES = att::SHM_ATTN > 66 * LDA_B ? att::SHM_ATTN : 66 * LDA_B;
__global__ __launch_bounds__(512) void mega(MP p) {
  __shared__ __attribute__((aligned(16))) char lds[LDS_BYTES];
  cg::grid_group grid = cg::this_grid();
  const int nblk = gridDim.x;
  int bid = blockIdx.x;
  const size_t gtid = (size_t)bid * 512 + otid(), gsz = (size_t)nblk * 512;
  const size_t TD = (size_t)1024 * 16384;
  const float* mod0 = p.MOD; const float* mod1 = p.MOD + 3 * 6144;
  cvt_t(p.s5_w_glu, p.Wt_glu, D, D, false, gtid, gsz);
  cvt_t(p.s5_w_o, p.Wt_o0, D, D, false, gtid, gsz);
  cvt_t(p.peer_w_q, p.Wt_q0, D, D, false, gtid, gsz);
  cvt_t(p.peer_w_q, p.Wt_q0lo, D, D, true, gtid, gsz);
  cvt_t(p.mla_w_o, p.Wt_o1, D, D, false, gtid, gsz);
  cvt_t(p.peer_w_q + (size_t)D * D, p.Wt_q1, D, D, false, gtid, gsz);
  cvt_t(p.peer_w_q + (size_t)D * D, p.Wt_q1lo, D, D, true, gtid, gsz);
  cvt_t(p.mla_w_dq, p.Wt_cat, D, 384, false, gtid, gsz);
  cvt_t(p.mla_w_dkv, p.Wt_cat + (size_t)384 * D, D, 320, false, gtid, gsz);
  cvt_t(p.mla_w_uq, p.Wt_uq, 384, 1536, false, gtid, gsz);
  cvt_t(p.mla_w_ukv, p.Wt_ukv, 256, 2048, false, gtid, gsz);
  cvt_plain(p.peer_keys, p.Khi, (size_t)2 * 131072 / 8, false, gtid, gsz);
  cvt_plain(p.peer_keys, p.Klo, (size_t)2 * 131072 / 8, true, gtid, gsz);
  cvt_rows_i8(p.peer_u, p.U0, p.SU0, 16384, (int)(gtid >> 6), (int)(gsz >> 6));
  cvt_rows_i8(p.peer_v, p.V0, p.SV0, 16384, (int)(gtid >> 6), (int)(gsz >> 6));
  if (bid < 64) ph_s5_prep(p.s5_a_re, p.s5_a_im, p.s5_log_dt, p.s5_b_re, p.s5_b_im, p.s5_c_re, p.s5_c_im, p.Ktab, p.Bst_t, p.Cin_t, bid, lds);
  else mod_item(p.c, p.c_ctx, p.ada_w, p.ada_b, p.MOD, bid - 64, lds);
  grid.sync();
  asm volatile("" : "+s"(bid));
  ph_s5_p1(p.x, p.ctx, mod0, p.Ktab, p.Bst_t, p.Ypart, p.Ssta, bid, lds);
  grid.sync();
  asm volatile("" : "+s"(bid));
  if (otid() < 64) ph_s5_carry(p.Ssta, p.s5_a_re, p.s5_a_im, p.s5_log_dt, p.HP, bid, otid());
  grid.sync();
  asm volatile("" : "+s"(bid));
  ph_s5_p3(p.x, p.ctx, mod0, p.s5_d, p.HP, p.Cin_t, p.Ypart, p.Gbf, bid, lds);
  grid.sync();
  asm volatile("" : "+s"(bid));
  {
    ChainP cp{p.Gbf, p.Wt_glu, p.Wt_o0, p.Wt_q0, p.Vbf, p.OQ, p.x, p.ctx, mod0, p.ln_g, p.ln_b, p.H1, p.Tbf, p.OQ, p.Wt_q0lo, p.Tlo};
    ph_chainA<true>(cp, bid, lds);
    __syncthreads();
    ph_route(RouteP{p.OQ, p.Khi, p.Klo, p.IDX, p.GATE, 66, 0}, bid, lds);
    __syncthreads();
    GatherP gp{p.Tbf, p.IDX, p.GATE, p.U0, p.V0, p.SU0, p.SV0, p.H1, mod0, p.ln_g + D, p.ln_b + D, p.H2, mod1};
    ph_gather_tm<false>(gp, bid * 66, 66, lds);
    __syncthreads();
    ProjP pp{p.Wt_cat, p.Wt_uq, p.Wt_ukv, p.mla_q_norm, p.mla_kv_norm, p.OQ  , p.Qa, p.Kn, p.Kr, p.Va};
    ph_mla_proj(pp, bid, lds);
  }
  grid.sync();
  asm volatile("" : "+s"(bid));
  {
    const size_t gtid5 = (size_t)bid * 512 + otid(), gsz5 = (size_t)gridDim.x * 512;
    cvt_rows_i8(p.peer_u + TD, p.U1, p.SU1, 16384, (int)(gtid5 >> 6), (int)(gsz5 >> 6));
    cvt_rows_i8(p.peer_v + TD, p.V1, p.SV1, 16384, (int)(gtid5 >> 6), (int)(gsz5 >> 6));
  }
  ph_attn(p.Qa, p.Kn, p.Kr, p.Va, p.AObf, bid, nblk, lds);
  grid.sync();
  asm volatile("" : "+s"(bid));
  {
    ChainP cp{p.AObf, nullptr, p.Wt_o1, p.Wt_q1, nullptr, p.OQ, p.H2, p.H2 + (size_t)NL * D, mod1, p.ln_g + 2 * D, p.ln_b + 2 * D, p.H3, p.Tbf1, p.OQ, p.Wt_q1lo, p.Tlo1};
    ph_chainA<false>(cp, bid, lds);
    __syncthreads();
    ph_route(RouteP{p.OQ, p.Khi1, p.Klo1, p.IDX, p.GATE, 64, 0}, bid, lds);
    __syncthreads();
    GatherP gp{p.Tbf1, p.IDX, p.GATE, p.U1, p.V1, p.SU1, p.SV1, p.H3, mod1, p.ln_g + 3 * D, p.ln_b + 3 * D, p.out, mod1};
    ph_gather_tm<true>(gp, bid * 64, 64, lds);
  }
}

extern "C" void kernel_launch(void* const* d_in, const int* in_sizes, int n_in, void* d_out, int out_size, void* d_ws, size_t ws_size, hipStream_t stream) {
  MP p{};
  const float** in = (const float**)&p;
  for (int i = 0; i < 29; ++i) in[i] = (const float*)d_in[i];
  p.out = (float*)d_out;
  char* ws = (char*)d_ws; size_t off = 0;
  auto carve = [&](size_t bytes) { char* q = ws + off; off += (bytes + 255) / 256 * 256; return q; };
  const size_t TDB = (size_t)1024 * 16384 * 2, BIG = (size_t)NT * D * 4, HALF = (size_t)NT * D * 2;
  p.MOD = (float*)carve(2 * 3 * 6144 * 4);
  p.Wt_glu = (bf16_t*)carve((size_t)D * D * 2); p.Wt_o0 = (bf16_t*)carve((size_t)D * D * 2); p.Wt_q0 = (bf16_t*)carve((size_t)D * D * 2); p.Wt_q0lo = (bf16_t*)carve((size_t)D * D * 2);
  p.Wt_o1 = (bf16_t*)carve((size_t)D * D * 2); p.Wt_q1 = (bf16_t*)carve((size_t)D * D * 2); p.Wt_q1lo = (bf16_t*)carve((size_t)D * D * 2);
  p.Wt_cat = (bf16_t*)carve((size_t)704 * D * 2); p.Wt_uq = (bf16_t*)carve((size_t)1536 * 384 * 2); p.Wt_ukv = (bf16_t*)carve((size_t)2048 * 256 * 2);
  p.Khi = (bf16_t*)carve((size_t)2 * 131072 * 2); p.Klo = (bf16_t*)carve((size_t)2 * 131072 * 2); p.Khi1 = p.Khi + 131072; p.Klo1 = p.Klo + 131072;
  char* T0 = carve(2 * TDB); p.U0 = (unsigned char*)T0; p.V0 = (unsigned char*)(T0 + TDB / 2); p.AObf = (bf16_t*)T0;
  p.SU0 = (float*)carve(16384 * 4); p.SV0 = (float*)carve(16384 * 4); p.SU1 = (float*)carve(16384 * 4); p.SV1 = (float*)carve(16384 * 4);
  const size_t KTAB_B = (size_t)64 * 127 * 256 * 2, BST_B = (size_t)64 * 256 * 1024 * 2, KN_B = (size_t)NB * 8 * KEYS * 128 * 2, KR_B = (size_t)NB * KEYS * 64 * 2;
  size_t x1 = KTAB_B + 2 * BST_B; if (x1 < 2 * KN_B + KR_B) x1 = 2 * KN_B + KR_B;
  char* X1 = carve(x1);
  p.Ktab = (bf16_t*)X1; p.Bst_t = (bf16_t*)(X1 + KTAB_B); p.Cin_t = (bf16_t*)(X1 + KTAB_B + BST_B);
  p.Kn = (bf16_t*)X1; p.Va = (bf16_t*)(X1 + KN_B); p.Kr = (bf16_t*)(X1 + 2 * KN_B); p.H3 = (float*)X1;
  char* X2 = carve(BIG); p.Ypart = (float*)X2; p.OQ = (float*)X2;
  char* X3 = carve(HALF); p.Ssta = (float*)X3; p.HP = (bf16_t*)(X3 + (size_t)NCC * 64 * 256 * 4); p.Vbf = (bf16_t*)X3; p.Tlo = (bf16_t*)X3; p.Tlo1 = (bf16_t*)X3;
  char* X4 = carve(HALF); p.Gbf = (bf16_t*)X4; p.Tbf = (bf16_t*)X4; p.Tbf1 = (bf16_t*)X4;
  char* X5 = carve(BIG); p.H1 = (float*)X5; p.U1 = (unsigned char*)X5; p.V1 = (unsigned char*)(X5 + TDB / 2);
  p.H2 = (float*)carve(BIG);
  p.IDX = (int*)carve((size_t)NT * 128 * 4); p.GATE = (float*)carve((size_t)NT * 128 * 4);
  p.Qa = (bf16_t*)carve((size_t)NB * 8 * SEQ * 192 * 2);
  p.ENT = (unsigned*)carve((size_t)256 * 8 * ECAP * 4); p.GATF = (float*)carve((size_t)256 * 8 * ECAP * 4);
  if (off > ws_size || n_in != 29) { fprintf(stderr, "kernel_launch: workspace too small (need %zu, have %zu) or n_in %d != 29\n", off, ws_size, n_in); return; }
  static int grid_blocks = 0;
  if (!grid_blocks) {
    int dev = 0, cus = 0, per_cu = 0;
    hipGetDevice(&dev);
    hipDeviceGetAttribute(&cus, hipDeviceAttributeMultiprocessorCount, dev);
    hipOccupancyMaxActiveBlocksPerMultiprocessor(&per_cu, mega, 512, 0);
    if (per_cu < 1 || cus < 256) { fprintf(stderr, "kernel_launch: need 256 resident workgroups (cus %d, per_cu %d)\n", cus, per_cu); return; }
    grid_blocks = 256;
  }
  void* args[] = {&p};
  hipError_t e = hipLaunchCooperativeKernel((void*)mega, dim3(grid_blocks), dim3(512), args, 0, stream);
  if (e != hipSuccess) fprintf(stderr, "cooperative launch failed: %s\n", hipGetErrorString(e));
}
```

```cpp
#include <hip/hip_runtime.h>
#include <math.h>
#include <hip/hip_cooperative_groups.h>
#include <cstdio>
namespace cg = cooperative_groups;
__device__ __forceinline__ int otid() { int t = (int)__builtin_amdgcn_workitem_id_x(); asm volatile("" : "+v"(t)); return t; }

constexpr int D = 1024, NB = 2, SEQ = 8192, CTX = 256;
constexpr int NL = NB * SEQ, NC = NB * CTX, NT = NL + NC;
constexpr float ALPHA = 1.4142135623730951f;
constexpr float LN_EPS = 1e-5f, RMS_EPS = 1e-6f;

__device__ __forceinline__ float wave_sum(float v) {
#pragma unroll
  for (int o = 32; o >= 1; o >>= 1) v += __shfl_xor(v, o);
  return v;
}
__device__ __forceinline__ int row_vec(int row) { return row < NL ? (row >> 13) : 2; }
__device__ __forceinline__ float gelu_exact(float x) { return 0.5f * x * (1.f + erff(x * 0.70710678118654752f)); }


typedef unsigned short bf16_t;
using bf16x8 = __attribute__((ext_vector_type(8))) short;
using f32x4 = __attribute__((ext_vector_type(4))) float;
__device__ __forceinline__ bf16_t f2bf(float f) { unsigned u = __float_as_uint(f); u += 0x7FFFu + ((u >> 16) & 1u); return (bf16_t)(u >> 16); }
__device__ __forceinline__ float bf2f(bf16_t h) { return __uint_as_float(((unsigned)h) << 16); }
__device__ __forceinline__ unsigned pack2bf(float lo, float hi) { return (unsigned)f2bf(lo) | ((unsigned)f2bf(hi) << 16); }
__device__ __forceinline__ float bflo(unsigned w) { return __uint_as_float(w << 16); }
__device__ __forceinline__ float bfhi(unsigned w) { return __uint_as_float(w & 0xFFFF0000u); }


constexpr int LDA_B = 1024 * 2 + 16;
template <int RT, int K>
__device__ __forceinline__ void gemm_unit(const char* const (&ap)[RT], const bf16_t* __restrict__ w0, const bf16_t* __restrict__ w1, int kmul, f32x4 (&acc)[RT][2]) {
  constexpr int KI = K / 128, NS = 2;
#pragma unroll
  for (int t = 0; t < RT; ++t) { acc[t][0] = f32x4{0.f, 0.f, 0.f, 0.f}; acc[t][1] = f32x4{0.f, 0.f, 0.f, 0.f}; }
  bf16x8 b[NS][4][2];
#pragma unroll
  for (int st = 0; st < NS - 1; ++st) {
    if (st < KI) {
#pragma unroll
      for (int s2 = 0; s2 < 4; ++s2) { b[st][s2][0] = *(const bf16x8*)(w0 + (st * 128 + s2 * 32) * kmul); b[st][s2][1] = *(const bf16x8*)(w1 + (st * 128 + s2 * 32) * kmul); }
    }
  }
  asm volatile("" ::: "memory");
  bf16x8 an[RT];
#pragma unroll
  for (int t = 0; t < RT; ++t) an[t] = *(const bf16x8*)(ap[t]);
#pragma unroll
  for (int it = 0; it < KI; ++it) {
    if (it + NS - 1 < KI) {
#pragma unroll
      for (int s2 = 0; s2 < 4; ++s2) {
        b[(it + NS - 1) % NS][s2][0] = *(const bf16x8*)(w0 + ((it + NS - 1) * 128 + s2 * 32) * kmul);
        b[(it + NS - 1) % NS][s2][1] = *(const bf16x8*)(w1 + ((it + NS - 1) * 128 + s2 * 32) * kmul);
      }
    }
    asm volatile("" ::: "memory");
#pragma unroll
    for (int s2 = 0; s2 < 4; ++s2) {
      bf16x8 ac[RT];
#pragma unroll
      for (int t = 0; t < RT; ++t) ac[t] = an[t];
      if (it * 4 + s2 + 1 < KI * 4) {
#pragma unroll
        for (int t = 0; t < RT; ++t) an[t] = *(const bf16x8*)(ap[t] + (it * 128 + s2 * 32 + 32) * 2);
      }
#pragma unroll
      for (int t = 0; t < RT; ++t) {
        acc[t][0] = __builtin_amdgcn_mfma_f32_16x16x32_bf16(ac[t], b[it % NS][s2][0], acc[t][0], 0, 0, 0);
        acc[t][1] = __builtin_amdgcn_mfma_f32_16x16x32_bf16(ac[t], b[it % NS][s2][1], acc[t][1], 0, 0, 0);
      }
    }
  }
}
template <int RT, int K, class Epi>
__device__ __forceinline__ void gemm_ldsA(const char* As, int lda_b, int nrows, const bf16_t* __restrict__ Wt, int N, Epi epi) {
  const int wave = otid() >> 6, lane = otid() & 63, l15 = lane & 15, q = lane >> 4;
  const char* ap[RT];
#pragma unroll
  for (int t = 0; t < RT; ++t) { int r = t * 16 + l15; r = r < nrows ? r : nrows - 1; ap[t] = As + r * lda_b + q * 16; }
#pragma unroll 1
  for (int unit = wave; unit < (N >> 5); unit += 8) {
    const int n0 = unit * 32;
    const bf16_t* w0 = Wt + (size_t)(n0 >> 4) * K * 16 + lane * 8;
    f32x4 acc[RT][2];
    gemm_unit<RT, K>(ap, w0, w0 + (size_t)K * 16, 16, acc);
#pragma unroll
    for (int t = 0; t < RT; ++t)
#pragma unroll
      for (int j = 0; j < 2; ++j)
#pragma unroll
        for (int r = 0; r < 4; ++r) {
          const int row = t * 16 + q * 4 + r, col = n0 + j * 16 + l15;
          if (row < nrows) epi(row, col, acc[t][j][r]);
        }
  }
}
struct EpiF32 { float* C; int ldc; __device__ __forceinline__ void operator()(int row, int col, float v) const { C[(size_t)row * ldc + col] = v; } };
struct EpiAddF32 { float* C; int ldc; __device__ __forceinline__ void operator()(int row, int col, float v) const { C[(size_t)row * ldc + col] += v; } };
struct EpiGluL { const char* As; bf16_t* V; __device__ __forceinline__ void operator()(int row, int col, float z) const {
  const float g = bf2f(*(const bf16_t*)(As + row * LDA_B + col * 2)); V[(size_t)row * D + col] = f2bf(g / (1.f + expf(-z))); } };

__device__ __forceinline__ void load_rows_lds(char* As, const bf16_t* __restrict__ src, int nrows) {
  for (int i = otid(); i < nrows * 128; i += 512) {
    const int r = i >> 7, c = i & 127;
    *(uint4*)(As + r * LDA_B + c * 16) = *(const uint4*)(src + (size_t)r * D + c * 8);
  }
}
__device__ __forceinline__ void ln_rows(char* As, int g0, int nrows, const float* Hl, const float* Hc, const float* __restrict__ O,
                                        const float* __restrict__ mod, int gate_i, const float* __restrict__ lng, const float* __restrict__ lnb,
                                        float* Hout, bf16_t* __restrict__ Tbf, int shift_i, int scale_i, bf16_t* __restrict__ Tlo) {
  const int wave = otid() >> 6, lane = otid() & 63;
  for (int rr = wave; rr < nrows; rr += 8) {
    const int row = g0 + rr;
    const float* hin = row < NL ? Hl + (size_t)row * D : Hc + (size_t)(row - NL) * D;
    const float* f = O + (size_t)row * D;
    const float* m = mod + row_vec(row) * 6144;
    const float* gm = m + gate_i * 1024;
    float r[16]; float s = 0.f;
#pragma unroll
    for (int i = 0; i < 4; ++i) {
      const int d = i * 256 + lane * 4;
      float4 h4 = *(const float4*)(hin + d), f4 = *(const float4*)(f + d), g4 = *(const float4*)(gm + d);
      r[i * 4 + 0] = ALPHA * h4.x + g4.x * f4.x; r[i * 4 + 1] = ALPHA * h4.y + g4.y * f4.y;
      r[i * 4 + 2] = ALPHA * h4.z + g4.z * f4.z; r[i * 4 + 3] = ALPHA * h4.w + g4.w * f4.w;
      s += r[i * 4 + 0] + r[i * 4 + 1] + r[i * 4 + 2] + r[i * 4 + 3];
    }
    const float mu = wave_sum(s) * (1.f / D);
    float vs = 0.f;
#pragma unroll
    for (int i = 0; i < 16; ++i) { float dlt = r[i] - mu; vs += dlt * dlt; }
    const float rstd = rsqrtf(wave_sum(vs) * (1.f / D) + LN_EPS);
#pragma unroll
    for (int i = 0; i < 4; ++i) {
      const int d = i * 256 + lane * 4;
      float4 g4 = *(const float4*)(lng + d), b4 = *(const float4*)(lnb + d);
      float4 o;
      o.x = (r[i * 4 + 0] - mu) * rstd * g4.x + b4.x; o.y = (r[i * 4 + 1] - mu) * rstd * g4.y + b4.y;
      o.z = (r[i * 4 + 2] - mu) * rstd * g4.z + b4.z; o.w = (r[i * 4 + 3] - mu) * rstd * g4.w + b4.w;
      *(float4*)(Hout + (size_t)row * D + d) = o;
      float4 sh = *(const float4*)(m + shift_i * 1024 + d), sc = *(const float4*)(m + scale_i * 1024 + d);
      const float t0 = o.x * (1.f + sc.x) + sh.x, t1 = o.y * (1.f + sc.y) + sh.y, t2 = o.z * (1.f + sc.z) + sh.z, t3 = o.w * (1.f + sc.w) + sh.w;
      uint2 w; w.x = pack2bf(t0, t1); w.y = pack2bf(t2, t3);
      *(uint2*)(As + rr * LDA_B + d * 2) = w;
      *(uint2*)(Tbf + (size_t)row * D + d) = w;

    }
  }
}


constexpr int S5T = 64, NCHUNK = (CTX + SEQ) / S5T  , NCC = NB * NCHUNK  ;
__device__ __forceinline__ int s5_token(int cc, int s) {
  const int b = cc / NCHUNK, ch = cc - b * NCHUNK;
  return ch < 4 ? NL + b * CTX + ch * S5T + s : b * SEQ + (ch - 4) * S5T + s;
}
__device__ __forceinline__ void ph_s5_prep(const float* __restrict__ a_re, const float* __restrict__ a_im, const float* __restrict__ log_dt,
                                                 const float* __restrict__ b_re, const float* __restrict__ b_im, const float* __restrict__ c_re, const float* __restrict__ c_im,
                                                 bf16_t* __restrict__ Ktab, bf16_t* __restrict__ Bst_t, bf16_t* __restrict__ Cin_t, int g, int part, char* lds) {
  float2 (*pw)[65][64] = reinterpret_cast<float2 (*)[65][64]>(lds);
  float2 (*Bp)[64][16] = reinterpret_cast<float2 (*)[64][16]>(lds + 2 * 65 * 64 * 8);
  float2 (*Cc)[16][64] = reinterpret_cast<float2 (*)[16][64]>(lds + 2 * 65 * 64 * 8 + 2 * 64 * 16 * 8);
  const int tid = otid();
  if (tid < 128) {
    const int dir = tid >> 6, p = tid & 63, gp = (dir * 64 + g) * 64 + p;
    const float are = a_re[gp], aim = a_im[gp], dt = expf(log_dt[dir * 64 + g]);
    const float mag = expf(are * dt);
    const float abr = mag * cosf(aim * dt), abi = mag * sinf(aim * dt);
    const float nr = abr - 1.f, ni = abi, den = are * are + aim * aim;
    const float fr = (nr * are + ni * aim) / den, fi = (ni * are - nr * aim) / den;
    float pr = 1.f, pi = 0.f;
    for (int e = 0; e <= 64; ++e) { pw[dir][e][p] = make_float2(pr, pi); const float nr2 = pr * abr - pi * abi, ni2 = pr * abi + pi * abr; pr = nr2; pi = ni2; }
    for (int ci = 0; ci < 16; ++ci) { const float br = b_re[gp * 16 + ci], bi = b_im[gp * 16 + ci]; Bp[dir][p][ci] = make_float2(fr * br - fi * bi, fr * bi + fi * br); }
    for (int co = 0; co < 16; ++co) { const int idx = ((dir * 64 + g) * 16 + co) * 64 + p; Cc[dir][co][p] = make_float2(c_re[idx], c_im[idx]); }
  }
  __syncthreads();
  for (int i = part * 8128 + tid; i < (part + 1) * 8128; i += 512) {
    const int ti = i >> 8, co = (i >> 4) & 15, ci = i & 15, tau = ti - 63;
    float acc = 0.f;
    if (tau >= 0) { for (int p = 0; p < 64; ++p) { const float2 c = Cc[0][co][p], w = pw[0][tau][p], b = Bp[0][p][ci];
        const float xr = c.x * w.x - c.y * w.y, xi = c.x * w.y + c.y * w.x; acc += xr * b.x - xi * b.y; } }
    if (tau <= 0) { for (int p = 0; p < 64; ++p) { const float2 c = Cc[1][co][p], w = pw[1][-tau][p], b = Bp[1][p][ci];
        const float xr = c.x * w.x - c.y * w.y, xi = c.x * w.y + c.y * w.x; acc += xr * b.x - xi * b.y; } }
    Ktab[(size_t)g * 127 * 256 + i] = f2bf(acc);
  }
  for (int i = part * 8192 + tid; i < (part + 1) * 8192; i += 512) {
    const int n = i >> 7, k8 = i & 127, dir = n >> 7, c = (n >> 6) & 1, p = n & 63, sidx = k8 >> 1, ci0 = (k8 & 1) * 8;
    const float2 w = pw[dir][dir == 0 ? 63 - sidx : sidx][p];
    float v[8];
#pragma unroll
    for (int j = 0; j < 8; ++j) { const float2 b = Bp[dir][p][ci0 + j]; v[j] = c == 0 ? (w.x * b.x - w.y * b.y) : (w.x * b.y + w.y * b.x); }
    uint4 o; o.x = pack2bf(v[0], v[1]); o.y = pack2bf(v[2], v[3]); o.z = pack2bf(v[4], v[5]); o.w = pack2bf(v[6], v[7]);
    *(uint4*)(Bst_t + (size_t)g * 256 * 1024 + ((size_t)((n >> 4) * 32 + (k8 >> 2)) * 64 + (k8 & 3) * 16 + (n & 15)) * 8) = o;
  }
  for (int i = part * 8192 + tid; i < (part + 1) * 8192; i += 512) {
    const int n = i >> 5, k8 = i & 31, t = n >> 4, co = n & 15, dir = k8 >> 4, c = (k8 >> 3) & 1, p0 = (k8 & 7) * 8;
    const int e = dir == 0 ? t + 1 : 64 - t;
    float v[8];
#pragma unroll
    for (int j = 0; j < 8; ++j) { const float2 cc = Cc[dir][co][p0 + j], w = pw[dir][e][p0 + j];
      v[j] = c == 0 ? (cc.x * w.x - cc.y * w.y) : -(cc.x * w.y + cc.y * w.x); }
    uint4 o; o.x = pack2bf(v[0], v[1]); o.y = pack2bf(v[2], v[3]); o.z = pack2bf(v[4], v[5]); o.w = pack2bf(v[6], v[7]);
    *(uint4*)(Cin_t + (size_t)g * 1024 * 256 + ((size_t)((n >> 4) * 8 + (k8 >> 2)) * 64 + (k8 & 3) * 16 + (n & 15)) * 8) = o;
  }
}
__device__ __forceinline__ void ph_s5_p1(const float* __restrict__ x, const float* __restrict__ ctx, const float* __restrict__ mod,
                                               const bf16_t* __restrict__ Ktab, const bf16_t* __restrict__ Bst_t, float* __restrict__ Ypart, float* __restrict__ S, int bid, char* As) {
  const int g = bid >> 2, cc0 = (bid & 3) * 66, tid = otid();
  const int wave = tid >> 6, lane = tid & 63, l15 = lane & 15, q = lane >> 4;
  for (int i = tid; i < 66 * 64 * 2; i += 512) {
    const int half = i & 1, sidx = (i >> 1) & 63, r = i >> 7;
    const int tok = s5_token(cc0 + r, sidx), ch = g * 16 + half * 8;
    const float* src = (tok < NL ? x + (size_t)tok * D : ctx + (size_t)(tok - NL) * D) + ch;
    const float* m = mod + row_vec(tok) * 6144;
    const float4 a = *(const float4*)src, b = *(const float4*)(src + 4);
    const float4 sh0 = *(const float4*)(m + ch), sh1 = *(const float4*)(m + ch + 4), sc0 = *(const float4*)(m + 1024 + ch), sc1 = *(const float4*)(m + 1024 + ch + 4);
    uint4 o;
    o.x = pack2bf(a.x * (1.f + sc0.x) + sh0.x, a.y * (1.f + sc0.y) + sh0.y); o.y = pack2bf(a.z * (1.f + sc0.z) + sh0.z, a.w * (1.f + sc0.w) + sh0.w);
    o.z = pack2bf(b.x * (1.f + sc1.x) + sh1.x, b.y * (1.f + sc1.y) + sh1.y); o.w = pack2bf(b.z * (1.f + sc1.z) + sh1.z, b.w * (1.f + sc1.w) + sh1.w);
    *(uint4*)(As + r * LDA_B + sidx * 32 + half * 16) = o;
  }
  __syncthreads();
  const char* ap[5];
#pragma unroll
  for (int t = 0; t < 5; ++t) { int r = t * 16 + l15; r = r < 66 ? r : 65; ap[t] = As + r * LDA_B + q * 16; }
  const bf16_t* Kg = Ktab + (size_t)g * 127 * 256;
#pragma unroll 1
  for (int unit = wave; unit < 40; unit += 8) {
    f32x4 acc[5][2];
    if (unit < 32) {
      const int t0 = unit * 2;
      const bf16_t* w0 = Kg + (t0 + 63 - (q >> 1)) * 256 + l15 * 16 + (q & 1) * 8;
      gemm_unit<5, 1024>(ap, w0, w0 + 256, -16, acc);
#pragma unroll
      for (int t = 0; t < 5; ++t)
#pragma unroll
        for (int j = 0; j < 2; ++j)
#pragma unroll
          for (int r = 0; r < 4; ++r) {
            const int row = t * 16 + q * 4 + r;
            if (row < 66) Ypart[(size_t)s5_token(cc0 + row, t0 + j) * D + g * 16 + l15] = acc[t][j][r];
          }
    } else {
      const int n0 = (unit - 32) * 32;
      const bf16_t* w0 = Bst_t + (size_t)g * 256 * 1024 + (size_t)(n0 >> 4) * 1024 * 16 + lane * 8;
      gemm_unit<5, 1024>(ap, w0, w0 + 1024 * 16, 16, acc);
#pragma unroll
      for (int t = 0; t < 5; ++t)
#pragma unroll
        for (int j = 0; j < 2; ++j)
#pragma unroll
          for (int r = 0; r < 4; ++r) {
            const int row = t * 16 + q * 4 + r;
            if (row < 66) S[((size_t)(cc0 + row) * 64 + g) * 256 + n0 + j * 16 + l15] = acc[t][j][r];
          }
    }
  }
}
__device__ __forceinline__ void ph_s5_carry(const float* __restrict__ S, const float* __restrict__ a_re, const float* __restrict__ a_im,
                                                 const float* __restrict__ log_dt, bf16_t* __restrict__ HP, int id, int p) {
  const int dir = id & 1, g = (id >> 1) & 63, b = id >> 7;
  const int gp = (dir * 64 + g) * 64 + p;
  const float are = a_re[gp], aim = a_im[gp], dt = expf(log_dt[dir * 64 + g]);
  const float mag = expf(are * dt);
  float tr = mag * cosf(aim * dt), ti = mag * sinf(aim * dt);
#pragma unroll
  for (int i = 0; i < 6; ++i) { const float nr = tr * tr - ti * ti, ni = 2.f * tr * ti; tr = nr; ti = ni; }
  float hr = 0.f, hi = 0.f;
#pragma unroll 4
  for (int step = 0; step < NCHUNK; ++step) {
    const int c = dir == 0 ? step : (step < 4 ? 3 - step : NCHUNK - 1 - (step - 4));
    const size_t base = ((size_t)(b * NCHUNK + c) * 64 + g) * 256 + dir * 128 + p;
    HP[base] = f2bf(hr); HP[base + 64] = f2bf(hi);
    const float sr = S[base], si = S[base + 64];
    const float nr = tr * hr - ti * hi + sr, ni = tr * hi + ti * hr + si;
    hr = nr; hi = ni;
  }
}
struct EpiS5 { const float* x; const float* ctx; const float* mod; const float* dvec; const float* Ypart; bf16_t* Gbf; int cc0; int g;
  __device__ __forceinline__ void operator()(int row, int col, float v) const {
    const int tok = s5_token(cc0 + row, col >> 4), ch = g * 16 + (col & 15);
    const float* m = mod + row_vec(tok) * 6144;
    const float xin = tok < NL ? x[(size_t)tok * D + ch] : ctx[(size_t)(tok - NL) * D + ch];
    const float mm = xin * (1.f + m[1024 + ch]) + m[ch];
    const float y = v + Ypart[(size_t)tok * D + ch] + dvec[ch] * mm;
    Gbf[(size_t)tok * D + ch] = f2bf(gelu_exact(y));
  } };
__device__ __forceinline__ void ph_s5_p3(const float* __restrict__ x, const float* __restrict__ ctx, const float* __restrict__ mod, const float* __restrict__ dvec,
                                               const bf16_t* __restrict__ HP, const bf16_t* __restrict__ Cin_t, const float* __restrict__ Ypart, bf16_t* __restrict__ Gbf, int bid, char* As) {
  const int g = bid >> 2, cc0 = (bid & 3) * 66, tid = otid();
  for (int i = tid; i < 66 * 32; i += 512) {
    const int r = i >> 5, c = i & 31;
    *(uint4*)(As + r * 528 + c * 16) = *(const uint4*)(HP + ((size_t)(cc0 + r) * 64 + g) * 256 + c * 8);
  }
  __syncthreads();
  gemm_ldsA<5, 256>(As, 528, 66, Cin_t + (size_t)g * 1024 * 256, 1024, EpiS5{x, ctx, mod, dvec, Ypart, Gbf, cc0, g});
}


struct ChainP {
  const bf16_t* Ain;
  const bf16_t* Wglu_t; const bf16_t* Wo_t; const bf16_t* Wq_t;
  bf16_t* Vbf; float* O; const float* Hl; const float* Hc; const float* mod; const float* lng; const float* lnb;
  float* Hout; bf16_t* Tbf; float* Q; const bf16_t* Wq_lo; bf16_t* Tlo;
};
template <bool L0>
__device__ __forceinline__ void ph_chainA(const ChainP& p, int bid, char* As) {
  constexpr int NR = L0 ? 66 : 64;
  constexpr int RT = L0 ? 5 : 4;
  const int g0 = bid * NR;
  load_rows_lds(As, p.Ain + (size_t)g0 * D, NR);
  __syncthreads();
  if (L0) {
    gemm_ldsA<RT, 1024>(As, LDA_B, NR, p.Wglu_t, D, EpiGluL{As, p.Vbf + (size_t)g0 * D});
    __syncthreads();
    load_rows_lds(As, p.Vbf + (size_t)g0 * D, NR);
    __syncthreads();
  }
  gemm_ldsA<RT, 1024>(As, LDA_B, NR, p.Wo_t, D, EpiF32{p.O + (size_t)g0 * D, D});
  __syncthreads();
  ln_rows(As, g0, NR, p.Hl, p.Hc, p.O, p.mod, 2, p.lng, p.lnb, p.Hout, p.Tbf, 3, 4, p.Tlo);
  __syncthreads();
  gemm_ldsA<RT, 1024>(As, LDA_B, NR, p.Wq_t, D, EpiF32{p.Q + (size_t)g0 * D, D});
}


constexpr int KEYS = SEQ + CTX;
struct EpiKV { bf16_t* Kn; bf16_t* Va; int g0; int pad; __device__ __forceinline__ void operator()(int row, int col, float v) const {
  const int g = g0 + row; int b, key;
  if (g < NL) { b = g >> 13; key = g & (SEQ - 1); } else { const int cidx = g - NL; b = cidx >> 8; key = SEQ + (cidx & (CTX - 1)); }
  const int head = col >> 8, j = col & 255;
  if (j < 128) Kn[((size_t)(b * 8 + head) * KEYS + key) * 128 + j] = f2bf(v);
  else Va[((size_t)(b * 8 + head) * KEYS + key) * 128 + (j - 128)] = f2bf(v);
} };
struct EpiQ { bf16_t* Qa; int g0; int pad; __device__ __forceinline__ void operator()(int row, int col, float v) const {
  const int g = g0 + row, b = g >> 13, n = g & (SEQ - 1);
  const int head = col / 192, j = col - head * 192;
  Qa[((size_t)(b * 8 + head) * SEQ + n) * 192 + j] = f2bf(v);
} };
struct ProjP { const bf16_t* Wcat_t; const bf16_t* Wuq_t; const bf16_t* Wukv_t; const float* q_norm; const float* kv_norm;
               float* PR; bf16_t* Qa; bf16_t* Kn; bf16_t* Kr; bf16_t* Va; };
__device__ __forceinline__ void ph_mla_proj(const ProjP& p, int bid, char* As) {
  const int g0 = bid * 66, wave = otid() >> 6, lane = otid() & 63;
  gemm_ldsA<5, 1024>(As, LDA_B, 66, p.Wcat_t, 704, EpiF32{p.PR + (size_t)g0 * D, D});
  __syncthreads();
  char* A1 = As; char* A2 = As + 66 * 784;
  for (int rr = wave; rr < 66; rr += 8) {
    const int g = g0 + rr;
    const float* pr = p.PR + (size_t)g * D;
    float v[6]; float ss = 0.f;
#pragma unroll
    for (int i = 0; i < 6; ++i) { v[i] = pr[i * 64 + lane]; ss += v[i] * v[i]; }
    float rn = rsqrtf(wave_sum(ss) * (1.f / 384.f) + RMS_EPS);
#pragma unroll
    for (int i = 0; i < 6; ++i) *(bf16_t*)(A1 + rr * 784 + (i * 64 + lane) * 2) = f2bf(v[i] * rn * p.q_norm[i * 64 + lane]);
    float w[4]; ss = 0.f;
#pragma unroll
    for (int i = 0; i < 4; ++i) { w[i] = pr[384 + i * 64 + lane]; ss += w[i] * w[i]; }
    rn = rsqrtf(wave_sum(ss) * (1.f / 256.f) + RMS_EPS);
#pragma unroll
    for (int i = 0; i < 4; ++i) *(bf16_t*)(A2 + rr * 528 + (i * 64 + lane) * 2) = f2bf(w[i] * rn * p.kv_norm[i * 64 + lane]);
    if (lane < 32) {
      float x1 = pr[640 + lane], x2 = pr[672 + lane];
      int b, key;
      if (g < NL) {
        b = g >> 13; key = g & (SEQ - 1);
        const int n = key, rr2 = n >> 6, cc = n & 63;
        const float inv = powf(10000.f, -(float)(lane & 15) / 16.f);
        const float ang = (lane < 16 ? (float)rr2 : (float)cc) * inv;
        const float cs = cosf(ang), sn = sinf(ang);
        const float y1 = x1 * cs - x2 * sn, y2 = x2 * cs + x1 * sn; x1 = y1; x2 = y2;
      } else { const int cidx = g - NL; b = cidx >> 8; key = SEQ + (cidx & (CTX - 1)); }
      bf16_t* kp = p.Kr + ((size_t)b * KEYS + key) * 64;
      kp[lane] = f2bf(x1); kp[32 + lane] = f2bf(x2);
    }
  }
  __syncthreads();
  int nq = NL - g0; nq = nq > 66 ? 66 : nq;
  if (nq > 0) gemm_ldsA<5, 384>(A1, 784, nq, p.Wuq_t, 1536, EpiQ{p.Qa, g0, 0});
  gemm_ldsA<5, 256>(A2, 528, 66, p.Wukv_t, 2048, EpiKV{p.Kn, p.Va, g0, 0});
  __syncthreads();
  for (int rr = wave; rr < nq; rr += 8) {
    const int g = g0 + rr, b = g >> 13, n = g & (SEQ - 1);
    if (lane < 32) {
      const float inv = powf(10000.f, -(float)(lane & 15) / 16.f);
      const float ang = (lane < 16 ? (float)(n >> 6) : (float)(n & 63)) * inv;
      const float cs = cosf(ang), sn = sinf(ang);
#pragma unroll
      for (int h = 0; h < 8; ++h) {
        bf16_t* qo = p.Qa + ((size_t)(b * 8 + h) * SEQ + n) * 192;
        const float x1 = bf2f(qo[128 + lane]), x2 = bf2f(qo[160 + lane]);
        qo[128 + lane] = f2bf(x1 * cs - x2 * sn); qo[160 + lane] = f2bf(x2 * cs + x1 * sn);
      }
    }
  }
}

namespace att {
using s16x4 = __attribute__((ext_vector_type(4))) short;
using f32x16 = __attribute__((ext_vector_type(16))) float;
using u32x4 = __attribute__((ext_vector_type(4))) unsigned;
constexpr int KVBLK = 64, KROW = 400;
constexpr float SCALE = 0.07216878364870322f;
constexpr float THR = 8.f;
constexpr int SHM_V = KVBLK * 128 * 2, SHM_K = KVBLK * KROW, QRROW = 240, SHM_QR = 256 * QRROW, SHM_ATTN = 2 * SHM_V + 2 * SHM_K + 8 * 64 * 4 + SHM_QR;
#define SBAR() __builtin_amdgcn_sched_barrier(0)
__device__ __forceinline__ int crow(int r, int hi) { return (r & 3) + 8 * (r >> 2) + 4 * hi; }
__device__ __forceinline__ unsigned cvtpk(float lo, float hi) { unsigned r; asm volatile("v_cvt_pk_bf16_f32 %0, %1, %2" : "=v"(r) : "v"(lo), "v"(hi)); return r; }
__device__ __forceinline__ void partialSM(f32x16& p0, f32x16& p1, float& m_reg, float& mn, float& alpha) {
  constexpr float C = SCALE * 1.4426950408889634f;
  float pmax = p0[0];
#pragma unroll
  for (int r = 1; r < 16; ++r) pmax = fmaxf(pmax, p0[r]);
#pragma unroll
  for (int r = 0; r < 16; ++r) pmax = fmaxf(pmax, p1[r]);
  { auto rr = __builtin_amdgcn_permlane32_swap(__float_as_uint(pmax), __float_as_uint(pmax), false, false);
    pmax = fmaxf(__uint_as_float(rr[0]), __uint_as_float(rr[1])); }
  if (__builtin_expect(__all(pmax - m_reg <= THR / SCALE), 1)) { mn = m_reg; alpha = 1.f; }
  else { mn = fmaxf(m_reg, pmax); alpha = __builtin_amdgcn_exp2f((m_reg - mn) * C); m_reg = mn; }
  const float mnC = -mn * C;
#pragma unroll
  for (int r = 0; r < 16; ++r) p0[r] = fmaf(p0[r], C, mnC);
#pragma unroll
  for (int r = 0; r < 16; ++r) p1[r] = fmaf(p1[r], C, mnC);
#pragma unroll
  for (int r = 0; r < 16; ++r) p0[r] = __builtin_amdgcn_exp2f(p0[r]);
}
__device__ __forceinline__ void finishSM(f32x16& p0, f32x16& p1, float alpha, float& l_reg, bf16x8& pa0, bf16x8& pa1, bf16x8& pa2, bf16x8& pa3) {
#pragma unroll
  for (int r = 0; r < 16; ++r) p1[r] = __builtin_amdgcn_exp2f(p1[r]);
  float ps = 0;
#pragma unroll
  for (int r = 0; r < 16; ++r) ps += p0[r];
#pragma unroll
  for (int r = 0; r < 16; ++r) ps += p1[r];
  { auto rr = __builtin_amdgcn_permlane32_swap(__float_as_uint(ps), __float_as_uint(ps), false, false);
    ps = __uint_as_float(rr[0]) + __uint_as_float(rr[1]); }
  l_reg = l_reg * alpha + ps;
#define PK4(P, BASE, OUT) do { unsigned a0 = cvtpk(P[BASE + 0], P[BASE + 1]), a1 = cvtpk(P[BASE + 2], P[BASE + 3]);   \
    unsigned b0 = cvtpk(P[BASE + 4], P[BASE + 5]), b1 = cvtpk(P[BASE + 6], P[BASE + 7]);                              \
    auto r0 = __builtin_amdgcn_permlane32_swap(a0, b0, false, false); auto r1 = __builtin_amdgcn_permlane32_swap(a1, b1, false, false); \
    u32x4 w = {r0[0], r1[0], r0[1], r1[1]}; OUT = *reinterpret_cast<bf16x8*>(&w); } while (0)
  PK4(p0, 0, pa0); PK4(p0, 8, pa1); PK4(p1, 0, pa2); PK4(p1, 8, pa3);
#undef PK4
}
__device__ __forceinline__ void qkt(f32x16& p0, f32x16& p1, const char* Ks, const bf16x8* qr, const char* qrl, int r32, int hi) {
  p0 = f32x16{}; p1 = f32x16{};
#pragma unroll
  for (int d0 = 0; d0 < 12; ++d0) { const int cb = (d0 * 16 + hi * 8) * 2;
    bf16x8 b0 = *reinterpret_cast<const bf16x8*>(Ks + r32 * KROW + cb);
    bf16x8 b1 = *reinterpret_cast<const bf16x8*>(Ks + (32 + r32) * KROW + cb);
    const bf16x8 qv = d0 < 5 ? qr[d0 < 5 ? d0 : 0] : *reinterpret_cast<const bf16x8*>(qrl + (d0 - 5) * 32);
    p0 = __builtin_amdgcn_mfma_f32_32x32x16_bf16(b0, qv, p0, 0, 0, 0);
    p1 = __builtin_amdgcn_mfma_f32_32x32x16_bf16(b1, qv, p1, 0, 0, 0); }
}
__device__ __forceinline__ int v_st(int k, int c) { const int kk = (k & ~0xC) | ((k & 4) << 1) | ((k & 8) >> 1); return ((kk >> 3) * 4 + (c >> 5)) * 512 + ((kk & 7) * 32 + (c & 31)) * 2; }
__device__ __forceinline__ int v_rd_base(int lane) { return ((lane & 3) << 3) | (((lane >> 2) & 3) << 6) | (((lane >> 4) & 1) << 5) | (((lane >> 5) & 1) << 8); }
constexpr int v_rd_off(int d0, int ks, int half) { return d0 * 512 + ks * 4096 + half * 2048; }
template <int OFF> __device__ __forceinline__ s16x4 tr_read(int vb) {
  s16x4 r; asm volatile("ds_read_b64_tr_b16 %0, %1 offset:%2" : "=&v"(r) : "v"(vb), "i"(OFF) : "memory"); return r;
}
template <int D0> __device__ __forceinline__ void pv_one(f32x16& od, int vb, bf16x8 pa0, bf16x8 pa1, bf16x8 pa2, bf16x8 pa3) {
  const s16x4 l0 = tr_read<v_rd_off(D0, 0, 0)>(vb), h0 = tr_read<v_rd_off(D0, 0, 1)>(vb), l1 = tr_read<v_rd_off(D0, 1, 0)>(vb), h1 = tr_read<v_rd_off(D0, 1, 1)>(vb);
  const s16x4 l2 = tr_read<v_rd_off(D0, 2, 0)>(vb), h2 = tr_read<v_rd_off(D0, 2, 1)>(vb), l3 = tr_read<v_rd_off(D0, 3, 0)>(vb), h3 = tr_read<v_rd_off(D0, 3, 1)>(vb);
  asm volatile("s_waitcnt lgkmcnt(0)" ::: "memory"); SBAR();
#define PK(L, H) (bf16x8){L[0], L[1], L[2], L[3], H[0], H[1], H[2], H[3]}
  od = __builtin_amdgcn_mfma_f32_32x32x16_bf16(pa0, PK(l0, h0), od, 0, 0, 0);
  od = __builtin_amdgcn_mfma_f32_32x32x16_bf16(pa1, PK(l1, h1), od, 0, 0, 0);
  od = __builtin_amdgcn_mfma_f32_32x32x16_bf16(pa2, PK(l2, h2), od, 0, 0, 0);
  od = __builtin_amdgcn_mfma_f32_32x32x16_bf16(pa3, PK(l3, h3), od, 0, 0, 0);
#undef PK
}
__device__ __forceinline__ void pv_d0(f32x16* o, int vb, bf16x8 pa0, bf16x8 pa1, bf16x8 pa2, bf16x8 pa3) {
  pv_one<0>(o[0], vb, pa0, pa1, pa2, pa3); pv_one<1>(o[1], vb, pa0, pa1, pa2, pa3); pv_one<2>(o[2], vb, pa0, pa1, pa2, pa3); pv_one<3>(o[3], vb, pa0, pa1, pa2, pa3);
}
__device__ __forceinline__ void attn_body(const bf16_t* __restrict__ Qb, const bf16_t* __restrict__ Kh, const bf16_t* __restrict__ Krb, const bf16_t* __restrict__ Vh,
                                          bf16_t* __restrict__ Ob, int nkeys, char* lds) {
  const int tid = otid(), wid = tid >> 6, lane = tid & 63, r32 = lane & 31, hi = lane >> 5;
  char* V_lds = lds; char* K_lds = lds + 2 * SHM_V;
  float* ws = (float*)(lds + 2 * SHM_V + 2 * SHM_K) + wid * 64; float* li_l = ws; float* al_l = ws + 32;
  float m_reg = -1e30f, l_reg = 0; f32x16 o[4] = {}; bf16x8 qr[5];
  const bf16_t* Qw = Qb + (size_t)(wid * 32 + r32) * 192 + hi * 8;
  char* qrl = lds + 2 * SHM_V + 2 * SHM_K + 8 * 64 * 4 + (wid * 32 + r32) * QRROW + hi * 16;
#pragma unroll
  for (int d0 = 0; d0 < 5; ++d0) qr[d0] = *reinterpret_cast<const bf16x8*>(Qw + d0 * 16);
#pragma unroll
  for (int d0 = 5; d0 < 12; ++d0) *reinterpret_cast<bf16x8*>(qrl + (d0 - 5) * 32) = *reinterpret_cast<const bf16x8*>(Qw + d0 * 16);
  const int sr = tid >> 4, sc = (tid & 15) * 8, vst0 = v_st(sr, sc), vst1 = v_st(32 + sr, sc);
  const int krw = tid >> 3, kch = tid & 7;
  const int vb0 = (int)(uintptr_t)V_lds + v_rd_base(lane);
  bf16x8 vs0, vs1, ks0, ks1, ks2;
#define SLOAD(k0) do { vs0 = *reinterpret_cast<const bf16x8*>(&Vh[(size_t)((k0) + sr) * 128 + sc]); vs1 = *reinterpret_cast<const bf16x8*>(&Vh[(size_t)((k0) + 32 + sr) * 128 + sc]); \
    const bf16_t* kp_ = &Kh[(size_t)((k0) + krw) * 128 + kch * 8]; \
    ks0 = *reinterpret_cast<const bf16x8*>(kp_); ks1 = *reinterpret_cast<const bf16x8*>(kp_ + 64); \
    ks2 = *reinterpret_cast<const bf16x8*>(&Krb[(size_t)((k0) + krw) * 64 + kch * 8]); } while (0)
#define SWRITE(b) do { *(bf16x8*)(V_lds + (b) * SHM_V + vst0) = vs0; *(bf16x8*)(V_lds + (b) * SHM_V + vst1) = vs1; \
    char* kl_ = K_lds + (b) * SHM_K + krw * KROW + kch * 16; \
    *(bf16x8*)(kl_) = ks0; *(bf16x8*)(kl_ + 128) = ks1; *(bf16x8*)(kl_ + 256) = ks2; } while (0)
#define SWAIT() asm volatile("s_waitcnt vmcnt(0)" ::: "memory")
#define RESC(a) do { if (__any((a) < 1.f)) { if (hi == 0) al_l[r32] = (a); asm volatile("s_waitcnt lgkmcnt(0)" ::: "memory"); \
    for (int d = 0; d < 4; ++d) for (int r = 0; r < 16; ++r) o[d][r] *= al_l[crow(r, hi)]; } } while (0)
  f32x16 pA0, pA1, pB0, pB1; float mnA, mnB, alA, alB; bf16x8 pa0, pa1, pa2, pa3; const int NTL = nkeys / KVBLK;
  SLOAD(0); SWAIT(); SWRITE(0); __syncthreads();
  qkt(pA0, pA1, K_lds, qr, qrl, r32, hi); partialSM(pA0, pA1, m_reg, mnA, alA);
  SLOAD(KVBLK);
  SWAIT(); SWRITE(1); __syncthreads();
  for (int j = 1; j + 1 < NTL; j += 2) {
    SBAR(); qkt(pB0, pB1, K_lds + SHM_K, qr, qrl, r32, hi);
    finishSM(pA0, pA1, alA, l_reg, pa0, pa1, pa2, pa3); SBAR();
    SLOAD((j + 1) * KVBLK); SBAR();
    pv_d0(o, vb0, pa0, pa1, pa2, pa3); partialSM(pB0, pB1, m_reg, mnB, alB);
    __syncthreads(); SWAIT(); SWRITE(0);
    RESC(alB); __syncthreads();
    SBAR(); qkt(pA0, pA1, K_lds, qr, qrl, r32, hi);
    finishSM(pB0, pB1, alB, l_reg, pa0, pa1, pa2, pa3); SBAR();
    SLOAD((j + 2) * KVBLK); SBAR();
    pv_d0(o, vb0 + SHM_V, pa0, pa1, pa2, pa3); partialSM(pA0, pA1, m_reg, mnA, alA);
    __syncthreads(); SWAIT(); SWRITE(1);
    RESC(alA); __syncthreads();
  }
  SBAR(); qkt(pB0, pB1, K_lds + SHM_K, qr, qrl, r32, hi);
  finishSM(pA0, pA1, alA, l_reg, pa0, pa1, pa2, pa3); SBAR();
  pv_d0(o, vb0, pa0, pa1, pa2, pa3); partialSM(pB0, pB1, m_reg, mnB, alB);
  __syncthreads(); RESC(alB);
  finishSM(pB0, pB1, alB, l_reg, pa0, pa1, pa2, pa3); SBAR();
  pv_d0(o, vb0 + SHM_V, pa0, pa1, pa2, pa3);
  if (hi == 0) li_l[r32] = l_reg; asm volatile("s_waitcnt lgkmcnt(0)" ::: "memory");
  float rli[16];
#pragma unroll
  for (int r = 0; r < 16; ++r) rli[r] = __builtin_amdgcn_rcpf(li_l[crow(r, hi)]);
  bf16_t* Ow = Ob + (size_t)(wid * 32) * D;
#pragma unroll
  for (int r = 0; r < 16; ++r) { const int orow = crow(r, hi);
#pragma unroll
    for (int d0 = 0; d0 < 4; ++d0) Ow[(size_t)orow * D + d0 * 32 + r32] = f2bf(o[d0][r] * rli[r]); }
  __syncthreads();
#undef SLOAD
#undef SWRITE
#undef SWAIT
#undef RESC
}
}

__device__ __forceinline__ void ph_attn(const bf16_t* __restrict__ Qa, const bf16_t* __restrict__ Kn, const bf16_t* __restrict__ Kr, const bf16_t* __restrict__ Va,
                                        bf16_t* __restrict__ AO, int bid, int nblk, char* lds) {
  for (int item = bid; item < 512; item += nblk) {
    const int b = item >> 8, h = item & 7, qb = (item >> 3) & 31;
    att::attn_body(Qa + ((size_t)(b * 8 + h) * SEQ + qb * 256) * 192, Kn + (size_t)(b * 8 + h) * KEYS * 128, Kr + (size_t)b * KEYS * 64,
                   Va + (size_t)(b * 8 + h) * KEYS * 128, AO + (size_t)(b * SEQ + qb * 256) * D + h * 128, KEYS, lds);
  }
}

namespace rt {
using f32x16 = __attribute__((ext_vector_type(16))) float;
__device__ __forceinline__ int sortable(float f) { const int b = __float_as_int(f); return b ^ ((b >> 31) & 0x7FFFFFFF); }
__device__ __forceinline__ float unsortable(int k) { return __int_as_float(k ^ ((k >> 31) & 0x7FFFFFFF)); }
__device__ __forceinline__ int imax(int a, int b) { return a > b ? a : b; }
__device__ __forceinline__ int imin(int a, int b) { return a < b ? a : b; }
template <int N> __device__ __forceinline__ void sort_desc(int (&v)[N]) {
#pragma unroll
  for (int k = 2; k <= N; k <<= 1) {
#pragma unroll
    for (int j = k >> 1; j > 0; j >>= 1) {
#pragma unroll
      for (int i = 0; i < N; ++i) {
        const int l = i ^ j;
        if (l > i) {
          const bool desc = ((i & k) == 0);
          const int a = v[i], b = v[l];
          v[i] = desc ? imax(a, b) : imin(a, b);
          v[l] = desc ? imin(a, b) : imax(a, b);
        }
      }
    }
  }
}
template <int N> __device__ __forceinline__ void merge_desc(int (&v)[N]) {
#pragma unroll
  for (int j = N >> 1; j > 0; j >>= 1) {
#pragma unroll
    for (int i = 0; i < N; ++i) {
      const int l = i ^ j;
      if (l > i) { const int a = v[i], b = v[l]; v[i] = imax(a, b); v[l] = imin(a, b); }
    }
  }
}
__device__ __forceinline__ void absorb16(int (&L)[16], int (&B)[16]) {
  sort_desc<16>(B);
#pragma unroll
  for (int i = 0; i < 16; ++i) L[i] = imax(L[i], B[15 - i]);
  merge_desc<16>(L);
}
__device__ __forceinline__ constexpr int npairs_row(int i) { return 16 / (i + 1); }
}

struct RouteP { const float* Q; const bf16_t* Khi; const bf16_t* Klo; int* IDX; float* GATE; int rows_per_block; int pad; };
__device__ __forceinline__ void ph_route(const RouteP& p, int bid, char* lds) {
  using namespace rt;
  int (*svl)[64][33] = reinterpret_cast<int (*)[64][33]>(lds);
  const int wave = otid() >> 6, lane = otid() & 63, r32 = lane & 31, hi = lane >> 5, hi4 = hi * 4;
  int nrows = p.rows_per_block; asm volatile("" : "+s"(nrows));
  const int g0 = bid * nrows;
  const int h = wave;
#pragma unroll 1
  for (int tg = 0; tg * 32 < nrows; ++tg) {
    int trow = tg * 32 + r32; const bool valid = trow < nrows; trow = valid ? trow : nrows - 1;
    const float* qrow = p.Q + (size_t)(g0 + trow) * D;
    int sv[2][16];
#pragma unroll
    for (int s = 0; s < 2; ++s) {
      const int hs = h * 2 + s;
      f32x16 acc[4];
#pragma unroll
      for (int m = 0; m < 4; ++m) acc[m] = f32x16{};
#pragma unroll
      for (int ks = 0; ks < 4; ++ks) {
        const float4 qa = *(const float4*)(qrow + hs * 64 + ks * 16 + hi * 8), qb = *(const float4*)(qrow + hs * 64 + ks * 16 + hi * 8 + 4);
        uint4 qh, ql;
        qh.x = pack2bf(qa.x, qa.y); qh.y = pack2bf(qa.z, qa.w); qh.z = pack2bf(qb.x, qb.y); qh.w = pack2bf(qb.z, qb.w);
        ql.x = pack2bf(qa.x - bflo(qh.x), qa.y - bfhi(qh.x)); ql.y = pack2bf(qa.z - bflo(qh.y), qa.w - bfhi(qh.y));
        ql.z = pack2bf(qb.x - bflo(qh.z), qb.y - bfhi(qh.z)); ql.w = pack2bf(qb.z - bflo(qh.w), qb.w - bfhi(qh.w));
        const bf16x8 bqh = *reinterpret_cast<const bf16x8*>(&qh), bql = *reinterpret_cast<const bf16x8*>(&ql);
#pragma unroll
        for (int m = 0; m < 4; ++m) {
          const size_t ko = ((size_t)(hs * 128 + m * 32 + r32)) * 64 + ks * 16 + hi * 8;
          const bf16x8 kh = *(const bf16x8*)(p.Khi + ko), kl = *(const bf16x8*)(p.Klo + ko);
          acc[m] = __builtin_amdgcn_mfma_f32_32x32x16_bf16(kh, bqh, acc[m], 0, 0, 0);
          acc[m] = __builtin_amdgcn_mfma_f32_32x32x16_bf16(kh, bql, acc[m], 0, 0, 0);
          acc[m] = __builtin_amdgcn_mfma_f32_32x32x16_bf16(kl, bqh, acc[m], 0, 0, 0);
        }
      }
      int L[16];
#pragma unroll
      for (int m = 0; m < 4; ++m) {
        int B[16];
#pragma unroll
        for (int r = 0; r < 16; ++r) B[r] = (sortable(acc[m][r]) & ~0x7F) | (m * 32 + (r & 3) + 8 * (r >> 2)) | hi4;
        if (m == 0) { sort_desc<16>(B);
#pragma unroll
          for (int i = 0; i < 16; ++i) L[i] = B[i]; }
        else absorb16(L, B);
      }
      int Lo[16], Hi[16];
#pragma unroll
      for (int i = 0; i < 16; ++i) { auto rr = __builtin_amdgcn_permlane32_swap((unsigned)L[i], (unsigned)L[i], false, false); Lo[i] = (int)rr[0]; Hi[i] = (int)rr[1]; }
#pragma unroll
      for (int i = 0; i < 16; ++i) L[i] = imax(Lo[i], Hi[15 - i]);
      merge_desc<16>(L);
#pragma unroll
      for (int i = 0; i < 16; ++i) { sv[s][i] = L[i]; svl[wave][lane][s * 16 + i] = L[i]; }
    }
    float f0[16], f1[16];
#pragma unroll
    for (int i = 0; i < 16; ++i) { f0[i] = unsortable(sv[0][i] & ~0x7F); f1[i] = unsortable(sv[1][i] & ~0x7F); }
    int Lc[16];
    {
      int C[64];
      int n = 0;
#pragma unroll
      for (int i = 0; i < 16; ++i)
#pragma unroll
        for (int j = 0; j < 16; ++j)
          if ((i + 1) * (j + 1) <= 16) { C[n] = (sortable(f0[i] + f1[j]) & ~0xFF) | (i * 16 + j); ++n; }
#pragma unroll
      for (int k = 50; k < 64; ++k) C[k] = (int)0x80000000;
#pragma unroll
      for (int m = 0; m < 4; ++m) {
        int B[16];
#pragma unroll
        for (int r = 0; r < 16; ++r) B[r] = C[m * 16 + r];
        if (m == 0) { sort_desc<16>(B);
#pragma unroll
          for (int i = 0; i < 16; ++i) Lc[i] = B[i]; }
        else absorb16(Lc, B);
      }
    }
    float e[16]; float esum = 0.f;
    const float vmax = unsortable(Lc[0] & ~0xFF);
#pragma unroll
    for (int r = 0; r < 16; ++r) { e[r] = expf(unsortable(Lc[r] & ~0xFF) - vmax); esum += e[r]; }
    const float inv = 1.f / esum;
    int eid[16];
#pragma unroll
    for (int r = 0; r < 16; ++r) {
      const int pr = Lc[r] & 0xFF;
      const int k0 = svl[wave][lane][pr >> 4] & 0x7F, k1 = svl[wave][lane][16 + (pr & 15)] & 0x7F;
      eid[r] = k0 * 128 + k1;
    }
    if (valid && hi == 0) {
      int* ip = p.IDX + (size_t)(g0 + trow) * 128 + h * 16; float* gp = p.GATE + (size_t)(g0 + trow) * 128 + h * 16;
#pragma unroll
      for (int r = 0; r < 16; r += 4) {
        *(int4*)(ip + r) = make_int4(eid[r], eid[r + 1], eid[r + 2], eid[r + 3]);
        *(float4*)(gp + r) = make_float4(e[r] * inv, e[r + 1] * inv, e[r + 2] * inv, e[r + 3] * inv);
      }
    }
  }
}

__device__ __forceinline__ float wave_sum_dpp(float v) {
  v += __uint_as_float(__builtin_amdgcn_update_dpp(0u, __float_as_uint(v), 0xB1, 0xF, 0xF, true));
  v += __uint_as_float(__builtin_amdgcn_update_dpp(0u, __float_as_uint(v), 0x4E, 0xF, 0xF, true));
  v += __uint_as_float(__builtin_amdgcn_update_dpp(0u, __float_as_uint(v), 0x141, 0xF, 0xF, true));
  v += __uint_as_float(__builtin_amdgcn_update_dpp(0u, __float_as_uint(v), 0x140, 0xF, 0xF, true));
  v += __uint_as_float(__builtin_amdgcn_update_dpp(0u, __float_as_uint(v), 0x142, 0xA, 0xF, true));
  v += __uint_as_float(__builtin_amdgcn_update_dpp(0u, __float_as_uint(v), 0x143, 0xC, 0xF, true));
  return __uint_as_float((unsigned)__builtin_amdgcn_readlane((int)__float_as_uint(v), 63));
}
__device__ __forceinline__ float gelu_fast(float x) {
  const float z = fabsf(x) * 0.70710678118654752f;
  const float t = __builtin_amdgcn_rcpf(fmaf(0.3275911f, z, 1.f));
  float pl = fmaf(1.061405429f, t, -1.453152027f); pl = fmaf(pl, t, 1.421413741f); pl = fmaf(pl, t, -0.284496736f); pl = fmaf(pl, t, 0.254829592f);
  const float e = __builtin_amdgcn_exp2f(-z * z * 1.4426950408889634f);
  const float erfa = 1.f - pl * t * e;
  const float hx = 0.5f * x;
  return hx + fabsf(hx) * erfa;
}
__device__ __forceinline__ void cvt_rows_i8(const float* __restrict__ src, unsigned char* __restrict__ dst, float* __restrict__ scl, int nrows, int wgid, int nw) {
  const int lane = otid() & 63;
  for (int r = wgid; r < nrows; r += nw) {
    float v[16];
    const float* sp = src + (size_t)r * D + lane * 4;
    *(float4*)&v[0] = *(const float4*)sp; *(float4*)&v[4] = *(const float4*)(sp + 256); *(float4*)&v[8] = *(const float4*)(sp + 512); *(float4*)&v[12] = *(const float4*)(sp + 768);
    float am = 0.f;
#pragma unroll
    for (int j = 0; j < 16; ++j) am = fmaxf(am, fabsf(v[j]));
#pragma unroll
    for (int o = 32; o >= 1; o >>= 1) am = fmaxf(am, __shfl_xor(am, o));
    const float sc = am > 0.f ? am * (1.f / 127.f) : 1.f, inv = 1.f / sc;
    unsigned w[4];
#pragma unroll
    for (int q4 = 0; q4 < 4; ++q4) {
      unsigned ww = 0u;
#pragma unroll
      for (int j = 0; j < 4; ++j) { int qi = (int)rintf(v[q4 * 4 + j] * inv) + 128; qi = qi < 1 ? 1 : (qi > 255 ? 255 : qi); ww |= (unsigned)qi << (8 * j); }
      w[q4] = ww;
    }
    *(uint4*)(dst + (size_t)r * D + lane * 16) = make_uint4(w[0], w[1], w[2], w[3]);
    if (lane == 0) scl[r] = sc;
  }
}

struct GatherP { const bf16_t* Tbf; const int* IDX; const float* GATE; const unsigned char* utab; const unsigned char* vtab; const float* su; const float* sv;
                 const float* Hin; const float* mod; const float* lng; const float* lnb; float* Hout; const float* modT; };
constexpr int BSHIFT = 9, NBUCK = 16384 >> BSHIFT;
constexpr int ECHUNK = 32, ECAP = 512;
#define UB0(w) ((float)((w) & 0xFFu))
#define UB1(w) ((float)(((w) >> 8) & 0xFFu))
#define UB2(w) ((float)(((w) >> 16) & 0xFFu))
#define UB3(w) ((float)((w) >> 24))
template <int RS, int NROUND, bool FINAL>
__device__ __forceinline__ void ph_gather_i8(const GatherP& p, int g0, int nrows, char* As, unsigned* __restrict__ ENTb, float* __restrict__ GATb) {
  const int tid = otid(), wave = tid >> 6, lane = tid & 63;
  load_rows_lds(As, p.Tbf + (size_t)g0 * D, nrows);
  unsigned* ent = ENTb + wave * ECAP; float* gat = GATb + wave * ECAP;
  const unsigned long long ltm = (1ull << lane) - 1ull;
  __syncthreads();
#pragma unroll 1
  for (int round = 0; round < NROUND; ++round) {
    const int s0 = round * RS;
    int cnt = 0;
#pragma unroll 1
    for (int i = 0; i < RS; ++i) {
      const int rr = wave + 8 * (s0 + i);
      if (rr < nrows) {
        const size_t ro = (size_t)(g0 + rr) * 128;
        const int a = p.IDX[ro + lane] >> BSHIFT, b = p.IDX[ro + 64 + lane] >> BSHIFT;
#pragma unroll 4
        for (int v = 0; v < NBUCK; ++v) { const int c = __popcll(__ballot(a == v)) + __popcll(__ballot(b == v)); if (lane == v) cnt += c; }
      }
    }
    int incl = cnt;
#pragma unroll
    for (int o = 1; o < 64; o <<= 1) { const int t = __shfl_up(incl, o); if (lane >= o) incl += t; }
    int base = incl - cnt;
    const int total = __builtin_amdgcn_readlane(incl, 63);
    float tsum[RS];
#pragma unroll
    for (int i = 0; i < RS; ++i) tsum[i] = 0.f;
#pragma unroll 1
    for (int i = 0; i < RS; ++i) {
      const int rr = wave + 8 * (s0 + i);
      if (rr < nrows) {
        const size_t ro = (size_t)(g0 + rr) * 128;
        const int ea = p.IDX[ro + lane], eb = p.IDX[ro + 64 + lane];
        const float ga = p.GATE[ro + lane], gb = p.GATE[ro + 64 + lane];
        const int a = ea >> BSHIFT, b = eb >> BSHIFT;
        int pa = 0, pb = 0;
#pragma unroll 4
        for (int v = 0; v < NBUCK; ++v) {
          const unsigned long long m0 = __ballot(a == v), m1 = __ballot(b == v);
          const int bv = __shfl(base, v), c0 = __popcll(m0);
          if (a == v) pa = bv + __popcll(m0 & ltm);
          if (b == v) pb = bv + c0 + __popcll(m1 & ltm);
          if (lane == v) base += c0 + __popcll(m1);
        }
        ent[pa] = (unsigned)ea | ((unsigned)i << 16); gat[pa] = ga;
        ent[pb] = (unsigned)eb | ((unsigned)i << 16); gat[pb] = gb;
        const char* tp = As + rr * LDA_B + lane * 32;
        const uint4 t0 = *(const uint4*)tp, t1 = *(const uint4*)(tp + 16);
        float ts = bflo(t0.x) + bfhi(t0.x) + bflo(t0.y) + bfhi(t0.y) + bflo(t0.z) + bfhi(t0.z) + bflo(t0.w) + bfhi(t0.w)
                 + bflo(t1.x) + bfhi(t1.x) + bflo(t1.y) + bfhi(t1.y) + bflo(t1.z) + bfhi(t1.z) + bflo(t1.w) + bfhi(t1.w);
        ts = wave_sum_dpp(ts);
#pragma unroll
        for (int k = 0; k < RS; ++k) if (k == i) tsum[k] = ts;
      }
    }
    int nvalid0 = 0;
#pragma unroll
    for (int i = 0; i < RS; ++i) nvalid0 += (8 * (s0 + i) < nrows) ? 1 : 0;
    const int nchunks = (128 * nvalid0 + ECHUNK - 1) / ECHUNK;
    for (int k = total + lane; k < (nchunks + 2) * ECHUNK; k += 64) { ent[k] = 0u; gat[k] = 0.f; }
    asm volatile("s_waitcnt vmcnt(0)" ::: "memory");
    float f[RS][16], asum[RS];
#pragma unroll
    for (int i = 0; i < RS; ++i) { asum[i] = 0.f;
#pragma unroll
      for (int j = 0; j < 16; ++j) f[i][j] = 0.f; }
    uint4 ub[8], vb[8]; float sub[8], svb[8];
    unsigned ecur = ent[lane & 31], enxt = ent[ECHUNK + (lane & 31)];
    float gcur = gat[lane & 31], gnxt = gat[ECHUNK + (lane & 31)];
#define ROWLOAD3(slot, ep) do { const unsigned e_ = (ep) & 0xFFFFu; \
        ub[slot] = *(const uint4*)(p.utab + (size_t)e_ * D + lane * 16); vb[slot] = *(const uint4*)(p.vtab + (size_t)e_ * D + lane * 16); \
        sub[slot] = p.su[e_]; svb[slot] = p.sv[e_]; } while (0)
#define ROWPROC3(slot, ep, gv) do { \
        const int ts_ = (int)((ep) >> 16); \
        const char* tp_ = As + (wave + 8 * (s0 + ts_)) * LDA_B + lane * 32; \
        const uint4 t0_ = *(const uint4*)tp_, t1_ = *(const uint4*)(tp_ + 16); \
        const uint4 a_ = ub[slot]; \
        float dot_ = bflo(t0_.x) * UB0(a_.x); dot_ = fmaf(bfhi(t0_.x), UB1(a_.x), dot_); dot_ = fmaf(bflo(t0_.y), UB2(a_.x), dot_); dot_ = fmaf(bfhi(t0_.y), UB3(a_.x), dot_); \
        dot_ = fmaf(bflo(t0_.z), UB0(a_.y), dot_); dot_ = fmaf(bfhi(t0_.z), UB1(a_.y), dot_); dot_ = fmaf(bflo(t0_.w), UB2(a_.y), dot_); dot_ = fmaf(bfhi(t0_.w), UB3(a_.y), dot_); \
        dot_ = fmaf(bflo(t1_.x), UB0(a_.z), dot_); dot_ = fmaf(bfhi(t1_.x), UB1(a_.z), dot_); dot_ = fmaf(bflo(t1_.y), UB2(a_.z), dot_); dot_ = fmaf(bfhi(t1_.y), UB3(a_.z), dot_); \
        dot_ = fmaf(bflo(t1_.z), UB0(a_.w), dot_); dot_ = fmaf(bfhi(t1_.z), UB1(a_.w), dot_); dot_ = fmaf(bflo(t1_.w), UB2(a_.w), dot_); dot_ = fmaf(bfhi(t1_.w), UB3(a_.w), dot_); \
        dot_ = wave_sum_dpp(dot_); \
        float tsv_ = tsum[0]; \
        _Pragma("unroll") for (int i_ = 1; i_ < RS; ++i_) tsv_ = (ts_ == i_) ? tsum[i_] : tsv_; \
        const float act_ = gelu_fast(sub[slot] * (dot_ - 128.f * tsv_)) * (gv) * svb[slot]; \
        const uint4 c_ = vb[slot]; \
        float x_[16] = {UB0(c_.x), UB1(c_.x), UB2(c_.x), UB3(c_.x), UB0(c_.y), UB1(c_.y), UB2(c_.y), UB3(c_.y), UB0(c_.z), UB1(c_.z), UB2(c_.z), UB3(c_.z), UB0(c_.w), UB1(c_.w), UB2(c_.w), UB3(c_.w)}; \
        _Pragma("unroll") for (int i_ = 0; i_ < RS; ++i_) { const float m_ = (ts_ == i_) ? act_ : 0.f;        \
          asum[i_] += m_; \
          _Pragma("unroll") for (int j_ = 0; j_ < 16; ++j_) f[i_][j_] = fmaf(m_, x_[j_], f[i_][j_]); } } while (0)
#define RL(v, j) ((unsigned)__builtin_amdgcn_readlane((int)(v), (j)))
#define RLF(v, j) __uint_as_float((unsigned)__builtin_amdgcn_readlane((int)__float_as_uint(v), (j)))
    ROWLOAD3(0, RL(ecur, 0)); ROWLOAD3(1, RL(ecur, 1)); ROWLOAD3(2, RL(ecur, 2)); ROWLOAD3(3, RL(ecur, 3)); ROWLOAD3(4, RL(ecur, 4)); ROWLOAD3(5, RL(ecur, 5)); ROWLOAD3(6, RL(ecur, 6)); ROWLOAD3(7, RL(ecur, 7));
#pragma unroll 1
    for (int c = 0; c < nchunks; ++c) {
      __syncthreads();
#pragma unroll 1
      for (int j = 0; j < ECHUNK - 8; j += 8) {
        ROWPROC3(0, RL(ecur, j + 0), RLF(gcur, j + 0)); ROWLOAD3(0, RL(ecur, j + 8));
        ROWPROC3(1, RL(ecur, j + 1), RLF(gcur, j + 1)); ROWLOAD3(1, RL(ecur, j + 9));
        ROWPROC3(2, RL(ecur, j + 2), RLF(gcur, j + 2)); ROWLOAD3(2, RL(ecur, j + 10));
        ROWPROC3(3, RL(ecur, j + 3), RLF(gcur, j + 3)); ROWLOAD3(3, RL(ecur, j + 11));
        ROWPROC3(4, RL(ecur, j + 4), RLF(gcur, j + 4)); ROWLOAD3(4, RL(ecur, j + 12));
        ROWPROC3(5, RL(ecur, j + 5), RLF(gcur, j + 5)); ROWLOAD3(5, RL(ecur, j + 13));
        ROWPROC3(6, RL(ecur, j + 6), RLF(gcur, j + 6)); ROWLOAD3(6, RL(ecur, j + 14));
        ROWPROC3(7, RL(ecur, j + 7), RLF(gcur, j + 7)); ROWLOAD3(7, RL(ecur, j + 15));
      }
      ROWPROC3(0, RL(ecur, ECHUNK - 8), RLF(gcur, ECHUNK - 8)); ROWLOAD3(0, RL(enxt, 0));
      ROWPROC3(1, RL(ecur, ECHUNK - 7), RLF(gcur, ECHUNK - 7)); ROWLOAD3(1, RL(enxt, 1));
      ROWPROC3(2, RL(ecur, ECHUNK - 6), RLF(gcur, ECHUNK - 6)); ROWLOAD3(2, RL(enxt, 2));
      ROWPROC3(3, RL(ecur, ECHUNK - 5), RLF(gcur, ECHUNK - 5)); ROWLOAD3(3, RL(enxt, 3));
      ROWPROC3(4, RL(ecur, ECHUNK - 4), RLF(gcur, ECHUNK - 4)); ROWLOAD3(4, RL(enxt, 4));
      ROWPROC3(5, RL(ecur, ECHUNK - 3), RLF(gcur, ECHUNK - 3)); ROWLOAD3(5, RL(enxt, 5));
      ROWPROC3(6, RL(ecur, ECHUNK - 2), RLF(gcur, ECHUNK - 2)); ROWLOAD3(6, RL(enxt, 6));
      ROWPROC3(7, RL(ecur, ECHUNK - 1), RLF(gcur, ECHUNK - 1)); ROWLOAD3(7, RL(enxt, 7));
      ecur = enxt; gcur = gnxt;
      enxt = ent[(c + 2) * ECHUNK + (lane & 31)]; gnxt = gat[(c + 2) * ECHUNK + (lane & 31)];
    }
#undef ROWLOAD3
#undef ROWPROC3
#undef RL
#undef RLF
#pragma unroll
    for (int i = 0; i < RS; ++i) {
      int rr = wave + 8 * (s0 + i); asm volatile("" : "+v"(rr));
      if (rr < nrows) {
        const int row = g0 + rr, v = row_vec(row);
        const float* hin = p.Hin + (size_t)row * D + lane * 16;
        const float* gm = p.mod + v * 6144 + 5 * 1024 + lane * 16;
        const float off = 128.f * asum[i];
        float r[16]; float ssum = 0.f;
#pragma unroll
        for (int q4 = 0; q4 < 4; ++q4) {
          const float4 h4 = *(const float4*)(hin + q4 * 4), g4 = *(const float4*)(gm + q4 * 4);
          r[q4 * 4 + 0] = ALPHA * h4.x + g4.x * (f[i][q4 * 4 + 0] - off); r[q4 * 4 + 1] = ALPHA * h4.y + g4.y * (f[i][q4 * 4 + 1] - off);
          r[q4 * 4 + 2] = ALPHA * h4.z + g4.z * (f[i][q4 * 4 + 2] - off); r[q4 * 4 + 3] = ALPHA * h4.w + g4.w * (f[i][q4 * 4 + 3] - off);
          ssum += r[q4 * 4 + 0] + r[q4 * 4 + 1] + r[q4 * 4 + 2] + r[q4 * 4 + 3];
        }
        const float mu = wave_sum(ssum) * (1.f / D);
        float vs = 0.f;
#pragma unroll
        for (int j = 0; j < 16; ++j) { const float dlt = r[j] - mu; vs += dlt * dlt; }
        const float rstd = rsqrtf(wave_sum(vs) * (1.f / D) + LN_EPS);
        float o[16];
#pragma unroll
        for (int q4 = 0; q4 < 4; ++q4) {
          const float4 g4 = *(const float4*)(p.lng + lane * 16 + q4 * 4), b4 = *(const float4*)(p.lnb + lane * 16 + q4 * 4);
          o[q4 * 4 + 0] = (r[q4 * 4 + 0] - mu) * rstd * g4.x + b4.x; o[q4 * 4 + 1] = (r[q4 * 4 + 1] - mu) * rstd * g4.y + b4.y;
          o[q4 * 4 + 2] = (r[q4 * 4 + 2] - mu) * rstd * g4.z + b4.z; o[q4 * 4 + 3] = (r[q4 * 4 + 3] - mu) * rstd * g4.w + b4.w;
          *(float4*)(p.Hout + (size_t)row * D + lane * 16 + q4 * 4) = make_float4(o[q4 * 4 + 0], o[q4 * 4 + 1], o[q4 * 4 + 2], o[q4 * 4 + 3]);
        }
        if (!FINAL) {
          const float* mt = p.modT + v * 6144 + lane * 16;
          unsigned w[8];
#pragma unroll
          for (int q2 = 0; q2 < 8; ++q2) {
            const float2 sh = *(const float2*)(mt + q2 * 2), sc = *(const float2*)(mt + 1024 + q2 * 2);
            w[q2] = pack2bf(o[q2 * 2] * (1.f + sc.x) + sh.x, o[q2 * 2 + 1] * (1.f + sc.y) + sh.y);
          }
          *(uint4*)(As + rr * LDA_B + lane * 32) = make_uint4(w[0], w[1], w[2], w[3]);
          *(uint4*)(As + rr * LDA_B + lane * 32 + 16) = make_uint4(w[4], w[5], w[6], w[7]);
        }
      }
    }
  }
}


template <bool FINAL>
__device__ __forceinline__ void ln_token(const GatherP& p, int row, int rr, int lane, const float (&f)[16], float asum, char* As) {
  const int v = row_vec(row);
  const float* hin = p.Hin + (size_t)row * D + lane * 4;
  const float* gm = p.mod + v * 6144 + 5 * 1024 + lane * 4;
  const float off = 128.f * asum;
  float r[16]; float ssum = 0.f;
#pragma unroll
  for (int q4 = 0; q4 < 4; ++q4) {
    const float4 h4 = *(const float4*)(hin + q4 * 256), g4 = *(const float4*)(gm + q4 * 256);
    r[q4 * 4 + 0] = ALPHA * h4.x + g4.x * (f[q4 * 4 + 0] - off); r[q4 * 4 + 1] = ALPHA * h4.y + g4.y * (f[q4 * 4 + 1] - off);
    r[q4 * 4 + 2] = ALPHA * h4.z + g4.z * (f[q4 * 4 + 2] - off); r[q4 * 4 + 3] = ALPHA * h4.w + g4.w * (f[q4 * 4 + 3] - off);
    ssum += r[q4 * 4 + 0] + r[q4 * 4 + 1] + r[q4 * 4 + 2] + r[q4 * 4 + 3];
  }
  const float mu = wave_sum(ssum) * (1.f / D);
  float vs = 0.f;
#pragma unroll
  for (int j = 0; j < 16; ++j) { const float dlt = r[j] - mu; vs += dlt * dlt; }
  const float rstd = rsqrtf(wave_sum(vs) * (1.f / D) + LN_EPS);
  float o[16];
#pragma unroll
  for (int q4 = 0; q4 < 4; ++q4) {
    const float4 g4 = *(const float4*)(p.lng + q4 * 256 + lane * 4), b4 = *(const float4*)(p.lnb + q4 * 256 + lane * 4);
    o[q4 * 4 + 0] = (r[q4 * 4 + 0] - mu) * rstd * g4.x + b4.x; o[q4 * 4 + 1] = (r[q4 * 4 + 1] - mu) * rstd * g4.y + b4.y;
    o[q4 * 4 + 2] = (r[q4 * 4 + 2] - mu) * rstd * g4.z + b4.z; o[q4 * 4 + 3] = (r[q4 * 4 + 3] - mu) * rstd * g4.w + b4.w;
    *(float4*)(p.Hout + (size_t)row * D + q4 * 256 + lane * 4) = make_float4(o[q4 * 4 + 0], o[q4 * 4 + 1], o[q4 * 4 + 2], o[q4 * 4 + 3]);
  }
  if (!FINAL) {
    const float* mt = p.modT + v * 6144 + lane * 4;
#pragma unroll
    for (int q4 = 0; q4 < 4; ++q4) {
      const float4 sh = *(const float4*)(mt + q4 * 256), sc = *(const float4*)(mt + 1024 + q4 * 256);
      uint2 w; w.x = pack2bf(o[q4 * 4] * (1.f + sc.x) + sh.x, o[q4 * 4 + 1] * (1.f + sc.y) + sh.y); w.y = pack2bf(o[q4 * 4 + 2] * (1.f + sc.z) + sh.z, o[q4 * 4 + 3] * (1.f + sc.w) + sh.w);
      *(uint2*)(As + rr * LDA_B + (q4 * 256 + lane * 4) * 2) = w;
    }
  }
}
constexpr int PARTW = 1088;
template <bool FINAL>
__device__ __forceinline__ void ph_gather_tm(const GatherP& p, int g0, int nrows, char* As, float* __restrict__ PART) {
  const int tid = otid(), wave = tid >> 6, lane = tid & 63;
  const int nfull = nrows >> 3, extra = nrows & 7;
  const int nun = nfull + (extra ? 1 : 0);
#pragma unroll 1
  for (int un = 0; un < nun; ++un) {
    int rr, kbeg, kcnt; bool partial;
    if (un < nfull) { rr = wave + 8 * un; kbeg = 0; kcnt = 128; partial = false; }
    else { const int wpt = 8 / extra; rr = nfull * 8 + wave / wpt; kcnt = 128 / wpt; kbeg = (wave % wpt) * kcnt; partial = true; }
    const int row = g0 + rr;
    float tf[16];
    {
      const bf16_t* tp = p.Tbf + (size_t)row * D + lane * 4;
      const uint2 t0 = *(const uint2*)tp, t1 = *(const uint2*)(tp + 256), t2 = *(const uint2*)(tp + 512), t3 = *(const uint2*)(tp + 768);
      tf[0] = bflo(t0.x); tf[1] = bfhi(t0.x); tf[2] = bflo(t0.y); tf[3] = bfhi(t0.y); tf[4] = bflo(t1.x); tf[5] = bfhi(t1.x); tf[6] = bflo(t1.y); tf[7] = bfhi(t1.y);
      tf[8] = bflo(t2.x); tf[9] = bfhi(t2.x); tf[10] = bflo(t2.y); tf[11] = bfhi(t2.y); tf[12] = bflo(t3.x); tf[13] = bfhi(t3.x); tf[14] = bflo(t3.y); tf[15] = bfhi(t3.y);
    }
    float tsum = 0.f;
#pragma unroll
    for (int j = 0; j < 16; ++j) tsum += tf[j];
    tsum = wave_sum_dpp(tsum) * 128.f;
    const int id_lo = p.IDX[(size_t)row * 128 + lane], id_hi = p.IDX[(size_t)row * 128 + 64 + lane];
    const float ga_lo = p.GATE[(size_t)row * 128 + lane], ga_hi = p.GATE[(size_t)row * 128 + 64 + lane];
    float f[16], asum = 0.f;
#pragma unroll
    for (int j = 0; j < 16; ++j) f[j] = 0.f;
    uint4 ub[8], vb[8]; float sub[8], svb[8];
#define TLOAD(slot, kk) do { const int e_ = __builtin_amdgcn_readlane((kk) < 64 ? id_lo : id_hi, (kk) & 63); \
      ub[slot] = *(const uint4*)(p.utab + (size_t)e_ * D + lane * 16); vb[slot] = *(const uint4*)(p.vtab + (size_t)e_ * D + lane * 16); \
      sub[slot] = p.su[e_]; svb[slot] = p.sv[e_]; } while (0)
#define TPROC(slot, kk) do { \
      const uint4 a_ = ub[slot]; \
      float dot_ = tf[0] * UB0(a_.x); dot_ = fmaf(tf[1], UB1(a_.x), dot_); dot_ = fmaf(tf[2], UB2(a_.x), dot_); dot_ = fmaf(tf[3], UB3(a_.x), dot_); \
      dot_ = fmaf(tf[4], UB0(a_.y), dot_); dot_ = fmaf(tf[5], UB1(a_.y), dot_); dot_ = fmaf(tf[6], UB2(a_.y), dot_); dot_ = fmaf(tf[7], UB3(a_.y), dot_); \
      dot_ = fmaf(tf[8], UB0(a_.z), dot_); dot_ = fmaf(tf[9], UB1(a_.z), dot_); dot_ = fmaf(tf[10], UB2(a_.z), dot_); dot_ = fmaf(tf[11], UB3(a_.z), dot_); \
      dot_ = fmaf(tf[12], UB0(a_.w), dot_); dot_ = fmaf(tf[13], UB1(a_.w), dot_); dot_ = fmaf(tf[14], UB2(a_.w), dot_); dot_ = fmaf(tf[15], UB3(a_.w), dot_); \
      dot_ = wave_sum_dpp(dot_); \
      const float g_ = __uint_as_float((unsigned)__builtin_amdgcn_readlane((int)__float_as_uint((kk) < 64 ? ga_lo : ga_hi), (kk) & 63)); \
      const float act_ = gelu_fast(sub[slot] * (dot_ - tsum)) * g_ * svb[slot]; \
      asum += act_; \
      const uint4 c_ = vb[slot]; \
      f[0] = fmaf(act_, UB0(c_.x), f[0]); f[1] = fmaf(act_, UB1(c_.x), f[1]); f[2] = fmaf(act_, UB2(c_.x), f[2]); f[3] = fmaf(act_, UB3(c_.x), f[3]); \
      f[4] = fmaf(act_, UB0(c_.y), f[4]); f[5] = fmaf(act_, UB1(c_.y), f[5]); f[6] = fmaf(act_, UB2(c_.y), f[6]); f[7] = fmaf(act_, UB3(c_.y), f[7]); \
      f[8] = fmaf(act_, UB0(c_.z), f[8]); f[9] = fmaf(act_, UB1(c_.z), f[9]); f[10] = fmaf(act_, UB2(c_.z), f[10]); f[11] = fmaf(act_, UB3(c_.z), f[11]); \
      f[12] = fmaf(act_, UB0(c_.w), f[12]); f[13] = fmaf(act_, UB1(c_.w), f[13]); f[14] = fmaf(act_, UB2(c_.w), f[14]); f[15] = fmaf(act_, UB3(c_.w), f[15]); } while (0)
    TLOAD(0, kbeg); TLOAD(1, kbeg + 1); TLOAD(2, kbeg + 2); TLOAD(3, kbeg + 3); TLOAD(4, kbeg + 4); TLOAD(5, kbeg + 5); TLOAD(6, kbeg + 6); TLOAD(7, kbeg + 7);
    const int kend = kbeg + kcnt - 8;
#pragma unroll 1
    for (int k = kbeg; k < kend; k += 8) {
      TPROC(0, k); TLOAD(0, k + 8); TPROC(1, k + 1); TLOAD(1, k + 9); TPROC(2, k + 2); TLOAD(2, k + 10); TPROC(3, k + 3); TLOAD(3, k + 11);
      TPROC(4, k + 4); TLOAD(4, k + 12); TPROC(5, k + 5); TLOAD(5, k + 13); TPROC(6, k + 6); TLOAD(6, k + 14); TPROC(7, k + 7); TLOAD(7, k + 15);
    }
    TPROC(0, kend); TPROC(1, kend + 1); TPROC(2, kend + 2); TPROC(3, kend + 3); TPROC(4, kend + 4); TPROC(5, kend + 5); TPROC(6, kend + 6); TPROC(7, kend + 7);
#undef TLOAD
#undef TPROC
    if (!partial) ln_token<FINAL>(p, row, rr, lane, f, asum, As);
    else {
      float* pp = PART + wave * PARTW + lane * 16;
      *(float4*)pp = make_float4(f[0], f[1], f[2], f[3]); *(float4*)(pp + 4) = make_float4(f[4], f[5], f[6], f[7]);
      *(float4*)(pp + 8) = make_float4(f[8], f[9], f[10], f[11]); *(float4*)(pp + 12) = make_float4(f[12], f[13], f[14], f[15]);
      if (lane == 0) PART[wave * PARTW + 1024] = asum;
    }
  }
  if (extra) {
    __syncthreads();
    if (wave < extra) {
      const int wpt = 8 / extra, rr = nfull * 8 + wave;
      float f[16], asum = 0.f;
#pragma unroll
      for (int j = 0; j < 16; ++j) f[j] = 0.f;
      for (int w2 = wave * wpt; w2 < wave * wpt + wpt; ++w2) {
        const float* pp = PART + w2 * PARTW + lane * 16;
#pragma unroll
        for (int q4 = 0; q4 < 4; ++q4) { const float4 x4 = *(const float4*)(pp + q4 * 4); f[q4 * 4] += x4.x; f[q4 * 4 + 1] += x4.y; f[q4 * 4 + 2] += x4.z; f[q4 * 4 + 3] += x4.w; }
        asum += PART[w2 * PARTW + 1024];
      }
      ln_token<FINAL>(p, g0 + rr, rr, lane, f, asum, As);
    }
  }
}

__device__ __forceinline__ void cvt_plain(const float* __restrict__ a, bf16_t* __restrict__ o, size_t n8, bool lo, size_t gtid, size_t gsz) {
  for (size_t i = gtid; i < n8; i += gsz) {
    float v[8];
    *(float4*)&v[0] = ((const float4*)a)[i * 2]; *(float4*)&v[4] = ((const float4*)a)[i * 2 + 1];
    if (lo) {
#pragma unroll
      for (int j = 0; j < 8; ++j) v[j] = v[j] - bf2f(f2bf(v[j]));
    }
    uint4 w; w.x = pack2bf(v[0], v[1]); w.y = pack2bf(v[2], v[3]); w.z = pack2bf(v[4], v[5]); w.w = pack2bf(v[6], v[7]);
    ((uint4*)o)[i] = w;
  }
}
__device__ __forceinline__ void cvt_t(const float* __restrict__ W, bf16_t* __restrict__ Wt, int K, int N, bool lo, size_t gtid, size_t gsz) {
  const size_t total = (size_t)N * (K / 8);
  for (size_t i = gtid; i < total; i += gsz) {
    const int n = (int)(i % N), k8 = (int)(i / N);
    float v[8];
#pragma unroll
    for (int j = 0; j < 8; ++j) { const float w = W[(size_t)(k8 * 8 + j) * N + n]; v[j] = lo ? w - bf2f(f2bf(w)) : w; }
    uint4 w; w.x = pack2bf(v[0], v[1]); w.y = pack2bf(v[2], v[3]); w.z = pack2bf(v[4], v[5]); w.w = pack2bf(v[6], v[7]);
    *(uint4*)(Wt + ((size_t)((n >> 4) * (K >> 5) + (k8 >> 2)) * 64 + (k8 & 3) * 16 + (n & 15)) * 8) = w;
  }
}
__device__ __forceinline__ void mod_item(const float* __restrict__ c, const float* __restrict__ c_ctx, const float* __restrict__ ada_w, const float* __restrict__ ada_b,
                                         float* __restrict__ MOD, int item, char* lds) {
  float* sc = (float*)lds;
  float* part = sc + 3072;
  const int tid = otid(), wave = tid >> 6, lane = tid & 63, l = item / 96, cg = item % 96;
  for (int i = tid; i < 3072; i += 512) { const int v = i >> 10, k = i & 1023; const float xv = v < 2 ? c[v * 1024 + k] : c_ctx[k]; sc[i] = xv / (1.f + expf(-xv)); }
  __syncthreads();
  float a0 = 0.f, a1 = 0.f, a2 = 0.f;
  const float* W = ada_w + (size_t)l * 1024 * 6144 + cg * 64 + lane;
#pragma unroll 16
  for (int k = wave * 128; k < wave * 128 + 128; ++k) { const float w = W[(size_t)k * 6144]; a0 += sc[k] * w; a1 += sc[1024 + k] * w; a2 += sc[2048 + k] * w; }
  part[(wave * 3 + 0) * 64 + lane] = a0; part[(wave * 3 + 1) * 64 + lane] = a1; part[(wave * 3 + 2) * 64 + lane] = a2;
  __syncthreads();
  if (tid < 192) {
    const int v = tid >> 6, ln = tid & 63; float sum = 0.f;
#pragma unroll
    for (int w = 0; w < 8; ++w) sum += part[(w * 3 + v) * 64 + ln];
    MOD[(l * 3 + v) * 6144 + cg * 64 + ln] = sum + ada_b[l * 6144 + cg * 64 + ln];
  }
  __syncthreads();
}


__device__ __forceinline__ void gbar(unsigned* cnt, unsigned target) {
  asm volatile("s_waitcnt vmcnt(0)" ::: "memory");
  __syncthreads();
  if (otid() == 0) {
    __builtin_amdgcn_fence(__ATOMIC_RELEASE, "agent");
    asm volatile("s_waitcnt vmcnt(0)" ::: "memory");
    __hip_atomic_fetch_add(cnt, 1u, __ATOMIC_RELAXED, __HIP_MEMORY_SCOPE_AGENT);
    unsigned spins = 0;
    while (__hip_atomic_load(cnt, __ATOMIC_RELAXED, __HIP_MEMORY_SCOPE_AGENT) < target) { __builtin_amdgcn_s_sleep(2); if (++spins > (1u << 24)) break; }
    __builtin_amdgcn_fence(__ATOMIC_ACQUIRE, "agent");
    asm volatile("s_waitcnt vmcnt(0)" ::: "memory");
  }
  __syncthreads();
}

struct MP {
  const float *x, *c, *ctx, *c_ctx, *ada_w, *ada_b, *ln_g, *ln_b, *s5_a_re, *s5_a_im, *s5_log_dt, *s5_b_re, *s5_b_im, *s5_c_re, *s5_c_im, *s5_d, *s5_w_glu, *s5_w_o;
  const float *mla_w_dq, *mla_q_norm, *mla_w_uq, *mla_w_dkv, *mla_kv_norm, *mla_w_ukv, *mla_w_o, *peer_w_q, *peer_keys, *peer_u, *peer_v;
  float* out;
  float* MOD; bf16_t *Wt_glu, *Wt_o0, *Wt_q0, *Wt_q0lo, *Wt_o1, *Wt_q1, *Wt_q1lo, *Wt_cat, *Wt_uq, *Wt_ukv, *Khi, *Klo, *Khi1, *Klo1;
  unsigned char *U0, *V0, *U1, *V1; float *SU0, *SV0, *SU1, *SV1; bf16_t *Ktab, *Bst_t, *Cin_t;
  float *Ypart, *Ssta; bf16_t *HP, *Gbf, *Vbf, *Tbf, *Tlo; float *OQ, *H1, *H2; int* IDX; float* GATE;
  bf16_t *Qa, *Kn, *Kr, *Va, *AObf; float* H3; bf16_t *Tbf1, *Tlo1; unsigned* ENT; float* GATF; unsigned* BAR; float* PART;
};
constexpr int LDS_BYTES = att::SHM_ATTN > 66 * LDA_B ? att::SHM_ATTN : 66 * LDA_B;
__global__ __launch_bounds__(512) void mega(MP p) {
  __shared__ __attribute__((aligned(16))) char lds[LDS_BYTES];
  cg::grid_group grid = cg::this_grid();
  const int nblk = gridDim.x;
  int bid = blockIdx.x;
  const size_t gtid = (size_t)bid * 512 + otid(), gsz = (size_t)nblk * 512;
  const size_t TD = (size_t)1024 * 16384;
  const float* mod0 = p.MOD; const float* mod1 = p.MOD + 3 * 6144;
  cvt_t(p.s5_w_glu, p.Wt_glu, D, D, false, gtid, gsz);
  cvt_t(p.s5_w_o, p.Wt_o0, D, D, false, gtid, gsz);
  cvt_t(p.peer_w_q, p.Wt_q0, D, D, false, gtid, gsz);
  cvt_t(p.mla_w_o, p.Wt_o1, D, D, false, gtid, gsz);
  cvt_t(p.peer_w_q + (size_t)D * D, p.Wt_q1, D, D, false, gtid, gsz);
  cvt_t(p.mla_w_dq, p.Wt_cat, D, 384, false, gtid, gsz);
  cvt_t(p.mla_w_dkv, p.Wt_cat + (size_t)384 * D, D, 320, false, gtid, gsz);
  cvt_t(p.mla_w_uq, p.Wt_uq, 384, 1536, false, gtid, gsz);
  cvt_t(p.mla_w_ukv, p.Wt_ukv, 256, 2048, false, gtid, gsz);
  cvt_plain(p.peer_keys, p.Khi, (size_t)2 * 131072 / 8, false, gtid, gsz);
  cvt_plain(p.peer_keys, p.Klo, (size_t)2 * 131072 / 8, true, gtid, gsz);
  cvt_rows_i8(p.peer_u, p.U0, p.SU0, 16384, (int)(gtid >> 6), (int)(gsz >> 6));
  cvt_rows_i8(p.peer_v, p.V0, p.SV0, 16384, (int)(gtid >> 6), (int)(gsz >> 6));
  ph_s5_prep(p.s5_a_re, p.s5_a_im, p.s5_log_dt, p.s5_b_re, p.s5_b_im, p.s5_c_re, p.s5_c_im, p.Ktab, p.Bst_t, p.Cin_t, bid >> 2, bid & 3, lds);
  __syncthreads();
  if (bid < 192) mod_item(p.c, p.c_ctx, p.ada_w, p.ada_b, p.MOD, bid, lds);
  grid.sync();
  asm volatile("" : "+s"(bid));
  ph_s5_p1(p.x, p.ctx, mod0, p.Ktab, p.Bst_t, p.Ypart, p.Ssta, bid, lds);
  gbar(p.BAR, 1u * (unsigned)nblk);
  asm volatile("" : "+s"(bid));
  if (otid() < 64) ph_s5_carry(p.Ssta, p.s5_a_re, p.s5_a_im, p.s5_log_dt, p.HP, bid, otid());
  gbar(p.BAR, 2u * (unsigned)nblk);
  asm volatile("" : "+s"(bid));
  ph_s5_p3(p.x, p.ctx, mod0, p.s5_d, p.HP, p.Cin_t, p.Ypart, p.Gbf, bid, lds);
  gbar(p.BAR, 3u * (unsigned)nblk);
  asm volatile("" : "+s"(bid));
  {
    ChainP cp{p.Gbf, p.Wt_glu, p.Wt_o0, p.Wt_q0, p.Vbf, p.OQ, p.x, p.ctx, mod0, p.ln_g, p.ln_b, p.H1, p.Tbf, p.OQ, p.Wt_q0lo, p.Tlo};
    ph_chainA<true>(cp, bid, lds);
    __syncthreads();
    ph_route(RouteP{p.OQ, p.Khi, p.Klo, p.IDX, p.GATE, 66, 0}, bid, lds);
    __syncthreads();
    GatherP gp{p.Tbf, p.IDX, p.GATE, p.U0, p.V0, p.SU0, p.SV0, p.H1, mod0, p.ln_g + D, p.ln_b + D, p.H2, mod1};
    ph_gather_tm<false>(gp, bid * 66, 66, lds, p.PART + (size_t)bid * 8 * PARTW);
    __syncthreads();
    ProjP pp{p.Wt_cat, p.Wt_uq, p.Wt_ukv, p.mla_q_norm, p.mla_kv_norm, p.OQ  , p.Qa, p.Kn, p.Kr, p.Va};
    ph_mla_proj(pp, bid, lds);
  }
  gbar(p.BAR, 4u * (unsigned)nblk);
  asm volatile("" : "+s"(bid));
  {
    const int wg5 = bid * 8 + (otid() >> 6);
    cvt_rows_i8(p.peer_u + TD, p.U1, p.SU1, 16384, wg5, nblk * 8);
    cvt_rows_i8(p.peer_v + TD, p.V1, p.SV1, 16384, wg5, nblk * 8);
  }
  ph_attn(p.Qa, p.Kn, p.Kr, p.Va, p.AObf, bid, nblk, lds);
  gbar(p.BAR, 5u * (unsigned)nblk);
  asm volatile("" : "+s"(bid));
  {
    ChainP cp{p.AObf, nullptr, p.Wt_o1, p.Wt_q1, nullptr, p.OQ, p.H2, p.H2 + (size_t)NL * D, mod1, p.ln_g + 2 * D, p.ln_b + 2 * D, p.H3, p.Tbf1, p.OQ, p.Wt_q1lo, p.Tlo1};
    ph_chainA<false>(cp, bid, lds);
    __syncthreads();
    ph_route(RouteP{p.OQ, p.Khi1, p.Klo1, p.IDX, p.GATE, 64, 0}, bid, lds);
    __syncthreads();
    GatherP gp{p.Tbf1, p.IDX, p.GATE, p.U1, p.V1, p.SU1, p.SV1, p.H3, mod1, p.ln_g + 3 * D, p.ln_b + 3 * D, p.out, mod1};
    ph_gather_tm<true>(gp, bid * 64, 64, lds, p.PART + (size_t)bid * 8 * PARTW);
  }
}

extern "C" void kernel_launch(void* const* d_in, const int* in_sizes, int n_in, void* d_out, int out_size, void* d_ws, size_t ws_size, hipStream_t stream) {
  MP p{};
  const float** in = (const float**)&p;
  for (int i = 0; i < 29; ++i) in[i] = (const float*)d_in[i];
  p.out = (float*)d_out;
  char* ws = (char*)d_ws; size_t off = 0;
  auto carve = [&](size_t bytes) { char* q = ws + off; off += (bytes + 255) / 256 * 256; return q; };
  const size_t TDB = (size_t)1024 * 16384 * 2, BIG = (size_t)NT * D * 4, HALF = (size_t)NT * D * 2;
  p.MOD = (float*)carve(2 * 3 * 6144 * 4);
  p.Wt_glu = (bf16_t*)carve((size_t)D * D * 2); p.Wt_o0 = (bf16_t*)carve((size_t)D * D * 2); p.Wt_q0 = (bf16_t*)carve((size_t)D * D * 2); p.Wt_q0lo = (bf16_t*)carve((size_t)D * D * 2);
  p.Wt_o1 = (bf16_t*)carve((size_t)D * D * 2); p.Wt_q1 = (bf16_t*)carve((size_t)D * D * 2); p.Wt_q1lo = (bf16_t*)carve((size_t)D * D * 2);
  p.Wt_cat = (bf16_t*)carve((size_t)704 * D * 2); p.Wt_uq = (bf16_t*)carve((size_t)1536 * 384 * 2); p.Wt_ukv = (bf16_t*)carve((size_t)2048 * 256 * 2);
  p.Khi = (bf16_t*)carve((size_t)2 * 131072 * 2); p.Klo = (bf16_t*)carve((size_t)2 * 131072 * 2); p.Khi1 = p.Khi + 131072; p.Klo1 = p.Klo + 131072;
  char* T0 = carve(TDB); p.U0 = (unsigned char*)T0; p.V0 = (unsigned char*)(T0 + TDB / 2); p.AObf = (bf16_t*)T0;
  p.SU0 = (float*)carve(16384 * 4); p.SV0 = (float*)carve(16384 * 4); p.SU1 = (float*)carve(16384 * 4); p.SV1 = (float*)carve(16384 * 4);
  const size_t KTAB_B = (size_t)64 * 127 * 256 * 2, BST_B = (size_t)64 * 256 * 1024 * 2, KN_B = (size_t)NB * 8 * KEYS * 128 * 2, KR_B = (size_t)NB * KEYS * 64 * 2;
  size_t x1 = KTAB_B + 2 * BST_B; if (x1 < 2 * KN_B + KR_B) x1 = 2 * KN_B + KR_B;
  char* X1 = carve(x1);
  p.Ktab = (bf16_t*)X1; p.Bst_t = (bf16_t*)(X1 + KTAB_B); p.Cin_t = (bf16_t*)(X1 + KTAB_B + BST_B);
  p.Kn = (bf16_t*)X1; p.Va = (bf16_t*)(X1 + KN_B); p.Kr = (bf16_t*)(X1 + 2 * KN_B); p.H3 = (float*)X1;
  char* X2 = carve(BIG); p.Ypart = (float*)X2; p.OQ = (float*)X2;
  char* X3 = carve(HALF); p.Ssta = (float*)X3; p.HP = (bf16_t*)(X3 + (size_t)NCC * 64 * 256 * 4); p.Vbf = (bf16_t*)X3; p.Tlo = (bf16_t*)X3; p.Tlo1 = (bf16_t*)X3;
  char* X4 = carve(HALF); p.Gbf = (bf16_t*)X4; p.Tbf = (bf16_t*)X4; p.Tbf1 = (bf16_t*)X4;
  char* X5 = carve(BIG); p.H1 = (float*)X5;
  char* T1 = carve(TDB); p.U1 = (unsigned char*)T1; p.V1 = (unsigned char*)(T1 + TDB / 2);
  p.H2 = (float*)carve(BIG);
  p.IDX = (int*)carve((size_t)NT * 128 * 4); p.GATE = (float*)carve((size_t)NT * 128 * 4);
  p.Qa = (bf16_t*)carve((size_t)NB * 8 * SEQ * 192 * 2);
  p.BAR = (unsigned*)carve(256);
  p.PART = (float*)carve((size_t)256 * 8 * PARTW * 4);
  p.ENT = nullptr; p.GATF = nullptr;
  if (off > ws_size || n_in != 29) { fprintf(stderr, "kernel_launch: workspace too small (need %zu, have %zu) or n_in %d != 29\n", off, ws_size, n_in); return; }
  static int grid_blocks = 0;
  if (!grid_blocks) {
    int dev = 0, cus = 0, per_cu = 0;
    hipGetDevice(&dev);
    hipDeviceGetAttribute(&cus, hipDeviceAttributeMultiprocessorCount, dev);
    hipOccupancyMaxActiveBlocksPerMultiprocessor(&per_cu, mega, 512, 0);
    if (per_cu < 1 || cus < 256) { fprintf(stderr, "kernel_launch: need 256 resident workgroups (cus %d, per_cu %d)\n", cus, per_cu); return; }
    grid_blocks = 256;
  }
  hipMemsetAsync(p.BAR, 0, 256, stream);
  void* args[] = {&p};
  hipError_t e = hipLaunchCooperativeKernel((void*)mega, dim3(grid_blocks), dim3(512), args, 0, stream);
  if (e != hipSuccess) fprintf(stderr, "cooperative launch failed: %s\n", hipGetErrorString(e));
}
```

```cpp
#include <hip/hip_runtime.h>
#include <math.h>
#include <hip/hip_cooperative_groups.h>
#include <cstdio>
namespace cg = cooperative_groups;
__device__ __forceinline__ int otid() { int t = (int)__builtin_amdgcn_workitem_id_x(); asm volatile("" : "+v"(t)); return t; }

constexpr int D = 1024, NB = 2, SEQ = 8192, CTX = 256;
constexpr int NL = NB * SEQ, NC = NB * CTX, NT = NL + NC;
constexpr float ALPHA = 1.4142135623730951f;
constexpr float LN_EPS = 1e-5f, RMS_EPS = 1e-6f;

__device__ __forceinline__ float wave_sum(float v) {
#pragma unroll
  for (int o = 32; o >= 1; o >>= 1) v += __shfl_xor(v, o);
  return v;
}
__device__ __forceinline__ int row_vec(int row) { return row < NL ? (row >> 13) : 2; }
__device__ __forceinline__ float gelu_exact(float x) { return 0.5f * x * (1.f + erff(x * 0.70710678118654752f)); }


typedef unsigned short bf16_t;
using bf16x8 = __attribute__((ext_vector_type(8))) short;
using f32x4 = __attribute__((ext_vector_type(4))) float;
__device__ __forceinline__ bf16_t f2bf(float f) { unsigned u = __float_as_uint(f); u += 0x7FFFu + ((u >> 16) & 1u); return (bf16_t)(u >> 16); }
__device__ __forceinline__ float bf2f(bf16_t h) { return __uint_as_float(((unsigned)h) << 16); }
__device__ __forceinline__ unsigned pack2bf(float lo, float hi) { return (unsigned)f2bf(lo) | ((unsigned)f2bf(hi) << 16); }
__device__ __forceinline__ float bflo(unsigned w) { return __uint_as_float(w << 16); }
__device__ __forceinline__ float bfhi(unsigned w) { return __uint_as_float(w & 0xFFFF0000u); }


constexpr int LDA_B = 1024 * 2 + 16;
template <int RT, int K>
__device__ __forceinline__ void gemm_unit(const char* const (&ap)[RT], const bf16_t* __restrict__ w0, const bf16_t* __restrict__ w1, int kmul, f32x4 (&acc)[RT][2]) {
  constexpr int KI = K / 128, NS = 2;
#pragma unroll
  for (int t = 0; t < RT; ++t) { acc[t][0] = f32x4{0.f, 0.f, 0.f, 0.f}; acc[t][1] = f32x4{0.f, 0.f, 0.f, 0.f}; }
  bf16x8 b[NS][4][2];
#pragma unroll
  for (int st = 0; st < NS - 1; ++st) {
    if (st < KI) {
#pragma unroll
      for (int s2 = 0; s2 < 4; ++s2) { b[st][s2][0] = *(const bf16x8*)(w0 + (st * 128 + s2 * 32) * kmul); b[st][s2][1] = *(const bf16x8*)(w1 + (st * 128 + s2 * 32) * kmul); }
    }
  }
  asm volatile("" ::: "memory");
  bf16x8 an[RT];
#pragma unroll
  for (int t = 0; t < RT; ++t) an[t] = *(const bf16x8*)(ap[t]);
#pragma unroll
  for (int it = 0; it < KI; ++it) {
    if (it + NS - 1 < KI) {
#pragma unroll
      for (int s2 = 0; s2 < 4; ++s2) {
        b[(it + NS - 1) % NS][s2][0] = *(const bf16x8*)(w0 + ((it + NS - 1) * 128 + s2 * 32) * kmul);
        b[(it + NS - 1) % NS][s2][1] = *(const bf16x8*)(w1 + ((it + NS - 1) * 128 + s2 * 32) * kmul);
      }
    }
    asm volatile("" ::: "memory");
#pragma unroll
    for (int s2 = 0; s2 < 4; ++s2) {
      bf16x8 ac[RT];
#pragma unroll
      for (int t = 0; t < RT; ++t) ac[t] = an[t];
      if (it * 4 + s2 + 1 < KI * 4) {
#pragma unroll
        for (int t = 0; t < RT; ++t) an[t] = *(const bf16x8*)(ap[t] + (it * 128 + s2 * 32 + 32) * 2);
      }
#pragma unroll
      for (int t = 0; t < RT; ++t) {
        acc[t][0] = __builtin_amdgcn_mfma_f32_16x16x32_bf16(ac[t], b[it % NS][s2][0], acc[t][0], 0, 0, 0);
        acc[t][1] = __builtin_amdgcn_mfma_f32_16x16x32_bf16(ac[t], b[it % NS][s2][1], acc[t][1], 0, 0, 0);
      }
    }
  }
}
template <int RT, int K, class Epi>
__device__ __forceinline__ void gemm_ldsA(const char* As, int lda_b, int nrows, const bf16_t* __restrict__ Wt, int N, Epi epi) {
  const int wave = otid() >> 6, lane = otid() & 63, l15 = lane & 15, q = lane >> 4;
  const char* ap[RT];
#pragma unroll
  for (int t = 0; t < RT; ++t) { int r = t * 16 + l15; r = r < nrows ? r : nrows - 1; ap[t] = As + r * lda_b + q * 16; }
#pragma unroll 1
  for (int unit = wave; unit < (N >> 5); unit += 8) {
    const int n0 = unit * 32;
    const bf16_t* w0 = Wt + (size_t)(n0 >> 4) * K * 16 + lane * 8;
    f32x4 acc[RT][2];
    gemm_unit<RT, K>(ap, w0, w0 + (size_t)K * 16, 16, acc);
#pragma unroll
    for (int t = 0; t < RT; ++t)
#pragma unroll
      for (int j = 0; j < 2; ++j)
#pragma unroll
        for (int r = 0; r < 4; ++r) {
          const int row = t * 16 + q * 4 + r, col = n0 + j * 16 + l15;
          if (row < nrows) epi(row, col, acc[t][j][r]);
        }
  }
}
struct EpiF32 { float* C; int ldc; __device__ __forceinline__ void operator()(int row, int col, float v) const { C[(size_t)row * ldc + col] = v; } };
struct EpiGluL { const char* As; bf16_t* V; __device__ __forceinline__ void operator()(int row, int col, float z) const {
  const float g = bf2f(*(const bf16_t*)(As + row * LDA_B + col * 2)); V[(size_t)row * D + col] = f2bf(g / (1.f + expf(-z))); } };

__device__ __forceinline__ void load_rows_lds(char* As, const bf16_t* __restrict__ src, int nrows) {
  const int t = otid(), total = nrows * 128;
#pragma unroll
  for (int h = 0; h < 2; ++h) {
    uint4 v[9];
#pragma unroll
    for (int k = 0; k < 9; ++k) { int i = t + (h * 9 + k) * 512; i = i < total ? i : total - 1; v[k] = *(const uint4*)(src + (size_t)(i >> 7) * D + (i & 127) * 8); }
#pragma unroll
    for (int k = 0; k < 9; ++k) { const int i = t + (h * 9 + k) * 512; if (i < total) *(uint4*)(As + (i >> 7) * LDA_B + (i & 127) * 16) = v[k]; }
  }
}
__device__ __forceinline__ void ln_rows(char* As, int g0, int nrows, const float* Hl, const float* Hc, const float* __restrict__ O,
                                        const float* __restrict__ mod, int gate_i, const float* __restrict__ lng, const float* __restrict__ lnb,
                                        float* Hout, bf16_t* __restrict__ Tbf, int shift_i, int scale_i) {
  const int wave = otid() >> 6, lane = otid() & 63;
  for (int rr = wave; rr < nrows; rr += 8) {
    const int row = g0 + rr;
    const float* hin = row < NL ? Hl + (size_t)row * D : Hc + (size_t)(row - NL) * D;
    const float* f = O + (size_t)row * D;
    const float* m = mod + row_vec(row) * 6144;
    const float* gm = m + gate_i * 1024;
    float r[16]; float s = 0.f;
#pragma unroll
    for (int i = 0; i < 4; ++i) {
      const int d = i * 256 + lane * 4;
      float4 h4 = *(const float4*)(hin + d), f4 = *(const float4*)(f + d), g4 = *(const float4*)(gm + d);
      r[i * 4 + 0] = ALPHA * h4.x + g4.x * f4.x; r[i * 4 + 1] = ALPHA * h4.y + g4.y * f4.y;
      r[i * 4 + 2] = ALPHA * h4.z + g4.z * f4.z; r[i * 4 + 3] = ALPHA * h4.w + g4.w * f4.w;
      s += r[i * 4 + 0] + r[i * 4 + 1] + r[i * 4 + 2] + r[i * 4 + 3];
    }
    const float mu = wave_sum(s) * (1.f / D);
    float vs = 0.f;
#pragma unroll
    for (int i = 0; i < 16; ++i) { float dlt = r[i] - mu; vs += dlt * dlt; }
    const float rstd = rsqrtf(wave_sum(vs) * (1.f / D) + LN_EPS);
#pragma unroll
    for (int i = 0; i < 4; ++i) {
      const int d = i * 256 + lane * 4;
      float4 g4 = *(const float4*)(lng + d), b4 = *(const float4*)(lnb + d);
      float4 o;
      o.x = (r[i * 4 + 0] - mu) * rstd * g4.x + b4.x; o.y = (r[i * 4 + 1] - mu) * rstd * g4.y + b4.y;
      o.z = (r[i * 4 + 2] - mu) * rstd * g4.z + b4.z; o.w = (r[i * 4 + 3] - mu) * rstd * g4.w + b4.w;
      *(float4*)(Hout + (size_t)row * D + d) = o;
      float4 sh = *(const float4*)(m + shift_i * 1024 + d), sc = *(const float4*)(m + scale_i * 1024 + d);
      const float t0 = o.x * (1.f + sc.x) + sh.x, t1 = o.y * (1.f + sc.y) + sh.y, t2 = o.z * (1.f + sc.z) + sh.z, t3 = o.w * (1.f + sc.w) + sh.w;
      uint2 w; w.x = pack2bf(t0, t1); w.y = pack2bf(t2, t3);
      *(uint2*)(As + rr * LDA_B + d * 2) = w;
      *(uint2*)(Tbf + (size_t)row * D + d) = w;

    }
  }
}


constexpr int S5T = 64, NCHUNK = (CTX + SEQ) / S5T  , NCC = NB * NCHUNK  ;
__device__ __forceinline__ int s5_token(int cc, int s) {
  const int b = cc / NCHUNK, ch = cc - b * NCHUNK;
  return ch < 4 ? NL + b * CTX + ch * S5T + s : b * SEQ + (ch - 4) * S5T + s;
}
__device__ __forceinline__ void cbar(volatile int* cnt, int& gen, int nwaves) {
  __builtin_amdgcn_fence(__ATOMIC_RELEASE, "workgroup");
  if ((otid() & 63) == 0) __hip_atomic_fetch_add((int*)cnt, 1, __ATOMIC_RELAXED, __HIP_MEMORY_SCOPE_WORKGROUP);
  ++gen;
  while (__hip_atomic_load((int*)cnt, __ATOMIC_RELAXED, __HIP_MEMORY_SCOPE_WORKGROUP) < gen * nwaves) __builtin_amdgcn_s_sleep(1);
  __builtin_amdgcn_fence(__ATOMIC_ACQUIRE, "workgroup");
}
__device__ __forceinline__ void ph_s5_prep(const float* __restrict__ a_re, const float* __restrict__ a_im, const float* __restrict__ log_dt,
                                                 const float* __restrict__ b_re, const float* __restrict__ b_im, const float* __restrict__ c_re, const float* __restrict__ c_im,
                                                 bf16_t* __restrict__ Ktab, bf16_t* __restrict__ Bst_t, bf16_t* __restrict__ Cin_t, int g, int part, char* lds, int tid, int nct, volatile int* cbc, int& cgen) {
  float2 (*pw)[65][64] = reinterpret_cast<float2 (*)[65][64]>(lds);
  float2 (*Bp)[64][16] = reinterpret_cast<float2 (*)[64][16]>(lds + 2 * 65 * 64 * 8);
  float2 (*Cc)[16][64] = reinterpret_cast<float2 (*)[16][64]>(lds + 2 * 65 * 64 * 8 + 2 * 64 * 16 * 8);
  if (tid < 128) {
    const int dir = tid >> 6, p = tid & 63, gp = (dir * 64 + g) * 64 + p;
    const float are = a_re[gp], aim = a_im[gp], dt = expf(log_dt[dir * 64 + g]);
    const float mag = expf(are * dt);
    const float abr = mag * cosf(aim * dt), abi = mag * sinf(aim * dt);
    const float nr = abr - 1.f, ni = abi, den = are * are + aim * aim;
    const float fr = (nr * are + ni * aim) / den, fi = (ni * are - nr * aim) / den;
    float pr = 1.f, pi = 0.f;
    for (int e = 0; e <= 64; ++e) { pw[dir][e][p] = make_float2(pr, pi); const float nr2 = pr * abr - pi * abi, ni2 = pr * abi + pi * abr; pr = nr2; pi = ni2; }
    for (int ci = 0; ci < 16; ++ci) { const float br = b_re[gp * 16 + ci], bi = b_im[gp * 16 + ci]; Bp[dir][p][ci] = make_float2(fr * br - fi * bi, fr * bi + fi * br); }
    for (int co = 0; co < 16; ++co) { const int idx = ((dir * 64 + g) * 16 + co) * 64 + p; Cc[dir][co][p] = make_float2(c_re[idx], c_im[idx]); }
  }
  cbar(cbc, cgen, nct >> 6);
  for (int i = part * 8128 + tid; i < (part + 1) * 8128; i += nct) {
    const int ti = i >> 8, co = (i >> 4) & 15, ci = i & 15, tau = ti - 63;
    float acc = 0.f;
    if (tau >= 0) { for (int p = 0; p < 64; ++p) { const float2 c = Cc[0][co][p], w = pw[0][tau][p], b = Bp[0][p][ci];
        const float xr = c.x * w.x - c.y * w.y, xi = c.x * w.y + c.y * w.x; acc += xr * b.x - xi * b.y; } }
    if (tau <= 0) { for (int p = 0; p < 64; ++p) { const float2 c = Cc[1][co][p], w = pw[1][-tau][p], b = Bp[1][p][ci];
        const float xr = c.x * w.x - c.y * w.y, xi = c.x * w.y + c.y * w.x; acc += xr * b.x - xi * b.y; } }
    Ktab[(size_t)g * 127 * 256 + i] = f2bf(acc);
  }
  for (int i = part * 8192 + tid; i < (part + 1) * 8192; i += nct) {
    const int n = i >> 7, k8 = i & 127, dir = n >> 7, c = (n >> 6) & 1, p = n & 63, sidx = k8 >> 1, ci0 = (k8 & 1) * 8;
    const float2 w = pw[dir][dir == 0 ? 63 - sidx : sidx][p];
    float v[8];
#pragma unroll
    for (int j = 0; j < 8; ++j) { const float2 b = Bp[dir][p][ci0 + j]; v[j] = c == 0 ? (w.x * b.x - w.y * b.y) : (w.x * b.y + w.y * b.x); }
    uint4 o; o.x = pack2bf(v[0], v[1]); o.y = pack2bf(v[2], v[3]); o.z = pack2bf(v[4], v[5]); o.w = pack2bf(v[6], v[7]);
    *(uint4*)(Bst_t + (size_t)g * 256 * 1024 + ((size_t)((n >> 4) * 32 + (k8 >> 2)) * 64 + (k8 & 3) * 16 + (n & 15)) * 8) = o;
  }
  for (int i = part * 8192 + tid; i < (part + 1) * 8192; i += nct) {
    const int n = i >> 5, k8 = i & 31, t = n >> 4, co = n & 15, dir = k8 >> 4, c = (k8 >> 3) & 1, p0 = (k8 & 7) * 8;
    const int e = dir == 0 ? t + 1 : 64 - t;
    float v[8];
#pragma unroll
    for (int j = 0; j < 8; ++j) { const float2 cc = Cc[dir][co][p0 + j], w = pw[dir][e][p0 + j];
      v[j] = c == 0 ? (cc.x * w.x - cc.y * w.y) : -(cc.x * w.y + cc.y * w.x); }
    uint4 o; o.x = pack2bf(v[0], v[1]); o.y = pack2bf(v[2], v[3]); o.z = pack2bf(v[4], v[5]); o.w = pack2bf(v[6], v[7]);
    *(uint4*)(Cin_t + (size_t)g * 1024 * 256 + ((size_t)((n >> 4) * 8 + (k8 >> 2)) * 64 + (k8 & 3) * 16 + (n & 15)) * 8) = o;
  }
}
__device__ __forceinline__ void ph_s5_p1(const float* __restrict__ x, const float* __restrict__ ctx, const float* __restrict__ mod,
                                               const bf16_t* __restrict__ Ktab, const bf16_t* __restrict__ Bst_t, float* __restrict__ Ypart, float* __restrict__ S, int bid, char* As) {
  const int g = bid >> 2, cc0 = (bid & 3) * 66, tid = otid();
  const int wave = tid >> 6, lane = tid & 63, l15 = lane & 15, q = lane >> 4;
#pragma unroll 4
  for (int i = tid; i < 66 * 64 * 2; i += 512) {
    const int half = i & 1, sidx = (i >> 1) & 63, r = i >> 7;
    const int tok = s5_token(cc0 + r, sidx), ch = g * 16 + half * 8;
    const float* src = (tok < NL ? x + (size_t)tok * D : ctx + (size_t)(tok - NL) * D) + ch;
    const float* m = mod + row_vec(tok) * 6144;
    const float4 a = *(const float4*)src, b = *(const float4*)(src + 4);
    const float4 sh0 = *(const float4*)(m + ch), sh1 = *(const float4*)(m + ch + 4), sc0 = *(const float4*)(m + 1024 + ch), sc1 = *(const float4*)(m + 1024 + ch + 4);
    uint4 o;
    o.x = pack2bf(a.x * (1.f + sc0.x) + sh0.x, a.y * (1.f + sc0.y) + sh0.y); o.y = pack2bf(a.z * (1.f + sc0.z) + sh0.z, a.w * (1.f + sc0.w) + sh0.w);
    o.z = pack2bf(b.x * (1.f + sc1.x) + sh1.x, b.y * (1.f + sc1.y) + sh1.y); o.w = pack2bf(b.z * (1.f + sc1.z) + sh1.z, b.w * (1.f + sc1.w) + sh1.w);
    *(uint4*)(As + r * LDA_B + sidx * 32 + half * 16) = o;
  }
  __syncthreads();
  const char* ap[5];
#pragma unroll
  for (int t = 0; t < 5; ++t) { int r = t * 16 + l15; r = r < 66 ? r : 65; ap[t] = As + r * LDA_B + q * 16; }
  const bf16_t* Kg = Ktab + (size_t)g * 127 * 256;
#pragma unroll 1
  for (int unit = wave; unit < 40; unit += 8) {
    f32x4 acc[5][2];
    if (unit < 32) {
      const int t0 = unit * 2;
      const bf16_t* w0 = Kg + (t0 + 63 - (q >> 1)) * 256 + l15 * 16 + (q & 1) * 8;
      gemm_unit<5, 1024>(ap, w0, w0 + 256, -16, acc);
#pragma unroll
      for (int t = 0; t < 5; ++t)
#pragma unroll
        for (int j = 0; j < 2; ++j)
#pragma unroll
          for (int r = 0; r < 4; ++r) {
            const int row = t * 16 + q * 4 + r;
            if (row < 66) Ypart[(size_t)s5_token(cc0 + row, t0 + j) * D + g * 16 + l15] = acc[t][j][r];
          }
    } else {
      const int n0 = (unit - 32) * 32;
      const bf16_t* w0 = Bst_t + (size_t)g * 256 * 1024 + (size_t)(n0 >> 4) * 1024 * 16 + lane * 8;
      gemm_unit<5, 1024>(ap, w0, w0 + 1024 * 16, 16, acc);
#pragma unroll
      for (int t = 0; t < 5; ++t)
#pragma unroll
        for (int j = 0; j < 2; ++j)
#pragma unroll
          for (int r = 0; r < 4; ++r) {
            const int row = t * 16 + q * 4 + r;
            if (row < 66) S[((size_t)(cc0 + row) * 64 + g) * 256 + n0 + j * 16 + l15] = acc[t][j][r];
          }
    }
  }
}
__device__ __forceinline__ void ph_s5_carry(const float* __restrict__ S, const float* __restrict__ a_re, const float* __restrict__ a_im,
                                                 const float* __restrict__ log_dt, bf16_t* __restrict__ HP, int id, int p) {
  const int dir = id & 1, g = (id >> 1) & 63, b = id >> 7;
  const int gp = (dir * 64 + g) * 64 + p;
  const float are = a_re[gp], aim = a_im[gp], dt = expf(log_dt[dir * 64 + g]);
  const float mag = expf(are * dt);
  float tr = mag * cosf(aim * dt), ti = mag * sinf(aim * dt);
#pragma unroll
  for (int i = 0; i < 6; ++i) { const float nr = tr * tr - ti * ti, ni = 2.f * tr * ti; tr = nr; ti = ni; }
  float hr = 0.f, hi = 0.f;
#pragma unroll 12
  for (int step = 0; step < NCHUNK; ++step) {
    const int c = dir == 0 ? step : (step < 4 ? 3 - step : NCHUNK - 1 - (step - 4));
    const size_t base = ((size_t)(b * NCHUNK + c) * 64 + g) * 256 + dir * 128 + p;
    HP[base] = f2bf(hr); HP[base + 64] = f2bf(hi);
    const float sr = S[base], si = S[base + 64];
    const float nr = tr * hr - ti * hi + sr, ni = tr * hi + ti * hr + si;
    hr = nr; hi = ni;
  }
}
struct EpiS5 { const float* x; const float* ctx; const float* mod; const float* dvec; const float* Ypart; bf16_t* Gbf; int cc0; int g;
  __device__ __forceinline__ void operator()(int row, int col, float v) const {
    const int tok = s5_token(cc0 + row, col >> 4), ch = g * 16 + (col & 15);
    const float* m = mod + row_vec(tok) * 6144;
    const float xin = tok < NL ? x[(size_t)tok * D + ch] : ctx[(size_t)(tok - NL) * D + ch];
    const float mm = xin * (1.f + m[1024 + ch]) + m[ch];
    const float y = v + Ypart[(size_t)tok * D + ch] + dvec[ch] * mm;
    Gbf[(size_t)tok * D + ch] = f2bf(gelu_exact(y));
  } };
__device__ __forceinline__ void ph_s5_p3(const float* __restrict__ x, const float* __restrict__ ctx, const float* __restrict__ mod, const float* __restrict__ dvec,
                                               const bf16_t* __restrict__ HP, const bf16_t* __restrict__ Cin_t, const float* __restrict__ Ypart, bf16_t* __restrict__ Gbf, int bid, char* As) {
  const int g = bid >> 2, cc0 = (bid & 3) * 66, tid = otid();
  for (int i = tid; i < 66 * 32; i += 512) {
    const int r = i >> 5, c = i & 31;
    *(uint4*)(As + r * 528 + c * 16) = *(const uint4*)(HP + ((size_t)(cc0 + r) * 64 + g) * 256 + c * 8);
  }
  __syncthreads();
  gemm_ldsA<5, 256>(As, 528, 66, Cin_t + (size_t)g * 1024 * 256, 1024, EpiS5{x, ctx, mod, dvec, Ypart, Gbf, cc0, g});
}


struct ChainP {
  const bf16_t* Ain;
  const bf16_t* Wglu_t; const bf16_t* Wo_t; const bf16_t* Wq_t;
  bf16_t* Vbf; float* O; const float* Hl; const float* Hc; const float* mod; const float* lng; const float* lnb;
  float* Hout; bf16_t* Tbf; float* Q;
};
template <bool L0>
__device__ __forceinline__ void ph_chainA(const ChainP& p, int bid, char* As) {
  constexpr int NR = L0 ? 66 : 64;
  constexpr int RT = L0 ? 5 : 4;
  const int g0 = bid * NR;
  load_rows_lds(As, p.Ain + (size_t)g0 * D, NR);
  __syncthreads();
  if (L0) {
    gemm_ldsA<RT, 1024>(As, LDA_B, NR, p.Wglu_t, D, EpiGluL{As, p.Vbf + (size_t)g0 * D});
    __syncthreads();
    load_rows_lds(As, p.Vbf + (size_t)g0 * D, NR);
    __syncthreads();
  }
  gemm_ldsA<RT, 1024>(As, LDA_B, NR, p.Wo_t, D, EpiF32{p.O + (size_t)g0 * D, D});
  __syncthreads();
  ln_rows(As, g0, NR, p.Hl, p.Hc, p.O, p.mod, 2, p.lng, p.lnb, p.Hout, p.Tbf, 3, 4);
  __syncthreads();
  gemm_ldsA<RT, 1024>(As, LDA_B, NR, p.Wq_t, D, EpiF32{p.Q + (size_t)g0 * D, D});
}


constexpr int KEYS = SEQ + CTX;
struct EpiKV { bf16_t* Kn; bf16_t* Va; int g0; int pad; __device__ __forceinline__ void operator()(int row, int col, float v) const {
  const int g = g0 + row; int b, key;
  if (g < NL) { b = g >> 13; key = g & (SEQ - 1); } else { const int cidx = g - NL; b = cidx >> 8; key = SEQ + (cidx & (CTX - 1)); }
  const int head = col >> 8, j = col & 255;
  if (j < 128) Kn[((size_t)(b * 8 + head) * KEYS + key) * 128 + j] = f2bf(v);
  else Va[((size_t)(b * 8 + head) * KEYS + key) * 128 + (j - 128)] = f2bf(v);
} };
struct EpiQ { bf16_t* Qa; int g0; int pad; __device__ __forceinline__ void operator()(int row, int col, float v) const {
  const int g = g0 + row, b = g >> 13, n = g & (SEQ - 1);
  const int head = col / 192, j = col - head * 192;
  Qa[((size_t)(b * 8 + head) * SEQ + n) * 192 + j] = f2bf(v);
} };
struct ProjP { const bf16_t* Wcat_t; const bf16_t* Wuq_t; const bf16_t* Wukv_t; const float* q_norm; const float* kv_norm;
               float* PR; bf16_t* Qa; bf16_t* Kn; bf16_t* Kr; bf16_t* Va; };
__device__ __forceinline__ void ph_mla_proj(const ProjP& p, int bid, char* As) {
  const int g0 = bid * 66, wave = otid() >> 6, lane = otid() & 63;
  gemm_ldsA<5, 1024>(As, LDA_B, 66, p.Wcat_t, 704, EpiF32{p.PR + (size_t)g0 * D, D});
  __syncthreads();
  char* A1 = As; char* A2 = As + 66 * 784;
  for (int rr = wave; rr < 66; rr += 8) {
    const int g = g0 + rr;
    const float* pr = p.PR + (size_t)g * D;
    float v[6]; float ss = 0.f;
#pragma unroll
    for (int i = 0; i < 6; ++i) { v[i] = pr[i * 64 + lane]; ss += v[i] * v[i]; }
    float rn = rsqrtf(wave_sum(ss) * (1.f / 384.f) + RMS_EPS);
#pragma unroll
    for (int i = 0; i < 6; ++i) *(bf16_t*)(A1 + rr * 784 + (i * 64 + lane) * 2) = f2bf(v[i] * rn * p.q_norm[i * 64 + lane]);
    float w[4]; ss = 0.f;
#pragma unroll
    for (int i = 0; i < 4; ++i) { w[i] = pr[384 + i * 64 + lane]; ss += w[i] * w[i]; }
    rn = rsqrtf(wave_sum(ss) * (1.f / 256.f) + RMS_EPS);
#pragma unroll
    for (int i = 0; i < 4; ++i) *(bf16_t*)(A2 + rr * 528 + (i * 64 + lane) * 2) = f2bf(w[i] * rn * p.kv_norm[i * 64 + lane]);
    if (lane < 32) {
      float x1 = pr[640 + lane], x2 = pr[672 + lane];
      int b, key;
      if (g < NL) {
        b = g >> 13; key = g & (SEQ - 1);
        const int n = key, rr2 = n >> 6, cc = n & 63;
        const float inv = powf(10000.f, -(float)(lane & 15) / 16.f);
        const float ang = (lane < 16 ? (float)rr2 : (float)cc) * inv;
        const float cs = cosf(ang), sn = sinf(ang);
        const float y1 = x1 * cs - x2 * sn, y2 = x2 * cs + x1 * sn; x1 = y1; x2 = y2;
      } else { const int cidx = g - NL; b = cidx >> 8; key = SEQ + (cidx & (CTX - 1)); }
      bf16_t* kp = p.Kr + ((size_t)b * KEYS + key) * 64;
      kp[lane] = f2bf(x1); kp[32 + lane] = f2bf(x2);
    }
  }
  __syncthreads();
  int nq = NL - g0; nq = nq > 66 ? 66 : nq;
  if (nq > 0) gemm_ldsA<5, 384>(A1, 784, nq, p.Wuq_t, 1536, EpiQ{p.Qa, g0, 0});
  gemm_ldsA<5, 256>(A2, 528, 66, p.Wukv_t, 2048, EpiKV{p.Kn, p.Va, g0, 0});
  __syncthreads();
  for (int rr = wave; rr < nq; rr += 8) {
    const int g = g0 + rr, b = g >> 13, n = g & (SEQ - 1);
    if (lane < 32) {
      const float inv = powf(10000.f, -(float)(lane & 15) / 16.f);
      const float ang = (lane < 16 ? (float)(n >> 6) : (float)(n & 63)) * inv;
      const float cs = cosf(ang), sn = sinf(ang);
#pragma unroll
      for (int h = 0; h < 8; ++h) {
        bf16_t* qo = p.Qa + ((size_t)(b * 8 + h) * SEQ + n) * 192;
        const float x1 = bf2f(qo[128 + lane]), x2 = bf2f(qo[160 + lane]);
        qo[128 + lane] = f2bf(x1 * cs - x2 * sn); qo[160 + lane] = f2bf(x2 * cs + x1 * sn);
      }
    }
  }
}

namespace att {
using s16x4 = __attribute__((ext_vector_type(4))) short;
using f32x16 = __attribute__((ext_vector_type(16))) float;
using u32x4 = __attribute__((ext_vector_type(4))) unsigned;
constexpr int KVBLK = 64, KROW = 400;
constexpr float SCALE = 0.07216878364870322f;
constexpr float THR = 8.f;
constexpr int SHM_V = KVBLK * 128 * 2, SHM_K = KVBLK * KROW, QRROW = 272, SHM_QR = 256 * QRROW, SHM_ATTN = 2 * SHM_V + 2 * SHM_K + 8 * 64 * 4 + SHM_QR;
#define SBAR() __builtin_amdgcn_sched_barrier(0)
__device__ __forceinline__ int crow(int r, int hi) { return (r & 3) + 8 * (r >> 2) + 4 * hi; }
__device__ __forceinline__ unsigned cvtpk(float lo, float hi) { unsigned r; asm volatile("v_cvt_pk_bf16_f32 %0, %1, %2" : "=v"(r) : "v"(lo), "v"(hi)); return r; }
__device__ __forceinline__ void partialSM(f32x16& p0, f32x16& p1, float& m_reg, float& mn, float& alpha) {
  constexpr float C = SCALE * 1.4426950408889634f;
  float pmax = p0[0];
#pragma unroll
  for (int r = 1; r < 16; ++r) pmax = fmaxf(pmax, p0[r]);
#pragma unroll
  for (int r = 0; r < 16; ++r) pmax = fmaxf(pmax, p1[r]);
  { auto rr = __builtin_amdgcn_permlane32_swap(__float_as_uint(pmax), __float_as_uint(pmax), false, false);
    pmax = fmaxf(__uint_as_float(rr[0]), __uint_as_float(rr[1])); }
  if (__builtin_expect(__all(pmax - m_reg <= THR / SCALE), 1)) { mn = m_reg; alpha = 1.f; }
  else { mn = fmaxf(m_reg, pmax); alpha = __builtin_amdgcn_exp2f((m_reg - mn) * C); m_reg = mn; }
  const float mnC = -mn * C;
#pragma unroll
  for (int r = 0; r < 16; ++r) p0[r] = fmaf(p0[r], C, mnC);
#pragma unroll
  for (int r = 0; r < 16; ++r) p1[r] = fmaf(p1[r], C, mnC);
#pragma unroll
  for (int r = 0; r < 16; ++r) p0[r] = __builtin_amdgcn_exp2f(p0[r]);
}
__device__ __forceinline__ void finishSM(f32x16& p0, f32x16& p1, float alpha, float& l_reg, bf16x8& pa0, bf16x8& pa1, bf16x8& pa2, bf16x8& pa3) {
#pragma unroll
  for (int r = 0; r < 16; ++r) p1[r] = __builtin_amdgcn_exp2f(p1[r]);
  float ps = 0;
#pragma unroll
  for (int r = 0; r < 16; ++r) ps += p0[r];
#pragma unroll
  for (int r = 0; r < 16; ++r) ps += p1[r];
  { auto rr = __builtin_amdgcn_permlane32_swap(__float_as_uint(ps), __float_as_uint(ps), false, false);
    ps = __uint_as_float(rr[0]) + __uint_as_float(rr[1]); }
  l_reg = l_reg * alpha + ps;
#define PK4(P, BASE, OUT) do { unsigned a0 = cvtpk(P[BASE + 0], P[BASE + 1]), a1 = cvtpk(P[BASE + 2], P[BASE + 3]);   \
    unsigned b0 = cvtpk(P[BASE + 4], P[BASE + 5]), b1 = cvtpk(P[BASE + 6], P[BASE + 7]);                              \
    auto r0 = __builtin_amdgcn_permlane32_swap(a0, b0, false, false); auto r1 = __builtin_amdgcn_permlane32_swap(a1, b1, false, false); \
    u32x4 w = {r0[0], r1[0], r0[1], r1[1]}; OUT = *reinterpret_cast<bf16x8*>(&w); } while (0)
  PK4(p0, 0, pa0); PK4(p0, 8, pa1); PK4(p1, 0, pa2); PK4(p1, 8, pa3);
#undef PK4
}
__device__ __forceinline__ void qkt(f32x16& p0, f32x16& p1, const char* Ks, const bf16x8* qr, const char* qrl, int r32, int hi) {
  p0 = f32x16{}; p1 = f32x16{};
#pragma unroll
  for (int d0 = 0; d0 < 12; ++d0) { const int cb = (d0 * 16 + hi * 8) * 2;
    bf16x8 b0 = *reinterpret_cast<const bf16x8*>(Ks + r32 * KROW + cb);
    bf16x8 b1 = *reinterpret_cast<const bf16x8*>(Ks + (32 + r32) * KROW + cb);
    const bf16x8 qv = d0 < 4 ? qr[d0 < 4 ? d0 : 0] : *reinterpret_cast<const bf16x8*>(qrl + (d0 - 4) * 32);
    p0 = __builtin_amdgcn_mfma_f32_32x32x16_bf16(b0, qv, p0, 0, 0, 0);
    p1 = __builtin_amdgcn_mfma_f32_32x32x16_bf16(b1, qv, p1, 0, 0, 0); }
}
__device__ __forceinline__ int v_st(int k, int c) { const int kk = (k & ~0xC) | ((k & 4) << 1) | ((k & 8) >> 1); return ((kk >> 3) * 4 + (c >> 5)) * 512 + ((kk & 7) * 32 + (c & 31)) * 2; }
__device__ __forceinline__ int v_rd_base(int lane) { return ((lane & 3) << 3) | (((lane >> 2) & 3) << 6) | (((lane >> 4) & 1) << 5) | (((lane >> 5) & 1) << 8); }
constexpr int v_rd_off(int d0, int ks, int half) { return d0 * 512 + ks * 4096 + half * 2048; }
template <int OFF> __device__ __forceinline__ s16x4 tr_read(int vb) {
  s16x4 r; asm volatile("ds_read_b64_tr_b16 %0, %1 offset:%2" : "=&v"(r) : "v"(vb), "i"(OFF) : "memory"); return r;
}
template <int D0> __device__ __forceinline__ void pv_one(f32x16& od, int vb, bf16x8 pa0, bf16x8 pa1, bf16x8 pa2, bf16x8 pa3) {
  const s16x4 l0 = tr_read<v_rd_off(D0, 0, 0)>(vb), h0 = tr_read<v_rd_off(D0, 0, 1)>(vb), l1 = tr_read<v_rd_off(D0, 1, 0)>(vb), h1 = tr_read<v_rd_off(D0, 1, 1)>(vb);
  const s16x4 l2 = tr_read<v_rd_off(D0, 2, 0)>(vb), h2 = tr_read<v_rd_off(D0, 2, 1)>(vb), l3 = tr_read<v_rd_off(D0, 3, 0)>(vb), h3 = tr_read<v_rd_off(D0, 3, 1)>(vb);
  asm volatile("s_waitcnt lgkmcnt(0)" ::: "memory"); SBAR();
#define PK(L, H) (bf16x8){L[0], L[1], L[2], L[3], H[0], H[1], H[2], H[3]}
  od = __builtin_amdgcn_mfma_f32_32x32x16_bf16(pa0, PK(l0, h0), od, 0, 0, 0);
  od = __builtin_amdgcn_mfma_f32_32x32x16_bf16(pa1, PK(l1, h1), od, 0, 0, 0);
  od = __builtin_amdgcn_mfma_f32_32x32x16_bf16(pa2, PK(l2, h2), od, 0, 0, 0);
  od = __builtin_amdgcn_mfma_f32_32x32x16_bf16(pa3, PK(l3, h3), od, 0, 0, 0);
#undef PK
}
__device__ __forceinline__ void pv_d0(f32x16* o, int vb, bf16x8 pa0, bf16x8 pa1, bf16x8 pa2, bf16x8 pa3) {
  pv_one<0>(o[0], vb, pa0, pa1, pa2, pa3); pv_one<1>(o[1], vb, pa0, pa1, pa2, pa3); pv_one<2>(o[2], vb, pa0, pa1, pa2, pa3); pv_one<3>(o[3], vb, pa0, pa1, pa2, pa3);
}
__device__ __forceinline__ void attn_body(const bf16_t* __restrict__ Qb, const bf16_t* __restrict__ Kh, const bf16_t* __restrict__ Krb, const bf16_t* __restrict__ Vh,
                                          bf16_t* __restrict__ Ob, int nkeys, char* lds) {
  const int tid = otid(), wid = tid >> 6, lane = tid & 63, r32 = lane & 31, hi = lane >> 5;
  char* V_lds = lds; char* K_lds = lds + 2 * SHM_V;
  float* ws = (float*)(lds + 2 * SHM_V + 2 * SHM_K) + wid * 64; float* li_l = ws; float* al_l = ws + 32;
  float m_reg = -1e30f, l_reg = 0; f32x16 o[4] = {}; bf16x8 qr[4];
  const bf16_t* Qw = Qb + (size_t)(wid * 32 + r32) * 192 + hi * 8;
  char* qrl = lds + 2 * SHM_V + 2 * SHM_K + 8 * 64 * 4 + (wid * 32 + r32) * QRROW + hi * 16;
#pragma unroll
  for (int d0 = 0; d0 < 4; ++d0) qr[d0] = *reinterpret_cast<const bf16x8*>(Qw + d0 * 16);
#pragma unroll
  for (int d0 = 4; d0 < 12; ++d0) *reinterpret_cast<bf16x8*>(qrl + (d0 - 4) * 32) = *reinterpret_cast<const bf16x8*>(Qw + d0 * 16);
  const int sr = tid >> 4, sc = (tid & 15) * 8, vst0 = v_st(sr, sc), vst1 = v_st(32 + sr, sc);
  const int krw = tid >> 3, kch = tid & 7;
  const int vb0 = (int)(uintptr_t)V_lds + v_rd_base(lane);
  bf16x8 vs0, vs1, ks0, ks1, ks2;
#define SLOAD(k0) do { vs0 = *reinterpret_cast<const bf16x8*>(&Vh[(size_t)((k0) + sr) * 128 + sc]); vs1 = *reinterpret_cast<const bf16x8*>(&Vh[(size_t)((k0) + 32 + sr) * 128 + sc]); \
    const bf16_t* kp_ = &Kh[(size_t)((k0) + krw) * 128 + kch * 8]; \
    ks0 = *reinterpret_cast<const bf16x8*>(kp_); ks1 = *reinterpret_cast<const bf16x8*>(kp_ + 64); \
    ks2 = *reinterpret_cast<const bf16x8*>(&Krb[(size_t)((k0) + krw) * 64 + kch * 8]); } while (0)
#define SWRITE(b) do { *(bf16x8*)(V_lds + (b) * SHM_V + vst0) = vs0; *(bf16x8*)(V_lds + (b) * SHM_V + vst1) = vs1; \
    char* kl_ = K_lds + (b) * SHM_K + krw * KROW + kch * 16; \
    *(bf16x8*)(kl_) = ks0; *(bf16x8*)(kl_ + 128) = ks1; *(bf16x8*)(kl_ + 256) = ks2; } while (0)
#define SWAIT() asm volatile("s_waitcnt vmcnt(0)" ::: "memory")
#define RESC(a) do { if (__any((a) < 1.f)) { if (hi == 0) al_l[r32] = (a); asm volatile("s_waitcnt lgkmcnt(0)" ::: "memory"); \
    for (int d = 0; d < 4; ++d) for (int r = 0; r < 16; ++r) o[d][r] *= al_l[crow(r, hi)]; } } while (0)
  f32x16 pA0, pA1, pB0, pB1; float mnA, mnB, alA, alB; bf16x8 pa0, pa1, pa2, pa3; const int NTL = nkeys / KVBLK;
  SLOAD(0); SWAIT(); SWRITE(0); __syncthreads();
  qkt(pA0, pA1, K_lds, qr, qrl, r32, hi); partialSM(pA0, pA1, m_reg, mnA, alA);
  SLOAD(KVBLK);
  SWAIT(); SWRITE(1); __syncthreads();
  for (int j = 1; j + 1 < NTL; j += 2) {
    SBAR(); qkt(pB0, pB1, K_lds + SHM_K, qr, qrl, r32, hi);
    finishSM(pA0, pA1, alA, l_reg, pa0, pa1, pa2, pa3); SBAR();
    SLOAD((j + 1) * KVBLK); SBAR();
    pv_d0(o, vb0, pa0, pa1, pa2, pa3); partialSM(pB0, pB1, m_reg, mnB, alB);
    __syncthreads(); SWAIT(); SWRITE(0);
    RESC(alB); __syncthreads();
    SBAR(); qkt(pA0, pA1, K_lds, qr, qrl, r32, hi);
    finishSM(pB0, pB1, alB, l_reg, pa0, pa1, pa2, pa3); SBAR();
    SLOAD((j + 2) * KVBLK); SBAR();
    pv_d0(o, vb0 + SHM_V, pa0, pa1, pa2, pa3); partialSM(pA0, pA1, m_reg, mnA, alA);
    __syncthreads(); SWAIT(); SWRITE(1);
    RESC(alA); __syncthreads();
  }
  SBAR(); qkt(pB0, pB1, K_lds + SHM_K, qr, qrl, r32, hi);
  finishSM(pA0, pA1, alA, l_reg, pa0, pa1, pa2, pa3); SBAR();
  pv_d0(o, vb0, pa0, pa1, pa2, pa3); partialSM(pB0, pB1, m_reg, mnB, alB);
  __syncthreads(); RESC(alB);
  finishSM(pB0, pB1, alB, l_reg, pa0, pa1, pa2, pa3); SBAR();
  pv_d0(o, vb0 + SHM_V, pa0, pa1, pa2, pa3);
  if (hi == 0) li_l[r32] = l_reg; asm volatile("s_waitcnt lgkmcnt(0)" ::: "memory");
  float rli[16];
#pragma unroll
  for (int r = 0; r < 16; ++r) rli[r] = __builtin_amdgcn_rcpf(li_l[crow(r, hi)]);
  bf16_t* Ow = Ob + (size_t)(wid * 32) * D;
#pragma unroll
  for (int r = 0; r < 16; ++r) { const int orow = crow(r, hi);
#pragma unroll
    for (int d0 = 0; d0 < 4; ++d0) Ow[(size_t)orow * D + d0 * 32 + r32] = f2bf(o[d0][r] * rli[r]); }
  __syncthreads();
#undef SLOAD
#undef SWRITE
#undef SWAIT
#undef RESC
}
}

__device__ __forceinline__ void ph_attn(const bf16_t* __restrict__ Qa, const bf16_t* __restrict__ Kn, const bf16_t* __restrict__ Kr, const bf16_t* __restrict__ Va,
                                        bf16_t* __restrict__ AO, int bid, int nblk, char* lds) {
  for (int item = bid; item < 512; item += nblk) {
    const int b = item >> 8, h = item & 7, qb = (item >> 3) & 31;
    att::attn_body(Qa + ((size_t)(b * 8 + h) * SEQ + qb * 256) * 192, Kn + (size_t)(b * 8 + h) * KEYS * 128, Kr + (size_t)b * KEYS * 64,
                   Va + (size_t)(b * 8 + h) * KEYS * 128, AO + (size_t)(b * SEQ + qb * 256) * D + h * 128, KEYS, lds);
  }
}

namespace rt {
using f32x16 = __attribute__((ext_vector_type(16))) float;
__device__ __forceinline__ int sortable(float f) { const int b = __float_as_int(f); return b ^ ((b >> 31) & 0x7FFFFFFF); }
__device__ __forceinline__ float unsortable(int k) { return __int_as_float(k ^ ((k >> 31) & 0x7FFFFFFF)); }
__device__ __forceinline__ int imax(int a, int b) { return a > b ? a : b; }
__device__ __forceinline__ int imin(int a, int b) { return a < b ? a : b; }
template <int N> __device__ __forceinline__ void sort_desc(int (&v)[N]) {
#pragma unroll
  for (int k = 2; k <= N; k <<= 1) {
#pragma unroll
    for (int j = k >> 1; j > 0; j >>= 1) {
#pragma unroll
      for (int i = 0; i < N; ++i) {
        const int l = i ^ j;
        if (l > i) {
          const bool desc = ((i & k) == 0);
          const int a = v[i], b = v[l];
          v[i] = desc ? imax(a, b) : imin(a, b);
          v[l] = desc ? imin(a, b) : imax(a, b);
        }
      }
    }
  }
}
template <int N> __device__ __forceinline__ void merge_desc(int (&v)[N]) {
#pragma unroll
  for (int j = N >> 1; j > 0; j >>= 1) {
#pragma unroll
    for (int i = 0; i < N; ++i) {
      const int l = i ^ j;
      if (l > i) { const int a = v[i], b = v[l]; v[i] = imax(a, b); v[l] = imin(a, b); }
    }
  }
}
__device__ __forceinline__ void absorb16(int (&L)[16], int (&B)[16]) {
  sort_desc<16>(B);
#pragma unroll
  for (int i = 0; i < 16; ++i) L[i] = imax(L[i], B[15 - i]);
  merge_desc<16>(L);
}
__device__ __forceinline__ constexpr int npairs_row(int i) { return 16 / (i + 1); }
}

struct RouteP { const float* Q; const bf16_t* Khi; int* IDX; float* GATE; int rows_per_block; int pad; };
__device__ __forceinline__ void ph_route(const RouteP& p, int bid, char* lds) {
  using namespace rt;
  int (*svl)[64][33] = reinterpret_cast<int (*)[64][33]>(lds);
  const int wave = otid() >> 6, lane = otid() & 63, r32 = lane & 31, hi = lane >> 5, hi4 = hi * 4;
  int nrows = p.rows_per_block; asm volatile("" : "+s"(nrows));
  const int g0 = bid * nrows;
  const int h = wave;
#pragma unroll 1
  for (int tg = 0; tg * 32 < nrows; ++tg) {
    int trow = tg * 32 + r32; const bool valid = trow < nrows; trow = valid ? trow : nrows - 1;
    const float* qrow = p.Q + (size_t)(g0 + trow) * D;
    int sv[2][16];
#pragma unroll
    for (int s = 0; s < 2; ++s) {
      const int hs = h * 2 + s;
      f32x16 acc[4];
#pragma unroll
      for (int m = 0; m < 4; ++m) acc[m] = f32x16{};
#pragma unroll
      for (int kp = 0; kp < 2; ++kp) {
        bf16x8 kf[2][4], qf[2];
#pragma unroll
        for (int k2 = 0; k2 < 2; ++k2)
#pragma unroll
          for (int m = 0; m < 4; ++m) kf[k2][m] = *(const bf16x8*)(p.Khi + ((size_t)(hs * 128 + m * 32 + r32)) * 64 + (kp * 2 + k2) * 16 + hi * 8);
#pragma unroll
        for (int k2 = 0; k2 < 2; ++k2) {
          const int ks = kp * 2 + k2;
          const float4 qa = *(const float4*)(qrow + hs * 64 + ks * 16 + hi * 8), qb = *(const float4*)(qrow + hs * 64 + ks * 16 + hi * 8 + 4);
          uint4 qh;
          qh.x = pack2bf(qa.x, qa.y); qh.y = pack2bf(qa.z, qa.w); qh.z = pack2bf(qb.x, qb.y); qh.w = pack2bf(qb.z, qb.w);
          qf[k2] = *reinterpret_cast<const bf16x8*>(&qh);
        }
#pragma unroll
        for (int k2 = 0; k2 < 2; ++k2)
#pragma unroll
          for (int m = 0; m < 4; ++m) acc[m] = __builtin_amdgcn_mfma_f32_32x32x16_bf16(kf[k2][m], qf[k2], acc[m], 0, 0, 0);
      }
      int L[16];
#pragma unroll
      for (int m = 0; m < 4; ++m) {
        int B[16];
#pragma unroll
        for (int r = 0; r < 16; ++r) B[r] = (sortable(acc[m][r]) & ~0x7F) | (m * 32 + (r & 3) + 8 * (r >> 2)) | hi4;
        if (m == 0) { sort_desc<16>(B);
#pragma unroll
          for (int i = 0; i < 16; ++i) L[i] = B[i]; }
        else absorb16(L, B);
      }
      int Lo[16], Hi[16];
#pragma unroll
      for (int i = 0; i < 16; ++i) { auto rr = __builtin_amdgcn_permlane32_swap((unsigned)L[i], (unsigned)L[i], false, false); Lo[i] = (int)rr[0]; Hi[i] = (int)rr[1]; }
#pragma unroll
      for (int i = 0; i < 16; ++i) L[i] = imax(Lo[i], Hi[15 - i]);
      merge_desc<16>(L);
#pragma unroll
      for (int i = 0; i < 16; ++i) { sv[s][i] = L[i]; svl[wave][lane][s * 16 + i] = L[i]; }
    }
    float f0[16], f1[16];
#pragma unroll
    for (int i = 0; i < 16; ++i) { f0[i] = unsortable(sv[0][i] & ~0x7F); f1[i] = unsortable(sv[1][i] & ~0x7F); }
    int Lc[16];
    {
      int C[64];
      int n = 0;
#pragma unroll
      for (int i = 0; i < 16; ++i)
#pragma unroll
        for (int j = 0; j < 16; ++j)
          if ((i + 1) * (j + 1) <= 16) { C[n] = (sortable(f0[i] + f1[j]) & ~0xFF) | (i * 16 + j); ++n; }
#pragma unroll
      for (int k = 50; k < 64; ++k) C[k] = (int)0x80000000;
#pragma unroll
      for (int m = 0; m < 4; ++m) {
        int B[16];
#pragma unroll
        for (int r = 0; r < 16; ++r) B[r] = C[m * 16 + r];
        if (m == 0) { sort_desc<16>(B);
#pragma unroll
          for (int i = 0; i < 16; ++i) Lc[i] = B[i]; }
        else absorb16(Lc, B);
      }
    }
    float e[16]; float esum = 0.f;
    const float vmax = unsortable(Lc[0] & ~0xFF);
#pragma unroll
    for (int r = 0; r < 16; ++r) { e[r] = expf(unsortable(Lc[r] & ~0xFF) - vmax); esum += e[r]; }
    const float inv = 1.f / esum;
    int eid[16];
#pragma unroll
    for (int r = 0; r < 16; ++r) {
      const int pr = Lc[r] & 0xFF;
      const int k0 = svl[wave][lane][pr >> 4] & 0x7F, k1 = svl[wave][lane][16 + (pr & 15)] & 0x7F;
      eid[r] = k0 * 128 + k1;
    }
    if (valid && hi == 0) {
      int* ip = p.IDX + (size_t)(g0 + trow) * 128 + h * 16; float* gp = p.GATE + (size_t)(g0 + trow) * 128 + h * 16;
#pragma unroll
      for (int r = 0; r < 16; r += 4) {
        *(int4*)(ip + r) = make_int4(eid[r], eid[r + 1], eid[r + 2], eid[r + 3]);
        *(float4*)(gp + r) = make_float4(e[r] * inv, e[r + 1] * inv, e[r + 2] * inv, e[r + 3] * inv);
      }
    }
  }
}

__device__ __forceinline__ float wave_sum_dpp(float v) {
  v += __uint_as_float(__builtin_amdgcn_update_dpp(0u, __float_as_uint(v), 0xB1, 0xF, 0xF, true));
  v += __uint_as_float(__builtin_amdgcn_update_dpp(0u, __float_as_uint(v), 0x4E, 0xF, 0xF, true));
  v += __uint_as_float(__builtin_amdgcn_update_dpp(0u, __float_as_uint(v), 0x141, 0xF, 0xF, true));
  v += __uint_as_float(__builtin_amdgcn_update_dpp(0u, __float_as_uint(v), 0x140, 0xF, 0xF, true));
  v += __uint_as_float(__builtin_amdgcn_update_dpp(0u, __float_as_uint(v), 0x142, 0xA, 0xF, true));
  v += __uint_as_float(__builtin_amdgcn_update_dpp(0u, __float_as_uint(v), 0x143, 0xC, 0xF, true));
  return __uint_as_float((unsigned)__builtin_amdgcn_readlane((int)__float_as_uint(v), 63));
}
__device__ __forceinline__ float gelu_fast(float x) {
  const float z = fabsf(x) * 0.70710678118654752f;
  const float t = __builtin_amdgcn_rcpf(fmaf(0.3275911f, z, 1.f));
  float pl = fmaf(1.061405429f, t, -1.453152027f); pl = fmaf(pl, t, 1.421413741f); pl = fmaf(pl, t, -0.284496736f); pl = fmaf(pl, t, 0.254829592f);
  const float e = __builtin_amdgcn_exp2f(-z * z * 1.4426950408889634f);
  const float erfa = 1.f - pl * t * e;
  const float hx = 0.5f * x;
  return hx + fabsf(hx) * erfa;
}
__device__ __forceinline__ void cvt_rows_i8(const float* __restrict__ src, unsigned char* __restrict__ dst, float* __restrict__ scl, int nrows, int wgid, int nw) {
  const int lane = otid() & 63;
  for (int r0 = wgid * 4; r0 < nrows; r0 += nw * 4) {
    float v[4][16];
#pragma unroll
    for (int u = 0; u < 4; ++u) {
      const float* sp = src + (size_t)(r0 + u) * D + lane * 4;
      *(float4*)&v[u][0] = *(const float4*)sp; *(float4*)&v[u][4] = *(const float4*)(sp + 256); *(float4*)&v[u][8] = *(const float4*)(sp + 512); *(float4*)&v[u][12] = *(const float4*)(sp + 768);
    }
#pragma unroll
    for (int u = 0; u < 4; ++u) {
      float am = 0.f;
#pragma unroll
      for (int j = 0; j < 16; ++j) am = fmaxf(am, fabsf(v[u][j]));
#pragma unroll
      for (int o = 32; o >= 1; o >>= 1) am = fmaxf(am, __shfl_xor(am, o));
      const float sc = am > 0.f ? am * (1.f / 127.f) : 1.f, inv = 1.f / sc;
      unsigned w[4];
#pragma unroll
      for (int q4 = 0; q4 < 4; ++q4) {
        unsigned ww = 0u;
#pragma unroll
        for (int j = 0; j < 4; ++j) { int qi = (int)rintf(v[u][q4 * 4 + j] * inv) + 128; qi = qi < 1 ? 1 : (qi > 255 ? 255 : qi); ww |= (unsigned)qi << (8 * j); }
        w[q4] = ww;
      }
      *(uint4*)(dst + (size_t)(r0 + u) * D + lane * 16) = make_uint4(w[0], w[1], w[2], w[3]);
      if (lane == 0) scl[r0 + u] = sc;
    }
  }
}

struct GatherP { const bf16_t* Tbf; const int* IDX; const float* GATE; const unsigned char* utab; const unsigned char* vtab; const float* su; const float* sv;
                 const float* Hin; const float* mod; const float* lng; const float* lnb; float* Hout; const float* modT; };
#define UB0(w) ((float)((w) & 0xFFu))
#define UB1(w) ((float)(((w) >> 8) & 0xFFu))
#define UB2(w) ((float)(((w) >> 16) & 0xFFu))
#define UB3(w) ((float)((w) >> 24))
template <bool FINAL>
__device__ __forceinline__ void ln_token(const GatherP& p, int row, int rr, int lane, const float (&f)[16], float asum, char* As) {
  const int v = row_vec(row);
  const float* hin = p.Hin + (size_t)row * D + lane * 4;
  const float* gm = p.mod + v * 6144 + 5 * 1024 + lane * 4;
  const float off = 128.f * asum;
  float r[16]; float ssum = 0.f;
#pragma unroll
  for (int q4 = 0; q4 < 4; ++q4) {
    const float4 h4 = *(const float4*)(hin + q4 * 256), g4 = *(const float4*)(gm + q4 * 256);
    r[q4 * 4 + 0] = ALPHA * h4.x + g4.x * (f[q4 * 4 + 0] - off); r[q4 * 4 + 1] = ALPHA * h4.y + g4.y * (f[q4 * 4 + 1] - off);
    r[q4 * 4 + 2] = ALPHA * h4.z + g4.z * (f[q4 * 4 + 2] - off); r[q4 * 4 + 3] = ALPHA * h4.w + g4.w * (f[q4 * 4 + 3] - off);
    ssum += r[q4 * 4 + 0] + r[q4 * 4 + 1] + r[q4 * 4 + 2] + r[q4 * 4 + 3];
  }
  const float mu = wave_sum(ssum) * (1.f / D);
  float vs = 0.f;
#pragma unroll
  for (int j = 0; j < 16; ++j) { const float dlt = r[j] - mu; vs += dlt * dlt; }
  const float rstd = rsqrtf(wave_sum(vs) * (1.f / D) + LN_EPS);
  float o[16];
#pragma unroll
  for (int q4 = 0; q4 < 4; ++q4) {
    const float4 g4 = *(const float4*)(p.lng + q4 * 256 + lane * 4), b4 = *(const float4*)(p.lnb + q4 * 256 + lane * 4);
    o[q4 * 4 + 0] = (r[q4 * 4 + 0] - mu) * rstd * g4.x + b4.x; o[q4 * 4 + 1] = (r[q4 * 4 + 1] - mu) * rstd * g4.y + b4.y;
    o[q4 * 4 + 2] = (r[q4 * 4 + 2] - mu) * rstd * g4.z + b4.z; o[q4 * 4 + 3] = (r[q4 * 4 + 3] - mu) * rstd * g4.w + b4.w;
    *(float4*)(p.Hout + (size_t)row * D + q4 * 256 + lane * 4) = make_float4(o[q4 * 4 + 0], o[q4 * 4 + 1], o[q4 * 4 + 2], o[q4 * 4 + 3]);
  }
  if (!FINAL) {
    const float* mt = p.modT + v * 6144 + lane * 4;
#pragma unroll
    for (int q4 = 0; q4 < 4; ++q4) {
      const float4 sh = *(const float4*)(mt + q4 * 256), sc = *(const float4*)(mt + 1024 + q4 * 256);
      uint2 w; w.x = pack2bf(o[q4 * 4] * (1.f + sc.x) + sh.x, o[q4 * 4 + 1] * (1.f + sc.y) + sh.y); w.y = pack2bf(o[q4 * 4 + 2] * (1.f + sc.z) + sh.z, o[q4 * 4 + 3] * (1.f + sc.w) + sh.w);
      *(uint2*)(As + rr * LDA_B + (q4 * 256 + lane * 4) * 2) = w;
    }
  }
}
constexpr int PARTW = 1088;
template <bool FINAL>
__device__ __forceinline__ void ph_gather_tm(const GatherP& p, int g0, int nrows, char* As, float* __restrict__ PART) {
  const int tid = otid(), wave = tid >> 6, lane = tid & 63;
  const int nfull = nrows >> 3, extra = nrows & 7;
  const int nun = nfull + (extra ? 1 : 0);
#pragma unroll 1
  for (int un = 0; un < nun; ++un) {
    int rr, kbeg, kcnt; bool partial;
    if (un < nfull) { rr = wave + 8 * un; kbeg = 0; kcnt = 128; partial = false; }
    else { const int wpt = 8 / extra; rr = nfull * 8 + wave / wpt; kcnt = 128 / wpt; kbeg = (wave % wpt) * kcnt; partial = true; }
    const int row = g0 + rr;
    float tf[16];
    {
      const bf16_t* tp = p.Tbf + (size_t)row * D + lane * 4;
      const uint2 t0 = *(const uint2*)tp, t1 = *(const uint2*)(tp + 256), t2 = *(const uint2*)(tp + 512), t3 = *(const uint2*)(tp + 768);
      tf[0] = bflo(t0.x); tf[1] = bfhi(t0.x); tf[2] = bflo(t0.y); tf[3] = bfhi(t0.y); tf[4] = bflo(t1.x); tf[5] = bfhi(t1.x); tf[6] = bflo(t1.y); tf[7] = bfhi(t1.y);
      tf[8] = bflo(t2.x); tf[9] = bfhi(t2.x); tf[10] = bflo(t2.y); tf[11] = bfhi(t2.y); tf[12] = bflo(t3.x); tf[13] = bfhi(t3.x); tf[14] = bflo(t3.y); tf[15] = bfhi(t3.y);
    }
    float tsum = 0.f;
#pragma unroll
    for (int j = 0; j < 16; ++j) tsum += tf[j];
    tsum = wave_sum_dpp(tsum) * 128.f;
    const int id_lo = p.IDX[(size_t)row * 128 + lane], id_hi = p.IDX[(size_t)row * 128 + 64 + lane];
    const float ga_lo = p.GATE[(size_t)row * 128 + lane], ga_hi = p.GATE[(size_t)row * 128 + 64 + lane];
    float f[16], asum = 0.f;
#pragma unroll
    for (int j = 0; j < 16; ++j) f[j] = 0.f;
    uint4 ub[8], vb[8]; float sub[8], svb[8];
#define TLOAD(slot, kk) do { const int e_ = __builtin_amdgcn_readlane((kk) < 64 ? id_lo : id_hi, (kk) & 63); \
      ub[slot] = *(const uint4*)(p.utab + (size_t)e_ * D + lane * 16); vb[slot] = *(const uint4*)(p.vtab + (size_t)e_ * D + lane * 16); \
      sub[slot] = p.su[e_]; svb[slot] = p.sv[e_]; } while (0)
#define TPROC(slot, kk) do { \
      const uint4 a_ = ub[slot]; \
      float dot_ = tf[0] * UB0(a_.x); dot_ = fmaf(tf[1], UB1(a_.x), dot_); dot_ = fmaf(tf[2], UB2(a_.x), dot_); dot_ = fmaf(tf[3], UB3(a_.x), dot_); \
      dot_ = fmaf(tf[4], UB0(a_.y), dot_); dot_ = fmaf(tf[5], UB1(a_.y), dot_); dot_ = fmaf(tf[6], UB2(a_.y), dot_); dot_ = fmaf(tf[7], UB3(a_.y), dot_); \
      dot_ = fmaf(tf[8], UB0(a_.z), dot_); dot_ = fmaf(tf[9], UB1(a_.z), dot_); dot_ = fmaf(tf[10], UB2(a_.z), dot_); dot_ = fmaf(tf[11], UB3(a_.z), dot_); \
      dot_ = fmaf(tf[12], UB0(a_.w), dot_); dot_ = fmaf(tf[13], UB1(a_.w), dot_); dot_ = fmaf(tf[14], UB2(a_.w), dot_); dot_ = fmaf(tf[15], UB3(a_.w), dot_); \
      dot_ = wave_sum_dpp(dot_); \
      const float g_ = __uint_as_float((unsigned)__builtin_amdgcn_readlane((int)__float_as_uint((kk) < 64 ? ga_lo : ga_hi), (kk) & 63)); \
      const float act_ = gelu_fast(sub[slot] * (dot_ - tsum)) * g_ * svb[slot]; \
      asum += act_; \
      const uint4 c_ = vb[slot]; \
      f[0] = fmaf(act_, UB0(c_.x), f[0]); f[1] = fmaf(act_, UB1(c_.x), f[1]); f[2] = fmaf(act_, UB2(c_.x), f[2]); f[3] = fmaf(act_, UB3(c_.x), f[3]); \
      f[4] = fmaf(act_, UB0(c_.y), f[4]); f[5] = fmaf(act_, UB1(c_.y), f[5]); f[6] = fmaf(act_, UB2(c_.y), f[6]); f[7] = fmaf(act_, UB3(c_.y), f[7]); \
      f[8] = fmaf(act_, UB0(c_.z), f[8]); f[9] = fmaf(act_, UB1(c_.z), f[9]); f[10] = fmaf(act_, UB2(c_.z), f[10]); f[11] = fmaf(act_, UB3(c_.z), f[11]); \
      f[12] = fmaf(act_, UB0(c_.w), f[12]); f[13] = fmaf(act_, UB1(c_.w), f[13]); f[14] = fmaf(act_, UB2(c_.w), f[14]); f[15] = fmaf(act_, UB3(c_.w), f[15]); } while (0)
    TLOAD(0, kbeg); TLOAD(1, kbeg + 1); TLOAD(2, kbeg + 2); TLOAD(3, kbeg + 3); TLOAD(4, kbeg + 4); TLOAD(5, kbeg + 5); TLOAD(6, kbeg + 6); TLOAD(7, kbeg + 7);
    const int kend = kbeg + kcnt - 8;
#pragma unroll 1
    for (int k = kbeg; k < kend; k += 8) {
      TPROC(0, k); TLOAD(0, k + 8); TPROC(1, k + 1); TLOAD(1, k + 9); TPROC(2, k + 2); TLOAD(2, k + 10); TPROC(3, k + 3); TLOAD(3, k + 11);
      TPROC(4, k + 4); TLOAD(4, k + 12); TPROC(5, k + 5); TLOAD(5, k + 13); TPROC(6, k + 6); TLOAD(6, k + 14); TPROC(7, k + 7); TLOAD(7, k + 15);
    }
    TPROC(0, kend); TPROC(1, kend + 1); TPROC(2, kend + 2); TPROC(3, kend + 3); TPROC(4, kend + 4); TPROC(5, kend + 5); TPROC(6, kend + 6); TPROC(7, kend + 7);
#undef TLOAD
#undef TPROC
    if (!partial) ln_token<FINAL>(p, row, rr, lane, f, asum, As);
    else {
      float* pp = PART + wave * PARTW + lane * 16;
      *(float4*)pp = make_float4(f[0], f[1], f[2], f[3]); *(float4*)(pp + 4) = make_float4(f[4], f[5], f[6], f[7]);
      *(float4*)(pp + 8) = make_float4(f[8], f[9], f[10], f[11]); *(float4*)(pp + 12) = make_float4(f[12], f[13], f[14], f[15]);
      if (lane == 0) PART[wave * PARTW + 1024] = asum;
    }
  }
  if (extra) {
    __syncthreads();
    if (wave < extra) {
      const int wpt = 8 / extra, rr = nfull * 8 + wave;
      float f[16], asum = 0.f;
#pragma unroll
      for (int j = 0; j < 16; ++j) f[j] = 0.f;
      for (int w2 = wave * wpt; w2 < wave * wpt + wpt; ++w2) {
        const float* pp = PART + w2 * PARTW + lane * 16;
#pragma unroll
        for (int q4 = 0; q4 < 4; ++q4) { const float4 x4 = *(const float4*)(pp + q4 * 4); f[q4 * 4] += x4.x; f[q4 * 4 + 1] += x4.y; f[q4 * 4 + 2] += x4.z; f[q4 * 4 + 3] += x4.w; }
        asum += PART[w2 * PARTW + 1024];
      }
      ln_token<FINAL>(p, g0 + rr, rr, lane, f, asum, As);
    }
  }
}

__device__ __forceinline__ void cvt_plain(const float* __restrict__ a, bf16_t* __restrict__ o, size_t n8, bool lo, size_t gtid, size_t gsz) {
  for (size_t i = gtid; i < n8; i += gsz) {
    float v[8];
    *(float4*)&v[0] = ((const float4*)a)[i * 2]; *(float4*)&v[4] = ((const float4*)a)[i * 2 + 1];
    if (lo) {
#pragma unroll
      for (int j = 0; j < 8; ++j) v[j] = v[j] - bf2f(f2bf(v[j]));
    }
    uint4 w; w.x = pack2bf(v[0], v[1]); w.y = pack2bf(v[2], v[3]); w.z = pack2bf(v[4], v[5]); w.w = pack2bf(v[6], v[7]);
    ((uint4*)o)[i] = w;
  }
}
__device__ __forceinline__ void cvt_t(const float* __restrict__ W, bf16_t* __restrict__ Wt, int K, int N, bool lo, size_t gtid, size_t gsz) {
  const size_t total = (size_t)N * (K / 8);
#pragma unroll 4
  for (size_t i = gtid; i < total; i += gsz) {
    const int n = (int)(i % N), k8 = (int)(i / N);
    float v[8];
#pragma unroll
    for (int j = 0; j < 8; ++j) { const float w = W[(size_t)(k8 * 8 + j) * N + n]; v[j] = lo ? w - bf2f(f2bf(w)) : w; }
    uint4 w; w.x = pack2bf(v[0], v[1]); w.y = pack2bf(v[2], v[3]); w.z = pack2bf(v[4], v[5]); w.w = pack2bf(v[6], v[7]);
    *(uint4*)(Wt + ((size_t)((n >> 4) * (K >> 5) + (k8 >> 2)) * 64 + (k8 & 3) * 16 + (n & 15)) * 8) = w;
  }
}
__device__ __forceinline__ void mod_item(const float* __restrict__ c, const float* __restrict__ c_ctx, const float* __restrict__ ada_w, const float* __restrict__ ada_b,
                                         float* __restrict__ MOD, int item, bool valid, char* lds, int tid, int nct, volatile int* cbc, int& cgen) {
  float* sc = (float*)lds;
  float* part = sc + 3072;
  const int wave = tid >> 6, lane = tid & 63, l = item / 96, cg = item % 96, nw = nct >> 6;
  if (valid) for (int i = tid; i < 3072; i += nct) { const int v = i >> 10, k = i & 1023; const float xv = v < 2 ? c[v * 1024 + k] : c_ctx[k]; sc[i] = xv / (1.f + expf(-xv)); }
  cbar(cbc, cgen, nw);
  if (valid) {
    float a0 = 0.f, a1 = 0.f, a2 = 0.f;
    const float* W = ada_w + (size_t)l * 1024 * 6144 + cg * 64 + lane;
    const int kb = wave * 171, ke = kb + 171 < 1024 ? kb + 171 : 1024;
#pragma unroll 19
    for (int k = kb; k < ke; ++k) { const float w = W[(size_t)k * 6144]; a0 += sc[k] * w; a1 += sc[1024 + k] * w; a2 += sc[2048 + k] * w; }
    part[(wave * 3 + 0) * 64 + lane] = a0; part[(wave * 3 + 1) * 64 + lane] = a1; part[(wave * 3 + 2) * 64 + lane] = a2;
  }
  cbar(cbc, cgen, nw);
  if (valid && tid < 192) {
    const int v = tid >> 6, ln = tid & 63; float sum = 0.f;
    for (int w = 0; w < nw; ++w) sum += part[(w * 3 + v) * 64 + ln];
    MOD[(l * 3 + v) * 6144 + cg * 64 + ln] = sum + ada_b[l * 6144 + cg * 64 + ln];
  }
}

__device__ __forceinline__ void gbar(unsigned* cnt, unsigned target) {
  asm volatile("s_waitcnt vmcnt(0)" ::: "memory");
  __syncthreads();
  if (otid() == 0) {
    __builtin_amdgcn_fence(__ATOMIC_RELEASE, "agent");
    asm volatile("s_waitcnt vmcnt(0)" ::: "memory");
    __hip_atomic_fetch_add(cnt, 1u, __ATOMIC_RELAXED, __HIP_MEMORY_SCOPE_AGENT);
    unsigned spins = 0;
    while (__hip_atomic_load(cnt, __ATOMIC_RELAXED, __HIP_MEMORY_SCOPE_AGENT) < target) { __builtin_amdgcn_s_sleep(2); if (++spins > (1u << 24)) break; }
    __builtin_amdgcn_fence(__ATOMIC_ACQUIRE, "agent");
    asm volatile("s_waitcnt vmcnt(0)" ::: "memory");
  }
  __syncthreads();
}

struct MP {
  const float *x, *c, *ctx, *c_ctx, *ada_w, *ada_b, *ln_g, *ln_b, *s5_a_re, *s5_a_im, *s5_log_dt, *s5_b_re, *s5_b_im, *s5_c_re, *s5_c_im, *s5_d, *s5_w_glu, *s5_w_o;
  const float *mla_w_dq, *mla_q_norm, *mla_w_uq, *mla_w_dkv, *mla_kv_norm, *mla_w_ukv, *mla_w_o, *peer_w_q, *peer_keys, *peer_u, *peer_v;
  float* out;
  float* MOD; bf16_t *Wt_glu, *Wt_o0, *Wt_q0, *Wt_o1, *Wt_q1, *Wt_cat, *Wt_uq, *Wt_ukv, *Khi, *Khi1;
  unsigned char *U0, *V0, *U1, *V1; float *SU0, *SV0, *SU1, *SV1; bf16_t *Ktab, *Bst_t, *Cin_t;
  float *Ypart, *Ssta; bf16_t *HP, *Gbf, *Vbf, *Tbf; float *OQ, *H1, *H2; int* IDX; float* GATE;
  bf16_t *Qa, *Kn, *Kr, *Va, *AObf; float* H3; bf16_t* Tbf1; unsigned* BAR; float* PART;
};
constexpr int LDS_BYTES = att::SHM_ATTN > 66 * LDA_B ? att::SHM_ATTN : 66 * LDA_B;
__global__ __launch_bounds__(512) void mega(MP p) {
  __shared__ __attribute__((aligned(16))) char lds[LDS_BYTES];
  cg::grid_group grid = cg::this_grid();
  const int nblk = gridDim.x;
  int bid = blockIdx.x;
  const size_t TD = (size_t)1024 * 16384;
  const float* mod0 = p.MOD; const float* mod1 = p.MOD + 3 * 6144;
  {
    volatile int* cbc = (volatile int*)(lds + LDS_BYTES - 16);
    if (otid() == 0) *cbc = 0;
    __syncthreads();
    const int t0 = otid();
    if (t0 < 128) {
      const size_t mt = (size_t)bid * 128 + t0, ms = (size_t)nblk * 128;
      const int mw = bid * 2 + (t0 >> 6), nmw = nblk * 2;
      cvt_t(p.s5_w_glu, p.Wt_glu, D, D, false, mt, ms);
      cvt_t(p.s5_w_o, p.Wt_o0, D, D, false, mt, ms);
      cvt_t(p.peer_w_q, p.Wt_q0, D, D, false, mt, ms);
      cvt_t(p.mla_w_o, p.Wt_o1, D, D, false, mt, ms);
      cvt_t(p.peer_w_q + (size_t)D * D, p.Wt_q1, D, D, false, mt, ms);
      cvt_t(p.mla_w_dq, p.Wt_cat, D, 384, false, mt, ms);
      cvt_t(p.mla_w_dkv, p.Wt_cat + (size_t)384 * D, D, 320, false, mt, ms);
      cvt_t(p.mla_w_uq, p.Wt_uq, 384, 1536, false, mt, ms);
      cvt_t(p.mla_w_ukv, p.Wt_ukv, 256, 2048, false, mt, ms);
      cvt_plain(p.peer_keys, p.Khi, (size_t)2 * 131072 / 8, false, mt, ms);
      cvt_rows_i8(p.peer_u, p.U0, p.SU0, 16384, mw, nmw);
      cvt_rows_i8(p.peer_v, p.V0, p.SV0, 16384, mw, nmw);
    } else {
      int cgen = 0;
      const int ct = t0 - 128;
      ph_s5_prep(p.s5_a_re, p.s5_a_im, p.s5_log_dt, p.s5_b_re, p.s5_b_im, p.s5_c_re, p.s5_c_im, p.Ktab, p.Bst_t, p.Cin_t, bid >> 2, bid & 3, lds, ct, 384, cbc, cgen);
      cbar(cbc, cgen, 6);
      mod_item(p.c, p.c_ctx, p.ada_w, p.ada_b, p.MOD, bid, bid < 192, lds, ct, 384, cbc, cgen);
      cvt_rows_i8(p.peer_u + TD, p.U1, p.SU1, 16384, bid * 6 + (ct >> 6), nblk * 6);
      cvt_rows_i8(p.peer_v + TD, p.V1, p.SV1, 16384, bid * 6 + (ct >> 6), nblk * 6);
    }
  }
  grid.sync();
  asm volatile("" : "+s"(bid));
  ph_s5_p1(p.x, p.ctx, mod0, p.Ktab, p.Bst_t, p.Ypart, p.Ssta, bid, lds);
  gbar(p.BAR, 1u * (unsigned)nblk);
  asm volatile("" : "+s"(bid));
  if (otid() < 64) ph_s5_carry(p.Ssta, p.s5_a_re, p.s5_a_im, p.s5_log_dt, p.HP, bid, otid());
  gbar(p.BAR, 2u * (unsigned)nblk);
  asm volatile("" : "+s"(bid));
  ph_s5_p3(p.x, p.ctx, mod0, p.s5_d, p.HP, p.Cin_t, p.Ypart, p.Gbf, bid, lds);
  gbar(p.BAR, 3u * (unsigned)nblk);
  asm volatile("" : "+s"(bid));
  {
    ChainP cp{p.Gbf, p.Wt_glu, p.Wt_o0, p.Wt_q0, p.Vbf, p.OQ, p.x, p.ctx, mod0, p.ln_g, p.ln_b, p.H1, p.Tbf, p.OQ};
    ph_chainA<true>(cp, bid, lds);
    __syncthreads();
    ph_route(RouteP{p.OQ, p.Khi, p.IDX, p.GATE, 66, 0}, bid, lds);
    __syncthreads();
    GatherP gp{p.Tbf, p.IDX, p.GATE, p.U0, p.V0, p.SU0, p.SV0, p.H1, mod0, p.ln_g + D, p.ln_b + D, p.H2, mod1};
    ph_gather_tm<false>(gp, bid * 66, 66, lds, p.PART + (size_t)bid * 8 * PARTW);
    __syncthreads();
    ProjP pp{p.Wt_cat, p.Wt_uq, p.Wt_ukv, p.mla_q_norm, p.mla_kv_norm, p.OQ  , p.Qa, p.Kn, p.Kr, p.Va};
    ph_mla_proj(pp, bid, lds);
  }
  gbar(p.BAR, 4u * (unsigned)nblk);
  asm volatile("" : "+s"(bid));
  ph_attn(p.Qa, p.Kn, p.Kr, p.Va, p.AObf, bid, nblk, lds);
  gbar(p.BAR, 5u * (unsigned)nblk);
  asm volatile("" : "+s"(bid));
  {
    ChainP cp{p.AObf, nullptr, p.Wt_o1, p.Wt_q1, nullptr, p.OQ, p.H2, p.H2 + (size_t)NL * D, mod1, p.ln_g + 2 * D, p.ln_b + 2 * D, p.H3, p.Tbf1, p.OQ};
    ph_chainA<false>(cp, bid, lds);
    __syncthreads();
    ph_route(RouteP{p.OQ, p.Khi1, p.IDX, p.GATE, 64, 0}, bid, lds);
    __syncthreads();
    GatherP gp{p.Tbf1, p.IDX, p.GATE, p.U1, p.V1, p.SU1, p.SV1, p.H3, mod1, p.ln_g + 3 * D, p.ln_b + 3 * D, p.out, mod1};
    ph_gather_tm<true>(gp, bid * 64, 64, lds, p.PART + (size_t)bid * 8 * PARTW);
  }
}

extern "C" void kernel_launch(void* const* d_in, const int* in_sizes, int n_in, void* d_out, int out_size, void* d_ws, size_t ws_size, hipStream_t stream) {
  MP p{};
  const float** in = (const float**)&p;
  for (int i = 0; i < 29; ++i) in[i] = (const float*)d_in[i];
  p.out = (float*)d_out;
  char* ws = (char*)d_ws; size_t off = 0;
  auto carve = [&](size_t bytes) { char* q = ws + off; off += (bytes + 255) / 256 * 256; return q; };
  const size_t TDB = (size_t)1024 * 16384 * 2, BIG = (size_t)NT * D * 4, HALF = (size_t)NT * D * 2;
  p.MOD = (float*)carve(2 * 3 * 6144 * 4);
  p.Wt_glu = (bf16_t*)carve((size_t)D * D * 2); p.Wt_o0 = (bf16_t*)carve((size_t)D * D * 2); p.Wt_q0 = (bf16_t*)carve((size_t)D * D * 2);
  p.Wt_o1 = (bf16_t*)carve((size_t)D * D * 2); p.Wt_q1 = (bf16_t*)carve((size_t)D * D * 2);
  p.Wt_cat = (bf16_t*)carve((size_t)704 * D * 2); p.Wt_uq = (bf16_t*)carve((size_t)1536 * 384 * 2); p.Wt_ukv = (bf16_t*)carve((size_t)2048 * 256 * 2);
  p.Khi = (bf16_t*)carve((size_t)2 * 131072 * 2); p.Khi1 = p.Khi + 131072;
  char* T0 = carve(TDB); p.U0 = (unsigned char*)T0; p.V0 = (unsigned char*)(T0 + TDB / 2); p.AObf = (bf16_t*)T0;
  p.SU0 = (float*)carve(16384 * 4); p.SV0 = (float*)carve(16384 * 4); p.SU1 = (float*)carve(16384 * 4); p.SV1 = (float*)carve(16384 * 4);
  const size_t KTAB_B = (size_t)64 * 127 * 256 * 2, BST_B = (size_t)64 * 256 * 1024 * 2, KN_B = (size_t)NB * 8 * KEYS * 128 * 2, KR_B = (size_t)NB * KEYS * 64 * 2;
  size_t x1 = KTAB_B + 2 * BST_B; if (x1 < 2 * KN_B + KR_B) x1 = 2 * KN_B + KR_B;
  char* X1 = carve(x1);
  p.Ktab = (bf16_t*)X1; p.Bst_t = (bf16_t*)(X1 + KTAB_B); p.Cin_t = (bf16_t*)(X1 + KTAB_B + BST_B);
  p.Kn = (bf16_t*)X1; p.Va = (bf16_t*)(X1 + KN_B); p.Kr = (bf16_t*)(X1 + 2 * KN_B); p.H3 = (float*)X1;
  char* X2 = carve(BIG); p.Ypart = (float*)X2; p.OQ = (float*)X2;
  char* X3 = carve(HALF); p.Ssta = (float*)X3; p.HP = (bf16_t*)(X3 + (size_t)NCC * 64 * 256 * 4); p.Vbf = (bf16_t*)X3;
  char* X4 = carve(HALF); p.Gbf = (bf16_t*)X4; p.Tbf = (bf16_t*)X4; p.Tbf1 = (bf16_t*)X4;
  char* X5 = carve(BIG); p.H1 = (float*)X5;
  char* T1 = carve(TDB); p.U1 = (unsigned char*)T1; p.V1 = (unsigned char*)(T1 + TDB / 2);
  p.H2 = (float*)carve(BIG);
  p.IDX = (int*)carve((size_t)NT * 128 * 4); p.GATE = (float*)carve((size_t)NT * 128 * 4);
  p.Qa = (bf16_t*)carve((size_t)NB * 8 * SEQ * 192 * 2);
  p.BAR = (unsigned*)carve(256);
  p.PART = (float*)carve((size_t)256 * 8 * PARTW * 4);
  if (off > ws_size || n_in != 29) { fprintf(stderr, "kernel_launch: workspace too small (need %zu, have %zu) or n_in %d != 29\n", off, ws_size, n_in); return; }
  static int grid_blocks = 0;
  if (!grid_blocks) {
    int dev = 0, cus = 0, per_cu = 0;
    hipGetDevice(&dev);
    hipDeviceGetAttribute(&cus, hipDeviceAttributeMultiprocessorCount, dev);
    hipOccupancyMaxActiveBlocksPerMultiprocessor(&per_cu, mega, 512, 0);
    if (per_cu < 1 || cus < 256) { fprintf(stderr, "kernel_launch: need 256 resident workgroups (cus %d, per_cu %d)\n", cus, per_cu); return; }
    grid_blocks = 256;
  }
  hipMemsetAsync(p.BAR, 0, 256, stream);
  void* args[] = {&p};
  hipError_t e = hipLaunchCooperativeKernel((void*)mega, dim3(grid_blocks), dim3(512), args, 0, stream);
  if (e != hipSuccess) fprintf(stderr, "cooperative launch failed: %s\n", hipGetErrorString(e));
}
```

```cpp
#include <hip/hip_runtime.h>
#include <math.h>
#include <hip/hip_cooperative_groups.h>
#include <cstdio>
namespace cg = cooperative_groups;
__device__ __forceinline__ int otid() { int t = (int)__builtin_amdgcn_workitem_id_x(); asm volatile("" : "+v"(t)); return t; }

constexpr int D = 1024, NB = 2, SEQ = 8192, CTX = 256;
constexpr int NL = NB * SEQ, NC = NB * CTX, NT = NL + NC;
constexpr float ALPHA = 1.4142135623730951f;
constexpr float LN_EPS = 1e-5f, RMS_EPS = 1e-6f;

__device__ __forceinline__ float wave_sum(float v) {
#pragma unroll
  for (int o = 32; o >= 1; o >>= 1) v += __shfl_xor(v, o);
  return v;
}
__device__ __forceinline__ int row_vec(int row) { return row < NL ? (row >> 13) : 2; }
__device__ __forceinline__ float gelu_exact(float x) { return 0.5f * x * (1.f + erff(x * 0.70710678118654752f)); }
__device__ __forceinline__ float gelu_fast(float x) {
  const float z = fabsf(x) * 0.70710678118654752f;
  const float t = __builtin_amdgcn_rcpf(fmaf(0.3275911f, z, 1.f));
  float pl = fmaf(1.061405429f, t, -1.453152027f); pl = fmaf(pl, t, 1.421413741f); pl = fmaf(pl, t, -0.284496736f); pl = fmaf(pl, t, 0.254829592f);
  const float e = __builtin_amdgcn_exp2f(-z * z * 1.4426950408889634f);
  const float erfa = 1.f - pl * t * e;
  const float hx = 0.5f * x;
  return hx + fabsf(hx) * erfa;
}


typedef unsigned short bf16_t;
using bf16x8 = __attribute__((ext_vector_type(8))) short;
using f32x4 = __attribute__((ext_vector_type(4))) float;
__device__ __forceinline__ bf16_t f2bf(float f) { unsigned u = __float_as_uint(f); u += 0x7FFFu + ((u >> 16) & 1u); return (bf16_t)(u >> 16); }
__device__ __forceinline__ float bf2f(bf16_t h) { return __uint_as_float(((unsigned)h) << 16); }
__device__ __forceinline__ unsigned pack2bf(float lo, float hi) { return (unsigned)f2bf(lo) | ((unsigned)f2bf(hi) << 16); }
__device__ __forceinline__ float bflo(unsigned w) { return __uint_as_float(w << 16); }
__device__ __forceinline__ float bfhi(unsigned w) { return __uint_as_float(w & 0xFFFF0000u); }


constexpr int LDA_B = 1024 * 2 + 16;
template <int RT, int K>
__device__ __forceinline__ void gemm_unit(const char* const (&ap)[RT], const bf16_t* __restrict__ w0, const bf16_t* __restrict__ w1, int kmul, f32x4 (&acc)[RT][2]) {
  constexpr int KI = K / 128, NS = 2;
#pragma unroll
  for (int t = 0; t < RT; ++t) { acc[t][0] = f32x4{0.f, 0.f, 0.f, 0.f}; acc[t][1] = f32x4{0.f, 0.f, 0.f, 0.f}; }
  bf16x8 b[NS][4][2];
#pragma unroll
  for (int st = 0; st < NS - 1; ++st) {
    if (st < KI) {
#pragma unroll
      for (int s2 = 0; s2 < 4; ++s2) { b[st][s2][0] = *(const bf16x8*)(w0 + (st * 128 + s2 * 32) * kmul); b[st][s2][1] = *(const bf16x8*)(w1 + (st * 128 + s2 * 32) * kmul); }
    }
  }
  asm volatile("" ::: "memory");
  bf16x8 an[RT];
#pragma unroll
  for (int t = 0; t < RT; ++t) an[t] = *(const bf16x8*)(ap[t]);
#pragma unroll
  for (int it = 0; it < KI; ++it) {
    if (it + NS - 1 < KI) {
#pragma unroll
      for (int s2 = 0; s2 < 4; ++s2) {
        b[(it + NS - 1) % NS][s2][0] = *(const bf16x8*)(w0 + ((it + NS - 1) * 128 + s2 * 32) * kmul);
        b[(it + NS - 1) % NS][s2][1] = *(const bf16x8*)(w1 + ((it + NS - 1) * 128 + s2 * 32) * kmul);
      }
    }
    asm volatile("" ::: "memory");
#pragma unroll
    for (int s2 = 0; s2 < 4; ++s2) {
      bf16x8 ac[RT];
#pragma unroll
      for (int t = 0; t < RT; ++t) ac[t] = an[t];
      if (it * 4 + s2 + 1 < KI * 4) {
#pragma unroll
        for (int t = 0; t < RT; ++t) an[t] = *(const bf16x8*)(ap[t] + (it * 128 + s2 * 32 + 32) * 2);
      }
#pragma unroll
      for (int t = 0; t < RT; ++t) {
        acc[t][0] = __builtin_amdgcn_mfma_f32_16x16x32_bf16(ac[t], b[it % NS][s2][0], acc[t][0], 0, 0, 0);
        acc[t][1] = __builtin_amdgcn_mfma_f32_16x16x32_bf16(ac[t], b[it % NS][s2][1], acc[t][1], 0, 0, 0);
      }
    }
  }
}
template <int RT, int K, class Epi>
__device__ __forceinline__ void gemm_ldsA(const char* As, int lda_b, int nrows, const bf16_t* __restrict__ Wt, int N, Epi epi) {
  const int wave = otid() >> 6, lane = otid() & 63, l15 = lane & 15, q = lane >> 4;
  const char* ap[RT];
#pragma unroll
  for (int t = 0; t < RT; ++t) { int r = t * 16 + l15; r = r < nrows ? r : nrows - 1; ap[t] = As + r * lda_b + q * 16; }
#pragma unroll 1
  for (int unit = wave; unit < (N >> 5); unit += 8) {
    const int n0 = unit * 32;
    const bf16_t* w0 = Wt + (size_t)(n0 >> 4) * K * 16 + lane * 8;
    f32x4 acc[RT][2];
    gemm_unit<RT, K>(ap, w0, w0 + (size_t)K * 16, 16, acc);
#pragma unroll
    for (int t = 0; t < RT; ++t)
#pragma unroll
      for (int j = 0; j < 2; ++j)
#pragma unroll
        for (int r = 0; r < 4; ++r) {
          const int row = t * 16 + q * 4 + r, col = n0 + j * 16 + l15;
          if (row < nrows) epi(row, col, acc[t][j][r]);
        }
  }
}
struct EpiF32 { float* C; int ldc; __device__ __forceinline__ void operator()(int row, int col, float v) const { C[(size_t)row * ldc + col] = v; } };
struct EpiGluL { const char* As; bf16_t* V; __device__ __forceinline__ void operator()(int row, int col, float z) const {
  const float g = bf2f(*(const bf16_t*)(As + row * LDA_B + col * 2)); V[(size_t)row * D + col] = f2bf(g / (1.f + expf(-z))); } };

__device__ __forceinline__ void load_rows_lds(char* As, const bf16_t* __restrict__ src, int nrows) {
  const int t = otid(), total = nrows * 128;
#pragma unroll
  for (int h = 0; h < 2; ++h) {
    uint4 v[9];
#pragma unroll
    for (int k = 0; k < 9; ++k) { int i = t + (h * 9 + k) * 512; i = i < total ? i : total - 1; v[k] = *(const uint4*)(src + (size_t)(i >> 7) * D + (i & 127) * 8); }
#pragma unroll
    for (int k = 0; k < 9; ++k) { const int i = t + (h * 9 + k) * 512; if (i < total) *(uint4*)(As + (i >> 7) * LDA_B + (i & 127) * 16) = v[k]; }
  }
}
__device__ __forceinline__ void ln_rows(char* As, int g0, int nrows, const float* Hl, const float* Hc, const float* __restrict__ O,
                                        const float* __restrict__ mod, int gate_i, const float* __restrict__ lng, const float* __restrict__ lnb,
                                        float* Hout, bf16_t* __restrict__ Tbf, int shift_i, int scale_i) {
  const int wave = otid() >> 6, lane = otid() & 63;
  for (int rr = wave; rr < nrows; rr += 8) {
    const int row = g0 + rr;
    const float* hin = row < NL ? Hl + (size_t)row * D : Hc + (size_t)(row - NL) * D;
    const float* f = O + (size_t)row * D;
    const float* m = mod + row_vec(row) * 6144;
    const float* gm = m + gate_i * 1024;
    float r[16]; float s = 0.f;
#pragma unroll
    for (int i = 0; i < 4; ++i) {
      const int d = i * 256 + lane * 4;
      float4 h4 = *(const float4*)(hin + d), f4 = *(const float4*)(f + d), g4 = *(const float4*)(gm + d);
      r[i * 4 + 0] = ALPHA * h4.x + g4.x * f4.x; r[i * 4 + 1] = ALPHA * h4.y + g4.y * f4.y;
      r[i * 4 + 2] = ALPHA * h4.z + g4.z * f4.z; r[i * 4 + 3] = ALPHA * h4.w + g4.w * f4.w;
      s += r[i * 4 + 0] + r[i * 4 + 1] + r[i * 4 + 2] + r[i * 4 + 3];
    }
    const float mu = wave_sum(s) * (1.f / D);
    float vs = 0.f;
#pragma unroll
    for (int i = 0; i < 16; ++i) { float dlt = r[i] - mu; vs += dlt * dlt; }
    const float rstd = rsqrtf(wave_sum(vs) * (1.f / D) + LN_EPS);
#pragma unroll
    for (int i = 0; i < 4; ++i) {
      const int d = i * 256 + lane * 4;
      float4 g4 = *(const float4*)(lng + d), b4 = *(const float4*)(lnb + d);
      float4 o;
      o.x = (r[i * 4 + 0] - mu) * rstd * g4.x + b4.x; o.y = (r[i * 4 + 1] - mu) * rstd * g4.y + b4.y;
      o.z = (r[i * 4 + 2] - mu) * rstd * g4.z + b4.z; o.w = (r[i * 4 + 3] - mu) * rstd * g4.w + b4.w;
      *(float4*)(Hout + (size_t)row * D + d) = o;
      float4 sh = *(const float4*)(m + shift_i * 1024 + d), sc = *(const float4*)(m + scale_i * 1024 + d);
      const float t0 = o.x * (1.f + sc.x) + sh.x, t1 = o.y * (1.f + sc.y) + sh.y, t2 = o.z * (1.f + sc.z) + sh.z, t3 = o.w * (1.f + sc.w) + sh.w;
      uint2 w; w.x = pack2bf(t0, t1); w.y = pack2bf(t2, t3);
      *(uint2*)(As + rr * LDA_B + d * 2) = w;
      *(uint2*)(Tbf + (size_t)row * D + d) = w;

    }
  }
}


constexpr int S5T = 64, NCHUNK = (CTX + SEQ) / S5T  , NCC = NB * NCHUNK  ;
__device__ __forceinline__ int s5_token(int cc, int s) {
  const int b = cc / NCHUNK, ch = cc - b * NCHUNK;
  return ch < 4 ? NL + b * CTX + ch * S5T + s : b * SEQ + (ch - 4) * S5T + s;
}
__device__ __forceinline__ void cbar(volatile int* cnt, int& gen, int nwaves) {
  __builtin_amdgcn_fence(__ATOMIC_RELEASE, "workgroup");
  if ((otid() & 63) == 0) __hip_atomic_fetch_add((int*)cnt, 1, __ATOMIC_RELAXED, __HIP_MEMORY_SCOPE_WORKGROUP);
  ++gen;
  while (__hip_atomic_load((int*)cnt, __ATOMIC_RELAXED, __HIP_MEMORY_SCOPE_WORKGROUP) < gen * nwaves) __builtin_amdgcn_s_sleep(1);
  __builtin_amdgcn_fence(__ATOMIC_ACQUIRE, "workgroup");
}
__device__ __forceinline__ void ph_s5_prep(const float* __restrict__ a_re, const float* __restrict__ a_im, const float* __restrict__ log_dt,
                                                 const float* __restrict__ b_re, const float* __restrict__ b_im, const float* __restrict__ c_re, const float* __restrict__ c_im,
                                                 bf16_t* __restrict__ Ktab, bf16_t* __restrict__ Bst_t, bf16_t* __restrict__ Cin_t, int g, int part, char* lds, int tid, int nct, volatile int* cbc, int& cgen) {
  float2 (*pw)[65][64] = reinterpret_cast<float2 (*)[65][64]>(lds);
  float2 (*Bp)[64][16] = reinterpret_cast<float2 (*)[64][16]>(lds + 2 * 65 * 64 * 8);
  float2 (*Cc)[16][64] = reinterpret_cast<float2 (*)[16][64]>(lds + 2 * 65 * 64 * 8 + 2 * 64 * 16 * 8);
  if (tid < 128) {
    const int dir = tid >> 6, p = tid & 63, gp = (dir * 64 + g) * 64 + p;
    const float are = a_re[gp], aim = a_im[gp], dt = expf(log_dt[dir * 64 + g]);
    const float mag = expf(are * dt);
    const float abr = mag * cosf(aim * dt), abi = mag * sinf(aim * dt);
    const float nr = abr - 1.f, ni = abi, den = are * are + aim * aim;
    const float fr = (nr * are + ni * aim) / den, fi = (ni * are - nr * aim) / den;
    float pr = 1.f, pi = 0.f;
    for (int e = 0; e <= 64; ++e) { pw[dir][e][p] = make_float2(pr, pi); const float nr2 = pr * abr - pi * abi, ni2 = pr * abi + pi * abr; pr = nr2; pi = ni2; }
    for (int ci = 0; ci < 16; ++ci) { const float br = b_re[gp * 16 + ci], bi = b_im[gp * 16 + ci]; Bp[dir][p][ci] = make_float2(fr * br - fi * bi, fr * bi + fi * br); }
    for (int co = 0; co < 16; ++co) { const int idx = ((dir * 64 + g) * 16 + co) * 64 + p; Cc[dir][co][p] = make_float2(c_re[idx], c_im[idx]); }
  }
  cbar(cbc, cgen, nct >> 6);
  for (int i = part * 8128 + tid; i < (part + 1) * 8128; i += nct) {
    const int ti = i >> 8, co = (i >> 4) & 15, ci = i & 15, tau = ti - 63;
    float acc = 0.f;
    if (tau >= 0) { for (int p = 0; p < 64; ++p) { const float2 c = Cc[0][co][p], w = pw[0][tau][p], b = Bp[0][p][ci];
        const float xr = c.x * w.x - c.y * w.y, xi = c.x * w.y + c.y * w.x; acc += xr * b.x - xi * b.y; } }
    if (tau <= 0) { for (int p = 0; p < 64; ++p) { const float2 c = Cc[1][co][p], w = pw[1][-tau][p], b = Bp[1][p][ci];
        const float xr = c.x * w.x - c.y * w.y, xi = c.x * w.y + c.y * w.x; acc += xr * b.x - xi * b.y; } }
    Ktab[(size_t)g * 127 * 256 + i] = f2bf(acc);
  }
  for (int i = part * 8192 + tid; i < (part + 1) * 8192; i += nct) {
    const int n = i >> 7, k8 = i & 127, dir = n >> 7, c = (n >> 6) & 1, p = n & 63, sidx = k8 >> 1, ci0 = (k8 & 1) * 8;
    const float2 w = pw[dir][dir == 0 ? 63 - sidx : sidx][p];
    float v[8];
#pragma unroll
    for (int j = 0; j < 8; ++j) { const float2 b = Bp[dir][p][ci0 + j]; v[j] = c == 0 ? (w.x * b.x - w.y * b.y) : (w.x * b.y + w.y * b.x); }
    uint4 o; o.x = pack2bf(v[0], v[1]); o.y = pack2bf(v[2], v[3]); o.z = pack2bf(v[4], v[5]); o.w = pack2bf(v[6], v[7]);
    *(uint4*)(Bst_t + (size_t)g * 256 * 1024 + ((size_t)((n >> 4) * 32 + (k8 >> 2)) * 64 + (k8 & 3) * 16 + (n & 15)) * 8) = o;
  }
  for (int i = part * 8192 + tid; i < (part + 1) * 8192; i += nct) {
    const int n = i >> 5, k8 = i & 31, t = n >> 4, co = n & 15, dir = k8 >> 4, c = (k8 >> 3) & 1, p0 = (k8 & 7) * 8;
    const int e = dir == 0 ? t + 1 : 64 - t;
    float v[8];
#pragma unroll
    for (int j = 0; j < 8; ++j) { const float2 cc = Cc[dir][co][p0 + j], w = pw[dir][e][p0 + j];
      v[j] = c == 0 ? (cc.x * w.x - cc.y * w.y) : -(cc.x * w.y + cc.y * w.x); }
    uint4 o; o.x = pack2bf(v[0], v[1]); o.y = pack2bf(v[2], v[3]); o.z = pack2bf(v[4], v[5]); o.w = pack2bf(v[6], v[7]);
    *(uint4*)(Cin_t + (size_t)g * 1024 * 256 + ((size_t)((n >> 4) * 8 + (k8 >> 2)) * 64 + (k8 & 3) * 16 + (n & 15)) * 8) = o;
  }
}
__device__ __forceinline__ void ph_s5_p1(const float* __restrict__ x, const float* __restrict__ ctx, const float* __restrict__ mod,
                                               const bf16_t* __restrict__ Ktab, const bf16_t* __restrict__ Bst_t, float* __restrict__ Ypart, float* __restrict__ S, int bid, char* As) {
  const int g = bid >> 2, cc0 = (bid & 3) * 66, tid = otid();
  const int wave = tid >> 6, lane = tid & 63, l15 = lane & 15, q = lane >> 4;
#pragma unroll 4
  for (int i = tid; i < 66 * 64 * 2; i += 512) {
    const int half = i & 1, sidx = (i >> 1) & 63, r = i >> 7;
    const int tok = s5_token(cc0 + r, sidx), ch = g * 16 + half * 8;
    const float* src = (tok < NL ? x + (size_t)tok * D : ctx + (size_t)(tok - NL) * D) + ch;
    const float* m = mod + row_vec(tok) * 6144;
    const float4 a = *(const float4*)src, b = *(const float4*)(src + 4);
    const float4 sh0 = *(const float4*)(m + ch), sh1 = *(const float4*)(m + ch + 4), sc0 = *(const float4*)(m + 1024 + ch), sc1 = *(const float4*)(m + 1024 + ch + 4);
    uint4 o;
    o.x = pack2bf(a.x * (1.f + sc0.x) + sh0.x, a.y * (1.f + sc0.y) + sh0.y); o.y = pack2bf(a.z * (1.f + sc0.z) + sh0.z, a.w * (1.f + sc0.w) + sh0.w);
    o.z = pack2bf(b.x * (1.f + sc1.x) + sh1.x, b.y * (1.f + sc1.y) + sh1.y); o.w = pack2bf(b.z * (1.f + sc1.z) + sh1.z, b.w * (1.f + sc1.w) + sh1.w);
    *(uint4*)(As + r * LDA_B + sidx * 32 + half * 16) = o;
  }
  __syncthreads();
  const char* ap[5];
#pragma unroll
  for (int t = 0; t < 5; ++t) { int r = t * 16 + l15; r = r < 66 ? r : 65; ap[t] = As + r * LDA_B + q * 16; }
  const bf16_t* Kg = Ktab + (size_t)g * 127 * 256;
#pragma unroll 1
  for (int unit = wave; unit < 40; unit += 8) {
    f32x4 acc[5][2];
    if (unit < 32) {
      const int t0 = unit * 2;
      const bf16_t* w0 = Kg + (t0 + 63 - (q >> 1)) * 256 + l15 * 16 + (q & 1) * 8;
      gemm_unit<5, 1024>(ap, w0, w0 + 256, -16, acc);
#pragma unroll
      for (int t = 0; t < 5; ++t)
#pragma unroll
        for (int j = 0; j < 2; ++j)
#pragma unroll
          for (int r = 0; r < 4; ++r) {
            const int row = t * 16 + q * 4 + r;
            if (row < 66) Ypart[(size_t)s5_token(cc0 + row, t0 + j) * D + g * 16 + l15] = acc[t][j][r];
          }
    } else {
      const int n0 = (unit - 32) * 32;
      const bf16_t* w0 = Bst_t + (size_t)g * 256 * 1024 + (size_t)(n0 >> 4) * 1024 * 16 + lane * 8;
      gemm_unit<5, 1024>(ap, w0, w0 + 1024 * 16, 16, acc);
#pragma unroll
      for (int t = 0; t < 5; ++t)
#pragma unroll
        for (int j = 0; j < 2; ++j)
#pragma unroll
          for (int r = 0; r < 4; ++r) {
            const int row = t * 16 + q * 4 + r;
            if (row < 66) S[((size_t)(cc0 + row) * 64 + g) * 256 + n0 + j * 16 + l15] = acc[t][j][r];
          }
    }
  }
}
__device__ __forceinline__ void ph_s5_carry(const float* __restrict__ S, const float* __restrict__ a_re, const float* __restrict__ a_im,
                                                 const float* __restrict__ log_dt, bf16_t* __restrict__ HP, int id, int p) {
  const int dir = id & 1, g = (id >> 1) & 63, b = id >> 7;
  const int gp = (dir * 64 + g) * 64 + p;
  const float are = a_re[gp], aim = a_im[gp], dt = expf(log_dt[dir * 64 + g]);
  const float mag = expf(are * dt);
  float tr = mag * cosf(aim * dt), ti = mag * sinf(aim * dt);
#pragma unroll
  for (int i = 0; i < 6; ++i) { const float nr = tr * tr - ti * ti, ni = 2.f * tr * ti; tr = nr; ti = ni; }
  float hr = 0.f, hi = 0.f;
#pragma unroll 12
  for (int step = 0; step < NCHUNK; ++step) {
    const int c = dir == 0 ? step : (step < 4 ? 3 - step : NCHUNK - 1 - (step - 4));
    const size_t base = ((size_t)(b * NCHUNK + c) * 64 + g) * 256 + dir * 128 + p;
    HP[base] = f2bf(hr); HP[base + 64] = f2bf(hi);
    const float sr = S[base], si = S[base + 64];
    const float nr = tr * hr - ti * hi + sr, ni = tr * hi + ti * hr + si;
    hr = nr; hi = ni;
  }
}
struct EpiS5 { const float* x; const float* ctx; const float* Ypart; bf16_t* Gbf; const float* cst; int cc0; int ch;
  __device__ __forceinline__ void operator()(int row, int col, float v) const {
    const int tok = s5_token(cc0 + row, col >> 4), vi = row_vec(tok);
    const float xin = tok < NL ? x[(size_t)tok * D + ch] : ctx[(size_t)(tok - NL) * D + ch];
    const float mm = xin * (1.f + cst[1 + vi * 2]) + cst[2 + vi * 2];
    const float y = v + Ypart[(size_t)tok * D + ch] + cst[0] * mm;
    Gbf[(size_t)tok * D + ch] = f2bf(gelu_fast(y));
  } };
__device__ __forceinline__ void ph_s5_p3(const float* __restrict__ x, const float* __restrict__ ctx, const float* __restrict__ mod, const float* __restrict__ dvec,
                                               const bf16_t* __restrict__ HP, const bf16_t* __restrict__ Cin_t, const float* __restrict__ Ypart, bf16_t* __restrict__ Gbf, int bid, char* As) {
  const int g = bid >> 2, cc0 = (bid & 3) * 66, tid = otid();
  for (int i = tid; i < 66 * 32; i += 512) {
    const int r = i >> 5, c = i & 31;
    *(uint4*)(As + r * 528 + c * 16) = *(const uint4*)(HP + ((size_t)(cc0 + r) * 64 + g) * 256 + c * 8);
  }
  __syncthreads();
  float* cst = (float*)(As + 66 * 528);
  if (tid < 16) {
    const int c0 = g * 16 + tid;
    cst[tid * 8 + 0] = dvec[c0];
    cst[tid * 8 + 1] = mod[1024 + c0]; cst[tid * 8 + 2] = mod[c0];
    cst[tid * 8 + 3] = mod[6144 + 1024 + c0]; cst[tid * 8 + 4] = mod[6144 + c0];
    cst[tid * 8 + 5] = mod[2 * 6144 + 1024 + c0]; cst[tid * 8 + 6] = mod[2 * 6144 + c0];
  }
  __syncthreads();
  gemm_ldsA<5, 256>(As, 528, 66, Cin_t + (size_t)g * 1024 * 256, 1024, EpiS5{x, ctx, Ypart, Gbf, cst + (otid() & 15) * 8, cc0, g * 16 + (otid() & 15)});
}


struct ChainP {
  const bf16_t* Ain;
  const bf16_t* Wglu_t; const bf16_t* Wo_t; const bf16_t* Wq_t;
  bf16_t* Vbf; float* O; const float* Hl; const float* Hc; const float* mod; const float* lng; const float* lnb;
  float* Hout; bf16_t* Tbf; float* Q;
};
template <bool L0>
__device__ __forceinline__ void ph_chainA(const ChainP& p, int bid, char* As) {
  constexpr int NR = L0 ? 66 : 64;
  constexpr int RT = L0 ? 5 : 4;
  const int g0 = bid * NR;
  load_rows_lds(As, p.Ain + (size_t)g0 * D, NR);
  __syncthreads();
  if (L0) {
    gemm_ldsA<RT, 1024>(As, LDA_B, NR, p.Wglu_t, D, EpiGluL{As, p.Vbf + (size_t)g0 * D});
    __syncthreads();
    load_rows_lds(As, p.Vbf + (size_t)g0 * D, NR);
    __syncthreads();
  }
  gemm_ldsA<RT, 1024>(As, LDA_B, NR, p.Wo_t, D, EpiF32{p.O + (size_t)g0 * D, D});
  __syncthreads();
  ln_rows(As, g0, NR, p.Hl, p.Hc, p.O, p.mod, 2, p.lng, p.lnb, p.Hout, p.Tbf, 3, 4);
  __syncthreads();
  gemm_ldsA<RT, 1024>(As, LDA_B, NR, p.Wq_t, D, EpiF32{p.Q + (size_t)g0 * D, D});
}


constexpr int KEYS = SEQ + CTX;
struct EpiKV { bf16_t* Kn; bf16_t* Va; int g0; int pad; __device__ __forceinline__ void operator()(int row, int col, float v) const {
  const int g = g0 + row; int b, key;
  if (g < NL) { b = g >> 13; key = g & (SEQ - 1); } else { const int cidx = g - NL; b = cidx >> 8; key = SEQ + (cidx & (CTX - 1)); }
  const int head = col >> 8, j = col & 255;
  if (j < 128) Kn[((size_t)(b * 8 + head) * KEYS + key) * 128 + j] = f2bf(v);
  else Va[((size_t)(b * 8 + head) * KEYS + key) * 128 + (j - 128)] = f2bf(v);
} };
struct EpiQ { bf16_t* Qa; int g0; int pad; __device__ __forceinline__ void operator()(int row, int col, float v) const {
  const int g = g0 + row, b = g >> 13, n = g & (SEQ - 1);
  const int head = col / 192, j = col - head * 192;
  Qa[((size_t)(b * 8 + head) * SEQ + n) * 192 + j] = f2bf(v);
} };
struct ProjP { const bf16_t* Wcat_t; const bf16_t* Wuq_t; const bf16_t* Wukv_t; const float* q_norm; const float* kv_norm;
               float* PR; bf16_t* Qa; bf16_t* Kn; bf16_t* Kr; bf16_t* Va; };
__device__ __forceinline__ void ph_mla_proj(const ProjP& p, int bid, char* As) {
  const int g0 = bid * 66, wave = otid() >> 6, lane = otid() & 63;
  gemm_ldsA<5, 1024>(As, LDA_B, 66, p.Wcat_t, 704, EpiF32{p.PR + (size_t)g0 * D, D});
  __syncthreads();
  char* A1 = As; char* A2 = As + 66 * 784;
  for (int rr = wave; rr < 66; rr += 8) {
    const int g = g0 + rr;
    const float* pr = p.PR + (size_t)g * D;
    float v[6]; float ss = 0.f;
#pragma unroll
    for (int i = 0; i < 6; ++i) { v[i] = pr[i * 64 + lane]; ss += v[i] * v[i]; }
    float rn = rsqrtf(wave_sum(ss) * (1.f / 384.f) + RMS_EPS);
#pragma unroll
    for (int i = 0; i < 6; ++i) *(bf16_t*)(A1 + rr * 784 + (i * 64 + lane) * 2) = f2bf(v[i] * rn * p.q_norm[i * 64 + lane]);
    float w[4]; ss = 0.f;
#pragma unroll
    for (int i = 0; i < 4; ++i) { w[i] = pr[384 + i * 64 + lane]; ss += w[i] * w[i]; }
    rn = rsqrtf(wave_sum(ss) * (1.f / 256.f) + RMS_EPS);
#pragma unroll
    for (int i = 0; i < 4; ++i) *(bf16_t*)(A2 + rr * 528 + (i * 64 + lane) * 2) = f2bf(w[i] * rn * p.kv_norm[i * 64 + lane]);
    if (lane < 32) {
      float x1 = pr[640 + lane], x2 = pr[672 + lane];
      int b, key;
      if (g < NL) {
        b = g >> 13; key = g & (SEQ - 1);
        const int n = key, rr2 = n >> 6, cc = n & 63;
        const float inv = powf(10000.f, -(float)(lane & 15) / 16.f);
        const float ang = (lane < 16 ? (float)rr2 : (float)cc) * inv;
        const float cs = cosf(ang), sn = sinf(ang);
        const float y1 = x1 * cs - x2 * sn, y2 = x2 * cs + x1 * sn; x1 = y1; x2 = y2;
      } else { const int cidx = g - NL; b = cidx >> 8; key = SEQ + (cidx & (CTX - 1)); }
      bf16_t* kp = p.Kr + ((size_t)b * KEYS + key) * 64;
      kp[lane] = f2bf(x1); kp[32 + lane] = f2bf(x2);
    }
  }
  __syncthreads();
  int nq = NL - g0; nq = nq > 66 ? 66 : nq;
  if (nq > 0) gemm_ldsA<5, 384>(A1, 784, nq, p.Wuq_t, 1536, EpiQ{p.Qa, g0, 0});
  gemm_ldsA<5, 256>(A2, 528, 66, p.Wukv_t, 2048, EpiKV{p.Kn, p.Va, g0, 0});
  __syncthreads();
  for (int rr = wave; rr < nq; rr += 8) {
    const int g = g0 + rr, b = g >> 13, n = g & (SEQ - 1);
    if (lane < 32) {
      const float inv = powf(10000.f, -(float)(lane & 15) / 16.f);
      const float ang = (lane < 16 ? (float)(n >> 6) : (float)(n & 63)) * inv;
      const float cs = cosf(ang), sn = sinf(ang);
#pragma unroll
      for (int h = 0; h < 8; ++h) {
        bf16_t* qo = p.Qa + ((size_t)(b * 8 + h) * SEQ + n) * 192;
        const float x1 = bf2f(qo[128 + lane]), x2 = bf2f(qo[160 + lane]);
        qo[128 + lane] = f2bf(x1 * cs - x2 * sn); qo[160 + lane] = f2bf(x2 * cs + x1 * sn);
      }
    }
  }
}

namespace att {
using s16x4 = __attribute__((ext_vector_type(4))) short;
using f32x16 = __attribute__((ext_vector_type(16))) float;
using u32x4 = __attribute__((ext_vector_type(4))) unsigned;
constexpr int KVBLK = 64, KROW = 400;
constexpr float SCALE = 0.07216878364870322f;
constexpr float THR = 8.f;
constexpr int SHM_V = KVBLK * 128 * 2, SHM_K = KVBLK * KROW, QRROW = 272, SHM_QR = 256 * QRROW, SHM_ATTN = 2 * SHM_V + 2 * SHM_K + 8 * 64 * 4 + SHM_QR;
#define SBAR() __builtin_amdgcn_sched_barrier(0)
__device__ __forceinline__ int crow(int r, int hi) { return (r & 3) + 8 * (r >> 2) + 4 * hi; }
__device__ __forceinline__ unsigned cvtpk(float lo, float hi) { unsigned r; asm volatile("v_cvt_pk_bf16_f32 %0, %1, %2" : "=v"(r) : "v"(lo), "v"(hi)); return r; }
__device__ __forceinline__ void partialSM(f32x16& p0, f32x16& p1, float& m_reg, float& mn, float& alpha) {
  constexpr float C = SCALE * 1.4426950408889634f;
  float pmax = p0[0];
#pragma unroll
  for (int r = 1; r < 16; ++r) pmax = fmaxf(pmax, p0[r]);
#pragma unroll
  for (int r = 0; r < 16; ++r) pmax = fmaxf(pmax, p1[r]);
  { auto rr = __builtin_amdgcn_permlane32_swap(__float_as_uint(pmax), __float_as_uint(pmax), false, false);
    pmax = fmaxf(__uint_as_float(rr[0]), __uint_as_float(rr[1])); }
  if (__builtin_expect(__all(pmax - m_reg <= THR / SCALE), 1)) { mn = m_reg; alpha = 1.f; }
  else { mn = fmaxf(m_reg, pmax); alpha = __builtin_amdgcn_exp2f((m_reg - mn) * C); m_reg = mn; }
  const float mnC = -mn * C;
#pragma unroll
  for (int r = 0; r < 16; ++r) p0[r] = fmaf(p0[r], C, mnC);
#pragma unroll
  for (int r = 0; r < 16; ++r) p1[r] = fmaf(p1[r], C, mnC);
#pragma unroll
  for (int r = 0; r < 16; ++r) p0[r] = __builtin_amdgcn_exp2f(p0[r]);
}
__device__ __forceinline__ void finishSM(f32x16& p0, f32x16& p1, float alpha, float& l_reg, bf16x8& pa0, bf16x8& pa1, bf16x8& pa2, bf16x8& pa3) {
#pragma unroll
  for (int r = 0; r < 16; ++r) p1[r] = __builtin_amdgcn_exp2f(p1[r]);
  float ps = 0;
#pragma unroll
  for (int r = 0; r < 16; ++r) ps += p0[r];
#pragma unroll
  for (int r = 0; r < 16; ++r) ps += p1[r];
  { auto rr = __builtin_amdgcn_permlane32_swap(__float_as_uint(ps), __float_as_uint(ps), false, false);
    ps = __uint_as_float(rr[0]) + __uint_as_float(rr[1]); }
  l_reg = l_reg * alpha + ps;
#define PK4(P, BASE, OUT) do { unsigned a0 = cvtpk(P[BASE + 0], P[BASE + 1]), a1 = cvtpk(P[BASE + 2], P[BASE + 3]);   \
    unsigned b0 = cvtpk(P[BASE + 4], P[BASE + 5]), b1 = cvtpk(P[BASE + 6], P[BASE + 7]);                              \
    auto r0 = __builtin_amdgcn_permlane32_swap(a0, b0, false, false); auto r1 = __builtin_amdgcn_permlane32_swap(a1, b1, false, false); \
    u32x4 w = {r0[0], r1[0], r0[1], r1[1]}; OUT = *reinterpret_cast<bf16x8*>(&w); } while (0)
  PK4(p0, 0, pa0); PK4(p0, 8, pa1); PK4(p1, 0, pa2); PK4(p1, 8, pa3);
#undef PK4
}
__device__ __forceinline__ void qkt(f32x16& p0, f32x16& p1, const char* Ks, const bf16x8* qr, const char* qrl, int r32, int hi) {
  p0 = f32x16{}; p1 = f32x16{};
#pragma unroll
  for (int d0 = 0; d0 < 12; ++d0) { const int cb = (d0 * 16 + hi * 8) * 2;
    bf16x8 b0 = *reinterpret_cast<const bf16x8*>(Ks + r32 * KROW + cb);
    bf16x8 b1 = *reinterpret_cast<const bf16x8*>(Ks + (32 + r32) * KROW + cb);
    const bf16x8 qv = d0 < 4 ? qr[d0 < 4 ? d0 : 0] : *reinterpret_cast<const bf16x8*>(qrl + (d0 - 4) * 32);
    p0 = __builtin_amdgcn_mfma_f32_32x32x16_bf16(b0, qv, p0, 0, 0, 0);
    p1 = __builtin_amdgcn_mfma_f32_32x32x16_bf16(b1, qv, p1, 0, 0, 0); }
}
__device__ __forceinline__ int v_st(int k, int c) { const int kk = (k & ~0xC) | ((k & 4) << 1) | ((k & 8) >> 1); return ((kk >> 3) * 4 + (c >> 5)) * 512 + ((kk & 7) * 32 + (c & 31)) * 2; }
__device__ __forceinline__ int v_rd_base(int lane) { return ((lane & 3) << 3) | (((lane >> 2) & 3) << 6) | (((lane >> 4) & 1) << 5) | (((lane >> 5) & 1) << 8); }
constexpr int v_rd_off(int d0, int ks, int half) { return d0 * 512 + ks * 4096 + half * 2048; }
template <int OFF> __device__ __forceinline__ s16x4 tr_read(int vb) {
  s16x4 r; asm volatile("ds_read_b64_tr_b16 %0, %1 offset:%2" : "=&v"(r) : "v"(vb), "i"(OFF) : "memory"); return r;
}
template <int D0> __device__ __forceinline__ void pv_one(f32x16& od, int vb, bf16x8 pa0, bf16x8 pa1, bf16x8 pa2, bf16x8 pa3) {
  const s16x4 l0 = tr_read<v_rd_off(D0, 0, 0)>(vb), h0 = tr_read<v_rd_off(D0, 0, 1)>(vb), l1 = tr_read<v_rd_off(D0, 1, 0)>(vb), h1 = tr_read<v_rd_off(D0, 1, 1)>(vb);
  const s16x4 l2 = tr_read<v_rd_off(D0, 2, 0)>(vb), h2 = tr_read<v_rd_off(D0, 2, 1)>(vb), l3 = tr_read<v_rd_off(D0, 3, 0)>(vb), h3 = tr_read<v_rd_off(D0, 3, 1)>(vb);
  asm volatile("s_waitcnt lgkmcnt(0)" ::: "memory"); SBAR();
#define PK(L, H) (bf16x8){L[0], L[1], L[2], L[3], H[0], H[1], H[2], H[3]}
  od = __builtin_amdgcn_mfma_f32_32x32x16_bf16(pa0, PK(l0, h0), od, 0, 0, 0);
  od = __builtin_amdgcn_mfma_f32_32x32x16_bf16(pa1, PK(l1, h1), od, 0, 0, 0);
  od = __builtin_amdgcn_mfma_f32_32x32x16_bf16(pa2, PK(l2, h2), od, 0, 0, 0);
  od = __builtin_amdgcn_mfma_f32_32x32x16_bf16(pa3, PK(l3, h3), od, 0, 0, 0);
#undef PK
}
__device__ __forceinline__ void pv_d0(f32x16* o, int vb, bf16x8 pa0, bf16x8 pa1, bf16x8 pa2, bf16x8 pa3) {
  pv_one<0>(o[0], vb, pa0, pa1, pa2, pa3); pv_one<1>(o[1], vb, pa0, pa1, pa2, pa3); pv_one<2>(o[2], vb, pa0, pa1, pa2, pa3); pv_one<3>(o[3], vb, pa0, pa1, pa2, pa3);
}
__device__ __forceinline__ void attn_body(const bf16_t* __restrict__ Qb, const bf16_t* __restrict__ Kh, const bf16_t* __restrict__ Krb, const bf16_t* __restrict__ Vh,
                                          bf16_t* __restrict__ Ob, int nkeys, char* lds) {
  const int tid = otid(), wid = tid >> 6, lane = tid & 63, r32 = lane & 31, hi = lane >> 5;
  char* V_lds = lds; char* K_lds = lds + 2 * SHM_V;
  float* ws = (float*)(lds + 2 * SHM_V + 2 * SHM_K) + wid * 64; float* li_l = ws; float* al_l = ws + 32;
  float m_reg = -1e30f, l_reg = 0; f32x16 o[4] = {}; bf16x8 qr[4];
  const bf16_t* Qw = Qb + (size_t)(wid * 32 + r32) * 192 + hi * 8;
  char* qrl = lds + 2 * SHM_V + 2 * SHM_K + 8 * 64 * 4 + (wid * 32 + r32) * QRROW + hi * 16;
#pragma unroll
  for (int d0 = 0; d0 < 4; ++d0) qr[d0] = *reinterpret_cast<const bf16x8*>(Qw + d0 * 16);
#pragma unroll
  for (int d0 = 4; d0 < 12; ++d0) *reinterpret_cast<bf16x8*>(qrl + (d0 - 4) * 32) = *reinterpret_cast<const bf16x8*>(Qw + d0 * 16);
  const int sr = tid >> 4, sc = (tid & 15) * 8, vst0 = v_st(sr, sc), vst1 = v_st(32 + sr, sc);
  const int krw = tid >> 3, kch = tid & 7;
  const int vb0 = (int)(uintptr_t)V_lds + v_rd_base(lane);
  bf16x8 vs0, vs1, ks0, ks1, ks2;
#define SLOAD(k0) do { vs0 = *reinterpret_cast<const bf16x8*>(&Vh[(size_t)((k0) + sr) * 128 + sc]); vs1 = *reinterpret_cast<const bf16x8*>(&Vh[(size_t)((k0) + 32 + sr) * 128 + sc]); \
    const bf16_t* kp_ = &Kh[(size_t)((k0) + krw) * 128 + kch * 8]; \
    ks0 = *reinterpret_cast<const bf16x8*>(kp_); ks1 = *reinterpret_cast<const bf16x8*>(kp_ + 64); \
    ks2 = *reinterpret_cast<const bf16x8*>(&Krb[(size_t)((k0) + krw) * 64 + kch * 8]); } while (0)
#define SWRITE(b) do { *(bf16x8*)(V_lds + (b) * SHM_V + vst0) = vs0; *(bf16x8*)(V_lds + (b) * SHM_V + vst1) = vs1; \
    char* kl_ = K_lds + (b) * SHM_K + krw * KROW + kch * 16; \
    *(bf16x8*)(kl_) = ks0; *(bf16x8*)(kl_ + 128) = ks1; *(bf16x8*)(kl_ + 256) = ks2; } while (0)
#define SWAIT() asm volatile("s_waitcnt vmcnt(0)" ::: "memory")
#define RESC(a) do { if (__any((a) < 1.f)) { if (hi == 0) al_l[r32] = (a); asm volatile("s_waitcnt lgkmcnt(0)" ::: "memory"); \
    for (int d = 0; d < 4; ++d) for (int r = 0; r < 16; ++r) o[d][r] *= al_l[crow(r, hi)]; } } while (0)
  f32x16 pA0, pA1, pB0, pB1; float mnA, mnB, alA, alB; bf16x8 pa0, pa1, pa2, pa3; const int NTL = nkeys / KVBLK;
  SLOAD(0); SWAIT(); SWRITE(0); __syncthreads();
  qkt(pA0, pA1, K_lds, qr, qrl, r32, hi); partialSM(pA0, pA1, m_reg, mnA, alA);
  SLOAD(KVBLK);
  SWAIT(); SWRITE(1); __syncthreads();
  for (int j = 1; j + 1 < NTL; j += 2) {
    SBAR(); qkt(pB0, pB1, K_lds + SHM_K, qr, qrl, r32, hi);
    finishSM(pA0, pA1, alA, l_reg, pa0, pa1, pa2, pa3); SBAR();
    SLOAD((j + 1) * KVBLK); SBAR();
    pv_d0(o, vb0, pa0, pa1, pa2, pa3); partialSM(pB0, pB1, m_reg, mnB, alB);
    __syncthreads(); SWAIT(); SWRITE(0);
    RESC(alB); __syncthreads();
    SBAR(); qkt(pA0, pA1, K_lds, qr, qrl, r32, hi);
    finishSM(pB0, pB1, alB, l_reg, pa0, pa1, pa2, pa3); SBAR();
    SLOAD((j + 2) * KVBLK); SBAR();
    pv_d0(o, vb0 + SHM_V, pa0, pa1, pa2, pa3); partialSM(pA0, pA1, m_reg, mnA, alA);
    __syncthreads(); SWAIT(); SWRITE(1);
    RESC(alA); __syncthreads();
  }
  SBAR(); qkt(pB0, pB1, K_lds + SHM_K, qr, qrl, r32, hi);
  finishSM(pA0, pA1, alA, l_reg, pa0, pa1, pa2, pa3); SBAR();
  pv_d0(o, vb0, pa0, pa1, pa2, pa3); partialSM(pB0, pB1, m_reg, mnB, alB);
  __syncthreads(); RESC(alB);
  finishSM(pB0, pB1, alB, l_reg, pa0, pa1, pa2, pa3); SBAR();
  pv_d0(o, vb0 + SHM_V, pa0, pa1, pa2, pa3);
  if (hi == 0) li_l[r32] = l_reg; asm volatile("s_waitcnt lgkmcnt(0)" ::: "memory");
  float rli[16];
#pragma unroll
  for (int r = 0; r < 16; ++r) rli[r] = __builtin_amdgcn_rcpf(li_l[crow(r, hi)]);
  bf16_t* Ow = Ob + (size_t)(wid * 32) * D;
#pragma unroll
  for (int r = 0; r < 16; ++r) { const int orow = crow(r, hi);
#pragma unroll
    for (int d0 = 0; d0 < 4; ++d0) Ow[(size_t)orow * D + d0 * 32 + r32] = f2bf(o[d0][r] * rli[r]); }
  __syncthreads();
#undef SLOAD
#undef SWRITE
#undef SWAIT
#undef RESC
}
}

__device__ __forceinline__ void ph_attn(const bf16_t* __restrict__ Qa, const bf16_t* __restrict__ Kn, const bf16_t* __restrict__ Kr, const bf16_t* __restrict__ Va,
                                        bf16_t* __restrict__ AO, int bid, int nblk, char* lds) {
  for (int item = bid; item < 512; item += nblk) {
    const int b = item >> 8, h = item & 7, qb = (item >> 3) & 31;
    att::attn_body(Qa + ((size_t)(b * 8 + h) * SEQ + qb * 256) * 192, Kn + (size_t)(b * 8 + h) * KEYS * 128, Kr + (size_t)b * KEYS * 64,
                   Va + (size_t)(b * 8 + h) * KEYS * 128, AO + (size_t)(b * SEQ + qb * 256) * D + h * 128, KEYS, lds);
  }
}

namespace rt {
using f32x16 = __attribute__((ext_vector_type(16))) float;
__device__ __forceinline__ int sortable(float f) { const int b = __float_as_int(f); return b ^ ((b >> 31) & 0x7FFFFFFF); }
__device__ __forceinline__ float unsortable(int k) { return __int_as_float(k ^ ((k >> 31) & 0x7FFFFFFF)); }
__device__ __forceinline__ int imax(int a, int b) { return a > b ? a : b; }
__device__ __forceinline__ int imin(int a, int b) { return a < b ? a : b; }
template <int N> __device__ __forceinline__ void sort_desc(int (&v)[N]) {
#pragma unroll
  for (int k = 2; k <= N; k <<= 1) {
#pragma unroll
    for (int j = k >> 1; j > 0; j >>= 1) {
#pragma unroll
      for (int i = 0; i < N; ++i) {
        const int l = i ^ j;
        if (l > i) {
          const bool desc = ((i & k) == 0);
          const int a = v[i], b = v[l];
          v[i] = desc ? imax(a, b) : imin(a, b);
          v[l] = desc ? imin(a, b) : imax(a, b);
        }
      }
    }
  }
}
template <int N> __device__ __forceinline__ void merge_desc(int (&v)[N]) {
#pragma unroll
  for (int j = N >> 1; j > 0; j >>= 1) {
#pragma unroll
    for (int i = 0; i < N; ++i) {
      const int l = i ^ j;
      if (l > i) { const int a = v[i], b = v[l]; v[i] = imax(a, b); v[l] = imin(a, b); }
    }
  }
}
__device__ __forceinline__ void absorb16(int (&L)[16], int (&B)[16]) {
  sort_desc<16>(B);
#pragma unroll
  for (int i = 0; i < 16; ++i) L[i] = imax(L[i], B[15 - i]);
  merge_desc<16>(L);
}
__device__ __forceinline__ constexpr int npairs_row(int i) { return 16 / (i + 1); }
}

struct RouteP { const float* Q; const bf16_t* Khi; int* IDX; float* GATE; int rows_per_block; int pad; };
__device__ __forceinline__ void ph_route(const RouteP& p, int bid, char* lds) {
  using namespace rt;
  int (*svl)[64][33] = reinterpret_cast<int (*)[64][33]>(lds);
  const int wave = otid() >> 6, lane = otid() & 63, r32 = lane & 31, hi = lane >> 5, hi4 = hi * 4;
  int nrows = p.rows_per_block; asm volatile("" : "+s"(nrows));
  const int g0 = bid * nrows;
  const int h = wave;
#pragma unroll 1
  for (int tg = 0; tg * 32 < nrows; ++tg) {
    int trow = tg * 32 + r32; const bool valid = trow < nrows; trow = valid ? trow : nrows - 1;
    const float* qrow = p.Q + (size_t)(g0 + trow) * D;
    int sv[2][16];
#pragma unroll
    for (int s = 0; s < 2; ++s) {
      const int hs = h * 2 + s;
      f32x16 acc[4];
#pragma unroll
      for (int m = 0; m < 4; ++m) acc[m] = f32x16{};
#pragma unroll
      for (int kp = 0; kp < 2; ++kp) {
        bf16x8 kf[2][4], qf[2];
#pragma unroll
        for (int k2 = 0; k2 < 2; ++k2)
#pragma unroll
          for (int m = 0; m < 4; ++m) kf[k2][m] = *(const bf16x8*)(p.Khi + ((size_t)(hs * 128 + m * 32 + r32)) * 64 + (kp * 2 + k2) * 16 + hi * 8);
#pragma unroll
        for (int k2 = 0; k2 < 2; ++k2) {
          const int ks = kp * 2 + k2;
          const float4 qa = *(const float4*)(qrow + hs * 64 + ks * 16 + hi * 8), qb = *(const float4*)(qrow + hs * 64 + ks * 16 + hi * 8 + 4);
          uint4 qh;
          qh.x = pack2bf(qa.x, qa.y); qh.y = pack2bf(qa.z, qa.w); qh.z = pack2bf(qb.x, qb.y); qh.w = pack2bf(qb.z, qb.w);
          qf[k2] = *reinterpret_cast<const bf16x8*>(&qh);
        }
#pragma unroll
        for (int k2 = 0; k2 < 2; ++k2)
#pragma unroll
          for (int m = 0; m < 4; ++m) acc[m] = __builtin_amdgcn_mfma_f32_32x32x16_bf16(kf[k2][m], qf[k2], acc[m], 0, 0, 0);
      }
      int L[16];
#pragma unroll
      for (int m = 0; m < 4; ++m) {
        int B[16];
#pragma unroll
        for (int r = 0; r < 16; ++r) B[r] = (sortable(acc[m][r]) & ~0x7F) | (m * 32 + (r & 3) + 8 * (r >> 2)) | hi4;
        if (m == 0) { sort_desc<16>(B);
#pragma unroll
          for (int i = 0; i < 16; ++i) L[i] = B[i]; }
        else absorb16(L, B);
      }
      int Lo[16], Hi[16];
#pragma unroll
      for (int i = 0; i < 16; ++i) { auto rr = __builtin_amdgcn_permlane32_swap((unsigned)L[i], (unsigned)L[i], false, false); Lo[i] = (int)rr[0]; Hi[i] = (int)rr[1]; }
#pragma unroll
      for (int i = 0; i < 16; ++i) L[i] = imax(Lo[i], Hi[15 - i]);
      merge_desc<16>(L);
#pragma unroll
      for (int i = 0; i < 16; ++i) { sv[s][i] = L[i]; svl[wave][lane][s * 16 + i] = L[i]; }
    }
    float f0[16], f1[16];
#pragma unroll
    for (int i = 0; i < 16; ++i) { f0[i] = unsortable(sv[0][i] & ~0x7F); f1[i] = unsortable(sv[1][i] & ~0x7F); }
    int Lc[16];
    {
      int C[64];
      int n = 0;
#pragma unroll
      for (int i = 0; i < 16; ++i)
#pragma unroll
        for (int j = 0; j < 16; ++j)
          if ((i + 1) * (j + 1) <= 16) { C[n] = (sortable(f0[i] + f1[j]) & ~0xFF) | (i * 16 + j); ++n; }
#pragma unroll
      for (int k = 50; k < 64; ++k) C[k] = (int)0x80000000;
#pragma unroll
      for (int m = 0; m < 4; ++m) {
        int B[16];
#pragma unroll
        for (int r = 0; r < 16; ++r) B[r] = C[m * 16 + r];
        if (m == 0) { sort_desc<16>(B);
#pragma unroll
          for (int i = 0; i < 16; ++i) Lc[i] = B[i]; }
        else absorb16(Lc, B);
      }
    }
    float e[16]; float esum = 0.f;
    const float vmax = unsortable(Lc[0] & ~0xFF);
#pragma unroll
    for (int r = 0; r < 16; ++r) { e[r] = expf(unsortable(Lc[r] & ~0xFF) - vmax); esum += e[r]; }
    const float inv = 1.f / esum;
    int eid[16];
#pragma unroll
    for (int r = 0; r < 16; ++r) {
      const int pr = Lc[r] & 0xFF;
      const int k0 = svl[wave][lane][pr >> 4] & 0x7F, k1 = svl[wave][lane][16 + (pr & 15)] & 0x7F;
      eid[r] = k0 * 128 + k1;
    }
    if (valid && hi == 0) {
      int* ip = p.IDX + (size_t)(g0 + trow) * 128 + h * 16; float* gp = p.GATE + (size_t)(g0 + trow) * 128 + h * 16;
#pragma unroll
      for (int r = 0; r < 16; r += 4) {
        *(int4*)(ip + r) = make_int4(eid[r], eid[r + 1], eid[r + 2], eid[r + 3]);
        *(float4*)(gp + r) = make_float4(e[r] * inv, e[r + 1] * inv, e[r + 2] * inv, e[r + 3] * inv);
      }
    }
  }
}

__device__ __forceinline__ float wave_sum_dpp(float v) {
  v += __uint_as_float(__builtin_amdgcn_update_dpp(0u, __float_as_uint(v), 0xB1, 0xF, 0xF, true));
  v += __uint_as_float(__builtin_amdgcn_update_dpp(0u, __float_as_uint(v), 0x4E, 0xF, 0xF, true));
  v += __uint_as_float(__builtin_amdgcn_update_dpp(0u, __float_as_uint(v), 0x141, 0xF, 0xF, true));
  v += __uint_as_float(__builtin_amdgcn_update_dpp(0u, __float_as_uint(v), 0x140, 0xF, 0xF, true));
  v += __uint_as_float(__builtin_amdgcn_update_dpp(0u, __float_as_uint(v), 0x142, 0xA, 0xF, true));
  v += __uint_as_float(__builtin_amdgcn_update_dpp(0u, __float_as_uint(v), 0x143, 0xC, 0xF, true));
  return __uint_as_float((unsigned)__builtin_amdgcn_readlane((int)__float_as_uint(v), 63));
}
__device__ __forceinline__ void cvt_rows_i8(const float* __restrict__ src, unsigned char* __restrict__ dst, float* __restrict__ scl, int nrows, int wgid, int nw) {
  const int lane = otid() & 63;
  for (int r0 = wgid * 4; r0 < nrows; r0 += nw * 4) {
    float v[4][16];
#pragma unroll
    for (int u = 0; u < 4; ++u) {
      const float* sp = src + (size_t)(r0 + u) * D + lane * 4;
      *(float4*)&v[u][0] = *(const float4*)sp; *(float4*)&v[u][4] = *(const float4*)(sp + 256); *(float4*)&v[u][8] = *(const float4*)(sp + 512); *(float4*)&v[u][12] = *(const float4*)(sp + 768);
    }
#pragma unroll
    for (int u = 0; u < 4; ++u) {
      float am = 0.f;
#pragma unroll
      for (int j = 0; j < 16; ++j) am = fmaxf(am, fabsf(v[u][j]));
#pragma unroll
      for (int o = 32; o >= 1; o >>= 1) am = fmaxf(am, __shfl_xor(am, o));
      const float sc = am > 0.f ? am * (1.f / 127.f) : 1.f, inv = 1.f / sc;
      unsigned w[4];
#pragma unroll
      for (int q4 = 0; q4 < 4; ++q4) {
        unsigned ww = 0u;
#pragma unroll
        for (int j = 0; j < 4; ++j) { int qi = (int)rintf(v[u][q4 * 4 + j] * inv) + 128; qi = qi < 1 ? 1 : (qi > 255 ? 255 : qi); ww |= (unsigned)qi << (8 * j); }
        w[q4] = ww;
      }
      *(uint4*)(dst + (size_t)(r0 + u) * D + lane * 16) = make_uint4(w[0], w[1], w[2], w[3]);
      if (lane == 0) scl[r0 + u] = sc;
    }
  }
}

struct GatherP { const bf16_t* Tbf; const int* IDX; const float* GATE; const unsigned char* utab; const unsigned char* vtab; const float* su; const float* sv;
                 const float* Hin; const float* mod; const float* lng; const float* lnb; float* Hout; const float* modT; };
#define UB0(w) ((float)((w) & 0xFFu))
#define UB1(w) ((float)(((w) >> 8) & 0xFFu))
#define UB2(w) ((float)(((w) >> 16) & 0xFFu))
#define UB3(w) ((float)((w) >> 24))
template <bool FINAL>
__device__ __forceinline__ void ln_token(const GatherP& p, int row, int rr, int lane, const float (&f)[16], float asum, char* As) {
  const int v = row_vec(row);
  const float* hin = p.Hin + (size_t)row * D + lane * 4;
  const float* gm = p.mod + v * 6144 + 5 * 1024 + lane * 4;
  const float off = 128.f * asum;
  float r[16]; float ssum = 0.f;
#pragma unroll
  for (int q4 = 0; q4 < 4; ++q4) {
    const float4 h4 = *(const float4*)(hin + q4 * 256), g4 = *(const float4*)(gm + q4 * 256);
    r[q4 * 4 + 0] = ALPHA * h4.x + g4.x * (f[q4 * 4 + 0] - off); r[q4 * 4 + 1] = ALPHA * h4.y + g4.y * (f[q4 * 4 + 1] - off);
    r[q4 * 4 + 2] = ALPHA * h4.z + g4.z * (f[q4 * 4 + 2] - off); r[q4 * 4 + 3] = ALPHA * h4.w + g4.w * (f[q4 * 4 + 3] - off);
    ssum += r[q4 * 4 + 0] + r[q4 * 4 + 1] + r[q4 * 4 + 2] + r[q4 * 4 + 3];
  }
  const float mu = wave_sum(ssum) * (1.f / D);
  float vs = 0.f;
#pragma unroll
  for (int j = 0; j < 16; ++j) { const float dlt = r[j] - mu; vs += dlt * dlt; }
  const float rstd = rsqrtf(wave_sum(vs) * (1.f / D) + LN_EPS);
  float o[16];
#pragma unroll
  for (int q4 = 0; q4 < 4; ++q4) {
    const float4 g4 = *(const float4*)(p.lng + q4 * 256 + lane * 4), b4 = *(const float4*)(p.lnb + q4 * 256 + lane * 4);
    o[q4 * 4 + 0] = (r[q4 * 4 + 0] - mu) * rstd * g4.x + b4.x; o[q4 * 4 + 1] = (r[q4 * 4 + 1] - mu) * rstd * g4.y + b4.y;
    o[q4 * 4 + 2] = (r[q4 * 4 + 2] - mu) * rstd * g4.z + b4.z; o[q4 * 4 + 3] = (r[q4 * 4 + 3] - mu) * rstd * g4.w + b4.w;
    *(float4*)(p.Hout + (size_t)row * D + q4 * 256 + lane * 4) = make_float4(o[q4 * 4 + 0], o[q4 * 4 + 1], o[q4 * 4 + 2], o[q4 * 4 + 3]);
  }
  if (!FINAL) {
    const float* mt = p.modT + v * 6144 + lane * 4;
#pragma unroll
    for (int q4 = 0; q4 < 4; ++q4) {
      const float4 sh = *(const float4*)(mt + q4 * 256), sc = *(const float4*)(mt + 1024 + q4 * 256);
      uint2 w; w.x = pack2bf(o[q4 * 4] * (1.f + sc.x) + sh.x, o[q4 * 4 + 1] * (1.f + sc.y) + sh.y); w.y = pack2bf(o[q4 * 4 + 2] * (1.f + sc.z) + sh.z, o[q4 * 4 + 3] * (1.f + sc.w) + sh.w);
      *(uint2*)(As + rr * LDA_B + (q4 * 256 + lane * 4) * 2) = w;
    }
  }
}
constexpr int PARTW = 1088;
template <bool FINAL>
__device__ __forceinline__ void ph_gather_tm(const GatherP& p, int g0, int nrows, char* As, float* __restrict__ PART) {
  const int tid = otid(), wave = tid >> 6, lane = tid & 63;
  const int nfull = nrows >> 3, extra = nrows & 7;
  const int nun = nfull + (extra ? 1 : 0);
#pragma unroll 1
  for (int un = 0; un < nun; ++un) {
    int rr, kbeg, kcnt; bool partial;
    if (un < nfull) { rr = wave + 8 * un; kbeg = 0; kcnt = 128; partial = false; }
    else { const int wpt = 8 / extra; rr = nfull * 8 + wave / wpt; kcnt = 128 / wpt; kbeg = (wave % wpt) * kcnt; partial = true; }
    const int row = g0 + rr;
    float tf[16];
    {
      const bf16_t* tp = p.Tbf + (size_t)row * D + lane * 4;
      const uint2 t0 = *(const uint2*)tp, t1 = *(const uint2*)(tp + 256), t2 = *(const uint2*)(tp + 512), t3 = *(const uint2*)(tp + 768);
      tf[0] = bflo(t0.x); tf[1] = bfhi(t0.x); tf[2] = bflo(t0.y); tf[3] = bfhi(t0.y); tf[4] = bflo(t1.x); tf[5] = bfhi(t1.x); tf[6] = bflo(t1.y); tf[7] = bfhi(t1.y);
      tf[8] = bflo(t2.x); tf[9] = bfhi(t2.x); tf[10] = bflo(t2.y); tf[11] = bfhi(t2.y); tf[12] = bflo(t3.x); tf[13] = bfhi(t3.x); tf[14] = bflo(t3.y); tf[15] = bfhi(t3.y);
    }
    float tsum = 0.f;
#pragma unroll
    for (int j = 0; j < 16; ++j) tsum += tf[j];
    tsum = wave_sum_dpp(tsum) * 128.f;
    const int id_lo = p.IDX[(size_t)row * 128 + lane], id_hi = p.IDX[(size_t)row * 128 + 64 + lane];
    const float ga_lo = p.GATE[(size_t)row * 128 + lane], ga_hi = p.GATE[(size_t)row * 128 + 64 + lane];
    float f[16], asum = 0.f;
#pragma unroll
    for (int j = 0; j < 16; ++j) f[j] = 0.f;
    uint4 ub[8], vb[8]; float sub[8], svb[8];
#define TLOAD(slot, kk) do { const int e_ = __builtin_amdgcn_readlane((kk) < 64 ? id_lo : id_hi, (kk) & 63); \
      ub[slot] = *(const uint4*)(p.utab + (size_t)e_ * D + lane * 16); vb[slot] = *(const uint4*)(p.vtab + (size_t)e_ * D + lane * 16); \
      sub[slot] = p.su[e_]; svb[slot] = p.sv[e_]; } while (0)
#define TPROC(slot, kk) do { \
      const uint4 a_ = ub[slot]; \
      float dot_ = tf[0] * UB0(a_.x); dot_ = fmaf(tf[1], UB1(a_.x), dot_); dot_ = fmaf(tf[2], UB2(a_.x), dot_); dot_ = fmaf(tf[3], UB3(a_.x), dot_); \
      dot_ = fmaf(tf[4], UB0(a_.y), dot_); dot_ = fmaf(tf[5], UB1(a_.y), dot_); dot_ = fmaf(tf[6], UB2(a_.y), dot_); dot_ = fmaf(tf[7], UB3(a_.y), dot_); \
      dot_ = fmaf(tf[8], UB0(a_.z), dot_); dot_ = fmaf(tf[9], UB1(a_.z), dot_); dot_ = fmaf(tf[10], UB2(a_.z), dot_); dot_ = fmaf(tf[11], UB3(a_.z), dot_); \
      dot_ = fmaf(tf[12], UB0(a_.w), dot_); dot_ = fmaf(tf[13], UB1(a_.w), dot_); dot_ = fmaf(tf[14], UB2(a_.w), dot_); dot_ = fmaf(tf[15], UB3(a_.w), dot_); \
      dot_ = wave_sum_dpp(dot_); \
      const float g_ = __uint_as_float((unsigned)__builtin_amdgcn_readlane((int)__float_as_uint((kk) < 64 ? ga_lo : ga_hi), (kk) & 63)); \
      const float act_ = gelu_fast(sub[slot] * (dot_ - tsum)) * g_ * svb[slot]; \
      asum += act_; \
      const uint4 c_ = vb[slot]; \
      f[0] = fmaf(act_, UB0(c_.x), f[0]); f[1] = fmaf(act_, UB1(c_.x), f[1]); f[2] = fmaf(act_, UB2(c_.x), f[2]); f[3] = fmaf(act_, UB3(c_.x), f[3]); \
      f[4] = fmaf(act_, UB0(c_.y), f[4]); f[5] = fmaf(act_, UB1(c_.y), f[5]); f[6] = fmaf(act_, UB2(c_.y), f[6]); f[7] = fmaf(act_, UB3(c_.y), f[7]); \
      f[8] = fmaf(act_, UB0(c_.z), f[8]); f[9] = fmaf(act_, UB1(c_.z), f[9]); f[10] = fmaf(act_, UB2(c_.z), f[10]); f[11] = fmaf(act_, UB3(c_.z), f[11]); \
      f[12] = fmaf(act_, UB0(c_.w), f[12]); f[13] = fmaf(act_, UB1(c_.w), f[13]); f[14] = fmaf(act_, UB2(c_.w), f[14]); f[15] = fmaf(act_, UB3(c_.w), f[15]); } while (0)
    TLOAD(0, kbeg); TLOAD(1, kbeg + 1); TLOAD(2, kbeg + 2); TLOAD(3, kbeg + 3); TLOAD(4, kbeg + 4); TLOAD(5, kbeg + 5); TLOAD(6, kbeg + 6); TLOAD(7, kbeg + 7);
    const int kend = kbeg + kcnt - 8;
#pragma unroll 1
    for (int k = kbeg; k < kend; k += 8) {
      TPROC(0, k); TLOAD(0, k + 8); TPROC(1, k + 1); TLOAD(1, k + 9); TPROC(2, k + 2); TLOAD(2, k + 10); TPROC(3, k + 3); TLOAD(3, k + 11);
      TPROC(4, k + 4); TLOAD(4, k + 12); TPROC(5, k + 5); TLOAD(5, k + 13); TPROC(6, k + 6); TLOAD(6, k + 14); TPROC(7, k + 7); TLOAD(7, k + 15);
    }
    TPROC(0, kend); TPROC(1, kend + 1); TPROC(2, kend + 2); TPROC(3, kend + 3); TPROC(4, kend + 4); TPROC(5, kend + 5); TPROC(6, kend + 6); TPROC(7, kend + 7);
#undef TLOAD
#undef TPROC
    if (!partial) ln_token<FINAL>(p, row, rr, lane, f, asum, As);
    else {
      float* pp = PART + wave * PARTW + lane * 16;
      *(float4*)pp = make_float4(f[0], f[1], f[2], f[3]); *(float4*)(pp + 4) = make_float4(f[4], f[5], f[6], f[7]);
      *(float4*)(pp + 8) = make_float4(f[8], f[9], f[10], f[11]); *(float4*)(pp + 12) = make_float4(f[12], f[13], f[14], f[15]);
      if (lane == 0) PART[wave * PARTW + 1024] = asum;
    }
  }
  if (extra) {
    __syncthreads();
    if (wave < extra) {
      const int wpt = 8 / extra, rr = nfull * 8 + wave;
      float f[16], asum = 0.f;
#pragma unroll
      for (int j = 0; j < 16; ++j) f[j] = 0.f;
      for (int w2 = wave * wpt; w2 < wave * wpt + wpt; ++w2) {
        const float* pp = PART + w2 * PARTW + lane * 16;
#pragma unroll
        for (int q4 = 0; q4 < 4; ++q4) { const float4 x4 = *(const float4*)(pp + q4 * 4); f[q4 * 4] += x4.x; f[q4 * 4 + 1] += x4.y; f[q4 * 4 + 2] += x4.z; f[q4 * 4 + 3] += x4.w; }
        asum += PART[w2 * PARTW + 1024];
      }
      ln_token<FINAL>(p, g0 + rr, rr, lane, f, asum, As);
    }
  }
}

__device__ __forceinline__ void cvt_plain(const float* __restrict__ a, bf16_t* __restrict__ o, size_t n8, bool lo, size_t gtid, size_t gsz) {
  for (size_t i = gtid; i < n8; i += gsz) {
    float v[8];
    *(float4*)&v[0] = ((const float4*)a)[i * 2]; *(float4*)&v[4] = ((const float4*)a)[i * 2 + 1];
    if (lo) {
#pragma unroll
      for (int j = 0; j < 8; ++j) v[j] = v[j] - bf2f(f2bf(v[j]));
    }
    uint4 w; w.x = pack2bf(v[0], v[1]); w.y = pack2bf(v[2], v[3]); w.z = pack2bf(v[4], v[5]); w.w = pack2bf(v[6], v[7]);
    ((uint4*)o)[i] = w;
  }
}
__device__ __forceinline__ void cvt_t(const float* __restrict__ W, bf16_t* __restrict__ Wt, int K, int N, bool lo, size_t gtid, size_t gsz) {
  const size_t total = (size_t)N * (K / 8);
#pragma unroll 4
  for (size_t i = gtid; i < total; i += gsz) {
    const int n = (int)(i % N), k8 = (int)(i / N);
    float v[8];
#pragma unroll
    for (int j = 0; j < 8; ++j) { const float w = W[(size_t)(k8 * 8 + j) * N + n]; v[j] = lo ? w - bf2f(f2bf(w)) : w; }
    uint4 w; w.x = pack2bf(v[0], v[1]); w.y = pack2bf(v[2], v[3]); w.z = pack2bf(v[4], v[5]); w.w = pack2bf(v[6], v[7]);
    *(uint4*)(Wt + ((size_t)((n >> 4) * (K >> 5) + (k8 >> 2)) * 64 + (k8 & 3) * 16 + (n & 15)) * 8) = w;
  }
}
__device__ __forceinline__ void mod_item(const float* __restrict__ c, const float* __restrict__ c_ctx, const float* __restrict__ ada_w, const float* __restrict__ ada_b,
                                         float* __restrict__ MOD, int item, bool valid, char* lds, int tid, int nct, volatile int* cbc, int& cgen) {
  float* sc = (float*)lds;
  float* part = sc + 3072;
  const int wave = tid >> 6, lane = tid & 63, l = item / 96, cg = item % 96, nw = nct >> 6;
  if (valid) for (int i = tid; i < 3072; i += nct) { const int v = i >> 10, k = i & 1023; const float xv = v < 2 ? c[v * 1024 + k] : c_ctx[k]; sc[i] = xv / (1.f + expf(-xv)); }
  cbar(cbc, cgen, nw);
  if (valid) {
    float a0 = 0.f, a1 = 0.f, a2 = 0.f;
    const float* W = ada_w + (size_t)l * 1024 * 6144 + cg * 64 + lane;
    const int kb = wave * 171, ke = kb + 171 < 1024 ? kb + 171 : 1024;
#pragma unroll 19
    for (int k = kb; k < ke; ++k) { const float w = W[(size_t)k * 6144]; a0 += sc[k] * w; a1 += sc[1024 + k] * w; a2 += sc[2048 + k] * w; }
    part[(wave * 3 + 0) * 64 + lane] = a0; part[(wave * 3 + 1) * 64 + lane] = a1; part[(wave * 3 + 2) * 64 + lane] = a2;
  }
  cbar(cbc, cgen, nw);
  if (valid && tid < 192) {
    const int v = tid >> 6, ln = tid & 63; float sum = 0.f;
    for (int w = 0; w < nw; ++w) sum += part[(w * 3 + v) * 64 + ln];
    MOD[(l * 3 + v) * 6144 + cg * 64 + ln] = sum + ada_b[l * 6144 + cg * 64 + ln];
  }
}

__device__ __forceinline__ void gbar(unsigned* cnt, unsigned target) {
  asm volatile("s_waitcnt vmcnt(0)" ::: "memory");
  __syncthreads();
  if (otid() == 0) {
    __builtin_amdgcn_fence(__ATOMIC_RELEASE, "agent");
    asm volatile("s_waitcnt vmcnt(0)" ::: "memory");
    __hip_atomic_fetch_add(cnt, 1u, __ATOMIC_RELAXED, __HIP_MEMORY_SCOPE_AGENT);
    unsigned spins = 0;
    while (__hip_atomic_load(cnt, __ATOMIC_RELAXED, __HIP_MEMORY_SCOPE_AGENT) < target) { __builtin_amdgcn_s_sleep(2); if (++spins > (1u << 24)) break; }
    __builtin_amdgcn_fence(__ATOMIC_ACQUIRE, "agent");
    asm volatile("s_waitcnt vmcnt(0)" ::: "memory");
  }
  __syncthreads();
}

struct MP {
  const float *x, *c, *ctx, *c_ctx, *ada_w, *ada_b, *ln_g, *ln_b, *s5_a_re, *s5_a_im, *s5_log_dt, *s5_b_re, *s5_b_im, *s5_c_re, *s5_c_im, *s5_d, *s5_w_glu, *s5_w_o;
  const float *mla_w_dq, *mla_q_norm, *mla_w_uq, *mla_w_dkv, *mla_kv_norm, *mla_w_ukv, *mla_w_o, *peer_w_q, *peer_keys, *peer_u, *peer_v;
  float* out;
  float* MOD; bf16_t *Wt_glu, *Wt_o0, *Wt_q0, *Wt_o1, *Wt_q1, *Wt_cat, *Wt_uq, *Wt_ukv, *Khi, *Khi1;
  unsigned char *U0, *V0, *U1, *V1; float *SU0, *SV0, *SU1, *SV1; bf16_t *Ktab, *Bst_t, *Cin_t;
  float *Ypart, *Ssta; bf16_t *HP, *Gbf, *Vbf, *Tbf; float *OQ, *H1, *H2; int* IDX; float* GATE;
  bf16_t *Qa, *Kn, *Kr, *Va, *AObf; float* H3; bf16_t* Tbf1; unsigned* BAR; float* PART;
};
constexpr int LDS_BYTES = att::SHM_ATTN > 66 * LDA_B ? att::SHM_ATTN : 66 * LDA_B;
__global__ __launch_bounds__(512) void mega(MP p) {
  __shared__ __attribute__((aligned(16))) char lds[LDS_BYTES];
  cg::grid_group grid = cg::this_grid();
  const int nblk = gridDim.x;
  int bid = blockIdx.x;
  const size_t TD = (size_t)1024 * 16384;
  const float* mod0 = p.MOD; const float* mod1 = p.MOD + 3 * 6144;
  {
    volatile int* cbc = (volatile int*)(lds + LDS_BYTES - 16);
    if (otid() == 0) *cbc = 0;
    __syncthreads();
    const int t0 = otid();
    if (t0 < 128) {
      const size_t mt = (size_t)bid * 128 + t0, ms = (size_t)nblk * 128;
      const int mw = bid * 2 + (t0 >> 6), nmw = nblk * 2;
      cvt_t(p.s5_w_glu, p.Wt_glu, D, D, false, mt, ms);
      cvt_t(p.s5_w_o, p.Wt_o0, D, D, false, mt, ms);
      cvt_t(p.peer_w_q, p.Wt_q0, D, D, false, mt, ms);
      cvt_t(p.mla_w_o, p.Wt_o1, D, D, false, mt, ms);
      cvt_t(p.peer_w_q + (size_t)D * D, p.Wt_q1, D, D, false, mt, ms);
      cvt_t(p.mla_w_dq, p.Wt_cat, D, 384, false, mt, ms);
      cvt_t(p.mla_w_dkv, p.Wt_cat + (size_t)384 * D, D, 320, false, mt, ms);
      cvt_t(p.mla_w_uq, p.Wt_uq, 384, 1536, false, mt, ms);
      cvt_t(p.mla_w_ukv, p.Wt_ukv, 256, 2048, false, mt, ms);
      cvt_plain(p.peer_keys, p.Khi, (size_t)2 * 131072 / 8, false, mt, ms);
      cvt_rows_i8(p.peer_u, p.U0, p.SU0, 16384, mw, nmw);
      cvt_rows_i8(p.peer_v, p.V0, p.SV0, 16384, mw, nmw);
    } else {
      int cgen = 0;
      const int ct = t0 - 128;
      ph_s5_prep(p.s5_a_re, p.s5_a_im, p.s5_log_dt, p.s5_b_re, p.s5_b_im, p.s5_c_re, p.s5_c_im, p.Ktab, p.Bst_t, p.Cin_t, bid >> 2, bid & 3, lds, ct, 384, cbc, cgen);
      cbar(cbc, cgen, 6);
      mod_item(p.c, p.c_ctx, p.ada_w, p.ada_b, p.MOD, bid, bid < 192, lds, ct, 384, cbc, cgen);
      cvt_rows_i8(p.peer_u + TD, p.U1, p.SU1, 16384, bid * 6 + (ct >> 6), nblk * 6);
      cvt_rows_i8(p.peer_v + TD, p.V1, p.SV1, 16384, bid * 6 + (ct >> 6), nblk * 6);
    }
  }
  grid.sync();
  asm volatile("" : "+s"(bid));
  ph_s5_p1(p.x, p.ctx, mod0, p.Ktab, p.Bst_t, p.Ypart, p.Ssta, bid, lds);
  gbar(p.BAR, 1u * (unsigned)nblk);
  asm volatile("" : "+s"(bid));
  if (otid() < 64) ph_s5_carry(p.Ssta, p.s5_a_re, p.s5_a_im, p.s5_log_dt, p.HP, bid, otid());
  gbar(p.BAR, 2u * (unsigned)nblk);
  asm volatile("" : "+s"(bid));
  ph_s5_p3(p.x, p.ctx, mod0, p.s5_d, p.HP, p.Cin_t, p.Ypart, p.Gbf, bid, lds);
  gbar(p.BAR, 3u * (unsigned)nblk);
  asm volatile("" : "+s"(bid));
  {
    ChainP cp{p.Gbf, p.Wt_glu, p.Wt_o0, p.Wt_q0, p.Vbf, p.OQ, p.x, p.ctx, mod0, p.ln_g, p.ln_b, p.H1, p.Tbf, p.OQ};
    ph_chainA<true>(cp, bid, lds);
    __syncthreads();
    ph_route(RouteP{p.OQ, p.Khi, p.IDX, p.GATE, 66, 0}, bid, lds);
    __syncthreads();
    GatherP gp{p.Tbf, p.IDX, p.GATE, p.U0, p.V0, p.SU0, p.SV0, p.H1, mod0, p.ln_g + D, p.ln_b + D, p.H2, mod1};
    ph_gather_tm<false>(gp, bid * 66, 66, lds, p.PART + (size_t)bid * 8 * PARTW);
    __syncthreads();
    ProjP pp{p.Wt_cat, p.Wt_uq, p.Wt_ukv, p.mla_q_norm, p.mla_kv_norm, p.OQ  , p.Qa, p.Kn, p.Kr, p.Va};
    ph_mla_proj(pp, bid, lds);
  }
  gbar(p.BAR, 4u * (unsigned)nblk);
  asm volatile("" : "+s"(bid));
  ph_attn(p.Qa, p.Kn, p.Kr, p.Va, p.AObf, bid, nblk, lds);
  gbar(p.BAR, 5u * (unsigned)nblk);
  asm volatile("" : "+s"(bid));
  {
    ChainP cp{p.AObf, nullptr, p.Wt_o1, p.Wt_q1, nullptr, p.OQ, p.H2, p.H2 + (size_t)NL * D, mod1, p.ln_g + 2 * D, p.ln_b + 2 * D, p.H3, p.Tbf1, p.OQ};
    ph_chainA<false>(cp, bid, lds);
    __syncthreads();
    ph_route(RouteP{p.OQ, p.Khi1, p.IDX, p.GATE, 64, 0}, bid, lds);
    __syncthreads();
    GatherP gp{p.Tbf1, p.IDX, p.GATE, p.U1, p.V1, p.SU1, p.SV1, p.H3, mod1, p.ln_g + 3 * D, p.ln_b + 3 * D, p.out, mod1};
    ph_gather_tm<true>(gp, bid * 64, 64, lds, p.PART + (size_t)bid * 8 * PARTW);
  }
}

extern "C" void kernel_launch(void* const* d_in, const int* in_sizes, int n_in, void* d_out, int out_size, void* d_ws, size_t ws_size, hipStream_t stream) {
  MP p{};
  const float** in = (const float**)&p;
  for (int i = 0; i < 29; ++i) in[i] = (const float*)d_in[i];
  p.out = (float*)d_out;
  char* ws = (char*)d_ws; size_t off = 0;
  auto carve = [&](size_t bytes) { char* q = ws + off; off += (bytes + 255) / 256 * 256; return q; };
  const size_t TDB = (size_t)1024 * 16384 * 2, BIG = (size_t)NT * D * 4, HALF = (size_t)NT * D * 2;
  p.MOD = (float*)carve(2 * 3 * 6144 * 4);
  p.Wt_glu = (bf16_t*)carve((size_t)D * D * 2); p.Wt_o0 = (bf16_t*)carve((size_t)D * D * 2); p.Wt_q0 = (bf16_t*)carve((size_t)D * D * 2);
  p.Wt_o1 = (bf16_t*)carve((size_t)D * D * 2); p.Wt_q1 = (bf16_t*)carve((size_t)D * D * 2);
  p.Wt_cat = (bf16_t*)carve((size_t)704 * D * 2); p.Wt_uq = (bf16_t*)carve((size_t)1536 * 384 * 2); p.Wt_ukv = (bf16_t*)carve((size_t)2048 * 256 * 2);
  p.Khi = (bf16_t*)carve((size_t)2 * 131072 * 2); p.Khi1 = p.Khi + 131072;
  char* T0 = carve(TDB); p.U0 = (unsigned char*)T0; p.V0 = (unsigned char*)(T0 + TDB / 2); p.AObf = (bf16_t*)T0;
  p.SU0 = (float*)carve(16384 * 4); p.SV0 = (float*)carve(16384 * 4); p.SU1 = (float*)carve(16384 * 4); p.SV1 = (float*)carve(16384 * 4);
  const size_t KTAB_B = (size_t)64 * 127 * 256 * 2, BST_B = (size_t)64 * 256 * 1024 * 2, KN_B = (size_t)NB * 8 * KEYS * 128 * 2, KR_B = (size_t)NB * KEYS * 64 * 2;
  size_t x1 = KTAB_B + 2 * BST_B; if (x1 < 2 * KN_B + KR_B) x1 = 2 * KN_B + KR_B;
  char* X1 = carve(x1);
  p.Ktab = (bf16_t*)X1; p.Bst_t = (bf16_t*)(X1 + KTAB_B); p.Cin_t = (bf16_t*)(X1 + KTAB_B + BST_B);
  p.Kn = (bf16_t*)X1; p.Va = (bf16_t*)(X1 + KN_B); p.Kr = (bf16_t*)(X1 + 2 * KN_B); p.H3 = (float*)X1;
  char* X2 = carve(BIG); p.Ypart = (float*)X2; p.OQ = (float*)X2;
  char* X3 = carve(HALF); p.Ssta = (float*)X3; p.HP = (bf16_t*)(X3 + (size_t)NCC * 64 * 256 * 4); p.Vbf = (bf16_t*)X3;
  char* X4 = carve(HALF); p.Gbf = (bf16_t*)X4; p.Tbf = (bf16_t*)X4; p.Tbf1 = (bf16_t*)X4;
  char* X5 = carve(BIG); p.H1 = (float*)X5;
  char* T1 = carve(TDB); p.U1 = (unsigned char*)T1; p.V1 = (unsigned char*)(T1 + TDB / 2);
  p.H2 = (float*)carve(BIG);
  p.IDX = (int*)carve((size_t)NT * 128 * 4); p.GATE = (float*)carve((size_t)NT * 128 * 4);
  p.Qa = (bf16_t*)carve((size_t)NB * 8 * SEQ * 192 * 2);
  p.BAR = (unsigned*)carve(256);
  p.PART = (float*)carve((size_t)256 * 8 * PARTW * 4);
  if (off > ws_size || n_in != 29) { fprintf(stderr, "kernel_launch: workspace too small (need %zu, have %zu) or n_in %d != 29\n", off, ws_size, n_in); return; }
  static int grid_blocks = 0;
  if (!grid_blocks) {
    int dev = 0, cus = 0, per_cu = 0;
    hipGetDevice(&dev);
    hipDeviceGetAttribute(&cus, hipDeviceAttributeMultiprocessorCount, dev);
    hipOccupancyMaxActiveBlocksPerMultiprocessor(&per_cu, mega, 512, 0);
    if (per_cu < 1 || cus < 256) { fprintf(stderr, "kernel_launch: need 256 resident workgroups (cus %d, per_cu %d)\n", cus, per_cu); return; }
    grid_blocks = 256;
  }
  hipMemsetAsync(p.BAR, 0, 256, stream);
  void* args[] = {&p};
  hipError_t e = hipLaunchCooperativeKernel((void*)mega, dim3(grid_blocks), dim3(512), args, 0, stream);
  if (e != hipSuccess) fprintf(stderr, "cooperative launch failed: %s\n", hipGetErrorString(e));
}
```

```cpp
#include <hip/hip_runtime.h>
#include <math.h>
#include <hip/hip_cooperative_groups.h>
#include <cstdio>
namespace cg = cooperative_groups;
__device__ __forceinline__ int otid() { int t = (int)__builtin_amdgcn_workitem_id_x(); asm volatile("" : "+v"(t)); return t; }

constexpr int D = 1024, NB = 2, SEQ = 8192, CTX = 256;
constexpr int NL = NB * SEQ, NC = NB * CTX, NT = NL + NC;
constexpr float ALPHA = 1.4142135623730951f;
constexpr float LN_EPS = 1e-5f, RMS_EPS = 1e-6f;

__device__ __forceinline__ float wave_sum(float v) {
#pragma unroll
  for (int o = 32; o >= 1; o >>= 1) v += __shfl_xor(v, o);
  return v;
}
__device__ __forceinline__ int row_vec(int row) { return row < NL ? (row >> 13) : 2; }
__device__ __forceinline__ float gelu_exact(float x) { return 0.5f * x * (1.f + erff(x * 0.70710678118654752f)); }
__device__ __forceinline__ float gelu_fast(float x) {
  const float z = fabsf(x) * 0.70710678118654752f;
  const float t = __builtin_amdgcn_rcpf(fmaf(0.3275911f, z, 1.f));
  float pl = fmaf(1.061405429f, t, -1.453152027f); pl = fmaf(pl, t, 1.421413741f); pl = fmaf(pl, t, -0.284496736f); pl = fmaf(pl, t, 0.254829592f);
  const float e = __builtin_amdgcn_exp2f(-z * z * 1.4426950408889634f);
  const float erfa = 1.f - pl * t * e;
  const float hx = 0.5f * x;
  return hx + fabsf(hx) * erfa;
}


typedef unsigned short bf16_t;
using bf16x8 = __attribute__((ext_vector_type(8))) short;
using f32x4 = __attribute__((ext_vector_type(4))) float;
__device__ __forceinline__ bf16_t f2bf(float f) { unsigned u = __float_as_uint(f); u += 0x7FFFu + ((u >> 16) & 1u); return (bf16_t)(u >> 16); }
__device__ __forceinline__ float bf2f(bf16_t h) { return __uint_as_float(((unsigned)h) << 16); }
__device__ __forceinline__ unsigned pack2bf(float lo, float hi) { return (unsigned)f2bf(lo) | ((unsigned)f2bf(hi) << 16); }
__device__ __forceinline__ float bflo(unsigned w) { return __uint_as_float(w << 16); }
__device__ __forceinline__ float bfhi(unsigned w) { return __uint_as_float(w & 0xFFFF0000u); }


constexpr int LDA_B = 1024 * 2 + 16;
template <int RT, int K>
__device__ __forceinline__ void gemm_unit(const char* const (&ap)[RT], const bf16_t* __restrict__ w0, const bf16_t* __restrict__ w1, int kmul, f32x4 (&acc)[RT][2]) {
  constexpr int KI = K / 128, NS = 2;
#pragma unroll
  for (int t = 0; t < RT; ++t) { acc[t][0] = f32x4{0.f, 0.f, 0.f, 0.f}; acc[t][1] = f32x4{0.f, 0.f, 0.f, 0.f}; }
  bf16x8 b[NS][4][2];
#pragma unroll
  for (int st = 0; st < NS - 1; ++st) {
    if (st < KI) {
#pragma unroll
      for (int s2 = 0; s2 < 4; ++s2) { b[st][s2][0] = *(const bf16x8*)(w0 + (st * 128 + s2 * 32) * kmul); b[st][s2][1] = *(const bf16x8*)(w1 + (st * 128 + s2 * 32) * kmul); }
    }
  }
  asm volatile("" ::: "memory");
  bf16x8 an[RT];
#pragma unroll
  for (int t = 0; t < RT; ++t) an[t] = *(const bf16x8*)(ap[t]);
#pragma unroll
  for (int it = 0; it < KI; ++it) {
    if (it + NS - 1 < KI) {
#pragma unroll
      for (int s2 = 0; s2 < 4; ++s2) {
        b[(it + NS - 1) % NS][s2][0] = *(const bf16x8*)(w0 + ((it + NS - 1) * 128 + s2 * 32) * kmul);
        b[(it + NS - 1) % NS][s2][1] = *(const bf16x8*)(w1 + ((it + NS - 1) * 128 + s2 * 32) * kmul);
      }
    }
    asm volatile("" ::: "memory");
#pragma unroll
    for (int s2 = 0; s2 < 4; ++s2) {
      bf16x8 ac[RT];
#pragma unroll
      for (int t = 0; t < RT; ++t) ac[t] = an[t];
      if (it * 4 + s2 + 1 < KI * 4) {
#pragma unroll
        for (int t = 0; t < RT; ++t) an[t] = *(const bf16x8*)(ap[t] + (it * 128 + s2 * 32 + 32) * 2);
      }
#pragma unroll
      for (int t = 0; t < RT; ++t) {
        acc[t][0] = __builtin_amdgcn_mfma_f32_16x16x32_bf16(ac[t], b[it % NS][s2][0], acc[t][0], 0, 0, 0);
        acc[t][1] = __builtin_amdgcn_mfma_f32_16x16x32_bf16(ac[t], b[it % NS][s2][1], acc[t][1], 0, 0, 0);
      }
    }
  }
}
template <int RT, int K, class Epi>
__device__ __forceinline__ void gemm_ldsA(const char* As, int lda_b, int nrows, const bf16_t* __restrict__ Wt, int N, Epi epi) {
  const int wave = otid() >> 6, lane = otid() & 63, l15 = lane & 15, q = lane >> 4;
  const char* ap[RT];
#pragma unroll
  for (int t = 0; t < RT; ++t) { int r = t * 16 + l15; r = r < nrows ? r : nrows - 1; ap[t] = As + r * lda_b + q * 16; }
#pragma unroll 1
  for (int unit = wave; unit < (N >> 5); unit += 8) {
    const int n0 = unit * 32;
    const bf16_t* w0 = Wt + (size_t)(n0 >> 4) * K * 16 + lane * 8;
    f32x4 acc[RT][2];
    gemm_unit<RT, K>(ap, w0, w0 + (size_t)K * 16, 16, acc);
#pragma unroll
    for (int t = 0; t < RT; ++t)
#pragma unroll
      for (int j = 0; j < 2; ++j)
#pragma unroll
        for (int r = 0; r < 4; ++r) {
          const int row = t * 16 + q * 4 + r, col = n0 + j * 16 + l15;
          if (row < nrows) epi(row, col, acc[t][j][r]);
        }
  }
}
struct EpiF32 { float* C; int ldc; __device__ __forceinline__ void operator()(int row, int col, float v) const { C[(size_t)row * ldc + col] = v; } };
struct EpiGluL { const char* As; bf16_t* V; __device__ __forceinline__ void operator()(int row, int col, float z) const {
  const float g = bf2f(*(const bf16_t*)(As + row * LDA_B + col * 2)); V[(size_t)row * D + col] = f2bf(g / (1.f + expf(-z))); } };

__device__ __forceinline__ void load_rows_lds(char* As, const bf16_t* __restrict__ src, int nrows) {
  const int t = otid(), total = nrows * 128;
#pragma unroll
  for (int h = 0; h < 2; ++h) {
    uint4 v[9];
#pragma unroll
    for (int k = 0; k < 9; ++k) { int i = t + (h * 9 + k) * 512; i = i < total ? i : total - 1; v[k] = *(const uint4*)(src + (size_t)(i >> 7) * D + (i & 127) * 8); }
#pragma unroll
    for (int k = 0; k < 9; ++k) { const int i = t + (h * 9 + k) * 512; if (i < total) *(uint4*)(As + (i >> 7) * LDA_B + (i & 127) * 16) = v[k]; }
  }
}
__device__ __forceinline__ void ln_rows(char* As, int g0, int nrows, const float* Hl, const float* Hc, const float* __restrict__ O,
                                        const float* __restrict__ mod, int gate_i, const float* __restrict__ lng, const float* __restrict__ lnb,
                                        float* Hout, bf16_t* __restrict__ Tbf, int shift_i, int scale_i) {
  const int wave = otid() >> 6, lane = otid() & 63;
  for (int rr = wave; rr < nrows; rr += 8) {
    const int row = g0 + rr;
    const float* hin = row < NL ? Hl + (size_t)row * D : Hc + (size_t)(row - NL) * D;
    const float* f = O + (size_t)row * D;
    const float* m = mod + row_vec(row) * 6144;
    const float* gm = m + gate_i * 1024;
    float r[16]; float s = 0.f;
#pragma unroll
    for (int i = 0; i < 4; ++i) {
      const int d = i * 256 + lane * 4;
      float4 h4 = *(const float4*)(hin + d), f4 = *(const float4*)(f + d), g4 = *(const float4*)(gm + d);
      r[i * 4 + 0] = ALPHA * h4.x + g4.x * f4.x; r[i * 4 + 1] = ALPHA * h4.y + g4.y * f4.y;
      r[i * 4 + 2] = ALPHA * h4.z + g4.z * f4.z; r[i * 4 + 3] = ALPHA * h4.w + g4.w * f4.w;
      s += r[i * 4 + 0] + r[i * 4 + 1] + r[i * 4 + 2] + r[i * 4 + 3];
    }
    const float mu = wave_sum(s) * (1.f / D);
    float vs = 0.f;
#pragma unroll
    for (int i = 0; i < 16; ++i) { float dlt = r[i] - mu; vs += dlt * dlt; }
    const float rstd = rsqrtf(wave_sum(vs) * (1.f / D) + LN_EPS);
#pragma unroll
    for (int i = 0; i < 4; ++i) {
      const int d = i * 256 + lane * 4;
      float4 g4 = *(const float4*)(lng + d), b4 = *(const float4*)(lnb + d);
      float4 o;
      o.x = (r[i * 4 + 0] - mu) * rstd * g4.x + b4.x; o.y = (r[i * 4 + 1] - mu) * rstd * g4.y + b4.y;
      o.z = (r[i * 4 + 2] - mu) * rstd * g4.z + b4.z; o.w = (r[i * 4 + 3] - mu) * rstd * g4.w + b4.w;
      *(float4*)(Hout + (size_t)row * D + d) = o;
      float4 sh = *(const float4*)(m + shift_i * 1024 + d), sc = *(const float4*)(m + scale_i * 1024 + d);
      const float t0 = o.x * (1.f + sc.x) + sh.x, t1 = o.y * (1.f + sc.y) + sh.y, t2 = o.z * (1.f + sc.z) + sh.z, t3 = o.w * (1.f + sc.w) + sh.w;
      uint2 w; w.x = pack2bf(t0, t1); w.y = pack2bf(t2, t3);
      *(uint2*)(As + rr * LDA_B + d * 2) = w;
      *(uint2*)(Tbf + (size_t)row * D + d) = w;

    }
  }
}


constexpr int S5T = 64, NCHUNK = (CTX + SEQ) / S5T  , NCC = NB * NCHUNK  ;
__device__ __forceinline__ int s5_token(int cc, int s) {
  const int b = cc / NCHUNK, ch = cc - b * NCHUNK;
  return ch < 4 ? NL + b * CTX + ch * S5T + s : b * SEQ + (ch - 4) * S5T + s;
}
__device__ __forceinline__ void cbar(volatile int* cnt, int& gen, int nwaves) {
  __builtin_amdgcn_fence(__ATOMIC_RELEASE, "workgroup");
  if ((otid() & 63) == 0) __hip_atomic_fetch_add((int*)cnt, 1, __ATOMIC_RELAXED, __HIP_MEMORY_SCOPE_WORKGROUP);
  ++gen;
  while (__hip_atomic_load((int*)cnt, __ATOMIC_RELAXED, __HIP_MEMORY_SCOPE_WORKGROUP) < gen * nwaves) __builtin_amdgcn_s_sleep(1);
  __builtin_amdgcn_fence(__ATOMIC_ACQUIRE, "workgroup");
}
__device__ __forceinline__ void ph_s5_prep(const float* __restrict__ a_re, const float* __restrict__ a_im, const float* __restrict__ log_dt,
                                                 const float* __restrict__ b_re, const float* __restrict__ b_im, const float* __restrict__ c_re, const float* __restrict__ c_im,
                                                 bf16_t* __restrict__ Ktab, bf16_t* __restrict__ Bst_t, bf16_t* __restrict__ Cin_t, int g, int part, char* lds, int tid, int nct, volatile int* cbc, int& cgen) {
  float2 (*pw)[65][64] = reinterpret_cast<float2 (*)[65][64]>(lds);
  float2 (*Bp)[64][16] = reinterpret_cast<float2 (*)[64][16]>(lds + 2 * 65 * 64 * 8);
  float2 (*Cc)[16][64] = reinterpret_cast<float2 (*)[16][64]>(lds + 2 * 65 * 64 * 8 + 2 * 64 * 16 * 8);
  if (tid < 128) {
    const int dir = tid >> 6, p = tid & 63, gp = (dir * 64 + g) * 64 + p;
    const float are = a_re[gp], aim = a_im[gp], dt = expf(log_dt[dir * 64 + g]);
    const float mag = expf(are * dt);
    const float abr = mag * cosf(aim * dt), abi = mag * sinf(aim * dt);
    const float nr = abr - 1.f, ni = abi, den = are * are + aim * aim;
    const float fr = (nr * are + ni * aim) / den, fi = (ni * are - nr * aim) / den;
    float pr = 1.f, pi = 0.f;
    for (int e = 0; e <= 64; ++e) { pw[dir][e][p] = make_float2(pr, pi); const float nr2 = pr * abr - pi * abi, ni2 = pr * abi + pi * abr; pr = nr2; pi = ni2; }
    for (int ci = 0; ci < 16; ++ci) { const float br = b_re[gp * 16 + ci], bi = b_im[gp * 16 + ci]; Bp[dir][p][ci] = make_float2(fr * br - fi * bi, fr * bi + fi * br); }
    for (int co = 0; co < 16; ++co) { const int idx = ((dir * 64 + g) * 16 + co) * 64 + p; Cc[dir][co][p] = make_float2(c_re[idx], c_im[idx]); }
  }
  cbar(cbc, cgen, nct >> 6);
  for (int i = part * 8128 + tid; i < (part + 1) * 8128; i += nct) {
    const int ti = i >> 8, co = (i >> 4) & 15, ci = i & 15, tau = ti - 63;
    float acc = 0.f;
    if (tau >= 0) { for (int p = 0; p < 64; ++p) { const float2 c = Cc[0][co][p], w = pw[0][tau][p], b = Bp[0][p][ci];
        const float xr = c.x * w.x - c.y * w.y, xi = c.x * w.y + c.y * w.x; acc += xr * b.x - xi * b.y; } }
    if (tau <= 0) { for (int p = 0; p < 64; ++p) { const float2 c = Cc[1][co][p], w = pw[1][-tau][p], b = Bp[1][p][ci];
        const float xr = c.x * w.x - c.y * w.y, xi = c.x * w.y + c.y * w.x; acc += xr * b.x - xi * b.y; } }
    Ktab[(size_t)g * 127 * 256 + i] = f2bf(acc);
  }
  for (int i = part * 8192 + tid; i < (part + 1) * 8192; i += nct) {
    const int n = i >> 7, k8 = i & 127, dir = n >> 7, c = (n >> 6) & 1, p = n & 63, sidx = k8 >> 1, ci0 = (k8 & 1) * 8;
    const float2 w = pw[dir][dir == 0 ? 63 - sidx : sidx][p];
    float v[8];
#pragma unroll
    for (int j = 0; j < 8; ++j) { const float2 b = Bp[dir][p][ci0 + j]; v[j] = c == 0 ? (w.x * b.x - w.y * b.y) : (w.x * b.y + w.y * b.x); }
    uint4 o; o.x = pack2bf(v[0], v[1]); o.y = pack2bf(v[2], v[3]); o.z = pack2bf(v[4], v[5]); o.w = pack2bf(v[6], v[7]);
    *(uint4*)(Bst_t + (size_t)g * 256 * 1024 + ((size_t)((n >> 4) * 32 + (k8 >> 2)) * 64 + (k8 & 3) * 16 + (n & 15)) * 8) = o;
  }
  for (int i = part * 8192 + tid; i < (part + 1) * 8192; i += nct) {
    const int n = i >> 5, k8 = i & 31, t = n >> 4, co = n & 15, dir = k8 >> 4, c = (k8 >> 3) & 1, p0 = (k8 & 7) * 8;
    const int e = dir == 0 ? t + 1 : 64 - t;
    float v[8];
#pragma unroll
    for (int j = 0; j < 8; ++j) { const float2 cc = Cc[dir][co][p0 + j], w = pw[dir][e][p0 + j];
      v[j] = c == 0 ? (cc.x * w.x - cc.y * w.y) : -(cc.x * w.y + cc.y * w.x); }
    uint4 o; o.x = pack2bf(v[0], v[1]); o.y = pack2bf(v[2], v[3]); o.z = pack2bf(v[4], v[5]); o.w = pack2bf(v[6], v[7]);
    *(uint4*)(Cin_t + (size_t)g * 1024 * 256 + ((size_t)((n >> 4) * 8 + (k8 >> 2)) * 64 + (k8 & 3) * 16 + (n & 15)) * 8) = o;
  }
}
__device__ __forceinline__ void ph_s5_p1(const float* __restrict__ x, const float* __restrict__ ctx, const float* __restrict__ mod,
                                               const bf16_t* __restrict__ Ktab, const bf16_t* __restrict__ Bst_t, float* __restrict__ Ypart, float* __restrict__ S, int bid, char* As) {
  const int g = bid >> 2, cc0 = (bid & 3) * 66, tid = otid();
  const int wave = tid >> 6, lane = tid & 63, l15 = lane & 15, q = lane >> 4;
#pragma unroll 4
  for (int i = tid; i < 66 * 64 * 2; i += 512) {
    const int half = i & 1, sidx = (i >> 1) & 63, r = i >> 7;
    const int tok = s5_token(cc0 + r, sidx), ch = g * 16 + half * 8;
    const float* src = (tok < NL ? x + (size_t)tok * D : ctx + (size_t)(tok - NL) * D) + ch;
    const float* m = mod + row_vec(tok) * 6144;
    const float4 a = *(const float4*)src, b = *(const float4*)(src + 4);
    const float4 sh0 = *(const float4*)(m + ch), sh1 = *(const float4*)(m + ch + 4), sc0 = *(const float4*)(m + 1024 + ch), sc1 = *(const float4*)(m + 1024 + ch + 4);
    uint4 o;
    o.x = pack2bf(a.x * (1.f + sc0.x) + sh0.x, a.y * (1.f + sc0.y) + sh0.y); o.y = pack2bf(a.z * (1.f + sc0.z) + sh0.z, a.w * (1.f + sc0.w) + sh0.w);
    o.z = pack2bf(b.x * (1.f + sc1.x) + sh1.x, b.y * (1.f + sc1.y) + sh1.y); o.w = pack2bf(b.z * (1.f + sc1.z) + sh1.z, b.w * (1.f + sc1.w) + sh1.w);
    *(uint4*)(As + r * LDA_B + sidx * 32 + half * 16) = o;
  }
  __syncthreads();
  const char* ap[5];
#pragma unroll
  for (int t = 0; t < 5; ++t) { int r = t * 16 + l15; r = r < 66 ? r : 65; ap[t] = As + r * LDA_B + q * 16; }
  const bf16_t* Kg = Ktab + (size_t)g * 127 * 256;
#pragma unroll 1
  for (int unit = wave; unit < 40; unit += 8) {
    f32x4 acc[5][2];
    if (unit < 32) {
      const int t0 = unit * 2;
      const bf16_t* w0 = Kg + (t0 + 63 - (q >> 1)) * 256 + l15 * 16 + (q & 1) * 8;
      gemm_unit<5, 1024>(ap, w0, w0 + 256, -16, acc);
#pragma unroll
      for (int t = 0; t < 5; ++t)
#pragma unroll
        for (int j = 0; j < 2; ++j)
#pragma unroll
          for (int r = 0; r < 4; ++r) {
            const int row = t * 16 + q * 4 + r;
            if (row < 66) Ypart[(size_t)s5_token(cc0 + row, t0 + j) * D + g * 16 + l15] = acc[t][j][r];
          }
    } else {
      const int n0 = (unit - 32) * 32;
      const bf16_t* w0 = Bst_t + (size_t)g * 256 * 1024 + (size_t)(n0 >> 4) * 1024 * 16 + lane * 8;
      gemm_unit<5, 1024>(ap, w0, w0 + 1024 * 16, 16, acc);
#pragma unroll
      for (int t = 0; t < 5; ++t)
#pragma unroll
        for (int j = 0; j < 2; ++j)
#pragma unroll
          for (int r = 0; r < 4; ++r) {
            const int row = t * 16 + q * 4 + r;
            if (row < 66) S[((size_t)(cc0 + row) * 64 + g) * 256 + n0 + j * 16 + l15] = acc[t][j][r];
          }
    }
  }
}
__device__ __forceinline__ void ph_s5_carry(const float* __restrict__ S, const float* __restrict__ a_re, const float* __restrict__ a_im,
                                                 const float* __restrict__ log_dt, bf16_t* __restrict__ HP, int id, int p) {
  const int dir = id & 1, g = (id >> 1) & 63, b = id >> 7;
  const int gp = (dir * 64 + g) * 64 + p;
  const float are = a_re[gp], aim = a_im[gp], dt = expf(log_dt[dir * 64 + g]);
  const float mag = expf(are * dt);
  float tr = mag * cosf(aim * dt), ti = mag * sinf(aim * dt);
#pragma unroll
  for (int i = 0; i < 6; ++i) { const float nr = tr * tr - ti * ti, ni = 2.f * tr * ti; tr = nr; ti = ni; }
  float hr = 0.f, hi = 0.f;
#pragma unroll 12
  for (int step = 0; step < NCHUNK; ++step) {
    const int c = dir == 0 ? step : (step < 4 ? 3 - step : NCHUNK - 1 - (step - 4));
    const size_t base = ((size_t)(b * NCHUNK + c) * 64 + g) * 256 + dir * 128 + p;
    HP[base] = f2bf(hr); HP[base + 64] = f2bf(hi);
    const float sr = S[base], si = S[base + 64];
    const float nr = tr * hr - ti * hi + sr, ni = tr * hi + ti * hr + si;
    hr = nr; hi = ni;
  }
}
struct EpiS5 { const float* x; const float* ctx; const float* Ypart; bf16_t* Gbf; const float* cst; int cc0; int ch;
  __device__ __forceinline__ void operator()(int row, int col, float v) const {
    const int tok = s5_token(cc0 + row, col >> 4), vi = row_vec(tok);
    const float xin = tok < NL ? x[(size_t)tok * D + ch] : ctx[(size_t)(tok - NL) * D + ch];
    const float mm = xin * (1.f + cst[1 + vi * 2]) + cst[2 + vi * 2];
    const float y = v + Ypart[(size_t)tok * D + ch] + cst[0] * mm;
    Gbf[(size_t)tok * D + ch] = f2bf(gelu_fast(y));
  } };
__device__ __forceinline__ void ph_s5_p3(const float* __restrict__ x, const float* __restrict__ ctx, const float* __restrict__ mod, const float* __restrict__ dvec,
                                               const bf16_t* __restrict__ HP, const bf16_t* __restrict__ Cin_t, const float* __restrict__ Ypart, bf16_t* __restrict__ Gbf, int bid, char* As) {
  const int g = bid >> 2, cc0 = (bid & 3) * 66, tid = otid();
  for (int i = tid; i < 66 * 32; i += 512) {
    const int r = i >> 5, c = i & 31;
    *(uint4*)(As + r * 528 + c * 16) = *(const uint4*)(HP + ((size_t)(cc0 + r) * 64 + g) * 256 + c * 8);
  }
  __syncthreads();
  float* cst = (float*)(As + 66 * 528);
  if (tid < 16) {
    const int c0 = g * 16 + tid;
    cst[tid * 8 + 0] = dvec[c0];
    cst[tid * 8 + 1] = mod[1024 + c0]; cst[tid * 8 + 2] = mod[c0];
    cst[tid * 8 + 3] = mod[6144 + 1024 + c0]; cst[tid * 8 + 4] = mod[6144 + c0];
    cst[tid * 8 + 5] = mod[2 * 6144 + 1024 + c0]; cst[tid * 8 + 6] = mod[2 * 6144 + c0];
  }
  __syncthreads();
  gemm_ldsA<5, 256>(As, 528, 66, Cin_t + (size_t)g * 1024 * 256, 1024, EpiS5{x, ctx, Ypart, Gbf, cst + (otid() & 15) * 8, cc0, g * 16 + (otid() & 15)});
}


struct ChainP {
  const bf16_t* Ain;
  const bf16_t* Wglu_t; const bf16_t* Wo_t; const bf16_t* Wq_t;
  bf16_t* Vbf; float* O; const float* Hl; const float* Hc; const float* mod; const float* lng; const float* lnb;
  float* Hout; bf16_t* Tbf; float* Q;
};
template <bool L0>
__device__ __forceinline__ void ph_chainA(const ChainP& p, int bid, char* As) {
  constexpr int NR = L0 ? 66 : 64;
  constexpr int RT = L0 ? 5 : 4;
  const int g0 = bid * NR;
  load_rows_lds(As, p.Ain + (size_t)g0 * D, NR);
  __syncthreads();
  if (L0) {
    gemm_ldsA<RT, 1024>(As, LDA_B, NR, p.Wglu_t, D, EpiGluL{As, p.Vbf + (size_t)g0 * D});
    __syncthreads();
    load_rows_lds(As, p.Vbf + (size_t)g0 * D, NR);
    __syncthreads();
  }
  gemm_ldsA<RT, 1024>(As, LDA_B, NR, p.Wo_t, D, EpiF32{p.O + (size_t)g0 * D, D});
  __syncthreads();
  ln_rows(As, g0, NR, p.Hl, p.Hc, p.O, p.mod, 2, p.lng, p.lnb, p.Hout, p.Tbf, 3, 4);
  __syncthreads();
  gemm_ldsA<RT, 1024>(As, LDA_B, NR, p.Wq_t, D, EpiF32{p.Q + (size_t)g0 * D, D});
}


constexpr int KEYS = SEQ + CTX;
struct EpiKV { bf16_t* Kn; bf16_t* Va; int g0; int pad; __device__ __forceinline__ void operator()(int row, int col, float v) const {
  const int g = g0 + row; int b, key;
  if (g < NL) { b = g >> 13; key = g & (SEQ - 1); } else { const int cidx = g - NL; b = cidx >> 8; key = SEQ + (cidx & (CTX - 1)); }
  const int head = col >> 8, j = col & 255;
  if (j < 128) Kn[((size_t)(b * 8 + head) * KEYS + key) * 128 + j] = f2bf(v);
  else Va[((size_t)(b * 8 + head) * KEYS + key) * 128 + (j - 128)] = f2bf(v);
} };
struct EpiQ { bf16_t* Qa; int g0; int pad; __device__ __forceinline__ void operator()(int row, int col, float v) const {
  const int g = g0 + row, b = g >> 13, n = g & (SEQ - 1);
  const int head = col / 192, j = col - head * 192;
  Qa[((size_t)(b * 8 + head) * SEQ + n) * 192 + j] = f2bf(v);
} };
struct ProjP { const bf16_t* Wcat_t; const bf16_t* Wuq_t; const bf16_t* Wukv_t; const float* q_norm; const float* kv_norm;
               float* PR; bf16_t* Qa; bf16_t* Kn; bf16_t* Kr; bf16_t* Va; };
__device__ __forceinline__ void ph_mla_proj(const ProjP& p, int bid, char* As) {
  const int g0 = bid * 66, wave = otid() >> 6, lane = otid() & 63;
  gemm_ldsA<5, 1024>(As, LDA_B, 66, p.Wcat_t, 704, EpiF32{p.PR + (size_t)g0 * D, D});
  __syncthreads();
  char* A1 = As; char* A2 = As + 66 * 784;
  for (int rr = wave; rr < 66; rr += 8) {
    const int g = g0 + rr;
    const float* pr = p.PR + (size_t)g * D;
    float v[6]; float ss = 0.f;
#pragma unroll
    for (int i = 0; i < 6; ++i) { v[i] = pr[i * 64 + lane]; ss += v[i] * v[i]; }
    float rn = rsqrtf(wave_sum(ss) * (1.f / 384.f) + RMS_EPS);
#pragma unroll
    for (int i = 0; i < 6; ++i) *(bf16_t*)(A1 + rr * 784 + (i * 64 + lane) * 2) = f2bf(v[i] * rn * p.q_norm[i * 64 + lane]);
    float w[4]; ss = 0.f;
#pragma unroll
    for (int i = 0; i < 4; ++i) { w[i] = pr[384 + i * 64 + lane]; ss += w[i] * w[i]; }
    rn = rsqrtf(wave_sum(ss) * (1.f / 256.f) + RMS_EPS);
#pragma unroll
    for (int i = 0; i < 4; ++i) *(bf16_t*)(A2 + rr * 528 + (i * 64 + lane) * 2) = f2bf(w[i] * rn * p.kv_norm[i * 64 + lane]);
    if (lane < 32) {
      float x1 = pr[640 + lane], x2 = pr[672 + lane];
      int b, key;
      if (g < NL) {
        b = g >> 13; key = g & (SEQ - 1);
        const int n = key, rr2 = n >> 6, cc = n & 63;
        const float inv = powf(10000.f, -(float)(lane & 15) / 16.f);
        const float ang = (lane < 16 ? (float)rr2 : (float)cc) * inv;
        const float cs = cosf(ang), sn = sinf(ang);
        const float y1 = x1 * cs - x2 * sn, y2 = x2 * cs + x1 * sn; x1 = y1; x2 = y2;
      } else { const int cidx = g - NL; b = cidx >> 8; key = SEQ + (cidx & (CTX - 1)); }
      bf16_t* kp = p.Kr + ((size_t)b * KEYS + key) * 64;
      kp[lane] = f2bf(x1); kp[32 + lane] = f2bf(x2);
    }
  }
  __syncthreads();
  int nq = NL - g0; nq = nq > 66 ? 66 : nq;
  if (nq > 0) gemm_ldsA<5, 384>(A1, 784, nq, p.Wuq_t, 1536, EpiQ{p.Qa, g0, 0});
  gemm_ldsA<5, 256>(A2, 528, 66, p.Wukv_t, 2048, EpiKV{p.Kn, p.Va, g0, 0});
  __syncthreads();
  for (int rr = wave; rr < nq; rr += 8) {
    const int g = g0 + rr, b = g >> 13, n = g & (SEQ - 1);
    if (lane < 32) {
      const float inv = powf(10000.f, -(float)(lane & 15) / 16.f);
      const float ang = (lane < 16 ? (float)(n >> 6) : (float)(n & 63)) * inv;
      const float cs = cosf(ang), sn = sinf(ang);
#pragma unroll
      for (int h = 0; h < 8; ++h) {
        bf16_t* qo = p.Qa + ((size_t)(b * 8 + h) * SEQ + n) * 192;
        const float x1 = bf2f(qo[128 + lane]), x2 = bf2f(qo[160 + lane]);
        qo[128 + lane] = f2bf(x1 * cs - x2 * sn); qo[160 + lane] = f2bf(x2 * cs + x1 * sn);
      }
    }
  }
}

namespace att {
using s16x4 = __attribute__((ext_vector_type(4))) short;
using f32x16 = __attribute__((ext_vector_type(16))) float;
using u32x4 = __attribute__((ext_vector_type(4))) unsigned;
constexpr int KVBLK = 64, KROW = 400;
constexpr float SCALE = 0.07216878364870322f;
constexpr float THR = 8.f;
constexpr int SHM_V = KVBLK * 128 * 2, SHM_K = KVBLK * KROW, QRROW = 272, SHM_QR = 256 * QRROW, SHM_ATTN = 2 * SHM_V + 2 * SHM_K + 8 * 64 * 4 + SHM_QR;
#define SBAR() __builtin_amdgcn_sched_barrier(0)
__device__ __forceinline__ int crow(int r, int hi) { return (r & 3) + 8 * (r >> 2) + 4 * hi; }
__device__ __forceinline__ unsigned cvtpk(float lo, float hi) { unsigned r; asm volatile("v_cvt_pk_bf16_f32 %0, %1, %2" : "=v"(r) : "v"(lo), "v"(hi)); return r; }
__device__ __forceinline__ void partialSM(f32x16& p0, f32x16& p1, float& m_reg, float& mn, float& alpha) {
  constexpr float C = SCALE * 1.4426950408889634f;
  float pmax = p0[0];
#pragma unroll
  for (int r = 1; r < 16; ++r) pmax = fmaxf(pmax, p0[r]);
#pragma unroll
  for (int r = 0; r < 16; ++r) pmax = fmaxf(pmax, p1[r]);
  { auto rr = __builtin_amdgcn_permlane32_swap(__float_as_uint(pmax), __float_as_uint(pmax), false, false);
    pmax = fmaxf(__uint_as_float(rr[0]), __uint_as_float(rr[1])); }
  if (__builtin_expect(__all(pmax - m_reg <= THR / SCALE), 1)) { mn = m_reg; alpha = 1.f; }
  else { mn = fmaxf(m_reg, pmax); alpha = __builtin_amdgcn_exp2f((m_reg - mn) * C); m_reg = mn; }
  const float mnC = -mn * C;
#pragma unroll
  for (int r = 0; r < 16; ++r) p0[r] = fmaf(p0[r], C, mnC);
#pragma unroll
  for (int r = 0; r < 16; ++r) p1[r] = fmaf(p1[r], C, mnC);
#pragma unroll
  for (int r = 0; r < 16; ++r) p0[r] = __builtin_amdgcn_exp2f(p0[r]);
}
__device__ __forceinline__ void finishSM(f32x16& p0, f32x16& p1, float alpha, float& l_reg, bf16x8& pa0, bf16x8& pa1, bf16x8& pa2, bf16x8& pa3) {
#pragma unroll
  for (int r = 0; r < 16; ++r) p1[r] = __builtin_amdgcn_exp2f(p1[r]);
  float ps = 0;
#pragma unroll
  for (int r = 0; r < 16; ++r) ps += p0[r];
#pragma unroll
  for (int r = 0; r < 16; ++r) ps += p1[r];
  { auto rr = __builtin_amdgcn_permlane32_swap(__float_as_uint(ps), __float_as_uint(ps), false, false);
    ps = __uint_as_float(rr[0]) + __uint_as_float(rr[1]); }
  l_reg = l_reg * alpha + ps;
#define PK4(P, BASE, OUT) do { unsigned a0 = cvtpk(P[BASE + 0], P[BASE + 1]), a1 = cvtpk(P[BASE + 2], P[BASE + 3]);   \
    unsigned b0 = cvtpk(P[BASE + 4], P[BASE + 5]), b1 = cvtpk(P[BASE + 6], P[BASE + 7]);                              \
    auto r0 = __builtin_amdgcn_permlane32_swap(a0, b0, false, false); auto r1 = __builtin_amdgcn_permlane32_swap(a1, b1, false, false); \
    u32x4 w = {r0[0], r1[0], r0[1], r1[1]}; OUT = *reinterpret_cast<bf16x8*>(&w); } while (0)
  PK4(p0, 0, pa0); PK4(p0, 8, pa1); PK4(p1, 0, pa2); PK4(p1, 8, pa3);
#undef PK4
}
__device__ __forceinline__ void qkt(f32x16& p0, f32x16& p1, const char* Ks, const bf16x8* qr, const char* qrl, int r32, int hi) {
  p0 = f32x16{}; p1 = f32x16{};
#pragma unroll
  for (int d0 = 0; d0 < 12; ++d0) { const int cb = (d0 * 16 + hi * 8) * 2;
    bf16x8 b0 = *reinterpret_cast<const bf16x8*>(Ks + r32 * KROW + cb);
    bf16x8 b1 = *reinterpret_cast<const bf16x8*>(Ks + (32 + r32) * KROW + cb);
    const bf16x8 qv = d0 < 4 ? qr[d0 < 4 ? d0 : 0] : *reinterpret_cast<const bf16x8*>(qrl + (d0 - 4) * 32);
    p0 = __builtin_amdgcn_mfma_f32_32x32x16_bf16(b0, qv, p0, 0, 0, 0);
    p1 = __builtin_amdgcn_mfma_f32_32x32x16_bf16(b1, qv, p1, 0, 0, 0); }
}
__device__ __forceinline__ int v_st(int k, int c) { const int kk = (k & ~0xC) | ((k & 4) << 1) | ((k & 8) >> 1); return ((kk >> 3) * 4 + (c >> 5)) * 512 + ((kk & 7) * 32 + (c & 31)) * 2; }
__device__ __forceinline__ int v_rd_base(int lane) { return ((lane & 3) << 3) | (((lane >> 2) & 3) << 6) | (((lane >> 4) & 1) << 5) | (((lane >> 5) & 1) << 8); }
constexpr int v_rd_off(int d0, int ks, int half) { return d0 * 512 + ks * 4096 + half * 2048; }
template <int OFF> __device__ __forceinline__ s16x4 tr_read(int vb) {
  s16x4 r; asm volatile("ds_read_b64_tr_b16 %0, %1 offset:%2" : "=&v"(r) : "v"(vb), "i"(OFF) : "memory"); return r;
}
template <int D0> __device__ __forceinline__ void pv_one(f32x16& od, int vb, bf16x8 pa0, bf16x8 pa1, bf16x8 pa2, bf16x8 pa3) {
  const s16x4 l0 = tr_read<v_rd_off(D0, 0, 0)>(vb), h0 = tr_read<v_rd_off(D0, 0, 1)>(vb), l1 = tr_read<v_rd_off(D0, 1, 0)>(vb), h1 = tr_read<v_rd_off(D0, 1, 1)>(vb);
  const s16x4 l2 = tr_read<v_rd_off(D0, 2, 0)>(vb), h2 = tr_read<v_rd_off(D0, 2, 1)>(vb), l3 = tr_read<v_rd_off(D0, 3, 0)>(vb), h3 = tr_read<v_rd_off(D0, 3, 1)>(vb);
  asm volatile("s_waitcnt lgkmcnt(0)" ::: "memory"); SBAR();
#define PK(L, H) (bf16x8){L[0], L[1], L[2], L[3], H[0], H[1], H[2], H[3]}
  od = __builtin_amdgcn_mfma_f32_32x32x16_bf16(pa0, PK(l0, h0), od, 0, 0, 0);
  od = __builtin_amdgcn_mfma_f32_32x32x16_bf16(pa1, PK(l1, h1), od, 0, 0, 0);
  od = __builtin_amdgcn_mfma_f32_32x32x16_bf16(pa2, PK(l2, h2), od, 0, 0, 0);
  od = __builtin_amdgcn_mfma_f32_32x32x16_bf16(pa3, PK(l3, h3), od, 0, 0, 0);
#undef PK
}
__device__ __forceinline__ void pv_d0(f32x16* o, int vb, bf16x8 pa0, bf16x8 pa1, bf16x8 pa2, bf16x8 pa3) {
  pv_one<0>(o[0], vb, pa0, pa1, pa2, pa3); pv_one<1>(o[1], vb, pa0, pa1, pa2, pa3); pv_one<2>(o[2], vb, pa0, pa1, pa2, pa3); pv_one<3>(o[3], vb, pa0, pa1, pa2, pa3);
}
__device__ __forceinline__ void attn_body(const bf16_t* __restrict__ Qb, const bf16_t* __restrict__ Kh, const bf16_t* __restrict__ Krb, const bf16_t* __restrict__ Vh,
                                          bf16_t* __restrict__ Ob, int nkeys, char* lds) {
  const int tid = otid(), wid = tid >> 6, lane = tid & 63, r32 = lane & 31, hi = lane >> 5;
  char* V_lds = lds; char* K_lds = lds + 2 * SHM_V;
  float* ws = (float*)(lds + 2 * SHM_V + 2 * SHM_K) + wid * 64; float* li_l = ws; float* al_l = ws + 32;
  float m_reg = -1e30f, l_reg = 0; f32x16 o[4] = {}; bf16x8 qr[4];
  const bf16_t* Qw = Qb + (size_t)(wid * 32 + r32) * 192 + hi * 8;
  char* qrl = lds + 2 * SHM_V + 2 * SHM_K + 8 * 64 * 4 + (wid * 32 + r32) * QRROW + hi * 16;
#pragma unroll
  for (int d0 = 0; d0 < 4; ++d0) qr[d0] = *reinterpret_cast<const bf16x8*>(Qw + d0 * 16);
#pragma unroll
  for (int d0 = 4; d0 < 12; ++d0) *reinterpret_cast<bf16x8*>(qrl + (d0 - 4) * 32) = *reinterpret_cast<const bf16x8*>(Qw + d0 * 16);
  const int sr = tid >> 4, sc = (tid & 15) * 8, vst0 = v_st(sr, sc), vst1 = v_st(32 + sr, sc);
  const int krw = tid >> 3, kch = tid & 7;
  const int vb0 = (int)(uintptr_t)V_lds + v_rd_base(lane);
  bf16x8 vs0, vs1, ks0, ks1, ks2;
#define SLOAD(k0) do { vs0 = *reinterpret_cast<const bf16x8*>(&Vh[(size_t)((k0) + sr) * 128 + sc]); vs1 = *reinterpret_cast<const bf16x8*>(&Vh[(size_t)((k0) + 32 + sr) * 128 + sc]); \
    const bf16_t* kp_ = &Kh[(size_t)((k0) + krw) * 128 + kch * 8]; \
    ks0 = *reinterpret_cast<const bf16x8*>(kp_); ks1 = *reinterpret_cast<const bf16x8*>(kp_ + 64); \
    ks2 = *reinterpret_cast<const bf16x8*>(&Krb[(size_t)((k0) + krw) * 64 + kch * 8]); } while (0)
#define SWRITE(b) do { *(bf16x8*)(V_lds + (b) * SHM_V + vst0) = vs0; *(bf16x8*)(V_lds + (b) * SHM_V + vst1) = vs1; \
    char* kl_ = K_lds + (b) * SHM_K + krw * KROW + kch * 16; \
    *(bf16x8*)(kl_) = ks0; *(bf16x8*)(kl_ + 128) = ks1; *(bf16x8*)(kl_ + 256) = ks2; } while (0)
#define SWAIT() asm volatile("s_waitcnt vmcnt(0)" ::: "memory")
#define RESC(a) do { if (__any((a) < 1.f)) { if (hi == 0) al_l[r32] = (a); asm volatile("s_waitcnt lgkmcnt(0)" ::: "memory"); \
    for (int d = 0; d < 4; ++d) for (int r = 0; r < 16; ++r) o[d][r] *= al_l[crow(r, hi)]; } } while (0)
  f32x16 pA0, pA1, pB0, pB1; float mnA, mnB, alA, alB; bf16x8 pa0, pa1, pa2, pa3; const int NTL = nkeys / KVBLK;
  SLOAD(0); SWAIT(); SWRITE(0); __syncthreads();
  qkt(pA0, pA1, K_lds, qr, qrl, r32, hi); partialSM(pA0, pA1, m_reg, mnA, alA);
  SLOAD(KVBLK);
  SWAIT(); SWRITE(1); __syncthreads();
  for (int j = 1; j + 1 < NTL; j += 2) {
    SBAR(); qkt(pB0, pB1, K_lds + SHM_K, qr, qrl, r32, hi);
    finishSM(pA0, pA1, alA, l_reg, pa0, pa1, pa2, pa3); SBAR();
    SLOAD((j + 1) * KVBLK); SBAR();
    pv_d0(o, vb0, pa0, pa1, pa2, pa3); partialSM(pB0, pB1, m_reg, mnB, alB);
    __syncthreads(); SWAIT(); SWRITE(0);
    RESC(alB); __syncthreads();
    SBAR(); qkt(pA0, pA1, K_lds, qr, qrl, r32, hi);
    finishSM(pB0, pB1, alB, l_reg, pa0, pa1, pa2, pa3); SBAR();
    SLOAD((j + 2) * KVBLK); SBAR();
    pv_d0(o, vb0 + SHM_V, pa0, pa1, pa2, pa3); partialSM(pA0, pA1, m_reg, mnA, alA);
    __syncthreads(); SWAIT(); SWRITE(1);
    RESC(alA); __syncthreads();
  }
  SBAR(); qkt(pB0, pB1, K_lds + SHM_K, qr, qrl, r32, hi);
  finishSM(pA0, pA1, alA, l_reg, pa0, pa1, pa2, pa3); SBAR();
  pv_d0(o, vb0, pa0, pa1, pa2, pa3); partialSM(pB0, pB1, m_reg, mnB, alB);
  __syncthreads(); RESC(alB);
  finishSM(pB0, pB1, alB, l_reg, pa0, pa1, pa2, pa3); SBAR();
  pv_d0(o, vb0 + SHM_V, pa0, pa1, pa2, pa3);
  if (hi == 0) li_l[r32] = l_reg; asm volatile("s_waitcnt lgkmcnt(0)" ::: "memory");
  float rli[16];
#pragma unroll
  for (int r = 0; r < 16; ++r) rli[r] = __builtin_amdgcn_rcpf(li_l[crow(r, hi)]);
  bf16_t* Ow = Ob + (size_t)(wid * 32) * D;
#pragma unroll
  for (int r = 0; r < 16; ++r) { const int orow = crow(r, hi);
#pragma unroll
    for (int d0 = 0; d0 < 4; ++d0) Ow[(size_t)orow * D + d0 * 32 + r32] = f2bf(o[d0][r] * rli[r]); }
  __syncthreads();
#undef SLOAD
#undef SWRITE
#undef SWAIT
#undef RESC
}
}

__device__ __forceinline__ void ph_attn(const bf16_t* __restrict__ Qa, const bf16_t* __restrict__ Kn, const bf16_t* __restrict__ Kr, const bf16_t* __restrict__ Va,
                                        bf16_t* __restrict__ AO, int bid, int nblk, char* lds) {
  for (int item = bid; item < 512; item += nblk) {
    const int b = item >> 8, h = item & 7, qb = (item >> 3) & 31;
    att::attn_body(Qa + ((size_t)(b * 8 + h) * SEQ + qb * 256) * 192, Kn + (size_t)(b * 8 + h) * KEYS * 128, Kr + (size_t)b * KEYS * 64,
                   Va + (size_t)(b * 8 + h) * KEYS * 128, AO + (size_t)(b * SEQ + qb * 256) * D + h * 128, KEYS, lds);
  }
}

namespace rt {
using f32x16 = __attribute__((ext_vector_type(16))) float;
__device__ __forceinline__ int sortable(float f) { const int b = __float_as_int(f); return b ^ ((b >> 31) & 0x7FFFFFFF); }
__device__ __forceinline__ float unsortable(int k) { return __int_as_float(k ^ ((k >> 31) & 0x7FFFFFFF)); }
__device__ __forceinline__ int imax(int a, int b) { return a > b ? a : b; }
__device__ __forceinline__ int imin(int a, int b) { return a < b ? a : b; }
template <int N> __device__ __forceinline__ void sort_desc(int (&v)[N]) {
#pragma unroll
  for (int k = 2; k <= N; k <<= 1) {
#pragma unroll
    for (int j = k >> 1; j > 0; j >>= 1) {
#pragma unroll
      for (int i = 0; i < N; ++i) {
        const int l = i ^ j;
        if (l > i) {
          const bool desc = ((i & k) == 0);
          const int a = v[i], b = v[l];
          v[i] = desc ? imax(a, b) : imin(a, b);
          v[l] = desc ? imin(a, b) : imax(a, b);
        }
      }
    }
  }
}
template <int N> __device__ __forceinline__ void merge_desc(int (&v)[N]) {
#pragma unroll
  for (int j = N >> 1; j > 0; j >>= 1) {
#pragma unroll
    for (int i = 0; i < N; ++i) {
      const int l = i ^ j;
      if (l > i) { const int a = v[i], b = v[l]; v[i] = imax(a, b); v[l] = imin(a, b); }
    }
  }
}
__device__ __forceinline__ void absorb16(int (&L)[16], int (&B)[16]) {
  sort_desc<16>(B);
#pragma unroll
  for (int i = 0; i < 16; ++i) L[i] = imax(L[i], B[15 - i]);
  merge_desc<16>(L);
}
__device__ __forceinline__ constexpr int npairs_row(int i) { return 16 / (i + 1); }
}

struct RouteP { const float* Q; const bf16_t* Khi; int* IDX; float* GATE; int rows_per_block; int pad; };
__device__ __forceinline__ void ph_route(const RouteP& p, int bid, char* lds) {
  using namespace rt;
  int (*svl)[64][33] = reinterpret_cast<int (*)[64][33]>(lds);
  const int wave = otid() >> 6, lane = otid() & 63, r32 = lane & 31, hi = lane >> 5, hi4 = hi * 4;
  int nrows = p.rows_per_block; asm volatile("" : "+s"(nrows));
  const int g0 = bid * nrows;
  const int h = wave;
#pragma unroll 1
  for (int tg = 0; tg * 32 < nrows; ++tg) {
    int trow = tg * 32 + r32; const bool valid = trow < nrows; trow = valid ? trow : nrows - 1;
    const float* qrow = p.Q + (size_t)(g0 + trow) * D;
    int sv[2][16];
#pragma unroll
    for (int s = 0; s < 2; ++s) {
      const int hs = h * 2 + s;
      f32x16 acc[4];
#pragma unroll
      for (int m = 0; m < 4; ++m) acc[m] = f32x16{};
#pragma unroll
      for (int kp = 0; kp < 2; ++kp) {
        bf16x8 kf[2][4], qf[2];
#pragma unroll
        for (int k2 = 0; k2 < 2; ++k2)
#pragma unroll
          for (int m = 0; m < 4; ++m) kf[k2][m] = *(const bf16x8*)(p.Khi + ((size_t)(hs * 128 + m * 32 + r32)) * 64 + (kp * 2 + k2) * 16 + hi * 8);
#pragma unroll
        for (int k2 = 0; k2 < 2; ++k2) {
          const int ks = kp * 2 + k2;
          const float4 qa = *(const float4*)(qrow + hs * 64 + ks * 16 + hi * 8), qb = *(const float4*)(qrow + hs * 64 + ks * 16 + hi * 8 + 4);
          uint4 qh;
          qh.x = pack2bf(qa.x, qa.y); qh.y = pack2bf(qa.z, qa.w); qh.z = pack2bf(qb.x, qb.y); qh.w = pack2bf(qb.z, qb.w);
          qf[k2] = *reinterpret_cast<const bf16x8*>(&qh);
        }
#pragma unroll
        for (int k2 = 0; k2 < 2; ++k2)
#pragma unroll
          for (int m = 0; m < 4; ++m) acc[m] = __builtin_amdgcn_mfma_f32_32x32x16_bf16(kf[k2][m], qf[k2], acc[m], 0, 0, 0);
      }
      int L[16];
#pragma unroll
      for (int m = 0; m < 4; ++m) {
        int B[16];
#pragma unroll
        for (int r = 0; r < 16; ++r) B[r] = (sortable(acc[m][r]) & ~0x7F) | (m * 32 + (r & 3) + 8 * (r >> 2)) | hi4;
        if (m == 0) { sort_desc<16>(B);
#pragma unroll
          for (int i = 0; i < 16; ++i) L[i] = B[i]; }
        else absorb16(L, B);
      }
      int Lo[16], Hi[16];
#pragma unroll
      for (int i = 0; i < 16; ++i) { auto rr = __builtin_amdgcn_permlane32_swap((unsigned)L[i], (unsigned)L[i], false, false); Lo[i] = (int)rr[0]; Hi[i] = (int)rr[1]; }
#pragma unroll
      for (int i = 0; i < 16; ++i) L[i] = imax(Lo[i], Hi[15 - i]);
      merge_desc<16>(L);
#pragma unroll
      for (int i = 0; i < 16; ++i) { sv[s][i] = L[i]; svl[wave][lane][s * 16 + i] = L[i]; }
    }
    float f0[16], f1[16];
#pragma unroll
    for (int i = 0; i < 16; ++i) { f0[i] = unsortable(sv[0][i] & ~0x7F); f1[i] = unsortable(sv[1][i] & ~0x7F); }
    int Lc[16];
    {
      int C[64];
      int n = 0;
#pragma unroll
      for (int i = 0; i < 16; ++i)
#pragma unroll
        for (int j = 0; j < 16; ++j)
          if ((i + 1) * (j + 1) <= 16) { C[n] = (sortable(f0[i] + f1[j]) & ~0xFF) | (i * 16 + j); ++n; }
#pragma unroll
      for (int k = 50; k < 64; ++k) C[k] = (int)0x80000000;
#pragma unroll
      for (int m = 0; m < 4; ++m) {
        int B[16];
#pragma unroll
        for (int r = 0; r < 16; ++r) B[r] = C[m * 16 + r];
        if (m == 0) { sort_desc<16>(B);
#pragma unroll
          for (int i = 0; i < 16; ++i) Lc[i] = B[i]; }
        else absorb16(Lc, B);
      }
    }
    float e[16]; float esum = 0.f;
    const float vmax = unsortable(Lc[0] & ~0xFF);
#pragma unroll
    for (int r = 0; r < 16; ++r) { e[r] = expf(unsortable(Lc[r] & ~0xFF) - vmax); esum += e[r]; }
    const float inv = 1.f / esum;
    int eid[16];
#pragma unroll
    for (int r = 0; r < 16; ++r) {
      const int pr = Lc[r] & 0xFF;
      const int k0 = svl[wave][lane][pr >> 4] & 0x7F, k1 = svl[wave][lane][16 + (pr & 15)] & 0x7F;
      eid[r] = k0 * 128 + k1;
    }
    if (valid && hi == 0) {
      int* ip = p.IDX + (size_t)(g0 + trow) * 128 + h * 16; float* gp = p.GATE + (size_t)(g0 + trow) * 128 + h * 16;
#pragma unroll
      for (int r = 0; r < 16; r += 4) {
        *(int4*)(ip + r) = make_int4(eid[r], eid[r + 1], eid[r + 2], eid[r + 3]);
        *(float4*)(gp + r) = make_float4(e[r] * inv, e[r + 1] * inv, e[r + 2] * inv, e[r + 3] * inv);
      }
    }
  }
}

__device__ __forceinline__ float wave_sum_dpp(float v) {
  v += __uint_as_float(__builtin_amdgcn_update_dpp(0u, __float_as_uint(v), 0xB1, 0xF, 0xF, true));
  v += __uint_as_float(__builtin_amdgcn_update_dpp(0u, __float_as_uint(v), 0x4E, 0xF, 0xF, true));
  v += __uint_as_float(__builtin_amdgcn_update_dpp(0u, __float_as_uint(v), 0x141, 0xF, 0xF, true));
  v += __uint_as_float(__builtin_amdgcn_update_dpp(0u, __float_as_uint(v), 0x140, 0xF, 0xF, true));
  v += __uint_as_float(__builtin_amdgcn_update_dpp(0u, __float_as_uint(v), 0x142, 0xA, 0xF, true));
  v += __uint_as_float(__builtin_amdgcn_update_dpp(0u, __float_as_uint(v), 0x143, 0xC, 0xF, true));
  return __uint_as_float((unsigned)__builtin_amdgcn_readlane((int)__float_as_uint(v), 63));
}
__device__ __forceinline__ void cvt_rows_i8(const float* __restrict__ src, unsigned char* __restrict__ dst, float* __restrict__ scl, int nrows, int wgid, int nw) {
  const int lane = otid() & 63;
  for (int r0 = wgid * 4; r0 < nrows; r0 += nw * 4) {
    float v[4][16];
#pragma unroll
    for (int u = 0; u < 4; ++u) {
      const float* sp = src + (size_t)(r0 + u) * D + lane * 4;
      *(float4*)&v[u][0] = *(const float4*)sp; *(float4*)&v[u][4] = *(const float4*)(sp + 256); *(float4*)&v[u][8] = *(const float4*)(sp + 512); *(float4*)&v[u][12] = *(const float4*)(sp + 768);
    }
#pragma unroll
    for (int u = 0; u < 4; ++u) {
      float am = 0.f;
#pragma unroll
      for (int j = 0; j < 16; ++j) am = fmaxf(am, fabsf(v[u][j]));
#pragma unroll
      for (int o = 32; o >= 1; o >>= 1) am = fmaxf(am, __shfl_xor(am, o));
      const float sc = am > 0.f ? am * (1.f / 127.f) : 1.f, inv = 1.f / sc;
      unsigned w[4];
#pragma unroll
      for (int q4 = 0; q4 < 4; ++q4) {
        unsigned ww = 0u;
#pragma unroll
        for (int j = 0; j < 4; ++j) { int qi = (int)rintf(v[u][q4 * 4 + j] * inv) + 128; qi = qi < 1 ? 1 : (qi > 255 ? 255 : qi); ww |= (unsigned)qi << (8 * j); }
        w[q4] = ww;
      }
      *(uint4*)(dst + (size_t)(r0 + u) * D + lane * 16) = make_uint4(w[0], w[1], w[2], w[3]);
      if (lane == 0) scl[r0 + u] = sc;
    }
  }
}

struct GatherP { const bf16_t* Tbf; const int* IDX; const float* GATE; const unsigned char* utab; const unsigned char* vtab; const float* su; const float* sv;
                 const float* Hin; const float* mod; const float* lng; const float* lnb; float* Hout; const float* modT; };
#define UB0(w) ((float)((w) & 0xFFu))
#define UB1(w) ((float)(((w) >> 8) & 0xFFu))
#define UB2(w) ((float)(((w) >> 16) & 0xFFu))
#define UB3(w) ((float)((w) >> 24))
template <bool FINAL>
__device__ __forceinline__ void ln_token(const GatherP& p, int row, int rr, int lane, const float (&f)[16], float asum, char* As) {
  const int v = row_vec(row);
  const float* hin = p.Hin + (size_t)row * D + lane * 4;
  const float* gm = p.mod + v * 6144 + 5 * 1024 + lane * 4;
  const float off = 128.f * asum;
  float r[16]; float ssum = 0.f;
#pragma unroll
  for (int q4 = 0; q4 < 4; ++q4) {
    const float4 h4 = *(const float4*)(hin + q4 * 256), g4 = *(const float4*)(gm + q4 * 256);
    r[q4 * 4 + 0] = ALPHA * h4.x + g4.x * (f[q4 * 4 + 0] - off); r[q4 * 4 + 1] = ALPHA * h4.y + g4.y * (f[q4 * 4 + 1] - off);
    r[q4 * 4 + 2] = ALPHA * h4.z + g4.z * (f[q4 * 4 + 2] - off); r[q4 * 4 + 3] = ALPHA * h4.w + g4.w * (f[q4 * 4 + 3] - off);
    ssum += r[q4 * 4 + 0] + r[q4 * 4 + 1] + r[q4 * 4 + 2] + r[q4 * 4 + 3];
  }
  const float mu = wave_sum(ssum) * (1.f / D);
  float vs = 0.f;
#pragma unroll
  for (int j = 0; j < 16; ++j) { const float dlt = r[j] - mu; vs += dlt * dlt; }
  const float rstd = rsqrtf(wave_sum(vs) * (1.f / D) + LN_EPS);
  float o[16];
#pragma unroll
  for (int q4 = 0; q4 < 4; ++q4) {
    const float4 g4 = *(const float4*)(p.lng + q4 * 256 + lane * 4), b4 = *(const float4*)(p.lnb + q4 * 256 + lane * 4);
    o[q4 * 4 + 0] = (r[q4 * 4 + 0] - mu) * rstd * g4.x + b4.x; o[q4 * 4 + 1] = (r[q4 * 4 + 1] - mu) * rstd * g4.y + b4.y;
    o[q4 * 4 + 2] = (r[q4 * 4 + 2] - mu) * rstd * g4.z + b4.z; o[q4 * 4 + 3] = (r[q4 * 4 + 3] - mu) * rstd * g4.w + b4.w;
    *(float4*)(p.Hout + (size_t)row * D + q4 * 256 + lane * 4) = make_float4(o[q4 * 4 + 0], o[q4 * 4 + 1], o[q4 * 4 + 2], o[q4 * 4 + 3]);
  }
  if (!FINAL) {
    const float* mt = p.modT + v * 6144 + lane * 4;
#pragma unroll
    for (int q4 = 0; q4 < 4; ++q4) {
      const float4 sh = *(const float4*)(mt + q4 * 256), sc = *(const float4*)(mt + 1024 + q4 * 256);
      uint2 w; w.x = pack2bf(o[q4 * 4] * (1.f + sc.x) + sh.x, o[q4 * 4 + 1] * (1.f + sc.y) + sh.y); w.y = pack2bf(o[q4 * 4 + 2] * (1.f + sc.z) + sh.z, o[q4 * 4 + 3] * (1.f + sc.w) + sh.w);
      *(uint2*)(As + rr * LDA_B + (q4 * 256 + lane * 4) * 2) = w;
    }
  }
}
constexpr int PARTW = 1088;
template <bool FINAL>
__device__ __forceinline__ void ph_gather_tm(const GatherP& p, int g0, int nrows, char* As, float* __restrict__ PART) {
  const int tid = otid(), wave = tid >> 6, lane = tid & 63;
  const int nfull = nrows >> 3, extra = nrows & 7;
  const int nun = nfull + (extra ? 1 : 0);
#pragma unroll 1
  for (int un = 0; un < nun; ++un) {
    int rr, kbeg, kcnt; bool partial;
    if (un < nfull) { rr = wave + 8 * un; kbeg = 0; kcnt = 128; partial = false; }
    else { const int wpt = 8 / extra; rr = nfull * 8 + wave / wpt; kcnt = 128 / wpt; kbeg = (wave % wpt) * kcnt; partial = true; }
    const int row = g0 + rr;
    float tf[16];
    {
      const bf16_t* tp = p.Tbf + (size_t)row * D + lane * 4;
      const uint2 t0 = *(const uint2*)tp, t1 = *(const uint2*)(tp + 256), t2 = *(const uint2*)(tp + 512), t3 = *(const uint2*)(tp + 768);
      tf[0] = bflo(t0.x); tf[1] = bfhi(t0.x); tf[2] = bflo(t0.y); tf[3] = bfhi(t0.y); tf[4] = bflo(t1.x); tf[5] = bfhi(t1.x); tf[6] = bflo(t1.y); tf[7] = bfhi(t1.y);
      tf[8] = bflo(t2.x); tf[9] = bfhi(t2.x); tf[10] = bflo(t2.y); tf[11] = bfhi(t2.y); tf[12] = bflo(t3.x); tf[13] = bfhi(t3.x); tf[14] = bflo(t3.y); tf[15] = bfhi(t3.y);
    }
    float tsum = 0.f;
#pragma unroll
    for (int j = 0; j < 16; ++j) tsum += tf[j];
    tsum = wave_sum_dpp(tsum) * 128.f;
    const int id_lo = p.IDX[(size_t)row * 128 + lane], id_hi = p.IDX[(size_t)row * 128 + 64 + lane];
    const float ga_lo = p.GATE[(size_t)row * 128 + lane], ga_hi = p.GATE[(size_t)row * 128 + 64 + lane];
    float f[16], asum = 0.f;
#pragma unroll
    for (int j = 0; j < 16; ++j) f[j] = 0.f;
    uint4 ub[8], vb[8]; float sub[8], svb[8];
#define TLOAD(slot, kk) do { const int e_ = __builtin_amdgcn_readlane((kk) < 64 ? id_lo : id_hi, (kk) & 63); \
      ub[slot] = *(const uint4*)(p.utab + (size_t)e_ * D + lane * 16); vb[slot] = *(const uint4*)(p.vtab + (size_t)e_ * D + lane * 16); \
      sub[slot] = p.su[e_]; svb[slot] = p.sv[e_]; } while (0)
    auto proc4 = [&](int s0, int k0) {
      float dot[4];
#pragma unroll
      for (int u = 0; u < 4; ++u) {
        const uint4 a_ = ub[s0 + u];
        float d = tf[0] * UB0(a_.x); d = fmaf(tf[1], UB1(a_.x), d); d = fmaf(tf[2], UB2(a_.x), d); d = fmaf(tf[3], UB3(a_.x), d);
        d = fmaf(tf[4], UB0(a_.y), d); d = fmaf(tf[5], UB1(a_.y), d); d = fmaf(tf[6], UB2(a_.y), d); d = fmaf(tf[7], UB3(a_.y), d);
        d = fmaf(tf[8], UB0(a_.z), d); d = fmaf(tf[9], UB1(a_.z), d); d = fmaf(tf[10], UB2(a_.z), d); d = fmaf(tf[11], UB3(a_.z), d);
        d = fmaf(tf[12], UB0(a_.w), d); d = fmaf(tf[13], UB1(a_.w), d); d = fmaf(tf[14], UB2(a_.w), d); d = fmaf(tf[15], UB3(a_.w), d);
        dot[u] = d;
      }
#define DPPSTEP(ctl, rm) do { _Pragma("unroll") for (int u = 0; u < 4; ++u) dot[u] += __uint_as_float(__builtin_amdgcn_update_dpp(0u, __float_as_uint(dot[u]), ctl, rm, 0xF, true)); } while (0)
      DPPSTEP(0xB1, 0xF); DPPSTEP(0x4E, 0xF); DPPSTEP(0x141, 0xF); DPPSTEP(0x140, 0xF); DPPSTEP(0x142, 0xA); DPPSTEP(0x143, 0xC);
#undef DPPSTEP
      float act[4];
#pragma unroll
      for (int u = 0; u < 4; ++u) {
        const int kk = k0 + u;
        const float tot = __uint_as_float((unsigned)__builtin_amdgcn_readlane((int)__float_as_uint(dot[u]), 63));
        const float g_ = __uint_as_float((unsigned)__builtin_amdgcn_readlane((int)__float_as_uint(kk < 64 ? ga_lo : ga_hi), kk & 63));
        act[u] = gelu_fast(sub[s0 + u] * (tot - tsum)) * g_ * svb[s0 + u];
      }
#pragma unroll
      for (int u = 0; u < 4; ++u) {
        const float act_ = act[u];
        asum += act_;
        const uint4 c_ = vb[s0 + u];
        f[0] = fmaf(act_, UB0(c_.x), f[0]); f[1] = fmaf(act_, UB1(c_.x), f[1]); f[2] = fmaf(act_, UB2(c_.x), f[2]); f[3] = fmaf(act_, UB3(c_.x), f[3]);
        f[4] = fmaf(act_, UB0(c_.y), f[4]); f[5] = fmaf(act_, UB1(c_.y), f[5]); f[6] = fmaf(act_, UB2(c_.y), f[6]); f[7] = fmaf(act_, UB3(c_.y), f[7]);
        f[8] = fmaf(act_, UB0(c_.z), f[8]); f[9] = fmaf(act_, UB1(c_.z), f[9]); f[10] = fmaf(act_, UB2(c_.z), f[10]); f[11] = fmaf(act_, UB3(c_.z), f[11]);
        f[12] = fmaf(act_, UB0(c_.w), f[12]); f[13] = fmaf(act_, UB1(c_.w), f[13]); f[14] = fmaf(act_, UB2(c_.w), f[14]); f[15] = fmaf(act_, UB3(c_.w), f[15]);
      }
    };
    TLOAD(0, kbeg); TLOAD(1, kbeg + 1); TLOAD(2, kbeg + 2); TLOAD(3, kbeg + 3); TLOAD(4, kbeg + 4); TLOAD(5, kbeg + 5); TLOAD(6, kbeg + 6); TLOAD(7, kbeg + 7);
    const int kend = kbeg + kcnt - 8;
#pragma unroll 1
    for (int k = kbeg; k < kend; k += 8) {
      proc4(0, k); TLOAD(0, k + 8); TLOAD(1, k + 9); TLOAD(2, k + 10); TLOAD(3, k + 11);
      proc4(4, k + 4); TLOAD(4, k + 12); TLOAD(5, k + 13); TLOAD(6, k + 14); TLOAD(7, k + 15);
    }
    proc4(0, kend); proc4(4, kend + 4);
#undef TLOAD
    if (!partial) ln_token<FINAL>(p, row, rr, lane, f, asum, As);
    else {
      float* pp = PART + wave * PARTW + lane * 16;
      *(float4*)pp = make_float4(f[0], f[1], f[2], f[3]); *(float4*)(pp + 4) = make_float4(f[4], f[5], f[6], f[7]);
      *(float4*)(pp + 8) = make_float4(f[8], f[9], f[10], f[11]); *(float4*)(pp + 12) = make_float4(f[12], f[13], f[14], f[15]);
      if (lane == 0) PART[wave * PARTW + 1024] = asum;
    }
  }
  if (extra) {
    __syncthreads();
    if (wave < extra) {
      const int wpt = 8 / extra, rr = nfull * 8 + wave;
      float f[16], asum = 0.f;
#pragma unroll
      for (int j = 0; j < 16; ++j) f[j] = 0.f;
      for (int w2 = wave * wpt; w2 < wave * wpt + wpt; ++w2) {
        const float* pp = PART + w2 * PARTW + lane * 16;
#pragma unroll
        for (int q4 = 0; q4 < 4; ++q4) { const float4 x4 = *(const float4*)(pp + q4 * 4); f[q4 * 4] += x4.x; f[q4 * 4 + 1] += x4.y; f[q4 * 4 + 2] += x4.z; f[q4 * 4 + 3] += x4.w; }
        asum += PART[w2 * PARTW + 1024];
      }
      ln_token<FINAL>(p, g0 + rr, rr, lane, f, asum, As);
    }
  }
}

__device__ __forceinline__ void cvt_plain(const float* __restrict__ a, bf16_t* __restrict__ o, size_t n8, bool lo, size_t gtid, size_t gsz) {
  for (size_t i = gtid; i < n8; i += gsz) {
    float v[8];
    *(float4*)&v[0] = ((const float4*)a)[i * 2]; *(float4*)&v[4] = ((const float4*)a)[i * 2 + 1];
    if (lo) {
#pragma unroll
      for (int j = 0; j < 8; ++j) v[j] = v[j] - bf2f(f2bf(v[j]));
    }
    uint4 w; w.x = pack2bf(v[0], v[1]); w.y = pack2bf(v[2], v[3]); w.z = pack2bf(v[4], v[5]); w.w = pack2bf(v[6], v[7]);
    ((uint4*)o)[i] = w;
  }
}
__device__ __forceinline__ void cvt_t(const float* __restrict__ W, bf16_t* __restrict__ Wt, int K, int N, bool lo, size_t gtid, size_t gsz) {
  const size_t total = (size_t)N * (K / 8);
#pragma unroll 4
  for (size_t i = gtid; i < total; i += gsz) {
    const int n = (int)(i % N), k8 = (int)(i / N);
    float v[8];
#pragma unroll
    for (int j = 0; j < 8; ++j) { const float w = W[(size_t)(k8 * 8 + j) * N + n]; v[j] = lo ? w - bf2f(f2bf(w)) : w; }
    uint4 w; w.x = pack2bf(v[0], v[1]); w.y = pack2bf(v[2], v[3]); w.z = pack2bf(v[4], v[5]); w.w = pack2bf(v[6], v[7]);
    *(uint4*)(Wt + ((size_t)((n >> 4) * (K >> 5) + (k8 >> 2)) * 64 + (k8 & 3) * 16 + (n & 15)) * 8) = w;
  }
}
__device__ __forceinline__ void mod_item(const float* __restrict__ c, const float* __restrict__ c_ctx, const float* __restrict__ ada_w, const float* __restrict__ ada_b,
                                         float* __restrict__ MOD, int item, bool valid, char* lds, int tid, int nct, volatile int* cbc, int& cgen) {
  float* sc = (float*)lds;
  float* part = sc + 3072;
  const int wave = tid >> 6, lane = tid & 63, l = item / 96, cg = item % 96, nw = nct >> 6;
  if (valid) for (int i = tid; i < 3072; i += nct) { const int v = i >> 10, k = i & 1023; const float xv = v < 2 ? c[v * 1024 + k] : c_ctx[k]; sc[i] = xv / (1.f + expf(-xv)); }
  cbar(cbc, cgen, nw);
  if (valid) {
    float a0 = 0.f, a1 = 0.f, a2 = 0.f;
    const float* W = ada_w + (size_t)l * 1024 * 6144 + cg * 64 + lane;
    const int kb = wave * 171, ke = kb + 171 < 1024 ? kb + 171 : 1024;
#pragma unroll 19
    for (int k = kb; k < ke; ++k) { const float w = W[(size_t)k * 6144]; a0 += sc[k] * w; a1 += sc[1024 + k] * w; a2 += sc[2048 + k] * w; }
    part[(wave * 3 + 0) * 64 + lane] = a0; part[(wave * 3 + 1) * 64 + lane] = a1; part[(wave * 3 + 2) * 64 + lane] = a2;
  }
  cbar(cbc, cgen, nw);
  if (valid && tid < 192) {
    const int v = tid >> 6, ln = tid & 63; float sum = 0.f;
    for (int w = 0; w < nw; ++w) sum += part[(w * 3 + v) * 64 + ln];
    MOD[(l * 3 + v) * 6144 + cg * 64 + ln] = sum + ada_b[l * 6144 + cg * 64 + ln];
  }
}

__device__ __forceinline__ void gbar(unsigned* cnt, unsigned target) {
  asm volatile("s_waitcnt vmcnt(0)" ::: "memory");
  __syncthreads();
  if (otid() == 0) {
    __builtin_amdgcn_fence(__ATOMIC_RELEASE, "agent");
    asm volatile("s_waitcnt vmcnt(0)" ::: "memory");
    __hip_atomic_fetch_add(cnt, 1u, __ATOMIC_RELAXED, __HIP_MEMORY_SCOPE_AGENT);
    unsigned spins = 0;
    while (__hip_atomic_load(cnt, __ATOMIC_RELAXED, __HIP_MEMORY_SCOPE_AGENT) < target) { __builtin_amdgcn_s_sleep(2); if (++spins > (1u << 24)) break; }
    __builtin_amdgcn_fence(__ATOMIC_ACQUIRE, "agent");
    asm volatile("s_waitcnt vmcnt(0)" ::: "memory");
  }
  __syncthreads();
}

struct MP {
  const float *x, *c, *ctx, *c_ctx, *ada_w, *ada_b, *ln_g, *ln_b, *s5_a_re, *s5_a_im, *s5_log_dt, *s5_b_re, *s5_b_im, *s5_c_re, *s5_c_im, *s5_d, *s5_w_glu, *s5_w_o;
  const float *mla_w_dq, *mla_q_norm, *mla_w_uq, *mla_w_dkv, *mla_kv_norm, *mla_w_ukv, *mla_w_o, *peer_w_q, *peer_keys, *peer_u, *peer_v;
  float* out;
  float* MOD; bf16_t *Wt_glu, *Wt_o0, *Wt_q0, *Wt_o1, *Wt_q1, *Wt_cat, *Wt_uq, *Wt_ukv, *Khi, *Khi1;
  unsigned char *U0, *V0, *U1, *V1; float *SU0, *SV0, *SU1, *SV1; bf16_t *Ktab, *Bst_t, *Cin_t;
  float *Ypart, *Ssta; bf16_t *HP, *Gbf, *Vbf, *Tbf; float *OQ, *H1, *H2; int* IDX; float* GATE;
  bf16_t *Qa, *Kn, *Kr, *Va, *AObf; float* H3; bf16_t* Tbf1; unsigned* BAR; float* PART;
};
constexpr int LDS_BYTES = att::SHM_ATTN > 66 * LDA_B ? att::SHM_ATTN : 66 * LDA_B;
__global__ __launch_bounds__(512) void mega(MP p) {
  __shared__ __attribute__((aligned(16))) char lds[LDS_BYTES];
  cg::grid_group grid = cg::this_grid();
  const int nblk = gridDim.x;
  int bid = blockIdx.x;
  const size_t TD = (size_t)1024 * 16384;
  const float* mod0 = p.MOD; const float* mod1 = p.MOD + 3 * 6144;
  {
    volatile int* cbc = (volatile int*)(lds + LDS_BYTES - 16);
    if (otid() == 0) *cbc = 0;
    __syncthreads();
    const int t0 = otid();
    if (t0 < 128) {
      const size_t mt = (size_t)bid * 128 + t0, ms = (size_t)nblk * 128;
      const int mw = bid * 2 + (t0 >> 6), nmw = nblk * 2;
      cvt_t(p.s5_w_glu, p.Wt_glu, D, D, false, mt, ms);
      cvt_t(p.s5_w_o, p.Wt_o0, D, D, false, mt, ms);
      cvt_t(p.peer_w_q, p.Wt_q0, D, D, false, mt, ms);
      cvt_t(p.mla_w_o, p.Wt_o1, D, D, false, mt, ms);
      cvt_t(p.peer_w_q + (size_t)D * D, p.Wt_q1, D, D, false, mt, ms);
      cvt_t(p.mla_w_dq, p.Wt_cat, D, 384, false, mt, ms);
      cvt_t(p.mla_w_dkv, p.Wt_cat + (size_t)384 * D, D, 320, false, mt, ms);
      cvt_t(p.mla_w_uq, p.Wt_uq, 384, 1536, false, mt, ms);
      cvt_t(p.mla_w_ukv, p.Wt_ukv, 256, 2048, false, mt, ms);
      cvt_plain(p.peer_keys, p.Khi, (size_t)2 * 131072 / 8, false, mt, ms);
      cvt_rows_i8(p.peer_u, p.U0, p.SU0, 16384, mw, nmw);
      cvt_rows_i8(p.peer_v, p.V0, p.SV0, 16384, mw, nmw);
    } else {
      int cgen = 0;
      const int ct = t0 - 128;
      ph_s5_prep(p.s5_a_re, p.s5_a_im, p.s5_log_dt, p.s5_b_re, p.s5_b_im, p.s5_c_re, p.s5_c_im, p.Ktab, p.Bst_t, p.Cin_t, bid >> 2, bid & 3, lds, ct, 384, cbc, cgen);
      cbar(cbc, cgen, 6);
      mod_item(p.c, p.c_ctx, p.ada_w, p.ada_b, p.MOD, bid, bid < 192, lds, ct, 384, cbc, cgen);
      cvt_rows_i8(p.peer_u + TD, p.U1, p.SU1, 16384, bid * 6 + (ct >> 6), nblk * 6);
      cvt_rows_i8(p.peer_v + TD, p.V1, p.SV1, 16384, bid * 6 + (ct >> 6), nblk * 6);
    }
  }
  grid.sync();
  asm volatile("" : "+s"(bid));
  ph_s5_p1(p.x, p.ctx, mod0, p.Ktab, p.Bst_t, p.Ypart, p.Ssta, bid, lds);
  gbar(p.BAR, 1u * (unsigned)nblk);
  asm volatile("" : "+s"(bid));
  if (otid() < 64) ph_s5_carry(p.Ssta, p.s5_a_re, p.s5_a_im, p.s5_log_dt, p.HP, bid, otid());
  gbar(p.BAR, 2u * (unsigned)nblk);
  asm volatile("" : "+s"(bid));
  ph_s5_p3(p.x, p.ctx, mod0, p.s5_d, p.HP, p.Cin_t, p.Ypart, p.Gbf, bid, lds);
  gbar(p.BAR, 3u * (unsigned)nblk);
  asm volatile("" : "+s"(bid));
  {
    ChainP cp{p.Gbf, p.Wt_glu, p.Wt_o0, p.Wt_q0, p.Vbf, p.OQ, p.x, p.ctx, mod0, p.ln_g, p.ln_b, p.H1, p.Tbf, p.OQ};
    ph_chainA<true>(cp, bid, lds);
    __syncthreads();
    ph_route(RouteP{p.OQ, p.Khi, p.IDX, p.GATE, 66, 0}, bid, lds);
    __syncthreads();
    GatherP gp{p.Tbf, p.IDX, p.GATE, p.U0, p.V0, p.SU0, p.SV0, p.H1, mod0, p.ln_g + D, p.ln_b + D, p.H2, mod1};
    ph_gather_tm<false>(gp, bid * 66, 66, lds, p.PART + (size_t)bid * 8 * PARTW);
    __syncthreads();
    ProjP pp{p.Wt_cat, p.Wt_uq, p.Wt_ukv, p.mla_q_norm, p.mla_kv_norm, p.OQ  , p.Qa, p.Kn, p.Kr, p.Va};
    ph_mla_proj(pp, bid, lds);
  }
  gbar(p.BAR, 4u * (unsigned)nblk);
  asm volatile("" : "+s"(bid));
  ph_attn(p.Qa, p.Kn, p.Kr, p.Va, p.AObf, bid, nblk, lds);
  gbar(p.BAR, 5u * (unsigned)nblk);
  asm volatile("" : "+s"(bid));
  {
    ChainP cp{p.AObf, nullptr, p.Wt_o1, p.Wt_q1, nullptr, p.OQ, p.H2, p.H2 + (size_t)NL * D, mod1, p.ln_g + 2 * D, p.ln_b + 2 * D, p.H3, p.Tbf1, p.OQ};
    ph_chainA<false>(cp, bid, lds);
    __syncthreads();
    ph_route(RouteP{p.OQ, p.Khi1, p.IDX, p.GATE, 64, 0}, bid, lds);
    __syncthreads();
    GatherP gp{p.Tbf1, p.IDX, p.GATE, p.U1, p.V1, p.SU1, p.SV1, p.H3, mod1, p.ln_g + 3 * D, p.ln_b + 3 * D, p.out, mod1};
    ph_gather_tm<true>(gp, bid * 64, 64, lds, p.PART + (size_t)bid * 8 * PARTW);
  }
}

extern "C" void kernel_launch(void* const* d_in, const int* in_sizes, int n_in, void* d_out, int out_size, void* d_ws, size_t ws_size, hipStream_t stream) {
  MP p{};
  const float** in = (const float**)&p;
  for (int i = 0; i < 29; ++i) in[i] = (const float*)d_in[i];
  p.out = (float*)d_out;
  char* ws = (char*)d_ws; size_t off = 0;
  auto carve = [&](size_t bytes) { char* q = ws + off; off += (bytes + 255) / 256 * 256; return q; };
  const size_t TDB = (size_t)1024 * 16384 * 2, BIG = (size_t)NT * D * 4, HALF = (size_t)NT * D * 2;
  p.MOD = (float*)carve(2 * 3 * 6144 * 4);
  p.Wt_glu = (bf16_t*)carve((size_t)D * D * 2); p.Wt_o0 = (bf16_t*)carve((size_t)D * D * 2); p.Wt_q0 = (bf16_t*)carve((size_t)D * D * 2);
  p.Wt_o1 = (bf16_t*)carve((size_t)D * D * 2); p.Wt_q1 = (bf16_t*)carve((size_t)D * D * 2);
  p.Wt_cat = (bf16_t*)carve((size_t)704 * D * 2); p.Wt_uq = (bf16_t*)carve((size_t)1536 * 384 * 2); p.Wt_ukv = (bf16_t*)carve((size_t)2048 * 256 * 2);
  p.Khi = (bf16_t*)carve((size_t)2 * 131072 * 2); p.Khi1 = p.Khi + 131072;
  char* T0 = carve(TDB); p.U0 = (unsigned char*)T0; p.V0 = (unsigned char*)(T0 + TDB / 2); p.AObf = (bf16_t*)T0;
  p.SU0 = (float*)carve(16384 * 4); p.SV0 = (float*)carve(16384 * 4); p.SU1 = (float*)carve(16384 * 4); p.SV1 = (float*)carve(16384 * 4);
  const size_t KTAB_B = (size_t)64 * 127 * 256 * 2, BST_B = (size_t)64 * 256 * 1024 * 2, KN_B = (size_t)NB * 8 * KEYS * 128 * 2, KR_B = (size_t)NB * KEYS * 64 * 2;
  size_t x1 = KTAB_B + 2 * BST_B; if (x1 < 2 * KN_B + KR_B) x1 = 2 * KN_B + KR_B;
  char* X1 = carve(x1);
  p.Ktab = (bf16_t*)X1; p.Bst_t = (bf16_t*)(X1 + KTAB_B); p.Cin_t = (bf16_t*)(X1 + KTAB_B + BST_B);
  p.Kn = (bf16_t*)X1; p.Va = (bf16_t*)(X1 + KN_B); p.Kr = (bf16_t*)(X1 + 2 * KN_B); p.H3 = (float*)X1;
  char* X2 = carve(BIG); p.Ypart = (float*)X2; p.OQ = (float*)X2;
  char* X3 = carve(HALF); p.Ssta = (float*)X3; p.HP = (bf16_t*)(X3 + (size_t)NCC * 64 * 256 * 4); p.Vbf = (bf16_t*)X3;
  char* X4 = carve(HALF); p.Gbf = (bf16_t*)X4; p.Tbf = (bf16_t*)X4; p.Tbf1 = (bf16_t*)X4;
  char* X5 = carve(BIG); p.H1 = (float*)X5;
  char* T1 = carve(TDB); p.U1 = (unsigned char*)T1; p.V1 = (unsigned char*)(T1 + TDB / 2);
  p.H2 = (float*)carve(BIG);
  p.IDX = (int*)carve((size_t)NT * 128 * 4); p.GATE = (float*)carve((size_t)NT * 128 * 4);
  p.Qa = (bf16_t*)carve((size_t)NB * 8 * SEQ * 192 * 2);
  p.BAR = (unsigned*)carve(256);
  p.PART = (float*)carve((size_t)256 * 8 * PARTW * 4);
  if (off > ws_size || n_in != 29) { fprintf(stderr, "kernel_launch: workspace too small (need %zu, have %zu) or n_in %d != 29\n", off, ws_size, n_in); return; }
  static int grid_blocks = 0;
  if (!grid_blocks) {
    int dev = 0, cus = 0, per_cu = 0;
    hipGetDevice(&dev);
    hipDeviceGetAttribute(&cus, hipDeviceAttributeMultiprocessorCount, dev);
    hipOccupancyMaxActiveBlocksPerMultiprocessor(&per_cu, mega, 512, 0);
    if (per_cu < 1 || cus < 256) { fprintf(stderr, "kernel_launch: need 256 resident workgroups (cus %d, per_cu %d)\n", cus, per_cu); return; }
    grid_blocks = 256;
  }
  hipMemsetAsync(p.BAR, 0, 256, stream);
  void* args[] = {&p};
  hipError_t e = hipLaunchCooperativeKernel((void*)mega, dim3(grid_blocks), dim3(512), args, 0, stream);
  if (e != hipSuccess) fprintf(stderr, "cooperative launch failed: %s\n", hipGetErrorString(e));
}
```

```cpp
#include <hip/hip_runtime.h>
#include <math.h>
#include <hip/hip_cooperative_groups.h>
#include <cstdio>
namespace cg = cooperative_groups;
__device__ __forceinline__ int otid() { int t = (int)__builtin_amdgcn_workitem_id_x(); asm volatile("" : "+v"(t)); return t; }

constexpr int D = 1024, NB = 2, SEQ = 8192, CTX = 256;
constexpr int NL = NB * SEQ, NC = NB * CTX, NT = NL + NC;
constexpr float ALPHA = 1.4142135623730951f;
constexpr float LN_EPS = 1e-5f, RMS_EPS = 1e-6f;

__device__ __forceinline__ float wave_sum(float v) {
#pragma unroll
  for (int o = 32; o >= 1; o >>= 1) v += __shfl_xor(v, o);
  return v;
}
__device__ __forceinline__ int row_vec(int row) { return row < NL ? (row >> 13) : 2; }
__device__ __forceinline__ float gelu_exact(float x) { return 0.5f * x * (1.f + erff(x * 0.70710678118654752f)); }
__device__ __forceinline__ float gelu_fast(float x) {
  const float z = fabsf(x) * 0.70710678118654752f;
  const float t = __builtin_amdgcn_rcpf(fmaf(0.3275911f, z, 1.f));
  float pl = fmaf(1.061405429f, t, -1.453152027f); pl = fmaf(pl, t, 1.421413741f); pl = fmaf(pl, t, -0.284496736f); pl = fmaf(pl, t, 0.254829592f);
  const float e = __builtin_amdgcn_exp2f(-z * z * 1.4426950408889634f);
  const float erfa = 1.f - pl * t * e;
  const float hx = 0.5f * x;
  return hx + fabsf(hx) * erfa;
}


typedef unsigned short bf16_t;
using bf16x8 = __attribute__((ext_vector_type(8))) short;
using f32x4 = __attribute__((ext_vector_type(4))) float;
__device__ __forceinline__ bf16_t f2bf(float f) { unsigned u = __float_as_uint(f); u += 0x7FFFu + ((u >> 16) & 1u); return (bf16_t)(u >> 16); }
__device__ __forceinline__ float bf2f(bf16_t h) { return __uint_as_float(((unsigned)h) << 16); }
__device__ __forceinline__ unsigned pack2bf(float lo, float hi) { return (unsigned)f2bf(lo) | ((unsigned)f2bf(hi) << 16); }
__device__ __forceinline__ float bflo(unsigned w) { return __uint_as_float(w << 16); }
__device__ __forceinline__ float bfhi(unsigned w) { return __uint_as_float(w & 0xFFFF0000u); }


constexpr int LDA_B = 1024 * 2 + 16;
template <int RT, int K>
__device__ __forceinline__ void gemm_unit(const char* const (&ap)[RT], const bf16_t* __restrict__ w0, const bf16_t* __restrict__ w1, int kmul, f32x4 (&acc)[RT][2]) {
  constexpr int KI = K / 128, NS = 2;
#pragma unroll
  for (int t = 0; t < RT; ++t) { acc[t][0] = f32x4{0.f, 0.f, 0.f, 0.f}; acc[t][1] = f32x4{0.f, 0.f, 0.f, 0.f}; }
  bf16x8 b[NS][4][2];
#pragma unroll
  for (int st = 0; st < NS - 1; ++st) {
    if (st < KI) {
#pragma unroll
      for (int s2 = 0; s2 < 4; ++s2) { b[st][s2][0] = *(const bf16x8*)(w0 + (st * 128 + s2 * 32) * kmul); b[st][s2][1] = *(const bf16x8*)(w1 + (st * 128 + s2 * 32) * kmul); }
    }
  }
  asm volatile("" ::: "memory");
  bf16x8 an[RT];
#pragma unroll
  for (int t = 0; t < RT; ++t) an[t] = *(const bf16x8*)(ap[t]);
#pragma unroll
  for (int it = 0; it < KI; ++it) {
    if (it + NS - 1 < KI) {
#pragma unroll
      for (int s2 = 0; s2 < 4; ++s2) {
        b[(it + NS - 1) % NS][s2][0] = *(const bf16x8*)(w0 + ((it + NS - 1) * 128 + s2 * 32) * kmul);
        b[(it + NS - 1) % NS][s2][1] = *(const bf16x8*)(w1 + ((it + NS - 1) * 128 + s2 * 32) * kmul);
      }
    }
    asm volatile("" ::: "memory");
#pragma unroll
    for (int s2 = 0; s2 < 4; ++s2) {
      bf16x8 ac[RT];
#pragma unroll
      for (int t = 0; t < RT; ++t) ac[t] = an[t];
      if (it * 4 + s2 + 1 < KI * 4) {
#pragma unroll
        for (int t = 0; t < RT; ++t) an[t] = *(const bf16x8*)(ap[t] + (it * 128 + s2 * 32 + 32) * 2);
      }
#pragma unroll
      for (int t = 0; t < RT; ++t) {
        acc[t][0] = __builtin_amdgcn_mfma_f32_16x16x32_bf16(ac[t], b[it % NS][s2][0], acc[t][0], 0, 0, 0);
        acc[t][1] = __builtin_amdgcn_mfma_f32_16x16x32_bf16(ac[t], b[it % NS][s2][1], acc[t][1], 0, 0, 0);
      }
    }
  }
}
template <int RT, int K, class Epi>
__device__ __forceinline__ void gemm_ldsA(const char* As, int lda_b, int nrows, const bf16_t* __restrict__ Wt, int N, Epi epi) {
  const int wave = otid() >> 6, lane = otid() & 63, l15 = lane & 15, q = lane >> 4;
  const char* ap[RT];
#pragma unroll
  for (int t = 0; t < RT; ++t) { int r = t * 16 + l15; r = r < nrows ? r : nrows - 1; ap[t] = As + r * lda_b + q * 16; }
#pragma unroll 1
  for (int unit = wave; unit < (N >> 5); unit += 8) {
    const int n0 = unit * 32;
    const bf16_t* w0 = Wt + (size_t)(n0 >> 4) * K * 16 + lane * 8;
    f32x4 acc[RT][2];
    gemm_unit<RT, K>(ap, w0, w0 + (size_t)K * 16, 16, acc);
#pragma unroll
    for (int t = 0; t < RT; ++t)
#pragma unroll
      for (int j = 0; j < 2; ++j)
#pragma unroll
        for (int r = 0; r < 4; ++r) {
          const int row = t * 16 + q * 4 + r, col = n0 + j * 16 + l15;
          if (row < nrows) epi(row, col, acc[t][j][r]);
        }
  }
}
struct EpiBF16 { bf16_t* C; int ldc; __device__ __forceinline__ void operator()(int row, int col, float v) const { C[(size_t)row * ldc + col] = f2bf(v); } };
struct EpiF32 { float* C; int ldc; __device__ __forceinline__ void operator()(int row, int col, float v) const { C[(size_t)row * ldc + col] = v; } };
struct EpiGluL { const char* As; bf16_t* V; __device__ __forceinline__ void operator()(int row, int col, float z) const {
  const float g = bf2f(*(const bf16_t*)(As + row * LDA_B + col * 2)); V[(size_t)row * D + col] = f2bf(g / (1.f + expf(-z))); } };

__device__ __forceinline__ void load_rows_lds(char* As, const bf16_t* __restrict__ src, int nrows) {
  const int t = otid(), total = nrows * 128;
#pragma unroll
  for (int h = 0; h < 2; ++h) {
    uint4 v[9];
#pragma unroll
    for (int k = 0; k < 9; ++k) { int i = t + (h * 9 + k) * 512; i = i < total ? i : total - 1; v[k] = *(const uint4*)(src + (size_t)(i >> 7) * D + (i & 127) * 8); }
#pragma unroll
    for (int k = 0; k < 9; ++k) { const int i = t + (h * 9 + k) * 512; if (i < total) *(uint4*)(As + (i >> 7) * LDA_B + (i & 127) * 16) = v[k]; }
  }
}
__device__ __forceinline__ void ln_rows(char* As, int g0, int nrows, const float* Hl, const float* Hc, const bf16_t* __restrict__ O,
                                        const float* __restrict__ mod, int gate_i, const float* __restrict__ lng, const float* __restrict__ lnb,
                                        float* Hout, bf16_t* __restrict__ Tbf, int shift_i, int scale_i) {
  const int wave = otid() >> 6, lane = otid() & 63;
  for (int rr = wave; rr < nrows; rr += 8) {
    const int row = g0 + rr;
    const float* hin = row < NL ? Hl + (size_t)row * D : Hc + (size_t)(row - NL) * D;
    const bf16_t* f = O + (size_t)row * D;
    const float* m = mod + row_vec(row) * 6144;
    const float* gm = m + gate_i * 1024;
    float r[16]; float s = 0.f;
#pragma unroll
    for (int i = 0; i < 4; ++i) {
      const int d = i * 256 + lane * 4;
      const uint2 fw = *(const uint2*)(f + d);
      float4 h4 = *(const float4*)(hin + d), f4 = make_float4(bflo(fw.x), bfhi(fw.x), bflo(fw.y), bfhi(fw.y)), g4 = *(const float4*)(gm + d);
      r[i * 4 + 0] = ALPHA * h4.x + g4.x * f4.x; r[i * 4 + 1] = ALPHA * h4.y + g4.y * f4.y;
      r[i * 4 + 2] = ALPHA * h4.z + g4.z * f4.z; r[i * 4 + 3] = ALPHA * h4.w + g4.w * f4.w;
      s += r[i * 4 + 0] + r[i * 4 + 1] + r[i * 4 + 2] + r[i * 4 + 3];
    }
    const float mu = wave_sum(s) * (1.f / D);
    float vs = 0.f;
#pragma unroll
    for (int i = 0; i < 16; ++i) { float dlt = r[i] - mu; vs += dlt * dlt; }
    const float rstd = rsqrtf(wave_sum(vs) * (1.f / D) + LN_EPS);
#pragma unroll
    for (int i = 0; i < 4; ++i) {
      const int d = i * 256 + lane * 4;
      float4 g4 = *(const float4*)(lng + d), b4 = *(const float4*)(lnb + d);
      float4 o;
      o.x = (r[i * 4 + 0] - mu) * rstd * g4.x + b4.x; o.y = (r[i * 4 + 1] - mu) * rstd * g4.y + b4.y;
      o.z = (r[i * 4 + 2] - mu) * rstd * g4.z + b4.z; o.w = (r[i * 4 + 3] - mu) * rstd * g4.w + b4.w;
      *(float4*)(Hout + (size_t)row * D + d) = o;
      float4 sh = *(const float4*)(m + shift_i * 1024 + d), sc = *(const float4*)(m + scale_i * 1024 + d);
      const float t0 = o.x * (1.f + sc.x) + sh.x, t1 = o.y * (1.f + sc.y) + sh.y, t2 = o.z * (1.f + sc.z) + sh.z, t3 = o.w * (1.f + sc.w) + sh.w;
      uint2 w; w.x = pack2bf(t0, t1); w.y = pack2bf(t2, t3);
      *(uint2*)(As + rr * LDA_B + d * 2) = w;
      *(uint2*)(Tbf + (size_t)row * D + d) = w;

    }
  }
}


constexpr int S5T = 64, NCHUNK = (CTX + SEQ) / S5T  , NCC = NB * NCHUNK  ;
__device__ __forceinline__ int s5_token(int cc, int s) {
  const int b = cc / NCHUNK, ch = cc - b * NCHUNK;
  return ch < 4 ? NL + b * CTX + ch * S5T + s : b * SEQ + (ch - 4) * S5T + s;
}
__device__ __forceinline__ void cbar(volatile int* cnt, int& gen, int nwaves) {
  __builtin_amdgcn_fence(__ATOMIC_RELEASE, "workgroup");
  if ((otid() & 63) == 0) __hip_atomic_fetch_add((int*)cnt, 1, __ATOMIC_RELAXED, __HIP_MEMORY_SCOPE_WORKGROUP);
  ++gen;
  while (__hip_atomic_load((int*)cnt, __ATOMIC_RELAXED, __HIP_MEMORY_SCOPE_WORKGROUP) < gen * nwaves) __builtin_amdgcn_s_sleep(1);
  __builtin_amdgcn_fence(__ATOMIC_ACQUIRE, "workgroup");
}
__device__ __forceinline__ void ph_s5_prep(const float* __restrict__ a_re, const float* __restrict__ a_im, const float* __restrict__ log_dt,
                                                 const float* __restrict__ b_re, const float* __restrict__ b_im, const float* __restrict__ c_re, const float* __restrict__ c_im,
                                                 bf16_t* __restrict__ Ktab, bf16_t* __restrict__ Bst_t, bf16_t* __restrict__ Cin_t, int g, int part, char* lds, int tid, int nct, volatile int* cbc, int& cgen) {
  float2 (*pw)[65][64] = reinterpret_cast<float2 (*)[65][64]>(lds);
  float2 (*Bp)[64][16] = reinterpret_cast<float2 (*)[64][16]>(lds + 2 * 65 * 64 * 8);
  float2 (*Cc)[16][64] = reinterpret_cast<float2 (*)[16][64]>(lds + 2 * 65 * 64 * 8 + 2 * 64 * 16 * 8);
  float2 (*fs)[64] = reinterpret_cast<float2 (*)[64]>(lds + 2 * 65 * 64 * 8 + 2 * 64 * 16 * 8 + 2 * 16 * 64 * 8);
  if (tid < 128) {
    const int dir = tid >> 6, p = tid & 63, gp = (dir * 64 + g) * 64 + p;
    const float are = a_re[gp], aim = a_im[gp], dt = expf(log_dt[dir * 64 + g]);
    const float mag = expf(are * dt);
    const float abr = mag * cosf(aim * dt), abi = mag * sinf(aim * dt);
    const float nr = abr - 1.f, ni = abi, den = are * are + aim * aim;
    fs[dir][p] = make_float2((nr * are + ni * aim) / den, (ni * are - nr * aim) / den);
    float pr = 1.f, pi = 0.f;
    for (int e = 0; e <= 64; ++e) { pw[dir][e][p] = make_float2(pr, pi); const float nr2 = pr * abr - pi * abi, ni2 = pr * abi + pi * abr; pr = nr2; pi = ni2; }
  }
  cbar(cbc, cgen, nct >> 6);
  for (int i = tid; i < 2048; i += nct) {
    const int dir = i >> 10, p = (i >> 4) & 63, ci = i & 15;
    const size_t gi = ((size_t)(dir * 64 + g) * 64 + p) * 16 + ci;
    const float br = b_re[gi], bi = b_im[gi]; const float2 f = fs[dir][p];
    Bp[dir][p][ci] = make_float2(f.x * br - f.y * bi, f.x * bi + f.y * br);
    const int co = (i >> 6) & 15, p2 = i & 63;
    const size_t ci2 = ((size_t)(dir * 64 + g) * 16 + co) * 64 + p2;
    Cc[dir][co][p2] = make_float2(c_re[ci2], c_im[ci2]);
  }
  cbar(cbc, cgen, nct >> 6);
  for (int i = part * 508 + tid; i < (part + 1) * 508; i += nct) {
    const int ti = i >> 4, co = i & 15, tau = ti - 63;
    float acc[16];
#pragma unroll
    for (int ci = 0; ci < 16; ++ci) acc[ci] = 0.f;
    if (tau >= 0) {
      for (int p = 0; p < 64; ++p) {
        const float2 c = Cc[0][co][p], w = pw[0][tau][p];
        const float xr = c.x * w.x - c.y * w.y, xi = c.x * w.y + c.y * w.x;
#pragma unroll
        for (int ci = 0; ci < 16; ++ci) { const float2 bb = Bp[0][p][ci]; acc[ci] += xr * bb.x - xi * bb.y; }
      }
    }
    if (tau <= 0) {
      for (int p = 0; p < 64; ++p) {
        const float2 c = Cc[1][co][p], w = pw[1][-tau][p];
        const float xr = c.x * w.x - c.y * w.y, xi = c.x * w.y + c.y * w.x;
#pragma unroll
        for (int ci = 0; ci < 16; ++ci) { const float2 bb = Bp[1][p][ci]; acc[ci] += xr * bb.x - xi * bb.y; }
      }
    }
    uint4 o0, o1;
    o0.x = pack2bf(acc[0], acc[1]); o0.y = pack2bf(acc[2], acc[3]); o0.z = pack2bf(acc[4], acc[5]); o0.w = pack2bf(acc[6], acc[7]);
    o1.x = pack2bf(acc[8], acc[9]); o1.y = pack2bf(acc[10], acc[11]); o1.z = pack2bf(acc[12], acc[13]); o1.w = pack2bf(acc[14], acc[15]);
    bf16_t* kp = Ktab + (size_t)g * 127 * 256 + (size_t)i * 16;
    *(uint4*)kp = o0; *(uint4*)(kp + 8) = o1;
  }
  for (int i = part * 8192 + tid; i < (part + 1) * 8192; i += nct) {
    const int n = i >> 7, k8 = i & 127, dir = n >> 7, c = (n >> 6) & 1, p = n & 63, sidx = k8 >> 1, ci0 = (k8 & 1) * 8;
    const float2 w = pw[dir][dir == 0 ? 63 - sidx : sidx][p];
    float v[8];
#pragma unroll
    for (int j = 0; j < 8; ++j) { const float2 b = Bp[dir][p][ci0 + j]; v[j] = c == 0 ? (w.x * b.x - w.y * b.y) : (w.x * b.y + w.y * b.x); }
    uint4 o; o.x = pack2bf(v[0], v[1]); o.y = pack2bf(v[2], v[3]); o.z = pack2bf(v[4], v[5]); o.w = pack2bf(v[6], v[7]);
    *(uint4*)(Bst_t + (size_t)g * 256 * 1024 + ((size_t)((n >> 4) * 32 + (k8 >> 2)) * 64 + (k8 & 3) * 16 + (n & 15)) * 8) = o;
  }
  for (int i = part * 8192 + tid; i < (part + 1) * 8192; i += nct) {
    const int n = i >> 5, k8 = i & 31, t = n >> 4, co = n & 15, dir = k8 >> 4, c = (k8 >> 3) & 1, p0 = (k8 & 7) * 8;
    const int e = dir == 0 ? t + 1 : 64 - t;
    float v[8];
#pragma unroll
    for (int j = 0; j < 8; ++j) { const float2 cc = Cc[dir][co][p0 + j], w = pw[dir][e][p0 + j];
      v[j] = c == 0 ? (cc.x * w.x - cc.y * w.y) : -(cc.x * w.y + cc.y * w.x); }
    uint4 o; o.x = pack2bf(v[0], v[1]); o.y = pack2bf(v[2], v[3]); o.z = pack2bf(v[4], v[5]); o.w = pack2bf(v[6], v[7]);
    *(uint4*)(Cin_t + (size_t)g * 1024 * 256 + ((size_t)((n >> 4) * 8 + (k8 >> 2)) * 64 + (k8 & 3) * 16 + (n & 15)) * 8) = o;
  }
}
__device__ __forceinline__ void ph_s5_p1(const float* __restrict__ x, const float* __restrict__ ctx, const float* __restrict__ mod,
                                               const bf16_t* __restrict__ Ktab, const bf16_t* __restrict__ Bst_t, bf16_t* __restrict__ Ypart, float* __restrict__ S, int bid, char* As) {
  const int g = bid >> 2, cc0 = (bid & 3) * 66, tid = otid();
  const int wave = tid >> 6, lane = tid & 63, l15 = lane & 15, q = lane >> 4;
#pragma unroll 4
  for (int i = tid; i < 66 * 64 * 2; i += 512) {
    const int half = i & 1, sidx = (i >> 1) & 63, r = i >> 7;
    const int tok = s5_token(cc0 + r, sidx), ch = g * 16 + half * 8;
    const float* src = (tok < NL ? x + (size_t)tok * D : ctx + (size_t)(tok - NL) * D) + ch;
    const float* m = mod + row_vec(tok) * 6144;
    const float4 a = *(const float4*)src, b = *(const float4*)(src + 4);
    const float4 sh0 = *(const float4*)(m + ch), sh1 = *(const float4*)(m + ch + 4), sc0 = *(const float4*)(m + 1024 + ch), sc1 = *(const float4*)(m + 1024 + ch + 4);
    uint4 o;
    o.x = pack2bf(a.x * (1.f + sc0.x) + sh0.x, a.y * (1.f + sc0.y) + sh0.y); o.y = pack2bf(a.z * (1.f + sc0.z) + sh0.z, a.w * (1.f + sc0.w) + sh0.w);
    o.z = pack2bf(b.x * (1.f + sc1.x) + sh1.x, b.y * (1.f + sc1.y) + sh1.y); o.w = pack2bf(b.z * (1.f + sc1.z) + sh1.z, b.w * (1.f + sc1.w) + sh1.w);
    *(uint4*)(As + r * LDA_B + sidx * 32 + half * 16) = o;
  }
  __syncthreads();
  const char* ap[5];
#pragma unroll
  for (int t = 0; t < 5; ++t) { int r = t * 16 + l15; r = r < 66 ? r : 65; ap[t] = As + r * LDA_B + q * 16; }
  const bf16_t* Kg = Ktab + (size_t)g * 127 * 256;
#pragma unroll 1
  for (int unit = wave; unit < 40; unit += 8) {
    f32x4 acc[5][2];
    if (unit < 32) {
      const int t0 = unit * 2;
      const bf16_t* w0 = Kg + (t0 + 63 - (q >> 1)) * 256 + l15 * 16 + (q & 1) * 8;
      gemm_unit<5, 1024>(ap, w0, w0 + 256, -16, acc);
#pragma unroll
      for (int t = 0; t < 5; ++t)
#pragma unroll
        for (int j = 0; j < 2; ++j)
#pragma unroll
          for (int r = 0; r < 4; ++r) {
            const int row = t * 16 + q * 4 + r;
            if (row < 66) Ypart[(size_t)s5_token(cc0 + row, t0 + j) * D + g * 16 + l15] = f2bf(acc[t][j][r]);
          }
    } else {
      const int n0 = (unit - 32) * 32;
      const bf16_t* w0 = Bst_t + (size_t)g * 256 * 1024 + (size_t)(n0 >> 4) * 1024 * 16 + lane * 8;
      gemm_unit<5, 1024>(ap, w0, w0 + 1024 * 16, 16, acc);
#pragma unroll
      for (int t = 0; t < 5; ++t)
#pragma unroll
        for (int j = 0; j < 2; ++j)
#pragma unroll
          for (int r = 0; r < 4; ++r) {
            const int row = t * 16 + q * 4 + r;
            if (row < 66) S[((size_t)(cc0 + row) * 64 + g) * 256 + n0 + j * 16 + l15] = acc[t][j][r];
          }
    }
  }
}
__device__ __forceinline__ void ph_s5_carry(const float* __restrict__ S, const float* __restrict__ a_re, const float* __restrict__ a_im,
                                                 const float* __restrict__ log_dt, bf16_t* __restrict__ HP, int id, int p) {
  const int dir = id & 1, g = (id >> 1) & 63, b = id >> 7;
  const int gp = (dir * 64 + g) * 64 + p;
  const float are = a_re[gp], aim = a_im[gp], dt = expf(log_dt[dir * 64 + g]);
  const float mag = expf(are * dt);
  float tr = mag * cosf(aim * dt), ti = mag * sinf(aim * dt);
#pragma unroll
  for (int i = 0; i < 6; ++i) { const float nr = tr * tr - ti * ti, ni = 2.f * tr * ti; tr = nr; ti = ni; }
  float hr = 0.f, hi = 0.f;
#pragma unroll 12
  for (int step = 0; step < NCHUNK; ++step) {
    const int c = dir == 0 ? step : (step < 4 ? 3 - step : NCHUNK - 1 - (step - 4));
    const size_t base = ((size_t)(b * NCHUNK + c) * 64 + g) * 256 + dir * 128 + p;
    HP[base] = f2bf(hr); HP[base + 64] = f2bf(hi);
    const float sr = S[base], si = S[base + 64];
    const float nr = tr * hr - ti * hi + sr, ni = tr * hi + ti * hr + si;
    hr = nr; hi = ni;
  }
}
struct EpiS5 { const float* x; const float* ctx; const bf16_t* Ypart; bf16_t* Gbf; const float* cst; int cc0; int ch;
  __device__ __forceinline__ void operator()(int row, int col, float v) const {
    const int tok = s5_token(cc0 + row, col >> 4), vi = row_vec(tok);
    const float xin = tok < NL ? x[(size_t)tok * D + ch] : ctx[(size_t)(tok - NL) * D + ch];
    const float mm = xin * (1.f + cst[1 + vi * 2]) + cst[2 + vi * 2];
    const float y = v + bf2f(Ypart[(size_t)tok * D + ch]) + cst[0] * mm;
    Gbf[(size_t)tok * D + ch] = f2bf(gelu_fast(y));
  } };
__device__ __forceinline__ void ph_s5_p3(const float* __restrict__ x, const float* __restrict__ ctx, const float* __restrict__ mod, const float* __restrict__ dvec,
                                               const bf16_t* __restrict__ HP, const bf16_t* __restrict__ Cin_t, const bf16_t* __restrict__ Ypart, bf16_t* __restrict__ Gbf, int bid, char* As) {
  const int g = bid >> 2, cc0 = (bid & 3) * 66, tid = otid();
  for (int i = tid; i < 66 * 32; i += 512) {
    const int r = i >> 5, c = i & 31;
    *(uint4*)(As + r * 528 + c * 16) = *(const uint4*)(HP + ((size_t)(cc0 + r) * 64 + g) * 256 + c * 8);
  }
  __syncthreads();
  float* cst = (float*)(As + 66 * 528);
  if (tid < 16) {
    const int c0 = g * 16 + tid;
    cst[tid * 8 + 0] = dvec[c0];
    cst[tid * 8 + 1] = mod[1024 + c0]; cst[tid * 8 + 2] = mod[c0];
    cst[tid * 8 + 3] = mod[6144 + 1024 + c0]; cst[tid * 8 + 4] = mod[6144 + c0];
    cst[tid * 8 + 5] = mod[2 * 6144 + 1024 + c0]; cst[tid * 8 + 6] = mod[2 * 6144 + c0];
  }
  __syncthreads();
  gemm_ldsA<5, 256>(As, 528, 66, Cin_t + (size_t)g * 1024 * 256, 1024, EpiS5{x, ctx, Ypart, Gbf, cst + (otid() & 15) * 8, cc0, g * 16 + (otid() & 15)});
}


struct ChainP {
  const bf16_t* Ain;
  const bf16_t* Wglu_t; const bf16_t* Wo_t; const bf16_t* Wq_t;
  bf16_t* Vbf; bf16_t* O; const float* Hl; const float* Hc; const float* mod; const float* lng; const float* lnb;
  float* Hout; bf16_t* Tbf; bf16_t* Q;
};
template <bool L0>
__device__ __forceinline__ void ph_chainA(const ChainP& p, int bid, char* As) {
  constexpr int NR = L0 ? 66 : 64;
  constexpr int RT = L0 ? 5 : 4;
  const int g0 = bid * NR;
  load_rows_lds(As, p.Ain + (size_t)g0 * D, NR);
  __syncthreads();
  if (L0) {
    gemm_ldsA<RT, 1024>(As, LDA_B, NR, p.Wglu_t, D, EpiGluL{As, p.Vbf + (size_t)g0 * D});
    __syncthreads();
    load_rows_lds(As, p.Vbf + (size_t)g0 * D, NR);
    __syncthreads();
  }
  gemm_ldsA<RT, 1024>(As, LDA_B, NR, p.Wo_t, D, EpiBF16{p.O + (size_t)g0 * D, D});
  __syncthreads();
  ln_rows(As, g0, NR, p.Hl, p.Hc, p.O, p.mod, 2, p.lng, p.lnb, p.Hout, p.Tbf, 3, 4);
  __syncthreads();
  gemm_ldsA<RT, 1024>(As, LDA_B, NR, p.Wq_t, D, EpiBF16{p.Q + (size_t)g0 * D, D});
}


constexpr int KEYS = SEQ + CTX;
struct EpiKV { bf16_t* Kn; bf16_t* Va; int g0; int pad; __device__ __forceinline__ void operator()(int row, int col, float v) const {
  const int g = g0 + row; int b, key;
  if (g < NL) { b = g >> 13; key = g & (SEQ - 1); } else { const int cidx = g - NL; b = cidx >> 8; key = SEQ + (cidx & (CTX - 1)); }
  const int head = col >> 8, j = col & 255;
  if (j < 128) Kn[((size_t)(b * 8 + head) * KEYS + key) * 128 + j] = f2bf(v);
  else Va[((size_t)(b * 8 + head) * KEYS + key) * 128 + (j - 128)] = f2bf(v);
} };
struct EpiQ { bf16_t* Qa; int g0; int pad; __device__ __forceinline__ void operator()(int row, int col, float v) const {
  const int g = g0 + row, b = g >> 13, n = g & (SEQ - 1);
  const int head = col / 192, j = col - head * 192;
  Qa[((size_t)(b * 8 + head) * SEQ + n) * 192 + j] = f2bf(v);
} };
struct ProjP { const bf16_t* Wcat_t; const bf16_t* Wuq_t; const bf16_t* Wukv_t; const float* q_norm; const float* kv_norm;
               float* PR; bf16_t* Qa; bf16_t* Kn; bf16_t* Kr; bf16_t* Va; };
__device__ __forceinline__ void ph_mla_proj(const ProjP& p, int bid, char* As) {
  const int g0 = bid * 66, wave = otid() >> 6, lane = otid() & 63;
  gemm_ldsA<5, 1024>(As, LDA_B, 66, p.Wcat_t, 704, EpiF32{p.PR + (size_t)g0 * D, D});
  __syncthreads();
  char* A1 = As; char* A2 = As + 66 * 784;
  for (int rr = wave; rr < 66; rr += 8) {
    const int g = g0 + rr;
    const float* pr = p.PR + (size_t)g * D;
    float v[6]; float ss = 0.f;
#pragma unroll
    for (int i = 0; i < 6; ++i) { v[i] = pr[i * 64 + lane]; ss += v[i] * v[i]; }
    float rn = rsqrtf(wave_sum(ss) * (1.f / 384.f) + RMS_EPS);
#pragma unroll
    for (int i = 0; i < 6; ++i) *(bf16_t*)(A1 + rr * 784 + (i * 64 + lane) * 2) = f2bf(v[i] * rn * p.q_norm[i * 64 + lane]);
    float w[4]; ss = 0.f;
#pragma unroll
    for (int i = 0; i < 4; ++i) { w[i] = pr[384 + i * 64 + lane]; ss += w[i] * w[i]; }
    rn = rsqrtf(wave_sum(ss) * (1.f / 256.f) + RMS_EPS);
#pragma unroll
    for (int i = 0; i < 4; ++i) *(bf16_t*)(A2 + rr * 528 + (i * 64 + lane) * 2) = f2bf(w[i] * rn * p.kv_norm[i * 64 + lane]);
    if (lane < 32) {
      float x1 = pr[640 + lane], x2 = pr[672 + lane];
      int b, key;
      if (g < NL) {
        b = g >> 13; key = g & (SEQ - 1);
        const int n = key, rr2 = n >> 6, cc = n & 63;
        const float inv = powf(10000.f, -(float)(lane & 15) / 16.f);
        const float ang = (lane < 16 ? (float)rr2 : (float)cc) * inv;
        const float cs = cosf(ang), sn = sinf(ang);
        const float y1 = x1 * cs - x2 * sn, y2 = x2 * cs + x1 * sn; x1 = y1; x2 = y2;
      } else { const int cidx = g - NL; b = cidx >> 8; key = SEQ + (cidx & (CTX - 1)); }
      bf16_t* kp = p.Kr + ((size_t)b * KEYS + key) * 64;
      kp[lane] = f2bf(x1); kp[32 + lane] = f2bf(x2);
    }
  }
  __syncthreads();
  int nq = NL - g0; nq = nq > 66 ? 66 : nq;
  if (nq > 0) gemm_ldsA<5, 384>(A1, 784, nq, p.Wuq_t, 1536, EpiQ{p.Qa, g0, 0});
  gemm_ldsA<5, 256>(A2, 528, 66, p.Wukv_t, 2048, EpiKV{p.Kn, p.Va, g0, 0});
  __syncthreads();
  for (int rr = wave; rr < nq; rr += 8) {
    const int g = g0 + rr, b = g >> 13, n = g & (SEQ - 1);
    if (lane < 32) {
      const float inv = powf(10000.f, -(float)(lane & 15) / 16.f);
      const float ang = (lane < 16 ? (float)(n >> 6) : (float)(n & 63)) * inv;
      const float cs = cosf(ang), sn = sinf(ang);
#pragma unroll
      for (int h = 0; h < 8; ++h) {
        bf16_t* qo = p.Qa + ((size_t)(b * 8 + h) * SEQ + n) * 192;
        const float x1 = bf2f(qo[128 + lane]), x2 = bf2f(qo[160 + lane]);
        qo[128 + lane] = f2bf(x1 * cs - x2 * sn); qo[160 + lane] = f2bf(x2 * cs + x1 * sn);
      }
    }
  }
}

namespace att {
using s16x4 = __attribute__((ext_vector_type(4))) short;
using f32x16 = __attribute__((ext_vector_type(16))) float;
using u32x4 = __attribute__((ext_vector_type(4))) unsigned;
constexpr int KVBLK = 64, KROW = 400;
constexpr float SCALE = 0.07216878364870322f;
constexpr float THR = 8.f;
constexpr int SHM_V = KVBLK * 128 * 2, SHM_K = KVBLK * KROW, QRROW = 272, SHM_QR = 256 * QRROW, SHM_ATTN = 2 * SHM_V + 2 * SHM_K + 8 * 64 * 4 + SHM_QR;
#define SBAR() __builtin_amdgcn_sched_barrier(0)
__device__ __forceinline__ int crow(int r, int hi) { return (r & 3) + 8 * (r >> 2) + 4 * hi; }
__device__ __forceinline__ unsigned cvtpk(float lo, float hi) { unsigned r; asm volatile("v_cvt_pk_bf16_f32 %0, %1, %2" : "=v"(r) : "v"(lo), "v"(hi)); return r; }
__device__ __forceinline__ void partialSM(f32x16& p0, f32x16& p1, float& m_reg, float& mn, float& alpha) {
  constexpr float C = SCALE * 1.4426950408889634f;
  float pmax = p0[0];
#pragma unroll
  for (int r = 1; r < 16; ++r) pmax = fmaxf(pmax, p0[r]);
#pragma unroll
  for (int r = 0; r < 16; ++r) pmax = fmaxf(pmax, p1[r]);
  { auto rr = __builtin_amdgcn_permlane32_swap(__float_as_uint(pmax), __float_as_uint(pmax), false, false);
    pmax = fmaxf(__uint_as_float(rr[0]), __uint_as_float(rr[1])); }
  if (__builtin_expect(__all(pmax - m_reg <= THR / SCALE), 1)) { mn = m_reg; alpha = 1.f; }
  else { mn = fmaxf(m_reg, pmax); alpha = __builtin_amdgcn_exp2f((m_reg - mn) * C); m_reg = mn; }
  const float mnC = -mn * C;
#pragma unroll
  for (int r = 0; r < 16; ++r) p0[r] = fmaf(p0[r], C, mnC);
#pragma unroll
  for (int r = 0; r < 16; ++r) p1[r] = fmaf(p1[r], C, mnC);
#pragma unroll
  for (int r = 0; r < 16; ++r) p0[r] = __builtin_amdgcn_exp2f(p0[r]);
}
__device__ __forceinline__ void finishSM(f32x16& p0, f32x16& p1, float alpha, float& l_reg, bf16x8& pa0, bf16x8& pa1, bf16x8& pa2, bf16x8& pa3) {
#pragma unroll
  for (int r = 0; r < 16; ++r) p1[r] = __builtin_amdgcn_exp2f(p1[r]);
  float ps = 0;
#pragma unroll
  for (int r = 0; r < 16; ++r) ps += p0[r];
#pragma unroll
  for (int r = 0; r < 16; ++r) ps += p1[r];
  { auto rr = __builtin_amdgcn_permlane32_swap(__float_as_uint(ps), __float_as_uint(ps), false, false);
    ps = __uint_as_float(rr[0]) + __uint_as_float(rr[1]); }
  l_reg = l_reg * alpha + ps;
#define PK4(P, BASE, OUT) do { unsigned a0 = cvtpk(P[BASE + 0], P[BASE + 1]), a1 = cvtpk(P[BASE + 2], P[BASE + 3]);   \
    unsigned b0 = cvtpk(P[BASE + 4], P[BASE + 5]), b1 = cvtpk(P[BASE + 6], P[BASE + 7]);                              \
    auto r0 = __builtin_amdgcn_permlane32_swap(a0, b0, false, false); auto r1 = __builtin_amdgcn_permlane32_swap(a1, b1, false, false); \
    u32x4 w = {r0[0], r1[0], r0[1], r1[1]}; OUT = *reinterpret_cast<bf16x8*>(&w); } while (0)
  PK4(p0, 0, pa0); PK4(p0, 8, pa1); PK4(p1, 0, pa2); PK4(p1, 8, pa3);
#undef PK4
}
__device__ __forceinline__ void qkt(f32x16& p0, f32x16& p1, const char* Ks, const bf16x8* qr, const char* qrl, int r32, int hi) {
  p0 = f32x16{}; p1 = f32x16{};
#pragma unroll
  for (int d0 = 0; d0 < 12; ++d0) { const int cb = (d0 * 16 + hi * 8) * 2;
    bf16x8 b0 = *reinterpret_cast<const bf16x8*>(Ks + r32 * KROW + cb);
    bf16x8 b1 = *reinterpret_cast<const bf16x8*>(Ks + (32 + r32) * KROW + cb);
    const bf16x8 qv = d0 < 4 ? qr[d0 < 4 ? d0 : 0] : *reinterpret_cast<const bf16x8*>(qrl + (d0 - 4) * 32);
    p0 = __builtin_amdgcn_mfma_f32_32x32x16_bf16(b0, qv, p0, 0, 0, 0);
    p1 = __builtin_amdgcn_mfma_f32_32x32x16_bf16(b1, qv, p1, 0, 0, 0); }
}
__device__ __forceinline__ int v_st(int k, int c) { const int kk = (k & ~0xC) | ((k & 4) << 1) | ((k & 8) >> 1); return ((kk >> 3) * 4 + (c >> 5)) * 512 + ((kk & 7) * 32 + (c & 31)) * 2; }
__device__ __forceinline__ int v_rd_base(int lane) { return ((lane & 3) << 3) | (((lane >> 2) & 3) << 6) | (((lane >> 4) & 1) << 5) | (((lane >> 5) & 1) << 8); }
constexpr int v_rd_off(int d0, int ks, int half) { return d0 * 512 + ks * 4096 + half * 2048; }
template <int OFF> __device__ __forceinline__ s16x4 tr_read(int vb) {
  s16x4 r; asm volatile("ds_read_b64_tr_b16 %0, %1 offset:%2" : "=&v"(r) : "v"(vb), "i"(OFF) : "memory"); return r;
}
template <int D0> __device__ __forceinline__ void pv_one(f32x16& od, int vb, bf16x8 pa0, bf16x8 pa1, bf16x8 pa2, bf16x8 pa3) {
  const s16x4 l0 = tr_read<v_rd_off(D0, 0, 0)>(vb), h0 = tr_read<v_rd_off(D0, 0, 1)>(vb), l1 = tr_read<v_rd_off(D0, 1, 0)>(vb), h1 = tr_read<v_rd_off(D0, 1, 1)>(vb);
  const s16x4 l2 = tr_read<v_rd_off(D0, 2, 0)>(vb), h2 = tr_read<v_rd_off(D0, 2, 1)>(vb), l3 = tr_read<v_rd_off(D0, 3, 0)>(vb), h3 = tr_read<v_rd_off(D0, 3, 1)>(vb);
  asm volatile("s_waitcnt lgkmcnt(0)" ::: "memory"); SBAR();
#define PK(L, H) (bf16x8){L[0], L[1], L[2], L[3], H[0], H[1], H[2], H[3]}
  od = __builtin_amdgcn_mfma_f32_32x32x16_bf16(pa0, PK(l0, h0), od, 0, 0, 0);
  od = __builtin_amdgcn_mfma_f32_32x32x16_bf16(pa1, PK(l1, h1), od, 0, 0, 0);
  od = __builtin_amdgcn_mfma_f32_32x32x16_bf16(pa2, PK(l2, h2), od, 0, 0, 0);
  od = __builtin_amdgcn_mfma_f32_32x32x16_bf16(pa3, PK(l3, h3), od, 0, 0, 0);
#undef PK
}
__device__ __forceinline__ void pv_d0(f32x16* o, int vb, bf16x8 pa0, bf16x8 pa1, bf16x8 pa2, bf16x8 pa3) {
  pv_one<0>(o[0], vb, pa0, pa1, pa2, pa3); pv_one<1>(o[1], vb, pa0, pa1, pa2, pa3); pv_one<2>(o[2], vb, pa0, pa1, pa2, pa3); pv_one<3>(o[3], vb, pa0, pa1, pa2, pa3);
}
__device__ __forceinline__ void attn_body(const bf16_t* __restrict__ Qb, const bf16_t* __restrict__ Kh, const bf16_t* __restrict__ Krb, const bf16_t* __restrict__ Vh,
                                          bf16_t* __restrict__ Ob, int nkeys, char* lds) {
  const int tid = otid(), wid = tid >> 6, lane = tid & 63, r32 = lane & 31, hi = lane >> 5;
  char* V_lds = lds; char* K_lds = lds + 2 * SHM_V;
  float* ws = (float*)(lds + 2 * SHM_V + 2 * SHM_K) + wid * 64; float* li_l = ws; float* al_l = ws + 32;
  float m_reg = -1e30f, l_reg = 0; f32x16 o[4] = {}; bf16x8 qr[4];
  const bf16_t* Qw = Qb + (size_t)(wid * 32 + r32) * 192 + hi * 8;
  char* qrl = lds + 2 * SHM_V + 2 * SHM_K + 8 * 64 * 4 + (wid * 32 + r32) * QRROW + hi * 16;
#pragma unroll
  for (int d0 = 0; d0 < 4; ++d0) qr[d0] = *reinterpret_cast<const bf16x8*>(Qw + d0 * 16);
#pragma unroll
  for (int d0 = 4; d0 < 12; ++d0) *reinterpret_cast<bf16x8*>(qrl + (d0 - 4) * 32) = *reinterpret_cast<const bf16x8*>(Qw + d0 * 16);
  const int sr = tid >> 4, sc = (tid & 15) * 8, vst0 = v_st(sr, sc), vst1 = v_st(32 + sr, sc);
  const int krw = tid >> 3, kch = tid & 7;
  const int vb0 = (int)(uintptr_t)V_lds + v_rd_base(lane);
  bf16x8 vs0, vs1, ks0, ks1, ks2;
#define SLOAD(k0) do { vs0 = *reinterpret_cast<const bf16x8*>(&Vh[(size_t)((k0) + sr) * 128 + sc]); vs1 = *reinterpret_cast<const bf16x8*>(&Vh[(size_t)((k0) + 32 + sr) * 128 + sc]); \
    const bf16_t* kp_ = &Kh[(size_t)((k0) + krw) * 128 + kch * 8]; \
    ks0 = *reinterpret_cast<const bf16x8*>(kp_); ks1 = *reinterpret_cast<const bf16x8*>(kp_ + 64); \
    ks2 = *reinterpret_cast<const bf16x8*>(&Krb[(size_t)((k0) + krw) * 64 + kch * 8]); } while (0)
#define SWRITE(b) do { *(bf16x8*)(V_lds + (b) * SHM_V + vst0) = vs0; *(bf16x8*)(V_lds + (b) * SHM_V + vst1) = vs1; \
    char* kl_ = K_lds + (b) * SHM_K + krw * KROW + kch * 16; \
    *(bf16x8*)(kl_) = ks0; *(bf16x8*)(kl_ + 128) = ks1; *(bf16x8*)(kl_ + 256) = ks2; } while (0)
#define SWAIT() asm volatile("s_waitcnt vmcnt(0)" ::: "memory")
#define RESC(a) do { if (__any((a) < 1.f)) { if (hi == 0) al_l[r32] = (a); asm volatile("s_waitcnt lgkmcnt(0)" ::: "memory"); \
    for (int d = 0; d < 4; ++d) for (int r = 0; r < 16; ++r) o[d][r] *= al_l[crow(r, hi)]; } } while (0)
  f32x16 pA0, pA1, pB0, pB1; float mnA, mnB, alA, alB; bf16x8 pa0, pa1, pa2, pa3; const int NTL = nkeys / KVBLK;
  SLOAD(0); SWAIT(); SWRITE(0); __syncthreads();
  qkt(pA0, pA1, K_lds, qr, qrl, r32, hi); partialSM(pA0, pA1, m_reg, mnA, alA);
  SLOAD(KVBLK);
  SWAIT(); SWRITE(1); __syncthreads();
  for (int j = 1; j + 1 < NTL; j += 2) {
    SBAR(); qkt(pB0, pB1, K_lds + SHM_K, qr, qrl, r32, hi);
    finishSM(pA0, pA1, alA, l_reg, pa0, pa1, pa2, pa3); SBAR();
    SLOAD((j + 1) * KVBLK); SBAR();
    pv_d0(o, vb0, pa0, pa1, pa2, pa3); partialSM(pB0, pB1, m_reg, mnB, alB);
    __syncthreads(); SWAIT(); SWRITE(0);
    RESC(alB); __syncthreads();
    SBAR(); qkt(pA0, pA1, K_lds, qr, qrl, r32, hi);
    finishSM(pB0, pB1, alB, l_reg, pa0, pa1, pa2, pa3); SBAR();
    SLOAD((j + 2) * KVBLK); SBAR();
    pv_d0(o, vb0 + SHM_V, pa0, pa1, pa2, pa3); partialSM(pA0, pA1, m_reg, mnA, alA);
    __syncthreads(); SWAIT(); SWRITE(1);
    RESC(alA); __syncthreads();
  }
  SBAR(); qkt(pB0, pB1, K_lds + SHM_K, qr, qrl, r32, hi);
  finishSM(pA0, pA1, alA, l_reg, pa0, pa1, pa2, pa3); SBAR();
  pv_d0(o, vb0, pa0, pa1, pa2, pa3); partialSM(pB0, pB1, m_reg, mnB, alB);
  __syncthreads(); RESC(alB);
  finishSM(pB0, pB1, alB, l_reg, pa0, pa1, pa2, pa3); SBAR();
  pv_d0(o, vb0 + SHM_V, pa0, pa1, pa2, pa3);
  if (hi == 0) li_l[r32] = l_reg; asm volatile("s_waitcnt lgkmcnt(0)" ::: "memory");
  float rli[16];
#pragma unroll
  for (int r = 0; r < 16; ++r) rli[r] = __builtin_amdgcn_rcpf(li_l[crow(r, hi)]);
  bf16_t* Ow = Ob + (size_t)(wid * 32) * D;
#pragma unroll
  for (int r = 0; r < 16; ++r) { const int orow = crow(r, hi);
#pragma unroll
    for (int d0 = 0; d0 < 4; ++d0) Ow[(size_t)orow * D + d0 * 32 + r32] = f2bf(o[d0][r] * rli[r]); }
  __syncthreads();
#undef SLOAD
#undef SWRITE
#undef SWAIT
#undef RESC
}
}

__device__ __forceinline__ void ph_attn(const bf16_t* __restrict__ Qa, const bf16_t* __restrict__ Kn, const bf16_t* __restrict__ Kr, const bf16_t* __restrict__ Va,
                                        bf16_t* __restrict__ AO, int bid, int nblk, char* lds) {
  for (int item = bid; item < 512; item += nblk) {
    const int b = item >> 8, h = item & 7, qb = (item >> 3) & 31;
    att::attn_body(Qa + ((size_t)(b * 8 + h) * SEQ + qb * 256) * 192, Kn + (size_t)(b * 8 + h) * KEYS * 128, Kr + (size_t)b * KEYS * 64,
                   Va + (size_t)(b * 8 + h) * KEYS * 128, AO + (size_t)(b * SEQ + qb * 256) * D + h * 128, KEYS, lds);
  }
}

namespace rt {
using f32x16 = __attribute__((ext_vector_type(16))) float;
__device__ __forceinline__ int sortable(float f) { const int b = __float_as_int(f); return b ^ ((b >> 31) & 0x7FFFFFFF); }
__device__ __forceinline__ float unsortable(int k) { return __int_as_float(k ^ ((k >> 31) & 0x7FFFFFFF)); }
__device__ __forceinline__ int imax(int a, int b) { return a > b ? a : b; }
__device__ __forceinline__ int imin(int a, int b) { return a < b ? a : b; }
template <int N> __device__ __forceinline__ void sort_desc(int (&v)[N]) {
#pragma unroll
  for (int k = 2; k <= N; k <<= 1) {
#pragma unroll
    for (int j = k >> 1; j > 0; j >>= 1) {
#pragma unroll
      for (int i = 0; i < N; ++i) {
        const int l = i ^ j;
        if (l > i) {
          const bool desc = ((i & k) == 0);
          const int a = v[i], b = v[l];
          v[i] = desc ? imax(a, b) : imin(a, b);
          v[l] = desc ? imin(a, b) : imax(a, b);
        }
      }
    }
  }
}
template <int N> __device__ __forceinline__ void merge_desc(int (&v)[N]) {
#pragma unroll
  for (int j = N >> 1; j > 0; j >>= 1) {
#pragma unroll
    for (int i = 0; i < N; ++i) {
      const int l = i ^ j;
      if (l > i) { const int a = v[i], b = v[l]; v[i] = imax(a, b); v[l] = imin(a, b); }
    }
  }
}
__device__ __forceinline__ void absorb16(int (&L)[16], int (&B)[16]) {
  sort_desc<16>(B);
#pragma unroll
  for (int i = 0; i < 16; ++i) L[i] = imax(L[i], B[15 - i]);
  merge_desc<16>(L);
}
__device__ __forceinline__ constexpr int npairs_row(int i) { return 16 / (i + 1); }
}

struct RouteP { const bf16_t* Q; const bf16_t* Khi; int* IDX; float* GATE; int rows_per_block; int pad; };
__device__ __forceinline__ void ph_route(const RouteP& p, int bid, char* lds) {
  using namespace rt;
  int (*svl)[64][33] = reinterpret_cast<int (*)[64][33]>(lds);
  const int wave = otid() >> 6, lane = otid() & 63, r32 = lane & 31, hi = lane >> 5, hi4 = hi * 4;
  int nrows = p.rows_per_block; asm volatile("" : "+s"(nrows));
  const int g0 = bid * nrows;
  const int h = wave;
#pragma unroll 1
  for (int tg = 0; tg * 32 < nrows; ++tg) {
    int trow = tg * 32 + r32; const bool valid = trow < nrows; trow = valid ? trow : nrows - 1;
    const bf16_t* qrow = p.Q + (size_t)(g0 + trow) * D;
    int sv[2][16];
#pragma unroll
    for (int s = 0; s < 2; ++s) {
      const int hs = h * 2 + s;
      f32x16 acc[4];
#pragma unroll
      for (int m = 0; m < 4; ++m) acc[m] = f32x16{};
#pragma unroll
      for (int kp = 0; kp < 2; ++kp) {
        bf16x8 kf[2][4], qf[2];
#pragma unroll
        for (int k2 = 0; k2 < 2; ++k2)
#pragma unroll
          for (int m = 0; m < 4; ++m) kf[k2][m] = *(const bf16x8*)(p.Khi + ((size_t)(hs * 128 + m * 32 + r32)) * 64 + (kp * 2 + k2) * 16 + hi * 8);
#pragma unroll
        for (int k2 = 0; k2 < 2; ++k2) {
          const int ks = kp * 2 + k2;
          qf[k2] = *(const bf16x8*)(qrow + hs * 64 + ks * 16 + hi * 8);
        }
#pragma unroll
        for (int k2 = 0; k2 < 2; ++k2)
#pragma unroll
          for (int m = 0; m < 4; ++m) acc[m] = __builtin_amdgcn_mfma_f32_32x32x16_bf16(kf[k2][m], qf[k2], acc[m], 0, 0, 0);
      }
      int L[16];
#pragma unroll
      for (int m = 0; m < 4; ++m) {
        int B[16];
#pragma unroll
        for (int r = 0; r < 16; ++r) B[r] = (sortable(acc[m][r]) & ~0x7F) | (m * 32 + (r & 3) + 8 * (r >> 2)) | hi4;
        if (m == 0) { sort_desc<16>(B);
#pragma unroll
          for (int i = 0; i < 16; ++i) L[i] = B[i]; }
        else absorb16(L, B);
      }
      int Lo[16], Hi[16];
#pragma unroll
      for (int i = 0; i < 16; ++i) { auto rr = __builtin_amdgcn_permlane32_swap((unsigned)L[i], (unsigned)L[i], false, false); Lo[i] = (int)rr[0]; Hi[i] = (int)rr[1]; }
#pragma unroll
      for (int i = 0; i < 16; ++i) L[i] = imax(Lo[i], Hi[15 - i]);
      merge_desc<16>(L);
#pragma unroll
      for (int i = 0; i < 16; ++i) { sv[s][i] = L[i]; svl[wave][lane][s * 16 + i] = L[i]; }
    }
    float f0[16], f1[16];
#pragma unroll
    for (int i = 0; i < 16; ++i) { f0[i] = unsortable(sv[0][i] & ~0x7F); f1[i] = unsortable(sv[1][i] & ~0x7F); }
    int Lc[16];
    {
      int C[64];
      int n = 0;
#pragma unroll
      for (int i = 0; i < 16; ++i)
#pragma unroll
        for (int j = 0; j < 16; ++j)
          if ((i + 1) * (j + 1) <= 16) { C[n] = (sortable(f0[i] + f1[j]) & ~0xFF) | (i * 16 + j); ++n; }
#pragma unroll
      for (int k = 50; k < 64; ++k) C[k] = (int)0x80000000;
#pragma unroll
      for (int m = 0; m < 4; ++m) {
        int B[16];
#pragma unroll
        for (int r = 0; r < 16; ++r) B[r] = C[m * 16 + r];
        if (m == 0) { sort_desc<16>(B);
#pragma unroll
          for (int i = 0; i < 16; ++i) Lc[i] = B[i]; }
        else absorb16(Lc, B);
      }
    }
    float e[16]; float esum = 0.f;
    const float vmax = unsortable(Lc[0] & ~0xFF);
#pragma unroll
    for (int r = 0; r < 16; ++r) { e[r] = expf(unsortable(Lc[r] & ~0xFF) - vmax); esum += e[r]; }
    const float inv = 1.f / esum;
    int eid[16];
#pragma unroll
    for (int r = 0; r < 16; ++r) {
      const int pr = Lc[r] & 0xFF;
      const int k0 = svl[wave][lane][pr >> 4] & 0x7F, k1 = svl[wave][lane][16 + (pr & 15)] & 0x7F;
      eid[r] = k0 * 128 + k1;
    }
    if (valid && hi == 0) {
      int* ip = p.IDX + (size_t)(g0 + trow) * 128 + h * 16; float* gp = p.GATE + (size_t)(g0 + trow) * 128 + h * 16;
#pragma unroll
      for (int r = 0; r < 16; r += 4) {
        *(int4*)(ip + r) = make_int4(eid[r], eid[r + 1], eid[r + 2], eid[r + 3]);
        *(float4*)(gp + r) = make_float4(e[r] * inv, e[r + 1] * inv, e[r + 2] * inv, e[r + 3] * inv);
      }
    }
  }
}

__device__ __forceinline__ float wave_sum_dpp(float v) {
  v += __uint_as_float(__builtin_amdgcn_update_dpp(0u, __float_as_uint(v), 0xB1, 0xF, 0xF, true));
  v += __uint_as_float(__builtin_amdgcn_update_dpp(0u, __float_as_uint(v), 0x4E, 0xF, 0xF, true));
  v += __uint_as_float(__builtin_amdgcn_update_dpp(0u, __float_as_uint(v), 0x141, 0xF, 0xF, true));
  v += __uint_as_float(__builtin_amdgcn_update_dpp(0u, __float_as_uint(v), 0x140, 0xF, 0xF, true));
  v += __uint_as_float(__builtin_amdgcn_update_dpp(0u, __float_as_uint(v), 0x142, 0xA, 0xF, true));
  v += __uint_as_float(__builtin_amdgcn_update_dpp(0u, __float_as_uint(v), 0x143, 0xC, 0xF, true));
  return __uint_as_float((unsigned)__builtin_amdgcn_readlane((int)__float_as_uint(v), 63));
}
__device__ __forceinline__ void cvt_rows_i8(const float* __restrict__ src, unsigned char* __restrict__ dst, float* __restrict__ scl, int nrows, int wgid, int nw) {
  const int lane = otid() & 63;
  for (int r0 = wgid * 4; r0 < nrows; r0 += nw * 4) {
    float v[4][16];
#pragma unroll
    for (int u = 0; u < 4; ++u) {
      const float* sp = src + (size_t)(r0 + u) * D + lane * 4;
      *(float4*)&v[u][0] = *(const float4*)sp; *(float4*)&v[u][4] = *(const float4*)(sp + 256); *(float4*)&v[u][8] = *(const float4*)(sp + 512); *(float4*)&v[u][12] = *(const float4*)(sp + 768);
    }
#pragma unroll
    for (int u = 0; u < 4; ++u) {
      float am = 0.f;
#pragma unroll
      for (int j = 0; j < 16; ++j) am = fmaxf(am, fabsf(v[u][j]));
#pragma unroll
      for (int o = 32; o >= 1; o >>= 1) am = fmaxf(am, __shfl_xor(am, o));
      const float sc = am > 0.f ? am * (1.f / 127.f) : 1.f, inv = 1.f / sc;
      unsigned w[4];
#pragma unroll
      for (int q4 = 0; q4 < 4; ++q4) {
        unsigned ww = 0u;
#pragma unroll
        for (int j = 0; j < 4; ++j) { int qi = (int)rintf(v[u][q4 * 4 + j] * inv) + 128; qi = qi < 1 ? 1 : (qi > 255 ? 255 : qi); ww |= (unsigned)qi << (8 * j); }
        w[q4] = ww;
      }
      *(uint4*)(dst + (size_t)(r0 + u) * D + lane * 16) = make_uint4(w[0], w[1], w[2], w[3]);
      if (lane == 0) scl[r0 + u] = sc;
    }
  }
}

struct GatherP { const bf16_t* Tbf; const int* IDX; const float* GATE; const unsigned char* utab; const unsigned char* vtab; const float* su; const float* sv;
                 const float* Hin; const float* mod; const float* lng; const float* lnb; float* Hout; const float* modT; };
#define UB0(w) ((float)((w) & 0xFFu))
#define UB1(w) ((float)(((w) >> 8) & 0xFFu))
#define UB2(w) ((float)(((w) >> 16) & 0xFFu))
#define UB3(w) ((float)((w) >> 24))
template <bool FINAL>
__device__ __forceinline__ void ln_token(const GatherP& p, int row, int rr, int lane, const float (&f)[16], float asum, char* As) {
  const int v = row_vec(row);
  const float* hin = p.Hin + (size_t)row * D + lane * 4;
  const float* gm = p.mod + v * 6144 + 5 * 1024 + lane * 4;
  const float off = 128.f * asum;
  float r[16]; float ssum = 0.f;
#pragma unroll
  for (int q4 = 0; q4 < 4; ++q4) {
    const float4 h4 = *(const float4*)(hin + q4 * 256), g4 = *(const float4*)(gm + q4 * 256);
    r[q4 * 4 + 0] = ALPHA * h4.x + g4.x * (f[q4 * 4 + 0] - off); r[q4 * 4 + 1] = ALPHA * h4.y + g4.y * (f[q4 * 4 + 1] - off);
    r[q4 * 4 + 2] = ALPHA * h4.z + g4.z * (f[q4 * 4 + 2] - off); r[q4 * 4 + 3] = ALPHA * h4.w + g4.w * (f[q4 * 4 + 3] - off);
    ssum += r[q4 * 4 + 0] + r[q4 * 4 + 1] + r[q4 * 4 + 2] + r[q4 * 4 + 3];
  }
  const float mu = wave_sum(ssum) * (1.f / D);
  float vs = 0.f;
#pragma unroll
  for (int j = 0; j < 16; ++j) { const float dlt = r[j] - mu; vs += dlt * dlt; }
  const float rstd = rsqrtf(wave_sum(vs) * (1.f / D) + LN_EPS);
  float o[16];
#pragma unroll
  for (int q4 = 0; q4 < 4; ++q4) {
    const float4 g4 = *(const float4*)(p.lng + q4 * 256 + lane * 4), b4 = *(const float4*)(p.lnb + q4 * 256 + lane * 4);
    o[q4 * 4 + 0] = (r[q4 * 4 + 0] - mu) * rstd * g4.x + b4.x; o[q4 * 4 + 1] = (r[q4 * 4 + 1] - mu) * rstd * g4.y + b4.y;
    o[q4 * 4 + 2] = (r[q4 * 4 + 2] - mu) * rstd * g4.z + b4.z; o[q4 * 4 + 3] = (r[q4 * 4 + 3] - mu) * rstd * g4.w + b4.w;
    *(float4*)(p.Hout + (size_t)row * D + q4 * 256 + lane * 4) = make_float4(o[q4 * 4 + 0], o[q4 * 4 + 1], o[q4 * 4 + 2], o[q4 * 4 + 3]);
  }
  if (!FINAL) {
    const float* mt = p.modT + v * 6144 + lane * 4;
#pragma unroll
    for (int q4 = 0; q4 < 4; ++q4) {
      const float4 sh = *(const float4*)(mt + q4 * 256), sc = *(const float4*)(mt + 1024 + q4 * 256);
      uint2 w; w.x = pack2bf(o[q4 * 4] * (1.f + sc.x) + sh.x, o[q4 * 4 + 1] * (1.f + sc.y) + sh.y); w.y = pack2bf(o[q4 * 4 + 2] * (1.f + sc.z) + sh.z, o[q4 * 4 + 3] * (1.f + sc.w) + sh.w);
      *(uint2*)(As + rr * LDA_B + (q4 * 256 + lane * 4) * 2) = w;
    }
  }
}
constexpr int PARTW = 1088;
template <bool FINAL>
__device__ __forceinline__ void ph_gather_tm(const GatherP& p, int g0, int nrows, char* As, float* __restrict__ PART) {
  const int tid = otid(), wave = tid >> 6, lane = tid & 63;
  const int nfull = nrows >> 3, extra = nrows & 7;
  const int nun = nfull + (extra ? 1 : 0);
#pragma unroll 1
  for (int un = 0; un < nun; ++un) {
    int rr, kbeg, kcnt; bool partial;
    if (un < nfull) { rr = wave + 8 * un; kbeg = 0; kcnt = 128; partial = false; }
    else { const int wpt = 8 / extra; rr = nfull * 8 + wave / wpt; kcnt = 128 / wpt; kbeg = (wave % wpt) * kcnt; partial = true; }
    const int row = g0 + rr;
    float tf[16];
    {
      const bf16_t* tp = p.Tbf + (size_t)row * D + lane * 4;
      const uint2 t0 = *(const uint2*)tp, t1 = *(const uint2*)(tp + 256), t2 = *(const uint2*)(tp + 512), t3 = *(const uint2*)(tp + 768);
      tf[0] = bflo(t0.x); tf[1] = bfhi(t0.x); tf[2] = bflo(t0.y); tf[3] = bfhi(t0.y); tf[4] = bflo(t1.x); tf[5] = bfhi(t1.x); tf[6] = bflo(t1.y); tf[7] = bfhi(t1.y);
      tf[8] = bflo(t2.x); tf[9] = bfhi(t2.x); tf[10] = bflo(t2.y); tf[11] = bfhi(t2.y); tf[12] = bflo(t3.x); tf[13] = bfhi(t3.x); tf[14] = bflo(t3.y); tf[15] = bfhi(t3.y);
    }
    float tsum = 0.f;
#pragma unroll
    for (int j = 0; j < 16; ++j) tsum += tf[j];
    tsum = wave_sum_dpp(tsum) * 128.f;
    const int id_lo = p.IDX[(size_t)row * 128 + lane], id_hi = p.IDX[(size_t)row * 128 + 64 + lane];
    const float ga_lo = p.GATE[(size_t)row * 128 + lane], ga_hi = p.GATE[(size_t)row * 128 + 64 + lane];
    float f[16], asum = 0.f;
#pragma unroll
    for (int j = 0; j < 16; ++j) f[j] = 0.f;
    uint4 ub[8], vb[8]; float sub[8], svb[8];
#define TLOAD(slot, kk) do { const int e_ = __builtin_amdgcn_readlane((kk) < 64 ? id_lo : id_hi, (kk) & 63); \
      ub[slot] = *(const uint4*)(p.utab + (size_t)e_ * D + lane * 16); vb[slot] = *(const uint4*)(p.vtab + (size_t)e_ * D + lane * 16); \
      sub[slot] = p.su[e_]; svb[slot] = p.sv[e_]; } while (0)
    auto proc4 = [&](int s0, int k0) {
      float dot[4];
#pragma unroll
      for (int u = 0; u < 4; ++u) {
        const uint4 a_ = ub[s0 + u];
        float d = tf[0] * UB0(a_.x); d = fmaf(tf[1], UB1(a_.x), d); d = fmaf(tf[2], UB2(a_.x), d); d = fmaf(tf[3], UB3(a_.x), d);
        d = fmaf(tf[4], UB0(a_.y), d); d = fmaf(tf[5], UB1(a_.y), d); d = fmaf(tf[6], UB2(a_.y), d); d = fmaf(tf[7], UB3(a_.y), d);
        d = fmaf(tf[8], UB0(a_.z), d); d = fmaf(tf[9], UB1(a_.z), d); d = fmaf(tf[10], UB2(a_.z), d); d = fmaf(tf[11], UB3(a_.z), d);
        d = fmaf(tf[12], UB0(a_.w), d); d = fmaf(tf[13], UB1(a_.w), d); d = fmaf(tf[14], UB2(a_.w), d); d = fmaf(tf[15], UB3(a_.w), d);
        dot[u] = d;
      }
#define DPPSTEP(ctl, rm) do { _Pragma("unroll") for (int u = 0; u < 4; ++u) dot[u] += __uint_as_float(__builtin_amdgcn_update_dpp(0u, __float_as_uint(dot[u]), ctl, rm, 0xF, true)); } while (0)
      DPPSTEP(0xB1, 0xF); DPPSTEP(0x4E, 0xF); DPPSTEP(0x141, 0xF); DPPSTEP(0x140, 0xF); DPPSTEP(0x142, 0xA); DPPSTEP(0x143, 0xC);
#undef DPPSTEP
      float act[4];
#pragma unroll
      for (int u = 0; u < 4; ++u) {
        const int kk = k0 + u;
        const float tot = __uint_as_float((unsigned)__builtin_amdgcn_readlane((int)__float_as_uint(dot[u]), 63));
        const float g_ = __uint_as_float((unsigned)__builtin_amdgcn_readlane((int)__float_as_uint(kk < 64 ? ga_lo : ga_hi), kk & 63));
        act[u] = gelu_fast(sub[s0 + u] * (tot - tsum)) * g_ * svb[s0 + u];
      }
#pragma unroll
      for (int u = 0; u < 4; ++u) {
        const float act_ = act[u];
        asum += act_;
        const uint4 c_ = vb[s0 + u];
        f[0] = fmaf(act_, UB0(c_.x), f[0]); f[1] = fmaf(act_, UB1(c_.x), f[1]); f[2] = fmaf(act_, UB2(c_.x), f[2]); f[3] = fmaf(act_, UB3(c_.x), f[3]);
        f[4] = fmaf(act_, UB0(c_.y), f[4]); f[5] = fmaf(act_, UB1(c_.y), f[5]); f[6] = fmaf(act_, UB2(c_.y), f[6]); f[7] = fmaf(act_, UB3(c_.y), f[7]);
        f[8] = fmaf(act_, UB0(c_.z), f[8]); f[9] = fmaf(act_, UB1(c_.z), f[9]); f[10] = fmaf(act_, UB2(c_.z), f[10]); f[11] = fmaf(act_, UB3(c_.z), f[11]);
        f[12] = fmaf(act_, UB0(c_.w), f[12]); f[13] = fmaf(act_, UB1(c_.w), f[13]); f[14] = fmaf(act_, UB2(c_.w), f[14]); f[15] = fmaf(act_, UB3(c_.w), f[15]);
      }
    };
    TLOAD(0, kbeg); TLOAD(1, kbeg + 1); TLOAD(2, kbeg + 2); TLOAD(3, kbeg + 3); TLOAD(4, kbeg + 4); TLOAD(5, kbeg + 5); TLOAD(6, kbeg + 6); TLOAD(7, kbeg + 7);
    const int kend = kbeg + kcnt - 8;
#pragma unroll 1
    for (int k = kbeg; k < kend; k += 8) {
      proc4(0, k); TLOAD(0, k + 8); TLOAD(1, k + 9); TLOAD(2, k + 10); TLOAD(3, k + 11);
      proc4(4, k + 4); TLOAD(4, k + 12); TLOAD(5, k + 13); TLOAD(6, k + 14); TLOAD(7, k + 15);
    }
    proc4(0, kend); proc4(4, kend + 4);
#undef TLOAD
    if (!partial) ln_token<FINAL>(p, row, rr, lane, f, asum, As);
    else {
      float* pp = PART + wave * PARTW + lane * 16;
      *(float4*)pp = make_float4(f[0], f[1], f[2], f[3]); *(float4*)(pp + 4) = make_float4(f[4], f[5], f[6], f[7]);
      *(float4*)(pp + 8) = make_float4(f[8], f[9], f[10], f[11]); *(float4*)(pp + 12) = make_float4(f[12], f[13], f[14], f[15]);
      if (lane == 0) PART[wave * PARTW + 1024] = asum;
    }
  }
  if (extra) {
    __syncthreads();
    if (wave < extra) {
      const int wpt = 8 / extra, rr = nfull * 8 + wave;
      float f[16], asum = 0.f;
#pragma unroll
      for (int j = 0; j < 16; ++j) f[j] = 0.f;
      for (int w2 = wave * wpt; w2 < wave * wpt + wpt; ++w2) {
        const float* pp = PART + w2 * PARTW + lane * 16;
#pragma unroll
        for (int q4 = 0; q4 < 4; ++q4) { const float4 x4 = *(const float4*)(pp + q4 * 4); f[q4 * 4] += x4.x; f[q4 * 4 + 1] += x4.y; f[q4 * 4 + 2] += x4.z; f[q4 * 4 + 3] += x4.w; }
        asum += PART[w2 * PARTW + 1024];
      }
      ln_token<FINAL>(p, g0 + rr, rr, lane, f, asum, As);
    }
  }
}

__device__ __forceinline__ void cvt_plain(const float* __restrict__ a, bf16_t* __restrict__ o, size_t n8, bool lo, size_t gtid, size_t gsz) {
  for (size_t i = gtid; i < n8; i += gsz) {
    float v[8];
    *(float4*)&v[0] = ((const float4*)a)[i * 2]; *(float4*)&v[4] = ((const float4*)a)[i * 2 + 1];
    if (lo) {
#pragma unroll
      for (int j = 0; j < 8; ++j) v[j] = v[j] - bf2f(f2bf(v[j]));
    }
    uint4 w; w.x = pack2bf(v[0], v[1]); w.y = pack2bf(v[2], v[3]); w.z = pack2bf(v[4], v[5]); w.w = pack2bf(v[6], v[7]);
    ((uint4*)o)[i] = w;
  }
}
__device__ __forceinline__ void cvt_t(const float* __restrict__ W, bf16_t* __restrict__ Wt, int K, int N, bool lo, size_t gtid, size_t gsz) {
  const size_t total = (size_t)N * (K / 8);
#pragma unroll 4
  for (size_t i = gtid; i < total; i += gsz) {
    const int n = (int)(i % N), k8 = (int)(i / N);
    float v[8];
#pragma unroll
    for (int j = 0; j < 8; ++j) { const float w = W[(size_t)(k8 * 8 + j) * N + n]; v[j] = lo ? w - bf2f(f2bf(w)) : w; }
    uint4 w; w.x = pack2bf(v[0], v[1]); w.y = pack2bf(v[2], v[3]); w.z = pack2bf(v[4], v[5]); w.w = pack2bf(v[6], v[7]);
    *(uint4*)(Wt + ((size_t)((n >> 4) * (K >> 5) + (k8 >> 2)) * 64 + (k8 & 3) * 16 + (n & 15)) * 8) = w;
  }
}
__device__ __forceinline__ void mod_item(const float* __restrict__ c, const float* __restrict__ c_ctx, const float* __restrict__ ada_w, const float* __restrict__ ada_b,
                                         float* __restrict__ MOD, int item, bool valid, char* lds, int tid, int nct, volatile int* cbc, int& cgen) {
  float* sc = (float*)lds;
  float* part = sc + 3072;
  const int wave = tid >> 6, lane = tid & 63, l = item / 96, cg = item % 96, nw = nct >> 6;
  if (valid) for (int i = tid; i < 3072; i += nct) { const int v = i >> 10, k = i & 1023; const float xv = v < 2 ? c[v * 1024 + k] : c_ctx[k]; sc[i] = xv / (1.f + expf(-xv)); }
  cbar(cbc, cgen, nw);
  if (valid) {
    float a0 = 0.f, a1 = 0.f, a2 = 0.f;
    const float* W = ada_w + (size_t)l * 1024 * 6144 + cg * 64 + lane;
    const int kb = wave * 171, ke = kb + 171 < 1024 ? kb + 171 : 1024;
#pragma unroll 19
    for (int k = kb; k < ke; ++k) { const float w = W[(size_t)k * 6144]; a0 += sc[k] * w; a1 += sc[1024 + k] * w; a2 += sc[2048 + k] * w; }
    part[(wave * 3 + 0) * 64 + lane] = a0; part[(wave * 3 + 1) * 64 + lane] = a1; part[(wave * 3 + 2) * 64 + lane] = a2;
  }
  cbar(cbc, cgen, nw);
  if (valid && tid < 192) {
    const int v = tid >> 6, ln = tid & 63; float sum = 0.f;
    for (int w = 0; w < nw; ++w) sum += part[(w * 3 + v) * 64 + ln];
    MOD[(l * 3 + v) * 6144 + cg * 64 + ln] = sum + ada_b[l * 6144 + cg * 64 + ln];
  }
}

__device__ __forceinline__ void gbar(unsigned* cnt, unsigned target) {
  asm volatile("s_waitcnt vmcnt(0)" ::: "memory");
  __syncthreads();
  if (otid() == 0) {
    __builtin_amdgcn_fence(__ATOMIC_RELEASE, "agent");
    asm volatile("s_waitcnt vmcnt(0)" ::: "memory");
    __hip_atomic_fetch_add(cnt, 1u, __ATOMIC_RELAXED, __HIP_MEMORY_SCOPE_AGENT);
    unsigned spins = 0;
    while (__hip_atomic_load(cnt, __ATOMIC_RELAXED, __HIP_MEMORY_SCOPE_AGENT) < target) { __builtin_amdgcn_s_sleep(2); if (++spins > (1u << 24)) break; }
    __builtin_amdgcn_fence(__ATOMIC_ACQUIRE, "agent");
    asm volatile("s_waitcnt vmcnt(0)" ::: "memory");
  }
  __syncthreads();
}

struct MP {
  const float *x, *c, *ctx, *c_ctx, *ada_w, *ada_b, *ln_g, *ln_b, *s5_a_re, *s5_a_im, *s5_log_dt, *s5_b_re, *s5_b_im, *s5_c_re, *s5_c_im, *s5_d, *s5_w_glu, *s5_w_o;
  const float *mla_w_dq, *mla_q_norm, *mla_w_uq, *mla_w_dkv, *mla_kv_norm, *mla_w_ukv, *mla_w_o, *peer_w_q, *peer_keys, *peer_u, *peer_v;
  float* out;
  float* MOD; bf16_t *Wt_glu, *Wt_o0, *Wt_q0, *Wt_o1, *Wt_q1, *Wt_cat, *Wt_uq, *Wt_ukv, *Khi, *Khi1;
  unsigned char *U0, *V0, *U1, *V1; float *SU0, *SV0, *SU1, *SV1; bf16_t *Ktab, *Bst_t, *Cin_t;
  bf16_t* Ypart; float* Ssta; bf16_t *HP, *Gbf, *Vbf, *Tbf; float *OQ, *H1, *H2; int* IDX; float* GATE;
  bf16_t *Qa, *Kn, *Kr, *Va, *AObf; float* H3; bf16_t* Tbf1; unsigned* BAR; float* PART;
};
constexpr int LDS_BYTES = att::SHM_ATTN > 66 * LDA_B ? att::SHM_ATTN : 66 * LDA_B;
__global__ __launch_bounds__(512) void mega(MP p) {
  __shared__ __attribute__((aligned(16))) char lds[LDS_BYTES];
  cg::grid_group grid = cg::this_grid();
  const int nblk = gridDim.x;
  int bid = blockIdx.x;
  const size_t TD = (size_t)1024 * 16384;
  const float* mod0 = p.MOD; const float* mod1 = p.MOD + 3 * 6144;
  {
    volatile int* cbc = (volatile int*)(lds + LDS_BYTES - 16);
    if (otid() == 0) *cbc = 0;
    __syncthreads();
    const int t0 = otid();
    if (t0 < 128) {
      const size_t mt = (size_t)bid * 128 + t0, ms = (size_t)nblk * 128;
      const int mw = bid * 2 + (t0 >> 6), nmw = nblk * 2;
      cvt_t(p.s5_w_glu, p.Wt_glu, D, D, false, mt, ms);
      cvt_t(p.s5_w_o, p.Wt_o0, D, D, false, mt, ms);
      cvt_t(p.peer_w_q, p.Wt_q0, D, D, false, mt, ms);
      cvt_t(p.mla_w_o, p.Wt_o1, D, D, false, mt, ms);
      cvt_t(p.peer_w_q + (size_t)D * D, p.Wt_q1, D, D, false, mt, ms);
      cvt_t(p.mla_w_dq, p.Wt_cat, D, 384, false, mt, ms);
      cvt_t(p.mla_w_dkv, p.Wt_cat + (size_t)384 * D, D, 320, false, mt, ms);
      cvt_t(p.mla_w_uq, p.Wt_uq, 384, 1536, false, mt, ms);
      cvt_t(p.mla_w_ukv, p.Wt_ukv, 256, 2048, false, mt, ms);
      cvt_plain(p.peer_keys, p.Khi, (size_t)2 * 131072 / 8, false, mt, ms);
      cvt_rows_i8(p.peer_u, p.U0, p.SU0, 16384, mw, nmw);
      cvt_rows_i8(p.peer_v, p.V0, p.SV0, 16384, mw, nmw);
      cvt_rows_i8(p.peer_u + TD, p.U1, p.SU1, 16384, mw, nmw);
      cvt_rows_i8(p.peer_v + TD, p.V1, p.SV1, 16384, mw, nmw);
    } else {
      int cgen = 0;
      const int ct = t0 - 128;
      ph_s5_prep(p.s5_a_re, p.s5_a_im, p.s5_log_dt, p.s5_b_re, p.s5_b_im, p.s5_c_re, p.s5_c_im, p.Ktab, p.Bst_t, p.Cin_t, bid >> 2, bid & 3, lds, ct, 384, cbc, cgen);
      cbar(cbc, cgen, 6);
      mod_item(p.c, p.c_ctx, p.ada_w, p.ada_b, p.MOD, bid, bid < 192, lds, ct, 384, cbc, cgen);
    }
  }
  grid.sync();
  asm volatile("" : "+s"(bid));
  ph_s5_p1(p.x, p.ctx, mod0, p.Ktab, p.Bst_t, p.Ypart, p.Ssta, bid, lds);
  gbar(p.BAR, 1u * (unsigned)nblk);
  asm volatile("" : "+s"(bid));
  if (otid() < 64) ph_s5_carry(p.Ssta, p.s5_a_re, p.s5_a_im, p.s5_log_dt, p.HP, bid, otid());
  gbar(p.BAR, 2u * (unsigned)nblk);
  asm volatile("" : "+s"(bid));
  ph_s5_p3(p.x, p.ctx, mod0, p.s5_d, p.HP, p.Cin_t, p.Ypart, p.Gbf, bid, lds);
  gbar(p.BAR, 3u * (unsigned)nblk);
  asm volatile("" : "+s"(bid));
  {
    ChainP cp{p.Gbf, p.Wt_glu, p.Wt_o0, p.Wt_q0, p.Vbf, (bf16_t*)p.OQ + (size_t)bid * 66 * D, p.x, p.ctx, mod0, p.ln_g, p.ln_b, p.H1, p.Tbf, (bf16_t*)p.OQ + (size_t)bid * 66 * D  };
    ph_chainA<true>(cp, bid, lds);
    __syncthreads();
    ph_route(RouteP{(bf16_t*)p.OQ + (size_t)bid * 66 * D, p.Khi, p.IDX, p.GATE, 66, 0}, bid, lds);
    __syncthreads();
    GatherP gp{p.Tbf, p.IDX, p.GATE, p.U0, p.V0, p.SU0, p.SV0, p.H1, mod0, p.ln_g + D, p.ln_b + D, p.H2, mod1};
    ph_gather_tm<false>(gp, bid * 66, 66, lds, p.PART + (size_t)bid * 8 * PARTW);
    __syncthreads();
    ProjP pp{p.Wt_cat, p.Wt_uq, p.Wt_ukv, p.mla_q_norm, p.mla_kv_norm, p.OQ  , p.Qa, p.Kn, p.Kr, p.Va};
    ph_mla_proj(pp, bid, lds);
  }
  gbar(p.BAR, 4u * (unsigned)nblk);
  asm volatile("" : "+s"(bid));
  ph_attn(p.Qa, p.Kn, p.Kr, p.Va, p.AObf, bid, nblk, lds);
  gbar(p.BAR, 5u * (unsigned)nblk);
  asm volatile("" : "+s"(bid));
  {
    ChainP cp{p.AObf, nullptr, p.Wt_o1, p.Wt_q1, nullptr, (bf16_t*)p.OQ + (size_t)bid * 64 * D, p.H2, p.H2 + (size_t)NL * D, mod1, p.ln_g + 2 * D, p.ln_b + 2 * D, p.H3, p.Tbf1, (bf16_t*)p.OQ + (size_t)bid * 64 * D};
    ph_chainA<false>(cp, bid, lds);
    __syncthreads();
    ph_route(RouteP{(bf16_t*)p.OQ + (size_t)bid * 64 * D, p.Khi1, p.IDX, p.GATE, 64, 0}, bid, lds);
    __syncthreads();
    GatherP gp{p.Tbf1, p.IDX, p.GATE, p.U1, p.V1, p.SU1, p.SV1, p.H3, mod1, p.ln_g + 3 * D, p.ln_b + 3 * D, p.out, mod1};
    ph_gather_tm<true>(gp, bid * 64, 64, lds, p.PART + (size_t)bid * 8 * PARTW);
  }
}

extern "C" void kernel_launch(void* const* d_in, const int* in_sizes, int n_in, void* d_out, int out_size, void* d_ws, size_t ws_size, hipStream_t stream) {
  MP p{};
  const float** in = (const float**)&p;
  for (int i = 0; i < 29; ++i) in[i] = (const float*)d_in[i];
  p.out = (float*)d_out;
  char* ws = (char*)d_ws; size_t off = 0;
  auto carve = [&](size_t bytes) { char* q = ws + off; off += (bytes + 255) / 256 * 256; return q; };
  const size_t TDB = (size_t)1024 * 16384 * 2, BIG = (size_t)NT * D * 4, HALF = (size_t)NT * D * 2;
  p.MOD = (float*)carve(2 * 3 * 6144 * 4);
  p.Wt_glu = (bf16_t*)carve((size_t)D * D * 2); p.Wt_o0 = (bf16_t*)carve((size_t)D * D * 2); p.Wt_q0 = (bf16_t*)carve((size_t)D * D * 2);
  p.Wt_o1 = (bf16_t*)carve((size_t)D * D * 2); p.Wt_q1 = (bf16_t*)carve((size_t)D * D * 2);
  p.Wt_cat = (bf16_t*)carve((size_t)704 * D * 2); p.Wt_uq = (bf16_t*)carve((size_t)1536 * 384 * 2); p.Wt_ukv = (bf16_t*)carve((size_t)2048 * 256 * 2);
  p.Khi = (bf16_t*)carve((size_t)2 * 131072 * 2); p.Khi1 = p.Khi + 131072;
  char* T0 = carve(TDB); p.U0 = (unsigned char*)T0; p.V0 = (unsigned char*)(T0 + TDB / 2); p.AObf = (bf16_t*)T0;
  p.SU0 = (float*)carve(16384 * 4); p.SV0 = (float*)carve(16384 * 4); p.SU1 = (float*)carve(16384 * 4); p.SV1 = (float*)carve(16384 * 4);
  const size_t KTAB_B = (size_t)64 * 127 * 256 * 2, BST_B = (size_t)64 * 256 * 1024 * 2, KN_B = (size_t)NB * 8 * KEYS * 128 * 2, KR_B = (size_t)NB * KEYS * 64 * 2;
  size_t x1 = KTAB_B + 2 * BST_B; if (x1 < 2 * KN_B + KR_B) x1 = 2 * KN_B + KR_B;
  char* X1 = carve(x1);
  p.Ktab = (bf16_t*)X1; p.Bst_t = (bf16_t*)(X1 + KTAB_B); p.Cin_t = (bf16_t*)(X1 + KTAB_B + BST_B);
  p.Kn = (bf16_t*)X1; p.Va = (bf16_t*)(X1 + KN_B); p.Kr = (bf16_t*)(X1 + 2 * KN_B); p.H3 = (float*)X1;
  char* X2 = carve(BIG); p.Ypart = (bf16_t*)X2; p.OQ = (float*)X2;
  char* X3 = carve(HALF); p.Ssta = (float*)X3; p.HP = (bf16_t*)(X3 + (size_t)NCC * 64 * 256 * 4); p.Vbf = (bf16_t*)X3;
  char* X4 = carve(HALF); p.Gbf = (bf16_t*)X4; p.Tbf = (bf16_t*)X4; p.Tbf1 = (bf16_t*)X4;
  char* X5 = carve(BIG); p.H1 = (float*)X5;
  char* T1 = carve(TDB); p.U1 = (unsigned char*)T1; p.V1 = (unsigned char*)(T1 + TDB / 2);
  p.H2 = (float*)carve(BIG);
  p.IDX = (int*)carve((size_t)NT * 128 * 4); p.GATE = (float*)carve((size_t)NT * 128 * 4);
  p.Qa = (bf16_t*)carve((size_t)NB * 8 * SEQ * 192 * 2);
  p.BAR = (unsigned*)carve(256);
  p.PART = (float*)carve((size_t)256 * 8 * PARTW * 4);
  if (off > ws_size || n_in != 29) { fprintf(stderr, "kernel_launch: workspace too small (need %zu, have %zu) or n_in %d != 29\n", off, ws_size, n_in); return; }
  static int grid_blocks = 0;
  if (!grid_blocks) {
    int dev = 0, cus = 0, per_cu = 0;
    hipGetDevice(&dev);
    hipDeviceGetAttribute(&cus, hipDeviceAttributeMultiprocessorCount, dev);
    hipOccupancyMaxActiveBlocksPerMultiprocessor(&per_cu, mega, 512, 0);
    if (per_cu < 1 || cus < 256) { fprintf(stderr, "kernel_launch: need 256 resident workgroups (cus %d, per_cu %d)\n", cus, per_cu); return; }
    grid_blocks = 256;
  }
  hipMemsetAsync(p.BAR, 0, 256, stream);
  void* args[] = {&p};
  hipError_t e = hipLaunchCooperativeKernel((void*)mega, dim3(grid_blocks), dim3(512), args, 0, stream);
  if (e != hipSuccess) fprintf(stderr, "cooperative launch failed: %s\n", hipGetErrorString(e));
}
```

```cpp
#include <hip/hip_runtime.h>
#include <math.h>
#include <hip/hip_cooperative_groups.h>
#include <cstdio>
namespace cg = cooperative_groups;
__device__ __forceinline__ int otid() { int t = (int)__builtin_amdgcn_workitem_id_x(); asm volatile("" : "+v"(t)); return t; }

constexpr int D = 1024, NB = 2, SEQ = 8192, CTX = 256;
constexpr int NL = NB * SEQ, NC = NB * CTX, NT = NL + NC;
constexpr float ALPHA = 1.4142135623730951f;
constexpr float LN_EPS = 1e-5f, RMS_EPS = 1e-6f;

__device__ __forceinline__ float wave_sum_dpp(float v) {
  v += __uint_as_float(__builtin_amdgcn_update_dpp(0u, __float_as_uint(v), 0xB1, 0xF, 0xF, true));
  v += __uint_as_float(__builtin_amdgcn_update_dpp(0u, __float_as_uint(v), 0x4E, 0xF, 0xF, true));
  v += __uint_as_float(__builtin_amdgcn_update_dpp(0u, __float_as_uint(v), 0x141, 0xF, 0xF, true));
  v += __uint_as_float(__builtin_amdgcn_update_dpp(0u, __float_as_uint(v), 0x140, 0xF, 0xF, true));
  v += __uint_as_float(__builtin_amdgcn_update_dpp(0u, __float_as_uint(v), 0x142, 0xA, 0xF, true));
  v += __uint_as_float(__builtin_amdgcn_update_dpp(0u, __float_as_uint(v), 0x143, 0xC, 0xF, true));
  return __uint_as_float((unsigned)__builtin_amdgcn_readlane((int)__float_as_uint(v), 63));
}
__device__ __forceinline__ float wave_sum(float v) { return wave_sum_dpp(v); }
__device__ __forceinline__ int row_vec(int row) { return row < NL ? (row >> 13) : 2; }
__device__ __forceinline__ float gelu_exact(float x) { return 0.5f * x * (1.f + erff(x * 0.70710678118654752f)); }
__device__ __forceinline__ float gelu_fast(float x) {
  const float z = fabsf(x) * 0.70710678118654752f;
  const float t = __builtin_amdgcn_rcpf(fmaf(0.3275911f, z, 1.f));
  float pl = fmaf(1.061405429f, t, -1.453152027f); pl = fmaf(pl, t, 1.421413741f); pl = fmaf(pl, t, -0.284496736f); pl = fmaf(pl, t, 0.254829592f);
  const float e = __builtin_amdgcn_exp2f(-z * z * 1.4426950408889634f);
  const float erfa = 1.f - pl * t * e;
  const float hx = 0.5f * x;
  return hx + fabsf(hx) * erfa;
}


typedef unsigned short bf16_t;
using bf16x8 = __attribute__((ext_vector_type(8))) short;
using f32x4 = __attribute__((ext_vector_type(4))) float;
__device__ __forceinline__ bf16_t f2bf(float f) { unsigned u = __float_as_uint(f); u += 0x7FFFu + ((u >> 16) & 1u); return (bf16_t)(u >> 16); }
__device__ __forceinline__ float bf2f(bf16_t h) { return __uint_as_float(((unsigned)h) << 16); }
__device__ __forceinline__ unsigned pack2bf(float lo, float hi) { return (unsigned)f2bf(lo) | ((unsigned)f2bf(hi) << 16); }
__device__ __forceinline__ float bflo(unsigned w) { return __uint_as_float(w << 16); }
__device__ __forceinline__ float bfhi(unsigned w) { return __uint_as_float(w & 0xFFFF0000u); }


constexpr int LDA_B = 1024 * 2 + 16;
template <int RT, int K>
__device__ __forceinline__ void gemm_unit(const char* const (&ap)[RT], const bf16_t* __restrict__ w0, const bf16_t* __restrict__ w1, int kmul, f32x4 (&acc)[RT][2]) {
  constexpr int KI = K / 128, NS = 2;
#pragma unroll
  for (int t = 0; t < RT; ++t) { acc[t][0] = f32x4{0.f, 0.f, 0.f, 0.f}; acc[t][1] = f32x4{0.f, 0.f, 0.f, 0.f}; }
  bf16x8 b[NS][4][2];
#pragma unroll
  for (int st = 0; st < NS - 1; ++st) {
    if (st < KI) {
#pragma unroll
      for (int s2 = 0; s2 < 4; ++s2) { b[st][s2][0] = *(const bf16x8*)(w0 + (st * 128 + s2 * 32) * kmul); b[st][s2][1] = *(const bf16x8*)(w1 + (st * 128 + s2 * 32) * kmul); }
    }
  }
  asm volatile("" ::: "memory");
  bf16x8 an[RT];
#pragma unroll
  for (int t = 0; t < RT; ++t) an[t] = *(const bf16x8*)(ap[t]);
#pragma unroll
  for (int it = 0; it < KI; ++it) {
    if (it + NS - 1 < KI) {
#pragma unroll
      for (int s2 = 0; s2 < 4; ++s2) {
        b[(it + NS - 1) % NS][s2][0] = *(const bf16x8*)(w0 + ((it + NS - 1) * 128 + s2 * 32) * kmul);
        b[(it + NS - 1) % NS][s2][1] = *(const bf16x8*)(w1 + ((it + NS - 1) * 128 + s2 * 32) * kmul);
      }
    }
    asm volatile("" ::: "memory");
#pragma unroll
    for (int s2 = 0; s2 < 4; ++s2) {
      bf16x8 ac[RT];
#pragma unroll
      for (int t = 0; t < RT; ++t) ac[t] = an[t];
      if (it * 4 + s2 + 1 < KI * 4) {
#pragma unroll
        for (int t = 0; t < RT; ++t) an[t] = *(const bf16x8*)(ap[t] + (it * 128 + s2 * 32 + 32) * 2);
      }
#pragma unroll
      for (int t = 0; t < RT; ++t) {
        acc[t][0] = __builtin_amdgcn_mfma_f32_16x16x32_bf16(ac[t], b[it % NS][s2][0], acc[t][0], 0, 0, 0);
        acc[t][1] = __builtin_amdgcn_mfma_f32_16x16x32_bf16(ac[t], b[it % NS][s2][1], acc[t][1], 0, 0, 0);
      }
    }
  }
}
template <int RT, int K, class Epi>
__device__ __forceinline__ void gemm_ldsA(const char* As, int lda_b, int nrows, const bf16_t* __restrict__ Wt, int N, Epi epi) {
  const int wave = otid() >> 6, lane = otid() & 63, l15 = lane & 15, q = lane >> 4;
  const char* ap[RT];
#pragma unroll
  for (int t = 0; t < RT; ++t) { int r = t * 16 + l15; r = r < nrows ? r : nrows - 1; ap[t] = As + r * lda_b + q * 16; }
#pragma unroll 1
  for (int unit = wave; unit < (N >> 5); unit += 8) {
    const int n0 = unit * 32;
    const bf16_t* w0 = Wt + (size_t)(n0 >> 4) * K * 16 + lane * 8;
    f32x4 acc[RT][2];
    gemm_unit<RT, K>(ap, w0, w0 + (size_t)K * 16, 16, acc);
#pragma unroll
    for (int t = 0; t < RT; ++t)
#pragma unroll
      for (int j = 0; j < 2; ++j)
#pragma unroll
        for (int r = 0; r < 4; ++r) {
          const int row = t * 16 + q * 4 + r, col = n0 + j * 16 + l15;
          if (row < nrows) epi(row, col, acc[t][j][r]);
        }
  }
}
struct EpiBF16 { bf16_t* C; int ldc; __device__ __forceinline__ void operator()(int row, int col, float v) const { C[(size_t)row * ldc + col] = f2bf(v); } };
struct EpiF32 { float* C; int ldc; __device__ __forceinline__ void operator()(int row, int col, float v) const { C[(size_t)row * ldc + col] = v; } };
struct EpiGluL { const char* As; bf16_t* V; __device__ __forceinline__ void operator()(int row, int col, float z) const {
  const float g = bf2f(*(const bf16_t*)(As + row * LDA_B + col * 2)); V[(size_t)row * D + col] = f2bf(g / (1.f + expf(-z))); } };

__device__ __forceinline__ void load_rows_lds(char* As, const bf16_t* __restrict__ src, int nrows) {
  const int t = otid(), total = nrows * 128;
#pragma unroll
  for (int h = 0; h < 2; ++h) {
    uint4 v[9];
#pragma unroll
    for (int k = 0; k < 9; ++k) { int i = t + (h * 9 + k) * 512; i = i < total ? i : total - 1; v[k] = *(const uint4*)(src + (size_t)(i >> 7) * D + (i & 127) * 8); }
#pragma unroll
    for (int k = 0; k < 9; ++k) { const int i = t + (h * 9 + k) * 512; if (i < total) *(uint4*)(As + (i >> 7) * LDA_B + (i & 127) * 16) = v[k]; }
  }
}
__device__ __forceinline__ void ln_rows(char* As, int g0, int nrows, const float* Hl, const float* Hc, const bf16_t* __restrict__ O,
                                        const float* __restrict__ mod, int gate_i, const float* __restrict__ lng, const float* __restrict__ lnb,
                                        float* Hout, bf16_t* __restrict__ Tbf, int shift_i, int scale_i) {
  const int wave = otid() >> 6, lane = otid() & 63;
  for (int rr = wave; rr < nrows; rr += 8) {
    const int row = g0 + rr;
    const float* hin = row < NL ? Hl + (size_t)row * D : Hc + (size_t)(row - NL) * D;
    const bf16_t* f = O + (size_t)row * D;
    const float* m = mod + row_vec(row) * 6144;
    const float* gm = m + gate_i * 1024;
    float r[16]; float s = 0.f;
#pragma unroll
    for (int i = 0; i < 4; ++i) {
      const int d = i * 256 + lane * 4;
      const uint2 fw = *(const uint2*)(f + d);
      float4 h4 = *(const float4*)(hin + d), f4 = make_float4(bflo(fw.x), bfhi(fw.x), bflo(fw.y), bfhi(fw.y)), g4 = *(const float4*)(gm + d);
      r[i * 4 + 0] = ALPHA * h4.x + g4.x * f4.x; r[i * 4 + 1] = ALPHA * h4.y + g4.y * f4.y;
      r[i * 4 + 2] = ALPHA * h4.z + g4.z * f4.z; r[i * 4 + 3] = ALPHA * h4.w + g4.w * f4.w;
      s += r[i * 4 + 0] + r[i * 4 + 1] + r[i * 4 + 2] + r[i * 4 + 3];
    }
    const float mu = wave_sum(s) * (1.f / D);
    float vs = 0.f;
#pragma unroll
    for (int i = 0; i < 16; ++i) { float dlt = r[i] - mu; vs += dlt * dlt; }
    const float rstd = rsqrtf(wave_sum(vs) * (1.f / D) + LN_EPS);
#pragma unroll
    for (int i = 0; i < 4; ++i) {
      const int d = i * 256 + lane * 4;
      float4 g4 = *(const float4*)(lng + d), b4 = *(const float4*)(lnb + d);
      float4 o;
      o.x = (r[i * 4 + 0] - mu) * rstd * g4.x + b4.x; o.y = (r[i * 4 + 1] - mu) * rstd * g4.y + b4.y;
      o.z = (r[i * 4 + 2] - mu) * rstd * g4.z + b4.z; o.w = (r[i * 4 + 3] - mu) * rstd * g4.w + b4.w;
      *(float4*)(Hout + (size_t)row * D + d) = o;
      float4 sh = *(const float4*)(m + shift_i * 1024 + d), sc = *(const float4*)(m + scale_i * 1024 + d);
      const float t0 = o.x * (1.f + sc.x) + sh.x, t1 = o.y * (1.f + sc.y) + sh.y, t2 = o.z * (1.f + sc.z) + sh.z, t3 = o.w * (1.f + sc.w) + sh.w;
      uint2 w; w.x = pack2bf(t0, t1); w.y = pack2bf(t2, t3);
      *(uint2*)(As + rr * LDA_B + d * 2) = w;
      *(uint2*)(Tbf + (size_t)row * D + d) = w;

    }
  }
}


constexpr int S5T = 64, NCHUNK = (CTX + SEQ) / S5T  , NCC = NB * NCHUNK  ;
__device__ __forceinline__ int s5_token(int cc, int s) {
  const int b = cc / NCHUNK, ch = cc - b * NCHUNK;
  return ch < 4 ? NL + b * CTX + ch * S5T + s : b * SEQ + (ch - 4) * S5T + s;
}
__device__ __forceinline__ void cbar(volatile int* cnt, int& gen, int nwaves) {
  __builtin_amdgcn_fence(__ATOMIC_RELEASE, "workgroup");
  if ((otid() & 63) == 0) __hip_atomic_fetch_add((int*)cnt, 1, __ATOMIC_RELAXED, __HIP_MEMORY_SCOPE_WORKGROUP);
  ++gen;
  while (__hip_atomic_load((int*)cnt, __ATOMIC_RELAXED, __HIP_MEMORY_SCOPE_WORKGROUP) < gen * nwaves) __builtin_amdgcn_s_sleep(1);
  __builtin_amdgcn_fence(__ATOMIC_ACQUIRE, "workgroup");
}
__device__ __forceinline__ void ph_s5_prep(const float* __restrict__ a_re, const float* __restrict__ a_im, const float* __restrict__ log_dt,
                                                 const float* __restrict__ b_re, const float* __restrict__ b_im, const float* __restrict__ c_re, const float* __restrict__ c_im,
                                                 bf16_t* __restrict__ Ktab, bf16_t* __restrict__ Bst_t, bf16_t* __restrict__ Cin_t, int g, int part, char* lds, int tid, int nct, volatile int* cbc, int& cgen) {
  float2 (*pw)[65][64] = reinterpret_cast<float2 (*)[65][64]>(lds);
  float2 (*Bp)[64][16] = reinterpret_cast<float2 (*)[64][16]>(lds + 2 * 65 * 64 * 8);
  float2 (*Cc)[16][64] = reinterpret_cast<float2 (*)[16][64]>(lds + 2 * 65 * 64 * 8 + 2 * 64 * 16 * 8);
  float2 (*fs)[64] = reinterpret_cast<float2 (*)[64]>(lds + 2 * 65 * 64 * 8 + 2 * 64 * 16 * 8 + 2 * 16 * 64 * 8);
  if (tid < 128) {
    const int dir = tid >> 6, p = tid & 63, gp = (dir * 64 + g) * 64 + p;
    const float are = a_re[gp], aim = a_im[gp], dt = expf(log_dt[dir * 64 + g]);
    const float mag = expf(are * dt);
    const float abr = mag * cosf(aim * dt), abi = mag * sinf(aim * dt);
    const float nr = abr - 1.f, ni = abi, den = are * are + aim * aim;
    fs[dir][p] = make_float2((nr * are + ni * aim) / den, (ni * are - nr * aim) / den);
    float pr = 1.f, pi = 0.f;
    for (int e = 0; e <= 64; ++e) { pw[dir][e][p] = make_float2(pr, pi); const float nr2 = pr * abr - pi * abi, ni2 = pr * abi + pi * abr; pr = nr2; pi = ni2; }
  }
  cbar(cbc, cgen, nct >> 6);
  for (int i = tid; i < 2048; i += nct) {
    const int dir = i >> 10, p = (i >> 4) & 63, ci = i & 15;
    const size_t gi = ((size_t)(dir * 64 + g) * 64 + p) * 16 + ci;
    const float br = b_re[gi], bi = b_im[gi]; const float2 f = fs[dir][p];
    Bp[dir][p][ci] = make_float2(f.x * br - f.y * bi, f.x * bi + f.y * br);
    const int co = (i >> 6) & 15, p2 = i & 63;
    const size_t ci2 = ((size_t)(dir * 64 + g) * 16 + co) * 64 + p2;
    Cc[dir][co][p2] = make_float2(c_re[ci2], c_im[ci2]);
  }
  cbar(cbc, cgen, nct >> 6);
  for (int i = part * 508 + tid; i < (part + 1) * 508; i += nct) {
    const int ti = i >> 4, co = i & 15, tau = ti - 63;
    float acc[16];
#pragma unroll
    for (int ci = 0; ci < 16; ++ci) acc[ci] = 0.f;
    if (tau >= 0) {
      for (int p = 0; p < 64; ++p) {
        const float2 c = Cc[0][co][p], w = pw[0][tau][p];
        const float xr = c.x * w.x - c.y * w.y, xi = c.x * w.y + c.y * w.x;
#pragma unroll
        for (int ci = 0; ci < 16; ++ci) { const float2 bb = Bp[0][p][ci]; acc[ci] += xr * bb.x - xi * bb.y; }
      }
    }
    if (tau <= 0) {
      for (int p = 0; p < 64; ++p) {
        const float2 c = Cc[1][co][p], w = pw[1][-tau][p];
        const float xr = c.x * w.x - c.y * w.y, xi = c.x * w.y + c.y * w.x;
#pragma unroll
        for (int ci = 0; ci < 16; ++ci) { const float2 bb = Bp[1][p][ci]; acc[ci] += xr * bb.x - xi * bb.y; }
      }
    }
    uint4 o0, o1;
    o0.x = pack2bf(acc[0], acc[1]); o0.y = pack2bf(acc[2], acc[3]); o0.z = pack2bf(acc[4], acc[5]); o0.w = pack2bf(acc[6], acc[7]);
    o1.x = pack2bf(acc[8], acc[9]); o1.y = pack2bf(acc[10], acc[11]); o1.z = pack2bf(acc[12], acc[13]); o1.w = pack2bf(acc[14], acc[15]);
    bf16_t* kp = Ktab + (size_t)g * 127 * 256 + (size_t)i * 16;
    *(uint4*)kp = o0; *(uint4*)(kp + 8) = o1;
  }
  for (int i = part * 8192 + tid; i < (part + 1) * 8192; i += nct) {
    const int n = i >> 7, k8 = i & 127, dir = n >> 7, c = (n >> 6) & 1, p = n & 63, sidx = k8 >> 1, ci0 = (k8 & 1) * 8;
    const float2 w = pw[dir][dir == 0 ? 63 - sidx : sidx][p];
    float v[8];
#pragma unroll
    for (int j = 0; j < 8; ++j) { const float2 b = Bp[dir][p][ci0 + j]; v[j] = c == 0 ? (w.x * b.x - w.y * b.y) : (w.x * b.y + w.y * b.x); }
    uint4 o; o.x = pack2bf(v[0], v[1]); o.y = pack2bf(v[2], v[3]); o.z = pack2bf(v[4], v[5]); o.w = pack2bf(v[6], v[7]);
    *(uint4*)(Bst_t + (size_t)g * 256 * 1024 + ((size_t)((n >> 4) * 32 + (k8 >> 2)) * 64 + (k8 & 3) * 16 + (n & 15)) * 8) = o;
  }
  for (int i = part * 8192 + tid; i < (part + 1) * 8192; i += nct) {
    const int n = i >> 5, k8 = i & 31, t = n >> 4, co = n & 15, dir = k8 >> 4, c = (k8 >> 3) & 1, p0 = (k8 & 7) * 8;
    const int e = dir == 0 ? t + 1 : 64 - t;
    float v[8];
#pragma unroll
    for (int j = 0; j < 8; ++j) { const float2 cc = Cc[dir][co][p0 + j], w = pw[dir][e][p0 + j];
      v[j] = c == 0 ? (cc.x * w.x - cc.y * w.y) : -(cc.x * w.y + cc.y * w.x); }
    uint4 o; o.x = pack2bf(v[0], v[1]); o.y = pack2bf(v[2], v[3]); o.z = pack2bf(v[4], v[5]); o.w = pack2bf(v[6], v[7]);
    *(uint4*)(Cin_t + (size_t)g * 1024 * 256 + ((size_t)((n >> 4) * 8 + (k8 >> 2)) * 64 + (k8 & 3) * 16 + (n & 15)) * 8) = o;
  }
}
__device__ __forceinline__ void ph_s5_p1(const float* __restrict__ x, const float* __restrict__ ctx, const float* __restrict__ mod,
                                               const bf16_t* __restrict__ Ktab, const bf16_t* __restrict__ Bst_t, bf16_t* __restrict__ Ypart, float* __restrict__ S, int bid, char* As) {
  const int g = bid >> 2, cc0 = (bid & 3) * 66, tid = otid();
  const int wave = tid >> 6, lane = tid & 63, l15 = lane & 15, q = lane >> 4;
#pragma unroll 4
  for (int i = tid; i < 66 * 64 * 2; i += 512) {
    const int half = i & 1, sidx = (i >> 1) & 63, r = i >> 7;
    const int tok = s5_token(cc0 + r, sidx), ch = g * 16 + half * 8;
    const float* src = (tok < NL ? x + (size_t)tok * D : ctx + (size_t)(tok - NL) * D) + ch;
    const float* m = mod + row_vec(tok) * 6144;
    const float4 a = *(const float4*)src, b = *(const float4*)(src + 4);
    const float4 sh0 = *(const float4*)(m + ch), sh1 = *(const float4*)(m + ch + 4), sc0 = *(const float4*)(m + 1024 + ch), sc1 = *(const float4*)(m + 1024 + ch + 4);
    uint4 o;
    o.x = pack2bf(a.x * (1.f + sc0.x) + sh0.x, a.y * (1.f + sc0.y) + sh0.y); o.y = pack2bf(a.z * (1.f + sc0.z) + sh0.z, a.w * (1.f + sc0.w) + sh0.w);
    o.z = pack2bf(b.x * (1.f + sc1.x) + sh1.x, b.y * (1.f + sc1.y) + sh1.y); o.w = pack2bf(b.z * (1.f + sc1.z) + sh1.z, b.w * (1.f + sc1.w) + sh1.w);
    *(uint4*)(As + r * LDA_B + sidx * 32 + half * 16) = o;
  }
  __syncthreads();
  const char* ap[5];
#pragma unroll
  for (int t = 0; t < 5; ++t) { int r = t * 16 + l15; r = r < 66 ? r : 65; ap[t] = As + r * LDA_B + q * 16; }
  const bf16_t* Kg = Ktab + (size_t)g * 127 * 256;
#pragma unroll 1
  for (int unit = wave; unit < 40; unit += 8) {
    f32x4 acc[5][2];
    if (unit < 32) {
      const int t0 = unit * 2;
      const bf16_t* w0 = Kg + (t0 + 63 - (q >> 1)) * 256 + l15 * 16 + (q & 1) * 8;
      gemm_unit<5, 1024>(ap, w0, w0 + 256, -16, acc);
#pragma unroll
      for (int t = 0; t < 5; ++t)
#pragma unroll
        for (int j = 0; j < 2; ++j)
#pragma unroll
          for (int r = 0; r < 4; ++r) {
            const int row = t * 16 + q * 4 + r;
            if (row < 66) Ypart[(size_t)s5_token(cc0 + row, t0 + j) * D + g * 16 + l15] = f2bf(acc[t][j][r]);
          }
    } else {
      const int n0 = (unit - 32) * 32;
      const bf16_t* w0 = Bst_t + (size_t)g * 256 * 1024 + (size_t)(n0 >> 4) * 1024 * 16 + lane * 8;
      gemm_unit<5, 1024>(ap, w0, w0 + 1024 * 16, 16, acc);
#pragma unroll
      for (int t = 0; t < 5; ++t)
#pragma unroll
        for (int j = 0; j < 2; ++j)
#pragma unroll
          for (int r = 0; r < 4; ++r) {
            const int row = t * 16 + q * 4 + r;
            if (row < 66) S[((size_t)(cc0 + row) * 64 + g) * 256 + n0 + j * 16 + l15] = acc[t][j][r];
          }
    }
  }
}
__device__ __forceinline__ void ph_s5_carry(const float* __restrict__ S, const float* __restrict__ a_re, const float* __restrict__ a_im,
                                                 const float* __restrict__ log_dt, bf16_t* __restrict__ HP, int id, int p) {
  const int dir = id & 1, g = (id >> 1) & 63, b = id >> 7;
  const int gp = (dir * 64 + g) * 64 + p;
  const float are = a_re[gp], aim = a_im[gp], dt = expf(log_dt[dir * 64 + g]);
  const float mag = expf(are * dt);
  float tr = mag * cosf(aim * dt), ti = mag * sinf(aim * dt);
#pragma unroll
  for (int i = 0; i < 6; ++i) { const float nr = tr * tr - ti * ti, ni = 2.f * tr * ti; tr = nr; ti = ni; }
  float hr = 0.f, hi = 0.f;
#pragma unroll 12
  for (int step = 0; step < NCHUNK; ++step) {
    const int c = dir == 0 ? step : (step < 4 ? 3 - step : NCHUNK - 1 - (step - 4));
    const size_t base = ((size_t)(b * NCHUNK + c) * 64 + g) * 256 + dir * 128 + p;
    HP[base] = f2bf(hr); HP[base + 64] = f2bf(hi);
    const float sr = S[base], si = S[base + 64];
    const float nr = tr * hr - ti * hi + sr, ni = tr * hi + ti * hr + si;
    hr = nr; hi = ni;
  }
}
struct EpiS5 { const float* x; const float* ctx; const bf16_t* Ypart; bf16_t* Gbf; const float* cst; int cc0; int ch;
  __device__ __forceinline__ void operator()(int row, int col, float v) const {
    const int tok = s5_token(cc0 + row, col >> 4), vi = row_vec(tok);
    const float xin = tok < NL ? x[(size_t)tok * D + ch] : ctx[(size_t)(tok - NL) * D + ch];
    const float mm = xin * (1.f + cst[1 + vi * 2]) + cst[2 + vi * 2];
    const float y = v + bf2f(Ypart[(size_t)tok * D + ch]) + cst[0] * mm;
    Gbf[(size_t)tok * D + ch] = f2bf(gelu_fast(y));
  } };
__device__ __forceinline__ void ph_s5_p3(const float* __restrict__ x, const float* __restrict__ ctx, const float* __restrict__ mod, const float* __restrict__ dvec,
                                               const bf16_t* __restrict__ HP, const bf16_t* __restrict__ Cin_t, const bf16_t* __restrict__ Ypart, bf16_t* __restrict__ Gbf, int bid, char* As) {
  const int g = bid >> 2, cc0 = (bid & 3) * 66, tid = otid();
  for (int i = tid; i < 66 * 32; i += 512) {
    const int r = i >> 5, c = i & 31;
    *(uint4*)(As + r * 528 + c * 16) = *(const uint4*)(HP + ((size_t)(cc0 + r) * 64 + g) * 256 + c * 8);
  }
  __syncthreads();
  float* cst = (float*)(As + 66 * 528);
  if (tid < 16) {
    const int c0 = g * 16 + tid;
    cst[tid * 8 + 0] = dvec[c0];
    cst[tid * 8 + 1] = mod[1024 + c0]; cst[tid * 8 + 2] = mod[c0];
    cst[tid * 8 + 3] = mod[6144 + 1024 + c0]; cst[tid * 8 + 4] = mod[6144 + c0];
    cst[tid * 8 + 5] = mod[2 * 6144 + 1024 + c0]; cst[tid * 8 + 6] = mod[2 * 6144 + c0];
  }
  __syncthreads();
  gemm_ldsA<5, 256>(As, 528, 66, Cin_t + (size_t)g * 1024 * 256, 1024, EpiS5{x, ctx, Ypart, Gbf, cst + (otid() & 15) * 8, cc0, g * 16 + (otid() & 15)});
}


struct ChainP {
  const bf16_t* Ain;
  const bf16_t* Wglu_t; const bf16_t* Wo_t; const bf16_t* Wq_t;
  bf16_t* Vbf; bf16_t* O; const float* Hl; const float* Hc; const float* mod; const float* lng; const float* lnb;
  float* Hout; bf16_t* Tbf; bf16_t* Q;
};
template <bool L0>
__device__ __forceinline__ void ph_chainA(const ChainP& p, int bid, char* As) {
  constexpr int NR = L0 ? 66 : 64;
  constexpr int RT = L0 ? 5 : 4;
  const int g0 = bid * NR;
  load_rows_lds(As, p.Ain + (size_t)g0 * D, NR);
  __syncthreads();
  if (L0) {
    gemm_ldsA<RT, 1024>(As, LDA_B, NR, p.Wglu_t, D, EpiGluL{As, p.Vbf + (size_t)g0 * D});
    __syncthreads();
    load_rows_lds(As, p.Vbf + (size_t)g0 * D, NR);
    __syncthreads();
  }
  gemm_ldsA<RT, 1024>(As, LDA_B, NR, p.Wo_t, D, EpiBF16{p.O + (size_t)g0 * D, D});
  __syncthreads();
  ln_rows(As, g0, NR, p.Hl, p.Hc, p.O, p.mod, 2, p.lng, p.lnb, p.Hout, p.Tbf, 3, 4);
  __syncthreads();
  gemm_ldsA<RT, 1024>(As, LDA_B, NR, p.Wq_t, D, EpiBF16{p.Q + (size_t)g0 * D, D});
}


constexpr int KEYS = SEQ + CTX;
struct EpiKV { bf16_t* Kn; bf16_t* Va; int g0; int pad; __device__ __forceinline__ void operator()(int row, int col, float v) const {
  const int g = g0 + row; int b, key;
  if (g < NL) { b = g >> 13; key = g & (SEQ - 1); } else { const int cidx = g - NL; b = cidx >> 8; key = SEQ + (cidx & (CTX - 1)); }
  const int head = col >> 8, j = col & 255;
  if (j < 128) Kn[((size_t)(b * 8 + head) * KEYS + key) * 128 + j] = f2bf(v);
  else Va[((size_t)(b * 8 + head) * KEYS + key) * 128 + (j - 128)] = f2bf(v);
} };
struct EpiQ { bf16_t* Qa; int g0; int pad; __device__ __forceinline__ void operator()(int row, int col, float v) const {
  const int g = g0 + row, b = g >> 13, n = g & (SEQ - 1);
  const int head = col / 192, j = col - head * 192;
  Qa[((size_t)(b * 8 + head) * SEQ + n) * 192 + j] = f2bf(v);
} };
struct ProjP { const bf16_t* Wcat_t; const bf16_t* Wuq_t; const bf16_t* Wukv_t; const float* q_norm; const float* kv_norm;
               float* PR; bf16_t* Qa; bf16_t* Kn; bf16_t* Kr; bf16_t* Va; };
__device__ __forceinline__ void ph_mla_proj(const ProjP& p, int bid, char* As) {
  const int g0 = bid * 66, wave = otid() >> 6, lane = otid() & 63;
  gemm_ldsA<5, 1024>(As, LDA_B, 66, p.Wcat_t, 704, EpiF32{p.PR + (size_t)g0 * D, D});
  __syncthreads();
  char* A1 = As; char* A2 = As + 66 * 784;
  for (int rr = wave; rr < 66; rr += 8) {
    const int g = g0 + rr;
    const float* pr = p.PR + (size_t)g * D;
    float v[6]; float ss = 0.f;
#pragma unroll
    for (int i = 0; i < 6; ++i) { v[i] = pr[i * 64 + lane]; ss += v[i] * v[i]; }
    float rn = rsqrtf(wave_sum(ss) * (1.f / 384.f) + RMS_EPS);
#pragma unroll
    for (int i = 0; i < 6; ++i) *(bf16_t*)(A1 + rr * 784 + (i * 64 + lane) * 2) = f2bf(v[i] * rn * p.q_norm[i * 64 + lane]);
    float w[4]; ss = 0.f;
#pragma unroll
    for (int i = 0; i < 4; ++i) { w[i] = pr[384 + i * 64 + lane]; ss += w[i] * w[i]; }
    rn = rsqrtf(wave_sum(ss) * (1.f / 256.f) + RMS_EPS);
#pragma unroll
    for (int i = 0; i < 4; ++i) *(bf16_t*)(A2 + rr * 528 + (i * 64 + lane) * 2) = f2bf(w[i] * rn * p.kv_norm[i * 64 + lane]);
    if (lane < 32) {
      float x1 = pr[640 + lane], x2 = pr[672 + lane];
      int b, key;
      if (g < NL) {
        b = g >> 13; key = g & (SEQ - 1);
        const int n = key, rr2 = n >> 6, cc = n & 63;
        const float inv = powf(10000.f, -(float)(lane & 15) / 16.f);
        const float ang = (lane < 16 ? (float)rr2 : (float)cc) * inv;
        const float cs = cosf(ang), sn = sinf(ang);
        const float y1 = x1 * cs - x2 * sn, y2 = x2 * cs + x1 * sn; x1 = y1; x2 = y2;
      } else { const int cidx = g - NL; b = cidx >> 8; key = SEQ + (cidx & (CTX - 1)); }
      bf16_t* kp = p.Kr + ((size_t)b * KEYS + key) * 64;
      kp[lane] = f2bf(x1); kp[32 + lane] = f2bf(x2);
    }
  }
  __syncthreads();
  int nq = NL - g0; nq = nq > 66 ? 66 : nq;
  if (nq > 0) gemm_ldsA<5, 384>(A1, 784, nq, p.Wuq_t, 1536, EpiQ{p.Qa, g0, 0});
  gemm_ldsA<5, 256>(A2, 528, 66, p.Wukv_t, 2048, EpiKV{p.Kn, p.Va, g0, 0});
  __syncthreads();
  for (int rr = wave; rr < nq; rr += 8) {
    const int g = g0 + rr, b = g >> 13, n = g & (SEQ - 1);
    if (lane < 32) {
      const float inv = powf(10000.f, -(float)(lane & 15) / 16.f);
      const float ang = (lane < 16 ? (float)(n >> 6) : (float)(n & 63)) * inv;
      const float cs = cosf(ang), sn = sinf(ang);
#pragma unroll
      for (int h = 0; h < 8; ++h) {
        bf16_t* qo = p.Qa + ((size_t)(b * 8 + h) * SEQ + n) * 192;
        const float x1 = bf2f(qo[128 + lane]), x2 = bf2f(qo[160 + lane]);
        qo[128 + lane] = f2bf(x1 * cs - x2 * sn); qo[160 + lane] = f2bf(x2 * cs + x1 * sn);
      }
    }
  }
}

namespace att {
using s16x4 = __attribute__((ext_vector_type(4))) short;
using f32x16 = __attribute__((ext_vector_type(16))) float;
using u32x4 = __attribute__((ext_vector_type(4))) unsigned;
constexpr int KVBLK = 64, KROW = 400;
constexpr float SCALE = 0.07216878364870322f;
constexpr float THR = 8.f;
constexpr int SHM_V = KVBLK * 128 * 2, SHM_K = KVBLK * KROW, QRROW = 272, SHM_QR = 256 * QRROW, SHM_ATTN = 2 * SHM_V + 2 * SHM_K + 8 * 64 * 4 + SHM_QR;
#define SBAR() __builtin_amdgcn_sched_barrier(0)
__device__ __forceinline__ int crow(int r, int hi) { return (r & 3) + 8 * (r >> 2) + 4 * hi; }
__device__ __forceinline__ unsigned cvtpk(float lo, float hi) { unsigned r; asm volatile("v_cvt_pk_bf16_f32 %0, %1, %2" : "=v"(r) : "v"(lo), "v"(hi)); return r; }
__device__ __forceinline__ void partialSM(f32x16& p0, f32x16& p1, float& m_reg, float& mn, float& alpha) {
  constexpr float C = SCALE * 1.4426950408889634f;
  float pmax = p0[0];
#pragma unroll
  for (int r = 1; r < 16; ++r) pmax = fmaxf(pmax, p0[r]);
#pragma unroll
  for (int r = 0; r < 16; ++r) pmax = fmaxf(pmax, p1[r]);
  { auto rr = __builtin_amdgcn_permlane32_swap(__float_as_uint(pmax), __float_as_uint(pmax), false, false);
    pmax = fmaxf(__uint_as_float(rr[0]), __uint_as_float(rr[1])); }
  if (__builtin_expect(__all(pmax - m_reg <= THR / SCALE), 1)) { mn = m_reg; alpha = 1.f; }
  else { mn = fmaxf(m_reg, pmax); alpha = __builtin_amdgcn_exp2f((m_reg - mn) * C); m_reg = mn; }
  const float mnC = -mn * C;
#pragma unroll
  for (int r = 0; r < 16; ++r) p0[r] = fmaf(p0[r], C, mnC);
#pragma unroll
  for (int r = 0; r < 16; ++r) p1[r] = fmaf(p1[r], C, mnC);
#pragma unroll
  for (int r = 0; r < 16; ++r) p0[r] = __builtin_amdgcn_exp2f(p0[r]);
}
__device__ __forceinline__ void finishSM(f32x16& p0, f32x16& p1, float alpha, float& l_reg, bf16x8& pa0, bf16x8& pa1, bf16x8& pa2, bf16x8& pa3) {
#pragma unroll
  for (int r = 0; r < 16; ++r) p1[r] = __builtin_amdgcn_exp2f(p1[r]);
  float ps = 0;
#pragma unroll
  for (int r = 0; r < 16; ++r) ps += p0[r];
#pragma unroll
  for (int r = 0; r < 16; ++r) ps += p1[r];
  { auto rr = __builtin_amdgcn_permlane32_swap(__float_as_uint(ps), __float_as_uint(ps), false, false);
    ps = __uint_as_float(rr[0]) + __uint_as_float(rr[1]); }
  l_reg = l_reg * alpha + ps;
#define PK4(P, BASE, OUT) do { unsigned a0 = cvtpk(P[BASE + 0], P[BASE + 1]), a1 = cvtpk(P[BASE + 2], P[BASE + 3]);   \
    unsigned b0 = cvtpk(P[BASE + 4], P[BASE + 5]), b1 = cvtpk(P[BASE + 6], P[BASE + 7]);                              \
    auto r0 = __builtin_amdgcn_permlane32_swap(a0, b0, false, false); auto r1 = __builtin_amdgcn_permlane32_swap(a1, b1, false, false); \
    u32x4 w = {r0[0], r1[0], r0[1], r1[1]}; OUT = *reinterpret_cast<bf16x8*>(&w); } while (0)
  PK4(p0, 0, pa0); PK4(p0, 8, pa1); PK4(p1, 0, pa2); PK4(p1, 8, pa3);
#undef PK4
}
__device__ __forceinline__ void qkt(f32x16& p0, f32x16& p1, const char* Ks, const bf16x8* qr, const char* qrl, int r32, int hi) {
  p0 = f32x16{}; p1 = f32x16{};
#pragma unroll
  for (int d0 = 0; d0 < 12; ++d0) { const int cb = (d0 * 16 + hi * 8) * 2;
    bf16x8 b0 = *reinterpret_cast<const bf16x8*>(Ks + r32 * KROW + cb);
    bf16x8 b1 = *reinterpret_cast<const bf16x8*>(Ks + (32 + r32) * KROW + cb);
    const bf16x8 qv = d0 < 4 ? qr[d0 < 4 ? d0 : 0] : *reinterpret_cast<const bf16x8*>(qrl + (d0 - 4) * 32);
    p0 = __builtin_amdgcn_mfma_f32_32x32x16_bf16(b0, qv, p0, 0, 0, 0);
    p1 = __builtin_amdgcn_mfma_f32_32x32x16_bf16(b1, qv, p1, 0, 0, 0); }
}
__device__ __forceinline__ int v_st(int k, int c) { const int kk = (k & ~0xC) | ((k & 4) << 1) | ((k & 8) >> 1); return ((kk >> 3) * 4 + (c >> 5)) * 512 + ((kk & 7) * 32 + (c & 31)) * 2; }
__device__ __forceinline__ int v_rd_base(int lane) { return ((lane & 3) << 3) | (((lane >> 2) & 3) << 6) | (((lane >> 4) & 1) << 5) | (((lane >> 5) & 1) << 8); }
constexpr int v_rd_off(int d0, int ks, int half) { return d0 * 512 + ks * 4096 + half * 2048; }
template <int OFF> __device__ __forceinline__ s16x4 tr_read(int vb) {
  s16x4 r; asm volatile("ds_read_b64_tr_b16 %0, %1 offset:%2" : "=&v"(r) : "v"(vb), "i"(OFF) : "memory"); return r;
}
template <int D0> __device__ __forceinline__ void pv_one(f32x16& od, int vb, bf16x8 pa0, bf16x8 pa1, bf16x8 pa2, bf16x8 pa3) {
  const s16x4 l0 = tr_read<v_rd_off(D0, 0, 0)>(vb), h0 = tr_read<v_rd_off(D0, 0, 1)>(vb), l1 = tr_read<v_rd_off(D0, 1, 0)>(vb), h1 = tr_read<v_rd_off(D0, 1, 1)>(vb);
  const s16x4 l2 = tr_read<v_rd_off(D0, 2, 0)>(vb), h2 = tr_read<v_rd_off(D0, 2, 1)>(vb), l3 = tr_read<v_rd_off(D0, 3, 0)>(vb), h3 = tr_read<v_rd_off(D0, 3, 1)>(vb);
  asm volatile("s_waitcnt lgkmcnt(0)" ::: "memory"); SBAR();
#define PK(L, H) (bf16x8){L[0], L[1], L[2], L[3], H[0], H[1], H[2], H[3]}
  od = __builtin_amdgcn_mfma_f32_32x32x16_bf16(pa0, PK(l0, h0), od, 0, 0, 0);
  od = __builtin_amdgcn_mfma_f32_32x32x16_bf16(pa1, PK(l1, h1), od, 0, 0, 0);
  od = __builtin_amdgcn_mfma_f32_32x32x16_bf16(pa2, PK(l2, h2), od, 0, 0, 0);
  od = __builtin_amdgcn_mfma_f32_32x32x16_bf16(pa3, PK(l3, h3), od, 0, 0, 0);
#undef PK
}
__device__ __forceinline__ void pv_d0(f32x16* o, int vb, bf16x8 pa0, bf16x8 pa1, bf16x8 pa2, bf16x8 pa3) {
  pv_one<0>(o[0], vb, pa0, pa1, pa2, pa3); pv_one<1>(o[1], vb, pa0, pa1, pa2, pa3); pv_one<2>(o[2], vb, pa0, pa1, pa2, pa3); pv_one<3>(o[3], vb, pa0, pa1, pa2, pa3);
}
__device__ __forceinline__ void attn_body(const bf16_t* __restrict__ Qb, const bf16_t* __restrict__ Kh, const bf16_t* __restrict__ Krb, const bf16_t* __restrict__ Vh,
                                          bf16_t* __restrict__ Ob, int nkeys, char* lds) {
  const int tid = otid(), wid = tid >> 6, lane = tid & 63, r32 = lane & 31, hi = lane >> 5;
  char* V_lds = lds; char* K_lds = lds + 2 * SHM_V;
  float* ws = (float*)(lds + 2 * SHM_V + 2 * SHM_K) + wid * 64; float* li_l = ws; float* al_l = ws + 32;
  float m_reg = -1e30f, l_reg = 0; f32x16 o[4] = {}; bf16x8 qr[4];
  const bf16_t* Qw = Qb + (size_t)(wid * 32 + r32) * 192 + hi * 8;
  char* qrl = lds + 2 * SHM_V + 2 * SHM_K + 8 * 64 * 4 + (wid * 32 + r32) * QRROW + hi * 16;
#pragma unroll
  for (int d0 = 0; d0 < 4; ++d0) qr[d0] = *reinterpret_cast<const bf16x8*>(Qw + d0 * 16);
#pragma unroll
  for (int d0 = 4; d0 < 12; ++d0) *reinterpret_cast<bf16x8*>(qrl + (d0 - 4) * 32) = *reinterpret_cast<const bf16x8*>(Qw + d0 * 16);
  const int sr = tid >> 4, sc = (tid & 15) * 8, vst0 = v_st(sr, sc), vst1 = v_st(32 + sr, sc);
  const int krw = tid >> 3, kch = tid & 7;
  const int vb0 = (int)(uintptr_t)V_lds + v_rd_base(lane);
  bf16x8 vs0, vs1, ks0, ks1, ks2;
#define SLOAD(k0) do { vs0 = *reinterpret_cast<const bf16x8*>(&Vh[(size_t)((k0) + sr) * 128 + sc]); vs1 = *reinterpret_cast<const bf16x8*>(&Vh[(size_t)((k0) + 32 + sr) * 128 + sc]); \
    const bf16_t* kp_ = &Kh[(size_t)((k0) + krw) * 128 + kch * 8]; \
    ks0 = *reinterpret_cast<const bf16x8*>(kp_); ks1 = *reinterpret_cast<const bf16x8*>(kp_ + 64); \
    ks2 = *reinterpret_cast<const bf16x8*>(&Krb[(size_t)((k0) + krw) * 64 + kch * 8]); } while (0)
#define SWRITE(b) do { *(bf16x8*)(V_lds + (b) * SHM_V + vst0) = vs0; *(bf16x8*)(V_lds + (b) * SHM_V + vst1) = vs1; \
    char* kl_ = K_lds + (b) * SHM_K + krw * KROW + kch * 16; \
    *(bf16x8*)(kl_) = ks0; *(bf16x8*)(kl_ + 128) = ks1; *(bf16x8*)(kl_ + 256) = ks2; } while (0)
#define SWAIT() asm volatile("s_waitcnt vmcnt(0)" ::: "memory")
#define RESC(a) do { if (__any((a) < 1.f)) { if (hi == 0) al_l[r32] = (a); asm volatile("s_waitcnt lgkmcnt(0)" ::: "memory"); \
    for (int d = 0; d < 4; ++d) for (int r = 0; r < 16; ++r) o[d][r] *= al_l[crow(r, hi)]; } } while (0)
  f32x16 pA0, pA1, pB0, pB1; float mnA, mnB, alA, alB; bf16x8 pa0, pa1, pa2, pa3; const int NTL = nkeys / KVBLK;
  SLOAD(0); SWAIT(); SWRITE(0); __syncthreads();
  qkt(pA0, pA1, K_lds, qr, qrl, r32, hi); partialSM(pA0, pA1, m_reg, mnA, alA);
  SLOAD(KVBLK);
  SWAIT(); SWRITE(1); __syncthreads();
  for (int j = 1; j + 1 < NTL; j += 2) {
    SBAR(); qkt(pB0, pB1, K_lds + SHM_K, qr, qrl, r32, hi);
    finishSM(pA0, pA1, alA, l_reg, pa0, pa1, pa2, pa3); SBAR();
    SLOAD((j + 1) * KVBLK); SBAR();
    pv_d0(o, vb0, pa0, pa1, pa2, pa3); partialSM(pB0, pB1, m_reg, mnB, alB);
    __syncthreads(); SWAIT(); SWRITE(0);
    RESC(alB); __syncthreads();
    SBAR(); qkt(pA0, pA1, K_lds, qr, qrl, r32, hi);
    finishSM(pB0, pB1, alB, l_reg, pa0, pa1, pa2, pa3); SBAR();
    SLOAD((j + 2) * KVBLK); SBAR();
    pv_d0(o, vb0 + SHM_V, pa0, pa1, pa2, pa3); partialSM(pA0, pA1, m_reg, mnA, alA);
    __syncthreads(); SWAIT(); SWRITE(1);
    RESC(alA); __syncthreads();
  }
  SBAR(); qkt(pB0, pB1, K_lds + SHM_K, qr, qrl, r32, hi);
  finishSM(pA0, pA1, alA, l_reg, pa0, pa1, pa2, pa3); SBAR();
  pv_d0(o, vb0, pa0, pa1, pa2, pa3); partialSM(pB0, pB1, m_reg, mnB, alB);
  __syncthreads(); RESC(alB);
  finishSM(pB0, pB1, alB, l_reg, pa0, pa1, pa2, pa3); SBAR();
  pv_d0(o, vb0 + SHM_V, pa0, pa1, pa2, pa3);
  if (hi == 0) li_l[r32] = l_reg; asm volatile("s_waitcnt lgkmcnt(0)" ::: "memory");
  float rli[16];
#pragma unroll
  for (int r = 0; r < 16; ++r) rli[r] = __builtin_amdgcn_rcpf(li_l[crow(r, hi)]);
  bf16_t* Ow = Ob + (size_t)(wid * 32) * D;
#pragma unroll
  for (int r = 0; r < 16; ++r) { const int orow = crow(r, hi);
#pragma unroll
    for (int d0 = 0; d0 < 4; ++d0) Ow[(size_t)orow * D + d0 * 32 + r32] = f2bf(o[d0][r] * rli[r]); }
  __syncthreads();
#undef SLOAD
#undef SWRITE
#undef SWAIT
#undef RESC
}
}

__device__ __forceinline__ void ph_attn(const bf16_t* __restrict__ Qa, const bf16_t* __restrict__ Kn, const bf16_t* __restrict__ Kr, const bf16_t* __restrict__ Va,
                                        bf16_t* __restrict__ AO, int bid, int nblk, char* lds) {
  for (int item = bid; item < 512; item += nblk) {
    const int b = item >> 8, h = item & 7, qb = (item >> 3) & 31;
    att::attn_body(Qa + ((size_t)(b * 8 + h) * SEQ + qb * 256) * 192, Kn + (size_t)(b * 8 + h) * KEYS * 128, Kr + (size_t)b * KEYS * 64,
                   Va + (size_t)(b * 8 + h) * KEYS * 128, AO + (size_t)(b * SEQ + qb * 256) * D + h * 128, KEYS, lds);
  }
}

namespace rt {
using f32x16 = __attribute__((ext_vector_type(16))) float;
__device__ __forceinline__ int sortable(float f) { const int b = __float_as_int(f); return b ^ ((b >> 31) & 0x7FFFFFFF); }
__device__ __forceinline__ float unsortable(int k) { return __int_as_float(k ^ ((k >> 31) & 0x7FFFFFFF)); }
__device__ __forceinline__ int imax(int a, int b) { return a > b ? a : b; }
__device__ __forceinline__ int imin(int a, int b) { return a < b ? a : b; }
template <int N> __device__ __forceinline__ void sort_desc(int (&v)[N]) {
#pragma unroll
  for (int k = 2; k <= N; k <<= 1) {
#pragma unroll
    for (int j = k >> 1; j > 0; j >>= 1) {
#pragma unroll
      for (int i = 0; i < N; ++i) {
        const int l = i ^ j;
        if (l > i) {
          const bool desc = ((i & k) == 0);
          const int a = v[i], b = v[l];
          v[i] = desc ? imax(a, b) : imin(a, b);
          v[l] = desc ? imin(a, b) : imax(a, b);
        }
      }
    }
  }
}
template <int N> __device__ __forceinline__ void merge_desc(int (&v)[N]) {
#pragma unroll
  for (int j = N >> 1; j > 0; j >>= 1) {
#pragma unroll
    for (int i = 0; i < N; ++i) {
      const int l = i ^ j;
      if (l > i) { const int a = v[i], b = v[l]; v[i] = imax(a, b); v[l] = imin(a, b); }
    }
  }
}
__device__ __forceinline__ void absorb16(int (&L)[16], int (&B)[16]) {
  sort_desc<16>(B);
#pragma unroll
  for (int i = 0; i < 16; ++i) L[i] = imax(L[i], B[15 - i]);
  merge_desc<16>(L);
}
__device__ __forceinline__ constexpr int npairs_row(int i) { return 16 / (i + 1); }
}

struct RouteP { const bf16_t* Q; const bf16_t* Khi; int* IDX; float* GATE; int rows_per_block; int pad; };
__device__ __forceinline__ void ph_route(const RouteP& p, int bid, char* lds) {
  using namespace rt;
  int (*svl)[64][33] = reinterpret_cast<int (*)[64][33]>(lds);
  const int wave = otid() >> 6, lane = otid() & 63, r32 = lane & 31, hi = lane >> 5, hi4 = hi * 4;
  int nrows = p.rows_per_block; asm volatile("" : "+s"(nrows));
  const int g0 = bid * nrows;
  const int h = wave;
#pragma unroll 1
  for (int tg = 0; tg * 32 < nrows; ++tg) {
    int trow = tg * 32 + r32; const bool valid = trow < nrows; trow = valid ? trow : nrows - 1;
    const bf16_t* qrow = p.Q + (size_t)(g0 + trow) * D;
    int sv[2][16];
#pragma unroll
    for (int s = 0; s < 2; ++s) {
      const int hs = h * 2 + s;
      f32x16 acc[4];
#pragma unroll
      for (int m = 0; m < 4; ++m) acc[m] = f32x16{};
#pragma unroll
      for (int kp = 0; kp < 2; ++kp) {
        bf16x8 kf[2][4], qf[2];
#pragma unroll
        for (int k2 = 0; k2 < 2; ++k2)
#pragma unroll
          for (int m = 0; m < 4; ++m) kf[k2][m] = *(const bf16x8*)(p.Khi + ((size_t)(hs * 128 + m * 32 + r32)) * 64 + (kp * 2 + k2) * 16 + hi * 8);
#pragma unroll
        for (int k2 = 0; k2 < 2; ++k2) {
          const int ks = kp * 2 + k2;
          qf[k2] = *(const bf16x8*)(qrow + hs * 64 + ks * 16 + hi * 8);
        }
#pragma unroll
        for (int k2 = 0; k2 < 2; ++k2)
#pragma unroll
          for (int m = 0; m < 4; ++m) acc[m] = __builtin_amdgcn_mfma_f32_32x32x16_bf16(kf[k2][m], qf[k2], acc[m], 0, 0, 0);
      }
      int L[16];
#pragma unroll
      for (int m = 0; m < 4; ++m) {
        int B[16];
#pragma unroll
        for (int r = 0; r < 16; ++r) B[r] = (sortable(acc[m][r]) & ~0x7F) | (m * 32 + (r & 3) + 8 * (r >> 2)) | hi4;
        if (m == 0) { sort_desc<16>(B);
#pragma unroll
          for (int i = 0; i < 16; ++i) L[i] = B[i]; }
        else absorb16(L, B);
      }
      int Lo[16], Hi[16];
#pragma unroll
      for (int i = 0; i < 16; ++i) { auto rr = __builtin_amdgcn_permlane32_swap((unsigned)L[i], (unsigned)L[i], false, false); Lo[i] = (int)rr[0]; Hi[i] = (int)rr[1]; }
#pragma unroll
      for (int i = 0; i < 16; ++i) L[i] = imax(Lo[i], Hi[15 - i]);
      merge_desc<16>(L);
#pragma unroll
      for (int i = 0; i < 16; ++i) { sv[s][i] = L[i]; svl[wave][lane][s * 16 + i] = L[i]; }
    }
    float f0[16], f1[16];
#pragma unroll
    for (int i = 0; i < 16; ++i) { f0[i] = unsortable(sv[0][i] & ~0x7F); f1[i] = unsortable(sv[1][i] & ~0x7F); }
    int Lc[16];
    {
      int C[64];
      int n = 0;
#pragma unroll
      for (int i = 0; i < 16; ++i)
#pragma unroll
        for (int j = 0; j < 16; ++j)
          if ((i + 1) * (j + 1) <= 16) { C[n] = (sortable(f0[i] + f1[j]) & ~0xFF) | (i * 16 + j); ++n; }
#pragma unroll
      for (int k = 50; k < 64; ++k) C[k] = (int)0x80000000;
#pragma unroll
      for (int m = 0; m < 4; ++m) {
        int B[16];
#pragma unroll
        for (int r = 0; r < 16; ++r) B[r] = C[m * 16 + r];
        if (m == 0) { sort_desc<16>(B);
#pragma unroll
          for (int i = 0; i < 16; ++i) Lc[i] = B[i]; }
        else absorb16(Lc, B);
      }
    }
    float e[16]; float esum = 0.f;
    const float vmax = unsortable(Lc[0] & ~0xFF);
#pragma unroll
    for (int r = 0; r < 16; ++r) { e[r] = expf(unsortable(Lc[r] & ~0xFF) - vmax); esum += e[r]; }
    const float inv = 1.f / esum;
    int eid[16];
#pragma unroll
    for (int r = 0; r < 16; ++r) {
      const int pr = Lc[r] & 0xFF;
      const int k0 = svl[wave][lane][pr >> 4] & 0x7F, k1 = svl[wave][lane][16 + (pr & 15)] & 0x7F;
      eid[r] = k0 * 128 + k1;
    }
    if (valid && hi == 0) {
      int* ip = p.IDX + (size_t)(g0 + trow) * 128 + h * 16; float* gp = p.GATE + (size_t)(g0 + trow) * 128 + h * 16;
#pragma unroll
      for (int r = 0; r < 16; r += 4) {
        *(int4*)(ip + r) = make_int4(eid[r], eid[r + 1], eid[r + 2], eid[r + 3]);
        *(float4*)(gp + r) = make_float4(e[r] * inv, e[r + 1] * inv, e[r + 2] * inv, e[r + 3] * inv);
      }
    }
  }
}

__device__ __forceinline__ void cvt_rows_i8(const float* __restrict__ src, unsigned char* __restrict__ dst, float* __restrict__ scl, int nrows, int wgid, int nw) {
  const int lane = otid() & 63;
  for (int r0 = wgid * 4; r0 < nrows; r0 += nw * 4) {
    float v[4][16];
#pragma unroll
    for (int u = 0; u < 4; ++u) {
      const float* sp = src + (size_t)(r0 + u) * D + lane * 4;
      *(float4*)&v[u][0] = *(const float4*)sp; *(float4*)&v[u][4] = *(const float4*)(sp + 256); *(float4*)&v[u][8] = *(const float4*)(sp + 512); *(float4*)&v[u][12] = *(const float4*)(sp + 768);
    }
#pragma unroll
    for (int u = 0; u < 4; ++u) {
      float am = 0.f;
#pragma unroll
      for (int j = 0; j < 16; ++j) am = fmaxf(am, fabsf(v[u][j]));
#pragma unroll
      for (int o = 32; o >= 1; o >>= 1) am = fmaxf(am, __shfl_xor(am, o));
      const float sc = am > 0.f ? am * (1.f / 127.f) : 1.f, inv = 1.f / sc;
      unsigned w[4];
#pragma unroll
      for (int q4 = 0; q4 < 4; ++q4) {
        unsigned ww = 0u;
#pragma unroll
        for (int j = 0; j < 4; ++j) { int qi = (int)rintf(v[u][q4 * 4 + j] * inv) + 128; qi = qi < 1 ? 1 : (qi > 255 ? 255 : qi); ww |= (unsigned)qi << (8 * j); }
        w[q4] = ww;
      }
      *(uint4*)(dst + (size_t)(r0 + u) * D + lane * 16) = make_uint4(w[0], w[1], w[2], w[3]);
      if (lane == 0) scl[r0 + u] = sc;
    }
  }
}

struct GatherP { const bf16_t* Tbf; const int* IDX; const float* GATE; const unsigned char* utab; const unsigned char* vtab; const float* su; const float* sv;
                 const float* Hin; const float* mod; const float* lng; const float* lnb; float* Hout; const float* modT; };
#define UB0(w) ((float)((w) & 0xFFu))
#define UB1(w) ((float)(((w) >> 8) & 0xFFu))
#define UB2(w) ((float)(((w) >> 16) & 0xFFu))
#define UB3(w) ((float)((w) >> 24))
template <bool FINAL>
__device__ __forceinline__ void ln_token(const GatherP& p, int row, int rr, int lane, const float (&f)[16], float asum, char* As) {
  const int v = row_vec(row);
  const float* hin = p.Hin + (size_t)row * D + lane * 4;
  const float* gm = p.mod + v * 6144 + 5 * 1024 + lane * 4;
  const float off = 128.f * asum;
  float r[16]; float ssum = 0.f;
#pragma unroll
  for (int q4 = 0; q4 < 4; ++q4) {
    const float4 h4 = *(const float4*)(hin + q4 * 256), g4 = *(const float4*)(gm + q4 * 256);
    r[q4 * 4 + 0] = ALPHA * h4.x + g4.x * (f[q4 * 4 + 0] - off); r[q4 * 4 + 1] = ALPHA * h4.y + g4.y * (f[q4 * 4 + 1] - off);
    r[q4 * 4 + 2] = ALPHA * h4.z + g4.z * (f[q4 * 4 + 2] - off); r[q4 * 4 + 3] = ALPHA * h4.w + g4.w * (f[q4 * 4 + 3] - off);
    ssum += r[q4 * 4 + 0] + r[q4 * 4 + 1] + r[q4 * 4 + 2] + r[q4 * 4 + 3];
  }
  const float mu = wave_sum(ssum) * (1.f / D);
  float vs = 0.f;
#pragma unroll
  for (int j = 0; j < 16; ++j) { const float dlt = r[j] - mu; vs += dlt * dlt; }
  const float rstd = rsqrtf(wave_sum(vs) * (1.f / D) + LN_EPS);
  float o[16];
#pragma unroll
  for (int q4 = 0; q4 < 4; ++q4) {
    const float4 g4 = *(const float4*)(p.lng + q4 * 256 + lane * 4), b4 = *(const float4*)(p.lnb + q4 * 256 + lane * 4);
    o[q4 * 4 + 0] = (r[q4 * 4 + 0] - mu) * rstd * g4.x + b4.x; o[q4 * 4 + 1] = (r[q4 * 4 + 1] - mu) * rstd * g4.y + b4.y;
    o[q4 * 4 + 2] = (r[q4 * 4 + 2] - mu) * rstd * g4.z + b4.z; o[q4 * 4 + 3] = (r[q4 * 4 + 3] - mu) * rstd * g4.w + b4.w;
    *(float4*)(p.Hout + (size_t)row * D + q4 * 256 + lane * 4) = make_float4(o[q4 * 4 + 0], o[q4 * 4 + 1], o[q4 * 4 + 2], o[q4 * 4 + 3]);
  }
  if (!FINAL) {
    const float* mt = p.modT + v * 6144 + lane * 4;
#pragma unroll
    for (int q4 = 0; q4 < 4; ++q4) {
      const float4 sh = *(const float4*)(mt + q4 * 256), sc = *(const float4*)(mt + 1024 + q4 * 256);
      uint2 w; w.x = pack2bf(o[q4 * 4] * (1.f + sc.x) + sh.x, o[q4 * 4 + 1] * (1.f + sc.y) + sh.y); w.y = pack2bf(o[q4 * 4 + 2] * (1.f + sc.z) + sh.z, o[q4 * 4 + 3] * (1.f + sc.w) + sh.w);
      *(uint2*)(As + rr * LDA_B + (q4 * 256 + lane * 4) * 2) = w;
    }
  }
}
constexpr int PARTW = 1088;
template <bool FINAL>
__device__ __forceinline__ void ph_gather_tm(const GatherP& p, int g0, int nrows, char* As, float* __restrict__ PART) {
  const int tid = otid(), wave = tid >> 6, lane = tid & 63;
  const int nfull = nrows >> 3, extra = nrows & 7;
  const int nun = nfull + (extra ? 1 : 0);
#pragma unroll 1
  for (int un = 0; un < nun; ++un) {
    int rr, kbeg, kcnt; bool partial;
    if (un < nfull) { rr = wave + 8 * un; kbeg = 0; kcnt = 128; partial = false; }
    else { const int wpt = 8 / extra; rr = nfull * 8 + wave / wpt; kcnt = 128 / wpt; kbeg = (wave % wpt) * kcnt; partial = true; }
    const int row = g0 + rr;
    float tf[16];
    {
      const bf16_t* tp = p.Tbf + (size_t)row * D + lane * 4;
      const uint2 t0 = *(const uint2*)tp, t1 = *(const uint2*)(tp + 256), t2 = *(const uint2*)(tp + 512), t3 = *(const uint2*)(tp + 768);
      tf[0] = bflo(t0.x); tf[1] = bfhi(t0.x); tf[2] = bflo(t0.y); tf[3] = bfhi(t0.y); tf[4] = bflo(t1.x); tf[5] = bfhi(t1.x); tf[6] = bflo(t1.y); tf[7] = bfhi(t1.y);
      tf[8] = bflo(t2.x); tf[9] = bfhi(t2.x); tf[10] = bflo(t2.y); tf[11] = bfhi(t2.y); tf[12] = bflo(t3.x); tf[13] = bfhi(t3.x); tf[14] = bflo(t3.y); tf[15] = bfhi(t3.y);
    }
    float tsum = 0.f;
#pragma unroll
    for (int j = 0; j < 16; ++j) tsum += tf[j];
    tsum = wave_sum_dpp(tsum) * 128.f;
    const int id_lo = p.IDX[(size_t)row * 128 + lane], id_hi = p.IDX[(size_t)row * 128 + 64 + lane];
    const float ga_lo = p.GATE[(size_t)row * 128 + lane], ga_hi = p.GATE[(size_t)row * 128 + 64 + lane];
    float f[16], asum = 0.f;
#pragma unroll
    for (int j = 0; j < 16; ++j) f[j] = 0.f;
    uint4 ub[8], vb[8]; float sub[8], svb[8];
#define TLOAD(slot, kk) do { const int e_ = __builtin_amdgcn_readlane((kk) < 64 ? id_lo : id_hi, (kk) & 63); \
      ub[slot] = *(const uint4*)(p.utab + (size_t)e_ * D + lane * 16); vb[slot] = *(const uint4*)(p.vtab + (size_t)e_ * D + lane * 16); \
      sub[slot] = p.su[e_]; svb[slot] = p.sv[e_]; } while (0)
    auto proc4 = [&](int s0, int k0) {
      float dot[4];
#pragma unroll
      for (int u = 0; u < 4; ++u) {
        const uint4 a_ = ub[s0 + u];
        float d = tf[0] * UB0(a_.x); d = fmaf(tf[1], UB1(a_.x), d); d = fmaf(tf[2], UB2(a_.x), d); d = fmaf(tf[3], UB3(a_.x), d);
        d = fmaf(tf[4], UB0(a_.y), d); d = fmaf(tf[5], UB1(a_.y), d); d = fmaf(tf[6], UB2(a_.y), d); d = fmaf(tf[7], UB3(a_.y), d);
        d = fmaf(tf[8], UB0(a_.z), d); d = fmaf(tf[9], UB1(a_.z), d); d = fmaf(tf[10], UB2(a_.z), d); d = fmaf(tf[11], UB3(a_.z), d);
        d = fmaf(tf[12], UB0(a_.w), d); d = fmaf(tf[13], UB1(a_.w), d); d = fmaf(tf[14], UB2(a_.w), d); d = fmaf(tf[15], UB3(a_.w), d);
        dot[u] = d;
      }
#define DPPSTEP(ctl, rm) do { _Pragma("unroll") for (int u = 0; u < 4; ++u) dot[u] += __uint_as_float(__builtin_amdgcn_update_dpp(0u, __float_as_uint(dot[u]), ctl, rm, 0xF, true)); } while (0)
      DPPSTEP(0xB1, 0xF); DPPSTEP(0x4E, 0xF); DPPSTEP(0x141, 0xF); DPPSTEP(0x140, 0xF); DPPSTEP(0x142, 0xA); DPPSTEP(0x143, 0xC);
#undef DPPSTEP
      float act[4];
#pragma unroll
      for (int u = 0; u < 4; ++u) {
        const int kk = k0 + u;
        const float tot = __uint_as_float((unsigned)__builtin_amdgcn_readlane((int)__float_as_uint(dot[u]), 63));
        const float g_ = __uint_as_float((unsigned)__builtin_amdgcn_readlane((int)__float_as_uint(kk < 64 ? ga_lo : ga_hi), kk & 63));
        act[u] = gelu_fast(sub[s0 + u] * (tot - tsum)) * g_ * svb[s0 + u];
      }
#pragma unroll
      for (int u = 0; u < 4; ++u) {
        const float act_ = act[u];
        asum += act_;
        const uint4 c_ = vb[s0 + u];
        f[0] = fmaf(act_, UB0(c_.x), f[0]); f[1] = fmaf(act_, UB1(c_.x), f[1]); f[2] = fmaf(act_, UB2(c_.x), f[2]); f[3] = fmaf(act_, UB3(c_.x), f[3]);
        f[4] = fmaf(act_, UB0(c_.y), f[4]); f[5] = fmaf(act_, UB1(c_.y), f[5]); f[6] = fmaf(act_, UB2(c_.y), f[6]); f[7] = fmaf(act_, UB3(c_.y), f[7]);
        f[8] = fmaf(act_, UB0(c_.z), f[8]); f[9] = fmaf(act_, UB1(c_.z), f[9]); f[10] = fmaf(act_, UB2(c_.z), f[10]); f[11] = fmaf(act_, UB3(c_.z), f[11]);
        f[12] = fmaf(act_, UB0(c_.w), f[12]); f[13] = fmaf(act_, UB1(c_.w), f[13]); f[14] = fmaf(act_, UB2(c_.w), f[14]); f[15] = fmaf(act_, UB3(c_.w), f[15]);
      }
    };
    TLOAD(0, kbeg); TLOAD(1, kbeg + 1); TLOAD(2, kbeg + 2); TLOAD(3, kbeg + 3); TLOAD(4, kbeg + 4); TLOAD(5, kbeg + 5); TLOAD(6, kbeg + 6); TLOAD(7, kbeg + 7);
    const int kend = kbeg + kcnt - 8;
#pragma unroll 1
    for (int k = kbeg; k < kend; k += 8) {
      proc4(0, k); TLOAD(0, k + 8); TLOAD(1, k + 9); TLOAD(2, k + 10); TLOAD(3, k + 11);
      proc4(4, k + 4); TLOAD(4, k + 12); TLOAD(5, k + 13); TLOAD(6, k + 14); TLOAD(7, k + 15);
    }
    proc4(0, kend); proc4(4, kend + 4);
#undef TLOAD
    if (!partial) ln_token<FINAL>(p, row, rr, lane, f, asum, As);
    else {
      float* pp = PART + wave * PARTW + lane * 16;
      *(float4*)pp = make_float4(f[0], f[1], f[2], f[3]); *(float4*)(pp + 4) = make_float4(f[4], f[5], f[6], f[7]);
      *(float4*)(pp + 8) = make_float4(f[8], f[9], f[10], f[11]); *(float4*)(pp + 12) = make_float4(f[12], f[13], f[14], f[15]);
      if (lane == 0) PART[wave * PARTW + 1024] = asum;
    }
  }
  if (extra) {
    __syncthreads();
    if (wave < extra) {
      const int wpt = 8 / extra, rr = nfull * 8 + wave;
      float f[16], asum = 0.f;
#pragma unroll
      for (int j = 0; j < 16; ++j) f[j] = 0.f;
      for (int w2 = wave * wpt; w2 < wave * wpt + wpt; ++w2) {
        const float* pp = PART + w2 * PARTW + lane * 16;
#pragma unroll
        for (int q4 = 0; q4 < 4; ++q4) { const float4 x4 = *(const float4*)(pp + q4 * 4); f[q4 * 4] += x4.x; f[q4 * 4 + 1] += x4.y; f[q4 * 4 + 2] += x4.z; f[q4 * 4 + 3] += x4.w; }
        asum += PART[w2 * PARTW + 1024];
      }
      ln_token<FINAL>(p, g0 + rr, rr, lane, f, asum, As);
    }
  }
}

__device__ __forceinline__ void cvt_plain(const float* __restrict__ a, bf16_t* __restrict__ o, size_t n8, bool lo, size_t gtid, size_t gsz) {
  for (size_t i = gtid; i < n8; i += gsz) {
    float v[8];
    *(float4*)&v[0] = ((const float4*)a)[i * 2]; *(float4*)&v[4] = ((const float4*)a)[i * 2 + 1];
    if (lo) {
#pragma unroll
      for (int j = 0; j < 8; ++j) v[j] = v[j] - bf2f(f2bf(v[j]));
    }
    uint4 w; w.x = pack2bf(v[0], v[1]); w.y = pack2bf(v[2], v[3]); w.z = pack2bf(v[4], v[5]); w.w = pack2bf(v[6], v[7]);
    ((uint4*)o)[i] = w;
  }
}
__device__ __forceinline__ void cvt_t(const float* __restrict__ W, bf16_t* __restrict__ Wt, int K, int N, bool lo, size_t gtid, size_t gsz) {
  const size_t total = (size_t)N * (K / 8);
#pragma unroll 4
  for (size_t i = gtid; i < total; i += gsz) {
    const int n = (int)(i % N), k8 = (int)(i / N);
    float v[8];
#pragma unroll
    for (int j = 0; j < 8; ++j) { const float w = W[(size_t)(k8 * 8 + j) * N + n]; v[j] = lo ? w - bf2f(f2bf(w)) : w; }
    uint4 w; w.x = pack2bf(v[0], v[1]); w.y = pack2bf(v[2], v[3]); w.z = pack2bf(v[4], v[5]); w.w = pack2bf(v[6], v[7]);
    *(uint4*)(Wt + ((size_t)((n >> 4) * (K >> 5) + (k8 >> 2)) * 64 + (k8 & 3) * 16 + (n & 15)) * 8) = w;
  }
}
__device__ __forceinline__ void mod_item(const float* __restrict__ c, const float* __restrict__ c_ctx, const float* __restrict__ ada_w, const float* __restrict__ ada_b,
                                         float* __restrict__ MOD, int item, bool valid, char* lds, int tid, int nct, volatile int* cbc, int& cgen) {
  float* sc = (float*)lds;
  float* part = sc + 3072;
  const int wave = tid >> 6, lane = tid & 63, l = item / 96, cg = item % 96, nw = nct >> 6;
  if (valid) for (int i = tid; i < 3072; i += nct) { const int v = i >> 10, k = i & 1023; const float xv = v < 2 ? c[v * 1024 + k] : c_ctx[k]; sc[i] = xv / (1.f + expf(-xv)); }
  cbar(cbc, cgen, nw);
  if (valid) {
    float a0 = 0.f, a1 = 0.f, a2 = 0.f;
    const float* W = ada_w + (size_t)l * 1024 * 6144 + cg * 64 + lane;
    const int kb = wave * 171, ke = kb + 171 < 1024 ? kb + 171 : 1024;
#pragma unroll 19
    for (int k = kb; k < ke; ++k) { const float w = W[(size_t)k * 6144]; a0 += sc[k] * w; a1 += sc[1024 + k] * w; a2 += sc[2048 + k] * w; }
    part[(wave * 3 + 0) * 64 + lane] = a0; part[(wave * 3 + 1) * 64 + lane] = a1; part[(wave * 3 + 2) * 64 + lane] = a2;
  }
  cbar(cbc, cgen, nw);
  if (valid && tid < 192) {
    const int v = tid >> 6, ln = tid & 63; float sum = 0.f;
    for (int w = 0; w < nw; ++w) sum += part[(w * 3 + v) * 64 + ln];
    MOD[(l * 3 + v) * 6144 + cg * 64 + ln] = sum + ada_b[l * 6144 + cg * 64 + ln];
  }
}

__device__ __forceinline__ void gbar(unsigned* cnt, unsigned target) {
  asm volatile("s_waitcnt vmcnt(0)" ::: "memory");
  __syncthreads();
  if (otid() == 0) {
    __builtin_amdgcn_fence(__ATOMIC_RELEASE, "agent");
    asm volatile("s_waitcnt vmcnt(0)" ::: "memory");
    __hip_atomic_fetch_add(cnt, 1u, __ATOMIC_RELAXED, __HIP_MEMORY_SCOPE_AGENT);
    unsigned spins = 0;
    while (__hip_atomic_load(cnt, __ATOMIC_RELAXED, __HIP_MEMORY_SCOPE_AGENT) < target) { __builtin_amdgcn_s_sleep(2); if (++spins > (1u << 24)) break; }
    __builtin_amdgcn_fence(__ATOMIC_ACQUIRE, "agent");
    asm volatile("s_waitcnt vmcnt(0)" ::: "memory");
  }
  __syncthreads();
}

struct MP {
  const float *x, *c, *ctx, *c_ctx, *ada_w, *ada_b, *ln_g, *ln_b, *s5_a_re, *s5_a_im, *s5_log_dt, *s5_b_re, *s5_b_im, *s5_c_re, *s5_c_im, *s5_d, *s5_w_glu, *s5_w_o;
  const float *mla_w_dq, *mla_q_norm, *mla_w_uq, *mla_w_dkv, *mla_kv_norm, *mla_w_ukv, *mla_w_o, *peer_w_q, *peer_keys, *peer_u, *peer_v;
  float* out;
  float* MOD; bf16_t *Wt_glu, *Wt_o0, *Wt_q0, *Wt_o1, *Wt_q1, *Wt_cat, *Wt_uq, *Wt_ukv, *Khi, *Khi1;
  unsigned char *U0, *V0, *U1, *V1; float *SU0, *SV0, *SU1, *SV1; bf16_t *Ktab, *Bst_t, *Cin_t;
  bf16_t* Ypart; float* Ssta; bf16_t *HP, *Gbf, *Vbf, *Tbf; float *OQ, *H1, *H2; int* IDX; float* GATE;
  bf16_t *Qa, *Kn, *Kr, *Va, *AObf; float* H3; bf16_t* Tbf1; unsigned* BAR; float* PART;
};
constexpr int LDS_BYTES = att::SHM_ATTN > 66 * LDA_B ? att::SHM_ATTN : 66 * LDA_B;
__global__ __launch_bounds__(512) void mega(MP p) {
  __shared__ __attribute__((aligned(16))) char lds[LDS_BYTES];
  cg::grid_group grid = cg::this_grid();
  const int nblk = gridDim.x;
  int bid = blockIdx.x;
  const size_t TD = (size_t)1024 * 16384;
  const float* mod0 = p.MOD; const float* mod1 = p.MOD + 3 * 6144;
  {
    volatile int* cbc = (volatile int*)(lds + LDS_BYTES - 16);
    if (otid() == 0) *cbc = 0;
    __syncthreads();
    const int t0 = otid();
    if (t0 < 128) {
      const size_t mt = (size_t)bid * 128 + t0, ms = (size_t)nblk * 128;
      const int mw = bid * 2 + (t0 >> 6), nmw = nblk * 2;
      cvt_t(p.s5_w_glu, p.Wt_glu, D, D, false, mt, ms);
      cvt_t(p.s5_w_o, p.Wt_o0, D, D, false, mt, ms);
      cvt_t(p.peer_w_q, p.Wt_q0, D, D, false, mt, ms);
      cvt_t(p.mla_w_o, p.Wt_o1, D, D, false, mt, ms);
      cvt_t(p.peer_w_q + (size_t)D * D, p.Wt_q1, D, D, false, mt, ms);
      cvt_t(p.mla_w_dq, p.Wt_cat, D, 384, false, mt, ms);
      cvt_t(p.mla_w_dkv, p.Wt_cat + (size_t)384 * D, D, 320, false, mt, ms);
      cvt_t(p.mla_w_uq, p.Wt_uq, 384, 1536, false, mt, ms);
      cvt_t(p.mla_w_ukv, p.Wt_ukv, 256, 2048, false, mt, ms);
      cvt_plain(p.peer_keys, p.Khi, (size_t)2 * 131072 / 8, false, mt, ms);
      cvt_rows_i8(p.peer_u, p.U0, p.SU0, 16384, mw, nmw);
      cvt_rows_i8(p.peer_v, p.V0, p.SV0, 16384, mw, nmw);
      cvt_rows_i8(p.peer_u + TD, p.U1, p.SU1, 16384, mw, nmw);
      cvt_rows_i8(p.peer_v + TD, p.V1, p.SV1, 16384, mw, nmw);
    } else {
      int cgen = 0;
      const int ct = t0 - 128;
      ph_s5_prep(p.s5_a_re, p.s5_a_im, p.s5_log_dt, p.s5_b_re, p.s5_b_im, p.s5_c_re, p.s5_c_im, p.Ktab, p.Bst_t, p.Cin_t, bid >> 2, bid & 3, lds, ct, 384, cbc, cgen);
      cbar(cbc, cgen, 6);
      mod_item(p.c, p.c_ctx, p.ada_w, p.ada_b, p.MOD, bid, bid < 192, lds, ct, 384, cbc, cgen);
    }
  }
  grid.sync();
  asm volatile("" : "+s"(bid));
  ph_s5_p1(p.x, p.ctx, mod0, p.Ktab, p.Bst_t, p.Ypart, p.Ssta, bid, lds);
  gbar(p.BAR, 1u * (unsigned)nblk);
  asm volatile("" : "+s"(bid));
  if (otid() < 64) ph_s5_carry(p.Ssta, p.s5_a_re, p.s5_a_im, p.s5_log_dt, p.HP, bid, otid());
  gbar(p.BAR, 2u * (unsigned)nblk);
  asm volatile("" : "+s"(bid));
  ph_s5_p3(p.x, p.ctx, mod0, p.s5_d, p.HP, p.Cin_t, p.Ypart, p.Gbf, bid, lds);
  gbar(p.BAR, 3u * (unsigned)nblk);
  asm volatile("" : "+s"(bid));
  {
    ChainP cp{p.Gbf, p.Wt_glu, p.Wt_o0, p.Wt_q0, p.Vbf, (bf16_t*)p.OQ + (size_t)bid * 66 * D, p.x, p.ctx, mod0, p.ln_g, p.ln_b, p.H1, p.Tbf, (bf16_t*)p.OQ + (size_t)bid * 66 * D  };
    ph_chainA<true>(cp, bid, lds);
    __syncthreads();
    ph_route(RouteP{(bf16_t*)p.OQ + (size_t)bid * 66 * D, p.Khi, p.IDX, p.GATE, 66, 0}, bid, lds);
    __syncthreads();
    GatherP gp{p.Tbf, p.IDX, p.GATE, p.U0, p.V0, p.SU0, p.SV0, p.H1, mod0, p.ln_g + D, p.ln_b + D, p.H2, mod1};
    ph_gather_tm<false>(gp, bid * 66, 66, lds, p.PART + (size_t)bid * 8 * PARTW);
    __syncthreads();
    ProjP pp{p.Wt_cat, p.Wt_uq, p.Wt_ukv, p.mla_q_norm, p.mla_kv_norm, p.OQ  , p.Qa, p.Kn, p.Kr, p.Va};
    ph_mla_proj(pp, bid, lds);
  }
  gbar(p.BAR, 4u * (unsigned)nblk);
  asm volatile("" : "+s"(bid));
  ph_attn(p.Qa, p.Kn, p.Kr, p.Va, p.AObf, bid, nblk, lds);
  gbar(p.BAR, 5u * (unsigned)nblk);
  asm volatile("" : "+s"(bid));
  {
    ChainP cp{p.AObf, nullptr, p.Wt_o1, p.Wt_q1, nullptr, (bf16_t*)p.OQ + (size_t)bid * 64 * D, p.H2, p.H2 + (size_t)NL * D, mod1, p.ln_g + 2 * D, p.ln_b + 2 * D, p.H3, p.Tbf1, (bf16_t*)p.OQ + (size_t)bid * 64 * D};
    ph_chainA<false>(cp, bid, lds);
    __syncthreads();
    ph_route(RouteP{(bf16_t*)p.OQ + (size_t)bid * 64 * D, p.Khi1, p.IDX, p.GATE, 64, 0}, bid, lds);
    __syncthreads();
    GatherP gp{p.Tbf1, p.IDX, p.GATE, p.U1, p.V1, p.SU1, p.SV1, p.H3, mod1, p.ln_g + 3 * D, p.ln_b + 3 * D, p.out, mod1};
    ph_gather_tm<true>(gp, bid * 64, 64, lds, p.PART + (size_t)bid * 8 * PARTW);
  }
}

extern "C" void kernel_launch(void* const* d_in, const int* in_sizes, int n_in, void* d_out, int out_size, void* d_ws, size_t ws_size, hipStream_t stream) {
  MP p{};
  const float** in = (const float**)&p;
  for (int i = 0; i < 29; ++i) in[i] = (const float*)d_in[i];
  p.out = (float*)d_out;
  char* ws = (char*)d_ws; size_t off = 0;
  auto carve = [&](size_t bytes) { char* q = ws + off; off += (bytes + 255) / 256 * 256; return q; };
  const size_t TDB = (size_t)1024 * 16384 * 2, BIG = (size_t)NT * D * 4, HALF = (size_t)NT * D * 2;
  p.MOD = (float*)carve(2 * 3 * 6144 * 4);
  p.Wt_glu = (bf16_t*)carve((size_t)D * D * 2); p.Wt_o0 = (bf16_t*)carve((size_t)D * D * 2); p.Wt_q0 = (bf16_t*)carve((size_t)D * D * 2);
  p.Wt_o1 = (bf16_t*)carve((size_t)D * D * 2); p.Wt_q1 = (bf16_t*)carve((size_t)D * D * 2);
  p.Wt_cat = (bf16_t*)carve((size_t)704 * D * 2); p.Wt_uq = (bf16_t*)carve((size_t)1536 * 384 * 2); p.Wt_ukv = (bf16_t*)carve((size_t)2048 * 256 * 2);
  p.Khi = (bf16_t*)carve((size_t)2 * 131072 * 2); p.Khi1 = p.Khi + 131072;
  char* T0 = carve(TDB); p.U0 = (unsigned char*)T0; p.V0 = (unsigned char*)(T0 + TDB / 2); p.AObf = (bf16_t*)T0;
  p.SU0 = (float*)carve(16384 * 4); p.SV0 = (float*)carve(16384 * 4); p.SU1 = (float*)carve(16384 * 4); p.SV1 = (float*)carve(16384 * 4);
  const size_t KTAB_B = (size_t)64 * 127 * 256 * 2, BST_B = (size_t)64 * 256 * 1024 * 2, KN_B = (size_t)NB * 8 * KEYS * 128 * 2, KR_B = (size_t)NB * KEYS * 64 * 2;
  size_t x1 = KTAB_B + 2 * BST_B; if (x1 < 2 * KN_B + KR_B) x1 = 2 * KN_B + KR_B;
  char* X1 = carve(x1);
  p.Ktab = (bf16_t*)X1; p.Bst_t = (bf16_t*)(X1 + KTAB_B); p.Cin_t = (bf16_t*)(X1 + KTAB_B + BST_B);
  p.Kn = (bf16_t*)X1; p.Va = (bf16_t*)(X1 + KN_B); p.Kr = (bf16_t*)(X1 + 2 * KN_B); p.H3 = (float*)X1;
  char* X2 = carve(BIG); p.Ypart = (bf16_t*)X2; p.OQ = (float*)X2;
  char* X3 = carve(HALF); p.Ssta = (float*)X3; p.HP = (bf16_t*)(X3 + (size_t)NCC * 64 * 256 * 4); p.Vbf = (bf16_t*)X3;
  char* X4 = carve(HALF); p.Gbf = (bf16_t*)X4; p.Tbf = (bf16_t*)X4; p.Tbf1 = (bf16_t*)X4;
  char* X5 = carve(BIG); p.H1 = (float*)X5;
  char* T1 = carve(TDB); p.U1 = (unsigned char*)T1; p.V1 = (unsigned char*)(T1 + TDB / 2);
  p.H2 = (float*)carve(BIG);
  p.IDX = (int*)carve((size_t)NT * 128 * 4); p.GATE = (float*)carve((size_t)NT * 128 * 4);
  p.Qa = (bf16_t*)carve((size_t)NB * 8 * SEQ * 192 * 2);
  p.BAR = (unsigned*)carve(256);
  p.PART = (float*)carve((size_t)256 * 8 * PARTW * 4);
  if (off > ws_size || n_in != 29) { fprintf(stderr, "kernel_launch: workspace too small (need %zu, have %zu) or n_in %d != 29\n", off, ws_size, n_in); return; }
  static int grid_blocks = 0;
  if (!grid_blocks) {
    int dev = 0, cus = 0, per_cu = 0;
    hipGetDevice(&dev);
    hipDeviceGetAttribute(&cus, hipDeviceAttributeMultiprocessorCount, dev);
    hipOccupancyMaxActiveBlocksPerMultiprocessor(&per_cu, mega, 512, 0);
    if (per_cu < 1 || cus < 256) { fprintf(stderr, "kernel_launch: need 256 resident workgroups (cus %d, per_cu %d)\n", cus, per_cu); return; }
    grid_blocks = 256;
  }
  hipMemsetAsync(p.BAR, 0, 256, stream);
  void* args[] = {&p};
  hipError_t e = hipLaunchCooperativeKernel((void*)mega, dim3(grid_blocks), dim3(512), args, 0, stream);
  if (e != hipSuccess) fprintf(stderr, "cooperative launch failed: %s\n", hipGetErrorString(e));
}
```

```cpp
#include <hip/hip_runtime.h>
#include <math.h>
#include <hip/hip_cooperative_groups.h>
#include <cstdio>
namespace cg = cooperative_groups;
__device__ __forceinline__ int otid() { int t = (int)__builtin_amdgcn_workitem_id_x(); asm volatile("" : "+v"(t)); return t; }

constexpr int D = 1024, NB = 2, SEQ = 8192, CTX = 256;
constexpr int NL = NB * SEQ, NC = NB * CTX, NT = NL + NC;
constexpr float ALPHA = 1.4142135623730951f;
constexpr float LN_EPS = 1e-5f, RMS_EPS = 1e-6f;

__device__ __forceinline__ float wave_sum_dpp(float v) {
  v += __uint_as_float(__builtin_amdgcn_update_dpp(0u, __float_as_uint(v), 0xB1, 0xF, 0xF, true));
  v += __uint_as_float(__builtin_amdgcn_update_dpp(0u, __float_as_uint(v), 0x4E, 0xF, 0xF, true));
  v += __uint_as_float(__builtin_amdgcn_update_dpp(0u, __float_as_uint(v), 0x141, 0xF, 0xF, true));
  v += __uint_as_float(__builtin_amdgcn_update_dpp(0u, __float_as_uint(v), 0x140, 0xF, 0xF, true));
  v += __uint_as_float(__builtin_amdgcn_update_dpp(0u, __float_as_uint(v), 0x142, 0xA, 0xF, true));
  v += __uint_as_float(__builtin_amdgcn_update_dpp(0u, __float_as_uint(v), 0x143, 0xC, 0xF, true));
  return __uint_as_float((unsigned)__builtin_amdgcn_readlane((int)__float_as_uint(v), 63));
}
__device__ __forceinline__ float wave_sum(float v) { return wave_sum_dpp(v); }
__device__ __forceinline__ int row_vec(int row) { return row < NL ? (row >> 13) : 2; }
__device__ __forceinline__ float gelu_exact(float x) { return 0.5f * x * (1.f + erff(x * 0.70710678118654752f)); }
__device__ __forceinline__ float gelu_fast(float x) {
  const float z = fabsf(x) * 0.70710678118654752f;
  const float t = __builtin_amdgcn_rcpf(fmaf(0.3275911f, z, 1.f));
  float pl = fmaf(1.061405429f, t, -1.453152027f); pl = fmaf(pl, t, 1.421413741f); pl = fmaf(pl, t, -0.284496736f); pl = fmaf(pl, t, 0.254829592f);
  const float e = __builtin_amdgcn_exp2f(-z * z * 1.4426950408889634f);
  const float erfa = 1.f - pl * t * e;
  const float hx = 0.5f * x;
  return hx + fabsf(hx) * erfa;
}


typedef unsigned short bf16_t;
using bf16x8 = __attribute__((ext_vector_type(8))) short;
using f32x4 = __attribute__((ext_vector_type(4))) float;
__device__ __forceinline__ bf16_t f2bf(float f) { unsigned u = __float_as_uint(f); u += 0x7FFFu + ((u >> 16) & 1u); return (bf16_t)(u >> 16); }
__device__ __forceinline__ unsigned char f2fp8(float v) { return (unsigned char)(__builtin_amdgcn_cvt_pk_fp8_f32(v, v, 0, false) & 0xFF); }
__device__ __forceinline__ float bf2f(bf16_t h) { return __uint_as_float(((unsigned)h) << 16); }
__device__ __forceinline__ unsigned pack2bf(float lo, float hi) { return (unsigned)f2bf(lo) | ((unsigned)f2bf(hi) << 16); }
__device__ __forceinline__ float bflo(unsigned w) { return __uint_as_float(w << 16); }
__device__ __forceinline__ float bfhi(unsigned w) { return __uint_as_float(w & 0xFFFF0000u); }


constexpr int LDA_B = 1024 * 2 + 16;
template <int RT, int K>
__device__ __forceinline__ void gemm_unit(const char* const (&ap)[RT], const bf16_t* __restrict__ w0, const bf16_t* __restrict__ w1, int kmul, f32x4 (&acc)[RT][2]) {
  constexpr int KI = K / 128, NS = 2;
#pragma unroll
  for (int t = 0; t < RT; ++t) { acc[t][0] = f32x4{0.f, 0.f, 0.f, 0.f}; acc[t][1] = f32x4{0.f, 0.f, 0.f, 0.f}; }
  bf16x8 b[NS][4][2];
#pragma unroll
  for (int st = 0; st < NS - 1; ++st) {
    if (st < KI) {
#pragma unroll
      for (int s2 = 0; s2 < 4; ++s2) { b[st][s2][0] = *(const bf16x8*)(w0 + (st * 128 + s2 * 32) * kmul); b[st][s2][1] = *(const bf16x8*)(w1 + (st * 128 + s2 * 32) * kmul); }
    }
  }
  asm volatile("" ::: "memory");
  bf16x8 an[RT];
#pragma unroll
  for (int t = 0; t < RT; ++t) an[t] = *(const bf16x8*)(ap[t]);
#pragma unroll
  for (int it = 0; it < KI; ++it) {
    if (it + NS - 1 < KI) {
#pragma unroll
      for (int s2 = 0; s2 < 4; ++s2) {
        b[(it + NS - 1) % NS][s2][0] = *(const bf16x8*)(w0 + ((it + NS - 1) * 128 + s2 * 32) * kmul);
        b[(it + NS - 1) % NS][s2][1] = *(const bf16x8*)(w1 + ((it + NS - 1) * 128 + s2 * 32) * kmul);
      }
    }
    asm volatile("" ::: "memory");
#pragma unroll
    for (int s2 = 0; s2 < 4; ++s2) {
      bf16x8 ac[RT];
#pragma unroll
      for (int t = 0; t < RT; ++t) ac[t] = an[t];
      if (it * 4 + s2 + 1 < KI * 4) {
#pragma unroll
        for (int t = 0; t < RT; ++t) an[t] = *(const bf16x8*)(ap[t] + (it * 128 + s2 * 32 + 32) * 2);
      }
#pragma unroll
      for (int t = 0; t < RT; ++t) {
        acc[t][0] = __builtin_amdgcn_mfma_f32_16x16x32_bf16(ac[t], b[it % NS][s2][0], acc[t][0], 0, 0, 0);
        acc[t][1] = __builtin_amdgcn_mfma_f32_16x16x32_bf16(ac[t], b[it % NS][s2][1], acc[t][1], 0, 0, 0);
      }
    }
  }
}
template <int RT, int K, class Epi>
__device__ __forceinline__ void gemm_ldsA(const char* As, int lda_b, int nrows, const bf16_t* __restrict__ Wt, int N, Epi epi) {
  const int wave = otid() >> 6, lane = otid() & 63, l15 = lane & 15, q = lane >> 4;
  const char* ap[RT];
#pragma unroll
  for (int t = 0; t < RT; ++t) { int r = t * 16 + l15; r = r < nrows ? r : nrows - 1; ap[t] = As + r * lda_b + q * 16; }
#pragma unroll 1
  for (int unit = wave; unit < (N >> 5); unit += 8) {
    const int n0 = unit * 32;
    const bf16_t* w0 = Wt + (size_t)(n0 >> 4) * K * 16 + lane * 8;
    f32x4 acc[RT][2];
    gemm_unit<RT, K>(ap, w0, w0 + (size_t)K * 16, 16, acc);
#pragma unroll
    for (int t = 0; t < RT; ++t)
#pragma unroll
      for (int j = 0; j < 2; ++j)
#pragma unroll
        for (int r = 0; r < 4; ++r) {
          const int row = t * 16 + q * 4 + r, col = n0 + j * 16 + l15;
          if (row < nrows) epi(row, col, acc[t][j][r]);
        }
  }
}
struct EpiBF16 { bf16_t* C; int ldc; __device__ __forceinline__ void operator()(int row, int col, float v) const { C[(size_t)row * ldc + col] = f2bf(v); } };
struct EpiF32 { float* C; int ldc; __device__ __forceinline__ void operator()(int row, int col, float v) const { C[(size_t)row * ldc + col] = v; } };
struct EpiGluL { const char* As; bf16_t* V; __device__ __forceinline__ void operator()(int row, int col, float z) const {
  const float g = bf2f(*(const bf16_t*)(As + row * LDA_B + col * 2)); V[(size_t)row * D + col] = f2bf(g / (1.f + expf(-z))); } };

__device__ __forceinline__ void load_rows_lds(char* As, const bf16_t* __restrict__ src, int nrows) {
  const int t = otid(), total = nrows * 128;
#pragma unroll
  for (int h = 0; h < 2; ++h) {
    uint4 v[9];
#pragma unroll
    for (int k = 0; k < 9; ++k) { int i = t + (h * 9 + k) * 512; i = i < total ? i : total - 1; v[k] = *(const uint4*)(src + (size_t)(i >> 7) * D + (i & 127) * 8); }
#pragma unroll
    for (int k = 0; k < 9; ++k) { const int i = t + (h * 9 + k) * 512; if (i < total) *(uint4*)(As + (i >> 7) * LDA_B + (i & 127) * 16) = v[k]; }
  }
}
__device__ __forceinline__ void ln_rows(char* As, int g0, int nrows, const float* Hl, const float* Hc, const bf16_t* __restrict__ O,
                                        const float* __restrict__ mod, int gate_i, const float* __restrict__ lng, const float* __restrict__ lnb,
                                        float* Hout, bf16_t* __restrict__ Tbf, int shift_i, int scale_i) {
  const int wave = otid() >> 6, lane = otid() & 63;
  for (int rr = wave; rr < nrows; rr += 8) {
    const int row = g0 + rr;
    const float* hin = row < NL ? Hl + (size_t)row * D : Hc + (size_t)(row - NL) * D;
    const bf16_t* f = O + (size_t)row * D;
    const float* m = mod + row_vec(row) * 6144;
    const float* gm = m + gate_i * 1024;
    float r[16]; float s = 0.f;
#pragma unroll
    for (int i = 0; i < 4; ++i) {
      const int d = i * 256 + lane * 4;
      const uint2 fw = *(const uint2*)(f + d);
      float4 h4 = *(const float4*)(hin + d), f4 = make_float4(bflo(fw.x), bfhi(fw.x), bflo(fw.y), bfhi(fw.y)), g4 = *(const float4*)(gm + d);
      r[i * 4 + 0] = ALPHA * h4.x + g4.x * f4.x; r[i * 4 + 1] = ALPHA * h4.y + g4.y * f4.y;
      r[i * 4 + 2] = ALPHA * h4.z + g4.z * f4.z; r[i * 4 + 3] = ALPHA * h4.w + g4.w * f4.w;
      s += r[i * 4 + 0] + r[i * 4 + 1] + r[i * 4 + 2] + r[i * 4 + 3];
    }
    const float mu = wave_sum(s) * (1.f / D);
    float vs = 0.f;
#pragma unroll
    for (int i = 0; i < 16; ++i) { float dlt = r[i] - mu; vs += dlt * dlt; }
    const float rstd = rsqrtf(wave_sum(vs) * (1.f / D) + LN_EPS);
#pragma unroll
    for (int i = 0; i < 4; ++i) {
      const int d = i * 256 + lane * 4;
      float4 g4 = *(const float4*)(lng + d), b4 = *(const float4*)(lnb + d);
      float4 o;
      o.x = (r[i * 4 + 0] - mu) * rstd * g4.x + b4.x; o.y = (r[i * 4 + 1] - mu) * rstd * g4.y + b4.y;
      o.z = (r[i * 4 + 2] - mu) * rstd * g4.z + b4.z; o.w = (r[i * 4 + 3] - mu) * rstd * g4.w + b4.w;
      *(float4*)(Hout + (size_t)row * D + d) = o;
      float4 sh = *(const float4*)(m + shift_i * 1024 + d), sc = *(const float4*)(m + scale_i * 1024 + d);
      const float t0 = o.x * (1.f + sc.x) + sh.x, t1 = o.y * (1.f + sc.y) + sh.y, t2 = o.z * (1.f + sc.z) + sh.z, t3 = o.w * (1.f + sc.w) + sh.w;
      uint2 w; w.x = pack2bf(t0, t1); w.y = pack2bf(t2, t3);
      *(uint2*)(As + rr * LDA_B + d * 2) = w;
      *(uint2*)(Tbf + (size_t)row * D + d) = w;

    }
  }
}


constexpr int S5T = 64, NCHUNK = (CTX + SEQ) / S5T  , NCC = NB * NCHUNK  ;
__device__ __forceinline__ int s5_token(int cc, int s) {
  const int b = cc / NCHUNK, ch = cc - b * NCHUNK;
  return ch < 4 ? NL + b * CTX + ch * S5T + s : b * SEQ + (ch - 4) * S5T + s;
}
__device__ __forceinline__ void cbar(volatile int* cnt, int& gen, int nwaves) {
  __builtin_amdgcn_fence(__ATOMIC_RELEASE, "workgroup");
  if ((otid() & 63) == 0) __hip_atomic_fetch_add((int*)cnt, 1, __ATOMIC_RELAXED, __HIP_MEMORY_SCOPE_WORKGROUP);
  ++gen;
  while (__hip_atomic_load((int*)cnt, __ATOMIC_RELAXED, __HIP_MEMORY_SCOPE_WORKGROUP) < gen * nwaves) __builtin_amdgcn_s_sleep(1);
  __builtin_amdgcn_fence(__ATOMIC_ACQUIRE, "workgroup");
}
__device__ __forceinline__ void ph_s5_prep(const float* __restrict__ a_re, const float* __restrict__ a_im, const float* __restrict__ log_dt,
                                                 const float* __restrict__ b_re, const float* __restrict__ b_im, const float* __restrict__ c_re, const float* __restrict__ c_im,
                                                 bf16_t* __restrict__ Ktab, bf16_t* __restrict__ Bst_t, bf16_t* __restrict__ Cin_t, int g, int part, char* lds, int tid, int nct, volatile int* cbc, int& cgen) {
  float2 (*pw)[65][64] = reinterpret_cast<float2 (*)[65][64]>(lds);
  float2 (*Bp)[64][16] = reinterpret_cast<float2 (*)[64][16]>(lds + 2 * 65 * 64 * 8);
  float2 (*Cc)[16][64] = reinterpret_cast<float2 (*)[16][64]>(lds + 2 * 65 * 64 * 8 + 2 * 64 * 16 * 8);
  float2 (*fs)[64] = reinterpret_cast<float2 (*)[64]>(lds + 2 * 65 * 64 * 8 + 2 * 64 * 16 * 8 + 2 * 16 * 64 * 8);
  if (tid < 128) {
    const int dir = tid >> 6, p = tid & 63, gp = (dir * 64 + g) * 64 + p;
    const float are = a_re[gp], aim = a_im[gp], dt = expf(log_dt[dir * 64 + g]);
    const float mag = expf(are * dt);
    const float abr = mag * cosf(aim * dt), abi = mag * sinf(aim * dt);
    const float nr = abr - 1.f, ni = abi, den = are * are + aim * aim;
    fs[dir][p] = make_float2((nr * are + ni * aim) / den, (ni * are - nr * aim) / den);
    float pr = 1.f, pi = 0.f;
    for (int e = 0; e <= 64; ++e) { pw[dir][e][p] = make_float2(pr, pi); const float nr2 = pr * abr - pi * abi, ni2 = pr * abi + pi * abr; pr = nr2; pi = ni2; }
  }
  cbar(cbc, cgen, nct >> 6);
  for (int i = tid; i < 2048; i += nct) {
    const int dir = i >> 10, p = (i >> 4) & 63, ci = i & 15;
    const size_t gi = ((size_t)(dir * 64 + g) * 64 + p) * 16 + ci;
    const float br = b_re[gi], bi = b_im[gi]; const float2 f = fs[dir][p];
    Bp[dir][p][ci] = make_float2(f.x * br - f.y * bi, f.x * bi + f.y * br);
    const int co = (i >> 6) & 15, p2 = i & 63;
    const size_t ci2 = ((size_t)(dir * 64 + g) * 16 + co) * 64 + p2;
    Cc[dir][co][p2] = make_float2(c_re[ci2], c_im[ci2]);
  }
  cbar(cbc, cgen, nct >> 6);
  for (int i = part * 508 + tid; i < (part + 1) * 508; i += nct) {
    const int ti = i >> 4, co = i & 15, tau = ti - 63;
    float acc[16];
#pragma unroll
    for (int ci = 0; ci < 16; ++ci) acc[ci] = 0.f;
    if (tau >= 0) {
      for (int p = 0; p < 64; ++p) {
        const float2 c = Cc[0][co][p], w = pw[0][tau][p];
        const float xr = c.x * w.x - c.y * w.y, xi = c.x * w.y + c.y * w.x;
#pragma unroll
        for (int ci = 0; ci < 16; ++ci) { const float2 bb = Bp[0][p][ci]; acc[ci] += xr * bb.x - xi * bb.y; }
      }
    }
    if (tau <= 0) {
      for (int p = 0; p < 64; ++p) {
        const float2 c = Cc[1][co][p], w = pw[1][-tau][p];
        const float xr = c.x * w.x - c.y * w.y, xi = c.x * w.y + c.y * w.x;
#pragma unroll
        for (int ci = 0; ci < 16; ++ci) { const float2 bb = Bp[1][p][ci]; acc[ci] += xr * bb.x - xi * bb.y; }
      }
    }
    uint4 o0, o1;
    o0.x = pack2bf(acc[0], acc[1]); o0.y = pack2bf(acc[2], acc[3]); o0.z = pack2bf(acc[4], acc[5]); o0.w = pack2bf(acc[6], acc[7]);
    o1.x = pack2bf(acc[8], acc[9]); o1.y = pack2bf(acc[10], acc[11]); o1.z = pack2bf(acc[12], acc[13]); o1.w = pack2bf(acc[14], acc[15]);
    bf16_t* kp = Ktab + (size_t)g * 127 * 256 + (size_t)i * 16;
    *(uint4*)kp = o0; *(uint4*)(kp + 8) = o1;
  }
  for (int i = part * 8192 + tid; i < (part + 1) * 8192; i += nct) {
    const int n = i >> 7, k8 = i & 127, dir = n >> 7, c = (n >> 6) & 1, p = n & 63, sidx = k8 >> 1, ci0 = (k8 & 1) * 8;
    const float2 w = pw[dir][dir == 0 ? 63 - sidx : sidx][p];
    float v[8];
#pragma unroll
    for (int j = 0; j < 8; ++j) { const float2 b = Bp[dir][p][ci0 + j]; v[j] = c == 0 ? (w.x * b.x - w.y * b.y) : (w.x * b.y + w.y * b.x); }
    uint4 o; o.x = pack2bf(v[0], v[1]); o.y = pack2bf(v[2], v[3]); o.z = pack2bf(v[4], v[5]); o.w = pack2bf(v[6], v[7]);
    *(uint4*)(Bst_t + (size_t)g * 256 * 1024 + ((size_t)((n >> 4) * 32 + (k8 >> 2)) * 64 + (k8 & 3) * 16 + (n & 15)) * 8) = o;
  }
  for (int i = part * 8192 + tid; i < (part + 1) * 8192; i += nct) {
    const int n = i >> 5, k8 = i & 31, t = n >> 4, co = n & 15, dir = k8 >> 4, c = (k8 >> 3) & 1, p0 = (k8 & 7) * 8;
    const int e = dir == 0 ? t + 1 : 64 - t;
    float v[8];
#pragma unroll
    for (int j = 0; j < 8; ++j) { const float2 cc = Cc[dir][co][p0 + j], w = pw[dir][e][p0 + j];
      v[j] = c == 0 ? (cc.x * w.x - cc.y * w.y) : -(cc.x * w.y + cc.y * w.x); }
    uint4 o; o.x = pack2bf(v[0], v[1]); o.y = pack2bf(v[2], v[3]); o.z = pack2bf(v[4], v[5]); o.w = pack2bf(v[6], v[7]);
    *(uint4*)(Cin_t + (size_t)g * 1024 * 256 + ((size_t)((n >> 4) * 8 + (k8 >> 2)) * 64 + (k8 & 3) * 16 + (n & 15)) * 8) = o;
  }
}
__device__ __forceinline__ void ph_s5_p1(const float* __restrict__ x, const float* __restrict__ ctx, const float* __restrict__ mod,
                                               const bf16_t* __restrict__ Ktab, const bf16_t* __restrict__ Bst_t, bf16_t* __restrict__ Ypart, float* __restrict__ S, int bid, char* As) {
  const int g = bid >> 2, cc0 = (bid & 3) * 66, tid = otid();
  const int wave = tid >> 6, lane = tid & 63, l15 = lane & 15, q = lane >> 4;
#pragma unroll 4
  for (int i = tid; i < 66 * 64 * 2; i += 512) {
    const int half = i & 1, sidx = (i >> 1) & 63, r = i >> 7;
    const int tok = s5_token(cc0 + r, sidx), ch = g * 16 + half * 8;
    const float* src = (tok < NL ? x + (size_t)tok * D : ctx + (size_t)(tok - NL) * D) + ch;
    const float* m = mod + row_vec(tok) * 6144;
    const float4 a = *(const float4*)src, b = *(const float4*)(src + 4);
    const float4 sh0 = *(const float4*)(m + ch), sh1 = *(const float4*)(m + ch + 4), sc0 = *(const float4*)(m + 1024 + ch), sc1 = *(const float4*)(m + 1024 + ch + 4);
    uint4 o;
    o.x = pack2bf(a.x * (1.f + sc0.x) + sh0.x, a.y * (1.f + sc0.y) + sh0.y); o.y = pack2bf(a.z * (1.f + sc0.z) + sh0.z, a.w * (1.f + sc0.w) + sh0.w);
    o.z = pack2bf(b.x * (1.f + sc1.x) + sh1.x, b.y * (1.f + sc1.y) + sh1.y); o.w = pack2bf(b.z * (1.f + sc1.z) + sh1.z, b.w * (1.f + sc1.w) + sh1.w);
    *(uint4*)(As + r * LDA_B + sidx * 32 + half * 16) = o;
  }
  __syncthreads();
  const char* ap[5];
#pragma unroll
  for (int t = 0; t < 5; ++t) { int r = t * 16 + l15; r = r < 66 ? r : 65; ap[t] = As + r * LDA_B + q * 16; }
  const bf16_t* Kg = Ktab + (size_t)g * 127 * 256;
#pragma unroll 1
  for (int unit = wave; unit < 40; unit += 8) {
    f32x4 acc[5][2];
    if (unit < 32) {
      const int t0 = unit * 2;
      const bf16_t* w0 = Kg + (t0 + 63 - (q >> 1)) * 256 + l15 * 16 + (q & 1) * 8;
      gemm_unit<5, 1024>(ap, w0, w0 + 256, -16, acc);
#pragma unroll
      for (int t = 0; t < 5; ++t)
#pragma unroll
        for (int j = 0; j < 2; ++j)
#pragma unroll
          for (int r = 0; r < 4; ++r) {
            const int row = t * 16 + q * 4 + r;
            if (row < 66) Ypart[(size_t)s5_token(cc0 + row, t0 + j) * D + g * 16 + l15] = f2bf(acc[t][j][r]);
          }
    } else {
      const int n0 = (unit - 32) * 32;
      const bf16_t* w0 = Bst_t + (size_t)g * 256 * 1024 + (size_t)(n0 >> 4) * 1024 * 16 + lane * 8;
      gemm_unit<5, 1024>(ap, w0, w0 + 1024 * 16, 16, acc);
#pragma unroll
      for (int t = 0; t < 5; ++t)
#pragma unroll
        for (int j = 0; j < 2; ++j)
#pragma unroll
          for (int r = 0; r < 4; ++r) {
            const int row = t * 16 + q * 4 + r;
            if (row < 66) S[((size_t)(cc0 + row) * 64 + g) * 256 + n0 + j * 16 + l15] = acc[t][j][r];
          }
    }
  }
}
__device__ __forceinline__ void ph_s5_carry(const float* __restrict__ S, const float* __restrict__ a_re, const float* __restrict__ a_im,
                                                 const float* __restrict__ log_dt, bf16_t* __restrict__ HP, int id, int p) {
  const int dir = id & 1, g = (id >> 1) & 63, b = id >> 7;
  const int gp = (dir * 64 + g) * 64 + p;
  const float are = a_re[gp], aim = a_im[gp], dt = expf(log_dt[dir * 64 + g]);
  const float mag = expf(are * dt);
  float tr = mag * cosf(aim * dt), ti = mag * sinf(aim * dt);
#pragma unroll
  for (int i = 0; i < 6; ++i) { const float nr = tr * tr - ti * ti, ni = 2.f * tr * ti; tr = nr; ti = ni; }
  float hr = 0.f, hi = 0.f;
#pragma unroll 12
  for (int step = 0; step < NCHUNK; ++step) {
    const int c = dir == 0 ? step : (step < 4 ? 3 - step : NCHUNK - 1 - (step - 4));
    const size_t base = ((size_t)(b * NCHUNK + c) * 64 + g) * 256 + dir * 128 + p;
    HP[base] = f2bf(hr); HP[base + 64] = f2bf(hi);
    const float sr = S[base], si = S[base + 64];
    const float nr = tr * hr - ti * hi + sr, ni = tr * hi + ti * hr + si;
    hr = nr; hi = ni;
  }
}
struct EpiS5 { const float* x; const float* ctx; const bf16_t* Ypart; bf16_t* Gbf; const float* cst; int cc0; int ch;
  __device__ __forceinline__ void operator()(int row, int col, float v) const {
    const int tok = s5_token(cc0 + row, col >> 4), vi = row_vec(tok);
    const float xin = tok < NL ? x[(size_t)tok * D + ch] : ctx[(size_t)(tok - NL) * D + ch];
    const float mm = xin * (1.f + cst[1 + vi * 2]) + cst[2 + vi * 2];
    const float y = v + bf2f(Ypart[(size_t)tok * D + ch]) + cst[0] * mm;
    Gbf[(size_t)tok * D + ch] = f2bf(gelu_fast(y));
  } };
__device__ __forceinline__ void ph_s5_p3(const float* __restrict__ x, const float* __restrict__ ctx, const float* __restrict__ mod, const float* __restrict__ dvec,
                                               const bf16_t* __restrict__ HP, const bf16_t* __restrict__ Cin_t, const bf16_t* __restrict__ Ypart, bf16_t* __restrict__ Gbf, int bid, char* As) {
  const int g = bid >> 2, cc0 = (bid & 3) * 66, tid = otid();
  for (int i = tid; i < 66 * 32; i += 512) {
    const int r = i >> 5, c = i & 31;
    *(uint4*)(As + r * 528 + c * 16) = *(const uint4*)(HP + ((size_t)(cc0 + r) * 64 + g) * 256 + c * 8);
  }
  __syncthreads();
  float* cst = (float*)(As + 66 * 528);
  if (tid < 16) {
    const int c0 = g * 16 + tid;
    cst[tid * 8 + 0] = dvec[c0];
    cst[tid * 8 + 1] = mod[1024 + c0]; cst[tid * 8 + 2] = mod[c0];
    cst[tid * 8 + 3] = mod[6144 + 1024 + c0]; cst[tid * 8 + 4] = mod[6144 + c0];
    cst[tid * 8 + 5] = mod[2 * 6144 + 1024 + c0]; cst[tid * 8 + 6] = mod[2 * 6144 + c0];
  }
  __syncthreads();
  gemm_ldsA<5, 256>(As, 528, 66, Cin_t + (size_t)g * 1024 * 256, 1024, EpiS5{x, ctx, Ypart, Gbf, cst + (otid() & 15) * 8, cc0, g * 16 + (otid() & 15)});
}


struct ChainP {
  const bf16_t* Ain;
  const bf16_t* Wglu_t; const bf16_t* Wo_t; const bf16_t* Wq_t;
  bf16_t* Vbf; bf16_t* O; const float* Hl; const float* Hc; const float* mod; const float* lng; const float* lnb;
  float* Hout; bf16_t* Tbf; bf16_t* Q;
};
template <bool L0>
__device__ __forceinline__ void ph_chainA(const ChainP& p, int bid, char* As) {
  constexpr int NR = L0 ? 66 : 64;
  constexpr int RT = L0 ? 5 : 4;
  const int g0 = bid * NR;
  load_rows_lds(As, p.Ain + (size_t)g0 * D, NR);
  __syncthreads();
  if (L0) {
    gemm_ldsA<RT, 1024>(As, LDA_B, NR, p.Wglu_t, D, EpiGluL{As, p.Vbf + (size_t)g0 * D});
    __syncthreads();
    load_rows_lds(As, p.Vbf + (size_t)g0 * D, NR);
    __syncthreads();
  }
  gemm_ldsA<RT, 1024>(As, LDA_B, NR, p.Wo_t, D, EpiBF16{p.O + (size_t)g0 * D, D});
  __syncthreads();
  ln_rows(As, g0, NR, p.Hl, p.Hc, p.O, p.mod, 2, p.lng, p.lnb, p.Hout, p.Tbf, 3, 4);
  __syncthreads();
  gemm_ldsA<RT, 1024>(As, LDA_B, NR, p.Wq_t, D, EpiBF16{p.Q + (size_t)g0 * D, D});
}


constexpr int KEYS = SEQ + CTX;
struct EpiKV { unsigned char* Kn; unsigned char* Vl; int g0; int sh; __device__ __forceinline__ void operator()(int row, int col, float v) const {
  const int head = col >> 8, j = col & 255;
  if (j < 128) {
    const int g = g0 + row; int b, key;
    if (g < NL) { b = g >> 13; key = g & (SEQ - 1); } else { const int cidx = g - NL; b = cidx >> 8; key = SEQ + (cidx & (CTX - 1)); }
    Kn[((size_t)(b * 8 + head) * KEYS + key) * 128 + j] = f2fp8(v * 4.f);
  } else Vl[(head * 128 + (j - 128)) * 68 + row + sh] = f2fp8(v * 4.f);
} };
struct EpiQ { bf16_t* Qa; int g0; int pad; __device__ __forceinline__ void operator()(int row, int col, float v) const {
  const int g = g0 + row, b = g >> 13, n = g & (SEQ - 1);
  const int head = col / 192, j = col - head * 192;
  Qa[((size_t)(b * 8 + head) * SEQ + n) * 192 + j] = f2bf(v);
} };
struct ProjP { const bf16_t* Wcat_t; const bf16_t* Wuq_t; const bf16_t* Wukv_t; const float* q_norm; const float* kv_norm;
               float* PR; bf16_t* Qa; unsigned char* Kn; unsigned char* Kr; unsigned char* Va; };
__device__ __forceinline__ void ph_mla_proj(const ProjP& p, int bid, char* As) {
  const int g0 = bid * 66, wave = otid() >> 6, lane = otid() & 63;
  gemm_ldsA<5, 1024>(As, LDA_B, 66, p.Wcat_t, 704, EpiF32{p.PR + (size_t)g0 * D, D});
  __syncthreads();
  char* A1 = As; char* A2 = As + 66 * 784;
  for (int rr = wave; rr < 66; rr += 8) {
    const int g = g0 + rr;
    const float* pr = p.PR + (size_t)g * D;
    float v[6]; float ss = 0.f;
#pragma unroll
    for (int i = 0; i < 6; ++i) { v[i] = pr[i * 64 + lane]; ss += v[i] * v[i]; }
    float rn = rsqrtf(wave_sum(ss) * (1.f / 384.f) + RMS_EPS);
#pragma unroll
    for (int i = 0; i < 6; ++i) *(bf16_t*)(A1 + rr * 784 + (i * 64 + lane) * 2) = f2bf(v[i] * rn * p.q_norm[i * 64 + lane]);
    float w[4]; ss = 0.f;
#pragma unroll
    for (int i = 0; i < 4; ++i) { w[i] = pr[384 + i * 64 + lane]; ss += w[i] * w[i]; }
    rn = rsqrtf(wave_sum(ss) * (1.f / 256.f) + RMS_EPS);
#pragma unroll
    for (int i = 0; i < 4; ++i) *(bf16_t*)(A2 + rr * 528 + (i * 64 + lane) * 2) = f2bf(w[i] * rn * p.kv_norm[i * 64 + lane]);
    if (lane < 32) {
      float x1 = pr[640 + lane], x2 = pr[672 + lane];
      int b, key;
      if (g < NL) {
        b = g >> 13; key = g & (SEQ - 1);
        const int n = key, rr2 = n >> 6, cc = n & 63;
        const float inv = powf(10000.f, -(float)(lane & 15) / 16.f);
        const float ang = (lane < 16 ? (float)rr2 : (float)cc) * inv;
        const float cs = cosf(ang), sn = sinf(ang);
        const float y1 = x1 * cs - x2 * sn, y2 = x2 * cs + x1 * sn; x1 = y1; x2 = y2;
      } else { const int cidx = g - NL; b = cidx >> 8; key = SEQ + (cidx & (CTX - 1)); }
      unsigned char* kp = p.Kr + ((size_t)b * KEYS + key) * 64;
      kp[lane] = f2fp8(x1 * 4.f); kp[32 + lane] = f2fp8(x2 * 4.f);
    }
  }
  __syncthreads();
  int nq = NL - g0; nq = nq > 66 ? 66 : nq;
  if (nq > 0) gemm_ldsA<5, 384>(A1, 784, nq, p.Wuq_t, 1536, EpiQ{p.Qa, g0, 0});
  unsigned char* Vl = (unsigned char*)As + 66 * 784 + 66 * 528;
  const int sh = g0 & 3;
  gemm_ldsA<5, 256>(A2, 528, 66, p.Wukv_t, 2048, EpiKV{p.Kn, Vl, g0, sh});
  __syncthreads();
  for (int i = otid(); i < 1024 * 17; i += 512) {
    const int dvg = i / 17, q4 = i - dvg * 17, g4 = g0 - sh + 4 * q4;
    const unsigned w = *(const unsigned*)(Vl + dvg * 68 + 4 * q4);
    int b, key;
    if (g4 < NL) { b = g4 >> 13; key = g4 & (SEQ - 1); } else { const int cidx = g4 - NL; b = cidx >> 8; key = SEQ + (cidx & (CTX - 1)); }
    const int m = (key & 63) >> 2, posd = (m & 1) * 8 + (m >> 3) * 4 + ((m >> 1) & 3);
    unsigned char* dst = p.Va + ((size_t)(b * 8 + (dvg >> 7)) * (KEYS / 64) + (key >> 6)) * 8192 + (dvg & 127) * 64 + posd * 4;
    if (g4 >= g0 && g4 + 3 < g0 + 66) *(unsigned*)dst = w;
    else if (g4 < g0) *(unsigned short*)(dst + 2) = (unsigned short)(w >> 16);
    else *(unsigned short*)dst = (unsigned short)(w & 0xFFFFu);
  }
  for (int rr = wave; rr < nq; rr += 8) {
    const int g = g0 + rr, b = g >> 13, n = g & (SEQ - 1);
    if (lane < 32) {
      const float inv = powf(10000.f, -(float)(lane & 15) / 16.f);
      const float ang = (lane < 16 ? (float)(n >> 6) : (float)(n & 63)) * inv;
      const float cs = cosf(ang), sn = sinf(ang);
#pragma unroll
      for (int h = 0; h < 8; ++h) {
        bf16_t* qo = p.Qa + ((size_t)(b * 8 + h) * SEQ + n) * 192;
        const float x1 = bf2f(qo[128 + lane]), x2 = bf2f(qo[160 + lane]);
        qo[128 + lane] = f2bf(x1 * cs - x2 * sn); qo[160 + lane] = f2bf(x2 * cs + x1 * sn);
      }
    }
  }
}

namespace att {
using i32x8 = __attribute__((ext_vector_type(8))) int;
using i32x4 = __attribute__((ext_vector_type(4))) int;
using f32x16 = __attribute__((ext_vector_type(16))) float;
constexpr int KVBLK = 64, KROW = 208, VROW = 80, NTILE = KEYS / 64;
constexpr float QKS = 4.f, VS = 4.f;
constexpr float SC = 0.07216878364870322f / (QKS * QKS);
constexpr float THR = 3.f, PSH = 4.f;
constexpr int SHM_V = 128 * VROW, SHM_K = KVBLK * KROW, SHM_ATTN = 2 * SHM_V + 2 * SHM_K + 8 * 64 * 4;
#define SBAR() __builtin_amdgcn_sched_barrier(0)
__device__ __forceinline__ int crow(int r, int hi) { return (r & 3) + 8 * (r >> 2) + 4 * hi; }
__device__ __forceinline__ f32x16 mfma8(i32x8 a, i32x8 b, f32x16 c) { return __builtin_amdgcn_mfma_scale_f32_32x32x64_f8f6f4(a, b, c, 0, 0, 0, 0x7F7F7F7F, 0, 0x7F7F7F7F); }
__device__ __forceinline__ i32x8 cat8(i32x4 a, i32x4 b) { return __builtin_shufflevector(a, b, 0, 1, 2, 3, 4, 5, 6, 7); }
__device__ __forceinline__ int pk4(float a, float b, float c, float d) { const int w = __builtin_amdgcn_cvt_pk_fp8_f32(a, b, 0, false); return __builtin_amdgcn_cvt_pk_fp8_f32(c, d, w, true); }
__device__ __forceinline__ void partialSM(f32x16& p0, f32x16& p1, float& m_reg, float& mn, float& alpha) {
  constexpr float C = SC * 1.4426950408889634f;
  float pmax = p0[0];
#pragma unroll
  for (int r = 1; r < 16; ++r) pmax = fmaxf(pmax, p0[r]);
#pragma unroll
  for (int r = 0; r < 16; ++r) pmax = fmaxf(pmax, p1[r]);
  { auto rr = __builtin_amdgcn_permlane32_swap(__float_as_uint(pmax), __float_as_uint(pmax), false, false);
    pmax = fmaxf(__uint_as_float(rr[0]), __uint_as_float(rr[1])); }
  if (__builtin_expect(__all(pmax - m_reg <= THR / SC), 1)) { mn = m_reg; alpha = 1.f; }
  else { mn = fmaxf(m_reg, pmax); alpha = __builtin_amdgcn_exp2f((m_reg - mn) * C); m_reg = mn; }
  const float mnC = PSH - mn * C;
#pragma unroll
  for (int r = 0; r < 16; ++r) p0[r] = fmaf(p0[r], C, mnC);
#pragma unroll
  for (int r = 0; r < 16; ++r) p1[r] = fmaf(p1[r], C, mnC);
#pragma unroll
  for (int r = 0; r < 16; ++r) p0[r] = __builtin_amdgcn_exp2f(p0[r]);
}
__device__ __forceinline__ void finishSM(f32x16& p0, f32x16& p1, float alpha, float& l_reg, i32x8& pa) {
#pragma unroll
  for (int r = 0; r < 16; ++r) p1[r] = __builtin_amdgcn_exp2f(p1[r]);
  float ps = 0;
#pragma unroll
  for (int r = 0; r < 16; ++r) ps += p0[r];
#pragma unroll
  for (int r = 0; r < 16; ++r) ps += p1[r];
  { auto rr = __builtin_amdgcn_permlane32_swap(__float_as_uint(ps), __float_as_uint(ps), false, false);
    ps = __uint_as_float(rr[0]) + __uint_as_float(rr[1]); }
  l_reg = l_reg * alpha + ps;
#pragma unroll
  for (int w = 0; w < 4; ++w) { pa[w] = pk4(p0[4 * w], p0[4 * w + 1], p0[4 * w + 2], p0[4 * w + 3]); pa[4 + w] = pk4(p1[4 * w], p1[4 * w + 1], p1[4 * w + 2], p1[4 * w + 3]); }
}
__device__ __forceinline__ void qkt(f32x16& p0, f32x16& p1, const char* Ks, const i32x8* q, int r32, int hi) {
  p0 = f32x16{}; p1 = f32x16{};
  const char* k0 = Ks + r32 * KROW + hi * 32; const char* k1 = k0 + 32 * KROW;
#pragma unroll
  for (int s = 0; s < 3; ++s) {
    const i32x8 a0 = cat8(*reinterpret_cast<const i32x4*>(k0 + s * 64), *reinterpret_cast<const i32x4*>(k0 + s * 64 + 16));
    const i32x8 a1 = cat8(*reinterpret_cast<const i32x4*>(k1 + s * 64), *reinterpret_cast<const i32x4*>(k1 + s * 64 + 16));
    p0 = mfma8(a0, q[s], p0);
    p1 = mfma8(a1, q[s], p1); }
}
__device__ __forceinline__ void pv_all(f32x16* o, const char* Vs, i32x8 pa, int r32, int hi) {
  const char* v0 = Vs + r32 * VROW + hi * 32;
#pragma unroll
  for (int d0 = 0; d0 < 4; ++d0) {
    const i32x8 vb = cat8(*reinterpret_cast<const i32x4*>(v0 + d0 * 32 * VROW), *reinterpret_cast<const i32x4*>(v0 + d0 * 32 * VROW + 16));
    o[d0] = mfma8(pa, vb, o[d0]); }
}
__device__ __forceinline__ void attn_body(const bf16_t* __restrict__ Qb, const unsigned char* __restrict__ Kn, const unsigned char* __restrict__ Krb, const unsigned char* __restrict__ Vt,
                                          bf16_t* __restrict__ Ob, char* lds) {
  const int tid = otid(), wid = tid >> 6, lane = tid & 63, r32 = lane & 31, hi = lane >> 5;
  char* V_lds = lds; char* K_lds = lds + 2 * SHM_V;
  float* ws = (float*)(lds + 2 * SHM_V + 2 * SHM_K) + wid * 64; float* li_l = ws; float* al_l = ws + 32;
  float m_reg = -1e30f, l_reg = 0; f32x16 o[4] = {}; i32x8 q[3];
  { const bf16_t* Qw = Qb + (size_t)(wid * 32 + r32) * 192 + hi * 32;
#pragma unroll
    for (int s = 0; s < 3; ++s) {
#pragma unroll
      for (int c = 0; c < 4; ++c) { const uint4 w = *reinterpret_cast<const uint4*>(Qw + s * 64 + c * 8);
        q[s][2 * c] = pk4(bflo(w.x) * QKS, bfhi(w.x) * QKS, bflo(w.y) * QKS, bfhi(w.y) * QKS);
        q[s][2 * c + 1] = pk4(bflo(w.z) * QKS, bfhi(w.z) * QKS, bflo(w.w) * QKS, bfhi(w.w) * QKS); } } }
  const int vdst = (tid >> 2) * VROW + (tid & 3) * 16, kdst = (tid >> 3) * KROW + (tid & 7) * 16, rdst = (tid >> 2) * KROW + 128 + (tid & 3) * 16;
  uint4 vs, ks, rs = make_uint4(0u, 0u, 0u, 0u);
#define SLOAD(t) do { vs = *reinterpret_cast<const uint4*>(Vt + (size_t)(t) * 8192 + tid * 16); ks = *reinterpret_cast<const uint4*>(Kn + (size_t)(t) * 8192 + tid * 16); \
    if (tid < 256) rs = *reinterpret_cast<const uint4*>(Krb + (size_t)(t) * 4096 + tid * 16); } while (0)
#define SWRITE(b) do { *(uint4*)(V_lds + (b) * SHM_V + vdst) = vs; *(uint4*)(K_lds + (b) * SHM_K + kdst) = ks; \
    if (tid < 256) *(uint4*)(K_lds + (b) * SHM_K + rdst) = rs; } while (0)
#define SWAIT() asm volatile("s_waitcnt vmcnt(0)" ::: "memory")
#define RESC(a) do { if (__any((a) < 1.f)) { if (hi == 0) al_l[r32] = (a); asm volatile("s_waitcnt lgkmcnt(0)" ::: "memory"); \
    for (int d = 0; d < 4; ++d) for (int r = 0; r < 16; ++r) o[d][r] *= al_l[crow(r, hi)]; } } while (0)
  f32x16 pA0, pA1, pB0, pB1; float mnA, mnB, alA, alB; i32x8 pa;
  SLOAD(0); SWAIT(); SWRITE(0); __syncthreads();
  qkt(pA0, pA1, K_lds, q, r32, hi); partialSM(pA0, pA1, m_reg, mnA, alA);
  SLOAD(1);
  SWAIT(); SWRITE(1); __syncthreads();
  for (int j = 1; j + 1 < NTILE; j += 2) {
    SBAR(); qkt(pB0, pB1, K_lds + SHM_K, q, r32, hi);
    finishSM(pA0, pA1, alA, l_reg, pa); SBAR();
    SLOAD(j + 1); SBAR();
    pv_all(o, V_lds, pa, r32, hi); partialSM(pB0, pB1, m_reg, mnB, alB);
    __syncthreads(); SWAIT(); SWRITE(0);
    RESC(alB); __syncthreads();
    SBAR(); qkt(pA0, pA1, K_lds, q, r32, hi);
    finishSM(pB0, pB1, alB, l_reg, pa); SBAR();
    SLOAD(j + 2); SBAR();
    pv_all(o, V_lds + SHM_V, pa, r32, hi); partialSM(pA0, pA1, m_reg, mnA, alA);
    __syncthreads(); SWAIT(); SWRITE(1);
    RESC(alA); __syncthreads();
  }
  SBAR(); qkt(pB0, pB1, K_lds + SHM_K, q, r32, hi);
  finishSM(pA0, pA1, alA, l_reg, pa); SBAR();
  pv_all(o, V_lds, pa, r32, hi); partialSM(pB0, pB1, m_reg, mnB, alB);
  __syncthreads(); RESC(alB);
  finishSM(pB0, pB1, alB, l_reg, pa); SBAR();
  pv_all(o, V_lds + SHM_V, pa, r32, hi);
  if (hi == 0) li_l[r32] = l_reg; asm volatile("s_waitcnt lgkmcnt(0)" ::: "memory");
  float rli[16];
#pragma unroll
  for (int r = 0; r < 16; ++r) rli[r] = __builtin_amdgcn_rcpf(li_l[crow(r, hi)]) * (1.f / VS);
  bf16_t* Ow = Ob + (size_t)(wid * 32) * D;
#pragma unroll
  for (int r = 0; r < 16; ++r) { const int orow = crow(r, hi);
#pragma unroll
    for (int d0 = 0; d0 < 4; ++d0) Ow[(size_t)orow * D + d0 * 32 + r32] = f2bf(o[d0][r] * rli[r]); }
  __syncthreads();
#undef SLOAD
#undef SWRITE
#undef SWAIT
#undef RESC
}
}

__device__ __forceinline__ void ph_attn(const bf16_t* __restrict__ Qa, const unsigned char* __restrict__ Kn, const unsigned char* __restrict__ Kr, const unsigned char* __restrict__ Vt,
                                        bf16_t* __restrict__ AO, int bid, int nblk, char* lds) {
  for (int item = bid; item < 512; item += nblk) {
    const int b = item >> 8, h = item & 7, qb = (item >> 3) & 31;
    att::attn_body(Qa + ((size_t)(b * 8 + h) * SEQ + qb * 256) * 192, Kn + (size_t)(b * 8 + h) * KEYS * 128, Kr + (size_t)b * KEYS * 64,
                   Vt + (size_t)(b * 8 + h) * KEYS * 128, AO + (size_t)(b * SEQ + qb * 256) * D + h * 128, lds);
  }
}

namespace rt {
using f32x16 = __attribute__((ext_vector_type(16))) float;
__device__ __forceinline__ int sortable(float f) { const int b = __float_as_int(f); return b ^ ((b >> 31) & 0x7FFFFFFF); }
__device__ __forceinline__ float unsortable(int k) { return __int_as_float(k ^ ((k >> 31) & 0x7FFFFFFF)); }
__device__ __forceinline__ int imax(int a, int b) { return a > b ? a : b; }
__device__ __forceinline__ int imin(int a, int b) { return a < b ? a : b; }
template <int N> __device__ __forceinline__ void sort_desc(int (&v)[N]) {
#pragma unroll
  for (int k = 2; k <= N; k <<= 1) {
#pragma unroll
    for (int j = k >> 1; j > 0; j >>= 1) {
#pragma unroll
      for (int i = 0; i < N; ++i) {
        const int l = i ^ j;
        if (l > i) {
          const bool desc = ((i & k) == 0);
          const int a = v[i], b = v[l];
          v[i] = desc ? imax(a, b) : imin(a, b);
          v[l] = desc ? imin(a, b) : imax(a, b);
        }
      }
    }
  }
}
template <int N> __device__ __forceinline__ void merge_desc(int (&v)[N]) {
#pragma unroll
  for (int j = N >> 1; j > 0; j >>= 1) {
#pragma unroll
    for (int i = 0; i < N; ++i) {
      const int l = i ^ j;
      if (l > i) { const int a = v[i], b = v[l]; v[i] = imax(a, b); v[l] = imin(a, b); }
    }
  }
}
__device__ __forceinline__ void absorb16(int (&L)[16], int (&B)[16]) {
  sort_desc<16>(B);
#pragma unroll
  for (int i = 0; i < 16; ++i) L[i] = imax(L[i], B[15 - i]);
  merge_desc<16>(L);
}
__device__ __forceinline__ constexpr int npairs_row(int i) { return 16 / (i + 1); }
}

struct RouteP { const bf16_t* Q; const bf16_t* Khi; int* IDX; float* GATE; int rows_per_block; int pad; };
__device__ __forceinline__ void ph_route(const RouteP& p, int bid, char* lds) {
  using namespace rt;
  int (*svl)[64][33] = reinterpret_cast<int (*)[64][33]>(lds);
  const int wave = otid() >> 6, lane = otid() & 63, r32 = lane & 31, hi = lane >> 5, hi4 = hi * 4;
  int nrows = p.rows_per_block; asm volatile("" : "+s"(nrows));
  const int g0 = bid * nrows;
  const int h = wave;
#pragma unroll 1
  for (int tg = 0; tg * 32 < nrows; ++tg) {
    int trow = tg * 32 + r32; const bool valid = trow < nrows; trow = valid ? trow : nrows - 1;
    const bf16_t* qrow = p.Q + (size_t)(g0 + trow) * D;
    int sv[2][16];
#pragma unroll
    for (int s = 0; s < 2; ++s) {
      const int hs = h * 2 + s;
      f32x16 acc[4];
#pragma unroll
      for (int m = 0; m < 4; ++m) acc[m] = f32x16{};
#pragma unroll
      for (int kp = 0; kp < 2; ++kp) {
        bf16x8 kf[2][4], qf[2];
#pragma unroll
        for (int k2 = 0; k2 < 2; ++k2)
#pragma unroll
          for (int m = 0; m < 4; ++m) kf[k2][m] = *(const bf16x8*)(p.Khi + ((size_t)(hs * 128 + m * 32 + r32)) * 64 + (kp * 2 + k2) * 16 + hi * 8);
#pragma unroll
        for (int k2 = 0; k2 < 2; ++k2) {
          const int ks = kp * 2 + k2;
          qf[k2] = *(const bf16x8*)(qrow + hs * 64 + ks * 16 + hi * 8);
        }
#pragma unroll
        for (int k2 = 0; k2 < 2; ++k2)
#pragma unroll
          for (int m = 0; m < 4; ++m) acc[m] = __builtin_amdgcn_mfma_f32_32x32x16_bf16(kf[k2][m], qf[k2], acc[m], 0, 0, 0);
      }
      int L[16];
#pragma unroll
      for (int m = 0; m < 4; ++m) {
        int B[16];
#pragma unroll
        for (int r = 0; r < 16; ++r) B[r] = (sortable(acc[m][r]) & ~0x7F) | (m * 32 + (r & 3) + 8 * (r >> 2)) | hi4;
        if (m == 0) { sort_desc<16>(B);
#pragma unroll
          for (int i = 0; i < 16; ++i) L[i] = B[i]; }
        else absorb16(L, B);
      }
      int Lo[16], Hi[16];
#pragma unroll
      for (int i = 0; i < 16; ++i) { auto rr = __builtin_amdgcn_permlane32_swap((unsigned)L[i], (unsigned)L[i], false, false); Lo[i] = (int)rr[0]; Hi[i] = (int)rr[1]; }
#pragma unroll
      for (int i = 0; i < 16; ++i) L[i] = imax(Lo[i], Hi[15 - i]);
      merge_desc<16>(L);
#pragma unroll
      for (int i = 0; i < 16; ++i) { sv[s][i] = L[i]; svl[wave][lane][s * 16 + i] = L[i]; }
    }
    float f0[16], f1[16];
#pragma unroll
    for (int i = 0; i < 16; ++i) { f0[i] = unsortable(sv[0][i] & ~0x7F); f1[i] = unsortable(sv[1][i] & ~0x7F); }
    int Lc[16];
    {
      int C[64];
      int n = 0;
#pragma unroll
      for (int i = 0; i < 16; ++i)
#pragma unroll
        for (int j = 0; j < 16; ++j)
          if ((i + 1) * (j + 1) <= 16) { C[n] = (sortable(f0[i] + f1[j]) & ~0xFF) | (i * 16 + j); ++n; }
#pragma unroll
      for (int k = 50; k < 64; ++k) C[k] = (int)0x80000000;
#pragma unroll
      for (int m = 0; m < 4; ++m) {
        int B[16];
#pragma unroll
        for (int r = 0; r < 16; ++r) B[r] = C[m * 16 + r];
        if (m == 0) { sort_desc<16>(B);
#pragma unroll
          for (int i = 0; i < 16; ++i) Lc[i] = B[i]; }
        else absorb16(Lc, B);
      }
    }
    float e[16]; float esum = 0.f;
    const float vmax = unsortable(Lc[0] & ~0xFF);
#pragma unroll
    for (int r = 0; r < 16; ++r) { e[r] = expf(unsortable(Lc[r] & ~0xFF) - vmax); esum += e[r]; }
    const float inv = 1.f / esum;
    int eid[16];
#pragma unroll
    for (int r = 0; r < 16; ++r) {
      const int pr = Lc[r] & 0xFF;
      const int k0 = svl[wave][lane][pr >> 4] & 0x7F, k1 = svl[wave][lane][16 + (pr & 15)] & 0x7F;
      eid[r] = k0 * 128 + k1;
    }
    if (valid && hi == 0) {
      int* ip = p.IDX + (size_t)(g0 + trow) * 128 + h * 16; float* gp = p.GATE + (size_t)(g0 + trow) * 128 + h * 16;
#pragma unroll
      for (int r = 0; r < 16; r += 4) {
        *(int4*)(ip + r) = make_int4(eid[r], eid[r + 1], eid[r + 2], eid[r + 3]);
        *(float4*)(gp + r) = make_float4(e[r] * inv, e[r + 1] * inv, e[r + 2] * inv, e[r + 3] * inv);
      }
    }
  }
}

__device__ __forceinline__ void cvt_rows_i8(const float* __restrict__ src, unsigned char* __restrict__ dst, float* __restrict__ scl, int nrows, int wgid, int nw) {
  const int lane = otid() & 63;
  for (int r0 = wgid * 4; r0 < nrows; r0 += nw * 4) {
    float v[4][16];
#pragma unroll
    for (int u = 0; u < 4; ++u) {
      const float* sp = src + (size_t)(r0 + u) * D + lane * 4;
      *(float4*)&v[u][0] = *(const float4*)sp; *(float4*)&v[u][4] = *(const float4*)(sp + 256); *(float4*)&v[u][8] = *(const float4*)(sp + 512); *(float4*)&v[u][12] = *(const float4*)(sp + 768);
    }
#pragma unroll
    for (int u = 0; u < 4; ++u) {
      float am = 0.f;
#pragma unroll
      for (int j = 0; j < 16; ++j) am = fmaxf(am, fabsf(v[u][j]));
#pragma unroll
      for (int o = 32; o >= 1; o >>= 1) am = fmaxf(am, __shfl_xor(am, o));
      const float sc = am > 0.f ? am * (1.f / 127.f) : 1.f, inv = 1.f / sc;
      unsigned w[4];
#pragma unroll
      for (int q4 = 0; q4 < 4; ++q4) {
        unsigned ww = 0u;
#pragma unroll
        for (int j = 0; j < 4; ++j) { int qi = (int)rintf(v[u][q4 * 4 + j] * inv) + 128; qi = qi < 1 ? 1 : (qi > 255 ? 255 : qi); ww |= (unsigned)qi << (8 * j); }
        w[q4] = ww;
      }
      *(uint4*)(dst + (size_t)(r0 + u) * D + lane * 16) = make_uint4(w[0], w[1], w[2], w[3]);
      if (lane == 0) scl[r0 + u] = sc;
    }
  }
}

struct GatherP { const bf16_t* Tbf; const int* IDX; const float* GATE; const unsigned char* utab; const unsigned char* vtab; const float* su; const float* sv;
                 const float* Hin; const float* mod; const float* lng; const float* lnb; float* Hout; const float* modT; };
#define UB0(w) ((float)((w) & 0xFFu))
#define UB1(w) ((float)(((w) >> 8) & 0xFFu))
#define UB2(w) ((float)(((w) >> 16) & 0xFFu))
#define UB3(w) ((float)((w) >> 24))
template <bool FINAL>
__device__ __forceinline__ void ln_token(const GatherP& p, int row, int rr, int lane, const float (&f)[16], float asum, char* As) {
  const int v = row_vec(row);
  const float* hin = p.Hin + (size_t)row * D + lane * 4;
  const float* gm = p.mod + v * 6144 + 5 * 1024 + lane * 4;
  const float off = 128.f * asum;
  float r[16]; float ssum = 0.f;
#pragma unroll
  for (int q4 = 0; q4 < 4; ++q4) {
    const float4 h4 = *(const float4*)(hin + q4 * 256), g4 = *(const float4*)(gm + q4 * 256);
    r[q4 * 4 + 0] = ALPHA * h4.x + g4.x * (f[q4 * 4 + 0] - off); r[q4 * 4 + 1] = ALPHA * h4.y + g4.y * (f[q4 * 4 + 1] - off);
    r[q4 * 4 + 2] = ALPHA * h4.z + g4.z * (f[q4 * 4 + 2] - off); r[q4 * 4 + 3] = ALPHA * h4.w + g4.w * (f[q4 * 4 + 3] - off);
    ssum += r[q4 * 4 + 0] + r[q4 * 4 + 1] + r[q4 * 4 + 2] + r[q4 * 4 + 3];
  }
  const float mu = wave_sum(ssum) * (1.f / D);
  float vs = 0.f;
#pragma unroll
  for (int j = 0; j < 16; ++j) { const float dlt = r[j] - mu; vs += dlt * dlt; }
  const float rstd = rsqrtf(wave_sum(vs) * (1.f / D) + LN_EPS);
  float o[16];
#pragma unroll
  for (int q4 = 0; q4 < 4; ++q4) {
    const float4 g4 = *(const float4*)(p.lng + q4 * 256 + lane * 4), b4 = *(const float4*)(p.lnb + q4 * 256 + lane * 4);
    o[q4 * 4 + 0] = (r[q4 * 4 + 0] - mu) * rstd * g4.x + b4.x; o[q4 * 4 + 1] = (r[q4 * 4 + 1] - mu) * rstd * g4.y + b4.y;
    o[q4 * 4 + 2] = (r[q4 * 4 + 2] - mu) * rstd * g4.z + b4.z; o[q4 * 4 + 3] = (r[q4 * 4 + 3] - mu) * rstd * g4.w + b4.w;
    *(float4*)(p.Hout + (size_t)row * D + q4 * 256 + lane * 4) = make_float4(o[q4 * 4 + 0], o[q4 * 4 + 1], o[q4 * 4 + 2], o[q4 * 4 + 3]);
  }
  if (!FINAL) {
    const float* mt = p.modT + v * 6144 + lane * 4;
#pragma unroll
    for (int q4 = 0; q4 < 4; ++q4) {
      const float4 sh = *(const float4*)(mt + q4 * 256), sc = *(const float4*)(mt + 1024 + q4 * 256);
      uint2 w; w.x = pack2bf(o[q4 * 4] * (1.f + sc.x) + sh.x, o[q4 * 4 + 1] * (1.f + sc.y) + sh.y); w.y = pack2bf(o[q4 * 4 + 2] * (1.f + sc.z) + sh.z, o[q4 * 4 + 3] * (1.f + sc.w) + sh.w);
      *(uint2*)(As + rr * LDA_B + (q4 * 256 + lane * 4) * 2) = w;
    }
  }
}
constexpr int PARTW = 1088;
template <bool FINAL>
__device__ __forceinline__ void ph_gather_tm(const GatherP& p, int g0, int nrows, char* As, float* __restrict__ PART) {
  const int tid = otid(), wave = tid >> 6, lane = tid & 63;
  const int nfull = nrows >> 3, extra = nrows & 7;
  const int nun = nfull + (extra ? 1 : 0);
#pragma unroll 1
  for (int un = 0; un < nun; ++un) {
    int rr, kbeg, kcnt; bool partial;
    if (un < nfull) { rr = wave + 8 * un; kbeg = 0; kcnt = 128; partial = false; }
    else { const int wpt = 8 / extra; rr = nfull * 8 + wave / wpt; kcnt = 128 / wpt; kbeg = (wave % wpt) * kcnt; partial = true; }
    const int row = g0 + rr;
    float tf[16];
    {
      const bf16_t* tp = p.Tbf + (size_t)row * D + lane * 4;
      const uint2 t0 = *(const uint2*)tp, t1 = *(const uint2*)(tp + 256), t2 = *(const uint2*)(tp + 512), t3 = *(const uint2*)(tp + 768);
      tf[0] = bflo(t0.x); tf[1] = bfhi(t0.x); tf[2] = bflo(t0.y); tf[3] = bfhi(t0.y); tf[4] = bflo(t1.x); tf[5] = bfhi(t1.x); tf[6] = bflo(t1.y); tf[7] = bfhi(t1.y);
      tf[8] = bflo(t2.x); tf[9] = bfhi(t2.x); tf[10] = bflo(t2.y); tf[11] = bfhi(t2.y); tf[12] = bflo(t3.x); tf[13] = bfhi(t3.x); tf[14] = bflo(t3.y); tf[15] = bfhi(t3.y);
    }
    float tsum = 0.f;
#pragma unroll
    for (int j = 0; j < 16; ++j) tsum += tf[j];
    tsum = wave_sum_dpp(tsum) * 128.f;
    const int id_lo = p.IDX[(size_t)row * 128 + lane], id_hi = p.IDX[(size_t)row * 128 + 64 + lane];
    const float ga_lo = p.GATE[(size_t)row * 128 + lane], ga_hi = p.GATE[(size_t)row * 128 + 64 + lane];
    float f[16], asum = 0.f;
#pragma unroll
    for (int j = 0; j < 16; ++j) f[j] = 0.f;
    uint4 ub[8], vb[8]; float sub[8], svb[8];
#define TLOAD(slot, kk) do { const int e_ = __builtin_amdgcn_readlane((kk) < 64 ? id_lo : id_hi, (kk) & 63); \
      ub[slot] = *(const uint4*)(p.utab + (size_t)e_ * D + lane * 16); vb[slot] = *(const uint4*)(p.vtab + (size_t)e_ * D + lane * 16); \
      sub[slot] = p.su[e_]; svb[slot] = p.sv[e_]; } while (0)
    auto proc4 = [&](int s0, int k0) {
      float dot[4];
#pragma unroll
      for (int u = 0; u < 4; ++u) {
        const uint4 a_ = ub[s0 + u];
        float d = tf[0] * UB0(a_.x); d = fmaf(tf[1], UB1(a_.x), d); d = fmaf(tf[2], UB2(a_.x), d); d = fmaf(tf[3], UB3(a_.x), d);
        d = fmaf(tf[4], UB0(a_.y), d); d = fmaf(tf[5], UB1(a_.y), d); d = fmaf(tf[6], UB2(a_.y), d); d = fmaf(tf[7], UB3(a_.y), d);
        d = fmaf(tf[8], UB0(a_.z), d); d = fmaf(tf[9], UB1(a_.z), d); d = fmaf(tf[10], UB2(a_.z), d); d = fmaf(tf[11], UB3(a_.z), d);
        d = fmaf(tf[12], UB0(a_.w), d); d = fmaf(tf[13], UB1(a_.w), d); d = fmaf(tf[14], UB2(a_.w), d); d = fmaf(tf[15], UB3(a_.w), d);
        dot[u] = d;
      }
#define DPPSTEP(ctl, rm) do { _Pragma("unroll") for (int u = 0; u < 4; ++u) dot[u] += __uint_as_float(__builtin_amdgcn_update_dpp(0u, __float_as_uint(dot[u]), ctl, rm, 0xF, true)); } while (0)
      DPPSTEP(0xB1, 0xF); DPPSTEP(0x4E, 0xF); DPPSTEP(0x141, 0xF); DPPSTEP(0x140, 0xF); DPPSTEP(0x142, 0xA); DPPSTEP(0x143, 0xC);
#undef DPPSTEP
      float act[4];
#pragma unroll
      for (int u = 0; u < 4; ++u) {
        const int kk = k0 + u;
        const float tot = __uint_as_float((unsigned)__builtin_amdgcn_readlane((int)__float_as_uint(dot[u]), 63));
        const float g_ = __uint_as_float((unsigned)__builtin_amdgcn_readlane((int)__float_as_uint(kk < 64 ? ga_lo : ga_hi), kk & 63));
        act[u] = gelu_fast(sub[s0 + u] * (tot - tsum)) * g_ * svb[s0 + u];
      }
#pragma unroll
      for (int u = 0; u < 4; ++u) {
        const float act_ = act[u];
        asum += act_;
        const uint4 c_ = vb[s0 + u];
        f[0] = fmaf(act_, UB0(c_.x), f[0]); f[1] = fmaf(act_, UB1(c_.x), f[1]); f[2] = fmaf(act_, UB2(c_.x), f[2]); f[3] = fmaf(act_, UB3(c_.x), f[3]);
        f[4] = fmaf(act_, UB0(c_.y), f[4]); f[5] = fmaf(act_, UB1(c_.y), f[5]); f[6] = fmaf(act_, UB2(c_.y), f[6]); f[7] = fmaf(act_, UB3(c_.y), f[7]);
        f[8] = fmaf(act_, UB0(c_.z), f[8]); f[9] = fmaf(act_, UB1(c_.z), f[9]); f[10] = fmaf(act_, UB2(c_.z), f[10]); f[11] = fmaf(act_, UB3(c_.z), f[11]);
        f[12] = fmaf(act_, UB0(c_.w), f[12]); f[13] = fmaf(act_, UB1(c_.w), f[13]); f[14] = fmaf(act_, UB2(c_.w), f[14]); f[15] = fmaf(act_, UB3(c_.w), f[15]);
      }
    };
    TLOAD(0, kbeg); TLOAD(1, kbeg + 1); TLOAD(2, kbeg + 2); TLOAD(3, kbeg + 3); TLOAD(4, kbeg + 4); TLOAD(5, kbeg + 5); TLOAD(6, kbeg + 6); TLOAD(7, kbeg + 7);
    const int kend = kbeg + kcnt - 8;
#pragma unroll 1
    for (int k = kbeg; k < kend; k += 8) {
      proc4(0, k); TLOAD(0, k + 8); TLOAD(1, k + 9); TLOAD(2, k + 10); TLOAD(3, k + 11);
      proc4(4, k + 4); TLOAD(4, k + 12); TLOAD(5, k + 13); TLOAD(6, k + 14); TLOAD(7, k + 15);
    }
    proc4(0, kend); proc4(4, kend + 4);
#undef TLOAD
    if (!partial) ln_token<FINAL>(p, row, rr, lane, f, asum, As);
    else {
      float* pp = PART + wave * PARTW + lane * 16;
      *(float4*)pp = make_float4(f[0], f[1], f[2], f[3]); *(float4*)(pp + 4) = make_float4(f[4], f[5], f[6], f[7]);
      *(float4*)(pp + 8) = make_float4(f[8], f[9], f[10], f[11]); *(float4*)(pp + 12) = make_float4(f[12], f[13], f[14], f[15]);
      if (lane == 0) PART[wave * PARTW + 1024] = asum;
    }
  }
  if (extra) {
    __syncthreads();
    if (wave < extra) {
      const int wpt = 8 / extra, rr = nfull * 8 + wave;
      float f[16], asum = 0.f;
#pragma unroll
      for (int j = 0; j < 16; ++j) f[j] = 0.f;
      for (int w2 = wave * wpt; w2 < wave * wpt + wpt; ++w2) {
        const float* pp = PART + w2 * PARTW + lane * 16;
#pragma unroll
        for (int q4 = 0; q4 < 4; ++q4) { const float4 x4 = *(const float4*)(pp + q4 * 4); f[q4 * 4] += x4.x; f[q4 * 4 + 1] += x4.y; f[q4 * 4 + 2] += x4.z; f[q4 * 4 + 3] += x4.w; }
        asum += PART[w2 * PARTW + 1024];
      }
      ln_token<FINAL>(p, g0 + rr, rr, lane, f, asum, As);
    }
  }
}

__device__ __forceinline__ void cvt_plain(const float* __restrict__ a, bf16_t* __restrict__ o, size_t n8, bool lo, size_t gtid, size_t gsz) {
  for (size_t i = gtid; i < n8; i += gsz) {
    float v[8];
    *(float4*)&v[0] = ((const float4*)a)[i * 2]; *(float4*)&v[4] = ((const float4*)a)[i * 2 + 1];
    if (lo) {
#pragma unroll
      for (int j = 0; j < 8; ++j) v[j] = v[j] - bf2f(f2bf(v[j]));
    }
    uint4 w; w.x = pack2bf(v[0], v[1]); w.y = pack2bf(v[2], v[3]); w.z = pack2bf(v[4], v[5]); w.w = pack2bf(v[6], v[7]);
    ((uint4*)o)[i] = w;
  }
}
__device__ __forceinline__ void cvt_t(const float* __restrict__ W, bf16_t* __restrict__ Wt, int K, int N, bool lo, size_t gtid, size_t gsz) {
  const size_t total = (size_t)N * (K / 8);
#pragma unroll 4
  for (size_t i = gtid; i < total; i += gsz) {
    const int n = (int)(i % N), k8 = (int)(i / N);
    float v[8];
#pragma unroll
    for (int j = 0; j < 8; ++j) { const float w = W[(size_t)(k8 * 8 + j) * N + n]; v[j] = lo ? w - bf2f(f2bf(w)) : w; }
    uint4 w; w.x = pack2bf(v[0], v[1]); w.y = pack2bf(v[2], v[3]); w.z = pack2bf(v[4], v[5]); w.w = pack2bf(v[6], v[7]);
    *(uint4*)(Wt + ((size_t)((n >> 4) * (K >> 5) + (k8 >> 2)) * 64 + (k8 & 3) * 16 + (n & 15)) * 8) = w;
  }
}
__device__ __forceinline__ void mod_item(const float* __restrict__ c, const float* __restrict__ c_ctx, const float* __restrict__ ada_w, const float* __restrict__ ada_b,
                                         float* __restrict__ MOD, int item, bool valid, char* lds, int tid, int nct, volatile int* cbc, int& cgen) {
  float* sc = (float*)lds;
  float* part = sc + 3072;
  const int wave = tid >> 6, lane = tid & 63, l = item / 96, cg = item % 96, nw = nct >> 6;
  if (valid) for (int i = tid; i < 3072; i += nct) { const int v = i >> 10, k = i & 1023; const float xv = v < 2 ? c[v * 1024 + k] : c_ctx[k]; sc[i] = xv / (1.f + expf(-xv)); }
  cbar(cbc, cgen, nw);
  if (valid) {
    float a0 = 0.f, a1 = 0.f, a2 = 0.f;
    const float* W = ada_w + (size_t)l * 1024 * 6144 + cg * 64 + lane;
    const int kb = wave * 171, ke = kb + 171 < 1024 ? kb + 171 : 1024;
#pragma unroll 19
    for (int k = kb; k < ke; ++k) { const float w = W[(size_t)k * 6144]; a0 += sc[k] * w; a1 += sc[1024 + k] * w; a2 += sc[2048 + k] * w; }
    part[(wave * 3 + 0) * 64 + lane] = a0; part[(wave * 3 + 1) * 64 + lane] = a1; part[(wave * 3 + 2) * 64 + lane] = a2;
  }
  cbar(cbc, cgen, nw);
  if (valid && tid < 192) {
    const int v = tid >> 6, ln = tid & 63; float sum = 0.f;
    for (int w = 0; w < nw; ++w) sum += part[(w * 3 + v) * 64 + ln];
    MOD[(l * 3 + v) * 6144 + cg * 64 + ln] = sum + ada_b[l * 6144 + cg * 64 + ln];
  }
}

__device__ __forceinline__ void gbar(unsigned* cnt, unsigned target) {
  asm volatile("s_waitcnt vmcnt(0)" ::: "memory");
  __syncthreads();
  if (otid() == 0) {
    __builtin_amdgcn_fence(__ATOMIC_RELEASE, "agent");
    asm volatile("s_waitcnt vmcnt(0)" ::: "memory");
    __hip_atomic_fetch_add(cnt, 1u, __ATOMIC_RELAXED, __HIP_MEMORY_SCOPE_AGENT);
    unsigned spins = 0;
    while (__hip_atomic_load(cnt, __ATOMIC_RELAXED, __HIP_MEMORY_SCOPE_AGENT) < target) { __builtin_amdgcn_s_sleep(2); if (++spins > (1u << 24)) break; }
    __builtin_amdgcn_fence(__ATOMIC_ACQUIRE, "agent");
    asm volatile("s_waitcnt vmcnt(0)" ::: "memory");
  }
  __syncthreads();
}

struct MP {
  const float *x, *c, *ctx, *c_ctx, *ada_w, *ada_b, *ln_g, *ln_b, *s5_a_re, *s5_a_im, *s5_log_dt, *s5_b_re, *s5_b_im, *s5_c_re, *s5_c_im, *s5_d, *s5_w_glu, *s5_w_o;
  const float *mla_w_dq, *mla_q_norm, *mla_w_uq, *mla_w_dkv, *mla_kv_norm, *mla_w_ukv, *mla_w_o, *peer_w_q, *peer_keys, *peer_u, *peer_v;
  float* out;
  float* MOD; bf16_t *Wt_glu, *Wt_o0, *Wt_q0, *Wt_o1, *Wt_q1, *Wt_cat, *Wt_uq, *Wt_ukv, *Khi, *Khi1;
  unsigned char *U0, *V0, *U1, *V1; float *SU0, *SV0, *SU1, *SV1; bf16_t *Ktab, *Bst_t, *Cin_t;
  bf16_t* Ypart; float* Ssta; bf16_t *HP, *Gbf, *Vbf, *Tbf; float *OQ, *H1, *H2; int* IDX; float* GATE;
  bf16_t *Qa, *AObf; unsigned char *Kn, *Kr, *Va; float* H3; bf16_t* Tbf1; unsigned* BAR; float* PART;
};
constexpr int LDS_BYTES = 66 * 784 + 66 * 528 + 1024 * 68 + 64;
__global__ __launch_bounds__(512) void mega(MP p) {
  __shared__ __attribute__((aligned(16))) char lds[LDS_BYTES];
  cg::grid_group grid = cg::this_grid();
  const int nblk = gridDim.x;
  int bid = blockIdx.x;
  const size_t TD = (size_t)1024 * 16384;
  const float* mod0 = p.MOD; const float* mod1 = p.MOD + 3 * 6144;
  {
    volatile int* cbc = (volatile int*)(lds + LDS_BYTES - 16);
    if (otid() == 0) *cbc = 0;
    __syncthreads();
    const int t0 = otid();
    if (t0 < 128) {
      const size_t mt = (size_t)bid * 128 + t0, ms = (size_t)nblk * 128;
      const int mw = bid * 2 + (t0 >> 6), nmw = nblk * 2;
      cvt_t(p.s5_w_glu, p.Wt_glu, D, D, false, mt, ms);
      cvt_t(p.s5_w_o, p.Wt_o0, D, D, false, mt, ms);
      cvt_t(p.peer_w_q, p.Wt_q0, D, D, false, mt, ms);
      cvt_t(p.mla_w_o, p.Wt_o1, D, D, false, mt, ms);
      cvt_t(p.peer_w_q + (size_t)D * D, p.Wt_q1, D, D, false, mt, ms);
      cvt_t(p.mla_w_dq, p.Wt_cat, D, 384, false, mt, ms);
      cvt_t(p.mla_w_dkv, p.Wt_cat + (size_t)384 * D, D, 320, false, mt, ms);
      cvt_t(p.mla_w_uq, p.Wt_uq, 384, 1536, false, mt, ms);
      cvt_t(p.mla_w_ukv, p.Wt_ukv, 256, 2048, false, mt, ms);
      cvt_plain(p.peer_keys, p.Khi, (size_t)2 * 131072 / 8, false, mt, ms);
      cvt_rows_i8(p.peer_u, p.U0, p.SU0, 16384, mw, nmw);
      cvt_rows_i8(p.peer_v, p.V0, p.SV0, 16384, mw, nmw);
      cvt_rows_i8(p.peer_u + TD, p.U1, p.SU1, 16384, mw, nmw);
      cvt_rows_i8(p.peer_v + TD, p.V1, p.SV1, 16384, mw, nmw);
    } else {
      int cgen = 0;
      const int ct = t0 - 128;
      ph_s5_prep(p.s5_a_re, p.s5_a_im, p.s5_log_dt, p.s5_b_re, p.s5_b_im, p.s5_c_re, p.s5_c_im, p.Ktab, p.Bst_t, p.Cin_t, bid >> 2, bid & 3, lds, ct, 384, cbc, cgen);
      cbar(cbc, cgen, 6);
      mod_item(p.c, p.c_ctx, p.ada_w, p.ada_b, p.MOD, bid, bid < 192, lds, ct, 384, cbc, cgen);
    }
  }
  grid.sync();
  asm volatile("" : "+s"(bid));
  ph_s5_p1(p.x, p.ctx, mod0, p.Ktab, p.Bst_t, p.Ypart, p.Ssta, bid, lds);
  gbar(p.BAR, 1u * (unsigned)nblk);
  asm volatile("" : "+s"(bid));
  if (otid() < 64) ph_s5_carry(p.Ssta, p.s5_a_re, p.s5_a_im, p.s5_log_dt, p.HP, bid, otid());
  gbar(p.BAR, 2u * (unsigned)nblk);
  asm volatile("" : "+s"(bid));
  ph_s5_p3(p.x, p.ctx, mod0, p.s5_d, p.HP, p.Cin_t, p.Ypart, p.Gbf, bid, lds);
  gbar(p.BAR, 3u * (unsigned)nblk);
  asm volatile("" : "+s"(bid));
  {
    ChainP cp{p.Gbf, p.Wt_glu, p.Wt_o0, p.Wt_q0, p.Vbf, (bf16_t*)p.OQ + (size_t)bid * 66 * D, p.x, p.ctx, mod0, p.ln_g, p.ln_b, p.H1, p.Tbf, (bf16_t*)p.OQ + (size_t)bid * 66 * D  };
    ph_chainA<true>(cp, bid, lds);
    __syncthreads();
    ph_route(RouteP{(bf16_t*)p.OQ + (size_t)bid * 66 * D, p.Khi, p.IDX, p.GATE, 66, 0}, bid, lds);
    __syncthreads();
    GatherP gp{p.Tbf, p.IDX, p.GATE, p.U0, p.V0, p.SU0, p.SV0, p.H1, mod0, p.ln_g + D, p.ln_b + D, p.H2, mod1};
    ph_gather_tm<false>(gp, bid * 66, 66, lds, p.PART + (size_t)bid * 8 * PARTW);
    __syncthreads();
    ProjP pp{p.Wt_cat, p.Wt_uq, p.Wt_ukv, p.mla_q_norm, p.mla_kv_norm, p.OQ  , p.Qa, p.Kn, p.Kr, p.Va};
    ph_mla_proj(pp, bid, lds);
  }
  gbar(p.BAR, 4u * (unsigned)nblk);
  asm volatile("" : "+s"(bid));
  ph_attn(p.Qa, p.Kn, p.Kr, p.Va, p.AObf, bid, nblk, lds);
  gbar(p.BAR, 5u * (unsigned)nblk);
  asm volatile("" : "+s"(bid));
  {
    ChainP cp{p.AObf, nullptr, p.Wt_o1, p.Wt_q1, nullptr, (bf16_t*)p.OQ + (size_t)bid * 64 * D, p.H2, p.H2 + (size_t)NL * D, mod1, p.ln_g + 2 * D, p.ln_b + 2 * D, p.H3, p.Tbf1, (bf16_t*)p.OQ + (size_t)bid * 64 * D};
    ph_chainA<false>(cp, bid, lds);
    __syncthreads();
    ph_route(RouteP{(bf16_t*)p.OQ + (size_t)bid * 64 * D, p.Khi1, p.IDX, p.GATE, 64, 0}, bid, lds);
    __syncthreads();
    GatherP gp{p.Tbf1, p.IDX, p.GATE, p.U1, p.V1, p.SU1, p.SV1, p.H3, mod1, p.ln_g + 3 * D, p.ln_b + 3 * D, p.out, mod1};
    ph_gather_tm<true>(gp, bid * 64, 64, lds, p.PART + (size_t)bid * 8 * PARTW);
  }
}

extern "C" void kernel_launch(void* const* d_in, const int* in_sizes, int n_in, void* d_out, int out_size, void* d_ws, size_t ws_size, hipStream_t stream) {
  MP p{};
  const float** in = (const float**)&p;
  for (int i = 0; i < 29; ++i) in[i] = (const float*)d_in[i];
  p.out = (float*)d_out;
  char* ws = (char*)d_ws; size_t off = 0;
  auto carve = [&](size_t bytes) { char* q = ws + off; off += (bytes + 255) / 256 * 256; return q; };
  const size_t TDB = (size_t)1024 * 16384 * 2, BIG = (size_t)NT * D * 4, HALF = (size_t)NT * D * 2;
  p.MOD = (float*)carve(2 * 3 * 6144 * 4);
  p.Wt_glu = (bf16_t*)carve((size_t)D * D * 2); p.Wt_o0 = (bf16_t*)carve((size_t)D * D * 2); p.Wt_q0 = (bf16_t*)carve((size_t)D * D * 2);
  p.Wt_o1 = (bf16_t*)carve((size_t)D * D * 2); p.Wt_q1 = (bf16_t*)carve((size_t)D * D * 2);
  p.Wt_cat = (bf16_t*)carve((size_t)704 * D * 2); p.Wt_uq = (bf16_t*)carve((size_t)1536 * 384 * 2); p.Wt_ukv = (bf16_t*)carve((size_t)2048 * 256 * 2);
  p.Khi = (bf16_t*)carve((size_t)2 * 131072 * 2); p.Khi1 = p.Khi + 131072;
  char* T0 = carve(TDB); p.U0 = (unsigned char*)T0; p.V0 = (unsigned char*)(T0 + TDB / 2); p.AObf = (bf16_t*)T0;
  p.SU0 = (float*)carve(16384 * 4); p.SV0 = (float*)carve(16384 * 4); p.SU1 = (float*)carve(16384 * 4); p.SV1 = (float*)carve(16384 * 4);
  const size_t KTAB_B = (size_t)64 * 127 * 256 * 2, BST_B = (size_t)64 * 256 * 1024 * 2, KN_B = (size_t)NB * 8 * KEYS * 128 * 2, KR_B = (size_t)NB * KEYS * 64 * 2;
  size_t x1 = KTAB_B + 2 * BST_B; if (x1 < 2 * KN_B + KR_B) x1 = 2 * KN_B + KR_B;
  char* X1 = carve(x1);
  p.Ktab = (bf16_t*)X1; p.Bst_t = (bf16_t*)(X1 + KTAB_B); p.Cin_t = (bf16_t*)(X1 + KTAB_B + BST_B);
  p.Kn = (unsigned char*)X1; p.Va = (unsigned char*)(X1 + KN_B); p.Kr = (unsigned char*)(X1 + 2 * KN_B); p.H3 = (float*)X1;
  char* X2 = carve(BIG); p.Ypart = (bf16_t*)X2; p.OQ = (float*)X2;
  char* X3 = carve(HALF); p.Ssta = (float*)X3; p.HP = (bf16_t*)(X3 + (size_t)NCC * 64 * 256 * 4); p.Vbf = (bf16_t*)X3;
  char* X4 = carve(HALF); p.Gbf = (bf16_t*)X4; p.Tbf = (bf16_t*)X4; p.Tbf1 = (bf16_t*)X4;
  char* X5 = carve(BIG); p.H1 = (float*)X5;
  char* T1 = carve(TDB); p.U1 = (unsigned char*)T1; p.V1 = (unsigned char*)(T1 + TDB / 2);
  p.H2 = (float*)carve(BIG);
  p.IDX = (int*)carve((size_t)NT * 128 * 4); p.GATE = (float*)carve((size_t)NT * 128 * 4);
  p.Qa = (bf16_t*)carve((size_t)NB * 8 * SEQ * 192 * 2);
  p.BAR = (unsigned*)carve(256);
  p.PART = (float*)carve((size_t)256 * 8 * PARTW * 4);
  if (off > ws_size || n_in != 29) { fprintf(stderr, "kernel_launch: workspace too small (need %zu, have %zu) or n_in %d != 29\n", off, ws_size, n_in); return; }
  static int grid_blocks = 0;
  if (!grid_blocks) {
    int dev = 0, cus = 0, per_cu = 0;
    hipGetDevice(&dev);
    hipDeviceGetAttribute(&cus, hipDeviceAttributeMultiprocessorCount, dev);
    hipOccupancyMaxActiveBlocksPerMultiprocessor(&per_cu, mega, 512, 0);
    if (per_cu < 1 || cus < 256) { fprintf(stderr, "kernel_launch: need 256 resident workgroups (cus %d, per_cu %d)\n", cus, per_cu); return; }
    grid_blocks = 256;
  }
  hipMemsetAsync(p.BAR, 0, 256, stream);
  void* args[] = {&p};
  hipError_t e = hipLaunchCooperativeKernel((void*)mega, dim3(grid_blocks), dim3(512), args, 0, stream);
  if (e != hipSuccess) fprintf(stderr, "cooperative launch failed: %s\n", hipGetErrorString(e));
}
```

```cpp
#include <hip/hip_runtime.h>
#include <math.h>
#include <hip/hip_cooperative_groups.h>
#include <cstdio>
namespace cg = cooperative_groups;
__device__ __forceinline__ int otid() { int t = (int)__builtin_amdgcn_workitem_id_x(); asm volatile("" : "+v"(t)); return t; }

constexpr int D = 1024, NB = 2, SEQ = 8192, CTX = 256;
constexpr int NL = NB * SEQ, NC = NB * CTX, NT = NL + NC;
constexpr float ALPHA = 1.4142135623730951f;
constexpr float LN_EPS = 1e-5f, RMS_EPS = 1e-6f;

__device__ __forceinline__ float wave_sum_dpp(float v) {
  v += __uint_as_float(__builtin_amdgcn_update_dpp(0u, __float_as_uint(v), 0xB1, 0xF, 0xF, true));
  v += __uint_as_float(__builtin_amdgcn_update_dpp(0u, __float_as_uint(v), 0x4E, 0xF, 0xF, true));
  v += __uint_as_float(__builtin_amdgcn_update_dpp(0u, __float_as_uint(v), 0x141, 0xF, 0xF, true));
  v += __uint_as_float(__builtin_amdgcn_update_dpp(0u, __float_as_uint(v), 0x140, 0xF, 0xF, true));
  v += __uint_as_float(__builtin_amdgcn_update_dpp(0u, __float_as_uint(v), 0x142, 0xA, 0xF, true));
  v += __uint_as_float(__builtin_amdgcn_update_dpp(0u, __float_as_uint(v), 0x143, 0xC, 0xF, true));
  return __uint_as_float((unsigned)__builtin_amdgcn_readlane((int)__float_as_uint(v), 63));
}
__device__ __forceinline__ float wave_sum(float v) { return wave_sum_dpp(v); }
__device__ __forceinline__ int row_vec(int row) { return row < NL ? (row >> 13) : 2; }
__device__ __forceinline__ float gelu_exact(float x) { return 0.5f * x * (1.f + erff(x * 0.70710678118654752f)); }
__device__ __forceinline__ float gelu_fast(float x) {
  const float z = fabsf(x) * 0.70710678118654752f;
  const float t = __builtin_amdgcn_rcpf(fmaf(0.3275911f, z, 1.f));
  float pl = fmaf(1.061405429f, t, -1.453152027f); pl = fmaf(pl, t, 1.421413741f); pl = fmaf(pl, t, -0.284496736f); pl = fmaf(pl, t, 0.254829592f);
  const float e = __builtin_amdgcn_exp2f(-z * z * 1.4426950408889634f);
  const float erfa = 1.f - pl * t * e;
  const float hx = 0.5f * x;
  return hx + fabsf(hx) * erfa;
}


typedef unsigned short bf16_t;
using bf16x8 = __attribute__((ext_vector_type(8))) short;
using f32x4 = __attribute__((ext_vector_type(4))) float;
__device__ __forceinline__ bf16_t f2bf(float f) { unsigned u = __float_as_uint(f); u += 0x7FFFu + ((u >> 16) & 1u); return (bf16_t)(u >> 16); }
__device__ __forceinline__ unsigned char f2fp8(float v) { return (unsigned char)(__builtin_amdgcn_cvt_pk_fp8_f32(v, v, 0, false) & 0xFF); }
__device__ __forceinline__ float bf2f(bf16_t h) { return __uint_as_float(((unsigned)h) << 16); }
__device__ __forceinline__ unsigned pack2bf(float lo, float hi) { return (unsigned)f2bf(lo) | ((unsigned)f2bf(hi) << 16); }
__device__ __forceinline__ float bflo(unsigned w) { return __uint_as_float(w << 16); }
__device__ __forceinline__ float bfhi(unsigned w) { return __uint_as_float(w & 0xFFFF0000u); }


constexpr int LDA_B = 1024 * 2 + 16;
template <int RT, int K>
__device__ __forceinline__ void gemm_unit(const char* const (&ap)[RT], const bf16_t* __restrict__ w0, const bf16_t* __restrict__ w1, int kmul, f32x4 (&acc)[RT][2]) {
  constexpr int KI = K / 128, NS = 2;
#pragma unroll
  for (int t = 0; t < RT; ++t) { acc[t][0] = f32x4{0.f, 0.f, 0.f, 0.f}; acc[t][1] = f32x4{0.f, 0.f, 0.f, 0.f}; }
  bf16x8 b[NS][4][2];
#pragma unroll
  for (int st = 0; st < NS - 1; ++st) {
    if (st < KI) {
#pragma unroll
      for (int s2 = 0; s2 < 4; ++s2) { b[st][s2][0] = *(const bf16x8*)(w0 + (st * 128 + s2 * 32) * kmul); b[st][s2][1] = *(const bf16x8*)(w1 + (st * 128 + s2 * 32) * kmul); }
    }
  }
  asm volatile("" ::: "memory");
  bf16x8 an[RT];
#pragma unroll
  for (int t = 0; t < RT; ++t) an[t] = *(const bf16x8*)(ap[t]);
#pragma unroll
  for (int it = 0; it < KI; ++it) {
    if (it + NS - 1 < KI) {
#pragma unroll
      for (int s2 = 0; s2 < 4; ++s2) {
        b[(it + NS - 1) % NS][s2][0] = *(const bf16x8*)(w0 + ((it + NS - 1) * 128 + s2 * 32) * kmul);
        b[(it + NS - 1) % NS][s2][1] = *(const bf16x8*)(w1 + ((it + NS - 1) * 128 + s2 * 32) * kmul);
      }
    }
    asm volatile("" ::: "memory");
#pragma unroll
    for (int s2 = 0; s2 < 4; ++s2) {
      bf16x8 ac[RT];
#pragma unroll
      for (int t = 0; t < RT; ++t) ac[t] = an[t];
      if (it * 4 + s2 + 1 < KI * 4) {
#pragma unroll
        for (int t = 0; t < RT; ++t) an[t] = *(const bf16x8*)(ap[t] + (it * 128 + s2 * 32 + 32) * 2);
      }
#pragma unroll
      for (int t = 0; t < RT; ++t) {
        acc[t][0] = __builtin_amdgcn_mfma_f32_16x16x32_bf16(ac[t], b[it % NS][s2][0], acc[t][0], 0, 0, 0);
        acc[t][1] = __builtin_amdgcn_mfma_f32_16x16x32_bf16(ac[t], b[it % NS][s2][1], acc[t][1], 0, 0, 0);
      }
    }
  }
}
template <int RT, int K, class Epi>
__device__ __forceinline__ void gemm_ldsA(const char* As, int lda_b, int nrows, const bf16_t* __restrict__ Wt, int N, Epi epi) {
  const int wave = otid() >> 6, lane = otid() & 63, l15 = lane & 15, q = lane >> 4;
  const char* ap[RT];
#pragma unroll
  for (int t = 0; t < RT; ++t) { int r = t * 16 + l15; r = r < nrows ? r : nrows - 1; ap[t] = As + r * lda_b + q * 16; }
#pragma unroll 1
  for (int unit = wave; unit < (N >> 5); unit += 8) {
    const int n0 = unit * 32;
    const bf16_t* w0 = Wt + (size_t)(n0 >> 4) * K * 16 + lane * 8;
    f32x4 acc[RT][2];
    gemm_unit<RT, K>(ap, w0, w0 + (size_t)K * 16, 16, acc);
#pragma unroll
    for (int t = 0; t < RT; ++t)
#pragma unroll
      for (int j = 0; j < 2; ++j)
#pragma unroll
        for (int r = 0; r < 4; ++r) {
          const int row = t * 16 + q * 4 + r, col = n0 + j * 16 + l15;
          if (row < nrows) epi(row, col, acc[t][j][r]);
        }
  }
}
struct EpiBF16 { bf16_t* C; int ldc; __device__ __forceinline__ void operator()(int row, int col, float v) const { C[(size_t)row * ldc + col] = f2bf(v); } };
struct EpiF32 { float* C; int ldc; __device__ __forceinline__ void operator()(int row, int col, float v) const { C[(size_t)row * ldc + col] = v; } };
struct EpiGluL { const char* As; bf16_t* V; __device__ __forceinline__ void operator()(int row, int col, float z) const {
  const float g = bf2f(*(const bf16_t*)(As + row * LDA_B + col * 2)); V[(size_t)row * D + col] = f2bf(g / (1.f + expf(-z))); } };

__device__ __forceinline__ void load_rows_lds(char* As, const bf16_t* __restrict__ src, int nrows) {
  const int t = otid(), total = nrows * 128;
#pragma unroll
  for (int h = 0; h < 2; ++h) {
    uint4 v[9];
#pragma unroll
    for (int k = 0; k < 9; ++k) { int i = t + (h * 9 + k) * 512; i = i < total ? i : total - 1; v[k] = *(const uint4*)(src + (size_t)(i >> 7) * D + (i & 127) * 8); }
#pragma unroll
    for (int k = 0; k < 9; ++k) { const int i = t + (h * 9 + k) * 512; if (i < total) *(uint4*)(As + (i >> 7) * LDA_B + (i & 127) * 16) = v[k]; }
  }
}
__device__ __forceinline__ void ln_rows(char* As, int g0, int nrows, const float* Hl, const float* Hc, const bf16_t* __restrict__ O,
                                        const float* __restrict__ mod, int gate_i, const float* __restrict__ lng, const float* __restrict__ lnb,
                                        float* Hout, bf16_t* __restrict__ Tbf, int shift_i, int scale_i) {
  const int wave = otid() >> 6, lane = otid() & 63;
  for (int rr = wave; rr < nrows; rr += 8) {
    const int row = g0 + rr;
    const float* hin = row < NL ? Hl + (size_t)row * D : Hc + (size_t)(row - NL) * D;
    const bf16_t* f = O + (size_t)row * D;
    const float* m = mod + row_vec(row) * 6144;
    const float* gm = m + gate_i * 1024;
    float r[16]; float s = 0.f;
#pragma unroll
    for (int i = 0; i < 4; ++i) {
      const int d = i * 256 + lane * 4;
      const uint2 fw = *(const uint2*)(f + d);
      float4 h4 = *(const float4*)(hin + d), f4 = make_float4(bflo(fw.x), bfhi(fw.x), bflo(fw.y), bfhi(fw.y)), g4 = *(const float4*)(gm + d);
      r[i * 4 + 0] = ALPHA * h4.x + g4.x * f4.x; r[i * 4 + 1] = ALPHA * h4.y + g4.y * f4.y;
      r[i * 4 + 2] = ALPHA * h4.z + g4.z * f4.z; r[i * 4 + 3] = ALPHA * h4.w + g4.w * f4.w;
      s += r[i * 4 + 0] + r[i * 4 + 1] + r[i * 4 + 2] + r[i * 4 + 3];
    }
    const float mu = wave_sum(s) * (1.f / D);
    float vs = 0.f;
#pragma unroll
    for (int i = 0; i < 16; ++i) { float dlt = r[i] - mu; vs += dlt * dlt; }
    const float rstd = rsqrtf(wave_sum(vs) * (1.f / D) + LN_EPS);
#pragma unroll
    for (int i = 0; i < 4; ++i) {
      const int d = i * 256 + lane * 4;
      float4 g4 = *(const float4*)(lng + d), b4 = *(const float4*)(lnb + d);
      float4 o;
      o.x = (r[i * 4 + 0] - mu) * rstd * g4.x + b4.x; o.y = (r[i * 4 + 1] - mu) * rstd * g4.y + b4.y;
      o.z = (r[i * 4 + 2] - mu) * rstd * g4.z + b4.z; o.w = (r[i * 4 + 3] - mu) * rstd * g4.w + b4.w;
      *(float4*)(Hout + (size_t)row * D + d) = o;
      float4 sh = *(const float4*)(m + shift_i * 1024 + d), sc = *(const float4*)(m + scale_i * 1024 + d);
      const float t0 = o.x * (1.f + sc.x) + sh.x, t1 = o.y * (1.f + sc.y) + sh.y, t2 = o.z * (1.f + sc.z) + sh.z, t3 = o.w * (1.f + sc.w) + sh.w;
      uint2 w; w.x = pack2bf(t0, t1); w.y = pack2bf(t2, t3);
      *(uint2*)(As + rr * LDA_B + d * 2) = w;
      *(uint2*)(Tbf + (size_t)row * D + d) = w;

    }
  }
}


constexpr int S5T = 64, NCHUNK = (CTX + SEQ) / S5T  , NCC = NB * NCHUNK  ;
__device__ __forceinline__ int s5_token(int cc, int s) {
  const int b = cc / NCHUNK, ch = cc - b * NCHUNK;
  return ch < 4 ? NL + b * CTX + ch * S5T + s : b * SEQ + (ch - 4) * S5T + s;
}
__device__ __forceinline__ void cbar(volatile int* cnt, int& gen, int nwaves) {
  __builtin_amdgcn_fence(__ATOMIC_RELEASE, "workgroup");
  if ((otid() & 63) == 0) __hip_atomic_fetch_add((int*)cnt, 1, __ATOMIC_RELAXED, __HIP_MEMORY_SCOPE_WORKGROUP);
  ++gen;
  while (__hip_atomic_load((int*)cnt, __ATOMIC_RELAXED, __HIP_MEMORY_SCOPE_WORKGROUP) < gen * nwaves) __builtin_amdgcn_s_sleep(1);
  __builtin_amdgcn_fence(__ATOMIC_ACQUIRE, "workgroup");
}
__device__ __forceinline__ void ph_s5_prep(const float* __restrict__ a_re, const float* __restrict__ a_im, const float* __restrict__ log_dt,
                                                 const float* __restrict__ b_re, const float* __restrict__ b_im, const float* __restrict__ c_re, const float* __restrict__ c_im,
                                                 bf16_t* __restrict__ Ktab, bf16_t* __restrict__ Bst_t, bf16_t* __restrict__ Cin_t, int g, int part, char* lds, int tid, int nct, volatile int* cbc, int& cgen) {
  float2 (*pw)[65][64] = reinterpret_cast<float2 (*)[65][64]>(lds);
  float2 (*Bp)[64][16] = reinterpret_cast<float2 (*)[64][16]>(lds + 2 * 65 * 64 * 8);
  float2 (*Cc)[16][64] = reinterpret_cast<float2 (*)[16][64]>(lds + 2 * 65 * 64 * 8 + 2 * 64 * 16 * 8);
  float2 (*fs)[64] = reinterpret_cast<float2 (*)[64]>(lds + 2 * 65 * 64 * 8 + 2 * 64 * 16 * 8 + 2 * 16 * 64 * 8);
  if (tid < 128) {
    const int dir = tid >> 6, p = tid & 63, gp = (dir * 64 + g) * 64 + p;
    const float are = a_re[gp], aim = a_im[gp], dt = expf(log_dt[dir * 64 + g]);
    const float mag = expf(are * dt);
    const float abr = mag * cosf(aim * dt), abi = mag * sinf(aim * dt);
    const float nr = abr - 1.f, ni = abi, den = are * are + aim * aim;
    fs[dir][p] = make_float2((nr * are + ni * aim) / den, (ni * are - nr * aim) / den);
    float pr = 1.f, pi = 0.f;
    for (int e = 0; e <= 64; ++e) { pw[dir][e][p] = make_float2(pr, pi); const float nr2 = pr * abr - pi * abi, ni2 = pr * abi + pi * abr; pr = nr2; pi = ni2; }
  }
  cbar(cbc, cgen, nct >> 6);
  for (int i = tid; i < 2048; i += nct) {
    const int dir = i >> 10, p = (i >> 4) & 63, ci = i & 15;
    const size_t gi = ((size_t)(dir * 64 + g) * 64 + p) * 16 + ci;
    const float br = b_re[gi], bi = b_im[gi]; const float2 f = fs[dir][p];
    Bp[dir][p][ci] = make_float2(f.x * br - f.y * bi, f.x * bi + f.y * br);
    const int co = (i >> 6) & 15, p2 = i & 63;
    const size_t ci2 = ((size_t)(dir * 64 + g) * 16 + co) * 64 + p2;
    Cc[dir][co][p2] = make_float2(c_re[ci2], c_im[ci2]);
  }
  cbar(cbc, cgen, nct >> 6);
  for (int i = part * 508 + tid; i < (part + 1) * 508; i += nct) {
    const int ti = i >> 4, co = i & 15, tau = ti - 63;
    float acc[16];
#pragma unroll
    for (int ci = 0; ci < 16; ++ci) acc[ci] = 0.f;
    if (tau >= 0) {
      for (int p = 0; p < 64; ++p) {
        const float2 c = Cc[0][co][p], w = pw[0][tau][p];
        const float xr = c.x * w.x - c.y * w.y, xi = c.x * w.y + c.y * w.x;
#pragma unroll
        for (int ci = 0; ci < 16; ++ci) { const float2 bb = Bp[0][p][ci]; acc[ci] += xr * bb.x - xi * bb.y; }
      }
    }
    if (tau <= 0) {
      for (int p = 0; p < 64; ++p) {
        const float2 c = Cc[1][co][p], w = pw[1][-tau][p];
        const float xr = c.x * w.x - c.y * w.y, xi = c.x * w.y + c.y * w.x;
#pragma unroll
        for (int ci = 0; ci < 16; ++ci) { const float2 bb = Bp[1][p][ci]; acc[ci] += xr * bb.x - xi * bb.y; }
      }
    }
    uint4 o0, o1;
    o0.x = pack2bf(acc[0], acc[1]); o0.y = pack2bf(acc[2], acc[3]); o0.z = pack2bf(acc[4], acc[5]); o0.w = pack2bf(acc[6], acc[7]);
    o1.x = pack2bf(acc[8], acc[9]); o1.y = pack2bf(acc[10], acc[11]); o1.z = pack2bf(acc[12], acc[13]); o1.w = pack2bf(acc[14], acc[15]);
    bf16_t* kp = Ktab + (size_t)g * 127 * 256 + (size_t)i * 16;
    *(uint4*)kp = o0; *(uint4*)(kp + 8) = o1;
  }
  for (int i = part * 8192 + tid; i < (part + 1) * 8192; i += nct) {
    const int n = i >> 7, k8 = i & 127, dir = n >> 7, c = (n >> 6) & 1, p = n & 63, sidx = k8 >> 1, ci0 = (k8 & 1) * 8;
    const float2 w = pw[dir][dir == 0 ? 63 - sidx : sidx][p];
    float v[8];
#pragma unroll
    for (int j = 0; j < 8; ++j) { const float2 b = Bp[dir][p][ci0 + j]; v[j] = c == 0 ? (w.x * b.x - w.y * b.y) : (w.x * b.y + w.y * b.x); }
    uint4 o; o.x = pack2bf(v[0], v[1]); o.y = pack2bf(v[2], v[3]); o.z = pack2bf(v[4], v[5]); o.w = pack2bf(v[6], v[7]);
    *(uint4*)(Bst_t + (size_t)g * 256 * 1024 + ((size_t)((n >> 4) * 32 + (k8 >> 2)) * 64 + (k8 & 3) * 16 + (n & 15)) * 8) = o;
  }
  for (int i = part * 8192 + tid; i < (part + 1) * 8192; i += nct) {
    const int n = i >> 5, k8 = i & 31, t = n >> 4, co = n & 15, dir = k8 >> 4, c = (k8 >> 3) & 1, p0 = (k8 & 7) * 8;
    const int e = dir == 0 ? t + 1 : 64 - t;
    float v[8];
#pragma unroll
    for (int j = 0; j < 8; ++j) { const float2 cc = Cc[dir][co][p0 + j], w = pw[dir][e][p0 + j];
      v[j] = c == 0 ? (cc.x * w.x - cc.y * w.y) : -(cc.x * w.y + cc.y * w.x); }
    uint4 o; o.x = pack2bf(v[0], v[1]); o.y = pack2bf(v[2], v[3]); o.z = pack2bf(v[4], v[5]); o.w = pack2bf(v[6], v[7]);
    *(uint4*)(Cin_t + (size_t)g * 1024 * 256 + ((size_t)((n >> 4) * 8 + (k8 >> 2)) * 64 + (k8 & 3) * 16 + (n & 15)) * 8) = o;
  }
}
__device__ __forceinline__ void ph_s5_p1(const float* __restrict__ x, const float* __restrict__ ctx, const float* __restrict__ mod,
                                               const bf16_t* __restrict__ Ktab, const bf16_t* __restrict__ Bst_t, bf16_t* __restrict__ Ypart, float* __restrict__ S, int bid, char* As) {
  const int g = bid >> 2, cc0 = (bid & 3) * 66, tid = otid();
  const int wave = tid >> 6, lane = tid & 63, l15 = lane & 15, q = lane >> 4;
#pragma unroll 4
  for (int i = tid; i < 66 * 64 * 2; i += 512) {
    const int half = i & 1, sidx = (i >> 1) & 63, r = i >> 7;
    const int tok = s5_token(cc0 + r, sidx), ch = g * 16 + half * 8;
    const float* src = (tok < NL ? x + (size_t)tok * D : ctx + (size_t)(tok - NL) * D) + ch;
    const float* m = mod + row_vec(tok) * 6144;
    const float4 a = *(const float4*)src, b = *(const float4*)(src + 4);
    const float4 sh0 = *(const float4*)(m + ch), sh1 = *(const float4*)(m + ch + 4), sc0 = *(const float4*)(m + 1024 + ch), sc1 = *(const float4*)(m + 1024 + ch + 4);
    uint4 o;
    o.x = pack2bf(a.x * (1.f + sc0.x) + sh0.x, a.y * (1.f + sc0.y) + sh0.y); o.y = pack2bf(a.z * (1.f + sc0.z) + sh0.z, a.w * (1.f + sc0.w) + sh0.w);
    o.z = pack2bf(b.x * (1.f + sc1.x) + sh1.x, b.y * (1.f + sc1.y) + sh1.y); o.w = pack2bf(b.z * (1.f + sc1.z) + sh1.z, b.w * (1.f + sc1.w) + sh1.w);
    *(uint4*)(As + r * LDA_B + sidx * 32 + half * 16) = o;
  }
  __syncthreads();
  const char* ap[5];
#pragma unroll
  for (int t = 0; t < 5; ++t) { int r = t * 16 + l15; r = r < 66 ? r : 65; ap[t] = As + r * LDA_B + q * 16; }
  const bf16_t* Kg = Ktab + (size_t)g * 127 * 256;
#pragma unroll 1
  for (int unit = wave; unit < 40; unit += 8) {
    f32x4 acc[5][2];
    if (unit < 32) {
      const int t0 = unit * 2;
      const bf16_t* w0 = Kg + (t0 + 63 - (q >> 1)) * 256 + l15 * 16 + (q & 1) * 8;
      gemm_unit<5, 1024>(ap, w0, w0 + 256, -16, acc);
#pragma unroll
      for (int t = 0; t < 5; ++t)
#pragma unroll
        for (int j = 0; j < 2; ++j)
#pragma unroll
          for (int r = 0; r < 4; ++r) {
            const int row = t * 16 + q * 4 + r;
            if (row < 66) Ypart[(size_t)s5_token(cc0 + row, t0 + j) * D + g * 16 + l15] = f2bf(acc[t][j][r]);
          }
    } else {
      const int n0 = (unit - 32) * 32;
      const bf16_t* w0 = Bst_t + (size_t)g * 256 * 1024 + (size_t)(n0 >> 4) * 1024 * 16 + lane * 8;
      gemm_unit<5, 1024>(ap, w0, w0 + 1024 * 16, 16, acc);
#pragma unroll
      for (int t = 0; t < 5; ++t)
#pragma unroll
        for (int j = 0; j < 2; ++j)
#pragma unroll
          for (int r = 0; r < 4; ++r) {
            const int row = t * 16 + q * 4 + r;
            if (row < 66) S[((size_t)(cc0 + row) * 64 + g) * 256 + n0 + j * 16 + l15] = acc[t][j][r];
          }
    }
  }
}
__device__ __forceinline__ void ph_s5_carry(const float* __restrict__ S, const float* __restrict__ a_re, const float* __restrict__ a_im,
                                                 const float* __restrict__ log_dt, bf16_t* __restrict__ HP, int id, int p) {
  const int dir = id & 1, g = (id >> 1) & 63, b = id >> 7;
  const int gp = (dir * 64 + g) * 64 + p;
  const float are = a_re[gp], aim = a_im[gp], dt = expf(log_dt[dir * 64 + g]);
  const float mag = expf(are * dt);
  float tr = mag * cosf(aim * dt), ti = mag * sinf(aim * dt);
#pragma unroll
  for (int i = 0; i < 6; ++i) { const float nr = tr * tr - ti * ti, ni = 2.f * tr * ti; tr = nr; ti = ni; }
  float hr = 0.f, hi = 0.f;
#pragma unroll 12
  for (int step = 0; step < NCHUNK; ++step) {
    const int c = dir == 0 ? step : (step < 4 ? 3 - step : NCHUNK - 1 - (step - 4));
    const size_t base = ((size_t)(b * NCHUNK + c) * 64 + g) * 256 + dir * 128 + p;
    HP[base] = f2bf(hr); HP[base + 64] = f2bf(hi);
    const float sr = S[base], si = S[base + 64];
    const float nr = tr * hr - ti * hi + sr, ni = tr * hi + ti * hr + si;
    hr = nr; hi = ni;
  }
}
struct EpiS5 { const float* x; const float* ctx; const bf16_t* Ypart; bf16_t* Gbf; const float* cst; int cc0; int ch;
  __device__ __forceinline__ void operator()(int row, int col, float v) const {
    const int tok = s5_token(cc0 + row, col >> 4), vi = row_vec(tok);
    const float xin = tok < NL ? x[(size_t)tok * D + ch] : ctx[(size_t)(tok - NL) * D + ch];
    const float mm = xin * (1.f + cst[1 + vi * 2]) + cst[2 + vi * 2];
    const float y = v + bf2f(Ypart[(size_t)tok * D + ch]) + cst[0] * mm;
    Gbf[(size_t)tok * D + ch] = f2bf(gelu_fast(y));
  } };
__device__ __forceinline__ void ph_s5_p3(const float* __restrict__ x, const float* __restrict__ ctx, const float* __restrict__ mod, const float* __restrict__ dvec,
                                               const bf16_t* __restrict__ HP, const bf16_t* __restrict__ Cin_t, const bf16_t* __restrict__ Ypart, bf16_t* __restrict__ Gbf, int bid, char* As) {
  const int g = bid >> 2, cc0 = (bid & 3) * 66, tid = otid();
  for (int i = tid; i < 66 * 32; i += 512) {
    const int r = i >> 5, c = i & 31;
    *(uint4*)(As + r * 528 + c * 16) = *(const uint4*)(HP + ((size_t)(cc0 + r) * 64 + g) * 256 + c * 8);
  }
  __syncthreads();
  float* cst = (float*)(As + 66 * 528);
  if (tid < 16) {
    const int c0 = g * 16 + tid;
    cst[tid * 8 + 0] = dvec[c0];
    cst[tid * 8 + 1] = mod[1024 + c0]; cst[tid * 8 + 2] = mod[c0];
    cst[tid * 8 + 3] = mod[6144 + 1024 + c0]; cst[tid * 8 + 4] = mod[6144 + c0];
    cst[tid * 8 + 5] = mod[2 * 6144 + 1024 + c0]; cst[tid * 8 + 6] = mod[2 * 6144 + c0];
  }
  __syncthreads();
  gemm_ldsA<5, 256>(As, 528, 66, Cin_t + (size_t)g * 1024 * 256, 1024, EpiS5{x, ctx, Ypart, Gbf, cst + (otid() & 15) * 8, cc0, g * 16 + (otid() & 15)});
}


struct ChainP {
  const bf16_t* Ain;
  const bf16_t* Wglu_t; const bf16_t* Wo_t; const bf16_t* Wq_t;
  bf16_t* Vbf; bf16_t* O; const float* Hl; const float* Hc; const float* mod; const float* lng; const float* lnb;
  float* Hout; bf16_t* Tbf; bf16_t* Q;
};
template <bool L0>
__device__ __forceinline__ void ph_chainA(const ChainP& p, int bid, char* As) {
  constexpr int NR = L0 ? 66 : 64;
  constexpr int RT = L0 ? 5 : 4;
  const int g0 = bid * NR;
  load_rows_lds(As, p.Ain + (size_t)g0 * D, NR);
  __syncthreads();
  if (L0) {
    gemm_ldsA<RT, 1024>(As, LDA_B, NR, p.Wglu_t, D, EpiGluL{As, p.Vbf + (size_t)g0 * D});
    __syncthreads();
    load_rows_lds(As, p.Vbf + (size_t)g0 * D, NR);
    __syncthreads();
  }
  gemm_ldsA<RT, 1024>(As, LDA_B, NR, p.Wo_t, D, EpiBF16{p.O + (size_t)g0 * D, D});
  __syncthreads();
  ln_rows(As, g0, NR, p.Hl, p.Hc, p.O, p.mod, 2, p.lng, p.lnb, p.Hout, p.Tbf, 3, 4);
  __syncthreads();
  gemm_ldsA<RT, 1024>(As, LDA_B, NR, p.Wq_t, D, EpiBF16{p.Q + (size_t)g0 * D, D});
}


constexpr int KEYS = SEQ + CTX;
constexpr float att_KS = 0.5f;
struct EpiKV { unsigned char* Kn; unsigned char* Vl; int g0; int sh; __device__ __forceinline__ void operator()(int row, int col, float v) const {
  const int head = col >> 8, j = col & 255;
  if (j < 128) {
    const int g = g0 + row; int b, key;
    if (g < NL) { b = g >> 13; key = g & (SEQ - 1); } else { const int cidx = g - NL; b = cidx >> 8; key = SEQ + (cidx & (CTX - 1)); }
    Kn[((size_t)(b * 8 + head) * KEYS + key) * 128 + j] = f2fp8(v * att_KS);
  } else Vl[(head * 128 + (j - 128)) * 68 + row + sh] = f2fp8(v * 4.f);
} };
struct EpiQ { bf16_t* Qa; int g0; int pad; __device__ __forceinline__ void operator()(int row, int col, float v) const {
  const int g = g0 + row, b = g >> 13, n = g & (SEQ - 1);
  const int head = col / 192, j = col - head * 192;
  Qa[((size_t)(b * 8 + head) * SEQ + n) * 192 + j] = f2bf(v);
} };
struct ProjP { const bf16_t* Wcat_t; const bf16_t* Wuq_t; const bf16_t* Wukv_t; const float* q_norm; const float* kv_norm;
               float* PR; bf16_t* Qa; unsigned char* Kn; unsigned char* Kr; unsigned char* Va; };
__device__ __forceinline__ void ph_mla_proj(const ProjP& p, int bid, char* As) {
  const int g0 = bid * 66, wave = otid() >> 6, lane = otid() & 63;
  gemm_ldsA<5, 1024>(As, LDA_B, 66, p.Wcat_t, 704, EpiF32{p.PR + (size_t)g0 * D, D});
  __syncthreads();
  char* A1 = As; char* A2 = As + 66 * 784;
  for (int rr = wave; rr < 66; rr += 8) {
    const int g = g0 + rr;
    const float* pr = p.PR + (size_t)g * D;
    float v[6]; float ss = 0.f;
#pragma unroll
    for (int i = 0; i < 6; ++i) { v[i] = pr[i * 64 + lane]; ss += v[i] * v[i]; }
    float rn = rsqrtf(wave_sum(ss) * (1.f / 384.f) + RMS_EPS);
#pragma unroll
    for (int i = 0; i < 6; ++i) *(bf16_t*)(A1 + rr * 784 + (i * 64 + lane) * 2) = f2bf(v[i] * rn * p.q_norm[i * 64 + lane]);
    float w[4]; ss = 0.f;
#pragma unroll
    for (int i = 0; i < 4; ++i) { w[i] = pr[384 + i * 64 + lane]; ss += w[i] * w[i]; }
    rn = rsqrtf(wave_sum(ss) * (1.f / 256.f) + RMS_EPS);
#pragma unroll
    for (int i = 0; i < 4; ++i) *(bf16_t*)(A2 + rr * 528 + (i * 64 + lane) * 2) = f2bf(w[i] * rn * p.kv_norm[i * 64 + lane]);
    if (lane < 32) {
      float x1 = pr[640 + lane], x2 = pr[672 + lane];
      int b, key;
      if (g < NL) {
        b = g >> 13; key = g & (SEQ - 1);
        const int n = key, rr2 = n >> 6, cc = n & 63;
        const float inv = powf(10000.f, -(float)(lane & 15) / 16.f);
        const float ang = (lane < 16 ? (float)rr2 : (float)cc) * inv;
        const float cs = cosf(ang), sn = sinf(ang);
        const float y1 = x1 * cs - x2 * sn, y2 = x2 * cs + x1 * sn; x1 = y1; x2 = y2;
      } else { const int cidx = g - NL; b = cidx >> 8; key = SEQ + (cidx & (CTX - 1)); }
      unsigned char* kp = p.Kr + ((size_t)b * KEYS + key) * 64;
      kp[lane] = f2fp8(x1 * att_KS); kp[32 + lane] = f2fp8(x2 * att_KS);
    }
  }
  __syncthreads();
  int nq = NL - g0; nq = nq > 66 ? 66 : nq;
  if (nq > 0) gemm_ldsA<5, 384>(A1, 784, nq, p.Wuq_t, 1536, EpiQ{p.Qa, g0, 0});
  unsigned char* Vl = (unsigned char*)As + 66 * 784 + 66 * 528;
  const int sh = g0 & 3;
  gemm_ldsA<5, 256>(A2, 528, 66, p.Wukv_t, 2048, EpiKV{p.Kn, Vl, g0, sh});
  __syncthreads();
  for (int i = otid(); i < 1024 * 17; i += 512) {
    const int dvg = i / 17, q4 = i - dvg * 17, g4 = g0 - sh + 4 * q4;
    const unsigned w = *(const unsigned*)(Vl + dvg * 68 + 4 * q4);
    int b, key;
    if (g4 < NL) { b = g4 >> 13; key = g4 & (SEQ - 1); } else { const int cidx = g4 - NL; b = cidx >> 8; key = SEQ + (cidx & (CTX - 1)); }
    const int m = (key & 63) >> 2, posd = (m & 1) * 8 + (m >> 3) * 4 + ((m >> 1) & 3);
    unsigned char* dst = p.Va + ((size_t)(b * 8 + (dvg >> 7)) * (KEYS / 64) + (key >> 6)) * 8192 + (dvg & 127) * 64 + posd * 4;
    if (g4 >= g0 && g4 + 3 < g0 + 66) *(unsigned*)dst = w;
    else if (g4 < g0) *(unsigned short*)(dst + 2) = (unsigned short)(w >> 16);
    else *(unsigned short*)dst = (unsigned short)(w & 0xFFFFu);
  }
  for (int rr = wave; rr < nq; rr += 8) {
    const int g = g0 + rr, b = g >> 13, n = g & (SEQ - 1);
    if (lane < 32) {
      const float inv = powf(10000.f, -(float)(lane & 15) / 16.f);
      const float ang = (lane < 16 ? (float)(n >> 6) : (float)(n & 63)) * inv;
      const float cs = cosf(ang), sn = sinf(ang);
#pragma unroll
      for (int h = 0; h < 8; ++h) {
        bf16_t* qo = p.Qa + ((size_t)(b * 8 + h) * SEQ + n) * 192;
        const float x1 = bf2f(qo[128 + lane]), x2 = bf2f(qo[160 + lane]);
        qo[128 + lane] = f2bf(x1 * cs - x2 * sn); qo[160 + lane] = f2bf(x2 * cs + x1 * sn);
      }
    }
  }
}

namespace att {
using i32x8 = __attribute__((ext_vector_type(8))) int;
using i32x4 = __attribute__((ext_vector_type(4))) int;
using f32x16 = __attribute__((ext_vector_type(16))) float;
constexpr int KVBLK = 64, KROW = 208, VROW = 80, NTILE = KEYS / 64;
constexpr float KS = 0.5f, VS = 4.f;
constexpr float QS = 0.07216878364870322f * 1.4426950408889634f / KS;
constexpr float THR2 = 3.f * 1.4426950408889634f, PSH = 4.f;
constexpr int SHM_V = 128 * VROW, SHM_K = KVBLK * KROW, NSLOT = 3, SHM_ATTN = NSLOT * (SHM_V + SHM_K) + 8 * 64 * 4;
#define SBAR() __builtin_amdgcn_sched_barrier(0)
__device__ __forceinline__ int crow(int r, int hi) { return (r & 3) + 8 * (r >> 2) + 4 * hi; }
__device__ __forceinline__ f32x16 mfma8(i32x8 a, i32x8 b, f32x16 c) { return __builtin_amdgcn_mfma_scale_f32_32x32x64_f8f6f4(a, b, c, 0, 0, 0, 0, 0, 0); }
__device__ __forceinline__ i32x8 cat8(i32x4 a, i32x4 b) { return __builtin_shufflevector(a, b, 0, 1, 2, 3, 4, 5, 6, 7); }
__device__ __forceinline__ int pk4(float a, float b, float c, float d, int old = 0) { const int w = __builtin_amdgcn_cvt_pk_fp8_f32(a, b, old, false); return __builtin_amdgcn_cvt_pk_fp8_f32(c, d, w, true); }
__device__ __forceinline__ void softmax_tile(f32x16& p0, f32x16& p1, f32x16& bias, bool first, f32x16* o, float* al_l, int r32, int hi, i32x8& pa) {
  float pmax = p0[0];
#pragma unroll
  for (int r = 1; r < 16; ++r) pmax = fmaxf(pmax, p0[r]);
#pragma unroll
  for (int r = 0; r < 16; ++r) pmax = fmaxf(pmax, p1[r]);
  { auto rr = __builtin_amdgcn_permlane32_swap(__float_as_uint(pmax), __float_as_uint(pmax), false, false);
    pmax = fmaxf(__uint_as_float(rr[0]), __uint_as_float(rr[1])); }
  if (__builtin_expect(first || !__all(pmax <= PSH + THR2), 0)) {
    const float delta = first ? pmax - PSH : fmaxf(pmax - PSH, 0.f);
    if (!first) {
      if (hi == 0) al_l[r32] = __builtin_amdgcn_exp2f(-delta);
      asm volatile("s_waitcnt lgkmcnt(0)" ::: "memory");
#pragma unroll
      for (int d = 0; d < 5; ++d)
#pragma unroll
        for (int r = 0; r < 16; ++r) o[d][r] *= al_l[crow(r, hi)];
    }
    const float nb = bias[0] - delta;
#pragma unroll
    for (int r = 0; r < 16; ++r) { p0[r] -= delta; p1[r] -= delta; bias[r] = nb; }
  }
#pragma unroll
  for (int r = 0; r < 16; ++r) p0[r] = __builtin_amdgcn_exp2f(p0[r]);
#pragma unroll
  for (int r = 0; r < 16; ++r) p1[r] = __builtin_amdgcn_exp2f(p1[r]);
#pragma unroll
  for (int w = 0; w < 4; ++w) { pa[w] = pk4(p0[4 * w], p0[4 * w + 1], p0[4 * w + 2], p0[4 * w + 3], pa[w]); pa[4 + w] = pk4(p1[4 * w], p1[4 * w + 1], p1[4 * w + 2], p1[4 * w + 3], pa[4 + w]); }
}
__device__ __forceinline__ void qkt(f32x16& p0, f32x16& p1, const f32x16& bias, const char* Ks, const i32x8* q, int r32, int hi) {
  p0 = bias; p1 = bias;
  const char* k0 = Ks + r32 * KROW + hi * 32; const char* k1 = k0 + 32 * KROW;
#pragma unroll
  for (int s = 0; s < 3; ++s) {
    const i32x8 a0 = cat8(*reinterpret_cast<const i32x4*>(k0 + s * 64), *reinterpret_cast<const i32x4*>(k0 + s * 64 + 16));
    const i32x8 a1 = cat8(*reinterpret_cast<const i32x4*>(k1 + s * 64), *reinterpret_cast<const i32x4*>(k1 + s * 64 + 16));
    p0 = mfma8(a0, q[s], p0);
    p1 = mfma8(a1, q[s], p1); }
}
__device__ __forceinline__ void pv_all(f32x16* o, const char* Vs, i32x8 pa, int r32, int hi) {
  const char* v0 = Vs + r32 * VROW + hi * 32;
#pragma unroll
  for (int d0 = 0; d0 < 4; ++d0) {
    const i32x8 vb = cat8(*reinterpret_cast<const i32x4*>(v0 + d0 * 32 * VROW), *reinterpret_cast<const i32x4*>(v0 + d0 * 32 * VROW + 16));
    o[d0] = mfma8(pa, vb, o[d0]); }
  const i32x8 ones = {0x38383838, 0x38383838, 0x38383838, 0x38383838, 0x38383838, 0x38383838, 0x38383838, 0x38383838};
  o[4] = mfma8(pa, ones, o[4]);
}
__device__ __forceinline__ void attn_body(const bf16_t* __restrict__ Qb, const unsigned char* __restrict__ Kn, const unsigned char* __restrict__ Krb, const unsigned char* __restrict__ Vt,
                                          bf16_t* __restrict__ Ob, char* lds) {
  const int tid = otid(), wid = tid >> 6, lane = tid & 63, r32 = lane & 31, hi = lane >> 5;
  const bool lo4 = __builtin_amdgcn_readfirstlane(wid >> 2) == 0;
  char* V_lds = lds; char* K_lds = lds + NSLOT * SHM_V;
  float* al_l = (float*)(lds + NSLOT * (SHM_V + SHM_K)) + wid * 64;
  f32x16 bias = {}; f32x16 o[5] = {}; i32x8 q[3];
  { const bf16_t* Qw = Qb + (size_t)(wid * 32 + r32) * 192 + hi * 32;
#pragma unroll
    for (int s = 0; s < 3; ++s) {
#pragma unroll
      for (int c = 0; c < 4; ++c) { const uint4 w = *reinterpret_cast<const uint4*>(Qw + s * 64 + c * 8);
        q[s][2 * c] = pk4(bflo(w.x) * QS, bfhi(w.x) * QS, bflo(w.y) * QS, bfhi(w.y) * QS);
        q[s][2 * c + 1] = pk4(bflo(w.z) * QS, bfhi(w.z) * QS, bflo(w.w) * QS, bfhi(w.w) * QS); } } }
  i32x8 ones = {0x38383838, 0x38383838, 0x38383838, 0x38383838, 0x38383838, 0x38383838, 0x38383838, 0x38383838};
  const int vdst = (tid >> 2) * VROW + (tid & 3) * 16, kdst = (tid >> 3) * KROW + (tid & 7) * 16, rdst = (tid >> 2) * KROW + 128 + (tid & 3) * 16;
  const int kfo = r32 * KROW + hi * 32, vfo = r32 * VROW + hi * 32;
  uint4 vs, ks, rs = make_uint4(0u, 0u, 0u, 0u);
#define TLOAD(t) do { ks = *reinterpret_cast<const uint4*>(Kn + (size_t)(t) * 8192 + tid * 16); vs = *reinterpret_cast<const uint4*>(Vt + (size_t)(t) * 8192 + tid * 16); \
    if (lo4) rs = *reinterpret_cast<const uint4*>(Krb + (size_t)(t) * 4096 + tid * 16); } while (0)
#define TWRITE(sl) do { *(uint4*)(K_lds + (sl) * SHM_K + kdst) = ks; *(uint4*)(V_lds + (sl) * SHM_V + vdst) = vs; if (lo4) *(uint4*)(K_lds + (sl) * SHM_K + rdst) = rs; } while (0)
#define SWAIT() asm volatile("s_waitcnt vmcnt(0)" ::: "memory")
#define LD4(p) (*reinterpret_cast<const i32x4*>(p))
  f32x16 p0, p1; i32x8 pa = {};
  TLOAD(0); SWAIT(); TWRITE(0);
  TLOAD(1); SWAIT(); TWRITE(1);
  TLOAD(2);
  __syncthreads();
  int sl = 0, sl2 = 2;
#pragma unroll 1
  for (int i = 0; i < NTILE; ++i) {
    const char* kb = K_lds + sl * SHM_K + kfo; const char* vb = V_lds + sl * SHM_V + vfo;
    SBAR();
    i32x4 ka0 = LD4(kb), ka1 = LD4(kb + 16), ka2 = LD4(kb + 32 * KROW), ka3 = LD4(kb + 32 * KROW + 16);
    i32x4 kb0 = LD4(kb + 64), kb1 = LD4(kb + 80), kb2 = LD4(kb + 32 * KROW + 64), kb3 = LD4(kb + 32 * KROW + 80);
    SBAR();
    p0 = mfma8(cat8(ka0, ka1), q[0], bias); p1 = mfma8(cat8(ka2, ka3), q[0], bias);
    ka0 = LD4(kb + 128); ka1 = LD4(kb + 144); ka2 = LD4(kb + 32 * KROW + 128); ka3 = LD4(kb + 32 * KROW + 144);
    SBAR();
    p0 = mfma8(cat8(kb0, kb1), q[1], p0); p1 = mfma8(cat8(kb2, kb3), q[1], p1);
    i32x4 v00 = LD4(vb), v01 = LD4(vb + 16), v10 = LD4(vb + 32 * VROW), v11 = LD4(vb + 32 * VROW + 16);
    SBAR();
    p0 = mfma8(cat8(ka0, ka1), q[2], p0); p1 = mfma8(cat8(ka2, ka3), q[2], p1);
    SBAR();
    softmax_tile(p0, p1, bias, i == 0, o, al_l, r32, hi, pa);
    SBAR();
    i32x4 v20 = LD4(vb + 64 * VROW), v21 = LD4(vb + 64 * VROW + 16), v30 = LD4(vb + 96 * VROW), v31 = LD4(vb + 96 * VROW + 16);
    o[4] = mfma8(pa, ones, o[4]); o[0] = mfma8(pa, cat8(v00, v01), o[0]); o[1] = mfma8(pa, cat8(v10, v11), o[1]);
    SBAR();
    o[2] = mfma8(pa, cat8(v20, v21), o[2]); o[3] = mfma8(pa, cat8(v30, v31), o[3]);
    SBAR();
    SWAIT();
    if (i + 2 < NTILE) TWRITE(sl2);
    if (i + 3 < NTILE) TLOAD(i + 3);
    sl = sl == NSLOT - 1 ? 0 : sl + 1; sl2 = sl2 == NSLOT - 1 ? 0 : sl2 + 1;
    SBAR(); __syncthreads();
  }
  float rli[16];
#pragma unroll
  for (int r = 0; r < 16; ++r) rli[r] = __builtin_amdgcn_rcpf(o[4][r]) * (1.f / VS);
  bf16_t* Ow = Ob + (size_t)(wid * 32) * D;
#pragma unroll
  for (int r = 0; r < 16; ++r) { const int orow = crow(r, hi);
#pragma unroll
    for (int d0 = 0; d0 < 4; ++d0) Ow[(size_t)orow * D + d0 * 32 + r32] = f2bf(o[d0][r] * rli[r]); }
  __syncthreads();
#undef TLOAD
#undef TWRITE
#undef SWAIT
#undef LD4
}
}

__device__ __forceinline__ void ph_attn(const bf16_t* __restrict__ Qa, const unsigned char* __restrict__ Kn, const unsigned char* __restrict__ Kr, const unsigned char* __restrict__ Vt,
                                        bf16_t* __restrict__ AO, int bid, int nblk, char* lds) {
  for (int item = bid; item < 512; item += nblk) {
    const int b = item >> 8, h = item & 7, qb = (item >> 3) & 31;
    att::attn_body(Qa + ((size_t)(b * 8 + h) * SEQ + qb * 256) * 192, Kn + (size_t)(b * 8 + h) * KEYS * 128, Kr + (size_t)b * KEYS * 64,
                   Vt + (size_t)(b * 8 + h) * KEYS * 128, AO + (size_t)(b * SEQ + qb * 256) * D + h * 128, lds);
  }
}

namespace rt {
using f32x16 = __attribute__((ext_vector_type(16))) float;
__device__ __forceinline__ int sortable(float f) { const int b = __float_as_int(f); return b ^ ((b >> 31) & 0x7FFFFFFF); }
__device__ __forceinline__ float unsortable(int k) { return __int_as_float(k ^ ((k >> 31) & 0x7FFFFFFF)); }
__device__ __forceinline__ int imax(int a, int b) { return a > b ? a : b; }
__device__ __forceinline__ int imin(int a, int b) { return a < b ? a : b; }
template <int N> __device__ __forceinline__ void sort_desc(int (&v)[N]) {
#pragma unroll
  for (int k = 2; k <= N; k <<= 1) {
#pragma unroll
    for (int j = k >> 1; j > 0; j >>= 1) {
#pragma unroll
      for (int i = 0; i < N; ++i) {
        const int l = i ^ j;
        if (l > i) {
          const bool desc = ((i & k) == 0);
          const int a = v[i], b = v[l];
          v[i] = desc ? imax(a, b) : imin(a, b);
          v[l] = desc ? imin(a, b) : imax(a, b);
        }
      }
    }
  }
}
template <int N> __device__ __forceinline__ void merge_desc(int (&v)[N]) {
#pragma unroll
  for (int j = N >> 1; j > 0; j >>= 1) {
#pragma unroll
    for (int i = 0; i < N; ++i) {
      const int l = i ^ j;
      if (l > i) { const int a = v[i], b = v[l]; v[i] = imax(a, b); v[l] = imin(a, b); }
    }
  }
}
__device__ __forceinline__ void absorb16(int (&L)[16], int (&B)[16]) {
  sort_desc<16>(B);
#pragma unroll
  for (int i = 0; i < 16; ++i) L[i] = imax(L[i], B[15 - i]);
  merge_desc<16>(L);
}
__device__ __forceinline__ constexpr int npairs_row(int i) { return 16 / (i + 1); }
}

struct RouteP { const bf16_t* Q; const bf16_t* Khi; int* IDX; float* GATE; int rows_per_block; int pad; };
__device__ __forceinline__ void ph_route(const RouteP& p, int bid, char* lds) {
  using namespace rt;
  int (*svl)[64][33] = reinterpret_cast<int (*)[64][33]>(lds);
  const int wave = otid() >> 6, lane = otid() & 63, r32 = lane & 31, hi = lane >> 5, hi4 = hi * 4;
  int nrows = p.rows_per_block; asm volatile("" : "+s"(nrows));
  const int g0 = bid * nrows;
  const int h = wave;
#pragma unroll 1
  for (int tg = 0; tg * 32 < nrows; ++tg) {
    int trow = tg * 32 + r32; const bool valid = trow < nrows; trow = valid ? trow : nrows - 1;
    const bf16_t* qrow = p.Q + (size_t)(g0 + trow) * D;
    int sv[2][16];
#pragma unroll
    for (int s = 0; s < 2; ++s) {
      const int hs = h * 2 + s;
      f32x16 acc[4];
#pragma unroll
      for (int m = 0; m < 4; ++m) acc[m] = f32x16{};
#pragma unroll
      for (int kp = 0; kp < 2; ++kp) {
        bf16x8 kf[2][4], qf[2];
#pragma unroll
        for (int k2 = 0; k2 < 2; ++k2)
#pragma unroll
          for (int m = 0; m < 4; ++m) kf[k2][m] = *(const bf16x8*)(p.Khi + ((size_t)(hs * 128 + m * 32 + r32)) * 64 + (kp * 2 + k2) * 16 + hi * 8);
#pragma unroll
        for (int k2 = 0; k2 < 2; ++k2) {
          const int ks = kp * 2 + k2;
          qf[k2] = *(const bf16x8*)(qrow + hs * 64 + ks * 16 + hi * 8);
        }
#pragma unroll
        for (int k2 = 0; k2 < 2; ++k2)
#pragma unroll
          for (int m = 0; m < 4; ++m) acc[m] = __builtin_amdgcn_mfma_f32_32x32x16_bf16(kf[k2][m], qf[k2], acc[m], 0, 0, 0);
      }
      int L[16];
#pragma unroll
      for (int m = 0; m < 4; ++m) {
        int B[16];
#pragma unroll
        for (int r = 0; r < 16; ++r) B[r] = (sortable(acc[m][r]) & ~0x7F) | (m * 32 + (r & 3) + 8 * (r >> 2)) | hi4;
        if (m == 0) { sort_desc<16>(B);
#pragma unroll
          for (int i = 0; i < 16; ++i) L[i] = B[i]; }
        else absorb16(L, B);
      }
      int Lo[16], Hi[16];
#pragma unroll
      for (int i = 0; i < 16; ++i) { auto rr = __builtin_amdgcn_permlane32_swap((unsigned)L[i], (unsigned)L[i], false, false); Lo[i] = (int)rr[0]; Hi[i] = (int)rr[1]; }
#pragma unroll
      for (int i = 0; i < 16; ++i) L[i] = imax(Lo[i], Hi[15 - i]);
      merge_desc<16>(L);
#pragma unroll
      for (int i = 0; i < 16; ++i) { sv[s][i] = L[i]; svl[wave][lane][s * 16 + i] = L[i]; }
    }
    float f0[16], f1[16];
#pragma unroll
    for (int i = 0; i < 16; ++i) { f0[i] = unsortable(sv[0][i] & ~0x7F); f1[i] = unsortable(sv[1][i] & ~0x7F); }
    int Lc[16];
    {
      int C[64];
      int n = 0;
#pragma unroll
      for (int i = 0; i < 16; ++i)
#pragma unroll
        for (int j = 0; j < 16; ++j)
          if ((i + 1) * (j + 1) <= 16) { C[n] = (sortable(f0[i] + f1[j]) & ~0xFF) | (i * 16 + j); ++n; }
#pragma unroll
      for (int k = 50; k < 64; ++k) C[k] = (int)0x80000000;
#pragma unroll
      for (int m = 0; m < 4; ++m) {
        int B[16];
#pragma unroll
        for (int r = 0; r < 16; ++r) B[r] = C[m * 16 + r];
        if (m == 0) { sort_desc<16>(B);
#pragma unroll
          for (int i = 0; i < 16; ++i) Lc[i] = B[i]; }
        else absorb16(Lc, B);
      }
    }
    float e[16]; float esum = 0.f;
    const float vmax = unsortable(Lc[0] & ~0xFF);
#pragma unroll
    for (int r = 0; r < 16; ++r) { e[r] = expf(unsortable(Lc[r] & ~0xFF) - vmax); esum += e[r]; }
    const float inv = 1.f / esum;
    int eid[16];
#pragma unroll
    for (int r = 0; r < 16; ++r) {
      const int pr = Lc[r] & 0xFF;
      const int k0 = svl[wave][lane][pr >> 4] & 0x7F, k1 = svl[wave][lane][16 + (pr & 15)] & 0x7F;
      eid[r] = k0 * 128 + k1;
    }
    if (valid && hi == 0) {
      int* ip = p.IDX + (size_t)(g0 + trow) * 128 + h * 16; float* gp = p.GATE + (size_t)(g0 + trow) * 128 + h * 16;
#pragma unroll
      for (int r = 0; r < 16; r += 4) {
        *(int4*)(ip + r) = make_int4(eid[r], eid[r + 1], eid[r + 2], eid[r + 3]);
        *(float4*)(gp + r) = make_float4(e[r] * inv, e[r + 1] * inv, e[r + 2] * inv, e[r + 3] * inv);
      }
    }
  }
}

__device__ __forceinline__ void cvt_rows_i8(const float* __restrict__ src, unsigned char* __restrict__ dst, float* __restrict__ scl, int nrows, int wgid, int nw) {
  const int lane = otid() & 63;
  for (int r0 = wgid * 4; r0 < nrows; r0 += nw * 4) {
    float v[4][16];
#pragma unroll
    for (int u = 0; u < 4; ++u) {
      const float* sp = src + (size_t)(r0 + u) * D + lane * 4;
      *(float4*)&v[u][0] = *(const float4*)sp; *(float4*)&v[u][4] = *(const float4*)(sp + 256); *(float4*)&v[u][8] = *(const float4*)(sp + 512); *(float4*)&v[u][12] = *(const float4*)(sp + 768);
    }
#pragma unroll
    for (int u = 0; u < 4; ++u) {
      float am = 0.f;
#pragma unroll
      for (int j = 0; j < 16; ++j) am = fmaxf(am, fabsf(v[u][j]));
#pragma unroll
      for (int o = 32; o >= 1; o >>= 1) am = fmaxf(am, __shfl_xor(am, o));
      const float sc = am > 0.f ? am * (1.f / 127.f) : 1.f, inv = 1.f / sc;
      unsigned w[4];
#pragma unroll
      for (int q4 = 0; q4 < 4; ++q4) {
        unsigned ww = 0u;
#pragma unroll
        for (int j = 0; j < 4; ++j) { int qi = (int)rintf(v[u][q4 * 4 + j] * inv) + 128; qi = qi < 1 ? 1 : (qi > 255 ? 255 : qi); ww |= (unsigned)qi << (8 * j); }
        w[q4] = ww;
      }
      *(uint4*)(dst + (size_t)(r0 + u) * D + lane * 16) = make_uint4(w[0], w[1], w[2], w[3]);
      if (lane == 0) scl[r0 + u] = sc;
    }
  }
}

struct GatherP { const bf16_t* Tbf; const int* IDX; const float* GATE; const unsigned char* utab; const unsigned char* vtab; const float* su; const float* sv;
                 const float* Hin; const float* mod; const float* lng; const float* lnb; float* Hout; const float* modT; };
#define UB0(w) ((float)((w) & 0xFFu))
#define UB1(w) ((float)(((w) >> 8) & 0xFFu))
#define UB2(w) ((float)(((w) >> 16) & 0xFFu))
#define UB3(w) ((float)((w) >> 24))
template <bool FINAL>
__device__ __forceinline__ void ln_token(const GatherP& p, int row, int rr, int lane, const float (&f)[16], float asum, char* As) {
  const int v = row_vec(row);
  const float* hin = p.Hin + (size_t)row * D + lane * 4;
  const float* gm = p.mod + v * 6144 + 5 * 1024 + lane * 4;
  const float off = 128.f * asum;
  float r[16]; float ssum = 0.f;
#pragma unroll
  for (int q4 = 0; q4 < 4; ++q4) {
    const float4 h4 = *(const float4*)(hin + q4 * 256), g4 = *(const float4*)(gm + q4 * 256);
    r[q4 * 4 + 0] = ALPHA * h4.x + g4.x * (f[q4 * 4 + 0] - off); r[q4 * 4 + 1] = ALPHA * h4.y + g4.y * (f[q4 * 4 + 1] - off);
    r[q4 * 4 + 2] = ALPHA * h4.z + g4.z * (f[q4 * 4 + 2] - off); r[q4 * 4 + 3] = ALPHA * h4.w + g4.w * (f[q4 * 4 + 3] - off);
    ssum += r[q4 * 4 + 0] + r[q4 * 4 + 1] + r[q4 * 4 + 2] + r[q4 * 4 + 3];
  }
  const float mu = wave_sum(ssum) * (1.f / D);
  float vs = 0.f;
#pragma unroll
  for (int j = 0; j < 16; ++j) { const float dlt = r[j] - mu; vs += dlt * dlt; }
  const float rstd = rsqrtf(wave_sum(vs) * (1.f / D) + LN_EPS);
  float o[16];
#pragma unroll
  for (int q4 = 0; q4 < 4; ++q4) {
    const float4 g4 = *(const float4*)(p.lng + q4 * 256 + lane * 4), b4 = *(const float4*)(p.lnb + q4 * 256 + lane * 4);
    o[q4 * 4 + 0] = (r[q4 * 4 + 0] - mu) * rstd * g4.x + b4.x; o[q4 * 4 + 1] = (r[q4 * 4 + 1] - mu) * rstd * g4.y + b4.y;
    o[q4 * 4 + 2] = (r[q4 * 4 + 2] - mu) * rstd * g4.z + b4.z; o[q4 * 4 + 3] = (r[q4 * 4 + 3] - mu) * rstd * g4.w + b4.w;
    *(float4*)(p.Hout + (size_t)row * D + q4 * 256 + lane * 4) = make_float4(o[q4 * 4 + 0], o[q4 * 4 + 1], o[q4 * 4 + 2], o[q4 * 4 + 3]);
  }
  if (!FINAL) {
    const float* mt = p.modT + v * 6144 + lane * 4;
#pragma unroll
    for (int q4 = 0; q4 < 4; ++q4) {
      const float4 sh = *(const float4*)(mt + q4 * 256), sc = *(const float4*)(mt + 1024 + q4 * 256);
      uint2 w; w.x = pack2bf(o[q4 * 4] * (1.f + sc.x) + sh.x, o[q4 * 4 + 1] * (1.f + sc.y) + sh.y); w.y = pack2bf(o[q4 * 4 + 2] * (1.f + sc.z) + sh.z, o[q4 * 4 + 3] * (1.f + sc.w) + sh.w);
      *(uint2*)(As + rr * LDA_B + (q4 * 256 + lane * 4) * 2) = w;
    }
  }
}
constexpr int PARTW = 1088;
template <bool FINAL>
__device__ __forceinline__ void ph_gather_tm(const GatherP& p, int g0, int nrows, char* As, float* __restrict__ PART) {
  const int tid = otid(), wave = tid >> 6, lane = tid & 63;
  const int nfull = nrows >> 3, extra = nrows & 7;
  const int nun = nfull + (extra ? 1 : 0);
#pragma unroll 1
  for (int un = 0; un < nun; ++un) {
    int rr, kbeg, kcnt; bool partial;
    if (un < nfull) { rr = wave + 8 * un; kbeg = 0; kcnt = 128; partial = false; }
    else { const int wpt = 8 / extra; rr = nfull * 8 + wave / wpt; kcnt = 128 / wpt; kbeg = (wave % wpt) * kcnt; partial = true; }
    const int row = g0 + rr;
    float tf[16];
    {
      const bf16_t* tp = p.Tbf + (size_t)row * D + lane * 4;
      const uint2 t0 = *(const uint2*)tp, t1 = *(const uint2*)(tp + 256), t2 = *(const uint2*)(tp + 512), t3 = *(const uint2*)(tp + 768);
      tf[0] = bflo(t0.x); tf[1] = bfhi(t0.x); tf[2] = bflo(t0.y); tf[3] = bfhi(t0.y); tf[4] = bflo(t1.x); tf[5] = bfhi(t1.x); tf[6] = bflo(t1.y); tf[7] = bfhi(t1.y);
      tf[8] = bflo(t2.x); tf[9] = bfhi(t2.x); tf[10] = bflo(t2.y); tf[11] = bfhi(t2.y); tf[12] = bflo(t3.x); tf[13] = bfhi(t3.x); tf[14] = bflo(t3.y); tf[15] = bfhi(t3.y);
    }
    float tsum = 0.f;
#pragma unroll
    for (int j = 0; j < 16; ++j) tsum += tf[j];
    tsum = wave_sum_dpp(tsum) * 128.f;
    const int id_lo = p.IDX[(size_t)row * 128 + lane], id_hi = p.IDX[(size_t)row * 128 + 64 + lane];
    const float ga_lo = p.GATE[(size_t)row * 128 + lane], ga_hi = p.GATE[(size_t)row * 128 + 64 + lane];
    float f[16], asum = 0.f;
#pragma unroll
    for (int j = 0; j < 16; ++j) f[j] = 0.f;
    uint4 ub[8], vb[8]; float sub[8], svb[8];
#define TLOAD(slot, kk) do { const int e_ = __builtin_amdgcn_readlane((kk) < 64 ? id_lo : id_hi, (kk) & 63); \
      ub[slot] = *(const uint4*)(p.utab + (size_t)e_ * D + lane * 16); vb[slot] = *(const uint4*)(p.vtab + (size_t)e_ * D + lane * 16); \
      sub[slot] = p.su[e_]; svb[slot] = p.sv[e_]; } while (0)
    auto proc4 = [&](int s0, int k0) {
      float dot[4];
#pragma unroll
      for (int u = 0; u < 4; ++u) {
        const uint4 a_ = ub[s0 + u];
        float d = tf[0] * UB0(a_.x); d = fmaf(tf[1], UB1(a_.x), d); d = fmaf(tf[2], UB2(a_.x), d); d = fmaf(tf[3], UB3(a_.x), d);
        d = fmaf(tf[4], UB0(a_.y), d); d = fmaf(tf[5], UB1(a_.y), d); d = fmaf(tf[6], UB2(a_.y), d); d = fmaf(tf[7], UB3(a_.y), d);
        d = fmaf(tf[8], UB0(a_.z), d); d = fmaf(tf[9], UB1(a_.z), d); d = fmaf(tf[10], UB2(a_.z), d); d = fmaf(tf[11], UB3(a_.z), d);
        d = fmaf(tf[12], UB0(a_.w), d); d = fmaf(tf[13], UB1(a_.w), d); d = fmaf(tf[14], UB2(a_.w), d); d = fmaf(tf[15], UB3(a_.w), d);
        dot[u] = d;
      }
#define DPPSTEP(ctl, rm) do { _Pragma("unroll") for (int u = 0; u < 4; ++u) dot[u] += __uint_as_float(__builtin_amdgcn_update_dpp(0u, __float_as_uint(dot[u]), ctl, rm, 0xF, true)); } while (0)
      DPPSTEP(0xB1, 0xF); DPPSTEP(0x4E, 0xF); DPPSTEP(0x141, 0xF); DPPSTEP(0x140, 0xF); DPPSTEP(0x142, 0xA); DPPSTEP(0x143, 0xC);
#undef DPPSTEP
      float act[4];
#pragma unroll
      for (int u = 0; u < 4; ++u) {
        const int kk = k0 + u;
        const float tot = __uint_as_float((unsigned)__builtin_amdgcn_readlane((int)__float_as_uint(dot[u]), 63));
        const float g_ = __uint_as_float((unsigned)__builtin_amdgcn_readlane((int)__float_as_uint(kk < 64 ? ga_lo : ga_hi), kk & 63));
        act[u] = gelu_fast(sub[s0 + u] * (tot - tsum)) * g_ * svb[s0 + u];
      }
#pragma unroll
      for (int u = 0; u < 4; ++u) {
        const float act_ = act[u];
        asum += act_;
        const uint4 c_ = vb[s0 + u];
        f[0] = fmaf(act_, UB0(c_.x), f[0]); f[1] = fmaf(act_, UB1(c_.x), f[1]); f[2] = fmaf(act_, UB2(c_.x), f[2]); f[3] = fmaf(act_, UB3(c_.x), f[3]);
        f[4] = fmaf(act_, UB0(c_.y), f[4]); f[5] = fmaf(act_, UB1(c_.y), f[5]); f[6] = fmaf(act_, UB2(c_.y), f[6]); f[7] = fmaf(act_, UB3(c_.y), f[7]);
        f[8] = fmaf(act_, UB0(c_.z), f[8]); f[9] = fmaf(act_, UB1(c_.z), f[9]); f[10] = fmaf(act_, UB2(c_.z), f[10]); f[11] = fmaf(act_, UB3(c_.z), f[11]);
        f[12] = fmaf(act_, UB0(c_.w), f[12]); f[13] = fmaf(act_, UB1(c_.w), f[13]); f[14] = fmaf(act_, UB2(c_.w), f[14]); f[15] = fmaf(act_, UB3(c_.w), f[15]);
      }
    };
    TLOAD(0, kbeg); TLOAD(1, kbeg + 1); TLOAD(2, kbeg + 2); TLOAD(3, kbeg + 3); TLOAD(4, kbeg + 4); TLOAD(5, kbeg + 5); TLOAD(6, kbeg + 6); TLOAD(7, kbeg + 7);
    const int kend = kbeg + kcnt - 8;
#pragma unroll 1
    for (int k = kbeg; k < kend; k += 8) {
      proc4(0, k); TLOAD(0, k + 8); TLOAD(1, k + 9); TLOAD(2, k + 10); TLOAD(3, k + 11);
      proc4(4, k + 4); TLOAD(4, k + 12); TLOAD(5, k + 13); TLOAD(6, k + 14); TLOAD(7, k + 15);
    }
    proc4(0, kend); proc4(4, kend + 4);
#undef TLOAD
    if (!partial) ln_token<FINAL>(p, row, rr, lane, f, asum, As);
    else {
      float* pp = PART + wave * PARTW + lane * 16;
      *(float4*)pp = make_float4(f[0], f[1], f[2], f[3]); *(float4*)(pp + 4) = make_float4(f[4], f[5], f[6], f[7]);
      *(float4*)(pp + 8) = make_float4(f[8], f[9], f[10], f[11]); *(float4*)(pp + 12) = make_float4(f[12], f[13], f[14], f[15]);
      if (lane == 0) PART[wave * PARTW + 1024] = asum;
    }
  }
  if (extra) {
    __syncthreads();
    if (wave < extra) {
      const int wpt = 8 / extra, rr = nfull * 8 + wave;
      float f[16], asum = 0.f;
#pragma unroll
      for (int j = 0; j < 16; ++j) f[j] = 0.f;
      for (int w2 = wave * wpt; w2 < wave * wpt + wpt; ++w2) {
        const float* pp = PART + w2 * PARTW + lane * 16;
#pragma unroll
        for (int q4 = 0; q4 < 4; ++q4) { const float4 x4 = *(const float4*)(pp + q4 * 4); f[q4 * 4] += x4.x; f[q4 * 4 + 1] += x4.y; f[q4 * 4 + 2] += x4.z; f[q4 * 4 + 3] += x4.w; }
        asum += PART[w2 * PARTW + 1024];
      }
      ln_token<FINAL>(p, g0 + rr, rr, lane, f, asum, As);
    }
  }
}

__device__ __forceinline__ void cvt_plain(const float* __restrict__ a, bf16_t* __restrict__ o, size_t n8, bool lo, size_t gtid, size_t gsz) {
  for (size_t i = gtid; i < n8; i += gsz) {
    float v[8];
    *(float4*)&v[0] = ((const float4*)a)[i * 2]; *(float4*)&v[4] = ((const float4*)a)[i * 2 + 1];
    if (lo) {
#pragma unroll
      for (int j = 0; j < 8; ++j) v[j] = v[j] - bf2f(f2bf(v[j]));
    }
    uint4 w; w.x = pack2bf(v[0], v[1]); w.y = pack2bf(v[2], v[3]); w.z = pack2bf(v[4], v[5]); w.w = pack2bf(v[6], v[7]);
    ((uint4*)o)[i] = w;
  }
}
__device__ __forceinline__ void cvt_t(const float* __restrict__ W, bf16_t* __restrict__ Wt, int K, int N, bool lo, size_t gtid, size_t gsz) {
  const size_t total = (size_t)N * (K / 8);
#pragma unroll 4
  for (size_t i = gtid; i < total; i += gsz) {
    const int n = (int)(i % N), k8 = (int)(i / N);
    float v[8];
#pragma unroll
    for (int j = 0; j < 8; ++j) { const float w = W[(size_t)(k8 * 8 + j) * N + n]; v[j] = lo ? w - bf2f(f2bf(w)) : w; }
    uint4 w; w.x = pack2bf(v[0], v[1]); w.y = pack2bf(v[2], v[3]); w.z = pack2bf(v[4], v[5]); w.w = pack2bf(v[6], v[7]);
    *(uint4*)(Wt + ((size_t)((n >> 4) * (K >> 5) + (k8 >> 2)) * 64 + (k8 & 3) * 16 + (n & 15)) * 8) = w;
  }
}
__device__ __forceinline__ void mod_item(const float* __restrict__ c, const float* __restrict__ c_ctx, const float* __restrict__ ada_w, const float* __restrict__ ada_b,
                                         float* __restrict__ MOD, int item, bool valid, char* lds, int tid, int nct, volatile int* cbc, int& cgen) {
  float* sc = (float*)lds;
  float* part = sc + 3072;
  const int wave = tid >> 6, lane = tid & 63, l = item / 96, cg = item % 96, nw = nct >> 6;
  if (valid) for (int i = tid; i < 3072; i += nct) { const int v = i >> 10, k = i & 1023; const float xv = v < 2 ? c[v * 1024 + k] : c_ctx[k]; sc[i] = xv / (1.f + expf(-xv)); }
  cbar(cbc, cgen, nw);
  if (valid) {
    float a0 = 0.f, a1 = 0.f, a2 = 0.f;
    const float* W = ada_w + (size_t)l * 1024 * 6144 + cg * 64 + lane;
    const int kb = wave * 171, ke = kb + 171 < 1024 ? kb + 171 : 1024;
#pragma unroll 19
    for (int k = kb; k < ke; ++k) { const float w = W[(size_t)k * 6144]; a0 += sc[k] * w; a1 += sc[1024 + k] * w; a2 += sc[2048 + k] * w; }
    part[(wave * 3 + 0) * 64 + lane] = a0; part[(wave * 3 + 1) * 64 + lane] = a1; part[(wave * 3 + 2) * 64 + lane] = a2;
  }
  cbar(cbc, cgen, nw);
  if (valid && tid < 192) {
    const int v = tid >> 6, ln = tid & 63; float sum = 0.f;
    for (int w = 0; w < nw; ++w) sum += part[(w * 3 + v) * 64 + ln];
    MOD[(l * 3 + v) * 6144 + cg * 64 + ln] = sum + ada_b[l * 6144 + cg * 64 + ln];
  }
}

__device__ __forceinline__ void gbar(unsigned* cnt, unsigned target) {
  asm volatile("s_waitcnt vmcnt(0)" ::: "memory");
  __syncthreads();
  if (otid() == 0) {
    __builtin_amdgcn_fence(__ATOMIC_RELEASE, "agent");
    asm volatile("s_waitcnt vmcnt(0)" ::: "memory");
    __hip_atomic_fetch_add(cnt, 1u, __ATOMIC_RELAXED, __HIP_MEMORY_SCOPE_AGENT);
    unsigned spins = 0;
    while (__hip_atomic_load(cnt, __ATOMIC_RELAXED, __HIP_MEMORY_SCOPE_AGENT) < target) { __builtin_amdgcn_s_sleep(2); if (++spins > (1u << 24)) break; }
    __builtin_amdgcn_fence(__ATOMIC_ACQUIRE, "agent");
    asm volatile("s_waitcnt vmcnt(0)" ::: "memory");
  }
  __syncthreads();
}

struct MP {
  const float *x, *c, *ctx, *c_ctx, *ada_w, *ada_b, *ln_g, *ln_b, *s5_a_re, *s5_a_im, *s5_log_dt, *s5_b_re, *s5_b_im, *s5_c_re, *s5_c_im, *s5_d, *s5_w_glu, *s5_w_o;
  const float *mla_w_dq, *mla_q_norm, *mla_w_uq, *mla_w_dkv, *mla_kv_norm, *mla_w_ukv, *mla_w_o, *peer_w_q, *peer_keys, *peer_u, *peer_v;
  float* out;
  float* MOD; bf16_t *Wt_glu, *Wt_o0, *Wt_q0, *Wt_o1, *Wt_q1, *Wt_cat, *Wt_uq, *Wt_ukv, *Khi, *Khi1;
  unsigned char *U0, *V0, *U1, *V1; float *SU0, *SV0, *SU1, *SV1; bf16_t *Ktab, *Bst_t, *Cin_t;
  bf16_t* Ypart; float* Ssta; bf16_t *HP, *Gbf, *Vbf, *Tbf; float *OQ, *H1, *H2; int* IDX; float* GATE;
  bf16_t *Qa, *AObf; unsigned char *Kn, *Kr, *Va; float* H3; bf16_t* Tbf1; unsigned* BAR; float* PART;
};
constexpr int LDS_BYTES = 66 * 784 + 66 * 528 + 1024 * 68 + 64;
__global__ __launch_bounds__(512) void mega(MP p) {
  __shared__ __attribute__((aligned(16))) char lds[LDS_BYTES];
  cg::grid_group grid = cg::this_grid();
  const int nblk = gridDim.x;
  int bid = blockIdx.x;
  const size_t TD = (size_t)1024 * 16384;
  const float* mod0 = p.MOD; const float* mod1 = p.MOD + 3 * 6144;
  {
    volatile int* cbc = (volatile int*)(lds + LDS_BYTES - 16);
    if (otid() == 0) *cbc = 0;
    __syncthreads();
    const int t0 = otid();
    if (t0 < 128) {
      const size_t mt = (size_t)bid * 128 + t0, ms = (size_t)nblk * 128;
      const int mw = bid * 2 + (t0 >> 6), nmw = nblk * 2;
      cvt_t(p.s5_w_glu, p.Wt_glu, D, D, false, mt, ms);
      cvt_t(p.s5_w_o, p.Wt_o0, D, D, false, mt, ms);
      cvt_t(p.peer_w_q, p.Wt_q0, D, D, false, mt, ms);
      cvt_t(p.mla_w_o, p.Wt_o1, D, D, false, mt, ms);
      cvt_t(p.peer_w_q + (size_t)D * D, p.Wt_q1, D, D, false, mt, ms);
      cvt_t(p.mla_w_dq, p.Wt_cat, D, 384, false, mt, ms);
      cvt_t(p.mla_w_dkv, p.Wt_cat + (size_t)384 * D, D, 320, false, mt, ms);
      cvt_t(p.mla_w_uq, p.Wt_uq, 384, 1536, false, mt, ms);
      cvt_t(p.mla_w_ukv, p.Wt_ukv, 256, 2048, false, mt, ms);
      cvt_plain(p.peer_keys, p.Khi, (size_t)2 * 131072 / 8, false, mt, ms);
      cvt_rows_i8(p.peer_u, p.U0, p.SU0, 16384, mw, nmw);
      cvt_rows_i8(p.peer_v, p.V0, p.SV0, 16384, mw, nmw);
      cvt_rows_i8(p.peer_u + TD, p.U1, p.SU1, 16384, mw, nmw);
      cvt_rows_i8(p.peer_v + TD, p.V1, p.SV1, 16384, mw, nmw);
    } else {
      int cgen = 0;
      const int ct = t0 - 128;
      ph_s5_prep(p.s5_a_re, p.s5_a_im, p.s5_log_dt, p.s5_b_re, p.s5_b_im, p.s5_c_re, p.s5_c_im, p.Ktab, p.Bst_t, p.Cin_t, bid >> 2, bid & 3, lds, ct, 384, cbc, cgen);
      cbar(cbc, cgen, 6);
      mod_item(p.c, p.c_ctx, p.ada_w, p.ada_b, p.MOD, bid, bid < 192, lds, ct, 384, cbc, cgen);
    }
  }
  grid.sync();
  asm volatile("" : "+s"(bid));
  ph_s5_p1(p.x, p.ctx, mod0, p.Ktab, p.Bst_t, p.Ypart, p.Ssta, bid, lds);
  gbar(p.BAR, 1u * (unsigned)nblk);
  asm volatile("" : "+s"(bid));
  if (otid() < 64) ph_s5_carry(p.Ssta, p.s5_a_re, p.s5_a_im, p.s5_log_dt, p.HP, bid, otid());
  gbar(p.BAR, 2u * (unsigned)nblk);
  asm volatile("" : "+s"(bid));
  ph_s5_p3(p.x, p.ctx, mod0, p.s5_d, p.HP, p.Cin_t, p.Ypart, p.Gbf, bid, lds);
  gbar(p.BAR, 3u * (unsigned)nblk);
  asm volatile("" : "+s"(bid));
  {
    ChainP cp{p.Gbf, p.Wt_glu, p.Wt_o0, p.Wt_q0, p.Vbf, (bf16_t*)p.OQ + (size_t)bid * 66 * D, p.x, p.ctx, mod0, p.ln_g, p.ln_b, p.H1, p.Tbf, (bf16_t*)p.OQ + (size_t)bid * 66 * D  };
    ph_chainA<true>(cp, bid, lds);
    __syncthreads();
    ph_route(RouteP{(bf16_t*)p.OQ + (size_t)bid * 66 * D, p.Khi, p.IDX, p.GATE, 66, 0}, bid, lds);
    __syncthreads();
    GatherP gp{p.Tbf, p.IDX, p.GATE, p.U0, p.V0, p.SU0, p.SV0, p.H1, mod0, p.ln_g + D, p.ln_b + D, p.H2, mod1};
    ph_gather_tm<false>(gp, bid * 66, 66, lds, p.PART + (size_t)bid * 8 * PARTW);
    __syncthreads();
    ProjP pp{p.Wt_cat, p.Wt_uq, p.Wt_ukv, p.mla_q_norm, p.mla_kv_norm, p.OQ  , p.Qa, p.Kn, p.Kr, p.Va};
    ph_mla_proj(pp, bid, lds);
  }
  gbar(p.BAR, 4u * (unsigned)nblk);
  asm volatile("" : "+s"(bid));
  ph_attn(p.Qa, p.Kn, p.Kr, p.Va, p.AObf, bid, nblk, lds);
  gbar(p.BAR, 5u * (unsigned)nblk);
  asm volatile("" : "+s"(bid));
  {
    ChainP cp{p.AObf, nullptr, p.Wt_o1, p.Wt_q1, nullptr, (bf16_t*)p.OQ + (size_t)bid * 64 * D, p.H2, p.H2 + (size_t)NL * D, mod1, p.ln_g + 2 * D, p.ln_b + 2 * D, p.H3, p.Tbf1, (bf16_t*)p.OQ + (size_t)bid * 64 * D};
    ph_chainA<false>(cp, bid, lds);
    __syncthreads();
    ph_route(RouteP{(bf16_t*)p.OQ + (size_t)bid * 64 * D, p.Khi1, p.IDX, p.GATE, 64, 0}, bid, lds);
    __syncthreads();
    GatherP gp{p.Tbf1, p.IDX, p.GATE, p.U1, p.V1, p.SU1, p.SV1, p.H3, mod1, p.ln_g + 3 * D, p.ln_b + 3 * D, p.out, mod1};
    ph_gather_tm<true>(gp, bid * 64, 64, lds, p.PART + (size_t)bid * 8 * PARTW);
  }
}

extern "C" void kernel_launch(void* const* d_in, const int* in_sizes, int n_in, void* d_out, int out_size, void* d_ws, size_t ws_size, hipStream_t stream) {
  MP p{};
  const float** in = (const float**)&p;
  for (int i = 0; i < 29; ++i) in[i] = (const float*)d_in[i];
  p.out = (float*)d_out;
  char* ws = (char*)d_ws; size_t off = 0;
  auto carve = [&](size_t bytes) { char* q = ws + off; off += (bytes + 255) / 256 * 256; return q; };
  const size_t TDB = (size_t)1024 * 16384 * 2, BIG = (size_t)NT * D * 4, HALF = (size_t)NT * D * 2;
  p.MOD = (float*)carve(2 * 3 * 6144 * 4);
  p.Wt_glu = (bf16_t*)carve((size_t)D * D * 2); p.Wt_o0 = (bf16_t*)carve((size_t)D * D * 2); p.Wt_q0 = (bf16_t*)carve((size_t)D * D * 2);
  p.Wt_o1 = (bf16_t*)carve((size_t)D * D * 2); p.Wt_q1 = (bf16_t*)carve((size_t)D * D * 2);
  p.Wt_cat = (bf16_t*)carve((size_t)704 * D * 2); p.Wt_uq = (bf16_t*)carve((size_t)1536 * 384 * 2); p.Wt_ukv = (bf16_t*)carve((size_t)2048 * 256 * 2);
  p.Khi = (bf16_t*)carve((size_t)2 * 131072 * 2); p.Khi1 = p.Khi + 131072;
  char* T0 = carve(TDB); p.U0 = (unsigned char*)T0; p.V0 = (unsigned char*)(T0 + TDB / 2); p.AObf = (bf16_t*)T0;
  p.SU0 = (float*)carve(16384 * 4); p.SV0 = (float*)carve(16384 * 4); p.SU1 = (float*)carve(16384 * 4); p.SV1 = (float*)carve(16384 * 4);
  const size_t KTAB_B = (size_t)64 * 127 * 256 * 2, BST_B = (size_t)64 * 256 * 1024 * 2, KN_B = (size_t)NB * 8 * KEYS * 128 * 2, KR_B = (size_t)NB * KEYS * 64 * 2;
  size_t x1 = KTAB_B + 2 * BST_B; if (x1 < 2 * KN_B + KR_B) x1 = 2 * KN_B + KR_B;
  char* X1 = carve(x1);
  p.Ktab = (bf16_t*)X1; p.Bst_t = (bf16_t*)(X1 + KTAB_B); p.Cin_t = (bf16_t*)(X1 + KTAB_B + BST_B);
  p.Kn = (unsigned char*)X1; p.Va = (unsigned char*)(X1 + KN_B); p.Kr = (unsigned char*)(X1 + 2 * KN_B); p.H3 = (float*)X1;
  char* X2 = carve(BIG); p.Ypart = (bf16_t*)X2; p.OQ = (float*)X2;
  char* X3 = carve(HALF); p.Ssta = (float*)X3; p.HP = (bf16_t*)(X3 + (size_t)NCC * 64 * 256 * 4); p.Vbf = (bf16_t*)X3;
  char* X4 = carve(HALF); p.Gbf = (bf16_t*)X4; p.Tbf = (bf16_t*)X4; p.Tbf1 = (bf16_t*)X4;
  char* X5 = carve(BIG); p.H1 = (float*)X5;
  char* T1 = carve(TDB); p.U1 = (unsigned char*)T1; p.V1 = (unsigned char*)(T1 + TDB / 2);
  p.H2 = (float*)carve(BIG);
  p.IDX = (int*)carve((size_t)NT * 128 * 4); p.GATE = (float*)carve((size_t)NT * 128 * 4);
  p.Qa = (bf16_t*)carve((size_t)NB * 8 * SEQ * 192 * 2);
  p.BAR = (unsigned*)carve(256);
  p.PART = (float*)carve((size_t)256 * 8 * PARTW * 4);
  if (off > ws_size || n_in != 29) { fprintf(stderr, "kernel_launch: workspace too small (need %zu, have %zu) or n_in %d != 29\n", off, ws_size, n_in); return; }
  static int grid_blocks = 0;
  if (!grid_blocks) {
    int dev = 0, cus = 0, per_cu = 0;
    hipGetDevice(&dev);
    hipDeviceGetAttribute(&cus, hipDeviceAttributeMultiprocessorCount, dev);
    hipOccupancyMaxActiveBlocksPerMultiprocessor(&per_cu, mega, 512, 0);
    if (per_cu < 1 || cus < 256) { fprintf(stderr, "kernel_launch: need 256 resident workgroups (cus %d, per_cu %d)\n", cus, per_cu); return; }
    grid_blocks = 256;
  }
  hipMemsetAsync(p.BAR, 0, 256, stream);
  void* args[] = {&p};
  hipError_t e = hipLaunchCooperativeKernel((void*)mega, dim3(grid_blocks), dim3(512), args, 0, stream);
  if (e != hipSuccess) fprintf(stderr, "cooperative launch failed: %s\n", hipGetErrorString(e));
}
```

```cpp
#include <hip/hip_runtime.h>
#include <math.h>
#include <hip/hip_cooperative_groups.h>
#include <cstdio>
namespace cg = cooperative_groups;
__device__ __forceinline__ int otid() { int t = (int)__builtin_amdgcn_workitem_id_x(); asm volatile("" : "+v"(t)); return t; }

constexpr int D = 1024, NB = 2, SEQ = 8192, CTX = 256;
constexpr int NL = NB * SEQ, NC = NB * CTX, NT = NL + NC;
constexpr float ALPHA = 1.4142135623730951f;
constexpr float LN_EPS = 1e-5f, RMS_EPS = 1e-6f;

__device__ __forceinline__ float wave_sum_dpp(float v) {
  v += __uint_as_float(__builtin_amdgcn_update_dpp(0u, __float_as_uint(v), 0xB1, 0xF, 0xF, true));
  v += __uint_as_float(__builtin_amdgcn_update_dpp(0u, __float_as_uint(v), 0x4E, 0xF, 0xF, true));
  v += __uint_as_float(__builtin_amdgcn_update_dpp(0u, __float_as_uint(v), 0x141, 0xF, 0xF, true));
  v += __uint_as_float(__builtin_amdgcn_update_dpp(0u, __float_as_uint(v), 0x140, 0xF, 0xF, true));
  v += __uint_as_float(__builtin_amdgcn_update_dpp(0u, __float_as_uint(v), 0x142, 0xA, 0xF, true));
  v += __uint_as_float(__builtin_amdgcn_update_dpp(0u, __float_as_uint(v), 0x143, 0xC, 0xF, true));
  return __uint_as_float((unsigned)__builtin_amdgcn_readlane((int)__float_as_uint(v), 63));
}
__device__ __forceinline__ float wave_sum(float v) { return wave_sum_dpp(v); }
__device__ __forceinline__ float wave_max_dpp(float v) {
  v = fmaxf(v, __uint_as_float(__builtin_amdgcn_update_dpp(0u, __float_as_uint(v), 0xB1, 0xF, 0xF, true)));
  v = fmaxf(v, __uint_as_float(__builtin_amdgcn_update_dpp(0u, __float_as_uint(v), 0x4E, 0xF, 0xF, true)));
  v = fmaxf(v, __uint_as_float(__builtin_amdgcn_update_dpp(0u, __float_as_uint(v), 0x141, 0xF, 0xF, true)));
  v = fmaxf(v, __uint_as_float(__builtin_amdgcn_update_dpp(0u, __float_as_uint(v), 0x140, 0xF, 0xF, true)));
  v = fmaxf(v, __uint_as_float(__builtin_amdgcn_update_dpp(0u, __float_as_uint(v), 0x142, 0xA, 0xF, true)));
  v = fmaxf(v, __uint_as_float(__builtin_amdgcn_update_dpp(0u, __float_as_uint(v), 0x143, 0xC, 0xF, true)));
  return __uint_as_float((unsigned)__builtin_amdgcn_readlane((int)__float_as_uint(v), 63));
}
__device__ __forceinline__ int row_vec(int row) { return row < NL ? (row >> 13) : 2; }
__device__ __forceinline__ float gelu_exact(float x) { return 0.5f * x * (1.f + erff(x * 0.70710678118654752f)); }
__device__ __forceinline__ float gelu_fast(float x) {
  const float z = fabsf(x) * 0.70710678118654752f;
  const float t = __builtin_amdgcn_rcpf(fmaf(0.3275911f, z, 1.f));
  float pl = fmaf(1.061405429f, t, -1.453152027f); pl = fmaf(pl, t, 1.421413741f); pl = fmaf(pl, t, -0.284496736f); pl = fmaf(pl, t, 0.254829592f);
  const float e = __builtin_amdgcn_exp2f(-z * z * 1.4426950408889634f);
  const float erfa = 1.f - pl * t * e;
  const float hx = 0.5f * x;
  return hx + fabsf(hx) * erfa;
}


typedef unsigned short bf16_t;
using bf16x8 = __attribute__((ext_vector_type(8))) short;
using f32x4 = __attribute__((ext_vector_type(4))) float;
__device__ __forceinline__ bf16_t f2bf(float f) { unsigned u = __float_as_uint(f); u += 0x7FFFu + ((u >> 16) & 1u); return (bf16_t)(u >> 16); }
__device__ __forceinline__ unsigned char f2fp8(float v) { return (unsigned char)(__builtin_amdgcn_cvt_pk_fp8_f32(v, v, 0, false) & 0xFF); }
__device__ __forceinline__ float bf2f(bf16_t h) { return __uint_as_float(((unsigned)h) << 16); }
__device__ __forceinline__ unsigned pack2bf(float lo, float hi) { return (unsigned)f2bf(lo) | ((unsigned)f2bf(hi) << 16); }
__device__ __forceinline__ float bflo(unsigned w) { return __uint_as_float(w << 16); }
__device__ __forceinline__ float bfhi(unsigned w) { return __uint_as_float(w & 0xFFFF0000u); }


constexpr int LDA_B = 1024 * 2 + 16;
template <int RT, int K>
__device__ __forceinline__ void gemm_unit(const char* const (&ap)[RT], const bf16_t* __restrict__ w0, const bf16_t* __restrict__ w1, int kmul, f32x4 (&acc)[RT][2]) {
  constexpr int KI = K / 128, NS = 2;
#pragma unroll
  for (int t = 0; t < RT; ++t) { acc[t][0] = f32x4{0.f, 0.f, 0.f, 0.f}; acc[t][1] = f32x4{0.f, 0.f, 0.f, 0.f}; }
  bf16x8 b[NS][4][2];
#pragma unroll
  for (int st = 0; st < NS - 1; ++st) {
    if (st < KI) {
#pragma unroll
      for (int s2 = 0; s2 < 4; ++s2) { b[st][s2][0] = *(const bf16x8*)(w0 + (st * 128 + s2 * 32) * kmul); b[st][s2][1] = *(const bf16x8*)(w1 + (st * 128 + s2 * 32) * kmul); }
    }
  }
  asm volatile("" ::: "memory");
  bf16x8 an[RT];
#pragma unroll
  for (int t = 0; t < RT; ++t) an[t] = *(const bf16x8*)(ap[t]);
#pragma unroll
  for (int it = 0; it < KI; ++it) {
    if (it + NS - 1 < KI) {
#pragma unroll
      for (int s2 = 0; s2 < 4; ++s2) {
        b[(it + NS - 1) % NS][s2][0] = *(const bf16x8*)(w0 + ((it + NS - 1) * 128 + s2 * 32) * kmul);
        b[(it + NS - 1) % NS][s2][1] = *(const bf16x8*)(w1 + ((it + NS - 1) * 128 + s2 * 32) * kmul);
      }
    }
    asm volatile("" ::: "memory");
#pragma unroll
    for (int s2 = 0; s2 < 4; ++s2) {
      bf16x8 ac[RT];
#pragma unroll
      for (int t = 0; t < RT; ++t) ac[t] = an[t];
      if (it * 4 + s2 + 1 < KI * 4) {
#pragma unroll
        for (int t = 0; t < RT; ++t) an[t] = *(const bf16x8*)(ap[t] + (it * 128 + s2 * 32 + 32) * 2);
      }
#pragma unroll
      for (int t = 0; t < RT; ++t) {
        acc[t][0] = __builtin_amdgcn_mfma_f32_16x16x32_bf16(ac[t], b[it % NS][s2][0], acc[t][0], 0, 0, 0);
        acc[t][1] = __builtin_amdgcn_mfma_f32_16x16x32_bf16(ac[t], b[it % NS][s2][1], acc[t][1], 0, 0, 0);
      }
    }
  }
}
template <int RT, int K, class Epi>
__device__ __forceinline__ void gemm_ldsA(const char* As, int lda_b, int nrows, const bf16_t* __restrict__ Wt, int N, Epi epi) {
  const int wave = otid() >> 6, lane = otid() & 63, l15 = lane & 15, q = lane >> 4;
  const char* ap[RT];
#pragma unroll
  for (int t = 0; t < RT; ++t) { int r = t * 16 + l15; r = r < nrows ? r : nrows - 1; ap[t] = As + r * lda_b + q * 16; }
#pragma unroll 1
  for (int unit = wave; unit < (N >> 5); unit += 8) {
    const int n0 = unit * 32;
    const bf16_t* w0 = Wt + (size_t)(n0 >> 4) * K * 16 + lane * 8;
    f32x4 acc[RT][2];
    gemm_unit<RT, K>(ap, w0, w0 + (size_t)K * 16, 16, acc);
#pragma unroll
    for (int t = 0; t < RT; ++t)
#pragma unroll
      for (int j = 0; j < 2; ++j)
#pragma unroll
        for (int r = 0; r < 4; ++r) {
          const int row = t * 16 + q * 4 + r, col = n0 + j * 16 + l15;
          if (row < nrows) epi(row, col, acc[t][j][r]);
        }
  }
}
struct EpiBF16 { bf16_t* C; int ldc; __device__ __forceinline__ void operator()(int row, int col, float v) const { C[(size_t)row * ldc + col] = f2bf(v); } };
struct EpiF32 { float* C; int ldc; __device__ __forceinline__ void operator()(int row, int col, float v) const { C[(size_t)row * ldc + col] = v; } };
struct EpiGluL { const char* As; bf16_t* V; __device__ __forceinline__ void operator()(int row, int col, float z) const {
  const float g = bf2f(*(const bf16_t*)(As + row * LDA_B + col * 2)); V[(size_t)row * D + col] = f2bf(g / (1.f + expf(-z))); } };

__device__ __forceinline__ void load_rows_lds(char* As, const bf16_t* __restrict__ src, int nrows) {
  const int t = otid(), total = nrows * 128;
#pragma unroll
  for (int h = 0; h < 2; ++h) {
    uint4 v[9];
#pragma unroll
    for (int k = 0; k < 9; ++k) { int i = t + (h * 9 + k) * 512; i = i < total ? i : total - 1; v[k] = *(const uint4*)(src + (size_t)(i >> 7) * D + (i & 127) * 8); }
#pragma unroll
    for (int k = 0; k < 9; ++k) { const int i = t + (h * 9 + k) * 512; if (i < total) *(uint4*)(As + (i >> 7) * LDA_B + (i & 127) * 16) = v[k]; }
  }
}
__device__ __forceinline__ void ln_rows(char* As, int g0, int nrows, const float* Hl, const float* Hc, const bf16_t* __restrict__ O,
                                        const float* __restrict__ mod, int gate_i, const float* __restrict__ lng, const float* __restrict__ lnb,
                                        float* Hout, bf16_t* __restrict__ Tbf, int shift_i, int scale_i) {
  const int wave = otid() >> 6, lane = otid() & 63;
  for (int rr = wave; rr < nrows; rr += 8) {
    const int row = g0 + rr;
    const float* hin = row < NL ? Hl + (size_t)row * D : Hc + (size_t)(row - NL) * D;
    const bf16_t* f = O + (size_t)row * D;
    const float* m = mod + row_vec(row) * 6144;
    const float* gm = m + gate_i * 1024;
    float r[16]; float s = 0.f;
#pragma unroll
    for (int i = 0; i < 4; ++i) {
      const int d = i * 256 + lane * 4;
      const uint2 fw = *(const uint2*)(f + d);
      float4 h4 = *(const float4*)(hin + d), f4 = make_float4(bflo(fw.x), bfhi(fw.x), bflo(fw.y), bfhi(fw.y)), g4 = *(const float4*)(gm + d);
      r[i * 4 + 0] = ALPHA * h4.x + g4.x * f4.x; r[i * 4 + 1] = ALPHA * h4.y + g4.y * f4.y;
      r[i * 4 + 2] = ALPHA * h4.z + g4.z * f4.z; r[i * 4 + 3] = ALPHA * h4.w + g4.w * f4.w;
      s += r[i * 4 + 0] + r[i * 4 + 1] + r[i * 4 + 2] + r[i * 4 + 3];
    }
    const float mu = wave_sum(s) * (1.f / D);
    float vs = 0.f;
#pragma unroll
    for (int i = 0; i < 16; ++i) { float dlt = r[i] - mu; vs += dlt * dlt; }
    const float rstd = rsqrtf(wave_sum(vs) * (1.f / D) + LN_EPS);
#pragma unroll
    for (int i = 0; i < 4; ++i) {
      const int d = i * 256 + lane * 4;
      float4 g4 = *(const float4*)(lng + d), b4 = *(const float4*)(lnb + d);
      float4 o;
      o.x = (r[i * 4 + 0] - mu) * rstd * g4.x + b4.x; o.y = (r[i * 4 + 1] - mu) * rstd * g4.y + b4.y;
      o.z = (r[i * 4 + 2] - mu) * rstd * g4.z + b4.z; o.w = (r[i * 4 + 3] - mu) * rstd * g4.w + b4.w;
      *(float4*)(Hout + (size_t)row * D + d) = o;
      float4 sh = *(const float4*)(m + shift_i * 1024 + d), sc = *(const float4*)(m + scale_i * 1024 + d);
      const float t0 = o.x * (1.f + sc.x) + sh.x, t1 = o.y * (1.f + sc.y) + sh.y, t2 = o.z * (1.f + sc.z) + sh.z, t3 = o.w * (1.f + sc.w) + sh.w;
      uint2 w; w.x = pack2bf(t0, t1); w.y = pack2bf(t2, t3);
      *(uint2*)(As + rr * LDA_B + d * 2) = w;
      *(uint2*)(Tbf + (size_t)row * D + d) = w;

    }
  }
}


constexpr int S5T = 64, NCHUNK = (CTX + SEQ) / S5T  , NCC = NB * NCHUNK  ;
__device__ __forceinline__ int s5_token(int cc, int s) {
  const int b = cc / NCHUNK, ch = cc - b * NCHUNK;
  return ch < 4 ? NL + b * CTX + ch * S5T + s : b * SEQ + (ch - 4) * S5T + s;
}
__device__ __forceinline__ void cbar(volatile int* cnt, int& gen, int nwaves) {
  __builtin_amdgcn_fence(__ATOMIC_RELEASE, "workgroup");
  if ((otid() & 63) == 0) __hip_atomic_fetch_add((int*)cnt, 1, __ATOMIC_RELAXED, __HIP_MEMORY_SCOPE_WORKGROUP);
  ++gen;
  while (__hip_atomic_load((int*)cnt, __ATOMIC_RELAXED, __HIP_MEMORY_SCOPE_WORKGROUP) < gen * nwaves) __builtin_amdgcn_s_sleep(1);
  __builtin_amdgcn_fence(__ATOMIC_ACQUIRE, "workgroup");
}
__device__ __forceinline__ void ph_s5_prep(const float* __restrict__ a_re, const float* __restrict__ a_im, const float* __restrict__ log_dt,
                                                 const float* __restrict__ b_re, const float* __restrict__ b_im, const float* __restrict__ c_re, const float* __restrict__ c_im,
                                                 bf16_t* __restrict__ Ktab, bf16_t* __restrict__ Bst_t, bf16_t* __restrict__ Cin_t, int g, int part, char* lds, int tid, int nct, volatile int* cbc, int& cgen) {
  float2 (*pw)[65][64] = reinterpret_cast<float2 (*)[65][64]>(lds);
  float2 (*Bp)[64][16] = reinterpret_cast<float2 (*)[64][16]>(lds + 2 * 65 * 64 * 8);
  float2 (*Cc)[16][64] = reinterpret_cast<float2 (*)[16][64]>(lds + 2 * 65 * 64 * 8 + 2 * 64 * 16 * 8);
  float2 (*fs)[64] = reinterpret_cast<float2 (*)[64]>(lds + 2 * 65 * 64 * 8 + 2 * 64 * 16 * 8 + 2 * 16 * 64 * 8);
  if (tid < 128) {
    const int dir = tid >> 6, p = tid & 63, gp = (dir * 64 + g) * 64 + p;
    const float are = a_re[gp], aim = a_im[gp], dt = expf(log_dt[dir * 64 + g]);
    const float mag = expf(are * dt);
    const float abr = mag * cosf(aim * dt), abi = mag * sinf(aim * dt);
    const float nr = abr - 1.f, ni = abi, den = are * are + aim * aim;
    fs[dir][p] = make_float2((nr * are + ni * aim) / den, (ni * are - nr * aim) / den);
    float pr = 1.f, pi = 0.f;
    for (int e = 0; e <= 64; ++e) { pw[dir][e][p] = make_float2(pr, pi); const float nr2 = pr * abr - pi * abi, ni2 = pr * abi + pi * abr; pr = nr2; pi = ni2; }
  }
  cbar(cbc, cgen, nct >> 6);
  for (int i = tid; i < 2048; i += nct) {
    const int dir = i >> 10, p = (i >> 4) & 63, ci = i & 15;
    const size_t gi = ((size_t)(dir * 64 + g) * 64 + p) * 16 + ci;
    const float br = b_re[gi], bi = b_im[gi]; const float2 f = fs[dir][p];
    Bp[dir][p][ci] = make_float2(f.x * br - f.y * bi, f.x * bi + f.y * br);
    const int co = (i >> 6) & 15, p2 = i & 63;
    const size_t ci2 = ((size_t)(dir * 64 + g) * 16 + co) * 64 + p2;
    Cc[dir][co][p2] = make_float2(c_re[ci2], c_im[ci2]);
  }
  cbar(cbc, cgen, nct >> 6);
  for (int i = part * 508 + tid; i < (part + 1) * 508; i += nct) {
    const int ti = i >> 4, co = i & 15, tau = ti - 63;
    float acc[16];
#pragma unroll
    for (int ci = 0; ci < 16; ++ci) acc[ci] = 0.f;
    if (tau >= 0) {
      for (int p = 0; p < 64; ++p) {
        const float2 c = Cc[0][co][p], w = pw[0][tau][p];
        const float xr = c.x * w.x - c.y * w.y, xi = c.x * w.y + c.y * w.x;
#pragma unroll
        for (int ci = 0; ci < 16; ++ci) { const float2 bb = Bp[0][p][ci]; acc[ci] += xr * bb.x - xi * bb.y; }
      }
    }
    if (tau <= 0) {
      for (int p = 0; p < 64; ++p) {
        const float2 c = Cc[1][co][p], w = pw[1][-tau][p];
        const float xr = c.x * w.x - c.y * w.y, xi = c.x * w.y + c.y * w.x;
#pragma unroll
        for (int ci = 0; ci < 16; ++ci) { const float2 bb = Bp[1][p][ci]; acc[ci] += xr * bb.x - xi * bb.y; }
      }
    }
    uint4 o0, o1;
    o0.x = pack2bf(acc[0], acc[1]); o0.y = pack2bf(acc[2], acc[3]); o0.z = pack2bf(acc[4], acc[5]); o0.w = pack2bf(acc[6], acc[7]);
    o1.x = pack2bf(acc[8], acc[9]); o1.y = pack2bf(acc[10], acc[11]); o1.z = pack2bf(acc[12], acc[13]); o1.w = pack2bf(acc[14], acc[15]);
    bf16_t* kp = Ktab + (size_t)g * 127 * 256 + (size_t)i * 16;
    *(uint4*)kp = o0; *(uint4*)(kp + 8) = o1;
  }
  for (int i = part * 8192 + tid; i < (part + 1) * 8192; i += nct) {
    const int n = i >> 7, k8 = i & 127, dir = n >> 7, c = (n >> 6) & 1, p = n & 63, sidx = k8 >> 1, ci0 = (k8 & 1) * 8;
    const float2 w = pw[dir][dir == 0 ? 63 - sidx : sidx][p];
    float v[8];
#pragma unroll
    for (int j = 0; j < 8; ++j) { const float2 b = Bp[dir][p][ci0 + j]; v[j] = c == 0 ? (w.x * b.x - w.y * b.y) : (w.x * b.y + w.y * b.x); }
    uint4 o; o.x = pack2bf(v[0], v[1]); o.y = pack2bf(v[2], v[3]); o.z = pack2bf(v[4], v[5]); o.w = pack2bf(v[6], v[7]);
    *(uint4*)(Bst_t + (size_t)g * 256 * 1024 + ((size_t)((n >> 4) * 32 + (k8 >> 2)) * 64 + (k8 & 3) * 16 + (n & 15)) * 8) = o;
  }
  for (int i = part * 8192 + tid; i < (part + 1) * 8192; i += nct) {
    const int n = i >> 5, k8 = i & 31, t = n >> 4, co = n & 15, dir = k8 >> 4, c = (k8 >> 3) & 1, p0 = (k8 & 7) * 8;
    const int e = dir == 0 ? t + 1 : 64 - t;
    float v[8];
#pragma unroll
    for (int j = 0; j < 8; ++j) { const float2 cc = Cc[dir][co][p0 + j], w = pw[dir][e][p0 + j];
      v[j] = c == 0 ? (cc.x * w.x - cc.y * w.y) : -(cc.x * w.y + cc.y * w.x); }
    uint4 o; o.x = pack2bf(v[0], v[1]); o.y = pack2bf(v[2], v[3]); o.z = pack2bf(v[4], v[5]); o.w = pack2bf(v[6], v[7]);
    *(uint4*)(Cin_t + (size_t)g * 1024 * 256 + ((size_t)((n >> 4) * 8 + (k8 >> 2)) * 64 + (k8 & 3) * 16 + (n & 15)) * 8) = o;
  }
}
__device__ __forceinline__ void ph_s5_p1(const float* __restrict__ x, const float* __restrict__ ctx, const float* __restrict__ mod,
                                               const bf16_t* __restrict__ Ktab, const bf16_t* __restrict__ Bst_t, bf16_t* __restrict__ Ypart, float* __restrict__ S, int bid, char* As) {
  const int g = bid >> 2, cc0 = (bid & 3) * 66, tid = otid();
  const int wave = tid >> 6, lane = tid & 63, l15 = lane & 15, q = lane >> 4;
#pragma unroll 4
  for (int i = tid; i < 66 * 64 * 2; i += 512) {
    const int half = i & 1, sidx = (i >> 1) & 63, r = i >> 7;
    const int tok = s5_token(cc0 + r, sidx), ch = g * 16 + half * 8;
    const float* src = (tok < NL ? x + (size_t)tok * D : ctx + (size_t)(tok - NL) * D) + ch;
    const float* m = mod + row_vec(tok) * 6144;
    const float4 a = *(const float4*)src, b = *(const float4*)(src + 4);
    const float4 sh0 = *(const float4*)(m + ch), sh1 = *(const float4*)(m + ch + 4), sc0 = *(const float4*)(m + 1024 + ch), sc1 = *(const float4*)(m + 1024 + ch + 4);
    uint4 o;
    o.x = pack2bf(a.x * (1.f + sc0.x) + sh0.x, a.y * (1.f + sc0.y) + sh0.y); o.y = pack2bf(a.z * (1.f + sc0.z) + sh0.z, a.w * (1.f + sc0.w) + sh0.w);
    o.z = pack2bf(b.x * (1.f + sc1.x) + sh1.x, b.y * (1.f + sc1.y) + sh1.y); o.w = pack2bf(b.z * (1.f + sc1.z) + sh1.z, b.w * (1.f + sc1.w) + sh1.w);
    *(uint4*)(As + r * LDA_B + sidx * 32 + half * 16) = o;
  }
  __syncthreads();
  const char* ap[5];
#pragma unroll
  for (int t = 0; t < 5; ++t) { int r = t * 16 + l15; r = r < 66 ? r : 65; ap[t] = As + r * LDA_B + q * 16; }
  const bf16_t* Kg = Ktab + (size_t)g * 127 * 256;
#pragma unroll 1
  for (int unit = wave; unit < 40; unit += 8) {
    f32x4 acc[5][2];
    if (unit < 32) {
      const int t0 = unit * 2;
      const bf16_t* w0 = Kg + (t0 + 63 - (q >> 1)) * 256 + l15 * 16 + (q & 1) * 8;
      gemm_unit<5, 1024>(ap, w0, w0 + 256, -16, acc);
#pragma unroll
      for (int t = 0; t < 5; ++t)
#pragma unroll
        for (int j = 0; j < 2; ++j)
#pragma unroll
          for (int r = 0; r < 4; ++r) {
            const int row = t * 16 + q * 4 + r;
            if (row < 66) Ypart[(size_t)s5_token(cc0 + row, t0 + j) * D + g * 16 + l15] = f2bf(acc[t][j][r]);
          }
    } else {
      const int n0 = (unit - 32) * 32;
      const bf16_t* w0 = Bst_t + (size_t)g * 256 * 1024 + (size_t)(n0 >> 4) * 1024 * 16 + lane * 8;
      gemm_unit<5, 1024>(ap, w0, w0 + 1024 * 16, 16, acc);
#pragma unroll
      for (int t = 0; t < 5; ++t)
#pragma unroll
        for (int j = 0; j < 2; ++j)
#pragma unroll
          for (int r = 0; r < 4; ++r) {
            const int row = t * 16 + q * 4 + r;
            if (row < 66) S[((size_t)(cc0 + row) * 64 + g) * 256 + n0 + j * 16 + l15] = acc[t][j][r];
          }
    }
  }
}
__device__ __forceinline__ void ph_s5_carry(const float* __restrict__ S, const float* __restrict__ a_re, const float* __restrict__ a_im,
                                                 const float* __restrict__ log_dt, bf16_t* __restrict__ HP, int id, int p) {
  const int dir = id & 1, g = (id >> 1) & 63, b = id >> 7;
  const int gp = (dir * 64 + g) * 64 + p;
  const float are = a_re[gp], aim = a_im[gp], dt = expf(log_dt[dir * 64 + g]);
  const float mag = expf(are * dt);
  float tr = mag * cosf(aim * dt), ti = mag * sinf(aim * dt);
#pragma unroll
  for (int i = 0; i < 6; ++i) { const float nr = tr * tr - ti * ti, ni = 2.f * tr * ti; tr = nr; ti = ni; }
  float hr = 0.f, hi = 0.f;
#pragma unroll 12
  for (int step = 0; step < NCHUNK; ++step) {
    const int c = dir == 0 ? step : (step < 4 ? 3 - step : NCHUNK - 1 - (step - 4));
    const size_t base = ((size_t)(b * NCHUNK + c) * 64 + g) * 256 + dir * 128 + p;
    HP[base] = f2bf(hr); HP[base + 64] = f2bf(hi);
    const float sr = S[base], si = S[base + 64];
    const float nr = tr * hr - ti * hi + sr, ni = tr * hi + ti * hr + si;
    hr = nr; hi = ni;
  }
}
struct EpiS5 { const float* x; const float* ctx; const bf16_t* Ypart; bf16_t* Gbf; const float* cst; int cc0; int ch;
  __device__ __forceinline__ void operator()(int row, int col, float v) const {
    const int tok = s5_token(cc0 + row, col >> 4), vi = row_vec(tok);
    const float xin = tok < NL ? x[(size_t)tok * D + ch] : ctx[(size_t)(tok - NL) * D + ch];
    const float mm = xin * (1.f + cst[1 + vi * 2]) + cst[2 + vi * 2];
    const float y = v + bf2f(Ypart[(size_t)tok * D + ch]) + cst[0] * mm;
    Gbf[(size_t)tok * D + ch] = f2bf(gelu_fast(y));
  } };
__device__ __forceinline__ void ph_s5_p3(const float* __restrict__ x, const float* __restrict__ ctx, const float* __restrict__ mod, const float* __restrict__ dvec,
                                               const bf16_t* __restrict__ HP, const bf16_t* __restrict__ Cin_t, const bf16_t* __restrict__ Ypart, bf16_t* __restrict__ Gbf, int bid, char* As) {
  const int g = bid >> 2, cc0 = (bid & 3) * 66, tid = otid();
  for (int i = tid; i < 66 * 32; i += 512) {
    const int r = i >> 5, c = i & 31;
    *(uint4*)(As + r * 528 + c * 16) = *(const uint4*)(HP + ((size_t)(cc0 + r) * 64 + g) * 256 + c * 8);
  }
  __syncthreads();
  float* cst = (float*)(As + 66 * 528);
  if (tid < 16) {
    const int c0 = g * 16 + tid;
    cst[tid * 8 + 0] = dvec[c0];
    cst[tid * 8 + 1] = mod[1024 + c0]; cst[tid * 8 + 2] = mod[c0];
    cst[tid * 8 + 3] = mod[6144 + 1024 + c0]; cst[tid * 8 + 4] = mod[6144 + c0];
    cst[tid * 8 + 5] = mod[2 * 6144 + 1024 + c0]; cst[tid * 8 + 6] = mod[2 * 6144 + c0];
  }
  __syncthreads();
  gemm_ldsA<5, 256>(As, 528, 66, Cin_t + (size_t)g * 1024 * 256, 1024, EpiS5{x, ctx, Ypart, Gbf, cst + (otid() & 15) * 8, cc0, g * 16 + (otid() & 15)});
}


struct ChainP {
  const bf16_t* Ain;
  const bf16_t* Wglu_t; const bf16_t* Wo_t; const bf16_t* Wq_t;
  bf16_t* Vbf; bf16_t* O; const float* Hl; const float* Hc; const float* mod; const float* lng; const float* lnb;
  float* Hout; bf16_t* Tbf; bf16_t* Q;
};
template <bool L0>
__device__ __forceinline__ void ph_chainA(const ChainP& p, int bid, char* As) {
  constexpr int NR = L0 ? 66 : 64;
  constexpr int RT = L0 ? 5 : 4;
  const int g0 = bid * NR;
  load_rows_lds(As, p.Ain + (size_t)g0 * D, NR);
  __syncthreads();
  if (L0) {
    gemm_ldsA<RT, 1024>(As, LDA_B, NR, p.Wglu_t, D, EpiGluL{As, p.Vbf + (size_t)g0 * D});
    __syncthreads();
    load_rows_lds(As, p.Vbf + (size_t)g0 * D, NR);
    __syncthreads();
  }
  gemm_ldsA<RT, 1024>(As, LDA_B, NR, p.Wo_t, D, EpiBF16{p.O + (size_t)g0 * D, D});
  __syncthreads();
  ln_rows(As, g0, NR, p.Hl, p.Hc, p.O, p.mod, 2, p.lng, p.lnb, p.Hout, p.Tbf, 3, 4);
  __syncthreads();
  gemm_ldsA<RT, 1024>(As, LDA_B, NR, p.Wq_t, D, EpiBF16{p.Q + (size_t)g0 * D, D});
}


constexpr int KEYS = SEQ + CTX;
constexpr float att_KS = 0.5f;
struct EpiKV { unsigned char* Kn; unsigned char* Vl; int g0; int sh; __device__ __forceinline__ void operator()(int row, int col, float v) const {
  const int head = col >> 8, j = col & 255;
  if (j < 128) {
    const int g = g0 + row; int b, key;
    if (g < NL) { b = g >> 13; key = g & (SEQ - 1); } else { const int cidx = g - NL; b = cidx >> 8; key = SEQ + (cidx & (CTX - 1)); }
    Kn[((size_t)(b * 8 + head) * KEYS + key) * 128 + j] = f2fp8(v * att_KS);
  } else Vl[(head * 128 + (j - 128)) * 68 + row + sh] = f2fp8(v * 4.f);
} };
struct EpiQ { bf16_t* Qa; int g0; int pad; __device__ __forceinline__ void operator()(int row, int col, float v) const {
  const int g = g0 + row, b = g >> 13, n = g & (SEQ - 1);
  const int head = col / 192, j = col - head * 192;
  Qa[((size_t)(b * 8 + head) * SEQ + n) * 192 + j] = f2bf(v);
} };
struct ProjP { const bf16_t* Wcat_t; const bf16_t* Wuq_t; const bf16_t* Wukv_t; const float* q_norm; const float* kv_norm;
               float* PR; bf16_t* Qa; unsigned char* Kn; unsigned char* Kr; unsigned char* Va; };
__device__ __forceinline__ void ph_mla_proj(const ProjP& p, int bid, char* As) {
  const int g0 = bid * 66, wave = otid() >> 6, lane = otid() & 63;
  gemm_ldsA<5, 1024>(As, LDA_B, 66, p.Wcat_t, 704, EpiF32{p.PR + (size_t)g0 * D, D});
  __syncthreads();
  char* A1 = As; char* A2 = As + 66 * 784;
  for (int rr = wave; rr < 66; rr += 8) {
    const int g = g0 + rr;
    const float* pr = p.PR + (size_t)g * D;
    float v[6]; float ss = 0.f;
#pragma unroll
    for (int i = 0; i < 6; ++i) { v[i] = pr[i * 64 + lane]; ss += v[i] * v[i]; }
    float rn = rsqrtf(wave_sum(ss) * (1.f / 384.f) + RMS_EPS);
#pragma unroll
    for (int i = 0; i < 6; ++i) *(bf16_t*)(A1 + rr * 784 + (i * 64 + lane) * 2) = f2bf(v[i] * rn * p.q_norm[i * 64 + lane]);
    float w[4]; ss = 0.f;
#pragma unroll
    for (int i = 0; i < 4; ++i) { w[i] = pr[384 + i * 64 + lane]; ss += w[i] * w[i]; }
    rn = rsqrtf(wave_sum(ss) * (1.f / 256.f) + RMS_EPS);
#pragma unroll
    for (int i = 0; i < 4; ++i) *(bf16_t*)(A2 + rr * 528 + (i * 64 + lane) * 2) = f2bf(w[i] * rn * p.kv_norm[i * 64 + lane]);
    if (lane < 32) {
      float x1 = pr[640 + lane], x2 = pr[672 + lane];
      int b, key;
      if (g < NL) {
        b = g >> 13; key = g & (SEQ - 1);
        const int n = key, rr2 = n >> 6, cc = n & 63;
        const float inv = powf(10000.f, -(float)(lane & 15) / 16.f);
        const float ang = (lane < 16 ? (float)rr2 : (float)cc) * inv;
        const float cs = cosf(ang), sn = sinf(ang);
        const float y1 = x1 * cs - x2 * sn, y2 = x2 * cs + x1 * sn; x1 = y1; x2 = y2;
      } else { const int cidx = g - NL; b = cidx >> 8; key = SEQ + (cidx & (CTX - 1)); }
      unsigned char* kp = p.Kr + ((size_t)b * KEYS + key) * 64;
      kp[lane] = f2fp8(x1 * att_KS); kp[32 + lane] = f2fp8(x2 * att_KS);
    }
  }
  __syncthreads();
  int nq = NL - g0; nq = nq > 66 ? 66 : nq;
  if (nq > 0) gemm_ldsA<5, 384>(A1, 784, nq, p.Wuq_t, 1536, EpiQ{p.Qa, g0, 0});
  unsigned char* Vl = (unsigned char*)As + 66 * 784 + 66 * 528;
  const int sh = g0 & 3;
  gemm_ldsA<5, 256>(A2, 528, 66, p.Wukv_t, 2048, EpiKV{p.Kn, Vl, g0, sh});
  __syncthreads();
  for (int i = otid(); i < 1024 * 17; i += 512) {
    const int dvg = i / 17, q4 = i - dvg * 17, g4 = g0 - sh + 4 * q4;
    const unsigned w = *(const unsigned*)(Vl + dvg * 68 + 4 * q4);
    int b, key;
    if (g4 < NL) { b = g4 >> 13; key = g4 & (SEQ - 1); } else { const int cidx = g4 - NL; b = cidx >> 8; key = SEQ + (cidx & (CTX - 1)); }
    const int m = (key & 63) >> 2, posd = (m & 1) * 8 + (m >> 3) * 4 + ((m >> 1) & 3);
    unsigned char* dst = p.Va + ((size_t)(b * 8 + (dvg >> 7)) * (KEYS / 64) + (key >> 6)) * 8192 + (dvg & 127) * 64 + posd * 4;
    if (g4 >= g0 && g4 + 3 < g0 + 66) *(unsigned*)dst = w;
    else if (g4 < g0) *(unsigned short*)(dst + 2) = (unsigned short)(w >> 16);
    else *(unsigned short*)dst = (unsigned short)(w & 0xFFFFu);
  }
  for (int rr = wave; rr < nq; rr += 8) {
    const int g = g0 + rr, b = g >> 13, n = g & (SEQ - 1);
    if (lane < 32) {
      const float inv = powf(10000.f, -(float)(lane & 15) / 16.f);
      const float ang = (lane < 16 ? (float)(n >> 6) : (float)(n & 63)) * inv;
      const float cs = cosf(ang), sn = sinf(ang);
#pragma unroll
      for (int h = 0; h < 8; ++h) {
        bf16_t* qo = p.Qa + ((size_t)(b * 8 + h) * SEQ + n) * 192;
        const float x1 = bf2f(qo[128 + lane]), x2 = bf2f(qo[160 + lane]);
        qo[128 + lane] = f2bf(x1 * cs - x2 * sn); qo[160 + lane] = f2bf(x2 * cs + x1 * sn);
      }
    }
  }
}

namespace att {
using i32x8 = __attribute__((ext_vector_type(8))) int;
using i32x4 = __attribute__((ext_vector_type(4))) int;
using f32x16 = __attribute__((ext_vector_type(16))) float;
constexpr int KVBLK = 64, KROW = 208, VROW = 80, NTILE = KEYS / 64;
constexpr float KS = 0.5f, VS = 4.f;
constexpr float QS = 0.07216878364870322f * 1.4426950408889634f / KS;
constexpr float THR2 = 3.f * 1.4426950408889634f, PSH = 4.f;
constexpr int SHM_V = 128 * VROW, SHM_K = KVBLK * KROW, NSLOT = 3, SHM_ATTN = NSLOT * (SHM_V + SHM_K) + 8 * 64 * 4;
#define SBAR() __builtin_amdgcn_sched_barrier(0)
__device__ __forceinline__ int crow(int r, int hi) { return (r & 3) + 8 * (r >> 2) + 4 * hi; }
__device__ __forceinline__ f32x16 mfma8(i32x8 a, i32x8 b, f32x16 c) { return __builtin_amdgcn_mfma_scale_f32_32x32x64_f8f6f4(a, b, c, 0, 0, 0, 0, 0, 0); }
__device__ __forceinline__ i32x8 cat8(i32x4 a, i32x4 b) { return __builtin_shufflevector(a, b, 0, 1, 2, 3, 4, 5, 6, 7); }
__device__ __forceinline__ int pk4(float a, float b, float c, float d, int old = 0) { const int w = __builtin_amdgcn_cvt_pk_fp8_f32(a, b, old, false); return __builtin_amdgcn_cvt_pk_fp8_f32(c, d, w, true); }
__device__ __forceinline__ void softmax_tile(f32x16& p0, f32x16& p1, f32x16& bias, bool first, f32x16* o, float* al_l, int r32, int hi, i32x8& pa) {
  float pmax = p0[0];
#pragma unroll
  for (int r = 1; r < 16; ++r) pmax = fmaxf(pmax, p0[r]);
#pragma unroll
  for (int r = 0; r < 16; ++r) pmax = fmaxf(pmax, p1[r]);
  { auto rr = __builtin_amdgcn_permlane32_swap(__float_as_uint(pmax), __float_as_uint(pmax), false, false);
    pmax = fmaxf(__uint_as_float(rr[0]), __uint_as_float(rr[1])); }
  if (__builtin_expect(first || !__all(pmax <= PSH + THR2), 0)) {
    const float delta = first ? pmax - PSH : fmaxf(pmax - PSH, 0.f);
    if (!first) {
      if (hi == 0) al_l[r32] = __builtin_amdgcn_exp2f(-delta);
      asm volatile("s_waitcnt lgkmcnt(0)" ::: "memory");
#pragma unroll
      for (int d = 0; d < 5; ++d)
#pragma unroll
        for (int r = 0; r < 16; ++r) o[d][r] *= al_l[crow(r, hi)];
    }
    const float nb = bias[0] - delta;
#pragma unroll
    for (int r = 0; r < 16; ++r) { p0[r] -= delta; p1[r] -= delta; bias[r] = nb; }
  }
#pragma unroll
  for (int r = 0; r < 16; ++r) p0[r] = __builtin_amdgcn_exp2f(p0[r]);
#pragma unroll
  for (int r = 0; r < 16; ++r) p1[r] = __builtin_amdgcn_exp2f(p1[r]);
#pragma unroll
  for (int w = 0; w < 4; ++w) { pa[w] = pk4(p0[4 * w], p0[4 * w + 1], p0[4 * w + 2], p0[4 * w + 3], pa[w]); pa[4 + w] = pk4(p1[4 * w], p1[4 * w + 1], p1[4 * w + 2], p1[4 * w + 3], pa[4 + w]); }
}
__device__ __forceinline__ void qkt(f32x16& p0, f32x16& p1, const f32x16& bias, const char* Ks, const i32x8* q, int r32, int hi) {
  p0 = bias; p1 = bias;
  const char* k0 = Ks + r32 * KROW + hi * 32; const char* k1 = k0 + 32 * KROW;
#pragma unroll
  for (int s = 0; s < 3; ++s) {
    const i32x8 a0 = cat8(*reinterpret_cast<const i32x4*>(k0 + s * 64), *reinterpret_cast<const i32x4*>(k0 + s * 64 + 16));
    const i32x8 a1 = cat8(*reinterpret_cast<const i32x4*>(k1 + s * 64), *reinterpret_cast<const i32x4*>(k1 + s * 64 + 16));
    p0 = mfma8(a0, q[s], p0);
    p1 = mfma8(a1, q[s], p1); }
}
__device__ __forceinline__ void pv_all(f32x16* o, const char* Vs, i32x8 pa, int r32, int hi) {
  const char* v0 = Vs + r32 * VROW + hi * 32;
#pragma unroll
  for (int d0 = 0; d0 < 4; ++d0) {
    const i32x8 vb = cat8(*reinterpret_cast<const i32x4*>(v0 + d0 * 32 * VROW), *reinterpret_cast<const i32x4*>(v0 + d0 * 32 * VROW + 16));
    o[d0] = mfma8(pa, vb, o[d0]); }
  const i32x8 ones = {0x38383838, 0x38383838, 0x38383838, 0x38383838, 0x38383838, 0x38383838, 0x38383838, 0x38383838};
  o[4] = mfma8(pa, ones, o[4]);
}
__device__ __forceinline__ void attn_body(const bf16_t* __restrict__ Qb, const unsigned char* __restrict__ Kn, const unsigned char* __restrict__ Krb, const unsigned char* __restrict__ Vt,
                                          bf16_t* __restrict__ Ob, char* lds) {
  const int tid = otid(), wid = tid >> 6, lane = tid & 63, r32 = lane & 31, hi = lane >> 5;
  const bool lo4 = __builtin_amdgcn_readfirstlane(wid >> 2) == 0;
  char* V_lds = lds; char* K_lds = lds + NSLOT * SHM_V;
  float* al_l = (float*)(lds + NSLOT * (SHM_V + SHM_K)) + wid * 64;
  f32x16 bias = {}; f32x16 o[5] = {}; i32x8 q[3];
  { const bf16_t* Qw = Qb + (size_t)(wid * 32 + r32) * 192 + hi * 32;
#pragma unroll
    for (int s = 0; s < 3; ++s) {
#pragma unroll
      for (int c = 0; c < 4; ++c) { const uint4 w = *reinterpret_cast<const uint4*>(Qw + s * 64 + c * 8);
        q[s][2 * c] = pk4(bflo(w.x) * QS, bfhi(w.x) * QS, bflo(w.y) * QS, bfhi(w.y) * QS);
        q[s][2 * c + 1] = pk4(bflo(w.z) * QS, bfhi(w.z) * QS, bflo(w.w) * QS, bfhi(w.w) * QS); } } }
  i32x8 ones = {0x38383838, 0x38383838, 0x38383838, 0x38383838, 0x38383838, 0x38383838, 0x38383838, 0x38383838};
  const int vdst = (tid >> 2) * VROW + (tid & 3) * 16, kdst = (tid >> 3) * KROW + (tid & 7) * 16, rdst = (tid >> 2) * KROW + 128 + (tid & 3) * 16;
  const int kfo = r32 * KROW + hi * 32, vfo = r32 * VROW + hi * 32;
  uint4 vs, ks, rs = make_uint4(0u, 0u, 0u, 0u);
#define TLOAD(t) do { ks = *reinterpret_cast<const uint4*>(Kn + (size_t)(t) * 8192 + tid * 16); vs = *reinterpret_cast<const uint4*>(Vt + (size_t)(t) * 8192 + tid * 16); \
    if (lo4) rs = *reinterpret_cast<const uint4*>(Krb + (size_t)(t) * 4096 + tid * 16); } while (0)
#define TWRITE(sl) do { *(uint4*)(K_lds + (sl) * SHM_K + kdst) = ks; *(uint4*)(V_lds + (sl) * SHM_V + vdst) = vs; if (lo4) *(uint4*)(K_lds + (sl) * SHM_K + rdst) = rs; } while (0)
#define SWAIT() asm volatile("s_waitcnt vmcnt(0)" ::: "memory")
#define LD4(p) (*reinterpret_cast<const i32x4*>(p))
  f32x16 p0, p1; i32x8 pa = {};
  TLOAD(0); SWAIT(); TWRITE(0);
  TLOAD(1); SWAIT(); TWRITE(1);
  TLOAD(2);
  __syncthreads();
  int sl = 0, sl2 = 2;
#pragma unroll 1
  for (int i = 0; i < NTILE; ++i) {
    const char* kb = K_lds + sl * SHM_K + kfo; const char* vb = V_lds + sl * SHM_V + vfo;
    SBAR();
    i32x4 ka0 = LD4(kb), ka1 = LD4(kb + 16), ka2 = LD4(kb + 32 * KROW), ka3 = LD4(kb + 32 * KROW + 16);
    i32x4 kb0 = LD4(kb + 64), kb1 = LD4(kb + 80), kb2 = LD4(kb + 32 * KROW + 64), kb3 = LD4(kb + 32 * KROW + 80);
    SBAR();
    p0 = mfma8(cat8(ka0, ka1), q[0], bias); p1 = mfma8(cat8(ka2, ka3), q[0], bias);
    ka0 = LD4(kb + 128); ka1 = LD4(kb + 144); ka2 = LD4(kb + 32 * KROW + 128); ka3 = LD4(kb + 32 * KROW + 144);
    SBAR();
    p0 = mfma8(cat8(kb0, kb1), q[1], p0); p1 = mfma8(cat8(kb2, kb3), q[1], p1);
    i32x4 v00 = LD4(vb), v01 = LD4(vb + 16), v10 = LD4(vb + 32 * VROW), v11 = LD4(vb + 32 * VROW + 16);
    SBAR();
    p0 = mfma8(cat8(ka0, ka1), q[2], p0); p1 = mfma8(cat8(ka2, ka3), q[2], p1);
    SBAR();
    softmax_tile(p0, p1, bias, i == 0, o, al_l, r32, hi, pa);
    SBAR();
    i32x4 v20 = LD4(vb + 64 * VROW), v21 = LD4(vb + 64 * VROW + 16), v30 = LD4(vb + 96 * VROW), v31 = LD4(vb + 96 * VROW + 16);
    o[4] = mfma8(pa, ones, o[4]); o[0] = mfma8(pa, cat8(v00, v01), o[0]); o[1] = mfma8(pa, cat8(v10, v11), o[1]);
    SBAR();
    o[2] = mfma8(pa, cat8(v20, v21), o[2]); o[3] = mfma8(pa, cat8(v30, v31), o[3]);
    SBAR();
    SWAIT();
    if (i + 2 < NTILE) TWRITE(sl2);
    if (i + 3 < NTILE) TLOAD(i + 3);
    sl = sl == NSLOT - 1 ? 0 : sl + 1; sl2 = sl2 == NSLOT - 1 ? 0 : sl2 + 1;
    SBAR(); __syncthreads();
  }
  float rli[16];
#pragma unroll
  for (int r = 0; r < 16; ++r) rli[r] = __builtin_amdgcn_rcpf(o[4][r]) * (1.f / VS);
  bf16_t* Ow = Ob + (size_t)(wid * 32) * D;
#pragma unroll
  for (int r = 0; r < 16; ++r) { const int orow = crow(r, hi);
#pragma unroll
    for (int d0 = 0; d0 < 4; ++d0) Ow[(size_t)orow * D + d0 * 32 + r32] = f2bf(o[d0][r] * rli[r]); }
  __syncthreads();
#undef TLOAD
#undef TWRITE
#undef SWAIT
#undef LD4
}
}

__device__ __forceinline__ void ph_attn(const bf16_t* __restrict__ Qa, const unsigned char* __restrict__ Kn, const unsigned char* __restrict__ Kr, const unsigned char* __restrict__ Vt,
                                        bf16_t* __restrict__ AO, int bid, int nblk, char* lds) {
  for (int item = bid; item < 512; item += nblk) {
    const int b = item >> 8, h = item & 7, qb = (item >> 3) & 31;
    att::attn_body(Qa + ((size_t)(b * 8 + h) * SEQ + qb * 256) * 192, Kn + (size_t)(b * 8 + h) * KEYS * 128, Kr + (size_t)b * KEYS * 64,
                   Vt + (size_t)(b * 8 + h) * KEYS * 128, AO + (size_t)(b * SEQ + qb * 256) * D + h * 128, lds);
  }
}

namespace rt {
using f32x16 = __attribute__((ext_vector_type(16))) float;
__device__ __forceinline__ int sortable(float f) { const int b = __float_as_int(f); return b ^ ((b >> 31) & 0x7FFFFFFF); }
__device__ __forceinline__ float unsortable(int k) { return __int_as_float(k ^ ((k >> 31) & 0x7FFFFFFF)); }
__device__ __forceinline__ int imax(int a, int b) { return a > b ? a : b; }
__device__ __forceinline__ int imin(int a, int b) { return a < b ? a : b; }
template <int N> __device__ __forceinline__ void sort_desc(int (&v)[N]) {
#pragma unroll
  for (int k = 2; k <= N; k <<= 1) {
#pragma unroll
    for (int j = k >> 1; j > 0; j >>= 1) {
#pragma unroll
      for (int i = 0; i < N; ++i) {
        const int l = i ^ j;
        if (l > i) {
          const bool desc = ((i & k) == 0);
          const int a = v[i], b = v[l];
          v[i] = desc ? imax(a, b) : imin(a, b);
          v[l] = desc ? imin(a, b) : imax(a, b);
        }
      }
    }
  }
}
template <int N> __device__ __forceinline__ void merge_desc(int (&v)[N]) {
#pragma unroll
  for (int j = N >> 1; j > 0; j >>= 1) {
#pragma unroll
    for (int i = 0; i < N; ++i) {
      const int l = i ^ j;
      if (l > i) { const int a = v[i], b = v[l]; v[i] = imax(a, b); v[l] = imin(a, b); }
    }
  }
}
__device__ __forceinline__ void absorb16(int (&L)[16], int (&B)[16]) {
  sort_desc<16>(B);
#pragma unroll
  for (int i = 0; i < 16; ++i) L[i] = imax(L[i], B[15 - i]);
  merge_desc<16>(L);
}
__device__ __forceinline__ constexpr int npairs_row(int i) { return 16 / (i + 1); }
}

struct RouteP { const bf16_t* Q; const bf16_t* Khi; int* IDX; float* GATE; int rows_per_block; int pad; };
__device__ __forceinline__ void ph_route(const RouteP& p, int bid, char* lds) {
  using namespace rt;
  int (*svl)[64][33] = reinterpret_cast<int (*)[64][33]>(lds);
  const int wave = otid() >> 6, lane = otid() & 63, r32 = lane & 31, hi = lane >> 5, hi4 = hi * 4;
  int nrows = p.rows_per_block; asm volatile("" : "+s"(nrows));
  const int g0 = bid * nrows;
  const int h = wave;
#pragma unroll 1
  for (int tg = 0; tg * 32 < nrows; ++tg) {
    int trow = tg * 32 + r32; const bool valid = trow < nrows; trow = valid ? trow : nrows - 1;
    const bf16_t* qrow = p.Q + (size_t)(g0 + trow) * D;
    int sv[2][16];
#pragma unroll
    for (int s = 0; s < 2; ++s) {
      const int hs = h * 2 + s;
      f32x16 acc[4];
#pragma unroll
      for (int m = 0; m < 4; ++m) acc[m] = f32x16{};
#pragma unroll
      for (int kp = 0; kp < 2; ++kp) {
        bf16x8 kf[2][4], qf[2];
#pragma unroll
        for (int k2 = 0; k2 < 2; ++k2)
#pragma unroll
          for (int m = 0; m < 4; ++m) kf[k2][m] = *(const bf16x8*)(p.Khi + ((size_t)(hs * 128 + m * 32 + r32)) * 64 + (kp * 2 + k2) * 16 + hi * 8);
#pragma unroll
        for (int k2 = 0; k2 < 2; ++k2) {
          const int ks = kp * 2 + k2;
          qf[k2] = *(const bf16x8*)(qrow + hs * 64 + ks * 16 + hi * 8);
        }
#pragma unroll
        for (int k2 = 0; k2 < 2; ++k2)
#pragma unroll
          for (int m = 0; m < 4; ++m) acc[m] = __builtin_amdgcn_mfma_f32_32x32x16_bf16(kf[k2][m], qf[k2], acc[m], 0, 0, 0);
      }
      int L[16];
#pragma unroll
      for (int m = 0; m < 4; ++m) {
        int B[16];
#pragma unroll
        for (int r = 0; r < 16; ++r) B[r] = (sortable(acc[m][r]) & ~0x7F) | (m * 32 + (r & 3) + 8 * (r >> 2)) | hi4;
        if (m == 0) { sort_desc<16>(B);
#pragma unroll
          for (int i = 0; i < 16; ++i) L[i] = B[i]; }
        else absorb16(L, B);
      }
      int Lo[16], Hi[16];
#pragma unroll
      for (int i = 0; i < 16; ++i) { auto rr = __builtin_amdgcn_permlane32_swap((unsigned)L[i], (unsigned)L[i], false, false); Lo[i] = (int)rr[0]; Hi[i] = (int)rr[1]; }
#pragma unroll
      for (int i = 0; i < 16; ++i) L[i] = imax(Lo[i], Hi[15 - i]);
      merge_desc<16>(L);
#pragma unroll
      for (int i = 0; i < 16; ++i) { sv[s][i] = L[i]; svl[wave][lane][s * 16 + i] = L[i]; }
    }
    float f0[16], f1[16];
#pragma unroll
    for (int i = 0; i < 16; ++i) { f0[i] = unsortable(sv[0][i] & ~0x7F); f1[i] = unsortable(sv[1][i] & ~0x7F); }
    int Lc[16];
    {
      int C[64];
      int n = 0;
#pragma unroll
      for (int i = 0; i < 16; ++i)
#pragma unroll
        for (int j = 0; j < 16; ++j)
          if ((i + 1) * (j + 1) <= 16) { C[n] = (sortable(f0[i] + f1[j]) & ~0xFF) | (i * 16 + j); ++n; }
#pragma unroll
      for (int k = 50; k < 64; ++k) C[k] = (int)0x80000000;
#pragma unroll
      for (int m = 0; m < 4; ++m) {
        int B[16];
#pragma unroll
        for (int r = 0; r < 16; ++r) B[r] = C[m * 16 + r];
        if (m == 0) { sort_desc<16>(B);
#pragma unroll
          for (int i = 0; i < 16; ++i) Lc[i] = B[i]; }
        else absorb16(Lc, B);
      }
    }
    float e[16]; float esum = 0.f;
    const float vmax = unsortable(Lc[0] & ~0xFF);
#pragma unroll
    for (int r = 0; r < 16; ++r) { e[r] = expf(unsortable(Lc[r] & ~0xFF) - vmax); esum += e[r]; }
    const float inv = 1.f / esum;
    int eid[16];
#pragma unroll
    for (int r = 0; r < 16; ++r) {
      const int pr = Lc[r] & 0xFF;
      const int k0 = svl[wave][lane][pr >> 4] & 0x7F, k1 = svl[wave][lane][16 + (pr & 15)] & 0x7F;
      eid[r] = k0 * 128 + k1;
    }
    if (valid && hi == 0) {
      int* ip = p.IDX + (size_t)(g0 + trow) * 128 + h * 16; float* gp = p.GATE + (size_t)(g0 + trow) * 128 + h * 16;
#pragma unroll
      for (int r = 0; r < 16; r += 4) {
        *(int4*)(ip + r) = make_int4(eid[r], eid[r + 1], eid[r + 2], eid[r + 3]);
        *(float4*)(gp + r) = make_float4(e[r] * inv, e[r + 1] * inv, e[r + 2] * inv, e[r + 3] * inv);
      }
    }
  }
}

template <bool SIGNED>
__device__ __forceinline__ void cvt_rows_i8(const float* __restrict__ src, unsigned char* __restrict__ dst, float* __restrict__ scl, int nrows, int wgid, int nw) {
  const int lane = otid() & 63;
  for (int r0 = wgid * 4; r0 < nrows; r0 += nw * 4) {
    float v[4][16];
#pragma unroll
    for (int u = 0; u < 4; ++u) {
      const float* sp = src + (size_t)(r0 + u) * D + lane * 4;
      *(float4*)&v[u][0] = *(const float4*)sp; *(float4*)&v[u][4] = *(const float4*)(sp + 256); *(float4*)&v[u][8] = *(const float4*)(sp + 512); *(float4*)&v[u][12] = *(const float4*)(sp + 768);
    }
#pragma unroll
    for (int u = 0; u < 4; ++u) {
      float am = 0.f;
#pragma unroll
      for (int j = 0; j < 16; ++j) am = fmaxf(am, fabsf(v[u][j]));
#pragma unroll
      for (int o = 32; o >= 1; o >>= 1) am = fmaxf(am, __shfl_xor(am, o));
      const float sc = am > 0.f ? am * (1.f / 127.f) : 1.f, inv = 1.f / sc;
      unsigned w[4];
#pragma unroll
      for (int q4 = 0; q4 < 4; ++q4) {
        unsigned ww = 0u;
#pragma unroll
        for (int j = 0; j < 4; ++j) { int qi = (int)rintf(v[u][q4 * 4 + j] * inv) + (SIGNED ? 0 : 128); qi = SIGNED ? (qi < -127 ? -127 : (qi > 127 ? 127 : qi)) : (qi < 1 ? 1 : (qi > 255 ? 255 : qi)); ww |= (unsigned)(qi & 255) << (8 * j); }
        w[q4] = ww;
      }
      *(uint4*)(dst + (size_t)(r0 + u) * D + lane * 16) = make_uint4(w[0], w[1], w[2], w[3]);
      if (lane == 0) scl[r0 + u] = sc;
    }
  }
}

constexpr int QROW = 768;
__device__ __forceinline__ void cvt_rows_q6(const float* __restrict__ src, unsigned char* __restrict__ dst, float* __restrict__ scl, int nrows, int wgid, int nw) {
  const int lane = otid() & 63;
  for (int r0 = wgid * 4; r0 < nrows; r0 += nw * 4) {
    float v[4][16];
#pragma unroll
    for (int u = 0; u < 4; ++u) {
      const float* sp = src + (size_t)(r0 + u) * D + lane * 4;
      *(float4*)&v[u][0] = *(const float4*)sp; *(float4*)&v[u][4] = *(const float4*)(sp + 256); *(float4*)&v[u][8] = *(const float4*)(sp + 512); *(float4*)&v[u][12] = *(const float4*)(sp + 768);
    }
#pragma unroll
    for (int u = 0; u < 4; ++u) {
      float am = 0.f;
#pragma unroll
      for (int j = 0; j < 16; ++j) am = fmaxf(am, fabsf(v[u][j]));
#pragma unroll
      for (int o = 32; o >= 1; o >>= 1) am = fmaxf(am, __shfl_xor(am, o));
      const float sc = am > 0.f ? am * (1.f / 31.f) : 1.f, inv = 1.f / sc;
      unsigned long long lo = 0ull, hi = 0ull;
#pragma unroll
      for (int j = 0; j < 16; ++j) {
        int qi = (int)rintf(v[u][j] * inv) + 32; qi = qi < 1 ? 1 : (qi > 63 ? 63 : qi);
        const int bit = 6 * j;
        if (bit < 64) { lo |= (unsigned long long)qi << bit; if (bit > 58) hi |= (unsigned long long)qi >> (64 - bit); }
        else hi |= (unsigned long long)qi << (bit - 64);
      }
      unsigned* dp = (unsigned*)(dst + (size_t)(r0 + u) * QROW + lane * 12);
      dp[0] = (unsigned)lo; dp[1] = (unsigned)(lo >> 32); dp[2] = (unsigned)hi;
      if (lane == 0) scl[r0 + u] = sc;
    }
  }
}
struct q6w { unsigned x, y, z; };
template <int J> __device__ __forceinline__ float q6(const q6w& w) {
  constexpr int bit = 6 * J, wd = bit >> 5, sh = bit & 31;
  const unsigned lo = wd == 0 ? w.x : (wd == 1 ? w.y : w.z);
  if constexpr (sh == 26) return (float)(lo >> 26);
  else if constexpr (sh < 26) return (float)((lo >> sh) & 63u);
  else { const unsigned hi = wd == 0 ? w.y : w.z; return (float)(__builtin_amdgcn_alignbit(hi, lo, sh) & 63u); }
}

struct GatherP { const bf16_t* Tbf; const int* IDX; const float* GATE; const unsigned char* utab; const unsigned char* vtab; const float* su; const float* sv;
                 const float* Hin; const float* mod; const float* lng; const float* lnb; float* Hout; const float* modT; };
#define UB0(w) ((float)((w) & 0xFFu))
#define UB1(w) ((float)(((w) >> 8) & 0xFFu))
#define UB2(w) ((float)(((w) >> 16) & 0xFFu))
#define UB3(w) ((float)((w) >> 24))
template <bool FINAL>
__device__ __forceinline__ void ln_token(const GatherP& p, int row, int rr, int lane, const float (&f)[16], float asum, char* As) {
  const int v = row_vec(row);
  const float* hin = p.Hin + (size_t)row * D + lane * 4;
  const float* gm = p.mod + v * 6144 + 5 * 1024 + lane * 4;
  const float off = 32.f * asum;
  float r[16]; float ssum = 0.f;
#pragma unroll
  for (int q4 = 0; q4 < 4; ++q4) {
    const float4 h4 = *(const float4*)(hin + q4 * 256), g4 = *(const float4*)(gm + q4 * 256);
    r[q4 * 4 + 0] = ALPHA * h4.x + g4.x * (f[q4 * 4 + 0] - off); r[q4 * 4 + 1] = ALPHA * h4.y + g4.y * (f[q4 * 4 + 1] - off);
    r[q4 * 4 + 2] = ALPHA * h4.z + g4.z * (f[q4 * 4 + 2] - off); r[q4 * 4 + 3] = ALPHA * h4.w + g4.w * (f[q4 * 4 + 3] - off);
    ssum += r[q4 * 4 + 0] + r[q4 * 4 + 1] + r[q4 * 4 + 2] + r[q4 * 4 + 3];
  }
  const float mu = wave_sum(ssum) * (1.f / D);
  float vs = 0.f;
#pragma unroll
  for (int j = 0; j < 16; ++j) { const float dlt = r[j] - mu; vs += dlt * dlt; }
  const float rstd = rsqrtf(wave_sum(vs) * (1.f / D) + LN_EPS);
  float o[16];
#pragma unroll
  for (int q4 = 0; q4 < 4; ++q4) {
    const float4 g4 = *(const float4*)(p.lng + q4 * 256 + lane * 4), b4 = *(const float4*)(p.lnb + q4 * 256 + lane * 4);
    o[q4 * 4 + 0] = (r[q4 * 4 + 0] - mu) * rstd * g4.x + b4.x; o[q4 * 4 + 1] = (r[q4 * 4 + 1] - mu) * rstd * g4.y + b4.y;
    o[q4 * 4 + 2] = (r[q4 * 4 + 2] - mu) * rstd * g4.z + b4.z; o[q4 * 4 + 3] = (r[q4 * 4 + 3] - mu) * rstd * g4.w + b4.w;
    *(float4*)(p.Hout + (size_t)row * D + q4 * 256 + lane * 4) = make_float4(o[q4 * 4 + 0], o[q4 * 4 + 1], o[q4 * 4 + 2], o[q4 * 4 + 3]);
  }
  if (!FINAL) {
    const float* mt = p.modT + v * 6144 + lane * 4;
#pragma unroll
    for (int q4 = 0; q4 < 4; ++q4) {
      const float4 sh = *(const float4*)(mt + q4 * 256), sc = *(const float4*)(mt + 1024 + q4 * 256);
      uint2 w; w.x = pack2bf(o[q4 * 4] * (1.f + sc.x) + sh.x, o[q4 * 4 + 1] * (1.f + sc.y) + sh.y); w.y = pack2bf(o[q4 * 4 + 2] * (1.f + sc.z) + sh.z, o[q4 * 4 + 3] * (1.f + sc.w) + sh.w);
      *(uint2*)(As + rr * LDA_B + (q4 * 256 + lane * 4) * 2) = w;
    }
  }
}
constexpr int PARTW = 1088;
template <bool FINAL>
__device__ __forceinline__ void ph_gather_tm(const GatherP& p, int g0, int nrows, char* As, float* __restrict__ PART) {
  const int tid = otid(), wave = tid >> 6, lane = tid & 63;
  const int nfull = nrows >> 3, extra = nrows & 7;
  const int nun = nfull + (extra ? 1 : 0);
#pragma unroll 1
  for (int un = 0; un < nun; ++un) {
    int rr, kbeg, kcnt; bool partial;
    if (un < nfull) { rr = wave + 8 * un; kbeg = 0; kcnt = 128; partial = false; }
    else { const int wpt = 8 / extra; rr = nfull * 8 + wave / wpt; kcnt = 128 / wpt; kbeg = (wave % wpt) * kcnt; partial = true; }
    const int row = g0 + rr;
    float tf[16];
    {
      const bf16_t* tp = p.Tbf + (size_t)row * D + lane * 4;
      const uint2 t0 = *(const uint2*)tp, t1 = *(const uint2*)(tp + 256), t2 = *(const uint2*)(tp + 512), t3 = *(const uint2*)(tp + 768);
      tf[0] = bflo(t0.x); tf[1] = bfhi(t0.x); tf[2] = bflo(t0.y); tf[3] = bfhi(t0.y); tf[4] = bflo(t1.x); tf[5] = bfhi(t1.x); tf[6] = bflo(t1.y); tf[7] = bfhi(t1.y);
      tf[8] = bflo(t2.x); tf[9] = bfhi(t2.x); tf[10] = bflo(t2.y); tf[11] = bfhi(t2.y); tf[12] = bflo(t3.x); tf[13] = bfhi(t3.x); tf[14] = bflo(t3.y); tf[15] = bfhi(t3.y);
    }
    float tam = 0.f;
#pragma unroll
    for (int j = 0; j < 16; ++j) tam = fmaxf(tam, fabsf(tf[j]));
    tam = wave_max_dpp(tam);
    const float st = tam > 0.f ? tam * (1.f / 127.f) : 1.f, tinv = 1.f / st;
    int tq[4];
#pragma unroll
    for (int k4 = 0; k4 < 4; ++k4) {
      unsigned ww = 0u;
#pragma unroll
      for (int j = 0; j < 4; ++j) ww |= (unsigned)((int)rintf(tf[k4 * 4 + j] * tinv) & 255) << (8 * j);
      tq[k4] = (int)ww;
    }
    const int id_lo = p.IDX[(size_t)row * 128 + lane], id_hi = p.IDX[(size_t)row * 128 + 64 + lane];
    const float ga_lo = p.GATE[(size_t)row * 128 + lane], ga_hi = p.GATE[(size_t)row * 128 + 64 + lane];
    float f[16], asum = 0.f;
#pragma unroll
    for (int j = 0; j < 16; ++j) f[j] = 0.f;
    uint4 ub[8]; q6w vb[8]; float sub[8], svb[8];
#define TLOAD(slot, kk) do { const int e_ = __builtin_amdgcn_readlane((kk) < 64 ? id_lo : id_hi, (kk) & 63); \
      ub[slot] = *(const uint4*)(p.utab + (size_t)e_ * D + lane * 16); vb[slot] = *(const q6w*)(p.vtab + (size_t)e_ * QROW + lane * 12); \
      sub[slot] = p.su[e_]; svb[slot] = p.sv[e_]; } while (0)
    auto proc4 = [&](int s0, int k0) {
      float dot[4];
#pragma unroll
      for (int u = 0; u < 4; ++u) {
        const uint4 a_ = ub[s0 + u];
        int di = __builtin_amdgcn_sdot4((int)a_.x, tq[0], 0, false); di = __builtin_amdgcn_sdot4((int)a_.y, tq[1], di, false);
        di = __builtin_amdgcn_sdot4((int)a_.z, tq[2], di, false); di = __builtin_amdgcn_sdot4((int)a_.w, tq[3], di, false);
        const float d = (float)di;
        dot[u] = d;
      }
#define DPPSTEP(ctl, rm) do { _Pragma("unroll") for (int u = 0; u < 4; ++u) dot[u] += __uint_as_float(__builtin_amdgcn_update_dpp(0u, __float_as_uint(dot[u]), ctl, rm, 0xF, true)); } while (0)
      DPPSTEP(0xB1, 0xF); DPPSTEP(0x4E, 0xF); DPPSTEP(0x141, 0xF); DPPSTEP(0x140, 0xF); DPPSTEP(0x142, 0xA); DPPSTEP(0x143, 0xC);
#undef DPPSTEP
      float act[4];
#pragma unroll
      for (int u = 0; u < 4; ++u) {
        const int kk = k0 + u;
        const float tot = __uint_as_float((unsigned)__builtin_amdgcn_readlane((int)__float_as_uint(dot[u]), 63));
        const float g_ = __uint_as_float((unsigned)__builtin_amdgcn_readlane((int)__float_as_uint(kk < 64 ? ga_lo : ga_hi), kk & 63));
        act[u] = gelu_fast(sub[s0 + u] * st * tot) * g_ * svb[s0 + u];
      }
#pragma unroll
      for (int u = 0; u < 4; ++u) {
        const float act_ = act[u];
        asum += act_;
        const q6w c_ = vb[s0 + u];
        f[0] = fmaf(act_, q6<0>(c_), f[0]); f[1] = fmaf(act_, q6<1>(c_), f[1]); f[2] = fmaf(act_, q6<2>(c_), f[2]); f[3] = fmaf(act_, q6<3>(c_), f[3]);
        f[4] = fmaf(act_, q6<4>(c_), f[4]); f[5] = fmaf(act_, q6<5>(c_), f[5]); f[6] = fmaf(act_, q6<6>(c_), f[6]); f[7] = fmaf(act_, q6<7>(c_), f[7]);
        f[8] = fmaf(act_, q6<8>(c_), f[8]); f[9] = fmaf(act_, q6<9>(c_), f[9]); f[10] = fmaf(act_, q6<10>(c_), f[10]); f[11] = fmaf(act_, q6<11>(c_), f[11]);
        f[12] = fmaf(act_, q6<12>(c_), f[12]); f[13] = fmaf(act_, q6<13>(c_), f[13]); f[14] = fmaf(act_, q6<14>(c_), f[14]); f[15] = fmaf(act_, q6<15>(c_), f[15]);
      }
    };
    TLOAD(0, kbeg); TLOAD(1, kbeg + 1); TLOAD(2, kbeg + 2); TLOAD(3, kbeg + 3); TLOAD(4, kbeg + 4); TLOAD(5, kbeg + 5); TLOAD(6, kbeg + 6); TLOAD(7, kbeg + 7);
    const int kend = kbeg + kcnt - 8;
#pragma unroll 1
    for (int k = kbeg; k < kend; k += 8) {
      proc4(0, k); TLOAD(0, k + 8); TLOAD(1, k + 9); TLOAD(2, k + 10); TLOAD(3, k + 11);
      proc4(4, k + 4); TLOAD(4, k + 12); TLOAD(5, k + 13); TLOAD(6, k + 14); TLOAD(7, k + 15);
    }
    proc4(0, kend); proc4(4, kend + 4);
#undef TLOAD
    if (!partial) ln_token<FINAL>(p, row, rr, lane, f, asum, As);
    else {
      float* pp = PART + wave * PARTW + lane * 16;
      *(float4*)pp = make_float4(f[0], f[1], f[2], f[3]); *(float4*)(pp + 4) = make_float4(f[4], f[5], f[6], f[7]);
      *(float4*)(pp + 8) = make_float4(f[8], f[9], f[10], f[11]); *(float4*)(pp + 12) = make_float4(f[12], f[13], f[14], f[15]);
      if (lane == 0) PART[wave * PARTW + 1024] = asum;
    }
  }
  if (extra) {
    __syncthreads();
    if (wave < extra) {
      const int wpt = 8 / extra, rr = nfull * 8 + wave;
      float f[16], asum = 0.f;
#pragma unroll
      for (int j = 0; j < 16; ++j) f[j] = 0.f;
      for (int w2 = wave * wpt; w2 < wave * wpt + wpt; ++w2) {
        const float* pp = PART + w2 * PARTW + lane * 16;
#pragma unroll
        for (int q4 = 0; q4 < 4; ++q4) { const float4 x4 = *(const float4*)(pp + q4 * 4); f[q4 * 4] += x4.x; f[q4 * 4 + 1] += x4.y; f[q4 * 4 + 2] += x4.z; f[q4 * 4 + 3] += x4.w; }
        asum += PART[w2 * PARTW + 1024];
      }
      ln_token<FINAL>(p, g0 + rr, rr, lane, f, asum, As);
    }
  }
}

__device__ __forceinline__ void cvt_plain(const float* __restrict__ a, bf16_t* __restrict__ o, size_t n8, bool lo, size_t gtid, size_t gsz) {
  for (size_t i = gtid; i < n8; i += gsz) {
    float v[8];
    *(float4*)&v[0] = ((const float4*)a)[i * 2]; *(float4*)&v[4] = ((const float4*)a)[i * 2 + 1];
    if (lo) {
#pragma unroll
      for (int j = 0; j < 8; ++j) v[j] = v[j] - bf2f(f2bf(v[j]));
    }
    uint4 w; w.x = pack2bf(v[0], v[1]); w.y = pack2bf(v[2], v[3]); w.z = pack2bf(v[4], v[5]); w.w = pack2bf(v[6], v[7]);
    ((uint4*)o)[i] = w;
  }
}
__device__ __forceinline__ void cvt_t(const float* __restrict__ W, bf16_t* __restrict__ Wt, int K, int N, bool lo, size_t gtid, size_t gsz) {
  const size_t total = (size_t)N * (K / 8);
#pragma unroll 4
  for (size_t i = gtid; i < total; i += gsz) {
    const int n = (int)(i % N), k8 = (int)(i / N);
    float v[8];
#pragma unroll
    for (int j = 0; j < 8; ++j) { const float w = W[(size_t)(k8 * 8 + j) * N + n]; v[j] = lo ? w - bf2f(f2bf(w)) : w; }
    uint4 w; w.x = pack2bf(v[0], v[1]); w.y = pack2bf(v[2], v[3]); w.z = pack2bf(v[4], v[5]); w.w = pack2bf(v[6], v[7]);
    *(uint4*)(Wt + ((size_t)((n >> 4) * (K >> 5) + (k8 >> 2)) * 64 + (k8 & 3) * 16 + (n & 15)) * 8) = w;
  }
}
__device__ __forceinline__ void mod_item(const float* __restrict__ c, const float* __restrict__ c_ctx, const float* __restrict__ ada_w, const float* __restrict__ ada_b,
                                         float* __restrict__ MOD, int item, bool valid, char* lds, int tid, int nct, volatile int* cbc, int& cgen) {
  float* sc = (float*)lds;
  float* part = sc + 3072;
  const int wave = tid >> 6, lane = tid & 63, l = item / 96, cg = item % 96, nw = nct >> 6;
  if (valid) for (int i = tid; i < 3072; i += nct) { const int v = i >> 10, k = i & 1023; const float xv = v < 2 ? c[v * 1024 + k] : c_ctx[k]; sc[i] = xv / (1.f + expf(-xv)); }
  cbar(cbc, cgen, nw);
  if (valid) {
    float a0 = 0.f, a1 = 0.f, a2 = 0.f;
    const float* W = ada_w + (size_t)l * 1024 * 6144 + cg * 64 + lane;
    const int kb = wave * 171, ke = kb + 171 < 1024 ? kb + 171 : 1024;
#pragma unroll 19
    for (int k = kb; k < ke; ++k) { const float w = W[(size_t)k * 6144]; a0 += sc[k] * w; a1 += sc[1024 + k] * w; a2 += sc[2048 + k] * w; }
    part[(wave * 3 + 0) * 64 + lane] = a0; part[(wave * 3 + 1) * 64 + lane] = a1; part[(wave * 3 + 2) * 64 + lane] = a2;
  }
  cbar(cbc, cgen, nw);
  if (valid && tid < 192) {
    const int v = tid >> 6, ln = tid & 63; float sum = 0.f;
    for (int w = 0; w < nw; ++w) sum += part[(w * 3 + v) * 64 + ln];
    MOD[(l * 3 + v) * 6144 + cg * 64 + ln] = sum + ada_b[l * 6144 + cg * 64 + ln];
  }
}

__device__ __forceinline__ void gbar(unsigned* cnt, unsigned target) {
  asm volatile("s_waitcnt vmcnt(0)" ::: "memory");
  __syncthreads();
  if (otid() == 0) {
    __builtin_amdgcn_fence(__ATOMIC_RELEASE, "agent");
    asm volatile("s_waitcnt vmcnt(0)" ::: "memory");
    __hip_atomic_fetch_add(cnt, 1u, __ATOMIC_RELAXED, __HIP_MEMORY_SCOPE_AGENT);
    unsigned spins = 0;
    while (__hip_atomic_load(cnt, __ATOMIC_RELAXED, __HIP_MEMORY_SCOPE_AGENT) < target) { __builtin_amdgcn_s_sleep(2); if (++spins > (1u << 24)) break; }
    __builtin_amdgcn_fence(__ATOMIC_ACQUIRE, "agent");
    asm volatile("s_waitcnt vmcnt(0)" ::: "memory");
  }
  __syncthreads();
}

struct MP {
  const float *x, *c, *ctx, *c_ctx, *ada_w, *ada_b, *ln_g, *ln_b, *s5_a_re, *s5_a_im, *s5_log_dt, *s5_b_re, *s5_b_im, *s5_c_re, *s5_c_im, *s5_d, *s5_w_glu, *s5_w_o;
  const float *mla_w_dq, *mla_q_norm, *mla_w_uq, *mla_w_dkv, *mla_kv_norm, *mla_w_ukv, *mla_w_o, *peer_w_q, *peer_keys, *peer_u, *peer_v;
  float* out;
  float* MOD; bf16_t *Wt_glu, *Wt_o0, *Wt_q0, *Wt_o1, *Wt_q1, *Wt_cat, *Wt_uq, *Wt_ukv, *Khi, *Khi1;
  unsigned char *U0, *V0, *U1, *V1; float *SU0, *SV0, *SU1, *SV1; bf16_t *Ktab, *Bst_t, *Cin_t;
  bf16_t* Ypart; float* Ssta; bf16_t *HP, *Gbf, *Vbf, *Tbf; float *OQ, *H1, *H2; int* IDX; float* GATE;
  bf16_t *Qa, *AObf; unsigned char *Kn, *Kr, *Va; float* H3; bf16_t* Tbf1; unsigned* BAR; float* PART;
};
constexpr int LDS_BYTES = 66 * 784 + 66 * 528 + 1024 * 68 + 64;
__global__ __launch_bounds__(512) void mega(MP p) {
  __shared__ __attribute__((aligned(16))) char lds[LDS_BYTES];
  cg::grid_group grid = cg::this_grid();
  const int nblk = gridDim.x;
  int bid = blockIdx.x;
  const size_t TD = (size_t)1024 * 16384;
  const float* mod0 = p.MOD; const float* mod1 = p.MOD + 3 * 6144;
  {
    volatile int* cbc = (volatile int*)(lds + LDS_BYTES - 16);
    if (otid() == 0) *cbc = 0;
    __syncthreads();
    const int t0 = otid();
    if (t0 < 128) {
      const size_t mt = (size_t)bid * 128 + t0, ms = (size_t)nblk * 128;
      const int mw = bid * 2 + (t0 >> 6), nmw = nblk * 2;
      cvt_t(p.s5_w_glu, p.Wt_glu, D, D, false, mt, ms);
      cvt_t(p.s5_w_o, p.Wt_o0, D, D, false, mt, ms);
      cvt_t(p.peer_w_q, p.Wt_q0, D, D, false, mt, ms);
      cvt_t(p.mla_w_o, p.Wt_o1, D, D, false, mt, ms);
      cvt_t(p.peer_w_q + (size_t)D * D, p.Wt_q1, D, D, false, mt, ms);
      cvt_t(p.mla_w_dq, p.Wt_cat, D, 384, false, mt, ms);
      cvt_t(p.mla_w_dkv, p.Wt_cat + (size_t)384 * D, D, 320, false, mt, ms);
      cvt_t(p.mla_w_uq, p.Wt_uq, 384, 1536, false, mt, ms);
      cvt_t(p.mla_w_ukv, p.Wt_ukv, 256, 2048, false, mt, ms);
      cvt_plain(p.peer_keys, p.Khi, (size_t)2 * 131072 / 8, false, mt, ms);
      cvt_rows_i8<true>(p.peer_u, p.U0, p.SU0, 16384, mw, nmw);
      cvt_rows_q6(p.peer_v, p.V0, p.SV0, 16384, mw, nmw);
      cvt_rows_i8<true>(p.peer_u + TD, p.U1, p.SU1, 16384, mw, nmw);
      cvt_rows_q6(p.peer_v + TD, p.V1, p.SV1, 16384, mw, nmw);
    } else {
      int cgen = 0;
      const int ct = t0 - 128;
      ph_s5_prep(p.s5_a_re, p.s5_a_im, p.s5_log_dt, p.s5_b_re, p.s5_b_im, p.s5_c_re, p.s5_c_im, p.Ktab, p.Bst_t, p.Cin_t, bid >> 2, bid & 3, lds, ct, 384, cbc, cgen);
      cbar(cbc, cgen, 6);
      mod_item(p.c, p.c_ctx, p.ada_w, p.ada_b, p.MOD, bid, bid < 192, lds, ct, 384, cbc, cgen);
    }
  }
  grid.sync();
  asm volatile("" : "+s"(bid));
  ph_s5_p1(p.x, p.ctx, mod0, p.Ktab, p.Bst_t, p.Ypart, p.Ssta, bid, lds);
  gbar(p.BAR, 1u * (unsigned)nblk);
  asm volatile("" : "+s"(bid));
  if (otid() < 64) ph_s5_carry(p.Ssta, p.s5_a_re, p.s5_a_im, p.s5_log_dt, p.HP, bid, otid());
  gbar(p.BAR, 2u * (unsigned)nblk);
  asm volatile("" : "+s"(bid));
  ph_s5_p3(p.x, p.ctx, mod0, p.s5_d, p.HP, p.Cin_t, p.Ypart, p.Gbf, bid, lds);
  gbar(p.BAR, 3u * (unsigned)nblk);
  asm volatile("" : "+s"(bid));
  {
    ChainP cp{p.Gbf, p.Wt_glu, p.Wt_o0, p.Wt_q0, p.Vbf, (bf16_t*)p.OQ + (size_t)bid * 66 * D, p.x, p.ctx, mod0, p.ln_g, p.ln_b, p.H1, p.Tbf, (bf16_t*)p.OQ + (size_t)bid * 66 * D  };
    ph_chainA<true>(cp, bid, lds);
    __syncthreads();
    ph_route(RouteP{(bf16_t*)p.OQ + (size_t)bid * 66 * D, p.Khi, p.IDX, p.GATE, 66, 0}, bid, lds);
    __syncthreads();
    GatherP gp{p.Tbf, p.IDX, p.GATE, p.U0, p.V0, p.SU0, p.SV0, p.H1, mod0, p.ln_g + D, p.ln_b + D, p.H2, mod1};
    ph_gather_tm<false>(gp, bid * 66, 66, lds, p.PART + (size_t)bid * 8 * PARTW);
    __syncthreads();
    ProjP pp{p.Wt_cat, p.Wt_uq, p.Wt_ukv, p.mla_q_norm, p.mla_kv_norm, p.OQ  , p.Qa, p.Kn, p.Kr, p.Va};
    ph_mla_proj(pp, bid, lds);
  }
  gbar(p.BAR, 4u * (unsigned)nblk);
  asm volatile("" : "+s"(bid));
  ph_attn(p.Qa, p.Kn, p.Kr, p.Va, p.AObf, bid, nblk, lds);
  gbar(p.BAR, 5u * (unsigned)nblk);
  asm volatile("" : "+s"(bid));
  {
    ChainP cp{p.AObf, nullptr, p.Wt_o1, p.Wt_q1, nullptr, (bf16_t*)p.OQ + (size_t)bid * 64 * D, p.H2, p.H2 + (size_t)NL * D, mod1, p.ln_g + 2 * D, p.ln_b + 2 * D, p.H3, p.Tbf1, (bf16_t*)p.OQ + (size_t)bid * 64 * D};
    ph_chainA<false>(cp, bid, lds);
    __syncthreads();
    ph_route(RouteP{(bf16_t*)p.OQ + (size_t)bid * 64 * D, p.Khi1, p.IDX, p.GATE, 64, 0}, bid, lds);
    __syncthreads();
    GatherP gp{p.Tbf1, p.IDX, p.GATE, p.U1, p.V1, p.SU1, p.SV1, p.H3, mod1, p.ln_g + 3 * D, p.ln_b + 3 * D, p.out, mod1};
    ph_gather_tm<true>(gp, bid * 64, 64, lds, p.PART + (size_t)bid * 8 * PARTW);
  }
}

extern "C" void kernel_launch(void* const* d_in, const int* in_sizes, int n_in, void* d_out, int out_size, void* d_ws, size_t ws_size, hipStream_t stream) {
  MP p{};
  const float** in = (const float**)&p;
  for (int i = 0; i < 29; ++i) in[i] = (const float*)d_in[i];
  p.out = (float*)d_out;
  char* ws = (char*)d_ws; size_t off = 0;
  auto carve = [&](size_t bytes) { char* q = ws + off; off += (bytes + 255) / 256 * 256; return q; };
  const size_t TDB = (size_t)1024 * 16384 * 2, BIG = (size_t)NT * D * 4, HALF = (size_t)NT * D * 2;
  p.MOD = (float*)carve(2 * 3 * 6144 * 4);
  p.Wt_glu = (bf16_t*)carve((size_t)D * D * 2); p.Wt_o0 = (bf16_t*)carve((size_t)D * D * 2); p.Wt_q0 = (bf16_t*)carve((size_t)D * D * 2);
  p.Wt_o1 = (bf16_t*)carve((size_t)D * D * 2); p.Wt_q1 = (bf16_t*)carve((size_t)D * D * 2);
  p.Wt_cat = (bf16_t*)carve((size_t)704 * D * 2); p.Wt_uq = (bf16_t*)carve((size_t)1536 * 384 * 2); p.Wt_ukv = (bf16_t*)carve((size_t)2048 * 256 * 2);
  p.Khi = (bf16_t*)carve((size_t)2 * 131072 * 2); p.Khi1 = p.Khi + 131072;
  char* T0 = carve(TDB); p.U0 = (unsigned char*)T0; p.V0 = (unsigned char*)(T0 + TDB / 2); p.AObf = (bf16_t*)T0;
  p.SU0 = (float*)carve(16384 * 4); p.SV0 = (float*)carve(16384 * 4); p.SU1 = (float*)carve(16384 * 4); p.SV1 = (float*)carve(16384 * 4);
  const size_t KTAB_B = (size_t)64 * 127 * 256 * 2, BST_B = (size_t)64 * 256 * 1024 * 2, KN_B = (size_t)NB * 8 * KEYS * 128 * 2, KR_B = (size_t)NB * KEYS * 64 * 2;
  size_t x1 = KTAB_B + 2 * BST_B; if (x1 < 2 * KN_B + KR_B) x1 = 2 * KN_B + KR_B;
  char* X1 = carve(x1);
  p.Ktab = (bf16_t*)X1; p.Bst_t = (bf16_t*)(X1 + KTAB_B); p.Cin_t = (bf16_t*)(X1 + KTAB_B + BST_B);
  p.Kn = (unsigned char*)X1; p.Va = (unsigned char*)(X1 + KN_B); p.Kr = (unsigned char*)(X1 + 2 * KN_B); p.H3 = (float*)X1;
  char* X2 = carve(BIG); p.Ypart = (bf16_t*)X2; p.OQ = (float*)X2;
  char* X3 = carve(HALF); p.Ssta = (float*)X3; p.HP = (bf16_t*)(X3 + (size_t)NCC * 64 * 256 * 4); p.Vbf = (bf16_t*)X3;
  char* X4 = carve(HALF); p.Gbf = (bf16_t*)X4; p.Tbf = (bf16_t*)X4; p.Tbf1 = (bf16_t*)X4;
  char* X5 = carve(BIG); p.H1 = (float*)X5;
  char* T1 = carve(TDB); p.U1 = (unsigned char*)T1; p.V1 = (unsigned char*)(T1 + TDB / 2);
  p.H2 = (float*)carve(BIG);
  p.IDX = (int*)carve((size_t)NT * 128 * 4); p.GATE = (float*)carve((size_t)NT * 128 * 4);
  p.Qa = (bf16_t*)carve((size_t)NB * 8 * SEQ * 192 * 2);
  p.BAR = (unsigned*)carve(256);
  p.PART = (float*)carve((size_t)256 * 8 * PARTW * 4);
  if (off > ws_size || n_in != 29) { fprintf(stderr, "kernel_launch: workspace too small (need %zu, have %zu) or n_in %d != 29\n", off, ws_size, n_in); return; }
  static int grid_blocks = 0;
  if (!grid_blocks) {
    int dev = 0, cus = 0, per_cu = 0;
    hipGetDevice(&dev);
    hipDeviceGetAttribute(&cus, hipDeviceAttributeMultiprocessorCount, dev);
    hipOccupancyMaxActiveBlocksPerMultiprocessor(&per_cu, mega, 512, 0);
    if (per_cu < 1 || cus < 256) { fprintf(stderr, "kernel_launch: need 256 resident workgroups (cus %d, per_cu %d)\n", cus, per_cu); return; }
    grid_blocks = 256;
  }
  hipMemsetAsync(p.BAR, 0, 256, stream);
  void* args[] = {&p};
  hipError_t e = hipLaunchCooperativeKernel((void*)mega, dim3(grid_blocks), dim3(512), args, 0, stream);
  if (e != hipSuccess) fprintf(stderr, "cooperative launch failed: %s\n", hipGetErrorString(e));
}
```

```cpp
#include <hip/hip_runtime.h>
#include <math.h>
#include <hip/hip_cooperative_groups.h>
#include <cstdio>
namespace cg = cooperative_groups;
__device__ __forceinline__ int otid() { int t = (int)__builtin_amdgcn_workitem_id_x(); asm volatile("" : "+v"(t)); return t; }

constexpr int D = 1024, NB = 2, SEQ = 8192, CTX = 256;
constexpr int NL = NB * SEQ, NC = NB * CTX, NT = NL + NC;
constexpr float ALPHA = 1.4142135623730951f;
constexpr float LN_EPS = 1e-5f, RMS_EPS = 1e-6f;

__device__ __forceinline__ float wave_sum_dpp(float v) {
  v += __uint_as_float(__builtin_amdgcn_update_dpp(0u, __float_as_uint(v), 0xB1, 0xF, 0xF, true));
  v += __uint_as_float(__builtin_amdgcn_update_dpp(0u, __float_as_uint(v), 0x4E, 0xF, 0xF, true));
  v += __uint_as_float(__builtin_amdgcn_update_dpp(0u, __float_as_uint(v), 0x141, 0xF, 0xF, true));
  v += __uint_as_float(__builtin_amdgcn_update_dpp(0u, __float_as_uint(v), 0x140, 0xF, 0xF, true));
  v += __uint_as_float(__builtin_amdgcn_update_dpp(0u, __float_as_uint(v), 0x142, 0xA, 0xF, true));
  v += __uint_as_float(__builtin_amdgcn_update_dpp(0u, __float_as_uint(v), 0x143, 0xC, 0xF, true));
  return __uint_as_float((unsigned)__builtin_amdgcn_readlane((int)__float_as_uint(v), 63));
}
__device__ __forceinline__ float wave_sum(float v) { return wave_sum_dpp(v); }
__device__ __forceinline__ float wave_max_dpp(float v) {
  v = fmaxf(v, __uint_as_float(__builtin_amdgcn_update_dpp(0u, __float_as_uint(v), 0xB1, 0xF, 0xF, true)));
  v = fmaxf(v, __uint_as_float(__builtin_amdgcn_update_dpp(0u, __float_as_uint(v), 0x4E, 0xF, 0xF, true)));
  v = fmaxf(v, __uint_as_float(__builtin_amdgcn_update_dpp(0u, __float_as_uint(v), 0x141, 0xF, 0xF, true)));
  v = fmaxf(v, __uint_as_float(__builtin_amdgcn_update_dpp(0u, __float_as_uint(v), 0x140, 0xF, 0xF, true)));
  v = fmaxf(v, __uint_as_float(__builtin_amdgcn_update_dpp(0u, __float_as_uint(v), 0x142, 0xA, 0xF, true)));
  v = fmaxf(v, __uint_as_float(__builtin_amdgcn_update_dpp(0u, __float_as_uint(v), 0x143, 0xC, 0xF, true)));
  return __uint_as_float((unsigned)__builtin_amdgcn_readlane((int)__float_as_uint(v), 63));
}
__device__ __forceinline__ int row_vec(int row) { return row < NL ? (row >> 13) : 2; }
__device__ __forceinline__ float gelu_exact(float x) { return 0.5f * x * (1.f + erff(x * 0.70710678118654752f)); }
__device__ __forceinline__ float gelu_fast(float x) {
  const float z = fabsf(x) * 0.70710678118654752f;
  const float t = __builtin_amdgcn_rcpf(fmaf(0.3275911f, z, 1.f));
  float pl = fmaf(1.061405429f, t, -1.453152027f); pl = fmaf(pl, t, 1.421413741f); pl = fmaf(pl, t, -0.284496736f); pl = fmaf(pl, t, 0.254829592f);
  const float e = __builtin_amdgcn_exp2f(-z * z * 1.4426950408889634f);
  const float erfa = 1.f - pl * t * e;
  const float hx = 0.5f * x;
  return hx + fabsf(hx) * erfa;
}


typedef unsigned short bf16_t;
using bf16x8 = __attribute__((ext_vector_type(8))) short;
using f32x4 = __attribute__((ext_vector_type(4))) float;
__device__ __forceinline__ bf16_t f2bf(float f) { unsigned u = __float_as_uint(f); u += 0x7FFFu + ((u >> 16) & 1u); return (bf16_t)(u >> 16); }
__device__ __forceinline__ unsigned char f2fp8(float v) { return (unsigned char)(__builtin_amdgcn_cvt_pk_fp8_f32(v, v, 0, false) & 0xFF); }
__device__ __forceinline__ float bf2f(bf16_t h) { return __uint_as_float(((unsigned)h) << 16); }
__device__ __forceinline__ unsigned pack2bf(float lo, float hi) { return (unsigned)f2bf(lo) | ((unsigned)f2bf(hi) << 16); }
__device__ __forceinline__ float bflo(unsigned w) { return __uint_as_float(w << 16); }
__device__ __forceinline__ float bfhi(unsigned w) { return __uint_as_float(w & 0xFFFF0000u); }


constexpr int LDA_B = 1024 * 2 + 16;
template <int RT, int K>
__device__ __forceinline__ void gemm_unit(const char* const (&ap)[RT], const bf16_t* __restrict__ w0, const bf16_t* __restrict__ w1, int kmul, f32x4 (&acc)[RT][2]) {
  constexpr int KI = K / 128, NS = 2;
#pragma unroll
  for (int t = 0; t < RT; ++t) { acc[t][0] = f32x4{0.f, 0.f, 0.f, 0.f}; acc[t][1] = f32x4{0.f, 0.f, 0.f, 0.f}; }
  bf16x8 b[NS][4][2];
#pragma unroll
  for (int st = 0; st < NS - 1; ++st) {
    if (st < KI) {
#pragma unroll
      for (int s2 = 0; s2 < 4; ++s2) { b[st][s2][0] = *(const bf16x8*)(w0 + (st * 128 + s2 * 32) * kmul); b[st][s2][1] = *(const bf16x8*)(w1 + (st * 128 + s2 * 32) * kmul); }
    }
  }
  asm volatile("" ::: "memory");
  bf16x8 an[RT];
#pragma unroll
  for (int t = 0; t < RT; ++t) an[t] = *(const bf16x8*)(ap[t]);
#pragma unroll
  for (int it = 0; it < KI; ++it) {
    if (it + NS - 1 < KI) {
#pragma unroll
      for (int s2 = 0; s2 < 4; ++s2) {
        b[(it + NS - 1) % NS][s2][0] = *(const bf16x8*)(w0 + ((it + NS - 1) * 128 + s2 * 32) * kmul);
        b[(it + NS - 1) % NS][s2][1] = *(const bf16x8*)(w1 + ((it + NS - 1) * 128 + s2 * 32) * kmul);
      }
    }
    asm volatile("" ::: "memory");
#pragma unroll
    for (int s2 = 0; s2 < 4; ++s2) {
      bf16x8 ac[RT];
#pragma unroll
      for (int t = 0; t < RT; ++t) ac[t] = an[t];
      if (it * 4 + s2 + 1 < KI * 4) {
#pragma unroll
        for (int t = 0; t < RT; ++t) an[t] = *(const bf16x8*)(ap[t] + (it * 128 + s2 * 32 + 32) * 2);
      }
#pragma unroll
      for (int t = 0; t < RT; ++t) {
        acc[t][0] = __builtin_amdgcn_mfma_f32_16x16x32_bf16(ac[t], b[it % NS][s2][0], acc[t][0], 0, 0, 0);
        acc[t][1] = __builtin_amdgcn_mfma_f32_16x16x32_bf16(ac[t], b[it % NS][s2][1], acc[t][1], 0, 0, 0);
      }
    }
  }
}
template <int RT, int K, class Epi>
__device__ __forceinline__ void gemm_ldsA(const char* As, int lda_b, int nrows, const bf16_t* __restrict__ Wt, int N, Epi epi) {
  const int wave = otid() >> 6, lane = otid() & 63, l15 = lane & 15, q = lane >> 4;
  const char* ap[RT];
#pragma unroll
  for (int t = 0; t < RT; ++t) { int r = t * 16 + l15; r = r < nrows ? r : nrows - 1; ap[t] = As + r * lda_b + q * 16; }
#pragma unroll 1
  for (int unit = wave; unit < (N >> 5); unit += 8) {
    const int n0 = unit * 32;
    const bf16_t* w0 = Wt + (size_t)(n0 >> 4) * K * 16 + lane * 8;
    f32x4 acc[RT][2];
    gemm_unit<RT, K>(ap, w0, w0 + (size_t)K * 16, 16, acc);
#pragma unroll
    for (int t = 0; t < RT; ++t)
#pragma unroll
      for (int j = 0; j < 2; ++j)
#pragma unroll
        for (int r = 0; r < 4; ++r) {
          const int row = t * 16 + q * 4 + r, col = n0 + j * 16 + l15;
          if (row < nrows) epi(row, col, acc[t][j][r]);
        }
  }
}
struct EpiBF16 { bf16_t* C; int ldc; __device__ __forceinline__ void operator()(int row, int col, float v) const { C[(size_t)row * ldc + col] = f2bf(v); } };
struct EpiF32 { float* C; int ldc; __device__ __forceinline__ void operator()(int row, int col, float v) const { C[(size_t)row * ldc + col] = v; } };
struct EpiGluL { const char* As; bf16_t* V; __device__ __forceinline__ void operator()(int row, int col, float z) const {
  const float g = bf2f(*(const bf16_t*)(As + row * LDA_B + col * 2)); V[(size_t)row * D + col] = f2bf(g / (1.f + expf(-z))); } };

__device__ __forceinline__ void load_rows_lds(char* As, const bf16_t* __restrict__ src, int nrows) {
  const int t = otid(), total = nrows * 128;
#pragma unroll
  for (int h = 0; h < 2; ++h) {
    uint4 v[9];
#pragma unroll
    for (int k = 0; k < 9; ++k) { int i = t + (h * 9 + k) * 512; i = i < total ? i : total - 1; v[k] = *(const uint4*)(src + (size_t)(i >> 7) * D + (i & 127) * 8); }
#pragma unroll
    for (int k = 0; k < 9; ++k) { const int i = t + (h * 9 + k) * 512; if (i < total) *(uint4*)(As + (i >> 7) * LDA_B + (i & 127) * 16) = v[k]; }
  }
}
__device__ __forceinline__ void ln_rows(char* As, int g0, int nrows, const float* Hl, const float* Hc, const bf16_t* __restrict__ O,
                                        const float* __restrict__ mod, int gate_i, const float* __restrict__ lng, const float* __restrict__ lnb,
                                        float* Hout, bf16_t* __restrict__ Tbf, int shift_i, int scale_i) {
  const int wave = otid() >> 6, lane = otid() & 63;
  for (int rr = wave; rr < nrows; rr += 8) {
    const int row = g0 + rr;
    const float* hin = row < NL ? Hl + (size_t)row * D : Hc + (size_t)(row - NL) * D;
    const bf16_t* f = O + (size_t)row * D;
    const float* m = mod + row_vec(row) * 6144;
    const float* gm = m + gate_i * 1024;
    float r[16]; float s = 0.f;
#pragma unroll
    for (int i = 0; i < 4; ++i) {
      const int d = i * 256 + lane * 4;
      const uint2 fw = *(const uint2*)(f + d);
      float4 h4 = *(const float4*)(hin + d), f4 = make_float4(bflo(fw.x), bfhi(fw.x), bflo(fw.y), bfhi(fw.y)), g4 = *(const float4*)(gm + d);
      r[i * 4 + 0] = ALPHA * h4.x + g4.x * f4.x; r[i * 4 + 1] = ALPHA * h4.y + g4.y * f4.y;
      r[i * 4 + 2] = ALPHA * h4.z + g4.z * f4.z; r[i * 4 + 3] = ALPHA * h4.w + g4.w * f4.w;
      s += r[i * 4 + 0] + r[i * 4 + 1] + r[i * 4 + 2] + r[i * 4 + 3];
    }
    const float mu = wave_sum(s) * (1.f / D);
    float vs = 0.f;
#pragma unroll
    for (int i = 0; i < 16; ++i) { float dlt = r[i] - mu; vs += dlt * dlt; }
    const float rstd = rsqrtf(wave_sum(vs) * (1.f / D) + LN_EPS);
#pragma unroll
    for (int i = 0; i < 4; ++i) {
      const int d = i * 256 + lane * 4;
      float4 g4 = *(const float4*)(lng + d), b4 = *(const float4*)(lnb + d);
      float4 o;
      o.x = (r[i * 4 + 0] - mu) * rstd * g4.x + b4.x; o.y = (r[i * 4 + 1] - mu) * rstd * g4.y + b4.y;
      o.z = (r[i * 4 + 2] - mu) * rstd * g4.z + b4.z; o.w = (r[i * 4 + 3] - mu) * rstd * g4.w + b4.w;
      *(float4*)(Hout + (size_t)row * D + d) = o;
      float4 sh = *(const float4*)(m + shift_i * 1024 + d), sc = *(const float4*)(m + scale_i * 1024 + d);
      const float t0 = o.x * (1.f + sc.x) + sh.x, t1 = o.y * (1.f + sc.y) + sh.y, t2 = o.z * (1.f + sc.z) + sh.z, t3 = o.w * (1.f + sc.w) + sh.w;
      uint2 w; w.x = pack2bf(t0, t1); w.y = pack2bf(t2, t3);
      *(uint2*)(As + rr * LDA_B + d * 2) = w;
      *(uint2*)(Tbf + (size_t)row * D + d) = w;

    }
  }
}


constexpr int S5T = 64, NCHUNK = (CTX + SEQ) / S5T  , NCC = NB * NCHUNK  ;
__device__ __forceinline__ int s5_token(int cc, int s) {
  const int b = cc / NCHUNK, ch = cc - b * NCHUNK;
  return ch < 4 ? NL + b * CTX + ch * S5T + s : b * SEQ + (ch - 4) * S5T + s;
}
__device__ __forceinline__ void cbar(volatile int* cnt, int& gen, int nwaves) {
  __builtin_amdgcn_fence(__ATOMIC_RELEASE, "workgroup");
  if ((otid() & 63) == 0) __hip_atomic_fetch_add((int*)cnt, 1, __ATOMIC_RELAXED, __HIP_MEMORY_SCOPE_WORKGROUP);
  ++gen;
  while (__hip_atomic_load((int*)cnt, __ATOMIC_RELAXED, __HIP_MEMORY_SCOPE_WORKGROUP) < gen * nwaves) __builtin_amdgcn_s_sleep(1);
  __builtin_amdgcn_fence(__ATOMIC_ACQUIRE, "workgroup");
}
__device__ __forceinline__ void ph_s5_prep(const float* __restrict__ a_re, const float* __restrict__ a_im, const float* __restrict__ log_dt,
                                                 const float* __restrict__ b_re, const float* __restrict__ b_im, const float* __restrict__ c_re, const float* __restrict__ c_im,
                                                 bf16_t* __restrict__ Ktab, bf16_t* __restrict__ Bst_t, bf16_t* __restrict__ Cin_t, int g, int part, char* lds, int tid, int nct, volatile int* cbc, int& cgen) {
  float2 (*pw)[65][64] = reinterpret_cast<float2 (*)[65][64]>(lds);
  float2 (*Bp)[64][16] = reinterpret_cast<float2 (*)[64][16]>(lds + 2 * 65 * 64 * 8);
  float2 (*Cc)[16][64] = reinterpret_cast<float2 (*)[16][64]>(lds + 2 * 65 * 64 * 8 + 2 * 64 * 16 * 8);
  float2 (*fs)[64] = reinterpret_cast<float2 (*)[64]>(lds + 2 * 65 * 64 * 8 + 2 * 64 * 16 * 8 + 2 * 16 * 64 * 8);
  if (tid < 128) {
    const int dir = tid >> 6, p = tid & 63, gp = (dir * 64 + g) * 64 + p;
    const float are = a_re[gp], aim = a_im[gp], dt = expf(log_dt[dir * 64 + g]);
    const float mag = expf(are * dt);
    const float abr = mag * cosf(aim * dt), abi = mag * sinf(aim * dt);
    const float nr = abr - 1.f, ni = abi, den = are * are + aim * aim;
    fs[dir][p] = make_float2((nr * are + ni * aim) / den, (ni * are - nr * aim) / den);
    float pr = 1.f, pi = 0.f;
    for (int e = 0; e <= 64; ++e) { pw[dir][e][p] = make_float2(pr, pi); const float nr2 = pr * abr - pi * abi, ni2 = pr * abi + pi * abr; pr = nr2; pi = ni2; }
  }
  cbar(cbc, cgen, nct >> 6);
  for (int i = tid; i < 2048; i += nct) {
    const int dir = i >> 10, p = (i >> 4) & 63, ci = i & 15;
    const size_t gi = ((size_t)(dir * 64 + g) * 64 + p) * 16 + ci;
    const float br = b_re[gi], bi = b_im[gi]; const float2 f = fs[dir][p];
    Bp[dir][p][ci] = make_float2(f.x * br - f.y * bi, f.x * bi + f.y * br);
    const int co = (i >> 6) & 15, p2 = i & 63;
    const size_t ci2 = ((size_t)(dir * 64 + g) * 16 + co) * 64 + p2;
    Cc[dir][co][p2] = make_float2(c_re[ci2], c_im[ci2]);
  }
  cbar(cbc, cgen, nct >> 6);
  for (int i = part * 508 + tid; i < (part + 1) * 508; i += nct) {
    const int ti = i >> 4, co = i & 15, tau = ti - 63;
    float acc[16];
#pragma unroll
    for (int ci = 0; ci < 16; ++ci) acc[ci] = 0.f;
    if (tau >= 0) {
      for (int p = 0; p < 64; ++p) {
        const float2 c = Cc[0][co][p], w = pw[0][tau][p];
        const float xr = c.x * w.x - c.y * w.y, xi = c.x * w.y + c.y * w.x;
#pragma unroll
        for (int ci = 0; ci < 16; ++ci) { const float2 bb = Bp[0][p][ci]; acc[ci] += xr * bb.x - xi * bb.y; }
      }
    }
    if (tau <= 0) {
      for (int p = 0; p < 64; ++p) {
        const float2 c = Cc[1][co][p], w = pw[1][-tau][p];
        const float xr = c.x * w.x - c.y * w.y, xi = c.x * w.y + c.y * w.x;
#pragma unroll
        for (int ci = 0; ci < 16; ++ci) { const float2 bb = Bp[1][p][ci]; acc[ci] += xr * bb.x - xi * bb.y; }
      }
    }
    uint4 o0, o1;
    o0.x = pack2bf(acc[0], acc[1]); o0.y = pack2bf(acc[2], acc[3]); o0.z = pack2bf(acc[4], acc[5]); o0.w = pack2bf(acc[6], acc[7]);
    o1.x = pack2bf(acc[8], acc[9]); o1.y = pack2bf(acc[10], acc[11]); o1.z = pack2bf(acc[12], acc[13]); o1.w = pack2bf(acc[14], acc[15]);
    bf16_t* kp = Ktab + (size_t)g * 127 * 256 + (size_t)i * 16;
    *(uint4*)kp = o0; *(uint4*)(kp + 8) = o1;
  }
  for (int i = part * 8192 + tid; i < (part + 1) * 8192; i += nct) {
    const int n = (i >> 11) * 16 + (i & 15), k8 = ((i >> 6) & 31) * 4 + ((i >> 4) & 3);
    const int dir = n >> 7, c = (n >> 6) & 1, p = n & 63, sidx = k8 >> 1, ci0 = (k8 & 1) * 8;
    const float2 w = pw[dir][dir == 0 ? 63 - sidx : sidx][p];
    float v[8];
#pragma unroll
    for (int j = 0; j < 8; ++j) { const float2 b = Bp[dir][p][ci0 + j]; v[j] = c == 0 ? (w.x * b.x - w.y * b.y) : (w.x * b.y + w.y * b.x); }
    uint4 o; o.x = pack2bf(v[0], v[1]); o.y = pack2bf(v[2], v[3]); o.z = pack2bf(v[4], v[5]); o.w = pack2bf(v[6], v[7]);
    *(uint4*)(Bst_t + (size_t)g * 256 * 1024 + (size_t)i * 8) = o;
  }
  for (int i = part * 8192 + tid; i < (part + 1) * 8192; i += nct) {
    const int n = (i >> 9) * 16 + (i & 15), k8 = ((i >> 6) & 7) * 4 + ((i >> 4) & 3);
    const int t = n >> 4, co = n & 15, dir = k8 >> 4, c = (k8 >> 3) & 1, p0 = (k8 & 7) * 8;
    const int e = dir == 0 ? t + 1 : 64 - t;
    float v[8];
#pragma unroll
    for (int j = 0; j < 8; ++j) { const float2 cc = Cc[dir][co][p0 + j], w = pw[dir][e][p0 + j];
      v[j] = c == 0 ? (cc.x * w.x - cc.y * w.y) : -(cc.x * w.y + cc.y * w.x); }
    uint4 o; o.x = pack2bf(v[0], v[1]); o.y = pack2bf(v[2], v[3]); o.z = pack2bf(v[4], v[5]); o.w = pack2bf(v[6], v[7]);
    *(uint4*)(Cin_t + (size_t)g * 1024 * 256 + (size_t)i * 8) = o;
  }
}
__device__ __forceinline__ void ph_s5_p1(const float* __restrict__ x, const float* __restrict__ ctx, const float* __restrict__ mod,
                                               const bf16_t* __restrict__ Ktab, const bf16_t* __restrict__ Bst_t, bf16_t* __restrict__ Ypart, float* __restrict__ S, int bid, char* As) {
  const int g = bid >> 2, cc0 = (bid & 3) * 66, tid = otid();
  const int wave = tid >> 6, lane = tid & 63, l15 = lane & 15, q = lane >> 4;
#pragma unroll 4
  for (int i = tid; i < 66 * 64 * 2; i += 512) {
    const int half = i & 1, sidx = (i >> 1) & 63, r = i >> 7;
    const int tok = s5_token(cc0 + r, sidx), ch = g * 16 + half * 8;
    const float* src = (tok < NL ? x + (size_t)tok * D : ctx + (size_t)(tok - NL) * D) + ch;
    const float* m = mod + row_vec(tok) * 6144;
    const float4 a = *(const float4*)src, b = *(const float4*)(src + 4);
    const float4 sh0 = *(const float4*)(m + ch), sh1 = *(const float4*)(m + ch + 4), sc0 = *(const float4*)(m + 1024 + ch), sc1 = *(const float4*)(m + 1024 + ch + 4);
    uint4 o;
    o.x = pack2bf(a.x * (1.f + sc0.x) + sh0.x, a.y * (1.f + sc0.y) + sh0.y); o.y = pack2bf(a.z * (1.f + sc0.z) + sh0.z, a.w * (1.f + sc0.w) + sh0.w);
    o.z = pack2bf(b.x * (1.f + sc1.x) + sh1.x, b.y * (1.f + sc1.y) + sh1.y); o.w = pack2bf(b.z * (1.f + sc1.z) + sh1.z, b.w * (1.f + sc1.w) + sh1.w);
    *(uint4*)(As + r * LDA_B + sidx * 32 + half * 16) = o;
  }
  __syncthreads();
  const char* ap[5];
#pragma unroll
  for (int t = 0; t < 5; ++t) { int r = t * 16 + l15; r = r < 66 ? r : 65; ap[t] = As + r * LDA_B + q * 16; }
  const bf16_t* Kg = Ktab + (size_t)g * 127 * 256;
#pragma unroll 1
  for (int unit = wave; unit < 40; unit += 8) {
    f32x4 acc[5][2];
    if (unit < 32) {
      const int t0 = unit * 2;
      const bf16_t* w0 = Kg + (t0 + 63 - (q >> 1)) * 256 + l15 * 16 + (q & 1) * 8;
      gemm_unit<5, 1024>(ap, w0, w0 + 256, -16, acc);
#pragma unroll
      for (int t = 0; t < 5; ++t)
#pragma unroll
        for (int j = 0; j < 2; ++j)
#pragma unroll
          for (int r = 0; r < 4; ++r) {
            const int row = t * 16 + q * 4 + r;
            if (row < 66) Ypart[(size_t)s5_token(cc0 + row, t0 + j) * D + g * 16 + l15] = f2bf(acc[t][j][r]);
          }
    } else {
      const int n0 = (unit - 32) * 32;
      const bf16_t* w0 = Bst_t + (size_t)g * 256 * 1024 + (size_t)(n0 >> 4) * 1024 * 16 + lane * 8;
      gemm_unit<5, 1024>(ap, w0, w0 + 1024 * 16, 16, acc);
#pragma unroll
      for (int t = 0; t < 5; ++t)
#pragma unroll
        for (int j = 0; j < 2; ++j)
#pragma unroll
          for (int r = 0; r < 4; ++r) {
            const int row = t * 16 + q * 4 + r;
            if (row < 66) S[((size_t)(cc0 + row) * 64 + g) * 256 + n0 + j * 16 + l15] = acc[t][j][r];
          }
    }
  }
}
__device__ __forceinline__ void ph_s5_carry(const float* __restrict__ S, const float* __restrict__ a_re, const float* __restrict__ a_im,
                                                 const float* __restrict__ log_dt, bf16_t* __restrict__ HP, int id, int p) {
  const int dir = id & 1, g = (id >> 1) & 63, b = id >> 7;
  const int gp = (dir * 64 + g) * 64 + p;
  const float are = a_re[gp], aim = a_im[gp], dt = expf(log_dt[dir * 64 + g]);
  const float mag = expf(are * dt);
  float tr = mag * cosf(aim * dt), ti = mag * sinf(aim * dt);
#pragma unroll
  for (int i = 0; i < 6; ++i) { const float nr = tr * tr - ti * ti, ni = 2.f * tr * ti; tr = nr; ti = ni; }
  float hr = 0.f, hi = 0.f;
#pragma unroll 12
  for (int step = 0; step < NCHUNK; ++step) {
    const int c = dir == 0 ? step : (step < 4 ? 3 - step : NCHUNK - 1 - (step - 4));
    const size_t base = ((size_t)(b * NCHUNK + c) * 64 + g) * 256 + dir * 128 + p;
    HP[base] = f2bf(hr); HP[base + 64] = f2bf(hi);
    const float sr = S[base], si = S[base + 64];
    const float nr = tr * hr - ti * hi + sr, ni = tr * hi + ti * hr + si;
    hr = nr; hi = ni;
  }
}
struct EpiS5 { const float* x; const float* ctx; const bf16_t* Ypart; bf16_t* Gbf; const float* cst; int cc0; int ch;
  __device__ __forceinline__ void operator()(int row, int col, float v) const {
    const int tok = s5_token(cc0 + row, col >> 4), vi = row_vec(tok);
    const float xin = tok < NL ? x[(size_t)tok * D + ch] : ctx[(size_t)(tok - NL) * D + ch];
    const float mm = xin * (1.f + cst[1 + vi * 2]) + cst[2 + vi * 2];
    const float y = v + bf2f(Ypart[(size_t)tok * D + ch]) + cst[0] * mm;
    Gbf[(size_t)tok * D + ch] = f2bf(gelu_fast(y));
  } };
__device__ __forceinline__ void ph_s5_p3(const float* __restrict__ x, const float* __restrict__ ctx, const float* __restrict__ mod, const float* __restrict__ dvec,
                                               const bf16_t* __restrict__ HP, const bf16_t* __restrict__ Cin_t, const bf16_t* __restrict__ Ypart, bf16_t* __restrict__ Gbf, int bid, char* As) {
  const int g = bid >> 2, cc0 = (bid & 3) * 66, tid = otid();
  for (int i = tid; i < 66 * 32; i += 512) {
    const int r = i >> 5, c = i & 31;
    *(uint4*)(As + r * 528 + c * 16) = *(const uint4*)(HP + ((size_t)(cc0 + r) * 64 + g) * 256 + c * 8);
  }
  __syncthreads();
  float* cst = (float*)(As + 66 * 528);
  if (tid < 16) {
    const int c0 = g * 16 + tid;
    cst[tid * 8 + 0] = dvec[c0];
    cst[tid * 8 + 1] = mod[1024 + c0]; cst[tid * 8 + 2] = mod[c0];
    cst[tid * 8 + 3] = mod[6144 + 1024 + c0]; cst[tid * 8 + 4] = mod[6144 + c0];
    cst[tid * 8 + 5] = mod[2 * 6144 + 1024 + c0]; cst[tid * 8 + 6] = mod[2 * 6144 + c0];
  }
  __syncthreads();
  gemm_ldsA<5, 256>(As, 528, 66, Cin_t + (size_t)g * 1024 * 256, 1024, EpiS5{x, ctx, Ypart, Gbf, cst + (otid() & 15) * 8, cc0, g * 16 + (otid() & 15)});
}


struct ChainP {
  const bf16_t* Ain;
  const bf16_t* Wglu_t; const bf16_t* Wo_t; const bf16_t* Wq_t;
  bf16_t* Vbf; bf16_t* O; const float* Hl; const float* Hc; const float* mod; const float* lng; const float* lnb;
  float* Hout; bf16_t* Tbf; bf16_t* Q;
};
template <bool L0>
__device__ __forceinline__ void ph_chainA(const ChainP& p, int bid, char* As) {
  constexpr int NR = L0 ? 66 : 64;
  constexpr int RT = L0 ? 5 : 4;
  const int g0 = bid * NR;
  load_rows_lds(As, p.Ain + (size_t)g0 * D, NR);
  __syncthreads();
  if (L0) {
    gemm_ldsA<RT, 1024>(As, LDA_B, NR, p.Wglu_t, D, EpiGluL{As, p.Vbf + (size_t)g0 * D});
    __syncthreads();
    load_rows_lds(As, p.Vbf + (size_t)g0 * D, NR);
    __syncthreads();
  }
  gemm_ldsA<RT, 1024>(As, LDA_B, NR, p.Wo_t, D, EpiBF16{p.O + (size_t)g0 * D, D});
  __syncthreads();
  ln_rows(As, g0, NR, p.Hl, p.Hc, p.O, p.mod, 2, p.lng, p.lnb, p.Hout, p.Tbf, 3, 4);
  __syncthreads();
  gemm_ldsA<RT, 1024>(As, LDA_B, NR, p.Wq_t, D, EpiBF16{p.Q + (size_t)g0 * D, D});
}


constexpr int KEYS = SEQ + CTX;
constexpr float att_KS = 0.5f;
struct EpiKV { unsigned char* Kn; unsigned char* Vl; int g0; int sh; __device__ __forceinline__ void operator()(int row, int col, float v) const {
  const int head = col >> 8, j = col & 255;
  if (j < 128) {
    const int g = g0 + row; int b, key;
    if (g < NL) { b = g >> 13; key = g & (SEQ - 1); } else { const int cidx = g - NL; b = cidx >> 8; key = SEQ + (cidx & (CTX - 1)); }
    Kn[((size_t)(b * 8 + head) * KEYS + key) * 128 + j] = f2fp8(v * att_KS);
  } else Vl[(head * 128 + (j - 128)) * 68 + row + sh] = f2fp8(v * 4.f);
} };
struct EpiQ { bf16_t* Qa; int g0; int pad; __device__ __forceinline__ void operator()(int row, int col, float v) const {
  const int g = g0 + row, b = g >> 13, n = g & (SEQ - 1);
  const int head = col / 192, j = col - head * 192;
  Qa[((size_t)(b * 8 + head) * SEQ + n) * 192 + j] = f2bf(v);
} };
struct ProjP { const bf16_t* Wcat_t; const bf16_t* Wuq_t; const bf16_t* Wukv_t; const float* q_norm; const float* kv_norm;
               float* PR; bf16_t* Qa; unsigned char* Kn; unsigned char* Kr; unsigned char* Va; };
__device__ __forceinline__ void ph_mla_proj(const ProjP& p, int bid, char* As) {
  const int g0 = bid * 66, wave = otid() >> 6, lane = otid() & 63;
  gemm_ldsA<5, 1024>(As, LDA_B, 66, p.Wcat_t, 704, EpiF32{p.PR + (size_t)g0 * D, D});
  __syncthreads();
  char* A1 = As; char* A2 = As + 66 * 784;
  for (int rr = wave; rr < 66; rr += 8) {
    const int g = g0 + rr;
    const float* pr = p.PR + (size_t)g * D;
    float v[6]; float ss = 0.f;
#pragma unroll
    for (int i = 0; i < 6; ++i) { v[i] = pr[i * 64 + lane]; ss += v[i] * v[i]; }
    float rn = rsqrtf(wave_sum(ss) * (1.f / 384.f) + RMS_EPS);
#pragma unroll
    for (int i = 0; i < 6; ++i) *(bf16_t*)(A1 + rr * 784 + (i * 64 + lane) * 2) = f2bf(v[i] * rn * p.q_norm[i * 64 + lane]);
    float w[4]; ss = 0.f;
#pragma unroll
    for (int i = 0; i < 4; ++i) { w[i] = pr[384 + i * 64 + lane]; ss += w[i] * w[i]; }
    rn = rsqrtf(wave_sum(ss) * (1.f / 256.f) + RMS_EPS);
#pragma unroll
    for (int i = 0; i < 4; ++i) *(bf16_t*)(A2 + rr * 528 + (i * 64 + lane) * 2) = f2bf(w[i] * rn * p.kv_norm[i * 64 + lane]);
    if (lane < 32) {
      float x1 = pr[640 + lane], x2 = pr[672 + lane];
      int b, key;
      if (g < NL) {
        b = g >> 13; key = g & (SEQ - 1);
        const int n = key, rr2 = n >> 6, cc = n & 63;
        const float inv = powf(10000.f, -(float)(lane & 15) / 16.f);
        const float ang = (lane < 16 ? (float)rr2 : (float)cc) * inv;
        const float cs = cosf(ang), sn = sinf(ang);
        const float y1 = x1 * cs - x2 * sn, y2 = x2 * cs + x1 * sn; x1 = y1; x2 = y2;
      } else { const int cidx = g - NL; b = cidx >> 8; key = SEQ + (cidx & (CTX - 1)); }
      unsigned char* kp = p.Kr + ((size_t)b * KEYS + key) * 64;
      kp[lane] = f2fp8(x1 * att_KS); kp[32 + lane] = f2fp8(x2 * att_KS);
    }
  }
  __syncthreads();
  int nq = NL - g0; nq = nq > 66 ? 66 : nq;
  if (nq > 0) gemm_ldsA<5, 384>(A1, 784, nq, p.Wuq_t, 1536, EpiQ{p.Qa, g0, 0});
  unsigned char* Vl = (unsigned char*)As + 66 * 784 + 66 * 528;
  const int sh = g0 & 3;
  gemm_ldsA<5, 256>(A2, 528, 66, p.Wukv_t, 2048, EpiKV{p.Kn, Vl, g0, sh});
  __syncthreads();
  for (int i = otid(); i < 1024 * 17; i += 512) {
    const int dvg = i / 17, q4 = i - dvg * 17, g4 = g0 - sh + 4 * q4;
    const unsigned w = *(const unsigned*)(Vl + dvg * 68 + 4 * q4);
    int b, key;
    if (g4 < NL) { b = g4 >> 13; key = g4 & (SEQ - 1); } else { const int cidx = g4 - NL; b = cidx >> 8; key = SEQ + (cidx & (CTX - 1)); }
    const int m = (key & 63) >> 2, posd = (m & 1) * 8 + (m >> 3) * 4 + ((m >> 1) & 3);
    unsigned char* dst = p.Va + ((size_t)(b * 8 + (dvg >> 7)) * (KEYS / 64) + (key >> 6)) * 8192 + (dvg & 127) * 64 + posd * 4;
    if (g4 >= g0 && g4 + 3 < g0 + 66) *(unsigned*)dst = w;
    else if (g4 < g0) *(unsigned short*)(dst + 2) = (unsigned short)(w >> 16);
    else *(unsigned short*)dst = (unsigned short)(w & 0xFFFFu);
  }
  for (int rr = wave; rr < nq; rr += 8) {
    const int g = g0 + rr, b = g >> 13, n = g & (SEQ - 1);
    if (lane < 32) {
      const float inv = powf(10000.f, -(float)(lane & 15) / 16.f);
      const float ang = (lane < 16 ? (float)(n >> 6) : (float)(n & 63)) * inv;
      const float cs = cosf(ang), sn = sinf(ang);
#pragma unroll
      for (int h = 0; h < 8; ++h) {
        bf16_t* qo = p.Qa + ((size_t)(b * 8 + h) * SEQ + n) * 192;
        const float x1 = bf2f(qo[128 + lane]), x2 = bf2f(qo[160 + lane]);
        qo[128 + lane] = f2bf(x1 * cs - x2 * sn); qo[160 + lane] = f2bf(x2 * cs + x1 * sn);
      }
    }
  }
}

namespace att {
using i32x8 = __attribute__((ext_vector_type(8))) int;
using i32x4 = __attribute__((ext_vector_type(4))) int;
using f32x16 = __attribute__((ext_vector_type(16))) float;
constexpr int KVBLK = 64, KROW = 208, VROW = 80, NTILE = KEYS / 64;
constexpr float KS = 0.5f, VS = 4.f;
constexpr float QS = 0.07216878364870322f * 1.4426950408889634f / KS;
constexpr float THR2 = 3.f * 1.4426950408889634f, PSH = 4.f;
constexpr int SHM_V = 128 * VROW, SHM_K = KVBLK * KROW, NSLOT = 3, SHM_ATTN = NSLOT * (SHM_V + SHM_K) + 8 * 64 * 4;
#define SBAR() __builtin_amdgcn_sched_barrier(0)
__device__ __forceinline__ int crow(int r, int hi) { return (r & 3) + 8 * (r >> 2) + 4 * hi; }
__device__ __forceinline__ f32x16 mfma8(i32x8 a, i32x8 b, f32x16 c) { return __builtin_amdgcn_mfma_scale_f32_32x32x64_f8f6f4(a, b, c, 0, 0, 0, 0, 0, 0); }
__device__ __forceinline__ i32x8 cat8(i32x4 a, i32x4 b) { return __builtin_shufflevector(a, b, 0, 1, 2, 3, 4, 5, 6, 7); }
__device__ __forceinline__ int pk4(float a, float b, float c, float d, int old = 0) { const int w = __builtin_amdgcn_cvt_pk_fp8_f32(a, b, old, false); return __builtin_amdgcn_cvt_pk_fp8_f32(c, d, w, true); }
__device__ __forceinline__ void softmax_tile(f32x16& p0, f32x16& p1, f32x16& bias, bool first, f32x16* o, float* al_l, int r32, int hi, i32x8& pa) {
  float pmax = p0[0];
#pragma unroll
  for (int r = 1; r < 16; ++r) pmax = fmaxf(pmax, p0[r]);
#pragma unroll
  for (int r = 0; r < 16; ++r) pmax = fmaxf(pmax, p1[r]);
  { auto rr = __builtin_amdgcn_permlane32_swap(__float_as_uint(pmax), __float_as_uint(pmax), false, false);
    pmax = fmaxf(__uint_as_float(rr[0]), __uint_as_float(rr[1])); }
  if (__builtin_expect(first || !__all(pmax <= PSH + THR2), 0)) {
    const float delta = first ? pmax - PSH : fmaxf(pmax - PSH, 0.f);
    if (!first) {
      if (hi == 0) al_l[r32] = __builtin_amdgcn_exp2f(-delta);
      asm volatile("s_waitcnt lgkmcnt(0)" ::: "memory");
#pragma unroll
      for (int d = 0; d < 5; ++d)
#pragma unroll
        for (int r = 0; r < 16; ++r) o[d][r] *= al_l[crow(r, hi)];
    }
    const float nb = bias[0] - delta;
#pragma unroll
    for (int r = 0; r < 16; ++r) { p0[r] -= delta; p1[r] -= delta; bias[r] = nb; }
  }
#pragma unroll
  for (int r = 0; r < 16; ++r) p0[r] = __builtin_amdgcn_exp2f(p0[r]);
#pragma unroll
  for (int r = 0; r < 16; ++r) p1[r] = __builtin_amdgcn_exp2f(p1[r]);
#pragma unroll
  for (int w = 0; w < 4; ++w) { pa[w] = pk4(p0[4 * w], p0[4 * w + 1], p0[4 * w + 2], p0[4 * w + 3], pa[w]); pa[4 + w] = pk4(p1[4 * w], p1[4 * w + 1], p1[4 * w + 2], p1[4 * w + 3], pa[4 + w]); }
}
__device__ __forceinline__ void qkt(f32x16& p0, f32x16& p1, const f32x16& bias, const char* Ks, const i32x8* q, int r32, int hi) {
  p0 = bias; p1 = bias;
  const char* k0 = Ks + r32 * KROW + hi * 32; const char* k1 = k0 + 32 * KROW;
#pragma unroll
  for (int s = 0; s < 3; ++s) {
    const i32x8 a0 = cat8(*reinterpret_cast<const i32x4*>(k0 + s * 64), *reinterpret_cast<const i32x4*>(k0 + s * 64 + 16));
    const i32x8 a1 = cat8(*reinterpret_cast<const i32x4*>(k1 + s * 64), *reinterpret_cast<const i32x4*>(k1 + s * 64 + 16));
    p0 = mfma8(a0, q[s], p0);
    p1 = mfma8(a1, q[s], p1); }
}
__device__ __forceinline__ void pv_all(f32x16* o, const char* Vs, i32x8 pa, int r32, int hi) {
  const char* v0 = Vs + r32 * VROW + hi * 32;
#pragma unroll
  for (int d0 = 0; d0 < 4; ++d0) {
    const i32x8 vb = cat8(*reinterpret_cast<const i32x4*>(v0 + d0 * 32 * VROW), *reinterpret_cast<const i32x4*>(v0 + d0 * 32 * VROW + 16));
    o[d0] = mfma8(pa, vb, o[d0]); }
  const i32x8 ones = {0x38383838, 0x38383838, 0x38383838, 0x38383838, 0x38383838, 0x38383838, 0x38383838, 0x38383838};
  o[4] = mfma8(pa, ones, o[4]);
}
__device__ __forceinline__ void attn_body(const bf16_t* __restrict__ Qb, const unsigned char* __restrict__ Kn, const unsigned char* __restrict__ Krb, const unsigned char* __restrict__ Vt,
                                          bf16_t* __restrict__ Ob, char* lds) {
  const int tid = otid(), wid = tid >> 6, lane = tid & 63, r32 = lane & 31, hi = lane >> 5;
  const bool lo4 = __builtin_amdgcn_readfirstlane(wid >> 2) == 0;
  char* V_lds = lds; char* K_lds = lds + NSLOT * SHM_V;
  float* al_l = (float*)(lds + NSLOT * (SHM_V + SHM_K)) + wid * 64;
  f32x16 bias = {}; f32x16 o[5] = {}; i32x8 q[3];
  { const bf16_t* Qw = Qb + (size_t)(wid * 32 + r32) * 192 + hi * 32;
#pragma unroll
    for (int s = 0; s < 3; ++s) {
#pragma unroll
      for (int c = 0; c < 4; ++c) { const uint4 w = *reinterpret_cast<const uint4*>(Qw + s * 64 + c * 8);
        q[s][2 * c] = pk4(bflo(w.x) * QS, bfhi(w.x) * QS, bflo(w.y) * QS, bfhi(w.y) * QS);
        q[s][2 * c + 1] = pk4(bflo(w.z) * QS, bfhi(w.z) * QS, bflo(w.w) * QS, bfhi(w.w) * QS); } } }
  i32x8 ones = {0x38383838, 0x38383838, 0x38383838, 0x38383838, 0x38383838, 0x38383838, 0x38383838, 0x38383838};
  const int vdst = (tid >> 2) * VROW + (tid & 3) * 16, kdst = (tid >> 3) * KROW + (tid & 7) * 16, rdst = (tid >> 2) * KROW + 128 + (tid & 3) * 16;
  const int kfo = r32 * KROW + hi * 32, vfo = r32 * VROW + hi * 32;
  uint4 vs, ks, rs = make_uint4(0u, 0u, 0u, 0u);
#define TLOAD(t) do { ks = *reinterpret_cast<const uint4*>(Kn + (size_t)(t) * 8192 + tid * 16); vs = *reinterpret_cast<const uint4*>(Vt + (size_t)(t) * 8192 + tid * 16); \
    if (lo4) rs = *reinterpret_cast<const uint4*>(Krb + (size_t)(t) * 4096 + tid * 16); } while (0)
#define TWRITE(sl) do { *(uint4*)(K_lds + (sl) * SHM_K + kdst) = ks; *(uint4*)(V_lds + (sl) * SHM_V + vdst) = vs; if (lo4) *(uint4*)(K_lds + (sl) * SHM_K + rdst) = rs; } while (0)
#define SWAIT() asm volatile("s_waitcnt vmcnt(0)" ::: "memory")
#define LD4(p) (*reinterpret_cast<const i32x4*>(p))
  f32x16 p0, p1; i32x8 pa = {};
  TLOAD(0); SWAIT(); TWRITE(0);
  TLOAD(1); SWAIT(); TWRITE(1);
  TLOAD(2);
  __syncthreads();
  int sl = 0, sl2 = 2;
#pragma unroll 1
  for (int i = 0; i < NTILE; ++i) {
    const char* kb = K_lds + sl * SHM_K + kfo; const char* vb = V_lds + sl * SHM_V + vfo;
    SBAR();
    i32x4 ka0 = LD4(kb), ka1 = LD4(kb + 16), ka2 = LD4(kb + 32 * KROW), ka3 = LD4(kb + 32 * KROW + 16);
    i32x4 kb0 = LD4(kb + 64), kb1 = LD4(kb + 80), kb2 = LD4(kb + 32 * KROW + 64), kb3 = LD4(kb + 32 * KROW + 80);
    SBAR();
    p0 = mfma8(cat8(ka0, ka1), q[0], bias); p1 = mfma8(cat8(ka2, ka3), q[0], bias);
    ka0 = LD4(kb + 128); ka1 = LD4(kb + 144); ka2 = LD4(kb + 32 * KROW + 128); ka3 = LD4(kb + 32 * KROW + 144);
    SBAR();
    p0 = mfma8(cat8(kb0, kb1), q[1], p0); p1 = mfma8(cat8(kb2, kb3), q[1], p1);
    i32x4 v00 = LD4(vb), v01 = LD4(vb + 16), v10 = LD4(vb + 32 * VROW), v11 = LD4(vb + 32 * VROW + 16);
    SBAR();
    p0 = mfma8(cat8(ka0, ka1), q[2], p0); p1 = mfma8(cat8(ka2, ka3), q[2], p1);
    SBAR();
    softmax_tile(p0, p1, bias, i == 0, o, al_l, r32, hi, pa);
    SBAR();
    i32x4 v20 = LD4(vb + 64 * VROW), v21 = LD4(vb + 64 * VROW + 16), v30 = LD4(vb + 96 * VROW), v31 = LD4(vb + 96 * VROW + 16);
    o[4] = mfma8(pa, ones, o[4]); o[0] = mfma8(pa, cat8(v00, v01), o[0]); o[1] = mfma8(pa, cat8(v10, v11), o[1]);
    SBAR();
    o[2] = mfma8(pa, cat8(v20, v21), o[2]); o[3] = mfma8(pa, cat8(v30, v31), o[3]);
    SBAR();
    SWAIT();
    if (i + 2 < NTILE) TWRITE(sl2);
    if (i + 3 < NTILE) TLOAD(i + 3);
    sl = sl == NSLOT - 1 ? 0 : sl + 1; sl2 = sl2 == NSLOT - 1 ? 0 : sl2 + 1;
    SBAR(); __syncthreads();
  }
  float rli[16];
#pragma unroll
  for (int r = 0; r < 16; ++r) rli[r] = __builtin_amdgcn_rcpf(o[4][r]) * (1.f / VS);
  bf16_t* Ow = Ob + (size_t)(wid * 32) * D;
#pragma unroll
  for (int r = 0; r < 16; ++r) { const int orow = crow(r, hi);
#pragma unroll
    for (int d0 = 0; d0 < 4; ++d0) Ow[(size_t)orow * D + d0 * 32 + r32] = f2bf(o[d0][r] * rli[r]); }
  __syncthreads();
#undef TLOAD
#undef TWRITE
#undef SWAIT
#undef LD4
}
}

__device__ __forceinline__ void ph_attn(const bf16_t* __restrict__ Qa, const unsigned char* __restrict__ Kn, const unsigned char* __restrict__ Kr, const unsigned char* __restrict__ Vt,
                                        bf16_t* __restrict__ AO, int bid, int nblk, char* lds) {
  for (int item = bid; item < 512; item += nblk) {
    const int b = item >> 8, h = item & 7, qb = (item >> 3) & 31;
    att::attn_body(Qa + ((size_t)(b * 8 + h) * SEQ + qb * 256) * 192, Kn + (size_t)(b * 8 + h) * KEYS * 128, Kr + (size_t)b * KEYS * 64,
                   Vt + (size_t)(b * 8 + h) * KEYS * 128, AO + (size_t)(b * SEQ + qb * 256) * D + h * 128, lds);
  }
}

namespace rt {
using f32x16 = __attribute__((ext_vector_type(16))) float;
__device__ __forceinline__ int sortable(float f) { const int b = __float_as_int(f); return b ^ ((b >> 31) & 0x7FFFFFFF); }
__device__ __forceinline__ float unsortable(int k) { return __int_as_float(k ^ ((k >> 31) & 0x7FFFFFFF)); }
__device__ __forceinline__ int imax(int a, int b) { return a > b ? a : b; }
__device__ __forceinline__ int imin(int a, int b) { return a < b ? a : b; }
template <int N> __device__ __forceinline__ void sort_desc(int (&v)[N]) {
#pragma unroll
  for (int k = 2; k <= N; k <<= 1) {
#pragma unroll
    for (int j = k >> 1; j > 0; j >>= 1) {
#pragma unroll
      for (int i = 0; i < N; ++i) {
        const int l = i ^ j;
        if (l > i) {
          const bool desc = ((i & k) == 0);
          const int a = v[i], b = v[l];
          v[i] = desc ? imax(a, b) : imin(a, b);
          v[l] = desc ? imin(a, b) : imax(a, b);
        }
      }
    }
  }
}
template <int N> __device__ __forceinline__ void merge_desc(int (&v)[N]) {
#pragma unroll
  for (int j = N >> 1; j > 0; j >>= 1) {
#pragma unroll
    for (int i = 0; i < N; ++i) {
      const int l = i ^ j;
      if (l > i) { const int a = v[i], b = v[l]; v[i] = imax(a, b); v[l] = imin(a, b); }
    }
  }
}
__device__ __forceinline__ void absorb16(int (&L)[16], int (&B)[16]) {
  sort_desc<16>(B);
#pragma unroll
  for (int i = 0; i < 16; ++i) L[i] = imax(L[i], B[15 - i]);
  merge_desc<16>(L);
}
__device__ __forceinline__ constexpr int npairs_row(int i) { return 16 / (i + 1); }
}

struct RouteP { const bf16_t* Q; const bf16_t* Khi; int* IDX; float* GATE; int rows_per_block; int pad; };
__device__ __forceinline__ void ph_route(const RouteP& p, int bid, char* lds) {
  using namespace rt;
  int (*svl)[64][33] = reinterpret_cast<int (*)[64][33]>(lds);
  const int wave = otid() >> 6, lane = otid() & 63, r32 = lane & 31, hi = lane >> 5, hi4 = hi * 4;
  int nrows = p.rows_per_block; asm volatile("" : "+s"(nrows));
  const int g0 = bid * nrows;
  const int h = wave;
#pragma unroll 1
  for (int tg = 0; tg * 32 < nrows; ++tg) {
    int trow = tg * 32 + r32; const bool valid = trow < nrows; trow = valid ? trow : nrows - 1;
    const bf16_t* qrow = p.Q + (size_t)(g0 + trow) * D;
    int sv[2][16];
#pragma unroll
    for (int s = 0; s < 2; ++s) {
      const int hs = h * 2 + s;
      f32x16 acc[4];
#pragma unroll
      for (int m = 0; m < 4; ++m) acc[m] = f32x16{};
#pragma unroll
      for (int kp = 0; kp < 2; ++kp) {
        bf16x8 kf[2][4], qf[2];
#pragma unroll
        for (int k2 = 0; k2 < 2; ++k2)
#pragma unroll
          for (int m = 0; m < 4; ++m) kf[k2][m] = *(const bf16x8*)(p.Khi + ((size_t)(hs * 128 + m * 32 + r32)) * 64 + (kp * 2 + k2) * 16 + hi * 8);
#pragma unroll
        for (int k2 = 0; k2 < 2; ++k2) {
          const int ks = kp * 2 + k2;
          qf[k2] = *(const bf16x8*)(qrow + hs * 64 + ks * 16 + hi * 8);
        }
#pragma unroll
        for (int k2 = 0; k2 < 2; ++k2)
#pragma unroll
          for (int m = 0; m < 4; ++m) acc[m] = __builtin_amdgcn_mfma_f32_32x32x16_bf16(kf[k2][m], qf[k2], acc[m], 0, 0, 0);
      }
      int L[16];
#pragma unroll
      for (int m = 0; m < 4; ++m) {
        int B[16];
#pragma unroll
        for (int r = 0; r < 16; ++r) B[r] = (sortable(acc[m][r]) & ~0x7F) | (m * 32 + (r & 3) + 8 * (r >> 2)) | hi4;
        if (m == 0) { sort_desc<16>(B);
#pragma unroll
          for (int i = 0; i < 16; ++i) L[i] = B[i]; }
        else absorb16(L, B);
      }
      int Lo[16], Hi[16];
#pragma unroll
      for (int i = 0; i < 16; ++i) { auto rr = __builtin_amdgcn_permlane32_swap((unsigned)L[i], (unsigned)L[i], false, false); Lo[i] = (int)rr[0]; Hi[i] = (int)rr[1]; }
#pragma unroll
      for (int i = 0; i < 16; ++i) L[i] = imax(Lo[i], Hi[15 - i]);
      merge_desc<16>(L);
#pragma unroll
      for (int i = 0; i < 16; ++i) { sv[s][i] = L[i]; svl[wave][lane][s * 16 + i] = L[i]; }
    }
    float f0[16], f1[16];
#pragma unroll
    for (int i = 0; i < 16; ++i) { f0[i] = unsortable(sv[0][i] & ~0x7F); f1[i] = unsortable(sv[1][i] & ~0x7F); }
    int Lc[16];
    {
      int C[64];
      int n = 0;
#pragma unroll
      for (int i = 0; i < 16; ++i)
#pragma unroll
        for (int j = 0; j < 16; ++j)
          if ((i + 1) * (j + 1) <= 16) { C[n] = (sortable(f0[i] + f1[j]) & ~0xFF) | (i * 16 + j); ++n; }
#pragma unroll
      for (int k = 50; k < 64; ++k) C[k] = (int)0x80000000;
#pragma unroll
      for (int m = 0; m < 4; ++m) {
        int B[16];
#pragma unroll
        for (int r = 0; r < 16; ++r) B[r] = C[m * 16 + r];
        if (m == 0) { sort_desc<16>(B);
#pragma unroll
          for (int i = 0; i < 16; ++i) Lc[i] = B[i]; }
        else absorb16(Lc, B);
      }
    }
    float e[16]; float esum = 0.f;
    const float vmax = unsortable(Lc[0] & ~0xFF);
#pragma unroll
    for (int r = 0; r < 16; ++r) { e[r] = expf(unsortable(Lc[r] & ~0xFF) - vmax); esum += e[r]; }
    const float inv = 1.f / esum;
    int eid[16];
#pragma unroll
    for (int r = 0; r < 16; ++r) {
      const int pr = Lc[r] & 0xFF;
      const int k0 = svl[wave][lane][pr >> 4] & 0x7F, k1 = svl[wave][lane][16 + (pr & 15)] & 0x7F;
      eid[r] = k0 * 128 + k1;
    }
    if (valid && hi == 0) {
      int* ip = p.IDX + (size_t)(g0 + trow) * 128 + h * 16; float* gp = p.GATE + (size_t)(g0 + trow) * 128 + h * 16;
#pragma unroll
      for (int r = 0; r < 16; r += 4) {
        *(int4*)(ip + r) = make_int4(eid[r], eid[r + 1], eid[r + 2], eid[r + 3]);
        *(float4*)(gp + r) = make_float4(e[r] * inv, e[r + 1] * inv, e[r + 2] * inv, e[r + 3] * inv);
      }
    }
  }
}

constexpr int RB = 8;
template <bool SIGNED>
__device__ __forceinline__ void cvt_rows_i8(const float* __restrict__ src, unsigned char* __restrict__ dst, float* __restrict__ scl, int nrows, int wgid, int nw) {
  const int lane = otid() & 63;
  for (int r0 = wgid * RB; r0 < nrows; r0 += nw * RB) {
    float v[RB][16];
#pragma unroll
    for (int u = 0; u < RB; ++u) {
      const float* sp = src + (size_t)(r0 + u) * D + lane * 4;
      *(float4*)&v[u][0] = *(const float4*)sp; *(float4*)&v[u][4] = *(const float4*)(sp + 256); *(float4*)&v[u][8] = *(const float4*)(sp + 512); *(float4*)&v[u][12] = *(const float4*)(sp + 768);
    }
#pragma unroll
    for (int u = 0; u < RB; ++u) {
      float am = 0.f;
#pragma unroll
      for (int j = 0; j < 16; ++j) am = fmaxf(am, fabsf(v[u][j]));
      am = wave_max_dpp(am);
      const float sc = am > 0.f ? am * (1.f / 127.f) : 1.f, inv = 1.f / sc;
      unsigned w[4];
#pragma unroll
      for (int q4 = 0; q4 < 4; ++q4) {
        unsigned ww = 0u;
#pragma unroll
        for (int j = 0; j < 4; ++j) { int qi = (int)rintf(v[u][q4 * 4 + j] * inv) + (SIGNED ? 0 : 128); qi = SIGNED ? (qi < -127 ? -127 : (qi > 127 ? 127 : qi)) : (qi < 1 ? 1 : (qi > 255 ? 255 : qi)); ww |= (unsigned)(qi & 255) << (8 * j); }
        w[q4] = ww;
      }
      *(uint4*)(dst + (size_t)(r0 + u) * D + lane * 16) = make_uint4(w[0], w[1], w[2], w[3]);
      if (lane == 0) scl[r0 + u] = sc;
    }
  }
}

constexpr int QROW = 768;
__device__ __forceinline__ void cvt_rows_q6(const float* __restrict__ src, unsigned char* __restrict__ dst, float* __restrict__ scl, int nrows, int wgid, int nw) {
  const int lane = otid() & 63;
  for (int r0 = wgid * RB; r0 < nrows; r0 += nw * RB) {
    float v[RB][16];
#pragma unroll
    for (int u = 0; u < RB; ++u) {
      const float* sp = src + (size_t)(r0 + u) * D + lane * 4;
      *(float4*)&v[u][0] = *(const float4*)sp; *(float4*)&v[u][4] = *(const float4*)(sp + 256); *(float4*)&v[u][8] = *(const float4*)(sp + 512); *(float4*)&v[u][12] = *(const float4*)(sp + 768);
    }
#pragma unroll
    for (int u = 0; u < RB; ++u) {
      float am = 0.f;
#pragma unroll
      for (int j = 0; j < 16; ++j) am = fmaxf(am, fabsf(v[u][j]));
      am = wave_max_dpp(am);
      const float sc = am > 0.f ? am * (1.f / 31.f) : 1.f, inv = 1.f / sc;
      unsigned long long lo = 0ull, hi = 0ull;
#pragma unroll
      for (int j = 0; j < 16; ++j) {
        int qi = (int)rintf(v[u][j] * inv) + 32; qi = qi < 1 ? 1 : (qi > 63 ? 63 : qi);
        const int bit = 6 * j;
        if (bit < 64) { lo |= (unsigned long long)qi << bit; if (bit > 58) hi |= (unsigned long long)qi >> (64 - bit); }
        else hi |= (unsigned long long)qi << (bit - 64);
      }
      unsigned* dp = (unsigned*)(dst + (size_t)(r0 + u) * QROW + lane * 12);
      dp[0] = (unsigned)lo; dp[1] = (unsigned)(lo >> 32); dp[2] = (unsigned)hi;
      if (lane == 0) scl[r0 + u] = sc;
    }
  }
}
struct q6w { unsigned x, y, z; };
template <int J> __device__ __forceinline__ float q6(const q6w& w) {
  constexpr int bit = 6 * J, wd = bit >> 5, sh = bit & 31;
  const unsigned lo = wd == 0 ? w.x : (wd == 1 ? w.y : w.z);
  if constexpr (sh == 26) return (float)(lo >> 26);
  else if constexpr (sh < 26) return (float)((lo >> sh) & 63u);
  else { const unsigned hi = wd == 0 ? w.y : w.z; return (float)(__builtin_amdgcn_alignbit(hi, lo, sh) & 63u); }
}

struct GatherP { const bf16_t* Tbf; const int* IDX; const float* GATE; const unsigned char* utab; const unsigned char* vtab; const float* su; const float* sv;
                 const float* Hin; const float* mod; const float* lng; const float* lnb; float* Hout; const float* modT; };
#define UB0(w) ((float)((w) & 0xFFu))
#define UB1(w) ((float)(((w) >> 8) & 0xFFu))
#define UB2(w) ((float)(((w) >> 16) & 0xFFu))
#define UB3(w) ((float)((w) >> 24))
template <bool FINAL>
__device__ __forceinline__ void ln_token(const GatherP& p, int row, int rr, int lane, const float (&f)[16], float asum, char* As) {
  const int v = row_vec(row);
  const float* hin = p.Hin + (size_t)row * D + lane * 4;
  const float* gm = p.mod + v * 6144 + 5 * 1024 + lane * 4;
  const float off = 32.f * asum;
  float r[16]; float ssum = 0.f;
#pragma unroll
  for (int q4 = 0; q4 < 4; ++q4) {
    const float4 h4 = *(const float4*)(hin + q4 * 256), g4 = *(const float4*)(gm + q4 * 256);
    r[q4 * 4 + 0] = ALPHA * h4.x + g4.x * (f[q4 * 4 + 0] - off); r[q4 * 4 + 1] = ALPHA * h4.y + g4.y * (f[q4 * 4 + 1] - off);
    r[q4 * 4 + 2] = ALPHA * h4.z + g4.z * (f[q4 * 4 + 2] - off); r[q4 * 4 + 3] = ALPHA * h4.w + g4.w * (f[q4 * 4 + 3] - off);
    ssum += r[q4 * 4 + 0] + r[q4 * 4 + 1] + r[q4 * 4 + 2] + r[q4 * 4 + 3];
  }
  const float mu = wave_sum(ssum) * (1.f / D);
  float vs = 0.f;
#pragma unroll
  for (int j = 0; j < 16; ++j) { const float dlt = r[j] - mu; vs += dlt * dlt; }
  const float rstd = rsqrtf(wave_sum(vs) * (1.f / D) + LN_EPS);
  float o[16];
#pragma unroll
  for (int q4 = 0; q4 < 4; ++q4) {
    const float4 g4 = *(const float4*)(p.lng + q4 * 256 + lane * 4), b4 = *(const float4*)(p.lnb + q4 * 256 + lane * 4);
    o[q4 * 4 + 0] = (r[q4 * 4 + 0] - mu) * rstd * g4.x + b4.x; o[q4 * 4 + 1] = (r[q4 * 4 + 1] - mu) * rstd * g4.y + b4.y;
    o[q4 * 4 + 2] = (r[q4 * 4 + 2] - mu) * rstd * g4.z + b4.z; o[q4 * 4 + 3] = (r[q4 * 4 + 3] - mu) * rstd * g4.w + b4.w;
    *(float4*)(p.Hout + (size_t)row * D + q4 * 256 + lane * 4) = make_float4(o[q4 * 4 + 0], o[q4 * 4 + 1], o[q4 * 4 + 2], o[q4 * 4 + 3]);
  }
  if (!FINAL) {
    const float* mt = p.modT + v * 6144 + lane * 4;
#pragma unroll
    for (int q4 = 0; q4 < 4; ++q4) {
      const float4 sh = *(const float4*)(mt + q4 * 256), sc = *(const float4*)(mt + 1024 + q4 * 256);
      uint2 w; w.x = pack2bf(o[q4 * 4] * (1.f + sc.x) + sh.x, o[q4 * 4 + 1] * (1.f + sc.y) + sh.y); w.y = pack2bf(o[q4 * 4 + 2] * (1.f + sc.z) + sh.z, o[q4 * 4 + 3] * (1.f + sc.w) + sh.w);
      *(uint2*)(As + rr * LDA_B + (q4 * 256 + lane * 4) * 2) = w;
    }
  }
}
constexpr int PARTW = 1088;
template <bool FINAL>
__device__ __forceinline__ void ph_gather_tm(const GatherP& p, int g0, int nrows, char* As, float* __restrict__ PART) {
  const int tid = otid(), wave = tid >> 6, lane = tid & 63;
  const int nfull = nrows >> 3, extra = nrows & 7;
  const int nun = nfull + (extra ? 1 : 0);
#pragma unroll 1
  for (int un = 0; un < nun; ++un) {
    int rr, kbeg, kcnt; bool partial;
    if (un < nfull) { rr = wave + 8 * un; kbeg = 0; kcnt = 128; partial = false; }
    else { const int wpt = 8 / extra; rr = nfull * 8 + wave / wpt; kcnt = 128 / wpt; kbeg = (wave % wpt) * kcnt; partial = true; }
    const int row = g0 + rr;
    float tf[16];
    {
      const bf16_t* tp = p.Tbf + (size_t)row * D + lane * 4;
      const uint2 t0 = *(const uint2*)tp, t1 = *(const uint2*)(tp + 256), t2 = *(const uint2*)(tp + 512), t3 = *(const uint2*)(tp + 768);
      tf[0] = bflo(t0.x); tf[1] = bfhi(t0.x); tf[2] = bflo(t0.y); tf[3] = bfhi(t0.y); tf[4] = bflo(t1.x); tf[5] = bfhi(t1.x); tf[6] = bflo(t1.y); tf[7] = bfhi(t1.y);
      tf[8] = bflo(t2.x); tf[9] = bfhi(t2.x); tf[10] = bflo(t2.y); tf[11] = bfhi(t2.y); tf[12] = bflo(t3.x); tf[13] = bfhi(t3.x); tf[14] = bflo(t3.y); tf[15] = bfhi(t3.y);
    }
    float tam = 0.f;
#pragma unroll
    for (int j = 0; j < 16; ++j) tam = fmaxf(tam, fabsf(tf[j]));
    tam = wave_max_dpp(tam);
    const float st = tam > 0.f ? tam * (1.f / 127.f) : 1.f, tinv = 1.f / st;
    int tq[4];
#pragma unroll
    for (int k4 = 0; k4 < 4; ++k4) {
      unsigned ww = 0u;
#pragma unroll
      for (int j = 0; j < 4; ++j) ww |= (unsigned)((int)rintf(tf[k4 * 4 + j] * tinv) & 255) << (8 * j);
      tq[k4] = (int)ww;
    }
    const int id_lo = p.IDX[(size_t)row * 128 + lane], id_hi = p.IDX[(size_t)row * 128 + 64 + lane];
    const float ga_lo = p.GATE[(size_t)row * 128 + lane], ga_hi = p.GATE[(size_t)row * 128 + 64 + lane];
    const float su_lo = p.su[id_lo], su_hi = p.su[id_hi], sv_lo = p.sv[id_lo], sv_hi = p.sv[id_hi];
    float f[16];
#pragma unroll
    for (int j = 0; j < 16; ++j) f[j] = 0.f;
    uint4 rb[8];
    float dlo = 0.f, dhi = 0.f;
#define ULOAD(slot, kk) do { const int e_ = __builtin_amdgcn_readlane((kk) < 64 ? id_lo : id_hi, (kk) & 63); \
      rb[slot] = *(const uint4*)(p.utab + (size_t)e_ * D + lane * 16); } while (0)
#define VLOAD(slot, kk) do { const int e_ = __builtin_amdgcn_readlane((kk) < 64 ? id_lo : id_hi, (kk) & 63); \
      const q6w t_ = *(const q6w*)(p.vtab + (size_t)e_ * QROW + lane * 12); rb[slot].x = t_.x; rb[slot].y = t_.y; rb[slot].z = t_.z; } while (0)
    auto proc4u = [&](int s0, int k0) {
      float dot[4];
#pragma unroll
      for (int u = 0; u < 4; ++u) {
        const uint4 a_ = rb[s0 + u];
        int di = __builtin_amdgcn_sdot4((int)a_.x, tq[0], 0, false); di = __builtin_amdgcn_sdot4((int)a_.y, tq[1], di, false);
        di = __builtin_amdgcn_sdot4((int)a_.z, tq[2], di, false); di = __builtin_amdgcn_sdot4((int)a_.w, tq[3], di, false);
        dot[u] = (float)di;
      }
#define DPPSTEP(ctl, rm) do { _Pragma("unroll") for (int u = 0; u < 4; ++u) dot[u] += __uint_as_float(__builtin_amdgcn_update_dpp(0u, __float_as_uint(dot[u]), ctl, rm, 0xF, true)); } while (0)
      DPPSTEP(0xB1, 0xF); DPPSTEP(0x4E, 0xF); DPPSTEP(0x141, 0xF); DPPSTEP(0x140, 0xF); DPPSTEP(0x142, 0xA); DPPSTEP(0x143, 0xC);
#undef DPPSTEP
      if (k0 < 64) {
#pragma unroll
        for (int u = 0; u < 4; ++u) dlo = __uint_as_float(__builtin_amdgcn_update_dpp(__float_as_uint(dot[u]), __float_as_uint(dlo), 0x130, 0xF, 0xF, false));
      } else {
#pragma unroll
        for (int u = 0; u < 4; ++u) dhi = __uint_as_float(__builtin_amdgcn_update_dpp(__float_as_uint(dot[u]), __float_as_uint(dhi), 0x130, 0xF, 0xF, false));
      }
    };
    float act_lo = 0.f, act_hi = 0.f;
    auto proc4v = [&](int s0, int k0) {
      float act[4];
      if (k0 < 64) {
#pragma unroll
        for (int u = 0; u < 4; ++u) act[u] = __uint_as_float((unsigned)__builtin_amdgcn_readlane((int)__float_as_uint(act_lo), k0 + u));
      } else {
#pragma unroll
        for (int u = 0; u < 4; ++u) act[u] = __uint_as_float((unsigned)__builtin_amdgcn_readlane((int)__float_as_uint(act_hi), k0 - 64 + u));
      }
#pragma unroll
      for (int u = 0; u < 4; ++u) {
        const float act_ = act[u];
        const q6w c_ = {rb[s0 + u].x, rb[s0 + u].y, rb[s0 + u].z};
        f[0] = fmaf(act_, q6<0>(c_), f[0]); f[1] = fmaf(act_, q6<1>(c_), f[1]); f[2] = fmaf(act_, q6<2>(c_), f[2]); f[3] = fmaf(act_, q6<3>(c_), f[3]);
        f[4] = fmaf(act_, q6<4>(c_), f[4]); f[5] = fmaf(act_, q6<5>(c_), f[5]); f[6] = fmaf(act_, q6<6>(c_), f[6]); f[7] = fmaf(act_, q6<7>(c_), f[7]);
        f[8] = fmaf(act_, q6<8>(c_), f[8]); f[9] = fmaf(act_, q6<9>(c_), f[9]); f[10] = fmaf(act_, q6<10>(c_), f[10]); f[11] = fmaf(act_, q6<11>(c_), f[11]);
        f[12] = fmaf(act_, q6<12>(c_), f[12]); f[13] = fmaf(act_, q6<13>(c_), f[13]); f[14] = fmaf(act_, q6<14>(c_), f[14]); f[15] = fmaf(act_, q6<15>(c_), f[15]);
      }
    };
    ULOAD(0, kbeg); ULOAD(1, kbeg + 1); ULOAD(2, kbeg + 2); ULOAD(3, kbeg + 3); ULOAD(4, kbeg + 4); ULOAD(5, kbeg + 5); ULOAD(6, kbeg + 6); ULOAD(7, kbeg + 7);
    const int kend = kbeg + kcnt - 8;
#pragma unroll 1
    for (int k = kbeg; k < kend; k += 8) {
      proc4u(0, k); ULOAD(0, k + 8); ULOAD(1, k + 9); ULOAD(2, k + 10); ULOAD(3, k + 11);
      proc4u(4, k + 4); ULOAD(4, k + 12); ULOAD(5, k + 13); ULOAD(6, k + 14); ULOAD(7, k + 15);
    }
    proc4u(0, kend); VLOAD(0, kbeg); VLOAD(1, kbeg + 1); VLOAD(2, kbeg + 2); VLOAD(3, kbeg + 3);
    proc4u(4, kend + 4); VLOAD(4, kbeg + 4); VLOAD(5, kbeg + 5); VLOAD(6, kbeg + 6); VLOAD(7, kbeg + 7);
    if (partial) {
      const int srcl = ((lane - (kbeg & 63) + 32) & 63) * 4;
      const float sh_lo = __uint_as_float((unsigned)__builtin_amdgcn_ds_bpermute(srcl, (int)__float_as_uint(dlo))), sh_hi = __uint_as_float((unsigned)__builtin_amdgcn_ds_bpermute(srcl, (int)__float_as_uint(dhi)));
      const bool in = lane >= (kbeg & 63) && lane < (kbeg & 63) + 32;
      dlo = in ? sh_lo : 0.f; dhi = in ? sh_hi : 0.f;
    }
    act_lo = gelu_fast(su_lo * st * dlo) * ga_lo * sv_lo; act_hi = gelu_fast(su_hi * st * dhi) * ga_hi * sv_hi;
    const float asum = wave_sum_dpp(act_lo + act_hi);
#pragma unroll 1
    for (int k = kbeg; k < kend; k += 8) {
      proc4v(0, k); VLOAD(0, k + 8); VLOAD(1, k + 9); VLOAD(2, k + 10); VLOAD(3, k + 11);
      proc4v(4, k + 4); VLOAD(4, k + 12); VLOAD(5, k + 13); VLOAD(6, k + 14); VLOAD(7, k + 15);
    }
    proc4v(0, kend); proc4v(4, kend + 4);
#undef ULOAD
#undef VLOAD
    if (!partial) ln_token<FINAL>(p, row, rr, lane, f, asum, As);
    else {
      float* pp = PART + wave * PARTW + lane * 16;
      *(float4*)pp = make_float4(f[0], f[1], f[2], f[3]); *(float4*)(pp + 4) = make_float4(f[4], f[5], f[6], f[7]);
      *(float4*)(pp + 8) = make_float4(f[8], f[9], f[10], f[11]); *(float4*)(pp + 12) = make_float4(f[12], f[13], f[14], f[15]);
      if (lane == 0) PART[wave * PARTW + 1024] = asum;
    }
  }
  if (extra) {
    __syncthreads();
    if (wave < extra) {
      const int wpt = 8 / extra, rr = nfull * 8 + wave;
      float f[16], asum = 0.f;
#pragma unroll
      for (int j = 0; j < 16; ++j) f[j] = 0.f;
      for (int w2 = wave * wpt; w2 < wave * wpt + wpt; ++w2) {
        const float* pp = PART + w2 * PARTW + lane * 16;
#pragma unroll
        for (int q4 = 0; q4 < 4; ++q4) { const float4 x4 = *(const float4*)(pp + q4 * 4); f[q4 * 4] += x4.x; f[q4 * 4 + 1] += x4.y; f[q4 * 4 + 2] += x4.z; f[q4 * 4 + 3] += x4.w; }
        asum += PART[w2 * PARTW + 1024];
      }
      ln_token<FINAL>(p, g0 + rr, rr, lane, f, asum, As);
    }
  }
}

__device__ __forceinline__ void cvt_plain(const float* __restrict__ a, bf16_t* __restrict__ o, size_t n8, bool lo, size_t gtid, size_t gsz) {
  for (size_t i = gtid; i < n8; i += gsz) {
    float v[8];
    *(float4*)&v[0] = ((const float4*)a)[i * 2]; *(float4*)&v[4] = ((const float4*)a)[i * 2 + 1];
    if (lo) {
#pragma unroll
      for (int j = 0; j < 8; ++j) v[j] = v[j] - bf2f(f2bf(v[j]));
    }
    uint4 w; w.x = pack2bf(v[0], v[1]); w.y = pack2bf(v[2], v[3]); w.z = pack2bf(v[4], v[5]); w.w = pack2bf(v[6], v[7]);
    ((uint4*)o)[i] = w;
  }
}
__device__ __forceinline__ void cvt_t(const float* __restrict__ W, bf16_t* __restrict__ Wt, int K, int N, bool lo, size_t gtid, size_t gsz) {
  const int N4 = N >> 2;
  const size_t total = (size_t)N4 * (K / 8);
#pragma unroll 2
  for (size_t i = gtid; i < total; i += gsz) {
    const int n = (int)(i % N4) * 4, k8 = (int)(i / N4);
    float4 r[8];
#pragma unroll
    for (int j = 0; j < 8; ++j) r[j] = *(const float4*)(W + (size_t)(k8 * 8 + j) * N + n);
    if (lo) {
#pragma unroll
      for (int j = 0; j < 8; ++j) { r[j].x -= bf2f(f2bf(r[j].x)); r[j].y -= bf2f(f2bf(r[j].y)); r[j].z -= bf2f(f2bf(r[j].z)); r[j].w -= bf2f(f2bf(r[j].w)); }
    }
    uint4* dst = (uint4*)(Wt + ((size_t)((n >> 4) * (K >> 5) + (k8 >> 2)) * 64 + (k8 & 3) * 16 + (n & 15)) * 8);
    dst[0] = make_uint4(pack2bf(r[0].x, r[1].x), pack2bf(r[2].x, r[3].x), pack2bf(r[4].x, r[5].x), pack2bf(r[6].x, r[7].x));
    dst[1] = make_uint4(pack2bf(r[0].y, r[1].y), pack2bf(r[2].y, r[3].y), pack2bf(r[4].y, r[5].y), pack2bf(r[6].y, r[7].y));
    dst[2] = make_uint4(pack2bf(r[0].z, r[1].z), pack2bf(r[2].z, r[3].z), pack2bf(r[4].z, r[5].z), pack2bf(r[6].z, r[7].z));
    dst[3] = make_uint4(pack2bf(r[0].w, r[1].w), pack2bf(r[2].w, r[3].w), pack2bf(r[4].w, r[5].w), pack2bf(r[6].w, r[7].w));
  }
}
__device__ __forceinline__ void mod_item(const float* __restrict__ c, const float* __restrict__ c_ctx, const float* __restrict__ ada_w, const float* __restrict__ ada_b,
                                         float* __restrict__ MOD, int item, bool valid, char* lds, int tid, int nct, volatile int* cbc, int& cgen) {
  float* sc = (float*)lds;
  float* part = sc + 3072;
  const int wave = tid >> 6, lane = tid & 63, l = item / 96, cg = item % 96, nw = nct >> 6;
  if (valid) for (int i = tid; i < 3072; i += nct) { const int v = i >> 10, k = i & 1023; const float xv = v < 2 ? c[v * 1024 + k] : c_ctx[k]; sc[i] = xv / (1.f + expf(-xv)); }
  cbar(cbc, cgen, nw);
  if (valid) {
    float a0 = 0.f, a1 = 0.f, a2 = 0.f;
    const float* W = ada_w + (size_t)l * 1024 * 6144 + cg * 64 + lane;
    const int kb = wave * 171, ke = kb + 171 < 1024 ? kb + 171 : 1024;
#pragma unroll 57
    for (int k = kb; k < ke; ++k) { const float w = W[(size_t)k * 6144]; a0 += sc[k] * w; a1 += sc[1024 + k] * w; a2 += sc[2048 + k] * w; }
    part[(wave * 3 + 0) * 64 + lane] = a0; part[(wave * 3 + 1) * 64 + lane] = a1; part[(wave * 3 + 2) * 64 + lane] = a2;
  }
  cbar(cbc, cgen, nw);
  if (valid && tid < 192) {
    const int v = tid >> 6, ln = tid & 63; float sum = 0.f;
    for (int w = 0; w < nw; ++w) sum += part[(w * 3 + v) * 64 + ln];
    MOD[(l * 3 + v) * 6144 + cg * 64 + ln] = sum + ada_b[l * 6144 + cg * 64 + ln];
  }
}

__device__ __forceinline__ void gbar(unsigned* cnt, unsigned target) {
  asm volatile("s_waitcnt vmcnt(0)" ::: "memory");
  __syncthreads();
  if (otid() == 0) {
    __builtin_amdgcn_fence(__ATOMIC_RELEASE, "agent");
    asm volatile("s_waitcnt vmcnt(0)" ::: "memory");
    __hip_atomic_fetch_add(cnt, 1u, __ATOMIC_RELAXED, __HIP_MEMORY_SCOPE_AGENT);
    unsigned spins = 0;
    while (__hip_atomic_load(cnt, __ATOMIC_RELAXED, __HIP_MEMORY_SCOPE_AGENT) < target) { __builtin_amdgcn_s_sleep(2); if (++spins > (1u << 24)) break; }
    __builtin_amdgcn_fence(__ATOMIC_ACQUIRE, "agent");
    asm volatile("s_waitcnt vmcnt(0)" ::: "memory");
  }
  __syncthreads();
}

struct MP {
  const float *x, *c, *ctx, *c_ctx, *ada_w, *ada_b, *ln_g, *ln_b, *s5_a_re, *s5_a_im, *s5_log_dt, *s5_b_re, *s5_b_im, *s5_c_re, *s5_c_im, *s5_d, *s5_w_glu, *s5_w_o;
  const float *mla_w_dq, *mla_q_norm, *mla_w_uq, *mla_w_dkv, *mla_kv_norm, *mla_w_ukv, *mla_w_o, *peer_w_q, *peer_keys, *peer_u, *peer_v;
  float* out;
  float* MOD; bf16_t *Wt_glu, *Wt_o0, *Wt_q0, *Wt_o1, *Wt_q1, *Wt_cat, *Wt_uq, *Wt_ukv, *Khi, *Khi1;
  unsigned char *U0, *V0, *U1, *V1; float *SU0, *SV0, *SU1, *SV1; bf16_t *Ktab, *Bst_t, *Cin_t;
  bf16_t* Ypart; float* Ssta; bf16_t *HP, *Gbf, *Vbf, *Tbf; float *OQ, *H1, *H2; int* IDX; float* GATE;
  bf16_t *Qa, *AObf; unsigned char *Kn, *Kr, *Va; float* H3; bf16_t* Tbf1; unsigned* BAR; float* PART;
};
constexpr int LDS_BYTES = 66 * 784 + 66 * 528 + 1024 * 68 + 64;
__global__ __launch_bounds__(512) void mega(MP p) {
  __shared__ __attribute__((aligned(16))) char lds[LDS_BYTES];
  cg::grid_group grid = cg::this_grid();
  const int nblk = gridDim.x;
  int bid = blockIdx.x;
  const size_t TD = (size_t)1024 * 16384;
  const float* mod0 = p.MOD; const float* mod1 = p.MOD + 3 * 6144;
  {
    volatile int* cbc = (volatile int*)(lds + LDS_BYTES - 16);
    if (otid() == 0) *cbc = 0;
    __syncthreads();
    const int t0 = otid();
    if (t0 < 128) {
      const size_t mt = (size_t)bid * 128 + t0, ms = (size_t)nblk * 128;
      const int mw = bid * 2 + (t0 >> 6), nmw = nblk * 2;
      cvt_t(p.s5_w_glu, p.Wt_glu, D, D, false, mt, ms);
      cvt_t(p.s5_w_o, p.Wt_o0, D, D, false, mt, ms);
      cvt_t(p.peer_w_q, p.Wt_q0, D, D, false, mt, ms);
      cvt_t(p.mla_w_o, p.Wt_o1, D, D, false, mt, ms);
      cvt_t(p.peer_w_q + (size_t)D * D, p.Wt_q1, D, D, false, mt, ms);
      cvt_t(p.mla_w_dq, p.Wt_cat, D, 384, false, mt, ms);
      cvt_t(p.mla_w_dkv, p.Wt_cat + (size_t)384 * D, D, 320, false, mt, ms);
      cvt_t(p.mla_w_uq, p.Wt_uq, 384, 1536, false, mt, ms);
      cvt_t(p.mla_w_ukv, p.Wt_ukv, 256, 2048, false, mt, ms);
      cvt_plain(p.peer_keys, p.Khi, (size_t)2 * 131072 / 8, false, mt, ms);
      cvt_rows_i8<true>(p.peer_u, p.U0, p.SU0, 16384, mw, nmw);
      cvt_rows_q6(p.peer_v, p.V0, p.SV0, 16384, mw, nmw);
      cvt_rows_i8<true>(p.peer_u + TD, p.U1, p.SU1, 16384, mw, nmw);
      cvt_rows_q6(p.peer_v + TD, p.V1, p.SV1, 16384, mw, nmw);
    } else {
      int cgen = 0;
      const int ct = t0 - 128;
      ph_s5_prep(p.s5_a_re, p.s5_a_im, p.s5_log_dt, p.s5_b_re, p.s5_b_im, p.s5_c_re, p.s5_c_im, p.Ktab, p.Bst_t, p.Cin_t, bid >> 2, bid & 3, lds, ct, 384, cbc, cgen);
      cbar(cbc, cgen, 6);
      mod_item(p.c, p.c_ctx, p.ada_w, p.ada_b, p.MOD, bid, bid < 192, lds, ct, 384, cbc, cgen);
    }
  }
  grid.sync();
  asm volatile("" : "+s"(bid));
  ph_s5_p1(p.x, p.ctx, mod0, p.Ktab, p.Bst_t, p.Ypart, p.Ssta, bid, lds);
  gbar(p.BAR, 1u * (unsigned)nblk);
  asm volatile("" : "+s"(bid));
  if (otid() < 64) ph_s5_carry(p.Ssta, p.s5_a_re, p.s5_a_im, p.s5_log_dt, p.HP, bid, otid());
  gbar(p.BAR, 2u * (unsigned)nblk);
  asm volatile("" : "+s"(bid));
  ph_s5_p3(p.x, p.ctx, mod0, p.s5_d, p.HP, p.Cin_t, p.Ypart, p.Gbf, bid, lds);
  gbar(p.BAR, 3u * (unsigned)nblk);
  asm volatile("" : "+s"(bid));
  {
    ChainP cp{p.Gbf, p.Wt_glu, p.Wt_o0, p.Wt_q0, p.Vbf, (bf16_t*)p.OQ + (size_t)bid * 66 * D, p.x, p.ctx, mod0, p.ln_g, p.ln_b, p.H1, p.Tbf, (bf16_t*)p.OQ + (size_t)bid * 66 * D  };
    ph_chainA<true>(cp, bid, lds);
    __syncthreads();
    ph_route(RouteP{(bf16_t*)p.OQ + (size_t)bid * 66 * D, p.Khi, p.IDX, p.GATE, 66, 0}, bid, lds);
    __syncthreads();
    GatherP gp{p.Tbf, p.IDX, p.GATE, p.U0, p.V0, p.SU0, p.SV0, p.H1, mod0, p.ln_g + D, p.ln_b + D, p.H2, mod1};
    ph_gather_tm<false>(gp, bid * 66, 66, lds, p.PART + (size_t)bid * 8 * PARTW);
    __syncthreads();
    ProjP pp{p.Wt_cat, p.Wt_uq, p.Wt_ukv, p.mla_q_norm, p.mla_kv_norm, p.OQ  , p.Qa, p.Kn, p.Kr, p.Va};
    ph_mla_proj(pp, bid, lds);
  }
  gbar(p.BAR, 4u * (unsigned)nblk);
  asm volatile("" : "+s"(bid));
  ph_attn(p.Qa, p.Kn, p.Kr, p.Va, p.AObf, bid, nblk, lds);
  gbar(p.BAR, 5u * (unsigned)nblk);
  asm volatile("" : "+s"(bid));
  {
    ChainP cp{p.AObf, nullptr, p.Wt_o1, p.Wt_q1, nullptr, (bf16_t*)p.OQ + (size_t)bid * 64 * D, p.H2, p.H2 + (size_t)NL * D, mod1, p.ln_g + 2 * D, p.ln_b + 2 * D, p.H3, p.Tbf1, (bf16_t*)p.OQ + (size_t)bid * 64 * D};
    ph_chainA<false>(cp, bid, lds);
    __syncthreads();
    ph_route(RouteP{(bf16_t*)p.OQ + (size_t)bid * 64 * D, p.Khi1, p.IDX, p.GATE, 64, 0}, bid, lds);
    __syncthreads();
    GatherP gp{p.Tbf1, p.IDX, p.GATE, p.U1, p.V1, p.SU1, p.SV1, p.H3, mod1, p.ln_g + 3 * D, p.ln_b + 3 * D, p.out, mod1};
    ph_gather_tm<true>(gp, bid * 64, 64, lds, p.PART + (size_t)bid * 8 * PARTW);
  }
}

extern "C" void kernel_launch(void* const* d_in, const int* in_sizes, int n_in, void* d_out, int out_size, void* d_ws, size_t ws_size, hipStream_t stream) {
  MP p{};
  const float** in = (const float**)&p;
  for (int i = 0; i < 29; ++i) in[i] = (const float*)d_in[i];
  p.out = (float*)d_out;
  char* ws = (char*)d_ws; size_t off = 0;
  auto carve = [&](size_t bytes) { char* q = ws + off; off += (bytes + 255) / 256 * 256; return q; };
  const size_t TDB = (size_t)1024 * 16384 * 2, BIG = (size_t)NT * D * 4, HALF = (size_t)NT * D * 2;
  p.MOD = (float*)carve(2 * 3 * 6144 * 4);
  p.Wt_glu = (bf16_t*)carve((size_t)D * D * 2); p.Wt_o0 = (bf16_t*)carve((size_t)D * D * 2); p.Wt_q0 = (bf16_t*)carve((size_t)D * D * 2);
  p.Wt_o1 = (bf16_t*)carve((size_t)D * D * 2); p.Wt_q1 = (bf16_t*)carve((size_t)D * D * 2);
  p.Wt_cat = (bf16_t*)carve((size_t)704 * D * 2); p.Wt_uq = (bf16_t*)carve((size_t)1536 * 384 * 2); p.Wt_ukv = (bf16_t*)carve((size_t)2048 * 256 * 2);
  p.Khi = (bf16_t*)carve((size_t)2 * 131072 * 2); p.Khi1 = p.Khi + 131072;
  char* T0 = carve(TDB); p.U0 = (unsigned char*)T0; p.V0 = (unsigned char*)(T0 + TDB / 2); p.AObf = (bf16_t*)T0;
  p.SU0 = (float*)carve(16384 * 4); p.SV0 = (float*)carve(16384 * 4); p.SU1 = (float*)carve(16384 * 4); p.SV1 = (float*)carve(16384 * 4);
  const size_t KTAB_B = (size_t)64 * 127 * 256 * 2, BST_B = (size_t)64 * 256 * 1024 * 2, KN_B = (size_t)NB * 8 * KEYS * 128 * 2, KR_B = (size_t)NB * KEYS * 64 * 2;
  size_t x1 = KTAB_B + 2 * BST_B; if (x1 < 2 * KN_B + KR_B) x1 = 2 * KN_B + KR_B;
  char* X1 = carve(x1);
  p.Ktab = (bf16_t*)X1; p.Bst_t = (bf16_t*)(X1 + KTAB_B); p.Cin_t = (bf16_t*)(X1 + KTAB_B + BST_B);
  p.Kn = (unsigned char*)X1; p.Va = (unsigned char*)(X1 + KN_B); p.Kr = (unsigned char*)(X1 + 2 * KN_B); p.H3 = (float*)X1;
  char* X2 = carve(BIG); p.Ypart = (bf16_t*)X2; p.OQ = (float*)X2;
  char* X3 = carve(HALF); p.Ssta = (float*)X3; p.HP = (bf16_t*)(X3 + (size_t)NCC * 64 * 256 * 4); p.Vbf = (bf16_t*)X3;
  char* X4 = carve(HALF); p.Gbf = (bf16_t*)X4; p.Tbf = (bf16_t*)X4; p.Tbf1 = (bf16_t*)X4;
  char* X5 = carve(BIG); p.H1 = (float*)X5;
  char* T1 = carve(TDB); p.U1 = (unsigned char*)T1; p.V1 = (unsigned char*)(T1 + TDB / 2);
  p.H2 = (float*)carve(BIG);
  p.IDX = (int*)carve((size_t)NT * 128 * 4); p.GATE = (float*)carve((size_t)NT * 128 * 4);
  p.Qa = (bf16_t*)carve((size_t)NB * 8 * SEQ * 192 * 2);
  p.BAR = (unsigned*)carve(256);
  p.PART = (float*)carve((size_t)256 * 8 * PARTW * 4);
  if (off > ws_size || n_in != 29) { fprintf(stderr, "kernel_launch: workspace too small (need %zu, have %zu) or n_in %d != 29\n", off, ws_size, n_in); return; }
  static int grid_blocks = 0;
  if (!grid_blocks) {
    int dev = 0, cus = 0, per_cu = 0;
    hipGetDevice(&dev);
    hipDeviceGetAttribute(&cus, hipDeviceAttributeMultiprocessorCount, dev);
    hipOccupancyMaxActiveBlocksPerMultiprocessor(&per_cu, mega, 512, 0);
    if (per_cu < 1 || cus < 256) { fprintf(stderr, "kernel_launch: need 256 resident workgroups (cus %d, per_cu %d)\n", cus, per_cu); return; }
    grid_blocks = 256;
  }
  hipMemsetAsync(p.BAR, 0, 256, stream);
  void* args[] = {&p};
  hipError_t e = hipLaunchCooperativeKernel((void*)mega, dim3(grid_blocks), dim3(512), args, 0, stream);
  if (e != hipSuccess) fprintf(stderr, "cooperative launch failed: %s\n", hipGetErrorString(e));
}
```

```cpp
#include <hip/hip_runtime.h>
#include <math.h>
#include <hip/hip_cooperative_groups.h>
#include <cstdio>
namespace cg = cooperative_groups;
__device__ __forceinline__ int otid() { int t = (int)__builtin_amdgcn_workitem_id_x(); asm volatile("" : "+v"(t)); return t; }

constexpr int D = 1024, NB = 2, SEQ = 8192, CTX = 256;
constexpr int NL = NB * SEQ, NC = NB * CTX, NT = NL + NC;
constexpr float ALPHA = 1.4142135623730951f;
constexpr float LN_EPS = 1e-5f, RMS_EPS = 1e-6f;

__device__ __forceinline__ float wave_sum_dpp(float v) {
  v += __uint_as_float(__builtin_amdgcn_update_dpp(0u, __float_as_uint(v), 0xB1, 0xF, 0xF, true));
  v += __uint_as_float(__builtin_amdgcn_update_dpp(0u, __float_as_uint(v), 0x4E, 0xF, 0xF, true));
  v += __uint_as_float(__builtin_amdgcn_update_dpp(0u, __float_as_uint(v), 0x141, 0xF, 0xF, true));
  v += __uint_as_float(__builtin_amdgcn_update_dpp(0u, __float_as_uint(v), 0x140, 0xF, 0xF, true));
  v += __uint_as_float(__builtin_amdgcn_update_dpp(0u, __float_as_uint(v), 0x142, 0xA, 0xF, true));
  v += __uint_as_float(__builtin_amdgcn_update_dpp(0u, __float_as_uint(v), 0x143, 0xC, 0xF, true));
  return __uint_as_float((unsigned)__builtin_amdgcn_readlane((int)__float_as_uint(v), 63));
}
__device__ __forceinline__ float wave_sum(float v) { return wave_sum_dpp(v); }
__device__ __forceinline__ float wave_max_dpp(float v) {
  v = fmaxf(v, __uint_as_float(__builtin_amdgcn_update_dpp(0u, __float_as_uint(v), 0xB1, 0xF, 0xF, true)));
  v = fmaxf(v, __uint_as_float(__builtin_amdgcn_update_dpp(0u, __float_as_uint(v), 0x4E, 0xF, 0xF, true)));
  v = fmaxf(v, __uint_as_float(__builtin_amdgcn_update_dpp(0u, __float_as_uint(v), 0x141, 0xF, 0xF, true)));
  v = fmaxf(v, __uint_as_float(__builtin_amdgcn_update_dpp(0u, __float_as_uint(v), 0x140, 0xF, 0xF, true)));
  v = fmaxf(v, __uint_as_float(__builtin_amdgcn_update_dpp(0u, __float_as_uint(v), 0x142, 0xA, 0xF, true)));
  v = fmaxf(v, __uint_as_float(__builtin_amdgcn_update_dpp(0u, __float_as_uint(v), 0x143, 0xC, 0xF, true)));
  return __uint_as_float((unsigned)__builtin_amdgcn_readlane((int)__float_as_uint(v), 63));
}
__device__ __forceinline__ int row_vec(int row) { return row < NL ? (row >> 13) : 2; }
__device__ __forceinline__ float gelu_exact(float x) { return 0.5f * x * (1.f + erff(x * 0.70710678118654752f)); }
__device__ __forceinline__ float gelu_fast(float x) {
  const float z = fabsf(x) * 0.70710678118654752f;
  const float t = __builtin_amdgcn_rcpf(fmaf(0.3275911f, z, 1.f));
  float pl = fmaf(1.061405429f, t, -1.453152027f); pl = fmaf(pl, t, 1.421413741f); pl = fmaf(pl, t, -0.284496736f); pl = fmaf(pl, t, 0.254829592f);
  const float e = __builtin_amdgcn_exp2f(-z * z * 1.4426950408889634f);
  const float erfa = 1.f - pl * t * e;
  const float hx = 0.5f * x;
  return hx + fabsf(hx) * erfa;
}


typedef unsigned short bf16_t;
using bf16x8 = __attribute__((ext_vector_type(8))) short;
using f32x4 = __attribute__((ext_vector_type(4))) float;
__device__ __forceinline__ bf16_t f2bf(float f) { unsigned u = __float_as_uint(f); u += 0x7FFFu + ((u >> 16) & 1u); return (bf16_t)(u >> 16); }
__device__ __forceinline__ unsigned char f2fp8(float v) { return (unsigned char)(__builtin_amdgcn_cvt_pk_fp8_f32(v, v, 0, false) & 0xFF); }
__device__ __forceinline__ float bf2f(bf16_t h) { return __uint_as_float(((unsigned)h) << 16); }
__device__ __forceinline__ unsigned pack2bf(float lo, float hi) { return (unsigned)f2bf(lo) | ((unsigned)f2bf(hi) << 16); }
__device__ __forceinline__ float bflo(unsigned w) { return __uint_as_float(w << 16); }
__device__ __forceinline__ float bfhi(unsigned w) { return __uint_as_float(w & 0xFFFF0000u); }


constexpr int LDA_B = 1024 * 2 + 16;
template <int RT, int K>
__device__ __forceinline__ void gemm_unit(const char* const (&ap)[RT], const bf16_t* __restrict__ w0, const bf16_t* __restrict__ w1, int kmul, f32x4 (&acc)[RT][2]) {
  constexpr int KI = K / 128, NS = 2;
#pragma unroll
  for (int t = 0; t < RT; ++t) { acc[t][0] = f32x4{0.f, 0.f, 0.f, 0.f}; acc[t][1] = f32x4{0.f, 0.f, 0.f, 0.f}; }
  bf16x8 b[NS][4][2];
#pragma unroll
  for (int st = 0; st < NS - 1; ++st) {
    if (st < KI) {
#pragma unroll
      for (int s2 = 0; s2 < 4; ++s2) { b[st][s2][0] = *(const bf16x8*)(w0 + (st * 128 + s2 * 32) * kmul); b[st][s2][1] = *(const bf16x8*)(w1 + (st * 128 + s2 * 32) * kmul); }
    }
  }
  asm volatile("" ::: "memory");
  bf16x8 an[RT];
#pragma unroll
  for (int t = 0; t < RT; ++t) an[t] = *(const bf16x8*)(ap[t]);
#pragma unroll
  for (int it = 0; it < KI; ++it) {
    if (it + NS - 1 < KI) {
#pragma unroll
      for (int s2 = 0; s2 < 4; ++s2) {
        b[(it + NS - 1) % NS][s2][0] = *(const bf16x8*)(w0 + ((it + NS - 1) * 128 + s2 * 32) * kmul);
        b[(it + NS - 1) % NS][s2][1] = *(const bf16x8*)(w1 + ((it + NS - 1) * 128 + s2 * 32) * kmul);
      }
    }
    asm volatile("" ::: "memory");
#pragma unroll
    for (int s2 = 0; s2 < 4; ++s2) {
      bf16x8 ac[RT];
#pragma unroll
      for (int t = 0; t < RT; ++t) ac[t] = an[t];
      if (it * 4 + s2 + 1 < KI * 4) {
#pragma unroll
        for (int t = 0; t < RT; ++t) an[t] = *(const bf16x8*)(ap[t] + (it * 128 + s2 * 32 + 32) * 2);
      }
#pragma unroll
      for (int t = 0; t < RT; ++t) {
        acc[t][0] = __builtin_amdgcn_mfma_f32_16x16x32_bf16(ac[t], b[it % NS][s2][0], acc[t][0], 0, 0, 0);
        acc[t][1] = __builtin_amdgcn_mfma_f32_16x16x32_bf16(ac[t], b[it % NS][s2][1], acc[t][1], 0, 0, 0);
      }
    }
  }
}
typedef __bf16 bf16raw2 __attribute__((ext_vector_type(2)));
__device__ __forceinline__ bf16x8 w8_frag(unsigned lo, unsigned hi) {
  const bf16raw2 e0 = __builtin_amdgcn_cvt_scalef32_pk_bf16_fp8(lo, 0.03125f, false), e1 = __builtin_amdgcn_cvt_scalef32_pk_bf16_fp8(lo, 0.03125f, true);
  const bf16raw2 e2 = __builtin_amdgcn_cvt_scalef32_pk_bf16_fp8(hi, 0.03125f, false), e3 = __builtin_amdgcn_cvt_scalef32_pk_bf16_fp8(hi, 0.03125f, true);
  uint4 w; w.x = *(const unsigned*)&e0; w.y = *(const unsigned*)&e1; w.z = *(const unsigned*)&e2; w.w = *(const unsigned*)&e3;
  return *(const bf16x8*)&w;
}
template <int RT, int K>
__device__ __forceinline__ void gemm_unit8(const char* const (&ap)[RT], const unsigned char* __restrict__ w0, const unsigned char* __restrict__ w1, f32x4 (&acc)[RT][2]) {
  constexpr int KI = K / 128, NS = 2;
#pragma unroll
  for (int t = 0; t < RT; ++t) { acc[t][0] = f32x4{0.f, 0.f, 0.f, 0.f}; acc[t][1] = f32x4{0.f, 0.f, 0.f, 0.f}; }
  uint4 b[NS][2][2];
#pragma unroll
  for (int st = 0; st < NS - 1; ++st) {
    if (st < KI) {
#pragma unroll
      for (int pr = 0; pr < 2; ++pr) { b[st][pr][0] = *(const uint4*)(w0 + (st * 2 + pr) * 1024); b[st][pr][1] = *(const uint4*)(w1 + (st * 2 + pr) * 1024); }
    }
  }
  asm volatile("" ::: "memory");
  bf16x8 an[RT];
#pragma unroll
  for (int t = 0; t < RT; ++t) an[t] = *(const bf16x8*)(ap[t]);
#pragma unroll
  for (int it = 0; it < KI; ++it) {
    if (it + NS - 1 < KI) {
#pragma unroll
      for (int pr = 0; pr < 2; ++pr) {
        b[(it + NS - 1) % NS][pr][0] = *(const uint4*)(w0 + ((it + NS - 1) * 2 + pr) * 1024);
        b[(it + NS - 1) % NS][pr][1] = *(const uint4*)(w1 + ((it + NS - 1) * 2 + pr) * 1024);
      }
    }
    asm volatile("" ::: "memory");
#pragma unroll
    for (int s2 = 0; s2 < 4; ++s2) {
      bf16x8 ac[RT];
#pragma unroll
      for (int t = 0; t < RT; ++t) ac[t] = an[t];
      if (it * 4 + s2 + 1 < KI * 4) {
#pragma unroll
        for (int t = 0; t < RT; ++t) an[t] = *(const bf16x8*)(ap[t] + (it * 128 + s2 * 32 + 32) * 2);
      }
      const uint4 q0 = b[it % NS][s2 >> 1][0], q1 = b[it % NS][s2 >> 1][1];
      const bf16x8 f0 = (s2 & 1) ? w8_frag(q0.z, q0.w) : w8_frag(q0.x, q0.y), f1 = (s2 & 1) ? w8_frag(q1.z, q1.w) : w8_frag(q1.x, q1.y);
#pragma unroll
      for (int t = 0; t < RT; ++t) {
        acc[t][0] = __builtin_amdgcn_mfma_f32_16x16x32_bf16(ac[t], f0, acc[t][0], 0, 0, 0);
        acc[t][1] = __builtin_amdgcn_mfma_f32_16x16x32_bf16(ac[t], f1, acc[t][1], 0, 0, 0);
      }
    }
  }
}
template <int RT, int K, class Epi>
__device__ __forceinline__ void gemm_ldsA8(const char* As, int lda_b, int nrows, const unsigned char* __restrict__ Wt, int N, Epi epi) {
  const int wave = otid() >> 6, lane = otid() & 63, l15 = lane & 15, q = lane >> 4;
  const char* ap[RT];
#pragma unroll
  for (int t = 0; t < RT; ++t) { int r = t * 16 + l15; r = r < nrows ? r : nrows - 1; ap[t] = As + r * lda_b + q * 16; }
#pragma unroll 1
  for (int unit = wave; unit < (N >> 5); unit += 8) {
    const int n0 = unit * 32;
    const unsigned char* w0 = Wt + (size_t)(n0 >> 4) * K * 16 + lane * 16;
    f32x4 acc[RT][2];
    gemm_unit8<RT, K>(ap, w0, w0 + (size_t)K * 16, acc);
#pragma unroll
    for (int t = 0; t < RT; ++t)
#pragma unroll
      for (int j = 0; j < 2; ++j)
#pragma unroll
        for (int r = 0; r < 4; ++r) {
          const int row = t * 16 + q * 4 + r, col = n0 + j * 16 + l15;
          if (row < nrows) epi(row, col, acc[t][j][r]);
        }
  }
}
template <int RT, int K, class Epi>
__device__ __forceinline__ void gemm_ldsA(const char* As, int lda_b, int nrows, const bf16_t* __restrict__ Wt, int N, Epi epi) {
  const int wave = otid() >> 6, lane = otid() & 63, l15 = lane & 15, q = lane >> 4;
  const char* ap[RT];
#pragma unroll
  for (int t = 0; t < RT; ++t) { int r = t * 16 + l15; r = r < nrows ? r : nrows - 1; ap[t] = As + r * lda_b + q * 16; }
#pragma unroll 1
  for (int unit = wave; unit < (N >> 5); unit += 8) {
    const int n0 = unit * 32;
    const bf16_t* w0 = Wt + (size_t)(n0 >> 4) * K * 16 + lane * 8;
    f32x4 acc[RT][2];
    gemm_unit<RT, K>(ap, w0, w0 + (size_t)K * 16, 16, acc);
#pragma unroll
    for (int t = 0; t < RT; ++t)
#pragma unroll
      for (int j = 0; j < 2; ++j)
#pragma unroll
        for (int r = 0; r < 4; ++r) {
          const int row = t * 16 + q * 4 + r, col = n0 + j * 16 + l15;
          if (row < nrows) epi(row, col, acc[t][j][r]);
        }
  }
}
struct EpiBF16 { bf16_t* C; int ldc; __device__ __forceinline__ void operator()(int row, int col, float v) const { C[(size_t)row * ldc + col] = f2bf(v); } };
struct EpiF32 { float* C; int ldc; __device__ __forceinline__ void operator()(int row, int col, float v) const { C[(size_t)row * ldc + col] = v; } };
struct EpiGluL { const char* As; bf16_t* V; __device__ __forceinline__ void operator()(int row, int col, float z) const {
  const float g = bf2f(*(const bf16_t*)(As + row * LDA_B + col * 2)); V[(size_t)row * D + col] = f2bf(g / (1.f + expf(-z))); } };

__device__ __forceinline__ void load_rows_lds(char* As, const bf16_t* __restrict__ src, int nrows) {
  const int t = otid(), total = nrows * 128;
#pragma unroll
  for (int h = 0; h < 2; ++h) {
    uint4 v[9];
#pragma unroll
    for (int k = 0; k < 9; ++k) { int i = t + (h * 9 + k) * 512; i = i < total ? i : total - 1; v[k] = *(const uint4*)(src + (size_t)(i >> 7) * D + (i & 127) * 8); }
#pragma unroll
    for (int k = 0; k < 9; ++k) { const int i = t + (h * 9 + k) * 512; if (i < total) *(uint4*)(As + (i >> 7) * LDA_B + (i & 127) * 16) = v[k]; }
  }
}
__device__ __forceinline__ void ln_rows(char* As, int g0, int nrows, const float* Hl, const float* Hc, const bf16_t* __restrict__ O,
                                        const float* __restrict__ mod, int gate_i, const float* __restrict__ lng, const float* __restrict__ lnb,
                                        float* Hout, bf16_t* __restrict__ Tbf, int shift_i, int scale_i) {
  const int wave = otid() >> 6, lane = otid() & 63;
  for (int rr = wave; rr < nrows; rr += 8) {
    const int row = g0 + rr;
    const float* hin = row < NL ? Hl + (size_t)row * D : Hc + (size_t)(row - NL) * D;
    const bf16_t* f = O + (size_t)row * D;
    const float* m = mod + row_vec(row) * 6144;
    const float* gm = m + gate_i * 1024;
    float r[16]; float s = 0.f;
#pragma unroll
    for (int i = 0; i < 4; ++i) {
      const int d = i * 256 + lane * 4;
      const uint2 fw = *(const uint2*)(f + d);
      float4 h4 = *(const float4*)(hin + d), f4 = make_float4(bflo(fw.x), bfhi(fw.x), bflo(fw.y), bfhi(fw.y)), g4 = *(const float4*)(gm + d);
      r[i * 4 + 0] = ALPHA * h4.x + g4.x * f4.x; r[i * 4 + 1] = ALPHA * h4.y + g4.y * f4.y;
      r[i * 4 + 2] = ALPHA * h4.z + g4.z * f4.z; r[i * 4 + 3] = ALPHA * h4.w + g4.w * f4.w;
      s += r[i * 4 + 0] + r[i * 4 + 1] + r[i * 4 + 2] + r[i * 4 + 3];
    }
    const float mu = wave_sum(s) * (1.f / D);
    float vs = 0.f;
#pragma unroll
    for (int i = 0; i < 16; ++i) { float dlt = r[i] - mu; vs += dlt * dlt; }
    const float rstd = rsqrtf(wave_sum(vs) * (1.f / D) + LN_EPS);
#pragma unroll
    for (int i = 0; i < 4; ++i) {
      const int d = i * 256 + lane * 4;
      float4 g4 = *(const float4*)(lng + d), b4 = *(const float4*)(lnb + d);
      float4 o;
      o.x = (r[i * 4 + 0] - mu) * rstd * g4.x + b4.x; o.y = (r[i * 4 + 1] - mu) * rstd * g4.y + b4.y;
      o.z = (r[i * 4 + 2] - mu) * rstd * g4.z + b4.z; o.w = (r[i * 4 + 3] - mu) * rstd * g4.w + b4.w;
      *(float4*)(Hout + (size_t)row * D + d) = o;
      float4 sh = *(const float4*)(m + shift_i * 1024 + d), sc = *(const float4*)(m + scale_i * 1024 + d);
      const float t0 = o.x * (1.f + sc.x) + sh.x, t1 = o.y * (1.f + sc.y) + sh.y, t2 = o.z * (1.f + sc.z) + sh.z, t3 = o.w * (1.f + sc.w) + sh.w;
      uint2 w; w.x = pack2bf(t0, t1); w.y = pack2bf(t2, t3);
      *(uint2*)(As + rr * LDA_B + d * 2) = w;
      *(uint2*)(Tbf + (size_t)row * D + d) = w;

    }
  }
}


constexpr int S5T = 64, NCHUNK = (CTX + SEQ) / S5T  , NCC = NB * NCHUNK  ;
__device__ __forceinline__ int s5_token(int cc, int s) {
  const int b = cc / NCHUNK, ch = cc - b * NCHUNK;
  return ch < 4 ? NL + b * CTX + ch * S5T + s : b * SEQ + (ch - 4) * S5T + s;
}
__device__ __forceinline__ void cbar(volatile int* cnt, int& gen, int nwaves) {
  __builtin_amdgcn_fence(__ATOMIC_RELEASE, "workgroup");
  if ((otid() & 63) == 0) __hip_atomic_fetch_add((int*)cnt, 1, __ATOMIC_RELAXED, __HIP_MEMORY_SCOPE_WORKGROUP);
  ++gen;
  while (__hip_atomic_load((int*)cnt, __ATOMIC_RELAXED, __HIP_MEMORY_SCOPE_WORKGROUP) < gen * nwaves) __builtin_amdgcn_s_sleep(1);
  __builtin_amdgcn_fence(__ATOMIC_ACQUIRE, "workgroup");
}
__device__ __forceinline__ void ph_s5_prep(const float* __restrict__ a_re, const float* __restrict__ a_im, const float* __restrict__ log_dt,
                                                 const float* __restrict__ b_re, const float* __restrict__ b_im, const float* __restrict__ c_re, const float* __restrict__ c_im,
                                                 bf16_t* __restrict__ Ktab, bf16_t* __restrict__ Bst_t, bf16_t* __restrict__ Cin_t, int g, int part, char* lds, int tid, int nct, volatile int* cbc, int& cgen) {
  float2 (*pw)[65][64] = reinterpret_cast<float2 (*)[65][64]>(lds);
  float2 (*Bp)[64][16] = reinterpret_cast<float2 (*)[64][16]>(lds + 2 * 65 * 64 * 8);
  float2 (*Cc)[16][64] = reinterpret_cast<float2 (*)[16][64]>(lds + 2 * 65 * 64 * 8 + 2 * 64 * 16 * 8);
  float2 (*fs)[64] = reinterpret_cast<float2 (*)[64]>(lds + 2 * 65 * 64 * 8 + 2 * 64 * 16 * 8 + 2 * 16 * 64 * 8);
  if (tid < 128) {
    const int dir = tid >> 6, p = tid & 63, gp = (dir * 64 + g) * 64 + p;
    const float are = a_re[gp], aim = a_im[gp], dt = expf(log_dt[dir * 64 + g]);
    const float mag = expf(are * dt);
    const float abr = mag * cosf(aim * dt), abi = mag * sinf(aim * dt);
    const float nr = abr - 1.f, ni = abi, den = are * are + aim * aim;
    fs[dir][p] = make_float2((nr * are + ni * aim) / den, (ni * are - nr * aim) / den);
    float pr = 1.f, pi = 0.f;
    for (int e = 0; e <= 64; ++e) { pw[dir][e][p] = make_float2(pr, pi); const float nr2 = pr * abr - pi * abi, ni2 = pr * abi + pi * abr; pr = nr2; pi = ni2; }
  }
  cbar(cbc, cgen, nct >> 6);
  for (int i = tid; i < 2048; i += nct) {
    const int dir = i >> 10, p = (i >> 4) & 63, ci = i & 15;
    const size_t gi = ((size_t)(dir * 64 + g) * 64 + p) * 16 + ci;
    const float br = b_re[gi], bi = b_im[gi]; const float2 f = fs[dir][p];
    Bp[dir][p][ci] = make_float2(f.x * br - f.y * bi, f.x * bi + f.y * br);
    const int co = (i >> 6) & 15, p2 = i & 63;
    const size_t ci2 = ((size_t)(dir * 64 + g) * 16 + co) * 64 + p2;
    Cc[dir][co][p2] = make_float2(c_re[ci2], c_im[ci2]);
  }
  cbar(cbc, cgen, nct >> 6);
  for (int i = part * 508 + tid; i < (part + 1) * 508; i += nct) {
    const int ti = i >> 4, co = i & 15, tau = ti - 63;
    float acc[16];
#pragma unroll
    for (int ci = 0; ci < 16; ++ci) acc[ci] = 0.f;
    if (tau >= 0) {
      for (int p = 0; p < 64; ++p) {
        const float2 c = Cc[0][co][p], w = pw[0][tau][p];
        const float xr = c.x * w.x - c.y * w.y, xi = c.x * w.y + c.y * w.x;
#pragma unroll
        for (int ci = 0; ci < 16; ++ci) { const float2 bb = Bp[0][p][ci]; acc[ci] += xr * bb.x - xi * bb.y; }
      }
    }
    if (tau <= 0) {
      for (int p = 0; p < 64; ++p) {
        const float2 c = Cc[1][co][p], w = pw[1][-tau][p];
        const float xr = c.x * w.x - c.y * w.y, xi = c.x * w.y + c.y * w.x;
#pragma unroll
        for (int ci = 0; ci < 16; ++ci) { const float2 bb = Bp[1][p][ci]; acc[ci] += xr * bb.x - xi * bb.y; }
      }
    }
    uint4 o0, o1;
    o0.x = pack2bf(acc[0], acc[1]); o0.y = pack2bf(acc[2], acc[3]); o0.z = pack2bf(acc[4], acc[5]); o0.w = pack2bf(acc[6], acc[7]);
    o1.x = pack2bf(acc[8], acc[9]); o1.y = pack2bf(acc[10], acc[11]); o1.z = pack2bf(acc[12], acc[13]); o1.w = pack2bf(acc[14], acc[15]);
    bf16_t* kp = Ktab + (size_t)g * 127 * 256 + (size_t)i * 16;
    *(uint4*)kp = o0; *(uint4*)(kp + 8) = o1;
  }
  for (int i = part * 8192 + tid; i < (part + 1) * 8192; i += nct) {
    const int n = (i >> 11) * 16 + (i & 15), k8 = ((i >> 6) & 31) * 4 + ((i >> 4) & 3);
    const int dir = n >> 7, c = (n >> 6) & 1, p = n & 63, sidx = k8 >> 1, ci0 = (k8 & 1) * 8;
    const float2 w = pw[dir][dir == 0 ? 63 - sidx : sidx][p];
    float v[8];
#pragma unroll
    for (int j = 0; j < 8; ++j) { const float2 b = Bp[dir][p][ci0 + j]; v[j] = c == 0 ? (w.x * b.x - w.y * b.y) : (w.x * b.y + w.y * b.x); }
    uint4 o; o.x = pack2bf(v[0], v[1]); o.y = pack2bf(v[2], v[3]); o.z = pack2bf(v[4], v[5]); o.w = pack2bf(v[6], v[7]);
    *(uint4*)(Bst_t + (size_t)g * 256 * 1024 + (size_t)i * 8) = o;
  }
  for (int i = part * 8192 + tid; i < (part + 1) * 8192; i += nct) {
    const int n = (i >> 9) * 16 + (i & 15), k8 = ((i >> 6) & 7) * 4 + ((i >> 4) & 3);
    const int t = n >> 4, co = n & 15, dir = k8 >> 4, c = (k8 >> 3) & 1, p0 = (k8 & 7) * 8;
    const int e = dir == 0 ? t + 1 : 64 - t;
    float v[8];
#pragma unroll
    for (int j = 0; j < 8; ++j) { const float2 cc = Cc[dir][co][p0 + j], w = pw[dir][e][p0 + j];
      v[j] = c == 0 ? (cc.x * w.x - cc.y * w.y) : -(cc.x * w.y + cc.y * w.x); }
    uint4 o; o.x = pack2bf(v[0], v[1]); o.y = pack2bf(v[2], v[3]); o.z = pack2bf(v[4], v[5]); o.w = pack2bf(v[6], v[7]);
    *(uint4*)(Cin_t + (size_t)g * 1024 * 256 + (size_t)i * 8) = o;
  }
}
__device__ __forceinline__ void ph_s5_p1(const float* __restrict__ x, const float* __restrict__ ctx, const float* __restrict__ mod,
                                               const bf16_t* __restrict__ Ktab, const bf16_t* __restrict__ Bst_t, const float* __restrict__ dvec, bf16_t* __restrict__ Ypart, float* __restrict__ S, int bid, char* As) {
  const int g = bid >> 2, cc0 = (bid & 3) * 66, tid = otid();
  const int wave = tid >> 6, lane = tid & 63, l15 = lane & 15, q = lane >> 4;
  const float dch = dvec[g * 16 + l15];
#pragma unroll 4
  for (int i = tid; i < 66 * 64 * 2; i += 512) {
    const int half = i & 1, sidx = (i >> 1) & 63, r = i >> 7;
    const int tok = s5_token(cc0 + r, sidx), ch = g * 16 + half * 8;
    const float* src = (tok < NL ? x + (size_t)tok * D : ctx + (size_t)(tok - NL) * D) + ch;
    const float* m = mod + row_vec(tok) * 6144;
    const float4 a = *(const float4*)src, b = *(const float4*)(src + 4);
    const float4 sh0 = *(const float4*)(m + ch), sh1 = *(const float4*)(m + ch + 4), sc0 = *(const float4*)(m + 1024 + ch), sc1 = *(const float4*)(m + 1024 + ch + 4);
    uint4 o;
    o.x = pack2bf(a.x * (1.f + sc0.x) + sh0.x, a.y * (1.f + sc0.y) + sh0.y); o.y = pack2bf(a.z * (1.f + sc0.z) + sh0.z, a.w * (1.f + sc0.w) + sh0.w);
    o.z = pack2bf(b.x * (1.f + sc1.x) + sh1.x, b.y * (1.f + sc1.y) + sh1.y); o.w = pack2bf(b.z * (1.f + sc1.z) + sh1.z, b.w * (1.f + sc1.w) + sh1.w);
    *(uint4*)(As + r * LDA_B + sidx * 32 + half * 16) = o;
  }
  __syncthreads();
  const char* ap[5];
#pragma unroll
  for (int t = 0; t < 5; ++t) { int r = t * 16 + l15; r = r < 66 ? r : 65; ap[t] = As + r * LDA_B + q * 16; }
  const bf16_t* Kg = Ktab + (size_t)g * 127 * 256;
#pragma unroll 1
  for (int unit = wave; unit < 40; unit += 8) {
    f32x4 acc[5][2];
    if (unit < 32) {
      const int t0 = unit * 2;
      const bf16_t* w0 = Kg + (t0 + 63 - (q >> 1)) * 256 + l15 * 16 + (q & 1) * 8;
      gemm_unit<5, 1024>(ap, w0, w0 + 256, -16, acc);
#pragma unroll
      for (int t = 0; t < 5; ++t)
#pragma unroll
        for (int j = 0; j < 2; ++j)
#pragma unroll
          for (int r = 0; r < 4; ++r) {
            const int row = t * 16 + q * 4 + r;
            if (row < 66) Ypart[(size_t)s5_token(cc0 + row, t0 + j) * D + g * 16 + l15] = f2bf(acc[t][j][r] + dch * bf2f(*(const bf16_t*)(As + row * LDA_B + (t0 + j) * 32 + l15 * 2)));
          }
    } else {
      const int n0 = (unit - 32) * 32;
      const bf16_t* w0 = Bst_t + (size_t)g * 256 * 1024 + (size_t)(n0 >> 4) * 1024 * 16 + lane * 8;
      gemm_unit<5, 1024>(ap, w0, w0 + 1024 * 16, 16, acc);
#pragma unroll
      for (int t = 0; t < 5; ++t)
#pragma unroll
        for (int j = 0; j < 2; ++j)
#pragma unroll
          for (int r = 0; r < 4; ++r) {
            const int row = t * 16 + q * 4 + r;
            if (row < 66) S[((size_t)(cc0 + row) * 64 + g) * 256 + n0 + j * 16 + l15] = acc[t][j][r];
          }
    }
  }
}
__device__ __forceinline__ void ph_s5_carry(const float* __restrict__ S, const float* __restrict__ a_re, const float* __restrict__ a_im,
                                                 const float* __restrict__ log_dt, bf16_t* __restrict__ HP, int id, int p) {
  const int dir = id & 1, g = (id >> 1) & 63, b = id >> 7;
  const int gp = (dir * 64 + g) * 64 + p;
  const float are = a_re[gp], aim = a_im[gp], dt = expf(log_dt[dir * 64 + g]);
  const float mag = expf(are * dt);
  float tr = mag * cosf(aim * dt), ti = mag * sinf(aim * dt);
#pragma unroll
  for (int i = 0; i < 6; ++i) { const float nr = tr * tr - ti * ti, ni = 2.f * tr * ti; tr = nr; ti = ni; }
  float hr = 0.f, hi = 0.f;
#pragma unroll 12
  for (int step = 0; step < NCHUNK; ++step) {
    const int c = dir == 0 ? step : (step < 4 ? 3 - step : NCHUNK - 1 - (step - 4));
    const size_t base = ((size_t)(b * NCHUNK + c) * 64 + g) * 256 + dir * 128 + p;
    HP[base] = f2bf(hr); HP[base + 64] = f2bf(hi);
    const float sr = S[base], si = S[base + 64];
    const float nr = tr * hr - ti * hi + sr, ni = tr * hi + ti * hr + si;
    hr = nr; hi = ni;
  }
}
struct EpiS5 { const bf16_t* Ypart; bf16_t* Gbf; int cc0; int ch;
  __device__ __forceinline__ void operator()(int row, int col, float v) const {
    const size_t o = (size_t)s5_token(cc0 + row, col >> 4) * D + ch;
    Gbf[o] = f2bf(gelu_fast(v + bf2f(Ypart[o])));
  } };
__device__ __forceinline__ void ph_s5_p3(const bf16_t* __restrict__ HP, const bf16_t* __restrict__ Cin_t, const bf16_t* __restrict__ Ypart, bf16_t* __restrict__ Gbf, int bid, char* As) {
  const int g = bid >> 2, cc0 = (bid & 3) * 66, tid = otid();
  for (int i = tid; i < 66 * 32; i += 512) {
    const int r = i >> 5, c = i & 31;
    *(uint4*)(As + r * 528 + c * 16) = *(const uint4*)(HP + ((size_t)(cc0 + r) * 64 + g) * 256 + c * 8);
  }
  __syncthreads();
  gemm_ldsA<5, 256>(As, 528, 66, Cin_t + (size_t)g * 1024 * 256, 1024, EpiS5{Ypart, Gbf, cc0, g * 16 + (otid() & 15)});
}


struct ChainP {
  const bf16_t* Ain;
  const bf16_t* Wglu_t; const bf16_t* Wo_t; const bf16_t* Wq_t;
  bf16_t* Vbf; bf16_t* O; const float* Hl; const float* Hc; const float* mod; const float* lng; const float* lnb;
  float* Hout; bf16_t* Tbf; bf16_t* Q;
};
template <bool L0>
__device__ __forceinline__ void ph_chainA(const ChainP& p, int bid, char* As) {
  constexpr int NR = L0 ? 66 : 64;
  constexpr int RT = L0 ? 5 : 4;
  const int g0 = bid * NR;
  load_rows_lds(As, p.Ain + (size_t)g0 * D, NR);
  __syncthreads();
  if (L0) {
    gemm_ldsA<RT, 1024>(As, LDA_B, NR, p.Wglu_t, D, EpiGluL{As, p.Vbf + (size_t)g0 * D});
    __syncthreads();
    load_rows_lds(As, p.Vbf + (size_t)g0 * D, NR);
    __syncthreads();
  }
  if constexpr (L0) gemm_ldsA<RT, 1024>(As, LDA_B, NR, p.Wo_t, D, EpiBF16{p.O + (size_t)g0 * D, D});
  else gemm_ldsA8<RT, 1024>(As, LDA_B, NR, (const unsigned char*)p.Wo_t, D, EpiBF16{p.O + (size_t)g0 * D, D});
  __syncthreads();
  ln_rows(As, g0, NR, p.Hl, p.Hc, p.O, p.mod, 2, p.lng, p.lnb, p.Hout, p.Tbf, 3, 4);
  __syncthreads();
  gemm_ldsA<RT, 1024>(As, LDA_B, NR, p.Wq_t, D, EpiBF16{p.Q + (size_t)g0 * D, D});
}


constexpr int KEYS = SEQ + CTX;
constexpr float att_KS = 0.5f;
struct EpiKV { unsigned char* Kn; unsigned char* Vl; int g0; int sh; __device__ __forceinline__ void operator()(int row, int col, float v) const {
  const int head = col >> 8, j = col & 255;
  if (j < 128) {
    const int g = g0 + row; int b, key;
    if (g < NL) { b = g >> 13; key = g & (SEQ - 1); } else { const int cidx = g - NL; b = cidx >> 8; key = SEQ + (cidx & (CTX - 1)); }
    Kn[((size_t)(b * 8 + head) * KEYS + key) * 128 + j] = f2fp8(v * att_KS);
  } else Vl[(head * 128 + (j - 128)) * 68 + row + sh] = f2fp8(v * 4.f);
} };
struct EpiQ { bf16_t* Qa; int g0; int pad; __device__ __forceinline__ void operator()(int row, int col, float v) const {
  const int g = g0 + row, b = g >> 13, n = g & (SEQ - 1);
  const int head = col / 192, j = col - head * 192;
  Qa[((size_t)(b * 8 + head) * SEQ + n) * 192 + j] = f2bf(v);
} };
struct ProjP { const bf16_t* Wcat_t; const bf16_t* Wuq_t; const bf16_t* Wukv_t; const float* q_norm; const float* kv_norm;
               float* PR; bf16_t* Qa; unsigned char* Kn; unsigned char* Kr; unsigned char* Va; };
__device__ __forceinline__ void ph_mla_proj(const ProjP& p, int bid, char* As) {
  const int g0 = bid * 66, wave = otid() >> 6, lane = otid() & 63;
  gemm_ldsA8<5, 1024>(As, LDA_B, 66, (const unsigned char*)p.Wcat_t, 704, EpiF32{p.PR + (size_t)g0 * D, D});
  __syncthreads();
  char* A1 = As; char* A2 = As + 66 * 784;
  for (int rr = wave; rr < 66; rr += 8) {
    const int g = g0 + rr;
    const float* pr = p.PR + (size_t)g * D;
    float v[6]; float ss = 0.f;
#pragma unroll
    for (int i = 0; i < 6; ++i) { v[i] = pr[i * 64 + lane]; ss += v[i] * v[i]; }
    float rn = rsqrtf(wave_sum(ss) * (1.f / 384.f) + RMS_EPS);
#pragma unroll
    for (int i = 0; i < 6; ++i) *(bf16_t*)(A1 + rr * 784 + (i * 64 + lane) * 2) = f2bf(v[i] * rn * p.q_norm[i * 64 + lane]);
    float w[4]; ss = 0.f;
#pragma unroll
    for (int i = 0; i < 4; ++i) { w[i] = pr[384 + i * 64 + lane]; ss += w[i] * w[i]; }
    rn = rsqrtf(wave_sum(ss) * (1.f / 256.f) + RMS_EPS);
#pragma unroll
    for (int i = 0; i < 4; ++i) *(bf16_t*)(A2 + rr * 528 + (i * 64 + lane) * 2) = f2bf(w[i] * rn * p.kv_norm[i * 64 + lane]);
    if (lane < 32) {
      float x1 = pr[640 + lane], x2 = pr[672 + lane];
      int b, key;
      if (g < NL) {
        b = g >> 13; key = g & (SEQ - 1);
        const int n = key, rr2 = n >> 6, cc = n & 63;
        const float inv = powf(10000.f, -(float)(lane & 15) / 16.f);
        const float ang = (lane < 16 ? (float)rr2 : (float)cc) * inv;
        const float cs = cosf(ang), sn = sinf(ang);
        const float y1 = x1 * cs - x2 * sn, y2 = x2 * cs + x1 * sn; x1 = y1; x2 = y2;
      } else { const int cidx = g - NL; b = cidx >> 8; key = SEQ + (cidx & (CTX - 1)); }
      unsigned char* kp = p.Kr + ((size_t)b * KEYS + key) * 64;
      kp[lane] = f2fp8(x1 * att_KS); kp[32 + lane] = f2fp8(x2 * att_KS);
    }
  }
  __syncthreads();
  int nq = NL - g0; nq = nq > 66 ? 66 : nq;
  if (nq > 0) gemm_ldsA8<5, 384>(A1, 784, nq, (const unsigned char*)p.Wuq_t, 1536, EpiQ{p.Qa, g0, 0});
  unsigned char* Vl = (unsigned char*)As + 66 * 784 + 66 * 528;
  const int sh = g0 & 3;
  gemm_ldsA8<5, 256>(A2, 528, 66, (const unsigned char*)p.Wukv_t, 2048, EpiKV{p.Kn, Vl, g0, sh});
  __syncthreads();
  for (int i = otid(); i < 1024 * 17; i += 512) {
    const int dvg = i / 17, q4 = i - dvg * 17, g4 = g0 - sh + 4 * q4;
    const unsigned w = *(const unsigned*)(Vl + dvg * 68 + 4 * q4);
    int b, key;
    if (g4 < NL) { b = g4 >> 13; key = g4 & (SEQ - 1); } else { const int cidx = g4 - NL; b = cidx >> 8; key = SEQ + (cidx & (CTX - 1)); }
    const int m = (key & 63) >> 2, posd = (m & 1) * 8 + (m >> 3) * 4 + ((m >> 1) & 3);
    unsigned char* dst = p.Va + ((size_t)(b * 8 + (dvg >> 7)) * (KEYS / 64) + (key >> 6)) * 8192 + (dvg & 127) * 64 + posd * 4;
    if (g4 >= g0 && g4 + 3 < g0 + 66) *(unsigned*)dst = w;
    else if (g4 < g0) *(unsigned short*)(dst + 2) = (unsigned short)(w >> 16);
    else *(unsigned short*)dst = (unsigned short)(w & 0xFFFFu);
  }
  for (int rr = wave; rr < nq; rr += 8) {
    const int g = g0 + rr, b = g >> 13, n = g & (SEQ - 1);
    if (lane < 32) {
      const float inv = powf(10000.f, -(float)(lane & 15) / 16.f);
      const float ang = (lane < 16 ? (float)(n >> 6) : (float)(n & 63)) * inv;
      const float cs = cosf(ang), sn = sinf(ang);
#pragma unroll
      for (int h = 0; h < 8; ++h) {
        bf16_t* qo = p.Qa + ((size_t)(b * 8 + h) * SEQ + n) * 192;
        const float x1 = bf2f(qo[128 + lane]), x2 = bf2f(qo[160 + lane]);
        qo[128 + lane] = f2bf(x1 * cs - x2 * sn); qo[160 + lane] = f2bf(x2 * cs + x1 * sn);
      }
    }
  }
}

namespace att {
using i32x8 = __attribute__((ext_vector_type(8))) int;
using i32x4 = __attribute__((ext_vector_type(4))) int;
using f32x16 = __attribute__((ext_vector_type(16))) float;
constexpr int KVBLK = 64, KROW = 208, VROW = 80, NTILE = KEYS / 64;
constexpr float KS = 0.5f, VS = 4.f;
constexpr float QS = 0.07216878364870322f * 1.4426950408889634f / KS;
constexpr float THR2 = 3.f * 1.4426950408889634f, PSH = 4.f;
constexpr int SHM_V = 128 * VROW, SHM_K = KVBLK * KROW, NSLOT = 3, SHM_ATTN = NSLOT * (SHM_V + SHM_K) + 8 * 64 * 4;
#define SBAR() __builtin_amdgcn_sched_barrier(0)
__device__ __forceinline__ int crow(int r, int hi) { return (r & 3) + 8 * (r >> 2) + 4 * hi; }
__device__ __forceinline__ f32x16 mfma8(i32x8 a, i32x8 b, f32x16 c) { return __builtin_amdgcn_mfma_scale_f32_32x32x64_f8f6f4(a, b, c, 0, 0, 0, 0, 0, 0); }
__device__ __forceinline__ i32x8 cat8(i32x4 a, i32x4 b) { return __builtin_shufflevector(a, b, 0, 1, 2, 3, 4, 5, 6, 7); }
__device__ __forceinline__ int pk4(float a, float b, float c, float d, int old = 0) { const int w = __builtin_amdgcn_cvt_pk_fp8_f32(a, b, old, false); return __builtin_amdgcn_cvt_pk_fp8_f32(c, d, w, true); }
__device__ __forceinline__ void softmax_tile(f32x16& p0, f32x16& p1, f32x16& bias, bool first, f32x16* o, float* al_l, int r32, int hi, i32x8& pa) {
  float pmax = p0[0];
#pragma unroll
  for (int r = 1; r < 16; ++r) pmax = fmaxf(pmax, p0[r]);
#pragma unroll
  for (int r = 0; r < 16; ++r) pmax = fmaxf(pmax, p1[r]);
  { auto rr = __builtin_amdgcn_permlane32_swap(__float_as_uint(pmax), __float_as_uint(pmax), false, false);
    pmax = fmaxf(__uint_as_float(rr[0]), __uint_as_float(rr[1])); }
  if (__builtin_expect(first || !__all(pmax <= PSH + THR2), 0)) {
    const float delta = first ? pmax - PSH : fmaxf(pmax - PSH, 0.f);
    if (!first) {
      if (hi == 0) al_l[r32] = __builtin_amdgcn_exp2f(-delta);
      asm volatile("s_waitcnt lgkmcnt(0)" ::: "memory");
#pragma unroll
      for (int d = 0; d < 5; ++d)
#pragma unroll
        for (int r = 0; r < 16; ++r) o[d][r] *= al_l[crow(r, hi)];
    }
    const float nb = bias[0] - delta;
#pragma unroll
    for (int r = 0; r < 16; ++r) { p0[r] -= delta; p1[r] -= delta; bias[r] = nb; }
  }
#pragma unroll
  for (int r = 0; r < 16; ++r) p0[r] = __builtin_amdgcn_exp2f(p0[r]);
#pragma unroll
  for (int r = 0; r < 16; ++r) p1[r] = __builtin_amdgcn_exp2f(p1[r]);
#pragma unroll
  for (int w = 0; w < 4; ++w) { pa[w] = pk4(p0[4 * w], p0[4 * w + 1], p0[4 * w + 2], p0[4 * w + 3], pa[w]); pa[4 + w] = pk4(p1[4 * w], p1[4 * w + 1], p1[4 * w + 2], p1[4 * w + 3], pa[4 + w]); }
}
__device__ __forceinline__ void qkt(f32x16& p0, f32x16& p1, const f32x16& bias, const char* Ks, const i32x8* q, int r32, int hi) {
  p0 = bias; p1 = bias;
  const char* k0 = Ks + r32 * KROW + hi * 32; const char* k1 = k0 + 32 * KROW;
#pragma unroll
  for (int s = 0; s < 3; ++s) {
    const i32x8 a0 = cat8(*reinterpret_cast<const i32x4*>(k0 + s * 64), *reinterpret_cast<const i32x4*>(k0 + s * 64 + 16));
    const i32x8 a1 = cat8(*reinterpret_cast<const i32x4*>(k1 + s * 64), *reinterpret_cast<const i32x4*>(k1 + s * 64 + 16));
    p0 = mfma8(a0, q[s], p0);
    p1 = mfma8(a1, q[s], p1); }
}
__device__ __forceinline__ void pv_all(f32x16* o, const char* Vs, i32x8 pa, int r32, int hi) {
  const char* v0 = Vs + r32 * VROW + hi * 32;
#pragma unroll
  for (int d0 = 0; d0 < 4; ++d0) {
    const i32x8 vb = cat8(*reinterpret_cast<const i32x4*>(v0 + d0 * 32 * VROW), *reinterpret_cast<const i32x4*>(v0 + d0 * 32 * VROW + 16));
    o[d0] = mfma8(pa, vb, o[d0]); }
  const i32x8 ones = {0x38383838, 0x38383838, 0x38383838, 0x38383838, 0x38383838, 0x38383838, 0x38383838, 0x38383838};
  o[4] = mfma8(pa, ones, o[4]);
}
__device__ __forceinline__ void attn_body(const bf16_t* __restrict__ Qb, const unsigned char* __restrict__ Kn, const unsigned char* __restrict__ Krb, const unsigned char* __restrict__ Vt,
                                          bf16_t* __restrict__ Ob, char* lds) {
  const int tid = otid(), wid = tid >> 6, lane = tid & 63, r32 = lane & 31, hi = lane >> 5;
  const bool lo4 = __builtin_amdgcn_readfirstlane(wid >> 2) == 0;
  char* V_lds = lds; char* K_lds = lds + NSLOT * SHM_V;
  float* al_l = (float*)(lds + NSLOT * (SHM_V + SHM_K)) + wid * 64;
  f32x16 bias = {}; f32x16 o[5] = {}; i32x8 q[3];
  { const bf16_t* Qw = Qb + (size_t)(wid * 32 + r32) * 192 + hi * 32;
#pragma unroll
    for (int s = 0; s < 3; ++s) {
#pragma unroll
      for (int c = 0; c < 4; ++c) { const uint4 w = *reinterpret_cast<const uint4*>(Qw + s * 64 + c * 8);
        q[s][2 * c] = pk4(bflo(w.x) * QS, bfhi(w.x) * QS, bflo(w.y) * QS, bfhi(w.y) * QS);
        q[s][2 * c + 1] = pk4(bflo(w.z) * QS, bfhi(w.z) * QS, bflo(w.w) * QS, bfhi(w.w) * QS); } } }
  i32x8 ones = {0x38383838, 0x38383838, 0x38383838, 0x38383838, 0x38383838, 0x38383838, 0x38383838, 0x38383838};
  const int vdst = (tid >> 2) * VROW + (tid & 3) * 16, kdst = (tid >> 3) * KROW + (tid & 7) * 16, rdst = (tid >> 2) * KROW + 128 + (tid & 3) * 16;
  const int kfo = r32 * KROW + hi * 32, vfo = r32 * VROW + hi * 32;
  uint4 vs, ks, rs = make_uint4(0u, 0u, 0u, 0u);
#define TLOAD(t) do { ks = *reinterpret_cast<const uint4*>(Kn + (size_t)(t) * 8192 + tid * 16); vs = *reinterpret_cast<const uint4*>(Vt + (size_t)(t) * 8192 + tid * 16); \
    if (lo4) rs = *reinterpret_cast<const uint4*>(Krb + (size_t)(t) * 4096 + tid * 16); } while (0)
#define TWRITE(sl) do { *(uint4*)(K_lds + (sl) * SHM_K + kdst) = ks; *(uint4*)(V_lds + (sl) * SHM_V + vdst) = vs; if (lo4) *(uint4*)(K_lds + (sl) * SHM_K + rdst) = rs; } while (0)
#define SWAIT() asm volatile("s_waitcnt vmcnt(0)" ::: "memory")
#define LD4(p) (*reinterpret_cast<const i32x4*>(p))
  f32x16 p0, p1; i32x8 pa = {};
  TLOAD(0); SWAIT(); TWRITE(0);
  TLOAD(1); SWAIT(); TWRITE(1);
  TLOAD(2);
  __syncthreads();
  int sl = 0, sl2 = 2;
#pragma unroll 1
  for (int i = 0; i < NTILE; ++i) {
    const char* kb = K_lds + sl * SHM_K + kfo; const char* vb = V_lds + sl * SHM_V + vfo;
    SBAR();
    i32x4 ka0 = LD4(kb), ka1 = LD4(kb + 16), ka2 = LD4(kb + 32 * KROW), ka3 = LD4(kb + 32 * KROW + 16);
    i32x4 kb0 = LD4(kb + 64), kb1 = LD4(kb + 80), kb2 = LD4(kb + 32 * KROW + 64), kb3 = LD4(kb + 32 * KROW + 80);
    SBAR();
    p0 = mfma8(cat8(ka0, ka1), q[0], bias); p1 = mfma8(cat8(ka2, ka3), q[0], bias);
    ka0 = LD4(kb + 128); ka1 = LD4(kb + 144); ka2 = LD4(kb + 32 * KROW + 128); ka3 = LD4(kb + 32 * KROW + 144);
    SBAR();
    p0 = mfma8(cat8(kb0, kb1), q[1], p0); p1 = mfma8(cat8(kb2, kb3), q[1], p1);
    i32x4 v00 = LD4(vb), v01 = LD4(vb + 16), v10 = LD4(vb + 32 * VROW), v11 = LD4(vb + 32 * VROW + 16);
    SBAR();
    p0 = mfma8(cat8(ka0, ka1), q[2], p0); p1 = mfma8(cat8(ka2, ka3), q[2], p1);
    SBAR();
    softmax_tile(p0, p1, bias, i == 0, o, al_l, r32, hi, pa);
    SBAR();
    i32x4 v20 = LD4(vb + 64 * VROW), v21 = LD4(vb + 64 * VROW + 16), v30 = LD4(vb + 96 * VROW), v31 = LD4(vb + 96 * VROW + 16);
    o[4] = mfma8(pa, ones, o[4]); o[0] = mfma8(pa, cat8(v00, v01), o[0]); o[1] = mfma8(pa, cat8(v10, v11), o[1]);
    SBAR();
    o[2] = mfma8(pa, cat8(v20, v21), o[2]); o[3] = mfma8(pa, cat8(v30, v31), o[3]);
    SBAR();
    SWAIT();
    if (i + 2 < NTILE) TWRITE(sl2);
    if (i + 3 < NTILE) TLOAD(i + 3);
    sl = sl == NSLOT - 1 ? 0 : sl + 1; sl2 = sl2 == NSLOT - 1 ? 0 : sl2 + 1;
    SBAR(); __syncthreads();
  }
  float rli[16];
#pragma unroll
  for (int r = 0; r < 16; ++r) rli[r] = __builtin_amdgcn_rcpf(o[4][r]) * (1.f / VS);
  bf16_t* Ow = Ob + (size_t)(wid * 32) * D;
#pragma unroll
  for (int r = 0; r < 16; ++r) { const int orow = crow(r, hi);
#pragma unroll
    for (int d0 = 0; d0 < 4; ++d0) Ow[(size_t)orow * D + d0 * 32 + r32] = f2bf(o[d0][r] * rli[r]); }
  __syncthreads();
#undef TLOAD
#undef TWRITE
#undef SWAIT
#undef LD4
}
}

__device__ __forceinline__ void ph_attn(const bf16_t* __restrict__ Qa, const unsigned char* __restrict__ Kn, const unsigned char* __restrict__ Kr, const unsigned char* __restrict__ Vt,
                                        bf16_t* __restrict__ AO, int bid, int nblk, char* lds) {
  for (int item = bid; item < 512; item += nblk) {
    const int b = item >> 8, h = item & 7, qb = (item >> 3) & 31;
    att::attn_body(Qa + ((size_t)(b * 8 + h) * SEQ + qb * 256) * 192, Kn + (size_t)(b * 8 + h) * KEYS * 128, Kr + (size_t)b * KEYS * 64,
                   Vt + (size_t)(b * 8 + h) * KEYS * 128, AO + (size_t)(b * SEQ + qb * 256) * D + h * 128, lds);
  }
}

namespace rt {
using f32x16 = __attribute__((ext_vector_type(16))) float;
__device__ __forceinline__ int sortable(float f) { const int b = __float_as_int(f); return b ^ ((b >> 31) & 0x7FFFFFFF); }
__device__ __forceinline__ float unsortable(int k) { return __int_as_float(k ^ ((k >> 31) & 0x7FFFFFFF)); }
__device__ __forceinline__ int imax(int a, int b) { return a > b ? a : b; }
__device__ __forceinline__ int imin(int a, int b) { return a < b ? a : b; }
template <int N> __device__ __forceinline__ void sort_desc(int (&v)[N]) {
#pragma unroll
  for (int k = 2; k <= N; k <<= 1) {
#pragma unroll
    for (int j = k >> 1; j > 0; j >>= 1) {
#pragma unroll
      for (int i = 0; i < N; ++i) {
        const int l = i ^ j;
        if (l > i) {
          const bool desc = ((i & k) == 0);
          const int a = v[i], b = v[l];
          v[i] = desc ? imax(a, b) : imin(a, b);
          v[l] = desc ? imin(a, b) : imax(a, b);
        }
      }
    }
  }
}
template <int N> __device__ __forceinline__ void merge_desc(int (&v)[N]) {
#pragma unroll
  for (int j = N >> 1; j > 0; j >>= 1) {
#pragma unroll
    for (int i = 0; i < N; ++i) {
      const int l = i ^ j;
      if (l > i) { const int a = v[i], b = v[l]; v[i] = imax(a, b); v[l] = imin(a, b); }
    }
  }
}
__device__ __forceinline__ void absorb16(int (&L)[16], int (&B)[16]) {
  sort_desc<16>(B);
#pragma unroll
  for (int i = 0; i < 16; ++i) L[i] = imax(L[i], B[15 - i]);
  merge_desc<16>(L);
}
__device__ __forceinline__ constexpr int npairs_row(int i) { return 16 / (i + 1); }
}

struct RouteP { const bf16_t* Q; const bf16_t* Khi; int* IDX; float* GATE; int rows_per_block; int pad; };
__device__ __forceinline__ void ph_route(const RouteP& p, int bid, char* lds) {
  using namespace rt;
  int (*svl)[64][33] = reinterpret_cast<int (*)[64][33]>(lds);
  const int wave = otid() >> 6, lane = otid() & 63, r32 = lane & 31, hi = lane >> 5, hi4 = hi * 4;
  int nrows = p.rows_per_block; asm volatile("" : "+s"(nrows));
  const int g0 = bid * nrows;
  const int h = wave;
#pragma unroll 1
  for (int tg = 0; tg * 32 < nrows; ++tg) {
    int trow = tg * 32 + r32; const bool valid = trow < nrows; trow = valid ? trow : nrows - 1;
    const bf16_t* qrow = p.Q + (size_t)(g0 + trow) * D;
    int sv[2][16];
#pragma unroll
    for (int s = 0; s < 2; ++s) {
      const int hs = h * 2 + s;
      f32x16 acc[4];
#pragma unroll
      for (int m = 0; m < 4; ++m) acc[m] = f32x16{};
#pragma unroll
      for (int kp = 0; kp < 2; ++kp) {
        bf16x8 kf[2][4], qf[2];
#pragma unroll
        for (int k2 = 0; k2 < 2; ++k2)
#pragma unroll
          for (int m = 0; m < 4; ++m) kf[k2][m] = *(const bf16x8*)(p.Khi + ((size_t)(hs * 128 + m * 32 + r32)) * 64 + (kp * 2 + k2) * 16 + hi * 8);
#pragma unroll
        for (int k2 = 0; k2 < 2; ++k2) {
          const int ks = kp * 2 + k2;
          qf[k2] = *(const bf16x8*)(qrow + hs * 64 + ks * 16 + hi * 8);
        }
#pragma unroll
        for (int k2 = 0; k2 < 2; ++k2)
#pragma unroll
          for (int m = 0; m < 4; ++m) acc[m] = __builtin_amdgcn_mfma_f32_32x32x16_bf16(kf[k2][m], qf[k2], acc[m], 0, 0, 0);
      }
      int L[16];
#pragma unroll
      for (int m = 0; m < 4; ++m) {
        int B[16];
#pragma unroll
        for (int r = 0; r < 16; ++r) B[r] = (sortable(acc[m][r]) & ~0x7F) | (m * 32 + (r & 3) + 8 * (r >> 2)) | hi4;
        if (m == 0) { sort_desc<16>(B);
#pragma unroll
          for (int i = 0; i < 16; ++i) L[i] = B[i]; }
        else absorb16(L, B);
      }
      int Lo[16], Hi[16];
#pragma unroll
      for (int i = 0; i < 16; ++i) { auto rr = __builtin_amdgcn_permlane32_swap((unsigned)L[i], (unsigned)L[i], false, false); Lo[i] = (int)rr[0]; Hi[i] = (int)rr[1]; }
#pragma unroll
      for (int i = 0; i < 16; ++i) L[i] = imax(Lo[i], Hi[15 - i]);
      merge_desc<16>(L);
#pragma unroll
      for (int i = 0; i < 16; ++i) { sv[s][i] = L[i]; svl[wave][lane][s * 16 + i] = L[i]; }
    }
    float f0[16], f1[16];
#pragma unroll
    for (int i = 0; i < 16; ++i) { f0[i] = unsortable(sv[0][i] & ~0x7F); f1[i] = unsortable(sv[1][i] & ~0x7F); }
    int Lc[16];
    {
      int C[64];
      int n = 0;
#pragma unroll
      for (int i = 0; i < 16; ++i)
#pragma unroll
        for (int j = 0; j < 16; ++j)
          if ((i + 1) * (j + 1) <= 16) { C[n] = (sortable(f0[i] + f1[j]) & ~0xFF) | (i * 16 + j); ++n; }
#pragma unroll
      for (int k = 50; k < 64; ++k) C[k] = (int)0x80000000;
#pragma unroll
      for (int m = 0; m < 4; ++m) {
        int B[16];
#pragma unroll
        for (int r = 0; r < 16; ++r) B[r] = C[m * 16 + r];
        if (m == 0) { sort_desc<16>(B);
#pragma unroll
          for (int i = 0; i < 16; ++i) Lc[i] = B[i]; }
        else absorb16(Lc, B);
      }
    }
    float e[16]; float esum = 0.f;
    const float vmax = unsortable(Lc[0] & ~0xFF);
#pragma unroll
    for (int r = 0; r < 16; ++r) { e[r] = expf(unsortable(Lc[r] & ~0xFF) - vmax); esum += e[r]; }
    const float inv = 1.f / esum;
    int eid[16];
#pragma unroll
    for (int r = 0; r < 16; ++r) {
      const int pr = Lc[r] & 0xFF;
      const int k0 = svl[wave][lane][pr >> 4] & 0x7F, k1 = svl[wave][lane][16 + (pr & 15)] & 0x7F;
      eid[r] = k0 * 128 + k1;
    }
    if (valid && hi == 0) {
      int* ip = p.IDX + (size_t)(g0 + trow) * 128 + h * 16; float* gp = p.GATE + (size_t)(g0 + trow) * 128 + h * 16;
#pragma unroll
      for (int r = 0; r < 16; r += 4) {
        *(int4*)(ip + r) = make_int4(eid[r], eid[r + 1], eid[r + 2], eid[r + 3]);
        *(float4*)(gp + r) = make_float4(e[r] * inv, e[r + 1] * inv, e[r + 2] * inv, e[r + 3] * inv);
      }
    }
  }
}

constexpr int RB = 8;
template <bool SIGNED>
__device__ __forceinline__ void cvt_rows_i8(const float* __restrict__ src, unsigned char* __restrict__ dst, float* __restrict__ scl, int nrows, int wgid, int nw) {
  const int lane = otid() & 63;
  for (int r0 = wgid * RB; r0 < nrows; r0 += nw * RB) {
    float v[RB][16];
#pragma unroll
    for (int u = 0; u < RB; ++u) {
      const float* sp = src + (size_t)(r0 + u) * D + lane * 4;
      *(float4*)&v[u][0] = *(const float4*)sp; *(float4*)&v[u][4] = *(const float4*)(sp + 256); *(float4*)&v[u][8] = *(const float4*)(sp + 512); *(float4*)&v[u][12] = *(const float4*)(sp + 768);
    }
#pragma unroll
    for (int u = 0; u < RB; ++u) {
      float am = 0.f;
#pragma unroll
      for (int j = 0; j < 16; ++j) am = fmaxf(am, fabsf(v[u][j]));
      am = wave_max_dpp(am);
      const float sc = am > 0.f ? am * (1.f / 127.f) : 1.f, inv = 1.f / sc;
      unsigned w[4];
#pragma unroll
      for (int q4 = 0; q4 < 4; ++q4) {
        unsigned ww = 0u;
#pragma unroll
        for (int j = 0; j < 4; ++j) { int qi = (int)rintf(v[u][q4 * 4 + j] * inv) + (SIGNED ? 0 : 128); qi = SIGNED ? (qi < -127 ? -127 : (qi > 127 ? 127 : qi)) : (qi < 1 ? 1 : (qi > 255 ? 255 : qi)); ww |= (unsigned)(qi & 255) << (8 * j); }
        w[q4] = ww;
      }
      *(uint4*)(dst + (size_t)(r0 + u) * D + lane * 16) = make_uint4(w[0], w[1], w[2], w[3]);
      if (lane == 0) scl[r0 + u] = sc;
    }
  }
}

constexpr int QROW = 768;
__device__ __forceinline__ void cvt_rows_q6(const float* __restrict__ src, unsigned char* __restrict__ dst, float* __restrict__ scl, int nrows, int wgid, int nw) {
  const int lane = otid() & 63;
  for (int r0 = wgid * RB; r0 < nrows; r0 += nw * RB) {
    float v[RB][16];
#pragma unroll
    for (int u = 0; u < RB; ++u) {
      const float* sp = src + (size_t)(r0 + u) * D + lane * 4;
      *(float4*)&v[u][0] = *(const float4*)sp; *(float4*)&v[u][4] = *(const float4*)(sp + 256); *(float4*)&v[u][8] = *(const float4*)(sp + 512); *(float4*)&v[u][12] = *(const float4*)(sp + 768);
    }
#pragma unroll
    for (int u = 0; u < RB; ++u) {
      float am = 0.f;
#pragma unroll
      for (int j = 0; j < 16; ++j) am = fmaxf(am, fabsf(v[u][j]));
      am = wave_max_dpp(am);
      const float sc = am > 0.f ? am * (1.f / 31.f) : 1.f, inv = 1.f / sc;
      unsigned long long lo = 0ull, hi = 0ull;
#pragma unroll
      for (int j = 0; j < 16; ++j) {
        int qi = (int)rintf(v[u][j] * inv) + 32; qi = qi < 1 ? 1 : (qi > 63 ? 63 : qi);
        const int bit = 6 * j;
        if (bit < 64) { lo |= (unsigned long long)qi << bit; if (bit > 58) hi |= (unsigned long long)qi >> (64 - bit); }
        else hi |= (unsigned long long)qi << (bit - 64);
      }
      unsigned* dp = (unsigned*)(dst + (size_t)(r0 + u) * QROW + lane * 12);
      dp[0] = (unsigned)lo; dp[1] = (unsigned)(lo >> 32); dp[2] = (unsigned)hi;
      if (lane == 0) scl[r0 + u] = sc;
    }
  }
}
struct q6w { unsigned x, y, z; };
template <int J> __device__ __forceinline__ float q6(const q6w& w) {
  constexpr int bit = 6 * J, wd = bit >> 5, sh = bit & 31;
  const unsigned lo = wd == 0 ? w.x : (wd == 1 ? w.y : w.z);
  if constexpr (sh == 26) return (float)(lo >> 26);
  else if constexpr (sh < 26) return (float)((lo >> sh) & 63u);
  else { const unsigned hi = wd == 0 ? w.y : w.z; return (float)(__builtin_amdgcn_alignbit(hi, lo, sh) & 63u); }
}

struct GatherP { const bf16_t* Tbf; const int* IDX; const float* GATE; const unsigned char* utab; const unsigned char* vtab; const float* su; const float* sv;
                 const float* Hin; const float* mod; const float* lng; const float* lnb; float* Hout; const float* modT; };
#define UB0(w) ((float)((w) & 0xFFu))
#define UB1(w) ((float)(((w) >> 8) & 0xFFu))
#define UB2(w) ((float)(((w) >> 16) & 0xFFu))
#define UB3(w) ((float)((w) >> 24))
template <bool FINAL>
__device__ __forceinline__ void ln_token(const GatherP& p, int row, int rr, int lane, const float (&f)[16], float asum, char* As) {
  const int v = row_vec(row);
  const float* hin = p.Hin + (size_t)row * D + lane * 4;
  const float* gm = p.mod + v * 6144 + 5 * 1024 + lane * 4;
  const float off = 32.f * asum;
  float r[16]; float ssum = 0.f;
#pragma unroll
  for (int q4 = 0; q4 < 4; ++q4) {
    const float4 h4 = *(const float4*)(hin + q4 * 256), g4 = *(const float4*)(gm + q4 * 256);
    r[q4 * 4 + 0] = ALPHA * h4.x + g4.x * (f[q4 * 4 + 0] - off); r[q4 * 4 + 1] = ALPHA * h4.y + g4.y * (f[q4 * 4 + 1] - off);
    r[q4 * 4 + 2] = ALPHA * h4.z + g4.z * (f[q4 * 4 + 2] - off); r[q4 * 4 + 3] = ALPHA * h4.w + g4.w * (f[q4 * 4 + 3] - off);
    ssum += r[q4 * 4 + 0] + r[q4 * 4 + 1] + r[q4 * 4 + 2] + r[q4 * 4 + 3];
  }
  const float mu = wave_sum(ssum) * (1.f / D);
  float vs = 0.f;
#pragma unroll
  for (int j = 0; j < 16; ++j) { const float dlt = r[j] - mu; vs += dlt * dlt; }
  const float rstd = rsqrtf(wave_sum(vs) * (1.f / D) + LN_EPS);
  float o[16];
#pragma unroll
  for (int q4 = 0; q4 < 4; ++q4) {
    const float4 g4 = *(const float4*)(p.lng + q4 * 256 + lane * 4), b4 = *(const float4*)(p.lnb + q4 * 256 + lane * 4);
    o[q4 * 4 + 0] = (r[q4 * 4 + 0] - mu) * rstd * g4.x + b4.x; o[q4 * 4 + 1] = (r[q4 * 4 + 1] - mu) * rstd * g4.y + b4.y;
    o[q4 * 4 + 2] = (r[q4 * 4 + 2] - mu) * rstd * g4.z + b4.z; o[q4 * 4 + 3] = (r[q4 * 4 + 3] - mu) * rstd * g4.w + b4.w;
    *(float4*)(p.Hout + (size_t)row * D + q4 * 256 + lane * 4) = make_float4(o[q4 * 4 + 0], o[q4 * 4 + 1], o[q4 * 4 + 2], o[q4 * 4 + 3]);
  }
  if (!FINAL) {
    const float* mt = p.modT + v * 6144 + lane * 4;
#pragma unroll
    for (int q4 = 0; q4 < 4; ++q4) {
      const float4 sh = *(const float4*)(mt + q4 * 256), sc = *(const float4*)(mt + 1024 + q4 * 256);
      uint2 w; w.x = pack2bf(o[q4 * 4] * (1.f + sc.x) + sh.x, o[q4 * 4 + 1] * (1.f + sc.y) + sh.y); w.y = pack2bf(o[q4 * 4 + 2] * (1.f + sc.z) + sh.z, o[q4 * 4 + 3] * (1.f + sc.w) + sh.w);
      *(uint2*)(As + rr * LDA_B + (q4 * 256 + lane * 4) * 2) = w;
    }
  }
}
constexpr int PARTW = 1088;
template <bool FINAL>
__device__ __forceinline__ void ph_gather_tm(const GatherP& p, int g0, int nrows, char* As, float* __restrict__ PART) {
  const int tid = otid(), wave = tid >> 6, lane = tid & 63;
  const int nfull = nrows >> 3, extra = nrows & 7;
  const int nun = nfull + (extra ? 1 : 0);
#pragma unroll 1
  for (int un = 0; un < nun; ++un) {
    int rr, kbeg, kcnt; bool partial;
    if (un < nfull) { rr = wave + 8 * un; kbeg = 0; kcnt = 128; partial = false; }
    else { const int wpt = 8 / extra; rr = nfull * 8 + wave / wpt; kcnt = 128 / wpt; kbeg = (wave % wpt) * kcnt; partial = true; }
    const int row = g0 + rr;
    float tf[16];
    {
      const bf16_t* tp = p.Tbf + (size_t)row * D + lane * 4;
      const uint2 t0 = *(const uint2*)tp, t1 = *(const uint2*)(tp + 256), t2 = *(const uint2*)(tp + 512), t3 = *(const uint2*)(tp + 768);
      tf[0] = bflo(t0.x); tf[1] = bfhi(t0.x); tf[2] = bflo(t0.y); tf[3] = bfhi(t0.y); tf[4] = bflo(t1.x); tf[5] = bfhi(t1.x); tf[6] = bflo(t1.y); tf[7] = bfhi(t1.y);
      tf[8] = bflo(t2.x); tf[9] = bfhi(t2.x); tf[10] = bflo(t2.y); tf[11] = bfhi(t2.y); tf[12] = bflo(t3.x); tf[13] = bfhi(t3.x); tf[14] = bflo(t3.y); tf[15] = bfhi(t3.y);
    }
    float tam = 0.f;
#pragma unroll
    for (int j = 0; j < 16; ++j) tam = fmaxf(tam, fabsf(tf[j]));
    tam = wave_max_dpp(tam);
    const float st = tam > 0.f ? tam * (1.f / 127.f) : 1.f, tinv = 1.f / st;
    int tq[4];
#pragma unroll
    for (int k4 = 0; k4 < 4; ++k4) {
      unsigned ww = 0u;
#pragma unroll
      for (int j = 0; j < 4; ++j) ww |= (unsigned)((int)rintf(tf[k4 * 4 + j] * tinv) & 255) << (8 * j);
      tq[k4] = (int)ww;
    }
    const int id_lo = p.IDX[(size_t)row * 128 + lane], id_hi = p.IDX[(size_t)row * 128 + 64 + lane];
    const float ga_lo = p.GATE[(size_t)row * 128 + lane], ga_hi = p.GATE[(size_t)row * 128 + 64 + lane];
    const float su_lo = p.su[id_lo], su_hi = p.su[id_hi], sv_lo = p.sv[id_lo], sv_hi = p.sv[id_hi];
    float f[16];
#pragma unroll
    for (int j = 0; j < 16; ++j) f[j] = 0.f;
    uint4 rb[8];
    float dlo = 0.f, dhi = 0.f;
#define ULOAD(slot, kk) do { const int e_ = __builtin_amdgcn_readlane((kk) < 64 ? id_lo : id_hi, (kk) & 63); \
      rb[slot] = *(const uint4*)(p.utab + (size_t)e_ * D + lane * 16); } while (0)
#define VLOAD(slot, kk) do { const int e_ = __builtin_amdgcn_readlane((kk) < 64 ? id_lo : id_hi, (kk) & 63); \
      const q6w t_ = *(const q6w*)(p.vtab + (size_t)e_ * QROW + lane * 12); rb[slot].x = t_.x; rb[slot].y = t_.y; rb[slot].z = t_.z; } while (0)
    auto proc4u = [&](int s0, int k0) {
      float dot[4];
#pragma unroll
      for (int u = 0; u < 4; ++u) {
        const uint4 a_ = rb[s0 + u];
        int di = __builtin_amdgcn_sdot4((int)a_.x, tq[0], 0, false); di = __builtin_amdgcn_sdot4((int)a_.y, tq[1], di, false);
        di = __builtin_amdgcn_sdot4((int)a_.z, tq[2], di, false); di = __builtin_amdgcn_sdot4((int)a_.w, tq[3], di, false);
        dot[u] = (float)di;
      }
#define DPPSTEP(ctl, rm) do { _Pragma("unroll") for (int u = 0; u < 4; ++u) dot[u] += __uint_as_float(__builtin_amdgcn_update_dpp(0u, __float_as_uint(dot[u]), ctl, rm, 0xF, true)); } while (0)
      DPPSTEP(0xB1, 0xF); DPPSTEP(0x4E, 0xF); DPPSTEP(0x141, 0xF); DPPSTEP(0x140, 0xF); DPPSTEP(0x142, 0xA); DPPSTEP(0x143, 0xC);
#undef DPPSTEP
      if (k0 < 64) {
#pragma unroll
        for (int u = 0; u < 4; ++u) dlo = __uint_as_float(__builtin_amdgcn_update_dpp(__float_as_uint(dot[u]), __float_as_uint(dlo), 0x130, 0xF, 0xF, false));
      } else {
#pragma unroll
        for (int u = 0; u < 4; ++u) dhi = __uint_as_float(__builtin_amdgcn_update_dpp(__float_as_uint(dot[u]), __float_as_uint(dhi), 0x130, 0xF, 0xF, false));
      }
    };
    float act_lo = 0.f, act_hi = 0.f;
    auto proc4v = [&](int s0, int k0) {
      float act[4];
      if (k0 < 64) {
#pragma unroll
        for (int u = 0; u < 4; ++u) act[u] = __uint_as_float((unsigned)__builtin_amdgcn_readlane((int)__float_as_uint(act_lo), k0 + u));
      } else {
#pragma unroll
        for (int u = 0; u < 4; ++u) act[u] = __uint_as_float((unsigned)__builtin_amdgcn_readlane((int)__float_as_uint(act_hi), k0 - 64 + u));
      }
#pragma unroll
      for (int u = 0; u < 4; ++u) {
        const float act_ = act[u];
        const q6w c_ = {rb[s0 + u].x, rb[s0 + u].y, rb[s0 + u].z};
        f[0] = fmaf(act_, q6<0>(c_), f[0]); f[1] = fmaf(act_, q6<1>(c_), f[1]); f[2] = fmaf(act_, q6<2>(c_), f[2]); f[3] = fmaf(act_, q6<3>(c_), f[3]);
        f[4] = fmaf(act_, q6<4>(c_), f[4]); f[5] = fmaf(act_, q6<5>(c_), f[5]); f[6] = fmaf(act_, q6<6>(c_), f[6]); f[7] = fmaf(act_, q6<7>(c_), f[7]);
        f[8] = fmaf(act_, q6<8>(c_), f[8]); f[9] = fmaf(act_, q6<9>(c_), f[9]); f[10] = fmaf(act_, q6<10>(c_), f[10]); f[11] = fmaf(act_, q6<11>(c_), f[11]);
        f[12] = fmaf(act_, q6<12>(c_), f[12]); f[13] = fmaf(act_, q6<13>(c_), f[13]); f[14] = fmaf(act_, q6<14>(c_), f[14]); f[15] = fmaf(act_, q6<15>(c_), f[15]);
      }
    };
    ULOAD(0, kbeg); ULOAD(1, kbeg + 1); ULOAD(2, kbeg + 2); ULOAD(3, kbeg + 3); ULOAD(4, kbeg + 4); ULOAD(5, kbeg + 5); ULOAD(6, kbeg + 6); ULOAD(7, kbeg + 7);
    const int kend = kbeg + kcnt - 8;
#pragma unroll 1
    for (int k = kbeg; k < kend; k += 8) {
      proc4u(0, k); ULOAD(0, k + 8); ULOAD(1, k + 9); ULOAD(2, k + 10); ULOAD(3, k + 11);
      proc4u(4, k + 4); ULOAD(4, k + 12); ULOAD(5, k + 13); ULOAD(6, k + 14); ULOAD(7, k + 15);
    }
    proc4u(0, kend); VLOAD(0, kbeg); VLOAD(1, kbeg + 1); VLOAD(2, kbeg + 2); VLOAD(3, kbeg + 3);
    proc4u(4, kend + 4); VLOAD(4, kbeg + 4); VLOAD(5, kbeg + 5); VLOAD(6, kbeg + 6); VLOAD(7, kbeg + 7);
    if (partial) {
      const int srcl = ((lane - (kbeg & 63) + 32) & 63) * 4;
      const float sh_lo = __uint_as_float((unsigned)__builtin_amdgcn_ds_bpermute(srcl, (int)__float_as_uint(dlo))), sh_hi = __uint_as_float((unsigned)__builtin_amdgcn_ds_bpermute(srcl, (int)__float_as_uint(dhi)));
      const bool in = lane >= (kbeg & 63) && lane < (kbeg & 63) + 32;
      dlo = in ? sh_lo : 0.f; dhi = in ? sh_hi : 0.f;
    }
    act_lo = gelu_fast(su_lo * st * dlo) * ga_lo * sv_lo; act_hi = gelu_fast(su_hi * st * dhi) * ga_hi * sv_hi;
    const float asum = wave_sum_dpp(act_lo + act_hi);
#pragma unroll 1
    for (int k = kbeg; k < kend; k += 8) {
      proc4v(0, k); VLOAD(0, k + 8); VLOAD(1, k + 9); VLOAD(2, k + 10); VLOAD(3, k + 11);
      proc4v(4, k + 4); VLOAD(4, k + 12); VLOAD(5, k + 13); VLOAD(6, k + 14); VLOAD(7, k + 15);
    }
    proc4v(0, kend); proc4v(4, kend + 4);
#undef ULOAD
#undef VLOAD
    if (!partial) ln_token<FINAL>(p, row, rr, lane, f, asum, As);
    else {
      float* pp = PART + wave * PARTW + lane * 16;
      *(float4*)pp = make_float4(f[0], f[1], f[2], f[3]); *(float4*)(pp + 4) = make_float4(f[4], f[5], f[6], f[7]);
      *(float4*)(pp + 8) = make_float4(f[8], f[9], f[10], f[11]); *(float4*)(pp + 12) = make_float4(f[12], f[13], f[14], f[15]);
      if (lane == 0) PART[wave * PARTW + 1024] = asum;
    }
  }
  if (extra) {
    __syncthreads();
    if (wave < extra) {
      const int wpt = 8 / extra, rr = nfull * 8 + wave;
      float f[16], asum = 0.f;
#pragma unroll
      for (int j = 0; j < 16; ++j) f[j] = 0.f;
      for (int w2 = wave * wpt; w2 < wave * wpt + wpt; ++w2) {
        const float* pp = PART + w2 * PARTW + lane * 16;
#pragma unroll
        for (int q4 = 0; q4 < 4; ++q4) { const float4 x4 = *(const float4*)(pp + q4 * 4); f[q4 * 4] += x4.x; f[q4 * 4 + 1] += x4.y; f[q4 * 4 + 2] += x4.z; f[q4 * 4 + 3] += x4.w; }
        asum += PART[w2 * PARTW + 1024];
      }
      ln_token<FINAL>(p, g0 + rr, rr, lane, f, asum, As);
    }
  }
}

__device__ __forceinline__ void cvt_plain(const float* __restrict__ a, bf16_t* __restrict__ o, size_t n8, bool lo, size_t gtid, size_t gsz) {
  for (size_t i = gtid; i < n8; i += gsz) {
    float v[8];
    *(float4*)&v[0] = ((const float4*)a)[i * 2]; *(float4*)&v[4] = ((const float4*)a)[i * 2 + 1];
    if (lo) {
#pragma unroll
      for (int j = 0; j < 8; ++j) v[j] = v[j] - bf2f(f2bf(v[j]));
    }
    uint4 w; w.x = pack2bf(v[0], v[1]); w.y = pack2bf(v[2], v[3]); w.z = pack2bf(v[4], v[5]); w.w = pack2bf(v[6], v[7]);
    ((uint4*)o)[i] = w;
  }
}
__device__ __forceinline__ void cvt_t(const float* __restrict__ W, bf16_t* __restrict__ Wt, int K, int N, bool lo, size_t gtid, size_t gsz) {
  const int N4 = N >> 2;
  const size_t total = (size_t)N4 * (K / 8);
#pragma unroll 2
  for (size_t i = gtid; i < total; i += gsz) {
    const int n = (int)(i % N4) * 4, k8 = (int)(i / N4);
    float4 r[8];
#pragma unroll
    for (int j = 0; j < 8; ++j) r[j] = *(const float4*)(W + (size_t)(k8 * 8 + j) * N + n);
    if (lo) {
#pragma unroll
      for (int j = 0; j < 8; ++j) { r[j].x -= bf2f(f2bf(r[j].x)); r[j].y -= bf2f(f2bf(r[j].y)); r[j].z -= bf2f(f2bf(r[j].z)); r[j].w -= bf2f(f2bf(r[j].w)); }
    }
    uint4* dst = (uint4*)(Wt + ((size_t)((n >> 4) * (K >> 5) + (k8 >> 2)) * 64 + (k8 & 3) * 16 + (n & 15)) * 8);
    dst[0] = make_uint4(pack2bf(r[0].x, r[1].x), pack2bf(r[2].x, r[3].x), pack2bf(r[4].x, r[5].x), pack2bf(r[6].x, r[7].x));
    dst[1] = make_uint4(pack2bf(r[0].y, r[1].y), pack2bf(r[2].y, r[3].y), pack2bf(r[4].y, r[5].y), pack2bf(r[6].y, r[7].y));
    dst[2] = make_uint4(pack2bf(r[0].z, r[1].z), pack2bf(r[2].z, r[3].z), pack2bf(r[4].z, r[5].z), pack2bf(r[6].z, r[7].z));
    dst[3] = make_uint4(pack2bf(r[0].w, r[1].w), pack2bf(r[2].w, r[3].w), pack2bf(r[4].w, r[5].w), pack2bf(r[6].w, r[7].w));
  }
}
__device__ __forceinline__ void cvt_t8(const float* __restrict__ W, unsigned char* __restrict__ Wt, int K, int N, size_t gtid, size_t gsz) {
  const int N4 = N >> 2;
  const size_t total = (size_t)N4 * (K / 8);
#pragma unroll 2
  for (size_t i = gtid; i < total; i += gsz) {
    const int n = (int)(i % N4) * 4, k8 = (int)(i / N4);
    float4 r[8];
#pragma unroll
    for (int j = 0; j < 8; ++j) r[j] = *(const float4*)(W + (size_t)(k8 * 8 + j) * N + n);
    unsigned char* dst = Wt + ((size_t)((n >> 4) * (K >> 6) + (k8 >> 3)) * 64 + (k8 & 3) * 16 + (n & 15)) * 16 + ((k8 >> 2) & 1) * 8;
#define PK8(C) make_uint2((unsigned)__builtin_amdgcn_cvt_pk_fp8_f32(r[2].C * 32.f, r[3].C * 32.f, __builtin_amdgcn_cvt_pk_fp8_f32(r[0].C * 32.f, r[1].C * 32.f, 0, false), true), \
                          (unsigned)__builtin_amdgcn_cvt_pk_fp8_f32(r[6].C * 32.f, r[7].C * 32.f, __builtin_amdgcn_cvt_pk_fp8_f32(r[4].C * 32.f, r[5].C * 32.f, 0, false), true))
    *(uint2*)(dst) = PK8(x); *(uint2*)(dst + 16) = PK8(y); *(uint2*)(dst + 32) = PK8(z); *(uint2*)(dst + 48) = PK8(w);
#undef PK8
  }
}
__device__ __forceinline__ void mod_item(const float* __restrict__ c, const float* __restrict__ c_ctx, const float* __restrict__ ada_w, const float* __restrict__ ada_b,
                                         float* __restrict__ MOD, int item, bool valid, char* lds, int tid, int nct, volatile int* cbc, int& cgen) {
  float* sc = (float*)lds;
  float* part = sc + 3072;
  const int wave = tid >> 6, lane = tid & 63, l = item / 96, cg = item % 96, nw = nct >> 6;
  if (valid) for (int i = tid; i < 3072; i += nct) { const int v = i >> 10, k = i & 1023; const float xv = v < 2 ? c[v * 1024 + k] : c_ctx[k]; sc[i] = xv / (1.f + expf(-xv)); }
  cbar(cbc, cgen, nw);
  if (valid) {
    float a0 = 0.f, a1 = 0.f, a2 = 0.f;
    const float* W = ada_w + (size_t)l * 1024 * 6144 + cg * 64 + lane;
    const int kb = wave * 171, ke = kb + 171 < 1024 ? kb + 171 : 1024;
#pragma unroll 57
    for (int k = kb; k < ke; ++k) { const float w = W[(size_t)k * 6144]; a0 += sc[k] * w; a1 += sc[1024 + k] * w; a2 += sc[2048 + k] * w; }
    part[(wave * 3 + 0) * 64 + lane] = a0; part[(wave * 3 + 1) * 64 + lane] = a1; part[(wave * 3 + 2) * 64 + lane] = a2;
  }
  cbar(cbc, cgen, nw);
  if (valid && tid < 192) {
    const int v = tid >> 6, ln = tid & 63; float sum = 0.f;
    for (int w = 0; w < nw; ++w) sum += part[(w * 3 + v) * 64 + ln];
    MOD[(l * 3 + v) * 6144 + cg * 64 + ln] = sum + ada_b[l * 6144 + cg * 64 + ln];
  }
}

__device__ __forceinline__ void gbar(unsigned* cnt, unsigned target) {
  asm volatile("s_waitcnt vmcnt(0)" ::: "memory");
  __syncthreads();
  if (otid() == 0) {
    __builtin_amdgcn_fence(__ATOMIC_RELEASE, "agent");
    asm volatile("s_waitcnt vmcnt(0)" ::: "memory");
    __hip_atomic_fetch_add(cnt, 1u, __ATOMIC_RELAXED, __HIP_MEMORY_SCOPE_AGENT);
    unsigned spins = 0;
    while (__hip_atomic_load(cnt, __ATOMIC_RELAXED, __HIP_MEMORY_SCOPE_AGENT) < target) { __builtin_amdgcn_s_sleep(2); if (++spins > (1u << 24)) break; }
    __builtin_amdgcn_fence(__ATOMIC_ACQUIRE, "agent");
    asm volatile("s_waitcnt vmcnt(0)" ::: "memory");
  }
  __syncthreads();
}

struct MP {
  const float *x, *c, *ctx, *c_ctx, *ada_w, *ada_b, *ln_g, *ln_b, *s5_a_re, *s5_a_im, *s5_log_dt, *s5_b_re, *s5_b_im, *s5_c_re, *s5_c_im, *s5_d, *s5_w_glu, *s5_w_o;
  const float *mla_w_dq, *mla_q_norm, *mla_w_uq, *mla_w_dkv, *mla_kv_norm, *mla_w_ukv, *mla_w_o, *peer_w_q, *peer_keys, *peer_u, *peer_v;
  float* out;
  float* MOD; bf16_t *Wt_glu, *Wt_o0, *Wt_q0, *Wt_o1, *Wt_q1, *Wt_cat, *Wt_uq, *Wt_ukv, *Khi, *Khi1;
  unsigned char *U0, *V0, *U1, *V1; float *SU0, *SV0, *SU1, *SV1; bf16_t *Ktab, *Bst_t, *Cin_t;
  bf16_t* Ypart; float* Ssta; bf16_t *HP, *Gbf, *Vbf, *Tbf; float *OQ, *H1, *H2; int* IDX; float* GATE;
  bf16_t *Qa, *AObf; unsigned char *Kn, *Kr, *Va; float* H3; bf16_t* Tbf1; unsigned* BAR; float* PART;
};
constexpr int LDS_BYTES = 66 * 784 + 66 * 528 + 1024 * 68 + 64;
__global__ __launch_bounds__(512) void mega(MP p) {
  __shared__ __attribute__((aligned(16))) char lds[LDS_BYTES];
  cg::grid_group grid = cg::this_grid();
  const int nblk = gridDim.x;
  int bid = blockIdx.x;
  const size_t TD = (size_t)1024 * 16384;
  const float* mod0 = p.MOD; const float* mod1 = p.MOD + 3 * 6144;
  {
    volatile int* cbc = (volatile int*)(lds + LDS_BYTES - 16);
    if (otid() == 0) *cbc = 0;
    __syncthreads();
    const int t0 = otid();
    if (t0 < 128) {
      const size_t mt = (size_t)bid * 128 + t0, ms = (size_t)nblk * 128;
      const int mw = bid * 2 + (t0 >> 6), nmw = nblk * 2;
      cvt_t(p.s5_w_glu, p.Wt_glu, D, D, false, mt, ms);
      cvt_t(p.s5_w_o, p.Wt_o0, D, D, false, mt, ms);
      cvt_t(p.peer_w_q, p.Wt_q0, D, D, false, mt, ms);
      cvt_t8(p.mla_w_o, (unsigned char*)p.Wt_o1, D, D, mt, ms);
      cvt_t(p.peer_w_q + (size_t)D * D, p.Wt_q1, D, D, false, mt, ms);
      cvt_t8(p.mla_w_dq, (unsigned char*)p.Wt_cat, D, 384, mt, ms);
      cvt_t8(p.mla_w_dkv, (unsigned char*)p.Wt_cat + (size_t)384 * D, D, 320, mt, ms);
      cvt_t8(p.mla_w_uq, (unsigned char*)p.Wt_uq, 384, 1536, mt, ms);
      cvt_t8(p.mla_w_ukv, (unsigned char*)p.Wt_ukv, 256, 2048, mt, ms);
      cvt_plain(p.peer_keys, p.Khi, (size_t)2 * 131072 / 8, false, mt, ms);
      cvt_rows_i8<true>(p.peer_u, p.U0, p.SU0, 16384, mw, nmw);
      cvt_rows_q6(p.peer_v, p.V0, p.SV0, 16384, mw, nmw);
      cvt_rows_i8<true>(p.peer_u + TD, p.U1, p.SU1, 16384, mw, nmw);
      cvt_rows_q6(p.peer_v + TD, p.V1, p.SV1, 16384, mw, nmw);
    } else {
      int cgen = 0;
      const int ct = t0 - 128;
      ph_s5_prep(p.s5_a_re, p.s5_a_im, p.s5_log_dt, p.s5_b_re, p.s5_b_im, p.s5_c_re, p.s5_c_im, p.Ktab, p.Bst_t, p.Cin_t, bid >> 2, bid & 3, lds, ct, 384, cbc, cgen);
      cbar(cbc, cgen, 6);
      mod_item(p.c, p.c_ctx, p.ada_w, p.ada_b, p.MOD, bid, bid < 192, lds, ct, 384, cbc, cgen);
    }
  }
  grid.sync();
  asm volatile("" : "+s"(bid));
  ph_s5_p1(p.x, p.ctx, mod0, p.Ktab, p.Bst_t, p.s5_d, p.Ypart, p.Ssta, bid, lds);
  gbar(p.BAR + 16 + (bid >> 2) * 16, 4u);
  asm volatile("" : "+s"(bid));
  if (otid() < 64) ph_s5_carry(p.Ssta, p.s5_a_re, p.s5_a_im, p.s5_log_dt, p.HP, ((bid & 2) << 6) | ((bid >> 2) << 1) | (bid & 1), otid());
  gbar(p.BAR + 16 + (bid >> 2) * 16, 8u);
  asm volatile("" : "+s"(bid));
  ph_s5_p3(p.HP, p.Cin_t, p.Ypart, p.Gbf, bid, lds);
  gbar(p.BAR, 1u * (unsigned)nblk);
  asm volatile("" : "+s"(bid));
  {
    ChainP cp{p.Gbf, p.Wt_glu, p.Wt_o0, p.Wt_q0, p.Vbf, (bf16_t*)p.OQ + (size_t)bid * 66 * D, p.x, p.ctx, mod0, p.ln_g, p.ln_b, p.H1, p.Tbf, (bf16_t*)p.OQ + (size_t)bid * 66 * D  };
    ph_chainA<true>(cp, bid, lds);
    __syncthreads();
    ph_route(RouteP{(bf16_t*)p.OQ + (size_t)bid * 66 * D, p.Khi, p.IDX, p.GATE, 66, 0}, bid, lds);
    __syncthreads();
    GatherP gp{p.Tbf, p.IDX, p.GATE, p.U0, p.V0, p.SU0, p.SV0, p.H1, mod0, p.ln_g + D, p.ln_b + D, p.H2, mod1};
    ph_gather_tm<false>(gp, bid * 66, 66, lds, p.PART + (size_t)bid * 8 * PARTW);
    __syncthreads();
    ProjP pp{p.Wt_cat, p.Wt_uq, p.Wt_ukv, p.mla_q_norm, p.mla_kv_norm, p.OQ  , p.Qa, p.Kn, p.Kr, p.Va};
    ph_mla_proj(pp, bid, lds);
  }
  gbar(p.BAR, 2u * (unsigned)nblk);
  asm volatile("" : "+s"(bid));
  ph_attn(p.Qa, p.Kn, p.Kr, p.Va, p.AObf, bid, nblk, lds);
  gbar(p.BAR, 3u * (unsigned)nblk);
  asm volatile("" : "+s"(bid));
  {
    ChainP cp{p.AObf, nullptr, p.Wt_o1, p.Wt_q1, nullptr, (bf16_t*)p.OQ + (size_t)bid * 64 * D, p.H2, p.H2 + (size_t)NL * D, mod1, p.ln_g + 2 * D, p.ln_b + 2 * D, p.H3, p.Tbf1, (bf16_t*)p.OQ + (size_t)bid * 64 * D};
    ph_chainA<false>(cp, bid, lds);
    __syncthreads();
    ph_route(RouteP{(bf16_t*)p.OQ + (size_t)bid * 64 * D, p.Khi1, p.IDX, p.GATE, 64, 0}, bid, lds);
    __syncthreads();
    GatherP gp{p.Tbf1, p.IDX, p.GATE, p.U1, p.V1, p.SU1, p.SV1, p.H3, mod1, p.ln_g + 3 * D, p.ln_b + 3 * D, p.out, mod1};
    ph_gather_tm<true>(gp, bid * 64, 64, lds, p.PART + (size_t)bid * 8 * PARTW);
  }
}

extern "C" void kernel_launch(void* const* d_in, const int* in_sizes, int n_in, void* d_out, int out_size, void* d_ws, size_t ws_size, hipStream_t stream) {
  MP p{};
  const float** in = (const float**)&p;
  for (int i = 0; i < 29; ++i) in[i] = (const float*)d_in[i];
  p.out = (float*)d_out;
  char* ws = (char*)d_ws; size_t off = 0;
  auto carve = [&](size_t bytes) { char* q = ws + off; off += (bytes + 255) / 256 * 256; return q; };
  const size_t TDB = (size_t)1024 * 16384 * 2, BIG = (size_t)NT * D * 4, HALF = (size_t)NT * D * 2;
  p.MOD = (float*)carve(2 * 3 * 6144 * 4);
  p.Wt_glu = (bf16_t*)carve((size_t)D * D * 2); p.Wt_o0 = (bf16_t*)carve((size_t)D * D * 2); p.Wt_q0 = (bf16_t*)carve((size_t)D * D * 2);
  p.Wt_o1 = (bf16_t*)carve((size_t)D * D * 2); p.Wt_q1 = (bf16_t*)carve((size_t)D * D * 2);
  p.Wt_cat = (bf16_t*)carve((size_t)704 * D * 2); p.Wt_uq = (bf16_t*)carve((size_t)1536 * 384 * 2); p.Wt_ukv = (bf16_t*)carve((size_t)2048 * 256 * 2);
  p.Khi = (bf16_t*)carve((size_t)2 * 131072 * 2); p.Khi1 = p.Khi + 131072;
  char* T0 = carve(TDB); p.U0 = (unsigned char*)T0; p.V0 = (unsigned char*)(T0 + TDB / 2); p.AObf = (bf16_t*)T0;
  p.SU0 = (float*)carve(16384 * 4); p.SV0 = (float*)carve(16384 * 4); p.SU1 = (float*)carve(16384 * 4); p.SV1 = (float*)carve(16384 * 4);
  const size_t KTAB_B = (size_t)64 * 127 * 256 * 2, BST_B = (size_t)64 * 256 * 1024 * 2, KN_B = (size_t)NB * 8 * KEYS * 128 * 2, KR_B = (size_t)NB * KEYS * 64 * 2;
  size_t x1 = KTAB_B + 2 * BST_B; if (x1 < 2 * KN_B + KR_B) x1 = 2 * KN_B + KR_B;
  char* X1 = carve(x1);
  p.Ktab = (bf16_t*)X1; p.Bst_t = (bf16_t*)(X1 + KTAB_B); p.Cin_t = (bf16_t*)(X1 + KTAB_B + BST_B);
  p.Kn = (unsigned char*)X1; p.Va = (unsigned char*)(X1 + KN_B); p.Kr = (unsigned char*)(X1 + 2 * KN_B); p.H3 = (float*)X1;
  char* X2 = carve(BIG); p.Ypart = (bf16_t*)X2; p.OQ = (float*)X2;
  char* X3 = carve(HALF); p.Ssta = (float*)X3; p.HP = (bf16_t*)(X3 + (size_t)NCC * 64 * 256 * 4); p.Vbf = (bf16_t*)X3;
  char* X4 = carve(HALF); p.Gbf = (bf16_t*)X4; p.Tbf = (bf16_t*)X4; p.Tbf1 = (bf16_t*)X4;
  char* X5 = carve(BIG); p.H1 = (float*)X5;
  char* T1 = carve(TDB); p.U1 = (unsigned char*)T1; p.V1 = (unsigned char*)(T1 + TDB / 2);
  p.H2 = (float*)carve(BIG);
  p.IDX = (int*)carve((size_t)NT * 128 * 4); p.GATE = (float*)carve((size_t)NT * 128 * 4);
  p.Qa = (bf16_t*)carve((size_t)NB * 8 * SEQ * 192 * 2);
  p.BAR = (unsigned*)carve(8192);
  p.PART = (float*)carve((size_t)256 * 8 * PARTW * 4);
  if (off > ws_size || n_in != 29) { fprintf(stderr, "kernel_launch: workspace too small (need %zu, have %zu) or n_in %d != 29\n", off, ws_size, n_in); return; }
  static int grid_blocks = 0;
  if (!grid_blocks) {
    int dev = 0, cus = 0, per_cu = 0;
    hipGetDevice(&dev);
    hipDeviceGetAttribute(&cus, hipDeviceAttributeMultiprocessorCount, dev);
    hipOccupancyMaxActiveBlocksPerMultiprocessor(&per_cu, mega, 512, 0);
    if (per_cu < 1 || cus < 256) { fprintf(stderr, "kernel_launch: need 256 resident workgroups (cus %d, per_cu %d)\n", cus, per_cu); return; }
    grid_blocks = 256;
  }
  hipMemsetAsync(p.BAR, 0, 8192, stream);
  void* args[] = {&p};
  hipError_t e = hipLaunchCooperativeKernel((void*)mega, dim3(grid_blocks), dim3(512), args, 0, stream);
  if (e != hipSuccess) fprintf(stderr, "cooperative launch failed: %s\n", hipGetErrorString(e));
}
```

```cpp
#include <hip/hip_runtime.h>
#include <math.h>
#include <hip/hip_cooperative_groups.h>
#include <cstdio>
namespace cg = cooperative_groups;
__device__ __forceinline__ int otid() { int t = (int)__builtin_amdgcn_workitem_id_x(); asm volatile("" : "+v"(t)); return t; }

constexpr int D = 1024, NB = 2, SEQ = 8192, CTX = 256;
constexpr int NL = NB * SEQ, NC = NB * CTX, NT = NL + NC;
constexpr float ALPHA = 1.4142135623730951f;
constexpr float LN_EPS = 1e-5f, RMS_EPS = 1e-6f;

__device__ __forceinline__ float wave_sum_dpp(float v) {
  v += __uint_as_float(__builtin_amdgcn_update_dpp(0u, __float_as_uint(v), 0xB1, 0xF, 0xF, true));
  v += __uint_as_float(__builtin_amdgcn_update_dpp(0u, __float_as_uint(v), 0x4E, 0xF, 0xF, true));
  v += __uint_as_float(__builtin_amdgcn_update_dpp(0u, __float_as_uint(v), 0x141, 0xF, 0xF, true));
  v += __uint_as_float(__builtin_amdgcn_update_dpp(0u, __float_as_uint(v), 0x140, 0xF, 0xF, true));
  v += __uint_as_float(__builtin_amdgcn_update_dpp(0u, __float_as_uint(v), 0x142, 0xA, 0xF, true));
  v += __uint_as_float(__builtin_amdgcn_update_dpp(0u, __float_as_uint(v), 0x143, 0xC, 0xF, true));
  return __uint_as_float((unsigned)__builtin_amdgcn_readlane((int)__float_as_uint(v), 63));
}
__device__ __forceinline__ float wave_sum(float v) { return wave_sum_dpp(v); }
__device__ __forceinline__ float wave_max_dpp(float v) {
  v = fmaxf(v, __uint_as_float(__builtin_amdgcn_update_dpp(0u, __float_as_uint(v), 0xB1, 0xF, 0xF, true)));
  v = fmaxf(v, __uint_as_float(__builtin_amdgcn_update_dpp(0u, __float_as_uint(v), 0x4E, 0xF, 0xF, true)));
  v = fmaxf(v, __uint_as_float(__builtin_amdgcn_update_dpp(0u, __float_as_uint(v), 0x141, 0xF, 0xF, true)));
  v = fmaxf(v, __uint_as_float(__builtin_amdgcn_update_dpp(0u, __float_as_uint(v), 0x140, 0xF, 0xF, true)));
  v = fmaxf(v, __uint_as_float(__builtin_amdgcn_update_dpp(0u, __float_as_uint(v), 0x142, 0xA, 0xF, true)));
  v = fmaxf(v, __uint_as_float(__builtin_amdgcn_update_dpp(0u, __float_as_uint(v), 0x143, 0xC, 0xF, true)));
  return __uint_as_float((unsigned)__builtin_amdgcn_readlane((int)__float_as_uint(v), 63));
}
__device__ __forceinline__ int row_vec(int row) { return row < NL ? (row >> 13) : 2; }
__device__ __forceinline__ float gelu_exact(float x) { return 0.5f * x * (1.f + erff(x * 0.70710678118654752f)); }
__device__ __forceinline__ float gelu_fast(float x) {
  const float z = fabsf(x) * 0.70710678118654752f;
  const float t = __builtin_amdgcn_rcpf(fmaf(0.3275911f, z, 1.f));
  float pl = fmaf(1.061405429f, t, -1.453152027f); pl = fmaf(pl, t, 1.421413741f); pl = fmaf(pl, t, -0.284496736f); pl = fmaf(pl, t, 0.254829592f);
  const float e = __builtin_amdgcn_exp2f(-z * z * 1.4426950408889634f);
  const float erfa = 1.f - pl * t * e;
  const float hx = 0.5f * x;
  return hx + fabsf(hx) * erfa;
}


typedef unsigned short bf16_t;
using bf16x8 = __attribute__((ext_vector_type(8))) short;
using f32x4 = __attribute__((ext_vector_type(4))) float;
__device__ __forceinline__ bf16_t f2bf(float f) { unsigned u = __float_as_uint(f); u += 0x7FFFu + ((u >> 16) & 1u); return (bf16_t)(u >> 16); }
__device__ __forceinline__ unsigned char f2fp8(float v) { return (unsigned char)(__builtin_amdgcn_cvt_pk_fp8_f32(v, v, 0, false) & 0xFF); }
__device__ __forceinline__ float bf2f(bf16_t h) { return __uint_as_float(((unsigned)h) << 16); }
__device__ __forceinline__ unsigned pack2bf(float lo, float hi) { return (unsigned)f2bf(lo) | ((unsigned)f2bf(hi) << 16); }
__device__ __forceinline__ float bflo(unsigned w) { return __uint_as_float(w << 16); }
__device__ __forceinline__ float bfhi(unsigned w) { return __uint_as_float(w & 0xFFFF0000u); }


constexpr int LDA_B = 1024 * 2 + 16;
template <int RT, int K>
__device__ __forceinline__ void gemm_unit(const char* const (&ap)[RT], const bf16_t* __restrict__ w0, const bf16_t* __restrict__ w1, int kmul, f32x4 (&acc)[RT][2]) {
  constexpr int KI = K / 128, NS = 2;
#pragma unroll
  for (int t = 0; t < RT; ++t) { acc[t][0] = f32x4{0.f, 0.f, 0.f, 0.f}; acc[t][1] = f32x4{0.f, 0.f, 0.f, 0.f}; }
  bf16x8 b[NS][4][2];
#pragma unroll
  for (int st = 0; st < NS - 1; ++st) {
    if (st < KI) {
#pragma unroll
      for (int s2 = 0; s2 < 4; ++s2) { b[st][s2][0] = *(const bf16x8*)(w0 + (st * 128 + s2 * 32) * kmul); b[st][s2][1] = *(const bf16x8*)(w1 + (st * 128 + s2 * 32) * kmul); }
    }
  }
  asm volatile("" ::: "memory");
  bf16x8 an[RT];
#pragma unroll
  for (int t = 0; t < RT; ++t) an[t] = *(const bf16x8*)(ap[t]);
#pragma unroll
  for (int it = 0; it < KI; ++it) {
    if (it + NS - 1 < KI) {
#pragma unroll
      for (int s2 = 0; s2 < 4; ++s2) {
        b[(it + NS - 1) % NS][s2][0] = *(const bf16x8*)(w0 + ((it + NS - 1) * 128 + s2 * 32) * kmul);
        b[(it + NS - 1) % NS][s2][1] = *(const bf16x8*)(w1 + ((it + NS - 1) * 128 + s2 * 32) * kmul);
      }
    }
    asm volatile("" ::: "memory");
#pragma unroll
    for (int s2 = 0; s2 < 4; ++s2) {
      bf16x8 ac[RT];
#pragma unroll
      for (int t = 0; t < RT; ++t) ac[t] = an[t];
      if (it * 4 + s2 + 1 < KI * 4) {
#pragma unroll
        for (int t = 0; t < RT; ++t) an[t] = *(const bf16x8*)(ap[t] + (it * 128 + s2 * 32 + 32) * 2);
      }
#pragma unroll
      for (int t = 0; t < RT; ++t) {
        acc[t][0] = __builtin_amdgcn_mfma_f32_16x16x32_bf16(ac[t], b[it % NS][s2][0], acc[t][0], 0, 0, 0);
        acc[t][1] = __builtin_amdgcn_mfma_f32_16x16x32_bf16(ac[t], b[it % NS][s2][1], acc[t][1], 0, 0, 0);
      }
    }
  }
}
typedef __bf16 bf16raw2 __attribute__((ext_vector_type(2)));
__device__ __forceinline__ bf16x8 w8_frag(unsigned lo, unsigned hi) {
  const bf16raw2 e0 = __builtin_amdgcn_cvt_scalef32_pk_bf16_fp8(lo, 0.03125f, false), e1 = __builtin_amdgcn_cvt_scalef32_pk_bf16_fp8(lo, 0.03125f, true);
  const bf16raw2 e2 = __builtin_amdgcn_cvt_scalef32_pk_bf16_fp8(hi, 0.03125f, false), e3 = __builtin_amdgcn_cvt_scalef32_pk_bf16_fp8(hi, 0.03125f, true);
  uint4 w; w.x = *(const unsigned*)&e0; w.y = *(const unsigned*)&e1; w.z = *(const unsigned*)&e2; w.w = *(const unsigned*)&e3;
  return *(const bf16x8*)&w;
}
template <int RT, int K>
__device__ __forceinline__ void gemm_unit8(const char* const (&ap)[RT], const unsigned char* __restrict__ w0, const unsigned char* __restrict__ w1, f32x4 (&acc)[RT][2]) {
  constexpr int KI = K / 128, NS = 2;
#pragma unroll
  for (int t = 0; t < RT; ++t) { acc[t][0] = f32x4{0.f, 0.f, 0.f, 0.f}; acc[t][1] = f32x4{0.f, 0.f, 0.f, 0.f}; }
  uint4 b[NS][2][2];
#pragma unroll
  for (int st = 0; st < NS - 1; ++st) {
    if (st < KI) {
#pragma unroll
      for (int pr = 0; pr < 2; ++pr) { b[st][pr][0] = *(const uint4*)(w0 + (st * 2 + pr) * 1024); b[st][pr][1] = *(const uint4*)(w1 + (st * 2 + pr) * 1024); }
    }
  }
  asm volatile("" ::: "memory");
  bf16x8 an[RT];
#pragma unroll
  for (int t = 0; t < RT; ++t) an[t] = *(const bf16x8*)(ap[t]);
#pragma unroll
  for (int it = 0; it < KI; ++it) {
    if (it + NS - 1 < KI) {
#pragma unroll
      for (int pr = 0; pr < 2; ++pr) {
        b[(it + NS - 1) % NS][pr][0] = *(const uint4*)(w0 + ((it + NS - 1) * 2 + pr) * 1024);
        b[(it + NS - 1) % NS][pr][1] = *(const uint4*)(w1 + ((it + NS - 1) * 2 + pr) * 1024);
      }
    }
    asm volatile("" ::: "memory");
#pragma unroll
    for (int s2 = 0; s2 < 4; ++s2) {
      bf16x8 ac[RT];
#pragma unroll
      for (int t = 0; t < RT; ++t) ac[t] = an[t];
      if (it * 4 + s2 + 1 < KI * 4) {
#pragma unroll
        for (int t = 0; t < RT; ++t) an[t] = *(const bf16x8*)(ap[t] + (it * 128 + s2 * 32 + 32) * 2);
      }
      const uint4 q0 = b[it % NS][s2 >> 1][0], q1 = b[it % NS][s2 >> 1][1];
      const bf16x8 f0 = (s2 & 1) ? w8_frag(q0.z, q0.w) : w8_frag(q0.x, q0.y), f1 = (s2 & 1) ? w8_frag(q1.z, q1.w) : w8_frag(q1.x, q1.y);
#pragma unroll
      for (int t = 0; t < RT; ++t) {
        acc[t][0] = __builtin_amdgcn_mfma_f32_16x16x32_bf16(ac[t], f0, acc[t][0], 0, 0, 0);
        acc[t][1] = __builtin_amdgcn_mfma_f32_16x16x32_bf16(ac[t], f1, acc[t][1], 0, 0, 0);
      }
    }
  }
}
template <int RT, int K, class Epi>
__device__ __forceinline__ void gemm_ldsA8(const char* As, int lda_b, int nrows, const unsigned char* __restrict__ Wt, int N, Epi epi) {
  const int wave = otid() >> 6, lane = otid() & 63, l15 = lane & 15, q = lane >> 4;
  const char* ap[RT];
#pragma unroll
  for (int t = 0; t < RT; ++t) { int r = t * 16 + l15; r = r < nrows ? r : nrows - 1; ap[t] = As + r * lda_b + q * 16; }
#pragma unroll 1
  for (int unit = wave; unit < (N >> 5); unit += 8) {
    const int n0 = unit * 32;
    const unsigned char* w0 = Wt + (size_t)(n0 >> 4) * K * 16 + lane * 16;
    f32x4 acc[RT][2];
    gemm_unit8<RT, K>(ap, w0, w0 + (size_t)K * 16, acc);
#pragma unroll
    for (int t = 0; t < RT; ++t)
#pragma unroll
      for (int j = 0; j < 2; ++j)
#pragma unroll
        for (int r = 0; r < 4; ++r) {
          const int row = t * 16 + q * 4 + r, col = n0 + j * 16 + l15;
          if (row < nrows) epi(row, col, acc[t][j][r]);
        }
  }
}
template <int RT, int K, class Epi>
__device__ __forceinline__ void gemm_ldsA(const char* As, int lda_b, int nrows, const bf16_t* __restrict__ Wt, int N, Epi epi) {
  const int wave = otid() >> 6, lane = otid() & 63, l15 = lane & 15, q = lane >> 4;
  const char* ap[RT];
#pragma unroll
  for (int t = 0; t < RT; ++t) { int r = t * 16 + l15; r = r < nrows ? r : nrows - 1; ap[t] = As + r * lda_b + q * 16; }
#pragma unroll 1
  for (int unit = wave; unit < (N >> 5); unit += 8) {
    const int n0 = unit * 32;
    const bf16_t* w0 = Wt + (size_t)(n0 >> 4) * K * 16 + lane * 8;
    f32x4 acc[RT][2];
    gemm_unit<RT, K>(ap, w0, w0 + (size_t)K * 16, 16, acc);
#pragma unroll
    for (int t = 0; t < RT; ++t)
#pragma unroll
      for (int j = 0; j < 2; ++j)
#pragma unroll
        for (int r = 0; r < 4; ++r) {
          const int row = t * 16 + q * 4 + r, col = n0 + j * 16 + l15;
          if (row < nrows) epi(row, col, acc[t][j][r]);
        }
  }
}
struct EpiBF16 { bf16_t* C; int ldc; __device__ __forceinline__ void operator()(int row, int col, float v) const { C[(size_t)row * ldc + col] = f2bf(v); } };
struct EpiF32 { float* C; int ldc; __device__ __forceinline__ void operator()(int row, int col, float v) const { C[(size_t)row * ldc + col] = v; } };
struct EpiGluL { const char* As; bf16_t* V; __device__ __forceinline__ void operator()(int row, int col, float z) const {
  const float g = bf2f(*(const bf16_t*)(As + row * LDA_B + col * 2)); V[(size_t)row * D + col] = f2bf(g / (1.f + expf(-z))); } };

__device__ __forceinline__ void load_rows_lds(char* As, const bf16_t* __restrict__ src, int nrows) {
  const int t = otid(), total = nrows * 128;
#pragma unroll
  for (int h = 0; h < 2; ++h) {
    uint4 v[9];
#pragma unroll
    for (int k = 0; k < 9; ++k) { int i = t + (h * 9 + k) * 512; i = i < total ? i : total - 1; v[k] = *(const uint4*)(src + (size_t)(i >> 7) * D + (i & 127) * 8); }
#pragma unroll
    for (int k = 0; k < 9; ++k) { const int i = t + (h * 9 + k) * 512; if (i < total) *(uint4*)(As + (i >> 7) * LDA_B + (i & 127) * 16) = v[k]; }
  }
}
__device__ __forceinline__ void ln_rows(char* As, int g0, int nrows, const float* Hl, const float* Hc, const bf16_t* __restrict__ O,
                                        const float* __restrict__ mod, int gate_i, const float* __restrict__ lng, const float* __restrict__ lnb,
                                        float* Hout, bf16_t* __restrict__ Tbf, int shift_i, int scale_i) {
  const int wave = otid() >> 6, lane = otid() & 63;
  for (int rr = wave; rr < nrows; rr += 8) {
    const int row = g0 + rr;
    const float* hin = row < NL ? Hl + (size_t)row * D : Hc + (size_t)(row - NL) * D;
    const bf16_t* f = O + (size_t)row * D;
    const float* m = mod + row_vec(row) * 6144;
    const float* gm = m + gate_i * 1024;
    float r[16]; float s = 0.f;
#pragma unroll
    for (int i = 0; i < 4; ++i) {
      const int d = i * 256 + lane * 4;
      const uint2 fw = *(const uint2*)(f + d);
      float4 h4 = *(const float4*)(hin + d), f4 = make_float4(bflo(fw.x), bfhi(fw.x), bflo(fw.y), bfhi(fw.y)), g4 = *(const float4*)(gm + d);
      r[i * 4 + 0] = ALPHA * h4.x + g4.x * f4.x; r[i * 4 + 1] = ALPHA * h4.y + g4.y * f4.y;
      r[i * 4 + 2] = ALPHA * h4.z + g4.z * f4.z; r[i * 4 + 3] = ALPHA * h4.w + g4.w * f4.w;
      s += r[i * 4 + 0] + r[i * 4 + 1] + r[i * 4 + 2] + r[i * 4 + 3];
    }
    const float mu = wave_sum(s) * (1.f / D);
    float vs = 0.f;
#pragma unroll
    for (int i = 0; i < 16; ++i) { float dlt = r[i] - mu; vs += dlt * dlt; }
    const float rstd = rsqrtf(wave_sum(vs) * (1.f / D) + LN_EPS);
#pragma unroll
    for (int i = 0; i < 4; ++i) {
      const int d = i * 256 + lane * 4;
      float4 g4 = *(const float4*)(lng + d), b4 = *(const float4*)(lnb + d);
      float4 o;
      o.x = (r[i * 4 + 0] - mu) * rstd * g4.x + b4.x; o.y = (r[i * 4 + 1] - mu) * rstd * g4.y + b4.y;
      o.z = (r[i * 4 + 2] - mu) * rstd * g4.z + b4.z; o.w = (r[i * 4 + 3] - mu) * rstd * g4.w + b4.w;
      *(float4*)(Hout + (size_t)row * D + d) = o;
      float4 sh = *(const float4*)(m + shift_i * 1024 + d), sc = *(const float4*)(m + scale_i * 1024 + d);
      const float t0 = o.x * (1.f + sc.x) + sh.x, t1 = o.y * (1.f + sc.y) + sh.y, t2 = o.z * (1.f + sc.z) + sh.z, t3 = o.w * (1.f + sc.w) + sh.w;
      uint2 w; w.x = pack2bf(t0, t1); w.y = pack2bf(t2, t3);
      *(uint2*)(As + rr * LDA_B + d * 2) = w;
      *(uint2*)(Tbf + (size_t)row * D + d) = w;

    }
  }
}


constexpr int S5T = 64, NCHUNK = (CTX + SEQ) / S5T  , NCC = NB * NCHUNK  ;
__device__ __forceinline__ int s5_token(int cc, int s) {
  const int b = cc / NCHUNK, ch = cc - b * NCHUNK;
  return ch < 4 ? NL + b * CTX + ch * S5T + s : b * SEQ + (ch - 4) * S5T + s;
}
__device__ __forceinline__ void cbar(volatile int* cnt, int& gen, int nwaves) {
  __builtin_amdgcn_fence(__ATOMIC_RELEASE, "workgroup");
  if ((otid() & 63) == 0) __hip_atomic_fetch_add((int*)cnt, 1, __ATOMIC_RELAXED, __HIP_MEMORY_SCOPE_WORKGROUP);
  ++gen;
  while (__hip_atomic_load((int*)cnt, __ATOMIC_RELAXED, __HIP_MEMORY_SCOPE_WORKGROUP) < gen * nwaves) __builtin_amdgcn_s_sleep(1);
  __builtin_amdgcn_fence(__ATOMIC_ACQUIRE, "workgroup");
}
__device__ __forceinline__ void ph_s5_prep(const float* __restrict__ a_re, const float* __restrict__ a_im, const float* __restrict__ log_dt,
                                                 const float* __restrict__ b_re, const float* __restrict__ b_im, const float* __restrict__ c_re, const float* __restrict__ c_im,
                                                 bf16_t* __restrict__ Ktab, bf16_t* __restrict__ Bst_t, bf16_t* __restrict__ Cin_t, int g, int part, char* lds, int tid, int nct, volatile int* cbc, int& cgen) {
  float2 (*pw)[65][64] = reinterpret_cast<float2 (*)[65][64]>(lds);
  float2 (*Bp)[64][16] = reinterpret_cast<float2 (*)[64][16]>(lds + 2 * 65 * 64 * 8);
  float2 (*Cc)[16][64] = reinterpret_cast<float2 (*)[16][64]>(lds + 2 * 65 * 64 * 8 + 2 * 64 * 16 * 8);
  float2 (*fs)[64] = reinterpret_cast<float2 (*)[64]>(lds + 2 * 65 * 64 * 8 + 2 * 64 * 16 * 8 + 2 * 16 * 64 * 8);
  if (tid < 128) {
    const int dir = tid >> 6, p = tid & 63, gp = (dir * 64 + g) * 64 + p;
    const float are = a_re[gp], aim = a_im[gp], dt = expf(log_dt[dir * 64 + g]);
    const float mag = expf(are * dt);
    const float abr = mag * cosf(aim * dt), abi = mag * sinf(aim * dt);
    const float nr = abr - 1.f, ni = abi, den = are * are + aim * aim;
    fs[dir][p] = make_float2((nr * are + ni * aim) / den, (ni * are - nr * aim) / den);
    float pr = 1.f, pi = 0.f;
    for (int e = 0; e <= 64; ++e) { pw[dir][e][p] = make_float2(pr, pi); const float nr2 = pr * abr - pi * abi, ni2 = pr * abi + pi * abr; pr = nr2; pi = ni2; }
  }
  cbar(cbc, cgen, nct >> 6);
  for (int i = tid; i < 2048; i += nct) {
    const int dir = i >> 10, p = (i >> 4) & 63, ci = i & 15;
    const size_t gi = ((size_t)(dir * 64 + g) * 64 + p) * 16 + ci;
    const float br = b_re[gi], bi = b_im[gi]; const float2 f = fs[dir][p];
    Bp[dir][p][ci] = make_float2(f.x * br - f.y * bi, f.x * bi + f.y * br);
    const int co = (i >> 6) & 15, p2 = i & 63;
    const size_t ci2 = ((size_t)(dir * 64 + g) * 16 + co) * 64 + p2;
    Cc[dir][co][p2] = make_float2(c_re[ci2], c_im[ci2]);
  }
  cbar(cbc, cgen, nct >> 6);
  for (int i = part * 508 + tid; i < (part + 1) * 508; i += nct) {
    const int ti = i >> 4, co = i & 15, tau = ti - 63;
    float acc[16];
#pragma unroll
    for (int ci = 0; ci < 16; ++ci) acc[ci] = 0.f;
    if (tau >= 0) {
      for (int p = 0; p < 64; ++p) {
        const float2 c = Cc[0][co][p], w = pw[0][tau][p];
        const float xr = c.x * w.x - c.y * w.y, xi = c.x * w.y + c.y * w.x;
#pragma unroll
        for (int ci = 0; ci < 16; ++ci) { const float2 bb = Bp[0][p][ci]; acc[ci] += xr * bb.x - xi * bb.y; }
      }
    }
    if (tau <= 0) {
      for (int p = 0; p < 64; ++p) {
        const float2 c = Cc[1][co][p], w = pw[1][-tau][p];
        const float xr = c.x * w.x - c.y * w.y, xi = c.x * w.y + c.y * w.x;
#pragma unroll
        for (int ci = 0; ci < 16; ++ci) { const float2 bb = Bp[1][p][ci]; acc[ci] += xr * bb.x - xi * bb.y; }
      }
    }
    uint4 o0, o1;
    o0.x = pack2bf(acc[0], acc[1]); o0.y = pack2bf(acc[2], acc[3]); o0.z = pack2bf(acc[4], acc[5]); o0.w = pack2bf(acc[6], acc[7]);
    o1.x = pack2bf(acc[8], acc[9]); o1.y = pack2bf(acc[10], acc[11]); o1.z = pack2bf(acc[12], acc[13]); o1.w = pack2bf(acc[14], acc[15]);
    bf16_t* kp = Ktab + (size_t)g * 127 * 256 + (size_t)i * 16;
    *(uint4*)kp = o0; *(uint4*)(kp + 8) = o1;
  }
  for (int i = part * 8192 + tid; i < (part + 1) * 8192; i += nct) {
    const int n = (i >> 11) * 16 + (i & 15), k8 = ((i >> 6) & 31) * 4 + ((i >> 4) & 3);
    const int dir = n >> 7, c = (n >> 6) & 1, p = n & 63, sidx = k8 >> 1, ci0 = (k8 & 1) * 8;
    const float2 w = pw[dir][dir == 0 ? 63 - sidx : sidx][p];
    float v[8];
#pragma unroll
    for (int j = 0; j < 8; ++j) { const float2 b = Bp[dir][p][ci0 + j]; v[j] = c == 0 ? (w.x * b.x - w.y * b.y) : (w.x * b.y + w.y * b.x); }
    uint4 o; o.x = pack2bf(v[0], v[1]); o.y = pack2bf(v[2], v[3]); o.z = pack2bf(v[4], v[5]); o.w = pack2bf(v[6], v[7]);
    *(uint4*)(Bst_t + (size_t)g * 256 * 1024 + (size_t)i * 8) = o;
  }
  for (int i = part * 8192 + tid; i < (part + 1) * 8192; i += nct) {
    const int n = (i >> 9) * 16 + (i & 15), k8 = ((i >> 6) & 7) * 4 + ((i >> 4) & 3);
    const int t = n >> 4, co = n & 15, dir = k8 >> 4, c = (k8 >> 3) & 1, p0 = (k8 & 7) * 8;
    const int e = dir == 0 ? t + 1 : 64 - t;
    float v[8];
#pragma unroll
    for (int j = 0; j < 8; ++j) { const float2 cc = Cc[dir][co][p0 + j], w = pw[dir][e][p0 + j];
      v[j] = c == 0 ? (cc.x * w.x - cc.y * w.y) : -(cc.x * w.y + cc.y * w.x); }
    uint4 o; o.x = pack2bf(v[0], v[1]); o.y = pack2bf(v[2], v[3]); o.z = pack2bf(v[4], v[5]); o.w = pack2bf(v[6], v[7]);
    *(uint4*)(Cin_t + (size_t)g * 1024 * 256 + (size_t)i * 8) = o;
  }
}
__device__ __forceinline__ void ph_s5_p1(const float* __restrict__ x, const float* __restrict__ ctx, const float* __restrict__ mod,
                                               const bf16_t* __restrict__ Ktab, const bf16_t* __restrict__ Bst_t, const float* __restrict__ dvec, bf16_t* __restrict__ Ypart, float* __restrict__ S, int bid, char* As) {
  const int g = bid >> 2, cc0 = (bid & 3) * 66, tid = otid();
  const int wave = tid >> 6, lane = tid & 63, l15 = lane & 15, q = lane >> 4;
  const float dch = dvec[g * 16 + l15];
#pragma unroll 4
  for (int i = tid; i < 66 * 64 * 2; i += 512) {
    const int half = i & 1, sidx = (i >> 1) & 63, r = i >> 7;
    const int tok = s5_token(cc0 + r, sidx), ch = g * 16 + half * 8;
    const float* src = (tok < NL ? x + (size_t)tok * D : ctx + (size_t)(tok - NL) * D) + ch;
    const float* m = mod + row_vec(tok) * 6144;
    const float4 a = *(const float4*)src, b = *(const float4*)(src + 4);
    const float4 sh0 = *(const float4*)(m + ch), sh1 = *(const float4*)(m + ch + 4), sc0 = *(const float4*)(m + 1024 + ch), sc1 = *(const float4*)(m + 1024 + ch + 4);
    uint4 o;
    o.x = pack2bf(a.x * (1.f + sc0.x) + sh0.x, a.y * (1.f + sc0.y) + sh0.y); o.y = pack2bf(a.z * (1.f + sc0.z) + sh0.z, a.w * (1.f + sc0.w) + sh0.w);
    o.z = pack2bf(b.x * (1.f + sc1.x) + sh1.x, b.y * (1.f + sc1.y) + sh1.y); o.w = pack2bf(b.z * (1.f + sc1.z) + sh1.z, b.w * (1.f + sc1.w) + sh1.w);
    *(uint4*)(As + r * LDA_B + sidx * 32 + half * 16) = o;
  }
  __syncthreads();
  const char* ap[5];
#pragma unroll
  for (int t = 0; t < 5; ++t) { int r = t * 16 + l15; r = r < 66 ? r : 65; ap[t] = As + r * LDA_B + q * 16; }
  const bf16_t* Kg = Ktab + (size_t)g * 127 * 256;
#pragma unroll 1
  for (int unit = wave; unit < 40; unit += 8) {
    f32x4 acc[5][2];
    if (unit < 32) {
      const int t0 = unit * 2;
      const bf16_t* w0 = Kg + (t0 + 63 - (q >> 1)) * 256 + l15 * 16 + (q & 1) * 8;
      gemm_unit<5, 1024>(ap, w0, w0 + 256, -16, acc);
#pragma unroll
      for (int t = 0; t < 5; ++t)
#pragma unroll
        for (int j = 0; j < 2; ++j)
#pragma unroll
          for (int r = 0; r < 4; ++r) {
            const int row = t * 16 + q * 4 + r;
            if (row < 66) Ypart[(size_t)s5_token(cc0 + row, t0 + j) * D + g * 16 + l15] = f2bf(acc[t][j][r] + dch * bf2f(*(const bf16_t*)(As + row * LDA_B + (t0 + j) * 32 + l15 * 2)));
          }
    } else {
      const int n0 = (unit - 32) * 32;
      const bf16_t* w0 = Bst_t + (size_t)g * 256 * 1024 + (size_t)(n0 >> 4) * 1024 * 16 + lane * 8;
      gemm_unit<5, 1024>(ap, w0, w0 + 1024 * 16, 16, acc);
#pragma unroll
      for (int t = 0; t < 5; ++t)
#pragma unroll
        for (int j = 0; j < 2; ++j)
#pragma unroll
          for (int r = 0; r < 4; ++r) {
            const int row = t * 16 + q * 4 + r;
            if (row < 66) S[((size_t)(cc0 + row) * 64 + g) * 256 + n0 + j * 16 + l15] = acc[t][j][r];
          }
    }
  }
}
__device__ __forceinline__ void ph_s5_carry(const float* __restrict__ S, const float* __restrict__ a_re, const float* __restrict__ a_im,
                                                 const float* __restrict__ log_dt, bf16_t* __restrict__ HP, int id, int p) {
  const int dir = id & 1, g = (id >> 1) & 63, b = id >> 7;
  const int gp = (dir * 64 + g) * 64 + p;
  const float are = a_re[gp], aim = a_im[gp], dt = expf(log_dt[dir * 64 + g]);
  const float mag = expf(are * dt);
  float tr = mag * cosf(aim * dt), ti = mag * sinf(aim * dt);
#pragma unroll
  for (int i = 0; i < 6; ++i) { const float nr = tr * tr - ti * ti, ni = 2.f * tr * ti; tr = nr; ti = ni; }
  float hr = 0.f, hi = 0.f;
#pragma unroll 12
  for (int step = 0; step < NCHUNK; ++step) {
    const int c = dir == 0 ? step : (step < 4 ? 3 - step : NCHUNK - 1 - (step - 4));
    const size_t base = ((size_t)(b * NCHUNK + c) * 64 + g) * 256 + dir * 128 + p;
    HP[base] = f2bf(hr); HP[base + 64] = f2bf(hi);
    const float sr = S[base], si = S[base + 64];
    const float nr = tr * hr - ti * hi + sr, ni = tr * hi + ti * hr + si;
    hr = nr; hi = ni;
  }
}
struct EpiS5 { const bf16_t* Ypart; bf16_t* Gbf; int cc0; int ch;
  __device__ __forceinline__ void operator()(int row, int col, float v) const {
    const size_t o = (size_t)s5_token(cc0 + row, col >> 4) * D + ch;
    Gbf[o] = f2bf(gelu_fast(v + bf2f(Ypart[o])));
  } };
__device__ __forceinline__ void ph_s5_p3(const bf16_t* __restrict__ HP, const bf16_t* __restrict__ Cin_t, const bf16_t* __restrict__ Ypart, bf16_t* __restrict__ Gbf, int bid, char* As) {
  const int g = bid >> 2, cc0 = (bid & 3) * 66, tid = otid();
  for (int i = tid; i < 66 * 32; i += 512) {
    const int r = i >> 5, c = i & 31;
    *(uint4*)(As + r * 528 + c * 16) = *(const uint4*)(HP + ((size_t)(cc0 + r) * 64 + g) * 256 + c * 8);
  }
  __syncthreads();
  gemm_ldsA<5, 256>(As, 528, 66, Cin_t + (size_t)g * 1024 * 256, 1024, EpiS5{Ypart, Gbf, cc0, g * 16 + (otid() & 15)});
}


struct ChainP {
  const bf16_t* Ain;
  const bf16_t* Wglu_t; const bf16_t* Wo_t; const bf16_t* Wq_t;
  bf16_t* Vbf; bf16_t* O; const float* Hl; const float* Hc; const float* mod; const float* lng; const float* lnb;
  float* Hout; bf16_t* Tbf; bf16_t* Q;
};
template <bool L0>
__device__ __forceinline__ void ph_chainA(const ChainP& p, int bid, char* As) {
  constexpr int NR = L0 ? 66 : 64;
  constexpr int RT = L0 ? 5 : 4;
  const int g0 = bid * NR;
  load_rows_lds(As, p.Ain + (size_t)g0 * D, NR);
  __syncthreads();
  if (L0) {
    gemm_ldsA<RT, 1024>(As, LDA_B, NR, p.Wglu_t, D, EpiGluL{As, p.Vbf + (size_t)g0 * D});
    __syncthreads();
    load_rows_lds(As, p.Vbf + (size_t)g0 * D, NR);
    __syncthreads();
  }
  if constexpr (L0) gemm_ldsA<RT, 1024>(As, LDA_B, NR, p.Wo_t, D, EpiBF16{p.O + (size_t)g0 * D, D});
  else gemm_ldsA8<RT, 1024>(As, LDA_B, NR, (const unsigned char*)p.Wo_t, D, EpiBF16{p.O + (size_t)g0 * D, D});
  __syncthreads();
  ln_rows(As, g0, NR, p.Hl, p.Hc, p.O, p.mod, 2, p.lng, p.lnb, p.Hout, p.Tbf, 3, 4);
  __syncthreads();
  gemm_ldsA<RT, 1024>(As, LDA_B, NR, p.Wq_t, D, EpiBF16{p.Q + (size_t)g0 * D, D});
}


constexpr int KEYS = SEQ + CTX;
constexpr float att_KS = 0.5f;
struct EpiKV { unsigned char* Kn; unsigned char* Vl; int g0; int sh; __device__ __forceinline__ void operator()(int row, int col, float v) const {
  const int head = col >> 8, j = col & 255;
  if (j < 128) {
    const int g = g0 + row; int b, key;
    if (g < NL) { b = g >> 13; key = g & (SEQ - 1); } else { const int cidx = g - NL; b = cidx >> 8; key = SEQ + (cidx & (CTX - 1)); }
    Kn[((size_t)(b * 8 + head) * KEYS + key) * 128 + j] = f2fp8(v * att_KS);
  } else Vl[(head * 128 + (j - 128)) * 68 + row + sh] = f2fp8(v * 4.f);
} };
struct EpiQ { bf16_t* Qa; int g0; int pad; __device__ __forceinline__ void operator()(int row, int col, float v) const {
  const int g = g0 + row, b = g >> 13, n = g & (SEQ - 1);
  const int head = col / 192, j = col - head * 192;
  Qa[((size_t)(b * 8 + head) * SEQ + n) * 192 + j] = f2bf(v);
} };
struct ProjP { const bf16_t* Wcat_t; const bf16_t* Wuq_t; const bf16_t* Wukv_t; const float* q_norm; const float* kv_norm;
               float* PR; bf16_t* Qa; unsigned char* Kn; unsigned char* Kr; unsigned char* Va; };
__device__ __forceinline__ void ph_mla_proj(const ProjP& p, int bid, char* As) {
  const int g0 = bid * 66, wave = otid() >> 6, lane = otid() & 63;
  gemm_ldsA8<5, 1024>(As, LDA_B, 66, (const unsigned char*)p.Wcat_t, 704, EpiF32{p.PR + (size_t)g0 * D, D});
  __syncthreads();
  char* A1 = As; char* A2 = As + 66 * 784;
  for (int rr = wave; rr < 66; rr += 8) {
    const int g = g0 + rr;
    const float* pr = p.PR + (size_t)g * D;
    float v[6]; float ss = 0.f;
#pragma unroll
    for (int i = 0; i < 6; ++i) { v[i] = pr[i * 64 + lane]; ss += v[i] * v[i]; }
    float rn = rsqrtf(wave_sum(ss) * (1.f / 384.f) + RMS_EPS);
#pragma unroll
    for (int i = 0; i < 6; ++i) *(bf16_t*)(A1 + rr * 784 + (i * 64 + lane) * 2) = f2bf(v[i] * rn * p.q_norm[i * 64 + lane]);
    float w[4]; ss = 0.f;
#pragma unroll
    for (int i = 0; i < 4; ++i) { w[i] = pr[384 + i * 64 + lane]; ss += w[i] * w[i]; }
    rn = rsqrtf(wave_sum(ss) * (1.f / 256.f) + RMS_EPS);
#pragma unroll
    for (int i = 0; i < 4; ++i) *(bf16_t*)(A2 + rr * 528 + (i * 64 + lane) * 2) = f2bf(w[i] * rn * p.kv_norm[i * 64 + lane]);
    if (lane < 32) {
      float x1 = pr[640 + lane], x2 = pr[672 + lane];
      int b, key;
      if (g < NL) {
        b = g >> 13; key = g & (SEQ - 1);
        const int n = key, rr2 = n >> 6, cc = n & 63;
        const float inv = powf(10000.f, -(float)(lane & 15) / 16.f);
        const float ang = (lane < 16 ? (float)rr2 : (float)cc) * inv;
        const float cs = cosf(ang), sn = sinf(ang);
        const float y1 = x1 * cs - x2 * sn, y2 = x2 * cs + x1 * sn; x1 = y1; x2 = y2;
      } else { const int cidx = g - NL; b = cidx >> 8; key = SEQ + (cidx & (CTX - 1)); }
      unsigned char* kp = p.Kr + ((size_t)b * KEYS + key) * 64;
      kp[lane] = f2fp8(x1 * att_KS); kp[32 + lane] = f2fp8(x2 * att_KS);
    }
  }
  __syncthreads();
  int nq = NL - g0; nq = nq > 66 ? 66 : nq;
  if (nq > 0) gemm_ldsA8<5, 384>(A1, 784, nq, (const unsigned char*)p.Wuq_t, 1536, EpiQ{p.Qa, g0, 0});
  unsigned char* Vl = (unsigned char*)As + 66 * 784 + 66 * 528;
  const int sh = g0 & 3;
  gemm_ldsA8<5, 256>(A2, 528, 66, (const unsigned char*)p.Wukv_t, 2048, EpiKV{p.Kn, Vl, g0, sh});
  __syncthreads();
  for (int i = otid(); i < 1024 * 17; i += 512) {
    const int dvg = i / 17, q4 = i - dvg * 17, g4 = g0 - sh + 4 * q4;
    const unsigned w = *(const unsigned*)(Vl + dvg * 68 + 4 * q4);
    int b, key;
    if (g4 < NL) { b = g4 >> 13; key = g4 & (SEQ - 1); } else { const int cidx = g4 - NL; b = cidx >> 8; key = SEQ + (cidx & (CTX - 1)); }
    const int m = (key & 63) >> 2, posd = (m & 1) * 8 + (m >> 3) * 4 + ((m >> 1) & 3);
    unsigned char* dst = p.Va + ((size_t)(b * 8 + (dvg >> 7)) * (KEYS / 64) + (key >> 6)) * 8192 + (dvg & 127) * 64 + posd * 4;
    if (g4 >= g0 && g4 + 3 < g0 + 66) *(unsigned*)dst = w;
    else if (g4 < g0) *(unsigned short*)(dst + 2) = (unsigned short)(w >> 16);
    else *(unsigned short*)dst = (unsigned short)(w & 0xFFFFu);
  }
  for (int rr = wave; rr < nq; rr += 8) {
    const int g = g0 + rr, b = g >> 13, n = g & (SEQ - 1);
    if (lane < 32) {
      const float inv = powf(10000.f, -(float)(lane & 15) / 16.f);
      const float ang = (lane < 16 ? (float)(n >> 6) : (float)(n & 63)) * inv;
      const float cs = cosf(ang), sn = sinf(ang);
#pragma unroll
      for (int h = 0; h < 8; ++h) {
        bf16_t* qo = p.Qa + ((size_t)(b * 8 + h) * SEQ + n) * 192;
        const float x1 = bf2f(qo[128 + lane]), x2 = bf2f(qo[160 + lane]);
        qo[128 + lane] = f2bf(x1 * cs - x2 * sn); qo[160 + lane] = f2bf(x2 * cs + x1 * sn);
      }
    }
  }
}

namespace att {
using i32x8 = __attribute__((ext_vector_type(8))) int;
using i32x4 = __attribute__((ext_vector_type(4))) int;
using f32x16 = __attribute__((ext_vector_type(16))) float;
constexpr int KVBLK = 64, KROW = 208, VROW = 80, NTILE = KEYS / 64;
constexpr float KS = 0.5f, VS = 4.f;
constexpr float QS = 0.07216878364870322f * 1.4426950408889634f / KS;
constexpr float THR2 = 3.f * 1.4426950408889634f, PSH = 4.f;
constexpr int SHM_V = 128 * VROW, SHM_K = KVBLK * KROW, NSLOT = 3, SHM_ATTN = NSLOT * (SHM_V + SHM_K) + 8 * 64 * 4;
#define SBAR() __builtin_amdgcn_sched_barrier(0)
__device__ __forceinline__ int crow(int r, int hi) { return (r & 3) + 8 * (r >> 2) + 4 * hi; }
__device__ __forceinline__ f32x16 mfma8(i32x8 a, i32x8 b, f32x16 c) { return __builtin_amdgcn_mfma_scale_f32_32x32x64_f8f6f4(a, b, c, 0, 0, 0, 0, 0, 0); }
__device__ __forceinline__ i32x8 cat8(i32x4 a, i32x4 b) { return __builtin_shufflevector(a, b, 0, 1, 2, 3, 4, 5, 6, 7); }
__device__ __forceinline__ int pk4(float a, float b, float c, float d, int old = 0) { const int w = __builtin_amdgcn_cvt_pk_fp8_f32(a, b, old, false); return __builtin_amdgcn_cvt_pk_fp8_f32(c, d, w, true); }
__device__ __forceinline__ void softmax_tile(f32x16& p0, f32x16& p1, f32x16& bias, bool first, f32x16* o, float* al_l, int r32, int hi, i32x8& pa) {
  float pmax = p0[0];
#pragma unroll
  for (int r = 1; r < 16; ++r) pmax = fmaxf(pmax, p0[r]);
#pragma unroll
  for (int r = 0; r < 16; ++r) pmax = fmaxf(pmax, p1[r]);
  { auto rr = __builtin_amdgcn_permlane32_swap(__float_as_uint(pmax), __float_as_uint(pmax), false, false);
    pmax = fmaxf(__uint_as_float(rr[0]), __uint_as_float(rr[1])); }
  if (__builtin_expect(first || !__all(pmax <= PSH + THR2), 0)) {
    const float delta = first ? pmax - PSH : fmaxf(pmax - PSH, 0.f);
    if (!first) {
      if (hi == 0) al_l[r32] = __builtin_amdgcn_exp2f(-delta);
      asm volatile("s_waitcnt lgkmcnt(0)" ::: "memory");
#pragma unroll
      for (int d = 0; d < 5; ++d)
#pragma unroll
        for (int r = 0; r < 16; ++r) o[d][r] *= al_l[crow(r, hi)];
    }
    const float nb = bias[0] - delta;
#pragma unroll
    for (int r = 0; r < 16; ++r) { p0[r] -= delta; p1[r] -= delta; bias[r] = nb; }
  }
#pragma unroll
  for (int r = 0; r < 16; ++r) p0[r] = __builtin_amdgcn_exp2f(p0[r]);
#pragma unroll
  for (int r = 0; r < 16; ++r) p1[r] = __builtin_amdgcn_exp2f(p1[r]);
#pragma unroll
  for (int w = 0; w < 4; ++w) { pa[w] = pk4(p0[4 * w], p0[4 * w + 1], p0[4 * w + 2], p0[4 * w + 3], pa[w]); pa[4 + w] = pk4(p1[4 * w], p1[4 * w + 1], p1[4 * w + 2], p1[4 * w + 3], pa[4 + w]); }
}
__device__ __forceinline__ void qkt(f32x16& p0, f32x16& p1, const f32x16& bias, const char* Ks, const i32x8* q, int r32, int hi) {
  p0 = bias; p1 = bias;
  const char* k0 = Ks + r32 * KROW + hi * 32; const char* k1 = k0 + 32 * KROW;
#pragma unroll
  for (int s = 0; s < 3; ++s) {
    const i32x8 a0 = cat8(*reinterpret_cast<const i32x4*>(k0 + s * 64), *reinterpret_cast<const i32x4*>(k0 + s * 64 + 16));
    const i32x8 a1 = cat8(*reinterpret_cast<const i32x4*>(k1 + s * 64), *reinterpret_cast<const i32x4*>(k1 + s * 64 + 16));
    p0 = mfma8(a0, q[s], p0);
    p1 = mfma8(a1, q[s], p1); }
}
__device__ __forceinline__ void pv_all(f32x16* o, const char* Vs, i32x8 pa, int r32, int hi) {
  const char* v0 = Vs + r32 * VROW + hi * 32;
#pragma unroll
  for (int d0 = 0; d0 < 4; ++d0) {
    const i32x8 vb = cat8(*reinterpret_cast<const i32x4*>(v0 + d0 * 32 * VROW), *reinterpret_cast<const i32x4*>(v0 + d0 * 32 * VROW + 16));
    o[d0] = mfma8(pa, vb, o[d0]); }
  const i32x8 ones = {0x38383838, 0x38383838, 0x38383838, 0x38383838, 0x38383838, 0x38383838, 0x38383838, 0x38383838};
  o[4] = mfma8(pa, ones, o[4]);
}
__device__ __forceinline__ void attn_body(const bf16_t* __restrict__ Qb, const unsigned char* __restrict__ Kn, const unsigned char* __restrict__ Krb, const unsigned char* __restrict__ Vt,
                                          bf16_t* __restrict__ Ob, char* lds) {
  const int tid = otid(), wid = tid >> 6, lane = tid & 63, r32 = lane & 31, hi = lane >> 5;
  const bool lo4 = __builtin_amdgcn_readfirstlane(wid >> 2) == 0;
  char* V_lds = lds; char* K_lds = lds + NSLOT * SHM_V;
  float* al_l = (float*)(lds + NSLOT * (SHM_V + SHM_K)) + wid * 64;
  f32x16 bias = {}; f32x16 o[5] = {}; i32x8 q[3];
  { const bf16_t* Qw = Qb + (size_t)(wid * 32 + r32) * 192 + hi * 32;
#pragma unroll
    for (int s = 0; s < 3; ++s) {
#pragma unroll
      for (int c = 0; c < 4; ++c) { const uint4 w = *reinterpret_cast<const uint4*>(Qw + s * 64 + c * 8);
        q[s][2 * c] = pk4(bflo(w.x) * QS, bfhi(w.x) * QS, bflo(w.y) * QS, bfhi(w.y) * QS);
        q[s][2 * c + 1] = pk4(bflo(w.z) * QS, bfhi(w.z) * QS, bflo(w.w) * QS, bfhi(w.w) * QS); } } }
  i32x8 ones = {0x38383838, 0x38383838, 0x38383838, 0x38383838, 0x38383838, 0x38383838, 0x38383838, 0x38383838};
  const int vdst = (tid >> 2) * VROW + (tid & 3) * 16, kdst = (tid >> 3) * KROW + (tid & 7) * 16, rdst = (tid >> 2) * KROW + 128 + (tid & 3) * 16;
  const int kfo = r32 * KROW + hi * 32, vfo = r32 * VROW + hi * 32;
  uint4 vs, ks, rs = make_uint4(0u, 0u, 0u, 0u);
#define TLOAD(t) do { ks = *reinterpret_cast<const uint4*>(Kn + (size_t)(t) * 8192 + tid * 16); vs = *reinterpret_cast<const uint4*>(Vt + (size_t)(t) * 8192 + tid * 16); \
    if (lo4) rs = *reinterpret_cast<const uint4*>(Krb + (size_t)(t) * 4096 + tid * 16); } while (0)
#define TWRITE(sl) do { *(uint4*)(K_lds + (sl) * SHM_K + kdst) = ks; *(uint4*)(V_lds + (sl) * SHM_V + vdst) = vs; if (lo4) *(uint4*)(K_lds + (sl) * SHM_K + rdst) = rs; } while (0)
#define SWAIT() asm volatile("s_waitcnt vmcnt(0)" ::: "memory")
#define LD4(p) (*reinterpret_cast<const i32x4*>(p))
  f32x16 p0, p1; i32x8 pa = {};
  TLOAD(0); SWAIT(); TWRITE(0);
  TLOAD(1); SWAIT(); TWRITE(1);
  TLOAD(2);
  __syncthreads();
  int sl = 0, sl2 = 2;
#pragma unroll 1
  for (int i = 0; i < NTILE; ++i) {
    const char* kb = K_lds + sl * SHM_K + kfo; const char* vb = V_lds + sl * SHM_V + vfo;
    SBAR();
    i32x4 ka0 = LD4(kb), ka1 = LD4(kb + 16), ka2 = LD4(kb + 32 * KROW), ka3 = LD4(kb + 32 * KROW + 16);
    i32x4 kb0 = LD4(kb + 64), kb1 = LD4(kb + 80), kb2 = LD4(kb + 32 * KROW + 64), kb3 = LD4(kb + 32 * KROW + 80);
    SBAR();
    p0 = mfma8(cat8(ka0, ka1), q[0], bias); p1 = mfma8(cat8(ka2, ka3), q[0], bias);
    ka0 = LD4(kb + 128); ka1 = LD4(kb + 144); ka2 = LD4(kb + 32 * KROW + 128); ka3 = LD4(kb + 32 * KROW + 144);
    SBAR();
    p0 = mfma8(cat8(kb0, kb1), q[1], p0); p1 = mfma8(cat8(kb2, kb3), q[1], p1);
    i32x4 v00 = LD4(vb), v01 = LD4(vb + 16), v10 = LD4(vb + 32 * VROW), v11 = LD4(vb + 32 * VROW + 16);
    SBAR();
    p0 = mfma8(cat8(ka0, ka1), q[2], p0); p1 = mfma8(cat8(ka2, ka3), q[2], p1);
    SBAR();
    softmax_tile(p0, p1, bias, i == 0, o, al_l, r32, hi, pa);
    SBAR();
    i32x4 v20 = LD4(vb + 64 * VROW), v21 = LD4(vb + 64 * VROW + 16), v30 = LD4(vb + 96 * VROW), v31 = LD4(vb + 96 * VROW + 16);
    o[4] = mfma8(pa, ones, o[4]); o[0] = mfma8(pa, cat8(v00, v01), o[0]); o[1] = mfma8(pa, cat8(v10, v11), o[1]);
    SBAR();
    o[2] = mfma8(pa, cat8(v20, v21), o[2]); o[3] = mfma8(pa, cat8(v30, v31), o[3]);
    SBAR();
    SWAIT();
    if (i + 2 < NTILE) TWRITE(sl2);
    if (i + 3 < NTILE) TLOAD(i + 3);
    sl = sl == NSLOT - 1 ? 0 : sl + 1; sl2 = sl2 == NSLOT - 1 ? 0 : sl2 + 1;
    SBAR(); __syncthreads();
  }
  float rli[16];
#pragma unroll
  for (int r = 0; r < 16; ++r) rli[r] = __builtin_amdgcn_rcpf(o[4][r]) * (1.f / VS);
  bf16_t* Ow = Ob + (size_t)(wid * 32) * D;
#pragma unroll
  for (int r = 0; r < 16; ++r) { const int orow = crow(r, hi);
#pragma unroll
    for (int d0 = 0; d0 < 4; ++d0) Ow[(size_t)orow * D + d0 * 32 + r32] = f2bf(o[d0][r] * rli[r]); }
  __syncthreads();
#undef TLOAD
#undef TWRITE
#undef SWAIT
#undef LD4
}
}

__device__ __forceinline__ void ph_attn(const bf16_t* __restrict__ Qa, const unsigned char* __restrict__ Kn, const unsigned char* __restrict__ Kr, const unsigned char* __restrict__ Vt,
                                        bf16_t* __restrict__ AO, int bid, int nblk, char* lds) {
  for (int item = bid; item < 512; item += nblk) {
    const int b = item >> 8, h = item & 7, qb = (item >> 3) & 31;
    att::attn_body(Qa + ((size_t)(b * 8 + h) * SEQ + qb * 256) * 192, Kn + (size_t)(b * 8 + h) * KEYS * 128, Kr + (size_t)b * KEYS * 64,
                   Vt + (size_t)(b * 8 + h) * KEYS * 128, AO + (size_t)(b * SEQ + qb * 256) * D + h * 128, lds);
  }
}

namespace rt {
using f32x16 = __attribute__((ext_vector_type(16))) float;
__device__ __forceinline__ int sortable(float f) { const int b = __float_as_int(f); return b ^ ((b >> 31) & 0x7FFFFFFF); }
__device__ __forceinline__ float unsortable(int k) { return __int_as_float(k ^ ((k >> 31) & 0x7FFFFFFF)); }
__device__ __forceinline__ int imax(int a, int b) { return a > b ? a : b; }
__device__ __forceinline__ int imin(int a, int b) { return a < b ? a : b; }
template <int N> __device__ __forceinline__ void sort_desc(int (&v)[N]) {
#pragma unroll
  for (int k = 2; k <= N; k <<= 1) {
#pragma unroll
    for (int j = k >> 1; j > 0; j >>= 1) {
#pragma unroll
      for (int i = 0; i < N; ++i) {
        const int l = i ^ j;
        if (l > i) {
          const bool desc = ((i & k) == 0);
          const int a = v[i], b = v[l];
          v[i] = desc ? imax(a, b) : imin(a, b);
          v[l] = desc ? imin(a, b) : imax(a, b);
        }
      }
    }
  }
}
template <int N> __device__ __forceinline__ void merge_desc(int (&v)[N]) {
#pragma unroll
  for (int j = N >> 1; j > 0; j >>= 1) {
#pragma unroll
    for (int i = 0; i < N; ++i) {
      const int l = i ^ j;
      if (l > i) { const int a = v[i], b = v[l]; v[i] = imax(a, b); v[l] = imin(a, b); }
    }
  }
}
__device__ __forceinline__ void absorb16(int (&L)[16], int (&B)[16]) {
  sort_desc<16>(B);
#pragma unroll
  for (int i = 0; i < 16; ++i) L[i] = imax(L[i], B[15 - i]);
  merge_desc<16>(L);
}
__device__ __forceinline__ constexpr int npairs_row(int i) { return 16 / (i + 1); }
}

struct RouteP { const bf16_t* Q; const bf16_t* Khi; int* IDX; float* GATE; int rows_per_block; int pad; };
__device__ __forceinline__ void ph_route(const RouteP& p, int bid, char* lds) {
  using namespace rt;
  int (*svl)[64][33] = reinterpret_cast<int (*)[64][33]>(lds);
  const int wave = otid() >> 6, lane = otid() & 63, r32 = lane & 31, hi = lane >> 5, hi4 = hi * 4;
  int nrows = p.rows_per_block; asm volatile("" : "+s"(nrows));
  const int g0 = bid * nrows;
  const int h = wave;
#pragma unroll 1
  for (int tg = 0; tg * 32 < nrows; ++tg) {
    int trow = tg * 32 + r32; const bool valid = trow < nrows; trow = valid ? trow : nrows - 1;
    const bf16_t* qrow = p.Q + (size_t)(g0 + trow) * D;
    int sv[2][16];
#pragma unroll
    for (int s = 0; s < 2; ++s) {
      const int hs = h * 2 + s;
      f32x16 acc[4];
#pragma unroll
      for (int m = 0; m < 4; ++m) acc[m] = f32x16{};
#pragma unroll
      for (int kp = 0; kp < 2; ++kp) {
        bf16x8 kf[2][4], qf[2];
#pragma unroll
        for (int k2 = 0; k2 < 2; ++k2)
#pragma unroll
          for (int m = 0; m < 4; ++m) kf[k2][m] = *(const bf16x8*)(p.Khi + ((size_t)(hs * 128 + m * 32 + r32)) * 64 + (kp * 2 + k2) * 16 + hi * 8);
#pragma unroll
        for (int k2 = 0; k2 < 2; ++k2) {
          const int ks = kp * 2 + k2;
          qf[k2] = *(const bf16x8*)(qrow + hs * 64 + ks * 16 + hi * 8);
        }
#pragma unroll
        for (int k2 = 0; k2 < 2; ++k2)
#pragma unroll
          for (int m = 0; m < 4; ++m) acc[m] = __builtin_amdgcn_mfma_f32_32x32x16_bf16(kf[k2][m], qf[k2], acc[m], 0, 0, 0);
      }
      int L[16];
#pragma unroll
      for (int m = 0; m < 4; ++m) {
        int B[16];
#pragma unroll
        for (int r = 0; r < 16; ++r) B[r] = (sortable(acc[m][r]) & ~0x7F) | (m * 32 + (r & 3) + 8 * (r >> 2)) | hi4;
        if (m == 0) { sort_desc<16>(B);
#pragma unroll
          for (int i = 0; i < 16; ++i) L[i] = B[i]; }
        else absorb16(L, B);
      }
      int Lo[16], Hi[16];
#pragma unroll
      for (int i = 0; i < 16; ++i) { auto rr = __builtin_amdgcn_permlane32_swap((unsigned)L[i], (unsigned)L[i], false, false); Lo[i] = (int)rr[0]; Hi[i] = (int)rr[1]; }
#pragma unroll
      for (int i = 0; i < 16; ++i) L[i] = imax(Lo[i], Hi[15 - i]);
      merge_desc<16>(L);
#pragma unroll
      for (int i = 0; i < 16; ++i) { sv[s][i] = L[i]; svl[wave][lane][s * 16 + i] = L[i]; }
    }
    float f0[16], f1[16];
#pragma unroll
    for (int i = 0; i < 16; ++i) { f0[i] = unsortable(sv[0][i] & ~0x7F); f1[i] = unsortable(sv[1][i] & ~0x7F); }
    int Lc[16];
    {
      int C[64];
      int n = 0;
#pragma unroll
      for (int i = 0; i < 16; ++i)
#pragma unroll
        for (int j = 0; j < 16; ++j)
          if ((i + 1) * (j + 1) <= 16) { C[n] = (sortable(f0[i] + f1[j]) & ~0xFF) | (i * 16 + j); ++n; }
#pragma unroll
      for (int k = 50; k < 64; ++k) C[k] = (int)0x80000000;
#pragma unroll
      for (int m = 0; m < 4; ++m) {
        int B[16];
#pragma unroll
        for (int r = 0; r < 16; ++r) B[r] = C[m * 16 + r];
        if (m == 0) { sort_desc<16>(B);
#pragma unroll
          for (int i = 0; i < 16; ++i) Lc[i] = B[i]; }
        else absorb16(Lc, B);
      }
    }
    float e[16]; float esum = 0.f;
    const float vmax = unsortable(Lc[0] & ~0xFF);
#pragma unroll
    for (int r = 0; r < 16; ++r) { e[r] = expf(unsortable(Lc[r] & ~0xFF) - vmax); esum += e[r]; }
    const float inv = 1.f / esum;
    int eid[16];
#pragma unroll
    for (int r = 0; r < 16; ++r) {
      const int pr = Lc[r] & 0xFF;
      const int k0 = svl[wave][lane][pr >> 4] & 0x7F, k1 = svl[wave][lane][16 + (pr & 15)] & 0x7F;
      eid[r] = k0 * 128 + k1;
    }
    if (valid && hi == 0) {
      int* ip = p.IDX + (size_t)(g0 + trow) * 128 + h * 16; float* gp = p.GATE + (size_t)(g0 + trow) * 128 + h * 16;
#pragma unroll
      for (int r = 0; r < 16; r += 4) {
        *(int4*)(ip + r) = make_int4(eid[r], eid[r + 1], eid[r + 2], eid[r + 3]);
        *(float4*)(gp + r) = make_float4(e[r] * inv, e[r + 1] * inv, e[r + 2] * inv, e[r + 3] * inv);
      }
    }
  }
}

constexpr int RB = 8;
template <bool SIGNED>
__device__ __forceinline__ void cvt_rows_i8(const float* __restrict__ src, unsigned char* __restrict__ dst, float* __restrict__ scl, int nrows, int wgid, int nw) {
  const int lane = otid() & 63;
  for (int r0 = wgid * RB; r0 < nrows; r0 += nw * RB) {
    float v[RB][16];
#pragma unroll
    for (int u = 0; u < RB; ++u) {
      const float* sp = src + (size_t)(r0 + u) * D + lane * 4;
      *(float4*)&v[u][0] = *(const float4*)sp; *(float4*)&v[u][4] = *(const float4*)(sp + 256); *(float4*)&v[u][8] = *(const float4*)(sp + 512); *(float4*)&v[u][12] = *(const float4*)(sp + 768);
    }
#pragma unroll
    for (int u = 0; u < RB; ++u) {
      float am = 0.f;
#pragma unroll
      for (int j = 0; j < 16; ++j) am = fmaxf(am, fabsf(v[u][j]));
      am = wave_max_dpp(am);
      const float sc = am > 0.f ? am * (1.f / 127.f) : 1.f, inv = 1.f / sc;
      unsigned w[4];
#pragma unroll
      for (int q4 = 0; q4 < 4; ++q4) {
        unsigned ww = 0u;
#pragma unroll
        for (int j = 0; j < 4; ++j) { int qi = (int)rintf(v[u][q4 * 4 + j] * inv) + (SIGNED ? 0 : 128); qi = SIGNED ? (qi < -127 ? -127 : (qi > 127 ? 127 : qi)) : (qi < 1 ? 1 : (qi > 255 ? 255 : qi)); ww |= (unsigned)(qi & 255) << (8 * j); }
        w[q4] = ww;
      }
      *(uint4*)(dst + (size_t)(r0 + u) * D + lane * 16) = make_uint4(w[0], w[1], w[2], w[3]);
      if (lane == 0) scl[r0 + u] = sc;
    }
  }
}

constexpr int QROW = 768;
__device__ __forceinline__ void cvt_rows_q6(const float* __restrict__ src, unsigned char* __restrict__ dst, float* __restrict__ scl, int nrows, int wgid, int nw) {
  const int lane = otid() & 63;
  for (int r0 = wgid * RB; r0 < nrows; r0 += nw * RB) {
    float v[RB][16];
#pragma unroll
    for (int u = 0; u < RB; ++u) {
      const float* sp = src + (size_t)(r0 + u) * D + lane * 4;
      *(float4*)&v[u][0] = *(const float4*)sp; *(float4*)&v[u][4] = *(const float4*)(sp + 256); *(float4*)&v[u][8] = *(const float4*)(sp + 512); *(float4*)&v[u][12] = *(const float4*)(sp + 768);
    }
#pragma unroll
    for (int u = 0; u < RB; ++u) {
      float am = 0.f;
#pragma unroll
      for (int j = 0; j < 16; ++j) am = fmaxf(am, fabsf(v[u][j]));
      am = wave_max_dpp(am);
      const float sc = am > 0.f ? am * (1.f / 31.f) : 1.f, inv = 1.f / sc;
      unsigned long long lo = 0ull, hi = 0ull;
#pragma unroll
      for (int j = 0; j < 16; ++j) {
        int qi = (int)rintf(v[u][j] * inv) + 32; qi = qi < 1 ? 1 : (qi > 63 ? 63 : qi);
        const int bit = 6 * j;
        if (bit < 64) { lo |= (unsigned long long)qi << bit; if (bit > 58) hi |= (unsigned long long)qi >> (64 - bit); }
        else hi |= (unsigned long long)qi << (bit - 64);
      }
      unsigned* dp = (unsigned*)(dst + (size_t)(r0 + u) * QROW + lane * 12);
      dp[0] = (unsigned)lo; dp[1] = (unsigned)(lo >> 32); dp[2] = (unsigned)hi;
      if (lane == 0) scl[r0 + u] = sc;
    }
  }
}
struct q6w { unsigned x, y, z; };
template <int J> __device__ __forceinline__ float q6(const q6w& w) {
  constexpr int bit = 6 * J, wd = bit >> 5, sh = bit & 31;
  const unsigned lo = wd == 0 ? w.x : (wd == 1 ? w.y : w.z);
  if constexpr (sh == 26) return (float)(lo >> 26);
  else if constexpr (sh < 26) return (float)((lo >> sh) & 63u);
  else { const unsigned hi = wd == 0 ? w.y : w.z; return (float)(__builtin_amdgcn_alignbit(hi, lo, sh) & 63u); }
}

struct GatherP { const bf16_t* Tbf; const int* IDX; const float* GATE; const unsigned char* utab; const unsigned char* vtab; const float* su; const float* sv;
                 const float* Hin; const float* mod; const float* lng; const float* lnb; float* Hout; const float* modT; };
#define UB0(w) ((float)((w) & 0xFFu))
#define UB1(w) ((float)(((w) >> 8) & 0xFFu))
#define UB2(w) ((float)(((w) >> 16) & 0xFFu))
#define UB3(w) ((float)((w) >> 24))
template <bool FINAL>
__device__ __forceinline__ void ln_token(const GatherP& p, int row, int rr, int lane, const float (&f)[16], float asum, char* As) {
  const int v = row_vec(row);
  const float* hin = p.Hin + (size_t)row * D + lane * 4;
  const float* gm = p.mod + v * 6144 + 5 * 1024 + lane * 4;
  const float off = 32.f * asum;
  float r[16]; float ssum = 0.f;
#pragma unroll
  for (int q4 = 0; q4 < 4; ++q4) {
    const float4 h4 = *(const float4*)(hin + q4 * 256), g4 = *(const float4*)(gm + q4 * 256);
    r[q4 * 4 + 0] = ALPHA * h4.x + g4.x * (f[q4 * 4 + 0] - off); r[q4 * 4 + 1] = ALPHA * h4.y + g4.y * (f[q4 * 4 + 1] - off);
    r[q4 * 4 + 2] = ALPHA * h4.z + g4.z * (f[q4 * 4 + 2] - off); r[q4 * 4 + 3] = ALPHA * h4.w + g4.w * (f[q4 * 4 + 3] - off);
    ssum += r[q4 * 4 + 0] + r[q4 * 4 + 1] + r[q4 * 4 + 2] + r[q4 * 4 + 3];
  }
  const float mu = wave_sum(ssum) * (1.f / D);
  float vs = 0.f;
#pragma unroll
  for (int j = 0; j < 16; ++j) { const float dlt = r[j] - mu; vs += dlt * dlt; }
  const float rstd = rsqrtf(wave_sum(vs) * (1.f / D) + LN_EPS);
  float o[16];
#pragma unroll
  for (int q4 = 0; q4 < 4; ++q4) {
    const float4 g4 = *(const float4*)(p.lng + q4 * 256 + lane * 4), b4 = *(const float4*)(p.lnb + q4 * 256 + lane * 4);
    o[q4 * 4 + 0] = (r[q4 * 4 + 0] - mu) * rstd * g4.x + b4.x; o[q4 * 4 + 1] = (r[q4 * 4 + 1] - mu) * rstd * g4.y + b4.y;
    o[q4 * 4 + 2] = (r[q4 * 4 + 2] - mu) * rstd * g4.z + b4.z; o[q4 * 4 + 3] = (r[q4 * 4 + 3] - mu) * rstd * g4.w + b4.w;
    *(float4*)(p.Hout + (size_t)row * D + q4 * 256 + lane * 4) = make_float4(o[q4 * 4 + 0], o[q4 * 4 + 1], o[q4 * 4 + 2], o[q4 * 4 + 3]);
  }
  if (!FINAL) {
    const float* mt = p.modT + v * 6144 + lane * 4;
#pragma unroll
    for (int q4 = 0; q4 < 4; ++q4) {
      const float4 sh = *(const float4*)(mt + q4 * 256), sc = *(const float4*)(mt + 1024 + q4 * 256);
      uint2 w; w.x = pack2bf(o[q4 * 4] * (1.f + sc.x) + sh.x, o[q4 * 4 + 1] * (1.f + sc.y) + sh.y); w.y = pack2bf(o[q4 * 4 + 2] * (1.f + sc.z) + sh.z, o[q4 * 4 + 3] * (1.f + sc.w) + sh.w);
      *(uint2*)(As + rr * LDA_B + (q4 * 256 + lane * 4) * 2) = w;
    }
  }
}
constexpr int PARTW = 1088;
template <bool FINAL>
__device__ __forceinline__ void ph_gather_tm(const GatherP& p, int g0, int nrows, char* As, float* __restrict__ PART) {
  const int tid = otid(), wave = tid >> 6, lane = tid & 63;
  const int nfull = nrows >> 3, extra = nrows & 7;
  const int nun = nfull + (extra ? 1 : 0);
  auto desc = [&](int un, int& rr, int& kbeg, int& kcnt, bool& partial) {
    if (un < nfull) { rr = wave + 8 * un; kbeg = 0; kcnt = 128; partial = false; }
    else { const int wpt = 8 / extra; rr = nfull * 8 + wave / wpt; kcnt = 128 / wpt; kbeg = (wave % wpt) * kcnt; partial = true; }
  };
  uint2 nt0, nt1, nt2, nt3; int nid_lo, nid_hi; float nga_lo, nga_hi;
#define NLOAD(row_) do { const bf16_t* tp_ = p.Tbf + (size_t)(row_) * D + lane * 4; nt0 = *(const uint2*)tp_; nt1 = *(const uint2*)(tp_ + 256); nt2 = *(const uint2*)(tp_ + 512); nt3 = *(const uint2*)(tp_ + 768); \
    nid_lo = p.IDX[(size_t)(row_) * 128 + lane]; nid_hi = p.IDX[(size_t)(row_) * 128 + 64 + lane]; nga_lo = p.GATE[(size_t)(row_) * 128 + lane]; nga_hi = p.GATE[(size_t)(row_) * 128 + 64 + lane]; } while (0)
  { int rr0, kb0, kc0; bool pa0; desc(0, rr0, kb0, kc0, pa0); NLOAD(g0 + rr0); }
#pragma unroll 1
  for (int un = 0; un < nun; ++un) {
    int rr, kbeg, kcnt; bool partial;
    desc(un, rr, kbeg, kcnt, partial);
    const int row = g0 + rr;
    float tf[16];
    {
      const uint2 t0 = nt0, t1 = nt1, t2 = nt2, t3 = nt3;
      tf[0] = bflo(t0.x); tf[1] = bfhi(t0.x); tf[2] = bflo(t0.y); tf[3] = bfhi(t0.y); tf[4] = bflo(t1.x); tf[5] = bfhi(t1.x); tf[6] = bflo(t1.y); tf[7] = bfhi(t1.y);
      tf[8] = bflo(t2.x); tf[9] = bfhi(t2.x); tf[10] = bflo(t2.y); tf[11] = bfhi(t2.y); tf[12] = bflo(t3.x); tf[13] = bfhi(t3.x); tf[14] = bflo(t3.y); tf[15] = bfhi(t3.y);
    }
    float tam = 0.f;
#pragma unroll
    for (int j = 0; j < 16; ++j) tam = fmaxf(tam, fabsf(tf[j]));
    tam = wave_max_dpp(tam);
    const float st = tam > 0.f ? tam * (1.f / 127.f) : 1.f, tinv = 1.f / st;
    int tq[4];
#pragma unroll
    for (int k4 = 0; k4 < 4; ++k4) {
      unsigned ww = 0u;
#pragma unroll
      for (int j = 0; j < 4; ++j) ww |= (unsigned)((int)rintf(tf[k4 * 4 + j] * tinv) & 255) << (8 * j);
      tq[k4] = (int)ww;
    }
    const int id_lo = nid_lo, id_hi = nid_hi;
    const float ga_lo = nga_lo, ga_hi = nga_hi;
    const float su_lo = p.su[id_lo], su_hi = p.su[id_hi], sv_lo = p.sv[id_lo], sv_hi = p.sv[id_hi];
    float f[16];
#pragma unroll
    for (int j = 0; j < 16; ++j) f[j] = 0.f;
    uint4 rb[8];
    float dlo = 0.f, dhi = 0.f;
#define ULOAD(slot, kk) do { const int e_ = __builtin_amdgcn_readlane((kk) < 64 ? id_lo : id_hi, (kk) & 63); \
      rb[slot] = *(const uint4*)(p.utab + (size_t)e_ * D + lane * 16); } while (0)
#define VLOAD(slot, kk) do { const int e_ = __builtin_amdgcn_readlane((kk) < 64 ? id_lo : id_hi, (kk) & 63); \
      const q6w t_ = *(const q6w*)(p.vtab + (size_t)e_ * QROW + lane * 12); rb[slot].x = t_.x; rb[slot].y = t_.y; rb[slot].z = t_.z; } while (0)
    auto proc4u = [&](int s0, int k0) {
      float dot[4];
#pragma unroll
      for (int u = 0; u < 4; ++u) {
        const uint4 a_ = rb[s0 + u];
        int di = __builtin_amdgcn_sdot4((int)a_.x, tq[0], 0, false); di = __builtin_amdgcn_sdot4((int)a_.y, tq[1], di, false);
        di = __builtin_amdgcn_sdot4((int)a_.z, tq[2], di, false); di = __builtin_amdgcn_sdot4((int)a_.w, tq[3], di, false);
        dot[u] = (float)di;
      }
#define DPPSTEP(ctl, rm) do { _Pragma("unroll") for (int u = 0; u < 4; ++u) dot[u] += __uint_as_float(__builtin_amdgcn_update_dpp(0u, __float_as_uint(dot[u]), ctl, rm, 0xF, true)); } while (0)
      DPPSTEP(0xB1, 0xF); DPPSTEP(0x4E, 0xF); DPPSTEP(0x141, 0xF); DPPSTEP(0x140, 0xF); DPPSTEP(0x142, 0xA); DPPSTEP(0x143, 0xC);
#undef DPPSTEP
      if (k0 < 64) {
#pragma unroll
        for (int u = 0; u < 4; ++u) dlo = __uint_as_float(__builtin_amdgcn_update_dpp(__float_as_uint(dot[u]), __float_as_uint(dlo), 0x130, 0xF, 0xF, false));
      } else {
#pragma unroll
        for (int u = 0; u < 4; ++u) dhi = __uint_as_float(__builtin_amdgcn_update_dpp(__float_as_uint(dot[u]), __float_as_uint(dhi), 0x130, 0xF, 0xF, false));
      }
    };
    float act_lo = 0.f, act_hi = 0.f;
    auto proc4v = [&](int s0, int k0) {
      float act[4];
      if (k0 < 64) {
#pragma unroll
        for (int u = 0; u < 4; ++u) act[u] = __uint_as_float((unsigned)__builtin_amdgcn_readlane((int)__float_as_uint(act_lo), k0 + u));
      } else {
#pragma unroll
        for (int u = 0; u < 4; ++u) act[u] = __uint_as_float((unsigned)__builtin_amdgcn_readlane((int)__float_as_uint(act_hi), k0 - 64 + u));
      }
#pragma unroll
      for (int u = 0; u < 4; ++u) {
        const float act_ = act[u];
        const q6w c_ = {rb[s0 + u].x, rb[s0 + u].y, rb[s0 + u].z};
        f[0] = fmaf(act_, q6<0>(c_), f[0]); f[1] = fmaf(act_, q6<1>(c_), f[1]); f[2] = fmaf(act_, q6<2>(c_), f[2]); f[3] = fmaf(act_, q6<3>(c_), f[3]);
        f[4] = fmaf(act_, q6<4>(c_), f[4]); f[5] = fmaf(act_, q6<5>(c_), f[5]); f[6] = fmaf(act_, q6<6>(c_), f[6]); f[7] = fmaf(act_, q6<7>(c_), f[7]);
        f[8] = fmaf(act_, q6<8>(c_), f[8]); f[9] = fmaf(act_, q6<9>(c_), f[9]); f[10] = fmaf(act_, q6<10>(c_), f[10]); f[11] = fmaf(act_, q6<11>(c_), f[11]);
        f[12] = fmaf(act_, q6<12>(c_), f[12]); f[13] = fmaf(act_, q6<13>(c_), f[13]); f[14] = fmaf(act_, q6<14>(c_), f[14]); f[15] = fmaf(act_, q6<15>(c_), f[15]);
      }
    };
    ULOAD(0, kbeg); ULOAD(1, kbeg + 1); ULOAD(2, kbeg + 2); ULOAD(3, kbeg + 3); ULOAD(4, kbeg + 4); ULOAD(5, kbeg + 5); ULOAD(6, kbeg + 6); ULOAD(7, kbeg + 7);
    const int kend = kbeg + kcnt - 8;
#pragma unroll 1
    for (int k = kbeg; k < kend; k += 8) {
      proc4u(0, k); ULOAD(0, k + 8); ULOAD(1, k + 9); ULOAD(2, k + 10); ULOAD(3, k + 11);
      proc4u(4, k + 4); ULOAD(4, k + 12); ULOAD(5, k + 13); ULOAD(6, k + 14); ULOAD(7, k + 15);
    }
    proc4u(0, kend); VLOAD(0, kbeg); VLOAD(1, kbeg + 1); VLOAD(2, kbeg + 2); VLOAD(3, kbeg + 3);
    proc4u(4, kend + 4); VLOAD(4, kbeg + 4); VLOAD(5, kbeg + 5); VLOAD(6, kbeg + 6); VLOAD(7, kbeg + 7);
    if (partial) {
      const int srcl = ((lane - (kbeg & 63) + 32) & 63) * 4;
      const float sh_lo = __uint_as_float((unsigned)__builtin_amdgcn_ds_bpermute(srcl, (int)__float_as_uint(dlo))), sh_hi = __uint_as_float((unsigned)__builtin_amdgcn_ds_bpermute(srcl, (int)__float_as_uint(dhi)));
      const bool in = lane >= (kbeg & 63) && lane < (kbeg & 63) + 32;
      dlo = in ? sh_lo : 0.f; dhi = in ? sh_hi : 0.f;
    }
    act_lo = gelu_fast(su_lo * st * dlo) * ga_lo * sv_lo; act_hi = gelu_fast(su_hi * st * dhi) * ga_hi * sv_hi;
    const float asum = wave_sum_dpp(act_lo + act_hi);
    if (un + 1 < nun) { int nrr, nkb, nkc; bool npa; desc(un + 1, nrr, nkb, nkc, npa); NLOAD(g0 + nrr); }
#pragma unroll 1
    for (int k = kbeg; k < kend; k += 8) {
      proc4v(0, k); VLOAD(0, k + 8); VLOAD(1, k + 9); VLOAD(2, k + 10); VLOAD(3, k + 11);
      proc4v(4, k + 4); VLOAD(4, k + 12); VLOAD(5, k + 13); VLOAD(6, k + 14); VLOAD(7, k + 15);
    }
    proc4v(0, kend); proc4v(4, kend + 4);
#undef ULOAD
#undef VLOAD
    if (!partial) ln_token<FINAL>(p, row, rr, lane, f, asum, As);
    else {
      float* pp = PART + wave * PARTW + lane * 16;
      *(float4*)pp = make_float4(f[0], f[1], f[2], f[3]); *(float4*)(pp + 4) = make_float4(f[4], f[5], f[6], f[7]);
      *(float4*)(pp + 8) = make_float4(f[8], f[9], f[10], f[11]); *(float4*)(pp + 12) = make_float4(f[12], f[13], f[14], f[15]);
      if (lane == 0) PART[wave * PARTW + 1024] = asum;
    }
  }
#undef NLOAD
  if (extra) {
    __syncthreads();
    if (wave < extra) {
      const int wpt = 8 / extra, rr = nfull * 8 + wave;
      float f[16], asum = 0.f;
#pragma unroll
      for (int j = 0; j < 16; ++j) f[j] = 0.f;
      for (int w2 = wave * wpt; w2 < wave * wpt + wpt; ++w2) {
        const float* pp = PART + w2 * PARTW + lane * 16;
#pragma unroll
        for (int q4 = 0; q4 < 4; ++q4) { const float4 x4 = *(const float4*)(pp + q4 * 4); f[q4 * 4] += x4.x; f[q4 * 4 + 1] += x4.y; f[q4 * 4 + 2] += x4.z; f[q4 * 4 + 3] += x4.w; }
        asum += PART[w2 * PARTW + 1024];
      }
      ln_token<FINAL>(p, g0 + rr, rr, lane, f, asum, As);
    }
  }
}

__device__ __forceinline__ void cvt_plain(const float* __restrict__ a, bf16_t* __restrict__ o, size_t n8, bool lo, size_t gtid, size_t gsz) {
  for (size_t i = gtid; i < n8; i += gsz) {
    float v[8];
    *(float4*)&v[0] = ((const float4*)a)[i * 2]; *(float4*)&v[4] = ((const float4*)a)[i * 2 + 1];
    if (lo) {
#pragma unroll
      for (int j = 0; j < 8; ++j) v[j] = v[j] - bf2f(f2bf(v[j]));
    }
    uint4 w; w.x = pack2bf(v[0], v[1]); w.y = pack2bf(v[2], v[3]); w.z = pack2bf(v[4], v[5]); w.w = pack2bf(v[6], v[7]);
    ((uint4*)o)[i] = w;
  }
}
__device__ __forceinline__ void cvt_t(const float* __restrict__ W, bf16_t* __restrict__ Wt, int K, int N, bool lo, size_t gtid, size_t gsz) {
  const int N4 = N >> 2;
  const size_t total = (size_t)N4 * (K / 8);
#pragma unroll 2
  for (size_t i = gtid; i < total; i += gsz) {
    const int n = (int)(i % N4) * 4, k8 = (int)(i / N4);
    float4 r[8];
#pragma unroll
    for (int j = 0; j < 8; ++j) r[j] = *(const float4*)(W + (size_t)(k8 * 8 + j) * N + n);
    if (lo) {
#pragma unroll
      for (int j = 0; j < 8; ++j) { r[j].x -= bf2f(f2bf(r[j].x)); r[j].y -= bf2f(f2bf(r[j].y)); r[j].z -= bf2f(f2bf(r[j].z)); r[j].w -= bf2f(f2bf(r[j].w)); }
    }
    uint4* dst = (uint4*)(Wt + ((size_t)((n >> 4) * (K >> 5) + (k8 >> 2)) * 64 + (k8 & 3) * 16 + (n & 15)) * 8);
    dst[0] = make_uint4(pack2bf(r[0].x, r[1].x), pack2bf(r[2].x, r[3].x), pack2bf(r[4].x, r[5].x), pack2bf(r[6].x, r[7].x));
    dst[1] = make_uint4(pack2bf(r[0].y, r[1].y), pack2bf(r[2].y, r[3].y), pack2bf(r[4].y, r[5].y), pack2bf(r[6].y, r[7].y));
    dst[2] = make_uint4(pack2bf(r[0].z, r[1].z), pack2bf(r[2].z, r[3].z), pack2bf(r[4].z, r[5].z), pack2bf(r[6].z, r[7].z));
    dst[3] = make_uint4(pack2bf(r[0].w, r[1].w), pack2bf(r[2].w, r[3].w), pack2bf(r[4].w, r[5].w), pack2bf(r[6].w, r[7].w));
  }
}
__device__ __forceinline__ void cvt_t8(const float* __restrict__ W, unsigned char* __restrict__ Wt, int K, int N, size_t gtid, size_t gsz) {
  const int N4 = N >> 2;
  const size_t total = (size_t)N4 * (K / 8);
#pragma unroll 2
  for (size_t i = gtid; i < total; i += gsz) {
    const int n = (int)(i % N4) * 4, k8 = (int)(i / N4);
    float4 r[8];
#pragma unroll
    for (int j = 0; j < 8; ++j) r[j] = *(const float4*)(W + (size_t)(k8 * 8 + j) * N + n);
    unsigned char* dst = Wt + ((size_t)((n >> 4) * (K >> 6) + (k8 >> 3)) * 64 + (k8 & 3) * 16 + (n & 15)) * 16 + ((k8 >> 2) & 1) * 8;
#define PK8(C) make_uint2((unsigned)__builtin_amdgcn_cvt_pk_fp8_f32(r[2].C * 32.f, r[3].C * 32.f, __builtin_amdgcn_cvt_pk_fp8_f32(r[0].C * 32.f, r[1].C * 32.f, 0, false), true), \
                          (unsigned)__builtin_amdgcn_cvt_pk_fp8_f32(r[6].C * 32.f, r[7].C * 32.f, __builtin_amdgcn_cvt_pk_fp8_f32(r[4].C * 32.f, r[5].C * 32.f, 0, false), true))
    *(uint2*)(dst) = PK8(x); *(uint2*)(dst + 16) = PK8(y); *(uint2*)(dst + 32) = PK8(z); *(uint2*)(dst + 48) = PK8(w);
#undef PK8
  }
}
__device__ __forceinline__ void mod_item(const float* __restrict__ c, const float* __restrict__ c_ctx, const float* __restrict__ ada_w, const float* __restrict__ ada_b,
                                         float* __restrict__ MOD, int item, bool valid, char* lds, int tid, int nct, volatile int* cbc, int& cgen) {
  float* sc = (float*)lds;
  float* part = sc + 3072;
  const int wave = tid >> 6, lane = tid & 63, l = item / 96, cg = item % 96, nw = nct >> 6;
  if (valid) for (int i = tid; i < 3072; i += nct) { const int v = i >> 10, k = i & 1023; const float xv = v < 2 ? c[v * 1024 + k] : c_ctx[k]; sc[i] = xv / (1.f + expf(-xv)); }
  cbar(cbc, cgen, nw);
  if (valid) {
    float a0 = 0.f, a1 = 0.f, a2 = 0.f;
    const float* W = ada_w + (size_t)l * 1024 * 6144 + cg * 64 + lane;
    const int kb = wave * 171, ke = kb + 171 < 1024 ? kb + 171 : 1024;
#pragma unroll 57
    for (int k = kb; k < ke; ++k) { const float w = W[(size_t)k * 6144]; a0 += sc[k] * w; a1 += sc[1024 + k] * w; a2 += sc[2048 + k] * w; }
    part[(wave * 3 + 0) * 64 + lane] = a0; part[(wave * 3 + 1) * 64 + lane] = a1; part[(wave * 3 + 2) * 64 + lane] = a2;
  }
  cbar(cbc, cgen, nw);
  if (valid && tid < 192) {
    const int v = tid >> 6, ln = tid & 63; float sum = 0.f;
    for (int w = 0; w < nw; ++w) sum += part[(w * 3 + v) * 64 + ln];
    MOD[(l * 3 + v) * 6144 + cg * 64 + ln] = sum + ada_b[l * 6144 + cg * 64 + ln];
  }
}

__device__ __forceinline__ void gbar(unsigned* cnt, unsigned target) {
  asm volatile("s_waitcnt vmcnt(0)" ::: "memory");
  __syncthreads();
  if (otid() == 0) {
    __builtin_amdgcn_fence(__ATOMIC_RELEASE, "agent");
    asm volatile("s_waitcnt vmcnt(0)" ::: "memory");
    __hip_atomic_fetch_add(cnt, 1u, __ATOMIC_RELAXED, __HIP_MEMORY_SCOPE_AGENT);
    unsigned spins = 0;
    while (__hip_atomic_load(cnt, __ATOMIC_RELAXED, __HIP_MEMORY_SCOPE_AGENT) < target) { __builtin_amdgcn_s_sleep(2); if (++spins > (1u << 24)) break; }
    __builtin_amdgcn_fence(__ATOMIC_ACQUIRE, "agent");
    asm volatile("s_waitcnt vmcnt(0)" ::: "memory");
  }
  __syncthreads();
}

struct MP {
  const float *x, *c, *ctx, *c_ctx, *ada_w, *ada_b, *ln_g, *ln_b, *s5_a_re, *s5_a_im, *s5_log_dt, *s5_b_re, *s5_b_im, *s5_c_re, *s5_c_im, *s5_d, *s5_w_glu, *s5_w_o;
  const float *mla_w_dq, *mla_q_norm, *mla_w_uq, *mla_w_dkv, *mla_kv_norm, *mla_w_ukv, *mla_w_o, *peer_w_q, *peer_keys, *peer_u, *peer_v;
  float* out;
  float* MOD; bf16_t *Wt_glu, *Wt_o0, *Wt_q0, *Wt_o1, *Wt_q1, *Wt_cat, *Wt_uq, *Wt_ukv, *Khi, *Khi1;
  unsigned char *U0, *V0, *U1, *V1; float *SU0, *SV0, *SU1, *SV1; bf16_t *Ktab, *Bst_t, *Cin_t;
  bf16_t* Ypart; float* Ssta; bf16_t *HP, *Gbf, *Vbf, *Tbf; float *OQ, *H1, *H2; int* IDX; float* GATE;
  bf16_t *Qa, *AObf; unsigned char *Kn, *Kr, *Va; float* H3; bf16_t* Tbf1; unsigned* BAR; float* PART;
};
constexpr int LDS_BYTES = 66 * 784 + 66 * 528 + 1024 * 68 + 64;
__global__ __launch_bounds__(512) void mega(MP p) {
  __shared__ __attribute__((aligned(16))) char lds[LDS_BYTES];
  cg::grid_group grid = cg::this_grid();
  const int nblk = gridDim.x;
  int bid = blockIdx.x;
  const size_t TD = (size_t)1024 * 16384;
  const float* mod0 = p.MOD; const float* mod1 = p.MOD + 3 * 6144;
  {
    volatile int* cbc = (volatile int*)(lds + LDS_BYTES - 16);
    if (otid() == 0) *cbc = 0;
    __syncthreads();
    const int t0 = otid();
    if (t0 < 128) {
      const size_t mt = (size_t)bid * 128 + t0, ms = (size_t)nblk * 128;
      const int mw = bid * 2 + (t0 >> 6), nmw = nblk * 2;
      cvt_t(p.s5_w_glu, p.Wt_glu, D, D, false, mt, ms);
      cvt_t(p.s5_w_o, p.Wt_o0, D, D, false, mt, ms);
      cvt_t(p.peer_w_q, p.Wt_q0, D, D, false, mt, ms);
      cvt_t8(p.mla_w_o, (unsigned char*)p.Wt_o1, D, D, mt, ms);
      cvt_t(p.peer_w_q + (size_t)D * D, p.Wt_q1, D, D, false, mt, ms);
      cvt_t8(p.mla_w_dq, (unsigned char*)p.Wt_cat, D, 384, mt, ms);
      cvt_t8(p.mla_w_dkv, (unsigned char*)p.Wt_cat + (size_t)384 * D, D, 320, mt, ms);
      cvt_t8(p.mla_w_uq, (unsigned char*)p.Wt_uq, 384, 1536, mt, ms);
      cvt_t8(p.mla_w_ukv, (unsigned char*)p.Wt_ukv, 256, 2048, mt, ms);
      cvt_plain(p.peer_keys, p.Khi, (size_t)2 * 131072 / 8, false, mt, ms);
      cvt_rows_i8<true>(p.peer_u, p.U0, p.SU0, 16384, mw, nmw);
      cvt_rows_q6(p.peer_v, p.V0, p.SV0, 16384, mw, nmw);
      cvt_rows_i8<true>(p.peer_u + TD, p.U1, p.SU1, 16384, mw, nmw);
      cvt_rows_q6(p.peer_v + TD, p.V1, p.SV1, 16384, mw, nmw);
    } else {
      int cgen = 0;
      const int ct = t0 - 128;
      ph_s5_prep(p.s5_a_re, p.s5_a_im, p.s5_log_dt, p.s5_b_re, p.s5_b_im, p.s5_c_re, p.s5_c_im, p.Ktab, p.Bst_t, p.Cin_t, bid >> 2, bid & 3, lds, ct, 384, cbc, cgen);
      cbar(cbc, cgen, 6);
      mod_item(p.c, p.c_ctx, p.ada_w, p.ada_b, p.MOD, bid, bid < 192, lds, ct, 384, cbc, cgen);
    }
  }
  grid.sync();
  asm volatile("" : "+s"(bid));
  ph_s5_p1(p.x, p.ctx, mod0, p.Ktab, p.Bst_t, p.s5_d, p.Ypart, p.Ssta, bid, lds);
  gbar(p.BAR + 16 + (bid >> 2) * 16, 4u);
  asm volatile("" : "+s"(bid));
  if (otid() < 64) ph_s5_carry(p.Ssta, p.s5_a_re, p.s5_a_im, p.s5_log_dt, p.HP, ((bid & 2) << 6) | ((bid >> 2) << 1) | (bid & 1), otid());
  gbar(p.BAR + 16 + (bid >> 2) * 16, 8u);
  asm volatile("" : "+s"(bid));
  ph_s5_p3(p.HP, p.Cin_t, p.Ypart, p.Gbf, bid, lds);
  gbar(p.BAR, 1u * (unsigned)nblk);
  asm volatile("" : "+s"(bid));
  {
    ChainP cp{p.Gbf, p.Wt_glu, p.Wt_o0, p.Wt_q0, p.Vbf, (bf16_t*)p.OQ + (size_t)bid * 66 * D, p.x, p.ctx, mod0, p.ln_g, p.ln_b, p.H1, p.Tbf, (bf16_t*)p.OQ + (size_t)bid * 66 * D  };
    ph_chainA<true>(cp, bid, lds);
    __syncthreads();
    ph_route(RouteP{(bf16_t*)p.OQ + (size_t)bid * 66 * D, p.Khi, p.IDX, p.GATE, 66, 0}, bid, lds);
    __syncthreads();
    GatherP gp{p.Tbf, p.IDX, p.GATE, p.U0, p.V0, p.SU0, p.SV0, p.H1, mod0, p.ln_g + D, p.ln_b + D, p.H2, mod1};
    ph_gather_tm<false>(gp, bid * 66, 66, lds, p.PART + (size_t)bid * 8 * PARTW);
    __syncthreads();
    ProjP pp{p.Wt_cat, p.Wt_uq, p.Wt_ukv, p.mla_q_norm, p.mla_kv_norm, p.OQ  , p.Qa, p.Kn, p.Kr, p.Va};
    ph_mla_proj(pp, bid, lds);
  }
  gbar(p.BAR, 2u * (unsigned)nblk);
  asm volatile("" : "+s"(bid));
  ph_attn(p.Qa, p.Kn, p.Kr, p.Va, p.AObf, bid, nblk, lds);
  gbar(p.BAR, 3u * (unsigned)nblk);
  asm volatile("" : "+s"(bid));
  {
    ChainP cp{p.AObf, nullptr, p.Wt_o1, p.Wt_q1, nullptr, (bf16_t*)p.OQ + (size_t)bid * 64 * D, p.H2, p.H2 + (size_t)NL * D, mod1, p.ln_g + 2 * D, p.ln_b + 2 * D, p.H3, p.Tbf1, (bf16_t*)p.OQ + (size_t)bid * 64 * D};
    ph_chainA<false>(cp, bid, lds);
    __syncthreads();
    ph_route(RouteP{(bf16_t*)p.OQ + (size_t)bid * 64 * D, p.Khi1, p.IDX, p.GATE, 64, 0}, bid, lds);
    __syncthreads();
    GatherP gp{p.Tbf1, p.IDX, p.GATE, p.U1, p.V1, p.SU1, p.SV1, p.H3, mod1, p.ln_g + 3 * D, p.ln_b + 3 * D, p.out, mod1};
    ph_gather_tm<true>(gp, bid * 64, 64, lds, p.PART + (size_t)bid * 8 * PARTW);
  }
}

extern "C" void kernel_launch(void* const* d_in, const int* in_sizes, int n_in, void* d_out, int out_size, void* d_ws, size_t ws_size, hipStream_t stream) {
  MP p{};
  const float** in = (const float**)&p;
  for (int i = 0; i < 29; ++i) in[i] = (const float*)d_in[i];
  p.out = (float*)d_out;
  char* ws = (char*)d_ws; size_t off = 0;
  auto carve = [&](size_t bytes) { char* q = ws + off; off += (bytes + 255) / 256 * 256; return q; };
  const size_t TDB = (size_t)1024 * 16384 * 2, BIG = (size_t)NT * D * 4, HALF = (size_t)NT * D * 2;
  p.MOD = (float*)carve(2 * 3 * 6144 * 4);
  p.Wt_glu = (bf16_t*)carve((size_t)D * D * 2); p.Wt_o0 = (bf16_t*)carve((size_t)D * D * 2); p.Wt_q0 = (bf16_t*)carve((size_t)D * D * 2);
  p.Wt_o1 = (bf16_t*)carve((size_t)D * D * 2); p.Wt_q1 = (bf16_t*)carve((size_t)D * D * 2);
  p.Wt_cat = (bf16_t*)carve((size_t)704 * D * 2); p.Wt_uq = (bf16_t*)carve((size_t)1536 * 384 * 2); p.Wt_ukv = (bf16_t*)carve((size_t)2048 * 256 * 2);
  p.Khi = (bf16_t*)carve((size_t)2 * 131072 * 2); p.Khi1 = p.Khi + 131072;
  char* T0 = carve(TDB); p.U0 = (unsigned char*)T0; p.V0 = (unsigned char*)(T0 + TDB / 2); p.AObf = (bf16_t*)T0;
  p.SU0 = (float*)carve(16384 * 4); p.SV0 = (float*)carve(16384 * 4); p.SU1 = (float*)carve(16384 * 4); p.SV1 = (float*)carve(16384 * 4);
  const size_t KTAB_B = (size_t)64 * 127 * 256 * 2, BST_B = (size_t)64 * 256 * 1024 * 2, KN_B = (size_t)NB * 8 * KEYS * 128 * 2, KR_B = (size_t)NB * KEYS * 64 * 2;
  size_t x1 = KTAB_B + 2 * BST_B; if (x1 < 2 * KN_B + KR_B) x1 = 2 * KN_B + KR_B;
  char* X1 = carve(x1);
  p.Ktab = (bf16_t*)X1; p.Bst_t = (bf16_t*)(X1 + KTAB_B); p.Cin_t = (bf16_t*)(X1 + KTAB_B + BST_B);
  p.Kn = (unsigned char*)X1; p.Va = (unsigned char*)(X1 + KN_B); p.Kr = (unsigned char*)(X1 + 2 * KN_B); p.H3 = (float*)X1;
  char* X2 = carve(BIG); p.Ypart = (bf16_t*)X2; p.OQ = (float*)X2;
  char* X3 = carve(HALF); p.Ssta = (float*)X3; p.HP = (bf16_t*)(X3 + (size_t)NCC * 64 * 256 * 4); p.Vbf = (bf16_t*)X3;
  char* X4 = carve(HALF); p.Gbf = (bf16_t*)X4; p.Tbf = (bf16_t*)X4; p.Tbf1 = (bf16_t*)X4;
  char* X5 = carve(BIG); p.H1 = (float*)X5;
  char* T1 = carve(TDB); p.U1 = (unsigned char*)T1; p.V1 = (unsigned char*)(T1 + TDB / 2);
  p.H2 = (float*)carve(BIG);
  p.IDX = (int*)carve((size_t)NT * 128 * 4); p.GATE = (float*)carve((size_t)NT * 128 * 4);
  p.Qa = (bf16_t*)carve((size_t)NB * 8 * SEQ * 192 * 2);
  p.BAR = (unsigned*)carve(8192);
  p.PART = (float*)carve((size_t)256 * 8 * PARTW * 4);
  if (off > ws_size || n_in != 29) { fprintf(stderr, "kernel_launch: workspace too small (need %zu, have %zu) or n_in %d != 29\n", off, ws_size, n_in); return; }
  static int grid_blocks = 0;
  if (!grid_blocks) {
    int dev = 0, cus = 0, per_cu = 0;
    hipGetDevice(&dev);
    hipDeviceGetAttribute(&cus, hipDeviceAttributeMultiprocessorCount, dev);
    hipOccupancyMaxActiveBlocksPerMultiprocessor(&per_cu, mega, 512, 0);
    if (per_cu < 1 || cus < 256) { fprintf(stderr, "kernel_launch: need 256 resident workgroups (cus %d, per_cu %d)\n", cus, per_cu); return; }
    grid_blocks = 256;
  }
  hipMemsetAsync(p.BAR, 0, 8192, stream);
  void* args[] = {&p};
  hipError_t e = hipLaunchCooperativeKernel((void*)mega, dim3(grid_blocks), dim3(512), args, 0, stream);
  if (e != hipSuccess) fprintf(stderr, "cooperative launch failed: %s\n", hipGetErrorString(e));
}
```

```cpp
#include <hip/hip_runtime.h>
#include <math.h>
#include <hip/hip_cooperative_groups.h>
#include <cstdio>
namespace cg = cooperative_groups;
__device__ __forceinline__ int otid() { int t = (int)__builtin_amdgcn_workitem_id_x(); asm volatile("" : "+v"(t)); return t; }

constexpr int D = 1024, NB = 2, SEQ = 8192, CTX = 256;
constexpr int NL = NB * SEQ, NC = NB * CTX, NT = NL + NC;
constexpr float ALPHA = 1.4142135623730951f;
constexpr float LN_EPS = 1e-5f, RMS_EPS = 1e-6f;

__device__ __forceinline__ float wave_sum_dpp(float v) {
  v += __uint_as_float(__builtin_amdgcn_update_dpp(0u, __float_as_uint(v), 0xB1, 0xF, 0xF, true));
  v += __uint_as_float(__builtin_amdgcn_update_dpp(0u, __float_as_uint(v), 0x4E, 0xF, 0xF, true));
  v += __uint_as_float(__builtin_amdgcn_update_dpp(0u, __float_as_uint(v), 0x141, 0xF, 0xF, true));
  v += __uint_as_float(__builtin_amdgcn_update_dpp(0u, __float_as_uint(v), 0x140, 0xF, 0xF, true));
  v += __uint_as_float(__builtin_amdgcn_update_dpp(0u, __float_as_uint(v), 0x142, 0xA, 0xF, true));
  v += __uint_as_float(__builtin_amdgcn_update_dpp(0u, __float_as_uint(v), 0x143, 0xC, 0xF, true));
  return __uint_as_float((unsigned)__builtin_amdgcn_readlane((int)__float_as_uint(v), 63));
}
__device__ __forceinline__ float wave_sum(float v) { return wave_sum_dpp(v); }
__device__ __forceinline__ float wave_max_dpp(float v) {
  v = fmaxf(v, __uint_as_float(__builtin_amdgcn_update_dpp(0u, __float_as_uint(v), 0xB1, 0xF, 0xF, true)));
  v = fmaxf(v, __uint_as_float(__builtin_amdgcn_update_dpp(0u, __float_as_uint(v), 0x4E, 0xF, 0xF, true)));
  v = fmaxf(v, __uint_as_float(__builtin_amdgcn_update_dpp(0u, __float_as_uint(v), 0x141, 0xF, 0xF, true)));
  v = fmaxf(v, __uint_as_float(__builtin_amdgcn_update_dpp(0u, __float_as_uint(v), 0x140, 0xF, 0xF, true)));
  v = fmaxf(v, __uint_as_float(__builtin_amdgcn_update_dpp(0u, __float_as_uint(v), 0x142, 0xA, 0xF, true)));
  v = fmaxf(v, __uint_as_float(__builtin_amdgcn_update_dpp(0u, __float_as_uint(v), 0x143, 0xC, 0xF, true)));
  return __uint_as_float((unsigned)__builtin_amdgcn_readlane((int)__float_as_uint(v), 63));
}
__device__ __forceinline__ int row_vec(int row) { return row < NL ? (row >> 13) : 2; }
__device__ __forceinline__ float gelu_exact(float x) { return 0.5f * x * (1.f + erff(x * 0.70710678118654752f)); }
__device__ __forceinline__ float gelu_fast(float x) {
  const float z = fabsf(x) * 0.70710678118654752f;
  const float t = __builtin_amdgcn_rcpf(fmaf(0.3275911f, z, 1.f));
  float pl = fmaf(1.061405429f, t, -1.453152027f); pl = fmaf(pl, t, 1.421413741f); pl = fmaf(pl, t, -0.284496736f); pl = fmaf(pl, t, 0.254829592f);
  const float e = __builtin_amdgcn_exp2f(-z * z * 1.4426950408889634f);
  const float erfa = 1.f - pl * t * e;
  const float hx = 0.5f * x;
  return hx + fabsf(hx) * erfa;
}


typedef unsigned short bf16_t;
using bf16x8 = __attribute__((ext_vector_type(8))) short;
using f32x4 = __attribute__((ext_vector_type(4))) float;
__device__ __forceinline__ bf16_t f2bf(float f) { unsigned u = __float_as_uint(f); u += 0x7FFFu + ((u >> 16) & 1u); return (bf16_t)(u >> 16); }
__device__ __forceinline__ unsigned char f2fp8(float v) { return (unsigned char)(__builtin_amdgcn_cvt_pk_fp8_f32(v, v, 0, false) & 0xFF); }
__device__ __forceinline__ float bf2f(bf16_t h) { return __uint_as_float(((unsigned)h) << 16); }
__device__ __forceinline__ unsigned pack2bf(float lo, float hi) { return (unsigned)f2bf(lo) | ((unsigned)f2bf(hi) << 16); }
__device__ __forceinline__ float bflo(unsigned w) { return __uint_as_float(w << 16); }
__device__ __forceinline__ float bfhi(unsigned w) { return __uint_as_float(w & 0xFFFF0000u); }


constexpr int LDA_B = 1024 * 2 + 16;
template <int RT, int K>
__device__ __forceinline__ void gemm_unit(const char* const (&ap)[RT], const bf16_t* __restrict__ w0, const bf16_t* __restrict__ w1, int kmul, f32x4 (&acc)[RT][2]) {
  constexpr int KI = K / 128, NS = 2;
#pragma unroll
  for (int t = 0; t < RT; ++t) { acc[t][0] = f32x4{0.f, 0.f, 0.f, 0.f}; acc[t][1] = f32x4{0.f, 0.f, 0.f, 0.f}; }
  bf16x8 b[NS][4][2];
#pragma unroll
  for (int st = 0; st < NS - 1; ++st) {
    if (st < KI) {
#pragma unroll
      for (int s2 = 0; s2 < 4; ++s2) { b[st][s2][0] = *(const bf16x8*)(w0 + (st * 128 + s2 * 32) * kmul); b[st][s2][1] = *(const bf16x8*)(w1 + (st * 128 + s2 * 32) * kmul); }
    }
  }
  asm volatile("" ::: "memory");
  bf16x8 an[RT];
#pragma unroll
  for (int t = 0; t < RT; ++t) an[t] = *(const bf16x8*)(ap[t]);
#pragma unroll
  for (int it = 0; it < KI; ++it) {
    if (it + NS - 1 < KI) {
#pragma unroll
      for (int s2 = 0; s2 < 4; ++s2) {
        b[(it + NS - 1) % NS][s2][0] = *(const bf16x8*)(w0 + ((it + NS - 1) * 128 + s2 * 32) * kmul);
        b[(it + NS - 1) % NS][s2][1] = *(const bf16x8*)(w1 + ((it + NS - 1) * 128 + s2 * 32) * kmul);
      }
    }
    asm volatile("" ::: "memory");
#pragma unroll
    for (int s2 = 0; s2 < 4; ++s2) {
      bf16x8 ac[RT];
#pragma unroll
      for (int t = 0; t < RT; ++t) ac[t] = an[t];
      if (it * 4 + s2 + 1 < KI * 4) {
#pragma unroll
        for (int t = 0; t < RT; ++t) an[t] = *(const bf16x8*)(ap[t] + (it * 128 + s2 * 32 + 32) * 2);
      }
#pragma unroll
      for (int t = 0; t < RT; ++t) {
        acc[t][0] = __builtin_amdgcn_mfma_f32_16x16x32_bf16(ac[t], b[it % NS][s2][0], acc[t][0], 0, 0, 0);
        acc[t][1] = __builtin_amdgcn_mfma_f32_16x16x32_bf16(ac[t], b[it % NS][s2][1], acc[t][1], 0, 0, 0);
      }
    }
  }
}
typedef __bf16 bf16raw2 __attribute__((ext_vector_type(2)));
__device__ __forceinline__ bf16x8 w8_frag(unsigned lo, unsigned hi) {
  const bf16raw2 e0 = __builtin_amdgcn_cvt_scalef32_pk_bf16_fp8(lo, 0.03125f, false), e1 = __builtin_amdgcn_cvt_scalef32_pk_bf16_fp8(lo, 0.03125f, true);
  const bf16raw2 e2 = __builtin_amdgcn_cvt_scalef32_pk_bf16_fp8(hi, 0.03125f, false), e3 = __builtin_amdgcn_cvt_scalef32_pk_bf16_fp8(hi, 0.03125f, true);
  uint4 w; w.x = *(const unsigned*)&e0; w.y = *(const unsigned*)&e1; w.z = *(const unsigned*)&e2; w.w = *(const unsigned*)&e3;
  return *(const bf16x8*)&w;
}
template <int RT, int K>
__device__ __forceinline__ void gemm_unit8(const char* const (&ap)[RT], const unsigned char* __restrict__ w0, const unsigned char* __restrict__ w1, f32x4 (&acc)[RT][2]) {
  constexpr int KI = K / 128, NS = 2;
#pragma unroll
  for (int t = 0; t < RT; ++t) { acc[t][0] = f32x4{0.f, 0.f, 0.f, 0.f}; acc[t][1] = f32x4{0.f, 0.f, 0.f, 0.f}; }
  uint4 b[NS][2][2];
#pragma unroll
  for (int st = 0; st < NS - 1; ++st) {
    if (st < KI) {
#pragma unroll
      for (int pr = 0; pr < 2; ++pr) { b[st][pr][0] = *(const uint4*)(w0 + (st * 2 + pr) * 1024); b[st][pr][1] = *(const uint4*)(w1 + (st * 2 + pr) * 1024); }
    }
  }
  asm volatile("" ::: "memory");
  bf16x8 an[RT];
#pragma unroll
  for (int t = 0; t < RT; ++t) an[t] = *(const bf16x8*)(ap[t]);
#pragma unroll
  for (int it = 0; it < KI; ++it) {
    if (it + NS - 1 < KI) {
#pragma unroll
      for (int pr = 0; pr < 2; ++pr) {
        b[(it + NS - 1) % NS][pr][0] = *(const uint4*)(w0 + ((it + NS - 1) * 2 + pr) * 1024);
        b[(it + NS - 1) % NS][pr][1] = *(const uint4*)(w1 + ((it + NS - 1) * 2 + pr) * 1024);
      }
    }
    asm volatile("" ::: "memory");
#pragma unroll
    for (int s2 = 0; s2 < 4; ++s2) {
      bf16x8 ac[RT];
#pragma unroll
      for (int t = 0; t < RT; ++t) ac[t] = an[t];
      if (it * 4 + s2 + 1 < KI * 4) {
#pragma unroll
        for (int t = 0; t < RT; ++t) an[t] = *(const bf16x8*)(ap[t] + (it * 128 + s2 * 32 + 32) * 2);
      }
      const uint4 q0 = b[it % NS][s2 >> 1][0], q1 = b[it % NS][s2 >> 1][1];
      const bf16x8 f0 = (s2 & 1) ? w8_frag(q0.z, q0.w) : w8_frag(q0.x, q0.y), f1 = (s2 & 1) ? w8_frag(q1.z, q1.w) : w8_frag(q1.x, q1.y);
#pragma unroll
      for (int t = 0; t < RT; ++t) {
        acc[t][0] = __builtin_amdgcn_mfma_f32_16x16x32_bf16(ac[t], f0, acc[t][0], 0, 0, 0);
        acc[t][1] = __builtin_amdgcn_mfma_f32_16x16x32_bf16(ac[t], f1, acc[t][1], 0, 0, 0);
      }
    }
  }
}
template <int RT, int K, class Epi>
__device__ __forceinline__ void gemm_ldsA8(const char* As, int lda_b, int nrows, const unsigned char* __restrict__ Wt, int N, Epi epi) {
  const int wave = otid() >> 6, lane = otid() & 63, l15 = lane & 15, q = lane >> 4;
  const char* ap[RT];
#pragma unroll
  for (int t = 0; t < RT; ++t) { int r = t * 16 + l15; r = r < nrows ? r : nrows - 1; ap[t] = As + r * lda_b + q * 16; }
#pragma unroll 1
  for (int unit = wave; unit < (N >> 5); unit += 8) {
    const int n0 = unit * 32;
    const unsigned char* w0 = Wt + (size_t)(n0 >> 4) * K * 16 + lane * 16;
    f32x4 acc[RT][2];
    gemm_unit8<RT, K>(ap, w0, w0 + (size_t)K * 16, acc);
#pragma unroll
    for (int t = 0; t < RT; ++t)
#pragma unroll
      for (int j = 0; j < 2; ++j)
#pragma unroll
        for (int r = 0; r < 4; ++r) {
          const int row = t * 16 + q * 4 + r, col = n0 + j * 16 + l15;
          if (row < nrows) epi(row, col, acc[t][j][r]);
        }
  }
}
template <int RT, int K, class Epi>
__device__ __forceinline__ void gemm_ldsA(const char* As, int lda_b, int nrows, const bf16_t* __restrict__ Wt, int N, Epi epi) {
  const int wave = otid() >> 6, lane = otid() & 63, l15 = lane & 15, q = lane >> 4;
  const char* ap[RT];
#pragma unroll
  for (int t = 0; t < RT; ++t) { int r = t * 16 + l15; r = r < nrows ? r : nrows - 1; ap[t] = As + r * lda_b + q * 16; }
#pragma unroll 1
  for (int unit = wave; unit < (N >> 5); unit += 8) {
    const int n0 = unit * 32;
    const bf16_t* w0 = Wt + (size_t)(n0 >> 4) * K * 16 + lane * 8;
    f32x4 acc[RT][2];
    gemm_unit<RT, K>(ap, w0, w0 + (size_t)K * 16, 16, acc);
#pragma unroll
    for (int t = 0; t < RT; ++t)
#pragma unroll
      for (int j = 0; j < 2; ++j)
#pragma unroll
        for (int r = 0; r < 4; ++r) {
          const int row = t * 16 + q * 4 + r, col = n0 + j * 16 + l15;
          if (row < nrows) epi(row, col, acc[t][j][r]);
        }
  }
}
struct EpiBF16 { bf16_t* C; int ldc; __device__ __forceinline__ void operator()(int row, int col, float v) const { C[(size_t)row * ldc + col] = f2bf(v); } };
struct EpiF32 { float* C; int ldc; __device__ __forceinline__ void operator()(int row, int col, float v) const { C[(size_t)row * ldc + col] = v; } };
struct EpiGluL { const char* As; bf16_t* V; __device__ __forceinline__ void operator()(int row, int col, float z) const {
  const float g = bf2f(*(const bf16_t*)(As + row * LDA_B + col * 2)); V[(size_t)row * D + col] = f2bf(g / (1.f + expf(-z))); } };

__device__ __forceinline__ void load_rows_lds(char* As, const bf16_t* __restrict__ src, int nrows) {
  const int t = otid(), total = nrows * 128;
#pragma unroll
  for (int h = 0; h < 2; ++h) {
    uint4 v[9];
#pragma unroll
    for (int k = 0; k < 9; ++k) { int i = t + (h * 9 + k) * 512; i = i < total ? i : total - 1; v[k] = *(const uint4*)(src + (size_t)(i >> 7) * D + (i & 127) * 8); }
#pragma unroll
    for (int k = 0; k < 9; ++k) { const int i = t + (h * 9 + k) * 512; if (i < total) *(uint4*)(As + (i >> 7) * LDA_B + (i & 127) * 16) = v[k]; }
  }
}
__device__ __forceinline__ void ln_rows(char* As, int g0, int nrows, const float* Hl, const float* Hc, const bf16_t* __restrict__ O,
                                        const float* __restrict__ mod, int gate_i, const float* __restrict__ lng, const float* __restrict__ lnb,
                                        float* Hout, bf16_t* __restrict__ Tbf, int shift_i, int scale_i) {
  const int wave = otid() >> 6, lane = otid() & 63;
  for (int rr = wave; rr < nrows; rr += 8) {
    const int row = g0 + rr;
    const float* hin = row < NL ? Hl + (size_t)row * D : Hc + (size_t)(row - NL) * D;
    const bf16_t* f = O + (size_t)row * D;
    const float* m = mod + row_vec(row) * 6144;
    const float* gm = m + gate_i * 1024;
    float r[16]; float s = 0.f;
#pragma unroll
    for (int i = 0; i < 4; ++i) {
      const int d = i * 256 + lane * 4;
      const uint2 fw = *(const uint2*)(f + d);
      float4 h4 = *(const float4*)(hin + d), f4 = make_float4(bflo(fw.x), bfhi(fw.x), bflo(fw.y), bfhi(fw.y)), g4 = *(const float4*)(gm + d);
      r[i * 4 + 0] = ALPHA * h4.x + g4.x * f4.x; r[i * 4 + 1] = ALPHA * h4.y + g4.y * f4.y;
      r[i * 4 + 2] = ALPHA * h4.z + g4.z * f4.z; r[i * 4 + 3] = ALPHA * h4.w + g4.w * f4.w;
      s += r[i * 4 + 0] + r[i * 4 + 1] + r[i * 4 + 2] + r[i * 4 + 3];
    }
    const float mu = wave_sum(s) * (1.f / D);
    float vs = 0.f;
#pragma unroll
    for (int i = 0; i < 16; ++i) { float dlt = r[i] - mu; vs += dlt * dlt; }
    const float rstd = rsqrtf(wave_sum(vs) * (1.f / D) + LN_EPS);
#pragma unroll
    for (int i = 0; i < 4; ++i) {
      const int d = i * 256 + lane * 4;
      float4 g4 = *(const float4*)(lng + d), b4 = *(const float4*)(lnb + d);
      float4 o;
      o.x = (r[i * 4 + 0] - mu) * rstd * g4.x + b4.x; o.y = (r[i * 4 + 1] - mu) * rstd * g4.y + b4.y;
      o.z = (r[i * 4 + 2] - mu) * rstd * g4.z + b4.z; o.w = (r[i * 4 + 3] - mu) * rstd * g4.w + b4.w;
      *(float4*)(Hout + (size_t)row * D + d) = o;
      float4 sh = *(const float4*)(m + shift_i * 1024 + d), sc = *(const float4*)(m + scale_i * 1024 + d);
      const float t0 = o.x * (1.f + sc.x) + sh.x, t1 = o.y * (1.f + sc.y) + sh.y, t2 = o.z * (1.f + sc.z) + sh.z, t3 = o.w * (1.f + sc.w) + sh.w;
      uint2 w; w.x = pack2bf(t0, t1); w.y = pack2bf(t2, t3);
      *(uint2*)(As + rr * LDA_B + d * 2) = w;
      *(uint2*)(Tbf + (size_t)row * D + d) = w;

    }
  }
}


constexpr int S5T = 64, NCHUNK = (CTX + SEQ) / S5T  , NCC = NB * NCHUNK  ;
__device__ __forceinline__ int s5_token(int cc, int s) {
  const int b = cc / NCHUNK, ch = cc - b * NCHUNK;
  return ch < 4 ? NL + b * CTX + ch * S5T + s : b * SEQ + (ch - 4) * S5T + s;
}
__device__ __forceinline__ void cbar(volatile int* cnt, int& gen, int nwaves) {
  __builtin_amdgcn_fence(__ATOMIC_RELEASE, "workgroup");
  if ((otid() & 63) == 0) __hip_atomic_fetch_add((int*)cnt, 1, __ATOMIC_RELAXED, __HIP_MEMORY_SCOPE_WORKGROUP);
  ++gen;
  while (__hip_atomic_load((int*)cnt, __ATOMIC_RELAXED, __HIP_MEMORY_SCOPE_WORKGROUP) < gen * nwaves) __builtin_amdgcn_s_sleep(1);
  __builtin_amdgcn_fence(__ATOMIC_ACQUIRE, "workgroup");
}
__device__ __forceinline__ void ph_s5_prep(const float* __restrict__ a_re, const float* __restrict__ a_im, const float* __restrict__ log_dt,
                                                 const float* __restrict__ b_re, const float* __restrict__ b_im, const float* __restrict__ c_re, const float* __restrict__ c_im,
                                                 bf16_t* __restrict__ Ktab, bf16_t* __restrict__ Bst_t, bf16_t* __restrict__ Cin_t, int g, int part, char* lds, int tid, int nct, volatile int* cbc, int& cgen) {
  float2 (*pw)[65][64] = reinterpret_cast<float2 (*)[65][64]>(lds);
  float2 (*Bp)[64][16] = reinterpret_cast<float2 (*)[64][16]>(lds + 2 * 65 * 64 * 8);
  float2 (*Cc)[16][64] = reinterpret_cast<float2 (*)[16][64]>(lds + 2 * 65 * 64 * 8 + 2 * 64 * 16 * 8);
  float2 (*fs)[64] = reinterpret_cast<float2 (*)[64]>(lds + 2 * 65 * 64 * 8 + 2 * 64 * 16 * 8 + 2 * 16 * 64 * 8);
  if (tid < 128) {
    const int dir = tid >> 6, p = tid & 63, gp = (dir * 64 + g) * 64 + p;
    const float are = a_re[gp], aim = a_im[gp], dt = expf(log_dt[dir * 64 + g]);
    const float mag = expf(are * dt);
    const float abr = mag * cosf(aim * dt), abi = mag * sinf(aim * dt);
    const float nr = abr - 1.f, ni = abi, den = are * are + aim * aim;
    fs[dir][p] = make_float2((nr * are + ni * aim) / den, (ni * are - nr * aim) / den);
    float pr = 1.f, pi = 0.f;
    for (int e = 0; e <= 64; ++e) { pw[dir][e][p] = make_float2(pr, pi); const float nr2 = pr * abr - pi * abi, ni2 = pr * abi + pi * abr; pr = nr2; pi = ni2; }
  }
  cbar(cbc, cgen, nct >> 6);
  for (int i = tid; i < 2048; i += nct) {
    const int dir = i >> 10, p = (i >> 4) & 63, ci = i & 15;
    const size_t gi = ((size_t)(dir * 64 + g) * 64 + p) * 16 + ci;
    const float br = b_re[gi], bi = b_im[gi]; const float2 f = fs[dir][p];
    Bp[dir][p][ci] = make_float2(f.x * br - f.y * bi, f.x * bi + f.y * br);
    const int co = (i >> 6) & 15, p2 = i & 63;
    const size_t ci2 = ((size_t)(dir * 64 + g) * 16 + co) * 64 + p2;
    Cc[dir][co][p2] = make_float2(c_re[ci2], c_im[ci2]);
  }
  cbar(cbc, cgen, nct >> 6);
  for (int i = part * 508 + tid; i < (part + 1) * 508; i += nct) {
    const int ti = i >> 4, co = i & 15, tau = ti - 63;
    float acc[16];
#pragma unroll
    for (int ci = 0; ci < 16; ++ci) acc[ci] = 0.f;
    if (tau >= 0) {
      for (int p = 0; p < 64; ++p) {
        const float2 c = Cc[0][co][p], w = pw[0][tau][p];
        const float xr = c.x * w.x - c.y * w.y, xi = c.x * w.y + c.y * w.x;
#pragma unroll
        for (int ci = 0; ci < 16; ++ci) { const float2 bb = Bp[0][p][ci]; acc[ci] += xr * bb.x - xi * bb.y; }
      }
    }
    if (tau <= 0) {
      for (int p = 0; p < 64; ++p) {
        const float2 c = Cc[1][co][p], w = pw[1][-tau][p];
        const float xr = c.x * w.x - c.y * w.y, xi = c.x * w.y + c.y * w.x;
#pragma unroll
        for (int ci = 0; ci < 16; ++ci) { const float2 bb = Bp[1][p][ci]; acc[ci] += xr * bb.x - xi * bb.y; }
      }
    }
    uint4 o0, o1;
    o0.x = pack2bf(acc[0], acc[1]); o0.y = pack2bf(acc[2], acc[3]); o0.z = pack2bf(acc[4], acc[5]); o0.w = pack2bf(acc[6], acc[7]);
    o1.x = pack2bf(acc[8], acc[9]); o1.y = pack2bf(acc[10], acc[11]); o1.z = pack2bf(acc[12], acc[13]); o1.w = pack2bf(acc[14], acc[15]);
    bf16_t* kp = Ktab + (size_t)g * 127 * 256 + (size_t)i * 16;
    *(uint4*)kp = o0; *(uint4*)(kp + 8) = o1;
  }
  for (int i = part * 8192 + tid; i < (part + 1) * 8192; i += nct) {
    const int n = (i >> 11) * 16 + (i & 15), k8 = ((i >> 6) & 31) * 4 + ((i >> 4) & 3);
    const int dir = n >> 7, c = (n >> 6) & 1, p = n & 63, sidx = k8 >> 1, ci0 = (k8 & 1) * 8;
    const float2 w = pw[dir][dir == 0 ? 63 - sidx : sidx][p];
    float v[8];
#pragma unroll
    for (int j = 0; j < 8; ++j) { const float2 b = Bp[dir][p][ci0 + j]; v[j] = c == 0 ? (w.x * b.x - w.y * b.y) : (w.x * b.y + w.y * b.x); }
    uint4 o; o.x = pack2bf(v[0], v[1]); o.y = pack2bf(v[2], v[3]); o.z = pack2bf(v[4], v[5]); o.w = pack2bf(v[6], v[7]);
    *(uint4*)(Bst_t + (size_t)g * 256 * 1024 + (size_t)i * 8) = o;
  }
  for (int i = part * 8192 + tid; i < (part + 1) * 8192; i += nct) {
    const int n = (i >> 9) * 16 + (i & 15), k8 = ((i >> 6) & 7) * 4 + ((i >> 4) & 3);
    const int t = n >> 4, co = n & 15, dir = k8 >> 4, c = (k8 >> 3) & 1, p0 = (k8 & 7) * 8;
    const int e = dir == 0 ? t + 1 : 64 - t;
    float v[8];
#pragma unroll
    for (int j = 0; j < 8; ++j) { const float2 cc = Cc[dir][co][p0 + j], w = pw[dir][e][p0 + j];
      v[j] = c == 0 ? (cc.x * w.x - cc.y * w.y) : -(cc.x * w.y + cc.y * w.x); }
    uint4 o; o.x = pack2bf(v[0], v[1]); o.y = pack2bf(v[2], v[3]); o.z = pack2bf(v[4], v[5]); o.w = pack2bf(v[6], v[7]);
    *(uint4*)(Cin_t + (size_t)g * 1024 * 256 + (size_t)i * 8) = o;
  }
}
__device__ __forceinline__ void ph_s5_p1(const float* __restrict__ x, const float* __restrict__ ctx, const float* __restrict__ mod,
                                               const bf16_t* __restrict__ Ktab, const bf16_t* __restrict__ Bst_t, const float* __restrict__ dvec, bf16_t* __restrict__ Ypart, float* __restrict__ S, int bid, char* As) {
  const int g = bid >> 2, cc0 = (bid & 3) * 66, tid = otid();
  const int wave = tid >> 6, lane = tid & 63, l15 = lane & 15, q = lane >> 4;
  const float dch = dvec[g * 16 + l15];
#pragma unroll 4
  for (int i = tid; i < 66 * 64 * 2; i += 512) {
    const int half = i & 1, sidx = (i >> 1) & 63, r = i >> 7;
    const int tok = s5_token(cc0 + r, sidx), ch = g * 16 + half * 8;
    const float* src = (tok < NL ? x + (size_t)tok * D : ctx + (size_t)(tok - NL) * D) + ch;
    const float* m = mod + row_vec(tok) * 6144;
    const float4 a = *(const float4*)src, b = *(const float4*)(src + 4);
    const float4 sh0 = *(const float4*)(m + ch), sh1 = *(const float4*)(m + ch + 4), sc0 = *(const float4*)(m + 1024 + ch), sc1 = *(const float4*)(m + 1024 + ch + 4);
    uint4 o;
    o.x = pack2bf(a.x * (1.f + sc0.x) + sh0.x, a.y * (1.f + sc0.y) + sh0.y); o.y = pack2bf(a.z * (1.f + sc0.z) + sh0.z, a.w * (1.f + sc0.w) + sh0.w);
    o.z = pack2bf(b.x * (1.f + sc1.x) + sh1.x, b.y * (1.f + sc1.y) + sh1.y); o.w = pack2bf(b.z * (1.f + sc1.z) + sh1.z, b.w * (1.f + sc1.w) + sh1.w);
    *(uint4*)(As + r * LDA_B + sidx * 32 + half * 16) = o;
  }
  __syncthreads();
  const char* ap[5];
#pragma unroll
  for (int t = 0; t < 5; ++t) { int r = t * 16 + l15; r = r < 66 ? r : 65; ap[t] = As + r * LDA_B + q * 16; }
  const bf16_t* Kg = Ktab + (size_t)g * 127 * 256;
#pragma unroll 1
  for (int unit = wave; unit < 40; unit += 8) {
    f32x4 acc[5][2];
    if (unit < 32) {
      const int t0 = unit * 2;
      const bf16_t* w0 = Kg + (t0 + 63 - (q >> 1)) * 256 + l15 * 16 + (q & 1) * 8;
      gemm_unit<5, 1024>(ap, w0, w0 + 256, -16, acc);
#pragma unroll
      for (int t = 0; t < 5; ++t)
#pragma unroll
        for (int j = 0; j < 2; ++j)
#pragma unroll
          for (int r = 0; r < 4; ++r) {
            const int row = t * 16 + q * 4 + r;
            if (row < 66) Ypart[(size_t)s5_token(cc0 + row, t0 + j) * D + g * 16 + l15] = f2bf(acc[t][j][r] + dch * bf2f(*(const bf16_t*)(As + row * LDA_B + (t0 + j) * 32 + l15 * 2)));
          }
    } else {
      const int n0 = (unit - 32) * 32;
      const bf16_t* w0 = Bst_t + (size_t)g * 256 * 1024 + (size_t)(n0 >> 4) * 1024 * 16 + lane * 8;
      gemm_unit<5, 1024>(ap, w0, w0 + 1024 * 16, 16, acc);
#pragma unroll
      for (int t = 0; t < 5; ++t)
#pragma unroll
        for (int j = 0; j < 2; ++j)
#pragma unroll
          for (int r = 0; r < 4; ++r) {
            const int row = t * 16 + q * 4 + r;
            if (row < 66) S[((size_t)(cc0 + row) * 64 + g) * 256 + n0 + j * 16 + l15] = acc[t][j][r];
          }
    }
  }
}
__device__ __forceinline__ void ph_s5_carry(const float* __restrict__ S, const float* __restrict__ a_re, const float* __restrict__ a_im,
                                                 const float* __restrict__ log_dt, bf16_t* __restrict__ HP, int id, int p) {
  const int dir = id & 1, g = (id >> 1) & 63, b = id >> 7;
  const int gp = (dir * 64 + g) * 64 + p;
  const float are = a_re[gp], aim = a_im[gp], dt = expf(log_dt[dir * 64 + g]);
  const float mag = expf(are * dt);
  float tr = mag * cosf(aim * dt), ti = mag * sinf(aim * dt);
#pragma unroll
  for (int i = 0; i < 6; ++i) { const float nr = tr * tr - ti * ti, ni = 2.f * tr * ti; tr = nr; ti = ni; }
  float hr = 0.f, hi = 0.f;
#pragma unroll 12
  for (int step = 0; step < NCHUNK; ++step) {
    const int c = dir == 0 ? step : (step < 4 ? 3 - step : NCHUNK - 1 - (step - 4));
    const size_t base = ((size_t)(b * NCHUNK + c) * 64 + g) * 256 + dir * 128 + p;
    HP[base] = f2bf(hr); HP[base + 64] = f2bf(hi);
    const float sr = S[base], si = S[base + 64];
    const float nr = tr * hr - ti * hi + sr, ni = tr * hi + ti * hr + si;
    hr = nr; hi = ni;
  }
}
struct EpiS5 { const bf16_t* Ypart; bf16_t* Gbf; int cc0; int ch;
  __device__ __forceinline__ void operator()(int row, int col, float v) const {
    const size_t o = (size_t)s5_token(cc0 + row, col >> 4) * D + ch;
    Gbf[o] = f2bf(gelu_fast(v + bf2f(Ypart[o])));
  } };
__device__ __forceinline__ void ph_s5_p3(const bf16_t* __restrict__ HP, const bf16_t* __restrict__ Cin_t, const bf16_t* __restrict__ Ypart, bf16_t* __restrict__ Gbf, int bid, char* As) {
  const int g = bid >> 2, cc0 = (bid & 3) * 66, tid = otid();
  for (int i = tid; i < 66 * 32; i += 512) {
    const int r = i >> 5, c = i & 31;
    *(uint4*)(As + r * 528 + c * 16) = *(const uint4*)(HP + ((size_t)(cc0 + r) * 64 + g) * 256 + c * 8);
  }
  __syncthreads();
  gemm_ldsA<5, 256>(As, 528, 66, Cin_t + (size_t)g * 1024 * 256, 1024, EpiS5{Ypart, Gbf, cc0, g * 16 + (otid() & 15)});
}


struct ChainP {
  const bf16_t* Ain;
  const bf16_t* Wglu_t; const bf16_t* Wo_t; const bf16_t* Wq_t;
  bf16_t* Vbf; bf16_t* O; const float* Hl; const float* Hc; const float* mod; const float* lng; const float* lnb;
  float* Hout; bf16_t* Tbf; bf16_t* Q;
};
template <bool L0>
__device__ __forceinline__ void ph_chainA(const ChainP& p, int bid, char* As) {
  constexpr int NR = L0 ? 66 : 64;
  constexpr int RT = L0 ? 5 : 4;
  const int g0 = bid * NR;
  load_rows_lds(As, p.Ain + (size_t)g0 * D, NR);
  __syncthreads();
  if (L0) {
    gemm_ldsA<RT, 1024>(As, LDA_B, NR, p.Wglu_t, D, EpiGluL{As, p.Vbf + (size_t)g0 * D});
    __syncthreads();
    load_rows_lds(As, p.Vbf + (size_t)g0 * D, NR);
    __syncthreads();
  }
  if constexpr (L0) gemm_ldsA<RT, 1024>(As, LDA_B, NR, p.Wo_t, D, EpiBF16{p.O + (size_t)g0 * D, D});
  else gemm_ldsA8<RT, 1024>(As, LDA_B, NR, (const unsigned char*)p.Wo_t, D, EpiBF16{p.O + (size_t)g0 * D, D});
  __syncthreads();
  ln_rows(As, g0, NR, p.Hl, p.Hc, p.O, p.mod, 2, p.lng, p.lnb, p.Hout, p.Tbf, 3, 4);
  __syncthreads();
  gemm_ldsA<RT, 1024>(As, LDA_B, NR, p.Wq_t, D, EpiBF16{p.Q + (size_t)g0 * D, D});
}


constexpr int KEYS = SEQ + CTX;
constexpr float att_KS = 0.5f;
struct EpiKV { unsigned char* Kn; unsigned char* Vl; int g0; int sh; __device__ __forceinline__ void operator()(int row, int col, float v) const {
  const int head = col >> 8, j = col & 255;
  if (j < 128) {
    const int g = g0 + row; int b, key;
    if (g < NL) { b = g >> 13; key = g & (SEQ - 1); } else { const int cidx = g - NL; b = cidx >> 8; key = SEQ + (cidx & (CTX - 1)); }
    Kn[((size_t)(b * 8 + head) * KEYS + key) * 128 + j] = f2fp8(v * att_KS);
  } else Vl[(head * 128 + (j - 128)) * 68 + row + sh] = f2fp8(v * 4.f);
} };
struct EpiQ { bf16_t* Qa; int g0; int pad; __device__ __forceinline__ void operator()(int row, int col, float v) const {
  const int g = g0 + row, b = g >> 13, n = g & (SEQ - 1);
  const int head = col / 192, j = col - head * 192;
  Qa[((size_t)(b * 8 + head) * SEQ + n) * 192 + j] = f2bf(v);
} };
struct ProjP { const bf16_t* Wcat_t; const bf16_t* Wuq_t; const bf16_t* Wukv_t; const float* q_norm; const float* kv_norm;
               float* PR; bf16_t* Qa; unsigned char* Kn; unsigned char* Kr; unsigned char* Va; };
__device__ __forceinline__ void ph_mla_proj(const ProjP& p, int bid, char* As) {
  const int g0 = bid * 66, wave = otid() >> 6, lane = otid() & 63;
  gemm_ldsA8<5, 1024>(As, LDA_B, 66, (const unsigned char*)p.Wcat_t, 704, EpiF32{p.PR + (size_t)g0 * D, D});
  __syncthreads();
  char* A1 = As; char* A2 = As + 66 * 784;
  for (int rr = wave; rr < 66; rr += 8) {
    const int g = g0 + rr;
    const float* pr = p.PR + (size_t)g * D;
    float v[6]; float ss = 0.f;
#pragma unroll
    for (int i = 0; i < 6; ++i) { v[i] = pr[i * 64 + lane]; ss += v[i] * v[i]; }
    float rn = rsqrtf(wave_sum(ss) * (1.f / 384.f) + RMS_EPS);
#pragma unroll
    for (int i = 0; i < 6; ++i) *(bf16_t*)(A1 + rr * 784 + (i * 64 + lane) * 2) = f2bf(v[i] * rn * p.q_norm[i * 64 + lane]);
    float w[4]; ss = 0.f;
#pragma unroll
    for (int i = 0; i < 4; ++i) { w[i] = pr[384 + i * 64 + lane]; ss += w[i] * w[i]; }
    rn = rsqrtf(wave_sum(ss) * (1.f / 256.f) + RMS_EPS);
#pragma unroll
    for (int i = 0; i < 4; ++i) *(bf16_t*)(A2 + rr * 528 + (i * 64 + lane) * 2) = f2bf(w[i] * rn * p.kv_norm[i * 64 + lane]);
    if (lane < 32) {
      float x1 = pr[640 + lane], x2 = pr[672 + lane];
      int b, key;
      if (g < NL) {
        b = g >> 13; key = g & (SEQ - 1);
        const int n = key, rr2 = n >> 6, cc = n & 63;
        const float inv = powf(10000.f, -(float)(lane & 15) / 16.f);
        const float ang = (lane < 16 ? (float)rr2 : (float)cc) * inv;
        const float cs = cosf(ang), sn = sinf(ang);
        const float y1 = x1 * cs - x2 * sn, y2 = x2 * cs + x1 * sn; x1 = y1; x2 = y2;
      } else { const int cidx = g - NL; b = cidx >> 8; key = SEQ + (cidx & (CTX - 1)); }
      unsigned char* kp = p.Kr + ((size_t)b * KEYS + key) * 64;
      kp[lane] = f2fp8(x1 * att_KS); kp[32 + lane] = f2fp8(x2 * att_KS);
    }
  }
  __syncthreads();
  int nq = NL - g0; nq = nq > 66 ? 66 : nq;
  if (nq > 0) gemm_ldsA8<5, 384>(A1, 784, nq, (const unsigned char*)p.Wuq_t, 1536, EpiQ{p.Qa, g0, 0});
  unsigned char* Vl = (unsigned char*)As + 66 * 784 + 66 * 528;
  const int sh = g0 & 3;
  gemm_ldsA8<5, 256>(A2, 528, 66, (const unsigned char*)p.Wukv_t, 2048, EpiKV{p.Kn, Vl, g0, sh});
  __syncthreads();
  for (int i = otid(); i < 1024 * 17; i += 512) {
    const int dvg = i / 17, q4 = i - dvg * 17, g4 = g0 - sh + 4 * q4;
    const unsigned w = *(const unsigned*)(Vl + dvg * 68 + 4 * q4);
    int b, key;
    if (g4 < NL) { b = g4 >> 13; key = g4 & (SEQ - 1); } else { const int cidx = g4 - NL; b = cidx >> 8; key = SEQ + (cidx & (CTX - 1)); }
    const int m = (key & 63) >> 2, posd = (m & 1) * 8 + (m >> 3) * 4 + ((m >> 1) & 3);
    unsigned char* dst = p.Va + ((size_t)(b * 8 + (dvg >> 7)) * (KEYS / 64) + (key >> 6)) * 8192 + (dvg & 127) * 64 + posd * 4;
    if (g4 >= g0 && g4 + 3 < g0 + 66) *(unsigned*)dst = w;
    else if (g4 < g0) *(unsigned short*)(dst + 2) = (unsigned short)(w >> 16);
    else *(unsigned short*)dst = (unsigned short)(w & 0xFFFFu);
  }
  for (int rr = wave; rr < nq; rr += 8) {
    const int g = g0 + rr, b = g >> 13, n = g & (SEQ - 1);
    if (lane < 32) {
      const float inv = powf(10000.f, -(float)(lane & 15) / 16.f);
      const float ang = (lane < 16 ? (float)(n >> 6) : (float)(n & 63)) * inv;
      const float cs = cosf(ang), sn = sinf(ang);
#pragma unroll
      for (int h = 0; h < 8; ++h) {
        bf16_t* qo = p.Qa + ((size_t)(b * 8 + h) * SEQ + n) * 192;
        const float x1 = bf2f(qo[128 + lane]), x2 = bf2f(qo[160 + lane]);
        qo[128 + lane] = f2bf(x1 * cs - x2 * sn); qo[160 + lane] = f2bf(x2 * cs + x1 * sn);
      }
    }
  }
}

namespace att {
using i32x8 = __attribute__((ext_vector_type(8))) int;
using i32x4 = __attribute__((ext_vector_type(4))) int;
using f32x16 = __attribute__((ext_vector_type(16))) float;
constexpr int KVBLK = 64, KROW = 208, VROW = 80, NTILE = KEYS / 64;
constexpr float KS = 0.5f, VS = 4.f;
constexpr float QS = 0.07216878364870322f * 1.4426950408889634f / KS;
constexpr float THR2 = 3.f * 1.4426950408889634f, PSH = 4.f;
constexpr int SHM_V = 128 * VROW, SHM_K = KVBLK * KROW, NSLOT = 3, SHM_ATTN = NSLOT * (SHM_V + SHM_K) + 8 * 64 * 4;
#define SBAR() __builtin_amdgcn_sched_barrier(0)
__device__ __forceinline__ int crow(int r, int hi) { return (r & 3) + 8 * (r >> 2) + 4 * hi; }
__device__ __forceinline__ f32x16 mfma8(i32x8 a, i32x8 b, f32x16 c) { return __builtin_amdgcn_mfma_scale_f32_32x32x64_f8f6f4(a, b, c, 0, 0, 0, 0, 0, 0); }
__device__ __forceinline__ i32x8 cat8(i32x4 a, i32x4 b) { return __builtin_shufflevector(a, b, 0, 1, 2, 3, 4, 5, 6, 7); }
__device__ __forceinline__ int pk4(float a, float b, float c, float d, int old = 0) { const int w = __builtin_amdgcn_cvt_pk_fp8_f32(a, b, old, false); return __builtin_amdgcn_cvt_pk_fp8_f32(c, d, w, true); }
__device__ __forceinline__ void softmax_tile(f32x16& p0, f32x16& p1, f32x16& bias, bool first, f32x16* o, float* al_l, int r32, int hi, i32x8& pa) {
  float pmax = p0[0];
#pragma unroll
  for (int r = 1; r < 16; ++r) pmax = fmaxf(pmax, p0[r]);
#pragma unroll
  for (int r = 0; r < 16; ++r) pmax = fmaxf(pmax, p1[r]);
  { auto rr = __builtin_amdgcn_permlane32_swap(__float_as_uint(pmax), __float_as_uint(pmax), false, false);
    pmax = fmaxf(__uint_as_float(rr[0]), __uint_as_float(rr[1])); }
  if (__builtin_expect(first || !__all(pmax <= PSH + THR2), 0)) {
    const float delta = first ? pmax - PSH : fmaxf(pmax - PSH, 0.f);
    if (!first) {
      if (hi == 0) al_l[r32] = __builtin_amdgcn_exp2f(-delta);
      asm volatile("s_waitcnt lgkmcnt(0)" ::: "memory");
#pragma unroll
      for (int d = 0; d < 5; ++d)
#pragma unroll
        for (int r = 0; r < 16; ++r) o[d][r] *= al_l[crow(r, hi)];
    }
    const float nb = bias[0] - delta;
#pragma unroll
    for (int r = 0; r < 16; ++r) { p0[r] -= delta; p1[r] -= delta; bias[r] = nb; }
  }
#pragma unroll
  for (int r = 0; r < 16; ++r) p0[r] = __builtin_amdgcn_exp2f(p0[r]);
#pragma unroll
  for (int r = 0; r < 16; ++r) p1[r] = __builtin_amdgcn_exp2f(p1[r]);
#pragma unroll
  for (int w = 0; w < 4; ++w) { pa[w] = pk4(p0[4 * w], p0[4 * w + 1], p0[4 * w + 2], p0[4 * w + 3], pa[w]); pa[4 + w] = pk4(p1[4 * w], p1[4 * w + 1], p1[4 * w + 2], p1[4 * w + 3], pa[4 + w]); }
}
__device__ __forceinline__ void qkt(f32x16& p0, f32x16& p1, const f32x16& bias, const char* Ks, const i32x8* q, int r32, int hi) {
  p0 = bias; p1 = bias;
  const char* k0 = Ks + r32 * KROW + hi * 32; const char* k1 = k0 + 32 * KROW;
#pragma unroll
  for (int s = 0; s < 3; ++s) {
    const i32x8 a0 = cat8(*reinterpret_cast<const i32x4*>(k0 + s * 64), *reinterpret_cast<const i32x4*>(k0 + s * 64 + 16));
    const i32x8 a1 = cat8(*reinterpret_cast<const i32x4*>(k1 + s * 64), *reinterpret_cast<const i32x4*>(k1 + s * 64 + 16));
    p0 = mfma8(a0, q[s], p0);
    p1 = mfma8(a1, q[s], p1); }
}
__device__ __forceinline__ void pv_all(f32x16* o, const char* Vs, i32x8 pa, int r32, int hi) {
  const char* v0 = Vs + r32 * VROW + hi * 32;
#pragma unroll
  for (int d0 = 0; d0 < 4; ++d0) {
    const i32x8 vb = cat8(*reinterpret_cast<const i32x4*>(v0 + d0 * 32 * VROW), *reinterpret_cast<const i32x4*>(v0 + d0 * 32 * VROW + 16));
    o[d0] = mfma8(pa, vb, o[d0]); }
  const i32x8 ones = {0x38383838, 0x38383838, 0x38383838, 0x38383838, 0x38383838, 0x38383838, 0x38383838, 0x38383838};
  o[4] = mfma8(pa, ones, o[4]);
}
__device__ __forceinline__ void attn_body(const bf16_t* __restrict__ Qb, const unsigned char* __restrict__ Kn, const unsigned char* __restrict__ Krb, const unsigned char* __restrict__ Vt,
                                          bf16_t* __restrict__ Ob, char* lds) {
  const int tid = otid(), wid = tid >> 6, lane = tid & 63, r32 = lane & 31, hi = lane >> 5;
  const bool lo4 = __builtin_amdgcn_readfirstlane(wid >> 2) == 0;
  char* V_lds = lds; char* K_lds = lds + NSLOT * SHM_V;
  float* al_l = (float*)(lds + NSLOT * (SHM_V + SHM_K)) + wid * 64;
  f32x16 bias = {}; f32x16 o[5] = {}; i32x8 q[3];
  { const bf16_t* Qw = Qb + (size_t)(wid * 32 + r32) * 192 + hi * 32;
#pragma unroll
    for (int s = 0; s < 3; ++s) {
#pragma unroll
      for (int c = 0; c < 4; ++c) { const uint4 w = *reinterpret_cast<const uint4*>(Qw + s * 64 + c * 8);
        q[s][2 * c] = pk4(bflo(w.x) * QS, bfhi(w.x) * QS, bflo(w.y) * QS, bfhi(w.y) * QS);
        q[s][2 * c + 1] = pk4(bflo(w.z) * QS, bfhi(w.z) * QS, bflo(w.w) * QS, bfhi(w.w) * QS); } } }
  i32x8 ones = {0x38383838, 0x38383838, 0x38383838, 0x38383838, 0x38383838, 0x38383838, 0x38383838, 0x38383838};
  const int vdst = (tid >> 2) * VROW + (tid & 3) * 16, kdst = (tid >> 3) * KROW + (tid & 7) * 16, rdst = (tid >> 2) * KROW + 128 + (tid & 3) * 16;
  const int kfo = r32 * KROW + hi * 32, vfo = r32 * VROW + hi * 32;
  uint4 vs, ks, rs = make_uint4(0u, 0u, 0u, 0u);
#define TLOAD(t) do { ks = *reinterpret_cast<const uint4*>(Kn + (size_t)(t) * 8192 + tid * 16); vs = *reinterpret_cast<const uint4*>(Vt + (size_t)(t) * 8192 + tid * 16); \
    if (lo4) rs = *reinterpret_cast<const uint4*>(Krb + (size_t)(t) * 4096 + tid * 16); } while (0)
#define TWRITE(sl) do { *(uint4*)(K_lds + (sl) * SHM_K + kdst) = ks; *(uint4*)(V_lds + (sl) * SHM_V + vdst) = vs; if (lo4) *(uint4*)(K_lds + (sl) * SHM_K + rdst) = rs; } while (0)
#define SWAIT() asm volatile("s_waitcnt vmcnt(0)" ::: "memory")
#define LD4(p) (*reinterpret_cast<const i32x4*>(p))
  f32x16 p0, p1; i32x8 pa = {};
  TLOAD(0); SWAIT(); TWRITE(0);
  TLOAD(1); SWAIT(); TWRITE(1);
  TLOAD(2);
  __syncthreads();
  int sl = 0, sl2 = 2;
#pragma unroll 1
  for (int i = 0; i < NTILE; ++i) {
    const char* kb = K_lds + sl * SHM_K + kfo; const char* vb = V_lds + sl * SHM_V + vfo;
    SBAR();
    i32x4 ka0 = LD4(kb), ka1 = LD4(kb + 16), ka2 = LD4(kb + 32 * KROW), ka3 = LD4(kb + 32 * KROW + 16);
    i32x4 kb0 = LD4(kb + 64), kb1 = LD4(kb + 80), kb2 = LD4(kb + 32 * KROW + 64), kb3 = LD4(kb + 32 * KROW + 80);
    SBAR();
    p0 = mfma8(cat8(ka0, ka1), q[0], bias); p1 = mfma8(cat8(ka2, ka3), q[0], bias);
    ka0 = LD4(kb + 128); ka1 = LD4(kb + 144); ka2 = LD4(kb + 32 * KROW + 128); ka3 = LD4(kb + 32 * KROW + 144);
    SBAR();
    p0 = mfma8(cat8(kb0, kb1), q[1], p0); p1 = mfma8(cat8(kb2, kb3), q[1], p1);
    i32x4 v00 = LD4(vb), v01 = LD4(vb + 16), v10 = LD4(vb + 32 * VROW), v11 = LD4(vb + 32 * VROW + 16);
    SBAR();
    p0 = mfma8(cat8(ka0, ka1), q[2], p0); p1 = mfma8(cat8(ka2, ka3), q[2], p1);
    SBAR();
    softmax_tile(p0, p1, bias, i == 0, o, al_l, r32, hi, pa);
    SBAR();
    i32x4 v20 = LD4(vb + 64 * VROW), v21 = LD4(vb + 64 * VROW + 16), v30 = LD4(vb + 96 * VROW), v31 = LD4(vb + 96 * VROW + 16);
    o[4] = mfma8(pa, ones, o[4]); o[0] = mfma8(pa, cat8(v00, v01), o[0]); o[1] = mfma8(pa, cat8(v10, v11), o[1]);
    SBAR();
    o[2] = mfma8(pa, cat8(v20, v21), o[2]); o[3] = mfma8(pa, cat8(v30, v31), o[3]);
    SBAR();
    SWAIT();
    if (i + 2 < NTILE) TWRITE(sl2);
    if (i + 3 < NTILE) TLOAD(i + 3);
    sl = sl == NSLOT - 1 ? 0 : sl + 1; sl2 = sl2 == NSLOT - 1 ? 0 : sl2 + 1;
    SBAR(); __syncthreads();
  }
  float rli[16];
#pragma unroll
  for (int r = 0; r < 16; ++r) rli[r] = __builtin_amdgcn_rcpf(o[4][r]) * (1.f / VS);
  bf16_t* Ow = Ob + (size_t)(wid * 32) * D;
#pragma unroll
  for (int r = 0; r < 16; ++r) { const int orow = crow(r, hi);
#pragma unroll
    for (int d0 = 0; d0 < 4; ++d0) Ow[(size_t)orow * D + d0 * 32 + r32] = f2bf(o[d0][r] * rli[r]); }
  __syncthreads();
#undef TLOAD
#undef TWRITE
#undef SWAIT
#undef LD4
}
}

__device__ __forceinline__ void ph_attn(const bf16_t* __restrict__ Qa, const unsigned char* __restrict__ Kn, const unsigned char* __restrict__ Kr, const unsigned char* __restrict__ Vt,
                                        bf16_t* __restrict__ AO, int bid, int nblk, char* lds) {
  for (int item = bid; item < 512; item += nblk) {
    const int b = item >> 8, h = item & 7, qb = (item >> 3) & 31;
    att::attn_body(Qa + ((size_t)(b * 8 + h) * SEQ + qb * 256) * 192, Kn + (size_t)(b * 8 + h) * KEYS * 128, Kr + (size_t)b * KEYS * 64,
                   Vt + (size_t)(b * 8 + h) * KEYS * 128, AO + (size_t)(b * SEQ + qb * 256) * D + h * 128, lds);
  }
}

namespace rt {
using f32x16 = __attribute__((ext_vector_type(16))) float;
__device__ __forceinline__ int sortable(float f) { const int b = __float_as_int(f); return b ^ ((b >> 31) & 0x7FFFFFFF); }
__device__ __forceinline__ float unsortable(int k) { return __int_as_float(k ^ ((k >> 31) & 0x7FFFFFFF)); }
__device__ __forceinline__ int imax(int a, int b) { return a > b ? a : b; }
__device__ __forceinline__ int imin(int a, int b) { return a < b ? a : b; }
template <int N> __device__ __forceinline__ void sort_desc(int (&v)[N]) {
#pragma unroll
  for (int k = 2; k <= N; k <<= 1) {
#pragma unroll
    for (int j = k >> 1; j > 0; j >>= 1) {
#pragma unroll
      for (int i = 0; i < N; ++i) {
        const int l = i ^ j;
        if (l > i) {
          const bool desc = ((i & k) == 0);
          const int a = v[i], b = v[l];
          v[i] = desc ? imax(a, b) : imin(a, b);
          v[l] = desc ? imin(a, b) : imax(a, b);
        }
      }
    }
  }
}
template <int N> __device__ __forceinline__ void merge_desc(int (&v)[N]) {
#pragma unroll
  for (int j = N >> 1; j > 0; j >>= 1) {
#pragma unroll
    for (int i = 0; i < N; ++i) {
      const int l = i ^ j;
      if (l > i) { const int a = v[i], b = v[l]; v[i] = imax(a, b); v[l] = imin(a, b); }
    }
  }
}
__device__ __forceinline__ void absorb16(int (&L)[16], int (&B)[16]) {
  sort_desc<16>(B);
#pragma unroll
  for (int i = 0; i < 16; ++i) L[i] = imax(L[i], B[15 - i]);
  merge_desc<16>(L);
}
__device__ __forceinline__ constexpr int npairs_row(int i) { return 16 / (i + 1); }
}

struct RouteP { const bf16_t* Q; const bf16_t* Khi; int* IDX; float* GATE; int rows_per_block; int pad; };
__device__ __forceinline__ void ph_route(const RouteP& p, int bid, char* lds) {
  using namespace rt;
  int (*svl)[64][33] = reinterpret_cast<int (*)[64][33]>(lds);
  const int wave = otid() >> 6, lane = otid() & 63, r32 = lane & 31, hi = lane >> 5, hi4 = hi * 4;
  int nrows = p.rows_per_block; asm volatile("" : "+s"(nrows));
  const int g0 = bid * nrows;
  const int h = wave;
#pragma unroll 1
  for (int tg = 0; tg * 32 < nrows; ++tg) {
    int trow = tg * 32 + r32; const bool valid = trow < nrows; trow = valid ? trow : nrows - 1;
    const bf16_t* qrow = p.Q + (size_t)(g0 + trow) * D;
    int sv[2][16];
#pragma unroll
    for (int s = 0; s < 2; ++s) {
      const int hs = h * 2 + s;
      f32x16 acc[4];
#pragma unroll
      for (int m = 0; m < 4; ++m) acc[m] = f32x16{};
#pragma unroll
      for (int kp = 0; kp < 2; ++kp) {
        bf16x8 kf[2][4], qf[2];
#pragma unroll
        for (int k2 = 0; k2 < 2; ++k2)
#pragma unroll
          for (int m = 0; m < 4; ++m) kf[k2][m] = *(const bf16x8*)(p.Khi + ((size_t)(hs * 128 + m * 32 + r32)) * 64 + (kp * 2 + k2) * 16 + hi * 8);
#pragma unroll
        for (int k2 = 0; k2 < 2; ++k2) {
          const int ks = kp * 2 + k2;
          qf[k2] = *(const bf16x8*)(qrow + hs * 64 + ks * 16 + hi * 8);
        }
#pragma unroll
        for (int k2 = 0; k2 < 2; ++k2)
#pragma unroll
          for (int m = 0; m < 4; ++m) acc[m] = __builtin_amdgcn_mfma_f32_32x32x16_bf16(kf[k2][m], qf[k2], acc[m], 0, 0, 0);
      }
      int L[16];
#pragma unroll
      for (int m = 0; m < 4; ++m) {
        int B[16];
#pragma unroll
        for (int r = 0; r < 16; ++r) B[r] = (sortable(acc[m][r]) & ~0x7F) | (m * 32 + (r & 3) + 8 * (r >> 2)) | hi4;
        if (m == 0) { sort_desc<16>(B);
#pragma unroll
          for (int i = 0; i < 16; ++i) L[i] = B[i]; }
        else absorb16(L, B);
      }
      int Lo[16], Hi[16];
#pragma unroll
      for (int i = 0; i < 16; ++i) { auto rr = __builtin_amdgcn_permlane32_swap((unsigned)L[i], (unsigned)L[i], false, false); Lo[i] = (int)rr[0]; Hi[i] = (int)rr[1]; }
#pragma unroll
      for (int i = 0; i < 16; ++i) L[i] = imax(Lo[i], Hi[15 - i]);
      merge_desc<16>(L);
#pragma unroll
      for (int i = 0; i < 16; ++i) { sv[s][i] = L[i]; svl[wave][lane][s * 16 + i] = L[i]; }
    }
    float f0[16], f1[16];
#pragma unroll
    for (int i = 0; i < 16; ++i) { f0[i] = unsortable(sv[0][i] & ~0x7F); f1[i] = unsortable(sv[1][i] & ~0x7F); }
    int Lc[16];
    {
      int C[64];
      int n = 0;
#pragma unroll
      for (int i = 0; i < 16; ++i)
#pragma unroll
        for (int j = 0; j < 16; ++j)
          if ((i + 1) * (j + 1) <= 16) { C[n] = (sortable(f0[i] + f1[j]) & ~0xFF) | (i * 16 + j); ++n; }
#pragma unroll
      for (int k = 50; k < 64; ++k) C[k] = (int)0x80000000;
#pragma unroll
      for (int m = 0; m < 4; ++m) {
        int B[16];
#pragma unroll
        for (int r = 0; r < 16; ++r) B[r] = C[m * 16 + r];
        if (m == 0) { sort_desc<16>(B);
#pragma unroll
          for (int i = 0; i < 16; ++i) Lc[i] = B[i]; }
        else absorb16(Lc, B);
      }
    }
    float e[16]; float esum = 0.f;
    const float vmax = unsortable(Lc[0] & ~0xFF);
#pragma unroll
    for (int r = 0; r < 16; ++r) { e[r] = expf(unsortable(Lc[r] & ~0xFF) - vmax); esum += e[r]; }
    const float inv = 1.f / esum;
    int eid[16];
#pragma unroll
    for (int r = 0; r < 16; ++r) {
      const int pr = Lc[r] & 0xFF;
      const int k0 = svl[wave][lane][pr >> 4] & 0x7F, k1 = svl[wave][lane][16 + (pr & 15)] & 0x7F;
      eid[r] = k0 * 128 + k1;
    }
    if (valid && hi == 0) {
      int* ip = p.IDX + (size_t)(g0 + trow) * 128 + h * 16; float* gp = p.GATE + (size_t)(g0 + trow) * 128 + h * 16;
#pragma unroll
      for (int r = 0; r < 16; r += 4) {
        *(int4*)(ip + r) = make_int4(eid[r], eid[r + 1], eid[r + 2], eid[r + 3]);
        *(float4*)(gp + r) = make_float4(e[r] * inv, e[r + 1] * inv, e[r + 2] * inv, e[r + 3] * inv);
      }
    }
  }
}

constexpr int RB = 8;
template <bool SIGNED>
__device__ __forceinline__ void cvt_rows_i8(const float* __restrict__ src, unsigned char* __restrict__ dst, float* __restrict__ scl, int nrows, int wgid, int nw) {
  const int lane = otid() & 63;
  for (int r0 = wgid * RB; r0 < nrows; r0 += nw * RB) {
    float v[RB][16];
#pragma unroll
    for (int u = 0; u < RB; ++u) {
      const float* sp = src + (size_t)(r0 + u) * D + lane * 4;
      *(float4*)&v[u][0] = *(const float4*)sp; *(float4*)&v[u][4] = *(const float4*)(sp + 256); *(float4*)&v[u][8] = *(const float4*)(sp + 512); *(float4*)&v[u][12] = *(const float4*)(sp + 768);
    }
#pragma unroll
    for (int u = 0; u < RB; ++u) {
      float am = 0.f;
#pragma unroll
      for (int j = 0; j < 16; ++j) am = fmaxf(am, fabsf(v[u][j]));
      am = wave_max_dpp(am);
      const float sc = am > 0.f ? am * (1.f / 127.f) : 1.f, inv = 1.f / sc;
      unsigned w[4];
#pragma unroll
      for (int q4 = 0; q4 < 4; ++q4) {
        unsigned ww = 0u;
#pragma unroll
        for (int j = 0; j < 4; ++j) { int qi = (int)rintf(v[u][q4 * 4 + j] * inv) + (SIGNED ? 0 : 128); qi = SIGNED ? (qi < -127 ? -127 : (qi > 127 ? 127 : qi)) : (qi < 1 ? 1 : (qi > 255 ? 255 : qi)); ww |= (unsigned)(qi & 255) << (8 * j); }
        w[q4] = ww;
      }
      *(uint4*)(dst + (size_t)(r0 + u) * D + lane * 16) = make_uint4(w[0], w[1], w[2], w[3]);
      if (lane == 0) scl[r0 + u] = sc;
    }
  }
}

constexpr int QROW = 512;
__device__ __forceinline__ void cvt_rows_q6(const float* __restrict__ src, unsigned char* __restrict__ dst, float* __restrict__ scl, int nrows, int wgid, int nw) {
  const int lane = otid() & 63;
  for (int r0 = wgid * RB; r0 < nrows; r0 += nw * RB) {
    float v[RB][16];
#pragma unroll
    for (int u = 0; u < RB; ++u) {
      const float* sp = src + (size_t)(r0 + u) * D + lane * 4;
      *(float4*)&v[u][0] = *(const float4*)sp; *(float4*)&v[u][4] = *(const float4*)(sp + 256); *(float4*)&v[u][8] = *(const float4*)(sp + 512); *(float4*)&v[u][12] = *(const float4*)(sp + 768);
    }
#pragma unroll
    for (int u = 0; u < RB; ++u) {
      float am = 0.f;
#pragma unroll
      for (int j = 0; j < 16; ++j) am = fmaxf(am, fabsf(v[u][j]));
      am = wave_max_dpp(am);
      const float sc = am > 0.f ? am * (1.f / 7.f) : 1.f, inv = 1.f / sc;
      unsigned w0 = 0u, w1 = 0u;
#pragma unroll
      for (int j = 0; j < 8; ++j) {
        int qa = (int)rintf(v[u][j] * inv) + 8; qa = qa < 1 ? 1 : (qa > 15 ? 15 : qa);
        int qb = (int)rintf(v[u][8 + j] * inv) + 8; qb = qb < 1 ? 1 : (qb > 15 ? 15 : qb);
        w0 |= (unsigned)qa << (4 * j); w1 |= (unsigned)qb << (4 * j);
      }
      *(uint2*)(dst + (size_t)(r0 + u) * QROW + lane * 8) = make_uint2(w0, w1);
      if (lane == 0) scl[r0 + u] = sc;
    }
  }
}
struct q6w { unsigned x, y, z; };
template <int J> __device__ __forceinline__ float q6(const q6w& w) {
  const unsigned x = J < 8 ? w.x : w.y; constexpr int sh = 4 * (J & 7);
  if constexpr (sh == 28) return (float)(x >> 28); else return (float)((x >> sh) & 15u);
}

struct GatherP { const bf16_t* Tbf; const int* IDX; const float* GATE; const unsigned char* utab; const unsigned char* vtab; const float* su; const float* sv;
                 const float* Hin; const float* mod; const float* lng; const float* lnb; float* Hout; const float* modT; };
#define UB0(w) ((float)((w) & 0xFFu))
#define UB1(w) ((float)(((w) >> 8) & 0xFFu))
#define UB2(w) ((float)(((w) >> 16) & 0xFFu))
#define UB3(w) ((float)((w) >> 24))
template <bool FINAL>
__device__ __forceinline__ void ln_token(const GatherP& p, int row, int rr, int lane, const float (&f)[16], float asum, char* As) {
  const int v = row_vec(row);
  const float* hin = p.Hin + (size_t)row * D + lane * 4;
  const float* gm = p.mod + v * 6144 + 5 * 1024 + lane * 4;
  const float off = 8.f * asum;
  float r[16]; float ssum = 0.f;
#pragma unroll
  for (int q4 = 0; q4 < 4; ++q4) {
    const float4 h4 = *(const float4*)(hin + q4 * 256), g4 = *(const float4*)(gm + q4 * 256);
    r[q4 * 4 + 0] = ALPHA * h4.x + g4.x * (f[q4 * 4 + 0] - off); r[q4 * 4 + 1] = ALPHA * h4.y + g4.y * (f[q4 * 4 + 1] - off);
    r[q4 * 4 + 2] = ALPHA * h4.z + g4.z * (f[q4 * 4 + 2] - off); r[q4 * 4 + 3] = ALPHA * h4.w + g4.w * (f[q4 * 4 + 3] - off);
    ssum += r[q4 * 4 + 0] + r[q4 * 4 + 1] + r[q4 * 4 + 2] + r[q4 * 4 + 3];
  }
  const float mu = wave_sum(ssum) * (1.f / D);
  float vs = 0.f;
#pragma unroll
  for (int j = 0; j < 16; ++j) { const float dlt = r[j] - mu; vs += dlt * dlt; }
  const float rstd = rsqrtf(wave_sum(vs) * (1.f / D) + LN_EPS);
  float o[16];
#pragma unroll
  for (int q4 = 0; q4 < 4; ++q4) {
    const float4 g4 = *(const float4*)(p.lng + q4 * 256 + lane * 4), b4 = *(const float4*)(p.lnb + q4 * 256 + lane * 4);
    o[q4 * 4 + 0] = (r[q4 * 4 + 0] - mu) * rstd * g4.x + b4.x; o[q4 * 4 + 1] = (r[q4 * 4 + 1] - mu) * rstd * g4.y + b4.y;
    o[q4 * 4 + 2] = (r[q4 * 4 + 2] - mu) * rstd * g4.z + b4.z; o[q4 * 4 + 3] = (r[q4 * 4 + 3] - mu) * rstd * g4.w + b4.w;
    *(float4*)(p.Hout + (size_t)row * D + q4 * 256 + lane * 4) = make_float4(o[q4 * 4 + 0], o[q4 * 4 + 1], o[q4 * 4 + 2], o[q4 * 4 + 3]);
  }
  if (!FINAL) {
    const float* mt = p.modT + v * 6144 + lane * 4;
#pragma unroll
    for (int q4 = 0; q4 < 4; ++q4) {
      const float4 sh = *(const float4*)(mt + q4 * 256), sc = *(const float4*)(mt + 1024 + q4 * 256);
      uint2 w; w.x = pack2bf(o[q4 * 4] * (1.f + sc.x) + sh.x, o[q4 * 4 + 1] * (1.f + sc.y) + sh.y); w.y = pack2bf(o[q4 * 4 + 2] * (1.f + sc.z) + sh.z, o[q4 * 4 + 3] * (1.f + sc.w) + sh.w);
      *(uint2*)(As + rr * LDA_B + (q4 * 256 + lane * 4) * 2) = w;
    }
  }
}
constexpr int PARTW = 1088;
template <bool FINAL>
__device__ __forceinline__ void ph_gather_tm(const GatherP& p, int g0, int nrows, char* As, float* __restrict__ PART) {
  const int tid = otid(), wave = tid >> 6, lane = tid & 63;
  const int nfull = nrows >> 3, extra = nrows & 7;
  const int nun = nfull + (extra ? 1 : 0);
  auto desc = [&](int un, int& rr, int& kbeg, int& kcnt, bool& partial) {
    if (un < nfull) { rr = wave + 8 * un; kbeg = 0; kcnt = 128; partial = false; }
    else { const int wpt = 8 / extra; rr = nfull * 8 + wave / wpt; kcnt = 128 / wpt; kbeg = (wave % wpt) * kcnt; partial = true; }
  };
  uint2 nt0, nt1, nt2, nt3; int nid_lo, nid_hi; float nga_lo, nga_hi;
#define NLOAD(row_) do { const bf16_t* tp_ = p.Tbf + (size_t)(row_) * D + lane * 4; nt0 = *(const uint2*)tp_; nt1 = *(const uint2*)(tp_ + 256); nt2 = *(const uint2*)(tp_ + 512); nt3 = *(const uint2*)(tp_ + 768); \
    nid_lo = p.IDX[(size_t)(row_) * 128 + lane]; nid_hi = p.IDX[(size_t)(row_) * 128 + 64 + lane]; nga_lo = p.GATE[(size_t)(row_) * 128 + lane]; nga_hi = p.GATE[(size_t)(row_) * 128 + 64 + lane]; } while (0)
  { int rr0, kb0, kc0; bool pa0; desc(0, rr0, kb0, kc0, pa0); NLOAD(g0 + rr0); }
#pragma unroll 1
  for (int un = 0; un < nun; ++un) {
    int rr, kbeg, kcnt; bool partial;
    desc(un, rr, kbeg, kcnt, partial);
    const int row = g0 + rr;
    float tf[16];
    {
      const uint2 t0 = nt0, t1 = nt1, t2 = nt2, t3 = nt3;
      tf[0] = bflo(t0.x); tf[1] = bfhi(t0.x); tf[2] = bflo(t0.y); tf[3] = bfhi(t0.y); tf[4] = bflo(t1.x); tf[5] = bfhi(t1.x); tf[6] = bflo(t1.y); tf[7] = bfhi(t1.y);
      tf[8] = bflo(t2.x); tf[9] = bfhi(t2.x); tf[10] = bflo(t2.y); tf[11] = bfhi(t2.y); tf[12] = bflo(t3.x); tf[13] = bfhi(t3.x); tf[14] = bflo(t3.y); tf[15] = bfhi(t3.y);
    }
    float tam = 0.f;
#pragma unroll
    for (int j = 0; j < 16; ++j) tam = fmaxf(tam, fabsf(tf[j]));
    tam = wave_max_dpp(tam);
    const float st = tam > 0.f ? tam * (1.f / 127.f) : 1.f, tinv = 1.f / st;
    int tq[4];
#pragma unroll
    for (int k4 = 0; k4 < 4; ++k4) {
      unsigned ww = 0u;
#pragma unroll
      for (int j = 0; j < 4; ++j) ww |= (unsigned)((int)rintf(tf[k4 * 4 + j] * tinv) & 255) << (8 * j);
      tq[k4] = (int)ww;
    }
    const int id_lo = nid_lo, id_hi = nid_hi;
    const float ga_lo = nga_lo, ga_hi = nga_hi;
    const float su_lo = p.su[id_lo], su_hi = p.su[id_hi], sv_lo = p.sv[id_lo], sv_hi = p.sv[id_hi];
    float f[16];
#pragma unroll
    for (int j = 0; j < 16; ++j) f[j] = 0.f;
    uint4 rb[8];
    float dlo = 0.f, dhi = 0.f;
#define ULOAD(slot, kk) do { const int e_ = __builtin_amdgcn_readlane((kk) < 64 ? id_lo : id_hi, (kk) & 63); \
      rb[slot] = *(const uint4*)(p.utab + (size_t)e_ * D + lane * 16); } while (0)
#define VLOAD(slot, kk) do { const int e_ = __builtin_amdgcn_readlane((kk) < 64 ? id_lo : id_hi, (kk) & 63); \
      const uint2 t_ = *(const uint2*)(p.vtab + (size_t)e_ * QROW + lane * 8); rb[slot].x = t_.x; rb[slot].y = t_.y; } while (0)
    auto proc4u = [&](int s0, int k0) {
      float dot[4];
#pragma unroll
      for (int u = 0; u < 4; ++u) {
        const uint4 a_ = rb[s0 + u];
        int di = __builtin_amdgcn_sdot4((int)a_.x, tq[0], 0, false); di = __builtin_amdgcn_sdot4((int)a_.y, tq[1], di, false);
        di = __builtin_amdgcn_sdot4((int)a_.z, tq[2], di, false); di = __builtin_amdgcn_sdot4((int)a_.w, tq[3], di, false);
        dot[u] = (float)di;
      }
#define DPPSTEP(ctl, rm) do { _Pragma("unroll") for (int u = 0; u < 4; ++u) dot[u] += __uint_as_float(__builtin_amdgcn_update_dpp(0u, __float_as_uint(dot[u]), ctl, rm, 0xF, true)); } while (0)
      DPPSTEP(0xB1, 0xF); DPPSTEP(0x4E, 0xF); DPPSTEP(0x141, 0xF); DPPSTEP(0x140, 0xF); DPPSTEP(0x142, 0xA); DPPSTEP(0x143, 0xC);
#undef DPPSTEP
      if (k0 < 64) {
#pragma unroll
        for (int u = 0; u < 4; ++u) dlo = __uint_as_float(__builtin_amdgcn_update_dpp(__float_as_uint(dot[u]), __float_as_uint(dlo), 0x130, 0xF, 0xF, false));
      } else {
#pragma unroll
        for (int u = 0; u < 4; ++u) dhi = __uint_as_float(__builtin_amdgcn_update_dpp(__float_as_uint(dot[u]), __float_as_uint(dhi), 0x130, 0xF, 0xF, false));
      }
    };
    float act_lo = 0.f, act_hi = 0.f;
    auto proc4v = [&](int s0, int k0) {
      float act[4];
      if (k0 < 64) {
#pragma unroll
        for (int u = 0; u < 4; ++u) act[u] = __uint_as_float((unsigned)__builtin_amdgcn_readlane((int)__float_as_uint(act_lo), k0 + u));
      } else {
#pragma unroll
        for (int u = 0; u < 4; ++u) act[u] = __uint_as_float((unsigned)__builtin_amdgcn_readlane((int)__float_as_uint(act_hi), k0 - 64 + u));
      }
#pragma unroll
      for (int u = 0; u < 4; ++u) {
        const float act_ = act[u];
        const q6w c_ = {rb[s0 + u].x, rb[s0 + u].y, rb[s0 + u].z};
        f[0] = fmaf(act_, q6<0>(c_), f[0]); f[1] = fmaf(act_, q6<1>(c_), f[1]); f[2] = fmaf(act_, q6<2>(c_), f[2]); f[3] = fmaf(act_, q6<3>(c_), f[3]);
        f[4] = fmaf(act_, q6<4>(c_), f[4]); f[5] = fmaf(act_, q6<5>(c_), f[5]); f[6] = fmaf(act_, q6<6>(c_), f[6]); f[7] = fmaf(act_, q6<7>(c_), f[7]);
        f[8] = fmaf(act_, q6<8>(c_), f[8]); f[9] = fmaf(act_, q6<9>(c_), f[9]); f[10] = fmaf(act_, q6<10>(c_), f[10]); f[11] = fmaf(act_, q6<11>(c_), f[11]);
        f[12] = fmaf(act_, q6<12>(c_), f[12]); f[13] = fmaf(act_, q6<13>(c_), f[13]); f[14] = fmaf(act_, q6<14>(c_), f[14]); f[15] = fmaf(act_, q6<15>(c_), f[15]);
      }
    };
    ULOAD(0, kbeg); ULOAD(1, kbeg + 1); ULOAD(2, kbeg + 2); ULOAD(3, kbeg + 3); ULOAD(4, kbeg + 4); ULOAD(5, kbeg + 5); ULOAD(6, kbeg + 6); ULOAD(7, kbeg + 7);
    const int kend = kbeg + kcnt - 8;
#pragma unroll 1
    for (int k = kbeg; k < kend; k += 8) {
      proc4u(0, k); ULOAD(0, k + 8); ULOAD(1, k + 9); ULOAD(2, k + 10); ULOAD(3, k + 11);
      proc4u(4, k + 4); ULOAD(4, k + 12); ULOAD(5, k + 13); ULOAD(6, k + 14); ULOAD(7, k + 15);
    }
    proc4u(0, kend); VLOAD(0, kbeg); VLOAD(1, kbeg + 1); VLOAD(2, kbeg + 2); VLOAD(3, kbeg + 3);
    proc4u(4, kend + 4); VLOAD(4, kbeg + 4); VLOAD(5, kbeg + 5); VLOAD(6, kbeg + 6); VLOAD(7, kbeg + 7);
    if (partial) {
      const int srcl = ((lane - (kbeg & 63) + 32) & 63) * 4;
      const float sh_lo = __uint_as_float((unsigned)__builtin_amdgcn_ds_bpermute(srcl, (int)__float_as_uint(dlo))), sh_hi = __uint_as_float((unsigned)__builtin_amdgcn_ds_bpermute(srcl, (int)__float_as_uint(dhi)));
      const bool in = lane >= (kbeg & 63) && lane < (kbeg & 63) + 32;
      dlo = in ? sh_lo : 0.f; dhi = in ? sh_hi : 0.f;
    }
    act_lo = gelu_fast(su_lo * st * dlo) * ga_lo * sv_lo; act_hi = gelu_fast(su_hi * st * dhi) * ga_hi * sv_hi;
    const float asum = wave_sum_dpp(act_lo + act_hi);
    if (un + 1 < nun) { int nrr, nkb, nkc; bool npa; desc(un + 1, nrr, nkb, nkc, npa); NLOAD(g0 + nrr); }
#pragma unroll 1
    for (int k = kbeg; k < kend; k += 8) {
      proc4v(0, k); VLOAD(0, k + 8); VLOAD(1, k + 9); VLOAD(2, k + 10); VLOAD(3, k + 11);
      proc4v(4, k + 4); VLOAD(4, k + 12); VLOAD(5, k + 13); VLOAD(6, k + 14); VLOAD(7, k + 15);
    }
    proc4v(0, kend); proc4v(4, kend + 4);
#undef ULOAD
#undef VLOAD
    if (!partial) ln_token<FINAL>(p, row, rr, lane, f, asum, As);
    else {
      float* pp = PART + wave * PARTW + lane * 16;
      *(float4*)pp = make_float4(f[0], f[1], f[2], f[3]); *(float4*)(pp + 4) = make_float4(f[4], f[5], f[6], f[7]);
      *(float4*)(pp + 8) = make_float4(f[8], f[9], f[10], f[11]); *(float4*)(pp + 12) = make_float4(f[12], f[13], f[14], f[15]);
      if (lane == 0) PART[wave * PARTW + 1024] = asum;
    }
  }
#undef NLOAD
  if (extra) {
    __syncthreads();
    if (wave < extra) {
      const int wpt = 8 / extra, rr = nfull * 8 + wave;
      float f[16], asum = 0.f;
#pragma unroll
      for (int j = 0; j < 16; ++j) f[j] = 0.f;
      for (int w2 = wave * wpt; w2 < wave * wpt + wpt; ++w2) {
        const float* pp = PART + w2 * PARTW + lane * 16;
#pragma unroll
        for (int q4 = 0; q4 < 4; ++q4) { const float4 x4 = *(const float4*)(pp + q4 * 4); f[q4 * 4] += x4.x; f[q4 * 4 + 1] += x4.y; f[q4 * 4 + 2] += x4.z; f[q4 * 4 + 3] += x4.w; }
        asum += PART[w2 * PARTW + 1024];
      }
      ln_token<FINAL>(p, g0 + rr, rr, lane, f, asum, As);
    }
  }
}

__device__ __forceinline__ void cvt_plain(const float* __restrict__ a, bf16_t* __restrict__ o, size_t n8, bool lo, size_t gtid, size_t gsz) {
  for (size_t i = gtid; i < n8; i += gsz) {
    float v[8];
    *(float4*)&v[0] = ((const float4*)a)[i * 2]; *(float4*)&v[4] = ((const float4*)a)[i * 2 + 1];
    if (lo) {
#pragma unroll
      for (int j = 0; j < 8; ++j) v[j] = v[j] - bf2f(f2bf(v[j]));
    }
    uint4 w; w.x = pack2bf(v[0], v[1]); w.y = pack2bf(v[2], v[3]); w.z = pack2bf(v[4], v[5]); w.w = pack2bf(v[6], v[7]);
    ((uint4*)o)[i] = w;
  }
}
__device__ __forceinline__ void cvt_t(const float* __restrict__ W, bf16_t* __restrict__ Wt, int K, int N, bool lo, size_t gtid, size_t gsz) {
  const int N4 = N >> 2;
  const size_t total = (size_t)N4 * (K / 8);
#pragma unroll 2
  for (size_t i = gtid; i < total; i += gsz) {
    const int n = (int)(i % N4) * 4, k8 = (int)(i / N4);
    float4 r[8];
#pragma unroll
    for (int j = 0; j < 8; ++j) r[j] = *(const float4*)(W + (size_t)(k8 * 8 + j) * N + n);
    if (lo) {
#pragma unroll
      for (int j = 0; j < 8; ++j) { r[j].x -= bf2f(f2bf(r[j].x)); r[j].y -= bf2f(f2bf(r[j].y)); r[j].z -= bf2f(f2bf(r[j].z)); r[j].w -= bf2f(f2bf(r[j].w)); }
    }
    uint4* dst = (uint4*)(Wt + ((size_t)((n >> 4) * (K >> 5) + (k8 >> 2)) * 64 + (k8 & 3) * 16 + (n & 15)) * 8);
    dst[0] = make_uint4(pack2bf(r[0].x, r[1].x), pack2bf(r[2].x, r[3].x), pack2bf(r[4].x, r[5].x), pack2bf(r[6].x, r[7].x));
    dst[1] = make_uint4(pack2bf(r[0].y, r[1].y), pack2bf(r[2].y, r[3].y), pack2bf(r[4].y, r[5].y), pack2bf(r[6].y, r[7].y));
    dst[2] = make_uint4(pack2bf(r[0].z, r[1].z), pack2bf(r[2].z, r[3].z), pack2bf(r[4].z, r[5].z), pack2bf(r[6].z, r[7].z));
    dst[3] = make_uint4(pack2bf(r[0].w, r[1].w), pack2bf(r[2].w, r[3].w), pack2bf(r[4].w, r[5].w), pack2bf(r[6].w, r[7].w));
  }
}
__device__ __forceinline__ void cvt_t8(const float* __restrict__ W, unsigned char* __restrict__ Wt, int K, int N, size_t gtid, size_t gsz) {
  const int N4 = N >> 2;
  const size_t total = (size_t)N4 * (K / 8);
#pragma unroll 2
  for (size_t i = gtid; i < total; i += gsz) {
    const int n = (int)(i % N4) * 4, k8 = (int)(i / N4);
    float4 r[8];
#pragma unroll
    for (int j = 0; j < 8; ++j) r[j] = *(const float4*)(W + (size_t)(k8 * 8 + j) * N + n);
    unsigned char* dst = Wt + ((size_t)((n >> 4) * (K >> 6) + (k8 >> 3)) * 64 + (k8 & 3) * 16 + (n & 15)) * 16 + ((k8 >> 2) & 1) * 8;
#define PK8(C) make_uint2((unsigned)__builtin_amdgcn_cvt_pk_fp8_f32(r[2].C * 32.f, r[3].C * 32.f, __builtin_amdgcn_cvt_pk_fp8_f32(r[0].C * 32.f, r[1].C * 32.f, 0, false), true), \
                          (unsigned)__builtin_amdgcn_cvt_pk_fp8_f32(r[6].C * 32.f, r[7].C * 32.f, __builtin_amdgcn_cvt_pk_fp8_f32(r[4].C * 32.f, r[5].C * 32.f, 0, false), true))
    *(uint2*)(dst) = PK8(x); *(uint2*)(dst + 16) = PK8(y); *(uint2*)(dst + 32) = PK8(z); *(uint2*)(dst + 48) = PK8(w);
#undef PK8
  }
}
__device__ __forceinline__ void mod_item(const float* __restrict__ c, const float* __restrict__ c_ctx, const float* __restrict__ ada_w, const float* __restrict__ ada_b,
                                         float* __restrict__ MOD, int item, bool valid, char* lds, int tid, int nct, volatile int* cbc, int& cgen) {
  float* sc = (float*)lds;
  float* part = sc + 3072;
  const int wave = tid >> 6, lane = tid & 63, l = item / 96, cg = item % 96, nw = nct >> 6;
  if (valid) for (int i = tid; i < 3072; i += nct) { const int v = i >> 10, k = i & 1023; const float xv = v < 2 ? c[v * 1024 + k] : c_ctx[k]; sc[i] = xv / (1.f + expf(-xv)); }
  cbar(cbc, cgen, nw);
  if (valid) {
    float a0 = 0.f, a1 = 0.f, a2 = 0.f;
    const float* W = ada_w + (size_t)l * 1024 * 6144 + cg * 64 + lane;
    const int kb = wave * 171, ke = kb + 171 < 1024 ? kb + 171 : 1024;
#pragma unroll 57
    for (int k = kb; k < ke; ++k) { const float w = W[(size_t)k * 6144]; a0 += sc[k] * w; a1 += sc[1024 + k] * w; a2 += sc[2048 + k] * w; }
    part[(wave * 3 + 0) * 64 + lane] = a0; part[(wave * 3 + 1) * 64 + lane] = a1; part[(wave * 3 + 2) * 64 + lane] = a2;
  }
  cbar(cbc, cgen, nw);
  if (valid && tid < 192) {
    const int v = tid >> 6, ln = tid & 63; float sum = 0.f;
    for (int w = 0; w < nw; ++w) sum += part[(w * 3 + v) * 64 + ln];
    MOD[(l * 3 + v) * 6144 + cg * 64 + ln] = sum + ada_b[l * 6144 + cg * 64 + ln];
  }
}

__device__ __forceinline__ void gbar(unsigned* cnt, unsigned target) {
  asm volatile("s_waitcnt vmcnt(0)" ::: "memory");
  __syncthreads();
  if (otid() == 0) {
    __builtin_amdgcn_fence(__ATOMIC_RELEASE, "agent");
    asm volatile("s_waitcnt vmcnt(0)" ::: "memory");
    __hip_atomic_fetch_add(cnt, 1u, __ATOMIC_RELAXED, __HIP_MEMORY_SCOPE_AGENT);
    unsigned spins = 0;
    while (__hip_atomic_load(cnt, __ATOMIC_RELAXED, __HIP_MEMORY_SCOPE_AGENT) < target) { __builtin_amdgcn_s_sleep(2); if (++spins > (1u << 24)) break; }
    __builtin_amdgcn_fence(__ATOMIC_ACQUIRE, "agent");
    asm volatile("s_waitcnt vmcnt(0)" ::: "memory");
  }
  __syncthreads();
}

struct MP {
  const float *x, *c, *ctx, *c_ctx, *ada_w, *ada_b, *ln_g, *ln_b, *s5_a_re, *s5_a_im, *s5_log_dt, *s5_b_re, *s5_b_im, *s5_c_re, *s5_c_im, *s5_d, *s5_w_glu, *s5_w_o;
  const float *mla_w_dq, *mla_q_norm, *mla_w_uq, *mla_w_dkv, *mla_kv_norm, *mla_w_ukv, *mla_w_o, *peer_w_q, *peer_keys, *peer_u, *peer_v;
  float* out;
  float* MOD; bf16_t *Wt_glu, *Wt_o0, *Wt_q0, *Wt_o1, *Wt_q1, *Wt_cat, *Wt_uq, *Wt_ukv, *Khi, *Khi1;
  unsigned char *U0, *V0, *U1, *V1; float *SU0, *SV0, *SU1, *SV1; bf16_t *Ktab, *Bst_t, *Cin_t;
  bf16_t* Ypart; float* Ssta; bf16_t *HP, *Gbf, *Vbf, *Tbf; float *OQ, *H1, *H2; int* IDX; float* GATE;
  bf16_t *Qa, *AObf; unsigned char *Kn, *Kr, *Va; float* H3; bf16_t* Tbf1; unsigned* BAR; float* PART;
};
constexpr int LDS_BYTES = 66 * 784 + 66 * 528 + 1024 * 68 + 64;
__global__ __launch_bounds__(512) void mega(MP p) {
  __shared__ __attribute__((aligned(16))) char lds[LDS_BYTES];
  cg::grid_group grid = cg::this_grid();
  const int nblk = gridDim.x;
  int bid = blockIdx.x;
  const size_t TD = (size_t)1024 * 16384;
  const float* mod0 = p.MOD; const float* mod1 = p.MOD + 3 * 6144;
  {
    volatile int* cbc = (volatile int*)(lds + LDS_BYTES - 16);
    if (otid() == 0) *cbc = 0;
    __syncthreads();
    const int t0 = otid();
    if (t0 < 128) {
      const size_t mt = (size_t)bid * 128 + t0, ms = (size_t)nblk * 128;
      const int mw = bid * 2 + (t0 >> 6), nmw = nblk * 2;
      cvt_t(p.s5_w_glu, p.Wt_glu, D, D, false, mt, ms);
      cvt_t(p.s5_w_o, p.Wt_o0, D, D, false, mt, ms);
      cvt_t(p.peer_w_q, p.Wt_q0, D, D, false, mt, ms);
      cvt_t8(p.mla_w_o, (unsigned char*)p.Wt_o1, D, D, mt, ms);
      cvt_t(p.peer_w_q + (size_t)D * D, p.Wt_q1, D, D, false, mt, ms);
      cvt_t8(p.mla_w_dq, (unsigned char*)p.Wt_cat, D, 384, mt, ms);
      cvt_t8(p.mla_w_dkv, (unsigned char*)p.Wt_cat + (size_t)384 * D, D, 320, mt, ms);
      cvt_t8(p.mla_w_uq, (unsigned char*)p.Wt_uq, 384, 1536, mt, ms);
      cvt_t8(p.mla_w_ukv, (unsigned char*)p.Wt_ukv, 256, 2048, mt, ms);
      cvt_plain(p.peer_keys, p.Khi, (size_t)2 * 131072 / 8, false, mt, ms);
      cvt_rows_i8<true>(p.peer_u, p.U0, p.SU0, 16384, mw, nmw);
      cvt_rows_q6(p.peer_v, p.V0, p.SV0, 16384, mw, nmw);
      cvt_rows_i8<true>(p.peer_u + TD, p.U1, p.SU1, 16384, mw, nmw);
      cvt_rows_q6(p.peer_v + TD, p.V1, p.SV1, 16384, mw, nmw);
    } else {
      int cgen = 0;
      const int ct = t0 - 128;
      ph_s5_prep(p.s5_a_re, p.s5_a_im, p.s5_log_dt, p.s5_b_re, p.s5_b_im, p.s5_c_re, p.s5_c_im, p.Ktab, p.Bst_t, p.Cin_t, bid >> 2, bid & 3, lds, ct, 384, cbc, cgen);
      cbar(cbc, cgen, 6);
      mod_item(p.c, p.c_ctx, p.ada_w, p.ada_b, p.MOD, bid, bid < 192, lds, ct, 384, cbc, cgen);
    }
  }
  grid.sync();
  asm volatile("" : "+s"(bid));
  ph_s5_p1(p.x, p.ctx, mod0, p.Ktab, p.Bst_t, p.s5_d, p.Ypart, p.Ssta, bid, lds);
  gbar(p.BAR + 16 + (bid >> 2) * 16, 4u);
  asm volatile("" : "+s"(bid));
  if (otid() < 64) ph_s5_carry(p.Ssta, p.s5_a_re, p.s5_a_im, p.s5_log_dt, p.HP, ((bid & 2) << 6) | ((bid >> 2) << 1) | (bid & 1), otid());
  gbar(p.BAR + 16 + (bid >> 2) * 16, 8u);
  asm volatile("" : "+s"(bid));
  ph_s5_p3(p.HP, p.Cin_t, p.Ypart, p.Gbf, bid, lds);
  gbar(p.BAR, 1u * (unsigned)nblk);
  asm volatile("" : "+s"(bid));
  {
    ChainP cp{p.Gbf, p.Wt_glu, p.Wt_o0, p.Wt_q0, p.Vbf, (bf16_t*)p.OQ + (size_t)bid * 66 * D, p.x, p.ctx, mod0, p.ln_g, p.ln_b, p.H1, p.Tbf, (bf16_t*)p.OQ + (size_t)bid * 66 * D  };
    ph_chainA<true>(cp, bid, lds);
    __syncthreads();
    ph_route(RouteP{(bf16_t*)p.OQ + (size_t)bid * 66 * D, p.Khi, p.IDX, p.GATE, 66, 0}, bid, lds);
    __syncthreads();
    GatherP gp{p.Tbf, p.IDX, p.GATE, p.U0, p.V0, p.SU0, p.SV0, p.H1, mod0, p.ln_g + D, p.ln_b + D, p.H2, mod1};
    ph_gather_tm<false>(gp, bid * 66, 66, lds, p.PART + (size_t)bid * 8 * PARTW);
    __syncthreads();
    ProjP pp{p.Wt_cat, p.Wt_uq, p.Wt_ukv, p.mla_q_norm, p.mla_kv_norm, p.OQ  , p.Qa, p.Kn, p.Kr, p.Va};
    ph_mla_proj(pp, bid, lds);
  }
  gbar(p.BAR, 2u * (unsigned)nblk);
  asm volatile("" : "+s"(bid));
  ph_attn(p.Qa, p.Kn, p.Kr, p.Va, p.AObf, bid, nblk, lds);
  gbar(p.BAR, 3u * (unsigned)nblk);
  asm volatile("" : "+s"(bid));
  {
    ChainP cp{p.AObf, nullptr, p.Wt_o1, p.Wt_q1, nullptr, (bf16_t*)p.OQ + (size_t)bid * 64 * D, p.H2, p.H2 + (size_t)NL * D, mod1, p.ln_g + 2 * D, p.ln_b + 2 * D, p.H3, p.Tbf1, (bf16_t*)p.OQ + (size_t)bid * 64 * D};
    ph_chainA<false>(cp, bid, lds);
    __syncthreads();
    ph_route(RouteP{(bf16_t*)p.OQ + (size_t)bid * 64 * D, p.Khi1, p.IDX, p.GATE, 64, 0}, bid, lds);
    __syncthreads();
    GatherP gp{p.Tbf1, p.IDX, p.GATE, p.U1, p.V1, p.SU1, p.SV1, p.H3, mod1, p.ln_g + 3 * D, p.ln_b + 3 * D, p.out, mod1};
    ph_gather_tm<true>(gp, bid * 64, 64, lds, p.PART + (size_t)bid * 8 * PARTW);
  }
}

extern "C" void kernel_launch(void* const* d_in, const int* in_sizes, int n_in, void* d_out, int out_size, void* d_ws, size_t ws_size, hipStream_t stream) {
  MP p{};
  const float** in = (const float**)&p;
  for (int i = 0; i < 29; ++i) in[i] = (const float*)d_in[i];
  p.out = (float*)d_out;
  char* ws = (char*)d_ws; size_t off = 0;
  auto carve = [&](size_t bytes) { char* q = ws + off; off += (bytes + 255) / 256 * 256; return q; };
  const size_t TDB = (size_t)1024 * 16384 * 2, BIG = (size_t)NT * D * 4, HALF = (size_t)NT * D * 2;
  p.MOD = (float*)carve(2 * 3 * 6144 * 4);
  p.Wt_glu = (bf16_t*)carve((size_t)D * D * 2); p.Wt_o0 = (bf16_t*)carve((size_t)D * D * 2); p.Wt_q0 = (bf16_t*)carve((size_t)D * D * 2);
  p.Wt_o1 = (bf16_t*)carve((size_t)D * D * 2); p.Wt_q1 = (bf16_t*)carve((size_t)D * D * 2);
  p.Wt_cat = (bf16_t*)carve((size_t)704 * D * 2); p.Wt_uq = (bf16_t*)carve((size_t)1536 * 384 * 2); p.Wt_ukv = (bf16_t*)carve((size_t)2048 * 256 * 2);
  p.Khi = (bf16_t*)carve((size_t)2 * 131072 * 2); p.Khi1 = p.Khi + 131072;
  char* T0 = carve(TDB); p.U0 = (unsigned char*)T0; p.V0 = (unsigned char*)(T0 + TDB / 2); p.AObf = (bf16_t*)T0;
  p.SU0 = (float*)carve(16384 * 4); p.SV0 = (float*)carve(16384 * 4); p.SU1 = (float*)carve(16384 * 4); p.SV1 = (float*)carve(16384 * 4);
  const size_t KTAB_B = (size_t)64 * 127 * 256 * 2, BST_B = (size_t)64 * 256 * 1024 * 2, KN_B = (size_t)NB * 8 * KEYS * 128 * 2, KR_B = (size_t)NB * KEYS * 64 * 2;
  size_t x1 = KTAB_B + 2 * BST_B; if (x1 < 2 * KN_B + KR_B) x1 = 2 * KN_B + KR_B;
  char* X1 = carve(x1);
  p.Ktab = (bf16_t*)X1; p.Bst_t = (bf16_t*)(X1 + KTAB_B); p.Cin_t = (bf16_t*)(X1 + KTAB_B + BST_B);
  p.Kn = (unsigned char*)X1; p.Va = (unsigned char*)(X1 + KN_B); p.Kr = (unsigned char*)(X1 + 2 * KN_B); p.H3 = (float*)X1;
  char* X2 = carve(BIG); p.Ypart = (bf16_t*)X2; p.OQ = (float*)X2;
  char* X3 = carve(HALF); p.Ssta = (float*)X3; p.HP = (bf16_t*)(X3 + (size_t)NCC * 64 * 256 * 4); p.Vbf = (bf16_t*)X3;
  char* X4 = carve(HALF); p.Gbf = (bf16_t*)X4; p.Tbf = (bf16_t*)X4; p.Tbf1 = (bf16_t*)X4;
  char* X5 = carve(BIG); p.H1 = (float*)X5;
  char* T1 = carve(TDB); p.U1 = (unsigned char*)T1; p.V1 = (unsigned char*)(T1 + TDB / 2);
  p.H2 = (float*)carve(BIG);
  p.IDX = (int*)carve((size_t)NT * 128 * 4); p.GATE = (float*)carve((size_t)NT * 128 * 4);
  p.Qa = (bf16_t*)carve((size_t)NB * 8 * SEQ * 192 * 2);
  p.BAR = (unsigned*)carve(8192);
  p.PART = (float*)carve((size_t)256 * 8 * PARTW * 4);
  if (off > ws_size || n_in != 29) { fprintf(stderr, "kernel_launch: workspace too small (need %zu, have %zu) or n_in %d != 29\n", off, ws_size, n_in); return; }
  static int grid_blocks = 0;
  if (!grid_blocks) {
    int dev = 0, cus = 0, per_cu = 0;
    hipGetDevice(&dev);
    hipDeviceGetAttribute(&cus, hipDeviceAttributeMultiprocessorCount, dev);
    hipOccupancyMaxActiveBlocksPerMultiprocessor(&per_cu, mega, 512, 0);
    if (per_cu < 1 || cus < 256) { fprintf(stderr, "kernel_launch: need 256 resident workgroups (cus %d, per_cu %d)\n", cus, per_cu); return; }
    grid_blocks = 256;
  }
  hipMemsetAsync(p.BAR, 0, 8192, stream);
  void* args[] = {&p};
  hipError_t e = hipLaunchCooperativeKernel((void*)mega, dim3(grid_blocks), dim3(512), args, 0, stream);
  if (e != hipSuccess) fprintf(stderr, "cooperative launch failed: %s\n", hipGetErrorString(e));
}
```

```cpp
#include <hip/hip_runtime.h>
#include <math.h>
#include <hip/hip_cooperative_groups.h>
#include <cstdio>
namespace cg = cooperative_groups;
__device__ __forceinline__ int otid() { int t = (int)__builtin_amdgcn_workitem_id_x(); asm volatile("" : "+v"(t)); return t; }

constexpr int D = 1024, NB = 2, SEQ = 8192, CTX = 256;
constexpr int NL = NB * SEQ, NC = NB * CTX, NT = NL + NC;
constexpr float ALPHA = 1.4142135623730951f;
constexpr float LN_EPS = 1e-5f, RMS_EPS = 1e-6f;

__device__ __forceinline__ float wave_sum_dpp(float v) {
  v += __uint_as_float(__builtin_amdgcn_update_dpp(0u, __float_as_uint(v), 0xB1, 0xF, 0xF, true));
  v += __uint_as_float(__builtin_amdgcn_update_dpp(0u, __float_as_uint(v), 0x4E, 0xF, 0xF, true));
  v += __uint_as_float(__builtin_amdgcn_update_dpp(0u, __float_as_uint(v), 0x141, 0xF, 0xF, true));
  v += __uint_as_float(__builtin_amdgcn_update_dpp(0u, __float_as_uint(v), 0x140, 0xF, 0xF, true));
  v += __uint_as_float(__builtin_amdgcn_update_dpp(0u, __float_as_uint(v), 0x142, 0xA, 0xF, true));
  v += __uint_as_float(__builtin_amdgcn_update_dpp(0u, __float_as_uint(v), 0x143, 0xC, 0xF, true));
  return __uint_as_float((unsigned)__builtin_amdgcn_readlane((int)__float_as_uint(v), 63));
}
__device__ __forceinline__ float wave_sum(float v) { return wave_sum_dpp(v); }
__device__ __forceinline__ float wave_max_dpp(float v) {
  v = fmaxf(v, __uint_as_float(__builtin_amdgcn_update_dpp(0u, __float_as_uint(v), 0xB1, 0xF, 0xF, true)));
  v = fmaxf(v, __uint_as_float(__builtin_amdgcn_update_dpp(0u, __float_as_uint(v), 0x4E, 0xF, 0xF, true)));
  v = fmaxf(v, __uint_as_float(__builtin_amdgcn_update_dpp(0u, __float_as_uint(v), 0x141, 0xF, 0xF, true)));
  v = fmaxf(v, __uint_as_float(__builtin_amdgcn_update_dpp(0u, __float_as_uint(v), 0x140, 0xF, 0xF, true)));
  v = fmaxf(v, __uint_as_float(__builtin_amdgcn_update_dpp(0u, __float_as_uint(v), 0x142, 0xA, 0xF, true)));
  v = fmaxf(v, __uint_as_float(__builtin_amdgcn_update_dpp(0u, __float_as_uint(v), 0x143, 0xC, 0xF, true)));
  return __uint_as_float((unsigned)__builtin_amdgcn_readlane((int)__float_as_uint(v), 63));
}
__device__ __forceinline__ int row_vec(int row) { return row < NL ? (row >> 13) : 2; }
__device__ __forceinline__ float gelu_exact(float x) { return 0.5f * x * (1.f + erff(x * 0.70710678118654752f)); }
__device__ __forceinline__ float gelu_fast(float x) {
  const float z = fabsf(x) * 0.70710678118654752f;
  const float t = __builtin_amdgcn_rcpf(fmaf(0.3275911f, z, 1.f));
  float pl = fmaf(1.061405429f, t, -1.453152027f); pl = fmaf(pl, t, 1.421413741f); pl = fmaf(pl, t, -0.284496736f); pl = fmaf(pl, t, 0.254829592f);
  const float e = __builtin_amdgcn_exp2f(-z * z * 1.4426950408889634f);
  const float erfa = 1.f - pl * t * e;
  const float hx = 0.5f * x;
  return hx + fabsf(hx) * erfa;
}


typedef unsigned short bf16_t;
using bf16x8 = __attribute__((ext_vector_type(8))) short;
using f32x4 = __attribute__((ext_vector_type(4))) float;
__device__ __forceinline__ bf16_t f2bf(float f) { unsigned u = __float_as_uint(f); u += 0x7FFFu + ((u >> 16) & 1u); return (bf16_t)(u >> 16); }
__device__ __forceinline__ unsigned char f2fp8(float v) { return (unsigned char)(__builtin_amdgcn_cvt_pk_fp8_f32(v, v, 0, false) & 0xFF); }
__device__ __forceinline__ float bf2f(bf16_t h) { return __uint_as_float(((unsigned)h) << 16); }
__device__ __forceinline__ unsigned pack2bf(float lo, float hi) { return (unsigned)f2bf(lo) | ((unsigned)f2bf(hi) << 16); }
__device__ __forceinline__ float bflo(unsigned w) { return __uint_as_float(w << 16); }
__device__ __forceinline__ float bfhi(unsigned w) { return __uint_as_float(w & 0xFFFF0000u); }


constexpr int LDA_B = 1024 * 2 + 16;
template <int RT, int K>
__device__ __forceinline__ void gemm_unit(const char* const (&ap)[RT], const bf16_t* __restrict__ w0, const bf16_t* __restrict__ w1, int kmul, f32x4 (&acc)[RT][2]) {
  constexpr int KI = K / 128, NS = 2;
#pragma unroll
  for (int t = 0; t < RT; ++t) { acc[t][0] = f32x4{0.f, 0.f, 0.f, 0.f}; acc[t][1] = f32x4{0.f, 0.f, 0.f, 0.f}; }
  bf16x8 b[NS][4][2];
#pragma unroll
  for (int st = 0; st < NS - 1; ++st) {
    if (st < KI) {
#pragma unroll
      for (int s2 = 0; s2 < 4; ++s2) { b[st][s2][0] = *(const bf16x8*)(w0 + (st * 128 + s2 * 32) * kmul); b[st][s2][1] = *(const bf16x8*)(w1 + (st * 128 + s2 * 32) * kmul); }
    }
  }
  asm volatile("" ::: "memory");
  bf16x8 an[RT];
#pragma unroll
  for (int t = 0; t < RT; ++t) an[t] = *(const bf16x8*)(ap[t]);
#pragma unroll
  for (int it = 0; it < KI; ++it) {
    if (it + NS - 1 < KI) {
#pragma unroll
      for (int s2 = 0; s2 < 4; ++s2) {
        b[(it + NS - 1) % NS][s2][0] = *(const bf16x8*)(w0 + ((it + NS - 1) * 128 + s2 * 32) * kmul);
        b[(it + NS - 1) % NS][s2][1] = *(const bf16x8*)(w1 + ((it + NS - 1) * 128 + s2 * 32) * kmul);
      }
    }
    asm volatile("" ::: "memory");
#pragma unroll
    for (int s2 = 0; s2 < 4; ++s2) {
      bf16x8 ac[RT];
#pragma unroll
      for (int t = 0; t < RT; ++t) ac[t] = an[t];
      if (it * 4 + s2 + 1 < KI * 4) {
#pragma unroll
        for (int t = 0; t < RT; ++t) an[t] = *(const bf16x8*)(ap[t] + (it * 128 + s2 * 32 + 32) * 2);
      }
#pragma unroll
      for (int t = 0; t < RT; ++t) {
        acc[t][0] = __builtin_amdgcn_mfma_f32_16x16x32_bf16(ac[t], b[it % NS][s2][0], acc[t][0], 0, 0, 0);
        acc[t][1] = __builtin_amdgcn_mfma_f32_16x16x32_bf16(ac[t], b[it % NS][s2][1], acc[t][1], 0, 0, 0);
      }
    }
  }
}
typedef __bf16 bf16raw2 __attribute__((ext_vector_type(2)));
__device__ __forceinline__ bf16x8 w8_frag(unsigned lo, unsigned hi) {
  const bf16raw2 e0 = __builtin_amdgcn_cvt_scalef32_pk_bf16_fp8(lo, 0.03125f, false), e1 = __builtin_amdgcn_cvt_scalef32_pk_bf16_fp8(lo, 0.03125f, true);
  const bf16raw2 e2 = __builtin_amdgcn_cvt_scalef32_pk_bf16_fp8(hi, 0.03125f, false), e3 = __builtin_amdgcn_cvt_scalef32_pk_bf16_fp8(hi, 0.03125f, true);
  uint4 w; w.x = *(const unsigned*)&e0; w.y = *(const unsigned*)&e1; w.z = *(const unsigned*)&e2; w.w = *(const unsigned*)&e3;
  return *(const bf16x8*)&w;
}
template <int RT, int K>
__device__ __forceinline__ void gemm_unit8(const char* const (&ap)[RT], const unsigned char* __restrict__ w0, const unsigned char* __restrict__ w1, f32x4 (&acc)[RT][2]) {
  constexpr int KI = K / 128, NS = 2;
#pragma unroll
  for (int t = 0; t < RT; ++t) { acc[t][0] = f32x4{0.f, 0.f, 0.f, 0.f}; acc[t][1] = f32x4{0.f, 0.f, 0.f, 0.f}; }
  uint4 b[NS][2][2];
#pragma unroll
  for (int st = 0; st < NS - 1; ++st) {
    if (st < KI) {
#pragma unroll
      for (int pr = 0; pr < 2; ++pr) { b[st][pr][0] = *(const uint4*)(w0 + (st * 2 + pr) * 1024); b[st][pr][1] = *(const uint4*)(w1 + (st * 2 + pr) * 1024); }
    }
  }
  asm volatile("" ::: "memory");
  bf16x8 an[RT];
#pragma unroll
  for (int t = 0; t < RT; ++t) an[t] = *(const bf16x8*)(ap[t]);
#pragma unroll
  for (int it = 0; it < KI; ++it) {
    if (it + NS - 1 < KI) {
#pragma unroll
      for (int pr = 0; pr < 2; ++pr) {
        b[(it + NS - 1) % NS][pr][0] = *(const uint4*)(w0 + ((it + NS - 1) * 2 + pr) * 1024);
        b[(it + NS - 1) % NS][pr][1] = *(const uint4*)(w1 + ((it + NS - 1) * 2 + pr) * 1024);
      }
    }
    asm volatile("" ::: "memory");
#pragma unroll
    for (int s2 = 0; s2 < 4; ++s2) {
      bf16x8 ac[RT];
#pragma unroll
      for (int t = 0; t < RT; ++t) ac[t] = an[t];
      if (it * 4 + s2 + 1 < KI * 4) {
#pragma unroll
        for (int t = 0; t < RT; ++t) an[t] = *(const bf16x8*)(ap[t] + (it * 128 + s2 * 32 + 32) * 2);
      }
      const uint4 q0 = b[it % NS][s2 >> 1][0], q1 = b[it % NS][s2 >> 1][1];
      const bf16x8 f0 = (s2 & 1) ? w8_frag(q0.z, q0.w) : w8_frag(q0.x, q0.y), f1 = (s2 & 1) ? w8_frag(q1.z, q1.w) : w8_frag(q1.x, q1.y);
#pragma unroll
      for (int t = 0; t < RT; ++t) {
        acc[t][0] = __builtin_amdgcn_mfma_f32_16x16x32_bf16(ac[t], f0, acc[t][0], 0, 0, 0);
        acc[t][1] = __builtin_amdgcn_mfma_f32_16x16x32_bf16(ac[t], f1, acc[t][1], 0, 0, 0);
      }
    }
  }
}
template <int RT, int K, class Epi>
__device__ __forceinline__ void gemm_ldsA8(const char* As, int lda_b, int nrows, const unsigned char* __restrict__ Wt, int N, Epi epi) {
  const int wave = otid() >> 6, lane = otid() & 63, l15 = lane & 15, q = lane >> 4;
  const char* ap[RT];
#pragma unroll
  for (int t = 0; t < RT; ++t) { int r = t * 16 + l15; r = r < nrows ? r : nrows - 1; ap[t] = As + r * lda_b + q * 16; }
#pragma unroll 1
  for (int unit = wave; unit < (N >> 5); unit += 8) {
    const int n0 = unit * 32;
    const unsigned char* w0 = Wt + (size_t)(n0 >> 4) * K * 16 + lane * 16;
    f32x4 acc[RT][2];
    gemm_unit8<RT, K>(ap, w0, w0 + (size_t)K * 16, acc);
#pragma unroll
    for (int t = 0; t < RT; ++t)
#pragma unroll
      for (int j = 0; j < 2; ++j)
#pragma unroll
        for (int r = 0; r < 4; ++r) {
          const int row = t * 16 + q * 4 + r, col = n0 + j * 16 + l15;
          if (row < nrows) epi(row, col, acc[t][j][r]);
        }
  }
}
template <int RT, int K, class Epi>
__device__ __forceinline__ void gemm_ldsA(const char* As, int lda_b, int nrows, const bf16_t* __restrict__ Wt, int N, Epi epi) {
  const int wave = otid() >> 6, lane = otid() & 63, l15 = lane & 15, q = lane >> 4;
  const char* ap[RT];
#pragma unroll
  for (int t = 0; t < RT; ++t) { int r = t * 16 + l15; r = r < nrows ? r : nrows - 1; ap[t] = As + r * lda_b + q * 16; }
#pragma unroll 1
  for (int unit = wave; unit < (N >> 5); unit += 8) {
    const int n0 = unit * 32;
    const bf16_t* w0 = Wt + (size_t)(n0 >> 4) * K * 16 + lane * 8;
    f32x4 acc[RT][2];
    gemm_unit<RT, K>(ap, w0, w0 + (size_t)K * 16, 16, acc);
#pragma unroll
    for (int t = 0; t < RT; ++t)
#pragma unroll
      for (int j = 0; j < 2; ++j)
#pragma unroll
        for (int r = 0; r < 4; ++r) {
          const int row = t * 16 + q * 4 + r, col = n0 + j * 16 + l15;
          if (row < nrows) epi(row, col, acc[t][j][r]);
        }
  }
}
struct EpiBF16 { bf16_t* C; int ldc; __device__ __forceinline__ void operator()(int row, int col, float v) const { C[(size_t)row * ldc + col] = f2bf(v); } };
struct EpiF32 { float* C; int ldc; __device__ __forceinline__ void operator()(int row, int col, float v) const { C[(size_t)row * ldc + col] = v; } };
struct EpiGluL { const char* As; bf16_t* V; __device__ __forceinline__ void operator()(int row, int col, float z) const {
  const float g = bf2f(*(const bf16_t*)(As + row * LDA_B + col * 2)); V[(size_t)row * D + col] = f2bf(g / (1.f + expf(-z))); } };

__device__ __forceinline__ void load_rows_lds(char* As, const bf16_t* __restrict__ src, int nrows) {
  const int t = otid(), total = nrows * 128;
#pragma unroll
  for (int h = 0; h < 2; ++h) {
    uint4 v[9];
#pragma unroll
    for (int k = 0; k < 9; ++k) { int i = t + (h * 9 + k) * 512; i = i < total ? i : total - 1; v[k] = *(const uint4*)(src + (size_t)(i >> 7) * D + (i & 127) * 8); }
#pragma unroll
    for (int k = 0; k < 9; ++k) { const int i = t + (h * 9 + k) * 512; if (i < total) *(uint4*)(As + (i >> 7) * LDA_B + (i & 127) * 16) = v[k]; }
  }
}
__device__ __forceinline__ void ln_rows(char* As, int g0, int nrows, const float* Hl, const float* Hc, const bf16_t* __restrict__ O,
                                        const float* __restrict__ mod, int gate_i, const float* __restrict__ lng, const float* __restrict__ lnb,
                                        float* Hout, bf16_t* __restrict__ Tbf, int shift_i, int scale_i) {
  const int wave = otid() >> 6, lane = otid() & 63;
  for (int rr = wave; rr < nrows; rr += 8) {
    const int row = g0 + rr;
    const float* hin = row < NL ? Hl + (size_t)row * D : Hc + (size_t)(row - NL) * D;
    const bf16_t* f = O + (size_t)row * D;
    const float* m = mod + row_vec(row) * 6144;
    const float* gm = m + gate_i * 1024;
    float r[16]; float s = 0.f;
#pragma unroll
    for (int i = 0; i < 4; ++i) {
      const int d = i * 256 + lane * 4;
      const uint2 fw = *(const uint2*)(f + d);
      float4 h4 = *(const float4*)(hin + d), f4 = make_float4(bflo(fw.x), bfhi(fw.x), bflo(fw.y), bfhi(fw.y)), g4 = *(const float4*)(gm + d);
      r[i * 4 + 0] = ALPHA * h4.x + g4.x * f4.x; r[i * 4 + 1] = ALPHA * h4.y + g4.y * f4.y;
      r[i * 4 + 2] = ALPHA * h4.z + g4.z * f4.z; r[i * 4 + 3] = ALPHA * h4.w + g4.w * f4.w;
      s += r[i * 4 + 0] + r[i * 4 + 1] + r[i * 4 + 2] + r[i * 4 + 3];
    }
    const float mu = wave_sum(s) * (1.f / D);
    float vs = 0.f;
#pragma unroll
    for (int i = 0; i < 16; ++i) { float dlt = r[i] - mu; vs += dlt * dlt; }
    const float rstd = rsqrtf(wave_sum(vs) * (1.f / D) + LN_EPS);
#pragma unroll
    for (int i = 0; i < 4; ++i) {
      const int d = i * 256 + lane * 4;
      float4 g4 = *(const float4*)(lng + d), b4 = *(const float4*)(lnb + d);
      float4 o;
      o.x = (r[i * 4 + 0] - mu) * rstd * g4.x + b4.x; o.y = (r[i * 4 + 1] - mu) * rstd * g4.y + b4.y;
      o.z = (r[i * 4 + 2] - mu) * rstd * g4.z + b4.z; o.w = (r[i * 4 + 3] - mu) * rstd * g4.w + b4.w;
      *(float4*)(Hout + (size_t)row * D + d) = o;
      float4 sh = *(const float4*)(m + shift_i * 1024 + d), sc = *(const float4*)(m + scale_i * 1024 + d);
      const float t0 = o.x * (1.f + sc.x) + sh.x, t1 = o.y * (1.f + sc.y) + sh.y, t2 = o.z * (1.f + sc.z) + sh.z, t3 = o.w * (1.f + sc.w) + sh.w;
      uint2 w; w.x = pack2bf(t0, t1); w.y = pack2bf(t2, t3);
      *(uint2*)(As + rr * LDA_B + d * 2) = w;
      *(uint2*)(Tbf + (size_t)row * D + d) = w;

    }
  }
}


constexpr int S5T = 64, NCHUNK = (CTX + SEQ) / S5T  , NCC = NB * NCHUNK  ;
__device__ __forceinline__ int s5_token(int cc, int s) {
  const int b = cc / NCHUNK, ch = cc - b * NCHUNK;
  return ch < 4 ? NL + b * CTX + ch * S5T + s : b * SEQ + (ch - 4) * S5T + s;
}
__device__ __forceinline__ void cbar(volatile int* cnt, int& gen, int nwaves) {
  __builtin_amdgcn_fence(__ATOMIC_RELEASE, "workgroup");
  if ((otid() & 63) == 0) __hip_atomic_fetch_add((int*)cnt, 1, __ATOMIC_RELAXED, __HIP_MEMORY_SCOPE_WORKGROUP);
  ++gen;
  while (__hip_atomic_load((int*)cnt, __ATOMIC_RELAXED, __HIP_MEMORY_SCOPE_WORKGROUP) < gen * nwaves) __builtin_amdgcn_s_sleep(1);
  __builtin_amdgcn_fence(__ATOMIC_ACQUIRE, "workgroup");
}
__device__ __forceinline__ void ph_s5_prep(const float* __restrict__ a_re, const float* __restrict__ a_im, const float* __restrict__ log_dt,
                                                 const float* __restrict__ b_re, const float* __restrict__ b_im, const float* __restrict__ c_re, const float* __restrict__ c_im,
                                                 bf16_t* __restrict__ Ktab, bf16_t* __restrict__ Bst_t, bf16_t* __restrict__ Cin_t, int g, int part, char* lds, int tid, int nct, volatile int* cbc, int& cgen) {
  float2 (*pw)[65][64] = reinterpret_cast<float2 (*)[65][64]>(lds);
  float2 (*Bp)[64][16] = reinterpret_cast<float2 (*)[64][16]>(lds + 2 * 65 * 64 * 8);
  float2 (*Cc)[16][64] = reinterpret_cast<float2 (*)[16][64]>(lds + 2 * 65 * 64 * 8 + 2 * 64 * 16 * 8);
  float2 (*fs)[64] = reinterpret_cast<float2 (*)[64]>(lds + 2 * 65 * 64 * 8 + 2 * 64 * 16 * 8 + 2 * 16 * 64 * 8);
  if (tid < 128) {
    const int dir = tid >> 6, p = tid & 63, gp = (dir * 64 + g) * 64 + p;
    const float are = a_re[gp], aim = a_im[gp], dt = expf(log_dt[dir * 64 + g]);
    const float mag = expf(are * dt);
    const float abr = mag * cosf(aim * dt), abi = mag * sinf(aim * dt);
    const float nr = abr - 1.f, ni = abi, den = are * are + aim * aim;
    fs[dir][p] = make_float2((nr * are + ni * aim) / den, (ni * are - nr * aim) / den);
    float pr = 1.f, pi = 0.f;
    for (int e = 0; e <= 64; ++e) { pw[dir][e][p] = make_float2(pr, pi); const float nr2 = pr * abr - pi * abi, ni2 = pr * abi + pi * abr; pr = nr2; pi = ni2; }
  }
  cbar(cbc, cgen, nct >> 6);
  for (int i = tid; i < 2048; i += nct) {
    const int dir = i >> 10, p = (i >> 4) & 63, ci = i & 15;
    const size_t gi = ((size_t)(dir * 64 + g) * 64 + p) * 16 + ci;
    const float br = b_re[gi], bi = b_im[gi]; const float2 f = fs[dir][p];
    Bp[dir][p][ci] = make_float2(f.x * br - f.y * bi, f.x * bi + f.y * br);
    const int co = (i >> 6) & 15, p2 = i & 63;
    const size_t ci2 = ((size_t)(dir * 64 + g) * 16 + co) * 64 + p2;
    Cc[dir][co][p2] = make_float2(c_re[ci2], c_im[ci2]);
  }
  cbar(cbc, cgen, nct >> 6);
  for (int i = part * 508 + tid; i < (part + 1) * 508; i += nct) {
    const int ti = i >> 4, co = i & 15, tau = ti - 63;
    float acc[16];
#pragma unroll
    for (int ci = 0; ci < 16; ++ci) acc[ci] = 0.f;
    if (tau >= 0) {
      for (int p = 0; p < 64; ++p) {
        const float2 c = Cc[0][co][p], w = pw[0][tau][p];
        const float xr = c.x * w.x - c.y * w.y, xi = c.x * w.y + c.y * w.x;
#pragma unroll
        for (int ci = 0; ci < 16; ++ci) { const float2 bb = Bp[0][p][ci]; acc[ci] += xr * bb.x - xi * bb.y; }
      }
    }
    if (tau <= 0) {
      for (int p = 0; p < 64; ++p) {
        const float2 c = Cc[1][co][p], w = pw[1][-tau][p];
        const float xr = c.x * w.x - c.y * w.y, xi = c.x * w.y + c.y * w.x;
#pragma unroll
        for (int ci = 0; ci < 16; ++ci) { const float2 bb = Bp[1][p][ci]; acc[ci] += xr * bb.x - xi * bb.y; }
      }
    }
    uint4 o0, o1;
    o0.x = pack2bf(acc[0], acc[1]); o0.y = pack2bf(acc[2], acc[3]); o0.z = pack2bf(acc[4], acc[5]); o0.w = pack2bf(acc[6], acc[7]);
    o1.x = pack2bf(acc[8], acc[9]); o1.y = pack2bf(acc[10], acc[11]); o1.z = pack2bf(acc[12], acc[13]); o1.w = pack2bf(acc[14], acc[15]);
    bf16_t* kp = Ktab + (size_t)g * 127 * 256 + (size_t)i * 16;
    *(uint4*)kp = o0; *(uint4*)(kp + 8) = o1;
  }
  for (int i = part * 8192 + tid; i < (part + 1) * 8192; i += nct) {
    const int n = (i >> 11) * 16 + (i & 15), k8 = ((i >> 6) & 31) * 4 + ((i >> 4) & 3);
    const int dir = n >> 7, c = (n >> 6) & 1, p = n & 63, sidx = k8 >> 1, ci0 = (k8 & 1) * 8;
    const float2 w = pw[dir][dir == 0 ? 63 - sidx : sidx][p];
    float v[8];
#pragma unroll
    for (int j = 0; j < 8; ++j) { const float2 b = Bp[dir][p][ci0 + j]; v[j] = c == 0 ? (w.x * b.x - w.y * b.y) : (w.x * b.y + w.y * b.x); }
    uint4 o; o.x = pack2bf(v[0], v[1]); o.y = pack2bf(v[2], v[3]); o.z = pack2bf(v[4], v[5]); o.w = pack2bf(v[6], v[7]);
    *(uint4*)(Bst_t + (size_t)g * 256 * 1024 + (size_t)i * 8) = o;
  }
  for (int i = part * 8192 + tid; i < (part + 1) * 8192; i += nct) {
    const int n = (i >> 9) * 16 + (i & 15), k8 = ((i >> 6) & 7) * 4 + ((i >> 4) & 3);
    const int t = n >> 4, co = n & 15, dir = k8 >> 4, c = (k8 >> 3) & 1, p0 = (k8 & 7) * 8;
    const int e = dir == 0 ? t + 1 : 64 - t;
    float v[8];
#pragma unroll
    for (int j = 0; j < 8; ++j) { const float2 cc = Cc[dir][co][p0 + j], w = pw[dir][e][p0 + j];
      v[j] = c == 0 ? (cc.x * w.x - cc.y * w.y) : -(cc.x * w.y + cc.y * w.x); }
    uint4 o; o.x = pack2bf(v[0], v[1]); o.y = pack2bf(v[2], v[3]); o.z = pack2bf(v[4], v[5]); o.w = pack2bf(v[6], v[7]);
    *(uint4*)(Cin_t + (size_t)g * 1024 * 256 + (size_t)i * 8) = o;
  }
}
__device__ __forceinline__ void ph_s5_p1(const float* __restrict__ x, const float* __restrict__ ctx, const float* __restrict__ mod,
                                               const bf16_t* __restrict__ Ktab, const bf16_t* __restrict__ Bst_t, const float* __restrict__ dvec, bf16_t* __restrict__ Ypart, float* __restrict__ S, int bid, char* As) {
  const int g = bid >> 2, cc0 = (bid & 3) * 66, tid = otid();
  const int wave = tid >> 6, lane = tid & 63, l15 = lane & 15, q = lane >> 4;
  const float dch = dvec[g * 16 + l15];
#pragma unroll 4
  for (int i = tid; i < 66 * 64 * 2; i += 512) {
    const int half = i & 1, sidx = (i >> 1) & 63, r = i >> 7;
    const int tok = s5_token(cc0 + r, sidx), ch = g * 16 + half * 8;
    const float* src = (tok < NL ? x + (size_t)tok * D : ctx + (size_t)(tok - NL) * D) + ch;
    const float* m = mod + row_vec(tok) * 6144;
    const float4 a = *(const float4*)src, b = *(const float4*)(src + 4);
    const float4 sh0 = *(const float4*)(m + ch), sh1 = *(const float4*)(m + ch + 4), sc0 = *(const float4*)(m + 1024 + ch), sc1 = *(const float4*)(m + 1024 + ch + 4);
    uint4 o;
    o.x = pack2bf(a.x * (1.f + sc0.x) + sh0.x, a.y * (1.f + sc0.y) + sh0.y); o.y = pack2bf(a.z * (1.f + sc0.z) + sh0.z, a.w * (1.f + sc0.w) + sh0.w);
    o.z = pack2bf(b.x * (1.f + sc1.x) + sh1.x, b.y * (1.f + sc1.y) + sh1.y); o.w = pack2bf(b.z * (1.f + sc1.z) + sh1.z, b.w * (1.f + sc1.w) + sh1.w);
    *(uint4*)(As + r * LDA_B + sidx * 32 + half * 16) = o;
  }
  __syncthreads();
  const char* ap[5];
#pragma unroll
  for (int t = 0; t < 5; ++t) { int r = t * 16 + l15; r = r < 66 ? r : 65; ap[t] = As + r * LDA_B + q * 16; }
  const bf16_t* Kg = Ktab + (size_t)g * 127 * 256;
#pragma unroll 1
  for (int unit = wave; unit < 40; unit += 8) {
    f32x4 acc[5][2];
    if (unit < 32) {
      const int t0 = unit * 2;
      const bf16_t* w0 = Kg + (t0 + 63 - (q >> 1)) * 256 + l15 * 16 + (q & 1) * 8;
      gemm_unit<5, 1024>(ap, w0, w0 + 256, -16, acc);
#pragma unroll
      for (int t = 0; t < 5; ++t)
#pragma unroll
        for (int j = 0; j < 2; ++j)
#pragma unroll
          for (int r = 0; r < 4; ++r) {
            const int row = t * 16 + q * 4 + r;
            if (row < 66) Ypart[(size_t)s5_token(cc0 + row, t0 + j) * D + g * 16 + l15] = f2bf(acc[t][j][r] + dch * bf2f(*(const bf16_t*)(As + row * LDA_B + (t0 + j) * 32 + l15 * 2)));
          }
    } else {
      const int n0 = (unit - 32) * 32;
      const bf16_t* w0 = Bst_t + (size_t)g * 256 * 1024 + (size_t)(n0 >> 4) * 1024 * 16 + lane * 8;
      gemm_unit<5, 1024>(ap, w0, w0 + 1024 * 16, 16, acc);
#pragma unroll
      for (int t = 0; t < 5; ++t)
#pragma unroll
        for (int j = 0; j < 2; ++j)
#pragma unroll
          for (int r = 0; r < 4; ++r) {
            const int row = t * 16 + q * 4 + r;
            if (row < 66) S[((size_t)(cc0 + row) * 64 + g) * 256 + n0 + j * 16 + l15] = acc[t][j][r];
          }
    }
  }
}
__device__ __forceinline__ void ph_s5_carry(const float* __restrict__ S, const float* __restrict__ a_re, const float* __restrict__ a_im,
                                                 const float* __restrict__ log_dt, bf16_t* __restrict__ HP, int id, int p) {
  const int dir = id & 1, g = (id >> 1) & 63, b = id >> 7;
  const int gp = (dir * 64 + g) * 64 + p;
  const float are = a_re[gp], aim = a_im[gp], dt = expf(log_dt[dir * 64 + g]);
  const float mag = expf(are * dt);
  float tr = mag * cosf(aim * dt), ti = mag * sinf(aim * dt);
#pragma unroll
  for (int i = 0; i < 6; ++i) { const float nr = tr * tr - ti * ti, ni = 2.f * tr * ti; tr = nr; ti = ni; }
  float hr = 0.f, hi = 0.f;
#pragma unroll 12
  for (int step = 0; step < NCHUNK; ++step) {
    const int c = dir == 0 ? step : (step < 4 ? 3 - step : NCHUNK - 1 - (step - 4));
    const size_t base = ((size_t)(b * NCHUNK + c) * 64 + g) * 256 + dir * 128 + p;
    HP[base] = f2bf(hr); HP[base + 64] = f2bf(hi);
    const float sr = S[base], si = S[base + 64];
    const float nr = tr * hr - ti * hi + sr, ni = tr * hi + ti * hr + si;
    hr = nr; hi = ni;
  }
}
struct EpiS5 { const bf16_t* Ypart; bf16_t* Gbf; int cc0; int ch;
  __device__ __forceinline__ void operator()(int row, int col, float v) const {
    const size_t o = (size_t)s5_token(cc0 + row, col >> 4) * D + ch;
    Gbf[o] = f2bf(gelu_fast(v + bf2f(Ypart[o])));
  } };
__device__ __forceinline__ void ph_s5_p3(const bf16_t* __restrict__ HP, const bf16_t* __restrict__ Cin_t, const bf16_t* __restrict__ Ypart, bf16_t* __restrict__ Gbf, int bid, char* As) {
  const int g = bid >> 2, cc0 = (bid & 3) * 66, tid = otid();
  for (int i = tid; i < 66 * 32; i += 512) {
    const int r = i >> 5, c = i & 31;
    *(uint4*)(As + r * 528 + c * 16) = *(const uint4*)(HP + ((size_t)(cc0 + r) * 64 + g) * 256 + c * 8);
  }
  __syncthreads();
  gemm_ldsA<5, 256>(As, 528, 66, Cin_t + (size_t)g * 1024 * 256, 1024, EpiS5{Ypart, Gbf, cc0, g * 16 + (otid() & 15)});
}


struct ChainP {
  const bf16_t* Ain;
  const bf16_t* Wglu_t; const bf16_t* Wo_t; const bf16_t* Wq_t;
  bf16_t* Vbf; bf16_t* O; const float* Hl; const float* Hc; const float* mod; const float* lng; const float* lnb;
  float* Hout; bf16_t* Tbf; bf16_t* Q;
};
template <bool L0>
__device__ __forceinline__ void ph_chainA(const ChainP& p, int bid, char* As) {
  constexpr int NR = L0 ? 66 : 64;
  constexpr int RT = L0 ? 5 : 4;
  const int g0 = bid * NR;
  load_rows_lds(As, p.Ain + (size_t)g0 * D, NR);
  __syncthreads();
  if (L0) {
    gemm_ldsA<RT, 1024>(As, LDA_B, NR, p.Wglu_t, D, EpiGluL{As, p.Vbf + (size_t)g0 * D});
    __syncthreads();
    load_rows_lds(As, p.Vbf + (size_t)g0 * D, NR);
    __syncthreads();
  }
  if constexpr (L0) gemm_ldsA<RT, 1024>(As, LDA_B, NR, p.Wo_t, D, EpiBF16{p.O + (size_t)g0 * D, D});
  else gemm_ldsA8<RT, 1024>(As, LDA_B, NR, (const unsigned char*)p.Wo_t, D, EpiBF16{p.O + (size_t)g0 * D, D});
  __syncthreads();
  ln_rows(As, g0, NR, p.Hl, p.Hc, p.O, p.mod, 2, p.lng, p.lnb, p.Hout, p.Tbf, 3, 4);
  __syncthreads();
  gemm_ldsA<RT, 1024>(As, LDA_B, NR, p.Wq_t, D, EpiBF16{p.Q + (size_t)g0 * D, D});
}


constexpr int KEYS = SEQ + CTX;
constexpr float att_KS = 0.5f;
struct EpiKV { unsigned char* Kn; unsigned char* Vl; int g0; int sh; __device__ __forceinline__ void operator()(int row, int col, float v) const {
  const int head = col >> 8, j = col & 255;
  if (j < 128) {
    const int g = g0 + row; int b, key;
    if (g < NL) { b = g >> 13; key = g & (SEQ - 1); } else { const int cidx = g - NL; b = cidx >> 8; key = SEQ + (cidx & (CTX - 1)); }
    Kn[((size_t)(b * 8 + head) * KEYS + key) * 128 + j] = f2fp8(v * att_KS);
  } else Vl[(head * 128 + (j - 128)) * 68 + row + sh] = f2fp8(v * 4.f);
} };
struct EpiQ { bf16_t* Qa; int g0; int pad; __device__ __forceinline__ void operator()(int row, int col, float v) const {
  const int g = g0 + row, b = g >> 13, n = g & (SEQ - 1);
  const int head = col / 192, j = col - head * 192;
  Qa[((size_t)(b * 8 + head) * SEQ + n) * 192 + j] = f2bf(v);
} };
struct ProjP { const bf16_t* Wcat_t; const bf16_t* Wuq_t; const bf16_t* Wukv_t; const float* q_norm; const float* kv_norm;
               float* PR; bf16_t* Qa; unsigned char* Kn; unsigned char* Kr; unsigned char* Va; };
__device__ __forceinline__ void ph_mla_proj(const ProjP& p, int bid, char* As) {
  const int g0 = bid * 66, wave = otid() >> 6, lane = otid() & 63;
  gemm_ldsA8<5, 1024>(As, LDA_B, 66, (const unsigned char*)p.Wcat_t, 704, EpiF32{p.PR + (size_t)g0 * D, D});
  __syncthreads();
  char* A1 = As; char* A2 = As + 66 * 784;
  for (int rr = wave; rr < 66; rr += 8) {
    const int g = g0 + rr;
    const float* pr = p.PR + (size_t)g * D;
    float v[6]; float ss = 0.f;
#pragma unroll
    for (int i = 0; i < 6; ++i) { v[i] = pr[i * 64 + lane]; ss += v[i] * v[i]; }
    float rn = rsqrtf(wave_sum(ss) * (1.f / 384.f) + RMS_EPS);
#pragma unroll
    for (int i = 0; i < 6; ++i) *(bf16_t*)(A1 + rr * 784 + (i * 64 + lane) * 2) = f2bf(v[i] * rn * p.q_norm[i * 64 + lane]);
    float w[4]; ss = 0.f;
#pragma unroll
    for (int i = 0; i < 4; ++i) { w[i] = pr[384 + i * 64 + lane]; ss += w[i] * w[i]; }
    rn = rsqrtf(wave_sum(ss) * (1.f / 256.f) + RMS_EPS);
#pragma unroll
    for (int i = 0; i < 4; ++i) *(bf16_t*)(A2 + rr * 528 + (i * 64 + lane) * 2) = f2bf(w[i] * rn * p.kv_norm[i * 64 + lane]);
    if (lane < 32) {
      float x1 = pr[640 + lane], x2 = pr[672 + lane];
      int b, key;
      if (g < NL) {
        b = g >> 13; key = g & (SEQ - 1);
        const int n = key, rr2 = n >> 6, cc = n & 63;
        const float inv = powf(10000.f, -(float)(lane & 15) / 16.f);
        const float ang = (lane < 16 ? (float)rr2 : (float)cc) * inv;
        const float cs = cosf(ang), sn = sinf(ang);
        const float y1 = x1 * cs - x2 * sn, y2 = x2 * cs + x1 * sn; x1 = y1; x2 = y2;
      } else { const int cidx = g - NL; b = cidx >> 8; key = SEQ + (cidx & (CTX - 1)); }
      unsigned char* kp = p.Kr + ((size_t)b * KEYS + key) * 64;
      kp[lane] = f2fp8(x1 * att_KS); kp[32 + lane] = f2fp8(x2 * att_KS);
    }
  }
  __syncthreads();
  int nq = NL - g0; nq = nq > 66 ? 66 : nq;
  if (nq > 0) gemm_ldsA8<5, 384>(A1, 784, nq, (const unsigned char*)p.Wuq_t, 1536, EpiQ{p.Qa, g0, 0});
  unsigned char* Vl = (unsigned char*)As + 66 * 784 + 66 * 528;
  const int sh = g0 & 3;
  gemm_ldsA8<5, 256>(A2, 528, 66, (const unsigned char*)p.Wukv_t, 2048, EpiKV{p.Kn, Vl, g0, sh});
  __syncthreads();
  for (int i = otid(); i < 1024 * 17; i += 512) {
    const int dvg = i / 17, q4 = i - dvg * 17, g4 = g0 - sh + 4 * q4;
    const unsigned w = *(const unsigned*)(Vl + dvg * 68 + 4 * q4);
    int b, key;
    if (g4 < NL) { b = g4 >> 13; key = g4 & (SEQ - 1); } else { const int cidx = g4 - NL; b = cidx >> 8; key = SEQ + (cidx & (CTX - 1)); }
    const int m = (key & 63) >> 2, posd = (m & 1) * 8 + (m >> 3) * 4 + ((m >> 1) & 3);
    unsigned char* dst = p.Va + ((size_t)(b * 8 + (dvg >> 7)) * (KEYS / 64) + (key >> 6)) * 8192 + (dvg & 127) * 64 + posd * 4;
    if (g4 >= g0 && g4 + 3 < g0 + 66) *(unsigned*)dst = w;
    else if (g4 < g0) *(unsigned short*)(dst + 2) = (unsigned short)(w >> 16);
    else *(unsigned short*)dst = (unsigned short)(w & 0xFFFFu);
  }
  for (int rr = wave; rr < nq; rr += 8) {
    const int g = g0 + rr, b = g >> 13, n = g & (SEQ - 1);
    if (lane < 32) {
      const float inv = powf(10000.f, -(float)(lane & 15) / 16.f);
      const float ang = (lane < 16 ? (float)(n >> 6) : (float)(n & 63)) * inv;
      const float cs = cosf(ang), sn = sinf(ang);
#pragma unroll
      for (int h = 0; h < 8; ++h) {
        bf16_t* qo = p.Qa + ((size_t)(b * 8 + h) * SEQ + n) * 192;
        const float x1 = bf2f(qo[128 + lane]), x2 = bf2f(qo[160 + lane]);
        qo[128 + lane] = f2bf(x1 * cs - x2 * sn); qo[160 + lane] = f2bf(x2 * cs + x1 * sn);
      }
    }
  }
}

namespace att {
using i32x8 = __attribute__((ext_vector_type(8))) int;
using i32x4 = __attribute__((ext_vector_type(4))) int;
using f32x16 = __attribute__((ext_vector_type(16))) float;
constexpr int KVBLK = 64, KROW = 208, VROW = 80, NTILE = KEYS / 64;
constexpr float KS = 0.5f, VS = 4.f;
constexpr float QS = 0.07216878364870322f * 1.4426950408889634f / KS;
constexpr float THR2 = 3.f * 1.4426950408889634f, PSH = 4.f;
constexpr int SHM_V = 128 * VROW, SHM_K = KVBLK * KROW, NSLOT = 3, SHM_ATTN = NSLOT * (SHM_V + SHM_K) + 8 * 64 * 4;
#define SBAR() __builtin_amdgcn_sched_barrier(0)
__device__ __forceinline__ int crow(int r, int hi) { return (r & 3) + 8 * (r >> 2) + 4 * hi; }
__device__ __forceinline__ f32x16 mfma8(i32x8 a, i32x8 b, f32x16 c) { return __builtin_amdgcn_mfma_scale_f32_32x32x64_f8f6f4(a, b, c, 0, 0, 0, 0, 0, 0); }
__device__ __forceinline__ i32x8 cat8(i32x4 a, i32x4 b) { return __builtin_shufflevector(a, b, 0, 1, 2, 3, 4, 5, 6, 7); }
__device__ __forceinline__ int pk4(float a, float b, float c, float d, int old = 0) { const int w = __builtin_amdgcn_cvt_pk_fp8_f32(a, b, old, false); return __builtin_amdgcn_cvt_pk_fp8_f32(c, d, w, true); }
__device__ __forceinline__ void softmax_tile(f32x16& p0, f32x16& p1, f32x16& bias, bool first, f32x16* o, float* al_l, int r32, int hi, i32x8& pa) {
  float pmax = p0[0];
#pragma unroll
  for (int r = 1; r < 16; ++r) pmax = fmaxf(pmax, p0[r]);
#pragma unroll
  for (int r = 0; r < 16; ++r) pmax = fmaxf(pmax, p1[r]);
  { auto rr = __builtin_amdgcn_permlane32_swap(__float_as_uint(pmax), __float_as_uint(pmax), false, false);
    pmax = fmaxf(__uint_as_float(rr[0]), __uint_as_float(rr[1])); }
  if (__builtin_expect(first || !__all(pmax <= PSH + THR2), 0)) {
    const float delta = first ? pmax - PSH : fmaxf(pmax - PSH, 0.f);
    if (!first) {
      if (hi == 0) al_l[r32] = __builtin_amdgcn_exp2f(-delta);
      asm volatile("s_waitcnt lgkmcnt(0)" ::: "memory");
#pragma unroll
      for (int d = 0; d < 5; ++d)
#pragma unroll
        for (int r = 0; r < 16; ++r) o[d][r] *= al_l[crow(r, hi)];
    }
    const float nb = bias[0] - delta;
#pragma unroll
    for (int r = 0; r < 16; ++r) { p0[r] -= delta; p1[r] -= delta; bias[r] = nb; }
  }
#pragma unroll
  for (int r = 0; r < 16; ++r) p0[r] = __builtin_amdgcn_exp2f(p0[r]);
#pragma unroll
  for (int r = 0; r < 16; ++r) p1[r] = __builtin_amdgcn_exp2f(p1[r]);
#pragma unroll
  for (int w = 0; w < 4; ++w) { pa[w] = pk4(p0[4 * w], p0[4 * w + 1], p0[4 * w + 2], p0[4 * w + 3], pa[w]); pa[4 + w] = pk4(p1[4 * w], p1[4 * w + 1], p1[4 * w + 2], p1[4 * w + 3], pa[4 + w]); }
}
__device__ __forceinline__ void qkt(f32x16& p0, f32x16& p1, const f32x16& bias, const char* Ks, const i32x8* q, int r32, int hi) {
  p0 = bias; p1 = bias;
  const char* k0 = Ks + r32 * KROW + hi * 32; const char* k1 = k0 + 32 * KROW;
#pragma unroll
  for (int s = 0; s < 3; ++s) {
    const i32x8 a0 = cat8(*reinterpret_cast<const i32x4*>(k0 + s * 64), *reinterpret_cast<const i32x4*>(k0 + s * 64 + 16));
    const i32x8 a1 = cat8(*reinterpret_cast<const i32x4*>(k1 + s * 64), *reinterpret_cast<const i32x4*>(k1 + s * 64 + 16));
    p0 = mfma8(a0, q[s], p0);
    p1 = mfma8(a1, q[s], p1); }
}
__device__ __forceinline__ void pv_all(f32x16* o, const char* Vs, i32x8 pa, int r32, int hi) {
  const char* v0 = Vs + r32 * VROW + hi * 32;
#pragma unroll
  for (int d0 = 0; d0 < 4; ++d0) {
    const i32x8 vb = cat8(*reinterpret_cast<const i32x4*>(v0 + d0 * 32 * VROW), *reinterpret_cast<const i32x4*>(v0 + d0 * 32 * VROW + 16));
    o[d0] = mfma8(pa, vb, o[d0]); }
  const i32x8 ones = {0x38383838, 0x38383838, 0x38383838, 0x38383838, 0x38383838, 0x38383838, 0x38383838, 0x38383838};
  o[4] = mfma8(pa, ones, o[4]);
}
__device__ __forceinline__ void attn_body(const bf16_t* __restrict__ Qb, const unsigned char* __restrict__ Kn, const unsigned char* __restrict__ Krb, const unsigned char* __restrict__ Vt,
                                          bf16_t* __restrict__ Ob, char* lds) {
  const int tid = otid(), wid = tid >> 6, lane = tid & 63, r32 = lane & 31, hi = lane >> 5;
  const bool lo4 = __builtin_amdgcn_readfirstlane(wid >> 2) == 0;
  char* V_lds = lds; char* K_lds = lds + NSLOT * SHM_V;
  float* al_l = (float*)(lds + NSLOT * (SHM_V + SHM_K)) + wid * 64;
  f32x16 bias = {}; f32x16 o[5] = {}; i32x8 q[3];
  { const bf16_t* Qw = Qb + (size_t)(wid * 32 + r32) * 192 + hi * 32;
#pragma unroll
    for (int s = 0; s < 3; ++s) {
#pragma unroll
      for (int c = 0; c < 4; ++c) { const uint4 w = *reinterpret_cast<const uint4*>(Qw + s * 64 + c * 8);
        q[s][2 * c] = pk4(bflo(w.x) * QS, bfhi(w.x) * QS, bflo(w.y) * QS, bfhi(w.y) * QS);
        q[s][2 * c + 1] = pk4(bflo(w.z) * QS, bfhi(w.z) * QS, bflo(w.w) * QS, bfhi(w.w) * QS); } } }
  i32x8 ones = {0x38383838, 0x38383838, 0x38383838, 0x38383838, 0x38383838, 0x38383838, 0x38383838, 0x38383838};
  const int vdst = (tid >> 2) * VROW + (tid & 3) * 16, kdst = (tid >> 3) * KROW + (tid & 7) * 16, rdst = (tid >> 2) * KROW + 128 + (tid & 3) * 16;
  const int kfo = r32 * KROW + hi * 32, vfo = r32 * VROW + hi * 32;
  uint4 vs, ks, rs = make_uint4(0u, 0u, 0u, 0u);
#define TLOAD(t) do { ks = *reinterpret_cast<const uint4*>(Kn + (size_t)(t) * 8192 + tid * 16); vs = *reinterpret_cast<const uint4*>(Vt + (size_t)(t) * 8192 + tid * 16); \
    if (lo4) rs = *reinterpret_cast<const uint4*>(Krb + (size_t)(t) * 4096 + tid * 16); } while (0)
#define TWRITE(sl) do { *(uint4*)(K_lds + (sl) * SHM_K + kdst) = ks; *(uint4*)(V_lds + (sl) * SHM_V + vdst) = vs; if (lo4) *(uint4*)(K_lds + (sl) * SHM_K + rdst) = rs; } while (0)
#define SWAIT() asm volatile("s_waitcnt vmcnt(0)" ::: "memory")
#define LD4(p) (*reinterpret_cast<const i32x4*>(p))
  f32x16 p0, p1; i32x8 pa = {};
  TLOAD(0); SWAIT(); TWRITE(0);
  TLOAD(1); SWAIT(); TWRITE(1);
  TLOAD(2);
  __syncthreads();
  int sl = 0, sl2 = 2;
#pragma unroll 1
  for (int i = 0; i < NTILE; ++i) {
    const char* kb = K_lds + sl * SHM_K + kfo; const char* vb = V_lds + sl * SHM_V + vfo;
    SBAR();
    i32x4 ka0 = LD4(kb), ka1 = LD4(kb + 16), ka2 = LD4(kb + 32 * KROW), ka3 = LD4(kb + 32 * KROW + 16);
    i32x4 kb0 = LD4(kb + 64), kb1 = LD4(kb + 80), kb2 = LD4(kb + 32 * KROW + 64), kb3 = LD4(kb + 32 * KROW + 80);
    SBAR();
    p0 = mfma8(cat8(ka0, ka1), q[0], bias); p1 = mfma8(cat8(ka2, ka3), q[0], bias);
    ka0 = LD4(kb + 128); ka1 = LD4(kb + 144); ka2 = LD4(kb + 32 * KROW + 128); ka3 = LD4(kb + 32 * KROW + 144);
    SBAR();
    p0 = mfma8(cat8(kb0, kb1), q[1], p0); p1 = mfma8(cat8(kb2, kb3), q[1], p1);
    i32x4 v00 = LD4(vb), v01 = LD4(vb + 16), v10 = LD4(vb + 32 * VROW), v11 = LD4(vb + 32 * VROW + 16);
    SBAR();
    p0 = mfma8(cat8(ka0, ka1), q[2], p0); p1 = mfma8(cat8(ka2, ka3), q[2], p1);
    SBAR();
    softmax_tile(p0, p1, bias, i == 0, o, al_l, r32, hi, pa);
    SBAR();
    i32x4 v20 = LD4(vb + 64 * VROW), v21 = LD4(vb + 64 * VROW + 16), v30 = LD4(vb + 96 * VROW), v31 = LD4(vb + 96 * VROW + 16);
    o[4] = mfma8(pa, ones, o[4]); o[0] = mfma8(pa, cat8(v00, v01), o[0]); o[1] = mfma8(pa, cat8(v10, v11), o[1]);
    SBAR();
    o[2] = mfma8(pa, cat8(v20, v21), o[2]); o[3] = mfma8(pa, cat8(v30, v31), o[3]);
    SBAR();
    SWAIT();
    if (i + 2 < NTILE) TWRITE(sl2);
    if (i + 3 < NTILE) TLOAD(i + 3);
    sl = sl == NSLOT - 1 ? 0 : sl + 1; sl2 = sl2 == NSLOT - 1 ? 0 : sl2 + 1;
    SBAR(); __syncthreads();
  }
  float rli[16];
#pragma unroll
  for (int r = 0; r < 16; ++r) rli[r] = __builtin_amdgcn_rcpf(o[4][r]) * (1.f / VS);
  bf16_t* Ow = Ob + (size_t)(wid * 32) * D;
#pragma unroll
  for (int r = 0; r < 16; ++r) { const int orow = crow(r, hi);
#pragma unroll
    for (int d0 = 0; d0 < 4; ++d0) Ow[(size_t)orow * D + d0 * 32 + r32] = f2bf(o[d0][r] * rli[r]); }
  __syncthreads();
#undef TLOAD
#undef TWRITE
#undef SWAIT
#undef LD4
}
}

__device__ __forceinline__ void ph_attn(const bf16_t* __restrict__ Qa, const unsigned char* __restrict__ Kn, const unsigned char* __restrict__ Kr, const unsigned char* __restrict__ Vt,
                                        bf16_t* __restrict__ AO, int bid, int nblk, char* lds) {
  for (int item = bid; item < 512; item += nblk) {
    const int b = item >> 8, h = item & 7, qb = (item >> 3) & 31;
    att::attn_body(Qa + ((size_t)(b * 8 + h) * SEQ + qb * 256) * 192, Kn + (size_t)(b * 8 + h) * KEYS * 128, Kr + (size_t)b * KEYS * 64,
                   Vt + (size_t)(b * 8 + h) * KEYS * 128, AO + (size_t)(b * SEQ + qb * 256) * D + h * 128, lds);
  }
}

namespace rt {
using f32x16 = __attribute__((ext_vector_type(16))) float;
__device__ __forceinline__ int sortable(float f) { const int b = __float_as_int(f); return b ^ ((b >> 31) & 0x7FFFFFFF); }
__device__ __forceinline__ float unsortable(int k) { return __int_as_float(k ^ ((k >> 31) & 0x7FFFFFFF)); }
__device__ __forceinline__ int imax(int a, int b) { return a > b ? a : b; }
__device__ __forceinline__ int imin(int a, int b) { return a < b ? a : b; }
template <int N> __device__ __forceinline__ void sort_desc(int (&v)[N]) {
#pragma unroll
  for (int k = 2; k <= N; k <<= 1) {
#pragma unroll
    for (int j = k >> 1; j > 0; j >>= 1) {
#pragma unroll
      for (int i = 0; i < N; ++i) {
        const int l = i ^ j;
        if (l > i) {
          const bool desc = ((i & k) == 0);
          const int a = v[i], b = v[l];
          v[i] = desc ? imax(a, b) : imin(a, b);
          v[l] = desc ? imin(a, b) : imax(a, b);
        }
      }
    }
  }
}
template <int N> __device__ __forceinline__ void merge_desc(int (&v)[N]) {
#pragma unroll
  for (int j = N >> 1; j > 0; j >>= 1) {
#pragma unroll
    for (int i = 0; i < N; ++i) {
      const int l = i ^ j;
      if (l > i) { const int a = v[i], b = v[l]; v[i] = imax(a, b); v[l] = imin(a, b); }
    }
  }
}
__device__ __forceinline__ void absorb16(int (&L)[16], int (&B)[16]) {
  sort_desc<16>(B);
#pragma unroll
  for (int i = 0; i < 16; ++i) L[i] = imax(L[i], B[15 - i]);
  merge_desc<16>(L);
}
__device__ __forceinline__ constexpr int npairs_row(int i) { return 16 / (i + 1); }
}

struct RouteP { const bf16_t* Q; const bf16_t* Khi; int* IDX; float* GATE; int rows_per_block; int pad; };
__device__ __forceinline__ void ph_route(const RouteP& p, int bid, char* lds) {
  using namespace rt;
  int (*svl)[64][33] = reinterpret_cast<int (*)[64][33]>(lds);
  const int wave = otid() >> 6, lane = otid() & 63, r32 = lane & 31, hi = lane >> 5, hi4 = hi * 4;
  int nrows = p.rows_per_block; asm volatile("" : "+s"(nrows));
  const int g0 = bid * nrows;
  const int h = wave;
#pragma unroll 1
  for (int tg = 0; tg * 32 < nrows; ++tg) {
    int trow = tg * 32 + r32; const bool valid = trow < nrows; trow = valid ? trow : nrows - 1;
    const bf16_t* qrow = p.Q + (size_t)(g0 + trow) * D;
    int sv[2][16];
#pragma unroll
    for (int s = 0; s < 2; ++s) {
      const int hs = h * 2 + s;
      f32x16 acc[4];
#pragma unroll
      for (int m = 0; m < 4; ++m) acc[m] = f32x16{};
#pragma unroll
      for (int kp = 0; kp < 2; ++kp) {
        bf16x8 kf[2][4], qf[2];
#pragma unroll
        for (int k2 = 0; k2 < 2; ++k2)
#pragma unroll
          for (int m = 0; m < 4; ++m) kf[k2][m] = *(const bf16x8*)(p.Khi + ((size_t)(hs * 128 + m * 32 + r32)) * 64 + (kp * 2 + k2) * 16 + hi * 8);
#pragma unroll
        for (int k2 = 0; k2 < 2; ++k2) {
          const int ks = kp * 2 + k2;
          qf[k2] = *(const bf16x8*)(qrow + hs * 64 + ks * 16 + hi * 8);
        }
#pragma unroll
        for (int k2 = 0; k2 < 2; ++k2)
#pragma unroll
          for (int m = 0; m < 4; ++m) acc[m] = __builtin_amdgcn_mfma_f32_32x32x16_bf16(kf[k2][m], qf[k2], acc[m], 0, 0, 0);
      }
      int L[16];
#pragma unroll
      for (int m = 0; m < 4; ++m) {
        int B[16];
#pragma unroll
        for (int r = 0; r < 16; ++r) B[r] = (sortable(acc[m][r]) & ~0x7F) | (m * 32 + (r & 3) + 8 * (r >> 2)) | hi4;
        if (m == 0) { sort_desc<16>(B);
#pragma unroll
          for (int i = 0; i < 16; ++i) L[i] = B[i]; }
        else absorb16(L, B);
      }
      int Lo[16], Hi[16];
#pragma unroll
      for (int i = 0; i < 16; ++i) { auto rr = __builtin_amdgcn_permlane32_swap((unsigned)L[i], (unsigned)L[i], false, false); Lo[i] = (int)rr[0]; Hi[i] = (int)rr[1]; }
#pragma unroll
      for (int i = 0; i < 16; ++i) L[i] = imax(Lo[i], Hi[15 - i]);
      merge_desc<16>(L);
#pragma unroll
      for (int i = 0; i < 16; ++i) { sv[s][i] = L[i]; svl[wave][lane][s * 16 + i] = L[i]; }
    }
    float f0[16], f1[16];
#pragma unroll
    for (int i = 0; i < 16; ++i) { f0[i] = unsortable(sv[0][i] & ~0x7F); f1[i] = unsortable(sv[1][i] & ~0x7F); }
    int Lc[16];
    {
      int C[64];
      int n = 0;
#pragma unroll
      for (int i = 0; i < 16; ++i)
#pragma unroll
        for (int j = 0; j < 16; ++j)
          if ((i + 1) * (j + 1) <= 16) { C[n] = (sortable(f0[i] + f1[j]) & ~0xFF) | (i * 16 + j); ++n; }
#pragma unroll
      for (int k = 50; k < 64; ++k) C[k] = (int)0x80000000;
#pragma unroll
      for (int m = 0; m < 4; ++m) {
        int B[16];
#pragma unroll
        for (int r = 0; r < 16; ++r) B[r] = C[m * 16 + r];
        if (m == 0) { sort_desc<16>(B);
#pragma unroll
          for (int i = 0; i < 16; ++i) Lc[i] = B[i]; }
        else absorb16(Lc, B);
      }
    }
    float e[16]; float esum = 0.f;
    const float vmax = unsortable(Lc[0] & ~0xFF);
#pragma unroll
    for (int r = 0; r < 16; ++r) { e[r] = expf(unsortable(Lc[r] & ~0xFF) - vmax); esum += e[r]; }
    const float inv = 1.f / esum;
    int eid[16];
#pragma unroll
    for (int r = 0; r < 16; ++r) {
      const int pr = Lc[r] & 0xFF;
      const int k0 = svl[wave][lane][pr >> 4] & 0x7F, k1 = svl[wave][lane][16 + (pr & 15)] & 0x7F;
      eid[r] = k0 * 128 + k1;
    }
    if (valid && hi == 0) {
      int* ip = p.IDX + (size_t)(g0 + trow) * 128 + h * 16; float* gp = p.GATE + (size_t)(g0 + trow) * 128 + h * 16;
#pragma unroll
      for (int r = 0; r < 16; r += 4) {
        *(int4*)(ip + r) = make_int4(eid[r], eid[r + 1], eid[r + 2], eid[r + 3]);
        *(float4*)(gp + r) = make_float4(e[r] * inv, e[r + 1] * inv, e[r + 2] * inv, e[r + 3] * inv);
      }
    }
  }
}

constexpr int RB = 8;
template <bool SIGNED>
__device__ __forceinline__ void cvt_rows_i8(const float* __restrict__ src, unsigned char* __restrict__ dst, float* __restrict__ scl, int nrows, int wgid, int nw) {
  const int lane = otid() & 63;
  for (int r0 = wgid * RB; r0 < nrows; r0 += nw * RB) {
    float v[RB][16];
#pragma unroll
    for (int u = 0; u < RB; ++u) {
      const float* sp = src + (size_t)(r0 + u) * D + lane * 4;
      *(float4*)&v[u][0] = *(const float4*)sp; *(float4*)&v[u][4] = *(const float4*)(sp + 256); *(float4*)&v[u][8] = *(const float4*)(sp + 512); *(float4*)&v[u][12] = *(const float4*)(sp + 768);
    }
#pragma unroll
    for (int u = 0; u < RB; ++u) {
      float am = 0.f;
#pragma unroll
      for (int j = 0; j < 16; ++j) am = fmaxf(am, fabsf(v[u][j]));
      am = wave_max_dpp(am);
      const float sc = am > 0.f ? am * (1.f / 127.f) : 1.f, inv = 1.f / sc;
      unsigned w[4];
#pragma unroll
      for (int q4 = 0; q4 < 4; ++q4) {
        unsigned ww = 0u;
#pragma unroll
        for (int j = 0; j < 4; ++j) { int qi = (int)rintf(v[u][q4 * 4 + j] * inv) + (SIGNED ? 0 : 128); qi = SIGNED ? (qi < -127 ? -127 : (qi > 127 ? 127 : qi)) : (qi < 1 ? 1 : (qi > 255 ? 255 : qi)); ww |= (unsigned)(qi & 255) << (8 * j); }
        w[q4] = ww;
      }
      *(uint4*)(dst + (size_t)(r0 + u) * D + lane * 16) = make_uint4(w[0], w[1], w[2], w[3]);
      if (lane == 0) scl[r0 + u] = sc;
    }
  }
}

constexpr int QROW = 512;
__device__ __forceinline__ void cvt_rows_q6(const float* __restrict__ src, unsigned char* __restrict__ dst, float* __restrict__ scl, int nrows, int wgid, int nw) {
  const int lane = otid() & 63;
  for (int r0 = wgid * RB; r0 < nrows; r0 += nw * RB) {
    float v[RB][16];
#pragma unroll
    for (int u = 0; u < RB; ++u) {
      const float* sp = src + (size_t)(r0 + u) * D + lane * 4;
      *(float4*)&v[u][0] = *(const float4*)sp; *(float4*)&v[u][4] = *(const float4*)(sp + 256); *(float4*)&v[u][8] = *(const float4*)(sp + 512); *(float4*)&v[u][12] = *(const float4*)(sp + 768);
    }
#pragma unroll
    for (int u = 0; u < RB; ++u) {
      float am = 0.f;
#pragma unroll
      for (int j = 0; j < 16; ++j) am = fmaxf(am, fabsf(v[u][j]));
      am = wave_max_dpp(am);
      const float sc = am > 0.f ? am * (1.f / 7.f) : 1.f, inv = 1.f / sc;
      unsigned w0 = 0u, w1 = 0u;
#pragma unroll
      for (int j = 0; j < 8; ++j) {
        int qa = (int)rintf(v[u][j] * inv) + 8; qa = qa < 1 ? 1 : (qa > 15 ? 15 : qa);
        int qb = (int)rintf(v[u][8 + j] * inv) + 8; qb = qb < 1 ? 1 : (qb > 15 ? 15 : qb);
        w0 |= (unsigned)qa << (4 * j); w1 |= (unsigned)qb << (4 * j);
      }
      *(uint2*)(dst + (size_t)(r0 + u) * QROW + lane * 8) = make_uint2(w0, w1);
      if (lane == 0) scl[r0 + u] = sc;
    }
  }
}
struct q6w { unsigned x, y, z; };
template <int J> __device__ __forceinline__ float q6(const q6w& w) {
  const unsigned x = J < 8 ? w.x : w.y; constexpr int sh = 4 * (J & 7);
  if constexpr (sh == 28) return (float)(x >> 28); else return (float)((x >> sh) & 15u);
}

struct GatherP { const bf16_t* Tbf; const int* IDX; const float* GATE; const unsigned char* utab; const unsigned char* vtab; const float* su; const float* sv;
                 const float* Hin; const float* mod; const float* lng; const float* lnb; float* Hout; const float* modT; };
#define UB0(w) ((float)((w) & 0xFFu))
#define UB1(w) ((float)(((w) >> 8) & 0xFFu))
#define UB2(w) ((float)(((w) >> 16) & 0xFFu))
#define UB3(w) ((float)((w) >> 24))
template <bool FINAL>
__device__ __forceinline__ void ln_token(const GatherP& p, int row, int rr, int lane, const float (&f)[16], float asum, char* As) {
  const int v = row_vec(row);
  const float* hin = p.Hin + (size_t)row * D + lane * 4;
  const float* gm = p.mod + v * 6144 + 5 * 1024 + lane * 4;
  const float off = 8.f * asum;
  float r[16]; float ssum = 0.f;
#pragma unroll
  for (int q4 = 0; q4 < 4; ++q4) {
    const float4 h4 = *(const float4*)(hin + q4 * 256), g4 = *(const float4*)(gm + q4 * 256);
    r[q4 * 4 + 0] = ALPHA * h4.x + g4.x * (f[q4 * 4 + 0] - off); r[q4 * 4 + 1] = ALPHA * h4.y + g4.y * (f[q4 * 4 + 1] - off);
    r[q4 * 4 + 2] = ALPHA * h4.z + g4.z * (f[q4 * 4 + 2] - off); r[q4 * 4 + 3] = ALPHA * h4.w + g4.w * (f[q4 * 4 + 3] - off);
    ssum += r[q4 * 4 + 0] + r[q4 * 4 + 1] + r[q4 * 4 + 2] + r[q4 * 4 + 3];
  }
  const float mu = wave_sum(ssum) * (1.f / D);
  float vs = 0.f;
#pragma unroll
  for (int j = 0; j < 16; ++j) { const float dlt = r[j] - mu; vs += dlt * dlt; }
  const float rstd = rsqrtf(wave_sum(vs) * (1.f / D) + LN_EPS);
  float o[16];
#pragma unroll
  for (int q4 = 0; q4 < 4; ++q4) {
    const float4 g4 = *(const float4*)(p.lng + q4 * 256 + lane * 4), b4 = *(const float4*)(p.lnb + q4 * 256 + lane * 4);
    o[q4 * 4 + 0] = (r[q4 * 4 + 0] - mu) * rstd * g4.x + b4.x; o[q4 * 4 + 1] = (r[q4 * 4 + 1] - mu) * rstd * g4.y + b4.y;
    o[q4 * 4 + 2] = (r[q4 * 4 + 2] - mu) * rstd * g4.z + b4.z; o[q4 * 4 + 3] = (r[q4 * 4 + 3] - mu) * rstd * g4.w + b4.w;
    *(float4*)(p.Hout + (size_t)row * D + q4 * 256 + lane * 4) = make_float4(o[q4 * 4 + 0], o[q4 * 4 + 1], o[q4 * 4 + 2], o[q4 * 4 + 3]);
  }
  if (!FINAL) {
    const float* mt = p.modT + v * 6144 + lane * 4;
#pragma unroll
    for (int q4 = 0; q4 < 4; ++q4) {
      const float4 sh = *(const float4*)(mt + q4 * 256), sc = *(const float4*)(mt + 1024 + q4 * 256);
      uint2 w; w.x = pack2bf(o[q4 * 4] * (1.f + sc.x) + sh.x, o[q4 * 4 + 1] * (1.f + sc.y) + sh.y); w.y = pack2bf(o[q4 * 4 + 2] * (1.f + sc.z) + sh.z, o[q4 * 4 + 3] * (1.f + sc.w) + sh.w);
      *(uint2*)(As + rr * LDA_B + (q4 * 256 + lane * 4) * 2) = w;
    }
  }
}
constexpr int PARTW = 1088;
template <bool FINAL>
__device__ __forceinline__ void ph_gather_tm(const GatherP& p, int g0, int nrows, char* As, float* __restrict__ PART) {
  const int tid = otid(), wave = tid >> 6, lane = tid & 63;
  const int nfull = nrows >> 3, extra = nrows & 7;
  const int nun = nfull + (extra ? 1 : 0);
  typedef unsigned u32x4_t __attribute__((ext_vector_type(4))); typedef unsigned u32x2_t __attribute__((ext_vector_type(2)));
  const __amdgpu_buffer_rsrc_t ursrc = __builtin_amdgcn_make_buffer_rsrc((void*)p.utab, 0, 0x7FFFFFFF, 0x00020000);
  const __amdgpu_buffer_rsrc_t vrsrc = __builtin_amdgcn_make_buffer_rsrc((void*)p.vtab, 0, 0x7FFFFFFF, 0x00020000);
  const int lane16 = lane * 16, lane8 = lane * 8;
  auto desc = [&](int un, int& rr, int& kbeg, int& kcnt, bool& partial) {
    if (un < nfull) { rr = wave + 8 * un; kbeg = 0; kcnt = 128; partial = false; }
    else { const int wpt = 8 / extra; rr = nfull * 8 + wave / wpt; kcnt = 128 / wpt; kbeg = (wave % wpt) * kcnt; partial = true; }
  };
  uint2 nt0, nt1, nt2, nt3; int nid_lo, nid_hi; float nga_lo, nga_hi;
#define NLOAD(row_) do { const bf16_t* tp_ = p.Tbf + (size_t)(row_) * D + lane * 4; nt0 = *(const uint2*)tp_; nt1 = *(const uint2*)(tp_ + 256); nt2 = *(const uint2*)(tp_ + 512); nt3 = *(const uint2*)(tp_ + 768); \
    nid_lo = p.IDX[(size_t)(row_) * 128 + lane]; nid_hi = p.IDX[(size_t)(row_) * 128 + 64 + lane]; nga_lo = p.GATE[(size_t)(row_) * 128 + lane]; nga_hi = p.GATE[(size_t)(row_) * 128 + 64 + lane]; } while (0)
  { int rr0, kb0, kc0; bool pa0; desc(0, rr0, kb0, kc0, pa0); NLOAD(g0 + rr0); }
#pragma unroll 1
  for (int un = 0; un < nun; ++un) {
    int rr, kbeg, kcnt; bool partial;
    desc(un, rr, kbeg, kcnt, partial);
    const int row = g0 + rr;
    float tf[16];
    {
      const uint2 t0 = nt0, t1 = nt1, t2 = nt2, t3 = nt3;
      tf[0] = bflo(t0.x); tf[1] = bfhi(t0.x); tf[2] = bflo(t0.y); tf[3] = bfhi(t0.y); tf[4] = bflo(t1.x); tf[5] = bfhi(t1.x); tf[6] = bflo(t1.y); tf[7] = bfhi(t1.y);
      tf[8] = bflo(t2.x); tf[9] = bfhi(t2.x); tf[10] = bflo(t2.y); tf[11] = bfhi(t2.y); tf[12] = bflo(t3.x); tf[13] = bfhi(t3.x); tf[14] = bflo(t3.y); tf[15] = bfhi(t3.y);
    }
    float tam = 0.f;
#pragma unroll
    for (int j = 0; j < 16; ++j) tam = fmaxf(tam, fabsf(tf[j]));
    tam = wave_max_dpp(tam);
    const float st = tam > 0.f ? tam * (1.f / 127.f) : 1.f, tinv = 1.f / st;
    int tq[4];
#pragma unroll
    for (int k4 = 0; k4 < 4; ++k4) {
      unsigned ww = 0u;
#pragma unroll
      for (int j = 0; j < 4; ++j) ww |= (unsigned)((int)rintf(tf[k4 * 4 + j] * tinv) & 255) << (8 * j);
      tq[k4] = (int)ww;
    }
    const int id_lo = nid_lo, id_hi = nid_hi;
    const float ga_lo = nga_lo, ga_hi = nga_hi;
    const float su_lo = p.su[id_lo], su_hi = p.su[id_hi], sv_lo = p.sv[id_lo], sv_hi = p.sv[id_hi];
    float f[16];
#pragma unroll
    for (int j = 0; j < 16; ++j) f[j] = 0.f;
    uint4 rb[8];
    int dlo = 0, dhi = 0;
#define ULOAD(slot, kk) do { const int e_ = __builtin_amdgcn_readlane((kk) < 64 ? id_lo : id_hi, (kk) & 63); \
      const u32x4_t u_ = __builtin_amdgcn_raw_buffer_load_b128(ursrc, lane16, e_ * D, 0);        \
      rb[slot].x = u_.x; rb[slot].y = u_.y; rb[slot].z = u_.z; rb[slot].w = u_.w; } while (0)
#define VLOAD(slot, kk) do { const int e_ = __builtin_amdgcn_readlane((kk) < 64 ? id_lo : id_hi, (kk) & 63); \
      const u32x2_t t_ = __builtin_amdgcn_raw_buffer_load_b64(vrsrc, lane8, e_ * QROW, 0); rb[slot].x = t_.x; rb[slot].y = t_.y; } while (0)
    auto proc4u = [&](int s0, int k0) {
      int dot[4];
#pragma unroll
      for (int u = 0; u < 4; ++u) {
        const uint4 a_ = rb[s0 + u];
        int di = __builtin_amdgcn_sdot4((int)a_.x, tq[0], 0, false); di = __builtin_amdgcn_sdot4((int)a_.y, tq[1], di, false);
        di = __builtin_amdgcn_sdot4((int)a_.z, tq[2], di, false); di = __builtin_amdgcn_sdot4((int)a_.w, tq[3], di, false);
        dot[u] = di;
      }
#define DPPSTEP(ctl, rm) do { _Pragma("unroll") for (int u = 0; u < 4; ++u) dot[u] += __builtin_amdgcn_update_dpp(0, dot[u], ctl, rm, 0xF, true); } while (0)
      DPPSTEP(0xB1, 0xF); DPPSTEP(0x4E, 0xF); DPPSTEP(0x141, 0xF); DPPSTEP(0x140, 0xF); DPPSTEP(0x142, 0xA); DPPSTEP(0x143, 0xC);
#undef DPPSTEP
      if (k0 < 64) {
#pragma unroll
        for (int u = 0; u < 4; ++u) dlo = __builtin_amdgcn_update_dpp(dot[u], dlo, 0x130, 0xF, 0xF, false);
      } else {
#pragma unroll
        for (int u = 0; u < 4; ++u) dhi = __builtin_amdgcn_update_dpp(dot[u], dhi, 0x130, 0xF, 0xF, false);
      }
    };
    float act_lo = 0.f, act_hi = 0.f;
    auto proc4v = [&](int s0, int k0) {
      float act[4];
      if (k0 < 64) {
#pragma unroll
        for (int u = 0; u < 4; ++u) act[u] = __uint_as_float((unsigned)__builtin_amdgcn_readlane((int)__float_as_uint(act_lo), k0 + u));
      } else {
#pragma unroll
        for (int u = 0; u < 4; ++u) act[u] = __uint_as_float((unsigned)__builtin_amdgcn_readlane((int)__float_as_uint(act_hi), k0 - 64 + u));
      }
#pragma unroll
      for (int u = 0; u < 4; ++u) {
        const float act_ = act[u];
        const q6w c_ = {rb[s0 + u].x, rb[s0 + u].y, rb[s0 + u].z};
        f[0] = fmaf(act_, q6<0>(c_), f[0]); f[1] = fmaf(act_, q6<1>(c_), f[1]); f[2] = fmaf(act_, q6<2>(c_), f[2]); f[3] = fmaf(act_, q6<3>(c_), f[3]);
        f[4] = fmaf(act_, q6<4>(c_), f[4]); f[5] = fmaf(act_, q6<5>(c_), f[5]); f[6] = fmaf(act_, q6<6>(c_), f[6]); f[7] = fmaf(act_, q6<7>(c_), f[7]);
        f[8] = fmaf(act_, q6<8>(c_), f[8]); f[9] = fmaf(act_, q6<9>(c_), f[9]); f[10] = fmaf(act_, q6<10>(c_), f[10]); f[11] = fmaf(act_, q6<11>(c_), f[11]);
        f[12] = fmaf(act_, q6<12>(c_), f[12]); f[13] = fmaf(act_, q6<13>(c_), f[13]); f[14] = fmaf(act_, q6<14>(c_), f[14]); f[15] = fmaf(act_, q6<15>(c_), f[15]);
      }
    };
    ULOAD(0, kbeg); ULOAD(1, kbeg + 1); ULOAD(2, kbeg + 2); ULOAD(3, kbeg + 3); ULOAD(4, kbeg + 4); ULOAD(5, kbeg + 5); ULOAD(6, kbeg + 6); ULOAD(7, kbeg + 7);
    const int kend = kbeg + kcnt - 8;
#pragma unroll 1
    for (int k = kbeg; k < kend; k += 8) {
      proc4u(0, k); ULOAD(0, k + 8); ULOAD(1, k + 9); ULOAD(2, k + 10); ULOAD(3, k + 11);
      proc4u(4, k + 4); ULOAD(4, k + 12); ULOAD(5, k + 13); ULOAD(6, k + 14); ULOAD(7, k + 15);
    }
    proc4u(0, kend); VLOAD(0, kbeg); VLOAD(1, kbeg + 1); VLOAD(2, kbeg + 2); VLOAD(3, kbeg + 3);
    proc4u(4, kend + 4); VLOAD(4, kbeg + 4); VLOAD(5, kbeg + 5); VLOAD(6, kbeg + 6); VLOAD(7, kbeg + 7);
    if (partial) {
      const int srcl = ((lane - (kbeg & 63) + 32) & 63) * 4;
      const int sh_lo = __builtin_amdgcn_ds_bpermute(srcl, dlo), sh_hi = __builtin_amdgcn_ds_bpermute(srcl, dhi);
      const bool in = lane >= (kbeg & 63) && lane < (kbeg & 63) + 32;
      dlo = in ? sh_lo : 0; dhi = in ? sh_hi : 0;
    }
    act_lo = gelu_fast(su_lo * st * (float)dlo) * ga_lo * sv_lo; act_hi = gelu_fast(su_hi * st * (float)dhi) * ga_hi * sv_hi;
    const float asum = wave_sum_dpp(act_lo + act_hi);
    if (un + 1 < nun) { int nrr, nkb, nkc; bool npa; desc(un + 1, nrr, nkb, nkc, npa); NLOAD(g0 + nrr); }
#pragma unroll 1
    for (int k = kbeg; k < kend; k += 8) {
      proc4v(0, k); VLOAD(0, k + 8); VLOAD(1, k + 9); VLOAD(2, k + 10); VLOAD(3, k + 11);
      proc4v(4, k + 4); VLOAD(4, k + 12); VLOAD(5, k + 13); VLOAD(6, k + 14); VLOAD(7, k + 15);
    }
    proc4v(0, kend); proc4v(4, kend + 4);
#undef ULOAD
#undef VLOAD
    if (!partial) ln_token<FINAL>(p, row, rr, lane, f, asum, As);
    else {
      float* pp = PART + wave * PARTW + lane * 16;
      *(float4*)pp = make_float4(f[0], f[1], f[2], f[3]); *(float4*)(pp + 4) = make_float4(f[4], f[5], f[6], f[7]);
      *(float4*)(pp + 8) = make_float4(f[8], f[9], f[10], f[11]); *(float4*)(pp + 12) = make_float4(f[12], f[13], f[14], f[15]);
      if (lane == 0) PART[wave * PARTW + 1024] = asum;
    }
  }
#undef NLOAD
  if (extra) {
    __syncthreads();
    if (wave < extra) {
      const int wpt = 8 / extra, rr = nfull * 8 + wave;
      float f[16], asum = 0.f;
#pragma unroll
      for (int j = 0; j < 16; ++j) f[j] = 0.f;
      for (int w2 = wave * wpt; w2 < wave * wpt + wpt; ++w2) {
        const float* pp = PART + w2 * PARTW + lane * 16;
#pragma unroll
        for (int q4 = 0; q4 < 4; ++q4) { const float4 x4 = *(const float4*)(pp + q4 * 4); f[q4 * 4] += x4.x; f[q4 * 4 + 1] += x4.y; f[q4 * 4 + 2] += x4.z; f[q4 * 4 + 3] += x4.w; }
        asum += PART[w2 * PARTW + 1024];
      }
      ln_token<FINAL>(p, g0 + rr, rr, lane, f, asum, As);
    }
  }
}

__device__ __forceinline__ void cvt_plain(const float* __restrict__ a, bf16_t* __restrict__ o, size_t n8, bool lo, size_t gtid, size_t gsz) {
  for (size_t i = gtid; i < n8; i += gsz) {
    float v[8];
    *(float4*)&v[0] = ((const float4*)a)[i * 2]; *(float4*)&v[4] = ((const float4*)a)[i * 2 + 1];
    if (lo) {
#pragma unroll
      for (int j = 0; j < 8; ++j) v[j] = v[j] - bf2f(f2bf(v[j]));
    }
    uint4 w; w.x = pack2bf(v[0], v[1]); w.y = pack2bf(v[2], v[3]); w.z = pack2bf(v[4], v[5]); w.w = pack2bf(v[6], v[7]);
    ((uint4*)o)[i] = w;
  }
}
__device__ __forceinline__ void cvt_t(const float* __restrict__ W, bf16_t* __restrict__ Wt, int K, int N, bool lo, size_t gtid, size_t gsz) {
  const int N4 = N >> 2;
  const size_t total = (size_t)N4 * (K / 8);
#pragma unroll 2
  for (size_t i = gtid; i < total; i += gsz) {
    const int n = (int)(i % N4) * 4, k8 = (int)(i / N4);
    float4 r[8];
#pragma unroll
    for (int j = 0; j < 8; ++j) r[j] = *(const float4*)(W + (size_t)(k8 * 8 + j) * N + n);
    if (lo) {
#pragma unroll
      for (int j = 0; j < 8; ++j) { r[j].x -= bf2f(f2bf(r[j].x)); r[j].y -= bf2f(f2bf(r[j].y)); r[j].z -= bf2f(f2bf(r[j].z)); r[j].w -= bf2f(f2bf(r[j].w)); }
    }
    uint4* dst = (uint4*)(Wt + ((size_t)((n >> 4) * (K >> 5) + (k8 >> 2)) * 64 + (k8 & 3) * 16 + (n & 15)) * 8);
    dst[0] = make_uint4(pack2bf(r[0].x, r[1].x), pack2bf(r[2].x, r[3].x), pack2bf(r[4].x, r[5].x), pack2bf(r[6].x, r[7].x));
    dst[1] = make_uint4(pack2bf(r[0].y, r[1].y), pack2bf(r[2].y, r[3].y), pack2bf(r[4].y, r[5].y), pack2bf(r[6].y, r[7].y));
    dst[2] = make_uint4(pack2bf(r[0].z, r[1].z), pack2bf(r[2].z, r[3].z), pack2bf(r[4].z, r[5].z), pack2bf(r[6].z, r[7].z));
    dst[3] = make_uint4(pack2bf(r[0].w, r[1].w), pack2bf(r[2].w, r[3].w), pack2bf(r[4].w, r[5].w), pack2bf(r[6].w, r[7].w));
  }
}
__device__ __forceinline__ void cvt_t8(const float* __restrict__ W, unsigned char* __restrict__ Wt, int K, int N, size_t gtid, size_t gsz) {
  const int N4 = N >> 2;
  const size_t total = (size_t)N4 * (K / 8);
#pragma unroll 2
  for (size_t i = gtid; i < total; i += gsz) {
    const int n = (int)(i % N4) * 4, k8 = (int)(i / N4);
    float4 r[8];
#pragma unroll
    for (int j = 0; j < 8; ++j) r[j] = *(const float4*)(W + (size_t)(k8 * 8 + j) * N + n);
    unsigned char* dst = Wt + ((size_t)((n >> 4) * (K >> 6) + (k8 >> 3)) * 64 + (k8 & 3) * 16 + (n & 15)) * 16 + ((k8 >> 2) & 1) * 8;
#define PK8(C) make_uint2((unsigned)__builtin_amdgcn_cvt_pk_fp8_f32(r[2].C * 32.f, r[3].C * 32.f, __builtin_amdgcn_cvt_pk_fp8_f32(r[0].C * 32.f, r[1].C * 32.f, 0, false), true), \
                          (unsigned)__builtin_amdgcn_cvt_pk_fp8_f32(r[6].C * 32.f, r[7].C * 32.f, __builtin_amdgcn_cvt_pk_fp8_f32(r[4].C * 32.f, r[5].C * 32.f, 0, false), true))
    *(uint2*)(dst) = PK8(x); *(uint2*)(dst + 16) = PK8(y); *(uint2*)(dst + 32) = PK8(z); *(uint2*)(dst + 48) = PK8(w);
#undef PK8
  }
}
__device__ __forceinline__ void mod_item(const float* __restrict__ c, const float* __restrict__ c_ctx, const float* __restrict__ ada_w, const float* __restrict__ ada_b,
                                         float* __restrict__ MOD, int item, bool valid, char* lds, int tid, int nct, volatile int* cbc, int& cgen) {
  float* sc = (float*)lds;
  float* part = sc + 3072;
  const int wave = tid >> 6, lane = tid & 63, l = item / 96, cg = item % 96, nw = nct >> 6;
  if (valid) for (int i = tid; i < 3072; i += nct) { const int v = i >> 10, k = i & 1023; const float xv = v < 2 ? c[v * 1024 + k] : c_ctx[k]; sc[i] = xv / (1.f + expf(-xv)); }
  cbar(cbc, cgen, nw);
  if (valid) {
    float a0 = 0.f, a1 = 0.f, a2 = 0.f;
    const float* W = ada_w + (size_t)l * 1024 * 6144 + cg * 64 + lane;
    const int kb = wave * 171, ke = kb + 171 < 1024 ? kb + 171 : 1024;
#pragma unroll 57
    for (int k = kb; k < ke; ++k) { const float w = W[(size_t)k * 6144]; a0 += sc[k] * w; a1 += sc[1024 + k] * w; a2 += sc[2048 + k] * w; }
    part[(wave * 3 + 0) * 64 + lane] = a0; part[(wave * 3 + 1) * 64 + lane] = a1; part[(wave * 3 + 2) * 64 + lane] = a2;
  }
  cbar(cbc, cgen, nw);
  if (valid && tid < 192) {
    const int v = tid >> 6, ln = tid & 63; float sum = 0.f;
    for (int w = 0; w < nw; ++w) sum += part[(w * 3 + v) * 64 + ln];
    MOD[(l * 3 + v) * 6144 + cg * 64 + ln] = sum + ada_b[l * 6144 + cg * 64 + ln];
  }
}

__device__ __forceinline__ void gbar(unsigned* cnt, unsigned target) {
  asm volatile("s_waitcnt vmcnt(0)" ::: "memory");
  __syncthreads();
  if (otid() == 0) {
    __builtin_amdgcn_fence(__ATOMIC_RELEASE, "agent");
    asm volatile("s_waitcnt vmcnt(0)" ::: "memory");
    __hip_atomic_fetch_add(cnt, 1u, __ATOMIC_RELAXED, __HIP_MEMORY_SCOPE_AGENT);
    unsigned spins = 0;
    while (__hip_atomic_load(cnt, __ATOMIC_RELAXED, __HIP_MEMORY_SCOPE_AGENT) < target) { __builtin_amdgcn_s_sleep(2); if (++spins > (1u << 24)) break; }
    __builtin_amdgcn_fence(__ATOMIC_ACQUIRE, "agent");
    asm volatile("s_waitcnt vmcnt(0)" ::: "memory");
  }
  __syncthreads();
}

struct MP {
  const float *x, *c, *ctx, *c_ctx, *ada_w, *ada_b, *ln_g, *ln_b, *s5_a_re, *s5_a_im, *s5_log_dt, *s5_b_re, *s5_b_im, *s5_c_re, *s5_c_im, *s5_d, *s5_w_glu, *s5_w_o;
  const float *mla_w_dq, *mla_q_norm, *mla_w_uq, *mla_w_dkv, *mla_kv_norm, *mla_w_ukv, *mla_w_o, *peer_w_q, *peer_keys, *peer_u, *peer_v;
  float* out;
  float* MOD; bf16_t *Wt_glu, *Wt_o0, *Wt_q0, *Wt_o1, *Wt_q1, *Wt_cat, *Wt_uq, *Wt_ukv, *Khi, *Khi1;
  unsigned char *U0, *V0, *U1, *V1; float *SU0, *SV0, *SU1, *SV1; bf16_t *Ktab, *Bst_t, *Cin_t;
  bf16_t* Ypart; float* Ssta; bf16_t *HP, *Gbf, *Vbf, *Tbf; float *OQ, *H1, *H2; int* IDX; float* GATE;
  bf16_t *Qa, *AObf; unsigned char *Kn, *Kr, *Va; float* H3; bf16_t* Tbf1; unsigned* BAR; float* PART;
};
constexpr int LDS_BYTES = 66 * 784 + 66 * 528 + 1024 * 68 + 64;
__global__ __launch_bounds__(512) void mega(MP p) {
  __shared__ __attribute__((aligned(16))) char lds[LDS_BYTES];
  cg::grid_group grid = cg::this_grid();
  const int nblk = gridDim.x;
  int bid = blockIdx.x;
  const size_t TD = (size_t)1024 * 16384;
  const float* mod0 = p.MOD; const float* mod1 = p.MOD + 3 * 6144;
  {
    volatile int* cbc = (volatile int*)(lds + LDS_BYTES - 16);
    if (otid() == 0) *cbc = 0;
    __syncthreads();
    const int t0 = otid();
    if (t0 < 128) {
      const size_t mt = (size_t)bid * 128 + t0, ms = (size_t)nblk * 128;
      const int mw = bid * 2 + (t0 >> 6), nmw = nblk * 2;
      cvt_t(p.s5_w_glu, p.Wt_glu, D, D, false, mt, ms);
      cvt_t(p.s5_w_o, p.Wt_o0, D, D, false, mt, ms);
      cvt_t(p.peer_w_q, p.Wt_q0, D, D, false, mt, ms);
      cvt_t8(p.mla_w_o, (unsigned char*)p.Wt_o1, D, D, mt, ms);
      cvt_t(p.peer_w_q + (size_t)D * D, p.Wt_q1, D, D, false, mt, ms);
      cvt_t8(p.mla_w_dq, (unsigned char*)p.Wt_cat, D, 384, mt, ms);
      cvt_t8(p.mla_w_dkv, (unsigned char*)p.Wt_cat + (size_t)384 * D, D, 320, mt, ms);
      cvt_t8(p.mla_w_uq, (unsigned char*)p.Wt_uq, 384, 1536, mt, ms);
      cvt_t8(p.mla_w_ukv, (unsigned char*)p.Wt_ukv, 256, 2048, mt, ms);
      cvt_plain(p.peer_keys, p.Khi, (size_t)2 * 131072 / 8, false, mt, ms);
      cvt_rows_i8<true>(p.peer_u, p.U0, p.SU0, 16384, mw, nmw);
      cvt_rows_q6(p.peer_v, p.V0, p.SV0, 16384, mw, nmw);
      cvt_rows_i8<true>(p.peer_u + TD, p.U1, p.SU1, 16384, mw, nmw);
      cvt_rows_q6(p.peer_v + TD, p.V1, p.SV1, 16384, mw, nmw);
    } else {
      int cgen = 0;
      const int ct = t0 - 128;
      ph_s5_prep(p.s5_a_re, p.s5_a_im, p.s5_log_dt, p.s5_b_re, p.s5_b_im, p.s5_c_re, p.s5_c_im, p.Ktab, p.Bst_t, p.Cin_t, bid >> 2, bid & 3, lds, ct, 384, cbc, cgen);
      cbar(cbc, cgen, 6);
      mod_item(p.c, p.c_ctx, p.ada_w, p.ada_b, p.MOD, bid, bid < 192, lds, ct, 384, cbc, cgen);
    }
  }
  grid.sync();
  asm volatile("" : "+s"(bid));
  ph_s5_p1(p.x, p.ctx, mod0, p.Ktab, p.Bst_t, p.s5_d, p.Ypart, p.Ssta, bid, lds);
  gbar(p.BAR + 16 + (bid >> 2) * 16, 4u);
  asm volatile("" : "+s"(bid));
  if (otid() < 64) ph_s5_carry(p.Ssta, p.s5_a_re, p.s5_a_im, p.s5_log_dt, p.HP, ((bid & 2) << 6) | ((bid >> 2) << 1) | (bid & 1), otid());
  gbar(p.BAR + 16 + (bid >> 2) * 16, 8u);
  asm volatile("" : "+s"(bid));
  ph_s5_p3(p.HP, p.Cin_t, p.Ypart, p.Gbf, bid, lds);
  gbar(p.BAR, 1u * (unsigned)nblk);
  asm volatile("" : "+s"(bid));
  {
    ChainP cp{p.Gbf, p.Wt_glu, p.Wt_o0, p.Wt_q0, p.Vbf, (bf16_t*)p.OQ + (size_t)bid * 66 * D, p.x, p.ctx, mod0, p.ln_g, p.ln_b, p.H1, p.Tbf, (bf16_t*)p.OQ + (size_t)bid * 66 * D  };
    ph_chainA<true>(cp, bid, lds);
    __syncthreads();
    ph_route(RouteP{(bf16_t*)p.OQ + (size_t)bid * 66 * D, p.Khi, p.IDX, p.GATE, 66, 0}, bid, lds);
    __syncthreads();
    GatherP gp{p.Tbf, p.IDX, p.GATE, p.U0, p.V0, p.SU0, p.SV0, p.H1, mod0, p.ln_g + D, p.ln_b + D, p.H2, mod1};
    ph_gather_tm<false>(gp, bid * 66, 66, lds, p.PART + (size_t)bid * 8 * PARTW);
    __syncthreads();
    ProjP pp{p.Wt_cat, p.Wt_uq, p.Wt_ukv, p.mla_q_norm, p.mla_kv_norm, p.OQ  , p.Qa, p.Kn, p.Kr, p.Va};
    ph_mla_proj(pp, bid, lds);
  }
  gbar(p.BAR, 2u * (unsigned)nblk);
  asm volatile("" : "+s"(bid));
  ph_attn(p.Qa, p.Kn, p.Kr, p.Va, p.AObf, bid, nblk, lds);
  gbar(p.BAR, 3u * (unsigned)nblk);
  asm volatile("" : "+s"(bid));
  {
    ChainP cp{p.AObf, nullptr, p.Wt_o1, p.Wt_q1, nullptr, (bf16_t*)p.OQ + (size_t)bid * 64 * D, p.H2, p.H2 + (size_t)NL * D, mod1, p.ln_g + 2 * D, p.ln_b + 2 * D, p.H3, p.Tbf1, (bf16_t*)p.OQ + (size_t)bid * 64 * D};
    ph_chainA<false>(cp, bid, lds);
    __syncthreads();
    ph_route(RouteP{(bf16_t*)p.OQ + (size_t)bid * 64 * D, p.Khi1, p.IDX, p.GATE, 64, 0}, bid, lds);
    __syncthreads();
    GatherP gp{p.Tbf1, p.IDX, p.GATE, p.U1, p.V1, p.SU1, p.SV1, p.H3, mod1, p.ln_g + 3 * D, p.ln_b + 3 * D, p.out, mod1};
    ph_gather_tm<true>(gp, bid * 64, 64, lds, p.PART + (size_t)bid * 8 * PARTW);
  }
}

extern "C" void kernel_launch(void* const* d_in, const int* in_sizes, int n_in, void* d_out, int out_size, void* d_ws, size_t ws_size, hipStream_t stream) {
  MP p{};
  const float** in = (const float**)&p;
  for (int i = 0; i < 29; ++i) in[i] = (const float*)d_in[i];
  p.out = (float*)d_out;
  char* ws = (char*)d_ws; size_t off = 0;
  auto carve = [&](size_t bytes) { char* q = ws + off; off += (bytes + 255) / 256 * 256; return q; };
  const size_t TDB = (size_t)1024 * 16384 * 2, BIG = (size_t)NT * D * 4, HALF = (size_t)NT * D * 2;
  p.MOD = (float*)carve(2 * 3 * 6144 * 4);
  p.Wt_glu = (bf16_t*)carve((size_t)D * D * 2); p.Wt_o0 = (bf16_t*)carve((size_t)D * D * 2); p.Wt_q0 = (bf16_t*)carve((size_t)D * D * 2);
  p.Wt_o1 = (bf16_t*)carve((size_t)D * D * 2); p.Wt_q1 = (bf16_t*)carve((size_t)D * D * 2);
  p.Wt_cat = (bf16_t*)carve((size_t)704 * D * 2); p.Wt_uq = (bf16_t*)carve((size_t)1536 * 384 * 2); p.Wt_ukv = (bf16_t*)carve((size_t)2048 * 256 * 2);
  p.Khi = (bf16_t*)carve((size_t)2 * 131072 * 2); p.Khi1 = p.Khi + 131072;
  char* T0 = carve(TDB); p.U0 = (unsigned char*)T0; p.V0 = (unsigned char*)(T0 + TDB / 2); p.AObf = (bf16_t*)T0;
  p.SU0 = (float*)carve(16384 * 4); p.SV0 = (float*)carve(16384 * 4); p.SU1 = (float*)carve(16384 * 4); p.SV1 = (float*)carve(16384 * 4);
  const size_t KTAB_B = (size_t)64 * 127 * 256 * 2, BST_B = (size_t)64 * 256 * 1024 * 2, KN_B = (size_t)NB * 8 * KEYS * 128 * 2, KR_B = (size_t)NB * KEYS * 64 * 2;
  size_t x1 = KTAB_B + 2 * BST_B; if (x1 < 2 * KN_B + KR_B) x1 = 2 * KN_B + KR_B;
  char* X1 = carve(x1);
  p.Ktab = (bf16_t*)X1; p.Bst_t = (bf16_t*)(X1 + KTAB_B); p.Cin_t = (bf16_t*)(X1 + KTAB_B + BST_B);
  p.Kn = (unsigned char*)X1; p.Va = (unsigned char*)(X1 + KN_B); p.Kr = (unsigned char*)(X1 + 2 * KN_B); p.H3 = (float*)X1;
  char* X2 = carve(BIG); p.Ypart = (bf16_t*)X2; p.OQ = (float*)X2;
  char* X3 = carve(HALF); p.Ssta = (float*)X3; p.HP = (bf16_t*)(X3 + (size_t)NCC * 64 * 256 * 4); p.Vbf = (bf16_t*)X3;
  char* X4 = carve(HALF); p.Gbf = (bf16_t*)X4; p.Tbf = (bf16_t*)X4; p.Tbf1 = (bf16_t*)X4;
  char* X5 = carve(BIG); p.H1 = (float*)X5;
  char* T1 = carve(TDB); p.U1 = (unsigned char*)T1; p.V1 = (unsigned char*)(T1 + TDB / 2);
  p.H2 = (float*)carve(BIG);
  p.IDX = (int*)carve((size_t)NT * 128 * 4); p.GATE = (float*)carve((size_t)NT * 128 * 4);
  p.Qa = (bf16_t*)carve((size_t)NB * 8 * SEQ * 192 * 2);
  p.BAR = (unsigned*)carve(8192);
  p.PART = (float*)carve((size_t)256 * 8 * PARTW * 4);
  if (off > ws_size || n_in != 29) { fprintf(stderr, "kernel_launch: workspace too small (need %zu, have %zu) or n_in %d != 29\n", off, ws_size, n_in); return; }
  static int grid_blocks = 0;
  if (!grid_blocks) {
    int dev = 0, cus = 0, per_cu = 0;
    hipGetDevice(&dev);
    hipDeviceGetAttribute(&cus, hipDeviceAttributeMultiprocessorCount, dev);
    hipOccupancyMaxActiveBlocksPerMultiprocessor(&per_cu, mega, 512, 0);
    if (per_cu < 1 || cus < 256) { fprintf(stderr, "kernel_launch: need 256 resident workgroups (cus %d, per_cu %d)\n", cus, per_cu); return; }
    grid_blocks = 256;
  }
  hipMemsetAsync(p.BAR, 0, 8192, stream);
  void* args[] = {&p};
  hipError_t e = hipLaunchCooperativeKernel((void*)mega, dim3(grid_blocks), dim3(512), args, 0, stream);
  if (e != hipSuccess) fprintf(stderr, "cooperative launch failed: %s\n", hipGetErrorString(e));
}
```

```cpp
#include <hip/hip_runtime.h>
#include <math.h>
#include <hip/hip_cooperative_groups.h>
#include <cstdio>
namespace cg = cooperative_groups;
__device__ __forceinline__ int otid() { int t = (int)__builtin_amdgcn_workitem_id_x(); asm volatile("" : "+v"(t)); return t; }

constexpr int D = 1024, NB = 2, SEQ = 8192, CTX = 256;
constexpr int NL = NB * SEQ, NC = NB * CTX, NT = NL + NC;
constexpr float ALPHA = 1.4142135623730951f;
constexpr float LN_EPS = 1e-5f, RMS_EPS = 1e-6f;

__device__ __forceinline__ float wave_sum_dpp(float v) {
  v += __uint_as_float(__builtin_amdgcn_update_dpp(0u, __float_as_uint(v), 0xB1, 0xF, 0xF, true));
  v += __uint_as_float(__builtin_amdgcn_update_dpp(0u, __float_as_uint(v), 0x4E, 0xF, 0xF, true));
  v += __uint_as_float(__builtin_amdgcn_update_dpp(0u, __float_as_uint(v), 0x141, 0xF, 0xF, true));
  v += __uint_as_float(__builtin_amdgcn_update_dpp(0u, __float_as_uint(v), 0x140, 0xF, 0xF, true));
  v += __uint_as_float(__builtin_amdgcn_update_dpp(0u, __float_as_uint(v), 0x142, 0xA, 0xF, true));
  v += __uint_as_float(__builtin_amdgcn_update_dpp(0u, __float_as_uint(v), 0x143, 0xC, 0xF, true));
  return __uint_as_float((unsigned)__builtin_amdgcn_readlane((int)__float_as_uint(v), 63));
}
__device__ __forceinline__ float wave_sum(float v) { return wave_sum_dpp(v); }
__device__ __forceinline__ float wave_max_dpp(float v) {
  v = fmaxf(v, __uint_as_float(__builtin_amdgcn_update_dpp(0u, __float_as_uint(v), 0xB1, 0xF, 0xF, true)));
  v = fmaxf(v, __uint_as_float(__builtin_amdgcn_update_dpp(0u, __float_as_uint(v), 0x4E, 0xF, 0xF, true)));
  v = fmaxf(v, __uint_as_float(__builtin_amdgcn_update_dpp(0u, __float_as_uint(v), 0x141, 0xF, 0xF, true)));
  v = fmaxf(v, __uint_as_float(__builtin_amdgcn_update_dpp(0u, __float_as_uint(v), 0x140, 0xF, 0xF, true)));
  v = fmaxf(v, __uint_as_float(__builtin_amdgcn_update_dpp(0u, __float_as_uint(v), 0x142, 0xA, 0xF, true)));
  v = fmaxf(v, __uint_as_float(__builtin_amdgcn_update_dpp(0u, __float_as_uint(v), 0x143, 0xC, 0xF, true)));
  return __uint_as_float((unsigned)__builtin_amdgcn_readlane((int)__float_as_uint(v), 63));
}
__device__ __forceinline__ int row_vec(int row) { return row < NL ? (row >> 13) : 2; }
__device__ __forceinline__ float gelu_exact(float x) { return 0.5f * x * (1.f + erff(x * 0.70710678118654752f)); }
__device__ __forceinline__ float gelu_fast(float x) {
  const float z = fabsf(x) * 0.70710678118654752f;
  const float t = __builtin_amdgcn_rcpf(fmaf(0.3275911f, z, 1.f));
  float pl = fmaf(1.061405429f, t, -1.453152027f); pl = fmaf(pl, t, 1.421413741f); pl = fmaf(pl, t, -0.284496736f); pl = fmaf(pl, t, 0.254829592f);
  const float e = __builtin_amdgcn_exp2f(-z * z * 1.4426950408889634f);
  const float erfa = 1.f - pl * t * e;
  const float hx = 0.5f * x;
  return hx + fabsf(hx) * erfa;
}


typedef unsigned short bf16_t;
using bf16x8 = __attribute__((ext_vector_type(8))) short;
using f32x4 = __attribute__((ext_vector_type(4))) float;
__device__ __forceinline__ bf16_t f2bf(float f) { unsigned u = __float_as_uint(f); u += 0x7FFFu + ((u >> 16) & 1u); return (bf16_t)(u >> 16); }
__device__ __forceinline__ unsigned char f2fp8(float v) { return (unsigned char)(__builtin_amdgcn_cvt_pk_fp8_f32(v, v, 0, false) & 0xFF); }
__device__ __forceinline__ float bf2f(bf16_t h) { return __uint_as_float(((unsigned)h) << 16); }
__device__ __forceinline__ unsigned pack2bf(float lo, float hi) { return (unsigned)f2bf(lo) | ((unsigned)f2bf(hi) << 16); }
__device__ __forceinline__ float bflo(unsigned w) { return __uint_as_float(w << 16); }
__device__ __forceinline__ float bfhi(unsigned w) { return __uint_as_float(w & 0xFFFF0000u); }


constexpr int LDA_B = 1024 * 2 + 16;
template <int RT, int K>
__device__ __forceinline__ void gemm_unit(const char* const (&ap)[RT], const bf16_t* __restrict__ w0, const bf16_t* __restrict__ w1, int kmul, f32x4 (&acc)[RT][2]) {
  constexpr int KI = K / 128, NS = 2;
#pragma unroll
  for (int t = 0; t < RT; ++t) { acc[t][0] = f32x4{0.f, 0.f, 0.f, 0.f}; acc[t][1] = f32x4{0.f, 0.f, 0.f, 0.f}; }
  bf16x8 b[NS][4][2];
#pragma unroll
  for (int st = 0; st < NS - 1; ++st) {
    if (st < KI) {
#pragma unroll
      for (int s2 = 0; s2 < 4; ++s2) { b[st][s2][0] = *(const bf16x8*)(w0 + (st * 128 + s2 * 32) * kmul); b[st][s2][1] = *(const bf16x8*)(w1 + (st * 128 + s2 * 32) * kmul); }
    }
  }
  asm volatile("" ::: "memory");
  bf16x8 an[RT];
#pragma unroll
  for (int t = 0; t < RT; ++t) an[t] = *(const bf16x8*)(ap[t]);
#pragma unroll
  for (int it = 0; it < KI; ++it) {
    if (it + NS - 1 < KI) {
#pragma unroll
      for (int s2 = 0; s2 < 4; ++s2) {
        b[(it + NS - 1) % NS][s2][0] = *(const bf16x8*)(w0 + ((it + NS - 1) * 128 + s2 * 32) * kmul);
        b[(it + NS - 1) % NS][s2][1] = *(const bf16x8*)(w1 + ((it + NS - 1) * 128 + s2 * 32) * kmul);
      }
    }
    asm volatile("" ::: "memory");
#pragma unroll
    for (int s2 = 0; s2 < 4; ++s2) {
      bf16x8 ac[RT];
#pragma unroll
      for (int t = 0; t < RT; ++t) ac[t] = an[t];
      if (it * 4 + s2 + 1 < KI * 4) {
#pragma unroll
        for (int t = 0; t < RT; ++t) an[t] = *(const bf16x8*)(ap[t] + (it * 128 + s2 * 32 + 32) * 2);
      }
#pragma unroll
      for (int t = 0; t < RT; ++t) {
        acc[t][0] = __builtin_amdgcn_mfma_f32_16x16x32_bf16(ac[t], b[it % NS][s2][0], acc[t][0], 0, 0, 0);
        acc[t][1] = __builtin_amdgcn_mfma_f32_16x16x32_bf16(ac[t], b[it % NS][s2][1], acc[t][1], 0, 0, 0);
      }
    }
  }
}
typedef __bf16 bf16raw2 __attribute__((ext_vector_type(2)));
__device__ __forceinline__ bf16x8 w8_frag(unsigned lo, unsigned hi) {
  const bf16raw2 e0 = __builtin_amdgcn_cvt_scalef32_pk_bf16_fp8(lo, 0.03125f, false), e1 = __builtin_amdgcn_cvt_scalef32_pk_bf16_fp8(lo, 0.03125f, true);
  const bf16raw2 e2 = __builtin_amdgcn_cvt_scalef32_pk_bf16_fp8(hi, 0.03125f, false), e3 = __builtin_amdgcn_cvt_scalef32_pk_bf16_fp8(hi, 0.03125f, true);
  uint4 w; w.x = *(const unsigned*)&e0; w.y = *(const unsigned*)&e1; w.z = *(const unsigned*)&e2; w.w = *(const unsigned*)&e3;
  return *(const bf16x8*)&w;
}
template <int RT, int K>
__device__ __forceinline__ void gemm_unit8(const char* const (&ap)[RT], const unsigned char* __restrict__ w0, const unsigned char* __restrict__ w1, f32x4 (&acc)[RT][2]) {
  constexpr int KI = K / 128, NS = 2;
#pragma unroll
  for (int t = 0; t < RT; ++t) { acc[t][0] = f32x4{0.f, 0.f, 0.f, 0.f}; acc[t][1] = f32x4{0.f, 0.f, 0.f, 0.f}; }
  uint4 b[NS][2][2];
#pragma unroll
  for (int st = 0; st < NS - 1; ++st) {
    if (st < KI) {
#pragma unroll
      for (int pr = 0; pr < 2; ++pr) { b[st][pr][0] = *(const uint4*)(w0 + (st * 2 + pr) * 1024); b[st][pr][1] = *(const uint4*)(w1 + (st * 2 + pr) * 1024); }
    }
  }
  asm volatile("" ::: "memory");
  bf16x8 an[RT];
#pragma unroll
  for (int t = 0; t < RT; ++t) an[t] = *(const bf16x8*)(ap[t]);
#pragma unroll
  for (int it = 0; it < KI; ++it) {
    if (it + NS - 1 < KI) {
#pragma unroll
      for (int pr = 0; pr < 2; ++pr) {
        b[(it + NS - 1) % NS][pr][0] = *(const uint4*)(w0 + ((it + NS - 1) * 2 + pr) * 1024);
        b[(it + NS - 1) % NS][pr][1] = *(const uint4*)(w1 + ((it + NS - 1) * 2 + pr) * 1024);
      }
    }
    asm volatile("" ::: "memory");
#pragma unroll
    for (int s2 = 0; s2 < 4; ++s2) {
      bf16x8 ac[RT];
#pragma unroll
      for (int t = 0; t < RT; ++t) ac[t] = an[t];
      if (it * 4 + s2 + 1 < KI * 4) {
#pragma unroll
        for (int t = 0; t < RT; ++t) an[t] = *(const bf16x8*)(ap[t] + (it * 128 + s2 * 32 + 32) * 2);
      }
      const uint4 q0 = b[it % NS][s2 >> 1][0], q1 = b[it % NS][s2 >> 1][1];
      const bf16x8 f0 = (s2 & 1) ? w8_frag(q0.z, q0.w) : w8_frag(q0.x, q0.y), f1 = (s2 & 1) ? w8_frag(q1.z, q1.w) : w8_frag(q1.x, q1.y);
#pragma unroll
      for (int t = 0; t < RT; ++t) {
        acc[t][0] = __builtin_amdgcn_mfma_f32_16x16x32_bf16(ac[t], f0, acc[t][0], 0, 0, 0);
        acc[t][1] = __builtin_amdgcn_mfma_f32_16x16x32_bf16(ac[t], f1, acc[t][1], 0, 0, 0);
      }
    }
  }
}
template <int RT, int K, class Epi>
__device__ __forceinline__ void gemm_ldsA8(const char* As, int lda_b, int nrows, const unsigned char* __restrict__ Wt, int N, Epi epi) {
  const int wave = otid() >> 6, lane = otid() & 63, l15 = lane & 15, q = lane >> 4;
  const char* ap[RT];
#pragma unroll
  for (int t = 0; t < RT; ++t) { int r = t * 16 + l15; r = r < nrows ? r : nrows - 1; ap[t] = As + r * lda_b + q * 16; }
#pragma unroll 1
  for (int unit = wave; unit < (N >> 5); unit += 8) {
    const int n0 = unit * 32;
    const unsigned char* w0 = Wt + (size_t)(n0 >> 4) * K * 16 + lane * 16;
    f32x4 acc[RT][2];
    gemm_unit8<RT, K>(ap, w0, w0 + (size_t)K * 16, acc);
#pragma unroll
    for (int t = 0; t < RT; ++t)
#pragma unroll
      for (int j = 0; j < 2; ++j)
#pragma unroll
        for (int r = 0; r < 4; ++r) {
          const int row = t * 16 + q * 4 + r, col = n0 + j * 16 + l15;
          if (row < nrows) epi(row, col, acc[t][j][r]);
        }
  }
}
template <int RT, int K, class Epi>
__device__ __forceinline__ void gemm_ldsA(const char* As, int lda_b, int nrows, const bf16_t* __restrict__ Wt, int N, Epi epi) {
  const int wave = otid() >> 6, lane = otid() & 63, l15 = lane & 15, q = lane >> 4;
  const char* ap[RT];
#pragma unroll
  for (int t = 0; t < RT; ++t) { int r = t * 16 + l15; r = r < nrows ? r : nrows - 1; ap[t] = As + r * lda_b + q * 16; }
#pragma unroll 1
  for (int unit = wave; unit < (N >> 5); unit += 8) {
    const int n0 = unit * 32;
    const bf16_t* w0 = Wt + (size_t)(n0 >> 4) * K * 16 + lane * 8;
    f32x4 acc[RT][2];
    gemm_unit<RT, K>(ap, w0, w0 + (size_t)K * 16, 16, acc);
#pragma unroll
    for (int t = 0; t < RT; ++t)
#pragma unroll
      for (int j = 0; j < 2; ++j)
#pragma unroll
        for (int r = 0; r < 4; ++r) {
          const int row = t * 16 + q * 4 + r, col = n0 + j * 16 + l15;
          if (row < nrows) epi(row, col, acc[t][j][r]);
        }
  }
}
struct EpiBF16 { bf16_t* C; int ldc; __device__ __forceinline__ void operator()(int row, int col, float v) const { C[(size_t)row * ldc + col] = f2bf(v); } };
struct EpiF32 { float* C; int ldc; __device__ __forceinline__ void operator()(int row, int col, float v) const { C[(size_t)row * ldc + col] = v; } };
struct EpiGluL { const char* As; bf16_t* V; __device__ __forceinline__ void operator()(int row, int col, float z) const {
  const float g = bf2f(*(const bf16_t*)(As + row * LDA_B + col * 2)); V[(size_t)row * D + col] = f2bf(g / (1.f + expf(-z))); } };

__device__ __forceinline__ void load_rows_lds(char* As, const bf16_t* __restrict__ src, int nrows) {
  const int t = otid(), total = nrows * 128;
#pragma unroll
  for (int h = 0; h < 2; ++h) {
    uint4 v[9];
#pragma unroll
    for (int k = 0; k < 9; ++k) { int i = t + (h * 9 + k) * 512; i = i < total ? i : total - 1; v[k] = *(const uint4*)(src + (size_t)(i >> 7) * D + (i & 127) * 8); }
#pragma unroll
    for (int k = 0; k < 9; ++k) { const int i = t + (h * 9 + k) * 512; if (i < total) *(uint4*)(As + (i >> 7) * LDA_B + (i & 127) * 16) = v[k]; }
  }
}
__device__ __forceinline__ void ln_rows(char* As, int g0, int nrows, const float* Hl, const float* Hc, const bf16_t* __restrict__ O,
                                        const float* __restrict__ mod, int gate_i, const float* __restrict__ lng, const float* __restrict__ lnb,
                                        float* Hout, bf16_t* __restrict__ Tbf, int shift_i, int scale_i) {
  const int wave = otid() >> 6, lane = otid() & 63;
  for (int rr = wave; rr < nrows; rr += 8) {
    const int row = g0 + rr;
    const float* hin = row < NL ? Hl + (size_t)row * D : Hc + (size_t)(row - NL) * D;
    const bf16_t* f = O + (size_t)row * D;
    const float* m = mod + row_vec(row) * 6144;
    const float* gm = m + gate_i * 1024;
    float r[16]; float s = 0.f;
#pragma unroll
    for (int i = 0; i < 4; ++i) {
      const int d = i * 256 + lane * 4;
      const uint2 fw = *(const uint2*)(f + d);
      float4 h4 = *(const float4*)(hin + d), f4 = make_float4(bflo(fw.x), bfhi(fw.x), bflo(fw.y), bfhi(fw.y)), g4 = *(const float4*)(gm + d);
      r[i * 4 + 0] = ALPHA * h4.x + g4.x * f4.x; r[i * 4 + 1] = ALPHA * h4.y + g4.y * f4.y;
      r[i * 4 + 2] = ALPHA * h4.z + g4.z * f4.z; r[i * 4 + 3] = ALPHA * h4.w + g4.w * f4.w;
      s += r[i * 4 + 0] + r[i * 4 + 1] + r[i * 4 + 2] + r[i * 4 + 3];
    }
    const float mu = wave_sum(s) * (1.f / D);
    float vs = 0.f;
#pragma unroll
    for (int i = 0; i < 16; ++i) { float dlt = r[i] - mu; vs += dlt * dlt; }
    const float rstd = rsqrtf(wave_sum(vs) * (1.f / D) + LN_EPS);
#pragma unroll
    for (int i = 0; i < 4; ++i) {
      const int d = i * 256 + lane * 4;
      float4 g4 = *(const float4*)(lng + d), b4 = *(const float4*)(lnb + d);
      float4 o;
      o.x = (r[i * 4 + 0] - mu) * rstd * g4.x + b4.x; o.y = (r[i * 4 + 1] - mu) * rstd * g4.y + b4.y;
      o.z = (r[i * 4 + 2] - mu) * rstd * g4.z + b4.z; o.w = (r[i * 4 + 3] - mu) * rstd * g4.w + b4.w;
      *(float4*)(Hout + (size_t)row * D + d) = o;
      float4 sh = *(const float4*)(m + shift_i * 1024 + d), sc = *(const float4*)(m + scale_i * 1024 + d);
      const float t0 = o.x * (1.f + sc.x) + sh.x, t1 = o.y * (1.f + sc.y) + sh.y, t2 = o.z * (1.f + sc.z) + sh.z, t3 = o.w * (1.f + sc.w) + sh.w;
      uint2 w; w.x = pack2bf(t0, t1); w.y = pack2bf(t2, t3);
      *(uint2*)(As + rr * LDA_B + d * 2) = w;
      *(uint2*)(Tbf + (size_t)row * D + d) = w;

    }
  }
}


constexpr int S5T = 64, NCHUNK = (CTX + SEQ) / S5T  , NCC = NB * NCHUNK  ;
__device__ __forceinline__ int s5_token(int cc, int s) {
  const int b = cc / NCHUNK, ch = cc - b * NCHUNK;
  return ch < 4 ? NL + b * CTX + ch * S5T + s : b * SEQ + (ch - 4) * S5T + s;
}
__device__ __forceinline__ void cbar(volatile int* cnt, int& gen, int nwaves) {
  __builtin_amdgcn_fence(__ATOMIC_RELEASE, "workgroup");
  if ((otid() & 63) == 0) __hip_atomic_fetch_add((int*)cnt, 1, __ATOMIC_RELAXED, __HIP_MEMORY_SCOPE_WORKGROUP);
  ++gen;
  while (__hip_atomic_load((int*)cnt, __ATOMIC_RELAXED, __HIP_MEMORY_SCOPE_WORKGROUP) < gen * nwaves) __builtin_amdgcn_s_sleep(1);
  __builtin_amdgcn_fence(__ATOMIC_ACQUIRE, "workgroup");
}
__device__ __forceinline__ void ph_s5_prep(const float* __restrict__ a_re, const float* __restrict__ a_im, const float* __restrict__ log_dt,
                                                 const float* __restrict__ b_re, const float* __restrict__ b_im, const float* __restrict__ c_re, const float* __restrict__ c_im,
                                                 bf16_t* __restrict__ Ktab, bf16_t* __restrict__ Bst_t, bf16_t* __restrict__ Cin_t, int g, int part, char* lds, int tid, int nct, volatile int* cbc, int& cgen) {
  float2 (*pw)[65][64] = reinterpret_cast<float2 (*)[65][64]>(lds);
  float2 (*Bp)[64][16] = reinterpret_cast<float2 (*)[64][16]>(lds + 2 * 65 * 64 * 8);
  float2 (*Cc)[16][64] = reinterpret_cast<float2 (*)[16][64]>(lds + 2 * 65 * 64 * 8 + 2 * 64 * 16 * 8);
  float2 (*fs)[64] = reinterpret_cast<float2 (*)[64]>(lds + 2 * 65 * 64 * 8 + 2 * 64 * 16 * 8 + 2 * 16 * 64 * 8);
  if (tid < 128) {
    const int dir = tid >> 6, p = tid & 63, gp = (dir * 64 + g) * 64 + p;
    const float are = a_re[gp], aim = a_im[gp], dt = expf(log_dt[dir * 64 + g]);
    const float mag = expf(are * dt);
    const float abr = mag * cosf(aim * dt), abi = mag * sinf(aim * dt);
    const float nr = abr - 1.f, ni = abi, den = are * are + aim * aim;
    fs[dir][p] = make_float2((nr * are + ni * aim) / den, (ni * are - nr * aim) / den);
    float pr = 1.f, pi = 0.f;
    for (int e = 0; e <= 64; ++e) { pw[dir][e][p] = make_float2(pr, pi); const float nr2 = pr * abr - pi * abi, ni2 = pr * abi + pi * abr; pr = nr2; pi = ni2; }
  }
  cbar(cbc, cgen, nct >> 6);
  for (int i = tid; i < 2048; i += nct) {
    const int dir = i >> 10, p = (i >> 4) & 63, ci = i & 15;
    const size_t gi = ((size_t)(dir * 64 + g) * 64 + p) * 16 + ci;
    const float br = b_re[gi], bi = b_im[gi]; const float2 f = fs[dir][p];
    Bp[dir][p][ci] = make_float2(f.x * br - f.y * bi, f.x * bi + f.y * br);
    const int co = (i >> 6) & 15, p2 = i & 63;
    const size_t ci2 = ((size_t)(dir * 64 + g) * 16 + co) * 64 + p2;
    Cc[dir][co][p2] = make_float2(c_re[ci2], c_im[ci2]);
  }
  cbar(cbc, cgen, nct >> 6);
  for (int i = part * 508 + tid; i < (part + 1) * 508; i += nct) {
    const int ti = i >> 4, co = i & 15, tau = ti - 63;
    float acc[16];
#pragma unroll
    for (int ci = 0; ci < 16; ++ci) acc[ci] = 0.f;
    if (tau >= 0) {
      for (int p = 0; p < 64; ++p) {
        const float2 c = Cc[0][co][p], w = pw[0][tau][p];
        const float xr = c.x * w.x - c.y * w.y, xi = c.x * w.y + c.y * w.x;
#pragma unroll
        for (int ci = 0; ci < 16; ++ci) { const float2 bb = Bp[0][p][ci]; acc[ci] += xr * bb.x - xi * bb.y; }
      }
    }
    if (tau <= 0) {
      for (int p = 0; p < 64; ++p) {
        const float2 c = Cc[1][co][p], w = pw[1][-tau][p];
        const float xr = c.x * w.x - c.y * w.y, xi = c.x * w.y + c.y * w.x;
#pragma unroll
        for (int ci = 0; ci < 16; ++ci) { const float2 bb = Bp[1][p][ci]; acc[ci] += xr * bb.x - xi * bb.y; }
      }
    }
    uint4 o0, o1;
    o0.x = pack2bf(acc[0], acc[1]); o0.y = pack2bf(acc[2], acc[3]); o0.z = pack2bf(acc[4], acc[5]); o0.w = pack2bf(acc[6], acc[7]);
    o1.x = pack2bf(acc[8], acc[9]); o1.y = pack2bf(acc[10], acc[11]); o1.z = pack2bf(acc[12], acc[13]); o1.w = pack2bf(acc[14], acc[15]);
    bf16_t* kp = Ktab + (size_t)g * 127 * 256 + (size_t)i * 16;
    *(uint4*)kp = o0; *(uint4*)(kp + 8) = o1;
  }
  for (int i = part * 8192 + tid; i < (part + 1) * 8192; i += nct) {
    const int n = (i >> 11) * 16 + (i & 15), k8 = ((i >> 6) & 31) * 4 + ((i >> 4) & 3);
    const int dir = n >> 7, c = (n >> 6) & 1, p = n & 63, sidx = k8 >> 1, ci0 = (k8 & 1) * 8;
    const float2 w = pw[dir][dir == 0 ? 63 - sidx : sidx][p];
    float v[8];
#pragma unroll
    for (int j = 0; j < 8; ++j) { const float2 b = Bp[dir][p][ci0 + j]; v[j] = c == 0 ? (w.x * b.x - w.y * b.y) : (w.x * b.y + w.y * b.x); }
    uint4 o; o.x = pack2bf(v[0], v[1]); o.y = pack2bf(v[2], v[3]); o.z = pack2bf(v[4], v[5]); o.w = pack2bf(v[6], v[7]);
    *(uint4*)(Bst_t + (size_t)g * 256 * 1024 + (size_t)i * 8) = o;
  }
  for (int i = part * 8192 + tid; i < (part + 1) * 8192; i += nct) {
    const int n = (i >> 9) * 16 + (i & 15), k8 = ((i >> 6) & 7) * 4 + ((i >> 4) & 3);
    const int t = n >> 4, co = n & 15, dir = k8 >> 4, c = (k8 >> 3) & 1, p0 = (k8 & 7) * 8;
    const int e = dir == 0 ? t + 1 : 64 - t;
    float v[8];
#pragma unroll
    for (int j = 0; j < 8; ++j) { const float2 cc = Cc[dir][co][p0 + j], w = pw[dir][e][p0 + j];
      v[j] = c == 0 ? (cc.x * w.x - cc.y * w.y) : -(cc.x * w.y + cc.y * w.x); }
    uint4 o; o.x = pack2bf(v[0], v[1]); o.y = pack2bf(v[2], v[3]); o.z = pack2bf(v[4], v[5]); o.w = pack2bf(v[6], v[7]);
    *(uint4*)(Cin_t + (size_t)g * 1024 * 256 + (size_t)i * 8) = o;
  }
}
__device__ __forceinline__ void ph_s5_p1(const float* __restrict__ x, const float* __restrict__ ctx, const float* __restrict__ mod,
                                               const bf16_t* __restrict__ Ktab, const bf16_t* __restrict__ Bst_t, const float* __restrict__ dvec, bf16_t* __restrict__ Ypart, float* __restrict__ S, int bid, char* As) {
  const int g = bid >> 2, cc0 = (bid & 3) * 66, tid = otid();
  const int wave = tid >> 6, lane = tid & 63, l15 = lane & 15, q = lane >> 4;
  const float dch = dvec[g * 16 + l15];
#pragma unroll 4
  for (int i = tid; i < 66 * 64 * 2; i += 512) {
    const int half = i & 1, sidx = (i >> 1) & 63, r = i >> 7;
    const int tok = s5_token(cc0 + r, sidx), ch = g * 16 + half * 8;
    const float* src = (tok < NL ? x + (size_t)tok * D : ctx + (size_t)(tok - NL) * D) + ch;
    const float* m = mod + row_vec(tok) * 6144;
    const float4 a = *(const float4*)src, b = *(const float4*)(src + 4);
    const float4 sh0 = *(const float4*)(m + ch), sh1 = *(const float4*)(m + ch + 4), sc0 = *(const float4*)(m + 1024 + ch), sc1 = *(const float4*)(m + 1024 + ch + 4);
    uint4 o;
    o.x = pack2bf(a.x * (1.f + sc0.x) + sh0.x, a.y * (1.f + sc0.y) + sh0.y); o.y = pack2bf(a.z * (1.f + sc0.z) + sh0.z, a.w * (1.f + sc0.w) + sh0.w);
    o.z = pack2bf(b.x * (1.f + sc1.x) + sh1.x, b.y * (1.f + sc1.y) + sh1.y); o.w = pack2bf(b.z * (1.f + sc1.z) + sh1.z, b.w * (1.f + sc1.w) + sh1.w);
    *(uint4*)(As + r * LDA_B + sidx * 32 + half * 16) = o;
  }
  __syncthreads();
  const char* ap[5];
#pragma unroll
  for (int t = 0; t < 5; ++t) { int r = t * 16 + l15; r = r < 66 ? r : 65; ap[t] = As + r * LDA_B + q * 16; }
  const bf16_t* Kg = Ktab + (size_t)g * 127 * 256;
#pragma unroll 1
  for (int unit = wave; unit < 40; unit += 8) {
    f32x4 acc[5][2];
    if (unit < 32) {
      const int t0 = unit * 2;
      const bf16_t* w0 = Kg + (t0 + 63 - (q >> 1)) * 256 + l15 * 16 + (q & 1) * 8;
      gemm_unit<5, 1024>(ap, w0, w0 + 256, -16, acc);
      unsigned yw[20];
#pragma unroll
      for (int t = 0; t < 5; ++t)
#pragma unroll
        for (int j = 0; j < 2; ++j) {
          float yv[4];
#pragma unroll
          for (int r = 0; r < 4; ++r) {
            int row = t * 16 + q * 4 + r; row = row < 66 ? row : 65;
            yv[r] = acc[t][j][r] + dch * bf2f(*(const bf16_t*)(As + row * LDA_B + (t0 + j) * 32 + l15 * 2));
          }
          yw[(t * 2 + j) * 2] = pack2bf(yv[0], yv[1]); yw[(t * 2 + j) * 2 + 1] = pack2bf(yv[2], yv[3]);
        }
      uint4* yp = (uint4*)(Ypart + (((size_t)bid * 32 + unit) * 64 + lane) * 40);
#pragma unroll
      for (int c = 0; c < 5; ++c) yp[c] = make_uint4(yw[4 * c], yw[4 * c + 1], yw[4 * c + 2], yw[4 * c + 3]);
    } else {
      const int n0 = (unit - 32) * 32;
      const bf16_t* w0 = Bst_t + (size_t)g * 256 * 1024 + (size_t)(n0 >> 4) * 1024 * 16 + lane * 8;
      gemm_unit<5, 1024>(ap, w0, w0 + 1024 * 16, 16, acc);
#pragma unroll
      for (int t = 0; t < 5; ++t)
#pragma unroll
        for (int j = 0; j < 2; ++j)
#pragma unroll
          for (int r = 0; r < 4; ++r) {
            const int row = t * 16 + q * 4 + r;
            if (row < 66) S[((size_t)(cc0 + row) * 64 + g) * 256 + n0 + j * 16 + l15] = acc[t][j][r];
          }
    }
  }
}
__device__ __forceinline__ void ph_s5_carry(const float* __restrict__ S, const float* __restrict__ a_re, const float* __restrict__ a_im,
                                                 const float* __restrict__ log_dt, bf16_t* __restrict__ HP, int id, int p) {
  const int dir = id & 1, g = (id >> 1) & 63, b = id >> 7;
  const int gp = (dir * 64 + g) * 64 + p;
  const float are = a_re[gp], aim = a_im[gp], dt = expf(log_dt[dir * 64 + g]);
  const float mag = expf(are * dt);
  float tr = mag * cosf(aim * dt), ti = mag * sinf(aim * dt);
#pragma unroll
  for (int i = 0; i < 6; ++i) { const float nr = tr * tr - ti * ti, ni = 2.f * tr * ti; tr = nr; ti = ni; }
  float hr = 0.f, hi = 0.f;
#pragma unroll 22
  for (int step = 0; step < NCHUNK; ++step) {
    const int c = dir == 0 ? step : (step < 4 ? 3 - step : NCHUNK - 1 - (step - 4));
    const size_t base = ((size_t)(b * NCHUNK + c) * 64 + g) * 256 + dir * 128 + p;
    HP[base] = f2bf(hr); HP[base + 64] = f2bf(hi);
    const float sr = S[base], si = S[base + 64];
    const float nr = tr * hr - ti * hi + sr, ni = tr * hi + ti * hr + si;
    hr = nr; hi = ni;
  }
}
__device__ __forceinline__ void ph_s5_p3(const bf16_t* __restrict__ HP, const bf16_t* __restrict__ Cin_t, const bf16_t* __restrict__ Ypart, bf16_t* __restrict__ Gbf, int bid, char* As) {
  const int g = bid >> 2, cc0 = (bid & 3) * 66, tid = otid();
  for (int i = tid; i < 66 * 32; i += 512) {
    const int r = i >> 5, c = i & 31;
    *(uint4*)(As + r * 528 + c * 16) = *(const uint4*)(HP + ((size_t)(cc0 + r) * 64 + g) * 256 + c * 8);
  }
  __syncthreads();
  const int wave = otid() >> 6, lane = otid() & 63, l15 = lane & 15, q = lane >> 4;
  const char* ap[5];
#pragma unroll
  for (int t = 0; t < 5; ++t) { int r = t * 16 + l15; r = r < 66 ? r : 65; ap[t] = As + r * 528 + q * 16; }
#pragma unroll 1
  for (int unit = wave; unit < 32; unit += 8) {
    const uint4* yp = (const uint4*)(Ypart + (((size_t)bid * 32 + unit) * 64 + lane) * 40);
    unsigned yw[20];
#pragma unroll
    for (int c = 0; c < 5; ++c) { const uint4 y4 = yp[c]; yw[4 * c] = y4.x; yw[4 * c + 1] = y4.y; yw[4 * c + 2] = y4.z; yw[4 * c + 3] = y4.w; }
    const bf16_t* w0 = Cin_t + (size_t)g * 1024 * 256 + (size_t)(unit * 2) * 256 * 16 + lane * 8;
    f32x4 acc[5][2];
    gemm_unit<5, 256>(ap, w0, w0 + 256 * 16, 16, acc);
#pragma unroll
    for (int t = 0; t < 5; ++t)
#pragma unroll
      for (int j = 0; j < 2; ++j)
#pragma unroll
        for (int r = 0; r < 4; ++r) {
          const int row = t * 16 + q * 4 + r;
          const unsigned w = yw[(t * 2 + j) * 2 + (r >> 1)];
          const float y = acc[t][j][r] + ((r & 1) ? bfhi(w) : bflo(w));
          if (row < 66) Gbf[(size_t)s5_token(cc0 + row, unit * 2 + j) * D + g * 16 + l15] = f2bf(gelu_fast(y));
        }
  }
}


struct ChainP {
  const bf16_t* Ain;
  const bf16_t* Wglu_t; const bf16_t* Wo_t; const bf16_t* Wq_t;
  bf16_t* Vbf; bf16_t* O; const float* Hl; const float* Hc; const float* mod; const float* lng; const float* lnb;
  float* Hout; bf16_t* Tbf; bf16_t* Q;
};
template <bool L0>
__device__ __forceinline__ void ph_chainA(const ChainP& p, int bid, char* As) {
  constexpr int NR = L0 ? 66 : 64;
  constexpr int RT = L0 ? 5 : 4;
  const int g0 = bid * NR;
  load_rows_lds(As, p.Ain + (size_t)g0 * D, NR);
  __syncthreads();
  if (L0) {
    gemm_ldsA<RT, 1024>(As, LDA_B, NR, p.Wglu_t, D, EpiGluL{As, p.Vbf + (size_t)g0 * D});
    __syncthreads();
    load_rows_lds(As, p.Vbf + (size_t)g0 * D, NR);
    __syncthreads();
  }
  if constexpr (L0) gemm_ldsA<RT, 1024>(As, LDA_B, NR, p.Wo_t, D, EpiBF16{p.O + (size_t)g0 * D, D});
  else gemm_ldsA8<RT, 1024>(As, LDA_B, NR, (const unsigned char*)p.Wo_t, D, EpiBF16{p.O + (size_t)g0 * D, D});
  __syncthreads();
  ln_rows(As, g0, NR, p.Hl, p.Hc, p.O, p.mod, 2, p.lng, p.lnb, p.Hout, p.Tbf, 3, 4);
  __syncthreads();
  gemm_ldsA<RT, 1024>(As, LDA_B, NR, p.Wq_t, D, EpiBF16{p.Q + (size_t)g0 * D, D});
}


constexpr int KEYS = SEQ + CTX;
constexpr float att_KS = 0.5f;
struct EpiKV { unsigned char* Kn; unsigned char* Vl; int g0; int sh; __device__ __forceinline__ void operator()(int row, int col, float v) const {
  const int head = col >> 8, j = col & 255;
  if (j < 128) {
    const int g = g0 + row; int b, key;
    if (g < NL) { b = g >> 13; key = g & (SEQ - 1); } else { const int cidx = g - NL; b = cidx >> 8; key = SEQ + (cidx & (CTX - 1)); }
    Kn[((size_t)(b * 8 + head) * KEYS + key) * 128 + j] = f2fp8(v * att_KS);
  } else Vl[(head * 128 + (j - 128)) * 68 + row + sh] = f2fp8(v * 4.f);
} };
struct EpiQ { bf16_t* Qa; int g0; int pad; __device__ __forceinline__ void operator()(int row, int col, float v) const {
  const int g = g0 + row, b = g >> 13, n = g & (SEQ - 1);
  const int head = col / 192, j = col - head * 192;
  Qa[((size_t)(b * 8 + head) * SEQ + n) * 192 + j] = f2bf(v);
} };
struct ProjP { const bf16_t* Wcat_t; const bf16_t* Wuq_t; const bf16_t* Wukv_t; const float* q_norm; const float* kv_norm;
               float* PR; bf16_t* Qa; unsigned char* Kn; unsigned char* Kr; unsigned char* Va; };
__device__ __forceinline__ void ph_mla_proj(const ProjP& p, int bid, char* As) {
  const int g0 = bid * 66, wave = otid() >> 6, lane = otid() & 63;
  gemm_ldsA8<5, 1024>(As, LDA_B, 66, (const unsigned char*)p.Wcat_t, 704, EpiF32{p.PR + (size_t)g0 * D, D});
  __syncthreads();
  char* A1 = As; char* A2 = As + 66 * 784;
  for (int rr = wave; rr < 66; rr += 8) {
    const int g = g0 + rr;
    const float* pr = p.PR + (size_t)g * D;
    float v[6]; float ss = 0.f;
#pragma unroll
    for (int i = 0; i < 6; ++i) { v[i] = pr[i * 64 + lane]; ss += v[i] * v[i]; }
    float rn = rsqrtf(wave_sum(ss) * (1.f / 384.f) + RMS_EPS);
#pragma unroll
    for (int i = 0; i < 6; ++i) *(bf16_t*)(A1 + rr * 784 + (i * 64 + lane) * 2) = f2bf(v[i] * rn * p.q_norm[i * 64 + lane]);
    float w[4]; ss = 0.f;
#pragma unroll
    for (int i = 0; i < 4; ++i) { w[i] = pr[384 + i * 64 + lane]; ss += w[i] * w[i]; }
    rn = rsqrtf(wave_sum(ss) * (1.f / 256.f) + RMS_EPS);
#pragma unroll
    for (int i = 0; i < 4; ++i) *(bf16_t*)(A2 + rr * 528 + (i * 64 + lane) * 2) = f2bf(w[i] * rn * p.kv_norm[i * 64 + lane]);
    if (lane < 32) {
      float x1 = pr[640 + lane], x2 = pr[672 + lane];
      int b, key;
      if (g < NL) {
        b = g >> 13; key = g & (SEQ - 1);
        const int n = key, rr2 = n >> 6, cc = n & 63;
        const float inv = powf(10000.f, -(float)(lane & 15) / 16.f);
        const float ang = (lane < 16 ? (float)rr2 : (float)cc) * inv;
        const float cs = cosf(ang), sn = sinf(ang);
        const float y1 = x1 * cs - x2 * sn, y2 = x2 * cs + x1 * sn; x1 = y1; x2 = y2;
      } else { const int cidx = g - NL; b = cidx >> 8; key = SEQ + (cidx & (CTX - 1)); }
      unsigned char* kp = p.Kr + ((size_t)b * KEYS + key) * 64;
      kp[lane] = f2fp8(x1 * att_KS); kp[32 + lane] = f2fp8(x2 * att_KS);
    }
  }
  __syncthreads();
  int nq = NL - g0; nq = nq > 66 ? 66 : nq;
  if (nq > 0) gemm_ldsA8<5, 384>(A1, 784, nq, (const unsigned char*)p.Wuq_t, 1536, EpiQ{p.Qa, g0, 0});
  unsigned char* Vl = (unsigned char*)As + 66 * 784 + 66 * 528;
  const int sh = g0 & 3;
  gemm_ldsA8<5, 256>(A2, 528, 66, (const unsigned char*)p.Wukv_t, 2048, EpiKV{p.Kn, Vl, g0, sh});
  __syncthreads();
  for (int i = otid(); i < 1024 * 17; i += 512) {
    const int dvg = i / 17, q4 = i - dvg * 17, g4 = g0 - sh + 4 * q4;
    const unsigned w = *(const unsigned*)(Vl + dvg * 68 + 4 * q4);
    int b, key;
    if (g4 < NL) { b = g4 >> 13; key = g4 & (SEQ - 1); } else { const int cidx = g4 - NL; b = cidx >> 8; key = SEQ + (cidx & (CTX - 1)); }
    const int m = (key & 63) >> 2, posd = (m & 1) * 8 + (m >> 3) * 4 + ((m >> 1) & 3);
    unsigned char* dst = p.Va + ((size_t)(b * 8 + (dvg >> 7)) * (KEYS / 64) + (key >> 6)) * 8192 + (dvg & 127) * 64 + posd * 4;
    if (g4 >= g0 && g4 + 3 < g0 + 66) *(unsigned*)dst = w;
    else if (g4 < g0) *(unsigned short*)(dst + 2) = (unsigned short)(w >> 16);
    else *(unsigned short*)dst = (unsigned short)(w & 0xFFFFu);
  }
  for (int rr = wave; rr < nq; rr += 8) {
    const int g = g0 + rr, b = g >> 13, n = g & (SEQ - 1);
    if (lane < 32) {
      const float inv = powf(10000.f, -(float)(lane & 15) / 16.f);
      const float ang = (lane < 16 ? (float)(n >> 6) : (float)(n & 63)) * inv;
      const float cs = cosf(ang), sn = sinf(ang);
#pragma unroll
      for (int h = 0; h < 8; ++h) {
        bf16_t* qo = p.Qa + ((size_t)(b * 8 + h) * SEQ + n) * 192;
        const float x1 = bf2f(qo[128 + lane]), x2 = bf2f(qo[160 + lane]);
        qo[128 + lane] = f2bf(x1 * cs - x2 * sn); qo[160 + lane] = f2bf(x2 * cs + x1 * sn);
      }
    }
  }
}

namespace att {
using i32x8 = __attribute__((ext_vector_type(8))) int;
using i32x4 = __attribute__((ext_vector_type(4))) int;
using f32x16 = __attribute__((ext_vector_type(16))) float;
constexpr int KVBLK = 64, KROW = 208, VROW = 80, NTILE = KEYS / 64;
constexpr float KS = 0.5f, VS = 4.f;
constexpr float QS = 0.07216878364870322f * 1.4426950408889634f / KS;
constexpr float THR2 = 3.f * 1.4426950408889634f, PSH = 4.f;
constexpr int SHM_V = 128 * VROW, SHM_K = KVBLK * KROW, NSLOT = 3, SHM_ATTN = NSLOT * (SHM_V + SHM_K) + 8 * 64 * 4;
#define SBAR() __builtin_amdgcn_sched_barrier(0)
__device__ __forceinline__ int crow(int r, int hi) { return (r & 3) + 8 * (r >> 2) + 4 * hi; }
__device__ __forceinline__ f32x16 mfma8(i32x8 a, i32x8 b, f32x16 c) { return __builtin_amdgcn_mfma_scale_f32_32x32x64_f8f6f4(a, b, c, 0, 0, 0, 0, 0, 0); }
__device__ __forceinline__ i32x8 cat8(i32x4 a, i32x4 b) { return __builtin_shufflevector(a, b, 0, 1, 2, 3, 4, 5, 6, 7); }
__device__ __forceinline__ int pk4(float a, float b, float c, float d, int old = 0) { const int w = __builtin_amdgcn_cvt_pk_fp8_f32(a, b, old, false); return __builtin_amdgcn_cvt_pk_fp8_f32(c, d, w, true); }
__device__ __forceinline__ void softmax_tile(f32x16& p0, f32x16& p1, f32x16& bias, bool first, f32x16* o, float* al_l, int r32, int hi, i32x8& pa) {
  float pmax = p0[0];
#pragma unroll
  for (int r = 1; r < 16; ++r) pmax = fmaxf(pmax, p0[r]);
#pragma unroll
  for (int r = 0; r < 16; ++r) pmax = fmaxf(pmax, p1[r]);
  { auto rr = __builtin_amdgcn_permlane32_swap(__float_as_uint(pmax), __float_as_uint(pmax), false, false);
    pmax = fmaxf(__uint_as_float(rr[0]), __uint_as_float(rr[1])); }
  if (__builtin_expect(first || !__all(pmax <= PSH + THR2), 0)) {
    const float delta = first ? pmax - PSH : fmaxf(pmax - PSH, 0.f);
    if (!first) {
      if (hi == 0) al_l[r32] = __builtin_amdgcn_exp2f(-delta);
      asm volatile("s_waitcnt lgkmcnt(0)" ::: "memory");
#pragma unroll
      for (int d = 0; d < 5; ++d)
#pragma unroll
        for (int r = 0; r < 16; ++r) o[d][r] *= al_l[crow(r, hi)];
    }
    const float nb = bias[0] - delta;
#pragma unroll
    for (int r = 0; r < 16; ++r) { p0[r] -= delta; p1[r] -= delta; bias[r] = nb; }
  }
#pragma unroll
  for (int r = 0; r < 16; ++r) p0[r] = __builtin_amdgcn_exp2f(p0[r]);
#pragma unroll
  for (int r = 0; r < 16; ++r) p1[r] = __builtin_amdgcn_exp2f(p1[r]);
#pragma unroll
  for (int w = 0; w < 4; ++w) { pa[w] = pk4(p0[4 * w], p0[4 * w + 1], p0[4 * w + 2], p0[4 * w + 3], pa[w]); pa[4 + w] = pk4(p1[4 * w], p1[4 * w + 1], p1[4 * w + 2], p1[4 * w + 3], pa[4 + w]); }
}
__device__ __forceinline__ void qkt(f32x16& p0, f32x16& p1, const f32x16& bias, const char* Ks, const i32x8* q, int r32, int hi) {
  p0 = bias; p1 = bias;
  const char* k0 = Ks + r32 * KROW + hi * 32; const char* k1 = k0 + 32 * KROW;
#pragma unroll
  for (int s = 0; s < 3; ++s) {
    const i32x8 a0 = cat8(*reinterpret_cast<const i32x4*>(k0 + s * 64), *reinterpret_cast<const i32x4*>(k0 + s * 64 + 16));
    const i32x8 a1 = cat8(*reinterpret_cast<const i32x4*>(k1 + s * 64), *reinterpret_cast<const i32x4*>(k1 + s * 64 + 16));
    p0 = mfma8(a0, q[s], p0);
    p1 = mfma8(a1, q[s], p1); }
}
__device__ __forceinline__ void pv_all(f32x16* o, const char* Vs, i32x8 pa, int r32, int hi) {
  const char* v0 = Vs + r32 * VROW + hi * 32;
#pragma unroll
  for (int d0 = 0; d0 < 4; ++d0) {
    const i32x8 vb = cat8(*reinterpret_cast<const i32x4*>(v0 + d0 * 32 * VROW), *reinterpret_cast<const i32x4*>(v0 + d0 * 32 * VROW + 16));
    o[d0] = mfma8(pa, vb, o[d0]); }
  const i32x8 ones = {0x38383838, 0x38383838, 0x38383838, 0x38383838, 0x38383838, 0x38383838, 0x38383838, 0x38383838};
  o[4] = mfma8(pa, ones, o[4]);
}
__device__ __forceinline__ void attn_body(const bf16_t* __restrict__ Qb, const unsigned char* __restrict__ Kn, const unsigned char* __restrict__ Krb, const unsigned char* __restrict__ Vt,
                                          bf16_t* __restrict__ Ob, char* lds) {
  const int tid = otid(), wid = tid >> 6, lane = tid & 63, r32 = lane & 31, hi = lane >> 5;
  const bool lo4 = __builtin_amdgcn_readfirstlane(wid >> 2) == 0;
  char* V_lds = lds; char* K_lds = lds + NSLOT * SHM_V;
  float* al_l = (float*)(lds + NSLOT * (SHM_V + SHM_K)) + wid * 64;
  f32x16 bias = {}; f32x16 o[5] = {}; i32x8 q[3];
  { const bf16_t* Qw = Qb + (size_t)(wid * 32 + r32) * 192 + hi * 32;
#pragma unroll
    for (int s = 0; s < 3; ++s) {
#pragma unroll
      for (int c = 0; c < 4; ++c) { const uint4 w = *reinterpret_cast<const uint4*>(Qw + s * 64 + c * 8);
        q[s][2 * c] = pk4(bflo(w.x) * QS, bfhi(w.x) * QS, bflo(w.y) * QS, bfhi(w.y) * QS);
        q[s][2 * c + 1] = pk4(bflo(w.z) * QS, bfhi(w.z) * QS, bflo(w.w) * QS, bfhi(w.w) * QS); } } }
  i32x8 ones = {0x38383838, 0x38383838, 0x38383838, 0x38383838, 0x38383838, 0x38383838, 0x38383838, 0x38383838};
  const int vdst = (tid >> 2) * VROW + (tid & 3) * 16, kdst = (tid >> 3) * KROW + (tid & 7) * 16, rdst = (tid >> 2) * KROW + 128 + (tid & 3) * 16;
  const int kfo = r32 * KROW + hi * 32, vfo = r32 * VROW + hi * 32;
  uint4 vs, ks, rs = make_uint4(0u, 0u, 0u, 0u);
#define TLOAD(t) do { ks = *reinterpret_cast<const uint4*>(Kn + (size_t)(t) * 8192 + tid * 16); vs = *reinterpret_cast<const uint4*>(Vt + (size_t)(t) * 8192 + tid * 16); \
    if (lo4) rs = *reinterpret_cast<const uint4*>(Krb + (size_t)(t) * 4096 + tid * 16); } while (0)
#define TWRITE(sl) do { *(uint4*)(K_lds + (sl) * SHM_K + kdst) = ks; *(uint4*)(V_lds + (sl) * SHM_V + vdst) = vs; if (lo4) *(uint4*)(K_lds + (sl) * SHM_K + rdst) = rs; } while (0)
#define SWAIT() asm volatile("s_waitcnt vmcnt(0)" ::: "memory")
#define LD4(p) (*reinterpret_cast<const i32x4*>(p))
  f32x16 p0, p1; i32x8 pa = {};
  TLOAD(0); SWAIT(); TWRITE(0);
  TLOAD(1); SWAIT(); TWRITE(1);
  TLOAD(2);
  __syncthreads();
  int sl = 0, sl2 = 2;
#pragma unroll 1
  for (int i = 0; i < NTILE; ++i) {
    const char* kb = K_lds + sl * SHM_K + kfo; const char* vb = V_lds + sl * SHM_V + vfo;
    SBAR();
    i32x4 ka0 = LD4(kb), ka1 = LD4(kb + 16), ka2 = LD4(kb + 32 * KROW), ka3 = LD4(kb + 32 * KROW + 16);
    i32x4 kb0 = LD4(kb + 64), kb1 = LD4(kb + 80), kb2 = LD4(kb + 32 * KROW + 64), kb3 = LD4(kb + 32 * KROW + 80);
    SBAR();
    p0 = mfma8(cat8(ka0, ka1), q[0], bias); p1 = mfma8(cat8(ka2, ka3), q[0], bias);
    ka0 = LD4(kb + 128); ka1 = LD4(kb + 144); ka2 = LD4(kb + 32 * KROW + 128); ka3 = LD4(kb + 32 * KROW + 144);
    SBAR();
    p0 = mfma8(cat8(kb0, kb1), q[1], p0); p1 = mfma8(cat8(kb2, kb3), q[1], p1);
    i32x4 v00 = LD4(vb), v01 = LD4(vb + 16), v10 = LD4(vb + 32 * VROW), v11 = LD4(vb + 32 * VROW + 16);
    SBAR();
    p0 = mfma8(cat8(ka0, ka1), q[2], p0); p1 = mfma8(cat8(ka2, ka3), q[2], p1);
    SBAR();
    softmax_tile(p0, p1, bias, i == 0, o, al_l, r32, hi, pa);
    SBAR();
    i32x4 v20 = LD4(vb + 64 * VROW), v21 = LD4(vb + 64 * VROW + 16), v30 = LD4(vb + 96 * VROW), v31 = LD4(vb + 96 * VROW + 16);
    o[4] = mfma8(pa, ones, o[4]); o[0] = mfma8(pa, cat8(v00, v01), o[0]); o[1] = mfma8(pa, cat8(v10, v11), o[1]);
    SBAR();
    o[2] = mfma8(pa, cat8(v20, v21), o[2]); o[3] = mfma8(pa, cat8(v30, v31), o[3]);
    SBAR();
    SWAIT();
    if (i + 2 < NTILE) TWRITE(sl2);
    if (i + 3 < NTILE) TLOAD(i + 3);
    sl = sl == NSLOT - 1 ? 0 : sl + 1; sl2 = sl2 == NSLOT - 1 ? 0 : sl2 + 1;
    SBAR(); __syncthreads();
  }
  float rli[16];
#pragma unroll
  for (int r = 0; r < 16; ++r) rli[r] = __builtin_amdgcn_rcpf(o[4][r]) * (1.f / VS);
  bf16_t* Ow = Ob + (size_t)(wid * 32) * D;
#pragma unroll
  for (int r = 0; r < 16; ++r) { const int orow = crow(r, hi);
#pragma unroll
    for (int d0 = 0; d0 < 4; ++d0) Ow[(size_t)orow * D + d0 * 32 + r32] = f2bf(o[d0][r] * rli[r]); }
  __syncthreads();
#undef TLOAD
#undef TWRITE
#undef SWAIT
#undef LD4
}
}

__device__ __forceinline__ void ph_attn(const bf16_t* __restrict__ Qa, const unsigned char* __restrict__ Kn, const unsigned char* __restrict__ Kr, const unsigned char* __restrict__ Vt,
                                        bf16_t* __restrict__ AO, int bid, int nblk, char* lds) {
  for (int item = bid; item < 512; item += nblk) {
    const int b = item >> 8, h = item & 7, qb = (item >> 3) & 31;
    att::attn_body(Qa + ((size_t)(b * 8 + h) * SEQ + qb * 256) * 192, Kn + (size_t)(b * 8 + h) * KEYS * 128, Kr + (size_t)b * KEYS * 64,
                   Vt + (size_t)(b * 8 + h) * KEYS * 128, AO + (size_t)(b * SEQ + qb * 256) * D + h * 128, lds);
  }
}

namespace rt {
using f32x16 = __attribute__((ext_vector_type(16))) float;
__device__ __forceinline__ int sortable(float f) { const int b = __float_as_int(f); return b ^ ((b >> 31) & 0x7FFFFFFF); }
__device__ __forceinline__ float unsortable(int k) { return __int_as_float(k ^ ((k >> 31) & 0x7FFFFFFF)); }
__device__ __forceinline__ int imax(int a, int b) { return a > b ? a : b; }
__device__ __forceinline__ int imin(int a, int b) { return a < b ? a : b; }
template <int N> __device__ __forceinline__ void sort_desc(int (&v)[N]) {
#pragma unroll
  for (int k = 2; k <= N; k <<= 1) {
#pragma unroll
    for (int j = k >> 1; j > 0; j >>= 1) {
#pragma unroll
      for (int i = 0; i < N; ++i) {
        const int l = i ^ j;
        if (l > i) {
          const bool desc = ((i & k) == 0);
          const int a = v[i], b = v[l];
          v[i] = desc ? imax(a, b) : imin(a, b);
          v[l] = desc ? imin(a, b) : imax(a, b);
        }
      }
    }
  }
}
template <int N> __device__ __forceinline__ void merge_desc(int (&v)[N]) {
#pragma unroll
  for (int j = N >> 1; j > 0; j >>= 1) {
#pragma unroll
    for (int i = 0; i < N; ++i) {
      const int l = i ^ j;
      if (l > i) { const int a = v[i], b = v[l]; v[i] = imax(a, b); v[l] = imin(a, b); }
    }
  }
}
__device__ __forceinline__ void absorb16(int (&L)[16], int (&B)[16]) {
  sort_desc<16>(B);
#pragma unroll
  for (int i = 0; i < 16; ++i) L[i] = imax(L[i], B[15 - i]);
  merge_desc<16>(L);
}
__device__ __forceinline__ constexpr int npairs_row(int i) { return 16 / (i + 1); }
}

struct RouteP { const bf16_t* Q; const bf16_t* Khi; int* IDX; float* GATE; int rows_per_block; int pad; };
__device__ __forceinline__ void ph_route(const RouteP& p, int bid, char* lds) {
  using namespace rt;
  int (*svl)[64][33] = reinterpret_cast<int (*)[64][33]>(lds);
  const int wave = otid() >> 6, lane = otid() & 63, r32 = lane & 31, hi = lane >> 5, hi4 = hi * 4;
  int nrows = p.rows_per_block; asm volatile("" : "+s"(nrows));
  const int g0 = bid * nrows;
  const int h = wave;
#pragma unroll 1
  for (int tg = 0; tg * 32 < nrows; ++tg) {
    int trow = tg * 32 + r32; const bool valid = trow < nrows; trow = valid ? trow : nrows - 1;
    const bf16_t* qrow = p.Q + (size_t)(g0 + trow) * D;
    int sv[2][16];
#pragma unroll
    for (int s = 0; s < 2; ++s) {
      const int hs = h * 2 + s;
      f32x16 acc[4];
#pragma unroll
      for (int m = 0; m < 4; ++m) acc[m] = f32x16{};
#pragma unroll
      for (int kp = 0; kp < 2; ++kp) {
        bf16x8 kf[2][4], qf[2];
#pragma unroll
        for (int k2 = 0; k2 < 2; ++k2)
#pragma unroll
          for (int m = 0; m < 4; ++m) kf[k2][m] = *(const bf16x8*)(p.Khi + ((size_t)(hs * 128 + m * 32 + r32)) * 64 + (kp * 2 + k2) * 16 + hi * 8);
#pragma unroll
        for (int k2 = 0; k2 < 2; ++k2) {
          const int ks = kp * 2 + k2;
          qf[k2] = *(const bf16x8*)(qrow + hs * 64 + ks * 16 + hi * 8);
        }
#pragma unroll
        for (int k2 = 0; k2 < 2; ++k2)
#pragma unroll
          for (int m = 0; m < 4; ++m) acc[m] = __builtin_amdgcn_mfma_f32_32x32x16_bf16(kf[k2][m], qf[k2], acc[m], 0, 0, 0);
      }
      int L[16];
#pragma unroll
      for (int m = 0; m < 4; ++m) {
        int B[16];
#pragma unroll
        for (int r = 0; r < 16; ++r) B[r] = (sortable(acc[m][r]) & ~0x7F) | (m * 32 + (r & 3) + 8 * (r >> 2)) | hi4;
        if (m == 0) { sort_desc<16>(B);
#pragma unroll
          for (int i = 0; i < 16; ++i) L[i] = B[i]; }
        else absorb16(L, B);
      }
      int Lo[16], Hi[16];
#pragma unroll
      for (int i = 0; i < 16; ++i) { auto rr = __builtin_amdgcn_permlane32_swap((unsigned)L[i], (unsigned)L[i], false, false); Lo[i] = (int)rr[0]; Hi[i] = (int)rr[1]; }
#pragma unroll
      for (int i = 0; i < 16; ++i) L[i] = imax(Lo[i], Hi[15 - i]);
      merge_desc<16>(L);
#pragma unroll
      for (int i = 0; i < 16; ++i) { sv[s][i] = L[i]; svl[wave][lane][s * 16 + i] = L[i]; }
    }
    float f0[16], f1[16];
#pragma unroll
    for (int i = 0; i < 16; ++i) { f0[i] = unsortable(sv[0][i] & ~0x7F); f1[i] = unsortable(sv[1][i] & ~0x7F); }
    int Lc[16];
    {
      int C[64];
      int n = 0;
#pragma unroll
      for (int i = 0; i < 16; ++i)
#pragma unroll
        for (int j = 0; j < 16; ++j)
          if ((i + 1) * (j + 1) <= 16) { C[n] = (sortable(f0[i] + f1[j]) & ~0xFF) | (i * 16 + j); ++n; }
#pragma unroll
      for (int k = 50; k < 64; ++k) C[k] = (int)0x80000000;
#pragma unroll
      for (int m = 0; m < 4; ++m) {
        int B[16];
#pragma unroll
        for (int r = 0; r < 16; ++r) B[r] = C[m * 16 + r];
        if (m == 0) { sort_desc<16>(B);
#pragma unroll
          for (int i = 0; i < 16; ++i) Lc[i] = B[i]; }
        else absorb16(Lc, B);
      }
    }
    float e[16]; float esum = 0.f;
    const float vmax = unsortable(Lc[0] & ~0xFF);
#pragma unroll
    for (int r = 0; r < 16; ++r) { e[r] = expf(unsortable(Lc[r] & ~0xFF) - vmax); esum += e[r]; }
    const float inv = 1.f / esum;
    int eid[16];
#pragma unroll
    for (int r = 0; r < 16; ++r) {
      const int pr = Lc[r] & 0xFF;
      const int k0 = svl[wave][lane][pr >> 4] & 0x7F, k1 = svl[wave][lane][16 + (pr & 15)] & 0x7F;
      eid[r] = k0 * 128 + k1;
    }
    if (valid && hi == 0) {
      int* ip = p.IDX + (size_t)(g0 + trow) * 128 + h * 16; float* gp = p.GATE + (size_t)(g0 + trow) * 128 + h * 16;
#pragma unroll
      for (int r = 0; r < 16; r += 4) {
        *(int4*)(ip + r) = make_int4(eid[r], eid[r + 1], eid[r + 2], eid[r + 3]);
        *(float4*)(gp + r) = make_float4(e[r] * inv, e[r + 1] * inv, e[r + 2] * inv, e[r + 3] * inv);
      }
    }
  }
}

constexpr int RB = 8;
template <bool SIGNED>
__device__ __forceinline__ void cvt_rows_i8(const float* __restrict__ src, unsigned char* __restrict__ dst, float* __restrict__ scl, int nrows, int wgid, int nw) {
  const int lane = otid() & 63;
  for (int r0 = wgid * RB; r0 < nrows; r0 += nw * RB) {
    float v[RB][16];
#pragma unroll
    for (int u = 0; u < RB; ++u) {
      const float* sp = src + (size_t)(r0 + u) * D + lane * 4;
      *(float4*)&v[u][0] = *(const float4*)sp; *(float4*)&v[u][4] = *(const float4*)(sp + 256); *(float4*)&v[u][8] = *(const float4*)(sp + 512); *(float4*)&v[u][12] = *(const float4*)(sp + 768);
    }
#pragma unroll
    for (int u = 0; u < RB; ++u) {
      float am = 0.f;
#pragma unroll
      for (int j = 0; j < 16; ++j) am = fmaxf(am, fabsf(v[u][j]));
      am = wave_max_dpp(am);
      const float sc = am > 0.f ? am * (1.f / 127.f) : 1.f, inv = 1.f / sc;
      unsigned w[4];
#pragma unroll
      for (int q4 = 0; q4 < 4; ++q4) {
        unsigned ww = 0u;
#pragma unroll
        for (int j = 0; j < 4; ++j) { int qi = (int)rintf(v[u][q4 * 4 + j] * inv) + (SIGNED ? 0 : 128); qi = SIGNED ? (qi < -127 ? -127 : (qi > 127 ? 127 : qi)) : (qi < 1 ? 1 : (qi > 255 ? 255 : qi)); ww |= (unsigned)(qi & 255) << (8 * j); }
        w[q4] = ww;
      }
      *(uint4*)(dst + (size_t)(r0 + u) * D + lane * 16) = make_uint4(w[0], w[1], w[2], w[3]);
      if (lane == 0) scl[r0 + u] = sc;
    }
  }
}

constexpr int QROW = 512;
__device__ __forceinline__ void cvt_rows_q6(const float* __restrict__ src, unsigned char* __restrict__ dst, float* __restrict__ scl, int nrows, int wgid, int nw) {
  const int lane = otid() & 63;
  for (int r0 = wgid * RB; r0 < nrows; r0 += nw * RB) {
    float v[RB][16];
#pragma unroll
    for (int u = 0; u < RB; ++u) {
      const float* sp = src + (size_t)(r0 + u) * D + lane * 4;
      *(float4*)&v[u][0] = *(const float4*)sp; *(float4*)&v[u][4] = *(const float4*)(sp + 256); *(float4*)&v[u][8] = *(const float4*)(sp + 512); *(float4*)&v[u][12] = *(const float4*)(sp + 768);
    }
#pragma unroll
    for (int u = 0; u < RB; ++u) {
      float am = 0.f;
#pragma unroll
      for (int j = 0; j < 16; ++j) am = fmaxf(am, fabsf(v[u][j]));
      am = wave_max_dpp(am);
      const float sc = am > 0.f ? am * (1.f / 7.f) : 1.f, inv = 1.f / sc;
      unsigned w0 = 0u, w1 = 0u;
#pragma unroll
      for (int j = 0; j < 8; ++j) {
        int qa = (int)rintf(v[u][j] * inv) + 8; qa = qa < 1 ? 1 : (qa > 15 ? 15 : qa);
        int qb = (int)rintf(v[u][8 + j] * inv) + 8; qb = qb < 1 ? 1 : (qb > 15 ? 15 : qb);
        w0 |= (unsigned)qa << (4 * j); w1 |= (unsigned)qb << (4 * j);
      }
      *(uint2*)(dst + (size_t)(r0 + u) * QROW + lane * 8) = make_uint2(w0, w1);
      if (lane == 0) scl[r0 + u] = sc;
    }
  }
}
struct q6w { unsigned x, y, z; };
template <int J> __device__ __forceinline__ float q6(const q6w& w) {
  const unsigned x = J < 8 ? w.x : w.y; constexpr int sh = 4 * (J & 7);
  if constexpr (sh == 28) return (float)(x >> 28); else return (float)((x >> sh) & 15u);
}

struct GatherP { const bf16_t* Tbf; const int* IDX; const float* GATE; const unsigned char* utab; const unsigned char* vtab; const float* su; const float* sv;
                 const float* Hin; const float* mod; const float* lng; const float* lnb; float* Hout; const float* modT; };
#define UB0(w) ((float)((w) & 0xFFu))
#define UB1(w) ((float)(((w) >> 8) & 0xFFu))
#define UB2(w) ((float)(((w) >> 16) & 0xFFu))
#define UB3(w) ((float)((w) >> 24))
template <bool FINAL>
__device__ __forceinline__ void ln_token(const GatherP& p, int row, int rr, int lane, const float (&f)[16], float asum, char* As) {
  const int v = row_vec(row);
  const float* hin = p.Hin + (size_t)row * D + lane * 4;
  const float* gm = p.mod + v * 6144 + 5 * 1024 + lane * 4;
  const float off = 8.f * asum;
  float r[16]; float ssum = 0.f;
#pragma unroll
  for (int q4 = 0; q4 < 4; ++q4) {
    const float4 h4 = *(const float4*)(hin + q4 * 256), g4 = *(const float4*)(gm + q4 * 256);
    r[q4 * 4 + 0] = ALPHA * h4.x + g4.x * (f[q4 * 4 + 0] - off); r[q4 * 4 + 1] = ALPHA * h4.y + g4.y * (f[q4 * 4 + 1] - off);
    r[q4 * 4 + 2] = ALPHA * h4.z + g4.z * (f[q4 * 4 + 2] - off); r[q4 * 4 + 3] = ALPHA * h4.w + g4.w * (f[q4 * 4 + 3] - off);
    ssum += r[q4 * 4 + 0] + r[q4 * 4 + 1] + r[q4 * 4 + 2] + r[q4 * 4 + 3];
  }
  const float mu = wave_sum(ssum) * (1.f / D);
  float vs = 0.f;
#pragma unroll
  for (int j = 0; j < 16; ++j) { const float dlt = r[j] - mu; vs += dlt * dlt; }
  const float rstd = rsqrtf(wave_sum(vs) * (1.f / D) + LN_EPS);
  float o[16];
#pragma unroll
  for (int q4 = 0; q4 < 4; ++q4) {
    const float4 g4 = *(const float4*)(p.lng + q4 * 256 + lane * 4), b4 = *(const float4*)(p.lnb + q4 * 256 + lane * 4);
    o[q4 * 4 + 0] = (r[q4 * 4 + 0] - mu) * rstd * g4.x + b4.x; o[q4 * 4 + 1] = (r[q4 * 4 + 1] - mu) * rstd * g4.y + b4.y;
    o[q4 * 4 + 2] = (r[q4 * 4 + 2] - mu) * rstd * g4.z + b4.z; o[q4 * 4 + 3] = (r[q4 * 4 + 3] - mu) * rstd * g4.w + b4.w;
    *(float4*)(p.Hout + (size_t)row * D + q4 * 256 + lane * 4) = make_float4(o[q4 * 4 + 0], o[q4 * 4 + 1], o[q4 * 4 + 2], o[q4 * 4 + 3]);
  }
  if (!FINAL) {
    const float* mt = p.modT + v * 6144 + lane * 4;
#pragma unroll
    for (int q4 = 0; q4 < 4; ++q4) {
      const float4 sh = *(const float4*)(mt + q4 * 256), sc = *(const float4*)(mt + 1024 + q4 * 256);
      uint2 w; w.x = pack2bf(o[q4 * 4] * (1.f + sc.x) + sh.x, o[q4 * 4 + 1] * (1.f + sc.y) + sh.y); w.y = pack2bf(o[q4 * 4 + 2] * (1.f + sc.z) + sh.z, o[q4 * 4 + 3] * (1.f + sc.w) + sh.w);
      *(uint2*)(As + rr * LDA_B + (q4 * 256 + lane * 4) * 2) = w;
    }
  }
}
constexpr int PARTW = 1088;
template <bool FINAL>
__device__ __forceinline__ void ph_gather_tm(const GatherP& p, int g0, int nrows, char* As, float* __restrict__ PART) {
  const int tid = otid(), wave = tid >> 6, lane = tid & 63;
  const int nfull = nrows >> 3, extra = nrows & 7;
  const int nun = nfull + (extra ? 1 : 0);
  typedef unsigned u32x4_t __attribute__((ext_vector_type(4))); typedef unsigned u32x2_t __attribute__((ext_vector_type(2)));
  const __amdgpu_buffer_rsrc_t ursrc = __builtin_amdgcn_make_buffer_rsrc((void*)p.utab, 0, 0x7FFFFFFF, 0x00020000);
  const __amdgpu_buffer_rsrc_t vrsrc = __builtin_amdgcn_make_buffer_rsrc((void*)p.vtab, 0, 0x7FFFFFFF, 0x00020000);
  const int lane16 = lane * 16, lane8 = lane * 8;
  auto desc = [&](int un, int& rr, int& kbeg, int& kcnt, bool& partial) {
    if (un < nfull) { rr = wave + 8 * un; kbeg = 0; kcnt = 128; partial = false; }
    else { const int wpt = 8 / extra; rr = nfull * 8 + wave / wpt; kcnt = 128 / wpt; kbeg = (wave % wpt) * kcnt; partial = true; }
  };
  uint2 nt0, nt1, nt2, nt3; int nid_lo, nid_hi; float nga_lo, nga_hi;
#define NLOAD(row_) do { const bf16_t* tp_ = p.Tbf + (size_t)(row_) * D + lane * 4; nt0 = *(const uint2*)tp_; nt1 = *(const uint2*)(tp_ + 256); nt2 = *(const uint2*)(tp_ + 512); nt3 = *(const uint2*)(tp_ + 768); \
    nid_lo = p.IDX[(size_t)(row_) * 128 + lane]; nid_hi = p.IDX[(size_t)(row_) * 128 + 64 + lane]; nga_lo = p.GATE[(size_t)(row_) * 128 + lane]; nga_hi = p.GATE[(size_t)(row_) * 128 + 64 + lane]; } while (0)
  { int rr0, kb0, kc0; bool pa0; desc(0, rr0, kb0, kc0, pa0); NLOAD(g0 + rr0); }
#pragma unroll 1
  for (int un = 0; un < nun; ++un) {
    int rr, kbeg, kcnt; bool partial;
    desc(un, rr, kbeg, kcnt, partial);
    const int row = g0 + rr;
    float tf[16];
    {
      const uint2 t0 = nt0, t1 = nt1, t2 = nt2, t3 = nt3;
      tf[0] = bflo(t0.x); tf[1] = bfhi(t0.x); tf[2] = bflo(t0.y); tf[3] = bfhi(t0.y); tf[4] = bflo(t1.x); tf[5] = bfhi(t1.x); tf[6] = bflo(t1.y); tf[7] = bfhi(t1.y);
      tf[8] = bflo(t2.x); tf[9] = bfhi(t2.x); tf[10] = bflo(t2.y); tf[11] = bfhi(t2.y); tf[12] = bflo(t3.x); tf[13] = bfhi(t3.x); tf[14] = bflo(t3.y); tf[15] = bfhi(t3.y);
    }
    float tam = 0.f;
#pragma unroll
    for (int j = 0; j < 16; ++j) tam = fmaxf(tam, fabsf(tf[j]));
    tam = wave_max_dpp(tam);
    const float st = tam > 0.f ? tam * (1.f / 127.f) : 1.f, tinv = 1.f / st;
    int tq[4];
#pragma unroll
    for (int k4 = 0; k4 < 4; ++k4) {
      unsigned ww = 0u;
#pragma unroll
      for (int j = 0; j < 4; ++j) ww |= (unsigned)((int)rintf(tf[k4 * 4 + j] * tinv) & 255) << (8 * j);
      tq[k4] = (int)ww;
    }
    const int id_lo = nid_lo, id_hi = nid_hi;
    const float ga_lo = nga_lo, ga_hi = nga_hi;
    const float su_lo = p.su[id_lo], su_hi = p.su[id_hi], sv_lo = p.sv[id_lo], sv_hi = p.sv[id_hi];
    float f[16];
#pragma unroll
    for (int j = 0; j < 16; ++j) f[j] = 0.f;
    uint4 rb[8];
    int dlo = 0, dhi = 0;
#define ULOAD(slot, kk) do { const int e_ = __builtin_amdgcn_readlane((kk) < 64 ? id_lo : id_hi, (kk) & 63); \
      const u32x4_t u_ = __builtin_amdgcn_raw_buffer_load_b128(ursrc, lane16, e_ * D, 0);        \
      rb[slot].x = u_.x; rb[slot].y = u_.y; rb[slot].z = u_.z; rb[slot].w = u_.w; } while (0)
#define VLOAD(slot, kk) do { const int e_ = __builtin_amdgcn_readlane((kk) < 64 ? id_lo : id_hi, (kk) & 63); \
      const u32x2_t t_ = __builtin_amdgcn_raw_buffer_load_b64(vrsrc, lane8, e_ * QROW, 0); rb[slot].x = t_.x; rb[slot].y = t_.y; } while (0)
    auto proc4u = [&](int s0, int k0) {
      int dot[4];
#pragma unroll
      for (int u = 0; u < 4; ++u) {
        const uint4 a_ = rb[s0 + u];
        int di = __builtin_amdgcn_sdot4((int)a_.x, tq[0], 0, false); di = __builtin_amdgcn_sdot4((int)a_.y, tq[1], di, false);
        di = __builtin_amdgcn_sdot4((int)a_.z, tq[2], di, false); di = __builtin_amdgcn_sdot4((int)a_.w, tq[3], di, false);
        dot[u] = di;
      }
#define DPPSTEP(ctl, rm) do { _Pragma("unroll") for (int u = 0; u < 4; ++u) dot[u] += __builtin_amdgcn_update_dpp(0, dot[u], ctl, rm, 0xF, true); } while (0)
      DPPSTEP(0xB1, 0xF); DPPSTEP(0x4E, 0xF); DPPSTEP(0x141, 0xF); DPPSTEP(0x140, 0xF); DPPSTEP(0x142, 0xA); DPPSTEP(0x143, 0xC);
#undef DPPSTEP
      if (k0 < 64) {
#pragma unroll
        for (int u = 0; u < 4; ++u) dlo = __builtin_amdgcn_update_dpp(dot[u], dlo, 0x130, 0xF, 0xF, false);
      } else {
#pragma unroll
        for (int u = 0; u < 4; ++u) dhi = __builtin_amdgcn_update_dpp(dot[u], dhi, 0x130, 0xF, 0xF, false);
      }
    };
    float act_lo = 0.f, act_hi = 0.f;
    auto proc4v = [&](int s0, int k0) {
      float act[4];
      if (k0 < 64) {
#pragma unroll
        for (int u = 0; u < 4; ++u) act[u] = __uint_as_float((unsigned)__builtin_amdgcn_readlane((int)__float_as_uint(act_lo), k0 + u));
      } else {
#pragma unroll
        for (int u = 0; u < 4; ++u) act[u] = __uint_as_float((unsigned)__builtin_amdgcn_readlane((int)__float_as_uint(act_hi), k0 - 64 + u));
      }
#pragma unroll
      for (int u = 0; u < 4; ++u) {
        const float act_ = act[u];
        const q6w c_ = {rb[s0 + u].x, rb[s0 + u].y, rb[s0 + u].z};
        f[0] = fmaf(act_, q6<0>(c_), f[0]); f[1] = fmaf(act_, q6<1>(c_), f[1]); f[2] = fmaf(act_, q6<2>(c_), f[2]); f[3] = fmaf(act_, q6<3>(c_), f[3]);
        f[4] = fmaf(act_, q6<4>(c_), f[4]); f[5] = fmaf(act_, q6<5>(c_), f[5]); f[6] = fmaf(act_, q6<6>(c_), f[6]); f[7] = fmaf(act_, q6<7>(c_), f[7]);
        f[8] = fmaf(act_, q6<8>(c_), f[8]); f[9] = fmaf(act_, q6<9>(c_), f[9]); f[10] = fmaf(act_, q6<10>(c_), f[10]); f[11] = fmaf(act_, q6<11>(c_), f[11]);
        f[12] = fmaf(act_, q6<12>(c_), f[12]); f[13] = fmaf(act_, q6<13>(c_), f[13]); f[14] = fmaf(act_, q6<14>(c_), f[14]); f[15] = fmaf(act_, q6<15>(c_), f[15]);
      }
    };
    ULOAD(0, kbeg); ULOAD(1, kbeg + 1); ULOAD(2, kbeg + 2); ULOAD(3, kbeg + 3); ULOAD(4, kbeg + 4); ULOAD(5, kbeg + 5); ULOAD(6, kbeg + 6); ULOAD(7, kbeg + 7);
    const int kend = kbeg + kcnt - 8;
#pragma unroll 1
    for (int k = kbeg; k < kend; k += 8) {
      proc4u(0, k); ULOAD(0, k + 8); ULOAD(1, k + 9); ULOAD(2, k + 10); ULOAD(3, k + 11);
      proc4u(4, k + 4); ULOAD(4, k + 12); ULOAD(5, k + 13); ULOAD(6, k + 14); ULOAD(7, k + 15);
    }
    proc4u(0, kend); VLOAD(0, kbeg); VLOAD(1, kbeg + 1); VLOAD(2, kbeg + 2); VLOAD(3, kbeg + 3);
    proc4u(4, kend + 4); VLOAD(4, kbeg + 4); VLOAD(5, kbeg + 5); VLOAD(6, kbeg + 6); VLOAD(7, kbeg + 7);
    if (partial) {
      const int srcl = ((lane - (kbeg & 63) + 32) & 63) * 4;
      const int sh_lo = __builtin_amdgcn_ds_bpermute(srcl, dlo), sh_hi = __builtin_amdgcn_ds_bpermute(srcl, dhi);
      const bool in = lane >= (kbeg & 63) && lane < (kbeg & 63) + 32;
      dlo = in ? sh_lo : 0; dhi = in ? sh_hi : 0;
    }
    act_lo = gelu_fast(su_lo * st * (float)dlo) * ga_lo * sv_lo; act_hi = gelu_fast(su_hi * st * (float)dhi) * ga_hi * sv_hi;
    const float asum = wave_sum_dpp(act_lo + act_hi);
    if (un + 1 < nun) { int nrr, nkb, nkc; bool npa; desc(un + 1, nrr, nkb, nkc, npa); NLOAD(g0 + nrr); }
#pragma unroll 1
    for (int k = kbeg; k < kend; k += 8) {
      proc4v(0, k); VLOAD(0, k + 8); VLOAD(1, k + 9); VLOAD(2, k + 10); VLOAD(3, k + 11);
      proc4v(4, k + 4); VLOAD(4, k + 12); VLOAD(5, k + 13); VLOAD(6, k + 14); VLOAD(7, k + 15);
    }
    proc4v(0, kend); proc4v(4, kend + 4);
#undef ULOAD
#undef VLOAD
    if (!partial) ln_token<FINAL>(p, row, rr, lane, f, asum, As);
    else {
      float* pp = PART + wave * PARTW + lane * 16;
      *(float4*)pp = make_float4(f[0], f[1], f[2], f[3]); *(float4*)(pp + 4) = make_float4(f[4], f[5], f[6], f[7]);
      *(float4*)(pp + 8) = make_float4(f[8], f[9], f[10], f[11]); *(float4*)(pp + 12) = make_float4(f[12], f[13], f[14], f[15]);
      if (lane == 0) PART[wave * PARTW + 1024] = asum;
    }
  }
#undef NLOAD
  if (extra) {
    __syncthreads();
    if (wave < extra) {
      const int wpt = 8 / extra, rr = nfull * 8 + wave;
      float f[16], asum = 0.f;
#pragma unroll
      for (int j = 0; j < 16; ++j) f[j] = 0.f;
      for (int w2 = wave * wpt; w2 < wave * wpt + wpt; ++w2) {
        const float* pp = PART + w2 * PARTW + lane * 16;
#pragma unroll
        for (int q4 = 0; q4 < 4; ++q4) { const float4 x4 = *(const float4*)(pp + q4 * 4); f[q4 * 4] += x4.x; f[q4 * 4 + 1] += x4.y; f[q4 * 4 + 2] += x4.z; f[q4 * 4 + 3] += x4.w; }
        asum += PART[w2 * PARTW + 1024];
      }
      ln_token<FINAL>(p, g0 + rr, rr, lane, f, asum, As);
    }
  }
}

__device__ __forceinline__ void cvt_plain(const float* __restrict__ a, bf16_t* __restrict__ o, size_t n8, bool lo, size_t gtid, size_t gsz) {
  for (size_t i = gtid; i < n8; i += gsz) {
    float v[8];
    *(float4*)&v[0] = ((const float4*)a)[i * 2]; *(float4*)&v[4] = ((const float4*)a)[i * 2 + 1];
    if (lo) {
#pragma unroll
      for (int j = 0; j < 8; ++j) v[j] = v[j] - bf2f(f2bf(v[j]));
    }
    uint4 w; w.x = pack2bf(v[0], v[1]); w.y = pack2bf(v[2], v[3]); w.z = pack2bf(v[4], v[5]); w.w = pack2bf(v[6], v[7]);
    ((uint4*)o)[i] = w;
  }
}
__device__ __forceinline__ void cvt_t(const float* __restrict__ W, bf16_t* __restrict__ Wt, int K, int N, bool lo, size_t gtid, size_t gsz) {
  const int N4 = N >> 2;
  const size_t total = (size_t)N4 * (K / 8);
#pragma unroll 2
  for (size_t i = gtid; i < total; i += gsz) {
    const int n = (int)(i % N4) * 4, k8 = (int)(i / N4);
    float4 r[8];
#pragma unroll
    for (int j = 0; j < 8; ++j) r[j] = *(const float4*)(W + (size_t)(k8 * 8 + j) * N + n);
    if (lo) {
#pragma unroll
      for (int j = 0; j < 8; ++j) { r[j].x -= bf2f(f2bf(r[j].x)); r[j].y -= bf2f(f2bf(r[j].y)); r[j].z -= bf2f(f2bf(r[j].z)); r[j].w -= bf2f(f2bf(r[j].w)); }
    }
    uint4* dst = (uint4*)(Wt + ((size_t)((n >> 4) * (K >> 5) + (k8 >> 2)) * 64 + (k8 & 3) * 16 + (n & 15)) * 8);
    dst[0] = make_uint4(pack2bf(r[0].x, r[1].x), pack2bf(r[2].x, r[3].x), pack2bf(r[4].x, r[5].x), pack2bf(r[6].x, r[7].x));
    dst[1] = make_uint4(pack2bf(r[0].y, r[1].y), pack2bf(r[2].y, r[3].y), pack2bf(r[4].y, r[5].y), pack2bf(r[6].y, r[7].y));
    dst[2] = make_uint4(pack2bf(r[0].z, r[1].z), pack2bf(r[2].z, r[3].z), pack2bf(r[4].z, r[5].z), pack2bf(r[6].z, r[7].z));
    dst[3] = make_uint4(pack2bf(r[0].w, r[1].w), pack2bf(r[2].w, r[3].w), pack2bf(r[4].w, r[5].w), pack2bf(r[6].w, r[7].w));
  }
}
__device__ __forceinline__ void cvt_t8(const float* __restrict__ W, unsigned char* __restrict__ Wt, int K, int N, size_t gtid, size_t gsz) {
  const int N4 = N >> 2;
  const size_t total = (size_t)N4 * (K / 8);
#pragma unroll 2
  for (size_t i = gtid; i < total; i += gsz) {
    const int n = (int)(i % N4) * 4, k8 = (int)(i / N4);
    float4 r[8];
#pragma unroll
    for (int j = 0; j < 8; ++j) r[j] = *(const float4*)(W + (size_t)(k8 * 8 + j) * N + n);
    unsigned char* dst = Wt + ((size_t)((n >> 4) * (K >> 6) + (k8 >> 3)) * 64 + (k8 & 3) * 16 + (n & 15)) * 16 + ((k8 >> 2) & 1) * 8;
#define PK8(C) make_uint2((unsigned)__builtin_amdgcn_cvt_pk_fp8_f32(r[2].C * 32.f, r[3].C * 32.f, __builtin_amdgcn_cvt_pk_fp8_f32(r[0].C * 32.f, r[1].C * 32.f, 0, false), true), \
                          (unsigned)__builtin_amdgcn_cvt_pk_fp8_f32(r[6].C * 32.f, r[7].C * 32.f, __builtin_amdgcn_cvt_pk_fp8_f32(r[4].C * 32.f, r[5].C * 32.f, 0, false), true))
    *(uint2*)(dst) = PK8(x); *(uint2*)(dst + 16) = PK8(y); *(uint2*)(dst + 32) = PK8(z); *(uint2*)(dst + 48) = PK8(w);
#undef PK8
  }
}
__device__ __forceinline__ void mod_item(const float* __restrict__ c, const float* __restrict__ c_ctx, const float* __restrict__ ada_w, const float* __restrict__ ada_b,
                                         float* __restrict__ MOD, int item, bool valid, char* lds, int tid, int nct, volatile int* cbc, int& cgen) {
  float* sc = (float*)lds;
  float* part = sc + 3072;
  const int wave = tid >> 6, lane = tid & 63, l = item / 96, cg = item % 96, nw = nct >> 6;
  if (valid) for (int i = tid; i < 3072; i += nct) { const int v = i >> 10, k = i & 1023; const float xv = v < 2 ? c[v * 1024 + k] : c_ctx[k]; sc[i] = xv / (1.f + expf(-xv)); }
  cbar(cbc, cgen, nw);
  if (valid) {
    float a0 = 0.f, a1 = 0.f, a2 = 0.f;
    const float* W = ada_w + (size_t)l * 1024 * 6144 + cg * 64 + lane;
    const int kb = wave * 171, ke = kb + 171 < 1024 ? kb + 171 : 1024;
#pragma unroll 57
    for (int k = kb; k < ke; ++k) { const float w = W[(size_t)k * 6144]; a0 += sc[k] * w; a1 += sc[1024 + k] * w; a2 += sc[2048 + k] * w; }
    part[(wave * 3 + 0) * 64 + lane] = a0; part[(wave * 3 + 1) * 64 + lane] = a1; part[(wave * 3 + 2) * 64 + lane] = a2;
  }
  cbar(cbc, cgen, nw);
  if (valid && tid < 192) {
    const int v = tid >> 6, ln = tid & 63; float sum = 0.f;
    for (int w = 0; w < nw; ++w) sum += part[(w * 3 + v) * 64 + ln];
    MOD[(l * 3 + v) * 6144 + cg * 64 + ln] = sum + ada_b[l * 6144 + cg * 64 + ln];
  }
}

__device__ __forceinline__ void gbar(unsigned* cnt, unsigned target) {
  asm volatile("s_waitcnt vmcnt(0)" ::: "memory");
  __syncthreads();
  if (otid() == 0) {
    __builtin_amdgcn_fence(__ATOMIC_RELEASE, "agent");
    asm volatile("s_waitcnt vmcnt(0)" ::: "memory");
    __hip_atomic_fetch_add(cnt, 1u, __ATOMIC_RELAXED, __HIP_MEMORY_SCOPE_AGENT);
    unsigned spins = 0;
    while (__hip_atomic_load(cnt, __ATOMIC_RELAXED, __HIP_MEMORY_SCOPE_AGENT) < target) { __builtin_amdgcn_s_sleep(2); if (++spins > (1u << 24)) break; }
    __builtin_amdgcn_fence(__ATOMIC_ACQUIRE, "agent");
    asm volatile("s_waitcnt vmcnt(0)" ::: "memory");
  }
  __syncthreads();
}

struct MP {
  const float *x, *c, *ctx, *c_ctx, *ada_w, *ada_b, *ln_g, *ln_b, *s5_a_re, *s5_a_im, *s5_log_dt, *s5_b_re, *s5_b_im, *s5_c_re, *s5_c_im, *s5_d, *s5_w_glu, *s5_w_o;
  const float *mla_w_dq, *mla_q_norm, *mla_w_uq, *mla_w_dkv, *mla_kv_norm, *mla_w_ukv, *mla_w_o, *peer_w_q, *peer_keys, *peer_u, *peer_v;
  float* out;
  float* MOD; bf16_t *Wt_glu, *Wt_o0, *Wt_q0, *Wt_o1, *Wt_q1, *Wt_cat, *Wt_uq, *Wt_ukv, *Khi, *Khi1;
  unsigned char *U0, *V0, *U1, *V1; float *SU0, *SV0, *SU1, *SV1; bf16_t *Ktab, *Bst_t, *Cin_t;
  bf16_t* Ypart; float* Ssta; bf16_t *HP, *Gbf, *Vbf, *Tbf; float *OQ, *H1, *H2; int* IDX; float* GATE;
  bf16_t *Qa, *AObf; unsigned char *Kn, *Kr, *Va; float* H3; bf16_t* Tbf1; unsigned* BAR; float* PART;
};
constexpr int LDS_BYTES = 66 * 784 + 66 * 528 + 1024 * 68 + 64;
__global__ __launch_bounds__(512) void mega(MP p) {
  __shared__ __attribute__((aligned(16))) char lds[LDS_BYTES];
  cg::grid_group grid = cg::this_grid();
  const int nblk = gridDim.x;
  int bid = blockIdx.x;
  const size_t TD = (size_t)1024 * 16384;
  const float* mod0 = p.MOD; const float* mod1 = p.MOD + 3 * 6144;
  {
    volatile int* cbc = (volatile int*)(lds + LDS_BYTES - 16);
    if (otid() == 0) *cbc = 0;
    __syncthreads();
    const int t0 = otid();
    if (t0 < 128) {
      const size_t mt = (size_t)bid * 128 + t0, ms = (size_t)nblk * 128;
      const int mw = bid * 2 + (t0 >> 6), nmw = nblk * 2;
      cvt_t(p.s5_w_glu, p.Wt_glu, D, D, false, mt, ms);
      cvt_t(p.s5_w_o, p.Wt_o0, D, D, false, mt, ms);
      cvt_t(p.peer_w_q, p.Wt_q0, D, D, false, mt, ms);
      cvt_t8(p.mla_w_o, (unsigned char*)p.Wt_o1, D, D, mt, ms);
      cvt_t(p.peer_w_q + (size_t)D * D, p.Wt_q1, D, D, false, mt, ms);
      cvt_t8(p.mla_w_dq, (unsigned char*)p.Wt_cat, D, 384, mt, ms);
      cvt_t8(p.mla_w_dkv, (unsigned char*)p.Wt_cat + (size_t)384 * D, D, 320, mt, ms);
      cvt_t8(p.mla_w_uq, (unsigned char*)p.Wt_uq, 384, 1536, mt, ms);
      cvt_t8(p.mla_w_ukv, (unsigned char*)p.Wt_ukv, 256, 2048, mt, ms);
      cvt_plain(p.peer_keys, p.Khi, (size_t)2 * 131072 / 8, false, mt, ms);
      cvt_rows_i8<true>(p.peer_u, p.U0, p.SU0, 16384, mw, nmw);
      cvt_rows_q6(p.peer_v, p.V0, p.SV0, 16384, mw, nmw);
      cvt_rows_i8<true>(p.peer_u + TD, p.U1, p.SU1, 16384, mw, nmw);
      cvt_rows_q6(p.peer_v + TD, p.V1, p.SV1, 16384, mw, nmw);
    } else {
      int cgen = 0;
      const int ct = t0 - 128;
      ph_s5_prep(p.s5_a_re, p.s5_a_im, p.s5_log_dt, p.s5_b_re, p.s5_b_im, p.s5_c_re, p.s5_c_im, p.Ktab, p.Bst_t, p.Cin_t, bid >> 2, bid & 3, lds, ct, 384, cbc, cgen);
      cbar(cbc, cgen, 6);
      mod_item(p.c, p.c_ctx, p.ada_w, p.ada_b, p.MOD, bid, bid < 192, lds, ct, 384, cbc, cgen);
    }
  }
  grid.sync();
  asm volatile("" : "+s"(bid));
  ph_s5_p1(p.x, p.ctx, mod0, p.Ktab, p.Bst_t, p.s5_d, p.Ypart, p.Ssta, bid, lds);
  gbar(p.BAR + 16 + (bid >> 2) * 16, 4u);
  asm volatile("" : "+s"(bid));
  if (otid() < 64) ph_s5_carry(p.Ssta, p.s5_a_re, p.s5_a_im, p.s5_log_dt, p.HP, ((bid & 2) << 6) | ((bid >> 2) << 1) | (bid & 1), otid());
  gbar(p.BAR + 16 + (bid >> 2) * 16, 8u);
  asm volatile("" : "+s"(bid));
  ph_s5_p3(p.HP, p.Cin_t, p.Ypart, p.Gbf, bid, lds);
  gbar(p.BAR, 1u * (unsigned)nblk);
  asm volatile("" : "+s"(bid));
  {
    ChainP cp{p.Gbf, p.Wt_glu, p.Wt_o0, p.Wt_q0, p.Vbf, (bf16_t*)p.OQ + (size_t)bid * 66 * D, p.x, p.ctx, mod0, p.ln_g, p.ln_b, p.H1, p.Tbf, (bf16_t*)p.OQ + (size_t)bid * 66 * D  };
    ph_chainA<true>(cp, bid, lds);
    __syncthreads();
    ph_route(RouteP{(bf16_t*)p.OQ + (size_t)bid * 66 * D, p.Khi, p.IDX, p.GATE, 66, 0}, bid, lds);
    __syncthreads();
    GatherP gp{p.Tbf, p.IDX, p.GATE, p.U0, p.V0, p.SU0, p.SV0, p.H1, mod0, p.ln_g + D, p.ln_b + D, p.H2, mod1};
    ph_gather_tm<false>(gp, bid * 66, 66, lds, p.PART + (size_t)bid * 8 * PARTW);
    __syncthreads();
    ProjP pp{p.Wt_cat, p.Wt_uq, p.Wt_ukv, p.mla_q_norm, p.mla_kv_norm, p.OQ  , p.Qa, p.Kn, p.Kr, p.Va};
    ph_mla_proj(pp, bid, lds);
  }
  gbar(p.BAR, 2u * (unsigned)nblk);
  asm volatile("" : "+s"(bid));
  ph_attn(p.Qa, p.Kn, p.Kr, p.Va, p.AObf, bid, nblk, lds);
  gbar(p.BAR, 3u * (unsigned)nblk);
  asm volatile("" : "+s"(bid));
  {
    ChainP cp{p.AObf, nullptr, p.Wt_o1, p.Wt_q1, nullptr, (bf16_t*)p.OQ + (size_t)bid * 64 * D, p.H2, p.H2 + (size_t)NL * D, mod1, p.ln_g + 2 * D, p.ln_b + 2 * D, p.H3, p.Tbf1, (bf16_t*)p.OQ + (size_t)bid * 64 * D};
    ph_chainA<false>(cp, bid, lds);
    __syncthreads();
    ph_route(RouteP{(bf16_t*)p.OQ + (size_t)bid * 64 * D, p.Khi1, p.IDX, p.GATE, 64, 0}, bid, lds);
    __syncthreads();
    GatherP gp{p.Tbf1, p.IDX, p.GATE, p.U1, p.V1, p.SU1, p.SV1, p.H3, mod1, p.ln_g + 3 * D, p.ln_b + 3 * D, p.out, mod1};
    ph_gather_tm<true>(gp, bid * 64, 64, lds, p.PART + (size_t)bid * 8 * PARTW);
  }
}

extern "C" void kernel_launch(void* const* d_in, const int* in_sizes, int n_in, void* d_out, int out_size, void* d_ws, size_t ws_size, hipStream_t stream) {
  MP p{};
  const float** in = (const float**)&p;
  for (int i = 0; i < 29; ++i) in[i] = (const float*)d_in[i];
  p.out = (float*)d_out;
  char* ws = (char*)d_ws; size_t off = 0;
  auto carve = [&](size_t bytes) { char* q = ws + off; off += (bytes + 255) / 256 * 256; return q; };
  const size_t TDB = (size_t)1024 * 16384 * 2, BIG = (size_t)NT * D * 4, HALF = (size_t)NT * D * 2;
  p.MOD = (float*)carve(2 * 3 * 6144 * 4);
  p.Wt_glu = (bf16_t*)carve((size_t)D * D * 2); p.Wt_o0 = (bf16_t*)carve((size_t)D * D * 2); p.Wt_q0 = (bf16_t*)carve((size_t)D * D * 2);
  p.Wt_o1 = (bf16_t*)carve((size_t)D * D * 2); p.Wt_q1 = (bf16_t*)carve((size_t)D * D * 2);
  p.Wt_cat = (bf16_t*)carve((size_t)704 * D * 2); p.Wt_uq = (bf16_t*)carve((size_t)1536 * 384 * 2); p.Wt_ukv = (bf16_t*)carve((size_t)2048 * 256 * 2);
  p.Khi = (bf16_t*)carve((size_t)2 * 131072 * 2); p.Khi1 = p.Khi + 131072;
  char* T0 = carve(TDB); p.U0 = (unsigned char*)T0; p.V0 = (unsigned char*)(T0 + TDB / 2); p.AObf = (bf16_t*)T0;
  p.SU0 = (float*)carve(16384 * 4); p.SV0 = (float*)carve(16384 * 4); p.SU1 = (float*)carve(16384 * 4); p.SV1 = (float*)carve(16384 * 4);
  const size_t KTAB_B = (size_t)64 * 127 * 256 * 2, BST_B = (size_t)64 * 256 * 1024 * 2, KN_B = (size_t)NB * 8 * KEYS * 128 * 2, KR_B = (size_t)NB * KEYS * 64 * 2;
  size_t x1 = KTAB_B + 2 * BST_B; if (x1 < 2 * KN_B + KR_B) x1 = 2 * KN_B + KR_B;
  char* X1 = carve(x1);
  p.Ktab = (bf16_t*)X1; p.Bst_t = (bf16_t*)(X1 + KTAB_B); p.Cin_t = (bf16_t*)(X1 + KTAB_B + BST_B);
  p.Kn = (unsigned char*)X1; p.Va = (unsigned char*)(X1 + KN_B); p.Kr = (unsigned char*)(X1 + 2 * KN_B); p.H3 = (float*)X1;
  char* X2 = carve(BIG); p.Ypart = (bf16_t*)X2; p.OQ = (float*)X2;
  char* X3 = carve(HALF); p.Ssta = (float*)X3; p.HP = (bf16_t*)(X3 + (size_t)NCC * 64 * 256 * 4); p.Vbf = (bf16_t*)X3;
  char* X4 = carve(HALF); p.Gbf = (bf16_t*)X4; p.Tbf = (bf16_t*)X4; p.Tbf1 = (bf16_t*)X4;
  char* X5 = carve(BIG); p.H1 = (float*)X5;
  char* T1 = carve(TDB); p.U1 = (unsigned char*)T1; p.V1 = (unsigned char*)(T1 + TDB / 2);
  p.H2 = (float*)carve(BIG);
  p.IDX = (int*)carve((size_t)NT * 128 * 4); p.GATE = (float*)carve((size_t)NT * 128 * 4);
  p.Qa = (bf16_t*)carve((size_t)NB * 8 * SEQ * 192 * 2);
  p.BAR = (unsigned*)carve(8192);
  p.PART = (float*)carve((size_t)256 * 8 * PARTW * 4);
  if (off > ws_size || n_in != 29) { fprintf(stderr, "kernel_launch: workspace too small (need %zu, have %zu) or n_in %d != 29\n", off, ws_size, n_in); return; }
  static int grid_blocks = 0;
  if (!grid_blocks) {
    int dev = 0, cus = 0, per_cu = 0;
    hipGetDevice(&dev);
    hipDeviceGetAttribute(&cus, hipDeviceAttributeMultiprocessorCount, dev);
    hipOccupancyMaxActiveBlocksPerMultiprocessor(&per_cu, mega, 512, 0);
    if (per_cu < 1 || cus < 256) { fprintf(stderr, "kernel_launch: need 256 resident workgroups (cus %d, per_cu %d)\n", cus, per_cu); return; }
    grid_blocks = 256;
  }
  hipMemsetAsync(p.BAR, 0, 8192, stream);
  void* args[] = {&p};
  hipError_t e = hipLaunchCooperativeKernel((void*)mega, dim3(grid_blocks), dim3(512), args, 0, stream);
  if (e != hipSuccess) fprintf(stderr, "cooperative launch failed: %s\n", hipGetErrorString(e));
}
```

```cpp
#include <hip/hip_runtime.h>
#include <math.h>
#include <hip/hip_cooperative_groups.h>
#include <cstdio>
namespace cg = cooperative_groups;
__device__ __forceinline__ int otid() { int t = (int)__builtin_amdgcn_workitem_id_x(); asm volatile("" : "+v"(t)); return t; }

constexpr int D = 1024, NB = 2, SEQ = 8192, CTX = 256;
constexpr int NL = NB * SEQ, NC = NB * CTX, NT = NL + NC;
constexpr float ALPHA = 1.4142135623730951f;
constexpr float LN_EPS = 1e-5f, RMS_EPS = 1e-6f;

__device__ __forceinline__ float wave_sum_dpp(float v) {
  v += __uint_as_float(__builtin_amdgcn_update_dpp(0u, __float_as_uint(v), 0xB1, 0xF, 0xF, true));
  v += __uint_as_float(__builtin_amdgcn_update_dpp(0u, __float_as_uint(v), 0x4E, 0xF, 0xF, true));
  v += __uint_as_float(__builtin_amdgcn_update_dpp(0u, __float_as_uint(v), 0x141, 0xF, 0xF, true));
  v += __uint_as_float(__builtin_amdgcn_update_dpp(0u, __float_as_uint(v), 0x140, 0xF, 0xF, true));
  v += __uint_as_float(__builtin_amdgcn_update_dpp(0u, __float_as_uint(v), 0x142, 0xA, 0xF, true));
  v += __uint_as_float(__builtin_amdgcn_update_dpp(0u, __float_as_uint(v), 0x143, 0xC, 0xF, true));
  return __uint_as_float((unsigned)__builtin_amdgcn_readlane((int)__float_as_uint(v), 63));
}
__device__ __forceinline__ float wave_sum(float v) { return wave_sum_dpp(v); }
__device__ __forceinline__ float wave_max_dpp(float v) {
  v = fmaxf(v, __uint_as_float(__builtin_amdgcn_update_dpp(0u, __float_as_uint(v), 0xB1, 0xF, 0xF, true)));
  v = fmaxf(v, __uint_as_float(__builtin_amdgcn_update_dpp(0u, __float_as_uint(v), 0x4E, 0xF, 0xF, true)));
  v = fmaxf(v, __uint_as_float(__builtin_amdgcn_update_dpp(0u, __float_as_uint(v), 0x141, 0xF, 0xF, true)));
  v = fmaxf(v, __uint_as_float(__builtin_amdgcn_update_dpp(0u, __float_as_uint(v), 0x140, 0xF, 0xF, true)));
  v = fmaxf(v, __uint_as_float(__builtin_amdgcn_update_dpp(0u, __float_as_uint(v), 0x142, 0xA, 0xF, true)));
  v = fmaxf(v, __uint_as_float(__builtin_amdgcn_update_dpp(0u, __float_as_uint(v), 0x143, 0xC, 0xF, true)));
  return __uint_as_float((unsigned)__builtin_amdgcn_readlane((int)__float_as_uint(v), 63));
}
__device__ __forceinline__ int row_vec(int row) { return row < NL ? (row >> 13) : 2; }
__device__ __forceinline__ float gelu_exact(float x) { return 0.5f * x * (1.f + erff(x * 0.70710678118654752f)); }
__device__ __forceinline__ float gelu_fast(float x) {
  const float z = fabsf(x) * 0.70710678118654752f;
  const float t = __builtin_amdgcn_rcpf(fmaf(0.3275911f, z, 1.f));
  float pl = fmaf(1.061405429f, t, -1.453152027f); pl = fmaf(pl, t, 1.421413741f); pl = fmaf(pl, t, -0.284496736f); pl = fmaf(pl, t, 0.254829592f);
  const float e = __builtin_amdgcn_exp2f(-z * z * 1.4426950408889634f);
  const float erfa = 1.f - pl * t * e;
  const float hx = 0.5f * x;
  return hx + fabsf(hx) * erfa;
}


typedef unsigned short bf16_t;
using bf16x8 = __attribute__((ext_vector_type(8))) short;
using f32x4 = __attribute__((ext_vector_type(4))) float;
__device__ __forceinline__ bf16_t f2bf(float f) { unsigned u = __float_as_uint(f); u += 0x7FFFu + ((u >> 16) & 1u); return (bf16_t)(u >> 16); }
__device__ __forceinline__ unsigned char f2fp8(float v) { return (unsigned char)(__builtin_amdgcn_cvt_pk_fp8_f32(v, v, 0, false) & 0xFF); }
__device__ __forceinline__ float bf2f(bf16_t h) { return __uint_as_float(((unsigned)h) << 16); }
__device__ __forceinline__ unsigned pack2bf(float lo, float hi) { return (unsigned)f2bf(lo) | ((unsigned)f2bf(hi) << 16); }
__device__ __forceinline__ float bflo(unsigned w) { return __uint_as_float(w << 16); }
__device__ __forceinline__ float bfhi(unsigned w) { return __uint_as_float(w & 0xFFFF0000u); }


constexpr int LDA_B = 1024 * 2 + 16;
template <int RT, int K>
__device__ __forceinline__ void gemm_unit(const char* const (&ap)[RT], const bf16_t* __restrict__ w0, const bf16_t* __restrict__ w1, int kmul, f32x4 (&acc)[RT][2]) {
  constexpr int KI = K / 128, NS = 2;
#pragma unroll
  for (int t = 0; t < RT; ++t) { acc[t][0] = f32x4{0.f, 0.f, 0.f, 0.f}; acc[t][1] = f32x4{0.f, 0.f, 0.f, 0.f}; }
  bf16x8 b[NS][4][2];
#pragma unroll
  for (int st = 0; st < NS - 1; ++st) {
    if (st < KI) {
#pragma unroll
      for (int s2 = 0; s2 < 4; ++s2) { b[st][s2][0] = *(const bf16x8*)(w0 + (st * 128 + s2 * 32) * kmul); b[st][s2][1] = *(const bf16x8*)(w1 + (st * 128 + s2 * 32) * kmul); }
    }
  }
  asm volatile("" ::: "memory");
  bf16x8 an[RT];
#pragma unroll
  for (int t = 0; t < RT; ++t) an[t] = *(const bf16x8*)(ap[t]);
#pragma unroll
  for (int it = 0; it < KI; ++it) {
    if (it + NS - 1 < KI) {
#pragma unroll
      for (int s2 = 0; s2 < 4; ++s2) {
        b[(it + NS - 1) % NS][s2][0] = *(const bf16x8*)(w0 + ((it + NS - 1) * 128 + s2 * 32) * kmul);
        b[(it + NS - 1) % NS][s2][1] = *(const bf16x8*)(w1 + ((it + NS - 1) * 128 + s2 * 32) * kmul);
      }
    }
    asm volatile("" ::: "memory");
#pragma unroll
    for (int s2 = 0; s2 < 4; ++s2) {
      bf16x8 ac[RT];
#pragma unroll
      for (int t = 0; t < RT; ++t) ac[t] = an[t];
      if (it * 4 + s2 + 1 < KI * 4) {
#pragma unroll
        for (int t = 0; t < RT; ++t) an[t] = *(const bf16x8*)(ap[t] + (it * 128 + s2 * 32 + 32) * 2);
      }
#pragma unroll
      for (int t = 0; t < RT; ++t) {
        acc[t][0] = __builtin_amdgcn_mfma_f32_16x16x32_bf16(ac[t], b[it % NS][s2][0], acc[t][0], 0, 0, 0);
        acc[t][1] = __builtin_amdgcn_mfma_f32_16x16x32_bf16(ac[t], b[it % NS][s2][1], acc[t][1], 0, 0, 0);
      }
    }
  }
}
typedef __bf16 bf16raw2 __attribute__((ext_vector_type(2)));
__device__ __forceinline__ bf16x8 w8_frag(unsigned lo, unsigned hi) {
  const bf16raw2 e0 = __builtin_amdgcn_cvt_scalef32_pk_bf16_fp8(lo, 0.03125f, false), e1 = __builtin_amdgcn_cvt_scalef32_pk_bf16_fp8(lo, 0.03125f, true);
  const bf16raw2 e2 = __builtin_amdgcn_cvt_scalef32_pk_bf16_fp8(hi, 0.03125f, false), e3 = __builtin_amdgcn_cvt_scalef32_pk_bf16_fp8(hi, 0.03125f, true);
  uint4 w; w.x = *(const unsigned*)&e0; w.y = *(const unsigned*)&e1; w.z = *(const unsigned*)&e2; w.w = *(const unsigned*)&e3;
  return *(const bf16x8*)&w;
}
template <int RT, int K>
__device__ __forceinline__ void gemm_unit8(const char* const (&ap)[RT], const unsigned char* __restrict__ w0, const unsigned char* __restrict__ w1, f32x4 (&acc)[RT][2]) {
  constexpr int KI = K / 128, NS = 2;
#pragma unroll
  for (int t = 0; t < RT; ++t) { acc[t][0] = f32x4{0.f, 0.f, 0.f, 0.f}; acc[t][1] = f32x4{0.f, 0.f, 0.f, 0.f}; }
  uint4 b[NS][2][2];
#pragma unroll
  for (int st = 0; st < NS - 1; ++st) {
    if (st < KI) {
#pragma unroll
      for (int pr = 0; pr < 2; ++pr) { b[st][pr][0] = *(const uint4*)(w0 + (st * 2 + pr) * 1024); b[st][pr][1] = *(const uint4*)(w1 + (st * 2 + pr) * 1024); }
    }
  }
  asm volatile("" ::: "memory");
  bf16x8 an[RT];
#pragma unroll
  for (int t = 0; t < RT; ++t) an[t] = *(const bf16x8*)(ap[t]);
#pragma unroll
  for (int it = 0; it < KI; ++it) {
    if (it + NS - 1 < KI) {
#pragma unroll
      for (int pr = 0; pr < 2; ++pr) {
        b[(it + NS - 1) % NS][pr][0] = *(const uint4*)(w0 + ((it + NS - 1) * 2 + pr) * 1024);
        b[(it + NS - 1) % NS][pr][1] = *(const uint4*)(w1 + ((it + NS - 1) * 2 + pr) * 1024);
      }
    }
    asm volatile("" ::: "memory");
#pragma unroll
    for (int s2 = 0; s2 < 4; ++s2) {
      bf16x8 ac[RT];
#pragma unroll
      for (int t = 0; t < RT; ++t) ac[t] = an[t];
      if (it * 4 + s2 + 1 < KI * 4) {
#pragma unroll
        for (int t = 0; t < RT; ++t) an[t] = *(const bf16x8*)(ap[t] + (it * 128 + s2 * 32 + 32) * 2);
      }
      const uint4 q0 = b[it % NS][s2 >> 1][0], q1 = b[it % NS][s2 >> 1][1];
      const bf16x8 f0 = (s2 & 1) ? w8_frag(q0.z, q0.w) : w8_frag(q0.x, q0.y), f1 = (s2 & 1) ? w8_frag(q1.z, q1.w) : w8_frag(q1.x, q1.y);
#pragma unroll
      for (int t = 0; t < RT; ++t) {
        acc[t][0] = __builtin_amdgcn_mfma_f32_16x16x32_bf16(ac[t], f0, acc[t][0], 0, 0, 0);
        acc[t][1] = __builtin_amdgcn_mfma_f32_16x16x32_bf16(ac[t], f1, acc[t][1], 0, 0, 0);
      }
    }
  }
}
template <int RT, int K, class Epi>
__device__ __forceinline__ void gemm_ldsA8(const char* As, int lda_b, int nrows, const unsigned char* __restrict__ Wt, int N, Epi epi) {
  const int wave = otid() >> 6, lane = otid() & 63, l15 = lane & 15, q = lane >> 4;
  const char* ap[RT];
#pragma unroll
  for (int t = 0; t < RT; ++t) { int r = t * 16 + l15; r = r < nrows ? r : nrows - 1; ap[t] = As + r * lda_b + q * 16; }
#pragma unroll 1
  for (int unit = wave; unit < (N >> 5); unit += 8) {
    const int n0 = unit * 32;
    const unsigned char* w0 = Wt + (size_t)(n0 >> 4) * K * 16 + lane * 16;
    f32x4 acc[RT][2];
    gemm_unit8<RT, K>(ap, w0, w0 + (size_t)K * 16, acc);
#pragma unroll
    for (int t = 0; t < RT; ++t)
#pragma unroll
      for (int j = 0; j < 2; ++j)
#pragma unroll
        for (int r = 0; r < 4; ++r) {
          const int row = t * 16 + q * 4 + r, col = n0 + j * 16 + l15;
          if (row < nrows) epi(row, col, acc[t][j][r]);
        }
  }
}
template <int RT, int K, class Epi>
__device__ __forceinline__ void gemm_ldsA(const char* As, int lda_b, int nrows, const bf16_t* __restrict__ Wt, int N, Epi epi) {
  const int wave = otid() >> 6, lane = otid() & 63, l15 = lane & 15, q = lane >> 4;
  const char* ap[RT];
#pragma unroll
  for (int t = 0; t < RT; ++t) { int r = t * 16 + l15; r = r < nrows ? r : nrows - 1; ap[t] = As + r * lda_b + q * 16; }
#pragma unroll 1
  for (int unit = wave; unit < (N >> 5); unit += 8) {
    const int n0 = unit * 32;
    const bf16_t* w0 = Wt + (size_t)(n0 >> 4) * K * 16 + lane * 8;
    f32x4 acc[RT][2];
    gemm_unit<RT, K>(ap, w0, w0 + (size_t)K * 16, 16, acc);
#pragma unroll
    for (int t = 0; t < RT; ++t)
#pragma unroll
      for (int j = 0; j < 2; ++j)
#pragma unroll
        for (int r = 0; r < 4; ++r) {
          const int row = t * 16 + q * 4 + r, col = n0 + j * 16 + l15;
          if (row < nrows) epi(row, col, acc[t][j][r]);
        }
  }
}
struct EpiBF16 { bf16_t* C; int ldc; __device__ __forceinline__ void operator()(int row, int col, float v) const { C[(size_t)row * ldc + col] = f2bf(v); } };
struct EpiF32 { float* C; int ldc; __device__ __forceinline__ void operator()(int row, int col, float v) const { C[(size_t)row * ldc + col] = v; } };
struct EpiGluL { const char* As; bf16_t* V; __device__ __forceinline__ void operator()(int row, int col, float z) const {
  const float g = bf2f(*(const bf16_t*)(As + row * LDA_B + col * 2)); V[(size_t)row * D + col] = f2bf(g / (1.f + expf(-z))); } };

__device__ __forceinline__ void load_rows_lds(char* As, const bf16_t* __restrict__ src, int nrows) {
  const int t = otid(), total = nrows * 128;
#pragma unroll
  for (int h = 0; h < 2; ++h) {
    uint4 v[9];
#pragma unroll
    for (int k = 0; k < 9; ++k) { int i = t + (h * 9 + k) * 512; i = i < total ? i : total - 1; v[k] = *(const uint4*)(src + (size_t)(i >> 7) * D + (i & 127) * 8); }
#pragma unroll
    for (int k = 0; k < 9; ++k) { const int i = t + (h * 9 + k) * 512; if (i < total) *(uint4*)(As + (i >> 7) * LDA_B + (i & 127) * 16) = v[k]; }
  }
}
__device__ __forceinline__ void ln_rows(char* As, int g0, int nrows, const float* Hl, const float* Hc, const bf16_t* __restrict__ O,
                                        const float* __restrict__ mod, int gate_i, const float* __restrict__ lng, const float* __restrict__ lnb,
                                        float* Hout, bf16_t* __restrict__ Tbf, int shift_i, int scale_i) {
  const int wave = otid() >> 6, lane = otid() & 63;
  float4 lg[4], lb[4], gmv[4], shv[4], scv[4];
#pragma unroll
  for (int i = 0; i < 4; ++i) { const int d = i * 256 + lane * 4; lg[i] = *(const float4*)(lng + d); lb[i] = *(const float4*)(lnb + d); }
  int vcur = -1;
  for (int rr = wave; rr < nrows; rr += 8) {
    const int row = g0 + rr;
    const float* hin = row < NL ? Hl + (size_t)row * D : Hc + (size_t)(row - NL) * D;
    const bf16_t* f = O + (size_t)row * D;
    const int v = __builtin_amdgcn_readfirstlane(row_vec(row));
    uint2 fw[4]; float4 h4[4];
#pragma unroll
    for (int i = 0; i < 4; ++i) { const int d = i * 256 + lane * 4; fw[i] = *(const uint2*)(f + d); h4[i] = *(const float4*)(hin + d); }
    if (v != vcur) {
      vcur = v;
      const float* m = mod + v * 6144;
#pragma unroll
      for (int i = 0; i < 4; ++i) { const int d = i * 256 + lane * 4; gmv[i] = *(const float4*)(m + gate_i * 1024 + d); shv[i] = *(const float4*)(m + shift_i * 1024 + d); scv[i] = *(const float4*)(m + scale_i * 1024 + d); }
    }
    float r[16]; float s = 0.f;
#pragma unroll
    for (int i = 0; i < 4; ++i) {
      const float4 f4 = make_float4(bflo(fw[i].x), bfhi(fw[i].x), bflo(fw[i].y), bfhi(fw[i].y)), g4 = gmv[i];
      r[i * 4 + 0] = ALPHA * h4[i].x + g4.x * f4.x; r[i * 4 + 1] = ALPHA * h4[i].y + g4.y * f4.y;
      r[i * 4 + 2] = ALPHA * h4[i].z + g4.z * f4.z; r[i * 4 + 3] = ALPHA * h4[i].w + g4.w * f4.w;
      s += r[i * 4 + 0] + r[i * 4 + 1] + r[i * 4 + 2] + r[i * 4 + 3];
    }
    const float mu = wave_sum(s) * (1.f / D);
    float vs = 0.f;
#pragma unroll
    for (int i = 0; i < 16; ++i) { float dlt = r[i] - mu; vs += dlt * dlt; }
    const float rstd = rsqrtf(wave_sum(vs) * (1.f / D) + LN_EPS);
#pragma unroll
    for (int i = 0; i < 4; ++i) {
      const int d = i * 256 + lane * 4;
      const float4 g4 = lg[i], b4 = lb[i];
      float4 o;
      o.x = (r[i * 4 + 0] - mu) * rstd * g4.x + b4.x; o.y = (r[i * 4 + 1] - mu) * rstd * g4.y + b4.y;
      o.z = (r[i * 4 + 2] - mu) * rstd * g4.z + b4.z; o.w = (r[i * 4 + 3] - mu) * rstd * g4.w + b4.w;
      *(float4*)(Hout + (size_t)row * D + d) = o;
      const float4 sh = shv[i], sc = scv[i];
      const float t0 = o.x * (1.f + sc.x) + sh.x, t1 = o.y * (1.f + sc.y) + sh.y, t2 = o.z * (1.f + sc.z) + sh.z, t3 = o.w * (1.f + sc.w) + sh.w;
      uint2 w; w.x = pack2bf(t0, t1); w.y = pack2bf(t2, t3);
      *(uint2*)(As + rr * LDA_B + d * 2) = w;
      *(uint2*)(Tbf + (size_t)row * D + d) = w;
    }
  }
}


constexpr int S5T = 64, NCHUNK = (CTX + SEQ) / S5T  , NCC = NB * NCHUNK  ;
__device__ __forceinline__ int s5_token(int cc, int s) {
  const int b = cc / NCHUNK, ch = cc - b * NCHUNK;
  return ch < 4 ? NL + b * CTX + ch * S5T + s : b * SEQ + (ch - 4) * S5T + s;
}
__device__ __forceinline__ void cbar(volatile int* cnt, int& gen, int nwaves) {
  __builtin_amdgcn_fence(__ATOMIC_RELEASE, "workgroup");
  if ((otid() & 63) == 0) __hip_atomic_fetch_add((int*)cnt, 1, __ATOMIC_RELAXED, __HIP_MEMORY_SCOPE_WORKGROUP);
  ++gen;
  while (__hip_atomic_load((int*)cnt, __ATOMIC_RELAXED, __HIP_MEMORY_SCOPE_WORKGROUP) < gen * nwaves) __builtin_amdgcn_s_sleep(1);
  __builtin_amdgcn_fence(__ATOMIC_ACQUIRE, "workgroup");
}
__device__ __forceinline__ void ph_s5_prep(const float* __restrict__ a_re, const float* __restrict__ a_im, const float* __restrict__ log_dt,
                                                 const float* __restrict__ b_re, const float* __restrict__ b_im, const float* __restrict__ c_re, const float* __restrict__ c_im,
                                                 bf16_t* __restrict__ Ktab, bf16_t* __restrict__ Bst_t, bf16_t* __restrict__ Cin_t, int g, int part, char* lds, int tid, int nct, volatile int* cbc, int& cgen) {
  float2 (*pw)[65][64] = reinterpret_cast<float2 (*)[65][64]>(lds);
  float2 (*Bp)[64][16] = reinterpret_cast<float2 (*)[64][16]>(lds + 2 * 65 * 64 * 8);
  float2 (*Cc)[16][64] = reinterpret_cast<float2 (*)[16][64]>(lds + 2 * 65 * 64 * 8 + 2 * 64 * 16 * 8);
  float2 (*fs)[64] = reinterpret_cast<float2 (*)[64]>(lds + 2 * 65 * 64 * 8 + 2 * 64 * 16 * 8 + 2 * 16 * 64 * 8);
  if (tid < 128) {
    const int dir = tid >> 6, p = tid & 63, gp = (dir * 64 + g) * 64 + p;
    const float are = a_re[gp], aim = a_im[gp], dt = expf(log_dt[dir * 64 + g]);
    const float mag = expf(are * dt);
    const float abr = mag * cosf(aim * dt), abi = mag * sinf(aim * dt);
    const float nr = abr - 1.f, ni = abi, den = are * are + aim * aim;
    fs[dir][p] = make_float2((nr * are + ni * aim) / den, (ni * are - nr * aim) / den);
    float pr = 1.f, pi = 0.f;
    for (int e = 0; e <= 64; ++e) { pw[dir][e][p] = make_float2(pr, pi); const float nr2 = pr * abr - pi * abi, ni2 = pr * abi + pi * abr; pr = nr2; pi = ni2; }
  }
  cbar(cbc, cgen, nct >> 6);
  for (int i = tid; i < 2048; i += nct) {
    const int dir = i >> 10, p = (i >> 4) & 63, ci = i & 15;
    const size_t gi = ((size_t)(dir * 64 + g) * 64 + p) * 16 + ci;
    const float br = b_re[gi], bi = b_im[gi]; const float2 f = fs[dir][p];
    Bp[dir][p][ci] = make_float2(f.x * br - f.y * bi, f.x * bi + f.y * br);
    const int co = (i >> 6) & 15, p2 = i & 63;
    const size_t ci2 = ((size_t)(dir * 64 + g) * 16 + co) * 64 + p2;
    Cc[dir][co][p2] = make_float2(c_re[ci2], c_im[ci2]);
  }
  cbar(cbc, cgen, nct >> 6);
  for (int i = part * 508 + tid; i < (part + 1) * 508; i += nct) {
    const int ti = i >> 4, co = i & 15, tau = ti - 63;
    float acc[16];
#pragma unroll
    for (int ci = 0; ci < 16; ++ci) acc[ci] = 0.f;
    if (tau >= 0) {
      for (int p = 0; p < 64; ++p) {
        const float2 c = Cc[0][co][p], w = pw[0][tau][p];
        const float xr = c.x * w.x - c.y * w.y, xi = c.x * w.y + c.y * w.x;
#pragma unroll
        for (int ci = 0; ci < 16; ++ci) { const float2 bb = Bp[0][p][ci]; acc[ci] += xr * bb.x - xi * bb.y; }
      }
    }
    if (tau <= 0) {
      for (int p = 0; p < 64; ++p) {
        const float2 c = Cc[1][co][p], w = pw[1][-tau][p];
        const float xr = c.x * w.x - c.y * w.y, xi = c.x * w.y + c.y * w.x;
#pragma unroll
        for (int ci = 0; ci < 16; ++ci) { const float2 bb = Bp[1][p][ci]; acc[ci] += xr * bb.x - xi * bb.y; }
      }
    }
    uint4 o0, o1;
    o0.x = pack2bf(acc[0], acc[1]); o0.y = pack2bf(acc[2], acc[3]); o0.z = pack2bf(acc[4], acc[5]); o0.w = pack2bf(acc[6], acc[7]);
    o1.x = pack2bf(acc[8], acc[9]); o1.y = pack2bf(acc[10], acc[11]); o1.z = pack2bf(acc[12], acc[13]); o1.w = pack2bf(acc[14], acc[15]);
    bf16_t* kp = Ktab + (size_t)g * 127 * 256 + (size_t)i * 16;
    *(uint4*)kp = o0; *(uint4*)(kp + 8) = o1;
  }
  for (int i = part * 8192 + tid; i < (part + 1) * 8192; i += nct) {
    const int n = (i >> 11) * 16 + (i & 15), k8 = ((i >> 6) & 31) * 4 + ((i >> 4) & 3);
    const int dir = n >> 7, c = (n >> 6) & 1, p = n & 63, sidx = k8 >> 1, ci0 = (k8 & 1) * 8;
    const float2 w = pw[dir][dir == 0 ? 63 - sidx : sidx][p];
    float v[8];
#pragma unroll
    for (int j = 0; j < 8; ++j) { const float2 b = Bp[dir][p][ci0 + j]; v[j] = c == 0 ? (w.x * b.x - w.y * b.y) : (w.x * b.y + w.y * b.x); }
    uint4 o; o.x = pack2bf(v[0], v[1]); o.y = pack2bf(v[2], v[3]); o.z = pack2bf(v[4], v[5]); o.w = pack2bf(v[6], v[7]);
    *(uint4*)(Bst_t + (size_t)g * 256 * 1024 + (size_t)i * 8) = o;
  }
  for (int i = part * 8192 + tid; i < (part + 1) * 8192; i += nct) {
    const int n = (i >> 9) * 16 + (i & 15), k8 = ((i >> 6) & 7) * 4 + ((i >> 4) & 3);
    const int t = n >> 4, co = n & 15, dir = k8 >> 4, c = (k8 >> 3) & 1, p0 = (k8 & 7) * 8;
    const int e = dir == 0 ? t + 1 : 64 - t;
    float v[8];
#pragma unroll
    for (int j = 0; j < 8; ++j) { const float2 cc = Cc[dir][co][p0 + j], w = pw[dir][e][p0 + j];
      v[j] = c == 0 ? (cc.x * w.x - cc.y * w.y) : -(cc.x * w.y + cc.y * w.x); }
    uint4 o; o.x = pack2bf(v[0], v[1]); o.y = pack2bf(v[2], v[3]); o.z = pack2bf(v[4], v[5]); o.w = pack2bf(v[6], v[7]);
    *(uint4*)(Cin_t + (size_t)g * 1024 * 256 + (size_t)i * 8) = o;
  }
}
__device__ __forceinline__ void ph_s5_p1(const float* __restrict__ x, const float* __restrict__ ctx, const float* __restrict__ mod,
                                               const bf16_t* __restrict__ Ktab, const bf16_t* __restrict__ Bst_t, const float* __restrict__ dvec, bf16_t* __restrict__ Ypart, float* __restrict__ S, int bid, char* As) {
  const int g = bid >> 2, cc0 = (bid & 3) * 66, tid = otid();
  const int wave = tid >> 6, lane = tid & 63, l15 = lane & 15, q = lane >> 4;
  const float dch = dvec[g * 16 + l15];
#pragma unroll 4
  for (int i = tid; i < 66 * 64 * 2; i += 512) {
    const int half = i & 1, sidx = (i >> 1) & 63, r = i >> 7;
    const int tok = s5_token(cc0 + r, sidx), ch = g * 16 + half * 8;
    const float* src = (tok < NL ? x + (size_t)tok * D : ctx + (size_t)(tok - NL) * D) + ch;
    const float* m = mod + row_vec(tok) * 6144;
    const float4 a = *(const float4*)src, b = *(const float4*)(src + 4);
    const float4 sh0 = *(const float4*)(m + ch), sh1 = *(const float4*)(m + ch + 4), sc0 = *(const float4*)(m + 1024 + ch), sc1 = *(const float4*)(m + 1024 + ch + 4);
    uint4 o;
    o.x = pack2bf(a.x * (1.f + sc0.x) + sh0.x, a.y * (1.f + sc0.y) + sh0.y); o.y = pack2bf(a.z * (1.f + sc0.z) + sh0.z, a.w * (1.f + sc0.w) + sh0.w);
    o.z = pack2bf(b.x * (1.f + sc1.x) + sh1.x, b.y * (1.f + sc1.y) + sh1.y); o.w = pack2bf(b.z * (1.f + sc1.z) + sh1.z, b.w * (1.f + sc1.w) + sh1.w);
    *(uint4*)(As + r * LDA_B + sidx * 32 + half * 16) = o;
  }
  __syncthreads();
  const char* ap[5];
#pragma unroll
  for (int t = 0; t < 5; ++t) { int r = t * 16 + l15; r = r < 66 ? r : 65; ap[t] = As + r * LDA_B + q * 16; }
  const bf16_t* Kg = Ktab + (size_t)g * 127 * 256;
#pragma unroll 1
  for (int unit = wave; unit < 40; unit += 8) {
    f32x4 acc[5][2];
    if (unit < 32) {
      const int t0 = unit * 2;
      const bf16_t* w0 = Kg + (t0 + 63 - (q >> 1)) * 256 + l15 * 16 + (q & 1) * 8;
      gemm_unit<5, 1024>(ap, w0, w0 + 256, -16, acc);
      unsigned yw[20];
#pragma unroll
      for (int t = 0; t < 5; ++t)
#pragma unroll
        for (int j = 0; j < 2; ++j) {
          float yv[4];
#pragma unroll
          for (int r = 0; r < 4; ++r) {
            int row = t * 16 + q * 4 + r; row = row < 66 ? row : 65;
            yv[r] = acc[t][j][r] + dch * bf2f(*(const bf16_t*)(As + row * LDA_B + (t0 + j) * 32 + l15 * 2));
          }
          yw[(t * 2 + j) * 2] = pack2bf(yv[0], yv[1]); yw[(t * 2 + j) * 2 + 1] = pack2bf(yv[2], yv[3]);
        }
      uint4* yp = (uint4*)(Ypart + (((size_t)bid * 32 + unit) * 64 + lane) * 40);
#pragma unroll
      for (int c = 0; c < 5; ++c) yp[c] = make_uint4(yw[4 * c], yw[4 * c + 1], yw[4 * c + 2], yw[4 * c + 3]);
    } else {
      const int n0 = (unit - 32) * 32;
      const bf16_t* w0 = Bst_t + (size_t)g * 256 * 1024 + (size_t)(n0 >> 4) * 1024 * 16 + lane * 8;
      gemm_unit<5, 1024>(ap, w0, w0 + 1024 * 16, 16, acc);
#pragma unroll
      for (int t = 0; t < 5; ++t)
#pragma unroll
        for (int j = 0; j < 2; ++j)
#pragma unroll
          for (int r = 0; r < 4; ++r) {
            const int row = t * 16 + q * 4 + r;
            if (row < 66) S[((size_t)(cc0 + row) * 64 + g) * 256 + n0 + j * 16 + l15] = acc[t][j][r];
          }
    }
  }
}
__device__ __forceinline__ void ph_s5_carry(const float* __restrict__ S, const float* __restrict__ a_re, const float* __restrict__ a_im,
                                                 const float* __restrict__ log_dt, bf16_t* __restrict__ HP, int id, int p) {
  const int dir = id & 1, g = (id >> 1) & 63, b = id >> 7;
  const int gp = (dir * 64 + g) * 64 + p;
  const float are = a_re[gp], aim = a_im[gp], dt = expf(log_dt[dir * 64 + g]);
  const float mag = expf(are * dt);
  float tr = mag * cosf(aim * dt), ti = mag * sinf(aim * dt);
#pragma unroll
  for (int i = 0; i < 6; ++i) { const float nr = tr * tr - ti * ti, ni = 2.f * tr * ti; tr = nr; ti = ni; }
  float hr = 0.f, hi = 0.f;
#pragma unroll 22
  for (int step = 0; step < NCHUNK; ++step) {
    const int c = dir == 0 ? step : (step < 4 ? 3 - step : NCHUNK - 1 - (step - 4));
    const size_t base = ((size_t)(b * NCHUNK + c) * 64 + g) * 256 + dir * 128 + p;
    HP[base] = f2bf(hr); HP[base + 64] = f2bf(hi);
    const float sr = S[base], si = S[base + 64];
    const float nr = tr * hr - ti * hi + sr, ni = tr * hi + ti * hr + si;
    hr = nr; hi = ni;
  }
}
__device__ __forceinline__ void ph_s5_p3(const bf16_t* __restrict__ HP, const bf16_t* __restrict__ Cin_t, const bf16_t* __restrict__ Ypart, bf16_t* __restrict__ Gbf, int bid, char* As) {
  const int g = bid >> 2, cc0 = (bid & 3) * 66, tid = otid();
  for (int i = tid; i < 66 * 32; i += 512) {
    const int r = i >> 5, c = i & 31;
    *(uint4*)(As + r * 528 + c * 16) = *(const uint4*)(HP + ((size_t)(cc0 + r) * 64 + g) * 256 + c * 8);
  }
  __syncthreads();
  const int wave = otid() >> 6, lane = otid() & 63, l15 = lane & 15, q = lane >> 4;
  const char* ap[5];
#pragma unroll
  for (int t = 0; t < 5; ++t) { int r = t * 16 + l15; r = r < 66 ? r : 65; ap[t] = As + r * 528 + q * 16; }
#pragma unroll 1
  for (int unit = wave; unit < 32; unit += 8) {
    const uint4* yp = (const uint4*)(Ypart + (((size_t)bid * 32 + unit) * 64 + lane) * 40);
    unsigned yw[20];
#pragma unroll
    for (int c = 0; c < 5; ++c) { const uint4 y4 = yp[c]; yw[4 * c] = y4.x; yw[4 * c + 1] = y4.y; yw[4 * c + 2] = y4.z; yw[4 * c + 3] = y4.w; }
    const bf16_t* w0 = Cin_t + (size_t)g * 1024 * 256 + (size_t)(unit * 2) * 256 * 16 + lane * 8;
    f32x4 acc[5][2];
    gemm_unit<5, 256>(ap, w0, w0 + 256 * 16, 16, acc);
#pragma unroll
    for (int t = 0; t < 5; ++t)
#pragma unroll
      for (int j = 0; j < 2; ++j)
#pragma unroll
        for (int r = 0; r < 4; ++r) {
          const int row = t * 16 + q * 4 + r;
          const unsigned w = yw[(t * 2 + j) * 2 + (r >> 1)];
          const float y = acc[t][j][r] + ((r & 1) ? bfhi(w) : bflo(w));
          if (row < 66) Gbf[(size_t)s5_token(cc0 + row, unit * 2 + j) * D + g * 16 + l15] = f2bf(gelu_fast(y));
        }
  }
}


struct ChainP {
  const bf16_t* Ain;
  const bf16_t* Wglu_t; const bf16_t* Wo_t; const bf16_t* Wq_t;
  bf16_t* Vbf; bf16_t* O; const float* Hl; const float* Hc; const float* mod; const float* lng; const float* lnb;
  float* Hout; bf16_t* Tbf; bf16_t* Q;
};
template <bool L0>
__device__ __forceinline__ void ph_chainA(const ChainP& p, int bid, char* As) {
  constexpr int NR = L0 ? 66 : 64;
  constexpr int RT = L0 ? 5 : 4;
  const int g0 = bid * NR;
  load_rows_lds(As, p.Ain + (size_t)g0 * D, NR);
  __syncthreads();
  if (L0) {
    gemm_ldsA<RT, 1024>(As, LDA_B, NR, p.Wglu_t, D, EpiGluL{As, p.Vbf + (size_t)g0 * D});
    __syncthreads();
    load_rows_lds(As, p.Vbf + (size_t)g0 * D, NR);
    __syncthreads();
  }
  if constexpr (L0) gemm_ldsA<RT, 1024>(As, LDA_B, NR, p.Wo_t, D, EpiBF16{p.O + (size_t)g0 * D, D});
  else gemm_ldsA8<RT, 1024>(As, LDA_B, NR, (const unsigned char*)p.Wo_t, D, EpiBF16{p.O + (size_t)g0 * D, D});
  __syncthreads();
  ln_rows(As, g0, NR, p.Hl, p.Hc, p.O, p.mod, 2, p.lng, p.lnb, p.Hout, p.Tbf, 3, 4);
  __syncthreads();
  gemm_ldsA<RT, 1024>(As, LDA_B, NR, p.Wq_t, D, EpiBF16{p.Q + (size_t)g0 * D, D});
}


constexpr int KEYS = SEQ + CTX;
constexpr float att_KS = 0.5f;
struct EpiKV { unsigned char* Kn; unsigned char* Vl; int g0; int sh; __device__ __forceinline__ void operator()(int row, int col, float v) const {
  const int head = col >> 8, j = col & 255;
  if (j < 128) {
    const int g = g0 + row; int b, key;
    if (g < NL) { b = g >> 13; key = g & (SEQ - 1); } else { const int cidx = g - NL; b = cidx >> 8; key = SEQ + (cidx & (CTX - 1)); }
    Kn[((size_t)(b * 8 + head) * KEYS + key) * 128 + j] = f2fp8(v * att_KS);
  } else Vl[(head * 128 + (j - 128)) * 68 + row + sh] = f2fp8(v * 4.f);
} };
struct EpiQ { bf16_t* Qa; int g0; int pad; __device__ __forceinline__ void operator()(int row, int col, float v) const {
  const int g = g0 + row, b = g >> 13, n = g & (SEQ - 1);
  const int head = col / 192, j = col - head * 192;
  Qa[((size_t)(b * 8 + head) * SEQ + n) * 192 + j] = f2bf(v);
} };
struct ProjP { const bf16_t* Wcat_t; const bf16_t* Wuq_t; const bf16_t* Wukv_t; const float* q_norm; const float* kv_norm;
               float* PR; bf16_t* Qa; unsigned char* Kn; unsigned char* Kr; unsigned char* Va; };
__device__ __forceinline__ void ph_mla_proj(const ProjP& p, int bid, char* As) {
  const int g0 = bid * 66, wave = otid() >> 6, lane = otid() & 63;
  gemm_ldsA8<5, 1024>(As, LDA_B, 66, (const unsigned char*)p.Wcat_t, 704, EpiF32{p.PR + (size_t)g0 * D, D});
  __syncthreads();
  char* A1 = As; char* A2 = As + 66 * 784;
  for (int rr = wave; rr < 66; rr += 8) {
    const int g = g0 + rr;
    const float* pr = p.PR + (size_t)g * D;
    float v[6]; float ss = 0.f;
#pragma unroll
    for (int i = 0; i < 6; ++i) { v[i] = pr[i * 64 + lane]; ss += v[i] * v[i]; }
    float rn = rsqrtf(wave_sum(ss) * (1.f / 384.f) + RMS_EPS);
#pragma unroll
    for (int i = 0; i < 6; ++i) *(bf16_t*)(A1 + rr * 784 + (i * 64 + lane) * 2) = f2bf(v[i] * rn * p.q_norm[i * 64 + lane]);
    float w[4]; ss = 0.f;
#pragma unroll
    for (int i = 0; i < 4; ++i) { w[i] = pr[384 + i * 64 + lane]; ss += w[i] * w[i]; }
    rn = rsqrtf(wave_sum(ss) * (1.f / 256.f) + RMS_EPS);
#pragma unroll
    for (int i = 0; i < 4; ++i) *(bf16_t*)(A2 + rr * 528 + (i * 64 + lane) * 2) = f2bf(w[i] * rn * p.kv_norm[i * 64 + lane]);
    if (lane < 32) {
      float x1 = pr[640 + lane], x2 = pr[672 + lane];
      int b, key;
      if (g < NL) {
        b = g >> 13; key = g & (SEQ - 1);
        const int n = key, rr2 = n >> 6, cc = n & 63;
        const float inv = powf(10000.f, -(float)(lane & 15) / 16.f);
        const float ang = (lane < 16 ? (float)rr2 : (float)cc) * inv;
        const float cs = cosf(ang), sn = sinf(ang);
        const float y1 = x1 * cs - x2 * sn, y2 = x2 * cs + x1 * sn; x1 = y1; x2 = y2;
      } else { const int cidx = g - NL; b = cidx >> 8; key = SEQ + (cidx & (CTX - 1)); }
      unsigned char* kp = p.Kr + ((size_t)b * KEYS + key) * 64;
      kp[lane] = f2fp8(x1 * att_KS); kp[32 + lane] = f2fp8(x2 * att_KS);
    }
  }
  __syncthreads();
  int nq = NL - g0; nq = nq > 66 ? 66 : nq;
  if (nq > 0) gemm_ldsA8<5, 384>(A1, 784, nq, (const unsigned char*)p.Wuq_t, 1536, EpiQ{p.Qa, g0, 0});
  unsigned char* Vl = (unsigned char*)As + 66 * 784 + 66 * 528;
  const int sh = g0 & 3;
  gemm_ldsA8<5, 256>(A2, 528, 66, (const unsigned char*)p.Wukv_t, 2048, EpiKV{p.Kn, Vl, g0, sh});
  __syncthreads();
  for (int i = otid(); i < 1024 * 17; i += 512) {
    const int dvg = i / 17, q4 = i - dvg * 17, g4 = g0 - sh + 4 * q4;
    const unsigned w = *(const unsigned*)(Vl + dvg * 68 + 4 * q4);
    int b, key;
    if (g4 < NL) { b = g4 >> 13; key = g4 & (SEQ - 1); } else { const int cidx = g4 - NL; b = cidx >> 8; key = SEQ + (cidx & (CTX - 1)); }
    const int m = (key & 63) >> 2, posd = (m & 1) * 8 + (m >> 3) * 4 + ((m >> 1) & 3);
    unsigned char* dst = p.Va + ((size_t)(b * 8 + (dvg >> 7)) * (KEYS / 64) + (key >> 6)) * 8192 + (dvg & 127) * 64 + posd * 4;
    if (g4 >= g0 && g4 + 3 < g0 + 66) *(unsigned*)dst = w;
    else if (g4 < g0) *(unsigned short*)(dst + 2) = (unsigned short)(w >> 16);
    else *(unsigned short*)dst = (unsigned short)(w & 0xFFFFu);
  }
  for (int rr = wave; rr < nq; rr += 8) {
    const int g = g0 + rr, b = g >> 13, n = g & (SEQ - 1);
    if (lane < 32) {
      const float inv = powf(10000.f, -(float)(lane & 15) / 16.f);
      const float ang = (lane < 16 ? (float)(n >> 6) : (float)(n & 63)) * inv;
      const float cs = cosf(ang), sn = sinf(ang);
#pragma unroll
      for (int h = 0; h < 8; ++h) {
        bf16_t* qo = p.Qa + ((size_t)(b * 8 + h) * SEQ + n) * 192;
        const float x1 = bf2f(qo[128 + lane]), x2 = bf2f(qo[160 + lane]);
        qo[128 + lane] = f2bf(x1 * cs - x2 * sn); qo[160 + lane] = f2bf(x2 * cs + x1 * sn);
      }
    }
  }
}

namespace att {
using i32x8 = __attribute__((ext_vector_type(8))) int;
using i32x4 = __attribute__((ext_vector_type(4))) int;
using f32x16 = __attribute__((ext_vector_type(16))) float;
constexpr int KVBLK = 64, KROW = 208, VROW = 80, NTILE = KEYS / 64;
constexpr float KS = 0.5f, VS = 4.f;
constexpr float QS = 0.07216878364870322f * 1.4426950408889634f / KS;
constexpr float THR2 = 3.f * 1.4426950408889634f, PSH = 4.f;
constexpr int SHM_V = 128 * VROW, SHM_K = KVBLK * KROW, NSLOT = 3, SHM_ATTN = NSLOT * (SHM_V + SHM_K) + 8 * 64 * 4;
#define SBAR() __builtin_amdgcn_sched_barrier(0)
__device__ __forceinline__ int crow(int r, int hi) { return (r & 3) + 8 * (r >> 2) + 4 * hi; }
__device__ __forceinline__ f32x16 mfma8(i32x8 a, i32x8 b, f32x16 c) { return __builtin_amdgcn_mfma_scale_f32_32x32x64_f8f6f4(a, b, c, 0, 0, 0, 0, 0, 0); }
__device__ __forceinline__ i32x8 cat8(i32x4 a, i32x4 b) { return __builtin_shufflevector(a, b, 0, 1, 2, 3, 4, 5, 6, 7); }
__device__ __forceinline__ int pk4(float a, float b, float c, float d, int old = 0) { const int w = __builtin_amdgcn_cvt_pk_fp8_f32(a, b, old, false); return __builtin_amdgcn_cvt_pk_fp8_f32(c, d, w, true); }
__device__ __forceinline__ void softmax_tile(f32x16& p0, f32x16& p1, f32x16& bias, bool first, f32x16* o, float* al_l, int r32, int hi, i32x8& pa) {
  float pmax = p0[0];
#pragma unroll
  for (int r = 1; r < 16; ++r) pmax = fmaxf(pmax, p0[r]);
#pragma unroll
  for (int r = 0; r < 16; ++r) pmax = fmaxf(pmax, p1[r]);
  { auto rr = __builtin_amdgcn_permlane32_swap(__float_as_uint(pmax), __float_as_uint(pmax), false, false);
    pmax = fmaxf(__uint_as_float(rr[0]), __uint_as_float(rr[1])); }
  if (__builtin_expect(first || !__all(pmax <= PSH + THR2), 0)) {
    const float delta = first ? pmax - PSH : fmaxf(pmax - PSH, 0.f);
    if (!first) {
      if (hi == 0) al_l[r32] = __builtin_amdgcn_exp2f(-delta);
      asm volatile("s_waitcnt lgkmcnt(0)" ::: "memory");
#pragma unroll
      for (int d = 0; d < 5; ++d)
#pragma unroll
        for (int r = 0; r < 16; ++r) o[d][r] *= al_l[crow(r, hi)];
    }
    const float nb = bias[0] - delta;
#pragma unroll
    for (int r = 0; r < 16; ++r) { p0[r] -= delta; p1[r] -= delta; bias[r] = nb; }
  }
#pragma unroll
  for (int r = 0; r < 16; ++r) p0[r] = __builtin_amdgcn_exp2f(p0[r]);
#pragma unroll
  for (int r = 0; r < 16; ++r) p1[r] = __builtin_amdgcn_exp2f(p1[r]);
#pragma unroll
  for (int w = 0; w < 4; ++w) { pa[w] = pk4(p0[4 * w], p0[4 * w + 1], p0[4 * w + 2], p0[4 * w + 3], pa[w]); pa[4 + w] = pk4(p1[4 * w], p1[4 * w + 1], p1[4 * w + 2], p1[4 * w + 3], pa[4 + w]); }
}
__device__ __forceinline__ void qkt(f32x16& p0, f32x16& p1, const f32x16& bias, const char* Ks, const i32x8* q, int r32, int hi) {
  p0 = bias; p1 = bias;
  const char* k0 = Ks + r32 * KROW + hi * 32; const char* k1 = k0 + 32 * KROW;
#pragma unroll
  for (int s = 0; s < 3; ++s) {
    const i32x8 a0 = cat8(*reinterpret_cast<const i32x4*>(k0 + s * 64), *reinterpret_cast<const i32x4*>(k0 + s * 64 + 16));
    const i32x8 a1 = cat8(*reinterpret_cast<const i32x4*>(k1 + s * 64), *reinterpret_cast<const i32x4*>(k1 + s * 64 + 16));
    p0 = mfma8(a0, q[s], p0);
    p1 = mfma8(a1, q[s], p1); }
}
__device__ __forceinline__ void pv_all(f32x16* o, const char* Vs, i32x8 pa, int r32, int hi) {
  const char* v0 = Vs + r32 * VROW + hi * 32;
#pragma unroll
  for (int d0 = 0; d0 < 4; ++d0) {
    const i32x8 vb = cat8(*reinterpret_cast<const i32x4*>(v0 + d0 * 32 * VROW), *reinterpret_cast<const i32x4*>(v0 + d0 * 32 * VROW + 16));
    o[d0] = mfma8(pa, vb, o[d0]); }
  const i32x8 ones = {0x38383838, 0x38383838, 0x38383838, 0x38383838, 0x38383838, 0x38383838, 0x38383838, 0x38383838};
  o[4] = mfma8(pa, ones, o[4]);
}
__device__ __forceinline__ void attn_body(const bf16_t* __restrict__ Qb, const unsigned char* __restrict__ Kn, const unsigned char* __restrict__ Krb, const unsigned char* __restrict__ Vt,
                                          bf16_t* __restrict__ Ob, char* lds) {
  const int tid = otid(), wid = tid >> 6, lane = tid & 63, r32 = lane & 31, hi = lane >> 5;
  const bool lo4 = __builtin_amdgcn_readfirstlane(wid >> 2) == 0;
  char* V_lds = lds; char* K_lds = lds + NSLOT * SHM_V;
  float* al_l = (float*)(lds + NSLOT * (SHM_V + SHM_K)) + wid * 64;
  f32x16 bias = {}; f32x16 o[5] = {}; i32x8 q[3];
  { const bf16_t* Qw = Qb + (size_t)(wid * 32 + r32) * 192 + hi * 32;
#pragma unroll
    for (int s = 0; s < 3; ++s) {
#pragma unroll
      for (int c = 0; c < 4; ++c) { const uint4 w = *reinterpret_cast<const uint4*>(Qw + s * 64 + c * 8);
        q[s][2 * c] = pk4(bflo(w.x) * QS, bfhi(w.x) * QS, bflo(w.y) * QS, bfhi(w.y) * QS);
        q[s][2 * c + 1] = pk4(bflo(w.z) * QS, bfhi(w.z) * QS, bflo(w.w) * QS, bfhi(w.w) * QS); } } }
  i32x8 ones = {0x38383838, 0x38383838, 0x38383838, 0x38383838, 0x38383838, 0x38383838, 0x38383838, 0x38383838};
  const int vdst = (tid >> 2) * VROW + (tid & 3) * 16, kdst = (tid >> 3) * KROW + (tid & 7) * 16, rdst = (tid >> 2) * KROW + 128 + (tid & 3) * 16;
  const int kfo = r32 * KROW + hi * 32, vfo = r32 * VROW + hi * 32;
  uint4 vs, ks, rs = make_uint4(0u, 0u, 0u, 0u);
#define TLOAD(t) do { ks = *reinterpret_cast<const uint4*>(Kn + (size_t)(t) * 8192 + tid * 16); vs = *reinterpret_cast<const uint4*>(Vt + (size_t)(t) * 8192 + tid * 16); \
    if (lo4) rs = *reinterpret_cast<const uint4*>(Krb + (size_t)(t) * 4096 + tid * 16); } while (0)
#define TWRITE(sl) do { *(uint4*)(K_lds + (sl) * SHM_K + kdst) = ks; *(uint4*)(V_lds + (sl) * SHM_V + vdst) = vs; if (lo4) *(uint4*)(K_lds + (sl) * SHM_K + rdst) = rs; } while (0)
#define SWAIT() asm volatile("s_waitcnt vmcnt(0)" ::: "memory")
#define LD4(p) (*reinterpret_cast<const i32x4*>(p))
  f32x16 p0, p1; i32x8 pa = {};
  TLOAD(0); SWAIT(); TWRITE(0);
  TLOAD(1); SWAIT(); TWRITE(1);
  TLOAD(2);
  __syncthreads();
  int sl = 0, sl2 = 2;
#pragma unroll 1
  for (int i = 0; i < NTILE; ++i) {
    const char* kb = K_lds + sl * SHM_K + kfo; const char* vb = V_lds + sl * SHM_V + vfo;
    SBAR();
    i32x4 ka0 = LD4(kb), ka1 = LD4(kb + 16), ka2 = LD4(kb + 32 * KROW), ka3 = LD4(kb + 32 * KROW + 16);
    i32x4 kb0 = LD4(kb + 64), kb1 = LD4(kb + 80), kb2 = LD4(kb + 32 * KROW + 64), kb3 = LD4(kb + 32 * KROW + 80);
    SBAR();
    p0 = mfma8(cat8(ka0, ka1), q[0], bias); p1 = mfma8(cat8(ka2, ka3), q[0], bias);
    ka0 = LD4(kb + 128); ka1 = LD4(kb + 144); ka2 = LD4(kb + 32 * KROW + 128); ka3 = LD4(kb + 32 * KROW + 144);
    SBAR();
    p0 = mfma8(cat8(kb0, kb1), q[1], p0); p1 = mfma8(cat8(kb2, kb3), q[1], p1);
    i32x4 v00 = LD4(vb), v01 = LD4(vb + 16), v10 = LD4(vb + 32 * VROW), v11 = LD4(vb + 32 * VROW + 16);
    SBAR();
    p0 = mfma8(cat8(ka0, ka1), q[2], p0); p1 = mfma8(cat8(ka2, ka3), q[2], p1);
    SBAR();
    softmax_tile(p0, p1, bias, i == 0, o, al_l, r32, hi, pa);
    SBAR();
    i32x4 v20 = LD4(vb + 64 * VROW), v21 = LD4(vb + 64 * VROW + 16), v30 = LD4(vb + 96 * VROW), v31 = LD4(vb + 96 * VROW + 16);
    o[4] = mfma8(pa, ones, o[4]); o[0] = mfma8(pa, cat8(v00, v01), o[0]); o[1] = mfma8(pa, cat8(v10, v11), o[1]);
    SBAR();
    o[2] = mfma8(pa, cat8(v20, v21), o[2]); o[3] = mfma8(pa, cat8(v30, v31), o[3]);
    SBAR();
    SWAIT();
    if (i + 2 < NTILE) TWRITE(sl2);
    if (i + 3 < NTILE) TLOAD(i + 3);
    sl = sl == NSLOT - 1 ? 0 : sl + 1; sl2 = sl2 == NSLOT - 1 ? 0 : sl2 + 1;
    SBAR(); __syncthreads();
  }
  float rli[16];
#pragma unroll
  for (int r = 0; r < 16; ++r) rli[r] = __builtin_amdgcn_rcpf(o[4][r]) * (1.f / VS);
  bf16_t* Ow = Ob + (size_t)(wid * 32) * D;
#pragma unroll
  for (int r = 0; r < 16; ++r) { const int orow = crow(r, hi);
#pragma unroll
    for (int d0 = 0; d0 < 4; ++d0) Ow[(size_t)orow * D + d0 * 32 + r32] = f2bf(o[d0][r] * rli[r]); }
  __syncthreads();
#undef TLOAD
#undef TWRITE
#undef SWAIT
#undef LD4
}
}

__device__ __forceinline__ void ph_attn(const bf16_t* __restrict__ Qa, const unsigned char* __restrict__ Kn, const unsigned char* __restrict__ Kr, const unsigned char* __restrict__ Vt,
                                        bf16_t* __restrict__ AO, int bid, int nblk, char* lds) {
  for (int item = bid; item < 512; item += nblk) {
    const int b = item >> 8, h = item & 7, qb = (item >> 3) & 31;
    att::attn_body(Qa + ((size_t)(b * 8 + h) * SEQ + qb * 256) * 192, Kn + (size_t)(b * 8 + h) * KEYS * 128, Kr + (size_t)b * KEYS * 64,
                   Vt + (size_t)(b * 8 + h) * KEYS * 128, AO + (size_t)(b * SEQ + qb * 256) * D + h * 128, lds);
  }
}

namespace rt {
using f32x16 = __attribute__((ext_vector_type(16))) float;
__device__ __forceinline__ int sortable(float f) { const int b = __float_as_int(f); return b ^ ((b >> 31) & 0x7FFFFFFF); }
__device__ __forceinline__ float unsortable(int k) { return __int_as_float(k ^ ((k >> 31) & 0x7FFFFFFF)); }
__device__ __forceinline__ int imax(int a, int b) { return a > b ? a : b; }
__device__ __forceinline__ int imin(int a, int b) { return a < b ? a : b; }
template <int N> __device__ __forceinline__ void sort_desc(int (&v)[N]) {
#pragma unroll
  for (int k = 2; k <= N; k <<= 1) {
#pragma unroll
    for (int j = k >> 1; j > 0; j >>= 1) {
#pragma unroll
      for (int i = 0; i < N; ++i) {
        const int l = i ^ j;
        if (l > i) {
          const bool desc = ((i & k) == 0);
          const int a = v[i], b = v[l];
          v[i] = desc ? imax(a, b) : imin(a, b);
          v[l] = desc ? imin(a, b) : imax(a, b);
        }
      }
    }
  }
}
template <int N> __device__ __forceinline__ void merge_desc(int (&v)[N]) {
#pragma unroll
  for (int j = N >> 1; j > 0; j >>= 1) {
#pragma unroll
    for (int i = 0; i < N; ++i) {
      const int l = i ^ j;
      if (l > i) { const int a = v[i], b = v[l]; v[i] = imax(a, b); v[l] = imin(a, b); }
    }
  }
}
__device__ __forceinline__ void absorb16(int (&L)[16], int (&B)[16]) {
  sort_desc<16>(B);
#pragma unroll
  for (int i = 0; i < 16; ++i) L[i] = imax(L[i], B[15 - i]);
  merge_desc<16>(L);
}
__device__ __forceinline__ constexpr int npairs_row(int i) { return 16 / (i + 1); }
}

struct RouteP { const bf16_t* Q; const bf16_t* Khi; int* IDX; float* GATE; int rows_per_block; int pad; };
__device__ __forceinline__ void ph_route(const RouteP& p, int bid, char* lds) {
  using namespace rt;
  int (*svl)[64][33] = reinterpret_cast<int (*)[64][33]>(lds);
  const int wave = otid() >> 6, lane = otid() & 63, r32 = lane & 31, hi = lane >> 5, hi4 = hi * 4;
  int nrows = p.rows_per_block; asm volatile("" : "+s"(nrows));
  const int g0 = bid * nrows;
  const int h = wave;
#pragma unroll 1
  for (int tg = 0; tg * 32 < nrows; ++tg) {
    int trow = tg * 32 + r32; const bool valid = trow < nrows; trow = valid ? trow : nrows - 1;
    const bf16_t* qrow = p.Q + (size_t)(g0 + trow) * D;
    int sv[2][16];
#pragma unroll
    for (int s = 0; s < 2; ++s) {
      const int hs = h * 2 + s;
      f32x16 acc[4];
#pragma unroll
      for (int m = 0; m < 4; ++m) acc[m] = f32x16{};
#pragma unroll
      for (int kp = 0; kp < 2; ++kp) {
        bf16x8 kf[2][4], qf[2];
#pragma unroll
        for (int k2 = 0; k2 < 2; ++k2)
#pragma unroll
          for (int m = 0; m < 4; ++m) kf[k2][m] = *(const bf16x8*)(p.Khi + ((size_t)(hs * 128 + m * 32 + r32)) * 64 + (kp * 2 + k2) * 16 + hi * 8);
#pragma unroll
        for (int k2 = 0; k2 < 2; ++k2) {
          const int ks = kp * 2 + k2;
          qf[k2] = *(const bf16x8*)(qrow + hs * 64 + ks * 16 + hi * 8);
        }
#pragma unroll
        for (int k2 = 0; k2 < 2; ++k2)
#pragma unroll
          for (int m = 0; m < 4; ++m) acc[m] = __builtin_amdgcn_mfma_f32_32x32x16_bf16(kf[k2][m], qf[k2], acc[m], 0, 0, 0);
      }
      int L[16];
#pragma unroll
      for (int m = 0; m < 4; ++m) {
        int B[16];
#pragma unroll
        for (int r = 0; r < 16; ++r) B[r] = (sortable(acc[m][r]) & ~0x7F) | (m * 32 + (r & 3) + 8 * (r >> 2)) | hi4;
        if (m == 0) { sort_desc<16>(B);
#pragma unroll
          for (int i = 0; i < 16; ++i) L[i] = B[i]; }
        else absorb16(L, B);
      }
      int Lo[16], Hi[16];
#pragma unroll
      for (int i = 0; i < 16; ++i) { auto rr = __builtin_amdgcn_permlane32_swap((unsigned)L[i], (unsigned)L[i], false, false); Lo[i] = (int)rr[0]; Hi[i] = (int)rr[1]; }
#pragma unroll
      for (int i = 0; i < 16; ++i) L[i] = imax(Lo[i], Hi[15 - i]);
      merge_desc<16>(L);
#pragma unroll
      for (int i = 0; i < 16; ++i) { sv[s][i] = L[i]; svl[wave][lane][s * 16 + i] = L[i]; }
    }
    float f0[16], f1[16];
#pragma unroll
    for (int i = 0; i < 16; ++i) { f0[i] = unsortable(sv[0][i] & ~0x7F); f1[i] = unsortable(sv[1][i] & ~0x7F); }
    int Lc[16];
    {
      int C[64];
      int n = 0;
#pragma unroll
      for (int i = 0; i < 16; ++i)
#pragma unroll
        for (int j = 0; j < 16; ++j)
          if ((i + 1) * (j + 1) <= 16) { C[n] = (sortable(f0[i] + f1[j]) & ~0xFF) | (i * 16 + j); ++n; }
#pragma unroll
      for (int k = 50; k < 64; ++k) C[k] = (int)0x80000000;
#pragma unroll
      for (int m = 0; m < 4; ++m) {
        int B[16];
#pragma unroll
        for (int r = 0; r < 16; ++r) B[r] = C[m * 16 + r];
        if (m == 0) { sort_desc<16>(B);
#pragma unroll
          for (int i = 0; i < 16; ++i) Lc[i] = B[i]; }
        else absorb16(Lc, B);
      }
    }
    float e[16]; float esum = 0.f;
    const float vmax = unsortable(Lc[0] & ~0xFF);
#pragma unroll
    for (int r = 0; r < 16; ++r) { e[r] = expf(unsortable(Lc[r] & ~0xFF) - vmax); esum += e[r]; }
    const float inv = 1.f / esum;
    int eid[16];
#pragma unroll
    for (int r = 0; r < 16; ++r) {
      const int pr = Lc[r] & 0xFF;
      const int k0 = svl[wave][lane][pr >> 4] & 0x7F, k1 = svl[wave][lane][16 + (pr & 15)] & 0x7F;
      eid[r] = k0 * 128 + k1;
    }
    if (valid && hi == 0) {
      int* ip = p.IDX + (size_t)(g0 + trow) * 128 + h * 16; float* gp = p.GATE + (size_t)(g0 + trow) * 128 + h * 16;
#pragma unroll
      for (int r = 0; r < 16; r += 4) {
        *(int4*)(ip + r) = make_int4(eid[r], eid[r + 1], eid[r + 2], eid[r + 3]);
        *(float4*)(gp + r) = make_float4(e[r] * inv, e[r + 1] * inv, e[r + 2] * inv, e[r + 3] * inv);
      }
    }
  }
}

constexpr int RB = 8;
template <bool SIGNED>
__device__ __forceinline__ void cvt_rows_i8(const float* __restrict__ src, unsigned char* __restrict__ dst, float* __restrict__ scl, int nrows, int wgid, int nw) {
  const int lane = otid() & 63;
  for (int r0 = wgid * RB; r0 < nrows; r0 += nw * RB) {
    float v[RB][16];
#pragma unroll
    for (int u = 0; u < RB; ++u) {
      const float* sp = src + (size_t)(r0 + u) * D + lane * 4;
      *(float4*)&v[u][0] = *(const float4*)sp; *(float4*)&v[u][4] = *(const float4*)(sp + 256); *(float4*)&v[u][8] = *(const float4*)(sp + 512); *(float4*)&v[u][12] = *(const float4*)(sp + 768);
    }
#pragma unroll
    for (int u = 0; u < RB; ++u) {
      float am = 0.f;
#pragma unroll
      for (int j = 0; j < 16; ++j) am = fmaxf(am, fabsf(v[u][j]));
      am = wave_max_dpp(am);
      const float sc = am > 0.f ? am * (1.f / 127.f) : 1.f, inv = 1.f / sc;
      unsigned w[4];
#pragma unroll
      for (int q4 = 0; q4 < 4; ++q4) {
        unsigned ww = 0u;
#pragma unroll
        for (int j = 0; j < 4; ++j) { int qi = (int)rintf(v[u][q4 * 4 + j] * inv) + (SIGNED ? 0 : 128); qi = SIGNED ? (qi < -127 ? -127 : (qi > 127 ? 127 : qi)) : (qi < 1 ? 1 : (qi > 255 ? 255 : qi)); ww |= (unsigned)(qi & 255) << (8 * j); }
        w[q4] = ww;
      }
      *(uint4*)(dst + (size_t)(r0 + u) * D + lane * 16) = make_uint4(w[0], w[1], w[2], w[3]);
      if (lane == 0) scl[r0 + u] = sc;
    }
  }
}

constexpr int QROW = 512;
__device__ __forceinline__ void cvt_rows_q6(const float* __restrict__ src, unsigned char* __restrict__ dst, float* __restrict__ scl, int nrows, int wgid, int nw) {
  const int lane = otid() & 63;
  for (int r0 = wgid * RB; r0 < nrows; r0 += nw * RB) {
    float v[RB][16];
#pragma unroll
    for (int u = 0; u < RB; ++u) {
      const float* sp = src + (size_t)(r0 + u) * D + lane * 4;
      *(float4*)&v[u][0] = *(const float4*)sp; *(float4*)&v[u][4] = *(const float4*)(sp + 256); *(float4*)&v[u][8] = *(const float4*)(sp + 512); *(float4*)&v[u][12] = *(const float4*)(sp + 768);
    }
#pragma unroll
    for (int u = 0; u < RB; ++u) {
      float am = 0.f;
#pragma unroll
      for (int j = 0; j < 16; ++j) am = fmaxf(am, fabsf(v[u][j]));
      am = wave_max_dpp(am);
      const float sc = am > 0.f ? am * (1.f / 7.f) : 1.f, inv = 1.f / sc;
      unsigned w0 = 0u, w1 = 0u;
#pragma unroll
      for (int j = 0; j < 8; ++j) {
        int qa = (int)rintf(v[u][j] * inv) + 8; qa = qa < 1 ? 1 : (qa > 15 ? 15 : qa);
        int qb = (int)rintf(v[u][8 + j] * inv) + 8; qb = qb < 1 ? 1 : (qb > 15 ? 15 : qb);
        w0 |= (unsigned)qa << (4 * j); w1 |= (unsigned)qb << (4 * j);
      }
      *(uint2*)(dst + (size_t)(r0 + u) * QROW + lane * 8) = make_uint2(w0, w1);
      if (lane == 0) scl[r0 + u] = sc;
    }
  }
}
struct q6w { unsigned x, y, z; };
template <int J> __device__ __forceinline__ float q6(const q6w& w) {
  const unsigned x = J < 8 ? w.x : w.y; constexpr int sh = 4 * (J & 7);
  if constexpr (sh == 28) return (float)(x >> 28); else return (float)((x >> sh) & 15u);
}

struct GatherP { const bf16_t* Tbf; const int* IDX; const float* GATE; const unsigned char* utab; const unsigned char* vtab; const float* su; const float* sv;
                 const float* Hin; const float* mod; const float* lng; const float* lnb; float* Hout; const float* modT; };
#define UB0(w) ((float)((w) & 0xFFu))
#define UB1(w) ((float)(((w) >> 8) & 0xFFu))
#define UB2(w) ((float)(((w) >> 16) & 0xFFu))
#define UB3(w) ((float)((w) >> 24))
template <bool FINAL>
__device__ __forceinline__ void ln_token(const GatherP& p, int row, int rr, int lane, const float (&f)[16], float asum, char* As) {
  const int v = row_vec(row);
  const float* hin = p.Hin + (size_t)row * D + lane * 4;
  const float* gm = p.mod + v * 6144 + 5 * 1024 + lane * 4;
  const float off = 8.f * asum;
  float r[16]; float ssum = 0.f;
#pragma unroll
  for (int q4 = 0; q4 < 4; ++q4) {
    const float4 h4 = *(const float4*)(hin + q4 * 256), g4 = *(const float4*)(gm + q4 * 256);
    r[q4 * 4 + 0] = ALPHA * h4.x + g4.x * (f[q4 * 4 + 0] - off); r[q4 * 4 + 1] = ALPHA * h4.y + g4.y * (f[q4 * 4 + 1] - off);
    r[q4 * 4 + 2] = ALPHA * h4.z + g4.z * (f[q4 * 4 + 2] - off); r[q4 * 4 + 3] = ALPHA * h4.w + g4.w * (f[q4 * 4 + 3] - off);
    ssum += r[q4 * 4 + 0] + r[q4 * 4 + 1] + r[q4 * 4 + 2] + r[q4 * 4 + 3];
  }
  const float mu = wave_sum(ssum) * (1.f / D);
  float vs = 0.f;
#pragma unroll
  for (int j = 0; j < 16; ++j) { const float dlt = r[j] - mu; vs += dlt * dlt; }
  const float rstd = rsqrtf(wave_sum(vs) * (1.f / D) + LN_EPS);
  float o[16];
#pragma unroll
  for (int q4 = 0; q4 < 4; ++q4) {
    const float4 g4 = *(const float4*)(p.lng + q4 * 256 + lane * 4), b4 = *(const float4*)(p.lnb + q4 * 256 + lane * 4);
    o[q4 * 4 + 0] = (r[q4 * 4 + 0] - mu) * rstd * g4.x + b4.x; o[q4 * 4 + 1] = (r[q4 * 4 + 1] - mu) * rstd * g4.y + b4.y;
    o[q4 * 4 + 2] = (r[q4 * 4 + 2] - mu) * rstd * g4.z + b4.z; o[q4 * 4 + 3] = (r[q4 * 4 + 3] - mu) * rstd * g4.w + b4.w;
    *(float4*)(p.Hout + (size_t)row * D + q4 * 256 + lane * 4) = make_float4(o[q4 * 4 + 0], o[q4 * 4 + 1], o[q4 * 4 + 2], o[q4 * 4 + 3]);
  }
  if (!FINAL) {
    const float* mt = p.modT + v * 6144 + lane * 4;
#pragma unroll
    for (int q4 = 0; q4 < 4; ++q4) {
      const float4 sh = *(const float4*)(mt + q4 * 256), sc = *(const float4*)(mt + 1024 + q4 * 256);
      uint2 w; w.x = pack2bf(o[q4 * 4] * (1.f + sc.x) + sh.x, o[q4 * 4 + 1] * (1.f + sc.y) + sh.y); w.y = pack2bf(o[q4 * 4 + 2] * (1.f + sc.z) + sh.z, o[q4 * 4 + 3] * (1.f + sc.w) + sh.w);
      *(uint2*)(As + rr * LDA_B + (q4 * 256 + lane * 4) * 2) = w;
    }
  }
}
constexpr int PARTW = 1088;
template <bool FINAL>
__device__ __forceinline__ void ph_gather_tm(const GatherP& p, int g0, int nrows, char* As, float* __restrict__ PART) {
  const int tid = otid(), wave = tid >> 6, lane = tid & 63;
  const int nfull = nrows >> 3, extra = nrows & 7;
  const int nun = nfull + (extra ? 1 : 0);
  typedef unsigned u32x4_t __attribute__((ext_vector_type(4))); typedef unsigned u32x2_t __attribute__((ext_vector_type(2)));
  const __amdgpu_buffer_rsrc_t ursrc = __builtin_amdgcn_make_buffer_rsrc((void*)p.utab, 0, 0x7FFFFFFF, 0x00020000);
  const __amdgpu_buffer_rsrc_t vrsrc = __builtin_amdgcn_make_buffer_rsrc((void*)p.vtab, 0, 0x7FFFFFFF, 0x00020000);
  const int lane16 = lane * 16, lane8 = lane * 8;
  auto desc = [&](int un, int& rr, int& kbeg, int& kcnt, bool& partial) {
    if (un < nfull) { rr = wave + 8 * un; kbeg = 0; kcnt = 128; partial = false; }
    else { const int wpt = 8 / extra; rr = nfull * 8 + wave / wpt; kcnt = 128 / wpt; kbeg = (wave % wpt) * kcnt; partial = true; }
  };
  uint2 nt0, nt1, nt2, nt3; int nid_lo, nid_hi; float nga_lo, nga_hi;
#define NLOAD(row_) do { const bf16_t* tp_ = p.Tbf + (size_t)(row_) * D + lane * 4; nt0 = *(const uint2*)tp_; nt1 = *(const uint2*)(tp_ + 256); nt2 = *(const uint2*)(tp_ + 512); nt3 = *(const uint2*)(tp_ + 768); \
    nid_lo = p.IDX[(size_t)(row_) * 128 + lane]; nid_hi = p.IDX[(size_t)(row_) * 128 + 64 + lane]; nga_lo = p.GATE[(size_t)(row_) * 128 + lane]; nga_hi = p.GATE[(size_t)(row_) * 128 + 64 + lane]; } while (0)
  { int rr0, kb0, kc0; bool pa0; desc(0, rr0, kb0, kc0, pa0); NLOAD(g0 + rr0); }
#pragma unroll 1
  for (int un = 0; un < nun; ++un) {
    int rr, kbeg, kcnt; bool partial;
    desc(un, rr, kbeg, kcnt, partial);
    const int row = g0 + rr;
    float tf[16];
    {
      const uint2 t0 = nt0, t1 = nt1, t2 = nt2, t3 = nt3;
      tf[0] = bflo(t0.x); tf[1] = bfhi(t0.x); tf[2] = bflo(t0.y); tf[3] = bfhi(t0.y); tf[4] = bflo(t1.x); tf[5] = bfhi(t1.x); tf[6] = bflo(t1.y); tf[7] = bfhi(t1.y);
      tf[8] = bflo(t2.x); tf[9] = bfhi(t2.x); tf[10] = bflo(t2.y); tf[11] = bfhi(t2.y); tf[12] = bflo(t3.x); tf[13] = bfhi(t3.x); tf[14] = bflo(t3.y); tf[15] = bfhi(t3.y);
    }
    float tam = 0.f;
#pragma unroll
    for (int j = 0; j < 16; ++j) tam = fmaxf(tam, fabsf(tf[j]));
    tam = wave_max_dpp(tam);
    const float st = tam > 0.f ? tam * (1.f / 127.f) : 1.f, tinv = 1.f / st;
    int tq[4];
#pragma unroll
    for (int k4 = 0; k4 < 4; ++k4) {
      unsigned ww = 0u;
#pragma unroll
      for (int j = 0; j < 4; ++j) ww |= (unsigned)((int)rintf(tf[k4 * 4 + j] * tinv) & 255) << (8 * j);
      tq[k4] = (int)ww;
    }
    const int id_lo = nid_lo, id_hi = nid_hi;
    const float ga_lo = nga_lo, ga_hi = nga_hi;
    const float su_lo = p.su[id_lo], su_hi = p.su[id_hi], sv_lo = p.sv[id_lo], sv_hi = p.sv[id_hi];
    float f[16];
#pragma unroll
    for (int j = 0; j < 16; ++j) f[j] = 0.f;
    uint4 rb[8];
    int dlo = 0, dhi = 0;
#define ULOAD(slot, kk) do { const int e_ = __builtin_amdgcn_readlane((kk) < 64 ? id_lo : id_hi, (kk) & 63); \
      const u32x4_t u_ = __builtin_amdgcn_raw_buffer_load_b128(ursrc, lane16, e_ * D, 0);        \
      rb[slot].x = u_.x; rb[slot].y = u_.y; rb[slot].z = u_.z; rb[slot].w = u_.w; } while (0)
#define VLOAD(slot, kk) do { const int e_ = __builtin_amdgcn_readlane((kk) < 64 ? id_lo : id_hi, (kk) & 63); \
      const u32x2_t t_ = __builtin_amdgcn_raw_buffer_load_b64(vrsrc, lane8, e_ * QROW, 0); rb[slot].x = t_.x; rb[slot].y = t_.y; } while (0)
    auto proc4u = [&](int s0, int k0) {
      int dot[4];
#pragma unroll
      for (int u = 0; u < 4; ++u) {
        const uint4 a_ = rb[s0 + u];
        int di = __builtin_amdgcn_sdot4((int)a_.x, tq[0], 0, false); di = __builtin_amdgcn_sdot4((int)a_.y, tq[1], di, false);
        di = __builtin_amdgcn_sdot4((int)a_.z, tq[2], di, false); di = __builtin_amdgcn_sdot4((int)a_.w, tq[3], di, false);
        dot[u] = di;
      }
#define DPPSTEP(ctl, rm) do { _Pragma("unroll") for (int u = 0; u < 4; ++u) dot[u] += __builtin_amdgcn_update_dpp(0, dot[u], ctl, rm, 0xF, true); } while (0)
      DPPSTEP(0xB1, 0xF); DPPSTEP(0x4E, 0xF); DPPSTEP(0x141, 0xF); DPPSTEP(0x140, 0xF); DPPSTEP(0x142, 0xA); DPPSTEP(0x143, 0xC);
#undef DPPSTEP
      if (k0 < 64) {
#pragma unroll
        for (int u = 0; u < 4; ++u) dlo = __builtin_amdgcn_update_dpp(dot[u], dlo, 0x130, 0xF, 0xF, false);
      } else {
#pragma unroll
        for (int u = 0; u < 4; ++u) dhi = __builtin_amdgcn_update_dpp(dot[u], dhi, 0x130, 0xF, 0xF, false);
      }
    };
    float act_lo = 0.f, act_hi = 0.f;
    auto proc4v = [&](int s0, int k0) {
      float act[4];
      if (k0 < 64) {
#pragma unroll
        for (int u = 0; u < 4; ++u) act[u] = __uint_as_float((unsigned)__builtin_amdgcn_readlane((int)__float_as_uint(act_lo), k0 + u));
      } else {
#pragma unroll
        for (int u = 0; u < 4; ++u) act[u] = __uint_as_float((unsigned)__builtin_amdgcn_readlane((int)__float_as_uint(act_hi), k0 - 64 + u));
      }
#pragma unroll
      for (int u = 0; u < 4; ++u) {
        const float act_ = act[u];
        const q6w c_ = {rb[s0 + u].x, rb[s0 + u].y, rb[s0 + u].z};
        f[0] = fmaf(act_, q6<0>(c_), f[0]); f[1] = fmaf(act_, q6<1>(c_), f[1]); f[2] = fmaf(act_, q6<2>(c_), f[2]); f[3] = fmaf(act_, q6<3>(c_), f[3]);
        f[4] = fmaf(act_, q6<4>(c_), f[4]); f[5] = fmaf(act_, q6<5>(c_), f[5]); f[6] = fmaf(act_, q6<6>(c_), f[6]); f[7] = fmaf(act_, q6<7>(c_), f[7]);
        f[8] = fmaf(act_, q6<8>(c_), f[8]); f[9] = fmaf(act_, q6<9>(c_), f[9]); f[10] = fmaf(act_, q6<10>(c_), f[10]); f[11] = fmaf(act_, q6<11>(c_), f[11]);
        f[12] = fmaf(act_, q6<12>(c_), f[12]); f[13] = fmaf(act_, q6<13>(c_), f[13]); f[14] = fmaf(act_, q6<14>(c_), f[14]); f[15] = fmaf(act_, q6<15>(c_), f[15]);
      }
    };
    ULOAD(0, kbeg); ULOAD(1, kbeg + 1); ULOAD(2, kbeg + 2); ULOAD(3, kbeg + 3); ULOAD(4, kbeg + 4); ULOAD(5, kbeg + 5); ULOAD(6, kbeg + 6); ULOAD(7, kbeg + 7);
    const int kend = kbeg + kcnt - 8;
#pragma unroll 1
    for (int k = kbeg; k < kend; k += 8) {
      proc4u(0, k); ULOAD(0, k + 8); ULOAD(1, k + 9); ULOAD(2, k + 10); ULOAD(3, k + 11);
      proc4u(4, k + 4); ULOAD(4, k + 12); ULOAD(5, k + 13); ULOAD(6, k + 14); ULOAD(7, k + 15);
    }
    proc4u(0, kend); VLOAD(0, kbeg); VLOAD(1, kbeg + 1); VLOAD(2, kbeg + 2); VLOAD(3, kbeg + 3);
    proc4u(4, kend + 4); VLOAD(4, kbeg + 4); VLOAD(5, kbeg + 5); VLOAD(6, kbeg + 6); VLOAD(7, kbeg + 7);
    if (partial) {
      const int srcl = ((lane - (kbeg & 63) + 32) & 63) * 4;
      const int sh_lo = __builtin_amdgcn_ds_bpermute(srcl, dlo), sh_hi = __builtin_amdgcn_ds_bpermute(srcl, dhi);
      const bool in = lane >= (kbeg & 63) && lane < (kbeg & 63) + 32;
      dlo = in ? sh_lo : 0; dhi = in ? sh_hi : 0;
    }
    act_lo = gelu_fast(su_lo * st * (float)dlo) * ga_lo * sv_lo; act_hi = gelu_fast(su_hi * st * (float)dhi) * ga_hi * sv_hi;
    const float asum = wave_sum_dpp(act_lo + act_hi);
    if (un + 1 < nun) { int nrr, nkb, nkc; bool npa; desc(un + 1, nrr, nkb, nkc, npa); NLOAD(g0 + nrr); }
#pragma unroll 1
    for (int k = kbeg; k < kend; k += 8) {
      proc4v(0, k); VLOAD(0, k + 8); VLOAD(1, k + 9); VLOAD(2, k + 10); VLOAD(3, k + 11);
      proc4v(4, k + 4); VLOAD(4, k + 12); VLOAD(5, k + 13); VLOAD(6, k + 14); VLOAD(7, k + 15);
    }
    proc4v(0, kend); proc4v(4, kend + 4);
#undef ULOAD
#undef VLOAD
    if (!partial) ln_token<FINAL>(p, row, rr, lane, f, asum, As);
    else {
      float* pp = PART + wave * PARTW + lane * 16;
      *(float4*)pp = make_float4(f[0], f[1], f[2], f[3]); *(float4*)(pp + 4) = make_float4(f[4], f[5], f[6], f[7]);
      *(float4*)(pp + 8) = make_float4(f[8], f[9], f[10], f[11]); *(float4*)(pp + 12) = make_float4(f[12], f[13], f[14], f[15]);
      if (lane == 0) PART[wave * PARTW + 1024] = asum;
    }
  }
#undef NLOAD
  if (extra) {
    __syncthreads();
    if (wave < extra) {
      const int wpt = 8 / extra, rr = nfull * 8 + wave;
      float f[16], asum = 0.f;
#pragma unroll
      for (int j = 0; j < 16; ++j) f[j] = 0.f;
      for (int w2 = wave * wpt; w2 < wave * wpt + wpt; ++w2) {
        const float* pp = PART + w2 * PARTW + lane * 16;
#pragma unroll
        for (int q4 = 0; q4 < 4; ++q4) { const float4 x4 = *(const float4*)(pp + q4 * 4); f[q4 * 4] += x4.x; f[q4 * 4 + 1] += x4.y; f[q4 * 4 + 2] += x4.z; f[q4 * 4 + 3] += x4.w; }
        asum += PART[w2 * PARTW + 1024];
      }
      ln_token<FINAL>(p, g0 + rr, rr, lane, f, asum, As);
    }
  }
}

__device__ __forceinline__ void cvt_plain(const float* __restrict__ a, bf16_t* __restrict__ o, size_t n8, bool lo, size_t gtid, size_t gsz) {
  for (size_t i = gtid; i < n8; i += gsz) {
    float v[8];
    *(float4*)&v[0] = ((const float4*)a)[i * 2]; *(float4*)&v[4] = ((const float4*)a)[i * 2 + 1];
    if (lo) {
#pragma unroll
      for (int j = 0; j < 8; ++j) v[j] = v[j] - bf2f(f2bf(v[j]));
    }
    uint4 w; w.x = pack2bf(v[0], v[1]); w.y = pack2bf(v[2], v[3]); w.z = pack2bf(v[4], v[5]); w.w = pack2bf(v[6], v[7]);
    ((uint4*)o)[i] = w;
  }
}
__device__ __forceinline__ void cvt_t(const float* __restrict__ W, bf16_t* __restrict__ Wt, int K, int N, bool lo, size_t gtid, size_t gsz) {
  const int N4 = N >> 2;
  const size_t total = (size_t)N4 * (K / 8);
#pragma unroll 2
  for (size_t i = gtid; i < total; i += gsz) {
    const int n = (int)(i % N4) * 4, k8 = (int)(i / N4);
    float4 r[8];
#pragma unroll
    for (int j = 0; j < 8; ++j) r[j] = *(const float4*)(W + (size_t)(k8 * 8 + j) * N + n);
    if (lo) {
#pragma unroll
      for (int j = 0; j < 8; ++j) { r[j].x -= bf2f(f2bf(r[j].x)); r[j].y -= bf2f(f2bf(r[j].y)); r[j].z -= bf2f(f2bf(r[j].z)); r[j].w -= bf2f(f2bf(r[j].w)); }
    }
    uint4* dst = (uint4*)(Wt + ((size_t)((n >> 4) * (K >> 5) + (k8 >> 2)) * 64 + (k8 & 3) * 16 + (n & 15)) * 8);
    dst[0] = make_uint4(pack2bf(r[0].x, r[1].x), pack2bf(r[2].x, r[3].x), pack2bf(r[4].x, r[5].x), pack2bf(r[6].x, r[7].x));
    dst[1] = make_uint4(pack2bf(r[0].y, r[1].y), pack2bf(r[2].y, r[3].y), pack2bf(r[4].y, r[5].y), pack2bf(r[6].y, r[7].y));
    dst[2] = make_uint4(pack2bf(r[0].z, r[1].z), pack2bf(r[2].z, r[3].z), pack2bf(r[4].z, r[5].z), pack2bf(r[6].z, r[7].z));
    dst[3] = make_uint4(pack2bf(r[0].w, r[1].w), pack2bf(r[2].w, r[3].w), pack2bf(r[4].w, r[5].w), pack2bf(r[6].w, r[7].w));
  }
}
__device__ __forceinline__ void cvt_t8(const float* __restrict__ W, unsigned char* __restrict__ Wt, int K, int N, size_t gtid, size_t gsz) {
  const int N4 = N >> 2;
  const size_t total = (size_t)N4 * (K / 8);
#pragma unroll 2
  for (size_t i = gtid; i < total; i += gsz) {
    const int n = (int)(i % N4) * 4, k8 = (int)(i / N4);
    float4 r[8];
#pragma unroll
    for (int j = 0; j < 8; ++j) r[j] = *(const float4*)(W + (size_t)(k8 * 8 + j) * N + n);
    unsigned char* dst = Wt + ((size_t)((n >> 4) * (K >> 6) + (k8 >> 3)) * 64 + (k8 & 3) * 16 + (n & 15)) * 16 + ((k8 >> 2) & 1) * 8;
#define PK8(C) make_uint2((unsigned)__builtin_amdgcn_cvt_pk_fp8_f32(r[2].C * 32.f, r[3].C * 32.f, __builtin_amdgcn_cvt_pk_fp8_f32(r[0].C * 32.f, r[1].C * 32.f, 0, false), true), \
                          (unsigned)__builtin_amdgcn_cvt_pk_fp8_f32(r[6].C * 32.f, r[7].C * 32.f, __builtin_amdgcn_cvt_pk_fp8_f32(r[4].C * 32.f, r[5].C * 32.f, 0, false), true))
    *(uint2*)(dst) = PK8(x); *(uint2*)(dst + 16) = PK8(y); *(uint2*)(dst + 32) = PK8(z); *(uint2*)(dst + 48) = PK8(w);
#undef PK8
  }
}
__device__ __forceinline__ void mod_item(const float* __restrict__ c, const float* __restrict__ c_ctx, const float* __restrict__ ada_w, const float* __restrict__ ada_b,
                                         float* __restrict__ MOD, int item, bool valid, char* lds, int tid, int nct, volatile int* cbc, int& cgen) {
  float* sc = (float*)lds;
  float* part = sc + 3072;
  const int wave = tid >> 6, lane = tid & 63, l = item / 96, cg = item % 96, nw = nct >> 6;
  if (valid) for (int i = tid; i < 3072; i += nct) { const int v = i >> 10, k = i & 1023; const float xv = v < 2 ? c[v * 1024 + k] : c_ctx[k]; sc[i] = xv / (1.f + expf(-xv)); }
  cbar(cbc, cgen, nw);
  if (valid) {
    float a0 = 0.f, a1 = 0.f, a2 = 0.f;
    const float* W = ada_w + (size_t)l * 1024 * 6144 + cg * 64 + lane;
    const int kb = wave * 171, ke = kb + 171 < 1024 ? kb + 171 : 1024;
#pragma unroll 57
    for (int k = kb; k < ke; ++k) { const float w = W[(size_t)k * 6144]; a0 += sc[k] * w; a1 += sc[1024 + k] * w; a2 += sc[2048 + k] * w; }
    part[(wave * 3 + 0) * 64 + lane] = a0; part[(wave * 3 + 1) * 64 + lane] = a1; part[(wave * 3 + 2) * 64 + lane] = a2;
  }
  cbar(cbc, cgen, nw);
  if (valid && tid < 192) {
    const int v = tid >> 6, ln = tid & 63; float sum = 0.f;
    for (int w = 0; w < nw; ++w) sum += part[(w * 3 + v) * 64 + ln];
    MOD[(l * 3 + v) * 6144 + cg * 64 + ln] = sum + ada_b[l * 6144 + cg * 64 + ln];
  }
}

__device__ __forceinline__ void gbar(unsigned* cnt, unsigned target) {
  asm volatile("s_waitcnt vmcnt(0)" ::: "memory");
  __syncthreads();
  if (otid() == 0) {
    __builtin_amdgcn_fence(__ATOMIC_RELEASE, "agent");
    asm volatile("s_waitcnt vmcnt(0)" ::: "memory");
    __hip_atomic_fetch_add(cnt, 1u, __ATOMIC_RELAXED, __HIP_MEMORY_SCOPE_AGENT);
    unsigned spins = 0;
    while (__hip_atomic_load(cnt, __ATOMIC_RELAXED, __HIP_MEMORY_SCOPE_AGENT) < target) { __builtin_amdgcn_s_sleep(2); if (++spins > (1u << 24)) break; }
    __builtin_amdgcn_fence(__ATOMIC_ACQUIRE, "agent");
    asm volatile("s_waitcnt vmcnt(0)" ::: "memory");
  }
  __syncthreads();
}

struct MP {
  const float *x, *c, *ctx, *c_ctx, *ada_w, *ada_b, *ln_g, *ln_b, *s5_a_re, *s5_a_im, *s5_log_dt, *s5_b_re, *s5_b_im, *s5_c_re, *s5_c_im, *s5_d, *s5_w_glu, *s5_w_o;
  const float *mla_w_dq, *mla_q_norm, *mla_w_uq, *mla_w_dkv, *mla_kv_norm, *mla_w_ukv, *mla_w_o, *peer_w_q, *peer_keys, *peer_u, *peer_v;
  float* out;
  float* MOD; bf16_t *Wt_glu, *Wt_o0, *Wt_q0, *Wt_o1, *Wt_q1, *Wt_cat, *Wt_uq, *Wt_ukv, *Khi, *Khi1;
  unsigned char *U0, *V0, *U1, *V1; float *SU0, *SV0, *SU1, *SV1; bf16_t *Ktab, *Bst_t, *Cin_t;
  bf16_t* Ypart; float* Ssta; bf16_t *HP, *Gbf, *Vbf, *Tbf; float *OQ, *H1, *H2; int* IDX; float* GATE;
  bf16_t *Qa, *AObf; unsigned char *Kn, *Kr, *Va; float* H3; bf16_t* Tbf1; unsigned* BAR; float* PART;
};
constexpr int LDS_BYTES = 66 * 784 + 66 * 528 + 1024 * 68 + 64;
__global__ __launch_bounds__(512) void mega(MP p) {
  __shared__ __attribute__((aligned(16))) char lds[LDS_BYTES];
  cg::grid_group grid = cg::this_grid();
  const int nblk = gridDim.x;
  int bid = blockIdx.x;
  const size_t TD = (size_t)1024 * 16384;
  const float* mod0 = p.MOD; const float* mod1 = p.MOD + 3 * 6144;
  {
    volatile int* cbc = (volatile int*)(lds + LDS_BYTES - 16);
    if (otid() == 0) *cbc = 0;
    __syncthreads();
    const int t0 = otid();
    if (t0 < 128) {
      const size_t mt = (size_t)bid * 128 + t0, ms = (size_t)nblk * 128;
      const int mw = bid * 2 + (t0 >> 6), nmw = nblk * 2;
      cvt_t(p.s5_w_glu, p.Wt_glu, D, D, false, mt, ms);
      cvt_t(p.s5_w_o, p.Wt_o0, D, D, false, mt, ms);
      cvt_t(p.peer_w_q, p.Wt_q0, D, D, false, mt, ms);
      cvt_t8(p.mla_w_o, (unsigned char*)p.Wt_o1, D, D, mt, ms);
      cvt_t(p.peer_w_q + (size_t)D * D, p.Wt_q1, D, D, false, mt, ms);
      cvt_t8(p.mla_w_dq, (unsigned char*)p.Wt_cat, D, 384, mt, ms);
      cvt_t8(p.mla_w_dkv, (unsigned char*)p.Wt_cat + (size_t)384 * D, D, 320, mt, ms);
      cvt_t8(p.mla_w_uq, (unsigned char*)p.Wt_uq, 384, 1536, mt, ms);
      cvt_t8(p.mla_w_ukv, (unsigned char*)p.Wt_ukv, 256, 2048, mt, ms);
      cvt_plain(p.peer_keys, p.Khi, (size_t)2 * 131072 / 8, false, mt, ms);
      cvt_rows_i8<true>(p.peer_u, p.U0, p.SU0, 16384, mw, nmw);
      cvt_rows_q6(p.peer_v, p.V0, p.SV0, 16384, mw, nmw);
      cvt_rows_i8<true>(p.peer_u + TD, p.U1, p.SU1, 16384, mw, nmw);
      cvt_rows_q6(p.peer_v + TD, p.V1, p.SV1, 16384, mw, nmw);
    } else {
      int cgen = 0;
      const int ct = t0 - 128;
      ph_s5_prep(p.s5_a_re, p.s5_a_im, p.s5_log_dt, p.s5_b_re, p.s5_b_im, p.s5_c_re, p.s5_c_im, p.Ktab, p.Bst_t, p.Cin_t, bid >> 2, bid & 3, lds, ct, 384, cbc, cgen);
      cbar(cbc, cgen, 6);
      mod_item(p.c, p.c_ctx, p.ada_w, p.ada_b, p.MOD, bid, bid < 192, lds, ct, 384, cbc, cgen);
    }
  }
  grid.sync();
  asm volatile("" : "+s"(bid));
  ph_s5_p1(p.x, p.ctx, mod0, p.Ktab, p.Bst_t, p.s5_d, p.Ypart, p.Ssta, bid, lds);
  gbar(p.BAR + 16 + (bid >> 2) * 16, 4u);
  asm volatile("" : "+s"(bid));
  if (otid() < 64) ph_s5_carry(p.Ssta, p.s5_a_re, p.s5_a_im, p.s5_log_dt, p.HP, ((bid & 2) << 6) | ((bid >> 2) << 1) | (bid & 1), otid());
  gbar(p.BAR + 16 + (bid >> 2) * 16, 8u);
  asm volatile("" : "+s"(bid));
  ph_s5_p3(p.HP, p.Cin_t, p.Ypart, p.Gbf, bid, lds);
  gbar(p.BAR, 1u * (unsigned)nblk);
  asm volatile("" : "+s"(bid));
  {
    ChainP cp{p.Gbf, p.Wt_glu, p.Wt_o0, p.Wt_q0, p.Vbf, (bf16_t*)p.OQ + (size_t)bid * 66 * D, p.x, p.ctx, mod0, p.ln_g, p.ln_b, p.H1, p.Tbf, (bf16_t*)p.OQ + (size_t)bid * 66 * D  };
    ph_chainA<true>(cp, bid, lds);
    __syncthreads();
    ph_route(RouteP{(bf16_t*)p.OQ + (size_t)bid * 66 * D, p.Khi, p.IDX, p.GATE, 66, 0}, bid, lds);
    __syncthreads();
    GatherP gp{p.Tbf, p.IDX, p.GATE, p.U0, p.V0, p.SU0, p.SV0, p.H1, mod0, p.ln_g + D, p.ln_b + D, p.H2, mod1};
    ph_gather_tm<false>(gp, bid * 66, 66, lds, p.PART + (size_t)bid * 8 * PARTW);
    __syncthreads();
    ProjP pp{p.Wt_cat, p.Wt_uq, p.Wt_ukv, p.mla_q_norm, p.mla_kv_norm, p.OQ  , p.Qa, p.Kn, p.Kr, p.Va};
    ph_mla_proj(pp, bid, lds);
  }
  gbar(p.BAR, 2u * (unsigned)nblk);
  asm volatile("" : "+s"(bid));
  ph_attn(p.Qa, p.Kn, p.Kr, p.Va, p.AObf, bid, nblk, lds);
  gbar(p.BAR, 3u * (unsigned)nblk);
  asm volatile("" : "+s"(bid));
  {
    ChainP cp{p.AObf, nullptr, p.Wt_o1, p.Wt_q1, nullptr, (bf16_t*)p.OQ + (size_t)bid * 64 * D, p.H2, p.H2 + (size_t)NL * D, mod1, p.ln_g + 2 * D, p.ln_b + 2 * D, p.H3, p.Tbf1, (bf16_t*)p.OQ + (size_t)bid * 64 * D};
    ph_chainA<false>(cp, bid, lds);
    __syncthreads();
    ph_route(RouteP{(bf16_t*)p.OQ + (size_t)bid * 64 * D, p.Khi1, p.IDX, p.GATE, 64, 0}, bid, lds);
    __syncthreads();
    GatherP gp{p.Tbf1, p.IDX, p.GATE, p.U1, p.V1, p.SU1, p.SV1, p.H3, mod1, p.ln_g + 3 * D, p.ln_b + 3 * D, p.out, mod1};
    ph_gather_tm<true>(gp, bid * 64, 64, lds, p.PART + (size_t)bid * 8 * PARTW);
  }
}

extern "C" void kernel_launch(void* const* d_in, const int* in_sizes, int n_in, void* d_out, int out_size, void* d_ws, size_t ws_size, hipStream_t stream) {
  MP p{};
  const float** in = (const float**)&p;
  for (int i = 0; i < 29; ++i) in[i] = (const float*)d_in[i];
  p.out = (float*)d_out;
  char* ws = (char*)d_ws; size_t off = 0;
  auto carve = [&](size_t bytes) { char* q = ws + off; off += (bytes + 255) / 256 * 256; return q; };
  const size_t TDB = (size_t)1024 * 16384 * 2, BIG = (size_t)NT * D * 4, HALF = (size_t)NT * D * 2;
  p.MOD = (float*)carve(2 * 3 * 6144 * 4);
  p.Wt_glu = (bf16_t*)carve((size_t)D * D * 2); p.Wt_o0 = (bf16_t*)carve((size_t)D * D * 2); p.Wt_q0 = (bf16_t*)carve((size_t)D * D * 2);
  p.Wt_o1 = (bf16_t*)carve((size_t)D * D * 2); p.Wt_q1 = (bf16_t*)carve((size_t)D * D * 2);
  p.Wt_cat = (bf16_t*)carve((size_t)704 * D * 2); p.Wt_uq = (bf16_t*)carve((size_t)1536 * 384 * 2); p.Wt_ukv = (bf16_t*)carve((size_t)2048 * 256 * 2);
  p.Khi = (bf16_t*)carve((size_t)2 * 131072 * 2); p.Khi1 = p.Khi + 131072;
  char* T0 = carve(TDB); p.U0 = (unsigned char*)T0; p.V0 = (unsigned char*)(T0 + TDB / 2); p.AObf = (bf16_t*)T0;
  p.SU0 = (float*)carve(16384 * 4); p.SV0 = (float*)carve(16384 * 4); p.SU1 = (float*)carve(16384 * 4); p.SV1 = (float*)carve(16384 * 4);
  const size_t KTAB_B = (size_t)64 * 127 * 256 * 2, BST_B = (size_t)64 * 256 * 1024 * 2, KN_B = (size_t)NB * 8 * KEYS * 128 * 2, KR_B = (size_t)NB * KEYS * 64 * 2;
  size_t x1 = KTAB_B + 2 * BST_B; if (x1 < 2 * KN_B + KR_B) x1 = 2 * KN_B + KR_B;
  char* X1 = carve(x1);
  p.Ktab = (bf16_t*)X1; p.Bst_t = (bf16_t*)(X1 + KTAB_B); p.Cin_t = (bf16_t*)(X1 + KTAB_B + BST_B);
  p.Kn = (unsigned char*)X1; p.Va = (unsigned char*)(X1 + KN_B); p.Kr = (unsigned char*)(X1 + 2 * KN_B); p.H3 = (float*)X1;
  char* X2 = carve(BIG); p.Ypart = (bf16_t*)X2; p.OQ = (float*)X2;
  char* X3 = carve(HALF); p.Ssta = (float*)X3; p.HP = (bf16_t*)(X3 + (size_t)NCC * 64 * 256 * 4); p.Vbf = (bf16_t*)X3;
  char* X4 = carve(HALF); p.Gbf = (bf16_t*)X4; p.Tbf = (bf16_t*)X4; p.Tbf1 = (bf16_t*)X4;
  char* X5 = carve(BIG); p.H1 = (float*)X5;
  char* T1 = carve(TDB); p.U1 = (unsigned char*)T1; p.V1 = (unsigned char*)(T1 + TDB / 2);
  p.H2 = (float*)carve(BIG);
  p.IDX = (int*)carve((size_t)NT * 128 * 4); p.GATE = (float*)carve((size_t)NT * 128 * 4);
  p.Qa = (bf16_t*)carve((size_t)NB * 8 * SEQ * 192 * 2);
  p.BAR = (unsigned*)carve(8192);
  p.PART = (float*)carve((size_t)256 * 8 * PARTW * 4);
  if (off > ws_size || n_in != 29) { fprintf(stderr, "kernel_launch: workspace too small (need %zu, have %zu) or n_in %d != 29\n", off, ws_size, n_in); return; }
  static int grid_blocks = 0;
  if (!grid_blocks) {
    int dev = 0, cus = 0, per_cu = 0;
    hipGetDevice(&dev);
    hipDeviceGetAttribute(&cus, hipDeviceAttributeMultiprocessorCount, dev);
    hipOccupancyMaxActiveBlocksPerMultiprocessor(&per_cu, mega, 512, 0);
    if (per_cu < 1 || cus < 256) { fprintf(stderr, "kernel_launch: need 256 resident workgroups (cus %d, per_cu %d)\n", cus, per_cu); return; }
    grid_blocks = 256;
  }
  hipMemsetAsync(p.BAR, 0, 8192, stream);
  void* args[] = {&p};
  hipError_t e = hipLaunchCooperativeKernel((void*)mega, dim3(grid_blocks), dim3(512), args, 0, stream);
  if (e != hipSuccess) fprintf(stderr, "cooperative launch failed: %s\n", hipGetErrorString(e));
}
```
